# Optimizing an MI355X kernel written in HIP

```python
import jax, jax.numpy as jnp
from jax import lax
import numpy as np

D_MODEL = 1024
BATCH = 2
SEQ = 8192
DEPTH = 1

GRID_W = 64
CTX_LEN = 256
EPS = 1e-6

D_A = D_MODEL // 2
G_A = 4
CHUNK = 128

N_HEADS = 8
N_KV = 2
REP = N_HEADS // N_KV
HEAD_DIM = 64
D_Q = N_HEADS * HEAD_DIM
D_KV = N_KV * HEAD_DIM
WINDOW = 128
WBLK = 128
ROPE_THETA = 10000.0

D_IN = 2 * D_A + D_Q + 2 * D_KV + 2 * D_MODEL
SPLITS = (D_A, 2 * D_A, 2 * D_A + D_Q, 2 * D_A + D_Q + D_KV,
          2 * D_A + D_Q + 2 * D_KV, 2 * D_A + D_Q + 2 * D_KV + D_MODEL)
KV_LO = SPLITS[2]
KV_HI = SPLITS[4]

N_EXPERTS = 256
TOP_K = 8
D_EXPERT = D_MODEL // 4
D_SHARED = D_MODEL // 4
ROUTE_SCALE = 2.5
MOE_BLK = 128

kernel_name = 'hybrid_gmlp_swa_moe_dit_block'


def rmsnorm(x, g):
    x32 = x.astype(jnp.float32)
    y = x32 * lax.rsqrt(jnp.mean(x32 * x32, axis=-1, keepdims=True) + EPS)
    return y.astype(x.dtype) * g


def layernorm(x, g, b):
    x32 = x.astype(jnp.float32)
    mu = jnp.mean(x32, axis=-1, keepdims=True)
    var = jnp.mean(jnp.square(x32 - mu), axis=-1, keepdims=True)
    return ((x32 - mu) * lax.rsqrt(var + EPS)).astype(x.dtype) * g + b


def modulate(h, shift, scale):
    return h * (1 + scale) + shift


def ada_mod(cond, w, b):
    m = jax.nn.silu(cond) @ w + b
    return jnp.split(m[:, None, :], 6, axis=-1)


def axial_rope_tables(L, dtype):
    rows_n = L // GRID_W
    row, col = jnp.meshgrid(jnp.arange(rows_n), jnp.arange(GRID_W), indexing='ij')
    n_freq = HEAD_DIM // 4
    inv = ROPE_THETA ** (-jnp.arange(n_freq, dtype=jnp.float32) / n_freq)
    ang_r = row.reshape(-1)[:, None].astype(jnp.float32) * inv
    ang_c = col.reshape(-1)[:, None].astype(jnp.float32) * inv
    return (jnp.cos(ang_r).astype(dtype), jnp.sin(ang_r).astype(dtype),
            jnp.cos(ang_c).astype(dtype), jnp.sin(ang_c).astype(dtype))


def apply_rope(t, tables):
    cr, sr, cc, sc = tables

    def rot(xh, cos, sin):
        x1, x2 = jnp.split(xh, 2, axis=-1)
        cos = cos[None, :, None, :]
        sin = sin[None, :, None, :]
        return jnp.concatenate([x1 * cos - x2 * sin, x2 * cos + x1 * sin], axis=-1)

    t_row, t_col = jnp.split(t, 2, axis=-1)
    return jnp.concatenate([rot(t_row, cr, sr), rot(t_col, cc, sc)], axis=-1)


def heads(t, n):
    B, L, _ = t.shape
    return t.reshape(B, L, n, HEAD_DIM)


def split_proj(z):
    u, v, q, k, val, ga, gb = jnp.split(z, SPLITS, axis=-1)
    return u, v, heads(q, N_HEADS), heads(k, N_KV), heads(val, N_KV), ga, gb


def chunk_gmlp(u, v, ln_g, ln_b, w_s, b_s):
    B, L, _ = u.shape
    u = jax.nn.gelu(u)
    v = layernorm(jax.nn.gelu(v), ln_g, ln_b)
    vb = v.reshape(B, L // CHUNK, CHUNK, G_A, D_A // G_A)
    s = jnp.einsum('gpq,bnqgc->bnpgc', w_s, vb) + b_s.T[None, None, :, :, None]
    return u * s.reshape(B, L, D_A)


def window_attention(q, k, v, kc, vc, sink):
    B, L, _, _ = q.shape
    nb = L // WBLK
    scale = HEAD_DIM ** -0.5
    qb = q.reshape(B, nb, WBLK, N_KV, REP, HEAD_DIM)

    def band(t):
        tp = jnp.pad(t, ((0, 0), (WBLK, WBLK), (0, 0), (0, 0))).reshape(B, nb + 2, WBLK, N_KV, HEAD_DIM)
        return jnp.concatenate([tp[:, :-2], tp[:, 1:-1], tp[:, 2:]], axis=2)

    kw, vw = band(k), band(v)
    s_win = jnp.einsum('bnqhrd,bnkhd->bnhrqk', qb, kw).astype(jnp.float32) * scale
    q_pos = jnp.arange(nb)[:, None] * WBLK + jnp.arange(WBLK)[None, :]
    k_pos = jnp.arange(nb)[:, None] * WBLK - WBLK + jnp.arange(3 * WBLK)[None, :]
    kp = k_pos[:, None, :]
    valid = (kp >= 0) & (kp < L) & (jnp.abs(kp - q_pos[:, :, None]) <= WINDOW)
    s_win = jnp.where(valid[None, :, None, None], s_win, -jnp.inf)
    s_ctx = jnp.einsum('bnqhrd,bchd->bnhrqc', qb, kc).astype(jnp.float32) * scale
    s_sink = jnp.broadcast_to(sink.astype(jnp.float32).reshape(N_KV, REP)[None, None, :, :, None, None],
                              (B, nb, N_KV, REP, WBLK, 1))
    p = jax.nn.softmax(jnp.concatenate([s_win, s_ctx, s_sink], axis=-1), axis=-1).astype(v.dtype)
    n_win = 3 * WBLK
    n_ctx = kc.shape[1]
    o = (jnp.einsum('bnhrqk,bnkhd->bnqhrd', p[..., :n_win], vw)
         + jnp.einsum('bnhrqc,bchd->bnqhrd', p[..., n_win:n_win + n_ctx], vc))
    return o.reshape(B, L, D_Q)


def context_attention(qc, kc, vc, sink):
    B, C, _, _ = qc.shape
    qr = qc.reshape(B, C, N_KV, REP, HEAD_DIM)
    s = jnp.einsum('bqhrd,bkhd->bhrqk', qr, kc).astype(jnp.float32) * HEAD_DIM ** -0.5
    s_sink = jnp.broadcast_to(sink.astype(jnp.float32).reshape(N_KV, REP)[None, :, :, None, None],
                              (B, N_KV, REP, C, 1))
    p = jax.nn.softmax(jnp.concatenate([s, s_sink], axis=-1), axis=-1).astype(vc.dtype)
    o = jnp.einsum('bhrqk,bkhd->bqhrd', p[..., :C], vc)
    return o.reshape(B, C, D_Q)


def merge_branches(a, o, ga, gb, w_a, w_b, w_o):
    y = jax.nn.sigmoid(ga) * (a @ w_a) + jax.nn.sigmoid(gb) * (o @ w_b)
    return y @ w_o


def moe_ffn(h, router_w, router_b, w_gate, w_up, w_down, ws_gate, ws_up, ws_down):
    shape = h.shape
    hf = h.reshape(-1, D_MODEL)
    T = hf.shape[0]
    scores = jax.nn.sigmoid(hf.astype(jnp.float32) @ router_w.astype(jnp.float32))
    _, idx = lax.top_k(scores + router_b.astype(jnp.float32), TOP_K)
    sel = jnp.take_along_axis(scores, idx, axis=1)
    gate_w = ROUTE_SCALE * sel / jnp.sum(sel, axis=-1, keepdims=True)

    n_assign = T * TOP_K
    n_blocks = -(-n_assign // MOE_BLK) + N_EXPERTS
    flat_e = idx.reshape(-1)
    flat_t = jnp.repeat(jnp.arange(T, dtype=jnp.int32), TOP_K)
    order = jnp.argsort(flat_e)
    sorted_e = flat_e[order]
    sorted_t = flat_t[order]
    w_sorted = gate_w.reshape(-1)[order]
    counts = jnp.bincount(flat_e, length=N_EXPERTS)
    group_start = jnp.cumsum(counts) - counts
    padded_counts = (counts + MOE_BLK - 1) // MOE_BLK * MOE_BLK
    padded_end = jnp.cumsum(padded_counts)
    padded_start = padded_end - padded_counts
    dest = padded_start[sorted_e] + (jnp.arange(n_assign) - group_start[sorted_e])
    buf_tok = jnp.full((n_blocks * MOE_BLK,), T, jnp.int32).at[dest].set(sorted_t)
    block_expert = jnp.minimum(
        jnp.searchsorted(padded_end, jnp.arange(n_blocks) * MOE_BLK, side='right'), N_EXPERTS - 1)
    h_pad = jnp.concatenate([hf, jnp.zeros((1, D_MODEL), hf.dtype)], axis=0)

    def expert_block(args):
        tok, e = args
        xb = jnp.take(h_pad, tok, axis=0)
        act = jax.nn.silu(xb @ w_gate[e]) * (xb @ w_up[e])
        return act @ w_down[e]

    rows = lax.map(expert_block, (buf_tok.reshape(n_blocks, MOE_BLK), block_expert))
    rows = rows.reshape(n_blocks * MOE_BLK, D_MODEL)
    contrib = rows[dest] * w_sorted[:, None].astype(hf.dtype)
    routed = jax.ops.segment_sum(contrib, sorted_t, num_segments=T)
    shared = (jax.nn.silu(hf @ ws_gate) * (hf @ ws_up)) @ ws_down
    return (routed + shared).reshape(shape)


def setup_inputs(seed: int = 0) -> dict:
    key = jax.random.key(seed)
    ks = jax.random.split(key, 32)
    f32 = jnp.float32
    D = D_MODEL

    def nrm(k, shape, scale):
        return jax.random.normal(k, shape, f32) * scale

    return {
        'x': nrm(ks[0], (BATCH, SEQ, D), 1.0),
        'c': nrm(ks[1], (BATCH, D), 1.0),
        'ctx': nrm(ks[2], (BATCH, CTX_LEN, D), 1.0),
        'c_ctx': nrm(ks[3], (D,), 1.0),
        'ada_w': nrm(ks[4], (DEPTH, D, 6 * D), 0.5 * D ** -0.5),
        'ada_b': nrm(ks[5], (DEPTH, 6 * D), 0.02),
        'norm1_g': 1.0 + nrm(ks[6], (DEPTH, D), 0.05),
        'norm2_g': 1.0 + nrm(ks[7], (DEPTH, D), 0.05),
        'w_in': nrm(ks[8], (DEPTH, D, D_IN), D ** -0.5),
        'gmlp_ln_g': 1.0 + nrm(ks[9], (DEPTH, D_A), 0.05),
        'gmlp_ln_b': nrm(ks[10], (DEPTH, D_A), 0.02),
        'gmlp_ws': nrm(ks[11], (DEPTH, G_A, CHUNK, CHUNK), CHUNK ** -0.5),
        'gmlp_bs': 1.0 + nrm(ks[12], (DEPTH, G_A, CHUNK), 0.1),
        'attn_sink': nrm(ks[13], (DEPTH, N_HEADS), 0.5),
        'w_branch_a': nrm(ks[14], (DEPTH, D_A, D), D_A ** -0.5),
        'w_branch_b': nrm(ks[15], (DEPTH, D_Q, D), D_Q ** -0.5),
        'w_out': nrm(ks[16], (DEPTH, D, D), D ** -0.5),
        'router_w': nrm(ks[17], (DEPTH, D, N_EXPERTS), D ** -0.5),
        'router_b': nrm(ks[18], (DEPTH, N_EXPERTS), 0.01),
        'exp_w_gate': nrm(ks[19], (DEPTH, N_EXPERTS, D, D_EXPERT), D ** -0.5),
        'exp_w_up': nrm(ks[20], (DEPTH, N_EXPERTS, D, D_EXPERT), D ** -0.5),
        'exp_w_down': nrm(ks[21], (DEPTH, N_EXPERTS, D_EXPERT, D), D_EXPERT ** -0.5),
        'sh_w_gate': nrm(ks[22], (DEPTH, D, D_SHARED), D ** -0.5),
        'sh_w_up': nrm(ks[23], (DEPTH, D, D_SHARED), D ** -0.5),
        'sh_w_down': nrm(ks[24], (DEPTH, D_SHARED, D), D_SHARED ** -0.5),
        'final_g': 1.0 + nrm(ks[25], (D,), 0.05),
    }


def reference(x, c, ctx, c_ctx, ada_w, ada_b, norm1_g, norm2_g, w_in, gmlp_ln_g, gmlp_ln_b,
              gmlp_ws, gmlp_bs, attn_sink, w_branch_a, w_branch_b, w_out, router_w, router_b,
              exp_w_gate, exp_w_up, exp_w_down, sh_w_gate, sh_w_up, sh_w_down, final_g):
    rope = axial_rope_tables(x.shape[1], x.dtype)
    xc = ctx
    for l in range(DEPTH):
        last = l == DEPTH - 1
        sh1, sc1, g1, sh2, sc2, g2 = ada_mod(c, ada_w[l], ada_b[l])
        sh1c, sc1c, g1c, sh2c, sc2c, g2c = ada_mod(c_ctx[None], ada_w[l], ada_b[l])

        h = modulate(rmsnorm(x, norm1_g[l]), sh1, sc1)
        hc = modulate(rmsnorm(xc, norm1_g[l]), sh1c, sc1c)
        u, v, q, k, val, ga, gb = split_proj(h @ w_in[l])
        q = apply_rope(q, rope)
        k = apply_rope(k, rope)
        if last:
            k_c, v_c = jnp.split(hc @ w_in[l][:, KV_LO:KV_HI], 2, axis=-1)
            k_c, v_c = heads(k_c, N_KV), heads(v_c, N_KV)
        else:
            u_c, vv_c, q_c, k_c, v_c, ga_c, gb_c = split_proj(hc @ w_in[l])
        a = chunk_gmlp(u, v, gmlp_ln_g[l], gmlp_ln_b[l], gmlp_ws[l], gmlp_bs[l])
        o = window_attention(q, k, val, k_c, v_c, attn_sink[l])
        x = x + g1 * merge_branches(a, o, ga, gb, w_branch_a[l], w_branch_b[l], w_out[l])
        if not last:
            a_c = chunk_gmlp(u_c, vv_c, gmlp_ln_g[l], gmlp_ln_b[l], gmlp_ws[l], gmlp_bs[l])
            o_c = context_attention(q_c, k_c, v_c, attn_sink[l])
            xc = xc + g1c * merge_branches(a_c, o_c, ga_c, gb_c, w_branch_a[l], w_branch_b[l], w_out[l])

        moe_w = (router_w[l], router_b[l], exp_w_gate[l], exp_w_up[l], exp_w_down[l],
                 sh_w_gate[l], sh_w_up[l], sh_w_down[l])
        x = x + g2 * moe_ffn(modulate(rmsnorm(x, norm2_g[l]), sh2, sc2), *moe_w)
        if not last:
            xc = xc + g2c * moe_ffn(modulate(rmsnorm(xc, norm2_g[l]), sh2c, sc2c), *moe_w)
    return rmsnorm(x, final_g)
```

```cpp
#include <hip/hip_runtime.h>
#include <cstdio>
#include <cstdint>
namespace pg8 {
#define PG8_LAS __attribute__((address_space(3)))
typedef unsigned short bf16_t;
typedef short bf16x8 __attribute__((ext_vector_type(8)));
typedef float f32x4 __attribute__((ext_vector_type(4)));
typedef unsigned u32x4 __attribute__((ext_vector_type(4)));
constexpr int BM = 256, BK = 64, HALF = 128, HTB = HALF * BK * 2  , STAGE_BYTES = 8 * HTB, NXCD = 8, WGM = 8;

__host__ __device__ __forceinline__ int lds_byte(int r, int c) { const int st = (r >> 4) * 2 + (c >> 5), rr = r & 15, cc = c & 31, ob = rr * 64 + cc * 2; return st * 1024 + (ob ^ (((ob >> 9) & 1) << 5)); }
__host__ __device__ __forceinline__ void stage_rc(int b, int& R, int& C) { const int st = b / 1024, sb = b % 1024, swz = sb ^ (((sb >> 9) & 1) << 5); R = (st >> 1) * 16 + swz / 64; C = (st & 1) * 32 + (swz % 64) / 2; }
__host__ __device__ __forceinline__ int perm32(int rho) { const int n = rho >> 4, i = rho & 15; return 8 * (i >> 2) + 4 * n + (i & 3); }

struct Unit { int pm, pn; };
struct Gemm { const bf16_t* A; const bf16_t* Bt; int M, N, K; };

struct StaticOrder {
    int nM, nN, nwg, G, c;
    __host__ __device__ void init(int M, int N, int G_, int c_) { nM = M / BM; nN = N / BM; nwg = nM * nN; G = G_; c = c_; }
    __host__ __device__ bool next(int i, Unit& u) const {
        const long L = (long)i * G + c; if (L >= nwg) return false;
        int wgid = (int)L; { const int q = nwg / NXCD, r = nwg % NXCD, xcd = wgid % NXCD, off = wgid / NXCD; wgid = (xcd < r ? xcd * (q + 1) : r * (q + 1) + (xcd - r) * q) + off; }
        const int nig = WGM * nN, gid = wgid / nig, fm = gid * WGM, gsz = (nM - fm) < WGM ? (nM - fm) : WGM;
        u.pm = fm + ((wgid % nig) % gsz); u.pn = (wgid % nig) / gsz; return true;
    }
    __device__ __forceinline__ void a_ready(const Unit&) const {}
    __device__ __forceinline__ void done(const Unit&) const {}
};

__device__ __forceinline__ unsigned cvt_pk_bf16(float lo, float hi) { unsigned r; asm volatile("v_cvt_pk_bf16_f32 %0, %1, %2" : "=v"(r) : "v"(lo), "v"(hi)); return r; }
template <class Epi, class Sched, bool ALIGN_EPI = false, bool SP2 = false>
__device__ __forceinline__ void gemm_phase(PG8_LAS unsigned char* lds, const Gemm g, const Sched& S, const Epi& E) {
    const int tid = threadIdx.x, wid = __builtin_amdgcn_readfirstlane(tid >> 6), lane = tid & 63, wr = wid >> 2, wc = wid & 3, fr = lane & 15, fq = lane >> 4;
    const int K = g.K, nt = K / BK;
    unsigned voffA[2], voffB[2];
#pragma unroll
    for (int i = 0; i < 2; ++i) { int R, C; stage_rc(tid * 16 + i * 8192, R, C); const int Rb = Epi::PERM ? ((R & ~31) + perm32(R & 31)) : R;
        voffA[i] = (unsigned)(R * K + C) * 2u; voffB[i] = (unsigned)(Rb * K + C) * 2u; }
    const size_t kstep = (size_t)(BK * 2);
    const size_t hstep = (size_t)HALF * K * 2;
    const size_t tstep = 2 * hstep;
    const unsigned ldsw = (unsigned)wid * 1024u;
    const int aoff = lds_byte(wr * 64 + fr, fq * 8), boff = lds_byte(wc * 32 + fr, fq * 8);
#define PG8_SA(b, h) (((b) * 2 + (h)) * HTB)
#define PG8_SB(b, h) ((4 + (b) * 2 + (h)) * HTB)
#define PG8_STAGE(bufoff, gbase, voff) do { _Pragma("unroll") for (int _i = 0; _i < 2; ++_i) \
        __builtin_amdgcn_global_load_lds((const unsigned*)((const char*)(gbase) + (voff)[_i]), (PG8_LAS unsigned*)(lds + (bufoff) + ldsw + _i * 8192), 16, 0, 0); } while (0)
#define PG8_LDA(dst, b, h) do { _Pragma("unroll") for (int m = 0; m < 4; ++m) _Pragma("unroll") for (int k = 0; k < 2; ++k) dst[m][k] = *(const PG8_LAS bf16x8*)(lds + PG8_SA(b, h) + aoff + m * 2048 + k * 1024); } while (0)
#define PG8_LDB(dst, b, h) do { _Pragma("unroll") for (int n = 0; n < 2; ++n) _Pragma("unroll") for (int k = 0; k < 2; ++k) dst[n][k] = *(const PG8_LAS bf16x8*)(lds + PG8_SB(b, h) + boff + n * 2048 + k * 1024); } while (0)
#define PG8_MMA(ai, bj, At, Bt) do { __builtin_amdgcn_s_setprio(1); _Pragma("unroll") for (int m = 0; m < 4; ++m) _Pragma("unroll") for (int n = 0; n < 2; ++n) _Pragma("unroll") for (int k = 0; k < 2; ++k) \
        acc[ai][bj][m][n] = __builtin_amdgcn_mfma_f32_16x16x32_bf16(Bt[n][k], At[m][k], acc[ai][bj][m][n], 0, 0, 0); __builtin_amdgcn_s_setprio(0); } while (0)
#define PG8_WAIT_V(n) asm volatile("s_waitcnt vmcnt(" #n ")" ::: "memory")
#define PG8_WAIT_L(n) asm volatile("s_waitcnt lgkmcnt(" #n ")" ::: "memory")
#define PG8_BAR __builtin_amdgcn_s_barrier()
#define PG8_SCHED __builtin_amdgcn_sched_barrier(0)
    Unit cur, nxt; int ui = 0;
    if (!S.next(0, cur)) return;
    f32x4 acc[2][2][4][2];
#pragma unroll
    for (int a = 0; a < 2; ++a)
#pragma unroll
        for (int b = 0; b < 2; ++b)
#pragma unroll
            for (int m = 0; m < 4; ++m)
#pragma unroll
                for (int n = 0; n < 2; ++n) acc[a][b][m][n] = (f32x4){0.f, 0.f, 0.f, 0.f};
    bf16x8 At[4][2], B0[2][2], B1[2][2];
    const char* cA = (const char*)g.A + (size_t)cur.pm * tstep; const char* cB = (const char*)g.Bt + (size_t)cur.pn * tstep;
    S.a_ready(cur);
    if constexpr (SP2) {
        PG8_STAGE(PG8_SB(0, 0), cB, voffB); PG8_STAGE(PG8_SB(0, 1), cB + hstep, voffB); PG8_STAGE(PG8_SA(0, 0), cA, voffA); PG8_STAGE(PG8_SA(0, 1), cA + hstep, voffA);
        if (wr == 1) PG8_BAR;
        PG8_WAIT_V(2); PG8_BAR;
        PG8_STAGE(PG8_SB(1, 0), cB + kstep, voffB); PG8_STAGE(PG8_SA(1, 0), cA + kstep, voffA); PG8_STAGE(PG8_SB(1, 1), cB + hstep + kstep, voffB);
        PG8_WAIT_V(6); PG8_BAR;
    } else {
        PG8_STAGE(PG8_SB(0, 0), cB, voffB); PG8_STAGE(PG8_SA(0, 0), cA, voffA); PG8_STAGE(PG8_SB(0, 1), cB + hstep, voffB); PG8_STAGE(PG8_SA(0, 1), cA + hstep, voffA);
        if (wr == 1) PG8_BAR;
        PG8_WAIT_V(4); PG8_BAR;
        PG8_STAGE(PG8_SB(1, 0), cB + kstep, voffB); PG8_STAGE(PG8_SA(1, 0), cA + kstep, voffA); PG8_STAGE(PG8_SB(1, 1), cB + hstep + kstep, voffB);
        PG8_WAIT_V(6); PG8_BAR;
    }
    for (;;) {
        const bool has_next = S.next(ui + 1, nxt);
        const char* nA = has_next ? (const char*)g.A + (size_t)nxt.pm * tstep : cA; const char* nB = has_next ? (const char*)g.Bt + (size_t)nxt.pn * tstep : cB;
        for (int t = 0; t < nt; t += 2) {
            const bool last = (t == nt - 2);
            const char* a1 = cA + (size_t)(t + 1) * kstep;
            const char* a2 = last ? nA : cA + (size_t)(t + 2) * kstep; const char* b2 = last ? nB : cB + (size_t)(t + 2) * kstep;
            const char* a3 = a2 + kstep; const char* b3 = b2 + kstep;
            if (last && has_next) S.a_ready(nxt);
            if constexpr (SP2) {
            PG8_LDB(B0, 0, 0); PG8_LDB(B1, 0, 1); PG8_SCHED; PG8_LDA(At, 0, 0); PG8_STAGE(PG8_SA(1, 1), a1 + hstep, voffA);
            PG8_WAIT_V(8); PG8_WAIT_L(0); PG8_BAR; PG8_MMA(0, 0, At, B0); PG8_MMA(0, 1, At, B1); PG8_BAR; PG8_SCHED;
            PG8_LDA(At, 0, 1); PG8_STAGE(PG8_SB(0, 0), b2, voffB); PG8_STAGE(PG8_SB(0, 1), b2 + hstep, voffB); PG8_STAGE(PG8_SA(0, 0), a2, voffA);
            PG8_WAIT_V(8); PG8_WAIT_L(0); PG8_BAR; PG8_MMA(1, 0, At, B0); PG8_MMA(1, 1, At, B1); PG8_BAR; PG8_SCHED;
            PG8_LDB(B0, 1, 0); PG8_LDB(B1, 1, 1); PG8_SCHED; PG8_LDA(At, 1, 0); PG8_STAGE(PG8_SA(0, 1), a2 + hstep, voffA);
            PG8_WAIT_V(8); PG8_WAIT_L(0); PG8_BAR; PG8_MMA(0, 0, At, B0); PG8_MMA(0, 1, At, B1); PG8_BAR; PG8_SCHED;
            PG8_LDA(At, 1, 1); PG8_STAGE(PG8_SB(1, 0), b3, voffB); PG8_STAGE(PG8_SB(1, 1), b3 + hstep, voffB); PG8_STAGE(PG8_SA(1, 0), a3, voffA);
            PG8_WAIT_V(8); PG8_WAIT_L(0); PG8_BAR; PG8_MMA(1, 0, At, B0); PG8_MMA(1, 1, At, B1); PG8_BAR; PG8_SCHED;
            } else {
            PG8_LDB(B0, 0, 0); PG8_SCHED; PG8_LDA(At, 0, 0); PG8_STAGE(PG8_SA(1, 1), a1 + hstep, voffA);
            PG8_WAIT_L(8); PG8_BAR; PG8_WAIT_L(0); PG8_MMA(0, 0, At, B0); PG8_BAR; PG8_SCHED;
            PG8_LDB(B1, 0, 1); PG8_STAGE(PG8_SB(0, 0), b2, voffB);
            PG8_BAR; PG8_WAIT_L(0); PG8_MMA(0, 1, At, B1); PG8_BAR;
            PG8_LDA(At, 0, 1); PG8_STAGE(PG8_SA(0, 0), a2, voffA);
            PG8_BAR; PG8_WAIT_L(0); PG8_MMA(1, 0, At, B0); PG8_BAR; PG8_SCHED;
            PG8_STAGE(PG8_SB(0, 1), b2 + hstep, voffB);
            PG8_WAIT_V(6); PG8_BAR; PG8_MMA(1, 1, At, B1); PG8_BAR;
            PG8_LDB(B0, 1, 0); PG8_SCHED; PG8_LDA(At, 1, 0); PG8_STAGE(PG8_SA(0, 1), a2 + hstep, voffA);
            PG8_WAIT_L(8); PG8_BAR; PG8_WAIT_L(0); PG8_MMA(0, 0, At, B0); PG8_BAR; PG8_SCHED;
            PG8_LDB(B1, 1, 1); PG8_STAGE(PG8_SB(1, 0), b3, voffB);
            PG8_BAR; PG8_WAIT_L(0); PG8_MMA(0, 1, At, B1); PG8_BAR;
            PG8_LDA(At, 1, 1); PG8_STAGE(PG8_SA(1, 0), a3, voffA);
            PG8_BAR; PG8_WAIT_L(0); PG8_MMA(1, 0, At, B0); PG8_BAR; PG8_SCHED;
            PG8_STAGE(PG8_SB(1, 1), b3 + hstep, voffB);
            PG8_WAIT_V(6); PG8_BAR; PG8_MMA(1, 1, At, B1); PG8_BAR;
            }
        }
        if constexpr (ALIGN_EPI) { if (wr == 0) PG8_BAR; }
        if constexpr (!Epi::AFTER_DRAIN) { E(acc, cur, wr, wc, fr, fq); S.done(cur); }
        if (!has_next) break;
#pragma unroll
        for (int a = 0; a < 2; ++a)
#pragma unroll
            for (int b = 0; b < 2; ++b)
#pragma unroll
                for (int m = 0; m < 4; ++m)
#pragma unroll
                    for (int n = 0; n < 2; ++n) acc[a][b][m][n] = (f32x4){0.f, 0.f, 0.f, 0.f};
        cur = nxt; cA = nA; cB = nB; ++ui;
        if constexpr (ALIGN_EPI) { if (wr == 1) PG8_BAR; }
    }
    PG8_WAIT_V(0);
    if constexpr (!ALIGN_EPI) { if (wr == 0) PG8_BAR; }
    PG8_BAR;
    if constexpr (Epi::AFTER_DRAIN) { E.fused(acc, cur, wr, wc, fr, fq, lds, wid, lane); S.done(cur); }
#undef PG8_SA
#undef PG8_SB
#undef PG8_STAGE
#undef PG8_LDA
#undef PG8_LDB
#undef PG8_MMA
#undef PG8_WAIT_V
#undef PG8_WAIT_L
#undef PG8_BAR
#undef PG8_SCHED
}
}
#define GAS __attribute__((address_space(1)))
#define LAS __attribute__((address_space(3)))
typedef unsigned short bf16;
typedef unsigned v4u __attribute__((ext_vector_type(4)));
typedef float f32x4 __attribute__((ext_vector_type(4)));
typedef short bf16x8 __attribute__((ext_vector_type(8)));
typedef GAS unsigned gu32;
typedef GAS unsigned long long gu64;
#define RLX_AGENT __ATOMIC_RELAXED, __HIP_MEMORY_SCOPE_AGENT
#define LDS_WAIT() asm volatile("s_waitcnt lgkmcnt(0)" ::: "memory")
#define VM_WAIT() asm volatile("s_waitcnt vmcnt(0)" ::: "memory")
__device__ __forceinline__ unsigned long long rt() { return __builtin_amdgcn_s_memrealtime(); }
__device__ __forceinline__ unsigned f2bf(float f) { unsigned u = __builtin_bit_cast(unsigned, f); return (u + 0x7fffu + ((u >> 16) & 1u)) >> 16; }
__device__ __forceinline__ unsigned pk2(float lo, float hi) { return f2bf(lo) | (f2bf(hi) << 16); }

#define XB_TMO      128
#define XB_XCNT(j)  (256  + 64 * (j))
#define XB_XSUB(j)  (1280 + 64 * (j))
#define XB_XGEN(j)  (2304 + 64 * (j))
#define XB_TOP      3328
#define XB_TOPGEN   3392
#define XCD_BAR_WORDS 3456
#define XB_SPIN_CAP (1u << 18)

__device__ __forceinline__ unsigned xb_ld(unsigned* p)              { return __hip_atomic_load(p, __ATOMIC_RELAXED, __HIP_MEMORY_SCOPE_AGENT); }
__device__ __forceinline__ unsigned xb_add(unsigned* p, unsigned v) { return __hip_atomic_fetch_add(p, v, __ATOMIC_RELAXED, __HIP_MEMORY_SCOPE_AGENT); }
__device__ __forceinline__ unsigned xb_xcc_id() { return (unsigned)__builtin_amdgcn_s_getreg((3 << 11) | 20) & 0xFu; }
#define XB_SPIN(cond, bar) do { unsigned _sp = 0; while (cond) { __builtin_amdgcn_s_sleep(1); \
    if ((++_sp & 255u) == 0u) { if (xb_ld(&(bar)[XB_TMO])) break; if (_sp > XB_SPIN_CAP) { atomicAdd(&(bar)[XB_TMO], 1u); break; } } } } while (0)

struct XcdBarrier {
    unsigned* bar; unsigned x;
    volatile LAS unsigned* st;
};

__device__ __forceinline__ XcdBarrier xcd_barrier_post(unsigned* bar, volatile LAS unsigned* st) {
    XcdBarrier b; b.bar = bar; b.x = xb_xcc_id(); b.st = st;
    if (threadIdx.x == 0) (void)xb_add(&bar[XB_XCNT(b.x)], 1u);
    return b;
}
__device__ __forceinline__ void xcd_barrier_complete(unsigned* bar, unsigned x, unsigned& nloc, unsigned& nx) {
    const unsigned G = gridDim.x * gridDim.y * gridDim.z;
    unsigned sum, cnt, mine, sp = 0u;
    for (;;) {
        sum = 0u; cnt = 0u; mine = 0u;
#pragma unroll
        for (unsigned j = 0; j < 16; ++j) { const unsigned c = xb_ld(&bar[XB_XCNT(j)]); sum += c; cnt += (c > 0u) ? 1u : 0u; mine = (j == x) ? c : mine; }
        if (sum == G) break;
        __builtin_amdgcn_s_sleep(1);
        if ((++sp & 255u) == 0u) { if (xb_ld(&bar[XB_TMO])) break; if (sp > XB_SPIN_CAP) { atomicAdd(&bar[XB_TMO], 1u); break; } }
    }
    nloc = mine > 0u ? mine : 1u; nx = cnt > 0u ? cnt : 1u;
}

__device__ __forceinline__ void xcd_barrier(const XcdBarrier& b) {
    asm volatile("s_waitcnt vmcnt(0)" ::: "memory");
    __syncthreads();
    if (threadIdx.x == 0) {
        unsigned* bar = b.bar;
        __builtin_amdgcn_s_waitcnt(0);
        unsigned nloc = b.st[0], nx = b.st[1];
        if (nloc == 0u) { xcd_barrier_complete(bar, b.x, nloc, nx); b.st[0] = nloc; b.st[1] = nx; }
        const unsigned old = xb_add(&bar[XB_XSUB(b.x)], 1u);
        const unsigned gen = old / nloc;
        if (old + 1u == (gen + 1u) * nloc) {
            __builtin_amdgcn_fence(__ATOMIC_RELEASE, "agent");
            asm volatile("s_waitcnt vmcnt(0)" ::: "memory");
            const unsigned og = xb_add(&bar[XB_TOP], 1u);
            const unsigned tg = og / nx;
            if (og + 1u == (tg + 1u) * nx) xb_add(&bar[XB_TOPGEN], 1u);
            else XB_SPIN(xb_ld(&bar[XB_TOPGEN]) == tg, bar);
            __builtin_amdgcn_fence(__ATOMIC_ACQUIRE, "agent");
            xb_add(&bar[XB_XGEN(b.x)], 1u);
            asm volatile("s_waitcnt vmcnt(0)" ::: "memory");
        } else {
            XB_SPIN(xb_ld(&bar[XB_XGEN(b.x)]) == gen, bar);
            __builtin_amdgcn_fence(__ATOMIC_ACQUIRE, "agent");
            asm volatile("s_waitcnt vmcnt(0)" ::: "memory");
        }
    }
    __syncthreads();
}

constexpr int T = 16384, D = 1024, SEQ = 8192, NCTX = 256, TCX = 512, DIN = 3840, MH = T + TCX;
constexpr int ZU = 0, ZV = 512, ZQ = 1024, ZK = 1536, ZVA = 1664, ZGA = 1792, ZGB = 2816;
constexpr int NEXP = 256, NSLOT = 9, LISTCAP = 16384;
constexpr float LOG2E = 1.4426950408889634f;
constexpr float QSCALE = 0.125f * LOG2E;
constexpr size_t MiB = 1u << 20;
constexpr size_t WS_CTL = 0, CTL_ZERO_BYTES = 1 * MiB;
constexpr size_t WS_ADAP = 1 * MiB;
constexpr size_t WS_ADAF = 2 * MiB;
constexpr size_t WS_ROPE = 2 * MiB + 128 * 1024;
constexpr size_t WS_WST = 2 * MiB + 256 * 1024;
constexpr size_t WS_RWT = 3 * MiB;
constexpr size_t WS_WINT = 4 * MiB;
constexpr size_t WS_WAT = 12 * MiB, WS_WBT = 13 * MiB, WS_WOT = 14 * MiB;
constexpr size_t WS_KVC = 16 * MiB;
constexpr size_t WS_GATEW = 17 * MiB;
constexpr size_t WS_H = 18 * MiB;
constexpr size_t WS_Z = 52 * MiB;
constexpr size_t WS_A = 172 * MiB, WS_O = 188 * MiB;
constexpr size_t WS_TMP = 204 * MiB;
constexpr size_t WS_Y = 268 * MiB;
constexpr size_t WS_X1 = 300 * MiB;
constexpr size_t WS_H2 = 364 * MiB;
constexpr size_t WS_LIST = 396 * MiB;
constexpr size_t WS_CONTRIB = 414 * MiB;
constexpr size_t WS_END = 704 * MiB;
constexpr int CW_BAR = 4096;
constexpr int CW_CNT = 16384;
constexpr int SCR_BYTES = 148480;
constexpr int MISC_OFF = SCR_BYTES;
constexpr int LDS_BYTES = 152 * 1024;
constexpr int NWAVES = 8;

typedef float f32x2_t __attribute__((ext_vector_type(2)));
typedef __bf16 bf16x2_t __attribute__((ext_vector_type(2)));
typedef float f32x16 __attribute__((ext_vector_type(16)));
typedef short s16x4 __attribute__((ext_vector_type(4)));
typedef short v4i16_t __attribute__((ext_vector_type(4)));
typedef unsigned u32x2 __attribute__((ext_vector_type(2)));
typedef unsigned u32x4 __attribute__((ext_vector_type(4)));
typedef LAS unsigned char* ldsp;

__device__ __forceinline__ unsigned cvtpk(float lo, float hi) { f32x2_t v = {lo, hi}; bf16x2_t b = __builtin_convertvector(v, bf16x2_t); return __builtin_bit_cast(unsigned, b); }
__device__ __forceinline__ float bf2f(unsigned short u) { return __uint_as_float((unsigned)u << 16); }
__device__ __forceinline__ float bflo(unsigned w) { return __uint_as_float(w << 16); }
__device__ __forceinline__ float bfhi(unsigned w) { return __uint_as_float(w & 0xffff0000u); }
__device__ __forceinline__ float wave_sum(float v) {
#pragma unroll
    for (int o = 1; o < 64; o <<= 1) v += __shfl_xor(v, o);
    return v;
}
__device__ __forceinline__ float sigmoid_f(float x) { return __builtin_amdgcn_rcpf(1.f + __builtin_amdgcn_exp2f(-x * LOG2E)); }
__device__ __forceinline__ float silu_f(float x) { return x * sigmoid_f(x); }
__device__ __forceinline__ float gelu_f(float x) { const float u = 0.7978845608028654f * (x + 0.044715f * x * x * x); return x * sigmoid_f(2.f * u); }
__device__ __forceinline__ f32x16 mfma32(bf16x8 a, bf16x8 b, f32x16 c) { return __builtin_amdgcn_mfma_f32_32x32x16_bf16(a, b, c, 0, 0, 0); }
__device__ __forceinline__ f32x4 mfma16(bf16x8 a, bf16x8 b, f32x4 c) { return __builtin_amdgcn_mfma_f32_16x16x32_bf16(a, b, c, 0, 0, 0); }

struct Args { const float* in[26]; float* out; unsigned char* ws; int ph_lo, ph_hi; };
enum { I_X = 0, I_C, I_CTX, I_CCTX, I_ADAW, I_ADAB, I_N1G, I_N2G, I_WIN, I_LNG, I_LNB, I_GWS, I_GBS, I_SINK, I_WA, I_WB, I_WO, I_RW, I_RB, I_EG, I_EU, I_ED, I_SG, I_SU, I_SD, I_FG };

__device__ __forceinline__ void p0_transpose_item(const float* W, int K, int N, bf16* WT, LAS float* scr, int item, int lane) {
    const int nblk = N / 32, kb = item / nblk, nb = item % nblk, k0 = 64 * kb, n0 = 32 * nb;
#pragma unroll 8
    for (int i = 0; i < 32; ++i) { const int kk = 2 * i + (lane >> 5); scr[kk * 33 + (lane & 31)] = W[(size_t)(k0 + kk) * N + n0 + (lane & 31)]; }
    LDS_WAIT(); asm volatile("" ::: "memory");
    const int c = lane & 7;
#pragma unroll
    for (int j = 0; j < 4; ++j) { const int n = (lane >> 3) + 8 * j; const LAS float* s = scr + (8 * c) * 33 + n;
        v4u o; o.x = pk2(s[0 * 33], s[1 * 33]); o.y = pk2(s[2 * 33], s[3 * 33]); o.z = pk2(s[4 * 33], s[5 * 33]); o.w = pk2(s[6 * 33], s[7 * 33]);
        *(GAS v4u*)(WT + (size_t)(n0 + n) * K + k0 + 8 * c) = o; }
    LDS_WAIT(); asm volatile("" ::: "memory");
}

__device__ __forceinline__ void phase_prep(const Args& a, ldsp lds, int G) {
    const int tid = threadIdx.x, lane = tid & 63, wave = __builtin_amdgcn_readfirstlane(tid >> 6), blk = blockIdx.x;
    unsigned char* ws = a.ws;
    if (blk < 192) {
        const int cb = blk % 24, kc = blk / 24, col = cb * 256 + lane * 4, k0 = kc * 128 + wave * 16;
        const float* c = a.in[I_C]; const float* cc = a.in[I_CCTX]; const float* aw = a.in[I_ADAW];
        f32x4 a0 = {0.f, 0.f, 0.f, 0.f}, a1 = a0, a2 = a0;
#pragma unroll 4
        for (int k = 0; k < 16; ++k) {
            const int kk = k0 + k;
            const float s0 = silu_f(c[kk]), s1 = silu_f(c[1024 + kk]), s2 = silu_f(cc[kk]);
            const f32x4 w = *(const f32x4*)(aw + (size_t)kk * 6144 + col);
            a0 += w * s0; a1 += w * s1; a2 += w * s2;
        }
        LAS float* red = (LAS float*)lds;
        *(LAS f32x4*)(red + (wave * 3 + 0) * 256 + lane * 4) = a0;
        *(LAS f32x4*)(red + (wave * 3 + 1) * 256 + lane * 4) = a1;
        *(LAS f32x4*)(red + (wave * 3 + 2) * 256 + lane * 4) = a2;
        __syncthreads();
        float* adap = (float*)(ws + WS_ADAP);
        for (int idx = tid; idx < 768; idx += 512) {
            const int v = idx >> 8, cl = idx & 255; float s = 0.f;
#pragma unroll
            for (int w = 0; w < 8; ++w) s += red[(w * 3 + v) * 256 + cl];
            adap[(size_t)(kc * 3 + v) * 6144 + cb * 256 + cl] = s;
        }
        __syncthreads();
    }
    {
        LAS float* scr = (LAS float*)(lds + wave * 8704);
        const int gw = blk * NWAVES + wave, NGW = G * NWAVES;
        constexpr int I_1 = 16 * 120, I_2 = 8 * 32, I_3 = 8 * 32, I_4 = 16 * 32, I_5 = 16 * 8;
        for (int it = gw; it < I_1 + I_2 + I_3 + I_4 + I_5; it += NGW) {
            int r = it;
            if (r < I_1) { p0_transpose_item(a.in[I_WIN], 1024, 3840, (bf16*)(ws + WS_WINT), scr, r, lane); continue; } r -= I_1;
            if (r < I_2) { p0_transpose_item(a.in[I_WA], 512, 1024, (bf16*)(ws + WS_WAT), scr, r, lane); continue; } r -= I_2;
            if (r < I_3) { p0_transpose_item(a.in[I_WB], 512, 1024, (bf16*)(ws + WS_WBT), scr, r, lane); continue; } r -= I_3;
            if (r < I_4) { p0_transpose_item(a.in[I_WO], 1024, 1024, (bf16*)(ws + WS_WOT), scr, r, lane); continue; } r -= I_4;
            p0_transpose_item(a.in[I_RW], 1024, 256, (bf16*)(ws + WS_RWT), scr, r, lane);
        }
    }
    {
        const int gt = blk * 512 + tid, NT = G * 512;
        const float* gws = a.in[I_GWS]; bf16* wst = (bf16*)(ws + WS_WST);
        for (int i = gt; i < 8192; i += NT) {
            const f32x4 x0 = *(const f32x4*)(gws + i * 8), x1 = *(const f32x4*)(gws + i * 8 + 4);
            v4u o; o.x = cvtpk(x0[0], x0[1]); o.y = cvtpk(x0[2], x0[3]); o.z = cvtpk(x1[0], x1[1]); o.w = cvtpk(x1[2], x1[3]);
            *(v4u*)(wst + i * 8) = o;
        }
        float* rope = (float*)(ws + WS_ROPE);
        for (int i = gt; i < 2048; i += NT) {
            const int pos = i >> 4, f = i & 15;
            const float inv = __builtin_amdgcn_exp2f(-(float)f * (13.287712379549449f / 16.f));
            const float ang = (float)pos * inv;
            double rev = (double)ang * 0.15915494309189535; rev -= floor(rev);
            rope[pos * 32 + f] = __builtin_amdgcn_cosf((float)rev);
            rope[pos * 32 + 16 + f] = __builtin_amdgcn_sinf((float)rev);
        }
    }
}

__device__ __forceinline__ void phase_hnorm(const Args& a, ldsp lds, int G) {
    const int tid = threadIdx.x, lane = tid & 63, wave = __builtin_amdgcn_readfirstlane(tid >> 6), blk = blockIdx.x;
    unsigned char* ws = a.ws;
    const float* adap = (const float*)(ws + WS_ADAP); const float* adab = a.in[I_ADAB];
    LAS float* modv = (LAS float*)lds;
    for (int idx = tid; idx < 3 * 2048; idx += 512) {
        const int v = idx >> 11, j = idx & 2047; float s = adab[j];
#pragma unroll
        for (int kc = 0; kc < 8; ++kc) s += adap[(size_t)(kc * 3 + v) * 6144 + j];
        modv[idx] = (j >= 1024) ? s + 1.f : s;
    }
    { float* adaf = (float*)(ws + WS_ADAF);
      for (int idx = blk * 512 + tid; idx < 3 * 6144; idx += G * 512) {
          const int v = idx / 6144, j = idx % 6144; float s = adab[j];
#pragma unroll
          for (int kc = 0; kc < 8; ++kc) s += adap[(size_t)(kc * 3 + v) * 6144 + j];
          adaf[idx] = s; } }
    __syncthreads();
    const float* g1 = a.in[I_N1G]; bf16* H = (bf16*)(ws + WS_H);
    for (int t = blk * NWAVES + wave; t < MH; t += G * NWAVES) {
        const float* xr = (t < T) ? a.in[I_X] + (size_t)t * D : a.in[I_CTX] + (size_t)(t - T) * D;
        const int v = (t < T) ? (t >> 13) : 2;
        f32x4 x[4]; float ss = 0.f;
#pragma unroll
        for (int j = 0; j < 4; ++j) { x[j] = *(const f32x4*)(xr + 4 * lane + 256 * j); ss += (x[j][0] * x[j][0] + x[j][1] * x[j][1]) + (x[j][2] * x[j][2] + x[j][3] * x[j][3]); }
        const float r = rsqrtf(wave_sum(ss) * (1.f / D) + 1e-6f);
#pragma unroll
        for (int j = 0; j < 4; ++j) {
            const int col = 4 * lane + 256 * j;
            const f32x4 g = *(const f32x4*)(g1 + col);
            const f32x4 sh = *(LAS f32x4*)(modv + v * 2048 + col), sc = *(LAS f32x4*)(modv + v * 2048 + 1024 + col);
            const f32x4 h = (x[j] * r) * g * sc + sh;
            u32x2 o; o.x = cvtpk(h[0], h[1]); o.y = cvtpk(h[2], h[3]);
            *(u32x2*)(H + (size_t)t * D + col) = o;
        }
    }
}

struct WinOrder {
    pg8::StaticOrder so;
    __device__ void init(int G, int c) { so.init(T, DIN, G, c); }
    __device__ bool next(int i, pg8::Unit& u) const {
        const long L = (long)i * so.G + so.c;
        if (L < 960) return so.next(i, u);
        if (L < 962) { u.pm = 64 + (int)(L - 960); u.pn = 6; return true; }
        return false;
    }
    __device__ __forceinline__ void a_ready(const pg8::Unit&) const {}
    __device__ __forceinline__ void done(const pg8::Unit&) const {}
};
struct EpiWin {
    static constexpr bool PERM = false, AFTER_DRAIN = false;
    bf16* Z; bf16* KVC; const float* rope;
    __device__ __forceinline__ void operator()(const pg8::f32x4 (&acc)[2][2][4][2], const pg8::Unit& u, int wr, int wc, int fr, int fq) const {
        const int row0 = u.pm * 256 + wr * 64 + fr, colb = u.pn * 256 + wc * 32 + 4 * fq, pn = u.pn;
        if (u.pm >= 64) {
#pragma unroll
            for (int ai = 0; ai < 2; ++ai)
#pragma unroll
                for (int m = 0; m < 4; ++m) { bf16* rp = KVC + (size_t)(row0 + ai * 128 + m * 16 - T) * 256 + (colb - ZK);
#pragma unroll
                    for (int bj = 0; bj < 2; ++bj)
#pragma unroll
                        for (int n = 0; n < 2; ++n) { const pg8::f32x4 v = acc[ai][bj][m][n]; u32x2 o; o.x = cvtpk(v[0], v[1]); o.y = cvtpk(v[2], v[3]); *(u32x2*)(rp + bj * 128 + n * 16) = o; } }
            return;
        }
#pragma unroll
        for (int ai = 0; ai < 2; ++ai)
#pragma unroll
            for (int m = 0; m < 4; ++m) {
                const int r = row0 + ai * 128 + m * 16; bf16* rp = Z + (size_t)r * DIN + colb;
                if (pn <= 3) {
#pragma unroll
                    for (int bj = 0; bj < 2; ++bj)
#pragma unroll
                        for (int n = 0; n < 2; ++n) { const pg8::f32x4 v = acc[ai][bj][m][n]; u32x2 o; o.x = cvtpk(gelu_f(v[0]), gelu_f(v[1])); o.y = cvtpk(gelu_f(v[2]), gelu_f(v[3])); *(u32x2*)(rp + bj * 128 + n * 16) = o; }
                } else if (pn <= 6) {
                    const int pos = (wc & 1) ? (r & 63) : ((r & 8191) >> 6);
                    const pg8::f32x4 cs = *(const pg8::f32x4*)(rope + pos * 32 + 4 * fq), sn = *(const pg8::f32x4*)(rope + pos * 32 + 16 + 4 * fq);
                    const float sc = (pn < 6) ? QSCALE : 1.f;
#pragma unroll
                    for (int bj = 0; bj < 2; ++bj) {
                        const pg8::f32x4 x1 = acc[ai][bj][m][0], x2 = acc[ai][bj][m][1];
                        pg8::f32x4 o1, o2;
                        if (pn == 6 && bj == 1) { o1 = x1; o2 = x2; }
                        else { o1 = (x1 * cs - x2 * sn) * sc; o2 = (x2 * cs + x1 * sn) * sc; }
                        u32x2 w1, w2; w1.x = cvtpk(o1[0], o1[1]); w1.y = cvtpk(o1[2], o1[3]); w2.x = cvtpk(o2[0], o2[1]); w2.y = cvtpk(o2[2], o2[3]);
                        *(u32x2*)(rp + bj * 128) = w1; *(u32x2*)(rp + bj * 128 + 16) = w2;
                    }
                } else {
#pragma unroll
                    for (int bj = 0; bj < 2; ++bj)
#pragma unroll
                        for (int n = 0; n < 2; ++n) { const pg8::f32x4 v = acc[ai][bj][m][n]; u32x2 o; o.x = cvtpk(sigmoid_f(v[0]), sigmoid_f(v[1])); o.y = cvtpk(sigmoid_f(v[2]), sigmoid_f(v[3])); *(u32x2*)(rp + bj * 128 + n * 16) = o; }
                }
            }
    }
};
struct EpiMergeA {
    static constexpr bool PERM = true, AFTER_DRAIN = false;
    const bf16* Z; float* TMP;
    __device__ __forceinline__ void operator()(const pg8::f32x4 (&acc)[2][2][4][2], const pg8::Unit& u, int wr, int wc, int fr, int fq) const {
        const int row0 = u.pm * 256 + wr * 64 + fr, col0 = u.pn * 256 + wc * 32 + 8 * fq;
#pragma unroll
        for (int ai = 0; ai < 2; ++ai)
#pragma unroll
            for (int m = 0; m < 4; ++m) { const int r = row0 + ai * 128 + m * 16;
#pragma unroll
                for (int bj = 0; bj < 2; ++bj) { const int c = col0 + bj * 128;
                    const u32x4 g = *(const u32x4*)(Z + (size_t)r * DIN + ZGA + c);
                    const pg8::f32x4 v0 = acc[ai][bj][m][0], v1 = acc[ai][bj][m][1];
                    pg8::f32x4 o0 = {v0[0] * bflo(g.x), v0[1] * bfhi(g.x), v0[2] * bflo(g.y), v0[3] * bfhi(g.y)};
                    pg8::f32x4 o1 = {v1[0] * bflo(g.z), v1[1] * bfhi(g.z), v1[2] * bflo(g.w), v1[3] * bfhi(g.w)};
                    *(pg8::f32x4*)(TMP + (size_t)r * D + c) = o0; *(pg8::f32x4*)(TMP + (size_t)r * D + c + 4) = o1; } }
    }
};
struct EpiMergeB {
    static constexpr bool PERM = true, AFTER_DRAIN = false;
    const bf16* Z; const float* TMP; bf16* Y;
    __device__ __forceinline__ void operator()(const pg8::f32x4 (&acc)[2][2][4][2], const pg8::Unit& u, int wr, int wc, int fr, int fq) const {
        const int row0 = u.pm * 256 + wr * 64 + fr, col0 = u.pn * 256 + wc * 32 + 8 * fq;
#pragma unroll
        for (int ai = 0; ai < 2; ++ai)
#pragma unroll
            for (int m = 0; m < 4; ++m) { const int r = row0 + ai * 128 + m * 16;
#pragma unroll
                for (int bj = 0; bj < 2; ++bj) { const int c = col0 + bj * 128;
                    const u32x4 g = *(const u32x4*)(Z + (size_t)r * DIN + ZGB + c);
                    const pg8::f32x4 t0 = *(const pg8::f32x4*)(TMP + (size_t)r * D + c), t1 = *(const pg8::f32x4*)(TMP + (size_t)r * D + c + 4);
                    const pg8::f32x4 v0 = acc[ai][bj][m][0], v1 = acc[ai][bj][m][1];
                    u32x4 o;
                    o.x = cvtpk(t0[0] + v0[0] * bflo(g.x), t0[1] + v0[1] * bfhi(g.x)); o.y = cvtpk(t0[2] + v0[2] * bflo(g.y), t0[3] + v0[3] * bfhi(g.y));
                    o.z = cvtpk(t1[0] + v1[0] * bflo(g.z), t1[1] + v1[1] * bfhi(g.z)); o.w = cvtpk(t1[2] + v1[2] * bflo(g.w), t1[3] + v1[3] * bfhi(g.w));
                    *(u32x4*)(Y + (size_t)r * D + c) = o; } }
    }
};
struct EpiWo {
    static constexpr bool PERM = true, AFTER_DRAIN = false;
    const float* x; const float* adaf; float* X1;
    __device__ __forceinline__ void operator()(const pg8::f32x4 (&acc)[2][2][4][2], const pg8::Unit& u, int wr, int wc, int fr, int fq) const {
        const int row0 = u.pm * 256 + wr * 64 + fr, col0 = u.pn * 256 + wc * 32 + 8 * fq;
        const float* g1 = adaf + (u.pm >= 32 ? 6144 : 0) + 2048;
#pragma unroll
        for (int bj = 0; bj < 2; ++bj) { const int c = col0 + bj * 128;
            const pg8::f32x4 ga = *(const pg8::f32x4*)(g1 + c), gb = *(const pg8::f32x4*)(g1 + c + 4);
#pragma unroll
            for (int ai = 0; ai < 2; ++ai)
#pragma unroll
                for (int m = 0; m < 4; ++m) { const int r = row0 + ai * 128 + m * 16;
                    const pg8::f32x4 x0 = *(const pg8::f32x4*)(x + (size_t)r * D + c), x1 = *(const pg8::f32x4*)(x + (size_t)r * D + c + 4);
                    *(pg8::f32x4*)(X1 + (size_t)r * D + c) = x0 + ga * acc[ai][bj][m][0];
                    *(pg8::f32x4*)(X1 + (size_t)r * D + c + 4) = x1 + gb * acc[ai][bj][m][1]; } }
    }
};

__device__ __forceinline__ s16x4 vtr(LAS const unsigned char* p) { return __builtin_bit_cast(s16x4, __builtin_amdgcn_ds_read_tr16_b64_v4i16((LAS v4i16_t*)p)); }

__device__ __forceinline__ void attn_item(const bf16* Z, const bf16* KVC, const float* sink, bf16* Obuf, ldsp lds, int b, int nb, int hk, int qh) {
    const int tid = threadIdx.x, lane = tid & 63, wave = __builtin_amdgcn_readfirstlane(tid >> 6), r32 = lane & 31, hi = lane >> 5;
    const int rq = wave >> 1, head = hk * 4 + rq;
    const int iq = qh * 64 + (wave & 1) * 32 + r32;
    const int wlo = (nb == 0) ? 2 : qh, whi = (nb == 63) ? 4 : 5 + qh, nwin = whi - wlo, ntile = nwin + 4;
    const int tokq = b * SEQ + nb * 128 + iq;
    bf16x8 qr[4];
#pragma unroll
    for (int d0 = 0; d0 < 4; ++d0) qr[d0] = *(const bf16x8*)(Z + (size_t)tokq * DIN + ZQ + head * 64 + d0 * 16 + hi * 8);
    float mrun = sink[head] * LOG2E, lrun = (hi == 0) ? 1.f : 0.f;
    f32x16 o[2];
#pragma unroll
    for (int j = 0; j < 2; ++j)
#pragma unroll
        for (int r = 0; r < 16; ++r) o[j][r] = 0.f;
    const int kdst = wave * 1024 + lane * 16, vdst = 8192 + (wave >> 2) * 4096 + lane * 64 + (wave & 3) * 16;
#define ATT_SRC(s, kp, vp) do { const int tl_ = (s) < nwin ? wlo + (s) : 6 + (s) - nwin; \
        if (tl_ < 6) { const int tok_ = b * SEQ + (nb - 1 + (tl_ >> 1)) * 128 + (tl_ & 1) * 64 + lane; kp = Z + (size_t)tok_ * DIN + ZK + hk * 64 + wave * 8; vp = Z + (size_t)tok_ * DIN + ZVA + hk * 64 + wave * 8; } \
        else { const int row_ = b * NCTX + (tl_ - 6) * 64 + lane; kp = KVC + (size_t)row_ * 256 + hk * 64 + wave * 8; vp = KVC + (size_t)row_ * 256 + 128 + hk * 64 + wave * 8; } } while (0)
    u32x4 kreg, vreg;
    { const bf16 *kp, *vp; ATT_SRC(0, kp, vp); kreg = *(const u32x4*)kp; vreg = *(const u32x4*)vp; }
    *(LAS u32x4*)(lds + kdst) = kreg; *(LAS u32x4*)(lds + vdst) = vreg;
    __syncthreads();
    const int vrd = ((lane & 15) >> 2) * 64 + ((lane >> 4) & 1) * 32 + (lane & 3) * 8 + hi * 256;
    for (int s = 0; s < ntile; ++s) {
        const int base = (s & 1) * 16384;
        const int tl = s < nwin ? wlo + s : 6 + s - nwin;
        if (s + 1 < ntile) { const bf16 *kp, *vp; ATT_SRC(s + 1, kp, vp); kreg = *(const u32x4*)kp; vreg = *(const u32x4*)vp; }
        {
            f32x16 p0, p1;
#pragma unroll
            for (int r = 0; r < 16; ++r) { p0[r] = 0.f; p1[r] = 0.f; }
#pragma unroll
            for (int d0 = 0; d0 < 4; ++d0) {
                const bf16x8 k0 = *(LAS const bf16x8*)(lds + base + (2 * d0 + hi) * 1024 + r32 * 16);
                const bf16x8 k1 = *(LAS const bf16x8*)(lds + base + (2 * d0 + hi) * 1024 + (r32 + 32) * 16);
                p0 = mfma32(k0, qr[d0], p0); p1 = mfma32(k1, qr[d0], p1);
            }
            if (tl < 2) {
                const int j0 = (tl & 1) * 64 + 4 * hi;
#pragma unroll
                for (int r = 0; r < 16; ++r) { const int j = j0 + (r & 3) + 8 * (r >> 2); if (j < iq) p0[r] = -INFINITY; if (j + 32 < iq) p1[r] = -INFINITY; }
            } else if (tl == 4 || tl == 5) {
                const int j0 = (tl & 1) * 64 + 4 * hi;
#pragma unroll
                for (int r = 0; r < 16; ++r) { const int j = j0 + (r & 3) + 8 * (r >> 2); if (j > iq) p0[r] = -INFINITY; if (j + 32 > iq) p1[r] = -INFINITY; }
            }
            float mx = fmaxf(p0[0], p1[0]);
#pragma unroll
            for (int r = 1; r < 16; ++r) mx = fmaxf(mx, fmaxf(p0[r], p1[r]));
            mx = fmaxf(mx, __shfl_xor(mx, 32));
            const float mn = fmaxf(mrun, mx), alpha = __builtin_amdgcn_exp2f(mrun - mn);
            mrun = mn;
            float rs = 0.f;
#pragma unroll
            for (int r = 0; r < 16; ++r) { p0[r] = __builtin_amdgcn_exp2f(p0[r] - mn); p1[r] = __builtin_amdgcn_exp2f(p1[r] - mn); rs += p0[r] + p1[r]; }
            lrun = lrun * alpha + rs;
#pragma unroll
            for (int r = 0; r < 16; ++r) { o[0][r] *= alpha; o[1][r] *= alpha; }
            bf16x8 pf[4];
#pragma unroll
            for (int s4 = 0; s4 < 4; ++s4) {
                u32x4 w;
                if (s4 < 2) { w.x = cvtpk(p0[8 * s4 + 0], p0[8 * s4 + 1]); w.y = cvtpk(p0[8 * s4 + 2], p0[8 * s4 + 3]); w.z = cvtpk(p0[8 * s4 + 4], p0[8 * s4 + 5]); w.w = cvtpk(p0[8 * s4 + 6], p0[8 * s4 + 7]); }
                else { const int q = s4 - 2; w.x = cvtpk(p1[8 * q + 0], p1[8 * q + 1]); w.y = cvtpk(p1[8 * q + 2], p1[8 * q + 3]); w.z = cvtpk(p1[8 * q + 4], p1[8 * q + 5]); w.w = cvtpk(p1[8 * q + 6], p1[8 * q + 7]); }
                pf[s4] = __builtin_bit_cast(bf16x8, w);
            }
#pragma unroll
            for (int dblk = 0; dblk < 2; ++dblk)
#pragma unroll
                for (int s4 = 0; s4 < 4; ++s4) {
                    const s16x4 lo = vtr(lds + base + 8192 + dblk * 4096 + vrd + (16 * s4) * 64);
                    const s16x4 hh = vtr(lds + base + 8192 + dblk * 4096 + vrd + (16 * s4 + 8) * 64);
                    const bf16x8 vf = {lo[0], lo[1], lo[2], lo[3], hh[0], hh[1], hh[2], hh[3]};
                    o[dblk] = mfma32(vf, pf[s4], o[dblk]);
                }
        }
        if (s + 1 < ntile) { *(LAS u32x4*)(lds + (16384 - base) + kdst) = kreg; *(LAS u32x4*)(lds + (16384 - base) + vdst) = vreg; }
        __syncthreads();
    }
#undef ATT_SRC
    {
        const float lt = lrun + __shfl_xor(lrun, 32), inv = 1.f / lt;
        bf16* op = Obuf + (size_t)tokq * 512 + head * 64;
#pragma unroll
        for (int dblk = 0; dblk < 2; ++dblk)
#pragma unroll
            for (int r4 = 0; r4 < 4; ++r4) {
                u32x2 w; w.x = cvtpk(o[dblk][4 * r4] * inv, o[dblk][4 * r4 + 1] * inv); w.y = cvtpk(o[dblk][4 * r4 + 2] * inv, o[dblk][4 * r4 + 3] * inv);
                *(u32x2*)(op + 32 * dblk + 8 * r4 + 4 * hi) = w;
            }
    }
}

__device__ __forceinline__ void gmlp_item(const bf16* Z, const float* lng, const float* lnb, const bf16* WsT, const float* bs, bf16* Abuf, ldsp lds, int ch, int g) {
    const int tid = threadIdx.x, lane = tid & 63, wave = __builtin_amdgcn_readfirstlane(tid >> 6), fr = lane & 15, fq = lane >> 4;
    const int tok0 = ch * 128;
    LAS bf16* VT = (LAS bf16*)lds;
    f32x4 gA = *(const f32x4*)(lng + lane * 8), gB = *(const f32x4*)(lng + lane * 8 + 4), bA = *(const f32x4*)(lnb + lane * 8), bB = *(const f32x4*)(lnb + lane * 8 + 4);
#pragma unroll
    for (int rnd = 0; rnd < 2; ++rnd) {
        float y[8][8];
#pragma unroll
        for (int j = 0; j < 8; ++j) {
            const int tok = tok0 + wave * 16 + rnd * 8 + j;
            const u32x4 raw = *(const u32x4*)(Z + (size_t)tok * DIN + ZV + lane * 8);
            float x[8] = {bflo(raw.x), bfhi(raw.x), bflo(raw.y), bfhi(raw.y), bflo(raw.z), bfhi(raw.z), bflo(raw.w), bfhi(raw.w)};
            float s = 0.f;
#pragma unroll
            for (int i = 0; i < 8; ++i) s += x[i];
            const float mu = wave_sum(s) * (1.f / 512.f);
            float q = 0.f;
#pragma unroll
            for (int i = 0; i < 8; ++i) { x[i] -= mu; q += x[i] * x[i]; }
            const float rstd = rsqrtf(wave_sum(q) * (1.f / 512.f) + 1e-6f);
            y[j][0] = x[0] * rstd * gA[0] + bA[0]; y[j][1] = x[1] * rstd * gA[1] + bA[1]; y[j][2] = x[2] * rstd * gA[2] + bA[2]; y[j][3] = x[3] * rstd * gA[3] + bA[3];
            y[j][4] = x[4] * rstd * gB[0] + bB[0]; y[j][5] = x[5] * rstd * gB[1] + bB[1]; y[j][6] = x[6] * rstd * gB[2] + bB[2]; y[j][7] = x[7] * rstd * gB[3] + bB[3];
        }
        if ((lane >> 4) == g) {
#pragma unroll
            for (int i = 0; i < 8; ++i) {
                u32x4 w; w.x = cvtpk(y[0][i], y[1][i]); w.y = cvtpk(y[2][i], y[3][i]); w.z = cvtpk(y[4][i], y[5][i]); w.w = cvtpk(y[6][i], y[7][i]);
                *(LAS u32x4*)(VT + (8 * (lane & 15) + i) * 136 + wave * 16 + rnd * 8) = w;
            }
        }
    }
    __syncthreads();
    const int wm = wave >> 1, wn = wave & 1;
    f32x4 acc[2][4];
#pragma unroll
    for (int m = 0; m < 2; ++m)
#pragma unroll
        for (int n = 0; n < 4; ++n) acc[m][n] = (f32x4){0.f, 0.f, 0.f, 0.f};
#pragma unroll
    for (int ks = 0; ks < 4; ++ks) {
        bf16x8 af[2], bfr[4];
#pragma unroll
        for (int m = 0; m < 2; ++m) af[m] = *(const bf16x8*)(WsT + (size_t)g * 16384 + (32 * wm + 16 * m + fr) * 128 + 32 * ks + 8 * fq);
#pragma unroll
        for (int n = 0; n < 4; ++n) bfr[n] = *(LAS const bf16x8*)(VT + (64 * wn + 16 * n + fr) * 136 + 32 * ks + 8 * fq);
#pragma unroll
        for (int m = 0; m < 2; ++m)
#pragma unroll
            for (int n = 0; n < 4; ++n) acc[m][n] = mfma16(af[m], bfr[n], acc[m][n]);
    }
#pragma unroll
    for (int m = 0; m < 2; ++m)
#pragma unroll
        for (int reg = 0; reg < 4; ++reg) {
            const int p = 32 * wm + 16 * m + 4 * fq + reg, tok = tok0 + p; const float bias = bs[g * 128 + p];
#pragma unroll
            for (int n = 0; n < 4; ++n) {
                const int c = g * 128 + 64 * wn + 16 * n + fr;
                const float uu = bf2f(Z[(size_t)tok * DIN + ZU + c]);
                Abuf[(size_t)tok * 512 + c] = (bf16)(cvtpk(uu * (acc[m][n][reg] + bias), 0.f) & 0xffffu);
            }
        }
    __syncthreads();
}

__device__ __forceinline__ void phase_mixers(const Args& a, ldsp lds, int G, int vcu) {
    unsigned char* ws = a.ws;
    const bf16* Z = (const bf16*)(ws + WS_Z);
    for (int it = vcu; it < 512; it += G) {
        const int qh = it & 1, hk = (it >> 1) & 1, nb = (it >> 2) & 63, b = it >> 8;
        attn_item(Z, (const bf16*)(ws + WS_KVC), a.in[I_SINK], (bf16*)(ws + WS_O), lds, b, nb, hk, qh);
    }
    for (int it = vcu; it < 512; it += G) {
        gmlp_item(Z, a.in[I_LNG], a.in[I_LNB], (const bf16*)(ws + WS_WST), a.in[I_GBS], (bf16*)(ws + WS_A), lds, it >> 2, it & 3);
    }
}

__device__ __forceinline__ void router_item(const Args& a, ldsp lds, int it) {
    const int tid = threadIdx.x, lane = tid & 63, wave = __builtin_amdgcn_readfirstlane(tid >> 6), fr = lane & 15, fq = lane >> 4;
    unsigned char* ws = a.ws;
    const int t0 = it * 64, b = t0 >> 13;
    const float* X1 = (const float*)(ws + WS_X1); const float* adaf = (const float*)(ws + WS_ADAF) + b * 6144;
    const float* g2 = a.in[I_N2G]; bf16* H2 = (bf16*)(ws + WS_H2);
    {
        f32x4 gm[2][2], sh[2][2];
#pragma unroll
        for (int j = 0; j < 2; ++j)
#pragma unroll
            for (int h = 0; h < 2; ++h) {
                const int c = 8 * lane + 512 * j + 4 * h;
                const f32x4 gg = *(const f32x4*)(g2 + c), sc = *(const f32x4*)(adaf + 4 * 1024 + c);
                gm[j][h] = gg * (sc + 1.f); sh[j][h] = *(const f32x4*)(adaf + 3 * 1024 + c);
            }
#pragma unroll 2
        for (int tt = 0; tt < 8; ++tt) {
            const int row = wave * 8 + tt, tok = t0 + row;
            f32x4 x[2][2]; float ss = 0.f;
#pragma unroll
            for (int j = 0; j < 2; ++j)
#pragma unroll
                for (int h = 0; h < 2; ++h) { x[j][h] = *(const f32x4*)(X1 + (size_t)tok * D + 8 * lane + 512 * j + 4 * h); const f32x4 v = x[j][h]; ss += (v[0] * v[0] + v[1] * v[1]) + (v[2] * v[2] + v[3] * v[3]); }
            const float r = rsqrtf(wave_sum(ss) * (1.f / D) + 1e-6f);
#pragma unroll
            for (int j = 0; j < 2; ++j) {
                const f32x4 h0 = (x[j][0] * r) * gm[j][0] + sh[j][0], h1 = (x[j][1] * r) * gm[j][1] + sh[j][1];
                u32x4 w; w.x = cvtpk(h0[0], h0[1]); w.y = cvtpk(h0[2], h0[3]); w.z = cvtpk(h1[0], h1[1]); w.w = cvtpk(h1[2], h1[3]);
                *(u32x4*)(H2 + (size_t)tok * D + 8 * lane + 512 * j) = w;
                const int kc = lane + 64 * j;
                *(LAS u32x4*)(lds + kc * 1024 + ((row ^ (kc & 7)) * 16)) = w;
            }
        }
    }
    __syncthreads();
    const int wm = wave >> 2, wn = wave & 3;
    f32x4 acc[2][4];
#pragma unroll
    for (int m = 0; m < 2; ++m)
#pragma unroll
        for (int n = 0; n < 4; ++n) acc[m][n] = (f32x4){0.f, 0.f, 0.f, 0.f};
    const bf16* RwT = (const bf16*)(ws + WS_RWT);
#pragma unroll 4
    for (int ks = 0; ks < 32; ++ks) {
        const int kc = 4 * ks + fq;
        bf16x8 af[2], bfr[4];
#pragma unroll
        for (int m = 0; m < 2; ++m) af[m] = *(LAS const bf16x8*)(lds + kc * 1024 + (((32 * wm + 16 * m + fr) ^ (kc & 7)) * 16));
#pragma unroll
        for (int n = 0; n < 4; ++n) bfr[n] = *(const bf16x8*)(RwT + (size_t)(64 * wn + 16 * n + fr) * D + 32 * ks + 8 * fq);
#pragma unroll
        for (int m = 0; m < 2; ++m)
#pragma unroll
            for (int n = 0; n < 4; ++n) acc[m][n] = mfma16(af[m], bfr[n], acc[m][n]);
    }
    __syncthreads();
    LAS float* LG = (LAS float*)lds;
#pragma unroll
    for (int m = 0; m < 2; ++m)
#pragma unroll
        for (int n = 0; n < 4; ++n)
#pragma unroll
            for (int reg = 0; reg < 4; ++reg) LG[(32 * wm + 16 * m + 4 * fq + reg) * 256 + 64 * wn + 16 * n + fr] = acc[m][n][reg];
    __syncthreads();
    const float* rb = a.in[I_RB];
    unsigned* cnt = (unsigned*)(ws + WS_CTL) + CW_CNT; int* list = (int*)(ws + WS_LIST); float* gatew = (float*)(ws + WS_GATEW);
    float bias4[4];
#pragma unroll
    for (int i = 0; i < 4; ++i) bias4[i] = rb[lane + 64 * i];
    for (int tt = 0; tt < 8; ++tt) {
        const int row = wave * 8 + tt, tok = t0 + row;
        float sc[4], key[4];
#pragma unroll
        for (int i = 0; i < 4; ++i) { sc[i] = sigmoid_f(LG[row * 256 + lane + 64 * i]); key[i] = sc[i] + bias4[i]; }
        float mysel = 0.f; int myidx = 0; float ssum = 0.f;
#pragma unroll
        for (int k = 0; k < 8; ++k) {
            float bv = key[0]; int bi = lane;
#pragma unroll
            for (int i = 1; i < 4; ++i) if (key[i] > bv) { bv = key[i]; bi = lane + 64 * i; }
#pragma unroll
            for (int o = 1; o < 64; o <<= 1) { const float ov = __shfl_xor(bv, o); const int oi = __shfl_xor(bi, o); if (ov > bv || (ov == bv && oi < bi)) { bv = ov; bi = oi; } }
            const int slot = bi >> 6;
            const float scs = slot == 0 ? sc[0] : slot == 1 ? sc[1] : slot == 2 ? sc[2] : sc[3];
            const float selk = __shfl(scs, bi & 63);
            if ((bi & 63) == lane) {
#pragma unroll
                for (int i = 0; i < 4; ++i) if (i == slot) key[i] = -INFINITY;
            }
            ssum += selk;
            if (lane == k) { mysel = selk; myidx = bi; }
        }
        if (lane < 8) {
            const unsigned pos = atomicAdd(cnt + myidx, 1u);
            list[(size_t)myidx * LISTCAP + pos] = tok * NSLOT + lane;
            gatew[tok * 8 + lane] = 2.5f * mysel / ssum;
        }
    }
    __syncthreads();
}

__device__ __forceinline__ void moe_tile(const Args& a, ldsp lds, int e, int mt, int nrows) {
    const int tid = threadIdx.x, lane = tid & 63, wave = __builtin_amdgcn_readfirstlane(tid >> 6), fr = lane & 15, fq = lane >> 4;
    unsigned char* ws = a.ws;
    constexpr int ASTG = 0, BSTG = 16384, ACT = 81920, SLOTS = 147456, GWO = 147968;
    const bf16* H2 = (const bf16*)(ws + WS_H2);
    const float* Wg = (e < NEXP) ? a.in[I_EG] + (size_t)e * 262144 : a.in[I_SG];
    const float* Wu = (e < NEXP) ? a.in[I_EU] + (size_t)e * 262144 : a.in[I_SU];
    const float* Wd = (e < NEXP) ? a.in[I_ED] + (size_t)e * 262144 : a.in[I_SD];
    if (tid < 128) {
        int slot = -1; float gw = 0.f;
        if (tid < nrows) {
            if (e < NEXP) { slot = ((const int*)(ws + WS_LIST))[(size_t)e * LISTCAP + mt * 128 + tid]; gw = ((const float*)(ws + WS_GATEW))[(slot / NSLOT) * 8 + (slot % NSLOT)]; }
            else { slot = (mt * 128 + tid) * NSLOT + 8; gw = 1.f; }
        }
        ((LAS int*)(lds + SLOTS))[tid] = slot; ((LAS float*)(lds + GWO))[tid] = gw;
    }
    __syncthreads();
    const int wr = wave >> 2, wc = wave & 3;
    const int arow = tid >> 2, akc = tid & 3;
    const int aslot = ((LAS const int*)(lds + SLOTS))[arow];
    const bf16* asrc = H2 + (size_t)((aslot < 0 ? 0 : aslot) / NSLOT) * D + akc * 8;
    const int awr = ASTG + akc * 2048 + ((arow ^ (akc << 1)) * 16);
    const int ng = tid & 127, kg = tid >> 7, n4 = 4 * ng;
    const float* bsrc = ((n4 < 256) ? Wg : Wu) + (size_t)(kg * 8) * 256 + (n4 & 255);
    const int rho0 = ((n4 & 255) >> 6) * 128 + ((n4 >= 256) ? 64 : 0) + (n4 & 63);
    int bwr[4];
#pragma unroll
    for (int i = 0; i < 4; ++i) { const int rho = rho0 + i; bwr[i] = BSTG + kg * 8192 + ((rho ^ ((rho >> 3) & 3)) * 16); }
    int ard[4], brd[8];
#pragma unroll
    for (int m = 0; m < 4; ++m) { const int row = 64 * wr + 16 * m + fr; ard[m] = ASTG + fq * 2048 + ((row ^ (fq << 1)) * 16); }
#pragma unroll
    for (int n = 0; n < 8; ++n) { const int rho = 128 * wc + 16 * n + fr; brd[n] = BSTG + fq * 8192 + ((rho ^ ((rho >> 3) & 3)) * 16); }
    f32x4 acc[4][8];
#pragma unroll
    for (int m = 0; m < 4; ++m)
#pragma unroll
        for (int n = 0; n < 8; ++n) acc[m][n] = (f32x4){0.f, 0.f, 0.f, 0.f};
    u32x4 areg; f32x4 breg[8];
    areg = *(const u32x4*)asrc;
#pragma unroll
    for (int j = 0; j < 8; ++j) breg[j] = *(const f32x4*)(bsrc + (size_t)j * 256);
#define MOE_WRITE1(bufo) do { *(LAS u32x4*)(lds + (bufo) * 8192 + awr) = areg; \
        _Pragma("unroll") for (int i = 0; i < 4; ++i) { u32x4 w; w.x = cvtpk(breg[0][i], breg[1][i]); w.y = cvtpk(breg[2][i], breg[3][i]); w.z = cvtpk(breg[4][i], breg[5][i]); w.w = cvtpk(breg[6][i], breg[7][i]); \
            *(LAS u32x4*)(lds + (bufo) * 32768 + bwr[i]) = w; } } while (0)
    MOE_WRITE1(0);
    __syncthreads();
    for (int s = 0; s < 32; ++s) {
        const int buf = s & 1;
        if (s + 1 < 32) {
            areg = *(const u32x4*)(asrc + (s + 1) * 32);
#pragma unroll
            for (int j = 0; j < 8; ++j) breg[j] = *(const f32x4*)(bsrc + (size_t)((s + 1) * 32 + j) * 256);
        }
        bf16x8 af[4], bfr[8];
#pragma unroll
        for (int m = 0; m < 4; ++m) af[m] = *(LAS const bf16x8*)(lds + buf * 8192 + ard[m]);
#pragma unroll
        for (int n = 0; n < 8; ++n) bfr[n] = *(LAS const bf16x8*)(lds + buf * 32768 + brd[n]);
#pragma unroll
        for (int m = 0; m < 4; ++m)
#pragma unroll
            for (int n = 0; n < 8; ++n) acc[m][n] = mfma16(bfr[n], af[m], acc[m][n]);
        if (s + 1 < 32) MOE_WRITE1(1 - buf);
        __syncthreads();
    }
#undef MOE_WRITE1
#pragma unroll
    for (int m = 0; m < 4; ++m)
#pragma unroll
        for (int n = 0; n < 4; ++n) {
            const f32x4 gv = acc[m][n], uv = acc[m][n + 4];
            u32x2 w; w.x = cvtpk(silu_f(gv[0]) * uv[0], silu_f(gv[1]) * uv[1]); w.y = cvtpk(silu_f(gv[2]) * uv[2], silu_f(gv[3]) * uv[3]);
            const int row = 64 * wr + 16 * m + fr, kc = 8 * wc + 2 * n + (fq >> 1);
            *(LAS u32x2*)(lds + ACT + kc * 2048 + ((row ^ ((kc & 3) << 1)) * 16) + (fq & 1) * 8) = w;
        }
    __syncthreads();
    const int ng2 = tid & 63, kg2 = tid >> 6;
    const float* dsrc = Wd + (size_t)(kg2 * 8) * 1024 + 4 * ng2;
    int dwr[4];
#pragma unroll
    for (int i = 0; i < 4; ++i) { const int rho = 4 * ng2 + i; dwr[i] = BSTG + kg2 * 4096 + ((rho ^ ((rho >> 3) & 3)) * 16); }
    int brd2[4];
#pragma unroll
    for (int n = 0; n < 4; ++n) { const int rho = 64 * wc + 16 * n + fr; brd2[n] = BSTG + fq * 4096 + ((rho ^ ((rho >> 3) & 3)) * 16); }
    int rowm[4];
#pragma unroll
    for (int m = 0; m < 4; ++m) rowm[m] = 64 * wr + 16 * m + fr;
#pragma unroll
    for (int j = 0; j < 8; ++j) breg[j] = *(const f32x4*)(dsrc + (size_t)j * 1024);
#define MOE_WRITE2(bufo) do { _Pragma("unroll") for (int i = 0; i < 4; ++i) { u32x4 w; w.x = cvtpk(breg[0][i], breg[1][i]); w.y = cvtpk(breg[2][i], breg[3][i]); w.z = cvtpk(breg[4][i], breg[5][i]); w.w = cvtpk(breg[6][i], breg[7][i]); \
            *(LAS u32x4*)(lds + (bufo) * 32768 + dwr[i]) = w; } } while (0)
    MOE_WRITE2(0);
    __syncthreads();
    bf16* contrib = (bf16*)(ws + WS_CONTRIB);
    f32x4 acc2[4][4];
    for (int s = 0; s < 16; ++s) {
        const int buf = s & 1, pass = s >> 2, st = s & 3;
        if (st == 0) {
#pragma unroll
            for (int m = 0; m < 4; ++m)
#pragma unroll
                for (int n = 0; n < 4; ++n) acc2[m][n] = (f32x4){0.f, 0.f, 0.f, 0.f};
        }
        if (s + 1 < 16) { const int p1 = (s + 1) >> 2, s1 = (s + 1) & 3;
#pragma unroll
            for (int j = 0; j < 8; ++j) breg[j] = *(const f32x4*)(dsrc + (size_t)(64 * s1 + j) * 1024 + p1 * 256); }
#pragma unroll
        for (int ks = 0; ks < 2; ++ks) {
            bf16x8 af[4], bfr[4];
            const int kc = 8 * st + 4 * ks + fq;
#pragma unroll
            for (int m = 0; m < 4; ++m) af[m] = *(LAS const bf16x8*)(lds + ACT + kc * 2048 + ((rowm[m] ^ ((kc & 3) << 1)) * 16));
#pragma unroll
            for (int n = 0; n < 4; ++n) bfr[n] = *(LAS const bf16x8*)(lds + buf * 32768 + ks * 16384 + brd2[n]);
#pragma unroll
            for (int m = 0; m < 4; ++m)
#pragma unroll
                for (int n = 0; n < 4; ++n) acc2[m][n] = mfma16(bfr[n], af[m], acc2[m][n]);
        }
        if (st == 3) {
#pragma unroll
            for (int m = 0; m < 4; ++m) {
                const int slot = ((LAS const int*)(lds + SLOTS))[rowm[m]]; const float gw = ((LAS const float*)(lds + GWO))[rowm[m]];
                if (slot >= 0) {
                    bf16* cp = contrib + (size_t)slot * D + pass * 256 + 64 * wc + 4 * fq;
#pragma unroll
                    for (int n = 0; n < 4; ++n) { const f32x4 v = acc2[m][n] * gw; u32x2 w; w.x = cvtpk(v[0], v[1]); w.y = cvtpk(v[2], v[3]); *(u32x2*)(cp + 16 * n) = w; }
                }
            }
        }
        if (s + 1 < 16) MOE_WRITE2(1 - buf);
        __syncthreads();
    }
#undef MOE_WRITE2
}

__device__ __forceinline__ void phase_moe(const Args& a, ldsp lds, int G, int vcu) {
    const int tid = threadIdx.x;
    const unsigned* cnt = (const unsigned*)(a.ws + WS_CTL) + CW_CNT;
    LAS int* pre = (LAS int*)(lds + MISC_OFF + 512);
    if (tid == 0) { int s = 0; for (int e = 0; e < NEXP; ++e) { pre[e] = s; s += (int)((cnt[e] + 127u) >> 7); } pre[NEXP] = s; }
    __syncthreads();
    const int total = pre[NEXP], ntiles = total + T / 128;
    for (int j = vcu; j < ntiles; j += G) {
        int e, mt, nrows;
        if (j < total) {
            int lo = 0, hi = NEXP;
            while (hi - lo > 1) { const int mid = (lo + hi) >> 1; if (pre[mid] <= j) lo = mid; else hi = mid; }
            e = lo; mt = j - pre[e]; const int c = (int)cnt[e] - mt * 128; nrows = c < 128 ? c : 128;
        } else { e = NEXP; mt = j - total; nrows = 128; }
        moe_tile(a, lds, e, mt, nrows);
    }
}

__device__ __forceinline__ void phase_combine(const Args& a, int G) {
    const int tid = threadIdx.x, lane = tid & 63, wave = __builtin_amdgcn_readfirstlane(tid >> 6), blk = blockIdx.x;
    unsigned char* ws = a.ws;
    const float* X1 = (const float*)(ws + WS_X1); const bf16* contrib = (const bf16*)(ws + WS_CONTRIB); const float* fg = a.in[I_FG];
    for (int t = blk * NWAVES + wave; t < T; t += G * NWAVES) {
        const float* g2 = (const float*)(ws + WS_ADAF) + (t >> 13) * 6144 + 5 * 1024;
        f32x4 xv[2][2]; float ss = 0.f;
#pragma unroll
        for (int j = 0; j < 2; ++j) {
            const int c = 8 * lane + 512 * j;
            float sm[8] = {0.f, 0.f, 0.f, 0.f, 0.f, 0.f, 0.f, 0.f};
#pragma unroll
            for (int k = 0; k < NSLOT; ++k) {
                const u32x4 w = *(const u32x4*)(contrib + ((size_t)t * NSLOT + k) * D + c);
                sm[0] += bflo(w.x); sm[1] += bfhi(w.x); sm[2] += bflo(w.y); sm[3] += bfhi(w.y); sm[4] += bflo(w.z); sm[5] += bfhi(w.z); sm[6] += bflo(w.w); sm[7] += bfhi(w.w);
            }
#pragma unroll
            for (int h = 0; h < 2; ++h) {
                const f32x4 x1 = *(const f32x4*)(X1 + (size_t)t * D + c + 4 * h), gg = *(const f32x4*)(g2 + c + 4 * h);
                const f32x4 mv = {sm[4 * h], sm[4 * h + 1], sm[4 * h + 2], sm[4 * h + 3]};
                const f32x4 v = x1 + gg * mv; xv[j][h] = v; ss += (v[0] * v[0] + v[1] * v[1]) + (v[2] * v[2] + v[3] * v[3]);
            }
        }
        const float r = rsqrtf(wave_sum(ss) * (1.f / D) + 1e-6f);
#pragma unroll
        for (int j = 0; j < 2; ++j)
#pragma unroll
            for (int h = 0; h < 2; ++h) { const int c = 8 * lane + 512 * j + 4 * h; *(f32x4*)(a.out + (size_t)t * D + c) = (xv[j][h] * r) * *(const f32x4*)(fg + c); }
    }
}

constexpr int NPH = 9;
#ifndef N_LAUNCHES
#define N_LAUNCHES 1
#endif
__global__ void __launch_bounds__(NWAVES * 64, 2) mega(Args a) {
    extern __shared__ __attribute__((aligned(16))) unsigned char lds_raw[];
    ldsp lds = (ldsp)lds_raw;
    const int tid = threadIdx.x, G = gridDim.x, bx = blockIdx.x;
    const int vcu = (G % 8 == 0) ? (bx % 8) * (G / 8) + bx / 8 : bx;
    unsigned char* ws = a.ws;
    for (int u = tid; u < (LDS_BYTES - MISC_OFF) / 4; u += NWAVES * 64) ((LAS unsigned*)(lds + MISC_OFF))[u] = 0u;
    __syncthreads();
    volatile LAS unsigned* MISC = (volatile LAS unsigned*)(lds + MISC_OFF);
    XcdBarrier bar; bar.bar = (unsigned*)(ws + WS_CTL) + CW_BAR; bar.x = 0; bar.st = nullptr;
    if (N_LAUNCHES == 1) bar = xcd_barrier_post((unsigned*)(ws + WS_CTL) + CW_BAR, MISC + 8);
    const int lo = a.ph_lo, hi = a.ph_hi;
#ifndef PH_MASK
#define PH_MASK 0x1ff
#endif
#define IN(k) (((PH_MASK >> (k)) & 1) && lo <= (k) && (k) < hi)
#define SEAM(k) do { if (IN(k) && IN((k) + 1)) xcd_barrier(bar); } while (0)
    if (IN(0)) { phase_prep(a, lds, G); } SEAM(0);
    if (IN(1)) { phase_hnorm(a, lds, G); } SEAM(1);
    if (IN(2)) {
        pg8::Gemm g{(const pg8::bf16_t*)(ws + WS_H), (const pg8::bf16_t*)(ws + WS_WINT), MH, DIN, D};
        WinOrder S; S.init(G, bx);
        EpiWin E{(bf16*)(ws + WS_Z), (bf16*)(ws + WS_KVC), (const float*)(ws + WS_ROPE)};
        pg8::gemm_phase<EpiWin, WinOrder, true, true>(lds, g, S, E);
    } SEAM(2);
    if (IN(3)) { phase_mixers(a, lds, G, vcu); } SEAM(3);
    if (IN(4)) {
        { pg8::Gemm g{(const pg8::bf16_t*)(ws + WS_A), (const pg8::bf16_t*)(ws + WS_WAT), T, D, 512};
          pg8::StaticOrder S; S.init(T, D, G, bx);
          EpiMergeA E{(const bf16*)(ws + WS_Z), (float*)(ws + WS_TMP)};
          pg8::gemm_phase<EpiMergeA, pg8::StaticOrder, true, true>(lds, g, S, E); }
        { pg8::Gemm g{(const pg8::bf16_t*)(ws + WS_O), (const pg8::bf16_t*)(ws + WS_WBT), T, D, 512};
          pg8::StaticOrder S; S.init(T, D, G, bx);
          EpiMergeB E{(const bf16*)(ws + WS_Z), (const float*)(ws + WS_TMP), (bf16*)(ws + WS_Y)};
          pg8::gemm_phase<EpiMergeB, pg8::StaticOrder, true, true>(lds, g, S, E); }
    } SEAM(4);
    if (IN(5)) {
        pg8::Gemm g{(const pg8::bf16_t*)(ws + WS_Y), (const pg8::bf16_t*)(ws + WS_WOT), T, D, D};
        pg8::StaticOrder S; S.init(T, D, G, bx);
        EpiWo E{a.in[I_X], (const float*)(ws + WS_ADAF), (float*)(ws + WS_X1)};
        pg8::gemm_phase<EpiWo, pg8::StaticOrder, true, true>(lds, g, S, E);
    } SEAM(5);
    if (IN(6)) { for (int it = vcu; it < T / 64; it += G) router_item(a, lds, it); } SEAM(6);
    if (IN(7)) { phase_moe(a, lds, G, vcu); } SEAM(7);
    if (IN(8)) { phase_combine(a, G); }
#undef IN
#undef SEAM
}

extern "C" void kernel_launch(void* const* d_in, const int* in_sizes, int n_in, void* d_out, int out_size, void* d_ws, size_t ws_size, hipStream_t stream) {
    static int grid = 0;
    if (grid == 0) {
        if (n_in != 26 || out_size != T * D || ws_size < WS_END) { fprintf(stderr, "kernel_launch: unexpected shapes (n_in %d, out %d, ws %zu)\n", n_in, out_size, ws_size); grid = -1; return; }
        int dev = 0, cus = 0, per_cu = 0;
        (void)hipGetDevice(&dev); (void)hipDeviceGetAttribute(&cus, hipDeviceAttributeMultiprocessorCount, dev);
        (void)hipFuncSetAttribute((const void*)mega, hipFuncAttributeMaxDynamicSharedMemorySize, LDS_BYTES);
        (void)hipOccupancyMaxActiveBlocksPerMultiprocessor(&per_cu, (const void*)mega, NWAVES * 64, LDS_BYTES);
        (void)hipGetLastError();
        if (per_cu < 1) { fprintf(stderr, "kernel_launch: occupancy query says %d blocks per CU\n", per_cu); per_cu = 1; }
        grid = cus;
    }
    if (grid < 0) return;
    (void)hipMemsetAsync((char*)d_ws + WS_CTL, 0, CTL_ZERO_BYTES, stream);
    Args a{};
    for (int i = 0; i < 26; ++i) a.in[i] = (const float*)d_in[i];
    a.out = (float*)d_out; a.ws = (unsigned char*)d_ws;
    if (N_LAUNCHES == 1) {
        a.ph_lo = 0; a.ph_hi = NPH;
        void* kargs[] = {&a};
        hipError_t e = hipLaunchCooperativeKernel((const void*)mega, dim3(grid), dim3(NWAVES * 64), kargs, LDS_BYTES, stream);
        if (e != hipSuccess) fprintf(stderr, "kernel_launch: cooperative launch failed: %s (grid %d)\n", hipGetErrorString(e), grid);
    } else {
        for (int li = 0; li < NPH; ++li) {
            a.ph_lo = li; a.ph_hi = li + 1;
            hipLaunchKernelGGL(mega, dim3(grid), dim3(NWAVES * 64), LDS_BYTES, stream, a);
        }
    }
}
```

```cpp
#include <hip/hip_runtime.h>
#include <cstdio>
#include <cstdint>
namespace pg8 {
#define PG8_LAS __attribute__((address_space(3)))
typedef unsigned short bf16_t;
typedef short bf16x8 __attribute__((ext_vector_type(8)));
typedef float f32x4 __attribute__((ext_vector_type(4)));
typedef unsigned u32x4 __attribute__((ext_vector_type(4)));
constexpr int BM = 256, BK = 64, HALF = 128, HTB = HALF * BK * 2  , STAGE_BYTES = 8 * HTB, NXCD = 8, WGM = 8;

__host__ __device__ __forceinline__ int lds_byte(int r, int c) { const int st = (r >> 4) * 2 + (c >> 5), rr = r & 15, cc = c & 31, ob = rr * 64 + cc * 2; return st * 1024 + (ob ^ (((ob >> 9) & 1) << 5)); }
__host__ __device__ __forceinline__ void stage_rc(int b, int& R, int& C) { const int st = b / 1024, sb = b % 1024, swz = sb ^ (((sb >> 9) & 1) << 5); R = (st >> 1) * 16 + swz / 64; C = (st & 1) * 32 + (swz % 64) / 2; }
__host__ __device__ __forceinline__ int perm32(int rho) { const int n = rho >> 4, i = rho & 15; return 8 * (i >> 2) + 4 * n + (i & 3); }

struct Unit { int pm, pn; };
struct Gemm { const bf16_t* A; const bf16_t* Bt; int M, N, K; };

struct StaticOrder {
    int nM, nN, nwg, G, c;
    __host__ __device__ void init(int M, int N, int G_, int c_) { nM = M / BM; nN = N / BM; nwg = nM * nN; G = G_; c = c_; }
    __host__ __device__ bool next(int i, Unit& u) const {
        const long L = (long)i * G + c; if (L >= nwg) return false;
        int wgid = (int)L; { const int q = nwg / NXCD, r = nwg % NXCD, xcd = wgid % NXCD, off = wgid / NXCD; wgid = (xcd < r ? xcd * (q + 1) : r * (q + 1) + (xcd - r) * q) + off; }
        const int nig = WGM * nN, gid = wgid / nig, fm = gid * WGM, gsz = (nM - fm) < WGM ? (nM - fm) : WGM;
        u.pm = fm + ((wgid % nig) % gsz); u.pn = (wgid % nig) / gsz; return true;
    }
    __device__ __forceinline__ void a_ready(const Unit&) const {}
    __device__ __forceinline__ void done(const Unit&) const {}
};

__device__ __forceinline__ unsigned cvt_pk_bf16(float lo, float hi) { unsigned r; asm volatile("v_cvt_pk_bf16_f32 %0, %1, %2" : "=v"(r) : "v"(lo), "v"(hi)); return r; }
template <class Epi, class Sched, bool ALIGN_EPI = false, bool SP2 = false>
__device__ __forceinline__ void gemm_phase(PG8_LAS unsigned char* lds, const Gemm g, const Sched& S, const Epi& E) {
    const int tid = threadIdx.x, wid = __builtin_amdgcn_readfirstlane(tid >> 6), lane = tid & 63, wr = wid >> 2, wc = wid & 3, fr = lane & 15, fq = lane >> 4;
    const int K = g.K, nt = K / BK;
    unsigned voffA[2], voffB[2];
#pragma unroll
    for (int i = 0; i < 2; ++i) { int R, C; stage_rc(tid * 16 + i * 8192, R, C); const int Rb = Epi::PERM ? ((R & ~31) + perm32(R & 31)) : R;
        voffA[i] = (unsigned)(R * K + C) * 2u; voffB[i] = (unsigned)(Rb * K + C) * 2u; }
    const size_t kstep = (size_t)(BK * 2);
    const size_t hstep = (size_t)HALF * K * 2;
    const size_t tstep = 2 * hstep;
    const unsigned ldsw = (unsigned)wid * 1024u;
    const int aoff = lds_byte(wr * 64 + fr, fq * 8), boff = lds_byte(wc * 32 + fr, fq * 8);
#define PG8_SA(b, h) (((b) * 2 + (h)) * HTB)
#define PG8_SB(b, h) ((4 + (b) * 2 + (h)) * HTB)
#define PG8_STAGE(bufoff, gbase, voff) do { _Pragma("unroll") for (int _i = 0; _i < 2; ++_i) \
        __builtin_amdgcn_global_load_lds((const unsigned*)((const char*)(gbase) + (voff)[_i]), (PG8_LAS unsigned*)(lds + (bufoff) + ldsw + _i * 8192), 16, 0, 0); } while (0)
#define PG8_LDA(dst, b, h) do { _Pragma("unroll") for (int m = 0; m < 4; ++m) _Pragma("unroll") for (int k = 0; k < 2; ++k) dst[m][k] = *(const PG8_LAS bf16x8*)(lds + PG8_SA(b, h) + aoff + m * 2048 + k * 1024); } while (0)
#define PG8_LDB(dst, b, h) do { _Pragma("unroll") for (int n = 0; n < 2; ++n) _Pragma("unroll") for (int k = 0; k < 2; ++k) dst[n][k] = *(const PG8_LAS bf16x8*)(lds + PG8_SB(b, h) + boff + n * 2048 + k * 1024); } while (0)
#define PG8_MMA(ai, bj, At, Bt) do { __builtin_amdgcn_s_setprio(1); _Pragma("unroll") for (int m = 0; m < 4; ++m) _Pragma("unroll") for (int n = 0; n < 2; ++n) _Pragma("unroll") for (int k = 0; k < 2; ++k) \
        acc[ai][bj][m][n] = __builtin_amdgcn_mfma_f32_16x16x32_bf16(Bt[n][k], At[m][k], acc[ai][bj][m][n], 0, 0, 0); __builtin_amdgcn_s_setprio(0); } while (0)
#define PG8_WAIT_V(n) asm volatile("s_waitcnt vmcnt(" #n ")" ::: "memory")
#define PG8_WAIT_L(n) asm volatile("s_waitcnt lgkmcnt(" #n ")" ::: "memory")
#define PG8_BAR __builtin_amdgcn_s_barrier()
#define PG8_SCHED __builtin_amdgcn_sched_barrier(0)
    Unit cur, nxt; int ui = 0;
    if (!S.next(0, cur)) return;
    f32x4 acc[2][2][4][2];
#pragma unroll
    for (int a = 0; a < 2; ++a)
#pragma unroll
        for (int b = 0; b < 2; ++b)
#pragma unroll
            for (int m = 0; m < 4; ++m)
#pragma unroll
                for (int n = 0; n < 2; ++n) acc[a][b][m][n] = (f32x4){0.f, 0.f, 0.f, 0.f};
    bf16x8 At[4][2], B0[2][2], B1[2][2];
    const char* cA = (const char*)g.A + (size_t)cur.pm * tstep; const char* cB = (const char*)g.Bt + (size_t)cur.pn * tstep;
    S.a_ready(cur);
    if constexpr (SP2) {
        PG8_STAGE(PG8_SB(0, 0), cB, voffB); PG8_STAGE(PG8_SB(0, 1), cB + hstep, voffB); PG8_STAGE(PG8_SA(0, 0), cA, voffA); PG8_STAGE(PG8_SA(0, 1), cA + hstep, voffA);
        if (wr == 1) PG8_BAR;
        PG8_WAIT_V(2); PG8_BAR;
        PG8_STAGE(PG8_SB(1, 0), cB + kstep, voffB); PG8_STAGE(PG8_SA(1, 0), cA + kstep, voffA); PG8_STAGE(PG8_SB(1, 1), cB + hstep + kstep, voffB);
        PG8_WAIT_V(6); PG8_BAR;
    } else {
        PG8_STAGE(PG8_SB(0, 0), cB, voffB); PG8_STAGE(PG8_SA(0, 0), cA, voffA); PG8_STAGE(PG8_SB(0, 1), cB + hstep, voffB); PG8_STAGE(PG8_SA(0, 1), cA + hstep, voffA);
        if (wr == 1) PG8_BAR;
        PG8_WAIT_V(4); PG8_BAR;
        PG8_STAGE(PG8_SB(1, 0), cB + kstep, voffB); PG8_STAGE(PG8_SA(1, 0), cA + kstep, voffA); PG8_STAGE(PG8_SB(1, 1), cB + hstep + kstep, voffB);
        PG8_WAIT_V(6); PG8_BAR;
    }
    for (;;) {
        const bool has_next = S.next(ui + 1, nxt);
        const char* nA = has_next ? (const char*)g.A + (size_t)nxt.pm * tstep : cA; const char* nB = has_next ? (const char*)g.Bt + (size_t)nxt.pn * tstep : cB;
        for (int t = 0; t < nt; t += 2) {
            const bool last = (t == nt - 2);
            const char* a1 = cA + (size_t)(t + 1) * kstep;
            const char* a2 = last ? nA : cA + (size_t)(t + 2) * kstep; const char* b2 = last ? nB : cB + (size_t)(t + 2) * kstep;
            const char* a3 = a2 + kstep; const char* b3 = b2 + kstep;
            if (last && has_next) S.a_ready(nxt);
            if constexpr (SP2) {
            PG8_LDB(B0, 0, 0); PG8_LDB(B1, 0, 1); PG8_SCHED; PG8_LDA(At, 0, 0); PG8_STAGE(PG8_SA(1, 1), a1 + hstep, voffA);
            PG8_WAIT_V(8); PG8_WAIT_L(0); PG8_BAR; PG8_MMA(0, 0, At, B0); PG8_MMA(0, 1, At, B1); PG8_BAR; PG8_SCHED;
            PG8_LDA(At, 0, 1); PG8_STAGE(PG8_SB(0, 0), b2, voffB); PG8_STAGE(PG8_SB(0, 1), b2 + hstep, voffB); PG8_STAGE(PG8_SA(0, 0), a2, voffA);
            PG8_WAIT_V(8); PG8_WAIT_L(0); PG8_BAR; PG8_MMA(1, 0, At, B0); PG8_MMA(1, 1, At, B1); PG8_BAR; PG8_SCHED;
            PG8_LDB(B0, 1, 0); PG8_LDB(B1, 1, 1); PG8_SCHED; PG8_LDA(At, 1, 0); PG8_STAGE(PG8_SA(0, 1), a2 + hstep, voffA);
            PG8_WAIT_V(8); PG8_WAIT_L(0); PG8_BAR; PG8_MMA(0, 0, At, B0); PG8_MMA(0, 1, At, B1); PG8_BAR; PG8_SCHED;
            PG8_LDA(At, 1, 1); PG8_STAGE(PG8_SB(1, 0), b3, voffB); PG8_STAGE(PG8_SB(1, 1), b3 + hstep, voffB); PG8_STAGE(PG8_SA(1, 0), a3, voffA);
            PG8_WAIT_V(8); PG8_WAIT_L(0); PG8_BAR; PG8_MMA(1, 0, At, B0); PG8_MMA(1, 1, At, B1); PG8_BAR; PG8_SCHED;
            } else {
            PG8_LDB(B0, 0, 0); PG8_SCHED; PG8_LDA(At, 0, 0); PG8_STAGE(PG8_SA(1, 1), a1 + hstep, voffA);
            PG8_WAIT_L(8); PG8_BAR; PG8_WAIT_L(0); PG8_MMA(0, 0, At, B0); PG8_BAR; PG8_SCHED;
            PG8_LDB(B1, 0, 1); PG8_STAGE(PG8_SB(0, 0), b2, voffB);
            PG8_BAR; PG8_WAIT_L(0); PG8_MMA(0, 1, At, B1); PG8_BAR;
            PG8_LDA(At, 0, 1); PG8_STAGE(PG8_SA(0, 0), a2, voffA);
            PG8_BAR; PG8_WAIT_L(0); PG8_MMA(1, 0, At, B0); PG8_BAR; PG8_SCHED;
            PG8_STAGE(PG8_SB(0, 1), b2 + hstep, voffB);
            PG8_WAIT_V(6); PG8_BAR; PG8_MMA(1, 1, At, B1); PG8_BAR;
            PG8_LDB(B0, 1, 0); PG8_SCHED; PG8_LDA(At, 1, 0); PG8_STAGE(PG8_SA(0, 1), a2 + hstep, voffA);
            PG8_WAIT_L(8); PG8_BAR; PG8_WAIT_L(0); PG8_MMA(0, 0, At, B0); PG8_BAR; PG8_SCHED;
            PG8_LDB(B1, 1, 1); PG8_STAGE(PG8_SB(1, 0), b3, voffB);
            PG8_BAR; PG8_WAIT_L(0); PG8_MMA(0, 1, At, B1); PG8_BAR;
            PG8_LDA(At, 1, 1); PG8_STAGE(PG8_SA(1, 0), a3, voffA);
            PG8_BAR; PG8_WAIT_L(0); PG8_MMA(1, 0, At, B0); PG8_BAR; PG8_SCHED;
            PG8_STAGE(PG8_SB(1, 1), b3 + hstep, voffB);
            PG8_WAIT_V(6); PG8_BAR; PG8_MMA(1, 1, At, B1); PG8_BAR;
            }
        }
        if constexpr (ALIGN_EPI) { if (wr == 0) PG8_BAR; }
        if constexpr (!Epi::AFTER_DRAIN) { E(acc, cur, wr, wc, fr, fq); S.done(cur); }
        if (!has_next) break;
#pragma unroll
        for (int a = 0; a < 2; ++a)
#pragma unroll
            for (int b = 0; b < 2; ++b)
#pragma unroll
                for (int m = 0; m < 4; ++m)
#pragma unroll
                    for (int n = 0; n < 2; ++n) acc[a][b][m][n] = (f32x4){0.f, 0.f, 0.f, 0.f};
        cur = nxt; cA = nA; cB = nB; ++ui;
        if constexpr (ALIGN_EPI) { if (wr == 1) PG8_BAR; }
    }
    PG8_WAIT_V(0);
    if constexpr (!ALIGN_EPI) { if (wr == 0) PG8_BAR; }
    PG8_BAR;
    if constexpr (Epi::AFTER_DRAIN) { E.fused(acc, cur, wr, wc, fr, fq, lds, wid, lane); S.done(cur); }
#undef PG8_SA
#undef PG8_SB
#undef PG8_STAGE
#undef PG8_LDA
#undef PG8_LDB
#undef PG8_MMA
#undef PG8_WAIT_V
#undef PG8_WAIT_L
#undef PG8_BAR
#undef PG8_SCHED
}
}
#define GAS __attribute__((address_space(1)))
#define LAS __attribute__((address_space(3)))
typedef unsigned short bf16;
typedef unsigned v4u __attribute__((ext_vector_type(4)));
typedef float f32x4 __attribute__((ext_vector_type(4)));
typedef short bf16x8 __attribute__((ext_vector_type(8)));
typedef GAS unsigned gu32;
typedef GAS unsigned long long gu64;
#define RLX_AGENT __ATOMIC_RELAXED, __HIP_MEMORY_SCOPE_AGENT
#define LDS_WAIT() asm volatile("s_waitcnt lgkmcnt(0)" ::: "memory")
#define VM_WAIT() asm volatile("s_waitcnt vmcnt(0)" ::: "memory")
__device__ __forceinline__ unsigned long long rt() { return __builtin_amdgcn_s_memrealtime(); }
__device__ __forceinline__ unsigned f2bf(float f) { unsigned u = __builtin_bit_cast(unsigned, f); return (u + 0x7fffu + ((u >> 16) & 1u)) >> 16; }
__device__ __forceinline__ unsigned pk2(float lo, float hi) { return f2bf(lo) | (f2bf(hi) << 16); }

#define XB_TMO      128
#define XB_XCNT(j)  (256  + 64 * (j))
#define XB_XSUB(j)  (1280 + 64 * (j))
#define XB_XGEN(j)  (2304 + 64 * (j))
#define XB_TOP      3328
#define XB_TOPGEN   3392
#define XCD_BAR_WORDS 3456
#define XB_SPIN_CAP (1u << 18)

__device__ __forceinline__ unsigned xb_ld(unsigned* p)              { return __hip_atomic_load(p, __ATOMIC_RELAXED, __HIP_MEMORY_SCOPE_AGENT); }
__device__ __forceinline__ unsigned xb_add(unsigned* p, unsigned v) { return __hip_atomic_fetch_add(p, v, __ATOMIC_RELAXED, __HIP_MEMORY_SCOPE_AGENT); }
__device__ __forceinline__ unsigned xb_xcc_id() { return (unsigned)__builtin_amdgcn_s_getreg((3 << 11) | 20) & 0xFu; }
#define XB_SPIN(cond, bar) do { unsigned _sp = 0; while (cond) { __builtin_amdgcn_s_sleep(1); \
    if ((++_sp & 255u) == 0u) { if (xb_ld(&(bar)[XB_TMO])) break; if (_sp > XB_SPIN_CAP) { atomicAdd(&(bar)[XB_TMO], 1u); break; } } } } while (0)

struct XcdBarrier {
    unsigned* bar; unsigned x;
    volatile LAS unsigned* st;
};

__device__ __forceinline__ XcdBarrier xcd_barrier_post(unsigned* bar, volatile LAS unsigned* st) {
    XcdBarrier b; b.bar = bar; b.x = xb_xcc_id(); b.st = st;
    if (threadIdx.x == 0) (void)xb_add(&bar[XB_XCNT(b.x)], 1u);
    return b;
}
__device__ __forceinline__ void xcd_barrier_complete(unsigned* bar, unsigned x, unsigned& nloc, unsigned& nx) {
    const unsigned G = gridDim.x * gridDim.y * gridDim.z;
    unsigned sum, cnt, mine, sp = 0u;
    for (;;) {
        sum = 0u; cnt = 0u; mine = 0u;
#pragma unroll
        for (unsigned j = 0; j < 16; ++j) { const unsigned c = xb_ld(&bar[XB_XCNT(j)]); sum += c; cnt += (c > 0u) ? 1u : 0u; mine = (j == x) ? c : mine; }
        if (sum == G) break;
        __builtin_amdgcn_s_sleep(1);
        if ((++sp & 255u) == 0u) { if (xb_ld(&bar[XB_TMO])) break; if (sp > XB_SPIN_CAP) { atomicAdd(&bar[XB_TMO], 1u); break; } }
    }
    nloc = mine > 0u ? mine : 1u; nx = cnt > 0u ? cnt : 1u;
}

__device__ __forceinline__ void xcd_barrier(const XcdBarrier& b) {
    asm volatile("s_waitcnt vmcnt(0)" ::: "memory");
    __syncthreads();
    if (threadIdx.x == 0) {
        unsigned* bar = b.bar;
        __builtin_amdgcn_s_waitcnt(0);
        unsigned nloc = b.st[0], nx = b.st[1];
        if (nloc == 0u) { xcd_barrier_complete(bar, b.x, nloc, nx); b.st[0] = nloc; b.st[1] = nx; }
        const unsigned old = xb_add(&bar[XB_XSUB(b.x)], 1u);
        const unsigned gen = old / nloc;
        if (old + 1u == (gen + 1u) * nloc) {
            __builtin_amdgcn_fence(__ATOMIC_RELEASE, "agent");
            asm volatile("s_waitcnt vmcnt(0)" ::: "memory");
            const unsigned og = xb_add(&bar[XB_TOP], 1u);
            const unsigned tg = og / nx;
            if (og + 1u == (tg + 1u) * nx) xb_add(&bar[XB_TOPGEN], 1u);
            else XB_SPIN(xb_ld(&bar[XB_TOPGEN]) == tg, bar);
            __builtin_amdgcn_fence(__ATOMIC_ACQUIRE, "agent");
            xb_add(&bar[XB_XGEN(b.x)], 1u);
            asm volatile("s_waitcnt vmcnt(0)" ::: "memory");
        } else {
            XB_SPIN(xb_ld(&bar[XB_XGEN(b.x)]) == gen, bar);
            __builtin_amdgcn_fence(__ATOMIC_ACQUIRE, "agent");
            asm volatile("s_waitcnt vmcnt(0)" ::: "memory");
        }
    }
    __syncthreads();
}

constexpr int T = 16384, D = 1024, SEQ = 8192, NCTX = 256, TCX = 512, DIN = 3840, MH = T + TCX;
constexpr int ZU = 0, ZV = 512, ZQ = 1024, ZK = 1536, ZVA = 1664, ZGA = 1792, ZGB = 2816;
constexpr int NEXP = 256, NSLOT = 9, LISTCAP = 16384;
constexpr float LOG2E = 1.4426950408889634f;
constexpr float QSCALE = 0.125f * LOG2E;
constexpr size_t MiB = 1u << 20;
constexpr size_t WS_CTL = 0, CTL_ZERO_BYTES = 1 * MiB;
constexpr size_t WS_ADAP = 1 * MiB;
constexpr size_t WS_ADAF = 2 * MiB;
constexpr size_t WS_ROPE = 2 * MiB + 128 * 1024;
constexpr size_t WS_WST = 2 * MiB + 256 * 1024;
constexpr size_t WS_RWT = 3 * MiB;
constexpr size_t WS_WINT = 4 * MiB;
constexpr size_t WS_WAT = 12 * MiB, WS_WBT = 13 * MiB, WS_WOT = 14 * MiB;
constexpr size_t WS_KVC = 16 * MiB;
constexpr size_t WS_GATEW = 17 * MiB;
constexpr size_t WS_H = 18 * MiB;
constexpr size_t WS_Z = 52 * MiB;
constexpr size_t WS_A = 172 * MiB, WS_O = 188 * MiB;
constexpr size_t WS_TMP = 204 * MiB;
constexpr size_t WS_Y = 268 * MiB;
constexpr size_t WS_X1 = 300 * MiB;
constexpr size_t WS_H2 = 364 * MiB;
constexpr size_t WS_LIST = 396 * MiB;
constexpr size_t WS_CONTRIB = 414 * MiB;
constexpr size_t WS_END = 704 * MiB;
constexpr int CW_BAR = 4096;
constexpr int CW_CNT = 16384;
constexpr int CW_XRANK = 32768;
constexpr int SCR_BYTES = 148480;
constexpr int MISC_OFF = SCR_BYTES;
constexpr int LDS_BYTES = 152 * 1024;
constexpr int NWAVES = 8;

typedef float f32x2_t __attribute__((ext_vector_type(2)));
typedef __bf16 bf16x2_t __attribute__((ext_vector_type(2)));
typedef float f32x16 __attribute__((ext_vector_type(16)));
typedef short s16x4 __attribute__((ext_vector_type(4)));
typedef short v4i16_t __attribute__((ext_vector_type(4)));
typedef unsigned u32x2 __attribute__((ext_vector_type(2)));
typedef unsigned u32x4 __attribute__((ext_vector_type(4)));
typedef LAS unsigned char* ldsp;

__device__ __forceinline__ unsigned cvtpk(float lo, float hi) { f32x2_t v = {lo, hi}; bf16x2_t b = __builtin_convertvector(v, bf16x2_t); return __builtin_bit_cast(unsigned, b); }
__device__ __forceinline__ float bf2f(unsigned short u) { return __uint_as_float((unsigned)u << 16); }
__device__ __forceinline__ float bflo(unsigned w) { return __uint_as_float(w << 16); }
__device__ __forceinline__ float bfhi(unsigned w) { return __uint_as_float(w & 0xffff0000u); }
__device__ __forceinline__ float wave_sum(float v) {
#pragma unroll
    for (int o = 1; o < 64; o <<= 1) v += __shfl_xor(v, o);
    return v;
}
__device__ __forceinline__ float sigmoid_f(float x) { return __builtin_amdgcn_rcpf(1.f + __builtin_amdgcn_exp2f(-x * LOG2E)); }
__device__ __forceinline__ float silu_f(float x) { return x * sigmoid_f(x); }
__device__ __forceinline__ float gelu_f(float x) { const float u = 0.7978845608028654f * (x + 0.044715f * x * x * x); return x * sigmoid_f(2.f * u); }
__device__ __forceinline__ f32x16 mfma32(bf16x8 a, bf16x8 b, f32x16 c) { return __builtin_amdgcn_mfma_f32_32x32x16_bf16(a, b, c, 0, 0, 0); }
__device__ __forceinline__ f32x4 mfma16(bf16x8 a, bf16x8 b, f32x4 c) { return __builtin_amdgcn_mfma_f32_16x16x32_bf16(a, b, c, 0, 0, 0); }

struct Args { const float* in[26]; float* out; unsigned char* ws; int ph_lo, ph_hi; };
enum { I_X = 0, I_C, I_CTX, I_CCTX, I_ADAW, I_ADAB, I_N1G, I_N2G, I_WIN, I_LNG, I_LNB, I_GWS, I_GBS, I_SINK, I_WA, I_WB, I_WO, I_RW, I_RB, I_EG, I_EU, I_ED, I_SG, I_SU, I_SD, I_FG };

__device__ __forceinline__ void p0_transpose_item(const float* W, int K, int N, bf16* WT, LAS float* scr, int item, int lane) {
    const int nblk = N / 32, kb = item / nblk, nb = item % nblk, k0 = 64 * kb, n0 = 32 * nb;
#pragma unroll 8
    for (int i = 0; i < 32; ++i) { const int kk = 2 * i + (lane >> 5); scr[kk * 33 + (lane & 31)] = W[(size_t)(k0 + kk) * N + n0 + (lane & 31)]; }
    LDS_WAIT(); asm volatile("" ::: "memory");
    const int c = lane & 7;
#pragma unroll
    for (int j = 0; j < 4; ++j) { const int n = (lane >> 3) + 8 * j; const LAS float* s = scr + (8 * c) * 33 + n;
        v4u o; o.x = pk2(s[0 * 33], s[1 * 33]); o.y = pk2(s[2 * 33], s[3 * 33]); o.z = pk2(s[4 * 33], s[5 * 33]); o.w = pk2(s[6 * 33], s[7 * 33]);
        *(GAS v4u*)(WT + (size_t)(n0 + n) * K + k0 + 8 * c) = o; }
    LDS_WAIT(); asm volatile("" ::: "memory");
}

__device__ __forceinline__ void phase_prep(const Args& a, ldsp lds, int G) {
    const int tid = threadIdx.x, lane = tid & 63, wave = __builtin_amdgcn_readfirstlane(tid >> 6), blk = blockIdx.x;
    unsigned char* ws = a.ws;
    if (blk < 192) {
        const int cb = blk % 24, kc = blk / 24, col = cb * 256 + lane * 4, k0 = kc * 128 + wave * 16;
        const float* c = a.in[I_C]; const float* cc = a.in[I_CCTX]; const float* aw = a.in[I_ADAW];
        f32x4 a0 = {0.f, 0.f, 0.f, 0.f}, a1 = a0, a2 = a0;
#pragma unroll 4
        for (int k = 0; k < 16; ++k) {
            const int kk = k0 + k;
            const float s0 = silu_f(c[kk]), s1 = silu_f(c[1024 + kk]), s2 = silu_f(cc[kk]);
            const f32x4 w = *(const f32x4*)(aw + (size_t)kk * 6144 + col);
            a0 += w * s0; a1 += w * s1; a2 += w * s2;
        }
        LAS float* red = (LAS float*)lds;
        *(LAS f32x4*)(red + (wave * 3 + 0) * 256 + lane * 4) = a0;
        *(LAS f32x4*)(red + (wave * 3 + 1) * 256 + lane * 4) = a1;
        *(LAS f32x4*)(red + (wave * 3 + 2) * 256 + lane * 4) = a2;
        __syncthreads();
        float* adap = (float*)(ws + WS_ADAP);
        for (int idx = tid; idx < 768; idx += 512) {
            const int v = idx >> 8, cl = idx & 255; float s = 0.f;
#pragma unroll
            for (int w = 0; w < 8; ++w) s += red[(w * 3 + v) * 256 + cl];
            adap[(size_t)(kc * 3 + v) * 6144 + cb * 256 + cl] = s;
        }
        __syncthreads();
    }
    {
        LAS float* scr = (LAS float*)(lds + wave * 8704);
        const int gw = blk * NWAVES + wave, NGW = G * NWAVES;
        constexpr int I_1 = 16 * 120, I_2 = 8 * 32, I_3 = 8 * 32, I_4 = 16 * 32, I_5 = 16 * 8;
        for (int it = gw; it < I_1 + I_2 + I_3 + I_4 + I_5; it += NGW) {
            int r = it;
            if (r < I_1) { p0_transpose_item(a.in[I_WIN], 1024, 3840, (bf16*)(ws + WS_WINT), scr, r, lane); continue; } r -= I_1;
            if (r < I_2) { p0_transpose_item(a.in[I_WA], 512, 1024, (bf16*)(ws + WS_WAT), scr, r, lane); continue; } r -= I_2;
            if (r < I_3) { p0_transpose_item(a.in[I_WB], 512, 1024, (bf16*)(ws + WS_WBT), scr, r, lane); continue; } r -= I_3;
            if (r < I_4) { p0_transpose_item(a.in[I_WO], 1024, 1024, (bf16*)(ws + WS_WOT), scr, r, lane); continue; } r -= I_4;
            p0_transpose_item(a.in[I_RW], 1024, 256, (bf16*)(ws + WS_RWT), scr, r, lane);
        }
    }
    {
        const int gt = blk * 512 + tid, NT = G * 512;
        const float* gws = a.in[I_GWS]; bf16* wst = (bf16*)(ws + WS_WST);
        for (int i = gt; i < 8192; i += NT) {
            const f32x4 x0 = *(const f32x4*)(gws + i * 8), x1 = *(const f32x4*)(gws + i * 8 + 4);
            v4u o; o.x = cvtpk(x0[0], x0[1]); o.y = cvtpk(x0[2], x0[3]); o.z = cvtpk(x1[0], x1[1]); o.w = cvtpk(x1[2], x1[3]);
            *(v4u*)(wst + i * 8) = o;
        }
        float* rope = (float*)(ws + WS_ROPE);
        for (int i = gt; i < 2048; i += NT) {
            const int pos = i >> 4, f = i & 15;
            const float inv = __builtin_amdgcn_exp2f(-(float)f * (13.287712379549449f / 16.f));
            const float ang = (float)pos * inv;
            double rev = (double)ang * 0.15915494309189535; rev -= floor(rev);
            rope[pos * 32 + f] = __builtin_amdgcn_cosf((float)rev);
            rope[pos * 32 + 16 + f] = __builtin_amdgcn_sinf((float)rev);
        }
    }
}

__device__ __forceinline__ void phase_hnorm(const Args& a, ldsp lds, int G) {
    const int tid = threadIdx.x, lane = tid & 63, wave = __builtin_amdgcn_readfirstlane(tid >> 6), blk = blockIdx.x;
    unsigned char* ws = a.ws;
    const float* adap = (const float*)(ws + WS_ADAP); const float* adab = a.in[I_ADAB];
    LAS float* modv = (LAS float*)lds;
    for (int idx = tid; idx < 3 * 2048; idx += 512) {
        const int v = idx >> 11, j = idx & 2047; float s = adab[j];
#pragma unroll
        for (int kc = 0; kc < 8; ++kc) s += adap[(size_t)(kc * 3 + v) * 6144 + j];
        modv[idx] = (j >= 1024) ? s + 1.f : s;
    }
    { float* adaf = (float*)(ws + WS_ADAF);
      for (int idx = blk * 512 + tid; idx < 3 * 6144; idx += G * 512) {
          const int v = idx / 6144, j = idx % 6144; float s = adab[j];
#pragma unroll
          for (int kc = 0; kc < 8; ++kc) s += adap[(size_t)(kc * 3 + v) * 6144 + j];
          adaf[idx] = s; } }
    __syncthreads();
    const float* g1 = a.in[I_N1G]; bf16* H = (bf16*)(ws + WS_H);
    for (int t = blk * NWAVES + wave; t < MH; t += G * NWAVES) {
        const float* xr = (t < T) ? a.in[I_X] + (size_t)t * D : a.in[I_CTX] + (size_t)(t - T) * D;
        const int v = (t < T) ? (t >> 13) : 2;
        f32x4 x[4]; float ss = 0.f;
#pragma unroll
        for (int j = 0; j < 4; ++j) { x[j] = *(const f32x4*)(xr + 4 * lane + 256 * j); ss += (x[j][0] * x[j][0] + x[j][1] * x[j][1]) + (x[j][2] * x[j][2] + x[j][3] * x[j][3]); }
        const float r = rsqrtf(wave_sum(ss) * (1.f / D) + 1e-6f);
#pragma unroll
        for (int j = 0; j < 4; ++j) {
            const int col = 4 * lane + 256 * j;
            const f32x4 g = *(const f32x4*)(g1 + col);
            const f32x4 sh = *(LAS f32x4*)(modv + v * 2048 + col), sc = *(LAS f32x4*)(modv + v * 2048 + 1024 + col);
            const f32x4 h = (x[j] * r) * g * sc + sh;
            u32x2 o; o.x = cvtpk(h[0], h[1]); o.y = cvtpk(h[2], h[3]);
            *(u32x2*)(H + (size_t)t * D + col) = o;
        }
    }
}

struct WinOrder {
    pg8::StaticOrder so;
    __device__ void init(int G, int c) { so.init(T, DIN, G, c); }
    __device__ bool next(int i, pg8::Unit& u) const {
        const long L = (long)i * so.G + so.c;
        if (L < 960) return so.next(i, u);
        if (L < 962) { u.pm = 64 + (int)(L - 960); u.pn = 6; return true; }
        return false;
    }
    __device__ __forceinline__ void a_ready(const pg8::Unit&) const {}
    __device__ __forceinline__ void done(const pg8::Unit&) const {}
};
struct EpiWin {
    static constexpr bool PERM = false, AFTER_DRAIN = false;
    bf16* Z; bf16* KVC; const float* rope;
    __device__ __forceinline__ void operator()(const pg8::f32x4 (&acc)[2][2][4][2], const pg8::Unit& u, int wr, int wc, int fr, int fq) const {
        const int row0 = u.pm * 256 + wr * 64 + fr, colb = u.pn * 256 + wc * 32 + 4 * fq, pn = u.pn;
        if (u.pm >= 64) {
#pragma unroll
            for (int ai = 0; ai < 2; ++ai)
#pragma unroll
                for (int m = 0; m < 4; ++m) { bf16* rp = KVC + (size_t)(row0 + ai * 128 + m * 16 - T) * 256 + (colb - ZK);
#pragma unroll
                    for (int bj = 0; bj < 2; ++bj)
#pragma unroll
                        for (int n = 0; n < 2; ++n) { const pg8::f32x4 v = acc[ai][bj][m][n]; u32x2 o; o.x = cvtpk(v[0], v[1]); o.y = cvtpk(v[2], v[3]); *(u32x2*)(rp + bj * 128 + n * 16) = o; } }
            return;
        }
#pragma unroll
        for (int ai = 0; ai < 2; ++ai)
#pragma unroll
            for (int m = 0; m < 4; ++m) {
                const int r = row0 + ai * 128 + m * 16; bf16* rp = Z + (size_t)r * DIN + colb;
                if (pn <= 3) {
#pragma unroll
                    for (int bj = 0; bj < 2; ++bj)
#pragma unroll
                        for (int n = 0; n < 2; ++n) { const pg8::f32x4 v = acc[ai][bj][m][n]; u32x2 o; o.x = cvtpk(gelu_f(v[0]), gelu_f(v[1])); o.y = cvtpk(gelu_f(v[2]), gelu_f(v[3])); *(u32x2*)(rp + bj * 128 + n * 16) = o; }
                } else if (pn <= 6) {
                    const int pos = (wc & 1) ? (r & 63) : ((r & 8191) >> 6);
                    const pg8::f32x4 cs = *(const pg8::f32x4*)(rope + pos * 32 + 4 * fq), sn = *(const pg8::f32x4*)(rope + pos * 32 + 16 + 4 * fq);
                    const float sc = (pn < 6) ? QSCALE : 1.f;
#pragma unroll
                    for (int bj = 0; bj < 2; ++bj) {
                        const pg8::f32x4 x1 = acc[ai][bj][m][0], x2 = acc[ai][bj][m][1];
                        pg8::f32x4 o1, o2;
                        if (pn == 6 && bj == 1) { o1 = x1; o2 = x2; }
                        else { o1 = (x1 * cs - x2 * sn) * sc; o2 = (x2 * cs + x1 * sn) * sc; }
                        u32x2 w1, w2; w1.x = cvtpk(o1[0], o1[1]); w1.y = cvtpk(o1[2], o1[3]); w2.x = cvtpk(o2[0], o2[1]); w2.y = cvtpk(o2[2], o2[3]);
                        *(u32x2*)(rp + bj * 128) = w1; *(u32x2*)(rp + bj * 128 + 16) = w2;
                    }
                } else {
#pragma unroll
                    for (int bj = 0; bj < 2; ++bj)
#pragma unroll
                        for (int n = 0; n < 2; ++n) { const pg8::f32x4 v = acc[ai][bj][m][n]; u32x2 o; o.x = cvtpk(sigmoid_f(v[0]), sigmoid_f(v[1])); o.y = cvtpk(sigmoid_f(v[2]), sigmoid_f(v[3])); *(u32x2*)(rp + bj * 128 + n * 16) = o; }
                }
            }
    }
};
struct EpiMergeA {
    static constexpr bool PERM = true, AFTER_DRAIN = false;
    const bf16* Z; float* TMP;
    __device__ __forceinline__ void operator()(const pg8::f32x4 (&acc)[2][2][4][2], const pg8::Unit& u, int wr, int wc, int fr, int fq) const {
        const int row0 = u.pm * 256 + wr * 64 + fr, col0 = u.pn * 256 + wc * 32 + 8 * fq;
#pragma unroll
        for (int ai = 0; ai < 2; ++ai)
#pragma unroll
            for (int m = 0; m < 4; ++m) { const int r = row0 + ai * 128 + m * 16;
#pragma unroll
                for (int bj = 0; bj < 2; ++bj) { const int c = col0 + bj * 128;
                    const u32x4 g = *(const u32x4*)(Z + (size_t)r * DIN + ZGA + c);
                    const pg8::f32x4 v0 = acc[ai][bj][m][0], v1 = acc[ai][bj][m][1];
                    pg8::f32x4 o0 = {v0[0] * bflo(g.x), v0[1] * bfhi(g.x), v0[2] * bflo(g.y), v0[3] * bfhi(g.y)};
                    pg8::f32x4 o1 = {v1[0] * bflo(g.z), v1[1] * bfhi(g.z), v1[2] * bflo(g.w), v1[3] * bfhi(g.w)};
                    *(pg8::f32x4*)(TMP + (size_t)r * D + c) = o0; *(pg8::f32x4*)(TMP + (size_t)r * D + c + 4) = o1; } }
    }
};
struct EpiMergeB {
    static constexpr bool PERM = true, AFTER_DRAIN = false;
    const bf16* Z; const float* TMP; bf16* Y;
    __device__ __forceinline__ void operator()(const pg8::f32x4 (&acc)[2][2][4][2], const pg8::Unit& u, int wr, int wc, int fr, int fq) const {
        const int row0 = u.pm * 256 + wr * 64 + fr, col0 = u.pn * 256 + wc * 32 + 8 * fq;
#pragma unroll
        for (int ai = 0; ai < 2; ++ai)
#pragma unroll
            for (int m = 0; m < 4; ++m) { const int r = row0 + ai * 128 + m * 16;
#pragma unroll
                for (int bj = 0; bj < 2; ++bj) { const int c = col0 + bj * 128;
                    const u32x4 g = *(const u32x4*)(Z + (size_t)r * DIN + ZGB + c);
                    const pg8::f32x4 t0 = *(const pg8::f32x4*)(TMP + (size_t)r * D + c), t1 = *(const pg8::f32x4*)(TMP + (size_t)r * D + c + 4);
                    const pg8::f32x4 v0 = acc[ai][bj][m][0], v1 = acc[ai][bj][m][1];
                    u32x4 o;
                    o.x = cvtpk(t0[0] + v0[0] * bflo(g.x), t0[1] + v0[1] * bfhi(g.x)); o.y = cvtpk(t0[2] + v0[2] * bflo(g.y), t0[3] + v0[3] * bfhi(g.y));
                    o.z = cvtpk(t1[0] + v1[0] * bflo(g.z), t1[1] + v1[1] * bfhi(g.z)); o.w = cvtpk(t1[2] + v1[2] * bflo(g.w), t1[3] + v1[3] * bfhi(g.w));
                    *(u32x4*)(Y + (size_t)r * D + c) = o; } }
    }
};
struct EpiWo {
    static constexpr bool PERM = true, AFTER_DRAIN = false;
    const float* x; const float* adaf; float* X1;
    __device__ __forceinline__ void operator()(const pg8::f32x4 (&acc)[2][2][4][2], const pg8::Unit& u, int wr, int wc, int fr, int fq) const {
        const int row0 = u.pm * 256 + wr * 64 + fr, col0 = u.pn * 256 + wc * 32 + 8 * fq;
        const float* g1 = adaf + (u.pm >= 32 ? 6144 : 0) + 2048;
#pragma unroll
        for (int bj = 0; bj < 2; ++bj) { const int c = col0 + bj * 128;
            const pg8::f32x4 ga = *(const pg8::f32x4*)(g1 + c), gb = *(const pg8::f32x4*)(g1 + c + 4);
#pragma unroll
            for (int ai = 0; ai < 2; ++ai)
#pragma unroll
                for (int m = 0; m < 4; ++m) { const int r = row0 + ai * 128 + m * 16;
                    const pg8::f32x4 x0 = *(const pg8::f32x4*)(x + (size_t)r * D + c), x1 = *(const pg8::f32x4*)(x + (size_t)r * D + c + 4);
                    *(pg8::f32x4*)(X1 + (size_t)r * D + c) = x0 + ga * acc[ai][bj][m][0];
                    *(pg8::f32x4*)(X1 + (size_t)r * D + c + 4) = x1 + gb * acc[ai][bj][m][1]; } }
    }
};

__device__ __forceinline__ s16x4 vtr(LAS const unsigned char* p) { return __builtin_bit_cast(s16x4, __builtin_amdgcn_ds_read_tr16_b64_v4i16((LAS v4i16_t*)p)); }

__device__ __forceinline__ void attn_item(const bf16* Z, const bf16* KVC, const float* sink, bf16* Obuf, ldsp lds, int b, int nb, int hk, int qh) {
    const int tid = threadIdx.x, lane = tid & 63, wave = __builtin_amdgcn_readfirstlane(tid >> 6), r32 = lane & 31, hi = lane >> 5;
    const int rq = wave >> 1, head = hk * 4 + rq;
    const int iq = qh * 64 + (wave & 1) * 32 + r32;
    const int wlo = (nb == 0) ? 2 : qh, whi = (nb == 63) ? 4 : 5 + qh, nwin = whi - wlo, ntile = nwin + 4;
    const int tokq = b * SEQ + nb * 128 + iq;
    bf16x8 qr[4];
#pragma unroll
    for (int d0 = 0; d0 < 4; ++d0) qr[d0] = *(const bf16x8*)(Z + (size_t)tokq * DIN + ZQ + head * 64 + d0 * 16 + hi * 8);
    float mrun = sink[head] * LOG2E, lrun = (hi == 0) ? 1.f : 0.f;
    f32x16 o[2];
#pragma unroll
    for (int j = 0; j < 2; ++j)
#pragma unroll
        for (int r = 0; r < 16; ++r) o[j][r] = 0.f;
    const int kdst = wave * 1024 + lane * 16, vdst = 8192 + (wave >> 2) * 4096 + lane * 64 + (wave & 3) * 16;
#define ATT_SRC(s, kp, vp) do { const int tl_ = (s) < nwin ? wlo + (s) : 6 + (s) - nwin; \
        if (tl_ < 6) { const int tok_ = b * SEQ + (nb - 1 + (tl_ >> 1)) * 128 + (tl_ & 1) * 64 + lane; kp = Z + (size_t)tok_ * DIN + ZK + hk * 64 + wave * 8; vp = Z + (size_t)tok_ * DIN + ZVA + hk * 64 + wave * 8; } \
        else { const int row_ = b * NCTX + (tl_ - 6) * 64 + lane; kp = KVC + (size_t)row_ * 256 + hk * 64 + wave * 8; vp = KVC + (size_t)row_ * 256 + 128 + hk * 64 + wave * 8; } } while (0)
    u32x4 kreg, vreg;
    { const bf16 *kp, *vp; ATT_SRC(0, kp, vp); kreg = *(const u32x4*)kp; vreg = *(const u32x4*)vp; }
    *(LAS u32x4*)(lds + kdst) = kreg; *(LAS u32x4*)(lds + vdst) = vreg;
    __syncthreads();
    const int vrd = ((lane & 15) >> 2) * 64 + ((lane >> 4) & 1) * 32 + (lane & 3) * 8 + hi * 256;
    for (int s = 0; s < ntile; ++s) {
        const int base = (s & 1) * 16384;
        const int tl = s < nwin ? wlo + s : 6 + s - nwin;
        if (s + 1 < ntile) { const bf16 *kp, *vp; ATT_SRC(s + 1, kp, vp); kreg = *(const u32x4*)kp; vreg = *(const u32x4*)vp; }
        {
            f32x16 p0, p1;
#pragma unroll
            for (int r = 0; r < 16; ++r) { p0[r] = 0.f; p1[r] = 0.f; }
#pragma unroll
            for (int d0 = 0; d0 < 4; ++d0) {
                const bf16x8 k0 = *(LAS const bf16x8*)(lds + base + (2 * d0 + hi) * 1024 + r32 * 16);
                const bf16x8 k1 = *(LAS const bf16x8*)(lds + base + (2 * d0 + hi) * 1024 + (r32 + 32) * 16);
                p0 = mfma32(k0, qr[d0], p0); p1 = mfma32(k1, qr[d0], p1);
            }
            if (tl < 2) {
                const int j0 = (tl & 1) * 64 + 4 * hi;
#pragma unroll
                for (int r = 0; r < 16; ++r) { const int j = j0 + (r & 3) + 8 * (r >> 2); if (j < iq) p0[r] = -INFINITY; if (j + 32 < iq) p1[r] = -INFINITY; }
            } else if (tl == 4 || tl == 5) {
                const int j0 = (tl & 1) * 64 + 4 * hi;
#pragma unroll
                for (int r = 0; r < 16; ++r) { const int j = j0 + (r & 3) + 8 * (r >> 2); if (j > iq) p0[r] = -INFINITY; if (j + 32 > iq) p1[r] = -INFINITY; }
            }
            float mx = fmaxf(p0[0], p1[0]);
#pragma unroll
            for (int r = 1; r < 16; ++r) mx = fmaxf(mx, fmaxf(p0[r], p1[r]));
            mx = fmaxf(mx, __shfl_xor(mx, 32));
            const float mn = fmaxf(mrun, mx), alpha = __builtin_amdgcn_exp2f(mrun - mn);
            mrun = mn;
            float rs = 0.f;
#pragma unroll
            for (int r = 0; r < 16; ++r) { p0[r] = __builtin_amdgcn_exp2f(p0[r] - mn); p1[r] = __builtin_amdgcn_exp2f(p1[r] - mn); rs += p0[r] + p1[r]; }
            lrun = lrun * alpha + rs;
#pragma unroll
            for (int r = 0; r < 16; ++r) { o[0][r] *= alpha; o[1][r] *= alpha; }
            bf16x8 pf[4];
#pragma unroll
            for (int s4 = 0; s4 < 4; ++s4) {
                u32x4 w;
                if (s4 < 2) { w.x = cvtpk(p0[8 * s4 + 0], p0[8 * s4 + 1]); w.y = cvtpk(p0[8 * s4 + 2], p0[8 * s4 + 3]); w.z = cvtpk(p0[8 * s4 + 4], p0[8 * s4 + 5]); w.w = cvtpk(p0[8 * s4 + 6], p0[8 * s4 + 7]); }
                else { const int q = s4 - 2; w.x = cvtpk(p1[8 * q + 0], p1[8 * q + 1]); w.y = cvtpk(p1[8 * q + 2], p1[8 * q + 3]); w.z = cvtpk(p1[8 * q + 4], p1[8 * q + 5]); w.w = cvtpk(p1[8 * q + 6], p1[8 * q + 7]); }
                pf[s4] = __builtin_bit_cast(bf16x8, w);
            }
#pragma unroll
            for (int dblk = 0; dblk < 2; ++dblk)
#pragma unroll
                for (int s4 = 0; s4 < 4; ++s4) {
                    const s16x4 lo = vtr(lds + base + 8192 + dblk * 4096 + vrd + (16 * s4) * 64);
                    const s16x4 hh = vtr(lds + base + 8192 + dblk * 4096 + vrd + (16 * s4 + 8) * 64);
                    const bf16x8 vf = {lo[0], lo[1], lo[2], lo[3], hh[0], hh[1], hh[2], hh[3]};
                    o[dblk] = mfma32(vf, pf[s4], o[dblk]);
                }
        }
        if (s + 1 < ntile) { *(LAS u32x4*)(lds + (16384 - base) + kdst) = kreg; *(LAS u32x4*)(lds + (16384 - base) + vdst) = vreg; }
        __syncthreads();
    }
#undef ATT_SRC
    {
        const float lt = lrun + __shfl_xor(lrun, 32), inv = 1.f / lt;
        bf16* op = Obuf + (size_t)tokq * 512 + head * 64;
#pragma unroll
        for (int dblk = 0; dblk < 2; ++dblk)
#pragma unroll
            for (int r4 = 0; r4 < 4; ++r4) {
                u32x2 w; w.x = cvtpk(o[dblk][4 * r4] * inv, o[dblk][4 * r4 + 1] * inv); w.y = cvtpk(o[dblk][4 * r4 + 2] * inv, o[dblk][4 * r4 + 3] * inv);
                *(u32x2*)(op + 32 * dblk + 8 * r4 + 4 * hi) = w;
            }
    }
}

__device__ __forceinline__ void gmlp_item(const bf16* Z, const float* lng, const float* lnb, const bf16* WsT, const float* bs, bf16* Abuf, ldsp lds, int ch, int g) {
    const int tid = threadIdx.x, lane = tid & 63, wave = __builtin_amdgcn_readfirstlane(tid >> 6), fr = lane & 15, fq = lane >> 4;
    const int tok0 = ch * 128;
    LAS bf16* VT = (LAS bf16*)lds;
    f32x4 gA = *(const f32x4*)(lng + lane * 8), gB = *(const f32x4*)(lng + lane * 8 + 4), bA = *(const f32x4*)(lnb + lane * 8), bB = *(const f32x4*)(lnb + lane * 8 + 4);
#pragma unroll
    for (int rnd = 0; rnd < 2; ++rnd) {
        float y[8][8];
#pragma unroll
        for (int j = 0; j < 8; ++j) {
            const int tok = tok0 + wave * 16 + rnd * 8 + j;
            const u32x4 raw = *(const u32x4*)(Z + (size_t)tok * DIN + ZV + lane * 8);
            float x[8] = {bflo(raw.x), bfhi(raw.x), bflo(raw.y), bfhi(raw.y), bflo(raw.z), bfhi(raw.z), bflo(raw.w), bfhi(raw.w)};
            float s = 0.f;
#pragma unroll
            for (int i = 0; i < 8; ++i) s += x[i];
            const float mu = wave_sum(s) * (1.f / 512.f);
            float q = 0.f;
#pragma unroll
            for (int i = 0; i < 8; ++i) { x[i] -= mu; q += x[i] * x[i]; }
            const float rstd = rsqrtf(wave_sum(q) * (1.f / 512.f) + 1e-6f);
            y[j][0] = x[0] * rstd * gA[0] + bA[0]; y[j][1] = x[1] * rstd * gA[1] + bA[1]; y[j][2] = x[2] * rstd * gA[2] + bA[2]; y[j][3] = x[3] * rstd * gA[3] + bA[3];
            y[j][4] = x[4] * rstd * gB[0] + bB[0]; y[j][5] = x[5] * rstd * gB[1] + bB[1]; y[j][6] = x[6] * rstd * gB[2] + bB[2]; y[j][7] = x[7] * rstd * gB[3] + bB[3];
        }
        if ((lane >> 4) == g) {
#pragma unroll
            for (int i = 0; i < 8; ++i) {
                u32x4 w; w.x = cvtpk(y[0][i], y[1][i]); w.y = cvtpk(y[2][i], y[3][i]); w.z = cvtpk(y[4][i], y[5][i]); w.w = cvtpk(y[6][i], y[7][i]);
                *(LAS u32x4*)(VT + (8 * (lane & 15) + i) * 136 + wave * 16 + rnd * 8) = w;
            }
        }
    }
    __syncthreads();
    const int wm = wave >> 1, wn = wave & 1;
    f32x4 acc[2][4];
#pragma unroll
    for (int m = 0; m < 2; ++m)
#pragma unroll
        for (int n = 0; n < 4; ++n) acc[m][n] = (f32x4){0.f, 0.f, 0.f, 0.f};
#pragma unroll
    for (int ks = 0; ks < 4; ++ks) {
        bf16x8 af[2], bfr[4];
#pragma unroll
        for (int m = 0; m < 2; ++m) af[m] = *(const bf16x8*)(WsT + (size_t)g * 16384 + (32 * wm + 16 * m + fr) * 128 + 32 * ks + 8 * fq);
#pragma unroll
        for (int n = 0; n < 4; ++n) bfr[n] = *(LAS const bf16x8*)(VT + (64 * wn + 16 * n + fr) * 136 + 32 * ks + 8 * fq);
#pragma unroll
        for (int m = 0; m < 2; ++m)
#pragma unroll
            for (int n = 0; n < 4; ++n) acc[m][n] = mfma16(af[m], bfr[n], acc[m][n]);
    }
#pragma unroll
    for (int m = 0; m < 2; ++m)
#pragma unroll
        for (int reg = 0; reg < 4; ++reg) {
            const int p = 32 * wm + 16 * m + 4 * fq + reg, tok = tok0 + p; const float bias = bs[g * 128 + p];
#pragma unroll
            for (int n = 0; n < 4; ++n) {
                const int c = g * 128 + 64 * wn + 16 * n + fr;
                const float uu = bf2f(Z[(size_t)tok * DIN + ZU + c]);
                Abuf[(size_t)tok * 512 + c] = (bf16)(cvtpk(uu * (acc[m][n][reg] + bias), 0.f) & 0xffffu);
            }
        }
    __syncthreads();
}

__device__ __forceinline__ void phase_mixers(const Args& a, ldsp lds, int G, int vcu) {
    unsigned char* ws = a.ws;
    const bf16* Z = (const bf16*)(ws + WS_Z);
    for (int it = vcu; it < 512; it += G) {
        const int qh = it & 1, hk = (it >> 1) & 1, nb = (it >> 2) & 63, b = it >> 8;
        attn_item(Z, (const bf16*)(ws + WS_KVC), a.in[I_SINK], (bf16*)(ws + WS_O), lds, b, nb, hk, qh);
    }
    for (int it = vcu; it < 512; it += G) {
        gmlp_item(Z, a.in[I_LNG], a.in[I_LNB], (const bf16*)(ws + WS_WST), a.in[I_GBS], (bf16*)(ws + WS_A), lds, it >> 2, it & 3);
    }
}

#define KI_BEFORE(ka, ia, kb, ib) (((ka) > (kb)) || ((ka) == (kb) && (ia) < (ib)))
#define KI_CAS(K, I, p, q) do { const bool sw_ = KI_BEFORE(K[q], I[q], K[p], I[p]); const float kp_ = sw_ ? K[q] : K[p], kq_ = sw_ ? K[p] : K[q]; const int ip_ = sw_ ? I[q] : I[p], iq_ = sw_ ? I[p] : I[q]; \
        K[p] = kp_; I[p] = ip_; K[q] = kq_; I[q] = iq_; } while (0)
#define KI_SORT8(K, I) do { KI_CAS(K, I, 0, 1); KI_CAS(K, I, 2, 3); KI_CAS(K, I, 4, 5); KI_CAS(K, I, 6, 7); \
        KI_CAS(K, I, 0, 2); KI_CAS(K, I, 1, 3); KI_CAS(K, I, 4, 6); KI_CAS(K, I, 5, 7); \
        KI_CAS(K, I, 1, 2); KI_CAS(K, I, 5, 6); KI_CAS(K, I, 0, 4); KI_CAS(K, I, 3, 7); \
        KI_CAS(K, I, 1, 5); KI_CAS(K, I, 2, 6); KI_CAS(K, I, 1, 4); KI_CAS(K, I, 3, 6); \
        KI_CAS(K, I, 2, 4); KI_CAS(K, I, 3, 5); KI_CAS(K, I, 3, 4); } while (0)
#define KI_MERGE8(KA, IA, KB, IB) do { \
        _Pragma("unroll") for (int r_ = 0; r_ < 8; ++r_) { const bool tb_ = KI_BEFORE(KB[7 - r_], IB[7 - r_], KA[r_], IA[r_]); KA[r_] = tb_ ? KB[7 - r_] : KA[r_]; IA[r_] = tb_ ? IB[7 - r_] : IA[r_]; } \
        KI_CAS(KA, IA, 0, 4); KI_CAS(KA, IA, 1, 5); KI_CAS(KA, IA, 2, 6); KI_CAS(KA, IA, 3, 7); \
        KI_CAS(KA, IA, 0, 2); KI_CAS(KA, IA, 1, 3); KI_CAS(KA, IA, 4, 6); KI_CAS(KA, IA, 5, 7); \
        KI_CAS(KA, IA, 0, 1); KI_CAS(KA, IA, 2, 3); KI_CAS(KA, IA, 4, 5); KI_CAS(KA, IA, 6, 7); } while (0)
__device__ __forceinline__ void router_item(const Args& a, ldsp lds, int it) {
    const int tid = threadIdx.x, lane = tid & 63, wave = __builtin_amdgcn_readfirstlane(tid >> 6), fr = lane & 15, fq = lane >> 4;
    unsigned char* ws = a.ws;
    const int t0 = it * 64, b = t0 >> 13;
    const float* X1 = (const float*)(ws + WS_X1); const float* adaf = (const float*)(ws + WS_ADAF) + b * 6144;
    const float* g2 = a.in[I_N2G]; bf16* H2 = (bf16*)(ws + WS_H2);
    {
        f32x4 gm[2][2], sh[2][2];
#pragma unroll
        for (int j = 0; j < 2; ++j)
#pragma unroll
            for (int h = 0; h < 2; ++h) {
                const int c = 8 * lane + 512 * j + 4 * h;
                const f32x4 gg = *(const f32x4*)(g2 + c), sc = *(const f32x4*)(adaf + 4 * 1024 + c);
                gm[j][h] = gg * (sc + 1.f); sh[j][h] = *(const f32x4*)(adaf + 3 * 1024 + c);
            }
#pragma unroll
        for (int half = 0; half < 2; ++half) {
            f32x4 x[4][2][2];
#pragma unroll
            for (int tt = 0; tt < 4; ++tt)
#pragma unroll
                for (int j = 0; j < 2; ++j)
#pragma unroll
                    for (int h = 0; h < 2; ++h) x[tt][j][h] = *(const f32x4*)(X1 + (size_t)(t0 + wave * 8 + half * 4 + tt) * D + 8 * lane + 512 * j + 4 * h);
#pragma unroll
            for (int tt = 0; tt < 4; ++tt) {
                const int row = wave * 8 + half * 4 + tt, tok = t0 + row;
                float ss = 0.f;
#pragma unroll
                for (int j = 0; j < 2; ++j)
#pragma unroll
                    for (int h = 0; h < 2; ++h) { const f32x4 v = x[tt][j][h]; ss += (v[0] * v[0] + v[1] * v[1]) + (v[2] * v[2] + v[3] * v[3]); }
                const float r = rsqrtf(wave_sum(ss) * (1.f / D) + 1e-6f);
#pragma unroll
                for (int j = 0; j < 2; ++j) {
                    const f32x4 h0 = (x[tt][j][0] * r) * gm[j][0] + sh[j][0], h1 = (x[tt][j][1] * r) * gm[j][1] + sh[j][1];
                    u32x4 w; w.x = cvtpk(h0[0], h0[1]); w.y = cvtpk(h0[2], h0[3]); w.z = cvtpk(h1[0], h1[1]); w.w = cvtpk(h1[2], h1[3]);
                    *(u32x4*)(H2 + (size_t)tok * D + 8 * lane + 512 * j) = w;
                    const int kc = lane + 64 * j;
                    *(LAS u32x4*)(lds + kc * 1024 + ((row ^ (kc & 7)) * 16)) = w;
                }
            }
        }
    }
    __syncthreads();
    f32x4 acc[4][2];
#pragma unroll
    for (int m = 0; m < 4; ++m)
#pragma unroll
        for (int n = 0; n < 2; ++n) acc[m][n] = (f32x4){0.f, 0.f, 0.f, 0.f};
    const bf16* RwT = (const bf16*)(ws + WS_RWT) + (size_t)(32 * wave + fr) * D + 8 * fq;
#pragma unroll 8
    for (int ks = 0; ks < 32; ++ks) {
        const int kc = 4 * ks + fq;
        bf16x8 af[4], bfr[2];
#pragma unroll
        for (int n = 0; n < 2; ++n) bfr[n] = *(const bf16x8*)(RwT + (size_t)(16 * n) * D + 32 * ks);
#pragma unroll
        for (int m = 0; m < 4; ++m) af[m] = *(LAS const bf16x8*)(lds + kc * 1024 + (((16 * m + fr) ^ (kc & 7)) * 16));
#pragma unroll
        for (int m = 0; m < 4; ++m)
#pragma unroll
            for (int n = 0; n < 2; ++n) acc[m][n] = mfma16(af[m], bfr[n], acc[m][n]);
    }
    __syncthreads();
    LAS float* LG = (LAS float*)lds;
#pragma unroll
    for (int m = 0; m < 4; ++m)
#pragma unroll
        for (int n = 0; n < 2; ++n)
#pragma unroll
            for (int reg = 0; reg < 4; ++reg) LG[(32 * wave + 16 * n + fr) * 65 + 16 * m + 4 * fq + reg] = acc[m][n][reg];
    __syncthreads();
    LAS float* CK = (LAS float*)(lds + 69632); LAS int* CI = (LAS int*)(lds + 69632 + 16384);
    const float* rb = a.in[I_RB];
    float bk[8]; int bi[8];
#pragma unroll
    for (int q = 0; q < 4; ++q) {
        float gk[8]; int gi[8];
#pragma unroll
        for (int j = 0; j < 8; ++j) { const int e = 32 * wave + 8 * q + j; gk[j] = sigmoid_f(LG[e * 65 + lane]) + rb[e]; gi[j] = e; }
        KI_SORT8(gk, gi);
        if (q == 0) {
#pragma unroll
            for (int j = 0; j < 8; ++j) { bk[j] = gk[j]; bi[j] = gi[j]; }
        } else KI_MERGE8(bk, bi, gk, gi);
    }
#pragma unroll
    for (int r = 0; r < 8; ++r) { CK[(wave * 8 + r) * 64 + lane] = bk[r]; CI[(wave * 8 + r) * 64 + lane] = bi[r]; }
    __syncthreads();
#define RT_LEVEL(lvl) do { if ((wave & (2 * (lvl) - 1)) == 0) { float ok_[8]; int oi_[8]; \
            _Pragma("unroll") for (int r = 0; r < 8; ++r) { ok_[r] = CK[((wave + (lvl)) * 8 + r) * 64 + lane]; oi_[r] = CI[((wave + (lvl)) * 8 + r) * 64 + lane]; } \
            KI_MERGE8(bk, bi, ok_, oi_); \
            if ((lvl) < 4) { _Pragma("unroll") for (int r = 0; r < 8; ++r) { CK[(wave * 8 + r) * 64 + lane] = bk[r]; CI[(wave * 8 + r) * 64 + lane] = bi[r]; } } } \
        __syncthreads(); } while (0)
    RT_LEVEL(1); RT_LEVEL(2); RT_LEVEL(4);
#undef RT_LEVEL
    LAS unsigned* hist = (LAS unsigned*)(lds + 102400); LAS unsigned* hbase = hist + 256;
    if (tid < 256) hist[tid] = 0u;
    __syncthreads();
    unsigned* cnt = (unsigned*)(ws + WS_CTL) + CW_CNT; int* list = (int*)(ws + WS_LIST); float* gatew = (float*)(ws + WS_GATEW);
    unsigned rank[8];
    if (wave == 0) {
        const int tok = t0 + lane;
        float sel[8], ssum = 0.f;
#pragma unroll
        for (int r = 0; r < 8; ++r) { sel[r] = sigmoid_f(LG[bi[r] * 65 + lane]); ssum += sel[r]; }
#pragma unroll
        for (int r = 0; r < 8; ++r) rank[r] = __hip_atomic_fetch_add(&hist[bi[r]], 1u, __ATOMIC_RELAXED, __HIP_MEMORY_SCOPE_WORKGROUP);
        const float sc = 2.5f / ssum;
        f32x4 g0 = {sel[0] * sc, sel[1] * sc, sel[2] * sc, sel[3] * sc}, g1 = {sel[4] * sc, sel[5] * sc, sel[6] * sc, sel[7] * sc};
        *(f32x4*)(gatew + tok * 8) = g0; *(f32x4*)(gatew + tok * 8 + 4) = g1;
    }
    __syncthreads();
    if (tid < 256) { const unsigned h = hist[tid]; if (h) hbase[tid] = atomicAdd(cnt + 32 * tid, h); }
    __syncthreads();
    if (wave == 0) {
        const int tok = t0 + lane;
#pragma unroll
        for (int r = 0; r < 8; ++r) list[(size_t)bi[r] * LISTCAP + hbase[bi[r]] + rank[r]] = tok * NSLOT + r;
    }
    __syncthreads();
}

__device__ __forceinline__ void moe_tile(const Args& a, ldsp lds, int e, int mt, int nrows, int ntl) {
    const int tid = threadIdx.x, lane = tid & 63, wave = __builtin_amdgcn_readfirstlane(tid >> 6), fr = lane & 15, fq = lane >> 4;
    unsigned char* ws = a.ws;
    constexpr int ASTG = 0, BSTG = 16384, ACT = 49152, SLOTS = 114688, GWO = 115200;
    const bf16* H2 = (const bf16*)(ws + WS_H2);
    const float* Wg = (e < NEXP) ? a.in[I_EG] + (size_t)e * 262144 : a.in[I_SG];
    const float* Wu = (e < NEXP) ? a.in[I_EU] + (size_t)e * 262144 : a.in[I_SU];
    const float* Wd = (e < NEXP) ? a.in[I_ED] + (size_t)e * 262144 : a.in[I_SD];
    if (tid < 128) {
        int slot = -1; float gw = 0.f;
        if (tid < nrows) {
            if (e < NEXP) { slot = ((const int*)(ws + WS_LIST))[(size_t)e * LISTCAP + mt * 128 + tid]; gw = ((const float*)(ws + WS_GATEW))[(slot / NSLOT) * 8 + (slot % NSLOT)]; }
            else { slot = (mt * 128 + tid) * NSLOT + 8; gw = 1.f; }
        }
        ((LAS int*)(lds + SLOTS))[tid] = slot; ((LAS float*)(lds + GWO))[tid] = gw;
    }
    __syncthreads();
    const int wr = wave >> 2, wc = wave & 3;
    const int arow = tid >> 2, akc = tid & 3;
    const int aslot = ((LAS const int*)(lds + SLOTS))[arow];
    const bf16* asrc = H2 + (size_t)((aslot < 0 ? 0 : aslot) / NSLOT) * D + akc * 8;
    const int awr = ASTG + akc * 2048 + ((arow ^ (akc << 1)) * 16);
    const int ng = lane, kq = wave, cole = 4 * (ng & 31);
    const float* src1 = ((ng < 32) ? Wg : Wu) + (size_t)(4 * kq) * 256 + cole;
    const float* src2 = Wd + (size_t)(4 * kq) * 1024 + 4 * ng;
    int bwr1[4], bwr2[4];
#pragma unroll
    for (int i = 0; i < 4; ++i) {
        const int c1 = cole + i, rho1 = (c1 >> 5) * 64 + ((ng >= 32) ? 32 : 0) + (c1 & 31), rho2 = 4 * ng + i;
        bwr1[i] = BSTG + (kq >> 1) * 4096 + ((rho1 ^ ((rho1 >> 3) & 3)) * 16) + (kq & 1) * 8;
        bwr2[i] = BSTG + (kq >> 1) * 4096 + ((rho2 ^ ((rho2 >> 3) & 3)) * 16) + (kq & 1) * 8;
    }
    int ard[4], brd[4], rowm[4];
#pragma unroll
    for (int m = 0; m < 4; ++m) { rowm[m] = 64 * wr + 16 * m + fr; ard[m] = fq * 2048 + ((rowm[m] ^ (fq << 1)) * 16); }
#pragma unroll
    for (int n = 0; n < 4; ++n) { const int rho = 64 * wc + 16 * n + fr; brd[n] = BSTG + fq * 4096 + ((rho ^ ((rho >> 3) & 3)) * 16); }
    bf16* contrib = (bf16*)(ws + WS_CONTRIB);
    f32x4 acc[4][4];
    f32x4 B0[4], B1[4], B2[4], B3[4]; u32x4 A0, A1, A2, A3;
#define MOE_LOAD(s_, BR, AR) do { const int s0_ = (s_); const int ss_ = s0_ < 95 ? s0_ : 95; const bool g1_ = ss_ < 64; const int t_ = ss_ - 64; \
        const int k1_ = ss_ & 31, k2_ = t_ & 7; \
        const float* bp_ = g1_ ? src1 + (size_t)(32 * k1_) * 256 + 128 * (ss_ >> 5) : src2 + (size_t)(32 * k2_) * 1024 + 256 * (t_ >> 3); \
        const int str_ = g1_ ? 256 : 1024; \
        AR = *(const u32x4*)(asrc + 32 * k1_); \
        _Pragma("unroll") for (int j = 0; j < 4; ++j) BR[j] = *(const f32x4*)(bp_ + j * str_); } while (0)
#define MOE_WRITE(s_, BR, AR, buf_) do { const bool g1_ = (s_) < 64; \
        *(LAS u32x4*)(lds + (buf_) * 8192 + awr) = AR; \
        _Pragma("unroll") for (int i = 0; i < 4; ++i) { u32x2 w_; w_.x = cvtpk(BR[0][i], BR[1][i]); w_.y = cvtpk(BR[2][i], BR[3][i]); const int ad_ = g1_ ? bwr1[i] : bwr2[i]; *(LAS u32x2*)(lds + (buf_) * 16384 + ad_) = w_; } } while (0)
#define MOE_COMPUTE(s_, buf_) do { const int ss_ = (s_); \
        const int abase_ = (ss_ < 64) ? (buf_) * 8192 : ACT + ((ss_ - 64) & 7) * 8192; \
        bf16x8 af_[4], bf_[4]; \
        _Pragma("unroll") for (int m = 0; m < 4; ++m) af_[m] = *(LAS const bf16x8*)(lds + abase_ + ard[m]); \
        _Pragma("unroll") for (int n = 0; n < 4; ++n) bf_[n] = *(LAS const bf16x8*)(lds + (buf_) * 16384 + brd[n]); \
        _Pragma("unroll") for (int m = 0; m < 4; ++m) _Pragma("unroll") for (int n = 0; n < 4; ++n) acc[m][n] = mfma16(bf_[n], af_[m], acc[m][n]); } while (0)
    MOE_LOAD(0, B0, A0); MOE_LOAD(1, B1, A1); MOE_LOAD(2, B2, A2);
    MOE_WRITE(0, B0, A0, 0);
    __syncthreads();
    for (int s = 0; s < 96; s += 4) {
        if ((s & 31) == 0 || (s >= 64 && (s & 7) == 0)) {
#pragma unroll
            for (int m = 0; m < 4; ++m)
#pragma unroll
                for (int n = 0; n < 4; ++n) acc[m][n] = (f32x4){0.f, 0.f, 0.f, 0.f};
        }
        MOE_LOAD(s + 3, B3, A3); MOE_COMPUTE(s, 0); MOE_WRITE(s + 1, B1, A1, 1); __syncthreads();
        MOE_LOAD(s + 4, B0, A0); MOE_COMPUTE(s + 1, 1); MOE_WRITE(s + 2, B2, A2, 0); __syncthreads();
        MOE_LOAD(s + 5, B1, A1); MOE_COMPUTE(s + 2, 0); MOE_WRITE(s + 3, B3, A3, 1); __syncthreads();
        MOE_LOAD(s + 6, B2, A2); MOE_COMPUTE(s + 3, 1);
        if (s == 28 || s == 60) {
            const int p = s >> 5;
#pragma unroll
            for (int m = 0; m < 4; ++m)
#pragma unroll
                for (int n = 0; n < 2; ++n) {
                    const f32x4 gv = acc[m][n], uv = acc[m][n + 2];
                    u32x2 w; w.x = cvtpk(silu_f(gv[0]) * uv[0], silu_f(gv[1]) * uv[1]); w.y = cvtpk(silu_f(gv[2]) * uv[2], silu_f(gv[3]) * uv[3]);
                    const int kc = 16 * p + 4 * wc + 2 * n + (fq >> 1);
                    *(LAS u32x2*)(lds + ACT + kc * 2048 + ((rowm[m] ^ ((kc & 3) << 1)) * 16) + (fq & 1) * 8) = w;
                }
        } else if (s >= 64 && (s & 7) == 4) {
            const int q = (s - 64) >> 3;
#pragma unroll
            for (int m = 0; m < 4; ++m) {
                const int slot = ((LAS const int*)(lds + SLOTS))[rowm[m]]; const float gw = ((LAS const float*)(lds + GWO))[rowm[m]];
                if (slot >= 0) {
                    bf16* cp = contrib + (size_t)slot * D + q * 256 + 64 * wc + 4 * fq;
#pragma unroll
                    for (int n = 0; n < 4; ++n) { const f32x4 v = acc[m][n] * gw; u32x2 w; w.x = cvtpk(v[0], v[1]); w.y = cvtpk(v[2], v[3]); *(u32x2*)(cp + 16 * n) = w; }
                }
            }
        }
        MOE_WRITE(s + 4, B0, A0, 0); __syncthreads();
    }
#undef MOE_LOAD
#undef MOE_WRITE
#undef MOE_COMPUTE
}

__device__ __forceinline__ void phase_moe(const Args& a, ldsp lds, int G, int vcu) {
    const int tid = threadIdx.x;
    const unsigned* cnt = (const unsigned*)(a.ws + WS_CTL) + CW_CNT;
    LAS int* pre = (LAS int*)(lds + MISC_OFF + 512);
    if (tid == 0) { int s = 0; for (int e = 0; e < NEXP; ++e) { pre[e] = s; s += (int)((cnt[32 * e] + 127u) >> 7); } pre[NEXP] = s; }
    __syncthreads();
    const int total = pre[NEXP], ntiles = total + T / 128;
    for (int j = vcu; j < ntiles; j += G) {
        int e, mt, nrows, ntl;
        if (j < total) {
            int lo = 0, hi = NEXP;
            while (hi - lo > 1) { const int mid = (lo + hi) >> 1; if (pre[mid] <= j) lo = mid; else hi = mid; }
            e = lo; mt = j - pre[e]; const int c = (int)cnt[32 * e] - mt * 128; nrows = c < 128 ? c : 128; ntl = pre[e + 1] - pre[e];
        } else { e = NEXP; mt = j - total; nrows = 128; ntl = 8; }
        moe_tile(a, lds, e, mt, nrows, ntl);
    }
}

__device__ __forceinline__ void phase_combine(const Args& a, int G) {
    const int tid = threadIdx.x, lane = tid & 63, wave = __builtin_amdgcn_readfirstlane(tid >> 6), blk = blockIdx.x;
    unsigned char* ws = a.ws;
    const float* X1 = (const float*)(ws + WS_X1); const bf16* contrib = (const bf16*)(ws + WS_CONTRIB); const float* fg = a.in[I_FG];
    for (int t = blk * NWAVES + wave; t < T; t += G * NWAVES) {
        const float* g2 = (const float*)(ws + WS_ADAF) + (t >> 13) * 6144 + 5 * 1024;
        f32x4 xv[2][2]; float ss = 0.f;
#pragma unroll
        for (int j = 0; j < 2; ++j) {
            const int c = 8 * lane + 512 * j;
            float sm[8] = {0.f, 0.f, 0.f, 0.f, 0.f, 0.f, 0.f, 0.f};
#pragma unroll
            for (int k = 0; k < NSLOT; ++k) {
                const u32x4 w = *(const u32x4*)(contrib + ((size_t)t * NSLOT + k) * D + c);
                sm[0] += bflo(w.x); sm[1] += bfhi(w.x); sm[2] += bflo(w.y); sm[3] += bfhi(w.y); sm[4] += bflo(w.z); sm[5] += bfhi(w.z); sm[6] += bflo(w.w); sm[7] += bfhi(w.w);
            }
#pragma unroll
            for (int h = 0; h < 2; ++h) {
                const f32x4 x1 = *(const f32x4*)(X1 + (size_t)t * D + c + 4 * h), gg = *(const f32x4*)(g2 + c + 4 * h);
                const f32x4 mv = {sm[4 * h], sm[4 * h + 1], sm[4 * h + 2], sm[4 * h + 3]};
                const f32x4 v = x1 + gg * mv; xv[j][h] = v; ss += (v[0] * v[0] + v[1] * v[1]) + (v[2] * v[2] + v[3] * v[3]);
            }
        }
        const float r = rsqrtf(wave_sum(ss) * (1.f / D) + 1e-6f);
#pragma unroll
        for (int j = 0; j < 2; ++j)
#pragma unroll
            for (int h = 0; h < 2; ++h) { const int c = 8 * lane + 512 * j + 4 * h; *(f32x4*)(a.out + (size_t)t * D + c) = (xv[j][h] * r) * *(const f32x4*)(fg + c); }
    }
}

constexpr int NPH = 9;
#ifndef N_LAUNCHES
#define N_LAUNCHES 1
#endif
__global__ void __launch_bounds__(NWAVES * 64, 2) mega(Args a) {
    extern __shared__ __attribute__((aligned(16))) unsigned char lds_raw[];
    ldsp lds = (ldsp)lds_raw;
    const int tid = threadIdx.x, G = gridDim.x, bx = blockIdx.x;
    int vcu = (G % 8 == 0) ? (bx % 8) * (G / 8) + bx / 8 : bx;
    unsigned char* ws = a.ws;
    for (int u = tid; u < (LDS_BYTES - MISC_OFF) / 4; u += NWAVES * 64) ((LAS unsigned*)(lds + MISC_OFF))[u] = 0u;
    __syncthreads();
    volatile LAS unsigned* MISC = (volatile LAS unsigned*)(lds + MISC_OFF);
    XcdBarrier bar; bar.bar = (unsigned*)(ws + WS_CTL) + CW_BAR; bar.x = 0; bar.st = nullptr;
    if (N_LAUNCHES == 1) {
        bar = xcd_barrier_post((unsigned*)(ws + WS_CTL) + CW_BAR, MISC + 8);
        if (tid == 0) MISC[16] = atomicAdd((unsigned*)(ws + WS_CTL) + CW_XRANK + 64 * bar.x, 1u);
    }
    const int lo = a.ph_lo, hi = a.ph_hi;
#ifndef PH_MASK
#define PH_MASK 0x1ff
#endif
#define IN(k) (((PH_MASK >> (k)) & 1) && lo <= (k) && (k) < hi)
#define SEAM(k) do { if (IN(k) && IN((k) + 1)) xcd_barrier(bar); } while (0)
#ifndef PH_DUP
#define PH_DUP -1
#endif
#define REP(k) for (int rep_ = 0; rep_ < ((PH_DUP == (k)) ? 2 : 1); ++rep_)
    if (IN(0)) REP(0) { phase_prep(a, lds, G); } SEAM(0);
    if (N_LAUNCHES == 1 && IN(0) && IN(1)) {
        unsigned basex = 0;
        for (unsigned j = 0; j < bar.x; ++j) basex += xb_ld(&bar.bar[XB_XCNT(j)]);
        vcu = (int)(basex + MISC[16]);
    }
    if (IN(1)) REP(1) { phase_hnorm(a, lds, G); } SEAM(1);
    if (IN(2)) REP(2) {
        pg8::Gemm g{(const pg8::bf16_t*)(ws + WS_H), (const pg8::bf16_t*)(ws + WS_WINT), MH, DIN, D};
        WinOrder S; S.init(G, bx);
        EpiWin E{(bf16*)(ws + WS_Z), (bf16*)(ws + WS_KVC), (const float*)(ws + WS_ROPE)};
        pg8::gemm_phase<EpiWin, WinOrder, true, true>(lds, g, S, E);
    } SEAM(2);
    if (IN(3)) REP(3) { phase_mixers(a, lds, G, vcu); } SEAM(3);
    if (IN(4)) REP(4) {
        { pg8::Gemm g{(const pg8::bf16_t*)(ws + WS_A), (const pg8::bf16_t*)(ws + WS_WAT), T, D, 512};
          pg8::StaticOrder S; S.init(T, D, G, bx);
          EpiMergeA E{(const bf16*)(ws + WS_Z), (float*)(ws + WS_TMP)};
          pg8::gemm_phase<EpiMergeA, pg8::StaticOrder, true, true>(lds, g, S, E); }
        { pg8::Gemm g{(const pg8::bf16_t*)(ws + WS_O), (const pg8::bf16_t*)(ws + WS_WBT), T, D, 512};
          pg8::StaticOrder S; S.init(T, D, G, bx);
          EpiMergeB E{(const bf16*)(ws + WS_Z), (const float*)(ws + WS_TMP), (bf16*)(ws + WS_Y)};
          pg8::gemm_phase<EpiMergeB, pg8::StaticOrder, true, true>(lds, g, S, E); }
    } SEAM(4);
    if (IN(5)) REP(5) {
        pg8::Gemm g{(const pg8::bf16_t*)(ws + WS_Y), (const pg8::bf16_t*)(ws + WS_WOT), T, D, D};
        pg8::StaticOrder S; S.init(T, D, G, bx);
        EpiWo E{a.in[I_X], (const float*)(ws + WS_ADAF), (float*)(ws + WS_X1)};
        pg8::gemm_phase<EpiWo, pg8::StaticOrder, true, true>(lds, g, S, E);
    } SEAM(5);
    if (IN(6)) { for (int it = vcu; it < T / 64; it += G) router_item(a, lds, it); } SEAM(6);
    if (IN(7)) REP(7) { phase_moe(a, lds, G, vcu); } SEAM(7);
    if (IN(8)) REP(8) { phase_combine(a, G); }
#undef IN
#undef SEAM
}

extern "C" void kernel_launch(void* const* d_in, const int* in_sizes, int n_in, void* d_out, int out_size, void* d_ws, size_t ws_size, hipStream_t stream) {
    static int grid = 0;
    if (grid == 0) {
        if (n_in != 26 || out_size != T * D || ws_size < WS_END) { fprintf(stderr, "kernel_launch: unexpected shapes (n_in %d, out %d, ws %zu)\n", n_in, out_size, ws_size); grid = -1; return; }
        int dev = 0, cus = 0, per_cu = 0;
        (void)hipGetDevice(&dev); (void)hipDeviceGetAttribute(&cus, hipDeviceAttributeMultiprocessorCount, dev);
        (void)hipFuncSetAttribute((const void*)mega, hipFuncAttributeMaxDynamicSharedMemorySize, LDS_BYTES);
        (void)hipOccupancyMaxActiveBlocksPerMultiprocessor(&per_cu, (const void*)mega, NWAVES * 64, LDS_BYTES);
        (void)hipGetLastError();
        if (per_cu < 1) { fprintf(stderr, "kernel_launch: occupancy query says %d blocks per CU\n", per_cu); per_cu = 1; }
        grid = cus;
    }
    if (grid < 0) return;
    (void)hipMemsetAsync((char*)d_ws + WS_CTL, 0, CTL_ZERO_BYTES, stream);
    Args a{};
    for (int i = 0; i < 26; ++i) a.in[i] = (const float*)d_in[i];
    a.out = (float*)d_out; a.ws = (unsigned char*)d_ws;
    if (N_LAUNCHES == 1) {
        a.ph_lo = 0; a.ph_hi = NPH;
        void* kargs[] = {&a};
        hipError_t e = hipLaunchCooperativeKernel((const void*)mega, dim3(grid), dim3(NWAVES * 64), kargs, LDS_BYTES, stream);
        if (e != hipSuccess) fprintf(stderr, "kernel_launch: cooperative launch failed: %s (grid %d)\n", hipGetErrorString(e), grid);
    } else {
#ifndef HOST_DUP
#define HOST_DUP -1
#endif
        for (int li = 0; li < NPH; ++li) {
            a.ph_lo = li; a.ph_hi = li + 1;
            hipLaunchKernelGGL(mega, dim3(grid), dim3(NWAVES * 64), LDS_BYTES, stream, a);
            if (li == HOST_DUP) {
                if (li == 6) (void)hipMemsetAsync((char*)d_ws + WS_CTL, 0, CTL_ZERO_BYTES, stream);
                hipLaunchKernelGGL(mega, dim3(grid), dim3(NWAVES * 64), LDS_BYTES, stream, a);
            }
        }
    }
}
```

```cpp
#include <hip/hip_runtime.h>
#include <cstdio>
#include <cstdint>
namespace pg8 {
#define PG8_LAS __attribute__((address_space(3)))
typedef unsigned short bf16_t;
typedef short bf16x8 __attribute__((ext_vector_type(8)));
typedef float f32x4 __attribute__((ext_vector_type(4)));
typedef unsigned u32x4 __attribute__((ext_vector_type(4)));
constexpr int BM = 256, BK = 64, HALF = 128, HTB = HALF * BK * 2  , STAGE_BYTES = 8 * HTB, NXCD = 8, WGM = 8;

__host__ __device__ __forceinline__ int lds_byte(int r, int c) { const int st = (r >> 4) * 2 + (c >> 5), rr = r & 15, cc = c & 31, ob = rr * 64 + cc * 2; return st * 1024 + (ob ^ (((ob >> 9) & 1) << 5)); }
__host__ __device__ __forceinline__ void stage_rc(int b, int& R, int& C) { const int st = b / 1024, sb = b % 1024, swz = sb ^ (((sb >> 9) & 1) << 5); R = (st >> 1) * 16 + swz / 64; C = (st & 1) * 32 + (swz % 64) / 2; }
__host__ __device__ __forceinline__ int perm32(int rho) { const int n = rho >> 4, i = rho & 15; return 8 * (i >> 2) + 4 * n + (i & 3); }

struct Unit { int pm, pn; };
struct Gemm { const bf16_t* A; const bf16_t* Bt; int M, N, K; };

struct StaticOrder {
    int nM, nN, nwg, G, c;
    __host__ __device__ void init(int M, int N, int G_, int c_) { nM = M / BM; nN = N / BM; nwg = nM * nN; G = G_; c = c_; }
    __host__ __device__ bool next(int i, Unit& u) const {
        const long L = (long)i * G + c; if (L >= nwg) return false;
        int wgid = (int)L; { const int q = nwg / NXCD, r = nwg % NXCD, xcd = wgid % NXCD, off = wgid / NXCD; wgid = (xcd < r ? xcd * (q + 1) : r * (q + 1) + (xcd - r) * q) + off; }
        const int nig = WGM * nN, gid = wgid / nig, fm = gid * WGM, gsz = (nM - fm) < WGM ? (nM - fm) : WGM;
        u.pm = fm + ((wgid % nig) % gsz); u.pn = (wgid % nig) / gsz; return true;
    }
    __device__ __forceinline__ void a_ready(const Unit&) const {}
    __device__ __forceinline__ void done(const Unit&) const {}
};

__device__ __forceinline__ unsigned cvt_pk_bf16(float lo, float hi) { unsigned r; asm volatile("v_cvt_pk_bf16_f32 %0, %1, %2" : "=v"(r) : "v"(lo), "v"(hi)); return r; }
template <class Epi, class Sched, bool ALIGN_EPI = false, bool SP2 = false>
__device__ __forceinline__ void gemm_phase(PG8_LAS unsigned char* lds, const Gemm g, const Sched& S, const Epi& E) {
    const int tid = threadIdx.x, wid = __builtin_amdgcn_readfirstlane(tid >> 6), lane = tid & 63, wr = wid >> 2, wc = wid & 3, fr = lane & 15, fq = lane >> 4;
    const int K = g.K, nt = K / BK;
    unsigned voffA[2], voffB[2];
#pragma unroll
    for (int i = 0; i < 2; ++i) { int R, C; stage_rc(tid * 16 + i * 8192, R, C); const int Rb = Epi::PERM ? ((R & ~31) + perm32(R & 31)) : R;
        voffA[i] = (unsigned)(R * K + C) * 2u; voffB[i] = (unsigned)(Rb * K + C) * 2u; }
    const size_t kstep = (size_t)(BK * 2);
    const size_t hstep = (size_t)HALF * K * 2;
    const size_t tstep = 2 * hstep;
    const unsigned ldsw = (unsigned)wid * 1024u;
    const int aoff = lds_byte(wr * 64 + fr, fq * 8), boff = lds_byte(wc * 32 + fr, fq * 8);
#define PG8_SA(b, h) (((b) * 2 + (h)) * HTB)
#define PG8_SB(b, h) ((4 + (b) * 2 + (h)) * HTB)
#define PG8_STAGE(bufoff, gbase, voff) do { _Pragma("unroll") for (int _i = 0; _i < 2; ++_i) \
        __builtin_amdgcn_global_load_lds((const unsigned*)((const char*)(gbase) + (voff)[_i]), (PG8_LAS unsigned*)(lds + (bufoff) + ldsw + _i * 8192), 16, 0, 0); } while (0)
#define PG8_LDA(dst, b, h) do { _Pragma("unroll") for (int m = 0; m < 4; ++m) _Pragma("unroll") for (int k = 0; k < 2; ++k) dst[m][k] = *(const PG8_LAS bf16x8*)(lds + PG8_SA(b, h) + aoff + m * 2048 + k * 1024); } while (0)
#define PG8_LDB(dst, b, h) do { _Pragma("unroll") for (int n = 0; n < 2; ++n) _Pragma("unroll") for (int k = 0; k < 2; ++k) dst[n][k] = *(const PG8_LAS bf16x8*)(lds + PG8_SB(b, h) + boff + n * 2048 + k * 1024); } while (0)
#define PG8_MMA(ai, bj, At, Bt) do { __builtin_amdgcn_s_setprio(1); _Pragma("unroll") for (int m = 0; m < 4; ++m) _Pragma("unroll") for (int n = 0; n < 2; ++n) _Pragma("unroll") for (int k = 0; k < 2; ++k) \
        acc[ai][bj][m][n] = __builtin_amdgcn_mfma_f32_16x16x32_bf16(Bt[n][k], At[m][k], acc[ai][bj][m][n], 0, 0, 0); __builtin_amdgcn_s_setprio(0); } while (0)
#define PG8_WAIT_V(n) asm volatile("s_waitcnt vmcnt(" #n ")" ::: "memory")
#define PG8_WAIT_L(n) asm volatile("s_waitcnt lgkmcnt(" #n ")" ::: "memory")
#define PG8_BAR __builtin_amdgcn_s_barrier()
#define PG8_SCHED __builtin_amdgcn_sched_barrier(0)
    Unit cur, nxt; int ui = 0;
    if (!S.next(0, cur)) return;
    f32x4 acc[2][2][4][2];
#pragma unroll
    for (int a = 0; a < 2; ++a)
#pragma unroll
        for (int b = 0; b < 2; ++b)
#pragma unroll
            for (int m = 0; m < 4; ++m)
#pragma unroll
                for (int n = 0; n < 2; ++n) acc[a][b][m][n] = (f32x4){0.f, 0.f, 0.f, 0.f};
    bf16x8 At[4][2], B0[2][2], B1[2][2];
    const char* cA = (const char*)g.A + (size_t)cur.pm * tstep; const char* cB = (const char*)g.Bt + (size_t)cur.pn * tstep;
    S.a_ready(cur);
    if constexpr (SP2) {
        PG8_STAGE(PG8_SB(0, 0), cB, voffB); PG8_STAGE(PG8_SB(0, 1), cB + hstep, voffB); PG8_STAGE(PG8_SA(0, 0), cA, voffA); PG8_STAGE(PG8_SA(0, 1), cA + hstep, voffA);
        if (wr == 1) PG8_BAR;
        PG8_WAIT_V(2); PG8_BAR;
        PG8_STAGE(PG8_SB(1, 0), cB + kstep, voffB); PG8_STAGE(PG8_SA(1, 0), cA + kstep, voffA); PG8_STAGE(PG8_SB(1, 1), cB + hstep + kstep, voffB);
        PG8_WAIT_V(6); PG8_BAR;
    } else {
        PG8_STAGE(PG8_SB(0, 0), cB, voffB); PG8_STAGE(PG8_SA(0, 0), cA, voffA); PG8_STAGE(PG8_SB(0, 1), cB + hstep, voffB); PG8_STAGE(PG8_SA(0, 1), cA + hstep, voffA);
        if (wr == 1) PG8_BAR;
        PG8_WAIT_V(4); PG8_BAR;
        PG8_STAGE(PG8_SB(1, 0), cB + kstep, voffB); PG8_STAGE(PG8_SA(1, 0), cA + kstep, voffA); PG8_STAGE(PG8_SB(1, 1), cB + hstep + kstep, voffB);
        PG8_WAIT_V(6); PG8_BAR;
    }
    for (;;) {
        const bool has_next = S.next(ui + 1, nxt);
        const char* nA = has_next ? (const char*)g.A + (size_t)nxt.pm * tstep : cA; const char* nB = has_next ? (const char*)g.Bt + (size_t)nxt.pn * tstep : cB;
        for (int t = 0; t < nt; t += 2) {
            const bool last = (t == nt - 2);
            const char* a1 = cA + (size_t)(t + 1) * kstep;
            const char* a2 = last ? nA : cA + (size_t)(t + 2) * kstep; const char* b2 = last ? nB : cB + (size_t)(t + 2) * kstep;
            const char* a3 = a2 + kstep; const char* b3 = b2 + kstep;
            if (last && has_next) S.a_ready(nxt);
            if constexpr (SP2) {
            PG8_LDB(B0, 0, 0); PG8_LDB(B1, 0, 1); PG8_SCHED; PG8_LDA(At, 0, 0); PG8_STAGE(PG8_SA(1, 1), a1 + hstep, voffA);
            PG8_WAIT_V(8); PG8_WAIT_L(0); PG8_BAR; PG8_MMA(0, 0, At, B0); PG8_MMA(0, 1, At, B1); PG8_BAR; PG8_SCHED;
            PG8_LDA(At, 0, 1); PG8_STAGE(PG8_SB(0, 0), b2, voffB); PG8_STAGE(PG8_SB(0, 1), b2 + hstep, voffB); PG8_STAGE(PG8_SA(0, 0), a2, voffA);
            PG8_WAIT_V(8); PG8_WAIT_L(0); PG8_BAR; PG8_MMA(1, 0, At, B0); PG8_MMA(1, 1, At, B1); PG8_BAR; PG8_SCHED;
            PG8_LDB(B0, 1, 0); PG8_LDB(B1, 1, 1); PG8_SCHED; PG8_LDA(At, 1, 0); PG8_STAGE(PG8_SA(0, 1), a2 + hstep, voffA);
            PG8_WAIT_V(8); PG8_WAIT_L(0); PG8_BAR; PG8_MMA(0, 0, At, B0); PG8_MMA(0, 1, At, B1); PG8_BAR; PG8_SCHED;
            PG8_LDA(At, 1, 1); PG8_STAGE(PG8_SB(1, 0), b3, voffB); PG8_STAGE(PG8_SB(1, 1), b3 + hstep, voffB); PG8_STAGE(PG8_SA(1, 0), a3, voffA);
            PG8_WAIT_V(8); PG8_WAIT_L(0); PG8_BAR; PG8_MMA(1, 0, At, B0); PG8_MMA(1, 1, At, B1); PG8_BAR; PG8_SCHED;
            } else {
            PG8_LDB(B0, 0, 0); PG8_SCHED; PG8_LDA(At, 0, 0); PG8_STAGE(PG8_SA(1, 1), a1 + hstep, voffA);
            PG8_WAIT_L(8); PG8_BAR; PG8_WAIT_L(0); PG8_MMA(0, 0, At, B0); PG8_BAR; PG8_SCHED;
            PG8_LDB(B1, 0, 1); PG8_STAGE(PG8_SB(0, 0), b2, voffB);
            PG8_BAR; PG8_WAIT_L(0); PG8_MMA(0, 1, At, B1); PG8_BAR;
            PG8_LDA(At, 0, 1); PG8_STAGE(PG8_SA(0, 0), a2, voffA);
            PG8_BAR; PG8_WAIT_L(0); PG8_MMA(1, 0, At, B0); PG8_BAR; PG8_SCHED;
            PG8_STAGE(PG8_SB(0, 1), b2 + hstep, voffB);
            PG8_WAIT_V(6); PG8_BAR; PG8_MMA(1, 1, At, B1); PG8_BAR;
            PG8_LDB(B0, 1, 0); PG8_SCHED; PG8_LDA(At, 1, 0); PG8_STAGE(PG8_SA(0, 1), a2 + hstep, voffA);
            PG8_WAIT_L(8); PG8_BAR; PG8_WAIT_L(0); PG8_MMA(0, 0, At, B0); PG8_BAR; PG8_SCHED;
            PG8_LDB(B1, 1, 1); PG8_STAGE(PG8_SB(1, 0), b3, voffB);
            PG8_BAR; PG8_WAIT_L(0); PG8_MMA(0, 1, At, B1); PG8_BAR;
            PG8_LDA(At, 1, 1); PG8_STAGE(PG8_SA(1, 0), a3, voffA);
            PG8_BAR; PG8_WAIT_L(0); PG8_MMA(1, 0, At, B0); PG8_BAR; PG8_SCHED;
            PG8_STAGE(PG8_SB(1, 1), b3 + hstep, voffB);
            PG8_WAIT_V(6); PG8_BAR; PG8_MMA(1, 1, At, B1); PG8_BAR;
            }
        }
        if constexpr (ALIGN_EPI) { if (wr == 0) PG8_BAR; }
        if constexpr (!Epi::AFTER_DRAIN) { E(acc, cur, wr, wc, fr, fq); S.done(cur); }
        if (!has_next) break;
#pragma unroll
        for (int a = 0; a < 2; ++a)
#pragma unroll
            for (int b = 0; b < 2; ++b)
#pragma unroll
                for (int m = 0; m < 4; ++m)
#pragma unroll
                    for (int n = 0; n < 2; ++n) acc[a][b][m][n] = (f32x4){0.f, 0.f, 0.f, 0.f};
        cur = nxt; cA = nA; cB = nB; ++ui;
        if constexpr (ALIGN_EPI) { if (wr == 1) PG8_BAR; }
    }
    PG8_WAIT_V(0);
    if constexpr (!ALIGN_EPI) { if (wr == 0) PG8_BAR; }
    PG8_BAR;
    if constexpr (Epi::AFTER_DRAIN) { E.fused(acc, cur, wr, wc, fr, fq, lds, wid, lane); S.done(cur); }
#undef PG8_SA
#undef PG8_SB
#undef PG8_STAGE
#undef PG8_LDA
#undef PG8_LDB
#undef PG8_MMA
#undef PG8_WAIT_V
#undef PG8_WAIT_L
#undef PG8_BAR
#undef PG8_SCHED
}
}
#define GAS __attribute__((address_space(1)))
#define LAS __attribute__((address_space(3)))
typedef unsigned short bf16;
typedef unsigned v4u __attribute__((ext_vector_type(4)));
typedef float f32x4 __attribute__((ext_vector_type(4)));
typedef short bf16x8 __attribute__((ext_vector_type(8)));
typedef GAS unsigned gu32;
typedef GAS unsigned long long gu64;
#define RLX_AGENT __ATOMIC_RELAXED, __HIP_MEMORY_SCOPE_AGENT
#define LDS_WAIT() asm volatile("s_waitcnt lgkmcnt(0)" ::: "memory")
#define VM_WAIT() asm volatile("s_waitcnt vmcnt(0)" ::: "memory")
__device__ __forceinline__ unsigned long long rt() { return __builtin_amdgcn_s_memrealtime(); }
__device__ __forceinline__ unsigned f2bf(float f) { unsigned u = __builtin_bit_cast(unsigned, f); return (u + 0x7fffu + ((u >> 16) & 1u)) >> 16; }
__device__ __forceinline__ unsigned pk2(float lo, float hi) { return f2bf(lo) | (f2bf(hi) << 16); }

#define XB_TMO      128
#define XB_XCNT(j)  (256  + 64 * (j))
#define XB_XSUB(j)  (1280 + 64 * (j))
#define XB_XGEN(j)  (2304 + 64 * (j))
#define XB_TOP      3328
#define XB_TOPGEN   3392
#define XCD_BAR_WORDS 3456
#define XB_SPIN_CAP (1u << 18)

__device__ __forceinline__ unsigned xb_ld(unsigned* p)              { return __hip_atomic_load(p, __ATOMIC_RELAXED, __HIP_MEMORY_SCOPE_AGENT); }
__device__ __forceinline__ unsigned xb_add(unsigned* p, unsigned v) { return __hip_atomic_fetch_add(p, v, __ATOMIC_RELAXED, __HIP_MEMORY_SCOPE_AGENT); }
__device__ __forceinline__ unsigned xb_xcc_id() { return (unsigned)__builtin_amdgcn_s_getreg((3 << 11) | 20) & 0xFu; }
#define XB_SPIN(cond, bar) do { unsigned _sp = 0; while (cond) { __builtin_amdgcn_s_sleep(1); \
    if ((++_sp & 255u) == 0u) { if (xb_ld(&(bar)[XB_TMO])) break; if (_sp > XB_SPIN_CAP) { atomicAdd(&(bar)[XB_TMO], 1u); break; } } } } while (0)

struct XcdBarrier {
    unsigned* bar; unsigned x;
    volatile LAS unsigned* st;
};

__device__ __forceinline__ XcdBarrier xcd_barrier_post(unsigned* bar, volatile LAS unsigned* st) {
    XcdBarrier b; b.bar = bar; b.x = xb_xcc_id(); b.st = st;
    if (threadIdx.x == 0) (void)xb_add(&bar[XB_XCNT(b.x)], 1u);
    return b;
}
__device__ __forceinline__ void xcd_barrier_complete(unsigned* bar, unsigned x, unsigned& nloc, unsigned& nx) {
    const unsigned G = gridDim.x * gridDim.y * gridDim.z;
    unsigned sum, cnt, mine, sp = 0u;
    for (;;) {
        sum = 0u; cnt = 0u; mine = 0u;
#pragma unroll
        for (unsigned j = 0; j < 16; ++j) { const unsigned c = xb_ld(&bar[XB_XCNT(j)]); sum += c; cnt += (c > 0u) ? 1u : 0u; mine = (j == x) ? c : mine; }
        if (sum == G) break;
        __builtin_amdgcn_s_sleep(1);
        if ((++sp & 255u) == 0u) { if (xb_ld(&bar[XB_TMO])) break; if (sp > XB_SPIN_CAP) { atomicAdd(&bar[XB_TMO], 1u); break; } }
    }
    nloc = mine > 0u ? mine : 1u; nx = cnt > 0u ? cnt : 1u;
}

__device__ __forceinline__ void xcd_barrier(const XcdBarrier& b) {
    asm volatile("s_waitcnt vmcnt(0)" ::: "memory");
    __syncthreads();
    if (threadIdx.x == 0) {
        unsigned* bar = b.bar;
        __builtin_amdgcn_s_waitcnt(0);
        unsigned nloc = b.st[0], nx = b.st[1];
        if (nloc == 0u) { xcd_barrier_complete(bar, b.x, nloc, nx); b.st[0] = nloc; b.st[1] = nx; }
        const unsigned old = xb_add(&bar[XB_XSUB(b.x)], 1u);
        const unsigned gen = old / nloc;
        if (old + 1u == (gen + 1u) * nloc) {
            __builtin_amdgcn_fence(__ATOMIC_RELEASE, "agent");
            asm volatile("s_waitcnt vmcnt(0)" ::: "memory");
            const unsigned og = xb_add(&bar[XB_TOP], 1u);
            const unsigned tg = og / nx;
            if (og + 1u == (tg + 1u) * nx) xb_add(&bar[XB_TOPGEN], 1u);
            else XB_SPIN(xb_ld(&bar[XB_TOPGEN]) == tg, bar);
            __builtin_amdgcn_fence(__ATOMIC_ACQUIRE, "agent");
            xb_add(&bar[XB_XGEN(b.x)], 1u);
            asm volatile("s_waitcnt vmcnt(0)" ::: "memory");
        } else {
            XB_SPIN(xb_ld(&bar[XB_XGEN(b.x)]) == gen, bar);
            __builtin_amdgcn_fence(__ATOMIC_ACQUIRE, "agent");
            asm volatile("s_waitcnt vmcnt(0)" ::: "memory");
        }
    }
    __syncthreads();
}

constexpr int T = 16384, D = 1024, SEQ = 8192, NCTX = 256, TCX = 512, DIN = 3840, MH = T + TCX;
constexpr int ZU = 0, ZV = 512, ZQ = 1024, ZK = 1536, ZVA = 1664, ZGA = 1792, ZGB = 2816;
constexpr int NEXP = 256, NSLOT = 9, LISTCAP = 16384;
constexpr float LOG2E = 1.4426950408889634f;
constexpr float QSCALE = 0.125f * LOG2E;
constexpr size_t MiB = 1u << 20;
constexpr size_t WS_CTL = 0, CTL_ZERO_BYTES = 1 * MiB;
constexpr size_t WS_ADAP = 1 * MiB;
constexpr size_t WS_ADAF = 2 * MiB;
constexpr size_t WS_ROPE = 2 * MiB + 128 * 1024;
constexpr size_t WS_WST = 2 * MiB + 256 * 1024;
constexpr size_t WS_RWT = 3 * MiB;
constexpr size_t WS_WINT = 4 * MiB;
constexpr size_t WS_WAT = 12 * MiB, WS_WBT = 13 * MiB, WS_WOT = 14 * MiB;
constexpr size_t WS_KVC = 16 * MiB;
constexpr size_t WS_GATEW = 17 * MiB;
constexpr size_t WS_H = 18 * MiB;
constexpr size_t WS_Z = 52 * MiB;
constexpr size_t WS_A = 172 * MiB, WS_O = 188 * MiB;
constexpr size_t WS_TMP = 204 * MiB;
constexpr size_t WS_Y = 268 * MiB;
constexpr size_t WS_X1 = 300 * MiB;
constexpr size_t WS_H2 = 364 * MiB;
constexpr size_t WS_LIST = 396 * MiB;
constexpr size_t WS_CONTRIB = 414 * MiB;
constexpr size_t WS_END = 704 * MiB;
constexpr int CW_BAR = 4096;
constexpr int CW_CNT = 16384;
constexpr int CW_XRANK = 32768;
constexpr int SCR_BYTES = 148480;
constexpr int MISC_OFF = SCR_BYTES;
constexpr int LDS_BYTES = 152 * 1024;
constexpr int NWAVES = 8;

typedef float f32x2_t __attribute__((ext_vector_type(2)));
typedef __bf16 bf16x2_t __attribute__((ext_vector_type(2)));
typedef float f32x16 __attribute__((ext_vector_type(16)));
typedef short s16x4 __attribute__((ext_vector_type(4)));
typedef short v4i16_t __attribute__((ext_vector_type(4)));
typedef unsigned u32x2 __attribute__((ext_vector_type(2)));
typedef unsigned u32x4 __attribute__((ext_vector_type(4)));
typedef LAS unsigned char* ldsp;

__device__ __forceinline__ unsigned cvtpk(float lo, float hi) { f32x2_t v = {lo, hi}; bf16x2_t b = __builtin_convertvector(v, bf16x2_t); return __builtin_bit_cast(unsigned, b); }
__device__ __forceinline__ float bf2f(unsigned short u) { return __uint_as_float((unsigned)u << 16); }
__device__ __forceinline__ float bflo(unsigned w) { return __uint_as_float(w << 16); }
__device__ __forceinline__ float bfhi(unsigned w) { return __uint_as_float(w & 0xffff0000u); }
__device__ __forceinline__ float wave_sum(float v) {
#pragma unroll
    for (int o = 1; o < 64; o <<= 1) v += __shfl_xor(v, o);
    return v;
}
__device__ __forceinline__ float sigmoid_f(float x) { return __builtin_amdgcn_rcpf(1.f + __builtin_amdgcn_exp2f(-x * LOG2E)); }
__device__ __forceinline__ float silu_f(float x) { return x * sigmoid_f(x); }
__device__ __forceinline__ float gelu_f(float x) { const float u = 0.7978845608028654f * (x + 0.044715f * x * x * x); return x * sigmoid_f(2.f * u); }
__device__ __forceinline__ f32x16 mfma32(bf16x8 a, bf16x8 b, f32x16 c) { return __builtin_amdgcn_mfma_f32_32x32x16_bf16(a, b, c, 0, 0, 0); }
__device__ __forceinline__ f32x4 mfma16(bf16x8 a, bf16x8 b, f32x4 c) { return __builtin_amdgcn_mfma_f32_16x16x32_bf16(a, b, c, 0, 0, 0); }

struct Args { const float* in[26]; float* out; unsigned char* ws; int ph_lo, ph_hi; };
enum { I_X = 0, I_C, I_CTX, I_CCTX, I_ADAW, I_ADAB, I_N1G, I_N2G, I_WIN, I_LNG, I_LNB, I_GWS, I_GBS, I_SINK, I_WA, I_WB, I_WO, I_RW, I_RB, I_EG, I_EU, I_ED, I_SG, I_SU, I_SD, I_FG };

__device__ __forceinline__ void p0_transpose_item(const float* W, int K, int N, bf16* WT, LAS float* scr, int item, int lane) {
    const int nblk = N / 32, kb = item / nblk, nb = item % nblk, k0 = 64 * kb, n0 = 32 * nb;
#pragma unroll 8
    for (int i = 0; i < 32; ++i) { const int kk = 2 * i + (lane >> 5); scr[kk * 33 + (lane & 31)] = W[(size_t)(k0 + kk) * N + n0 + (lane & 31)]; }
    LDS_WAIT(); asm volatile("" ::: "memory");
    const int c = lane & 7;
#pragma unroll
    for (int j = 0; j < 4; ++j) { const int n = (lane >> 3) + 8 * j; const LAS float* s = scr + (8 * c) * 33 + n;
        v4u o; o.x = pk2(s[0 * 33], s[1 * 33]); o.y = pk2(s[2 * 33], s[3 * 33]); o.z = pk2(s[4 * 33], s[5 * 33]); o.w = pk2(s[6 * 33], s[7 * 33]);
        *(GAS v4u*)(WT + (size_t)(n0 + n) * K + k0 + 8 * c) = o; }
    LDS_WAIT(); asm volatile("" ::: "memory");
}

__device__ __forceinline__ void phase_prep(const Args& a, ldsp lds, int G) {
    const int tid = threadIdx.x, lane = tid & 63, wave = __builtin_amdgcn_readfirstlane(tid >> 6), blk = blockIdx.x;
    unsigned char* ws = a.ws;
    if (blk < 192) {
        const int cb = blk % 24, kc = blk / 24, col = cb * 256 + lane * 4, k0 = kc * 128 + wave * 16;
        const float* c = a.in[I_C]; const float* cc = a.in[I_CCTX]; const float* aw = a.in[I_ADAW];
        f32x4 a0 = {0.f, 0.f, 0.f, 0.f}, a1 = a0, a2 = a0;
#pragma unroll 4
        for (int k = 0; k < 16; ++k) {
            const int kk = k0 + k;
            const float s0 = silu_f(c[kk]), s1 = silu_f(c[1024 + kk]), s2 = silu_f(cc[kk]);
            const f32x4 w = *(const f32x4*)(aw + (size_t)kk * 6144 + col);
            a0 += w * s0; a1 += w * s1; a2 += w * s2;
        }
        LAS float* red = (LAS float*)lds;
        *(LAS f32x4*)(red + (wave * 3 + 0) * 256 + lane * 4) = a0;
        *(LAS f32x4*)(red + (wave * 3 + 1) * 256 + lane * 4) = a1;
        *(LAS f32x4*)(red + (wave * 3 + 2) * 256 + lane * 4) = a2;
        __syncthreads();
        float* adap = (float*)(ws + WS_ADAP);
        for (int idx = tid; idx < 768; idx += 512) {
            const int v = idx >> 8, cl = idx & 255; float s = 0.f;
#pragma unroll
            for (int w = 0; w < 8; ++w) s += red[(w * 3 + v) * 256 + cl];
            adap[(size_t)(kc * 3 + v) * 6144 + cb * 256 + cl] = s;
        }
        __syncthreads();
    }
    {
        LAS float* scr = (LAS float*)(lds + wave * 8704);
        const int gw = blk * NWAVES + wave, NGW = G * NWAVES;
        constexpr int I_1 = 16 * 120, I_2 = 8 * 32, I_3 = 8 * 32, I_4 = 16 * 32, I_5 = 16 * 8;
        for (int it = gw; it < I_1 + I_2 + I_3 + I_4 + I_5; it += NGW) {
            int r = it;
            if (r < I_1) { p0_transpose_item(a.in[I_WIN], 1024, 3840, (bf16*)(ws + WS_WINT), scr, r, lane); continue; } r -= I_1;
            if (r < I_2) { p0_transpose_item(a.in[I_WA], 512, 1024, (bf16*)(ws + WS_WAT), scr, r, lane); continue; } r -= I_2;
            if (r < I_3) { p0_transpose_item(a.in[I_WB], 512, 1024, (bf16*)(ws + WS_WBT), scr, r, lane); continue; } r -= I_3;
            if (r < I_4) { p0_transpose_item(a.in[I_WO], 1024, 1024, (bf16*)(ws + WS_WOT), scr, r, lane); continue; } r -= I_4;
            p0_transpose_item(a.in[I_RW], 1024, 256, (bf16*)(ws + WS_RWT), scr, r, lane);
        }
    }
    {
        const int gt = blk * 512 + tid, NT = G * 512;
        const float* gws = a.in[I_GWS]; bf16* wst = (bf16*)(ws + WS_WST);
        for (int i = gt; i < 8192; i += NT) {
            const f32x4 x0 = *(const f32x4*)(gws + i * 8), x1 = *(const f32x4*)(gws + i * 8 + 4);
            v4u o; o.x = cvtpk(x0[0], x0[1]); o.y = cvtpk(x0[2], x0[3]); o.z = cvtpk(x1[0], x1[1]); o.w = cvtpk(x1[2], x1[3]);
            *(v4u*)(wst + i * 8) = o;
        }
        float* rope = (float*)(ws + WS_ROPE);
        for (int i = gt; i < 2048; i += NT) {
            const int pos = i >> 4, f = i & 15;
            const float inv = __builtin_amdgcn_exp2f(-(float)f * (13.287712379549449f / 16.f));
            const float ang = (float)pos * inv;
            double rev = (double)ang * 0.15915494309189535; rev -= floor(rev);
            rope[pos * 32 + f] = __builtin_amdgcn_cosf((float)rev);
            rope[pos * 32 + 16 + f] = __builtin_amdgcn_sinf((float)rev);
        }
    }
}

__device__ __forceinline__ void phase_hnorm(const Args& a, ldsp lds, int G) {
    const int tid = threadIdx.x, lane = tid & 63, wave = __builtin_amdgcn_readfirstlane(tid >> 6), blk = blockIdx.x;
    unsigned char* ws = a.ws;
    const float* adap = (const float*)(ws + WS_ADAP); const float* adab = a.in[I_ADAB];
    LAS float* modv = (LAS float*)lds;
    for (int idx = tid; idx < 3 * 2048; idx += 512) {
        const int v = idx >> 11, j = idx & 2047; float s = adab[j];
#pragma unroll
        for (int kc = 0; kc < 8; ++kc) s += adap[(size_t)(kc * 3 + v) * 6144 + j];
        modv[idx] = (j >= 1024) ? s + 1.f : s;
    }
    { float* adaf = (float*)(ws + WS_ADAF);
      for (int idx = blk * 512 + tid; idx < 3 * 6144; idx += G * 512) {
          const int v = idx / 6144, j = idx % 6144; float s = adab[j];
#pragma unroll
          for (int kc = 0; kc < 8; ++kc) s += adap[(size_t)(kc * 3 + v) * 6144 + j];
          adaf[idx] = s; } }
    __syncthreads();
    const float* g1 = a.in[I_N1G]; bf16* H = (bf16*)(ws + WS_H);
    for (int t = blk * NWAVES + wave; t < MH; t += G * NWAVES) {
        const float* xr = (t < T) ? a.in[I_X] + (size_t)t * D : a.in[I_CTX] + (size_t)(t - T) * D;
        const int v = (t < T) ? (t >> 13) : 2;
        f32x4 x[4]; float ss = 0.f;
#pragma unroll
        for (int j = 0; j < 4; ++j) { x[j] = *(const f32x4*)(xr + 4 * lane + 256 * j); ss += (x[j][0] * x[j][0] + x[j][1] * x[j][1]) + (x[j][2] * x[j][2] + x[j][3] * x[j][3]); }
        const float r = rsqrtf(wave_sum(ss) * (1.f / D) + 1e-6f);
#pragma unroll
        for (int j = 0; j < 4; ++j) {
            const int col = 4 * lane + 256 * j;
            const f32x4 g = *(const f32x4*)(g1 + col);
            const f32x4 sh = *(LAS f32x4*)(modv + v * 2048 + col), sc = *(LAS f32x4*)(modv + v * 2048 + 1024 + col);
            const f32x4 h = (x[j] * r) * g * sc + sh;
            u32x2 o; o.x = cvtpk(h[0], h[1]); o.y = cvtpk(h[2], h[3]);
            *(u32x2*)(H + (size_t)t * D + col) = o;
        }
    }
}

struct WinOrder {
    pg8::StaticOrder so;
    __device__ void init(int G, int c) { so.init(T, DIN, G, c); }
    __device__ bool next(int i, pg8::Unit& u) const {
        const long L = (long)i * so.G + so.c;
        if (L < 960) return so.next(i, u);
        if (L < 962) { u.pm = 64 + (int)(L - 960); u.pn = 6; return true; }
        return false;
    }
    __device__ __forceinline__ void a_ready(const pg8::Unit&) const {}
    __device__ __forceinline__ void done(const pg8::Unit&) const {}
};
struct EpiWin {
    static constexpr bool PERM = false, AFTER_DRAIN = false;
    bf16* Z; bf16* KVC; const float* rope;
    __device__ __forceinline__ void operator()(const pg8::f32x4 (&acc)[2][2][4][2], const pg8::Unit& u, int wr, int wc, int fr, int fq) const {
        const int row0 = u.pm * 256 + wr * 64 + fr, colb = u.pn * 256 + wc * 32 + 4 * fq, pn = u.pn;
        if (u.pm >= 64) {
#pragma unroll
            for (int ai = 0; ai < 2; ++ai)
#pragma unroll
                for (int m = 0; m < 4; ++m) { bf16* rp = KVC + (size_t)(row0 + ai * 128 + m * 16 - T) * 256 + (colb - ZK);
#pragma unroll
                    for (int bj = 0; bj < 2; ++bj)
#pragma unroll
                        for (int n = 0; n < 2; ++n) { const pg8::f32x4 v = acc[ai][bj][m][n]; u32x2 o; o.x = cvtpk(v[0], v[1]); o.y = cvtpk(v[2], v[3]); *(u32x2*)(rp + bj * 128 + n * 16) = o; } }
            return;
        }
#pragma unroll
        for (int ai = 0; ai < 2; ++ai)
#pragma unroll
            for (int m = 0; m < 4; ++m) {
                const int r = row0 + ai * 128 + m * 16; bf16* rp = Z + (size_t)r * DIN + colb;
                if (pn <= 3) {
#pragma unroll
                    for (int bj = 0; bj < 2; ++bj)
#pragma unroll
                        for (int n = 0; n < 2; ++n) { const pg8::f32x4 v = acc[ai][bj][m][n]; u32x2 o; o.x = cvtpk(gelu_f(v[0]), gelu_f(v[1])); o.y = cvtpk(gelu_f(v[2]), gelu_f(v[3])); *(u32x2*)(rp + bj * 128 + n * 16) = o; }
                } else if (pn <= 6) {
                    const int pos = (wc & 1) ? (r & 63) : ((r & 8191) >> 6);
                    const pg8::f32x4 cs = *(const pg8::f32x4*)(rope + pos * 32 + 4 * fq), sn = *(const pg8::f32x4*)(rope + pos * 32 + 16 + 4 * fq);
                    const float sc = (pn < 6) ? QSCALE : 1.f;
#pragma unroll
                    for (int bj = 0; bj < 2; ++bj) {
                        const pg8::f32x4 x1 = acc[ai][bj][m][0], x2 = acc[ai][bj][m][1];
                        pg8::f32x4 o1, o2;
                        if (pn == 6 && bj == 1) { o1 = x1; o2 = x2; }
                        else { o1 = (x1 * cs - x2 * sn) * sc; o2 = (x2 * cs + x1 * sn) * sc; }
                        u32x2 w1, w2; w1.x = cvtpk(o1[0], o1[1]); w1.y = cvtpk(o1[2], o1[3]); w2.x = cvtpk(o2[0], o2[1]); w2.y = cvtpk(o2[2], o2[3]);
                        *(u32x2*)(rp + bj * 128) = w1; *(u32x2*)(rp + bj * 128 + 16) = w2;
                    }
                } else {
#pragma unroll
                    for (int bj = 0; bj < 2; ++bj)
#pragma unroll
                        for (int n = 0; n < 2; ++n) { const pg8::f32x4 v = acc[ai][bj][m][n]; u32x2 o; o.x = cvtpk(sigmoid_f(v[0]), sigmoid_f(v[1])); o.y = cvtpk(sigmoid_f(v[2]), sigmoid_f(v[3])); *(u32x2*)(rp + bj * 128 + n * 16) = o; }
                }
            }
    }
};
struct EpiMergeA {
    static constexpr bool PERM = true, AFTER_DRAIN = false;
    const bf16* Z; float* TMP;
    __device__ __forceinline__ void operator()(const pg8::f32x4 (&acc)[2][2][4][2], const pg8::Unit& u, int wr, int wc, int fr, int fq) const {
        const int row0 = u.pm * 256 + wr * 64 + fr, col0 = u.pn * 256 + wc * 32 + 8 * fq;
#pragma unroll
        for (int ai = 0; ai < 2; ++ai)
#pragma unroll
            for (int m = 0; m < 4; ++m) { const int r = row0 + ai * 128 + m * 16;
#pragma unroll
                for (int bj = 0; bj < 2; ++bj) { const int c = col0 + bj * 128;
                    const u32x4 g = *(const u32x4*)(Z + (size_t)r * DIN + ZGA + c);
                    const pg8::f32x4 v0 = acc[ai][bj][m][0], v1 = acc[ai][bj][m][1];
                    pg8::f32x4 o0 = {v0[0] * bflo(g.x), v0[1] * bfhi(g.x), v0[2] * bflo(g.y), v0[3] * bfhi(g.y)};
                    pg8::f32x4 o1 = {v1[0] * bflo(g.z), v1[1] * bfhi(g.z), v1[2] * bflo(g.w), v1[3] * bfhi(g.w)};
                    *(pg8::f32x4*)(TMP + (size_t)r * D + c) = o0; *(pg8::f32x4*)(TMP + (size_t)r * D + c + 4) = o1; } }
    }
};
struct EpiMergeB {
    static constexpr bool PERM = true, AFTER_DRAIN = false;
    const bf16* Z; const float* TMP; bf16* Y;
    __device__ __forceinline__ void operator()(const pg8::f32x4 (&acc)[2][2][4][2], const pg8::Unit& u, int wr, int wc, int fr, int fq) const {
        const int row0 = u.pm * 256 + wr * 64 + fr, col0 = u.pn * 256 + wc * 32 + 8 * fq;
#pragma unroll
        for (int ai = 0; ai < 2; ++ai)
#pragma unroll
            for (int m = 0; m < 4; ++m) { const int r = row0 + ai * 128 + m * 16;
#pragma unroll
                for (int bj = 0; bj < 2; ++bj) { const int c = col0 + bj * 128;
                    const u32x4 g = *(const u32x4*)(Z + (size_t)r * DIN + ZGB + c);
                    const pg8::f32x4 t0 = *(const pg8::f32x4*)(TMP + (size_t)r * D + c), t1 = *(const pg8::f32x4*)(TMP + (size_t)r * D + c + 4);
                    const pg8::f32x4 v0 = acc[ai][bj][m][0], v1 = acc[ai][bj][m][1];
                    u32x4 o;
                    o.x = cvtpk(t0[0] + v0[0] * bflo(g.x), t0[1] + v0[1] * bfhi(g.x)); o.y = cvtpk(t0[2] + v0[2] * bflo(g.y), t0[3] + v0[3] * bfhi(g.y));
                    o.z = cvtpk(t1[0] + v1[0] * bflo(g.z), t1[1] + v1[1] * bfhi(g.z)); o.w = cvtpk(t1[2] + v1[2] * bflo(g.w), t1[3] + v1[3] * bfhi(g.w));
                    *(u32x4*)(Y + (size_t)r * D + c) = o; } }
    }
};
struct EpiWo {
    static constexpr bool PERM = true, AFTER_DRAIN = false;
    const float* x; const float* adaf; float* X1;
    __device__ __forceinline__ void operator()(const pg8::f32x4 (&acc)[2][2][4][2], const pg8::Unit& u, int wr, int wc, int fr, int fq) const {
        const int row0 = u.pm * 256 + wr * 64 + fr, col0 = u.pn * 256 + wc * 32 + 8 * fq;
        const float* g1 = adaf + (u.pm >= 32 ? 6144 : 0) + 2048;
#pragma unroll
        for (int bj = 0; bj < 2; ++bj) { const int c = col0 + bj * 128;
            const pg8::f32x4 ga = *(const pg8::f32x4*)(g1 + c), gb = *(const pg8::f32x4*)(g1 + c + 4);
#pragma unroll
            for (int ai = 0; ai < 2; ++ai)
#pragma unroll
                for (int m = 0; m < 4; ++m) { const int r = row0 + ai * 128 + m * 16;
                    const pg8::f32x4 x0 = *(const pg8::f32x4*)(x + (size_t)r * D + c), x1 = *(const pg8::f32x4*)(x + (size_t)r * D + c + 4);
                    *(pg8::f32x4*)(X1 + (size_t)r * D + c) = x0 + ga * acc[ai][bj][m][0];
                    *(pg8::f32x4*)(X1 + (size_t)r * D + c + 4) = x1 + gb * acc[ai][bj][m][1]; } }
    }
};

__device__ __forceinline__ s16x4 vtr(LAS const unsigned char* p) { return __builtin_bit_cast(s16x4, __builtin_amdgcn_ds_read_tr16_b64_v4i16((LAS v4i16_t*)p)); }

__device__ __forceinline__ void attn_item(const bf16* Z, const bf16* KVC, const float* sink, bf16* Obuf, ldsp lds, int b, int nb, int hk, int qh) {
    const int tid = threadIdx.x, lane = tid & 63, wave = __builtin_amdgcn_readfirstlane(tid >> 6), r32 = lane & 31, hi = lane >> 5;
    const int rq = wave >> 1, head = hk * 4 + rq;
    const int iq = qh * 64 + (wave & 1) * 32 + r32;
    const int wlo = (nb == 0) ? 2 : qh, whi = (nb == 63) ? 4 : 5 + qh, nwin = whi - wlo, ntile = nwin + 4;
    const int tokq = b * SEQ + nb * 128 + iq;
    bf16x8 qr[4];
#pragma unroll
    for (int d0 = 0; d0 < 4; ++d0) qr[d0] = *(const bf16x8*)(Z + (size_t)tokq * DIN + ZQ + head * 64 + d0 * 16 + hi * 8);
    float mrun = sink[head] * LOG2E, lrun = (hi == 0) ? 1.f : 0.f;
    f32x16 o[2];
#pragma unroll
    for (int j = 0; j < 2; ++j)
#pragma unroll
        for (int r = 0; r < 16; ++r) o[j][r] = 0.f;
    const int kdst = wave * 1024 + lane * 16, vdst = 8192 + (wave >> 2) * 4096 + lane * 64 + (wave & 3) * 16;
#define ATT_SRC(s, kp, vp) do { const int tl_ = (s) < nwin ? wlo + (s) : 6 + (s) - nwin; \
        if (tl_ < 6) { const int tok_ = b * SEQ + (nb - 1 + (tl_ >> 1)) * 128 + (tl_ & 1) * 64 + lane; kp = Z + (size_t)tok_ * DIN + ZK + hk * 64 + wave * 8; vp = Z + (size_t)tok_ * DIN + ZVA + hk * 64 + wave * 8; } \
        else { const int row_ = b * NCTX + (tl_ - 6) * 64 + lane; kp = KVC + (size_t)row_ * 256 + hk * 64 + wave * 8; vp = KVC + (size_t)row_ * 256 + 128 + hk * 64 + wave * 8; } } while (0)
    u32x4 kreg, vreg;
    { const bf16 *kp, *vp; ATT_SRC(0, kp, vp); kreg = *(const u32x4*)kp; vreg = *(const u32x4*)vp; }
    *(LAS u32x4*)(lds + kdst) = kreg; *(LAS u32x4*)(lds + vdst) = vreg;
    __syncthreads();
    const int vrd = ((lane & 15) >> 2) * 64 + ((lane >> 4) & 1) * 32 + (lane & 3) * 8 + hi * 256;
    for (int s = 0; s < ntile; ++s) {
        const int base = (s & 1) * 16384;
        const int tl = s < nwin ? wlo + s : 6 + s - nwin;
        if (s + 1 < ntile) { const bf16 *kp, *vp; ATT_SRC(s + 1, kp, vp); kreg = *(const u32x4*)kp; vreg = *(const u32x4*)vp; }
        {
            f32x16 p0, p1;
#pragma unroll
            for (int r = 0; r < 16; ++r) { p0[r] = 0.f; p1[r] = 0.f; }
#pragma unroll
            for (int d0 = 0; d0 < 4; ++d0) {
                const bf16x8 k0 = *(LAS const bf16x8*)(lds + base + (2 * d0 + hi) * 1024 + r32 * 16);
                const bf16x8 k1 = *(LAS const bf16x8*)(lds + base + (2 * d0 + hi) * 1024 + (r32 + 32) * 16);
                p0 = mfma32(k0, qr[d0], p0); p1 = mfma32(k1, qr[d0], p1);
            }
            if (tl < 2) {
                const int j0 = (tl & 1) * 64 + 4 * hi;
#pragma unroll
                for (int r = 0; r < 16; ++r) { const int j = j0 + (r & 3) + 8 * (r >> 2); if (j < iq) p0[r] = -INFINITY; if (j + 32 < iq) p1[r] = -INFINITY; }
            } else if (tl == 4 || tl == 5) {
                const int j0 = (tl & 1) * 64 + 4 * hi;
#pragma unroll
                for (int r = 0; r < 16; ++r) { const int j = j0 + (r & 3) + 8 * (r >> 2); if (j > iq) p0[r] = -INFINITY; if (j + 32 > iq) p1[r] = -INFINITY; }
            }
            float mx = fmaxf(p0[0], p1[0]);
#pragma unroll
            for (int r = 1; r < 16; ++r) mx = fmaxf(mx, fmaxf(p0[r], p1[r]));
            mx = fmaxf(mx, __shfl_xor(mx, 32));
            const float mn = fmaxf(mrun, mx), alpha = __builtin_amdgcn_exp2f(mrun - mn);
            mrun = mn;
            float rs = 0.f;
#pragma unroll
            for (int r = 0; r < 16; ++r) { p0[r] = __builtin_amdgcn_exp2f(p0[r] - mn); p1[r] = __builtin_amdgcn_exp2f(p1[r] - mn); rs += p0[r] + p1[r]; }
            lrun = lrun * alpha + rs;
#pragma unroll
            for (int r = 0; r < 16; ++r) { o[0][r] *= alpha; o[1][r] *= alpha; }
            bf16x8 pf[4];
#pragma unroll
            for (int s4 = 0; s4 < 4; ++s4) {
                u32x4 w;
                if (s4 < 2) { w.x = cvtpk(p0[8 * s4 + 0], p0[8 * s4 + 1]); w.y = cvtpk(p0[8 * s4 + 2], p0[8 * s4 + 3]); w.z = cvtpk(p0[8 * s4 + 4], p0[8 * s4 + 5]); w.w = cvtpk(p0[8 * s4 + 6], p0[8 * s4 + 7]); }
                else { const int q = s4 - 2; w.x = cvtpk(p1[8 * q + 0], p1[8 * q + 1]); w.y = cvtpk(p1[8 * q + 2], p1[8 * q + 3]); w.z = cvtpk(p1[8 * q + 4], p1[8 * q + 5]); w.w = cvtpk(p1[8 * q + 6], p1[8 * q + 7]); }
                pf[s4] = __builtin_bit_cast(bf16x8, w);
            }
#pragma unroll
            for (int dblk = 0; dblk < 2; ++dblk)
#pragma unroll
                for (int s4 = 0; s4 < 4; ++s4) {
                    const s16x4 lo = vtr(lds + base + 8192 + dblk * 4096 + vrd + (16 * s4) * 64);
                    const s16x4 hh = vtr(lds + base + 8192 + dblk * 4096 + vrd + (16 * s4 + 8) * 64);
                    const bf16x8 vf = {lo[0], lo[1], lo[2], lo[3], hh[0], hh[1], hh[2], hh[3]};
                    o[dblk] = mfma32(vf, pf[s4], o[dblk]);
                }
        }
        if (s + 1 < ntile) { *(LAS u32x4*)(lds + (16384 - base) + kdst) = kreg; *(LAS u32x4*)(lds + (16384 - base) + vdst) = vreg; }
        __syncthreads();
    }
#undef ATT_SRC
    {
        const float lt = lrun + __shfl_xor(lrun, 32), inv = 1.f / lt;
        bf16* op = Obuf + (size_t)tokq * 512 + head * 64;
#pragma unroll
        for (int dblk = 0; dblk < 2; ++dblk)
#pragma unroll
            for (int r4 = 0; r4 < 4; ++r4) {
                u32x2 w; w.x = cvtpk(o[dblk][4 * r4] * inv, o[dblk][4 * r4 + 1] * inv); w.y = cvtpk(o[dblk][4 * r4 + 2] * inv, o[dblk][4 * r4 + 3] * inv);
                *(u32x2*)(op + 32 * dblk + 8 * r4 + 4 * hi) = w;
            }
    }
}

__device__ __forceinline__ void gmlp_item(const bf16* Z, const float* lng, const float* lnb, const bf16* WsT, const float* bs, bf16* Abuf, ldsp lds, int ch, int g) {
    const int tid = threadIdx.x, lane = tid & 63, wave = __builtin_amdgcn_readfirstlane(tid >> 6), fr = lane & 15, fq = lane >> 4;
    const int tok0 = ch * 128;
    LAS bf16* VT = (LAS bf16*)lds;
    f32x4 gA = *(const f32x4*)(lng + lane * 8), gB = *(const f32x4*)(lng + lane * 8 + 4), bA = *(const f32x4*)(lnb + lane * 8), bB = *(const f32x4*)(lnb + lane * 8 + 4);
#pragma unroll
    for (int rnd = 0; rnd < 2; ++rnd) {
        float y[8][8];
#pragma unroll
        for (int j = 0; j < 8; ++j) {
            const int tok = tok0 + wave * 16 + rnd * 8 + j;
            const u32x4 raw = *(const u32x4*)(Z + (size_t)tok * DIN + ZV + lane * 8);
            float x[8] = {bflo(raw.x), bfhi(raw.x), bflo(raw.y), bfhi(raw.y), bflo(raw.z), bfhi(raw.z), bflo(raw.w), bfhi(raw.w)};
            float s = 0.f;
#pragma unroll
            for (int i = 0; i < 8; ++i) s += x[i];
            const float mu = wave_sum(s) * (1.f / 512.f);
            float q = 0.f;
#pragma unroll
            for (int i = 0; i < 8; ++i) { x[i] -= mu; q += x[i] * x[i]; }
            const float rstd = rsqrtf(wave_sum(q) * (1.f / 512.f) + 1e-6f);
            y[j][0] = x[0] * rstd * gA[0] + bA[0]; y[j][1] = x[1] * rstd * gA[1] + bA[1]; y[j][2] = x[2] * rstd * gA[2] + bA[2]; y[j][3] = x[3] * rstd * gA[3] + bA[3];
            y[j][4] = x[4] * rstd * gB[0] + bB[0]; y[j][5] = x[5] * rstd * gB[1] + bB[1]; y[j][6] = x[6] * rstd * gB[2] + bB[2]; y[j][7] = x[7] * rstd * gB[3] + bB[3];
        }
        if ((lane >> 4) == g) {
#pragma unroll
            for (int i = 0; i < 8; ++i) {
                u32x4 w; w.x = cvtpk(y[0][i], y[1][i]); w.y = cvtpk(y[2][i], y[3][i]); w.z = cvtpk(y[4][i], y[5][i]); w.w = cvtpk(y[6][i], y[7][i]);
                *(LAS u32x4*)(VT + (8 * (lane & 15) + i) * 136 + wave * 16 + rnd * 8) = w;
            }
        }
    }
    __syncthreads();
    const int wm = wave >> 1, wn = wave & 1;
    f32x4 acc[2][4];
#pragma unroll
    for (int m = 0; m < 2; ++m)
#pragma unroll
        for (int n = 0; n < 4; ++n) acc[m][n] = (f32x4){0.f, 0.f, 0.f, 0.f};
#pragma unroll
    for (int ks = 0; ks < 4; ++ks) {
        bf16x8 af[2], bfr[4];
#pragma unroll
        for (int m = 0; m < 2; ++m) af[m] = *(const bf16x8*)(WsT + (size_t)g * 16384 + (32 * wm + 16 * m + fr) * 128 + 32 * ks + 8 * fq);
#pragma unroll
        for (int n = 0; n < 4; ++n) bfr[n] = *(LAS const bf16x8*)(VT + (64 * wn + 16 * n + fr) * 136 + 32 * ks + 8 * fq);
#pragma unroll
        for (int m = 0; m < 2; ++m)
#pragma unroll
            for (int n = 0; n < 4; ++n) acc[m][n] = mfma16(af[m], bfr[n], acc[m][n]);
    }
#pragma unroll
    for (int m = 0; m < 2; ++m)
#pragma unroll
        for (int reg = 0; reg < 4; ++reg) {
            const int p = 32 * wm + 16 * m + 4 * fq + reg, tok = tok0 + p; const float bias = bs[g * 128 + p];
#pragma unroll
            for (int n = 0; n < 4; ++n) {
                const int c = g * 128 + 64 * wn + 16 * n + fr;
                const float uu = bf2f(Z[(size_t)tok * DIN + ZU + c]);
                Abuf[(size_t)tok * 512 + c] = (bf16)(cvtpk(uu * (acc[m][n][reg] + bias), 0.f) & 0xffffu);
            }
        }
    __syncthreads();
}

__device__ __forceinline__ void phase_mixers(const Args& a, ldsp lds, int G, int vcu) {
    unsigned char* ws = a.ws;
    const bf16* Z = (const bf16*)(ws + WS_Z);
    for (int it = vcu; it < 512; it += G) {
        const int qh = it & 1, hk = (it >> 1) & 1, nb = (it >> 2) & 63, b = it >> 8;
        attn_item(Z, (const bf16*)(ws + WS_KVC), a.in[I_SINK], (bf16*)(ws + WS_O), lds, b, nb, hk, qh);
    }
    for (int it = vcu; it < 512; it += G) {
        gmlp_item(Z, a.in[I_LNG], a.in[I_LNB], (const bf16*)(ws + WS_WST), a.in[I_GBS], (bf16*)(ws + WS_A), lds, it >> 2, it & 3);
    }
}

#define KI_BEFORE(ka, ia, kb, ib) (((ka) > (kb)) || ((ka) == (kb) && (ia) < (ib)))
#define KI_CAS(K, I, p, q) do { const bool sw_ = KI_BEFORE(K[q], I[q], K[p], I[p]); const float kp_ = sw_ ? K[q] : K[p], kq_ = sw_ ? K[p] : K[q]; const int ip_ = sw_ ? I[q] : I[p], iq_ = sw_ ? I[p] : I[q]; \
        K[p] = kp_; I[p] = ip_; K[q] = kq_; I[q] = iq_; } while (0)
#define KI_SORT8(K, I) do { KI_CAS(K, I, 0, 1); KI_CAS(K, I, 2, 3); KI_CAS(K, I, 4, 5); KI_CAS(K, I, 6, 7); \
        KI_CAS(K, I, 0, 2); KI_CAS(K, I, 1, 3); KI_CAS(K, I, 4, 6); KI_CAS(K, I, 5, 7); \
        KI_CAS(K, I, 1, 2); KI_CAS(K, I, 5, 6); KI_CAS(K, I, 0, 4); KI_CAS(K, I, 3, 7); \
        KI_CAS(K, I, 1, 5); KI_CAS(K, I, 2, 6); KI_CAS(K, I, 1, 4); KI_CAS(K, I, 3, 6); \
        KI_CAS(K, I, 2, 4); KI_CAS(K, I, 3, 5); KI_CAS(K, I, 3, 4); } while (0)
#define KI_MERGE8(KA, IA, KB, IB) do { \
        _Pragma("unroll") for (int r_ = 0; r_ < 8; ++r_) { const bool tb_ = KI_BEFORE(KB[7 - r_], IB[7 - r_], KA[r_], IA[r_]); KA[r_] = tb_ ? KB[7 - r_] : KA[r_]; IA[r_] = tb_ ? IB[7 - r_] : IA[r_]; } \
        KI_CAS(KA, IA, 0, 4); KI_CAS(KA, IA, 1, 5); KI_CAS(KA, IA, 2, 6); KI_CAS(KA, IA, 3, 7); \
        KI_CAS(KA, IA, 0, 2); KI_CAS(KA, IA, 1, 3); KI_CAS(KA, IA, 4, 6); KI_CAS(KA, IA, 5, 7); \
        KI_CAS(KA, IA, 0, 1); KI_CAS(KA, IA, 2, 3); KI_CAS(KA, IA, 4, 5); KI_CAS(KA, IA, 6, 7); } while (0)
__device__ __forceinline__ void router_item(const Args& a, ldsp lds, int it) {
    const int tid = threadIdx.x, lane = tid & 63, wave = __builtin_amdgcn_readfirstlane(tid >> 6), fr = lane & 15, fq = lane >> 4;
    unsigned char* ws = a.ws;
    const int t0 = it * 64, b = t0 >> 13;
    const float* X1 = (const float*)(ws + WS_X1); const float* adaf = (const float*)(ws + WS_ADAF) + b * 6144;
    const float* g2 = a.in[I_N2G]; bf16* H2 = (bf16*)(ws + WS_H2);
    {
        f32x4 gm[2][2], sh[2][2];
#pragma unroll
        for (int j = 0; j < 2; ++j)
#pragma unroll
            for (int h = 0; h < 2; ++h) {
                const int c = 8 * lane + 512 * j + 4 * h;
                const f32x4 gg = *(const f32x4*)(g2 + c), sc = *(const f32x4*)(adaf + 4 * 1024 + c);
                gm[j][h] = gg * (sc + 1.f); sh[j][h] = *(const f32x4*)(adaf + 3 * 1024 + c);
            }
#pragma unroll
        for (int half = 0; half < 2; ++half) {
            f32x4 x[4][2][2];
#pragma unroll
            for (int tt = 0; tt < 4; ++tt)
#pragma unroll
                for (int j = 0; j < 2; ++j)
#pragma unroll
                    for (int h = 0; h < 2; ++h) x[tt][j][h] = *(const f32x4*)(X1 + (size_t)(t0 + wave * 8 + half * 4 + tt) * D + 8 * lane + 512 * j + 4 * h);
#pragma unroll
            for (int tt = 0; tt < 4; ++tt) {
                const int row = wave * 8 + half * 4 + tt, tok = t0 + row;
                float ss = 0.f;
#pragma unroll
                for (int j = 0; j < 2; ++j)
#pragma unroll
                    for (int h = 0; h < 2; ++h) { const f32x4 v = x[tt][j][h]; ss += (v[0] * v[0] + v[1] * v[1]) + (v[2] * v[2] + v[3] * v[3]); }
                const float r = rsqrtf(wave_sum(ss) * (1.f / D) + 1e-6f);
#pragma unroll
                for (int j = 0; j < 2; ++j) {
                    const f32x4 h0 = (x[tt][j][0] * r) * gm[j][0] + sh[j][0], h1 = (x[tt][j][1] * r) * gm[j][1] + sh[j][1];
                    u32x4 w; w.x = cvtpk(h0[0], h0[1]); w.y = cvtpk(h0[2], h0[3]); w.z = cvtpk(h1[0], h1[1]); w.w = cvtpk(h1[2], h1[3]);
                    *(u32x4*)(H2 + (size_t)tok * D + 8 * lane + 512 * j) = w;
                    const int kc = lane + 64 * j;
                    *(LAS u32x4*)(lds + kc * 1024 + ((row ^ (kc & 7)) * 16)) = w;
                }
            }
        }
    }
    __syncthreads();
    f32x4 acc[4][2];
#pragma unroll
    for (int m = 0; m < 4; ++m)
#pragma unroll
        for (int n = 0; n < 2; ++n) acc[m][n] = (f32x4){0.f, 0.f, 0.f, 0.f};
    const bf16* RwT = (const bf16*)(ws + WS_RWT) + (size_t)(32 * wave + fr) * D + 8 * fq;
#pragma unroll 8
    for (int ks = 0; ks < 32; ++ks) {
        const int kc = 4 * ks + fq;
        bf16x8 af[4], bfr[2];
#pragma unroll
        for (int n = 0; n < 2; ++n) bfr[n] = *(const bf16x8*)(RwT + (size_t)(16 * n) * D + 32 * ks);
#pragma unroll
        for (int m = 0; m < 4; ++m) af[m] = *(LAS const bf16x8*)(lds + kc * 1024 + (((16 * m + fr) ^ (kc & 7)) * 16));
#pragma unroll
        for (int m = 0; m < 4; ++m)
#pragma unroll
            for (int n = 0; n < 2; ++n) acc[m][n] = mfma16(af[m], bfr[n], acc[m][n]);
    }
    __syncthreads();
    LAS float* LG = (LAS float*)lds;
#pragma unroll
    for (int m = 0; m < 4; ++m)
#pragma unroll
        for (int n = 0; n < 2; ++n)
#pragma unroll
            for (int reg = 0; reg < 4; ++reg) LG[(32 * wave + 16 * n + fr) * 65 + 16 * m + 4 * fq + reg] = acc[m][n][reg];
    __syncthreads();
    LAS float* CK = (LAS float*)(lds + 69632); LAS int* CI = (LAS int*)(lds + 69632 + 16384);
    const float* rb = a.in[I_RB];
    float bk[8]; int bi[8];
#pragma unroll
    for (int q = 0; q < 4; ++q) {
        float gk[8]; int gi[8];
#pragma unroll
        for (int j = 0; j < 8; ++j) { const int e = 32 * wave + 8 * q + j; gk[j] = sigmoid_f(LG[e * 65 + lane]) + rb[e]; gi[j] = e; }
        KI_SORT8(gk, gi);
        if (q == 0) {
#pragma unroll
            for (int j = 0; j < 8; ++j) { bk[j] = gk[j]; bi[j] = gi[j]; }
        } else KI_MERGE8(bk, bi, gk, gi);
    }
#pragma unroll
    for (int r = 0; r < 8; ++r) { CK[(wave * 8 + r) * 64 + lane] = bk[r]; CI[(wave * 8 + r) * 64 + lane] = bi[r]; }
    __syncthreads();
#define RT_LEVEL(lvl) do { if ((wave & (2 * (lvl) - 1)) == 0) { float ok_[8]; int oi_[8]; \
            _Pragma("unroll") for (int r = 0; r < 8; ++r) { ok_[r] = CK[((wave + (lvl)) * 8 + r) * 64 + lane]; oi_[r] = CI[((wave + (lvl)) * 8 + r) * 64 + lane]; } \
            KI_MERGE8(bk, bi, ok_, oi_); \
            if ((lvl) < 4) { _Pragma("unroll") for (int r = 0; r < 8; ++r) { CK[(wave * 8 + r) * 64 + lane] = bk[r]; CI[(wave * 8 + r) * 64 + lane] = bi[r]; } } } \
        __syncthreads(); } while (0)
    RT_LEVEL(1); RT_LEVEL(2); RT_LEVEL(4);
#undef RT_LEVEL
    LAS unsigned* hist = (LAS unsigned*)(lds + 102400); LAS unsigned* hbase = hist + 256;
    if (tid < 256) hist[tid] = 0u;
    __syncthreads();
    unsigned* cnt = (unsigned*)(ws + WS_CTL) + CW_CNT; int* list = (int*)(ws + WS_LIST); float* gatew = (float*)(ws + WS_GATEW);
    unsigned rank[8];
    if (wave == 0) {
        const int tok = t0 + lane;
        float sel[8], ssum = 0.f;
#pragma unroll
        for (int r = 0; r < 8; ++r) { sel[r] = sigmoid_f(LG[bi[r] * 65 + lane]); ssum += sel[r]; }
#pragma unroll
        for (int r = 0; r < 8; ++r) rank[r] = __hip_atomic_fetch_add(&hist[bi[r]], 1u, __ATOMIC_RELAXED, __HIP_MEMORY_SCOPE_WORKGROUP);
        const float sc = 2.5f / ssum;
        f32x4 g0 = {sel[0] * sc, sel[1] * sc, sel[2] * sc, sel[3] * sc}, g1 = {sel[4] * sc, sel[5] * sc, sel[6] * sc, sel[7] * sc};
        *(f32x4*)(gatew + tok * 8) = g0; *(f32x4*)(gatew + tok * 8 + 4) = g1;
    }
    __syncthreads();
    if (tid < 256) { const unsigned h = hist[tid]; if (h) hbase[tid] = atomicAdd(cnt + 32 * tid, h); }
    __syncthreads();
    if (wave == 0) {
        const int tok = t0 + lane;
#pragma unroll
        for (int r = 0; r < 8; ++r) list[(size_t)bi[r] * LISTCAP + hbase[bi[r]] + rank[r]] = tok * NSLOT + r;
    }
    __syncthreads();
}

__device__ __forceinline__ void moe_tile(const Args& a, ldsp lds, int e, int mt, int nrows, int ntl) {
    const int tid = threadIdx.x, lane = tid & 63, wave = __builtin_amdgcn_readfirstlane(tid >> 6), fr = lane & 15, fq = lane >> 4;
    unsigned char* ws = a.ws;
    constexpr int ASTG = 0, BSTG = 16384, ACT = 49152, SLOTS = 114688, GWO = 115200;
    const bf16* H2 = (const bf16*)(ws + WS_H2);
    const float* Wg = (e < NEXP) ? a.in[I_EG] + (size_t)e * 262144 : a.in[I_SG];
    const float* Wu = (e < NEXP) ? a.in[I_EU] + (size_t)e * 262144 : a.in[I_SU];
    const float* Wd = (e < NEXP) ? a.in[I_ED] + (size_t)e * 262144 : a.in[I_SD];
    if (tid < 128) {
        int slot = -1; float gw = 0.f;
        if (tid < nrows) {
            if (e < NEXP) { slot = ((const int*)(ws + WS_LIST))[(size_t)e * LISTCAP + mt * 128 + tid]; gw = ((const float*)(ws + WS_GATEW))[(slot / NSLOT) * 8 + (slot % NSLOT)]; }
            else { slot = (mt * 128 + tid) * NSLOT + 8; gw = 1.f; }
        }
        ((LAS int*)(lds + SLOTS))[tid] = slot; ((LAS float*)(lds + GWO))[tid] = gw;
    }
    __syncthreads();
    const int wr = wave >> 2, wc = wave & 3;
    const int arow = tid >> 2, akc = tid & 3;
    const int aslot = ((LAS const int*)(lds + SLOTS))[arow];
    const bf16* asrc = H2 + (size_t)((aslot < 0 ? 0 : aslot) / NSLOT) * D + akc * 8;
    const int awr = ASTG + akc * 2048 + ((arow ^ (akc << 1)) * 16);
    const int ng = lane, kq = wave;
    const float* srcg = Wg + (size_t)(4 * kq) * 256 + 4 * ng;
    const float* srcu = Wu + (size_t)(4 * kq) * 256 + 4 * ng;
    const float* src2 = Wd + (size_t)(4 * kq) * 1024 + 4 * ng;
    int bwr2[4];
#pragma unroll
    for (int i = 0; i < 4; ++i) { const int rho2 = 4 * ng + i; bwr2[i] = BSTG + (kq >> 1) * 4096 + ((rho2 ^ ((rho2 >> 3) & 3)) * 16) + (kq & 1) * 8; }
    int ard[4], brd[4], rowm[4];
#pragma unroll
    for (int m = 0; m < 4; ++m) { rowm[m] = 64 * wr + 16 * m + fr; ard[m] = fq * 2048 + ((rowm[m] ^ (fq << 1)) * 16); }
#pragma unroll
    for (int n = 0; n < 4; ++n) { const int rho = 64 * wc + 16 * n + fr; brd[n] = BSTG + fq * 4096 + ((rho ^ ((rho >> 3) & 3)) * 16); }
    bf16* contrib = (bf16*)(ws + WS_CONTRIB);
    f32x4 acc[4][4];
    f32x4 B0[4], B1[4], B2[4], B3[4]; u32x4 A0, A1, A2, A3;
#define G1_LOAD(s_, BR, AR) do { const int s0_ = (s_); const int ss_ = s0_ < 63 ? s0_ : 63; \
        const float* bp_ = ((ss_ < 32) ? srcg : srcu) + (size_t)(32 * (ss_ & 31)) * 256; \
        AR = *(const u32x4*)(asrc + 32 * (ss_ & 31)); \
        _Pragma("unroll") for (int j = 0; j < 4; ++j) BR[j] = *(const f32x4*)(bp_ + j * 256); } while (0)
#define G1_WRITE(BR, AR, buf_) do { \
        *(LAS u32x4*)(lds + (buf_) * 8192 + awr) = AR; \
        _Pragma("unroll") for (int i = 0; i < 4; ++i) { u32x2 w_; w_.x = cvtpk(BR[0][i], BR[1][i]); w_.y = cvtpk(BR[2][i], BR[3][i]); *(LAS u32x2*)(lds + (buf_) * 16384 + bwr2[i]) = w_; } } while (0)
#define MOE_COMPUTE(abase_, buf_) do { \
        bf16x8 af_[4], bf_[4]; \
        _Pragma("unroll") for (int m = 0; m < 4; ++m) af_[m] = *(LAS const bf16x8*)(lds + (abase_) + ard[m]); \
        _Pragma("unroll") for (int n = 0; n < 4; ++n) bf_[n] = *(LAS const bf16x8*)(lds + (buf_) * 16384 + brd[n]); \
        _Pragma("unroll") for (int m = 0; m < 4; ++m) _Pragma("unroll") for (int n = 0; n < 4; ++n) acc[m][n] = mfma16(bf_[n], af_[m], acc[m][n]); } while (0)
#define ACC_ZERO() do { _Pragma("unroll") for (int m = 0; m < 4; ++m) _Pragma("unroll") for (int n = 0; n < 4; ++n) acc[m][n] = (f32x4){0.f, 0.f, 0.f, 0.f}; } while (0)
    G1_LOAD(0, B0, A0); G1_LOAD(1, B1, A1); G1_LOAD(2, B2, A2);
    G1_WRITE(B0, A0, 0);
    __syncthreads();
    for (int s = 0; s < 64; s += 4) {
        if ((s & 31) == 0) ACC_ZERO();
        G1_LOAD(s + 3, B3, A3); MOE_COMPUTE(0, 0); G1_WRITE(B1, A1, 1); __syncthreads();
        G1_LOAD(s + 4, B0, A0); MOE_COMPUTE(8192, 1); G1_WRITE(B2, A2, 0); __syncthreads();
        G1_LOAD(s + 5, B1, A1); MOE_COMPUTE(0, 0); G1_WRITE(B3, A3, 1); __syncthreads();
        G1_LOAD(s + 6, B2, A2); MOE_COMPUTE(8192, 1);
        if (s == 28) {
#pragma unroll
            for (int m = 0; m < 4; ++m)
#pragma unroll
                for (int n = 0; n < 4; ++n) {
                    const f32x4 gv = acc[m][n];
                    u32x2 w; w.x = cvtpk(silu_f(gv[0]), silu_f(gv[1])); w.y = cvtpk(silu_f(gv[2]), silu_f(gv[3]));
                    const int kc = 8 * wc + 2 * n + (fq >> 1);
                    *(LAS u32x2*)(lds + ACT + kc * 2048 + ((rowm[m] ^ ((kc & 3) << 1)) * 16) + (fq & 1) * 8) = w;
                }
        } else if (s == 60) {
#pragma unroll
            for (int m = 0; m < 4; ++m)
#pragma unroll
                for (int n = 0; n < 4; ++n) {
                    const f32x4 uv = acc[m][n];
                    const int kc = 8 * wc + 2 * n + (fq >> 1);
                    LAS u32x2* ap = (LAS u32x2*)(lds + ACT + kc * 2048 + ((rowm[m] ^ ((kc & 3) << 1)) * 16) + (fq & 1) * 8);
                    const u32x2 g = *ap;
                    u32x2 w; w.x = cvtpk(bflo(g.x) * uv[0], bfhi(g.x) * uv[1]); w.y = cvtpk(bflo(g.y) * uv[2], bfhi(g.y) * uv[3]);
                    *ap = w;
                }
        }
        G1_WRITE(B0, A0, 0); __syncthreads();
    }
#define G2_LOAD(s_, BR) do { const int s0_ = (s_); const int t_ = s0_ < 31 ? s0_ : 31; \
        const float* bp_ = src2 + (size_t)(32 * (t_ & 7)) * 1024 + 256 * (t_ >> 3); \
        _Pragma("unroll") for (int j = 0; j < 4; ++j) BR[j] = *(const f32x4*)(bp_ + j * 1024); } while (0)
#define G2_WRITE(BR, buf_) do { \
        _Pragma("unroll") for (int i = 0; i < 4; ++i) { u32x2 w_; w_.x = cvtpk(BR[0][i], BR[1][i]); w_.y = cvtpk(BR[2][i], BR[3][i]); *(LAS u32x2*)(lds + (buf_) * 16384 + bwr2[i]) = w_; } } while (0)
    G2_LOAD(0, B0); G2_LOAD(1, B1); G2_LOAD(2, B2);
    G2_WRITE(B0, 0);
    __syncthreads();
    for (int s = 0; s < 32; s += 4) {
        if ((s & 7) == 0) ACC_ZERO();
        G2_LOAD(s + 3, B3); MOE_COMPUTE(ACT + (s & 7) * 8192, 0); G2_WRITE(B1, 1); __syncthreads();
        G2_LOAD(s + 4, B0); MOE_COMPUTE(ACT + ((s + 1) & 7) * 8192, 1); G2_WRITE(B2, 0); __syncthreads();
        G2_LOAD(s + 5, B1); MOE_COMPUTE(ACT + ((s + 2) & 7) * 8192, 0); G2_WRITE(B3, 1); __syncthreads();
        G2_LOAD(s + 6, B2); MOE_COMPUTE(ACT + ((s + 3) & 7) * 8192, 1);
        if ((s & 7) == 4) {
            const int q = s >> 3;
#pragma unroll
            for (int m = 0; m < 4; ++m) {
                const int slot = ((LAS const int*)(lds + SLOTS))[rowm[m]]; const float gw = ((LAS const float*)(lds + GWO))[rowm[m]];
                if (slot >= 0) {
                    bf16* cp = contrib + (size_t)slot * D + q * 256 + 64 * wc + 4 * fq;
#pragma unroll
                    for (int n = 0; n < 4; ++n) { const f32x4 v = acc[m][n] * gw; u32x2 w; w.x = cvtpk(v[0], v[1]); w.y = cvtpk(v[2], v[3]); *(u32x2*)(cp + 16 * n) = w; }
                }
            }
        }
        G2_WRITE(B0, 0); __syncthreads();
    }
#undef G1_LOAD
#undef G1_WRITE
#undef G2_LOAD
#undef G2_WRITE
#undef ACC_ZERO
#undef MOE_COMPUTE
}

__device__ __forceinline__ void phase_moe(const Args& a, ldsp lds, int G, int vcu) {
    const int tid = threadIdx.x;
    const unsigned* cnt = (const unsigned*)(a.ws + WS_CTL) + CW_CNT;
    LAS int* pre = (LAS int*)(lds + MISC_OFF + 512);
    if (tid == 0) { int s = 0; for (int e = 0; e < NEXP; ++e) { pre[e] = s; s += (int)((cnt[32 * e] + 127u) >> 7); } pre[NEXP] = s; }
    __syncthreads();
    const int total = pre[NEXP], ntiles = total + T / 128;
    for (int j = vcu; j < ntiles; j += G) {
        int e, mt, nrows, ntl;
        if (j < total) {
            int lo = 0, hi = NEXP;
            while (hi - lo > 1) { const int mid = (lo + hi) >> 1; if (pre[mid] <= j) lo = mid; else hi = mid; }
            e = lo; mt = j - pre[e]; const int c = (int)cnt[32 * e] - mt * 128; nrows = c < 128 ? c : 128; ntl = pre[e + 1] - pre[e];
        } else { e = NEXP; mt = j - total; nrows = 128; ntl = 8; }
        moe_tile(a, lds, e, mt, nrows, ntl);
    }
}

__device__ __forceinline__ void phase_combine(const Args& a, int G) {
    const int tid = threadIdx.x, lane = tid & 63, wave = __builtin_amdgcn_readfirstlane(tid >> 6), blk = blockIdx.x;
    unsigned char* ws = a.ws;
    const float* X1 = (const float*)(ws + WS_X1); const bf16* contrib = (const bf16*)(ws + WS_CONTRIB); const float* fg = a.in[I_FG];
    for (int t = blk * NWAVES + wave; t < T; t += G * NWAVES) {
        const float* g2 = (const float*)(ws + WS_ADAF) + (t >> 13) * 6144 + 5 * 1024;
        f32x4 xv[2][2]; float ss = 0.f;
#pragma unroll
        for (int j = 0; j < 2; ++j) {
            const int c = 8 * lane + 512 * j;
            float sm[8] = {0.f, 0.f, 0.f, 0.f, 0.f, 0.f, 0.f, 0.f};
#pragma unroll
            for (int k = 0; k < NSLOT; ++k) {
                const u32x4 w = *(const u32x4*)(contrib + ((size_t)t * NSLOT + k) * D + c);
                sm[0] += bflo(w.x); sm[1] += bfhi(w.x); sm[2] += bflo(w.y); sm[3] += bfhi(w.y); sm[4] += bflo(w.z); sm[5] += bfhi(w.z); sm[6] += bflo(w.w); sm[7] += bfhi(w.w);
            }
#pragma unroll
            for (int h = 0; h < 2; ++h) {
                const f32x4 x1 = *(const f32x4*)(X1 + (size_t)t * D + c + 4 * h), gg = *(const f32x4*)(g2 + c + 4 * h);
                const f32x4 mv = {sm[4 * h], sm[4 * h + 1], sm[4 * h + 2], sm[4 * h + 3]};
                const f32x4 v = x1 + gg * mv; xv[j][h] = v; ss += (v[0] * v[0] + v[1] * v[1]) + (v[2] * v[2] + v[3] * v[3]);
            }
        }
        const float r = rsqrtf(wave_sum(ss) * (1.f / D) + 1e-6f);
#pragma unroll
        for (int j = 0; j < 2; ++j)
#pragma unroll
            for (int h = 0; h < 2; ++h) { const int c = 8 * lane + 512 * j + 4 * h; *(f32x4*)(a.out + (size_t)t * D + c) = (xv[j][h] * r) * *(const f32x4*)(fg + c); }
    }
}

constexpr int NPH = 9;
#ifndef N_LAUNCHES
#define N_LAUNCHES 1
#endif
__global__ void __launch_bounds__(NWAVES * 64, 2) mega(Args a) {
    extern __shared__ __attribute__((aligned(16))) unsigned char lds_raw[];
    ldsp lds = (ldsp)lds_raw;
    const int tid = threadIdx.x, G = gridDim.x, bx = blockIdx.x;
    int vcu = (G % 8 == 0) ? (bx % 8) * (G / 8) + bx / 8 : bx;
    unsigned char* ws = a.ws;
    for (int u = tid; u < (LDS_BYTES - MISC_OFF) / 4; u += NWAVES * 64) ((LAS unsigned*)(lds + MISC_OFF))[u] = 0u;
    __syncthreads();
    volatile LAS unsigned* MISC = (volatile LAS unsigned*)(lds + MISC_OFF);
    XcdBarrier bar; bar.bar = (unsigned*)(ws + WS_CTL) + CW_BAR; bar.x = 0; bar.st = nullptr;
    if (N_LAUNCHES == 1) {
        bar = xcd_barrier_post((unsigned*)(ws + WS_CTL) + CW_BAR, MISC + 8);
        if (tid == 0) MISC[16] = atomicAdd((unsigned*)(ws + WS_CTL) + CW_XRANK + 64 * bar.x, 1u);
    }
    const int lo = a.ph_lo, hi = a.ph_hi;
#ifndef PH_MASK
#define PH_MASK 0x1ff
#endif
#define IN(k) (((PH_MASK >> (k)) & 1) && lo <= (k) && (k) < hi)
#define SEAM(k) do { if (IN(k) && IN((k) + 1)) xcd_barrier(bar); } while (0)
#ifndef PH_DUP
#define PH_DUP -1
#endif
#define REP(k) for (int rep_ = 0; rep_ < ((PH_DUP == (k)) ? 2 : 1); ++rep_)
    if (IN(0)) REP(0) { phase_prep(a, lds, G); } SEAM(0);
    if (N_LAUNCHES == 1 && IN(0) && IN(1)) {
        unsigned basex = 0;
        for (unsigned j = 0; j < bar.x; ++j) basex += xb_ld(&bar.bar[XB_XCNT(j)]);
        vcu = (int)(basex + MISC[16]);
    }
    if (IN(1)) REP(1) { phase_hnorm(a, lds, G); } SEAM(1);
    if (IN(2)) REP(2) {
        pg8::Gemm g{(const pg8::bf16_t*)(ws + WS_H), (const pg8::bf16_t*)(ws + WS_WINT), MH, DIN, D};
        WinOrder S; S.init(G, bx);
        EpiWin E{(bf16*)(ws + WS_Z), (bf16*)(ws + WS_KVC), (const float*)(ws + WS_ROPE)};
        pg8::gemm_phase<EpiWin, WinOrder, true, true>(lds, g, S, E);
    } SEAM(2);
    if (IN(3)) REP(3) { phase_mixers(a, lds, G, vcu); } SEAM(3);
    if (IN(4)) REP(4) {
        { pg8::Gemm g{(const pg8::bf16_t*)(ws + WS_A), (const pg8::bf16_t*)(ws + WS_WAT), T, D, 512};
          pg8::StaticOrder S; S.init(T, D, G, bx);
          EpiMergeA E{(const bf16*)(ws + WS_Z), (float*)(ws + WS_TMP)};
          pg8::gemm_phase<EpiMergeA, pg8::StaticOrder, true, true>(lds, g, S, E); }
        { pg8::Gemm g{(const pg8::bf16_t*)(ws + WS_O), (const pg8::bf16_t*)(ws + WS_WBT), T, D, 512};
          pg8::StaticOrder S; S.init(T, D, G, bx);
          EpiMergeB E{(const bf16*)(ws + WS_Z), (const float*)(ws + WS_TMP), (bf16*)(ws + WS_Y)};
          pg8::gemm_phase<EpiMergeB, pg8::StaticOrder, true, true>(lds, g, S, E); }
    } SEAM(4);
    if (IN(5)) REP(5) {
        pg8::Gemm g{(const pg8::bf16_t*)(ws + WS_Y), (const pg8::bf16_t*)(ws + WS_WOT), T, D, D};
        pg8::StaticOrder S; S.init(T, D, G, bx);
        EpiWo E{a.in[I_X], (const float*)(ws + WS_ADAF), (float*)(ws + WS_X1)};
        pg8::gemm_phase<EpiWo, pg8::StaticOrder, true, true>(lds, g, S, E);
    } SEAM(5);
    if (IN(6)) { for (int it = vcu; it < T / 64; it += G) router_item(a, lds, it); } SEAM(6);
    if (IN(7)) REP(7) { phase_moe(a, lds, G, vcu); } SEAM(7);
    if (IN(8)) REP(8) { phase_combine(a, G); }
#undef IN
#undef SEAM
}

extern "C" void kernel_launch(void* const* d_in, const int* in_sizes, int n_in, void* d_out, int out_size, void* d_ws, size_t ws_size, hipStream_t stream) {
    static int grid = 0;
    if (grid == 0) {
        if (n_in != 26 || out_size != T * D || ws_size < WS_END) { fprintf(stderr, "kernel_launch: unexpected shapes (n_in %d, out %d, ws %zu)\n", n_in, out_size, ws_size); grid = -1; return; }
        int dev = 0, cus = 0, per_cu = 0;
        (void)hipGetDevice(&dev); (void)hipDeviceGetAttribute(&cus, hipDeviceAttributeMultiprocessorCount, dev);
        (void)hipFuncSetAttribute((const void*)mega, hipFuncAttributeMaxDynamicSharedMemorySize, LDS_BYTES);
        (void)hipOccupancyMaxActiveBlocksPerMultiprocessor(&per_cu, (const void*)mega, NWAVES * 64, LDS_BYTES);
        (void)hipGetLastError();
        if (per_cu < 1) { fprintf(stderr, "kernel_launch: occupancy query says %d blocks per CU\n", per_cu); per_cu = 1; }
        grid = cus;
    }
    if (grid < 0) return;
    (void)hipMemsetAsync((char*)d_ws + WS_CTL, 0, CTL_ZERO_BYTES, stream);
    Args a{};
    for (int i = 0; i < 26; ++i) a.in[i] = (const float*)d_in[i];
    a.out = (float*)d_out; a.ws = (unsigned char*)d_ws;
    if (N_LAUNCHES == 1) {
        a.ph_lo = 0; a.ph_hi = NPH;
        void* kargs[] = {&a};
        hipError_t e = hipLaunchCooperativeKernel((const void*)mega, dim3(grid), dim3(NWAVES * 64), kargs, LDS_BYTES, stream);
        if (e != hipSuccess) fprintf(stderr, "kernel_launch: cooperative launch failed: %s (grid %d)\n", hipGetErrorString(e), grid);
    } else {
#ifndef HOST_DUP
#define HOST_DUP -1
#endif
        for (int li = 0; li < NPH; ++li) {
            a.ph_lo = li; a.ph_hi = li + 1;
            hipLaunchKernelGGL(mega, dim3(grid), dim3(NWAVES * 64), LDS_BYTES, stream, a);
            if (li == HOST_DUP) {
                if (li == 6) (void)hipMemsetAsync((char*)d_ws + WS_CTL, 0, CTL_ZERO_BYTES, stream);
                hipLaunchKernelGGL(mega, dim3(grid), dim3(NWAVES * 64), LDS_BYTES, stream, a);
            }
        }
    }
}
```

```cpp
#include <hip/hip_runtime.h>
#include <cstdio>
#include <cstdint>
#include <type_traits>
namespace pg8 {
#define PG8_LAS __attribute__((address_space(3)))
typedef unsigned short bf16_t;
typedef short bf16x8 __attribute__((ext_vector_type(8)));
typedef float f32x4 __attribute__((ext_vector_type(4)));
typedef unsigned u32x4 __attribute__((ext_vector_type(4)));
constexpr int BM = 256, BK = 64, HALF = 128, HTB = HALF * BK * 2  , STAGE_BYTES = 8 * HTB, NXCD = 8, WGM = 8;

__host__ __device__ __forceinline__ int lds_byte(int r, int c) { const int st = (r >> 4) * 2 + (c >> 5), rr = r & 15, cc = c & 31, ob = rr * 64 + cc * 2; return st * 1024 + (ob ^ (((ob >> 9) & 1) << 5)); }
__host__ __device__ __forceinline__ void stage_rc(int b, int& R, int& C) { const int st = b / 1024, sb = b % 1024, swz = sb ^ (((sb >> 9) & 1) << 5); R = (st >> 1) * 16 + swz / 64; C = (st & 1) * 32 + (swz % 64) / 2; }
__host__ __device__ __forceinline__ int perm32(int rho) { const int n = rho >> 4, i = rho & 15; return 8 * (i >> 2) + 4 * n + (i & 3); }

struct Unit { int pm, pn; };
struct Gemm { const bf16_t* A; const bf16_t* Bt; int M, N, K; };

struct StaticOrder {
    int nM, nN, nwg, G, c;
    __host__ __device__ void init(int M, int N, int G_, int c_) { nM = M / BM; nN = N / BM; nwg = nM * nN; G = G_; c = c_; }
    __host__ __device__ bool next(int i, Unit& u) const {
        const long L = (long)i * G + c; if (L >= nwg) return false;
        int wgid = (int)L; { const int q = nwg / NXCD, r = nwg % NXCD, xcd = wgid % NXCD, off = wgid / NXCD; wgid = (xcd < r ? xcd * (q + 1) : r * (q + 1) + (xcd - r) * q) + off; }
        const int nig = WGM * nN, gid = wgid / nig, fm = gid * WGM, gsz = (nM - fm) < WGM ? (nM - fm) : WGM;
        u.pm = fm + ((wgid % nig) % gsz); u.pn = (wgid % nig) / gsz; return true;
    }
    __device__ __forceinline__ void a_ready(const Unit&) const {}
    __device__ __forceinline__ void done(const Unit&) const {}
};

__device__ __forceinline__ unsigned cvt_pk_bf16(float lo, float hi) { unsigned r; asm volatile("v_cvt_pk_bf16_f32 %0, %1, %2" : "=v"(r) : "v"(lo), "v"(hi)); return r; }
template <class Epi, class Sched, bool ALIGN_EPI = false, bool SP2 = false>
__device__ __forceinline__ void gemm_phase(PG8_LAS unsigned char* lds, const Gemm g, const Sched& S, const Epi& E) {
    const int tid = threadIdx.x, wid = __builtin_amdgcn_readfirstlane(tid >> 6), lane = tid & 63, wr = wid >> 2, wc = wid & 3, fr = lane & 15, fq = lane >> 4;
    const int K = g.K, nt = K / BK;
    unsigned voffA[2], voffB[2];
#pragma unroll
    for (int i = 0; i < 2; ++i) { int R, C; stage_rc(tid * 16 + i * 8192, R, C); const int Rb = Epi::PERM ? ((R & ~31) + perm32(R & 31)) : R;
        voffA[i] = (unsigned)(R * K + C) * 2u; voffB[i] = (unsigned)(Rb * K + C) * 2u; }
    const size_t kstep = (size_t)(BK * 2);
    const size_t hstep = (size_t)HALF * K * 2;
    const size_t tstep = 2 * hstep;
    const unsigned ldsw = (unsigned)wid * 1024u;
    const int aoff = lds_byte(wr * 64 + fr, fq * 8), boff = lds_byte(wc * 32 + fr, fq * 8);
#define PG8_SA(b, h) (((b) * 2 + (h)) * HTB)
#define PG8_SB(b, h) ((4 + (b) * 2 + (h)) * HTB)
#define PG8_STAGE(bufoff, gbase, voff) do { _Pragma("unroll") for (int _i = 0; _i < 2; ++_i) \
        __builtin_amdgcn_global_load_lds((const unsigned*)((const char*)(gbase) + (voff)[_i]), (PG8_LAS unsigned*)(lds + (bufoff) + ldsw + _i * 8192), 16, 0, 0); } while (0)
#define PG8_LDA(dst, b, h) do { _Pragma("unroll") for (int m = 0; m < 4; ++m) _Pragma("unroll") for (int k = 0; k < 2; ++k) dst[m][k] = *(const PG8_LAS bf16x8*)(lds + PG8_SA(b, h) + aoff + m * 2048 + k * 1024); } while (0)
#define PG8_LDB(dst, b, h) do { _Pragma("unroll") for (int n = 0; n < 2; ++n) _Pragma("unroll") for (int k = 0; k < 2; ++k) dst[n][k] = *(const PG8_LAS bf16x8*)(lds + PG8_SB(b, h) + boff + n * 2048 + k * 1024); } while (0)
#define PG8_MMA(ai, bj, At, Bt) do { __builtin_amdgcn_s_setprio(1); _Pragma("unroll") for (int m = 0; m < 4; ++m) _Pragma("unroll") for (int n = 0; n < 2; ++n) _Pragma("unroll") for (int k = 0; k < 2; ++k) \
        acc[ai][bj][m][n] = __builtin_amdgcn_mfma_f32_16x16x32_bf16(Bt[n][k], At[m][k], acc[ai][bj][m][n], 0, 0, 0); __builtin_amdgcn_s_setprio(0); } while (0)
#define PG8_WAIT_V(n) asm volatile("s_waitcnt vmcnt(" #n ")" ::: "memory")
#define PG8_WAIT_L(n) asm volatile("s_waitcnt lgkmcnt(" #n ")" ::: "memory")
#define PG8_BAR __builtin_amdgcn_s_barrier()
#define PG8_SCHED __builtin_amdgcn_sched_barrier(0)
    Unit cur, nxt; int ui = 0;
    if (!S.next(0, cur)) return;
    f32x4 acc[2][2][4][2];
#pragma unroll
    for (int a = 0; a < 2; ++a)
#pragma unroll
        for (int b = 0; b < 2; ++b)
#pragma unroll
            for (int m = 0; m < 4; ++m)
#pragma unroll
                for (int n = 0; n < 2; ++n) acc[a][b][m][n] = (f32x4){0.f, 0.f, 0.f, 0.f};
    bf16x8 At[4][2], B0[2][2], B1[2][2];
    const char* cA = (const char*)g.A + (size_t)cur.pm * tstep; const char* cB = (const char*)g.Bt + (size_t)cur.pn * tstep;
    S.a_ready(cur);
    if constexpr (SP2) {
        PG8_STAGE(PG8_SB(0, 0), cB, voffB); PG8_STAGE(PG8_SB(0, 1), cB + hstep, voffB); PG8_STAGE(PG8_SA(0, 0), cA, voffA); PG8_STAGE(PG8_SA(0, 1), cA + hstep, voffA);
        if (wr == 1) PG8_BAR;
        PG8_WAIT_V(2); PG8_BAR;
        PG8_STAGE(PG8_SB(1, 0), cB + kstep, voffB); PG8_STAGE(PG8_SA(1, 0), cA + kstep, voffA); PG8_STAGE(PG8_SB(1, 1), cB + hstep + kstep, voffB);
        PG8_WAIT_V(6); PG8_BAR;
    } else {
        PG8_STAGE(PG8_SB(0, 0), cB, voffB); PG8_STAGE(PG8_SA(0, 0), cA, voffA); PG8_STAGE(PG8_SB(0, 1), cB + hstep, voffB); PG8_STAGE(PG8_SA(0, 1), cA + hstep, voffA);
        if (wr == 1) PG8_BAR;
        PG8_WAIT_V(4); PG8_BAR;
        PG8_STAGE(PG8_SB(1, 0), cB + kstep, voffB); PG8_STAGE(PG8_SA(1, 0), cA + kstep, voffA); PG8_STAGE(PG8_SB(1, 1), cB + hstep + kstep, voffB);
        PG8_WAIT_V(6); PG8_BAR;
    }
    for (;;) {
        const bool has_next = S.next(ui + 1, nxt);
        const char* nA = has_next ? (const char*)g.A + (size_t)nxt.pm * tstep : cA; const char* nB = has_next ? (const char*)g.Bt + (size_t)nxt.pn * tstep : cB;
        for (int t = 0; t < nt; t += 2) {
            const bool last = (t == nt - 2);
            const char* a1 = cA + (size_t)(t + 1) * kstep;
            const char* a2 = last ? nA : cA + (size_t)(t + 2) * kstep; const char* b2 = last ? nB : cB + (size_t)(t + 2) * kstep;
            const char* a3 = a2 + kstep; const char* b3 = b2 + kstep;
            if (last && has_next) S.a_ready(nxt);
            if constexpr (SP2) {
            PG8_LDB(B0, 0, 0); PG8_LDB(B1, 0, 1); PG8_SCHED; PG8_LDA(At, 0, 0); PG8_STAGE(PG8_SA(1, 1), a1 + hstep, voffA);
            PG8_WAIT_V(8); PG8_WAIT_L(0); PG8_BAR; PG8_MMA(0, 0, At, B0); PG8_MMA(0, 1, At, B1); PG8_BAR; PG8_SCHED;
            PG8_LDA(At, 0, 1); PG8_STAGE(PG8_SB(0, 0), b2, voffB); PG8_STAGE(PG8_SB(0, 1), b2 + hstep, voffB); PG8_STAGE(PG8_SA(0, 0), a2, voffA);
            PG8_WAIT_V(8); PG8_WAIT_L(0); PG8_BAR; PG8_MMA(1, 0, At, B0); PG8_MMA(1, 1, At, B1); PG8_BAR; PG8_SCHED;
            PG8_LDB(B0, 1, 0); PG8_LDB(B1, 1, 1); PG8_SCHED; PG8_LDA(At, 1, 0); PG8_STAGE(PG8_SA(0, 1), a2 + hstep, voffA);
            PG8_WAIT_V(8); PG8_WAIT_L(0); PG8_BAR; PG8_MMA(0, 0, At, B0); PG8_MMA(0, 1, At, B1); PG8_BAR; PG8_SCHED;
            PG8_LDA(At, 1, 1); PG8_STAGE(PG8_SB(1, 0), b3, voffB); PG8_STAGE(PG8_SB(1, 1), b3 + hstep, voffB); PG8_STAGE(PG8_SA(1, 0), a3, voffA);
            PG8_WAIT_V(8); PG8_WAIT_L(0); PG8_BAR; PG8_MMA(1, 0, At, B0); PG8_MMA(1, 1, At, B1); PG8_BAR; PG8_SCHED;
            } else {
            PG8_LDB(B0, 0, 0); PG8_SCHED; PG8_LDA(At, 0, 0); PG8_STAGE(PG8_SA(1, 1), a1 + hstep, voffA);
            PG8_WAIT_L(8); PG8_BAR; PG8_WAIT_L(0); PG8_MMA(0, 0, At, B0); PG8_BAR; PG8_SCHED;
            PG8_LDB(B1, 0, 1); PG8_STAGE(PG8_SB(0, 0), b2, voffB);
            PG8_BAR; PG8_WAIT_L(0); PG8_MMA(0, 1, At, B1); PG8_BAR;
            PG8_LDA(At, 0, 1); PG8_STAGE(PG8_SA(0, 0), a2, voffA);
            PG8_BAR; PG8_WAIT_L(0); PG8_MMA(1, 0, At, B0); PG8_BAR; PG8_SCHED;
            PG8_STAGE(PG8_SB(0, 1), b2 + hstep, voffB);
            PG8_WAIT_V(6); PG8_BAR; PG8_MMA(1, 1, At, B1); PG8_BAR;
            PG8_LDB(B0, 1, 0); PG8_SCHED; PG8_LDA(At, 1, 0); PG8_STAGE(PG8_SA(0, 1), a2 + hstep, voffA);
            PG8_WAIT_L(8); PG8_BAR; PG8_WAIT_L(0); PG8_MMA(0, 0, At, B0); PG8_BAR; PG8_SCHED;
            PG8_LDB(B1, 1, 1); PG8_STAGE(PG8_SB(1, 0), b3, voffB);
            PG8_BAR; PG8_WAIT_L(0); PG8_MMA(0, 1, At, B1); PG8_BAR;
            PG8_LDA(At, 1, 1); PG8_STAGE(PG8_SA(1, 0), a3, voffA);
            PG8_BAR; PG8_WAIT_L(0); PG8_MMA(1, 0, At, B0); PG8_BAR; PG8_SCHED;
            PG8_STAGE(PG8_SB(1, 1), b3 + hstep, voffB);
            PG8_WAIT_V(6); PG8_BAR; PG8_MMA(1, 1, At, B1); PG8_BAR;
            }
        }
        if constexpr (ALIGN_EPI) { if (wr == 0) PG8_BAR; }
        if constexpr (!Epi::AFTER_DRAIN) { E(acc, cur, wr, wc, fr, fq); S.done(cur); }
        if (!has_next) break;
#pragma unroll
        for (int a = 0; a < 2; ++a)
#pragma unroll
            for (int b = 0; b < 2; ++b)
#pragma unroll
                for (int m = 0; m < 4; ++m)
#pragma unroll
                    for (int n = 0; n < 2; ++n) acc[a][b][m][n] = (f32x4){0.f, 0.f, 0.f, 0.f};
        cur = nxt; cA = nA; cB = nB; ++ui;
        if constexpr (ALIGN_EPI) { if (wr == 1) PG8_BAR; }
    }
    PG8_WAIT_V(0);
    if constexpr (!ALIGN_EPI) { if (wr == 0) PG8_BAR; }
    PG8_BAR;
    if constexpr (Epi::AFTER_DRAIN) { E.fused(acc, cur, wr, wc, fr, fq, lds, wid, lane); S.done(cur); }
#undef PG8_SA
#undef PG8_SB
#undef PG8_STAGE
#undef PG8_LDA
#undef PG8_LDB
#undef PG8_MMA
#undef PG8_WAIT_V
#undef PG8_WAIT_L
#undef PG8_BAR
#undef PG8_SCHED
}
}
#define GAS __attribute__((address_space(1)))
#define LAS __attribute__((address_space(3)))
typedef unsigned short bf16;
typedef unsigned v4u __attribute__((ext_vector_type(4)));
typedef float f32x4 __attribute__((ext_vector_type(4)));
typedef short bf16x8 __attribute__((ext_vector_type(8)));
typedef GAS unsigned gu32;
typedef GAS unsigned long long gu64;
#define RLX_AGENT __ATOMIC_RELAXED, __HIP_MEMORY_SCOPE_AGENT
#define LDS_WAIT() asm volatile("s_waitcnt lgkmcnt(0)" ::: "memory")
#define VM_WAIT() asm volatile("s_waitcnt vmcnt(0)" ::: "memory")
__device__ __forceinline__ unsigned long long rt() { return __builtin_amdgcn_s_memrealtime(); }
__device__ __forceinline__ unsigned f2bf(float f) { unsigned u = __builtin_bit_cast(unsigned, f); return (u + 0x7fffu + ((u >> 16) & 1u)) >> 16; }
__device__ __forceinline__ unsigned pk2(float lo, float hi) { return f2bf(lo) | (f2bf(hi) << 16); }

#define XB_TMO      128
#define XB_XCNT(j)  (256  + 64 * (j))
#define XB_XSUB(j)  (1280 + 64 * (j))
#define XB_XGEN(j)  (2304 + 64 * (j))
#define XB_TOP      3328
#define XB_TOPGEN   3392
#define XCD_BAR_WORDS 3456
#define XB_SPIN_CAP (1u << 18)

__device__ __forceinline__ unsigned xb_ld(unsigned* p)              { return __hip_atomic_load(p, __ATOMIC_RELAXED, __HIP_MEMORY_SCOPE_AGENT); }
__device__ __forceinline__ unsigned xb_add(unsigned* p, unsigned v) { return __hip_atomic_fetch_add(p, v, __ATOMIC_RELAXED, __HIP_MEMORY_SCOPE_AGENT); }
__device__ __forceinline__ unsigned xb_xcc_id() { return (unsigned)__builtin_amdgcn_s_getreg((3 << 11) | 20) & 0xFu; }
#define XB_SPIN(cond, bar) do { unsigned _sp = 0; while (cond) { __builtin_amdgcn_s_sleep(1); \
    if ((++_sp & 255u) == 0u) { if (xb_ld(&(bar)[XB_TMO])) break; if (_sp > XB_SPIN_CAP) { atomicAdd(&(bar)[XB_TMO], 1u); break; } } } } while (0)

struct XcdBarrier {
    unsigned* bar; unsigned x;
    volatile LAS unsigned* st;
};

__device__ __forceinline__ XcdBarrier xcd_barrier_post(unsigned* bar, volatile LAS unsigned* st) {
    XcdBarrier b; b.bar = bar; b.x = xb_xcc_id(); b.st = st;
    if (threadIdx.x == 0) (void)xb_add(&bar[XB_XCNT(b.x)], 1u);
    return b;
}
__device__ __forceinline__ void xcd_barrier_complete(unsigned* bar, unsigned x, unsigned& nloc, unsigned& nx) {
    const unsigned G = gridDim.x * gridDim.y * gridDim.z;
    unsigned sum, cnt, mine, sp = 0u;
    for (;;) {
        sum = 0u; cnt = 0u; mine = 0u;
#pragma unroll
        for (unsigned j = 0; j < 16; ++j) { const unsigned c = xb_ld(&bar[XB_XCNT(j)]); sum += c; cnt += (c > 0u) ? 1u : 0u; mine = (j == x) ? c : mine; }
        if (sum == G) break;
        __builtin_amdgcn_s_sleep(1);
        if ((++sp & 255u) == 0u) { if (xb_ld(&bar[XB_TMO])) break; if (sp > XB_SPIN_CAP) { atomicAdd(&bar[XB_TMO], 1u); break; } }
    }
    nloc = mine > 0u ? mine : 1u; nx = cnt > 0u ? cnt : 1u;
}

__device__ __forceinline__ void xcd_barrier(const XcdBarrier& b) {
    asm volatile("s_waitcnt vmcnt(0)" ::: "memory");
    __syncthreads();
    if (threadIdx.x == 0) {
        unsigned* bar = b.bar;
        __builtin_amdgcn_s_waitcnt(0);
        unsigned nloc = b.st[0], nx = b.st[1];
        if (nloc == 0u) { xcd_barrier_complete(bar, b.x, nloc, nx); b.st[0] = nloc; b.st[1] = nx; }
        const unsigned old = xb_add(&bar[XB_XSUB(b.x)], 1u);
        const unsigned gen = old / nloc;
        if (old + 1u == (gen + 1u) * nloc) {
            __builtin_amdgcn_fence(__ATOMIC_RELEASE, "agent");
            asm volatile("s_waitcnt vmcnt(0)" ::: "memory");
            const unsigned og = xb_add(&bar[XB_TOP], 1u);
            const unsigned tg = og / nx;
            if (og + 1u == (tg + 1u) * nx) xb_add(&bar[XB_TOPGEN], 1u);
            else XB_SPIN(xb_ld(&bar[XB_TOPGEN]) == tg, bar);
            __builtin_amdgcn_fence(__ATOMIC_ACQUIRE, "agent");
            xb_add(&bar[XB_XGEN(b.x)], 1u);
            asm volatile("s_waitcnt vmcnt(0)" ::: "memory");
        } else {
            XB_SPIN(xb_ld(&bar[XB_XGEN(b.x)]) == gen, bar);
            __builtin_amdgcn_fence(__ATOMIC_ACQUIRE, "agent");
            asm volatile("s_waitcnt vmcnt(0)" ::: "memory");
        }
    }
    __syncthreads();
}

constexpr int T = 16384, D = 1024, SEQ = 8192, NCTX = 256, TCX = 512, DIN = 3840, MH = T + TCX;
constexpr int ZU = 0, ZV = 512, ZQ = 1024, ZK = 1536, ZVA = 1664, ZGA = 1792, ZGB = 2816;
constexpr int NEXP = 256, NSLOT = 9, LISTCAP = 16384;
constexpr float LOG2E = 1.4426950408889634f;
constexpr float QSCALE = 0.125f * LOG2E;
constexpr size_t MiB = 1u << 20;
constexpr size_t WS_CTL = 0, CTL_ZERO_BYTES = 1 * MiB;
constexpr size_t WS_ADAP = 1 * MiB;
constexpr size_t WS_ADAF = 2 * MiB;
constexpr size_t WS_ROPE = 2 * MiB + 128 * 1024;
constexpr size_t WS_WST = 2 * MiB + 256 * 1024;
constexpr size_t WS_RWT = 3 * MiB;
constexpr size_t WS_WINT = 4 * MiB;
constexpr size_t WS_WAT = 12 * MiB, WS_WBT = 13 * MiB, WS_WOT = 14 * MiB;
constexpr size_t WS_KVC = 16 * MiB;
constexpr size_t WS_GATEW = 17 * MiB;
constexpr size_t WS_H = 18 * MiB;
constexpr size_t WS_Z = 52 * MiB;
constexpr size_t WS_A = 172 * MiB, WS_O = 188 * MiB;
constexpr size_t WS_TMP = 204 * MiB;
constexpr size_t WS_Y = 268 * MiB;
constexpr size_t WS_X1 = 300 * MiB;
constexpr size_t WS_H2 = 364 * MiB;
constexpr size_t WS_LIST = 396 * MiB;
constexpr size_t WS_CONTRIB = 414 * MiB;
constexpr size_t WS_END = 704 * MiB;
constexpr int CW_BAR = 4096;
constexpr int CW_CNT = 16384;
constexpr int CW_XRANK = 32768;
constexpr int SCR_BYTES = 148480;
constexpr int MISC_OFF = SCR_BYTES;
constexpr int LDS_BYTES = 152 * 1024;
constexpr int NWAVES = 8;

typedef float f32x2_t __attribute__((ext_vector_type(2)));
typedef __bf16 bf16x2_t __attribute__((ext_vector_type(2)));
typedef float f32x16 __attribute__((ext_vector_type(16)));
typedef short s16x4 __attribute__((ext_vector_type(4)));
typedef short v4i16_t __attribute__((ext_vector_type(4)));
typedef unsigned u32x2 __attribute__((ext_vector_type(2)));
typedef unsigned u32x4 __attribute__((ext_vector_type(4)));
typedef LAS unsigned char* ldsp;

__device__ __forceinline__ unsigned cvtpk(float lo, float hi) { f32x2_t v = {lo, hi}; bf16x2_t b = __builtin_convertvector(v, bf16x2_t); return __builtin_bit_cast(unsigned, b); }
__device__ __forceinline__ float bf2f(unsigned short u) { return __uint_as_float((unsigned)u << 16); }
__device__ __forceinline__ float bflo(unsigned w) { return __uint_as_float(w << 16); }
__device__ __forceinline__ float bfhi(unsigned w) { return __uint_as_float(w & 0xffff0000u); }
__device__ __forceinline__ float wave_sum(float v) {
#pragma unroll
    for (int o = 1; o < 64; o <<= 1) v += __shfl_xor(v, o);
    return v;
}
__device__ __forceinline__ float sigmoid_f(float x) { return __builtin_amdgcn_rcpf(1.f + __builtin_amdgcn_exp2f(-x * LOG2E)); }
__device__ __forceinline__ float silu_f(float x) { return x * sigmoid_f(x); }
__device__ __forceinline__ float gelu_f(float x) { const float u = 0.7978845608028654f * (x + 0.044715f * x * x * x); return x * sigmoid_f(2.f * u); }
__device__ __forceinline__ f32x16 mfma32(bf16x8 a, bf16x8 b, f32x16 c) { return __builtin_amdgcn_mfma_f32_32x32x16_bf16(a, b, c, 0, 0, 0); }
__device__ __forceinline__ f32x4 mfma16(bf16x8 a, bf16x8 b, f32x4 c) { return __builtin_amdgcn_mfma_f32_16x16x32_bf16(a, b, c, 0, 0, 0); }

struct Args { const float* in[26]; float* out; unsigned char* ws; int ph_lo, ph_hi; };
enum { I_X = 0, I_C, I_CTX, I_CCTX, I_ADAW, I_ADAB, I_N1G, I_N2G, I_WIN, I_LNG, I_LNB, I_GWS, I_GBS, I_SINK, I_WA, I_WB, I_WO, I_RW, I_RB, I_EG, I_EU, I_ED, I_SG, I_SU, I_SD, I_FG };

__device__ __forceinline__ void p0_transpose_item(const float* W, int K, int N, bf16* WT, LAS float* scr, int item, int lane) {
    const int nblk = N / 32, kb = item / nblk, nb = item % nblk, k0 = 64 * kb, n0 = 32 * nb;
#pragma unroll 8
    for (int i = 0; i < 32; ++i) { const int kk = 2 * i + (lane >> 5); scr[kk * 33 + (lane & 31)] = W[(size_t)(k0 + kk) * N + n0 + (lane & 31)]; }
    LDS_WAIT(); asm volatile("" ::: "memory");
    const int c = lane & 7;
#pragma unroll
    for (int j = 0; j < 4; ++j) { const int n = (lane >> 3) + 8 * j; const LAS float* s = scr + (8 * c) * 33 + n;
        v4u o; o.x = pk2(s[0 * 33], s[1 * 33]); o.y = pk2(s[2 * 33], s[3 * 33]); o.z = pk2(s[4 * 33], s[5 * 33]); o.w = pk2(s[6 * 33], s[7 * 33]);
        *(GAS v4u*)(WT + (size_t)(n0 + n) * K + k0 + 8 * c) = o; }
    LDS_WAIT(); asm volatile("" ::: "memory");
}

__device__ __forceinline__ void phase_prep(const Args& a, ldsp lds, int G) {
    const int tid = threadIdx.x, lane = tid & 63, wave = __builtin_amdgcn_readfirstlane(tid >> 6), blk = blockIdx.x;
    unsigned char* ws = a.ws;
    if (blk < 192) {
        const int cb = blk % 24, kc = blk / 24, col = cb * 256 + lane * 4, k0 = kc * 128 + wave * 16;
        const float* c = a.in[I_C]; const float* cc = a.in[I_CCTX]; const float* aw = a.in[I_ADAW];
        f32x4 a0 = {0.f, 0.f, 0.f, 0.f}, a1 = a0, a2 = a0;
#pragma unroll 4
        for (int k = 0; k < 16; ++k) {
            const int kk = k0 + k;
            const float s0 = silu_f(c[kk]), s1 = silu_f(c[1024 + kk]), s2 = silu_f(cc[kk]);
            const f32x4 w = *(const f32x4*)(aw + (size_t)kk * 6144 + col);
            a0 += w * s0; a1 += w * s1; a2 += w * s2;
        }
        LAS float* red = (LAS float*)lds;
        *(LAS f32x4*)(red + (wave * 3 + 0) * 256 + lane * 4) = a0;
        *(LAS f32x4*)(red + (wave * 3 + 1) * 256 + lane * 4) = a1;
        *(LAS f32x4*)(red + (wave * 3 + 2) * 256 + lane * 4) = a2;
        __syncthreads();
        float* adap = (float*)(ws + WS_ADAP);
        for (int idx = tid; idx < 768; idx += 512) {
            const int v = idx >> 8, cl = idx & 255; float s = 0.f;
#pragma unroll
            for (int w = 0; w < 8; ++w) s += red[(w * 3 + v) * 256 + cl];
            adap[(size_t)(kc * 3 + v) * 6144 + cb * 256 + cl] = s;
        }
        __syncthreads();
    }
    {
        LAS float* scr = (LAS float*)(lds + wave * 8704);
        const int gw = blk * NWAVES + wave, NGW = G * NWAVES;
        constexpr int I_1 = 16 * 120, I_2 = 8 * 32, I_3 = 8 * 32, I_4 = 16 * 32, I_5 = 16 * 8;
        for (int it = gw; it < I_1 + I_2 + I_3 + I_4 + I_5; it += NGW) {
            int r = it;
            if (r < I_1) { p0_transpose_item(a.in[I_WIN], 1024, 3840, (bf16*)(ws + WS_WINT), scr, r, lane); continue; } r -= I_1;
            if (r < I_2) { p0_transpose_item(a.in[I_WA], 512, 1024, (bf16*)(ws + WS_WAT), scr, r, lane); continue; } r -= I_2;
            if (r < I_3) { p0_transpose_item(a.in[I_WB], 512, 1024, (bf16*)(ws + WS_WBT), scr, r, lane); continue; } r -= I_3;
            if (r < I_4) { p0_transpose_item(a.in[I_WO], 1024, 1024, (bf16*)(ws + WS_WOT), scr, r, lane); continue; } r -= I_4;
            p0_transpose_item(a.in[I_RW], 1024, 256, (bf16*)(ws + WS_RWT), scr, r, lane);
        }
    }
    {
        const int gt = blk * 512 + tid, NT = G * 512;
        const float* gws = a.in[I_GWS]; bf16* wst = (bf16*)(ws + WS_WST);
        for (int i = gt; i < 8192; i += NT) {
            const f32x4 x0 = *(const f32x4*)(gws + i * 8), x1 = *(const f32x4*)(gws + i * 8 + 4);
            v4u o; o.x = cvtpk(x0[0], x0[1]); o.y = cvtpk(x0[2], x0[3]); o.z = cvtpk(x1[0], x1[1]); o.w = cvtpk(x1[2], x1[3]);
            *(v4u*)(wst + i * 8) = o;
        }
        float* rope = (float*)(ws + WS_ROPE);
        for (int i = gt; i < 2048; i += NT) {
            const int pos = i >> 4, f = i & 15;
            const float inv = __builtin_amdgcn_exp2f(-(float)f * (13.287712379549449f / 16.f));
            const float ang = (float)pos * inv;
            double rev = (double)ang * 0.15915494309189535; rev -= floor(rev);
            rope[pos * 32 + f] = __builtin_amdgcn_cosf((float)rev);
            rope[pos * 32 + 16 + f] = __builtin_amdgcn_sinf((float)rev);
        }
    }
}

__device__ __forceinline__ void phase_hnorm(const Args& a, ldsp lds, int G) {
    const int tid = threadIdx.x, lane = tid & 63, wave = __builtin_amdgcn_readfirstlane(tid >> 6), blk = blockIdx.x;
    unsigned char* ws = a.ws;
    const float* adap = (const float*)(ws + WS_ADAP); const float* adab = a.in[I_ADAB];
    LAS float* modv = (LAS float*)lds;
    for (int idx = tid; idx < 3 * 2048; idx += 512) {
        const int v = idx >> 11, j = idx & 2047; float s = adab[j];
#pragma unroll
        for (int kc = 0; kc < 8; ++kc) s += adap[(size_t)(kc * 3 + v) * 6144 + j];
        modv[idx] = (j >= 1024) ? s + 1.f : s;
    }
    { float* adaf = (float*)(ws + WS_ADAF);
      for (int idx = blk * 512 + tid; idx < 3 * 6144; idx += G * 512) {
          const int v = idx / 6144, j = idx % 6144; float s = adab[j];
#pragma unroll
          for (int kc = 0; kc < 8; ++kc) s += adap[(size_t)(kc * 3 + v) * 6144 + j];
          adaf[idx] = s; } }
    __syncthreads();
    const float* g1 = a.in[I_N1G]; bf16* H = (bf16*)(ws + WS_H);
    for (int t = blk * NWAVES + wave; t < MH; t += G * NWAVES) {
        const float* xr = (t < T) ? a.in[I_X] + (size_t)t * D : a.in[I_CTX] + (size_t)(t - T) * D;
        const int v = (t < T) ? (t >> 13) : 2;
        f32x4 x[4]; float ss = 0.f;
#pragma unroll
        for (int j = 0; j < 4; ++j) { x[j] = *(const f32x4*)(xr + 4 * lane + 256 * j); ss += (x[j][0] * x[j][0] + x[j][1] * x[j][1]) + (x[j][2] * x[j][2] + x[j][3] * x[j][3]); }
        const float r = rsqrtf(wave_sum(ss) * (1.f / D) + 1e-6f);
#pragma unroll
        for (int j = 0; j < 4; ++j) {
            const int col = 4 * lane + 256 * j;
            const f32x4 g = *(const f32x4*)(g1 + col);
            const f32x4 sh = *(LAS f32x4*)(modv + v * 2048 + col), sc = *(LAS f32x4*)(modv + v * 2048 + 1024 + col);
            const f32x4 h = (x[j] * r) * g * sc + sh;
            u32x2 o; o.x = cvtpk(h[0], h[1]); o.y = cvtpk(h[2], h[3]);
            *(u32x2*)(H + (size_t)t * D + col) = o;
        }
    }
}

struct WinOrder {
    pg8::StaticOrder so;
    __device__ void init(int G, int c) { so.init(T, DIN, G, c); }
    __device__ bool next(int i, pg8::Unit& u) const {
        const long L = (long)i * so.G + so.c;
        if (L < 960) return so.next(i, u);
        if (L < 962) { u.pm = 64 + (int)(L - 960); u.pn = 6; return true; }
        return false;
    }
    __device__ __forceinline__ void a_ready(const pg8::Unit&) const {}
    __device__ __forceinline__ void done(const pg8::Unit&) const {}
};
struct EpiWin {
    static constexpr bool PERM = false, AFTER_DRAIN = false;
    bf16* Z; bf16* KVC; const float* rope;
    __device__ __forceinline__ void operator()(const pg8::f32x4 (&acc)[2][2][4][2], const pg8::Unit& u, int wr, int wc, int fr, int fq) const {
        const int row0 = u.pm * 256 + wr * 64 + fr, colb = u.pn * 256 + wc * 32 + 4 * fq, pn = u.pn;
        if (u.pm >= 64) {
#pragma unroll
            for (int ai = 0; ai < 2; ++ai)
#pragma unroll
                for (int m = 0; m < 4; ++m) { bf16* rp = KVC + (size_t)(row0 + ai * 128 + m * 16 - T) * 256 + (colb - ZK);
#pragma unroll
                    for (int bj = 0; bj < 2; ++bj)
#pragma unroll
                        for (int n = 0; n < 2; ++n) { const pg8::f32x4 v = acc[ai][bj][m][n]; u32x2 o; o.x = cvtpk(v[0], v[1]); o.y = cvtpk(v[2], v[3]); *(u32x2*)(rp + bj * 128 + n * 16) = o; } }
            return;
        }
#pragma unroll
        for (int ai = 0; ai < 2; ++ai)
#pragma unroll
            for (int m = 0; m < 4; ++m) {
                const int r = row0 + ai * 128 + m * 16; bf16* rp = Z + (size_t)r * DIN + colb;
                if (pn <= 3) {
#pragma unroll
                    for (int bj = 0; bj < 2; ++bj)
#pragma unroll
                        for (int n = 0; n < 2; ++n) { const pg8::f32x4 v = acc[ai][bj][m][n]; u32x2 o; o.x = cvtpk(gelu_f(v[0]), gelu_f(v[1])); o.y = cvtpk(gelu_f(v[2]), gelu_f(v[3])); *(u32x2*)(rp + bj * 128 + n * 16) = o; }
                } else if (pn <= 6) {
                    const int pos = (wc & 1) ? (r & 63) : ((r & 8191) >> 6);
                    const pg8::f32x4 cs = *(const pg8::f32x4*)(rope + pos * 32 + 4 * fq), sn = *(const pg8::f32x4*)(rope + pos * 32 + 16 + 4 * fq);
                    const float sc = (pn < 6) ? QSCALE : 1.f;
#pragma unroll
                    for (int bj = 0; bj < 2; ++bj) {
                        const pg8::f32x4 x1 = acc[ai][bj][m][0], x2 = acc[ai][bj][m][1];
                        pg8::f32x4 o1, o2;
                        if (pn == 6 && bj == 1) { o1 = x1; o2 = x2; }
                        else { o1 = (x1 * cs - x2 * sn) * sc; o2 = (x2 * cs + x1 * sn) * sc; }
                        u32x2 w1, w2; w1.x = cvtpk(o1[0], o1[1]); w1.y = cvtpk(o1[2], o1[3]); w2.x = cvtpk(o2[0], o2[1]); w2.y = cvtpk(o2[2], o2[3]);
                        *(u32x2*)(rp + bj * 128) = w1; *(u32x2*)(rp + bj * 128 + 16) = w2;
                    }
                } else {
#pragma unroll
                    for (int bj = 0; bj < 2; ++bj)
#pragma unroll
                        for (int n = 0; n < 2; ++n) { const pg8::f32x4 v = acc[ai][bj][m][n]; u32x2 o; o.x = cvtpk(sigmoid_f(v[0]), sigmoid_f(v[1])); o.y = cvtpk(sigmoid_f(v[2]), sigmoid_f(v[3])); *(u32x2*)(rp + bj * 128 + n * 16) = o; }
                }
            }
    }
};
struct EpiMergeA {
    static constexpr bool PERM = true, AFTER_DRAIN = false;
    const bf16* Z; bf16* Y;
    __device__ __forceinline__ void operator()(const pg8::f32x4 (&acc)[2][2][4][2], const pg8::Unit& u, int wr, int wc, int fr, int fq) const {
        const int row0 = u.pm * 256 + wr * 64 + fr, col0 = u.pn * 256 + wc * 32 + 8 * fq;
#pragma unroll
        for (int ai = 0; ai < 2; ++ai)
#pragma unroll
            for (int m = 0; m < 4; ++m) { const int r = row0 + ai * 128 + m * 16;
#pragma unroll
                for (int bj = 0; bj < 2; ++bj) { const int c = col0 + bj * 128;
                    const u32x4 g = *(const u32x4*)(Z + (size_t)r * DIN + ZGA + c);
                    const pg8::f32x4 v0 = acc[ai][bj][m][0], v1 = acc[ai][bj][m][1];
                    u32x4 o;
                    o.x = cvtpk(v0[0] * bflo(g.x), v0[1] * bfhi(g.x)); o.y = cvtpk(v0[2] * bflo(g.y), v0[3] * bfhi(g.y));
                    o.z = cvtpk(v1[0] * bflo(g.z), v1[1] * bfhi(g.z)); o.w = cvtpk(v1[2] * bflo(g.w), v1[3] * bfhi(g.w));
                    *(u32x4*)(Y + (size_t)r * D + c) = o; } }
    }
};
struct EpiMergeB {
    static constexpr bool PERM = true, AFTER_DRAIN = false;
    const bf16* Z; bf16* Y;
    __device__ __forceinline__ void operator()(const pg8::f32x4 (&acc)[2][2][4][2], const pg8::Unit& u, int wr, int wc, int fr, int fq) const {
        const int row0 = u.pm * 256 + wr * 64 + fr, col0 = u.pn * 256 + wc * 32 + 8 * fq;
#pragma unroll
        for (int ai = 0; ai < 2; ++ai)
#pragma unroll
            for (int m = 0; m < 4; ++m) { const int r = row0 + ai * 128 + m * 16;
#pragma unroll
                for (int bj = 0; bj < 2; ++bj) { const int c = col0 + bj * 128;
                    const u32x4 g = *(const u32x4*)(Z + (size_t)r * DIN + ZGB + c);
                    const u32x4 tp = *(const u32x4*)(Y + (size_t)r * D + c);
                    const pg8::f32x4 t0 = {bflo(tp.x), bfhi(tp.x), bflo(tp.y), bfhi(tp.y)}, t1 = {bflo(tp.z), bfhi(tp.z), bflo(tp.w), bfhi(tp.w)};
                    const pg8::f32x4 v0 = acc[ai][bj][m][0], v1 = acc[ai][bj][m][1];
                    u32x4 o;
                    o.x = cvtpk(t0[0] + v0[0] * bflo(g.x), t0[1] + v0[1] * bfhi(g.x)); o.y = cvtpk(t0[2] + v0[2] * bflo(g.y), t0[3] + v0[3] * bfhi(g.y));
                    o.z = cvtpk(t1[0] + v1[0] * bflo(g.z), t1[1] + v1[1] * bfhi(g.z)); o.w = cvtpk(t1[2] + v1[2] * bflo(g.w), t1[3] + v1[3] * bfhi(g.w));
                    *(u32x4*)(Y + (size_t)r * D + c) = o; } }
    }
};
struct EpiWo {
    static constexpr bool PERM = true, AFTER_DRAIN = false;
    const float* x; const float* adaf; float* X1;
    __device__ __forceinline__ void operator()(const pg8::f32x4 (&acc)[2][2][4][2], const pg8::Unit& u, int wr, int wc, int fr, int fq) const {
        const int row0 = u.pm * 256 + wr * 64 + fr, col0 = u.pn * 256 + wc * 32 + 8 * fq;
        const float* g1 = adaf + (u.pm >= 32 ? 6144 : 0) + 2048;
#pragma unroll
        for (int bj = 0; bj < 2; ++bj) { const int c = col0 + bj * 128;
            const pg8::f32x4 ga = *(const pg8::f32x4*)(g1 + c), gb = *(const pg8::f32x4*)(g1 + c + 4);
#pragma unroll
            for (int ai = 0; ai < 2; ++ai)
#pragma unroll
                for (int m = 0; m < 4; ++m) { const int r = row0 + ai * 128 + m * 16;
                    const pg8::f32x4 x0 = *(const pg8::f32x4*)(x + (size_t)r * D + c), x1 = *(const pg8::f32x4*)(x + (size_t)r * D + c + 4);
                    *(pg8::f32x4*)(X1 + (size_t)r * D + c) = x0 + ga * acc[ai][bj][m][0];
                    *(pg8::f32x4*)(X1 + (size_t)r * D + c + 4) = x1 + gb * acc[ai][bj][m][1]; } }
    }
};


__device__ __forceinline__ s16x4 vtr(LAS const unsigned char* p) { return __builtin_bit_cast(s16x4, __builtin_amdgcn_ds_read_tr16_b64_v4i16((LAS v4i16_t*)p)); }

__device__ __forceinline__ void attn_item(const bf16* Z, const bf16* KVC, const float* sink, bf16* Obuf, ldsp lds, int b, int nb, int hk, int qh) {
    const int tid = threadIdx.x, lane = tid & 63, wave = __builtin_amdgcn_readfirstlane(tid >> 6), r32 = lane & 31, hi = lane >> 5;
    const int rq = wave >> 1, head = hk * 4 + rq;
    const int iq = qh * 64 + (wave & 1) * 32 + r32;
    const int wlo = (nb == 0) ? 2 : qh, whi = (nb == 63) ? 4 : 5 + qh, nwin = whi - wlo, ntile = nwin + 4;
    const int tokq = b * SEQ + nb * 128 + iq;
    bf16x8 qr[4];
#pragma unroll
    for (int d0 = 0; d0 < 4; ++d0) qr[d0] = *(const bf16x8*)(Z + (size_t)tokq * DIN + ZQ + head * 64 + d0 * 16 + hi * 8);
    float mrun = sink[head] * LOG2E, lrun = (hi == 0) ? 1.f : 0.f;
    f32x16 o[2];
#pragma unroll
    for (int j = 0; j < 2; ++j)
#pragma unroll
        for (int r = 0; r < 16; ++r) o[j][r] = 0.f;
    const int kdst = wave * 1024 + lane * 16, vdst = 8192 + (wave >> 2) * 4096 + lane * 64 + (wave & 3) * 16;
#define ATT_SRC(s, kp, vp) do { const int tl_ = (s) < nwin ? wlo + (s) : 6 + (s) - nwin; \
        if (tl_ < 6) { const int tok_ = b * SEQ + (nb - 1 + (tl_ >> 1)) * 128 + (tl_ & 1) * 64 + lane; kp = Z + (size_t)tok_ * DIN + ZK + hk * 64 + wave * 8; vp = Z + (size_t)tok_ * DIN + ZVA + hk * 64 + wave * 8; } \
        else { const int row_ = b * NCTX + (tl_ - 6) * 64 + lane; kp = KVC + (size_t)row_ * 256 + hk * 64 + wave * 8; vp = KVC + (size_t)row_ * 256 + 128 + hk * 64 + wave * 8; } } while (0)
    u32x4 kreg, vreg;
    { const bf16 *kp, *vp; ATT_SRC(0, kp, vp); kreg = *(const u32x4*)kp; vreg = *(const u32x4*)vp; }
    *(LAS u32x4*)(lds + kdst) = kreg; *(LAS u32x4*)(lds + vdst) = vreg;
    __syncthreads();
    const int vrd = ((lane & 15) >> 2) * 64 + ((lane >> 4) & 1) * 32 + (lane & 3) * 8 + hi * 256;
    for (int s = 0; s < ntile; ++s) {
        const int base = (s & 1) * 16384;
        const int tl = s < nwin ? wlo + s : 6 + s - nwin;
        if (s + 1 < ntile) { const bf16 *kp, *vp; ATT_SRC(s + 1, kp, vp); kreg = *(const u32x4*)kp; vreg = *(const u32x4*)vp; }
        {
            f32x16 p0, p1;
#pragma unroll
            for (int r = 0; r < 16; ++r) { p0[r] = 0.f; p1[r] = 0.f; }
#pragma unroll
            for (int d0 = 0; d0 < 4; ++d0) {
                const bf16x8 k0 = *(LAS const bf16x8*)(lds + base + (2 * d0 + hi) * 1024 + r32 * 16);
                const bf16x8 k1 = *(LAS const bf16x8*)(lds + base + (2 * d0 + hi) * 1024 + (r32 + 32) * 16);
                p0 = mfma32(k0, qr[d0], p0); p1 = mfma32(k1, qr[d0], p1);
            }
            if (tl < 2) {
                const int j0 = (tl & 1) * 64 + 4 * hi;
#pragma unroll
                for (int r = 0; r < 16; ++r) { const int j = j0 + (r & 3) + 8 * (r >> 2); if (j < iq) p0[r] = -INFINITY; if (j + 32 < iq) p1[r] = -INFINITY; }
            } else if (tl == 4 || tl == 5) {
                const int j0 = (tl & 1) * 64 + 4 * hi;
#pragma unroll
                for (int r = 0; r < 16; ++r) { const int j = j0 + (r & 3) + 8 * (r >> 2); if (j > iq) p0[r] = -INFINITY; if (j + 32 > iq) p1[r] = -INFINITY; }
            }
            float mx = fmaxf(p0[0], p1[0]);
#pragma unroll
            for (int r = 1; r < 16; ++r) mx = fmaxf(mx, fmaxf(p0[r], p1[r]));
            mx = fmaxf(mx, __shfl_xor(mx, 32));
            const float mn = fmaxf(mrun, mx), alpha = __builtin_amdgcn_exp2f(mrun - mn);
            mrun = mn;
            float rs = 0.f;
#pragma unroll
            for (int r = 0; r < 16; ++r) { p0[r] = __builtin_amdgcn_exp2f(p0[r] - mn); p1[r] = __builtin_amdgcn_exp2f(p1[r] - mn); rs += p0[r] + p1[r]; }
            lrun = lrun * alpha + rs;
#pragma unroll
            for (int r = 0; r < 16; ++r) { o[0][r] *= alpha; o[1][r] *= alpha; }
            bf16x8 pf[4];
#pragma unroll
            for (int s4 = 0; s4 < 4; ++s4) {
                u32x4 w;
                if (s4 < 2) { w.x = cvtpk(p0[8 * s4 + 0], p0[8 * s4 + 1]); w.y = cvtpk(p0[8 * s4 + 2], p0[8 * s4 + 3]); w.z = cvtpk(p0[8 * s4 + 4], p0[8 * s4 + 5]); w.w = cvtpk(p0[8 * s4 + 6], p0[8 * s4 + 7]); }
                else { const int q = s4 - 2; w.x = cvtpk(p1[8 * q + 0], p1[8 * q + 1]); w.y = cvtpk(p1[8 * q + 2], p1[8 * q + 3]); w.z = cvtpk(p1[8 * q + 4], p1[8 * q + 5]); w.w = cvtpk(p1[8 * q + 6], p1[8 * q + 7]); }
                pf[s4] = __builtin_bit_cast(bf16x8, w);
            }
#pragma unroll
            for (int dblk = 0; dblk < 2; ++dblk)
#pragma unroll
                for (int s4 = 0; s4 < 4; ++s4) {
                    const s16x4 lo = vtr(lds + base + 8192 + dblk * 4096 + vrd + (16 * s4) * 64);
                    const s16x4 hh = vtr(lds + base + 8192 + dblk * 4096 + vrd + (16 * s4 + 8) * 64);
                    const bf16x8 vf = {lo[0], lo[1], lo[2], lo[3], hh[0], hh[1], hh[2], hh[3]};
                    o[dblk] = mfma32(vf, pf[s4], o[dblk]);
                }
        }
        if (s + 1 < ntile) { *(LAS u32x4*)(lds + (16384 - base) + kdst) = kreg; *(LAS u32x4*)(lds + (16384 - base) + vdst) = vreg; }
        __syncthreads();
    }
#undef ATT_SRC
    {
        const float lt = lrun + __shfl_xor(lrun, 32), inv = 1.f / lt;
        bf16* op = Obuf + (size_t)tokq * 512 + head * 64;
#pragma unroll
        for (int dblk = 0; dblk < 2; ++dblk)
#pragma unroll
            for (int r4 = 0; r4 < 4; ++r4) {
                u32x2 w; w.x = cvtpk(o[dblk][4 * r4] * inv, o[dblk][4 * r4 + 1] * inv); w.y = cvtpk(o[dblk][4 * r4 + 2] * inv, o[dblk][4 * r4 + 3] * inv);
                *(u32x2*)(op + 32 * dblk + 8 * r4 + 4 * hi) = w;
            }
    }
}

__device__ __forceinline__ void gmlp_item(const bf16* Z, const float* lng, const float* lnb, const bf16* WsT, const float* bs, bf16* Abuf, ldsp lds, int ch, int g) {
    const int tid = threadIdx.x, lane = tid & 63, wave = __builtin_amdgcn_readfirstlane(tid >> 6), fr = lane & 15, fq = lane >> 4;
    const int tok0 = ch * 128;
    LAS bf16* VT = (LAS bf16*)lds;
    f32x4 gA = *(const f32x4*)(lng + lane * 8), gB = *(const f32x4*)(lng + lane * 8 + 4), bA = *(const f32x4*)(lnb + lane * 8), bB = *(const f32x4*)(lnb + lane * 8 + 4);
#pragma unroll
    for (int rnd = 0; rnd < 2; ++rnd) {
        float y[8][8];
#pragma unroll
        for (int j = 0; j < 8; ++j) {
            const int tok = tok0 + wave * 16 + rnd * 8 + j;
            const u32x4 raw = *(const u32x4*)(Z + (size_t)tok * DIN + ZV + lane * 8);
            float x[8] = {bflo(raw.x), bfhi(raw.x), bflo(raw.y), bfhi(raw.y), bflo(raw.z), bfhi(raw.z), bflo(raw.w), bfhi(raw.w)};
            float s = 0.f;
#pragma unroll
            for (int i = 0; i < 8; ++i) s += x[i];
            const float mu = wave_sum(s) * (1.f / 512.f);
            float q = 0.f;
#pragma unroll
            for (int i = 0; i < 8; ++i) { x[i] -= mu; q += x[i] * x[i]; }
            const float rstd = rsqrtf(wave_sum(q) * (1.f / 512.f) + 1e-6f);
            y[j][0] = x[0] * rstd * gA[0] + bA[0]; y[j][1] = x[1] * rstd * gA[1] + bA[1]; y[j][2] = x[2] * rstd * gA[2] + bA[2]; y[j][3] = x[3] * rstd * gA[3] + bA[3];
            y[j][4] = x[4] * rstd * gB[0] + bB[0]; y[j][5] = x[5] * rstd * gB[1] + bB[1]; y[j][6] = x[6] * rstd * gB[2] + bB[2]; y[j][7] = x[7] * rstd * gB[3] + bB[3];
        }
        if ((lane >> 4) == g) {
#pragma unroll
            for (int i = 0; i < 8; ++i) {
                u32x4 w; w.x = cvtpk(y[0][i], y[1][i]); w.y = cvtpk(y[2][i], y[3][i]); w.z = cvtpk(y[4][i], y[5][i]); w.w = cvtpk(y[6][i], y[7][i]);
                *(LAS u32x4*)(VT + (8 * (lane & 15) + i) * 136 + wave * 16 + rnd * 8) = w;
            }
        }
    }
    __syncthreads();
    const int wm = wave >> 1, wn = wave & 1;
    f32x4 acc[2][4];
#pragma unroll
    for (int m = 0; m < 2; ++m)
#pragma unroll
        for (int n = 0; n < 4; ++n) acc[m][n] = (f32x4){0.f, 0.f, 0.f, 0.f};
#pragma unroll
    for (int ks = 0; ks < 4; ++ks) {
        bf16x8 af[2], bfr[4];
#pragma unroll
        for (int m = 0; m < 2; ++m) af[m] = *(const bf16x8*)(WsT + (size_t)g * 16384 + (32 * wm + 16 * m + fr) * 128 + 32 * ks + 8 * fq);
#pragma unroll
        for (int n = 0; n < 4; ++n) bfr[n] = *(LAS const bf16x8*)(VT + (64 * wn + 16 * n + fr) * 136 + 32 * ks + 8 * fq);
#pragma unroll
        for (int m = 0; m < 2; ++m)
#pragma unroll
            for (int n = 0; n < 4; ++n) acc[m][n] = mfma16(af[m], bfr[n], acc[m][n]);
    }
#pragma unroll
    for (int m = 0; m < 2; ++m)
#pragma unroll
        for (int reg = 0; reg < 4; ++reg) {
            const int p = 32 * wm + 16 * m + 4 * fq + reg, tok = tok0 + p; const float bias = bs[g * 128 + p];
#pragma unroll
            for (int n = 0; n < 4; ++n) {
                const int c = g * 128 + 64 * wn + 16 * n + fr;
                const float uu = bf2f(Z[(size_t)tok * DIN + ZU + c]);
                Abuf[(size_t)tok * 512 + c] = (bf16)(cvtpk(uu * (acc[m][n][reg] + bias), 0.f) & 0xffffu);
            }
        }
    __syncthreads();
}

__device__ __forceinline__ void phase_mixers(const Args& a, ldsp lds, int G, int vcu) {
    unsigned char* ws = a.ws;
    const bf16* Z = (const bf16*)(ws + WS_Z);
    for (int it = vcu; it < 512; it += G) {
        const int qh = it & 1, hk = (it >> 1) & 1, nb = (it >> 2) & 63, b = it >> 8;
        attn_item(Z, (const bf16*)(ws + WS_KVC), a.in[I_SINK], (bf16*)(ws + WS_O), lds, b, nb, hk, qh);
    }
    for (int it = vcu; it < 512; it += G) {
        gmlp_item(Z, a.in[I_LNG], a.in[I_LNB], (const bf16*)(ws + WS_WST), a.in[I_GBS], (bf16*)(ws + WS_A), lds, it >> 2, it & 3);
    }
}

#define KI_BEFORE(ka, ia, kb, ib) (((ka) > (kb)) || ((ka) == (kb) && (ia) < (ib)))
#define KI_CAS(K, I, p, q) do { const bool sw_ = KI_BEFORE(K[q], I[q], K[p], I[p]); const float kp_ = sw_ ? K[q] : K[p], kq_ = sw_ ? K[p] : K[q]; const int ip_ = sw_ ? I[q] : I[p], iq_ = sw_ ? I[p] : I[q]; \
        K[p] = kp_; I[p] = ip_; K[q] = kq_; I[q] = iq_; } while (0)
#define KI_SORT8(K, I) do { KI_CAS(K, I, 0, 1); KI_CAS(K, I, 2, 3); KI_CAS(K, I, 4, 5); KI_CAS(K, I, 6, 7); \
        KI_CAS(K, I, 0, 2); KI_CAS(K, I, 1, 3); KI_CAS(K, I, 4, 6); KI_CAS(K, I, 5, 7); \
        KI_CAS(K, I, 1, 2); KI_CAS(K, I, 5, 6); KI_CAS(K, I, 0, 4); KI_CAS(K, I, 3, 7); \
        KI_CAS(K, I, 1, 5); KI_CAS(K, I, 2, 6); KI_CAS(K, I, 1, 4); KI_CAS(K, I, 3, 6); \
        KI_CAS(K, I, 2, 4); KI_CAS(K, I, 3, 5); KI_CAS(K, I, 3, 4); } while (0)
#define KI_MERGE8(KA, IA, KB, IB) do { \
        _Pragma("unroll") for (int r_ = 0; r_ < 8; ++r_) { const bool tb_ = KI_BEFORE(KB[7 - r_], IB[7 - r_], KA[r_], IA[r_]); KA[r_] = tb_ ? KB[7 - r_] : KA[r_]; IA[r_] = tb_ ? IB[7 - r_] : IA[r_]; } \
        KI_CAS(KA, IA, 0, 4); KI_CAS(KA, IA, 1, 5); KI_CAS(KA, IA, 2, 6); KI_CAS(KA, IA, 3, 7); \
        KI_CAS(KA, IA, 0, 2); KI_CAS(KA, IA, 1, 3); KI_CAS(KA, IA, 4, 6); KI_CAS(KA, IA, 5, 7); \
        KI_CAS(KA, IA, 0, 1); KI_CAS(KA, IA, 2, 3); KI_CAS(KA, IA, 4, 5); KI_CAS(KA, IA, 6, 7); } while (0)
__device__ __forceinline__ void router_item(const Args& a, ldsp lds, int it) {
    const int tid = threadIdx.x, lane = tid & 63, wave = __builtin_amdgcn_readfirstlane(tid >> 6), fr = lane & 15, fq = lane >> 4;
    unsigned char* ws = a.ws;
    const int t0 = it * 64, b = t0 >> 13;
    const float* X1 = (const float*)(ws + WS_X1); const float* adaf = (const float*)(ws + WS_ADAF) + b * 6144;
    const float* g2 = a.in[I_N2G]; bf16* H2 = (bf16*)(ws + WS_H2);
    {
        f32x4 gm[2][2], sh[2][2];
#pragma unroll
        for (int j = 0; j < 2; ++j)
#pragma unroll
            for (int h = 0; h < 2; ++h) {
                const int c = 8 * lane + 512 * j + 4 * h;
                const f32x4 gg = *(const f32x4*)(g2 + c), sc = *(const f32x4*)(adaf + 4 * 1024 + c);
                gm[j][h] = gg * (sc + 1.f); sh[j][h] = *(const f32x4*)(adaf + 3 * 1024 + c);
            }
#pragma unroll
        for (int half = 0; half < 2; ++half) {
            f32x4 x[4][2][2];
#pragma unroll
            for (int tt = 0; tt < 4; ++tt)
#pragma unroll
                for (int j = 0; j < 2; ++j)
#pragma unroll
                    for (int h = 0; h < 2; ++h) x[tt][j][h] = *(const f32x4*)(X1 + (size_t)(t0 + wave * 8 + half * 4 + tt) * D + 8 * lane + 512 * j + 4 * h);
#pragma unroll
            for (int tt = 0; tt < 4; ++tt) {
                const int row = wave * 8 + half * 4 + tt, tok = t0 + row;
                float ss = 0.f;
#pragma unroll
                for (int j = 0; j < 2; ++j)
#pragma unroll
                    for (int h = 0; h < 2; ++h) { const f32x4 v = x[tt][j][h]; ss += (v[0] * v[0] + v[1] * v[1]) + (v[2] * v[2] + v[3] * v[3]); }
                const float r = rsqrtf(wave_sum(ss) * (1.f / D) + 1e-6f);
#pragma unroll
                for (int j = 0; j < 2; ++j) {
                    const f32x4 h0 = (x[tt][j][0] * r) * gm[j][0] + sh[j][0], h1 = (x[tt][j][1] * r) * gm[j][1] + sh[j][1];
                    u32x4 w; w.x = cvtpk(h0[0], h0[1]); w.y = cvtpk(h0[2], h0[3]); w.z = cvtpk(h1[0], h1[1]); w.w = cvtpk(h1[2], h1[3]);
                    *(u32x4*)(H2 + (size_t)tok * D + 8 * lane + 512 * j) = w;
                    const int kc = lane + 64 * j;
                    *(LAS u32x4*)(lds + kc * 1024 + ((row ^ (kc & 7)) * 16)) = w;
                }
            }
        }
    }
    __syncthreads();
    f32x4 acc[4][2];
#pragma unroll
    for (int m = 0; m < 4; ++m)
#pragma unroll
        for (int n = 0; n < 2; ++n) acc[m][n] = (f32x4){0.f, 0.f, 0.f, 0.f};
    const bf16* RwT = (const bf16*)(ws + WS_RWT) + (size_t)(32 * wave + fr) * D + 8 * fq;
#pragma unroll 8
    for (int ks = 0; ks < 32; ++ks) {
        const int kc = 4 * ks + fq;
        bf16x8 af[4], bfr[2];
#pragma unroll
        for (int n = 0; n < 2; ++n) bfr[n] = *(const bf16x8*)(RwT + (size_t)(16 * n) * D + 32 * ks);
#pragma unroll
        for (int m = 0; m < 4; ++m) af[m] = *(LAS const bf16x8*)(lds + kc * 1024 + (((16 * m + fr) ^ (kc & 7)) * 16));
#pragma unroll
        for (int m = 0; m < 4; ++m)
#pragma unroll
            for (int n = 0; n < 2; ++n) acc[m][n] = mfma16(af[m], bfr[n], acc[m][n]);
    }
    __syncthreads();
    LAS float* LG = (LAS float*)lds;
#pragma unroll
    for (int m = 0; m < 4; ++m)
#pragma unroll
        for (int n = 0; n < 2; ++n)
#pragma unroll
            for (int reg = 0; reg < 4; ++reg) LG[(32 * wave + 16 * n + fr) * 65 + 16 * m + 4 * fq + reg] = acc[m][n][reg];
    __syncthreads();
    LAS float* CK = (LAS float*)(lds + 69632); LAS int* CI = (LAS int*)(lds + 69632 + 16384);
    const float* rb = a.in[I_RB];
    float bk[8]; int bi[8];
#pragma unroll
    for (int q = 0; q < 4; ++q) {
        float gk[8]; int gi[8];
#pragma unroll
        for (int j = 0; j < 8; ++j) { const int e = 32 * wave + 8 * q + j; gk[j] = sigmoid_f(LG[e * 65 + lane]) + rb[e]; gi[j] = e; }
        KI_SORT8(gk, gi);
        if (q == 0) {
#pragma unroll
            for (int j = 0; j < 8; ++j) { bk[j] = gk[j]; bi[j] = gi[j]; }
        } else KI_MERGE8(bk, bi, gk, gi);
    }
#pragma unroll
    for (int r = 0; r < 8; ++r) { CK[(wave * 8 + r) * 64 + lane] = bk[r]; CI[(wave * 8 + r) * 64 + lane] = bi[r]; }
    __syncthreads();
#define RT_LEVEL(lvl) do { if ((wave & (2 * (lvl) - 1)) == 0) { float ok_[8]; int oi_[8]; \
            _Pragma("unroll") for (int r = 0; r < 8; ++r) { ok_[r] = CK[((wave + (lvl)) * 8 + r) * 64 + lane]; oi_[r] = CI[((wave + (lvl)) * 8 + r) * 64 + lane]; } \
            KI_MERGE8(bk, bi, ok_, oi_); \
            if ((lvl) < 4) { _Pragma("unroll") for (int r = 0; r < 8; ++r) { CK[(wave * 8 + r) * 64 + lane] = bk[r]; CI[(wave * 8 + r) * 64 + lane] = bi[r]; } } } \
        __syncthreads(); } while (0)
    RT_LEVEL(1); RT_LEVEL(2); RT_LEVEL(4);
#undef RT_LEVEL
    LAS unsigned* hist = (LAS unsigned*)(lds + 102400); LAS unsigned* hbase = hist + 256;
    if (tid < 256) hist[tid] = 0u;
    __syncthreads();
    unsigned* cnt = (unsigned*)(ws + WS_CTL) + CW_CNT; int* list = (int*)(ws + WS_LIST); float* gatew = (float*)(ws + WS_GATEW);
    unsigned rank[8];
    if (wave == 0) {
        const int tok = t0 + lane;
        float sel[8], ssum = 0.f;
#pragma unroll
        for (int r = 0; r < 8; ++r) { sel[r] = sigmoid_f(LG[bi[r] * 65 + lane]); ssum += sel[r]; }
#pragma unroll
        for (int r = 0; r < 8; ++r) rank[r] = __hip_atomic_fetch_add(&hist[bi[r]], 1u, __ATOMIC_RELAXED, __HIP_MEMORY_SCOPE_WORKGROUP);
        const float sc = 2.5f / ssum;
        f32x4 g0 = {sel[0] * sc, sel[1] * sc, sel[2] * sc, sel[3] * sc}, g1 = {sel[4] * sc, sel[5] * sc, sel[6] * sc, sel[7] * sc};
        *(f32x4*)(gatew + tok * 8) = g0; *(f32x4*)(gatew + tok * 8 + 4) = g1;
    }
    __syncthreads();
    if (tid < 256) { const unsigned h = hist[tid]; if (h) hbase[tid] = atomicAdd(cnt + 32 * tid, h); }
    __syncthreads();
    if (wave == 0) {
        const int tok = t0 + lane;
#pragma unroll
        for (int r = 0; r < 8; ++r) list[(size_t)bi[r] * LISTCAP + hbase[bi[r]] + rank[r]] = tok * NSLOT + r;
    }
    __syncthreads();
}

__device__ __forceinline__ void moe_tile(const Args& a, ldsp lds, int e, int mt, int nrows, int ntl) {
    const int tid = threadIdx.x, lane = tid & 63, wave = __builtin_amdgcn_readfirstlane(tid >> 6), fr = lane & 15, fq = lane >> 4;
    unsigned char* ws = a.ws;
    constexpr int ASTG = 0, BSTG = 16384, ACT = 49152, SLOTS = 114688, GWO = 115200;
    const bf16* H2 = (const bf16*)(ws + WS_H2);
    const float* Wg = (e < NEXP) ? a.in[I_EG] + (size_t)e * 262144 : a.in[I_SG];
    const float* Wu = (e < NEXP) ? a.in[I_EU] + (size_t)e * 262144 : a.in[I_SU];
    const float* Wd = (e < NEXP) ? a.in[I_ED] + (size_t)e * 262144 : a.in[I_SD];
    if (tid < 128) {
        int slot = -1; float gw = 0.f;
        if (tid < nrows) {
            if (e < NEXP) { slot = ((const int*)(ws + WS_LIST))[(size_t)e * LISTCAP + mt * 128 + tid]; gw = ((const float*)(ws + WS_GATEW))[(slot / NSLOT) * 8 + (slot % NSLOT)]; }
            else { slot = (mt * 128 + tid) * NSLOT + 8; gw = 1.f; }
        }
        ((LAS int*)(lds + SLOTS))[tid] = slot; ((LAS float*)(lds + GWO))[tid] = gw;
    }
    __syncthreads();
    const int wr = wave >> 2, wc = wave & 3;
    const int arow = tid >> 2, akc = tid & 3;
    const int aslot = ((LAS const int*)(lds + SLOTS))[arow];
    const bf16* asrc = H2 + (size_t)((aslot < 0 ? 0 : aslot) / NSLOT) * D + akc * 8;
    const int awr = ASTG + akc * 2048 + ((arow ^ (akc << 1)) * 16);
    const int ng = lane, kq = wave;
    const float* srcg = Wg + (size_t)(4 * kq) * 256 + 4 * ng;
    const float* srcu = Wu + (size_t)(4 * kq) * 256 + 4 * ng;
    const float* src2 = Wd + (size_t)(4 * kq) * 1024 + 4 * ng;
    int bwr2[4];
#pragma unroll
    for (int i = 0; i < 4; ++i) { const int rho2 = 4 * ng + i; bwr2[i] = BSTG + (kq >> 1) * 4096 + ((rho2 ^ ((rho2 >> 3) & 3)) * 16) + (kq & 1) * 8; }
    int ard[4], brd[4], rowm[4];
#pragma unroll
    for (int m = 0; m < 4; ++m) { rowm[m] = 64 * wr + 16 * m + fr; ard[m] = fq * 2048 + ((rowm[m] ^ (fq << 1)) * 16); }
#pragma unroll
    for (int n = 0; n < 4; ++n) { const int rho = 64 * wc + 16 * n + fr; brd[n] = BSTG + fq * 4096 + ((rho ^ ((rho >> 3) & 3)) * 16); }
    bf16* contrib = (bf16*)(ws + WS_CONTRIB);
    f32x4 acc[4][4];
    f32x4 B0[4], B1[4], B2[4], B3[4]; u32x4 A0, A1, A2, A3;
#define G1_LOAD(s_, BR, AR) do { const int s0_ = (s_); const int ss_ = s0_ < 63 ? s0_ : 63; \
        const float* bp_ = ((ss_ < 32) ? srcg : srcu) + (size_t)(32 * (ss_ & 31)) * 256; \
        AR = *(const u32x4*)(asrc + 32 * (ss_ & 31)); \
        _Pragma("unroll") for (int j = 0; j < 4; ++j) BR[j] = *(const f32x4*)(bp_ + j * 256); } while (0)
#define G1_WRITE(BR, AR, buf_) do { \
        *(LAS u32x4*)(lds + (buf_) * 8192 + awr) = AR; \
        _Pragma("unroll") for (int i = 0; i < 4; ++i) { u32x2 w_; w_.x = cvtpk(BR[0][i], BR[1][i]); w_.y = cvtpk(BR[2][i], BR[3][i]); *(LAS u32x2*)(lds + (buf_) * 16384 + bwr2[i]) = w_; } } while (0)
#define MOE_COMPUTE(abase_, buf_) do { \
        bf16x8 af_[4], bf_[4]; \
        _Pragma("unroll") for (int m = 0; m < 4; ++m) af_[m] = *(LAS const bf16x8*)(lds + (abase_) + ard[m]); \
        _Pragma("unroll") for (int n = 0; n < 4; ++n) bf_[n] = *(LAS const bf16x8*)(lds + (buf_) * 16384 + brd[n]); \
        _Pragma("unroll") for (int m = 0; m < 4; ++m) _Pragma("unroll") for (int n = 0; n < 4; ++n) acc[m][n] = mfma16(bf_[n], af_[m], acc[m][n]); } while (0)
#define ACC_ZERO() do { _Pragma("unroll") for (int m = 0; m < 4; ++m) _Pragma("unroll") for (int n = 0; n < 4; ++n) acc[m][n] = (f32x4){0.f, 0.f, 0.f, 0.f}; } while (0)
    G1_LOAD(0, B0, A0); G1_LOAD(1, B1, A1); G1_LOAD(2, B2, A2);
    G1_WRITE(B0, A0, 0);
    __syncthreads();
    for (int s = 0; s < 64; s += 4) {
        if ((s & 31) == 0) ACC_ZERO();
        G1_LOAD(s + 3, B3, A3); MOE_COMPUTE(0, 0); G1_WRITE(B1, A1, 1); __syncthreads();
        G1_LOAD(s + 4, B0, A0); MOE_COMPUTE(8192, 1); G1_WRITE(B2, A2, 0); __syncthreads();
        G1_LOAD(s + 5, B1, A1); MOE_COMPUTE(0, 0); G1_WRITE(B3, A3, 1); __syncthreads();
        G1_LOAD(s + 6, B2, A2); MOE_COMPUTE(8192, 1);
        if (s == 28) {
#pragma unroll
            for (int m = 0; m < 4; ++m)
#pragma unroll
                for (int n = 0; n < 4; ++n) {
                    const f32x4 gv = acc[m][n];
                    u32x2 w; w.x = cvtpk(silu_f(gv[0]), silu_f(gv[1])); w.y = cvtpk(silu_f(gv[2]), silu_f(gv[3]));
                    const int kc = 8 * wc + 2 * n + (fq >> 1);
                    *(LAS u32x2*)(lds + ACT + kc * 2048 + ((rowm[m] ^ ((kc & 3) << 1)) * 16) + (fq & 1) * 8) = w;
                }
        } else if (s == 60) {
#pragma unroll
            for (int m = 0; m < 4; ++m)
#pragma unroll
                for (int n = 0; n < 4; ++n) {
                    const f32x4 uv = acc[m][n];
                    const int kc = 8 * wc + 2 * n + (fq >> 1);
                    LAS u32x2* ap = (LAS u32x2*)(lds + ACT + kc * 2048 + ((rowm[m] ^ ((kc & 3) << 1)) * 16) + (fq & 1) * 8);
                    const u32x2 g = *ap;
                    u32x2 w; w.x = cvtpk(bflo(g.x) * uv[0], bfhi(g.x) * uv[1]); w.y = cvtpk(bflo(g.y) * uv[2], bfhi(g.y) * uv[3]);
                    *ap = w;
                }
        }
        G1_WRITE(B0, A0, 0); __syncthreads();
    }
#define G2_LOAD(s_, BR) do { const int s0_ = (s_); const int t_ = s0_ < 31 ? s0_ : 31; \
        const float* bp_ = src2 + (size_t)(32 * (t_ & 7)) * 1024 + 256 * (t_ >> 3); \
        _Pragma("unroll") for (int j = 0; j < 4; ++j) BR[j] = *(const f32x4*)(bp_ + j * 1024); } while (0)
#define G2_WRITE(BR, buf_) do { \
        _Pragma("unroll") for (int i = 0; i < 4; ++i) { u32x2 w_; w_.x = cvtpk(BR[0][i], BR[1][i]); w_.y = cvtpk(BR[2][i], BR[3][i]); *(LAS u32x2*)(lds + (buf_) * 16384 + bwr2[i]) = w_; } } while (0)
    G2_LOAD(0, B0); G2_LOAD(1, B1); G2_LOAD(2, B2);
    G2_WRITE(B0, 0);
    __syncthreads();
    for (int s = 0; s < 32; s += 4) {
        if ((s & 7) == 0) ACC_ZERO();
        G2_LOAD(s + 3, B3); MOE_COMPUTE(ACT + (s & 7) * 8192, 0); G2_WRITE(B1, 1); __syncthreads();
        G2_LOAD(s + 4, B0); MOE_COMPUTE(ACT + ((s + 1) & 7) * 8192, 1); G2_WRITE(B2, 0); __syncthreads();
        G2_LOAD(s + 5, B1); MOE_COMPUTE(ACT + ((s + 2) & 7) * 8192, 0); G2_WRITE(B3, 1); __syncthreads();
        G2_LOAD(s + 6, B2); MOE_COMPUTE(ACT + ((s + 3) & 7) * 8192, 1);
        if ((s & 7) == 4) {
            const int q = s >> 3;
#pragma unroll
            for (int m = 0; m < 4; ++m) {
                const int slot = ((LAS const int*)(lds + SLOTS))[rowm[m]]; const float gw = ((LAS const float*)(lds + GWO))[rowm[m]];
                if (slot >= 0) {
                    bf16* cp = contrib + (size_t)slot * D + q * 256 + 64 * wc + 4 * fq;
#pragma unroll
                    for (int n = 0; n < 4; ++n) { const f32x4 v = acc[m][n] * gw; u32x2 w; w.x = cvtpk(v[0], v[1]); w.y = cvtpk(v[2], v[3]); *(u32x2*)(cp + 16 * n) = w; }
                }
            }
        }
        G2_WRITE(B0, 0); __syncthreads();
    }
#undef G1_LOAD
#undef G1_WRITE
#undef G2_LOAD
#undef G2_WRITE
#undef ACC_ZERO
#undef MOE_COMPUTE
}

template <int TD>
__device__ __forceinline__ void moe_tile_ws(const Args& a, ldsp lds, int e, int mt, int nrows, int ntl, unsigned& junk) {
    const int tid = threadIdx.x, lane = tid & 63, wave = __builtin_amdgcn_readfirstlane(tid >> 6), fr = lane & 15, fq = lane >> 4;
    unsigned char* ws = a.ws;
    constexpr int ASTG = 0, BSTG = 16384, ACT = 49152, SLOTS = 114688, GWO = 115200;
    const float* Wg = (e < NEXP) ? a.in[I_EG] + (size_t)e * 262144 : a.in[I_SG];
    const float* Wu = (e < NEXP) ? a.in[I_EU] + (size_t)e * 262144 : a.in[I_SU];
    const float* Wd = (e < NEXP) ? a.in[I_ED] + (size_t)e * 262144 : a.in[I_SD];
    if (tid < 128) {
        int slot = -1; float gw = 0.f;
        if (tid < nrows) {
            if (e < NEXP) { slot = ((const int*)(ws + WS_LIST))[(size_t)e * LISTCAP + mt * 128 + tid]; gw = ((const float*)(ws + WS_GATEW))[(slot / NSLOT) * 8 + (slot % NSLOT)]; }
            else { slot = (mt * 128 + tid) * NSLOT + 8; gw = 1.f; }
        }
        ((LAS int*)(lds + SLOTS))[tid] = slot; ((LAS float*)(lds + GWO))[tid] = gw;
    }
    __syncthreads();
    if (wave >= 4) {
        const int lt = tid - 256;
        const bf16* H2 = (const bf16*)(ws + WS_H2);
        const int arow = lt >> 1, ahalf = lt & 1;
        const int aslot = ((LAS const int*)(lds + SLOTS))[arow];
        const bf16* asrc = H2 + (size_t)((aslot < 0 ? 0 : aslot) / NSLOT) * D + 16 * ahalf;
        const int awr0 = ASTG + (2 * ahalf) * 2048 + ((arow ^ ((2 * ahalf) << 1)) * 16), awr1 = ASTG + (2 * ahalf + 1) * 2048 + ((arow ^ ((2 * ahalf + 1) << 1)) * 16);
        const int ng = lt & 63, kq = lt >> 6;
        const float* srcg = Wg + (size_t)(8 * kq) * 256 + 4 * ng;
        const float* srcu = Wu + (size_t)(8 * kq) * 256 + 4 * ng;
        const float* srcd = Wd + (size_t)(8 * kq) * 1024 + 4 * ng;
        const int bw = BSTG + kq * 4096 + (4 * ng) * 16, bx = ((4 * ng) >> 3) & 3;
        f32x4 B0[8], B1[8], B2[8], B3[8]; u32x4 A0[2], A1[2], A2[2], A3[2];
#define L_LOAD1(s_, BR, AR) do { const int ss_ = (s_); const int sa_ = ss_ < 63 ? ss_ : 63; const int t_ = ss_ - 64; \
            const float* bp_ = (ss_ < 32) ? srcg + (size_t)(32 * ss_) * 256 : (ss_ < 64) ? srcu + (size_t)(32 * (ss_ - 32)) * 256 : srcd + (size_t)(32 * (t_ & 7)) * 1024 + 256 * (t_ >> 3); \
            const int str_ = (ss_ < 64) ? 256 : 1024;        \
            AR[0] = *(const u32x4*)(asrc + 32 * (sa_ & 31)); AR[1] = *(const u32x4*)(asrc + 32 * (sa_ & 31) + 8); \
            _Pragma("unroll") for (int j = 0; j < 8; ++j) BR[j] = *(const f32x4*)(bp_ + j * str_); } while (0)
#define L_LOAD2(s_, BR) do { const int s0_ = (s_); const int t_ = s0_ < 31 ? s0_ : 31; \
            const float* bp_ = srcd + (size_t)(32 * (t_ & 7)) * 1024 + 256 * (t_ >> 3); \
            _Pragma("unroll") for (int j = 0; j < 8; ++j) BR[j] = *(const f32x4*)(bp_ + j * 1024); } while (0)
#define L_WRITEB(BR, buf_) do { _Pragma("unroll") for (int i = 0; i < 4; ++i) { u32x4 w_; w_.x = cvtpk(BR[0][i], BR[1][i]); w_.y = cvtpk(BR[2][i], BR[3][i]); w_.z = cvtpk(BR[4][i], BR[5][i]); w_.w = cvtpk(BR[6][i], BR[7][i]); \
            *(LAS u32x4*)(lds + (buf_) * 16384 + bw + ((i ^ bx) * 16)) = w_; } } while (0)
#define L_WRITEA(AR, buf_) do { *(LAS u32x4*)(lds + (buf_) * 8192 + awr0) = AR[0]; *(LAS u32x4*)(lds + (buf_) * 8192 + awr1) = AR[1]; } while (0)
        L_LOAD1(0, B0, A0); L_LOAD1(1, B1, A1); L_LOAD1(2, B2, A2);
        L_WRITEA(A0, 0); L_WRITEB(B0, 0);
        __syncthreads();
        for (int s = 0; s < 64; s += 4) {
            L_LOAD1(s + 3, B3, A3); L_WRITEA(A1, 1); L_WRITEB(B1, 1); __syncthreads();
            L_LOAD1(s + 4, B0, A0); L_WRITEA(A2, 0); L_WRITEB(B2, 0); __syncthreads();
            L_LOAD1(s + 5, B1, A1); L_WRITEA(A3, 1); L_WRITEB(B3, 1); __syncthreads();
            L_LOAD1(s + 6, B2, A2); L_WRITEA(A0, 0); L_WRITEB(B0, 0); __syncthreads();
        }
        for (int s = 0; s < 32; s += 4) {
            L_LOAD2(s + 3, B3); L_WRITEB(B1, 1); __syncthreads();
            L_LOAD2(s + 4, B0); L_WRITEB(B2, 0); __syncthreads();
            L_LOAD2(s + 5, B1); L_WRITEB(B3, 1); __syncthreads();
            L_LOAD2(s + 6, B2); L_WRITEB(B0, 0); __syncthreads();
        }
#undef L_LOAD1
#undef L_LOAD2
#undef L_WRITEB
#undef L_WRITEA
    } else {
        const int wr = wave >> 1, wc = wave & 1;
        int rowm[4], ard[4], brd[8];
#pragma unroll
        for (int m = 0; m < 4; ++m) { rowm[m] = 64 * wr + 16 * m + fr; ard[m] = fq * 2048 + ((rowm[m] ^ (fq << 1)) * 16); }
#pragma unroll
        for (int n = 0; n < 8; ++n) { const int rho = 128 * wc + 16 * n + fr; brd[n] = BSTG + fq * 4096 + ((rho ^ ((rho >> 3) & 3)) * 16); }
        bf16* contrib = (bf16*)(ws + WS_CONTRIB);
        const int nt = ntl >= 8 ? 8 : ntl >= 4 ? 4 : ntl >= 2 ? 2 : 1, role = mt & (nt - 1);
        const float* tg = Wg + (size_t)(tid >> 3) * 256 + (tid & 7) * 32;
        const float* tu = Wu + (size_t)(tid >> 3) * 256 + (tid & 7) * 32;
        const float* td = Wd + (size_t)(tid >> 3) * 1024 + (tid & 7) * 32;
#define M_TOUCH(st_) do { const int s0_ = (st_); if (false && s0_ < 96 && (s0_ & (nt - 1)) == role) { const int u_ = s0_ - 64; \
            const float* tp_ = (s0_ < 32) ? tg + (size_t)(32 * s0_) * 256 : (s0_ < 64) ? tu + (size_t)(32 * (s0_ - 32)) * 256 : td + (size_t)(32 * (u_ & 7)) * 1024 + 256 * (u_ >> 3); \
            asm volatile("global_load_dword %0, %1, off" : "+v"(junk) : "v"(tp_) : "memory"); } } while (0)
        f32x4 acc[4][8];
#define M_COMPUTE(abase_, buf_) do { \
            _Pragma("unroll") for (int nh = 0; nh < 2; ++nh) { bf16x8 af_[4], bf_[4]; \
                _Pragma("unroll") for (int m = 0; m < 4; ++m) af_[m] = *(LAS const bf16x8*)(lds + (abase_) + ard[m]); \
                _Pragma("unroll") for (int n = 0; n < 4; ++n) bf_[n] = *(LAS const bf16x8*)(lds + (buf_) * 16384 + brd[4 * nh + n]); \
                _Pragma("unroll") for (int m = 0; m < 4; ++m) _Pragma("unroll") for (int n = 0; n < 4; ++n) acc[m][4 * nh + n] = mfma16(bf_[n], af_[m], acc[m][4 * nh + n]); } } while (0)
#define M_ZERO() do { _Pragma("unroll") for (int m = 0; m < 4; ++m) _Pragma("unroll") for (int n = 0; n < 8; ++n) acc[m][n] = (f32x4){0.f, 0.f, 0.f, 0.f}; } while (0)
        for (int st = 0; st < TD; ++st) M_TOUCH(st);
        __syncthreads();
        for (int s = 0; s < 64; s += 4) {
            if ((s & 31) == 0) M_ZERO();
            M_TOUCH(s + TD); M_COMPUTE(0, 0); __syncthreads();
            M_TOUCH(s + 1 + TD); M_COMPUTE(8192, 1); __syncthreads();
            M_TOUCH(s + 2 + TD); M_COMPUTE(0, 0); __syncthreads();
            M_TOUCH(s + 3 + TD); M_COMPUTE(8192, 1);
            if (s == 28) {
#pragma unroll
                for (int m = 0; m < 4; ++m)
#pragma unroll
                    for (int n = 0; n < 8; ++n) {
                        const f32x4 gv = acc[m][n];
                        u32x2 w; w.x = cvtpk(silu_f(gv[0]), silu_f(gv[1])); w.y = cvtpk(silu_f(gv[2]), silu_f(gv[3]));
                        const int kc = 16 * wc + 2 * n + (fq >> 1);
                        *(LAS u32x2*)(lds + ACT + kc * 2048 + ((rowm[m] ^ ((kc & 3) << 1)) * 16) + (fq & 1) * 8) = w;
                    }
            } else if (s == 60) {
#pragma unroll
                for (int m = 0; m < 4; ++m)
#pragma unroll
                    for (int n = 0; n < 8; ++n) {
                        const f32x4 uv = acc[m][n];
                        const int kc = 16 * wc + 2 * n + (fq >> 1);
                        LAS u32x2* ap = (LAS u32x2*)(lds + ACT + kc * 2048 + ((rowm[m] ^ ((kc & 3) << 1)) * 16) + (fq & 1) * 8);
                        const u32x2 g = *ap;
                        u32x2 w; w.x = cvtpk(bflo(g.x) * uv[0], bfhi(g.x) * uv[1]); w.y = cvtpk(bflo(g.y) * uv[2], bfhi(g.y) * uv[3]);
                        *ap = w;
                    }
            }
            __syncthreads();
        }
        for (int s = 0; s < 32; s += 4) {
            if ((s & 7) == 0) M_ZERO();
            M_TOUCH(64 + s + TD); M_COMPUTE(ACT + (s & 7) * 8192, 0); __syncthreads();
            M_TOUCH(64 + s + 1 + TD); M_COMPUTE(ACT + ((s + 1) & 7) * 8192, 1); __syncthreads();
            M_TOUCH(64 + s + 2 + TD); M_COMPUTE(ACT + ((s + 2) & 7) * 8192, 0); __syncthreads();
            M_TOUCH(64 + s + 3 + TD); M_COMPUTE(ACT + ((s + 3) & 7) * 8192, 1);
            if ((s & 7) == 4) {
                const int q = s >> 3;
#pragma unroll
                for (int m = 0; m < 4; ++m) {
                    const int slot = ((LAS const int*)(lds + SLOTS))[rowm[m]]; const float gw = ((LAS const float*)(lds + GWO))[rowm[m]];
                    if (slot >= 0) {
                        bf16* cp = contrib + (size_t)slot * D + q * 256 + 128 * wc + 4 * fq;
#pragma unroll
                        for (int n = 0; n < 8; ++n) { const f32x4 v = acc[m][n] * gw; u32x2 w; w.x = cvtpk(v[0], v[1]); w.y = cvtpk(v[2], v[3]); *(u32x2*)(cp + 16 * n) = w; }
                    }
                }
            }
            __syncthreads();
        }
#undef M_TOUCH
#undef M_COMPUTE
#undef M_ZERO
    }
}

#ifndef MOE_TD
#define MOE_TD 8
#endif
__device__ __forceinline__ void phase_moe(const Args& a, ldsp lds, int G, int vcu) {
    const int tid = threadIdx.x;
    const unsigned* cnt = (const unsigned*)(a.ws + WS_CTL) + CW_CNT;
    LAS int* pre = (LAS int*)(lds + MISC_OFF + 512);
    if (tid == 0) { int s = 0; for (int e = 0; e < NEXP; ++e) { pre[e] = s; s += (int)((cnt[32 * e] + 127u) >> 7); } pre[NEXP] = s; }
    __syncthreads();
    const int total = pre[NEXP], ntiles = total + T / 128;
    unsigned junk = 0;
    for (int j = vcu; j < ntiles; j += G) {
        int e, mt, nrows, ntl;
        if (j < total) {
            int lo = 0, hi = NEXP;
            while (hi - lo > 1) { const int mid = (lo + hi) >> 1; if (pre[mid] <= j) lo = mid; else hi = mid; }
            e = lo; mt = j - pre[e]; const int c = (int)cnt[32 * e] - mt * 128; nrows = c < 128 ? c : 128; ntl = pre[e + 1] - pre[e];
        } else { e = NEXP; mt = j - total; nrows = 128; ntl = 8; }
        moe_tile_ws<MOE_TD>(a, lds, e, mt, nrows, ntl, junk);
    }
    asm volatile("s_waitcnt vmcnt(0)" : "+v"(junk) :: "memory");
}

__device__ __forceinline__ void phase_combine(const Args& a, int G) {
    const int tid = threadIdx.x, lane = tid & 63, wave = __builtin_amdgcn_readfirstlane(tid >> 6), blk = blockIdx.x;
    unsigned char* ws = a.ws;
    const float* X1 = (const float*)(ws + WS_X1); const bf16* contrib = (const bf16*)(ws + WS_CONTRIB); const float* fg = a.in[I_FG];
    for (int t = blk * NWAVES + wave; t < T; t += G * NWAVES) {
        const float* g2 = (const float*)(ws + WS_ADAF) + (t >> 13) * 6144 + 5 * 1024;
        f32x4 xv[2][2]; float ss = 0.f;
#pragma unroll
        for (int j = 0; j < 2; ++j) {
            const int c = 8 * lane + 512 * j;
            float sm[8] = {0.f, 0.f, 0.f, 0.f, 0.f, 0.f, 0.f, 0.f};
#pragma unroll
            for (int k = 0; k < NSLOT; ++k) {
                const u32x4 w = *(const u32x4*)(contrib + ((size_t)t * NSLOT + k) * D + c);
                sm[0] += bflo(w.x); sm[1] += bfhi(w.x); sm[2] += bflo(w.y); sm[3] += bfhi(w.y); sm[4] += bflo(w.z); sm[5] += bfhi(w.z); sm[6] += bflo(w.w); sm[7] += bfhi(w.w);
            }
#pragma unroll
            for (int h = 0; h < 2; ++h) {
                const f32x4 x1 = *(const f32x4*)(X1 + (size_t)t * D + c + 4 * h), gg = *(const f32x4*)(g2 + c + 4 * h);
                const f32x4 mv = {sm[4 * h], sm[4 * h + 1], sm[4 * h + 2], sm[4 * h + 3]};
                const f32x4 v = x1 + gg * mv; xv[j][h] = v; ss += (v[0] * v[0] + v[1] * v[1]) + (v[2] * v[2] + v[3] * v[3]);
            }
        }
        const float r = rsqrtf(wave_sum(ss) * (1.f / D) + 1e-6f);
#pragma unroll
        for (int j = 0; j < 2; ++j)
#pragma unroll
            for (int h = 0; h < 2; ++h) { const int c = 8 * lane + 512 * j + 4 * h; *(f32x4*)(a.out + (size_t)t * D + c) = (xv[j][h] * r) * *(const f32x4*)(fg + c); }
    }
}

constexpr int NPH = 9;
#ifndef N_LAUNCHES
#define N_LAUNCHES 1
#endif
__global__ void __launch_bounds__(NWAVES * 64, 2) mega(Args a) {
    extern __shared__ __attribute__((aligned(16))) unsigned char lds_raw[];
    ldsp lds = (ldsp)lds_raw;
    const int tid = threadIdx.x, G = gridDim.x, bx = blockIdx.x;
    int vcu = (G % 8 == 0) ? (bx % 8) * (G / 8) + bx / 8 : bx;
    unsigned char* ws = a.ws;
    for (int u = tid; u < (LDS_BYTES - MISC_OFF) / 4; u += NWAVES * 64) ((LAS unsigned*)(lds + MISC_OFF))[u] = 0u;
    __syncthreads();
    volatile LAS unsigned* MISC = (volatile LAS unsigned*)(lds + MISC_OFF);
    XcdBarrier bar; bar.bar = (unsigned*)(ws + WS_CTL) + CW_BAR; bar.x = 0; bar.st = nullptr;
    if (N_LAUNCHES == 1) {
        bar = xcd_barrier_post((unsigned*)(ws + WS_CTL) + CW_BAR, MISC + 8);
        if (tid == 0) MISC[16] = atomicAdd((unsigned*)(ws + WS_CTL) + CW_XRANK + 64 * bar.x, 1u);
    }
    const int lo = a.ph_lo, hi = a.ph_hi;
#ifndef PH_MASK
#define PH_MASK 0x1ff
#endif
#define IN(k) (((PH_MASK >> (k)) & 1) && lo <= (k) && (k) < hi)
#define SEAM(k) do { if (IN(k) && IN((k) + 1)) xcd_barrier(bar); } while (0)
#ifndef PH_DUP
#define PH_DUP -1
#endif
#define REP(k) for (int rep_ = 0; rep_ < ((PH_DUP == (k)) ? 2 : 1); ++rep_)
    if (IN(0)) REP(0) { phase_prep(a, lds, G); } SEAM(0);
    if (N_LAUNCHES == 1 && IN(0) && IN(1)) {
        unsigned basex = 0;
        for (unsigned j = 0; j < bar.x; ++j) basex += xb_ld(&bar.bar[XB_XCNT(j)]);
        vcu = (int)(basex + MISC[16]);
    }
    if (IN(1)) REP(1) { phase_hnorm(a, lds, G); } SEAM(1);
    if (IN(2)) REP(2) {
        pg8::Gemm g{(const pg8::bf16_t*)(ws + WS_H), (const pg8::bf16_t*)(ws + WS_WINT), MH, DIN, D};
        WinOrder S; S.init(G, bx);
        EpiWin E{(bf16*)(ws + WS_Z), (bf16*)(ws + WS_KVC), (const float*)(ws + WS_ROPE)};
        pg8::gemm_phase<EpiWin, WinOrder, true, true>(lds, g, S, E);
    } SEAM(2);
    if (IN(3)) REP(3) { phase_mixers(a, lds, G, vcu); } SEAM(3);
    if (IN(4)) REP(4) {
        { pg8::Gemm g{(const pg8::bf16_t*)(ws + WS_A), (const pg8::bf16_t*)(ws + WS_WAT), T, D, 512};
          pg8::StaticOrder S; S.init(T, D, G, bx);
          EpiMergeA E{(const bf16*)(ws + WS_Z), (bf16*)(ws + WS_Y)};
          pg8::gemm_phase<EpiMergeA, pg8::StaticOrder, true, true>(lds, g, S, E); }
        { pg8::Gemm g{(const pg8::bf16_t*)(ws + WS_O), (const pg8::bf16_t*)(ws + WS_WBT), T, D, 512};
          pg8::StaticOrder S; S.init(T, D, G, bx);
          EpiMergeB E{(const bf16*)(ws + WS_Z), (bf16*)(ws + WS_Y)};
          pg8::gemm_phase<EpiMergeB, pg8::StaticOrder, true, true>(lds, g, S, E); }
    } SEAM(4);
    if (IN(5)) REP(5) {
        pg8::Gemm g{(const pg8::bf16_t*)(ws + WS_Y), (const pg8::bf16_t*)(ws + WS_WOT), T, D, D};
        pg8::StaticOrder S; S.init(T, D, G, bx);
        EpiWo E{a.in[I_X], (const float*)(ws + WS_ADAF), (float*)(ws + WS_X1)};
        pg8::gemm_phase<EpiWo, pg8::StaticOrder, true, true>(lds, g, S, E);
    } SEAM(5);
    if (IN(6)) { for (int it = vcu; it < T / 64; it += G) router_item(a, lds, it); } SEAM(6);
    if (IN(7)) REP(7) { phase_moe(a, lds, G, vcu); } SEAM(7);
    if (IN(8)) REP(8) { phase_combine(a, G); }
#undef IN
#undef SEAM
}

extern "C" void kernel_launch(void* const* d_in, const int* in_sizes, int n_in, void* d_out, int out_size, void* d_ws, size_t ws_size, hipStream_t stream) {
    static int grid = 0;
    if (grid == 0) {
        if (n_in != 26 || out_size != T * D || ws_size < WS_END) { fprintf(stderr, "kernel_launch: unexpected shapes (n_in %d, out %d, ws %zu)\n", n_in, out_size, ws_size); grid = -1; return; }
        int dev = 0, cus = 0, per_cu = 0;
        (void)hipGetDevice(&dev); (void)hipDeviceGetAttribute(&cus, hipDeviceAttributeMultiprocessorCount, dev);
        (void)hipFuncSetAttribute((const void*)mega, hipFuncAttributeMaxDynamicSharedMemorySize, LDS_BYTES);
        (void)hipOccupancyMaxActiveBlocksPerMultiprocessor(&per_cu, (const void*)mega, NWAVES * 64, LDS_BYTES);
        (void)hipGetLastError();
        if (per_cu < 1) { fprintf(stderr, "kernel_launch: occupancy query says %d blocks per CU\n", per_cu); per_cu = 1; }
        grid = cus;
    }
    if (grid < 0) return;
    (void)hipMemsetAsync((char*)d_ws + WS_CTL, 0, CTL_ZERO_BYTES, stream);
    Args a{};
    for (int i = 0; i < 26; ++i) a.in[i] = (const float*)d_in[i];
    a.out = (float*)d_out; a.ws = (unsigned char*)d_ws;
    if (N_LAUNCHES == 1) {
        a.ph_lo = 0; a.ph_hi = NPH;
        void* kargs[] = {&a};
        hipError_t e = hipLaunchCooperativeKernel((const void*)mega, dim3(grid), dim3(NWAVES * 64), kargs, LDS_BYTES, stream);
        if (e != hipSuccess) fprintf(stderr, "kernel_launch: cooperative launch failed: %s (grid %d)\n", hipGetErrorString(e), grid);
    } else {
#ifndef HOST_DUP
#define HOST_DUP -1
#endif
        for (int li = 0; li < NPH; ++li) {
            a.ph_lo = li; a.ph_hi = li + 1;
            hipLaunchKernelGGL(mega, dim3(grid), dim3(NWAVES * 64), LDS_BYTES, stream, a);
            if (li == HOST_DUP) {
                if (li == 6) (void)hipMemsetAsync((char*)d_ws + WS_CTL, 0, CTL_ZERO_BYTES, stream);
                hipLaunchKernelGGL(mega, dim3(grid), dim3(NWAVES * 64), LDS_BYTES, stream, a);
            }
        }
    }
}
```

```cpp
#include <hip/hip_runtime.h>
#include <cstdio>
#include <cstdint>
#include <type_traits>
namespace pg8 {
#define PG8_LAS __attribute__((address_space(3)))
typedef unsigned short bf16_t;
typedef short bf16x8 __attribute__((ext_vector_type(8)));
typedef float f32x4 __attribute__((ext_vector_type(4)));
typedef unsigned u32x4 __attribute__((ext_vector_type(4)));
constexpr int BM = 256, BK = 64, HALF = 128, HTB = HALF * BK * 2  , STAGE_BYTES = 8 * HTB, NXCD = 8, WGM = 8;

__host__ __device__ __forceinline__ int lds_byte(int r, int c) { const int st = (r >> 4) * 2 + (c >> 5), rr = r & 15, cc = c & 31, ob = rr * 64 + cc * 2; return st * 1024 + (ob ^ (((ob >> 9) & 1) << 5)); }
__host__ __device__ __forceinline__ void stage_rc(int b, int& R, int& C) { const int st = b / 1024, sb = b % 1024, swz = sb ^ (((sb >> 9) & 1) << 5); R = (st >> 1) * 16 + swz / 64; C = (st & 1) * 32 + (swz % 64) / 2; }
__host__ __device__ __forceinline__ int perm32(int rho) { const int n = rho >> 4, i = rho & 15; return 8 * (i >> 2) + 4 * n + (i & 3); }

struct Unit { int pm, pn; };
struct Gemm { const bf16_t* A; const bf16_t* Bt; int M, N, K; };

struct StaticOrder {
    int nM, nN, nwg, G, c;
    __host__ __device__ void init(int M, int N, int G_, int c_) { nM = M / BM; nN = N / BM; nwg = nM * nN; G = G_; c = c_; }
    __host__ __device__ bool next(int i, Unit& u) const {
        const long L = (long)i * G + c; if (L >= nwg) return false;
        int wgid = (int)L; { const int q = nwg / NXCD, r = nwg % NXCD, xcd = wgid % NXCD, off = wgid / NXCD; wgid = (xcd < r ? xcd * (q + 1) : r * (q + 1) + (xcd - r) * q) + off; }
        const int nig = WGM * nN, gid = wgid / nig, fm = gid * WGM, gsz = (nM - fm) < WGM ? (nM - fm) : WGM;
        u.pm = fm + ((wgid % nig) % gsz); u.pn = (wgid % nig) / gsz; return true;
    }
    __device__ __forceinline__ void a_ready(const Unit&) const {}
    __device__ __forceinline__ void done(const Unit&) const {}
};

__device__ __forceinline__ unsigned cvt_pk_bf16(float lo, float hi) { unsigned r; asm volatile("v_cvt_pk_bf16_f32 %0, %1, %2" : "=v"(r) : "v"(lo), "v"(hi)); return r; }
template <class Epi, class Sched, bool ALIGN_EPI = false, bool SP2 = false>
__device__ __forceinline__ void gemm_phase(PG8_LAS unsigned char* lds, const Gemm g, const Sched& S, const Epi& E) {
    const int tid = threadIdx.x, wid = __builtin_amdgcn_readfirstlane(tid >> 6), lane = tid & 63, wr = wid >> 2, wc = wid & 3, fr = lane & 15, fq = lane >> 4;
    const int K = g.K, nt = K / BK;
    unsigned voffA[2], voffB[2];
#pragma unroll
    for (int i = 0; i < 2; ++i) { int R, C; stage_rc(tid * 16 + i * 8192, R, C); const int Rb = Epi::PERM ? ((R & ~31) + perm32(R & 31)) : R;
        voffA[i] = (unsigned)(R * K + C) * 2u; voffB[i] = (unsigned)(Rb * K + C) * 2u; }
    const size_t kstep = (size_t)(BK * 2);
    const size_t hstep = (size_t)HALF * K * 2;
    const size_t tstep = 2 * hstep;
    const unsigned ldsw = (unsigned)wid * 1024u;
    const int aoff = lds_byte(wr * 64 + fr, fq * 8), boff = lds_byte(wc * 32 + fr, fq * 8);
#define PG8_SA(b, h) (((b) * 2 + (h)) * HTB)
#define PG8_SB(b, h) ((4 + (b) * 2 + (h)) * HTB)
#define PG8_STAGE(bufoff, gbase, voff) do { _Pragma("unroll") for (int _i = 0; _i < 2; ++_i) \
        __builtin_amdgcn_global_load_lds((const unsigned*)((const char*)(gbase) + (voff)[_i]), (PG8_LAS unsigned*)(lds + (bufoff) + ldsw + _i * 8192), 16, 0, 0); } while (0)
#define PG8_LDA(dst, b, h) do { _Pragma("unroll") for (int m = 0; m < 4; ++m) _Pragma("unroll") for (int k = 0; k < 2; ++k) dst[m][k] = *(const PG8_LAS bf16x8*)(lds + PG8_SA(b, h) + aoff + m * 2048 + k * 1024); } while (0)
#define PG8_LDB(dst, b, h) do { _Pragma("unroll") for (int n = 0; n < 2; ++n) _Pragma("unroll") for (int k = 0; k < 2; ++k) dst[n][k] = *(const PG8_LAS bf16x8*)(lds + PG8_SB(b, h) + boff + n * 2048 + k * 1024); } while (0)
#define PG8_MMA(ai, bj, At, Bt) do { __builtin_amdgcn_s_setprio(1); _Pragma("unroll") for (int m = 0; m < 4; ++m) _Pragma("unroll") for (int n = 0; n < 2; ++n) _Pragma("unroll") for (int k = 0; k < 2; ++k) \
        acc[ai][bj][m][n] = __builtin_amdgcn_mfma_f32_16x16x32_bf16(Bt[n][k], At[m][k], acc[ai][bj][m][n], 0, 0, 0); __builtin_amdgcn_s_setprio(0); } while (0)
#define PG8_WAIT_V(n) asm volatile("s_waitcnt vmcnt(" #n ")" ::: "memory")
#define PG8_WAIT_L(n) asm volatile("s_waitcnt lgkmcnt(" #n ")" ::: "memory")
#define PG8_BAR __builtin_amdgcn_s_barrier()
#define PG8_SCHED __builtin_amdgcn_sched_barrier(0)
    Unit cur, nxt; int ui = 0;
    if (!S.next(0, cur)) return;
    f32x4 acc[2][2][4][2];
#pragma unroll
    for (int a = 0; a < 2; ++a)
#pragma unroll
        for (int b = 0; b < 2; ++b)
#pragma unroll
            for (int m = 0; m < 4; ++m)
#pragma unroll
                for (int n = 0; n < 2; ++n) acc[a][b][m][n] = (f32x4){0.f, 0.f, 0.f, 0.f};
    bf16x8 At[4][2], B0[2][2], B1[2][2];
    const char* cA = (const char*)g.A + (size_t)cur.pm * tstep; const char* cB = (const char*)g.Bt + (size_t)cur.pn * tstep;
    S.a_ready(cur);
    if constexpr (SP2) {
        PG8_STAGE(PG8_SB(0, 0), cB, voffB); PG8_STAGE(PG8_SB(0, 1), cB + hstep, voffB); PG8_STAGE(PG8_SA(0, 0), cA, voffA); PG8_STAGE(PG8_SA(0, 1), cA + hstep, voffA);
        if (wr == 1) PG8_BAR;
        PG8_WAIT_V(2); PG8_BAR;
        PG8_STAGE(PG8_SB(1, 0), cB + kstep, voffB); PG8_STAGE(PG8_SA(1, 0), cA + kstep, voffA); PG8_STAGE(PG8_SB(1, 1), cB + hstep + kstep, voffB);
        PG8_WAIT_V(6); PG8_BAR;
    } else {
        PG8_STAGE(PG8_SB(0, 0), cB, voffB); PG8_STAGE(PG8_SA(0, 0), cA, voffA); PG8_STAGE(PG8_SB(0, 1), cB + hstep, voffB); PG8_STAGE(PG8_SA(0, 1), cA + hstep, voffA);
        if (wr == 1) PG8_BAR;
        PG8_WAIT_V(4); PG8_BAR;
        PG8_STAGE(PG8_SB(1, 0), cB + kstep, voffB); PG8_STAGE(PG8_SA(1, 0), cA + kstep, voffA); PG8_STAGE(PG8_SB(1, 1), cB + hstep + kstep, voffB);
        PG8_WAIT_V(6); PG8_BAR;
    }
    for (;;) {
        const bool has_next = S.next(ui + 1, nxt);
        const char* nA = has_next ? (const char*)g.A + (size_t)nxt.pm * tstep : cA; const char* nB = has_next ? (const char*)g.Bt + (size_t)nxt.pn * tstep : cB;
        for (int t = 0; t < nt; t += 2) {
            const bool last = (t == nt - 2);
            const char* a1 = cA + (size_t)(t + 1) * kstep;
            const char* a2 = last ? nA : cA + (size_t)(t + 2) * kstep; const char* b2 = last ? nB : cB + (size_t)(t + 2) * kstep;
            const char* a3 = a2 + kstep; const char* b3 = b2 + kstep;
            if (last && has_next) S.a_ready(nxt);
            if constexpr (SP2) {
            PG8_LDB(B0, 0, 0); PG8_LDB(B1, 0, 1); PG8_SCHED; PG8_LDA(At, 0, 0); PG8_STAGE(PG8_SA(1, 1), a1 + hstep, voffA);
            PG8_WAIT_V(8); PG8_WAIT_L(0); PG8_BAR; PG8_MMA(0, 0, At, B0); PG8_MMA(0, 1, At, B1); PG8_BAR; PG8_SCHED;
            PG8_LDA(At, 0, 1); PG8_STAGE(PG8_SB(0, 0), b2, voffB); PG8_STAGE(PG8_SB(0, 1), b2 + hstep, voffB); PG8_STAGE(PG8_SA(0, 0), a2, voffA);
            PG8_WAIT_V(8); PG8_WAIT_L(0); PG8_BAR; PG8_MMA(1, 0, At, B0); PG8_MMA(1, 1, At, B1); PG8_BAR; PG8_SCHED;
            PG8_LDB(B0, 1, 0); PG8_LDB(B1, 1, 1); PG8_SCHED; PG8_LDA(At, 1, 0); PG8_STAGE(PG8_SA(0, 1), a2 + hstep, voffA);
            PG8_WAIT_V(8); PG8_WAIT_L(0); PG8_BAR; PG8_MMA(0, 0, At, B0); PG8_MMA(0, 1, At, B1); PG8_BAR; PG8_SCHED;
            PG8_LDA(At, 1, 1); PG8_STAGE(PG8_SB(1, 0), b3, voffB); PG8_STAGE(PG8_SB(1, 1), b3 + hstep, voffB); PG8_STAGE(PG8_SA(1, 0), a3, voffA);
            PG8_WAIT_V(8); PG8_WAIT_L(0); PG8_BAR; PG8_MMA(1, 0, At, B0); PG8_MMA(1, 1, At, B1); PG8_BAR; PG8_SCHED;
            } else {
            PG8_LDB(B0, 0, 0); PG8_SCHED; PG8_LDA(At, 0, 0); PG8_STAGE(PG8_SA(1, 1), a1 + hstep, voffA);
            PG8_WAIT_L(8); PG8_BAR; PG8_WAIT_L(0); PG8_MMA(0, 0, At, B0); PG8_BAR; PG8_SCHED;
            PG8_LDB(B1, 0, 1); PG8_STAGE(PG8_SB(0, 0), b2, voffB);
            PG8_BAR; PG8_WAIT_L(0); PG8_MMA(0, 1, At, B1); PG8_BAR;
            PG8_LDA(At, 0, 1); PG8_STAGE(PG8_SA(0, 0), a2, voffA);
            PG8_BAR; PG8_WAIT_L(0); PG8_MMA(1, 0, At, B0); PG8_BAR; PG8_SCHED;
            PG8_STAGE(PG8_SB(0, 1), b2 + hstep, voffB);
            PG8_WAIT_V(6); PG8_BAR; PG8_MMA(1, 1, At, B1); PG8_BAR;
            PG8_LDB(B0, 1, 0); PG8_SCHED; PG8_LDA(At, 1, 0); PG8_STAGE(PG8_SA(0, 1), a2 + hstep, voffA);
            PG8_WAIT_L(8); PG8_BAR; PG8_WAIT_L(0); PG8_MMA(0, 0, At, B0); PG8_BAR; PG8_SCHED;
            PG8_LDB(B1, 1, 1); PG8_STAGE(PG8_SB(1, 0), b3, voffB);
            PG8_BAR; PG8_WAIT_L(0); PG8_MMA(0, 1, At, B1); PG8_BAR;
            PG8_LDA(At, 1, 1); PG8_STAGE(PG8_SA(1, 0), a3, voffA);
            PG8_BAR; PG8_WAIT_L(0); PG8_MMA(1, 0, At, B0); PG8_BAR; PG8_SCHED;
            PG8_STAGE(PG8_SB(1, 1), b3 + hstep, voffB);
            PG8_WAIT_V(6); PG8_BAR; PG8_MMA(1, 1, At, B1); PG8_BAR;
            }
        }
        if constexpr (ALIGN_EPI) { if (wr == 0) PG8_BAR; }
        if constexpr (!Epi::AFTER_DRAIN) { E(acc, cur, wr, wc, fr, fq); S.done(cur); }
        if (!has_next) break;
#pragma unroll
        for (int a = 0; a < 2; ++a)
#pragma unroll
            for (int b = 0; b < 2; ++b)
#pragma unroll
                for (int m = 0; m < 4; ++m)
#pragma unroll
                    for (int n = 0; n < 2; ++n) acc[a][b][m][n] = (f32x4){0.f, 0.f, 0.f, 0.f};
        cur = nxt; cA = nA; cB = nB; ++ui;
        if constexpr (ALIGN_EPI) { if (wr == 1) PG8_BAR; }
    }
    PG8_WAIT_V(0);
    if constexpr (!ALIGN_EPI) { if (wr == 0) PG8_BAR; }
    PG8_BAR;
    if constexpr (Epi::AFTER_DRAIN) { E.fused(acc, cur, wr, wc, fr, fq, lds, wid, lane); S.done(cur); }
#undef PG8_SA
#undef PG8_SB
#undef PG8_STAGE
#undef PG8_LDA
#undef PG8_LDB
#undef PG8_MMA
#undef PG8_WAIT_V
#undef PG8_WAIT_L
#undef PG8_BAR
#undef PG8_SCHED
}
}
#define GAS __attribute__((address_space(1)))
#define LAS __attribute__((address_space(3)))
typedef unsigned short bf16;
typedef unsigned v4u __attribute__((ext_vector_type(4)));
typedef float f32x4 __attribute__((ext_vector_type(4)));
typedef short bf16x8 __attribute__((ext_vector_type(8)));
typedef GAS unsigned gu32;
typedef GAS unsigned long long gu64;
#define RLX_AGENT __ATOMIC_RELAXED, __HIP_MEMORY_SCOPE_AGENT
#define LDS_WAIT() asm volatile("s_waitcnt lgkmcnt(0)" ::: "memory")
#define VM_WAIT() asm volatile("s_waitcnt vmcnt(0)" ::: "memory")
__device__ __forceinline__ unsigned long long rt() { return __builtin_amdgcn_s_memrealtime(); }
__device__ __forceinline__ unsigned f2bf(float f) { unsigned u = __builtin_bit_cast(unsigned, f); return (u + 0x7fffu + ((u >> 16) & 1u)) >> 16; }
__device__ __forceinline__ unsigned pk2(float lo, float hi) { return f2bf(lo) | (f2bf(hi) << 16); }

#define XB_TMO      128
#define XB_XCNT(j)  (256  + 64 * (j))
#define XB_XSUB(j)  (1280 + 64 * (j))
#define XB_XGEN(j)  (2304 + 64 * (j))
#define XB_TOP      3328
#define XB_TOPGEN   3392
#define XCD_BAR_WORDS 3456
#define XB_SPIN_CAP (1u << 18)

__device__ __forceinline__ unsigned xb_ld(unsigned* p)              { return __hip_atomic_load(p, __ATOMIC_RELAXED, __HIP_MEMORY_SCOPE_AGENT); }
__device__ __forceinline__ unsigned xb_add(unsigned* p, unsigned v) { return __hip_atomic_fetch_add(p, v, __ATOMIC_RELAXED, __HIP_MEMORY_SCOPE_AGENT); }
__device__ __forceinline__ unsigned xb_xcc_id() { return (unsigned)__builtin_amdgcn_s_getreg((3 << 11) | 20) & 0xFu; }
#define XB_SPIN(cond, bar) do { unsigned _sp = 0; while (cond) { __builtin_amdgcn_s_sleep(1); \
    if ((++_sp & 255u) == 0u) { if (xb_ld(&(bar)[XB_TMO])) break; if (_sp > XB_SPIN_CAP) { atomicAdd(&(bar)[XB_TMO], 1u); break; } } } } while (0)

struct XcdBarrier {
    unsigned* bar; unsigned x;
    volatile LAS unsigned* st;
};

__device__ __forceinline__ XcdBarrier xcd_barrier_post(unsigned* bar, volatile LAS unsigned* st) {
    XcdBarrier b; b.bar = bar; b.x = xb_xcc_id(); b.st = st;
    if (threadIdx.x == 0) (void)xb_add(&bar[XB_XCNT(b.x)], 1u);
    return b;
}
__device__ __forceinline__ void xcd_barrier_complete(unsigned* bar, unsigned x, unsigned& nloc, unsigned& nx) {
    const unsigned G = gridDim.x * gridDim.y * gridDim.z;
    unsigned sum, cnt, mine, sp = 0u;
    for (;;) {
        sum = 0u; cnt = 0u; mine = 0u;
#pragma unroll
        for (unsigned j = 0; j < 16; ++j) { const unsigned c = xb_ld(&bar[XB_XCNT(j)]); sum += c; cnt += (c > 0u) ? 1u : 0u; mine = (j == x) ? c : mine; }
        if (sum == G) break;
        __builtin_amdgcn_s_sleep(1);
        if ((++sp & 255u) == 0u) { if (xb_ld(&bar[XB_TMO])) break; if (sp > XB_SPIN_CAP) { atomicAdd(&bar[XB_TMO], 1u); break; } }
    }
    nloc = mine > 0u ? mine : 1u; nx = cnt > 0u ? cnt : 1u;
}

__device__ __forceinline__ void xcd_barrier(const XcdBarrier& b) {
    asm volatile("s_waitcnt vmcnt(0)" ::: "memory");
    __syncthreads();
    if (threadIdx.x == 0) {
        unsigned* bar = b.bar;
        __builtin_amdgcn_s_waitcnt(0);
        unsigned nloc = b.st[0], nx = b.st[1];
        if (nloc == 0u) { xcd_barrier_complete(bar, b.x, nloc, nx); b.st[0] = nloc; b.st[1] = nx; }
        const unsigned old = xb_add(&bar[XB_XSUB(b.x)], 1u);
        const unsigned gen = old / nloc;
        if (old + 1u == (gen + 1u) * nloc) {
            __builtin_amdgcn_fence(__ATOMIC_RELEASE, "agent");
            asm volatile("s_waitcnt vmcnt(0)" ::: "memory");
            const unsigned og = xb_add(&bar[XB_TOP], 1u);
            const unsigned tg = og / nx;
            if (og + 1u == (tg + 1u) * nx) xb_add(&bar[XB_TOPGEN], 1u);
            else XB_SPIN(xb_ld(&bar[XB_TOPGEN]) == tg, bar);
            __builtin_amdgcn_fence(__ATOMIC_ACQUIRE, "agent");
            xb_add(&bar[XB_XGEN(b.x)], 1u);
            asm volatile("s_waitcnt vmcnt(0)" ::: "memory");
        } else {
            XB_SPIN(xb_ld(&bar[XB_XGEN(b.x)]) == gen, bar);
            __builtin_amdgcn_fence(__ATOMIC_ACQUIRE, "agent");
            asm volatile("s_waitcnt vmcnt(0)" ::: "memory");
        }
    }
    __syncthreads();
}

constexpr int T = 16384, D = 1024, SEQ = 8192, NCTX = 256, TCX = 512, DIN = 3840, MH = T + TCX;
constexpr int ZU = 0, ZV = 512, ZQ = 1024, ZK = 1536, ZVA = 1664, ZGA = 1792, ZGB = 2816;
constexpr int NEXP = 256, NSLOT = 9, LISTCAP = 16384;
constexpr float LOG2E = 1.4426950408889634f;
constexpr float QSCALE = 0.125f * LOG2E;
constexpr size_t MiB = 1u << 20;
constexpr size_t WS_CTL = 0, CTL_ZERO_BYTES = 1 * MiB;
constexpr size_t WS_ADAP = 1 * MiB;
constexpr size_t WS_ADAF = 2 * MiB;
constexpr size_t WS_ROPE = 2 * MiB + 128 * 1024;
constexpr size_t WS_WST = 2 * MiB + 256 * 1024;
constexpr size_t WS_RWT = 3 * MiB;
constexpr size_t WS_WINT = 4 * MiB;
constexpr size_t WS_WAT = 12 * MiB, WS_WBT = 13 * MiB, WS_WOT = 14 * MiB;
constexpr size_t WS_KVC = 16 * MiB;
constexpr size_t WS_GATEW = 17 * MiB;
constexpr size_t WS_H = 18 * MiB;
constexpr size_t WS_Z = 52 * MiB;
constexpr size_t WS_A = 172 * MiB, WS_O = 188 * MiB;
constexpr size_t WS_TMP = 204 * MiB;
constexpr size_t WS_Y = 268 * MiB;
constexpr size_t WS_X1 = 300 * MiB;
constexpr size_t WS_H2 = 364 * MiB;
constexpr size_t WS_LIST = 396 * MiB;
constexpr size_t WS_CONTRIB = 414 * MiB;
constexpr size_t WS_END = 704 * MiB;
constexpr int CW_BAR = 4096;
constexpr int CW_CNT = 16384;
constexpr int CW_XRANK = 32768;
constexpr int SCR_BYTES = 148480;
constexpr int MISC_OFF = SCR_BYTES;
constexpr int LDS_BYTES = 152 * 1024;
constexpr int NWAVES = 8;

typedef float f32x2_t __attribute__((ext_vector_type(2)));
typedef __bf16 bf16x2_t __attribute__((ext_vector_type(2)));
typedef float f32x16 __attribute__((ext_vector_type(16)));
typedef short s16x4 __attribute__((ext_vector_type(4)));
typedef short v4i16_t __attribute__((ext_vector_type(4)));
typedef unsigned u32x2 __attribute__((ext_vector_type(2)));
typedef unsigned u32x4 __attribute__((ext_vector_type(4)));
typedef LAS unsigned char* ldsp;

__device__ __forceinline__ unsigned cvtpk(float lo, float hi) { f32x2_t v = {lo, hi}; bf16x2_t b = __builtin_convertvector(v, bf16x2_t); return __builtin_bit_cast(unsigned, b); }
__device__ __forceinline__ float bf2f(unsigned short u) { return __uint_as_float((unsigned)u << 16); }
__device__ __forceinline__ float bflo(unsigned w) { return __uint_as_float(w << 16); }
__device__ __forceinline__ float bfhi(unsigned w) { return __uint_as_float(w & 0xffff0000u); }
__device__ __forceinline__ float wave_sum(float v) {
#pragma unroll
    for (int o = 1; o < 64; o <<= 1) v += __shfl_xor(v, o);
    return v;
}
__device__ __forceinline__ float sigmoid_f(float x) { return __builtin_amdgcn_rcpf(1.f + __builtin_amdgcn_exp2f(-x * LOG2E)); }
__device__ __forceinline__ float silu_f(float x) { return x * sigmoid_f(x); }
__device__ __forceinline__ float gelu_f(float x) { const float u = 0.7978845608028654f * (x + 0.044715f * x * x * x); return x * sigmoid_f(2.f * u); }
__device__ __forceinline__ f32x16 mfma32(bf16x8 a, bf16x8 b, f32x16 c) { return __builtin_amdgcn_mfma_f32_32x32x16_bf16(a, b, c, 0, 0, 0); }
__device__ __forceinline__ f32x4 mfma16(bf16x8 a, bf16x8 b, f32x4 c) { return __builtin_amdgcn_mfma_f32_16x16x32_bf16(a, b, c, 0, 0, 0); }

struct Args { const float* in[26]; float* out; unsigned char* ws; int ph_lo, ph_hi; };
enum { I_X = 0, I_C, I_CTX, I_CCTX, I_ADAW, I_ADAB, I_N1G, I_N2G, I_WIN, I_LNG, I_LNB, I_GWS, I_GBS, I_SINK, I_WA, I_WB, I_WO, I_RW, I_RB, I_EG, I_EU, I_ED, I_SG, I_SU, I_SD, I_FG };

__device__ __forceinline__ void p0_transpose_item(const float* W, int K, int N, bf16* WT, LAS float* scr, int item, int lane) {
    const int nblk = N / 32, kb = item / nblk, nb = item % nblk, k0 = 64 * kb, n0 = 32 * nb;
#pragma unroll 8
    for (int i = 0; i < 32; ++i) { const int kk = 2 * i + (lane >> 5); scr[kk * 33 + (lane & 31)] = W[(size_t)(k0 + kk) * N + n0 + (lane & 31)]; }
    LDS_WAIT(); asm volatile("" ::: "memory");
    const int c = lane & 7;
#pragma unroll
    for (int j = 0; j < 4; ++j) { const int n = (lane >> 3) + 8 * j; const LAS float* s = scr + (8 * c) * 33 + n;
        v4u o; o.x = pk2(s[0 * 33], s[1 * 33]); o.y = pk2(s[2 * 33], s[3 * 33]); o.z = pk2(s[4 * 33], s[5 * 33]); o.w = pk2(s[6 * 33], s[7 * 33]);
        *(GAS v4u*)(WT + (size_t)(n0 + n) * K + k0 + 8 * c) = o; }
    LDS_WAIT(); asm volatile("" ::: "memory");
}

__device__ __forceinline__ void phase_prep(const Args& a, ldsp lds, int G) {
    const int tid = threadIdx.x, lane = tid & 63, wave = __builtin_amdgcn_readfirstlane(tid >> 6), blk = blockIdx.x;
    unsigned char* ws = a.ws;
    if (blk < 192) {
        const int cb = blk % 24, kc = blk / 24, col = cb * 256 + lane * 4, k0 = kc * 128 + wave * 16;
        const float* c = a.in[I_C]; const float* cc = a.in[I_CCTX]; const float* aw = a.in[I_ADAW];
        f32x4 a0 = {0.f, 0.f, 0.f, 0.f}, a1 = a0, a2 = a0;
#pragma unroll 4
        for (int k = 0; k < 16; ++k) {
            const int kk = k0 + k;
            const float s0 = silu_f(c[kk]), s1 = silu_f(c[1024 + kk]), s2 = silu_f(cc[kk]);
            const f32x4 w = *(const f32x4*)(aw + (size_t)kk * 6144 + col);
            a0 += w * s0; a1 += w * s1; a2 += w * s2;
        }
        LAS float* red = (LAS float*)lds;
        *(LAS f32x4*)(red + (wave * 3 + 0) * 256 + lane * 4) = a0;
        *(LAS f32x4*)(red + (wave * 3 + 1) * 256 + lane * 4) = a1;
        *(LAS f32x4*)(red + (wave * 3 + 2) * 256 + lane * 4) = a2;
        __syncthreads();
        float* adap = (float*)(ws + WS_ADAP);
        for (int idx = tid; idx < 768; idx += 512) {
            const int v = idx >> 8, cl = idx & 255; float s = 0.f;
#pragma unroll
            for (int w = 0; w < 8; ++w) s += red[(w * 3 + v) * 256 + cl];
            adap[(size_t)(kc * 3 + v) * 6144 + cb * 256 + cl] = s;
        }
        __syncthreads();
    }
    {
        LAS float* scr = (LAS float*)(lds + wave * 8704);
        const int gw = blk * NWAVES + wave, NGW = G * NWAVES;
        constexpr int I_1 = 16 * 120, I_2 = 8 * 32, I_3 = 8 * 32, I_4 = 16 * 32, I_5 = 16 * 8;
        for (int it = gw; it < I_1 + I_2 + I_3 + I_4 + I_5; it += NGW) {
            int r = it;
            if (r < I_1) { p0_transpose_item(a.in[I_WIN], 1024, 3840, (bf16*)(ws + WS_WINT), scr, r, lane); continue; } r -= I_1;
            if (r < I_2) { p0_transpose_item(a.in[I_WA], 512, 1024, (bf16*)(ws + WS_WAT), scr, r, lane); continue; } r -= I_2;
            if (r < I_3) { p0_transpose_item(a.in[I_WB], 512, 1024, (bf16*)(ws + WS_WBT), scr, r, lane); continue; } r -= I_3;
            if (r < I_4) { p0_transpose_item(a.in[I_WO], 1024, 1024, (bf16*)(ws + WS_WOT), scr, r, lane); continue; } r -= I_4;
            p0_transpose_item(a.in[I_RW], 1024, 256, (bf16*)(ws + WS_RWT), scr, r, lane);
        }
    }
    {
        const int gt = blk * 512 + tid, NT = G * 512;
        const float* gws = a.in[I_GWS]; bf16* wst = (bf16*)(ws + WS_WST);
        for (int i = gt; i < 8192; i += NT) {
            const f32x4 x0 = *(const f32x4*)(gws + i * 8), x1 = *(const f32x4*)(gws + i * 8 + 4);
            v4u o; o.x = cvtpk(x0[0], x0[1]); o.y = cvtpk(x0[2], x0[3]); o.z = cvtpk(x1[0], x1[1]); o.w = cvtpk(x1[2], x1[3]);
            *(v4u*)(wst + i * 8) = o;
        }
        float* rope = (float*)(ws + WS_ROPE);
        for (int i = gt; i < 2048; i += NT) {
            const int pos = i >> 4, f = i & 15;
            const float inv = __builtin_amdgcn_exp2f(-(float)f * (13.287712379549449f / 16.f));
            const float ang = (float)pos * inv;
            double rev = (double)ang * 0.15915494309189535; rev -= floor(rev);
            rope[pos * 32 + f] = __builtin_amdgcn_cosf((float)rev);
            rope[pos * 32 + 16 + f] = __builtin_amdgcn_sinf((float)rev);
        }
    }
}

__device__ __forceinline__ void phase_hnorm(const Args& a, ldsp lds, int G) {
    const int tid = threadIdx.x, lane = tid & 63, wave = __builtin_amdgcn_readfirstlane(tid >> 6), blk = blockIdx.x;
    unsigned char* ws = a.ws;
    const float* adap = (const float*)(ws + WS_ADAP); const float* adab = a.in[I_ADAB];
    LAS float* modv = (LAS float*)lds;
    for (int idx = tid; idx < 3 * 2048; idx += 512) {
        const int v = idx >> 11, j = idx & 2047; float s = adab[j];
#pragma unroll
        for (int kc = 0; kc < 8; ++kc) s += adap[(size_t)(kc * 3 + v) * 6144 + j];
        modv[idx] = (j >= 1024) ? s + 1.f : s;
    }
    { float* adaf = (float*)(ws + WS_ADAF);
      for (int idx = blk * 512 + tid; idx < 3 * 6144; idx += G * 512) {
          const int v = idx / 6144, j = idx % 6144; float s = adab[j];
#pragma unroll
          for (int kc = 0; kc < 8; ++kc) s += adap[(size_t)(kc * 3 + v) * 6144 + j];
          adaf[idx] = s; } }
    __syncthreads();
    const float* g1 = a.in[I_N1G]; bf16* H = (bf16*)(ws + WS_H);
    for (int t = blk * NWAVES + wave; t < MH; t += G * NWAVES) {
        const float* xr = (t < T) ? a.in[I_X] + (size_t)t * D : a.in[I_CTX] + (size_t)(t - T) * D;
        const int v = (t < T) ? (t >> 13) : 2;
        f32x4 x[4]; float ss = 0.f;
#pragma unroll
        for (int j = 0; j < 4; ++j) { x[j] = *(const f32x4*)(xr + 4 * lane + 256 * j); ss += (x[j][0] * x[j][0] + x[j][1] * x[j][1]) + (x[j][2] * x[j][2] + x[j][3] * x[j][3]); }
        const float r = rsqrtf(wave_sum(ss) * (1.f / D) + 1e-6f);
#pragma unroll
        for (int j = 0; j < 4; ++j) {
            const int col = 4 * lane + 256 * j;
            const f32x4 g = *(const f32x4*)(g1 + col);
            const f32x4 sh = *(LAS f32x4*)(modv + v * 2048 + col), sc = *(LAS f32x4*)(modv + v * 2048 + 1024 + col);
            const f32x4 h = (x[j] * r) * g * sc + sh;
            u32x2 o; o.x = cvtpk(h[0], h[1]); o.y = cvtpk(h[2], h[3]);
            *(u32x2*)(H + (size_t)t * D + col) = o;
        }
    }
}

struct WinOrder {
    pg8::StaticOrder so;
    __device__ void init(int G, int c) { so.init(T, DIN, G, c); }
    __device__ bool next(int i, pg8::Unit& u) const {
        const long L = (long)i * so.G + so.c;
        if (L < 960) return so.next(i, u);
        if (L < 962) { u.pm = 64 + (int)(L - 960); u.pn = 6; return true; }
        return false;
    }
    __device__ __forceinline__ void a_ready(const pg8::Unit&) const {}
    __device__ __forceinline__ void done(const pg8::Unit&) const {}
};
struct EpiWin {
    static constexpr bool PERM = false, AFTER_DRAIN = false;
    bf16* Z; bf16* KVC; const float* rope;
    __device__ __forceinline__ void operator()(const pg8::f32x4 (&acc)[2][2][4][2], const pg8::Unit& u, int wr, int wc, int fr, int fq) const {
        const int row0 = u.pm * 256 + wr * 64 + fr, colb = u.pn * 256 + wc * 32 + 4 * fq, pn = u.pn;
        if (u.pm >= 64) {
#pragma unroll
            for (int ai = 0; ai < 2; ++ai)
#pragma unroll
                for (int m = 0; m < 4; ++m) { bf16* rp = KVC + (size_t)(row0 + ai * 128 + m * 16 - T) * 256 + (colb - ZK);
#pragma unroll
                    for (int bj = 0; bj < 2; ++bj)
#pragma unroll
                        for (int n = 0; n < 2; ++n) { const pg8::f32x4 v = acc[ai][bj][m][n]; u32x2 o; o.x = cvtpk(v[0], v[1]); o.y = cvtpk(v[2], v[3]); *(u32x2*)(rp + bj * 128 + n * 16) = o; } }
            return;
        }
#pragma unroll
        for (int ai = 0; ai < 2; ++ai)
#pragma unroll
            for (int m = 0; m < 4; ++m) {
                const int r = row0 + ai * 128 + m * 16; bf16* rp = Z + (size_t)r * DIN + colb;
                if (pn <= 3) {
#pragma unroll
                    for (int bj = 0; bj < 2; ++bj)
#pragma unroll
                        for (int n = 0; n < 2; ++n) { const pg8::f32x4 v = acc[ai][bj][m][n]; u32x2 o; o.x = cvtpk(gelu_f(v[0]), gelu_f(v[1])); o.y = cvtpk(gelu_f(v[2]), gelu_f(v[3])); *(u32x2*)(rp + bj * 128 + n * 16) = o; }
                } else if (pn <= 6) {
                    const int pos = (wc & 1) ? (r & 63) : ((r & 8191) >> 6);
                    const pg8::f32x4 cs = *(const pg8::f32x4*)(rope + pos * 32 + 4 * fq), sn = *(const pg8::f32x4*)(rope + pos * 32 + 16 + 4 * fq);
                    const float sc = (pn < 6) ? QSCALE : 1.f;
#pragma unroll
                    for (int bj = 0; bj < 2; ++bj) {
                        const pg8::f32x4 x1 = acc[ai][bj][m][0], x2 = acc[ai][bj][m][1];
                        pg8::f32x4 o1, o2;
                        if (pn == 6 && bj == 1) { o1 = x1; o2 = x2; }
                        else { o1 = (x1 * cs - x2 * sn) * sc; o2 = (x2 * cs + x1 * sn) * sc; }
                        u32x2 w1, w2; w1.x = cvtpk(o1[0], o1[1]); w1.y = cvtpk(o1[2], o1[3]); w2.x = cvtpk(o2[0], o2[1]); w2.y = cvtpk(o2[2], o2[3]);
                        *(u32x2*)(rp + bj * 128) = w1; *(u32x2*)(rp + bj * 128 + 16) = w2;
                    }
                } else {
#pragma unroll
                    for (int bj = 0; bj < 2; ++bj)
#pragma unroll
                        for (int n = 0; n < 2; ++n) { const pg8::f32x4 v = acc[ai][bj][m][n]; u32x2 o; o.x = cvtpk(sigmoid_f(v[0]), sigmoid_f(v[1])); o.y = cvtpk(sigmoid_f(v[2]), sigmoid_f(v[3])); *(u32x2*)(rp + bj * 128 + n * 16) = o; }
                }
            }
    }
};
struct EpiMergeA {
    static constexpr bool PERM = true, AFTER_DRAIN = false;
    const bf16* Z; bf16* Y;
    __device__ __forceinline__ void operator()(const pg8::f32x4 (&acc)[2][2][4][2], const pg8::Unit& u, int wr, int wc, int fr, int fq) const {
        const int row0 = u.pm * 256 + wr * 64 + fr, col0 = u.pn * 256 + wc * 32 + 8 * fq;
#pragma unroll
        for (int ai = 0; ai < 2; ++ai)
#pragma unroll
            for (int m = 0; m < 4; ++m) { const int r = row0 + ai * 128 + m * 16;
#pragma unroll
                for (int bj = 0; bj < 2; ++bj) { const int c = col0 + bj * 128;
                    const u32x4 g = *(const u32x4*)(Z + (size_t)r * DIN + ZGA + c);
                    const pg8::f32x4 v0 = acc[ai][bj][m][0], v1 = acc[ai][bj][m][1];
                    u32x4 o;
                    o.x = cvtpk(v0[0] * bflo(g.x), v0[1] * bfhi(g.x)); o.y = cvtpk(v0[2] * bflo(g.y), v0[3] * bfhi(g.y));
                    o.z = cvtpk(v1[0] * bflo(g.z), v1[1] * bfhi(g.z)); o.w = cvtpk(v1[2] * bflo(g.w), v1[3] * bfhi(g.w));
                    *(u32x4*)(Y + (size_t)r * D + c) = o; } }
    }
};
struct EpiMergeB {
    static constexpr bool PERM = true, AFTER_DRAIN = false;
    const bf16* Z; bf16* Y;
    __device__ __forceinline__ void operator()(const pg8::f32x4 (&acc)[2][2][4][2], const pg8::Unit& u, int wr, int wc, int fr, int fq) const {
        const int row0 = u.pm * 256 + wr * 64 + fr, col0 = u.pn * 256 + wc * 32 + 8 * fq;
#pragma unroll
        for (int ai = 0; ai < 2; ++ai)
#pragma unroll
            for (int m = 0; m < 4; ++m) { const int r = row0 + ai * 128 + m * 16;
#pragma unroll
                for (int bj = 0; bj < 2; ++bj) { const int c = col0 + bj * 128;
                    const u32x4 g = *(const u32x4*)(Z + (size_t)r * DIN + ZGB + c);
                    const u32x4 tp = *(const u32x4*)(Y + (size_t)r * D + c);
                    const pg8::f32x4 t0 = {bflo(tp.x), bfhi(tp.x), bflo(tp.y), bfhi(tp.y)}, t1 = {bflo(tp.z), bfhi(tp.z), bflo(tp.w), bfhi(tp.w)};
                    const pg8::f32x4 v0 = acc[ai][bj][m][0], v1 = acc[ai][bj][m][1];
                    u32x4 o;
                    o.x = cvtpk(t0[0] + v0[0] * bflo(g.x), t0[1] + v0[1] * bfhi(g.x)); o.y = cvtpk(t0[2] + v0[2] * bflo(g.y), t0[3] + v0[3] * bfhi(g.y));
                    o.z = cvtpk(t1[0] + v1[0] * bflo(g.z), t1[1] + v1[1] * bfhi(g.z)); o.w = cvtpk(t1[2] + v1[2] * bflo(g.w), t1[3] + v1[3] * bfhi(g.w));
                    *(u32x4*)(Y + (size_t)r * D + c) = o; } }
    }
};
struct EpiWo {
    static constexpr bool PERM = true, AFTER_DRAIN = false;
    const float* x; const float* adaf; bf16* X1;
    __device__ __forceinline__ void operator()(const pg8::f32x4 (&acc)[2][2][4][2], const pg8::Unit& u, int wr, int wc, int fr, int fq) const {
        const int row0 = u.pm * 256 + wr * 64 + fr, col0 = u.pn * 256 + wc * 32 + 8 * fq;
        const float* g1 = adaf + (u.pm >= 32 ? 6144 : 0) + 2048;
#pragma unroll
        for (int bj = 0; bj < 2; ++bj) { const int c = col0 + bj * 128;
            const pg8::f32x4 ga = *(const pg8::f32x4*)(g1 + c), gb = *(const pg8::f32x4*)(g1 + c + 4);
#pragma unroll
            for (int ai = 0; ai < 2; ++ai)
#pragma unroll
                for (int m = 0; m < 4; ++m) { const int r = row0 + ai * 128 + m * 16;
                    const pg8::f32x4 x0 = *(const pg8::f32x4*)(x + (size_t)r * D + c), x1 = *(const pg8::f32x4*)(x + (size_t)r * D + c + 4);
                    const pg8::f32x4 o0 = x0 + ga * acc[ai][bj][m][0], o1 = x1 + gb * acc[ai][bj][m][1];
                    u32x4 w; w.x = cvtpk(o0[0], o0[1]); w.y = cvtpk(o0[2], o0[3]); w.z = cvtpk(o1[0], o1[1]); w.w = cvtpk(o1[2], o1[3]);
                    *(u32x4*)(X1 + (size_t)r * D + c) = w; } }
    }
};

__device__ __forceinline__ s16x4 vtr(LAS const unsigned char* p) { return __builtin_bit_cast(s16x4, __builtin_amdgcn_ds_read_tr16_b64_v4i16((LAS v4i16_t*)p)); }

__device__ __forceinline__ void attn_item(const bf16* Z, const bf16* KVC, const float* sink, bf16* Obuf, ldsp lds, int b, int nb, int hk, int qh) {
    const int tid = threadIdx.x, lane = tid & 63, wave = __builtin_amdgcn_readfirstlane(tid >> 6), r32 = lane & 31, hi = lane >> 5;
    const int rq = wave >> 1, head = hk * 4 + rq;
    const int iq = qh * 64 + (wave & 1) * 32 + r32;
    const int wlo = (nb == 0) ? 2 : qh, whi = (nb == 63) ? 4 : 5 + qh, nwin = whi - wlo, ntile = nwin + 4;
    const int tokq = b * SEQ + nb * 128 + iq;
    bf16x8 qr[4];
#pragma unroll
    for (int d0 = 0; d0 < 4; ++d0) qr[d0] = *(const bf16x8*)(Z + (size_t)tokq * DIN + ZQ + head * 64 + d0 * 16 + hi * 8);
    float mrun = sink[head] * LOG2E, lrun = (hi == 0) ? 1.f : 0.f;
    f32x16 o[2];
#pragma unroll
    for (int j = 0; j < 2; ++j)
#pragma unroll
        for (int r = 0; r < 16; ++r) o[j][r] = 0.f;
    const int kdst = wave * 1024 + lane * 16, vdst = 8192 + (wave >> 2) * 4096 + lane * 64 + (wave & 3) * 16;
#define ATT_SRC(s, kp, vp) do { const int tl_ = (s) < nwin ? wlo + (s) : 6 + (s) - nwin; \
        if (tl_ < 6) { const int tok_ = b * SEQ + (nb - 1 + (tl_ >> 1)) * 128 + (tl_ & 1) * 64 + lane; kp = Z + (size_t)tok_ * DIN + ZK + hk * 64 + wave * 8; vp = Z + (size_t)tok_ * DIN + ZVA + hk * 64 + wave * 8; } \
        else { const int row_ = b * NCTX + (tl_ - 6) * 64 + lane; kp = KVC + (size_t)row_ * 256 + hk * 64 + wave * 8; vp = KVC + (size_t)row_ * 256 + 128 + hk * 64 + wave * 8; } } while (0)
    u32x4 kreg, vreg;
    { const bf16 *kp, *vp; ATT_SRC(0, kp, vp); kreg = *(const u32x4*)kp; vreg = *(const u32x4*)vp; }
    *(LAS u32x4*)(lds + kdst) = kreg; *(LAS u32x4*)(lds + vdst) = vreg;
    __syncthreads();
    const int vrd = ((lane & 15) >> 2) * 64 + ((lane >> 4) & 1) * 32 + (lane & 3) * 8 + hi * 256;
    for (int s = 0; s < ntile; ++s) {
        const int base = (s & 1) * 16384;
        const int tl = s < nwin ? wlo + s : 6 + s - nwin;
        if (s + 1 < ntile) { const bf16 *kp, *vp; ATT_SRC(s + 1, kp, vp); kreg = *(const u32x4*)kp; vreg = *(const u32x4*)vp; }
        {
            f32x16 p0, p1;
#pragma unroll
            for (int r = 0; r < 16; ++r) { p0[r] = 0.f; p1[r] = 0.f; }
#pragma unroll
            for (int d0 = 0; d0 < 4; ++d0) {
                const bf16x8 k0 = *(LAS const bf16x8*)(lds + base + (2 * d0 + hi) * 1024 + r32 * 16);
                const bf16x8 k1 = *(LAS const bf16x8*)(lds + base + (2 * d0 + hi) * 1024 + (r32 + 32) * 16);
                p0 = mfma32(k0, qr[d0], p0); p1 = mfma32(k1, qr[d0], p1);
            }
            if (tl < 2) {
                const int j0 = (tl & 1) * 64 + 4 * hi;
#pragma unroll
                for (int r = 0; r < 16; ++r) { const int j = j0 + (r & 3) + 8 * (r >> 2); if (j < iq) p0[r] = -INFINITY; if (j + 32 < iq) p1[r] = -INFINITY; }
            } else if (tl == 4 || tl == 5) {
                const int j0 = (tl & 1) * 64 + 4 * hi;
#pragma unroll
                for (int r = 0; r < 16; ++r) { const int j = j0 + (r & 3) + 8 * (r >> 2); if (j > iq) p0[r] = -INFINITY; if (j + 32 > iq) p1[r] = -INFINITY; }
            }
            float mx = fmaxf(p0[0], p1[0]);
#pragma unroll
            for (int r = 1; r < 16; ++r) mx = fmaxf(mx, fmaxf(p0[r], p1[r]));
            mx = fmaxf(mx, __shfl_xor(mx, 32));
            const float mn = fmaxf(mrun, mx), alpha = __builtin_amdgcn_exp2f(mrun - mn);
            mrun = mn;
            float rs = 0.f;
#pragma unroll
            for (int r = 0; r < 16; ++r) { p0[r] = __builtin_amdgcn_exp2f(p0[r] - mn); p1[r] = __builtin_amdgcn_exp2f(p1[r] - mn); rs += p0[r] + p1[r]; }
            lrun = lrun * alpha + rs;
#pragma unroll
            for (int r = 0; r < 16; ++r) { o[0][r] *= alpha; o[1][r] *= alpha; }
            bf16x8 pf[4];
#pragma unroll
            for (int s4 = 0; s4 < 4; ++s4) {
                u32x4 w;
                if (s4 < 2) { w.x = cvtpk(p0[8 * s4 + 0], p0[8 * s4 + 1]); w.y = cvtpk(p0[8 * s4 + 2], p0[8 * s4 + 3]); w.z = cvtpk(p0[8 * s4 + 4], p0[8 * s4 + 5]); w.w = cvtpk(p0[8 * s4 + 6], p0[8 * s4 + 7]); }
                else { const int q = s4 - 2; w.x = cvtpk(p1[8 * q + 0], p1[8 * q + 1]); w.y = cvtpk(p1[8 * q + 2], p1[8 * q + 3]); w.z = cvtpk(p1[8 * q + 4], p1[8 * q + 5]); w.w = cvtpk(p1[8 * q + 6], p1[8 * q + 7]); }
                pf[s4] = __builtin_bit_cast(bf16x8, w);
            }
#pragma unroll
            for (int dblk = 0; dblk < 2; ++dblk)
#pragma unroll
                for (int s4 = 0; s4 < 4; ++s4) {
                    const s16x4 lo = vtr(lds + base + 8192 + dblk * 4096 + vrd + (16 * s4) * 64);
                    const s16x4 hh = vtr(lds + base + 8192 + dblk * 4096 + vrd + (16 * s4 + 8) * 64);
                    const bf16x8 vf = {lo[0], lo[1], lo[2], lo[3], hh[0], hh[1], hh[2], hh[3]};
                    o[dblk] = mfma32(vf, pf[s4], o[dblk]);
                }
        }
        if (s + 1 < ntile) { *(LAS u32x4*)(lds + (16384 - base) + kdst) = kreg; *(LAS u32x4*)(lds + (16384 - base) + vdst) = vreg; }
        __syncthreads();
    }
#undef ATT_SRC
    {
        const float lt = lrun + __shfl_xor(lrun, 32), inv = 1.f / lt;
        bf16* op = Obuf + (size_t)tokq * 512 + head * 64;
#pragma unroll
        for (int dblk = 0; dblk < 2; ++dblk)
#pragma unroll
            for (int r4 = 0; r4 < 4; ++r4) {
                u32x2 w; w.x = cvtpk(o[dblk][4 * r4] * inv, o[dblk][4 * r4 + 1] * inv); w.y = cvtpk(o[dblk][4 * r4 + 2] * inv, o[dblk][4 * r4 + 3] * inv);
                *(u32x2*)(op + 32 * dblk + 8 * r4 + 4 * hi) = w;
            }
    }
}

__device__ __forceinline__ void gmlp_item(const bf16* Z, const float* lng, const float* lnb, const bf16* WsT, const float* bs, bf16* Abuf, ldsp lds, int ch, int g) {
    const int tid = threadIdx.x, lane = tid & 63, wave = __builtin_amdgcn_readfirstlane(tid >> 6), fr = lane & 15, fq = lane >> 4;
    const int tok0 = ch * 128;
    LAS bf16* VT = (LAS bf16*)lds;
    f32x4 gA = *(const f32x4*)(lng + lane * 8), gB = *(const f32x4*)(lng + lane * 8 + 4), bA = *(const f32x4*)(lnb + lane * 8), bB = *(const f32x4*)(lnb + lane * 8 + 4);
#pragma unroll
    for (int rnd = 0; rnd < 2; ++rnd) {
        float y[8][8];
#pragma unroll
        for (int j = 0; j < 8; ++j) {
            const int tok = tok0 + wave * 16 + rnd * 8 + j;
            const u32x4 raw = *(const u32x4*)(Z + (size_t)tok * DIN + ZV + lane * 8);
            float x[8] = {bflo(raw.x), bfhi(raw.x), bflo(raw.y), bfhi(raw.y), bflo(raw.z), bfhi(raw.z), bflo(raw.w), bfhi(raw.w)};
            float s = 0.f;
#pragma unroll
            for (int i = 0; i < 8; ++i) s += x[i];
            const float mu = wave_sum(s) * (1.f / 512.f);
            float q = 0.f;
#pragma unroll
            for (int i = 0; i < 8; ++i) { x[i] -= mu; q += x[i] * x[i]; }
            const float rstd = rsqrtf(wave_sum(q) * (1.f / 512.f) + 1e-6f);
            y[j][0] = x[0] * rstd * gA[0] + bA[0]; y[j][1] = x[1] * rstd * gA[1] + bA[1]; y[j][2] = x[2] * rstd * gA[2] + bA[2]; y[j][3] = x[3] * rstd * gA[3] + bA[3];
            y[j][4] = x[4] * rstd * gB[0] + bB[0]; y[j][5] = x[5] * rstd * gB[1] + bB[1]; y[j][6] = x[6] * rstd * gB[2] + bB[2]; y[j][7] = x[7] * rstd * gB[3] + bB[3];
        }
        if ((lane >> 4) == g) {
#pragma unroll
            for (int i = 0; i < 8; ++i) {
                u32x4 w; w.x = cvtpk(y[0][i], y[1][i]); w.y = cvtpk(y[2][i], y[3][i]); w.z = cvtpk(y[4][i], y[5][i]); w.w = cvtpk(y[6][i], y[7][i]);
                *(LAS u32x4*)(VT + (8 * (lane & 15) + i) * 136 + wave * 16 + rnd * 8) = w;
            }
        }
    }
    __syncthreads();
    const int wm = wave >> 1, wn = wave & 1;
    f32x4 acc[2][4];
#pragma unroll
    for (int m = 0; m < 2; ++m)
#pragma unroll
        for (int n = 0; n < 4; ++n) acc[m][n] = (f32x4){0.f, 0.f, 0.f, 0.f};
#pragma unroll
    for (int ks = 0; ks < 4; ++ks) {
        bf16x8 af[2], bfr[4];
#pragma unroll
        for (int m = 0; m < 2; ++m) af[m] = *(const bf16x8*)(WsT + (size_t)g * 16384 + (32 * wm + 16 * m + fr) * 128 + 32 * ks + 8 * fq);
#pragma unroll
        for (int n = 0; n < 4; ++n) bfr[n] = *(LAS const bf16x8*)(VT + (64 * wn + 16 * n + fr) * 136 + 32 * ks + 8 * fq);
#pragma unroll
        for (int m = 0; m < 2; ++m)
#pragma unroll
            for (int n = 0; n < 4; ++n) acc[m][n] = mfma16(af[m], bfr[n], acc[m][n]);
    }
#pragma unroll
    for (int m = 0; m < 2; ++m)
#pragma unroll
        for (int reg = 0; reg < 4; ++reg) {
            const int p = 32 * wm + 16 * m + 4 * fq + reg, tok = tok0 + p; const float bias = bs[g * 128 + p];
#pragma unroll
            for (int n = 0; n < 4; ++n) {
                const int c = g * 128 + 64 * wn + 16 * n + fr;
                const float uu = bf2f(Z[(size_t)tok * DIN + ZU + c]);
                Abuf[(size_t)tok * 512 + c] = (bf16)(cvtpk(uu * (acc[m][n][reg] + bias), 0.f) & 0xffffu);
            }
        }
    __syncthreads();
}

__device__ __forceinline__ void phase_mixers(const Args& a, ldsp lds, int G, int vcu) {
    unsigned char* ws = a.ws;
    const bf16* Z = (const bf16*)(ws + WS_Z);
    for (int it = vcu; it < 512; it += G) {
        const int qh = it & 1, hk = (it >> 1) & 1, nb = (it >> 2) & 63, b = it >> 8;
        attn_item(Z, (const bf16*)(ws + WS_KVC), a.in[I_SINK], (bf16*)(ws + WS_O), lds, b, nb, hk, qh);
    }
    for (int it = vcu; it < 512; it += G) {
        gmlp_item(Z, a.in[I_LNG], a.in[I_LNB], (const bf16*)(ws + WS_WST), a.in[I_GBS], (bf16*)(ws + WS_A), lds, it >> 2, it & 3);
    }
}

#define KI_BEFORE(ka, ia, kb, ib) (((ka) > (kb)) || ((ka) == (kb) && (ia) < (ib)))
#define KI_CAS(K, I, p, q) do { const bool sw_ = KI_BEFORE(K[q], I[q], K[p], I[p]); const float kp_ = sw_ ? K[q] : K[p], kq_ = sw_ ? K[p] : K[q]; const int ip_ = sw_ ? I[q] : I[p], iq_ = sw_ ? I[p] : I[q]; \
        K[p] = kp_; I[p] = ip_; K[q] = kq_; I[q] = iq_; } while (0)
#define KI_SORT8(K, I) do { KI_CAS(K, I, 0, 1); KI_CAS(K, I, 2, 3); KI_CAS(K, I, 4, 5); KI_CAS(K, I, 6, 7); \
        KI_CAS(K, I, 0, 2); KI_CAS(K, I, 1, 3); KI_CAS(K, I, 4, 6); KI_CAS(K, I, 5, 7); \
        KI_CAS(K, I, 1, 2); KI_CAS(K, I, 5, 6); KI_CAS(K, I, 0, 4); KI_CAS(K, I, 3, 7); \
        KI_CAS(K, I, 1, 5); KI_CAS(K, I, 2, 6); KI_CAS(K, I, 1, 4); KI_CAS(K, I, 3, 6); \
        KI_CAS(K, I, 2, 4); KI_CAS(K, I, 3, 5); KI_CAS(K, I, 3, 4); } while (0)
#define KI_MERGE8(KA, IA, KB, IB) do { \
        _Pragma("unroll") for (int r_ = 0; r_ < 8; ++r_) { const bool tb_ = KI_BEFORE(KB[7 - r_], IB[7 - r_], KA[r_], IA[r_]); KA[r_] = tb_ ? KB[7 - r_] : KA[r_]; IA[r_] = tb_ ? IB[7 - r_] : IA[r_]; } \
        KI_CAS(KA, IA, 0, 4); KI_CAS(KA, IA, 1, 5); KI_CAS(KA, IA, 2, 6); KI_CAS(KA, IA, 3, 7); \
        KI_CAS(KA, IA, 0, 2); KI_CAS(KA, IA, 1, 3); KI_CAS(KA, IA, 4, 6); KI_CAS(KA, IA, 5, 7); \
        KI_CAS(KA, IA, 0, 1); KI_CAS(KA, IA, 2, 3); KI_CAS(KA, IA, 4, 5); KI_CAS(KA, IA, 6, 7); } while (0)
__device__ __forceinline__ void router_item(const Args& a, ldsp lds, int it) {
    const int tid = threadIdx.x, lane = tid & 63, wave = __builtin_amdgcn_readfirstlane(tid >> 6), fr = lane & 15, fq = lane >> 4;
    unsigned char* ws = a.ws;
    const int t0 = it * 64, b = t0 >> 13;
    const bf16* X1 = (const bf16*)(ws + WS_X1); const float* adaf = (const float*)(ws + WS_ADAF) + b * 6144;
    const float* g2 = a.in[I_N2G]; bf16* H2 = (bf16*)(ws + WS_H2);
    {
        f32x4 gm[2][2], sh[2][2];
#pragma unroll
        for (int j = 0; j < 2; ++j)
#pragma unroll
            for (int h = 0; h < 2; ++h) {
                const int c = 8 * lane + 512 * j + 4 * h;
                const f32x4 gg = *(const f32x4*)(g2 + c), sc = *(const f32x4*)(adaf + 4 * 1024 + c);
                gm[j][h] = gg * (sc + 1.f); sh[j][h] = *(const f32x4*)(adaf + 3 * 1024 + c);
            }
#pragma unroll
        for (int half = 0; half < 2; ++half) {
            f32x4 x[4][2][2];
#pragma unroll
            for (int tt = 0; tt < 4; ++tt)
#pragma unroll
                for (int j = 0; j < 2; ++j) {
                    const u32x4 w = *(const u32x4*)(X1 + (size_t)(t0 + wave * 8 + half * 4 + tt) * D + 8 * lane + 512 * j);
                    x[tt][j][0] = (f32x4){bflo(w.x), bfhi(w.x), bflo(w.y), bfhi(w.y)}; x[tt][j][1] = (f32x4){bflo(w.z), bfhi(w.z), bflo(w.w), bfhi(w.w)};
                }
#pragma unroll
            for (int tt = 0; tt < 4; ++tt) {
                const int row = wave * 8 + half * 4 + tt, tok = t0 + row;
                float ss = 0.f;
#pragma unroll
                for (int j = 0; j < 2; ++j)
#pragma unroll
                    for (int h = 0; h < 2; ++h) { const f32x4 v = x[tt][j][h]; ss += (v[0] * v[0] + v[1] * v[1]) + (v[2] * v[2] + v[3] * v[3]); }
                const float r = rsqrtf(wave_sum(ss) * (1.f / D) + 1e-6f);
#pragma unroll
                for (int j = 0; j < 2; ++j) {
                    const f32x4 h0 = (x[tt][j][0] * r) * gm[j][0] + sh[j][0], h1 = (x[tt][j][1] * r) * gm[j][1] + sh[j][1];
                    u32x4 w; w.x = cvtpk(h0[0], h0[1]); w.y = cvtpk(h0[2], h0[3]); w.z = cvtpk(h1[0], h1[1]); w.w = cvtpk(h1[2], h1[3]);
                    *(u32x4*)(H2 + (size_t)tok * D + 8 * lane + 512 * j) = w;
                    const int kc = lane + 64 * j;
                    *(LAS u32x4*)(lds + kc * 1024 + ((row ^ (kc & 7)) * 16)) = w;
                }
            }
        }
    }
    __syncthreads();
    f32x4 acc[4][2];
#pragma unroll
    for (int m = 0; m < 4; ++m)
#pragma unroll
        for (int n = 0; n < 2; ++n) acc[m][n] = (f32x4){0.f, 0.f, 0.f, 0.f};
    const bf16* RwT = (const bf16*)(ws + WS_RWT) + (size_t)(32 * wave + fr) * D + 8 * fq;
#pragma unroll 8
    for (int ks = 0; ks < 32; ++ks) {
        const int kc = 4 * ks + fq;
        bf16x8 af[4], bfr[2];
#pragma unroll
        for (int n = 0; n < 2; ++n) bfr[n] = *(const bf16x8*)(RwT + (size_t)(16 * n) * D + 32 * ks);
#pragma unroll
        for (int m = 0; m < 4; ++m) af[m] = *(LAS const bf16x8*)(lds + kc * 1024 + (((16 * m + fr) ^ (kc & 7)) * 16));
#pragma unroll
        for (int m = 0; m < 4; ++m)
#pragma unroll
            for (int n = 0; n < 2; ++n) acc[m][n] = mfma16(af[m], bfr[n], acc[m][n]);
    }
    __syncthreads();
    LAS float* LG = (LAS float*)lds;
#pragma unroll
    for (int m = 0; m < 4; ++m)
#pragma unroll
        for (int n = 0; n < 2; ++n)
#pragma unroll
            for (int reg = 0; reg < 4; ++reg) LG[(32 * wave + 16 * n + fr) * 65 + 16 * m + 4 * fq + reg] = acc[m][n][reg];
    __syncthreads();
    LAS float* CK = (LAS float*)(lds + 69632); LAS int* CI = (LAS int*)(lds + 69632 + 16384);
    const float* rb = a.in[I_RB];
    float bk[8]; int bi[8];
#pragma unroll
    for (int q = 0; q < 4; ++q) {
        float gk[8]; int gi[8];
#pragma unroll
        for (int j = 0; j < 8; ++j) { const int e = 32 * wave + 8 * q + j; gk[j] = sigmoid_f(LG[e * 65 + lane]) + rb[e]; gi[j] = e; }
        KI_SORT8(gk, gi);
        if (q == 0) {
#pragma unroll
            for (int j = 0; j < 8; ++j) { bk[j] = gk[j]; bi[j] = gi[j]; }
        } else KI_MERGE8(bk, bi, gk, gi);
    }
#pragma unroll
    for (int r = 0; r < 8; ++r) { CK[(wave * 8 + r) * 64 + lane] = bk[r]; CI[(wave * 8 + r) * 64 + lane] = bi[r]; }
    __syncthreads();
#define RT_LEVEL(lvl) do { if ((wave & (2 * (lvl) - 1)) == 0) { float ok_[8]; int oi_[8]; \
            _Pragma("unroll") for (int r = 0; r < 8; ++r) { ok_[r] = CK[((wave + (lvl)) * 8 + r) * 64 + lane]; oi_[r] = CI[((wave + (lvl)) * 8 + r) * 64 + lane]; } \
            KI_MERGE8(bk, bi, ok_, oi_); \
            if ((lvl) < 4) { _Pragma("unroll") for (int r = 0; r < 8; ++r) { CK[(wave * 8 + r) * 64 + lane] = bk[r]; CI[(wave * 8 + r) * 64 + lane] = bi[r]; } } } \
        __syncthreads(); } while (0)
    RT_LEVEL(1); RT_LEVEL(2); RT_LEVEL(4);
#undef RT_LEVEL
    LAS unsigned* hist = (LAS unsigned*)(lds + 102400); LAS unsigned* hbase = hist + 256;
    if (tid < 256) hist[tid] = 0u;
    __syncthreads();
    unsigned* cnt = (unsigned*)(ws + WS_CTL) + CW_CNT; int* list = (int*)(ws + WS_LIST); float* gatew = (float*)(ws + WS_GATEW);
    unsigned rank[8];
    if (wave == 0) {
        const int tok = t0 + lane;
        float sel[8], ssum = 0.f;
#pragma unroll
        for (int r = 0; r < 8; ++r) { sel[r] = sigmoid_f(LG[bi[r] * 65 + lane]); ssum += sel[r]; }
#pragma unroll
        for (int r = 0; r < 8; ++r) rank[r] = __hip_atomic_fetch_add(&hist[bi[r]], 1u, __ATOMIC_RELAXED, __HIP_MEMORY_SCOPE_WORKGROUP);
        const float sc = 2.5f / ssum;
        f32x4 g0 = {sel[0] * sc, sel[1] * sc, sel[2] * sc, sel[3] * sc}, g1 = {sel[4] * sc, sel[5] * sc, sel[6] * sc, sel[7] * sc};
        *(f32x4*)(gatew + tok * 8) = g0; *(f32x4*)(gatew + tok * 8 + 4) = g1;
    }
    __syncthreads();
    if (tid < 256) { const unsigned h = hist[tid]; if (h) hbase[tid] = atomicAdd(cnt + 32 * tid, h); }
    __syncthreads();
    if (wave == 0) {
        const int tok = t0 + lane;
#pragma unroll
        for (int r = 0; r < 8; ++r) list[(size_t)bi[r] * LISTCAP + hbase[bi[r]] + rank[r]] = tok * NSLOT + r;
    }
    __syncthreads();
}

__device__ __forceinline__ void moe_tile(const Args& a, ldsp lds, int e, int mt, int nrows, int ntl) {
    const int tid = threadIdx.x, lane = tid & 63, wave = __builtin_amdgcn_readfirstlane(tid >> 6), fr = lane & 15, fq = lane >> 4;
    unsigned char* ws = a.ws;
    constexpr int ASTG = 0, BSTG = 16384, ACT = 49152, SLOTS = 114688, GWO = 115200;
    const bf16* H2 = (const bf16*)(ws + WS_H2);
    const float* Wg = (e < NEXP) ? a.in[I_EG] + (size_t)e * 262144 : a.in[I_SG];
    const float* Wu = (e < NEXP) ? a.in[I_EU] + (size_t)e * 262144 : a.in[I_SU];
    const float* Wd = (e < NEXP) ? a.in[I_ED] + (size_t)e * 262144 : a.in[I_SD];
    if (tid < 128) {
        int slot = -1; float gw = 0.f;
        if (tid < nrows) {
            if (e < NEXP) { slot = ((const int*)(ws + WS_LIST))[(size_t)e * LISTCAP + mt * 128 + tid]; gw = ((const float*)(ws + WS_GATEW))[(slot / NSLOT) * 8 + (slot % NSLOT)]; }
            else { slot = (mt * 128 + tid) * NSLOT + 8; gw = 1.f; }
        }
        ((LAS int*)(lds + SLOTS))[tid] = slot; ((LAS float*)(lds + GWO))[tid] = gw;
    }
    __syncthreads();
    const int wr = wave >> 2, wc = wave & 3;
    const int arow = tid >> 2, akc = tid & 3;
    const int aslot = ((LAS const int*)(lds + SLOTS))[arow];
    const bf16* asrc = H2 + (size_t)((aslot < 0 ? 0 : aslot) / NSLOT) * D + akc * 8;
    const int awr = ASTG + akc * 2048 + ((arow ^ (akc << 1)) * 16);
    const int ng = lane, kq = wave;
    const float* srcg = Wg + (size_t)(4 * kq) * 256 + 4 * ng;
    const float* srcu = Wu + (size_t)(4 * kq) * 256 + 4 * ng;
    const float* src2 = Wd + (size_t)(4 * kq) * 1024 + 4 * ng;
    int bwr2[4];
#pragma unroll
    for (int i = 0; i < 4; ++i) { const int rho2 = 4 * ng + i; bwr2[i] = BSTG + (kq >> 1) * 4096 + ((rho2 ^ ((rho2 >> 3) & 3)) * 16) + (kq & 1) * 8; }
    int ard[4], brd[4], rowm[4];
#pragma unroll
    for (int m = 0; m < 4; ++m) { rowm[m] = 64 * wr + 16 * m + fr; ard[m] = fq * 2048 + ((rowm[m] ^ (fq << 1)) * 16); }
#pragma unroll
    for (int n = 0; n < 4; ++n) { const int rho = 64 * wc + 16 * n + fr; brd[n] = BSTG + fq * 4096 + ((rho ^ ((rho >> 3) & 3)) * 16); }
    bf16* contrib = (bf16*)(ws + WS_CONTRIB);
    f32x4 acc[4][4];
    f32x4 B0[4], B1[4], B2[4], B3[4]; u32x4 A0, A1, A2, A3;
#define G1_LOAD(s_, BR, AR) do { const int s0_ = (s_); const int ss_ = s0_ < 63 ? s0_ : 63; \
        const float* bp_ = ((ss_ < 32) ? srcg : srcu) + (size_t)(32 * (ss_ & 31)) * 256; \
        AR = *(const u32x4*)(asrc + 32 * (ss_ & 31)); \
        _Pragma("unroll") for (int j = 0; j < 4; ++j) BR[j] = *(const f32x4*)(bp_ + j * 256); } while (0)
#define G1_WRITE(BR, AR, buf_) do { \
        *(LAS u32x4*)(lds + (buf_) * 8192 + awr) = AR; \
        _Pragma("unroll") for (int i = 0; i < 4; ++i) { u32x2 w_; w_.x = cvtpk(BR[0][i], BR[1][i]); w_.y = cvtpk(BR[2][i], BR[3][i]); *(LAS u32x2*)(lds + (buf_) * 16384 + bwr2[i]) = w_; } } while (0)
#define MOE_COMPUTE(abase_, buf_) do { \
        bf16x8 af_[4], bf_[4]; \
        _Pragma("unroll") for (int m = 0; m < 4; ++m) af_[m] = *(LAS const bf16x8*)(lds + (abase_) + ard[m]); \
        _Pragma("unroll") for (int n = 0; n < 4; ++n) bf_[n] = *(LAS const bf16x8*)(lds + (buf_) * 16384 + brd[n]); \
        _Pragma("unroll") for (int m = 0; m < 4; ++m) _Pragma("unroll") for (int n = 0; n < 4; ++n) acc[m][n] = mfma16(bf_[n], af_[m], acc[m][n]); } while (0)
#define ACC_ZERO() do { _Pragma("unroll") for (int m = 0; m < 4; ++m) _Pragma("unroll") for (int n = 0; n < 4; ++n) acc[m][n] = (f32x4){0.f, 0.f, 0.f, 0.f}; } while (0)
    G1_LOAD(0, B0, A0); G1_LOAD(1, B1, A1); G1_LOAD(2, B2, A2);
    G1_WRITE(B0, A0, 0);
    __syncthreads();
    for (int s = 0; s < 64; s += 4) {
        if ((s & 31) == 0) ACC_ZERO();
        G1_LOAD(s + 3, B3, A3); MOE_COMPUTE(0, 0); G1_WRITE(B1, A1, 1); __syncthreads();
        G1_LOAD(s + 4, B0, A0); MOE_COMPUTE(8192, 1); G1_WRITE(B2, A2, 0); __syncthreads();
        G1_LOAD(s + 5, B1, A1); MOE_COMPUTE(0, 0); G1_WRITE(B3, A3, 1); __syncthreads();
        G1_LOAD(s + 6, B2, A2); MOE_COMPUTE(8192, 1);
        if (s == 28) {
#pragma unroll
            for (int m = 0; m < 4; ++m)
#pragma unroll
                for (int n = 0; n < 4; ++n) {
                    const f32x4 gv = acc[m][n];
                    u32x2 w; w.x = cvtpk(silu_f(gv[0]), silu_f(gv[1])); w.y = cvtpk(silu_f(gv[2]), silu_f(gv[3]));
                    const int kc = 8 * wc + 2 * n + (fq >> 1);
                    *(LAS u32x2*)(lds + ACT + kc * 2048 + ((rowm[m] ^ ((kc & 3) << 1)) * 16) + (fq & 1) * 8) = w;
                }
        } else if (s == 60) {
#pragma unroll
            for (int m = 0; m < 4; ++m)
#pragma unroll
                for (int n = 0; n < 4; ++n) {
                    const f32x4 uv = acc[m][n];
                    const int kc = 8 * wc + 2 * n + (fq >> 1);
                    LAS u32x2* ap = (LAS u32x2*)(lds + ACT + kc * 2048 + ((rowm[m] ^ ((kc & 3) << 1)) * 16) + (fq & 1) * 8);
                    const u32x2 g = *ap;
                    u32x2 w; w.x = cvtpk(bflo(g.x) * uv[0], bfhi(g.x) * uv[1]); w.y = cvtpk(bflo(g.y) * uv[2], bfhi(g.y) * uv[3]);
                    *ap = w;
                }
        }
        G1_WRITE(B0, A0, 0); __syncthreads();
    }
#define G2_LOAD(s_, BR) do { const int s0_ = (s_); const int t_ = s0_ < 31 ? s0_ : 31; \
        const float* bp_ = src2 + (size_t)(32 * (t_ & 7)) * 1024 + 256 * (t_ >> 3); \
        _Pragma("unroll") for (int j = 0; j < 4; ++j) BR[j] = *(const f32x4*)(bp_ + j * 1024); } while (0)
#define G2_WRITE(BR, buf_) do { \
        _Pragma("unroll") for (int i = 0; i < 4; ++i) { u32x2 w_; w_.x = cvtpk(BR[0][i], BR[1][i]); w_.y = cvtpk(BR[2][i], BR[3][i]); *(LAS u32x2*)(lds + (buf_) * 16384 + bwr2[i]) = w_; } } while (0)
    G2_LOAD(0, B0); G2_LOAD(1, B1); G2_LOAD(2, B2);
    G2_WRITE(B0, 0);
    __syncthreads();
    for (int s = 0; s < 32; s += 4) {
        if ((s & 7) == 0) ACC_ZERO();
        G2_LOAD(s + 3, B3); MOE_COMPUTE(ACT + (s & 7) * 8192, 0); G2_WRITE(B1, 1); __syncthreads();
        G2_LOAD(s + 4, B0); MOE_COMPUTE(ACT + ((s + 1) & 7) * 8192, 1); G2_WRITE(B2, 0); __syncthreads();
        G2_LOAD(s + 5, B1); MOE_COMPUTE(ACT + ((s + 2) & 7) * 8192, 0); G2_WRITE(B3, 1); __syncthreads();
        G2_LOAD(s + 6, B2); MOE_COMPUTE(ACT + ((s + 3) & 7) * 8192, 1);
        if ((s & 7) == 4) {
            const int q = s >> 3;
#pragma unroll
            for (int m = 0; m < 4; ++m) {
                const int slot = ((LAS const int*)(lds + SLOTS))[rowm[m]]; const float gw = ((LAS const float*)(lds + GWO))[rowm[m]];
                if (slot >= 0) {
                    bf16* cp = contrib + (size_t)slot * D + q * 256 + 64 * wc + 4 * fq;
#pragma unroll
                    for (int n = 0; n < 4; ++n) { const f32x4 v = acc[m][n] * gw; u32x2 w; w.x = cvtpk(v[0], v[1]); w.y = cvtpk(v[2], v[3]); *(u32x2*)(cp + 16 * n) = w; }
                }
            }
        }
        G2_WRITE(B0, 0); __syncthreads();
    }
#undef G1_LOAD
#undef G1_WRITE
#undef G2_LOAD
#undef G2_WRITE
#undef ACC_ZERO
#undef MOE_COMPUTE
}

template <int TD>
__device__ __forceinline__ void moe_tile_ws(const Args& a, ldsp lds, int e, int mt, int nrows, int ntl, unsigned& junk) {
    const int tid = threadIdx.x, lane = tid & 63, wave = __builtin_amdgcn_readfirstlane(tid >> 6), fr = lane & 15, fq = lane >> 4;
    unsigned char* ws = a.ws;
    constexpr int ASTG = 0, BSTG = 16384, ACT = 49152, SLOTS = 114688, GWO = 115200;
    const float* Wg = (e < NEXP) ? a.in[I_EG] + (size_t)e * 262144 : a.in[I_SG];
    const float* Wu = (e < NEXP) ? a.in[I_EU] + (size_t)e * 262144 : a.in[I_SU];
    const float* Wd = (e < NEXP) ? a.in[I_ED] + (size_t)e * 262144 : a.in[I_SD];
    if (tid < 128) {
        int slot = -1; float gw = 0.f;
        if (tid < nrows) {
            if (e < NEXP) { slot = ((const int*)(ws + WS_LIST))[(size_t)e * LISTCAP + mt * 128 + tid]; gw = ((const float*)(ws + WS_GATEW))[(slot / NSLOT) * 8 + (slot % NSLOT)]; }
            else { slot = (mt * 128 + tid) * NSLOT + 8; gw = 1.f; }
        }
        ((LAS int*)(lds + SLOTS))[tid] = slot; ((LAS float*)(lds + GWO))[tid] = gw;
    }
    __syncthreads();
    if (wave >= 4) {
        const int lt = tid - 256;
        const bf16* H2 = (const bf16*)(ws + WS_H2);
        const int arow = lt >> 1, ahalf = lt & 1;
        const int aslot = ((LAS const int*)(lds + SLOTS))[arow];
        const bf16* asrc = H2 + (size_t)((aslot < 0 ? 0 : aslot) / NSLOT) * D + 16 * ahalf;
        const int awr0 = ASTG + (2 * ahalf) * 2048 + ((arow ^ ((2 * ahalf) << 1)) * 16), awr1 = ASTG + (2 * ahalf + 1) * 2048 + ((arow ^ ((2 * ahalf + 1) << 1)) * 16);
        const int ng = lt & 63, kq = lt >> 6;
        const float* srcg = Wg + (size_t)(8 * kq) * 256 + 4 * ng;
        const float* srcu = Wu + (size_t)(8 * kq) * 256 + 4 * ng;
        const float* srcd = Wd + (size_t)(8 * kq) * 1024 + 4 * ng;
        const int bw = BSTG + kq * 4096 + (4 * ng) * 16, bx = ((4 * ng) >> 3) & 3;
        f32x4 B0[8], B1[8], B2[8], B3[8]; u32x4 A0[2], A1[2], A2[2], A3[2];
#define L_LOAD1(s_, BR, AR) do { const int ss_ = (s_); const int sa_ = ss_ < 63 ? ss_ : 63; const int t_ = ss_ - 64; \
            const float* bp_ = (ss_ < 32) ? srcg + (size_t)(32 * ss_) * 256 : (ss_ < 64) ? srcu + (size_t)(32 * (ss_ - 32)) * 256 : srcd + (size_t)(32 * (t_ & 7)) * 1024 + 256 * (t_ >> 3); \
            const int str_ = (ss_ < 64) ? 256 : 1024;        \
            AR[0] = *(const u32x4*)(asrc + 32 * (sa_ & 31)); AR[1] = *(const u32x4*)(asrc + 32 * (sa_ & 31) + 8); \
            _Pragma("unroll") for (int j = 0; j < 8; ++j) BR[j] = *(const f32x4*)(bp_ + j * str_); } while (0)
#define L_LOAD2(s_, BR) do { const int s0_ = (s_); const int t_ = s0_ < 31 ? s0_ : 31; \
            const float* bp_ = srcd + (size_t)(32 * (t_ & 7)) * 1024 + 256 * (t_ >> 3); \
            _Pragma("unroll") for (int j = 0; j < 8; ++j) BR[j] = *(const f32x4*)(bp_ + j * 1024); } while (0)
#define L_WRITEB(BR, buf_) do { _Pragma("unroll") for (int i = 0; i < 4; ++i) { u32x4 w_; w_.x = cvtpk(BR[0][i], BR[1][i]); w_.y = cvtpk(BR[2][i], BR[3][i]); w_.z = cvtpk(BR[4][i], BR[5][i]); w_.w = cvtpk(BR[6][i], BR[7][i]); \
            *(LAS u32x4*)(lds + (buf_) * 16384 + bw + ((i ^ bx) * 16)) = w_; } } while (0)
#define L_WRITEA(AR, buf_) do { *(LAS u32x4*)(lds + (buf_) * 8192 + awr0) = AR[0]; *(LAS u32x4*)(lds + (buf_) * 8192 + awr1) = AR[1]; } while (0)
        L_LOAD1(0, B0, A0); L_LOAD1(1, B1, A1); L_LOAD1(2, B2, A2);
        L_WRITEA(A0, 0); L_WRITEB(B0, 0);
        __syncthreads();
        for (int s = 0; s < 64; s += 4) {
            L_LOAD1(s + 3, B3, A3); L_WRITEA(A1, 1); L_WRITEB(B1, 1); __syncthreads();
            L_LOAD1(s + 4, B0, A0); L_WRITEA(A2, 0); L_WRITEB(B2, 0); __syncthreads();
            L_LOAD1(s + 5, B1, A1); L_WRITEA(A3, 1); L_WRITEB(B3, 1); __syncthreads();
            L_LOAD1(s + 6, B2, A2); L_WRITEA(A0, 0); L_WRITEB(B0, 0); __syncthreads();
        }
        for (int s = 0; s < 32; s += 4) {
            L_LOAD2(s + 3, B3); L_WRITEB(B1, 1); __syncthreads();
            L_LOAD2(s + 4, B0); L_WRITEB(B2, 0); __syncthreads();
            L_LOAD2(s + 5, B1); L_WRITEB(B3, 1); __syncthreads();
            L_LOAD2(s + 6, B2); L_WRITEB(B0, 0); __syncthreads();
        }
#undef L_LOAD1
#undef L_LOAD2
#undef L_WRITEB
#undef L_WRITEA
    } else {
        const int wr = wave >> 1, wc = wave & 1;
        int rowm[4], ard[4], brd[8];
#pragma unroll
        for (int m = 0; m < 4; ++m) { rowm[m] = 64 * wr + 16 * m + fr; ard[m] = fq * 2048 + ((rowm[m] ^ (fq << 1)) * 16); }
#pragma unroll
        for (int n = 0; n < 8; ++n) { const int rho = 128 * wc + 16 * n + fr; brd[n] = BSTG + fq * 4096 + ((rho ^ ((rho >> 3) & 3)) * 16); }
        bf16* contrib = (bf16*)(ws + WS_CONTRIB);
        const int nt = ntl >= 8 ? 8 : ntl >= 4 ? 4 : ntl >= 2 ? 2 : 1, role = mt & (nt - 1);
        const float* tg = Wg + (size_t)(tid >> 3) * 256 + (tid & 7) * 32;
        const float* tu = Wu + (size_t)(tid >> 3) * 256 + (tid & 7) * 32;
        const float* td = Wd + (size_t)(tid >> 3) * 1024 + (tid & 7) * 32;
#define M_TOUCH(st_) do { const int s0_ = (st_); if (false && s0_ < 96 && (s0_ & (nt - 1)) == role) { const int u_ = s0_ - 64; \
            const float* tp_ = (s0_ < 32) ? tg + (size_t)(32 * s0_) * 256 : (s0_ < 64) ? tu + (size_t)(32 * (s0_ - 32)) * 256 : td + (size_t)(32 * (u_ & 7)) * 1024 + 256 * (u_ >> 3); \
            asm volatile("global_load_dword %0, %1, off" : "+v"(junk) : "v"(tp_) : "memory"); } } while (0)
        f32x4 acc[4][8];
#define M_COMPUTE(abase_, buf_) do { \
            _Pragma("unroll") for (int nh = 0; nh < 2; ++nh) { bf16x8 af_[4], bf_[4]; \
                _Pragma("unroll") for (int m = 0; m < 4; ++m) af_[m] = *(LAS const bf16x8*)(lds + (abase_) + ard[m]); \
                _Pragma("unroll") for (int n = 0; n < 4; ++n) bf_[n] = *(LAS const bf16x8*)(lds + (buf_) * 16384 + brd[4 * nh + n]); \
                _Pragma("unroll") for (int m = 0; m < 4; ++m) _Pragma("unroll") for (int n = 0; n < 4; ++n) acc[m][4 * nh + n] = mfma16(bf_[n], af_[m], acc[m][4 * nh + n]); } } while (0)
#define M_ZERO() do { _Pragma("unroll") for (int m = 0; m < 4; ++m) _Pragma("unroll") for (int n = 0; n < 8; ++n) acc[m][n] = (f32x4){0.f, 0.f, 0.f, 0.f}; } while (0)
        for (int st = 0; st < TD; ++st) M_TOUCH(st);
        __syncthreads();
        for (int s = 0; s < 64; s += 4) {
            if ((s & 31) == 0) M_ZERO();
            M_TOUCH(s + TD); M_COMPUTE(0, 0); __syncthreads();
            M_TOUCH(s + 1 + TD); M_COMPUTE(8192, 1); __syncthreads();
            M_TOUCH(s + 2 + TD); M_COMPUTE(0, 0); __syncthreads();
            M_TOUCH(s + 3 + TD); M_COMPUTE(8192, 1);
            if (s == 28) {
#pragma unroll
                for (int m = 0; m < 4; ++m)
#pragma unroll
                    for (int n = 0; n < 8; ++n) {
                        const f32x4 gv = acc[m][n];
                        u32x2 w; w.x = cvtpk(silu_f(gv[0]), silu_f(gv[1])); w.y = cvtpk(silu_f(gv[2]), silu_f(gv[3]));
                        const int kc = 16 * wc + 2 * n + (fq >> 1);
                        *(LAS u32x2*)(lds + ACT + kc * 2048 + ((rowm[m] ^ ((kc & 3) << 1)) * 16) + (fq & 1) * 8) = w;
                    }
            } else if (s == 60) {
#pragma unroll
                for (int m = 0; m < 4; ++m)
#pragma unroll
                    for (int n = 0; n < 8; ++n) {
                        const f32x4 uv = acc[m][n];
                        const int kc = 16 * wc + 2 * n + (fq >> 1);
                        LAS u32x2* ap = (LAS u32x2*)(lds + ACT + kc * 2048 + ((rowm[m] ^ ((kc & 3) << 1)) * 16) + (fq & 1) * 8);
                        const u32x2 g = *ap;
                        u32x2 w; w.x = cvtpk(bflo(g.x) * uv[0], bfhi(g.x) * uv[1]); w.y = cvtpk(bflo(g.y) * uv[2], bfhi(g.y) * uv[3]);
                        *ap = w;
                    }
            }
            __syncthreads();
        }
        for (int s = 0; s < 32; s += 4) {
            if ((s & 7) == 0) M_ZERO();
            M_TOUCH(64 + s + TD); M_COMPUTE(ACT + (s & 7) * 8192, 0); __syncthreads();
            M_TOUCH(64 + s + 1 + TD); M_COMPUTE(ACT + ((s + 1) & 7) * 8192, 1); __syncthreads();
            M_TOUCH(64 + s + 2 + TD); M_COMPUTE(ACT + ((s + 2) & 7) * 8192, 0); __syncthreads();
            M_TOUCH(64 + s + 3 + TD); M_COMPUTE(ACT + ((s + 3) & 7) * 8192, 1);
            if ((s & 7) == 4) {
                const int q = s >> 3;
#pragma unroll
                for (int m = 0; m < 4; ++m) {
                    const int slot = ((LAS const int*)(lds + SLOTS))[rowm[m]]; const float gw = ((LAS const float*)(lds + GWO))[rowm[m]];
                    if (slot >= 0) {
                        bf16* cp = contrib + (size_t)slot * D + q * 256 + 128 * wc + 4 * fq;
#pragma unroll
                        for (int n = 0; n < 8; ++n) { const f32x4 v = acc[m][n] * gw; u32x2 w; w.x = cvtpk(v[0], v[1]); w.y = cvtpk(v[2], v[3]); *(u32x2*)(cp + 16 * n) = w; }
                    }
                }
            }
            __syncthreads();
        }
#undef M_TOUCH
#undef M_COMPUTE
#undef M_ZERO
    }
}

#ifndef MOE_TD
#define MOE_TD 8
#endif
__device__ __forceinline__ void phase_moe(const Args& a, ldsp lds, int G, int vcu) {
    const int tid = threadIdx.x;
    const unsigned* cnt = (const unsigned*)(a.ws + WS_CTL) + CW_CNT;
    LAS int* pre = (LAS int*)(lds + MISC_OFF + 512);
    if (tid == 0) { int s = 0; for (int e = 0; e < NEXP; ++e) { pre[e] = s; s += (int)((cnt[32 * e] + 127u) >> 7); } pre[NEXP] = s; }
    __syncthreads();
    const int total = pre[NEXP], ntiles = total + T / 128;
    unsigned junk = 0;
    for (int j = vcu; j < ntiles; j += G) {
        int e, mt, nrows, ntl;
        if (j < total) {
            int lo = 0, hi = NEXP;
            while (hi - lo > 1) { const int mid = (lo + hi) >> 1; if (pre[mid] <= j) lo = mid; else hi = mid; }
            e = lo; mt = j - pre[e]; const int c = (int)cnt[32 * e] - mt * 128; nrows = c < 128 ? c : 128; ntl = pre[e + 1] - pre[e];
        } else { e = NEXP; mt = j - total; nrows = 128; ntl = 8; }
        moe_tile_ws<MOE_TD>(a, lds, e, mt, nrows, ntl, junk);
    }
    asm volatile("s_waitcnt vmcnt(0)" : "+v"(junk) :: "memory");
}

__device__ __forceinline__ void phase_combine(const Args& a, int G) {
    const int tid = threadIdx.x, lane = tid & 63, wave = __builtin_amdgcn_readfirstlane(tid >> 6), blk = blockIdx.x;
    unsigned char* ws = a.ws;
    const bf16* X1 = (const bf16*)(ws + WS_X1); const bf16* contrib = (const bf16*)(ws + WS_CONTRIB); const float* fg = a.in[I_FG];
    for (int t = blk * NWAVES + wave; t < T; t += G * NWAVES) {
        const float* g2 = (const float*)(ws + WS_ADAF) + (t >> 13) * 6144 + 5 * 1024;
        f32x4 xv[2][2]; float ss = 0.f;
#pragma unroll
        for (int j = 0; j < 2; ++j) {
            const int c = 8 * lane + 512 * j;
            float sm[8] = {0.f, 0.f, 0.f, 0.f, 0.f, 0.f, 0.f, 0.f};
#pragma unroll
            for (int k = 0; k < NSLOT; ++k) {
                const u32x4 w = *(const u32x4*)(contrib + ((size_t)t * NSLOT + k) * D + c);
                sm[0] += bflo(w.x); sm[1] += bfhi(w.x); sm[2] += bflo(w.y); sm[3] += bfhi(w.y); sm[4] += bflo(w.z); sm[5] += bfhi(w.z); sm[6] += bflo(w.w); sm[7] += bfhi(w.w);
            }
            const u32x4 xw = *(const u32x4*)(X1 + (size_t)t * D + c);
#pragma unroll
            for (int h = 0; h < 2; ++h) {
                const f32x4 x1 = h == 0 ? (f32x4){bflo(xw.x), bfhi(xw.x), bflo(xw.y), bfhi(xw.y)} : (f32x4){bflo(xw.z), bfhi(xw.z), bflo(xw.w), bfhi(xw.w)};
                const f32x4 gg = *(const f32x4*)(g2 + c + 4 * h);
                const f32x4 mv = {sm[4 * h], sm[4 * h + 1], sm[4 * h + 2], sm[4 * h + 3]};
                const f32x4 v = x1 + gg * mv; xv[j][h] = v; ss += (v[0] * v[0] + v[1] * v[1]) + (v[2] * v[2] + v[3] * v[3]);
            }
        }
        const float r = rsqrtf(wave_sum(ss) * (1.f / D) + 1e-6f);
#pragma unroll
        for (int j = 0; j < 2; ++j)
#pragma unroll
            for (int h = 0; h < 2; ++h) { const int c = 8 * lane + 512 * j + 4 * h; *(f32x4*)(a.out + (size_t)t * D + c) = (xv[j][h] * r) * *(const f32x4*)(fg + c); }
    }
}

constexpr int NPH = 9;
#ifndef N_LAUNCHES
#define N_LAUNCHES 1
#endif
__global__ void __launch_bounds__(NWAVES * 64, 2) mega(Args a) {
    extern __shared__ __attribute__((aligned(16))) unsigned char lds_raw[];
    ldsp lds = (ldsp)lds_raw;
    const int tid = threadIdx.x, G = gridDim.x, bx = blockIdx.x;
    int vcu = (G % 8 == 0) ? (bx % 8) * (G / 8) + bx / 8 : bx;
    unsigned char* ws = a.ws;
    for (int u = tid; u < (LDS_BYTES - MISC_OFF) / 4; u += NWAVES * 64) ((LAS unsigned*)(lds + MISC_OFF))[u] = 0u;
    __syncthreads();
    volatile LAS unsigned* MISC = (volatile LAS unsigned*)(lds + MISC_OFF);
    XcdBarrier bar; bar.bar = (unsigned*)(ws + WS_CTL) + CW_BAR; bar.x = 0; bar.st = nullptr;
    if (N_LAUNCHES == 1) {
        bar = xcd_barrier_post((unsigned*)(ws + WS_CTL) + CW_BAR, MISC + 8);
        if (tid == 0) MISC[16] = atomicAdd((unsigned*)(ws + WS_CTL) + CW_XRANK + 64 * bar.x, 1u);
    }
    const int lo = a.ph_lo, hi = a.ph_hi;
#ifndef PH_MASK
#define PH_MASK 0x1ff
#endif
#define IN(k) (((PH_MASK >> (k)) & 1) && lo <= (k) && (k) < hi)
#define SEAM(k) do { if (IN(k) && IN((k) + 1)) xcd_barrier(bar); } while (0)
#ifndef PH_DUP
#define PH_DUP -1
#endif
#define REP(k) for (int rep_ = 0; rep_ < ((PH_DUP == (k)) ? 2 : 1); ++rep_)
    if (IN(0)) REP(0) { phase_prep(a, lds, G); } SEAM(0);
    if (N_LAUNCHES == 1 && IN(0) && IN(1)) {
        unsigned basex = 0;
        for (unsigned j = 0; j < bar.x; ++j) basex += xb_ld(&bar.bar[XB_XCNT(j)]);
        vcu = (int)(basex + MISC[16]);
    }
    if (IN(1)) REP(1) { phase_hnorm(a, lds, G); } SEAM(1);
    if (IN(2)) REP(2) {
        pg8::Gemm g{(const pg8::bf16_t*)(ws + WS_H), (const pg8::bf16_t*)(ws + WS_WINT), MH, DIN, D};
        WinOrder S; S.init(G, bx);
        EpiWin E{(bf16*)(ws + WS_Z), (bf16*)(ws + WS_KVC), (const float*)(ws + WS_ROPE)};
        pg8::gemm_phase<EpiWin, WinOrder, true, true>(lds, g, S, E);
    } SEAM(2);
    if (IN(3)) REP(3) { phase_mixers(a, lds, G, vcu); } SEAM(3);
    if (IN(4)) REP(4) {
        { pg8::Gemm g{(const pg8::bf16_t*)(ws + WS_A), (const pg8::bf16_t*)(ws + WS_WAT), T, D, 512};
          pg8::StaticOrder S; S.init(T, D, G, bx);
          EpiMergeA E{(const bf16*)(ws + WS_Z), (bf16*)(ws + WS_Y)};
          pg8::gemm_phase<EpiMergeA, pg8::StaticOrder, true, true>(lds, g, S, E); }
        { pg8::Gemm g{(const pg8::bf16_t*)(ws + WS_O), (const pg8::bf16_t*)(ws + WS_WBT), T, D, 512};
          pg8::StaticOrder S; S.init(T, D, G, bx);
          EpiMergeB E{(const bf16*)(ws + WS_Z), (bf16*)(ws + WS_Y)};
          pg8::gemm_phase<EpiMergeB, pg8::StaticOrder, true, true>(lds, g, S, E); }
    } SEAM(4);
    if (IN(5)) REP(5) {
        pg8::Gemm g{(const pg8::bf16_t*)(ws + WS_Y), (const pg8::bf16_t*)(ws + WS_WOT), T, D, D};
        pg8::StaticOrder S; S.init(T, D, G, bx);
        EpiWo E{a.in[I_X], (const float*)(ws + WS_ADAF), (bf16*)(ws + WS_X1)};
        pg8::gemm_phase<EpiWo, pg8::StaticOrder, true, true>(lds, g, S, E);
    } SEAM(5);
    if (IN(6)) { for (int it = vcu; it < T / 64; it += G) router_item(a, lds, it); } SEAM(6);
    if (IN(7)) REP(7) { phase_moe(a, lds, G, vcu); } SEAM(7);
    if (IN(8)) REP(8) { phase_combine(a, G); }
#undef IN
#undef SEAM
}

extern "C" void kernel_launch(void* const* d_in, const int* in_sizes, int n_in, void* d_out, int out_size, void* d_ws, size_t ws_size, hipStream_t stream) {
    static int grid = 0;
    if (grid == 0) {
        if (n_in != 26 || out_size != T * D || ws_size < WS_END) { fprintf(stderr, "kernel_launch: unexpected shapes (n_in %d, out %d, ws %zu)\n", n_in, out_size, ws_size); grid = -1; return; }
        int dev = 0, cus = 0, per_cu = 0;
        (void)hipGetDevice(&dev); (void)hipDeviceGetAttribute(&cus, hipDeviceAttributeMultiprocessorCount, dev);
        (void)hipFuncSetAttribute((const void*)mega, hipFuncAttributeMaxDynamicSharedMemorySize, LDS_BYTES);
        (void)hipOccupancyMaxActiveBlocksPerMultiprocessor(&per_cu, (const void*)mega, NWAVES * 64, LDS_BYTES);
        (void)hipGetLastError();
        if (per_cu < 1) { fprintf(stderr, "kernel_launch: occupancy query says %d blocks per CU\n", per_cu); per_cu = 1; }
        grid = cus;
    }
    if (grid < 0) return;
    (void)hipMemsetAsync((char*)d_ws + WS_CTL, 0, CTL_ZERO_BYTES, stream);
    Args a{};
    for (int i = 0; i < 26; ++i) a.in[i] = (const float*)d_in[i];
    a.out = (float*)d_out; a.ws = (unsigned char*)d_ws;
    if (N_LAUNCHES == 1) {
        a.ph_lo = 0; a.ph_hi = NPH;
        void* kargs[] = {&a};
        hipError_t e = hipLaunchCooperativeKernel((const void*)mega, dim3(grid), dim3(NWAVES * 64), kargs, LDS_BYTES, stream);
        if (e != hipSuccess) fprintf(stderr, "kernel_launch: cooperative launch failed: %s (grid %d)\n", hipGetErrorString(e), grid);
    } else {
#ifndef HOST_DUP
#define HOST_DUP -1
#endif
        for (int li = 0; li < NPH; ++li) {
            a.ph_lo = li; a.ph_hi = li + 1;
            hipLaunchKernelGGL(mega, dim3(grid), dim3(NWAVES * 64), LDS_BYTES, stream, a);
            if (li == HOST_DUP) {
                if (li == 6) (void)hipMemsetAsync((char*)d_ws + WS_CTL, 0, CTL_ZERO_BYTES, stream);
                hipLaunchKernelGGL(mega, dim3(grid), dim3(NWAVES * 64), LDS_BYTES, stream, a);
            }
        }
    }
}
```

```cpp
#include <hip/hip_runtime.h>
#include <cstdio>
#include <cstdint>
#include <type_traits>
namespace pg8 {
#define PG8_LAS __attribute__((address_space(3)))
typedef unsigned short bf16_t;
typedef short bf16x8 __attribute__((ext_vector_type(8)));
typedef float f32x4 __attribute__((ext_vector_type(4)));
typedef unsigned u32x4 __attribute__((ext_vector_type(4)));
constexpr int BM = 256, BK = 64, HALF = 128, HTB = HALF * BK * 2  , STAGE_BYTES = 8 * HTB, NXCD = 8, WGM = 8;

__host__ __device__ __forceinline__ int lds_byte(int r, int c) { const int st = (r >> 4) * 2 + (c >> 5), rr = r & 15, cc = c & 31, ob = rr * 64 + cc * 2; return st * 1024 + (ob ^ (((ob >> 9) & 1) << 5)); }
__host__ __device__ __forceinline__ void stage_rc(int b, int& R, int& C) { const int st = b / 1024, sb = b % 1024, swz = sb ^ (((sb >> 9) & 1) << 5); R = (st >> 1) * 16 + swz / 64; C = (st & 1) * 32 + (swz % 64) / 2; }
__host__ __device__ __forceinline__ int perm32(int rho) { const int n = rho >> 4, i = rho & 15; return 8 * (i >> 2) + 4 * n + (i & 3); }

struct Unit { int pm, pn; };
struct Gemm { const bf16_t* A; const bf16_t* Bt; int M, N, K; };

struct StaticOrder {
    int nM, nN, nwg, G, c;
    __host__ __device__ void init(int M, int N, int G_, int c_) { nM = M / BM; nN = N / BM; nwg = nM * nN; G = G_; c = c_; }
    __host__ __device__ bool next(int i, Unit& u) const {
        const long L = (long)i * G + c; if (L >= nwg) return false;
        int wgid = (int)L; { const int q = nwg / NXCD, r = nwg % NXCD, xcd = wgid % NXCD, off = wgid / NXCD; wgid = (xcd < r ? xcd * (q + 1) : r * (q + 1) + (xcd - r) * q) + off; }
        const int nig = WGM * nN, gid = wgid / nig, fm = gid * WGM, gsz = (nM - fm) < WGM ? (nM - fm) : WGM;
        u.pm = fm + ((wgid % nig) % gsz); u.pn = (wgid % nig) / gsz; return true;
    }
    __device__ __forceinline__ void a_ready(const Unit&) const {}
    __device__ __forceinline__ void done(const Unit&) const {}
};

__device__ __forceinline__ unsigned cvt_pk_bf16(float lo, float hi) { unsigned r; asm volatile("v_cvt_pk_bf16_f32 %0, %1, %2" : "=v"(r) : "v"(lo), "v"(hi)); return r; }
template <class Epi, class Sched, bool ALIGN_EPI = false, bool SP2 = false>
__device__ __forceinline__ void gemm_phase(PG8_LAS unsigned char* lds, const Gemm g, const Sched& S, const Epi& E) {
    const int tid = threadIdx.x, wid = __builtin_amdgcn_readfirstlane(tid >> 6), lane = tid & 63, wr = wid >> 2, wc = wid & 3, fr = lane & 15, fq = lane >> 4;
    const int K = g.K, nt = K / BK;
    unsigned voffA[2], voffB[2];
#pragma unroll
    for (int i = 0; i < 2; ++i) { int R, C; stage_rc(tid * 16 + i * 8192, R, C); const int Rb = Epi::PERM ? ((R & ~31) + perm32(R & 31)) : R;
        voffA[i] = (unsigned)(R * K + C) * 2u; voffB[i] = (unsigned)(Rb * K + C) * 2u; }
    const size_t kstep = (size_t)(BK * 2);
    const size_t hstep = (size_t)HALF * K * 2;
    const size_t tstep = 2 * hstep;
    const unsigned ldsw = (unsigned)wid * 1024u;
    const int aoff = lds_byte(wr * 64 + fr, fq * 8), boff = lds_byte(wc * 32 + fr, fq * 8);
#define PG8_SA(b, h) (((b) * 2 + (h)) * HTB)
#define PG8_SB(b, h) ((4 + (b) * 2 + (h)) * HTB)
#define PG8_STAGE(bufoff, gbase, voff) do { _Pragma("unroll") for (int _i = 0; _i < 2; ++_i) \
        __builtin_amdgcn_global_load_lds((const unsigned*)((const char*)(gbase) + (voff)[_i]), (PG8_LAS unsigned*)(lds + (bufoff) + ldsw + _i * 8192), 16, 0, 0); } while (0)
#define PG8_LDA(dst, b, h) do { _Pragma("unroll") for (int m = 0; m < 4; ++m) _Pragma("unroll") for (int k = 0; k < 2; ++k) dst[m][k] = *(const PG8_LAS bf16x8*)(lds + PG8_SA(b, h) + aoff + m * 2048 + k * 1024); } while (0)
#define PG8_LDB(dst, b, h) do { _Pragma("unroll") for (int n = 0; n < 2; ++n) _Pragma("unroll") for (int k = 0; k < 2; ++k) dst[n][k] = *(const PG8_LAS bf16x8*)(lds + PG8_SB(b, h) + boff + n * 2048 + k * 1024); } while (0)
#define PG8_MMA(ai, bj, At, Bt) do { __builtin_amdgcn_s_setprio(1); _Pragma("unroll") for (int m = 0; m < 4; ++m) _Pragma("unroll") for (int n = 0; n < 2; ++n) _Pragma("unroll") for (int k = 0; k < 2; ++k) \
        acc[ai][bj][m][n] = __builtin_amdgcn_mfma_f32_16x16x32_bf16(Bt[n][k], At[m][k], acc[ai][bj][m][n], 0, 0, 0); __builtin_amdgcn_s_setprio(0); } while (0)
#define PG8_WAIT_V(n) asm volatile("s_waitcnt vmcnt(" #n ")" ::: "memory")
#define PG8_WAIT_L(n) asm volatile("s_waitcnt lgkmcnt(" #n ")" ::: "memory")
#define PG8_BAR __builtin_amdgcn_s_barrier()
#define PG8_SCHED __builtin_amdgcn_sched_barrier(0)
    Unit cur, nxt; int ui = 0;
    if (!S.next(0, cur)) return;
    f32x4 acc[2][2][4][2];
#pragma unroll
    for (int a = 0; a < 2; ++a)
#pragma unroll
        for (int b = 0; b < 2; ++b)
#pragma unroll
            for (int m = 0; m < 4; ++m)
#pragma unroll
                for (int n = 0; n < 2; ++n) acc[a][b][m][n] = (f32x4){0.f, 0.f, 0.f, 0.f};
    bf16x8 At[4][2], B0[2][2], B1[2][2];
    const char* cA = (const char*)g.A + (size_t)cur.pm * tstep; const char* cB = (const char*)g.Bt + (size_t)cur.pn * tstep;
    S.a_ready(cur);
    if constexpr (SP2) {
        PG8_STAGE(PG8_SB(0, 0), cB, voffB); PG8_STAGE(PG8_SB(0, 1), cB + hstep, voffB); PG8_STAGE(PG8_SA(0, 0), cA, voffA); PG8_STAGE(PG8_SA(0, 1), cA + hstep, voffA);
        if (wr == 1) PG8_BAR;
        PG8_WAIT_V(2); PG8_BAR;
        PG8_STAGE(PG8_SB(1, 0), cB + kstep, voffB); PG8_STAGE(PG8_SA(1, 0), cA + kstep, voffA); PG8_STAGE(PG8_SB(1, 1), cB + hstep + kstep, voffB);
        PG8_WAIT_V(6); PG8_BAR;
    } else {
        PG8_STAGE(PG8_SB(0, 0), cB, voffB); PG8_STAGE(PG8_SA(0, 0), cA, voffA); PG8_STAGE(PG8_SB(0, 1), cB + hstep, voffB); PG8_STAGE(PG8_SA(0, 1), cA + hstep, voffA);
        if (wr == 1) PG8_BAR;
        PG8_WAIT_V(4); PG8_BAR;
        PG8_STAGE(PG8_SB(1, 0), cB + kstep, voffB); PG8_STAGE(PG8_SA(1, 0), cA + kstep, voffA); PG8_STAGE(PG8_SB(1, 1), cB + hstep + kstep, voffB);
        PG8_WAIT_V(6); PG8_BAR;
    }
    for (;;) {
        const bool has_next = S.next(ui + 1, nxt);
        const char* nA = has_next ? (const char*)g.A + (size_t)nxt.pm * tstep : cA; const char* nB = has_next ? (const char*)g.Bt + (size_t)nxt.pn * tstep : cB;
        for (int t = 0; t < nt; t += 2) {
            const bool last = (t == nt - 2);
            const char* a1 = cA + (size_t)(t + 1) * kstep;
            const char* a2 = last ? nA : cA + (size_t)(t + 2) * kstep; const char* b2 = last ? nB : cB + (size_t)(t + 2) * kstep;
            const char* a3 = a2 + kstep; const char* b3 = b2 + kstep;
            if (last && has_next) S.a_ready(nxt);
            if constexpr (SP2) {
            PG8_LDB(B0, 0, 0); PG8_LDB(B1, 0, 1); PG8_SCHED; PG8_LDA(At, 0, 0); PG8_STAGE(PG8_SA(1, 1), a1 + hstep, voffA);
            PG8_WAIT_V(8); PG8_WAIT_L(0); PG8_BAR; PG8_MMA(0, 0, At, B0); PG8_MMA(0, 1, At, B1); PG8_BAR; PG8_SCHED;
            PG8_LDA(At, 0, 1); PG8_STAGE(PG8_SB(0, 0), b2, voffB); PG8_STAGE(PG8_SB(0, 1), b2 + hstep, voffB); PG8_STAGE(PG8_SA(0, 0), a2, voffA);
            PG8_WAIT_V(8); PG8_WAIT_L(0); PG8_BAR; PG8_MMA(1, 0, At, B0); PG8_MMA(1, 1, At, B1); PG8_BAR; PG8_SCHED;
            PG8_LDB(B0, 1, 0); PG8_LDB(B1, 1, 1); PG8_SCHED; PG8_LDA(At, 1, 0); PG8_STAGE(PG8_SA(0, 1), a2 + hstep, voffA);
            PG8_WAIT_V(8); PG8_WAIT_L(0); PG8_BAR; PG8_MMA(0, 0, At, B0); PG8_MMA(0, 1, At, B1); PG8_BAR; PG8_SCHED;
            PG8_LDA(At, 1, 1); PG8_STAGE(PG8_SB(1, 0), b3, voffB); PG8_STAGE(PG8_SB(1, 1), b3 + hstep, voffB); PG8_STAGE(PG8_SA(1, 0), a3, voffA);
            PG8_WAIT_V(8); PG8_WAIT_L(0); PG8_BAR; PG8_MMA(1, 0, At, B0); PG8_MMA(1, 1, At, B1); PG8_BAR; PG8_SCHED;
            } else {
            PG8_LDB(B0, 0, 0); PG8_SCHED; PG8_LDA(At, 0, 0); PG8_STAGE(PG8_SA(1, 1), a1 + hstep, voffA);
            PG8_WAIT_L(8); PG8_BAR; PG8_WAIT_L(0); PG8_MMA(0, 0, At, B0); PG8_BAR; PG8_SCHED;
            PG8_LDB(B1, 0, 1); PG8_STAGE(PG8_SB(0, 0), b2, voffB);
            PG8_BAR; PG8_WAIT_L(0); PG8_MMA(0, 1, At, B1); PG8_BAR;
            PG8_LDA(At, 0, 1); PG8_STAGE(PG8_SA(0, 0), a2, voffA);
            PG8_BAR; PG8_WAIT_L(0); PG8_MMA(1, 0, At, B0); PG8_BAR; PG8_SCHED;
            PG8_STAGE(PG8_SB(0, 1), b2 + hstep, voffB);
            PG8_WAIT_V(6); PG8_BAR; PG8_MMA(1, 1, At, B1); PG8_BAR;
            PG8_LDB(B0, 1, 0); PG8_SCHED; PG8_LDA(At, 1, 0); PG8_STAGE(PG8_SA(0, 1), a2 + hstep, voffA);
            PG8_WAIT_L(8); PG8_BAR; PG8_WAIT_L(0); PG8_MMA(0, 0, At, B0); PG8_BAR; PG8_SCHED;
            PG8_LDB(B1, 1, 1); PG8_STAGE(PG8_SB(1, 0), b3, voffB);
            PG8_BAR; PG8_WAIT_L(0); PG8_MMA(0, 1, At, B1); PG8_BAR;
            PG8_LDA(At, 1, 1); PG8_STAGE(PG8_SA(1, 0), a3, voffA);
            PG8_BAR; PG8_WAIT_L(0); PG8_MMA(1, 0, At, B0); PG8_BAR; PG8_SCHED;
            PG8_STAGE(PG8_SB(1, 1), b3 + hstep, voffB);
            PG8_WAIT_V(6); PG8_BAR; PG8_MMA(1, 1, At, B1); PG8_BAR;
            }
        }
        if constexpr (ALIGN_EPI) { if (wr == 0) PG8_BAR; }
        if constexpr (!Epi::AFTER_DRAIN) { E(acc, cur, wr, wc, fr, fq); S.done(cur); }
        if (!has_next) break;
#pragma unroll
        for (int a = 0; a < 2; ++a)
#pragma unroll
            for (int b = 0; b < 2; ++b)
#pragma unroll
                for (int m = 0; m < 4; ++m)
#pragma unroll
                    for (int n = 0; n < 2; ++n) acc[a][b][m][n] = (f32x4){0.f, 0.f, 0.f, 0.f};
        cur = nxt; cA = nA; cB = nB; ++ui;
        if constexpr (ALIGN_EPI) { if (wr == 1) PG8_BAR; }
    }
    PG8_WAIT_V(0);
    if constexpr (!ALIGN_EPI) { if (wr == 0) PG8_BAR; }
    PG8_BAR;
    if constexpr (Epi::AFTER_DRAIN) { E.fused(acc, cur, wr, wc, fr, fq, lds, wid, lane); S.done(cur); }
#undef PG8_SA
#undef PG8_SB
#undef PG8_STAGE
#undef PG8_LDA
#undef PG8_LDB
#undef PG8_MMA
#undef PG8_WAIT_V
#undef PG8_WAIT_L
#undef PG8_BAR
#undef PG8_SCHED
}
}
#define GAS __attribute__((address_space(1)))
#define LAS __attribute__((address_space(3)))
typedef unsigned short bf16;
typedef unsigned v4u __attribute__((ext_vector_type(4)));
typedef float f32x4 __attribute__((ext_vector_type(4)));
typedef short bf16x8 __attribute__((ext_vector_type(8)));
typedef GAS unsigned gu32;
typedef GAS unsigned long long gu64;
#define RLX_AGENT __ATOMIC_RELAXED, __HIP_MEMORY_SCOPE_AGENT
#define LDS_WAIT() asm volatile("s_waitcnt lgkmcnt(0)" ::: "memory")
#define VM_WAIT() asm volatile("s_waitcnt vmcnt(0)" ::: "memory")
__device__ __forceinline__ unsigned long long rt() { return __builtin_amdgcn_s_memrealtime(); }
__device__ __forceinline__ unsigned f2bf(float f) { unsigned u = __builtin_bit_cast(unsigned, f); return (u + 0x7fffu + ((u >> 16) & 1u)) >> 16; }
__device__ __forceinline__ unsigned pk2(float lo, float hi) { return f2bf(lo) | (f2bf(hi) << 16); }

#define XB_TMO      128
#define XB_XCNT(j)  (256  + 64 * (j))
#define XB_XSUB(j)  (1280 + 64 * (j))
#define XB_XGEN(j)  (2304 + 64 * (j))
#define XB_TOP      3328
#define XB_TOPGEN   3392
#define XCD_BAR_WORDS 3456
#define XB_SPIN_CAP (1u << 18)

__device__ __forceinline__ unsigned xb_ld(unsigned* p)              { return __hip_atomic_load(p, __ATOMIC_RELAXED, __HIP_MEMORY_SCOPE_AGENT); }
__device__ __forceinline__ unsigned xb_add(unsigned* p, unsigned v) { return __hip_atomic_fetch_add(p, v, __ATOMIC_RELAXED, __HIP_MEMORY_SCOPE_AGENT); }
__device__ __forceinline__ unsigned xb_xcc_id() { return (unsigned)__builtin_amdgcn_s_getreg((3 << 11) | 20) & 0xFu; }
#define XB_SPIN(cond, bar) do { unsigned _sp = 0; while (cond) { __builtin_amdgcn_s_sleep(1); \
    if ((++_sp & 255u) == 0u) { if (xb_ld(&(bar)[XB_TMO])) break; if (_sp > XB_SPIN_CAP) { atomicAdd(&(bar)[XB_TMO], 1u); break; } } } } while (0)

struct XcdBarrier {
    unsigned* bar; unsigned x;
    volatile LAS unsigned* st;
};

__device__ __forceinline__ XcdBarrier xcd_barrier_post(unsigned* bar, volatile LAS unsigned* st) {
    XcdBarrier b; b.bar = bar; b.x = xb_xcc_id(); b.st = st;
    if (threadIdx.x == 0) (void)xb_add(&bar[XB_XCNT(b.x)], 1u);
    return b;
}
__device__ __forceinline__ void xcd_barrier_complete(unsigned* bar, unsigned x, unsigned& nloc, unsigned& nx) {
    const unsigned G = gridDim.x * gridDim.y * gridDim.z;
    unsigned sum, cnt, mine, sp = 0u;
    for (;;) {
        sum = 0u; cnt = 0u; mine = 0u;
#pragma unroll
        for (unsigned j = 0; j < 16; ++j) { const unsigned c = xb_ld(&bar[XB_XCNT(j)]); sum += c; cnt += (c > 0u) ? 1u : 0u; mine = (j == x) ? c : mine; }
        if (sum == G) break;
        __builtin_amdgcn_s_sleep(1);
        if ((++sp & 255u) == 0u) { if (xb_ld(&bar[XB_TMO])) break; if (sp > XB_SPIN_CAP) { atomicAdd(&bar[XB_TMO], 1u); break; } }
    }
    nloc = mine > 0u ? mine : 1u; nx = cnt > 0u ? cnt : 1u;
}

__device__ __forceinline__ void xcd_barrier(const XcdBarrier& b) {
    asm volatile("s_waitcnt vmcnt(0)" ::: "memory");
    __syncthreads();
    if (threadIdx.x == 0) {
        unsigned* bar = b.bar;
        __builtin_amdgcn_s_waitcnt(0);
        unsigned nloc = b.st[0], nx = b.st[1];
        if (nloc == 0u) { xcd_barrier_complete(bar, b.x, nloc, nx); b.st[0] = nloc; b.st[1] = nx; }
        const unsigned old = xb_add(&bar[XB_XSUB(b.x)], 1u);
        const unsigned gen = old / nloc;
        if (old + 1u == (gen + 1u) * nloc) {
            __builtin_amdgcn_fence(__ATOMIC_RELEASE, "agent");
            asm volatile("s_waitcnt vmcnt(0)" ::: "memory");
            const unsigned og = xb_add(&bar[XB_TOP], 1u);
            const unsigned tg = og / nx;
            if (og + 1u == (tg + 1u) * nx) xb_add(&bar[XB_TOPGEN], 1u);
            else XB_SPIN(xb_ld(&bar[XB_TOPGEN]) == tg, bar);
            __builtin_amdgcn_fence(__ATOMIC_ACQUIRE, "agent");
            xb_add(&bar[XB_XGEN(b.x)], 1u);
            asm volatile("s_waitcnt vmcnt(0)" ::: "memory");
        } else {
            XB_SPIN(xb_ld(&bar[XB_XGEN(b.x)]) == gen, bar);
            __builtin_amdgcn_fence(__ATOMIC_ACQUIRE, "agent");
            asm volatile("s_waitcnt vmcnt(0)" ::: "memory");
        }
    }
    __syncthreads();
}

constexpr int T = 16384, D = 1024, SEQ = 8192, NCTX = 256, TCX = 512, DIN = 3840, MH = T + TCX;
constexpr int ZU = 0, ZV = 512, ZQ = 1024, ZK = 1536, ZVA = 1664, ZGA = 1792, ZGB = 2816;
constexpr int NEXP = 256, NSLOT = 9, LISTCAP = 16384;
constexpr float LOG2E = 1.4426950408889634f;
constexpr float QSCALE = 0.125f * LOG2E;
constexpr size_t MiB = 1u << 20;
constexpr size_t WS_CTL = 0, CTL_ZERO_BYTES = 1 * MiB;
constexpr size_t WS_ADAP = 1 * MiB;
constexpr size_t WS_ADAF = 2 * MiB;
constexpr size_t WS_ROPE = 2 * MiB + 128 * 1024;
constexpr size_t WS_WST = 2 * MiB + 256 * 1024;
constexpr size_t WS_RWT = 3 * MiB;
constexpr size_t WS_WINT = 4 * MiB;
constexpr size_t WS_WAT = 12 * MiB, WS_WBT = 13 * MiB, WS_WOT = 14 * MiB;
constexpr size_t WS_KVC = 16 * MiB;
constexpr size_t WS_GATEW = 17 * MiB;
constexpr size_t WS_H = 18 * MiB;
constexpr size_t WS_Z = 52 * MiB;
constexpr size_t WS_A = 172 * MiB, WS_O = 188 * MiB;
constexpr size_t WS_TMP = 204 * MiB;
constexpr size_t WS_Y = 268 * MiB;
constexpr size_t WS_X1 = 300 * MiB;
constexpr size_t WS_H2 = 364 * MiB;
constexpr size_t WS_LIST = 396 * MiB;
constexpr size_t WS_CONTRIB = 414 * MiB;
constexpr size_t WS_END = 704 * MiB;
constexpr int CW_BAR = 4096;
constexpr int CW_CNT = 16384;
constexpr int CW_XRANK = 32768;
constexpr int SCR_BYTES = 148480;
constexpr int MISC_OFF = SCR_BYTES;
constexpr int LDS_BYTES = 152 * 1024;
constexpr int NWAVES = 8;

typedef float f32x2_t __attribute__((ext_vector_type(2)));
typedef __bf16 bf16x2_t __attribute__((ext_vector_type(2)));
typedef float f32x16 __attribute__((ext_vector_type(16)));
typedef short s16x4 __attribute__((ext_vector_type(4)));
typedef short v4i16_t __attribute__((ext_vector_type(4)));
typedef unsigned u32x2 __attribute__((ext_vector_type(2)));
typedef unsigned u32x4 __attribute__((ext_vector_type(4)));
typedef LAS unsigned char* ldsp;

__device__ __forceinline__ unsigned cvtpk(float lo, float hi) { f32x2_t v = {lo, hi}; bf16x2_t b = __builtin_convertvector(v, bf16x2_t); return __builtin_bit_cast(unsigned, b); }
__device__ __forceinline__ float bf2f(unsigned short u) { return __uint_as_float((unsigned)u << 16); }
__device__ __forceinline__ float bflo(unsigned w) { return __uint_as_float(w << 16); }
__device__ __forceinline__ float bfhi(unsigned w) { return __uint_as_float(w & 0xffff0000u); }
__device__ __forceinline__ float wave_sum(float v) {
#pragma unroll
    for (int o = 1; o < 64; o <<= 1) v += __shfl_xor(v, o);
    return v;
}
__device__ __forceinline__ float sigmoid_f(float x) { return __builtin_amdgcn_rcpf(1.f + __builtin_amdgcn_exp2f(-x * LOG2E)); }
__device__ __forceinline__ float silu_f(float x) { return x * sigmoid_f(x); }
__device__ __forceinline__ float gelu_f(float x) { const float u = 0.7978845608028654f * (x + 0.044715f * x * x * x); return x * sigmoid_f(2.f * u); }
__device__ __forceinline__ f32x16 mfma32(bf16x8 a, bf16x8 b, f32x16 c) { return __builtin_amdgcn_mfma_f32_32x32x16_bf16(a, b, c, 0, 0, 0); }
__device__ __forceinline__ f32x4 mfma16(bf16x8 a, bf16x8 b, f32x4 c) { return __builtin_amdgcn_mfma_f32_16x16x32_bf16(a, b, c, 0, 0, 0); }

struct Args { const float* in[26]; float* out; unsigned char* ws; int ph_lo, ph_hi; };
enum { I_X = 0, I_C, I_CTX, I_CCTX, I_ADAW, I_ADAB, I_N1G, I_N2G, I_WIN, I_LNG, I_LNB, I_GWS, I_GBS, I_SINK, I_WA, I_WB, I_WO, I_RW, I_RB, I_EG, I_EU, I_ED, I_SG, I_SU, I_SD, I_FG };

__device__ __forceinline__ void p0_transpose_item(const float* W, int K, int N, bf16* WT, LAS float* scr, int item, int lane) {
    const int nblk = N / 32, kb = item / nblk, nb = item % nblk, k0 = 64 * kb, n0 = 32 * nb;
#pragma unroll 8
    for (int i = 0; i < 32; ++i) { const int kk = 2 * i + (lane >> 5); scr[kk * 33 + (lane & 31)] = W[(size_t)(k0 + kk) * N + n0 + (lane & 31)]; }
    LDS_WAIT(); asm volatile("" ::: "memory");
    const int c = lane & 7;
#pragma unroll
    for (int j = 0; j < 4; ++j) { const int n = (lane >> 3) + 8 * j; const LAS float* s = scr + (8 * c) * 33 + n;
        v4u o; o.x = pk2(s[0 * 33], s[1 * 33]); o.y = pk2(s[2 * 33], s[3 * 33]); o.z = pk2(s[4 * 33], s[5 * 33]); o.w = pk2(s[6 * 33], s[7 * 33]);
        *(GAS v4u*)(WT + (size_t)(n0 + n) * K + k0 + 8 * c) = o; }
    LDS_WAIT(); asm volatile("" ::: "memory");
}

__device__ __forceinline__ void phase_prep(const Args& a, ldsp lds, int G) {
    const int tid = threadIdx.x, lane = tid & 63, wave = __builtin_amdgcn_readfirstlane(tid >> 6), blk = blockIdx.x;
    unsigned char* ws = a.ws;
    if (blk < 192) {
        const int cb = blk % 24, kc = blk / 24, col = cb * 256 + lane * 4, k0 = kc * 128 + wave * 16;
        const float* c = a.in[I_C]; const float* cc = a.in[I_CCTX]; const float* aw = a.in[I_ADAW];
        f32x4 a0 = {0.f, 0.f, 0.f, 0.f}, a1 = a0, a2 = a0;
#pragma unroll 4
        for (int k = 0; k < 16; ++k) {
            const int kk = k0 + k;
            const float s0 = silu_f(c[kk]), s1 = silu_f(c[1024 + kk]), s2 = silu_f(cc[kk]);
            const f32x4 w = *(const f32x4*)(aw + (size_t)kk * 6144 + col);
            a0 += w * s0; a1 += w * s1; a2 += w * s2;
        }
        LAS float* red = (LAS float*)lds;
        *(LAS f32x4*)(red + (wave * 3 + 0) * 256 + lane * 4) = a0;
        *(LAS f32x4*)(red + (wave * 3 + 1) * 256 + lane * 4) = a1;
        *(LAS f32x4*)(red + (wave * 3 + 2) * 256 + lane * 4) = a2;
        __syncthreads();
        float* adap = (float*)(ws + WS_ADAP);
        for (int idx = tid; idx < 768; idx += 512) {
            const int v = idx >> 8, cl = idx & 255; float s = 0.f;
#pragma unroll
            for (int w = 0; w < 8; ++w) s += red[(w * 3 + v) * 256 + cl];
            adap[(size_t)(kc * 3 + v) * 6144 + cb * 256 + cl] = s;
        }
        __syncthreads();
    }
    {
        LAS float* scr = (LAS float*)(lds + wave * 8704);
        const int gw = blk * NWAVES + wave, NGW = G * NWAVES;
        constexpr int I_1 = 16 * 120, I_2 = 8 * 32, I_3 = 8 * 32, I_4 = 16 * 32, I_5 = 16 * 8;
        for (int it = gw; it < I_1 + I_2 + I_3 + I_4 + I_5; it += NGW) {
            int r = it;
            if (r < I_1) { p0_transpose_item(a.in[I_WIN], 1024, 3840, (bf16*)(ws + WS_WINT), scr, r, lane); continue; } r -= I_1;
            if (r < I_2) { p0_transpose_item(a.in[I_WA], 512, 1024, (bf16*)(ws + WS_WAT), scr, r, lane); continue; } r -= I_2;
            if (r < I_3) { p0_transpose_item(a.in[I_WB], 512, 1024, (bf16*)(ws + WS_WBT), scr, r, lane); continue; } r -= I_3;
            if (r < I_4) { p0_transpose_item(a.in[I_WO], 1024, 1024, (bf16*)(ws + WS_WOT), scr, r, lane); continue; } r -= I_4;
            p0_transpose_item(a.in[I_RW], 1024, 256, (bf16*)(ws + WS_RWT), scr, r, lane);
        }
    }
    {
        const int gt = blk * 512 + tid, NT = G * 512;
        const float* gws = a.in[I_GWS]; bf16* wst = (bf16*)(ws + WS_WST);
        for (int i = gt; i < 8192; i += NT) {
            const f32x4 x0 = *(const f32x4*)(gws + i * 8), x1 = *(const f32x4*)(gws + i * 8 + 4);
            v4u o; o.x = cvtpk(x0[0], x0[1]); o.y = cvtpk(x0[2], x0[3]); o.z = cvtpk(x1[0], x1[1]); o.w = cvtpk(x1[2], x1[3]);
            *(v4u*)(wst + i * 8) = o;
        }
        float* rope = (float*)(ws + WS_ROPE);
        for (int i = gt; i < 2048; i += NT) {
            const int pos = i >> 4, f = i & 15;
            const float inv = __builtin_amdgcn_exp2f(-(float)f * (13.287712379549449f / 16.f));
            const float ang = (float)pos * inv;
            double rev = (double)ang * 0.15915494309189535; rev -= floor(rev);
            rope[pos * 32 + f] = __builtin_amdgcn_cosf((float)rev);
            rope[pos * 32 + 16 + f] = __builtin_amdgcn_sinf((float)rev);
        }
    }
}

__device__ __forceinline__ void phase_hnorm(const Args& a, ldsp lds, int G) {
    const int tid = threadIdx.x, lane = tid & 63, wave = __builtin_amdgcn_readfirstlane(tid >> 6), blk = blockIdx.x;
    unsigned char* ws = a.ws;
    const float* adap = (const float*)(ws + WS_ADAP); const float* adab = a.in[I_ADAB];
    LAS float* modv = (LAS float*)lds;
    for (int idx = tid; idx < 3 * 2048; idx += 512) {
        const int v = idx >> 11, j = idx & 2047; float s = adab[j];
#pragma unroll
        for (int kc = 0; kc < 8; ++kc) s += adap[(size_t)(kc * 3 + v) * 6144 + j];
        modv[idx] = (j >= 1024) ? s + 1.f : s;
    }
    { float* adaf = (float*)(ws + WS_ADAF);
      for (int idx = blk * 512 + tid; idx < 3 * 6144; idx += G * 512) {
          const int v = idx / 6144, j = idx % 6144; float s = adab[j];
#pragma unroll
          for (int kc = 0; kc < 8; ++kc) s += adap[(size_t)(kc * 3 + v) * 6144 + j];
          adaf[idx] = s; } }
    __syncthreads();
    const float* g1 = a.in[I_N1G]; bf16* H = (bf16*)(ws + WS_H);
    for (int t = blk * NWAVES + wave; t < MH; t += G * NWAVES) {
        const float* xr = (t < T) ? a.in[I_X] + (size_t)t * D : a.in[I_CTX] + (size_t)(t - T) * D;
        const int v = (t < T) ? (t >> 13) : 2;
        f32x4 x[4]; float ss = 0.f;
#pragma unroll
        for (int j = 0; j < 4; ++j) { x[j] = *(const f32x4*)(xr + 4 * lane + 256 * j); ss += (x[j][0] * x[j][0] + x[j][1] * x[j][1]) + (x[j][2] * x[j][2] + x[j][3] * x[j][3]); }
        const float r = rsqrtf(wave_sum(ss) * (1.f / D) + 1e-6f);
#pragma unroll
        for (int j = 0; j < 4; ++j) {
            const int col = 4 * lane + 256 * j;
            const f32x4 g = *(const f32x4*)(g1 + col);
            const f32x4 sh = *(LAS f32x4*)(modv + v * 2048 + col), sc = *(LAS f32x4*)(modv + v * 2048 + 1024 + col);
            const f32x4 h = (x[j] * r) * g * sc + sh;
            u32x2 o; o.x = cvtpk(h[0], h[1]); o.y = cvtpk(h[2], h[3]);
            *(u32x2*)(H + (size_t)t * D + col) = o;
        }
    }
}

struct WinOrder {
    pg8::StaticOrder so;
    __device__ void init(int G, int c) { so.init(T, DIN, G, c); }
    __device__ bool next(int i, pg8::Unit& u) const {
        const long L = (long)i * so.G + so.c;
        if (L < 960) return so.next(i, u);
        if (L < 962) { u.pm = 64 + (int)(L - 960); u.pn = 6; return true; }
        return false;
    }
    __device__ __forceinline__ void a_ready(const pg8::Unit&) const {}
    __device__ __forceinline__ void done(const pg8::Unit&) const {}
};
struct EpiWin {
    static constexpr bool PERM = false, AFTER_DRAIN = false;
    bf16* Z; bf16* KVC; const float* rope;
    __device__ __forceinline__ void operator()(const pg8::f32x4 (&acc)[2][2][4][2], const pg8::Unit& u, int wr, int wc, int fr, int fq) const {
        const int row0 = u.pm * 256 + wr * 64 + fr, colb = u.pn * 256 + wc * 32 + 4 * fq, pn = u.pn;
        if (u.pm >= 64) {
#pragma unroll
            for (int ai = 0; ai < 2; ++ai)
#pragma unroll
                for (int m = 0; m < 4; ++m) { bf16* rp = KVC + (size_t)(row0 + ai * 128 + m * 16 - T) * 256 + (colb - ZK);
#pragma unroll
                    for (int bj = 0; bj < 2; ++bj)
#pragma unroll
                        for (int n = 0; n < 2; ++n) { const pg8::f32x4 v = acc[ai][bj][m][n]; u32x2 o; o.x = cvtpk(v[0], v[1]); o.y = cvtpk(v[2], v[3]); *(u32x2*)(rp + bj * 128 + n * 16) = o; } }
            return;
        }
#pragma unroll
        for (int ai = 0; ai < 2; ++ai)
#pragma unroll
            for (int m = 0; m < 4; ++m) {
                const int r = row0 + ai * 128 + m * 16; bf16* rp = Z + (size_t)r * DIN + colb;
                if (pn <= 3) {
#pragma unroll
                    for (int bj = 0; bj < 2; ++bj)
#pragma unroll
                        for (int n = 0; n < 2; ++n) { const pg8::f32x4 v = acc[ai][bj][m][n]; u32x2 o; o.x = cvtpk(gelu_f(v[0]), gelu_f(v[1])); o.y = cvtpk(gelu_f(v[2]), gelu_f(v[3])); *(u32x2*)(rp + bj * 128 + n * 16) = o; }
                } else if (pn <= 6) {
                    const int pos = (wc & 1) ? (r & 63) : ((r & 8191) >> 6);
                    const pg8::f32x4 cs = *(const pg8::f32x4*)(rope + pos * 32 + 4 * fq), sn = *(const pg8::f32x4*)(rope + pos * 32 + 16 + 4 * fq);
                    const float sc = (pn < 6) ? QSCALE : 1.f;
#pragma unroll
                    for (int bj = 0; bj < 2; ++bj) {
                        const pg8::f32x4 x1 = acc[ai][bj][m][0], x2 = acc[ai][bj][m][1];
                        pg8::f32x4 o1, o2;
                        if (pn == 6 && bj == 1) { o1 = x1; o2 = x2; }
                        else { o1 = (x1 * cs - x2 * sn) * sc; o2 = (x2 * cs + x1 * sn) * sc; }
                        u32x2 w1, w2; w1.x = cvtpk(o1[0], o1[1]); w1.y = cvtpk(o1[2], o1[3]); w2.x = cvtpk(o2[0], o2[1]); w2.y = cvtpk(o2[2], o2[3]);
                        *(u32x2*)(rp + bj * 128) = w1; *(u32x2*)(rp + bj * 128 + 16) = w2;
                    }
                } else {
#pragma unroll
                    for (int bj = 0; bj < 2; ++bj)
#pragma unroll
                        for (int n = 0; n < 2; ++n) { const pg8::f32x4 v = acc[ai][bj][m][n]; u32x2 o; o.x = cvtpk(sigmoid_f(v[0]), sigmoid_f(v[1])); o.y = cvtpk(sigmoid_f(v[2]), sigmoid_f(v[3])); *(u32x2*)(rp + bj * 128 + n * 16) = o; }
                }
            }
    }
};
struct EpiMergeA {
    static constexpr bool PERM = true, AFTER_DRAIN = false;
    const bf16* Z; bf16* Y;
    __device__ __forceinline__ void operator()(const pg8::f32x4 (&acc)[2][2][4][2], const pg8::Unit& u, int wr, int wc, int fr, int fq) const {
        const int row0 = u.pm * 256 + wr * 64 + fr, col0 = u.pn * 256 + wc * 32 + 8 * fq;
#pragma unroll
        for (int ai = 0; ai < 2; ++ai)
#pragma unroll
            for (int m = 0; m < 4; ++m) { const int r = row0 + ai * 128 + m * 16;
#pragma unroll
                for (int bj = 0; bj < 2; ++bj) { const int c = col0 + bj * 128;
                    const u32x4 g = *(const u32x4*)(Z + (size_t)r * DIN + ZGA + c);
                    const pg8::f32x4 v0 = acc[ai][bj][m][0], v1 = acc[ai][bj][m][1];
                    u32x4 o;
                    o.x = cvtpk(v0[0] * bflo(g.x), v0[1] * bfhi(g.x)); o.y = cvtpk(v0[2] * bflo(g.y), v0[3] * bfhi(g.y));
                    o.z = cvtpk(v1[0] * bflo(g.z), v1[1] * bfhi(g.z)); o.w = cvtpk(v1[2] * bflo(g.w), v1[3] * bfhi(g.w));
                    *(u32x4*)(Y + (size_t)r * D + c) = o; } }
    }
};
struct EpiMergeB {
    static constexpr bool PERM = true, AFTER_DRAIN = false;
    const bf16* Z; bf16* Y;
    __device__ __forceinline__ void operator()(const pg8::f32x4 (&acc)[2][2][4][2], const pg8::Unit& u, int wr, int wc, int fr, int fq) const {
        const int row0 = u.pm * 256 + wr * 64 + fr, col0 = u.pn * 256 + wc * 32 + 8 * fq;
#pragma unroll
        for (int ai = 0; ai < 2; ++ai)
#pragma unroll
            for (int m = 0; m < 4; ++m) { const int r = row0 + ai * 128 + m * 16;
#pragma unroll
                for (int bj = 0; bj < 2; ++bj) { const int c = col0 + bj * 128;
                    const u32x4 g = *(const u32x4*)(Z + (size_t)r * DIN + ZGB + c);
                    const u32x4 tp = *(const u32x4*)(Y + (size_t)r * D + c);
                    const pg8::f32x4 t0 = {bflo(tp.x), bfhi(tp.x), bflo(tp.y), bfhi(tp.y)}, t1 = {bflo(tp.z), bfhi(tp.z), bflo(tp.w), bfhi(tp.w)};
                    const pg8::f32x4 v0 = acc[ai][bj][m][0], v1 = acc[ai][bj][m][1];
                    u32x4 o;
                    o.x = cvtpk(t0[0] + v0[0] * bflo(g.x), t0[1] + v0[1] * bfhi(g.x)); o.y = cvtpk(t0[2] + v0[2] * bflo(g.y), t0[3] + v0[3] * bfhi(g.y));
                    o.z = cvtpk(t1[0] + v1[0] * bflo(g.z), t1[1] + v1[1] * bfhi(g.z)); o.w = cvtpk(t1[2] + v1[2] * bflo(g.w), t1[3] + v1[3] * bfhi(g.w));
                    *(u32x4*)(Y + (size_t)r * D + c) = o; } }
    }
};
struct EpiWo {
    static constexpr bool PERM = true, AFTER_DRAIN = false;
    const float* x; const float* adaf; bf16* X1;
    __device__ __forceinline__ void operator()(const pg8::f32x4 (&acc)[2][2][4][2], const pg8::Unit& u, int wr, int wc, int fr, int fq) const {
        const int row0 = u.pm * 256 + wr * 64 + fr, col0 = u.pn * 256 + wc * 32 + 8 * fq;
        const float* g1 = adaf + (u.pm >= 32 ? 6144 : 0) + 2048;
#pragma unroll
        for (int bj = 0; bj < 2; ++bj) { const int c = col0 + bj * 128;
            const pg8::f32x4 ga = *(const pg8::f32x4*)(g1 + c), gb = *(const pg8::f32x4*)(g1 + c + 4);
#pragma unroll
            for (int ai = 0; ai < 2; ++ai)
#pragma unroll
                for (int m = 0; m < 4; ++m) { const int r = row0 + ai * 128 + m * 16;
                    const pg8::f32x4 x0 = *(const pg8::f32x4*)(x + (size_t)r * D + c), x1 = *(const pg8::f32x4*)(x + (size_t)r * D + c + 4);
                    const pg8::f32x4 o0 = x0 + ga * acc[ai][bj][m][0], o1 = x1 + gb * acc[ai][bj][m][1];
                    u32x4 w; w.x = cvtpk(o0[0], o0[1]); w.y = cvtpk(o0[2], o0[3]); w.z = cvtpk(o1[0], o1[1]); w.w = cvtpk(o1[2], o1[3]);
                    *(u32x4*)(X1 + (size_t)r * D + c) = w; } }
    }
};

__device__ __forceinline__ s16x4 vtr(LAS const unsigned char* p) { return __builtin_bit_cast(s16x4, __builtin_amdgcn_ds_read_tr16_b64_v4i16((LAS v4i16_t*)p)); }

__device__ __forceinline__ void attn_item(const bf16* Z, const bf16* KVC, const float* sink, bf16* Obuf, ldsp lds, int b, int nb, int hk, int qh) {
    const int tid = threadIdx.x, lane = tid & 63, wave = __builtin_amdgcn_readfirstlane(tid >> 6), r32 = lane & 31, hi = lane >> 5;
    const int rq = wave >> 1, head = hk * 4 + rq;
    const int iq = qh * 64 + (wave & 1) * 32 + r32;
    const int wlo = (nb == 0) ? 2 : qh, whi = (nb == 63) ? 4 : 5 + qh, nwin = whi - wlo, ntile = nwin + 4;
    const int tokq = b * SEQ + nb * 128 + iq;
    bf16x8 qr[4];
#pragma unroll
    for (int d0 = 0; d0 < 4; ++d0) qr[d0] = *(const bf16x8*)(Z + (size_t)tokq * DIN + ZQ + head * 64 + d0 * 16 + hi * 8);
    float mrun = sink[head] * LOG2E, lrun = (hi == 0) ? 1.f : 0.f;
    f32x16 o[2];
#pragma unroll
    for (int j = 0; j < 2; ++j)
#pragma unroll
        for (int r = 0; r < 16; ++r) o[j][r] = 0.f;
    const int kdst = wave * 1024 + lane * 16, vdst = 8192 + (wave >> 2) * 4096 + lane * 64 + (wave & 3) * 16;
#define ATT_SRC(s, kp, vp) do { const int tl_ = (s) < nwin ? wlo + (s) : 6 + (s) - nwin; \
        if (tl_ < 6) { const int tok_ = b * SEQ + (nb - 1 + (tl_ >> 1)) * 128 + (tl_ & 1) * 64 + lane; kp = Z + (size_t)tok_ * DIN + ZK + hk * 64 + wave * 8; vp = Z + (size_t)tok_ * DIN + ZVA + hk * 64 + wave * 8; } \
        else { const int row_ = b * NCTX + (tl_ - 6) * 64 + lane; kp = KVC + (size_t)row_ * 256 + hk * 64 + wave * 8; vp = KVC + (size_t)row_ * 256 + 128 + hk * 64 + wave * 8; } } while (0)
    u32x4 kreg, vreg;
    { const bf16 *kp, *vp; ATT_SRC(0, kp, vp); kreg = *(const u32x4*)kp; vreg = *(const u32x4*)vp; }
    *(LAS u32x4*)(lds + kdst) = kreg; *(LAS u32x4*)(lds + vdst) = vreg;
    __syncthreads();
    const int vrd = ((lane & 15) >> 2) * 64 + ((lane >> 4) & 1) * 32 + (lane & 3) * 8 + hi * 256;
    for (int s = 0; s < ntile; ++s) {
        const int base = (s & 1) * 16384;
        const int tl = s < nwin ? wlo + s : 6 + s - nwin;
        if (s + 1 < ntile) { const bf16 *kp, *vp; ATT_SRC(s + 1, kp, vp); kreg = *(const u32x4*)kp; vreg = *(const u32x4*)vp; }
        {
            f32x16 p0, p1;
#pragma unroll
            for (int r = 0; r < 16; ++r) { p0[r] = 0.f; p1[r] = 0.f; }
#pragma unroll
            for (int d0 = 0; d0 < 4; ++d0) {
                const bf16x8 k0 = *(LAS const bf16x8*)(lds + base + (2 * d0 + hi) * 1024 + r32 * 16);
                const bf16x8 k1 = *(LAS const bf16x8*)(lds + base + (2 * d0 + hi) * 1024 + (r32 + 32) * 16);
                p0 = mfma32(k0, qr[d0], p0); p1 = mfma32(k1, qr[d0], p1);
            }
            if (tl < 2) {
                const int j0 = (tl & 1) * 64 + 4 * hi;
#pragma unroll
                for (int r = 0; r < 16; ++r) { const int j = j0 + (r & 3) + 8 * (r >> 2); if (j < iq) p0[r] = -INFINITY; if (j + 32 < iq) p1[r] = -INFINITY; }
            } else if (tl == 4 || tl == 5) {
                const int j0 = (tl & 1) * 64 + 4 * hi;
#pragma unroll
                for (int r = 0; r < 16; ++r) { const int j = j0 + (r & 3) + 8 * (r >> 2); if (j > iq) p0[r] = -INFINITY; if (j + 32 > iq) p1[r] = -INFINITY; }
            }
            float mx = fmaxf(p0[0], p1[0]);
#pragma unroll
            for (int r = 1; r < 16; ++r) mx = fmaxf(mx, fmaxf(p0[r], p1[r]));
            mx = fmaxf(mx, __shfl_xor(mx, 32));
            const float mn = fmaxf(mrun, mx), alpha = __builtin_amdgcn_exp2f(mrun - mn);
            mrun = mn;
            float rs = 0.f;
#pragma unroll
            for (int r = 0; r < 16; ++r) { p0[r] = __builtin_amdgcn_exp2f(p0[r] - mn); p1[r] = __builtin_amdgcn_exp2f(p1[r] - mn); rs += p0[r] + p1[r]; }
            lrun = lrun * alpha + rs;
#pragma unroll
            for (int r = 0; r < 16; ++r) { o[0][r] *= alpha; o[1][r] *= alpha; }
            bf16x8 pf[4];
#pragma unroll
            for (int s4 = 0; s4 < 4; ++s4) {
                u32x4 w;
                if (s4 < 2) { w.x = cvtpk(p0[8 * s4 + 0], p0[8 * s4 + 1]); w.y = cvtpk(p0[8 * s4 + 2], p0[8 * s4 + 3]); w.z = cvtpk(p0[8 * s4 + 4], p0[8 * s4 + 5]); w.w = cvtpk(p0[8 * s4 + 6], p0[8 * s4 + 7]); }
                else { const int q = s4 - 2; w.x = cvtpk(p1[8 * q + 0], p1[8 * q + 1]); w.y = cvtpk(p1[8 * q + 2], p1[8 * q + 3]); w.z = cvtpk(p1[8 * q + 4], p1[8 * q + 5]); w.w = cvtpk(p1[8 * q + 6], p1[8 * q + 7]); }
                pf[s4] = __builtin_bit_cast(bf16x8, w);
            }
#pragma unroll
            for (int dblk = 0; dblk < 2; ++dblk)
#pragma unroll
                for (int s4 = 0; s4 < 4; ++s4) {
                    const s16x4 lo = vtr(lds + base + 8192 + dblk * 4096 + vrd + (16 * s4) * 64);
                    const s16x4 hh = vtr(lds + base + 8192 + dblk * 4096 + vrd + (16 * s4 + 8) * 64);
                    const bf16x8 vf = {lo[0], lo[1], lo[2], lo[3], hh[0], hh[1], hh[2], hh[3]};
                    o[dblk] = mfma32(vf, pf[s4], o[dblk]);
                }
        }
        if (s + 1 < ntile) { *(LAS u32x4*)(lds + (16384 - base) + kdst) = kreg; *(LAS u32x4*)(lds + (16384 - base) + vdst) = vreg; }
        __syncthreads();
    }
#undef ATT_SRC
    {
        const float lt = lrun + __shfl_xor(lrun, 32), inv = 1.f / lt;
        bf16* op = Obuf + (size_t)tokq * 512 + head * 64;
#pragma unroll
        for (int dblk = 0; dblk < 2; ++dblk)
#pragma unroll
            for (int r4 = 0; r4 < 4; ++r4) {
                u32x2 w; w.x = cvtpk(o[dblk][4 * r4] * inv, o[dblk][4 * r4 + 1] * inv); w.y = cvtpk(o[dblk][4 * r4 + 2] * inv, o[dblk][4 * r4 + 3] * inv);
                *(u32x2*)(op + 32 * dblk + 8 * r4 + 4 * hi) = w;
            }
    }
}

__device__ __forceinline__ void gmlp_item(const bf16* Z, const float* lng, const float* lnb, const bf16* WsT, const float* bs, bf16* Abuf, ldsp lds, int ch, int g) {
    const int tid = threadIdx.x, lane = tid & 63, wave = __builtin_amdgcn_readfirstlane(tid >> 6), fr = lane & 15, fq = lane >> 4;
    const int tok0 = ch * 128;
    LAS bf16* VT = (LAS bf16*)lds;
    f32x4 gA = *(const f32x4*)(lng + lane * 8), gB = *(const f32x4*)(lng + lane * 8 + 4), bA = *(const f32x4*)(lnb + lane * 8), bB = *(const f32x4*)(lnb + lane * 8 + 4);
#pragma unroll
    for (int rnd = 0; rnd < 2; ++rnd) {
        float y[8][8];
#pragma unroll
        for (int j = 0; j < 8; ++j) {
            const int tok = tok0 + wave * 16 + rnd * 8 + j;
            const u32x4 raw = *(const u32x4*)(Z + (size_t)tok * DIN + ZV + lane * 8);
            float x[8] = {bflo(raw.x), bfhi(raw.x), bflo(raw.y), bfhi(raw.y), bflo(raw.z), bfhi(raw.z), bflo(raw.w), bfhi(raw.w)};
            float s = 0.f;
#pragma unroll
            for (int i = 0; i < 8; ++i) s += x[i];
            const float mu = wave_sum(s) * (1.f / 512.f);
            float q = 0.f;
#pragma unroll
            for (int i = 0; i < 8; ++i) { x[i] -= mu; q += x[i] * x[i]; }
            const float rstd = rsqrtf(wave_sum(q) * (1.f / 512.f) + 1e-6f);
            y[j][0] = x[0] * rstd * gA[0] + bA[0]; y[j][1] = x[1] * rstd * gA[1] + bA[1]; y[j][2] = x[2] * rstd * gA[2] + bA[2]; y[j][3] = x[3] * rstd * gA[3] + bA[3];
            y[j][4] = x[4] * rstd * gB[0] + bB[0]; y[j][5] = x[5] * rstd * gB[1] + bB[1]; y[j][6] = x[6] * rstd * gB[2] + bB[2]; y[j][7] = x[7] * rstd * gB[3] + bB[3];
        }
        if ((lane >> 4) == g) {
#pragma unroll
            for (int i = 0; i < 8; ++i) {
                u32x4 w; w.x = cvtpk(y[0][i], y[1][i]); w.y = cvtpk(y[2][i], y[3][i]); w.z = cvtpk(y[4][i], y[5][i]); w.w = cvtpk(y[6][i], y[7][i]);
                *(LAS u32x4*)(VT + (8 * (lane & 15) + i) * 136 + wave * 16 + rnd * 8) = w;
            }
        }
    }
    __syncthreads();
    const int wm = wave >> 1, wn = wave & 1;
    f32x4 acc[2][4];
#pragma unroll
    for (int m = 0; m < 2; ++m)
#pragma unroll
        for (int n = 0; n < 4; ++n) acc[m][n] = (f32x4){0.f, 0.f, 0.f, 0.f};
#pragma unroll
    for (int ks = 0; ks < 4; ++ks) {
        bf16x8 af[2], bfr[4];
#pragma unroll
        for (int m = 0; m < 2; ++m) af[m] = *(const bf16x8*)(WsT + (size_t)g * 16384 + (32 * wm + 16 * m + fr) * 128 + 32 * ks + 8 * fq);
#pragma unroll
        for (int n = 0; n < 4; ++n) bfr[n] = *(LAS const bf16x8*)(VT + (64 * wn + 16 * n + fr) * 136 + 32 * ks + 8 * fq);
#pragma unroll
        for (int m = 0; m < 2; ++m)
#pragma unroll
            for (int n = 0; n < 4; ++n) acc[m][n] = mfma16(af[m], bfr[n], acc[m][n]);
    }
#pragma unroll
    for (int m = 0; m < 2; ++m)
#pragma unroll
        for (int reg = 0; reg < 4; ++reg) {
            const int p = 32 * wm + 16 * m + 4 * fq + reg, tok = tok0 + p; const float bias = bs[g * 128 + p];
#pragma unroll
            for (int n = 0; n < 4; ++n) {
                const int c = g * 128 + 64 * wn + 16 * n + fr;
                const float uu = bf2f(Z[(size_t)tok * DIN + ZU + c]);
                Abuf[(size_t)tok * 512 + c] = (bf16)(cvtpk(uu * (acc[m][n][reg] + bias), 0.f) & 0xffffu);
            }
        }
    __syncthreads();
}

__device__ __forceinline__ void phase_mixers(const Args& a, ldsp lds, int G, int vcu) {
    unsigned char* ws = a.ws;
    const bf16* Z = (const bf16*)(ws + WS_Z);
    for (int it = vcu; it < 512; it += G) {
        const int qh = it & 1, hk = (it >> 1) & 1, nb = (it >> 2) & 63, b = it >> 8;
        attn_item(Z, (const bf16*)(ws + WS_KVC), a.in[I_SINK], (bf16*)(ws + WS_O), lds, b, nb, hk, qh);
    }
    for (int it = vcu; it < 512; it += G) {
        gmlp_item(Z, a.in[I_LNG], a.in[I_LNB], (const bf16*)(ws + WS_WST), a.in[I_GBS], (bf16*)(ws + WS_A), lds, it >> 2, it & 3);
    }
}

#define KI_BEFORE(ka, ia, kb, ib) (((ka) > (kb)) || ((ka) == (kb) && (ia) < (ib)))
#define KI_CAS(K, I, p, q) do { const bool sw_ = KI_BEFORE(K[q], I[q], K[p], I[p]); const float kp_ = sw_ ? K[q] : K[p], kq_ = sw_ ? K[p] : K[q]; const int ip_ = sw_ ? I[q] : I[p], iq_ = sw_ ? I[p] : I[q]; \
        K[p] = kp_; I[p] = ip_; K[q] = kq_; I[q] = iq_; } while (0)
#define KI_SORT8(K, I) do { KI_CAS(K, I, 0, 1); KI_CAS(K, I, 2, 3); KI_CAS(K, I, 4, 5); KI_CAS(K, I, 6, 7); \
        KI_CAS(K, I, 0, 2); KI_CAS(K, I, 1, 3); KI_CAS(K, I, 4, 6); KI_CAS(K, I, 5, 7); \
        KI_CAS(K, I, 1, 2); KI_CAS(K, I, 5, 6); KI_CAS(K, I, 0, 4); KI_CAS(K, I, 3, 7); \
        KI_CAS(K, I, 1, 5); KI_CAS(K, I, 2, 6); KI_CAS(K, I, 1, 4); KI_CAS(K, I, 3, 6); \
        KI_CAS(K, I, 2, 4); KI_CAS(K, I, 3, 5); KI_CAS(K, I, 3, 4); } while (0)
#define KI_MERGE8(KA, IA, KB, IB) do { \
        _Pragma("unroll") for (int r_ = 0; r_ < 8; ++r_) { const bool tb_ = KI_BEFORE(KB[7 - r_], IB[7 - r_], KA[r_], IA[r_]); KA[r_] = tb_ ? KB[7 - r_] : KA[r_]; IA[r_] = tb_ ? IB[7 - r_] : IA[r_]; } \
        KI_CAS(KA, IA, 0, 4); KI_CAS(KA, IA, 1, 5); KI_CAS(KA, IA, 2, 6); KI_CAS(KA, IA, 3, 7); \
        KI_CAS(KA, IA, 0, 2); KI_CAS(KA, IA, 1, 3); KI_CAS(KA, IA, 4, 6); KI_CAS(KA, IA, 5, 7); \
        KI_CAS(KA, IA, 0, 1); KI_CAS(KA, IA, 2, 3); KI_CAS(KA, IA, 4, 5); KI_CAS(KA, IA, 6, 7); } while (0)
__device__ __forceinline__ void router_item(const Args& a, ldsp lds, int it) {
    const int tid = threadIdx.x, lane = tid & 63, wave = __builtin_amdgcn_readfirstlane(tid >> 6), fr = lane & 15, fq = lane >> 4;
    unsigned char* ws = a.ws;
    const int t0 = it * 64, b = t0 >> 13;
    const bf16* X1 = (const bf16*)(ws + WS_X1); const float* adaf = (const float*)(ws + WS_ADAF) + b * 6144;
    const float* g2 = a.in[I_N2G]; bf16* H2 = (bf16*)(ws + WS_H2);
    {
        f32x4 gm[2][2], sh[2][2];
#pragma unroll
        for (int j = 0; j < 2; ++j)
#pragma unroll
            for (int h = 0; h < 2; ++h) {
                const int c = 8 * lane + 512 * j + 4 * h;
                const f32x4 gg = *(const f32x4*)(g2 + c), sc = *(const f32x4*)(adaf + 4 * 1024 + c);
                gm[j][h] = gg * (sc + 1.f); sh[j][h] = *(const f32x4*)(adaf + 3 * 1024 + c);
            }
#pragma unroll
        for (int half = 0; half < 2; ++half) {
            f32x4 x[4][2][2];
#pragma unroll
            for (int tt = 0; tt < 4; ++tt)
#pragma unroll
                for (int j = 0; j < 2; ++j) {
                    const u32x4 w = *(const u32x4*)(X1 + (size_t)(t0 + wave * 8 + half * 4 + tt) * D + 8 * lane + 512 * j);
                    x[tt][j][0] = (f32x4){bflo(w.x), bfhi(w.x), bflo(w.y), bfhi(w.y)}; x[tt][j][1] = (f32x4){bflo(w.z), bfhi(w.z), bflo(w.w), bfhi(w.w)};
                }
#pragma unroll
            for (int tt = 0; tt < 4; ++tt) {
                const int row = wave * 8 + half * 4 + tt, tok = t0 + row;
                float ss = 0.f;
#pragma unroll
                for (int j = 0; j < 2; ++j)
#pragma unroll
                    for (int h = 0; h < 2; ++h) { const f32x4 v = x[tt][j][h]; ss += (v[0] * v[0] + v[1] * v[1]) + (v[2] * v[2] + v[3] * v[3]); }
                const float r = rsqrtf(wave_sum(ss) * (1.f / D) + 1e-6f);
#pragma unroll
                for (int j = 0; j < 2; ++j) {
                    const f32x4 h0 = (x[tt][j][0] * r) * gm[j][0] + sh[j][0], h1 = (x[tt][j][1] * r) * gm[j][1] + sh[j][1];
                    u32x4 w; w.x = cvtpk(h0[0], h0[1]); w.y = cvtpk(h0[2], h0[3]); w.z = cvtpk(h1[0], h1[1]); w.w = cvtpk(h1[2], h1[3]);
                    *(u32x4*)(H2 + (size_t)tok * D + 8 * lane + 512 * j) = w;
                    const int kc = lane + 64 * j;
                    *(LAS u32x4*)(lds + kc * 1024 + ((row ^ (kc & 7)) * 16)) = w;
                }
            }
        }
    }
    __syncthreads();
    f32x4 acc[4][2];
#pragma unroll
    for (int m = 0; m < 4; ++m)
#pragma unroll
        for (int n = 0; n < 2; ++n) acc[m][n] = (f32x4){0.f, 0.f, 0.f, 0.f};
    const bf16* RwT = (const bf16*)(ws + WS_RWT) + (size_t)(32 * wave + fr) * D + 8 * fq;
#pragma unroll 8
    for (int ks = 0; ks < 32; ++ks) {
        const int kc = 4 * ks + fq;
        bf16x8 af[4], bfr[2];
#pragma unroll
        for (int n = 0; n < 2; ++n) bfr[n] = *(const bf16x8*)(RwT + (size_t)(16 * n) * D + 32 * ks);
#pragma unroll
        for (int m = 0; m < 4; ++m) af[m] = *(LAS const bf16x8*)(lds + kc * 1024 + (((16 * m + fr) ^ (kc & 7)) * 16));
#pragma unroll
        for (int m = 0; m < 4; ++m)
#pragma unroll
            for (int n = 0; n < 2; ++n) acc[m][n] = mfma16(af[m], bfr[n], acc[m][n]);
    }
    __syncthreads();
    LAS float* LG = (LAS float*)lds;
#pragma unroll
    for (int m = 0; m < 4; ++m)
#pragma unroll
        for (int n = 0; n < 2; ++n)
#pragma unroll
            for (int reg = 0; reg < 4; ++reg) LG[(32 * wave + 16 * n + fr) * 65 + 16 * m + 4 * fq + reg] = acc[m][n][reg];
    __syncthreads();
    LAS float* CK = (LAS float*)(lds + 69632); LAS int* CI = (LAS int*)(lds + 69632 + 16384);
    const float* rb = a.in[I_RB];
    float bk[8]; int bi[8];
#pragma unroll
    for (int q = 0; q < 4; ++q) {
        float gk[8]; int gi[8];
#pragma unroll
        for (int j = 0; j < 8; ++j) { const int e = 32 * wave + 8 * q + j; gk[j] = sigmoid_f(LG[e * 65 + lane]) + rb[e]; gi[j] = e; }
        KI_SORT8(gk, gi);
        if (q == 0) {
#pragma unroll
            for (int j = 0; j < 8; ++j) { bk[j] = gk[j]; bi[j] = gi[j]; }
        } else KI_MERGE8(bk, bi, gk, gi);
    }
#pragma unroll
    for (int r = 0; r < 8; ++r) { CK[(wave * 8 + r) * 64 + lane] = bk[r]; CI[(wave * 8 + r) * 64 + lane] = bi[r]; }
    __syncthreads();
#define RT_LEVEL(lvl) do { if ((wave & (2 * (lvl) - 1)) == 0) { float ok_[8]; int oi_[8]; \
            _Pragma("unroll") for (int r = 0; r < 8; ++r) { ok_[r] = CK[((wave + (lvl)) * 8 + r) * 64 + lane]; oi_[r] = CI[((wave + (lvl)) * 8 + r) * 64 + lane]; } \
            KI_MERGE8(bk, bi, ok_, oi_); \
            if ((lvl) < 4) { _Pragma("unroll") for (int r = 0; r < 8; ++r) { CK[(wave * 8 + r) * 64 + lane] = bk[r]; CI[(wave * 8 + r) * 64 + lane] = bi[r]; } } } \
        __syncthreads(); } while (0)
    RT_LEVEL(1); RT_LEVEL(2); RT_LEVEL(4);
#undef RT_LEVEL
    LAS unsigned* hist = (LAS unsigned*)(lds + 102400); LAS unsigned* hbase = hist + 256;
    if (tid < 256) hist[tid] = 0u;
    __syncthreads();
    unsigned* cnt = (unsigned*)(ws + WS_CTL) + CW_CNT; int* list = (int*)(ws + WS_LIST); float* gatew = (float*)(ws + WS_GATEW);
    unsigned rank[8];
    if (wave == 0) {
        const int tok = t0 + lane;
        float sel[8], ssum = 0.f;
#pragma unroll
        for (int r = 0; r < 8; ++r) { sel[r] = sigmoid_f(LG[bi[r] * 65 + lane]); ssum += sel[r]; }
#pragma unroll
        for (int r = 0; r < 8; ++r) rank[r] = __hip_atomic_fetch_add(&hist[bi[r]], 1u, __ATOMIC_RELAXED, __HIP_MEMORY_SCOPE_WORKGROUP);
        const float sc = 2.5f / ssum;
        f32x4 g0 = {sel[0] * sc, sel[1] * sc, sel[2] * sc, sel[3] * sc}, g1 = {sel[4] * sc, sel[5] * sc, sel[6] * sc, sel[7] * sc};
        *(f32x4*)(gatew + tok * 8) = g0; *(f32x4*)(gatew + tok * 8 + 4) = g1;
    }
    __syncthreads();
    if (tid < 256) { const unsigned h = hist[tid]; if (h) hbase[tid] = atomicAdd(cnt + 32 * tid, h); }
    __syncthreads();
    if (wave == 0) {
        const int tok = t0 + lane;
#pragma unroll
        for (int r = 0; r < 8; ++r) list[(size_t)bi[r] * LISTCAP + hbase[bi[r]] + rank[r]] = tok * NSLOT + r;
    }
    __syncthreads();
}

__device__ __forceinline__ void moe_tile(const Args& a, ldsp lds, int e, int mt, int nrows, int ntl) {
    const int tid = threadIdx.x, lane = tid & 63, wave = __builtin_amdgcn_readfirstlane(tid >> 6), fr = lane & 15, fq = lane >> 4;
    unsigned char* ws = a.ws;
    constexpr int ASTG = 0, BSTG = 16384, ACT = 49152, SLOTS = 114688, GWO = 115200;
    const bf16* H2 = (const bf16*)(ws + WS_H2);
    const float* Wg = (e < NEXP) ? a.in[I_EG] + (size_t)e * 262144 : a.in[I_SG];
    const float* Wu = (e < NEXP) ? a.in[I_EU] + (size_t)e * 262144 : a.in[I_SU];
    const float* Wd = (e < NEXP) ? a.in[I_ED] + (size_t)e * 262144 : a.in[I_SD];
    if (tid < 128) {
        int slot = -1; float gw = 0.f;
        if (tid < nrows) {
            if (e < NEXP) { slot = ((const int*)(ws + WS_LIST))[(size_t)e * LISTCAP + mt * 128 + tid]; gw = ((const float*)(ws + WS_GATEW))[(slot / NSLOT) * 8 + (slot % NSLOT)]; }
            else { slot = (mt * 128 + tid) * NSLOT + 8; gw = 1.f; }
        }
        ((LAS int*)(lds + SLOTS))[tid] = slot; ((LAS float*)(lds + GWO))[tid] = gw;
    }
    __syncthreads();
    const int wr = wave >> 2, wc = wave & 3;
    const int arow = tid >> 2, akc = tid & 3;
    const int aslot = ((LAS const int*)(lds + SLOTS))[arow];
    const bf16* asrc = H2 + (size_t)((aslot < 0 ? 0 : aslot) / NSLOT) * D + akc * 8;
    const int awr = ASTG + akc * 2048 + ((arow ^ (akc << 1)) * 16);
    const int ng = lane, kq = wave;
    const float* srcg = Wg + (size_t)(4 * kq) * 256 + 4 * ng;
    const float* srcu = Wu + (size_t)(4 * kq) * 256 + 4 * ng;
    const float* src2 = Wd + (size_t)(4 * kq) * 1024 + 4 * ng;
    int bwr2[4];
#pragma unroll
    for (int i = 0; i < 4; ++i) { const int rho2 = 4 * ng + i; bwr2[i] = BSTG + (kq >> 1) * 4096 + ((rho2 ^ ((rho2 >> 3) & 3)) * 16) + (kq & 1) * 8; }
    int ard[4], brd[4], rowm[4];
#pragma unroll
    for (int m = 0; m < 4; ++m) { rowm[m] = 64 * wr + 16 * m + fr; ard[m] = fq * 2048 + ((rowm[m] ^ (fq << 1)) * 16); }
#pragma unroll
    for (int n = 0; n < 4; ++n) { const int rho = 64 * wc + 16 * n + fr; brd[n] = BSTG + fq * 4096 + ((rho ^ ((rho >> 3) & 3)) * 16); }
    bf16* contrib = (bf16*)(ws + WS_CONTRIB);
    f32x4 acc[4][4];
    f32x4 B0[4], B1[4], B2[4], B3[4]; u32x4 A0, A1, A2, A3;
#define G1_LOAD(s_, BR, AR) do { const int s0_ = (s_); const int ss_ = s0_ < 63 ? s0_ : 63; \
        const float* bp_ = ((ss_ < 32) ? srcg : srcu) + (size_t)(32 * (ss_ & 31)) * 256; \
        AR = *(const u32x4*)(asrc + 32 * (ss_ & 31)); \
        _Pragma("unroll") for (int j = 0; j < 4; ++j) BR[j] = *(const f32x4*)(bp_ + j * 256); } while (0)
#define G1_WRITE(BR, AR, buf_) do { \
        *(LAS u32x4*)(lds + (buf_) * 8192 + awr) = AR; \
        _Pragma("unroll") for (int i = 0; i < 4; ++i) { u32x2 w_; w_.x = cvtpk(BR[0][i], BR[1][i]); w_.y = cvtpk(BR[2][i], BR[3][i]); *(LAS u32x2*)(lds + (buf_) * 16384 + bwr2[i]) = w_; } } while (0)
#define MOE_COMPUTE(abase_, buf_) do { \
        bf16x8 af_[4], bf_[4]; \
        _Pragma("unroll") for (int m = 0; m < 4; ++m) af_[m] = *(LAS const bf16x8*)(lds + (abase_) + ard[m]); \
        _Pragma("unroll") for (int n = 0; n < 4; ++n) bf_[n] = *(LAS const bf16x8*)(lds + (buf_) * 16384 + brd[n]); \
        _Pragma("unroll") for (int m = 0; m < 4; ++m) _Pragma("unroll") for (int n = 0; n < 4; ++n) acc[m][n] = mfma16(bf_[n], af_[m], acc[m][n]); } while (0)
#define ACC_ZERO() do { _Pragma("unroll") for (int m = 0; m < 4; ++m) _Pragma("unroll") for (int n = 0; n < 4; ++n) acc[m][n] = (f32x4){0.f, 0.f, 0.f, 0.f}; } while (0)
    G1_LOAD(0, B0, A0); G1_LOAD(1, B1, A1); G1_LOAD(2, B2, A2);
    G1_WRITE(B0, A0, 0);
    __syncthreads();
    for (int s = 0; s < 64; s += 4) {
        if ((s & 31) == 0) ACC_ZERO();
        G1_LOAD(s + 3, B3, A3); MOE_COMPUTE(0, 0); G1_WRITE(B1, A1, 1); __syncthreads();
        G1_LOAD(s + 4, B0, A0); MOE_COMPUTE(8192, 1); G1_WRITE(B2, A2, 0); __syncthreads();
        G1_LOAD(s + 5, B1, A1); MOE_COMPUTE(0, 0); G1_WRITE(B3, A3, 1); __syncthreads();
        G1_LOAD(s + 6, B2, A2); MOE_COMPUTE(8192, 1);
        if (s == 28) {
#pragma unroll
            for (int m = 0; m < 4; ++m)
#pragma unroll
                for (int n = 0; n < 4; ++n) {
                    const f32x4 gv = acc[m][n];
                    u32x2 w; w.x = cvtpk(silu_f(gv[0]), silu_f(gv[1])); w.y = cvtpk(silu_f(gv[2]), silu_f(gv[3]));
                    const int kc = 8 * wc + 2 * n + (fq >> 1);
                    *(LAS u32x2*)(lds + ACT + kc * 2048 + ((rowm[m] ^ ((kc & 3) << 1)) * 16) + (fq & 1) * 8) = w;
                }
        } else if (s == 60) {
#pragma unroll
            for (int m = 0; m < 4; ++m)
#pragma unroll
                for (int n = 0; n < 4; ++n) {
                    const f32x4 uv = acc[m][n];
                    const int kc = 8 * wc + 2 * n + (fq >> 1);
                    LAS u32x2* ap = (LAS u32x2*)(lds + ACT + kc * 2048 + ((rowm[m] ^ ((kc & 3) << 1)) * 16) + (fq & 1) * 8);
                    const u32x2 g = *ap;
                    u32x2 w; w.x = cvtpk(bflo(g.x) * uv[0], bfhi(g.x) * uv[1]); w.y = cvtpk(bflo(g.y) * uv[2], bfhi(g.y) * uv[3]);
                    *ap = w;
                }
        }
        G1_WRITE(B0, A0, 0); __syncthreads();
    }
#define G2_LOAD(s_, BR) do { const int s0_ = (s_); const int t_ = s0_ < 31 ? s0_ : 31; \
        const float* bp_ = src2 + (size_t)(32 * (t_ & 7)) * 1024 + 256 * (t_ >> 3); \
        _Pragma("unroll") for (int j = 0; j < 4; ++j) BR[j] = *(const f32x4*)(bp_ + j * 1024); } while (0)
#define G2_WRITE(BR, buf_) do { \
        _Pragma("unroll") for (int i = 0; i < 4; ++i) { u32x2 w_; w_.x = cvtpk(BR[0][i], BR[1][i]); w_.y = cvtpk(BR[2][i], BR[3][i]); *(LAS u32x2*)(lds + (buf_) * 16384 + bwr2[i]) = w_; } } while (0)
    G2_LOAD(0, B0); G2_LOAD(1, B1); G2_LOAD(2, B2);
    G2_WRITE(B0, 0);
    __syncthreads();
    for (int s = 0; s < 32; s += 4) {
        if ((s & 7) == 0) ACC_ZERO();
        G2_LOAD(s + 3, B3); MOE_COMPUTE(ACT + (s & 7) * 8192, 0); G2_WRITE(B1, 1); __syncthreads();
        G2_LOAD(s + 4, B0); MOE_COMPUTE(ACT + ((s + 1) & 7) * 8192, 1); G2_WRITE(B2, 0); __syncthreads();
        G2_LOAD(s + 5, B1); MOE_COMPUTE(ACT + ((s + 2) & 7) * 8192, 0); G2_WRITE(B3, 1); __syncthreads();
        G2_LOAD(s + 6, B2); MOE_COMPUTE(ACT + ((s + 3) & 7) * 8192, 1);
        if ((s & 7) == 4) {
            const int q = s >> 3;
#pragma unroll
            for (int m = 0; m < 4; ++m) {
                const int slot = ((LAS const int*)(lds + SLOTS))[rowm[m]]; const float gw = ((LAS const float*)(lds + GWO))[rowm[m]];
                if (slot >= 0) {
                    bf16* cp = contrib + (size_t)slot * D + q * 256 + 64 * wc + 4 * fq;
#pragma unroll
                    for (int n = 0; n < 4; ++n) { const f32x4 v = acc[m][n] * gw; u32x2 w; w.x = cvtpk(v[0], v[1]); w.y = cvtpk(v[2], v[3]); *(u32x2*)(cp + 16 * n) = w; }
                }
            }
        }
        G2_WRITE(B0, 0); __syncthreads();
    }
#undef G1_LOAD
#undef G1_WRITE
#undef G2_LOAD
#undef G2_WRITE
#undef ACC_ZERO
#undef MOE_COMPUTE
}

template <int TD>
__device__ __forceinline__ void moe_tile_ws(const Args& a, ldsp lds, int e, int mt, int nrows, int ntl, unsigned& junk) {
    const int tid = threadIdx.x, lane = tid & 63, wave = __builtin_amdgcn_readfirstlane(tid >> 6), fr = lane & 15, fq = lane >> 4;
    unsigned char* ws = a.ws;
    constexpr int ASTG = 0, BSTG = 16384, ACT = 49152, SLOTS = 114688, GWO = 115200;
    const float* Wg = (e < NEXP) ? a.in[I_EG] + (size_t)e * 262144 : a.in[I_SG];
    const float* Wu = (e < NEXP) ? a.in[I_EU] + (size_t)e * 262144 : a.in[I_SU];
    const float* Wd = (e < NEXP) ? a.in[I_ED] + (size_t)e * 262144 : a.in[I_SD];
    if (tid < 128) {
        int slot = -1; float gw = 0.f;
        if (tid < nrows) {
            if (e < NEXP) { slot = ((const int*)(ws + WS_LIST))[(size_t)e * LISTCAP + mt * 128 + tid]; gw = ((const float*)(ws + WS_GATEW))[(slot / NSLOT) * 8 + (slot % NSLOT)]; }
            else { slot = (mt * 128 + tid) * NSLOT + 8; gw = 1.f; }
        }
        ((LAS int*)(lds + SLOTS))[tid] = slot; ((LAS float*)(lds + GWO))[tid] = gw;
    }
    __syncthreads();
    if (wave >= 4) {
        const int lt = tid - 256;
        const bf16* H2 = (const bf16*)(ws + WS_H2);
        const int arow = lt >> 1, ahalf = lt & 1;
        const int aslot = ((LAS const int*)(lds + SLOTS))[arow];
        const bf16* asrc = H2 + (size_t)((aslot < 0 ? 0 : aslot) / NSLOT) * D + 16 * ahalf;
        const int awr0 = ASTG + (2 * ahalf) * 2048 + ((arow ^ ((2 * ahalf) << 1)) * 16), awr1 = ASTG + (2 * ahalf + 1) * 2048 + ((arow ^ ((2 * ahalf + 1) << 1)) * 16);
        const int ng = lt & 63, kq = lt >> 6;
        const float* srcg = Wg + (size_t)(8 * kq) * 256 + 4 * ng;
        const float* srcu = Wu + (size_t)(8 * kq) * 256 + 4 * ng;
        const float* srcd = Wd + (size_t)(8 * kq) * 1024 + 4 * ng;
        const int bw = BSTG + kq * 4096 + (4 * ng) * 16, bx = ((4 * ng) >> 3) & 3;
        f32x4 B0[8], B1[8], B2[8], B3[8]; u32x4 A0[2], A1[2], A2[2], A3[2];
#define L_LOADB1(s_, BR) do { const int ss_ = (s_); const int t_ = ss_ - 64; \
            const float* bp_ = (ss_ < 32) ? srcg + (size_t)(32 * ss_) * 256 : (ss_ < 64) ? srcu + (size_t)(32 * (ss_ - 32)) * 256 : srcd + (size_t)(32 * (t_ & 7)) * 1024 + 256 * (t_ >> 3); \
            const int str_ = (ss_ < 64) ? 256 : 1024;        \
            _Pragma("unroll") for (int j = 0; j < 8; ++j) BR[j] = *(const f32x4*)(bp_ + j * str_); } while (0)
#define L_LOADA2(s_, AR, AS) do { const int ss_ = (s_); const int sa_ = ss_ < 62 ? ss_ : 62; \
            AR[0] = *(const u32x4*)(asrc + 32 * (sa_ & 31)); AR[1] = *(const u32x4*)(asrc + 32 * (sa_ & 31) + 8); \
            AS[0] = *(const u32x4*)(asrc + 32 * (sa_ & 31) + 32); AS[1] = *(const u32x4*)(asrc + 32 * (sa_ & 31) + 40); } while (0)
#define L_LOAD2(s_, BR) do { const int s0_ = (s_); const int t_ = s0_ < 31 ? s0_ : 31; \
            const float* bp_ = srcd + (size_t)(32 * (t_ & 7)) * 1024 + 256 * (t_ >> 3); \
            _Pragma("unroll") for (int j = 0; j < 8; ++j) BR[j] = *(const f32x4*)(bp_ + j * 1024); } while (0)
#define L_WRITEB(BR, buf_) do { _Pragma("unroll") for (int i = 0; i < 4; ++i) { u32x4 w_; w_.x = cvtpk(BR[0][i], BR[1][i]); w_.y = cvtpk(BR[2][i], BR[3][i]); w_.z = cvtpk(BR[4][i], BR[5][i]); w_.w = cvtpk(BR[6][i], BR[7][i]); \
            *(LAS u32x4*)(lds + (buf_) * 16384 + bw + ((i ^ bx) * 16)) = w_; } } while (0)
#define L_WRITEA(AR, buf_) do { *(LAS u32x4*)(lds + (buf_) * 8192 + awr0) = AR[0]; *(LAS u32x4*)(lds + (buf_) * 8192 + awr1) = AR[1]; } while (0)
        L_LOADA2(0, A0, A1); L_LOADB1(0, B0); L_LOADB1(1, B1); L_LOADA2(2, A2, A3); L_LOADB1(2, B2);
        L_WRITEA(A0, 0); L_WRITEB(B0, 0);
        __syncthreads();
        for (int s = 0; s < 64; s += 4) {
            L_LOADB1(s + 3, B3); L_WRITEA(A1, 1); L_WRITEB(B1, 1); __syncthreads();
            L_LOADB1(s + 4, B0); L_LOADA2(s + 4, A0, A1); L_WRITEA(A2, 0); L_WRITEB(B2, 0); __syncthreads();
            L_LOADB1(s + 5, B1); L_WRITEA(A3, 1); L_WRITEB(B3, 1); __syncthreads();
            L_LOADB1(s + 6, B2); L_LOADA2(s + 6, A2, A3); L_WRITEA(A0, 0); L_WRITEB(B0, 0); __syncthreads();
        }
        for (int s = 0; s < 32; s += 4) {
            L_LOAD2(s + 3, B3); L_WRITEB(B1, 1); __syncthreads();
            L_LOAD2(s + 4, B0); L_WRITEB(B2, 0); __syncthreads();
            L_LOAD2(s + 5, B1); L_WRITEB(B3, 1); __syncthreads();
            L_LOAD2(s + 6, B2); L_WRITEB(B0, 0); __syncthreads();
        }
#undef L_LOADB1
#undef L_LOADA2
#undef L_LOAD2
#undef L_WRITEB
#undef L_WRITEA
    } else {
        const int wr = wave >> 1, wc = wave & 1;
        int rowm[4], ard[4], brd[8];
#pragma unroll
        for (int m = 0; m < 4; ++m) { rowm[m] = 64 * wr + 16 * m + fr; ard[m] = fq * 2048 + ((rowm[m] ^ (fq << 1)) * 16); }
#pragma unroll
        for (int n = 0; n < 8; ++n) { const int rho = 128 * wc + 16 * n + fr; brd[n] = BSTG + fq * 4096 + ((rho ^ ((rho >> 3) & 3)) * 16); }
        bf16* contrib = (bf16*)(ws + WS_CONTRIB);
        const int nt = ntl >= 8 ? 8 : ntl >= 4 ? 4 : ntl >= 2 ? 2 : 1, role = mt & (nt - 1);
        const float* tg = Wg + (size_t)(tid >> 3) * 256 + (tid & 7) * 32;
        const float* tu = Wu + (size_t)(tid >> 3) * 256 + (tid & 7) * 32;
        const float* td = Wd + (size_t)(tid >> 3) * 1024 + (tid & 7) * 32;
#define M_TOUCH(st_) do { const int s0_ = (st_); if (false && s0_ < 96 && (s0_ & (nt - 1)) == role) { const int u_ = s0_ - 64; \
            const float* tp_ = (s0_ < 32) ? tg + (size_t)(32 * s0_) * 256 : (s0_ < 64) ? tu + (size_t)(32 * (s0_ - 32)) * 256 : td + (size_t)(32 * (u_ & 7)) * 1024 + 256 * (u_ >> 3); \
            asm volatile("global_load_dword %0, %1, off" : "+v"(junk) : "v"(tp_) : "memory"); } } while (0)
        f32x4 acc[4][8];
#define M_COMPUTE(abase_, buf_) do { \
            _Pragma("unroll") for (int nh = 0; nh < 2; ++nh) { bf16x8 af_[4], bf_[4]; \
                _Pragma("unroll") for (int m = 0; m < 4; ++m) af_[m] = *(LAS const bf16x8*)(lds + (abase_) + ard[m]); \
                _Pragma("unroll") for (int n = 0; n < 4; ++n) bf_[n] = *(LAS const bf16x8*)(lds + (buf_) * 16384 + brd[4 * nh + n]); \
                _Pragma("unroll") for (int m = 0; m < 4; ++m) _Pragma("unroll") for (int n = 0; n < 4; ++n) acc[m][4 * nh + n] = mfma16(bf_[n], af_[m], acc[m][4 * nh + n]); } } while (0)
#define M_ZERO() do { _Pragma("unroll") for (int m = 0; m < 4; ++m) _Pragma("unroll") for (int n = 0; n < 8; ++n) acc[m][n] = (f32x4){0.f, 0.f, 0.f, 0.f}; } while (0)
        for (int st = 0; st < TD; ++st) M_TOUCH(st);
        __syncthreads();
        for (int s = 0; s < 64; s += 4) {
            if ((s & 31) == 0) M_ZERO();
            M_TOUCH(s + TD); M_COMPUTE(0, 0); __syncthreads();
            M_TOUCH(s + 1 + TD); M_COMPUTE(8192, 1); __syncthreads();
            M_TOUCH(s + 2 + TD); M_COMPUTE(0, 0); __syncthreads();
            M_TOUCH(s + 3 + TD); M_COMPUTE(8192, 1);
            if (s == 28) {
#pragma unroll
                for (int m = 0; m < 4; ++m)
#pragma unroll
                    for (int n = 0; n < 8; ++n) {
                        const f32x4 gv = acc[m][n];
                        u32x2 w; w.x = cvtpk(silu_f(gv[0]), silu_f(gv[1])); w.y = cvtpk(silu_f(gv[2]), silu_f(gv[3]));
                        const int kc = 16 * wc + 2 * n + (fq >> 1);
                        *(LAS u32x2*)(lds + ACT + kc * 2048 + ((rowm[m] ^ ((kc & 3) << 1)) * 16) + (fq & 1) * 8) = w;
                    }
            } else if (s == 60) {
#pragma unroll
                for (int m = 0; m < 4; ++m)
#pragma unroll
                    for (int n = 0; n < 8; ++n) {
                        const f32x4 uv = acc[m][n];
                        const int kc = 16 * wc + 2 * n + (fq >> 1);
                        LAS u32x2* ap = (LAS u32x2*)(lds + ACT + kc * 2048 + ((rowm[m] ^ ((kc & 3) << 1)) * 16) + (fq & 1) * 8);
                        const u32x2 g = *ap;
                        u32x2 w; w.x = cvtpk(bflo(g.x) * uv[0], bfhi(g.x) * uv[1]); w.y = cvtpk(bflo(g.y) * uv[2], bfhi(g.y) * uv[3]);
                        *ap = w;
                    }
            }
            __syncthreads();
        }
        for (int s = 0; s < 32; s += 4) {
            if ((s & 7) == 0) M_ZERO();
            M_TOUCH(64 + s + TD); M_COMPUTE(ACT + (s & 7) * 8192, 0); __syncthreads();
            M_TOUCH(64 + s + 1 + TD); M_COMPUTE(ACT + ((s + 1) & 7) * 8192, 1); __syncthreads();
            M_TOUCH(64 + s + 2 + TD); M_COMPUTE(ACT + ((s + 2) & 7) * 8192, 0); __syncthreads();
            M_TOUCH(64 + s + 3 + TD); M_COMPUTE(ACT + ((s + 3) & 7) * 8192, 1);
            if ((s & 7) == 4) {
                const int q = s >> 3;
#pragma unroll
                for (int m = 0; m < 4; ++m) {
                    const int slot = ((LAS const int*)(lds + SLOTS))[rowm[m]]; const float gw = ((LAS const float*)(lds + GWO))[rowm[m]];
                    if (slot >= 0) {
                        bf16* cp = contrib + (size_t)slot * D + q * 256 + 128 * wc + 4 * fq;
#pragma unroll
                        for (int n = 0; n < 8; ++n) { const f32x4 v = acc[m][n] * gw; u32x2 w; w.x = cvtpk(v[0], v[1]); w.y = cvtpk(v[2], v[3]); *(u32x2*)(cp + 16 * n) = w; }
                    }
                }
            }
            __syncthreads();
        }
#undef M_TOUCH
#undef M_COMPUTE
#undef M_ZERO
    }
}

#ifndef MOE_TD
#define MOE_TD 8
#endif
__device__ __forceinline__ void phase_moe(const Args& a, ldsp lds, int G, int vcu) {
    const int tid = threadIdx.x;
    const unsigned* cnt = (const unsigned*)(a.ws + WS_CTL) + CW_CNT;
    LAS int* pre = (LAS int*)(lds + MISC_OFF + 512);
    if (tid == 0) { int s = 0; for (int e = 0; e < NEXP; ++e) { pre[e] = s; s += (int)((cnt[32 * e] + 127u) >> 7); } pre[NEXP] = s; }
    __syncthreads();
    const int total = pre[NEXP], ntiles = total + T / 128;
    unsigned junk = 0;
    for (int j = vcu; j < ntiles; j += G) {
        int e, mt, nrows, ntl;
        if (j < total) {
            int lo = 0, hi = NEXP;
            while (hi - lo > 1) { const int mid = (lo + hi) >> 1; if (pre[mid] <= j) lo = mid; else hi = mid; }
            e = lo; mt = j - pre[e]; const int c = (int)cnt[32 * e] - mt * 128; nrows = c < 128 ? c : 128; ntl = pre[e + 1] - pre[e];
        } else { e = NEXP; mt = j - total; nrows = 128; ntl = 8; }
        moe_tile_ws<MOE_TD>(a, lds, e, mt, nrows, ntl, junk);
    }
    asm volatile("s_waitcnt vmcnt(0)" : "+v"(junk) :: "memory");
}

__device__ __forceinline__ void phase_combine(const Args& a, int G) {
    const int tid = threadIdx.x, lane = tid & 63, wave = __builtin_amdgcn_readfirstlane(tid >> 6), blk = blockIdx.x;
    unsigned char* ws = a.ws;
    const bf16* X1 = (const bf16*)(ws + WS_X1); const bf16* contrib = (const bf16*)(ws + WS_CONTRIB); const float* fg = a.in[I_FG];
    for (int t = blk * NWAVES + wave; t < T; t += G * NWAVES) {
        const float* g2 = (const float*)(ws + WS_ADAF) + (t >> 13) * 6144 + 5 * 1024;
        f32x4 xv[2][2]; float ss = 0.f;
#pragma unroll
        for (int j = 0; j < 2; ++j) {
            const int c = 8 * lane + 512 * j;
            float sm[8] = {0.f, 0.f, 0.f, 0.f, 0.f, 0.f, 0.f, 0.f};
#pragma unroll
            for (int k = 0; k < NSLOT; ++k) {
                const u32x4 w = *(const u32x4*)(contrib + ((size_t)t * NSLOT + k) * D + c);
                sm[0] += bflo(w.x); sm[1] += bfhi(w.x); sm[2] += bflo(w.y); sm[3] += bfhi(w.y); sm[4] += bflo(w.z); sm[5] += bfhi(w.z); sm[6] += bflo(w.w); sm[7] += bfhi(w.w);
            }
            const u32x4 xw = *(const u32x4*)(X1 + (size_t)t * D + c);
#pragma unroll
            for (int h = 0; h < 2; ++h) {
                const f32x4 x1 = h == 0 ? (f32x4){bflo(xw.x), bfhi(xw.x), bflo(xw.y), bfhi(xw.y)} : (f32x4){bflo(xw.z), bfhi(xw.z), bflo(xw.w), bfhi(xw.w)};
                const f32x4 gg = *(const f32x4*)(g2 + c + 4 * h);
                const f32x4 mv = {sm[4 * h], sm[4 * h + 1], sm[4 * h + 2], sm[4 * h + 3]};
                const f32x4 v = x1 + gg * mv; xv[j][h] = v; ss += (v[0] * v[0] + v[1] * v[1]) + (v[2] * v[2] + v[3] * v[3]);
            }
        }
        const float r = rsqrtf(wave_sum(ss) * (1.f / D) + 1e-6f);
#pragma unroll
        for (int j = 0; j < 2; ++j)
#pragma unroll
            for (int h = 0; h < 2; ++h) { const int c = 8 * lane + 512 * j + 4 * h; *(f32x4*)(a.out + (size_t)t * D + c) = (xv[j][h] * r) * *(const f32x4*)(fg + c); }
    }
}

constexpr int NPH = 9;
#ifndef N_LAUNCHES
#define N_LAUNCHES 1
#endif
__global__ void __launch_bounds__(NWAVES * 64, 2) mega(Args a) {
    extern __shared__ __attribute__((aligned(16))) unsigned char lds_raw[];
    ldsp lds = (ldsp)lds_raw;
    const int tid = threadIdx.x, G = gridDim.x, bx = blockIdx.x;
    int vcu = (G % 8 == 0) ? (bx % 8) * (G / 8) + bx / 8 : bx;
    unsigned char* ws = a.ws;
    for (int u = tid; u < (LDS_BYTES - MISC_OFF) / 4; u += NWAVES * 64) ((LAS unsigned*)(lds + MISC_OFF))[u] = 0u;
    __syncthreads();
    volatile LAS unsigned* MISC = (volatile LAS unsigned*)(lds + MISC_OFF);
    XcdBarrier bar; bar.bar = (unsigned*)(ws + WS_CTL) + CW_BAR; bar.x = 0; bar.st = nullptr;
    if (N_LAUNCHES == 1) {
        bar = xcd_barrier_post((unsigned*)(ws + WS_CTL) + CW_BAR, MISC + 8);
        if (tid == 0) MISC[16] = atomicAdd((unsigned*)(ws + WS_CTL) + CW_XRANK + 64 * bar.x, 1u);
    }
    const int lo = a.ph_lo, hi = a.ph_hi;
#ifndef PH_MASK
#define PH_MASK 0x1ff
#endif
#define IN(k) (((PH_MASK >> (k)) & 1) && lo <= (k) && (k) < hi)
#define SEAM(k) do { if (IN(k) && IN((k) + 1)) xcd_barrier(bar); } while (0)
#ifndef PH_DUP
#define PH_DUP -1
#endif
#define REP(k) for (int rep_ = 0; rep_ < ((PH_DUP == (k)) ? 2 : 1); ++rep_)
    if (IN(0)) REP(0) { phase_prep(a, lds, G); } SEAM(0);
    if (N_LAUNCHES == 1 && IN(0) && IN(1)) {
        unsigned basex = 0;
        for (unsigned j = 0; j < bar.x; ++j) basex += xb_ld(&bar.bar[XB_XCNT(j)]);
        vcu = (int)(basex + MISC[16]);
    }
    if (IN(1)) REP(1) { phase_hnorm(a, lds, G); } SEAM(1);
    if (IN(2)) REP(2) {
        pg8::Gemm g{(const pg8::bf16_t*)(ws + WS_H), (const pg8::bf16_t*)(ws + WS_WINT), MH, DIN, D};
        WinOrder S; S.init(G, bx);
        EpiWin E{(bf16*)(ws + WS_Z), (bf16*)(ws + WS_KVC), (const float*)(ws + WS_ROPE)};
        pg8::gemm_phase<EpiWin, WinOrder, true, true>(lds, g, S, E);
    } SEAM(2);
    if (IN(3)) REP(3) { phase_mixers(a, lds, G, vcu); } SEAM(3);
    if (IN(4)) REP(4) {
        { pg8::Gemm g{(const pg8::bf16_t*)(ws + WS_A), (const pg8::bf16_t*)(ws + WS_WAT), T, D, 512};
          pg8::StaticOrder S; S.init(T, D, G, bx);
          EpiMergeA E{(const bf16*)(ws + WS_Z), (bf16*)(ws + WS_Y)};
          pg8::gemm_phase<EpiMergeA, pg8::StaticOrder, true, true>(lds, g, S, E); }
        { pg8::Gemm g{(const pg8::bf16_t*)(ws + WS_O), (const pg8::bf16_t*)(ws + WS_WBT), T, D, 512};
          pg8::StaticOrder S; S.init(T, D, G, bx);
          EpiMergeB E{(const bf16*)(ws + WS_Z), (bf16*)(ws + WS_Y)};
          pg8::gemm_phase<EpiMergeB, pg8::StaticOrder, true, true>(lds, g, S, E); }
    } SEAM(4);
    if (IN(5)) REP(5) {
        pg8::Gemm g{(const pg8::bf16_t*)(ws + WS_Y), (const pg8::bf16_t*)(ws + WS_WOT), T, D, D};
        pg8::StaticOrder S; S.init(T, D, G, bx);
        EpiWo E{a.in[I_X], (const float*)(ws + WS_ADAF), (bf16*)(ws + WS_X1)};
        pg8::gemm_phase<EpiWo, pg8::StaticOrder, true, true>(lds, g, S, E);
    } SEAM(5);
    if (IN(6)) { for (int it = vcu; it < T / 64; it += G) router_item(a, lds, it); } SEAM(6);
    if (IN(7)) REP(7) { phase_moe(a, lds, G, vcu); } SEAM(7);
    if (IN(8)) REP(8) { phase_combine(a, G); }
#undef IN
#undef SEAM
}

extern "C" void kernel_launch(void* const* d_in, const int* in_sizes, int n_in, void* d_out, int out_size, void* d_ws, size_t ws_size, hipStream_t stream) {
    static int grid = 0;
    if (grid == 0) {
        if (n_in != 26 || out_size != T * D || ws_size < WS_END) { fprintf(stderr, "kernel_launch: unexpected shapes (n_in %d, out %d, ws %zu)\n", n_in, out_size, ws_size); grid = -1; return; }
        int dev = 0, cus = 0, per_cu = 0;
        (void)hipGetDevice(&dev); (void)hipDeviceGetAttribute(&cus, hipDeviceAttributeMultiprocessorCount, dev);
        (void)hipFuncSetAttribute((const void*)mega, hipFuncAttributeMaxDynamicSharedMemorySize, LDS_BYTES);
        (void)hipOccupancyMaxActiveBlocksPerMultiprocessor(&per_cu, (const void*)mega, NWAVES * 64, LDS_BYTES);
        (void)hipGetLastError();
        if (per_cu < 1) { fprintf(stderr, "kernel_launch: occupancy query says %d blocks per CU\n", per_cu); per_cu = 1; }
        grid = cus;
    }
    if (grid < 0) return;
    (void)hipMemsetAsync((char*)d_ws + WS_CTL, 0, CTL_ZERO_BYTES, stream);
    Args a{};
    for (int i = 0; i < 26; ++i) a.in[i] = (const float*)d_in[i];
    a.out = (float*)d_out; a.ws = (unsigned char*)d_ws;
    if (N_LAUNCHES == 1) {
        a.ph_lo = 0; a.ph_hi = NPH;
        void* kargs[] = {&a};
        hipError_t e = hipLaunchCooperativeKernel((const void*)mega, dim3(grid), dim3(NWAVES * 64), kargs, LDS_BYTES, stream);
        if (e != hipSuccess) fprintf(stderr, "kernel_launch: cooperative launch failed: %s (grid %d)\n", hipGetErrorString(e), grid);
    } else {
#ifndef HOST_DUP
#define HOST_DUP -1
#endif
        for (int li = 0; li < NPH; ++li) {
            a.ph_lo = li; a.ph_hi = li + 1;
            hipLaunchKernelGGL(mega, dim3(grid), dim3(NWAVES * 64), LDS_BYTES, stream, a);
            if (li == HOST_DUP) {
                if (li == 6) (void)hipMemsetAsync((char*)d_ws + WS_CTL, 0, CTL_ZERO_BYTES, stream);
                hipLaunchKernelGGL(mega, dim3(grid), dim3(NWAVES * 64), LDS_BYTES, stream, a);
            }
        }
    }
}
```

```cpp
#include <hip/hip_runtime.h>
#include <cstdio>
#include <cstdint>
#include <type_traits>
namespace pg8 {
#define PG8_LAS __attribute__((address_space(3)))
typedef unsigned short bf16_t;
typedef short bf16x8 __attribute__((ext_vector_type(8)));
typedef float f32x4 __attribute__((ext_vector_type(4)));
typedef unsigned u32x4 __attribute__((ext_vector_type(4)));
constexpr int BM = 256, BK = 64, HALF = 128, HTB = HALF * BK * 2  , STAGE_BYTES = 8 * HTB, NXCD = 8, WGM = 8;

__host__ __device__ __forceinline__ int lds_byte(int r, int c) { const int st = (r >> 4) * 2 + (c >> 5), rr = r & 15, cc = c & 31, ob = rr * 64 + cc * 2; return st * 1024 + (ob ^ (((ob >> 9) & 1) << 5)); }
__host__ __device__ __forceinline__ void stage_rc(int b, int& R, int& C) { const int st = b / 1024, sb = b % 1024, swz = sb ^ (((sb >> 9) & 1) << 5); R = (st >> 1) * 16 + swz / 64; C = (st & 1) * 32 + (swz % 64) / 2; }
__host__ __device__ __forceinline__ int perm32(int rho) { const int n = rho >> 4, i = rho & 15; return 8 * (i >> 2) + 4 * n + (i & 3); }

struct Unit { int pm, pn; };
struct Gemm { const bf16_t* A; const bf16_t* Bt; int M, N, K; };

struct StaticOrder {
    int nM, nN, nwg, G, c;
    __host__ __device__ void init(int M, int N, int G_, int c_) { nM = M / BM; nN = N / BM; nwg = nM * nN; G = G_; c = c_; }
    __host__ __device__ bool next(int i, Unit& u) const {
        const long L = (long)i * G + c; if (L >= nwg) return false;
        int wgid = (int)L; { const int q = nwg / NXCD, r = nwg % NXCD, xcd = wgid % NXCD, off = wgid / NXCD; wgid = (xcd < r ? xcd * (q + 1) : r * (q + 1) + (xcd - r) * q) + off; }
        const int nig = WGM * nN, gid = wgid / nig, fm = gid * WGM, gsz = (nM - fm) < WGM ? (nM - fm) : WGM;
        u.pm = fm + ((wgid % nig) % gsz); u.pn = (wgid % nig) / gsz; return true;
    }
    __device__ __forceinline__ void a_ready(const Unit&) const {}
    __device__ __forceinline__ void done(const Unit&) const {}
};

__device__ __forceinline__ unsigned cvt_pk_bf16(float lo, float hi) { unsigned r; asm volatile("v_cvt_pk_bf16_f32 %0, %1, %2" : "=v"(r) : "v"(lo), "v"(hi)); return r; }
template <class Epi, class Sched, bool ALIGN_EPI = false, bool SP2 = false>
__device__ __forceinline__ void gemm_phase(PG8_LAS unsigned char* lds, const Gemm g, const Sched& S, const Epi& E) {
    const int tid = threadIdx.x, wid = __builtin_amdgcn_readfirstlane(tid >> 6), lane = tid & 63, wr = wid >> 2, wc = wid & 3, fr = lane & 15, fq = lane >> 4;
    const int K = g.K, nt = K / BK;
    unsigned voffA[2], voffB[2];
#pragma unroll
    for (int i = 0; i < 2; ++i) { int R, C; stage_rc(tid * 16 + i * 8192, R, C); const int Rb = Epi::PERM ? ((R & ~31) + perm32(R & 31)) : R;
        voffA[i] = (unsigned)(R * K + C) * 2u; voffB[i] = (unsigned)(Rb * K + C) * 2u; }
    const size_t kstep = (size_t)(BK * 2);
    const size_t hstep = (size_t)HALF * K * 2;
    const size_t tstep = 2 * hstep;
    const unsigned ldsw = (unsigned)wid * 1024u;
    const int aoff = lds_byte(wr * 64 + fr, fq * 8), boff = lds_byte(wc * 32 + fr, fq * 8);
#define PG8_SA(b, h) (((b) * 2 + (h)) * HTB)
#define PG8_SB(b, h) ((4 + (b) * 2 + (h)) * HTB)
#define PG8_STAGE(bufoff, gbase, voff) do { _Pragma("unroll") for (int _i = 0; _i < 2; ++_i) \
        __builtin_amdgcn_global_load_lds((const unsigned*)((const char*)(gbase) + (voff)[_i]), (PG8_LAS unsigned*)(lds + (bufoff) + ldsw + _i * 8192), 16, 0, 0); } while (0)
#define PG8_LDA(dst, b, h) do { _Pragma("unroll") for (int m = 0; m < 4; ++m) _Pragma("unroll") for (int k = 0; k < 2; ++k) dst[m][k] = *(const PG8_LAS bf16x8*)(lds + PG8_SA(b, h) + aoff + m * 2048 + k * 1024); } while (0)
#define PG8_LDB(dst, b, h) do { _Pragma("unroll") for (int n = 0; n < 2; ++n) _Pragma("unroll") for (int k = 0; k < 2; ++k) dst[n][k] = *(const PG8_LAS bf16x8*)(lds + PG8_SB(b, h) + boff + n * 2048 + k * 1024); } while (0)
#define PG8_MMA(ai, bj, At, Bt) do { __builtin_amdgcn_s_setprio(1); _Pragma("unroll") for (int m = 0; m < 4; ++m) _Pragma("unroll") for (int n = 0; n < 2; ++n) _Pragma("unroll") for (int k = 0; k < 2; ++k) \
        acc[ai][bj][m][n] = __builtin_amdgcn_mfma_f32_16x16x32_bf16(Bt[n][k], At[m][k], acc[ai][bj][m][n], 0, 0, 0); __builtin_amdgcn_s_setprio(0); } while (0)
#define PG8_WAIT_V(n) asm volatile("s_waitcnt vmcnt(" #n ")" ::: "memory")
#define PG8_WAIT_L(n) asm volatile("s_waitcnt lgkmcnt(" #n ")" ::: "memory")
#define PG8_BAR __builtin_amdgcn_s_barrier()
#define PG8_SCHED __builtin_amdgcn_sched_barrier(0)
    Unit cur, nxt; int ui = 0;
    if (!S.next(0, cur)) return;
    f32x4 acc[2][2][4][2];
#pragma unroll
    for (int a = 0; a < 2; ++a)
#pragma unroll
        for (int b = 0; b < 2; ++b)
#pragma unroll
            for (int m = 0; m < 4; ++m)
#pragma unroll
                for (int n = 0; n < 2; ++n) acc[a][b][m][n] = (f32x4){0.f, 0.f, 0.f, 0.f};
    bf16x8 At[4][2], B0[2][2], B1[2][2];
    const char* cA = (const char*)g.A + (size_t)cur.pm * tstep; const char* cB = (const char*)g.Bt + (size_t)cur.pn * tstep;
    S.a_ready(cur);
    if constexpr (SP2) {
        PG8_STAGE(PG8_SB(0, 0), cB, voffB); PG8_STAGE(PG8_SB(0, 1), cB + hstep, voffB); PG8_STAGE(PG8_SA(0, 0), cA, voffA); PG8_STAGE(PG8_SA(0, 1), cA + hstep, voffA);
        if (wr == 1) PG8_BAR;
        PG8_WAIT_V(2); PG8_BAR;
        PG8_STAGE(PG8_SB(1, 0), cB + kstep, voffB); PG8_STAGE(PG8_SA(1, 0), cA + kstep, voffA); PG8_STAGE(PG8_SB(1, 1), cB + hstep + kstep, voffB);
        PG8_WAIT_V(6); PG8_BAR;
    } else {
        PG8_STAGE(PG8_SB(0, 0), cB, voffB); PG8_STAGE(PG8_SA(0, 0), cA, voffA); PG8_STAGE(PG8_SB(0, 1), cB + hstep, voffB); PG8_STAGE(PG8_SA(0, 1), cA + hstep, voffA);
        if (wr == 1) PG8_BAR;
        PG8_WAIT_V(4); PG8_BAR;
        PG8_STAGE(PG8_SB(1, 0), cB + kstep, voffB); PG8_STAGE(PG8_SA(1, 0), cA + kstep, voffA); PG8_STAGE(PG8_SB(1, 1), cB + hstep + kstep, voffB);
        PG8_WAIT_V(6); PG8_BAR;
    }
    for (;;) {
        const bool has_next = S.next(ui + 1, nxt);
        const char* nA = has_next ? (const char*)g.A + (size_t)nxt.pm * tstep : cA; const char* nB = has_next ? (const char*)g.Bt + (size_t)nxt.pn * tstep : cB;
        for (int t = 0; t < nt; t += 2) {
            const bool last = (t == nt - 2);
            const char* a1 = cA + (size_t)(t + 1) * kstep;
            const char* a2 = last ? nA : cA + (size_t)(t + 2) * kstep; const char* b2 = last ? nB : cB + (size_t)(t + 2) * kstep;
            const char* a3 = a2 + kstep; const char* b3 = b2 + kstep;
            if (last && has_next) S.a_ready(nxt);
            if constexpr (SP2) {
            PG8_LDB(B0, 0, 0); PG8_LDB(B1, 0, 1); PG8_SCHED; PG8_LDA(At, 0, 0); PG8_STAGE(PG8_SA(1, 1), a1 + hstep, voffA);
            PG8_WAIT_V(8); PG8_WAIT_L(0); PG8_BAR; PG8_MMA(0, 0, At, B0); PG8_MMA(0, 1, At, B1); PG8_BAR; PG8_SCHED;
            PG8_LDA(At, 0, 1); PG8_STAGE(PG8_SB(0, 0), b2, voffB); PG8_STAGE(PG8_SB(0, 1), b2 + hstep, voffB); PG8_STAGE(PG8_SA(0, 0), a2, voffA);
            PG8_WAIT_V(8); PG8_WAIT_L(0); PG8_BAR; PG8_MMA(1, 0, At, B0); PG8_MMA(1, 1, At, B1); PG8_BAR; PG8_SCHED;
            PG8_LDB(B0, 1, 0); PG8_LDB(B1, 1, 1); PG8_SCHED; PG8_LDA(At, 1, 0); PG8_STAGE(PG8_SA(0, 1), a2 + hstep, voffA);
            PG8_WAIT_V(8); PG8_WAIT_L(0); PG8_BAR; PG8_MMA(0, 0, At, B0); PG8_MMA(0, 1, At, B1); PG8_BAR; PG8_SCHED;
            PG8_LDA(At, 1, 1); PG8_STAGE(PG8_SB(1, 0), b3, voffB); PG8_STAGE(PG8_SB(1, 1), b3 + hstep, voffB); PG8_STAGE(PG8_SA(1, 0), a3, voffA);
            PG8_WAIT_V(8); PG8_WAIT_L(0); PG8_BAR; PG8_MMA(1, 0, At, B0); PG8_MMA(1, 1, At, B1); PG8_BAR; PG8_SCHED;
            } else {
            PG8_LDB(B0, 0, 0); PG8_SCHED; PG8_LDA(At, 0, 0); PG8_STAGE(PG8_SA(1, 1), a1 + hstep, voffA);
            PG8_WAIT_L(8); PG8_BAR; PG8_WAIT_L(0); PG8_MMA(0, 0, At, B0); PG8_BAR; PG8_SCHED;
            PG8_LDB(B1, 0, 1); PG8_STAGE(PG8_SB(0, 0), b2, voffB);
            PG8_BAR; PG8_WAIT_L(0); PG8_MMA(0, 1, At, B1); PG8_BAR;
            PG8_LDA(At, 0, 1); PG8_STAGE(PG8_SA(0, 0), a2, voffA);
            PG8_BAR; PG8_WAIT_L(0); PG8_MMA(1, 0, At, B0); PG8_BAR; PG8_SCHED;
            PG8_STAGE(PG8_SB(0, 1), b2 + hstep, voffB);
            PG8_WAIT_V(6); PG8_BAR; PG8_MMA(1, 1, At, B1); PG8_BAR;
            PG8_LDB(B0, 1, 0); PG8_SCHED; PG8_LDA(At, 1, 0); PG8_STAGE(PG8_SA(0, 1), a2 + hstep, voffA);
            PG8_WAIT_L(8); PG8_BAR; PG8_WAIT_L(0); PG8_MMA(0, 0, At, B0); PG8_BAR; PG8_SCHED;
            PG8_LDB(B1, 1, 1); PG8_STAGE(PG8_SB(1, 0), b3, voffB);
            PG8_BAR; PG8_WAIT_L(0); PG8_MMA(0, 1, At, B1); PG8_BAR;
            PG8_LDA(At, 1, 1); PG8_STAGE(PG8_SA(1, 0), a3, voffA);
            PG8_BAR; PG8_WAIT_L(0); PG8_MMA(1, 0, At, B0); PG8_BAR; PG8_SCHED;
            PG8_STAGE(PG8_SB(1, 1), b3 + hstep, voffB);
            PG8_WAIT_V(6); PG8_BAR; PG8_MMA(1, 1, At, B1); PG8_BAR;
            }
        }
        if constexpr (ALIGN_EPI) { if (wr == 0) PG8_BAR; }
        if constexpr (!Epi::AFTER_DRAIN) { E(acc, cur, wr, wc, fr, fq); S.done(cur); }
        if (!has_next) break;
#pragma unroll
        for (int a = 0; a < 2; ++a)
#pragma unroll
            for (int b = 0; b < 2; ++b)
#pragma unroll
                for (int m = 0; m < 4; ++m)
#pragma unroll
                    for (int n = 0; n < 2; ++n) acc[a][b][m][n] = (f32x4){0.f, 0.f, 0.f, 0.f};
        cur = nxt; cA = nA; cB = nB; ++ui;
        if constexpr (ALIGN_EPI) { if (wr == 1) PG8_BAR; }
    }
    PG8_WAIT_V(0);
    if constexpr (!ALIGN_EPI) { if (wr == 0) PG8_BAR; }
    PG8_BAR;
    if constexpr (Epi::AFTER_DRAIN) { E.fused(acc, cur, wr, wc, fr, fq, lds, wid, lane); S.done(cur); }
#undef PG8_SA
#undef PG8_SB
#undef PG8_STAGE
#undef PG8_LDA
#undef PG8_LDB
#undef PG8_MMA
#undef PG8_WAIT_V
#undef PG8_WAIT_L
#undef PG8_BAR
#undef PG8_SCHED
}
}
#define GAS __attribute__((address_space(1)))
#define LAS __attribute__((address_space(3)))
typedef unsigned short bf16;
typedef unsigned v4u __attribute__((ext_vector_type(4)));
typedef float f32x4 __attribute__((ext_vector_type(4)));
typedef short bf16x8 __attribute__((ext_vector_type(8)));
typedef GAS unsigned gu32;
typedef GAS unsigned long long gu64;
#define RLX_AGENT __ATOMIC_RELAXED, __HIP_MEMORY_SCOPE_AGENT
#define LDS_WAIT() asm volatile("s_waitcnt lgkmcnt(0)" ::: "memory")
#define VM_WAIT() asm volatile("s_waitcnt vmcnt(0)" ::: "memory")
__device__ __forceinline__ unsigned long long rt() { return __builtin_amdgcn_s_memrealtime(); }
__device__ __forceinline__ unsigned f2bf(float f) { unsigned u = __builtin_bit_cast(unsigned, f); return (u + 0x7fffu + ((u >> 16) & 1u)) >> 16; }
__device__ __forceinline__ unsigned pk2(float lo, float hi) { return f2bf(lo) | (f2bf(hi) << 16); }

#define XB_TMO      128
#define XB_XCNT(j)  (256  + 64 * (j))
#define XB_XSUB(j)  (1280 + 64 * (j))
#define XB_XGEN(j)  (2304 + 64 * (j))
#define XB_TOP      3328
#define XB_TOPGEN   3392
#define XCD_BAR_WORDS 3456
#define XB_SPIN_CAP (1u << 18)

__device__ __forceinline__ unsigned xb_ld(unsigned* p)              { return __hip_atomic_load(p, __ATOMIC_RELAXED, __HIP_MEMORY_SCOPE_AGENT); }
__device__ __forceinline__ unsigned xb_add(unsigned* p, unsigned v) { return __hip_atomic_fetch_add(p, v, __ATOMIC_RELAXED, __HIP_MEMORY_SCOPE_AGENT); }
__device__ __forceinline__ unsigned xb_xcc_id() { return (unsigned)__builtin_amdgcn_s_getreg((3 << 11) | 20) & 0xFu; }
#define XB_SPIN(cond, bar) do { unsigned _sp = 0; while (cond) { __builtin_amdgcn_s_sleep(1); \
    if ((++_sp & 255u) == 0u) { if (xb_ld(&(bar)[XB_TMO])) break; if (_sp > XB_SPIN_CAP) { atomicAdd(&(bar)[XB_TMO], 1u); break; } } } } while (0)

struct XcdBarrier {
    unsigned* bar; unsigned x;
    volatile LAS unsigned* st;
};

__device__ __forceinline__ XcdBarrier xcd_barrier_post(unsigned* bar, volatile LAS unsigned* st) {
    XcdBarrier b; b.bar = bar; b.x = xb_xcc_id(); b.st = st;
    if (threadIdx.x == 0) (void)xb_add(&bar[XB_XCNT(b.x)], 1u);
    return b;
}
__device__ __forceinline__ void xcd_barrier_complete(unsigned* bar, unsigned x, unsigned& nloc, unsigned& nx) {
    const unsigned G = gridDim.x * gridDim.y * gridDim.z;
    unsigned sum, cnt, mine, sp = 0u;
    for (;;) {
        sum = 0u; cnt = 0u; mine = 0u;
#pragma unroll
        for (unsigned j = 0; j < 16; ++j) { const unsigned c = xb_ld(&bar[XB_XCNT(j)]); sum += c; cnt += (c > 0u) ? 1u : 0u; mine = (j == x) ? c : mine; }
        if (sum == G) break;
        __builtin_amdgcn_s_sleep(1);
        if ((++sp & 255u) == 0u) { if (xb_ld(&bar[XB_TMO])) break; if (sp > XB_SPIN_CAP) { atomicAdd(&bar[XB_TMO], 1u); break; } }
    }
    nloc = mine > 0u ? mine : 1u; nx = cnt > 0u ? cnt : 1u;
}

__device__ __forceinline__ void xcd_barrier(const XcdBarrier& b) {
    asm volatile("s_waitcnt vmcnt(0)" ::: "memory");
    __syncthreads();
    if (threadIdx.x == 0) {
        unsigned* bar = b.bar;
        __builtin_amdgcn_s_waitcnt(0);
        unsigned nloc = b.st[0], nx = b.st[1];
        if (nloc == 0u) { xcd_barrier_complete(bar, b.x, nloc, nx); b.st[0] = nloc; b.st[1] = nx; }
        const unsigned old = xb_add(&bar[XB_XSUB(b.x)], 1u);
        const unsigned gen = old / nloc;
        if (old + 1u == (gen + 1u) * nloc) {
            __builtin_amdgcn_fence(__ATOMIC_RELEASE, "agent");
            asm volatile("s_waitcnt vmcnt(0)" ::: "memory");
            const unsigned og = xb_add(&bar[XB_TOP], 1u);
            const unsigned tg = og / nx;
            if (og + 1u == (tg + 1u) * nx) xb_add(&bar[XB_TOPGEN], 1u);
            else XB_SPIN(xb_ld(&bar[XB_TOPGEN]) == tg, bar);
            __builtin_amdgcn_fence(__ATOMIC_ACQUIRE, "agent");
            xb_add(&bar[XB_XGEN(b.x)], 1u);
            asm volatile("s_waitcnt vmcnt(0)" ::: "memory");
        } else {
            XB_SPIN(xb_ld(&bar[XB_XGEN(b.x)]) == gen, bar);
            __builtin_amdgcn_fence(__ATOMIC_ACQUIRE, "agent");
            asm volatile("s_waitcnt vmcnt(0)" ::: "memory");
        }
    }
    __syncthreads();
}

constexpr int T = 16384, D = 1024, SEQ = 8192, NCTX = 256, TCX = 512, DIN = 3840, MH = T + TCX;
constexpr int ZU = 0, ZV = 512, ZQ = 1024, ZK = 1536, ZVA = 1664, ZGA = 1792, ZGB = 2816;
constexpr int NEXP = 256, NSLOT = 9, LISTCAP = 16384;
constexpr float LOG2E = 1.4426950408889634f;
constexpr float QSCALE = 0.125f * LOG2E;
constexpr size_t MiB = 1u << 20;
constexpr size_t WS_CTL = 0, CTL_ZERO_BYTES = 1 * MiB;
constexpr size_t WS_ADAP = 1 * MiB;
constexpr size_t WS_ADAF = 2 * MiB;
constexpr size_t WS_ROPE = 2 * MiB + 128 * 1024;
constexpr size_t WS_WST = 2 * MiB + 256 * 1024;
constexpr size_t WS_RWT = 3 * MiB;
constexpr size_t WS_WINT = 4 * MiB;
constexpr size_t WS_WAT = 12 * MiB, WS_WBT = 13 * MiB, WS_WOT = 14 * MiB;
constexpr size_t WS_KVC = 16 * MiB;
constexpr size_t WS_GATEW = 17 * MiB;
constexpr size_t WS_H = 18 * MiB;
constexpr size_t WS_Z = 52 * MiB;
constexpr size_t WS_A = 172 * MiB, WS_O = 188 * MiB;
constexpr size_t WS_TMP = 204 * MiB;
constexpr size_t WS_Y = 268 * MiB;
constexpr size_t WS_X1 = 300 * MiB;
constexpr size_t WS_H2 = 364 * MiB;
constexpr size_t WS_LIST = 396 * MiB;
constexpr size_t WS_CONTRIB = 414 * MiB;
constexpr size_t WS_END = 704 * MiB;
constexpr int CW_BAR = 4096;
constexpr int CW_CNT = 16384;
constexpr int CW_XRANK = 32768;
constexpr int SCR_BYTES = 148480;
constexpr int MISC_OFF = SCR_BYTES;
constexpr int LDS_BYTES = 152 * 1024;
constexpr int NWAVES = 8;

typedef float f32x2_t __attribute__((ext_vector_type(2)));
typedef __bf16 bf16x2_t __attribute__((ext_vector_type(2)));
typedef float f32x16 __attribute__((ext_vector_type(16)));
typedef short s16x4 __attribute__((ext_vector_type(4)));
typedef short v4i16_t __attribute__((ext_vector_type(4)));
typedef unsigned u32x2 __attribute__((ext_vector_type(2)));
typedef unsigned u32x4 __attribute__((ext_vector_type(4)));
typedef LAS unsigned char* ldsp;

__device__ __forceinline__ unsigned cvtpk(float lo, float hi) { f32x2_t v = {lo, hi}; bf16x2_t b = __builtin_convertvector(v, bf16x2_t); return __builtin_bit_cast(unsigned, b); }
__device__ __forceinline__ float bf2f(unsigned short u) { return __uint_as_float((unsigned)u << 16); }
__device__ __forceinline__ float bflo(unsigned w) { return __uint_as_float(w << 16); }
__device__ __forceinline__ float bfhi(unsigned w) { return __uint_as_float(w & 0xffff0000u); }
__device__ __forceinline__ float wave_sum(float v) {
#pragma unroll
    for (int o = 1; o < 64; o <<= 1) v += __shfl_xor(v, o);
    return v;
}
__device__ __forceinline__ float sigmoid_f(float x) { return __builtin_amdgcn_rcpf(1.f + __builtin_amdgcn_exp2f(-x * LOG2E)); }
__device__ __forceinline__ float silu_f(float x) { return x * sigmoid_f(x); }
__device__ __forceinline__ float gelu_f(float x) { const float u = 0.7978845608028654f * (x + 0.044715f * x * x * x); return x * sigmoid_f(2.f * u); }
__device__ __forceinline__ f32x16 mfma32(bf16x8 a, bf16x8 b, f32x16 c) { return __builtin_amdgcn_mfma_f32_32x32x16_bf16(a, b, c, 0, 0, 0); }
__device__ __forceinline__ f32x4 mfma16(bf16x8 a, bf16x8 b, f32x4 c) { return __builtin_amdgcn_mfma_f32_16x16x32_bf16(a, b, c, 0, 0, 0); }

struct Args { const float* in[26]; float* out; unsigned char* ws; int ph_lo, ph_hi; };
enum { I_X = 0, I_C, I_CTX, I_CCTX, I_ADAW, I_ADAB, I_N1G, I_N2G, I_WIN, I_LNG, I_LNB, I_GWS, I_GBS, I_SINK, I_WA, I_WB, I_WO, I_RW, I_RB, I_EG, I_EU, I_ED, I_SG, I_SU, I_SD, I_FG };

__device__ __forceinline__ void p0_transpose_item(const float* W, int K, int N, bf16* WT, LAS float* scr, int item, int lane) {
    const int nblk = N / 32, kb = item / nblk, nb = item % nblk, k0 = 64 * kb, n0 = 32 * nb;
#pragma unroll 8
    for (int i = 0; i < 32; ++i) { const int kk = 2 * i + (lane >> 5); scr[kk * 33 + (lane & 31)] = W[(size_t)(k0 + kk) * N + n0 + (lane & 31)]; }
    LDS_WAIT(); asm volatile("" ::: "memory");
    const int c = lane & 7;
#pragma unroll
    for (int j = 0; j < 4; ++j) { const int n = (lane >> 3) + 8 * j; const LAS float* s = scr + (8 * c) * 33 + n;
        v4u o; o.x = pk2(s[0 * 33], s[1 * 33]); o.y = pk2(s[2 * 33], s[3 * 33]); o.z = pk2(s[4 * 33], s[5 * 33]); o.w = pk2(s[6 * 33], s[7 * 33]);
        *(GAS v4u*)(WT + (size_t)(n0 + n) * K + k0 + 8 * c) = o; }
    LDS_WAIT(); asm volatile("" ::: "memory");
}

__device__ __forceinline__ void phase_prep(const Args& a, ldsp lds, int G) {
    const int tid = threadIdx.x, lane = tid & 63, wave = __builtin_amdgcn_readfirstlane(tid >> 6), blk = blockIdx.x;
    unsigned char* ws = a.ws;
    if (blk < 192) {
        const int cb = blk % 24, kc = blk / 24, col = cb * 256 + lane * 4, k0 = kc * 128 + wave * 16;
        const float* c = a.in[I_C]; const float* cc = a.in[I_CCTX]; const float* aw = a.in[I_ADAW];
        f32x4 a0 = {0.f, 0.f, 0.f, 0.f}, a1 = a0, a2 = a0;
#pragma unroll 4
        for (int k = 0; k < 16; ++k) {
            const int kk = k0 + k;
            const float s0 = silu_f(c[kk]), s1 = silu_f(c[1024 + kk]), s2 = silu_f(cc[kk]);
            const f32x4 w = *(const f32x4*)(aw + (size_t)kk * 6144 + col);
            a0 += w * s0; a1 += w * s1; a2 += w * s2;
        }
        LAS float* red = (LAS float*)lds;
        *(LAS f32x4*)(red + (wave * 3 + 0) * 256 + lane * 4) = a0;
        *(LAS f32x4*)(red + (wave * 3 + 1) * 256 + lane * 4) = a1;
        *(LAS f32x4*)(red + (wave * 3 + 2) * 256 + lane * 4) = a2;
        __syncthreads();
        float* adap = (float*)(ws + WS_ADAP);
        for (int idx = tid; idx < 768; idx += 512) {
            const int v = idx >> 8, cl = idx & 255; float s = 0.f;
#pragma unroll
            for (int w = 0; w < 8; ++w) s += red[(w * 3 + v) * 256 + cl];
            adap[(size_t)(kc * 3 + v) * 6144 + cb * 256 + cl] = s;
        }
        __syncthreads();
    }
    {
        LAS float* scr = (LAS float*)(lds + wave * 8704);
        const int gw = blk * NWAVES + wave, NGW = G * NWAVES;
        constexpr int I_1 = 16 * 120, I_2 = 8 * 32, I_3 = 8 * 32, I_4 = 16 * 32, I_5 = 16 * 8;
        for (int it = gw; it < I_1 + I_2 + I_3 + I_4 + I_5; it += NGW) {
            int r = it;
            if (r < I_1) { p0_transpose_item(a.in[I_WIN], 1024, 3840, (bf16*)(ws + WS_WINT), scr, r, lane); continue; } r -= I_1;
            if (r < I_2) { p0_transpose_item(a.in[I_WA], 512, 1024, (bf16*)(ws + WS_WAT), scr, r, lane); continue; } r -= I_2;
            if (r < I_3) { p0_transpose_item(a.in[I_WB], 512, 1024, (bf16*)(ws + WS_WBT), scr, r, lane); continue; } r -= I_3;
            if (r < I_4) { p0_transpose_item(a.in[I_WO], 1024, 1024, (bf16*)(ws + WS_WOT), scr, r, lane); continue; } r -= I_4;
            p0_transpose_item(a.in[I_RW], 1024, 256, (bf16*)(ws + WS_RWT), scr, r, lane);
        }
    }
    {
        const int gt = blk * 512 + tid, NT = G * 512;
        const float* gws = a.in[I_GWS]; bf16* wst = (bf16*)(ws + WS_WST);
        for (int i = gt; i < 8192; i += NT) {
            const f32x4 x0 = *(const f32x4*)(gws + i * 8), x1 = *(const f32x4*)(gws + i * 8 + 4);
            v4u o; o.x = cvtpk(x0[0], x0[1]); o.y = cvtpk(x0[2], x0[3]); o.z = cvtpk(x1[0], x1[1]); o.w = cvtpk(x1[2], x1[3]);
            *(v4u*)(wst + i * 8) = o;
        }
        float* rope = (float*)(ws + WS_ROPE);
        for (int i = gt; i < 2048; i += NT) {
            const int pos = i >> 4, f = i & 15;
            const float inv = __builtin_amdgcn_exp2f(-(float)f * (13.287712379549449f / 16.f));
            const float ang = (float)pos * inv;
            double rev = (double)ang * 0.15915494309189535; rev -= floor(rev);
            rope[pos * 32 + f] = __builtin_amdgcn_cosf((float)rev);
            rope[pos * 32 + 16 + f] = __builtin_amdgcn_sinf((float)rev);
        }
    }
}

__device__ __forceinline__ void phase_hnorm(const Args& a, ldsp lds, int G) {
    const int tid = threadIdx.x, lane = tid & 63, wave = __builtin_amdgcn_readfirstlane(tid >> 6), blk = blockIdx.x;
    unsigned char* ws = a.ws;
    const float* adap = (const float*)(ws + WS_ADAP); const float* adab = a.in[I_ADAB];
    LAS float* modv = (LAS float*)lds;
    for (int idx = tid; idx < 3 * 2048; idx += 512) {
        const int v = idx >> 11, j = idx & 2047; float s = adab[j];
#pragma unroll
        for (int kc = 0; kc < 8; ++kc) s += adap[(size_t)(kc * 3 + v) * 6144 + j];
        modv[idx] = (j >= 1024) ? s + 1.f : s;
    }
    { float* adaf = (float*)(ws + WS_ADAF);
      for (int idx = blk * 512 + tid; idx < 3 * 6144; idx += G * 512) {
          const int v = idx / 6144, j = idx % 6144; float s = adab[j];
#pragma unroll
          for (int kc = 0; kc < 8; ++kc) s += adap[(size_t)(kc * 3 + v) * 6144 + j];
          adaf[idx] = s; } }
    __syncthreads();
    const float* g1 = a.in[I_N1G]; bf16* H = (bf16*)(ws + WS_H);
    for (int t = blk * NWAVES + wave; t < MH; t += G * NWAVES) {
        const float* xr = (t < T) ? a.in[I_X] + (size_t)t * D : a.in[I_CTX] + (size_t)(t - T) * D;
        const int v = (t < T) ? (t >> 13) : 2;
        f32x4 x[4]; float ss = 0.f;
#pragma unroll
        for (int j = 0; j < 4; ++j) { x[j] = *(const f32x4*)(xr + 4 * lane + 256 * j); ss += (x[j][0] * x[j][0] + x[j][1] * x[j][1]) + (x[j][2] * x[j][2] + x[j][3] * x[j][3]); }
        const float r = rsqrtf(wave_sum(ss) * (1.f / D) + 1e-6f);
#pragma unroll
        for (int j = 0; j < 4; ++j) {
            const int col = 4 * lane + 256 * j;
            const f32x4 g = *(const f32x4*)(g1 + col);
            const f32x4 sh = *(LAS f32x4*)(modv + v * 2048 + col), sc = *(LAS f32x4*)(modv + v * 2048 + 1024 + col);
            const f32x4 h = (x[j] * r) * g * sc + sh;
            u32x2 o; o.x = cvtpk(h[0], h[1]); o.y = cvtpk(h[2], h[3]);
            *(u32x2*)(H + (size_t)t * D + col) = o;
        }
    }
}

struct WinOrder {
    pg8::StaticOrder so;
    __device__ void init(int G, int c) { so.init(T, DIN, G, c); }
    __device__ bool next(int i, pg8::Unit& u) const {
        const long L = (long)i * so.G + so.c;
        if (L < 960) return so.next(i, u);
        if (L < 962) { u.pm = 64 + (int)(L - 960); u.pn = 6; return true; }
        return false;
    }
    __device__ __forceinline__ void a_ready(const pg8::Unit&) const {}
    __device__ __forceinline__ void done(const pg8::Unit&) const {}
};
struct EpiWin {
    static constexpr bool PERM = false, AFTER_DRAIN = false;
    bf16* Z; bf16* KVC; const float* rope;
    __device__ __forceinline__ void operator()(const pg8::f32x4 (&acc)[2][2][4][2], const pg8::Unit& u, int wr, int wc, int fr, int fq) const {
        const int row0 = u.pm * 256 + wr * 64 + fr, colb = u.pn * 256 + wc * 32 + 4 * fq, pn = u.pn;
        if (u.pm >= 64) {
#pragma unroll
            for (int ai = 0; ai < 2; ++ai)
#pragma unroll
                for (int m = 0; m < 4; ++m) { bf16* rp = KVC + (size_t)(row0 + ai * 128 + m * 16 - T) * 256 + (colb - ZK);
#pragma unroll
                    for (int bj = 0; bj < 2; ++bj)
#pragma unroll
                        for (int n = 0; n < 2; ++n) { const pg8::f32x4 v = acc[ai][bj][m][n]; u32x2 o; o.x = cvtpk(v[0], v[1]); o.y = cvtpk(v[2], v[3]); *(u32x2*)(rp + bj * 128 + n * 16) = o; } }
            return;
        }
#pragma unroll
        for (int ai = 0; ai < 2; ++ai)
#pragma unroll
            for (int m = 0; m < 4; ++m) {
                const int r = row0 + ai * 128 + m * 16; bf16* rp = Z + (size_t)r * DIN + colb;
                if (pn <= 3) {
#pragma unroll
                    for (int bj = 0; bj < 2; ++bj)
#pragma unroll
                        for (int n = 0; n < 2; ++n) { const pg8::f32x4 v = acc[ai][bj][m][n]; u32x2 o; o.x = cvtpk(gelu_f(v[0]), gelu_f(v[1])); o.y = cvtpk(gelu_f(v[2]), gelu_f(v[3])); *(u32x2*)(rp + bj * 128 + n * 16) = o; }
                } else if (pn <= 6) {
                    const int pos = (wc & 1) ? (r & 63) : ((r & 8191) >> 6);
                    const pg8::f32x4 cs = *(const pg8::f32x4*)(rope + pos * 32 + 4 * fq), sn = *(const pg8::f32x4*)(rope + pos * 32 + 16 + 4 * fq);
                    const float sc = (pn < 6) ? QSCALE : 1.f;
#pragma unroll
                    for (int bj = 0; bj < 2; ++bj) {
                        const pg8::f32x4 x1 = acc[ai][bj][m][0], x2 = acc[ai][bj][m][1];
                        pg8::f32x4 o1, o2;
                        if (pn == 6 && bj == 1) { o1 = x1; o2 = x2; }
                        else { o1 = (x1 * cs - x2 * sn) * sc; o2 = (x2 * cs + x1 * sn) * sc; }
                        u32x2 w1, w2; w1.x = cvtpk(o1[0], o1[1]); w1.y = cvtpk(o1[2], o1[3]); w2.x = cvtpk(o2[0], o2[1]); w2.y = cvtpk(o2[2], o2[3]);
                        *(u32x2*)(rp + bj * 128) = w1; *(u32x2*)(rp + bj * 128 + 16) = w2;
                    }
                } else {
#pragma unroll
                    for (int bj = 0; bj < 2; ++bj)
#pragma unroll
                        for (int n = 0; n < 2; ++n) { const pg8::f32x4 v = acc[ai][bj][m][n]; u32x2 o; o.x = cvtpk(sigmoid_f(v[0]), sigmoid_f(v[1])); o.y = cvtpk(sigmoid_f(v[2]), sigmoid_f(v[3])); *(u32x2*)(rp + bj * 128 + n * 16) = o; }
                }
            }
    }
};
struct EpiMergeA {
    static constexpr bool PERM = true, AFTER_DRAIN = false;
    const bf16* Z; bf16* Y;
    __device__ __forceinline__ void operator()(const pg8::f32x4 (&acc)[2][2][4][2], const pg8::Unit& u, int wr, int wc, int fr, int fq) const {
        const int row0 = u.pm * 256 + wr * 64 + fr, col0 = u.pn * 256 + wc * 32 + 8 * fq;
#pragma unroll
        for (int ai = 0; ai < 2; ++ai)
#pragma unroll
            for (int m = 0; m < 4; ++m) { const int r = row0 + ai * 128 + m * 16;
#pragma unroll
                for (int bj = 0; bj < 2; ++bj) { const int c = col0 + bj * 128;
                    const u32x4 g = *(const u32x4*)(Z + (size_t)r * DIN + ZGA + c);
                    const pg8::f32x4 v0 = acc[ai][bj][m][0], v1 = acc[ai][bj][m][1];
                    u32x4 o;
                    o.x = cvtpk(v0[0] * bflo(g.x), v0[1] * bfhi(g.x)); o.y = cvtpk(v0[2] * bflo(g.y), v0[3] * bfhi(g.y));
                    o.z = cvtpk(v1[0] * bflo(g.z), v1[1] * bfhi(g.z)); o.w = cvtpk(v1[2] * bflo(g.w), v1[3] * bfhi(g.w));
                    *(u32x4*)(Y + (size_t)r * D + c) = o; } }
    }
};
struct EpiMergeB {
    static constexpr bool PERM = true, AFTER_DRAIN = false;
    const bf16* Z; bf16* Y;
    __device__ __forceinline__ void operator()(const pg8::f32x4 (&acc)[2][2][4][2], const pg8::Unit& u, int wr, int wc, int fr, int fq) const {
        const int row0 = u.pm * 256 + wr * 64 + fr, col0 = u.pn * 256 + wc * 32 + 8 * fq;
#pragma unroll
        for (int ai = 0; ai < 2; ++ai)
#pragma unroll
            for (int m = 0; m < 4; ++m) { const int r = row0 + ai * 128 + m * 16;
#pragma unroll
                for (int bj = 0; bj < 2; ++bj) { const int c = col0 + bj * 128;
                    const u32x4 g = *(const u32x4*)(Z + (size_t)r * DIN + ZGB + c);
                    const u32x4 tp = *(const u32x4*)(Y + (size_t)r * D + c);
                    const pg8::f32x4 t0 = {bflo(tp.x), bfhi(tp.x), bflo(tp.y), bfhi(tp.y)}, t1 = {bflo(tp.z), bfhi(tp.z), bflo(tp.w), bfhi(tp.w)};
                    const pg8::f32x4 v0 = acc[ai][bj][m][0], v1 = acc[ai][bj][m][1];
                    u32x4 o;
                    o.x = cvtpk(t0[0] + v0[0] * bflo(g.x), t0[1] + v0[1] * bfhi(g.x)); o.y = cvtpk(t0[2] + v0[2] * bflo(g.y), t0[3] + v0[3] * bfhi(g.y));
                    o.z = cvtpk(t1[0] + v1[0] * bflo(g.z), t1[1] + v1[1] * bfhi(g.z)); o.w = cvtpk(t1[2] + v1[2] * bflo(g.w), t1[3] + v1[3] * bfhi(g.w));
                    *(u32x4*)(Y + (size_t)r * D + c) = o; } }
    }
};
struct EpiWo {
    static constexpr bool PERM = true, AFTER_DRAIN = false;
    const float* x; const float* adaf; bf16* X1;
    __device__ __forceinline__ void operator()(const pg8::f32x4 (&acc)[2][2][4][2], const pg8::Unit& u, int wr, int wc, int fr, int fq) const {
        const int row0 = u.pm * 256 + wr * 64 + fr, col0 = u.pn * 256 + wc * 32 + 8 * fq;
        const float* g1 = adaf + (u.pm >= 32 ? 6144 : 0) + 2048;
#pragma unroll
        for (int bj = 0; bj < 2; ++bj) { const int c = col0 + bj * 128;
            const pg8::f32x4 ga = *(const pg8::f32x4*)(g1 + c), gb = *(const pg8::f32x4*)(g1 + c + 4);
#pragma unroll
            for (int ai = 0; ai < 2; ++ai)
#pragma unroll
                for (int m = 0; m < 4; ++m) { const int r = row0 + ai * 128 + m * 16;
                    const pg8::f32x4 x0 = *(const pg8::f32x4*)(x + (size_t)r * D + c), x1 = *(const pg8::f32x4*)(x + (size_t)r * D + c + 4);
                    const pg8::f32x4 o0 = x0 + ga * acc[ai][bj][m][0], o1 = x1 + gb * acc[ai][bj][m][1];
                    u32x4 w; w.x = cvtpk(o0[0], o0[1]); w.y = cvtpk(o0[2], o0[3]); w.z = cvtpk(o1[0], o1[1]); w.w = cvtpk(o1[2], o1[3]);
                    *(u32x4*)(X1 + (size_t)r * D + c) = w; } }
    }
};


__device__ __forceinline__ s16x4 vtr(LAS const unsigned char* p) { return __builtin_bit_cast(s16x4, __builtin_amdgcn_ds_read_tr16_b64_v4i16((LAS v4i16_t*)p)); }

__device__ __forceinline__ void attn_item(const bf16* Z, const bf16* KVC, const float* sink, bf16* Obuf, ldsp lds, int b, int nb, int hk, int qh) {
    const int tid = threadIdx.x, lane = tid & 63, wave = __builtin_amdgcn_readfirstlane(tid >> 6), r32 = lane & 31, hi = lane >> 5;
    const int rq = wave >> 1, head = hk * 4 + rq;
    const int iq = qh * 64 + (wave & 1) * 32 + r32;
    const int wlo = (nb == 0) ? 2 : qh, whi = (nb == 63) ? 4 : 5 + qh, nwin = whi - wlo, ntile = nwin + 4;
    const int tokq = b * SEQ + nb * 128 + iq;
    bf16x8 qr[4];
#pragma unroll
    for (int d0 = 0; d0 < 4; ++d0) qr[d0] = *(const bf16x8*)(Z + (size_t)tokq * DIN + ZQ + head * 64 + d0 * 16 + hi * 8);
    float mrun = sink[head] * LOG2E, lrun = (hi == 0) ? 1.f : 0.f;
    f32x16 o[2];
#pragma unroll
    for (int j = 0; j < 2; ++j)
#pragma unroll
        for (int r = 0; r < 16; ++r) o[j][r] = 0.f;
    const int kdst = wave * 1024 + lane * 16, vdst = 8192 + (wave >> 2) * 4096 + lane * 64 + (wave & 3) * 16;
#define ATT_SRC(s, kp, vp) do { const int tl_ = (s) < nwin ? wlo + (s) : 6 + (s) - nwin; \
        if (tl_ < 6) { const int tok_ = b * SEQ + (nb - 1 + (tl_ >> 1)) * 128 + (tl_ & 1) * 64 + lane; kp = Z + (size_t)tok_ * DIN + ZK + hk * 64 + wave * 8; vp = Z + (size_t)tok_ * DIN + ZVA + hk * 64 + wave * 8; } \
        else { const int row_ = b * NCTX + (tl_ - 6) * 64 + lane; kp = KVC + (size_t)row_ * 256 + hk * 64 + wave * 8; vp = KVC + (size_t)row_ * 256 + 128 + hk * 64 + wave * 8; } } while (0)
    u32x4 kreg, vreg;
    { const bf16 *kp, *vp; ATT_SRC(0, kp, vp); kreg = *(const u32x4*)kp; vreg = *(const u32x4*)vp; }
    *(LAS u32x4*)(lds + kdst) = kreg; *(LAS u32x4*)(lds + vdst) = vreg;
    __syncthreads();
    const int vrd = ((lane & 15) >> 2) * 64 + ((lane >> 4) & 1) * 32 + (lane & 3) * 8 + hi * 256;
    for (int s = 0; s < ntile; ++s) {
        const int base = (s & 1) * 16384;
        const int tl = s < nwin ? wlo + s : 6 + s - nwin;
        if (s + 1 < ntile) { const bf16 *kp, *vp; ATT_SRC(s + 1, kp, vp); kreg = *(const u32x4*)kp; vreg = *(const u32x4*)vp; }
        {
            f32x16 p0, p1;
#pragma unroll
            for (int r = 0; r < 16; ++r) { p0[r] = 0.f; p1[r] = 0.f; }
#pragma unroll
            for (int d0 = 0; d0 < 4; ++d0) {
                const bf16x8 k0 = *(LAS const bf16x8*)(lds + base + (2 * d0 + hi) * 1024 + r32 * 16);
                const bf16x8 k1 = *(LAS const bf16x8*)(lds + base + (2 * d0 + hi) * 1024 + (r32 + 32) * 16);
                p0 = mfma32(k0, qr[d0], p0); p1 = mfma32(k1, qr[d0], p1);
            }
            if (tl < 2) {
                const int j0 = (tl & 1) * 64 + 4 * hi;
#pragma unroll
                for (int r = 0; r < 16; ++r) { const int j = j0 + (r & 3) + 8 * (r >> 2); if (j < iq) p0[r] = -INFINITY; if (j + 32 < iq) p1[r] = -INFINITY; }
            } else if (tl == 4 || tl == 5) {
                const int j0 = (tl & 1) * 64 + 4 * hi;
#pragma unroll
                for (int r = 0; r < 16; ++r) { const int j = j0 + (r & 3) + 8 * (r >> 2); if (j > iq) p0[r] = -INFINITY; if (j + 32 > iq) p1[r] = -INFINITY; }
            }
            float mx = fmaxf(p0[0], p1[0]);
#pragma unroll
            for (int r = 1; r < 16; ++r) mx = fmaxf(mx, fmaxf(p0[r], p1[r]));
            mx = fmaxf(mx, __shfl_xor(mx, 32));
            const float mn = fmaxf(mrun, mx), alpha = __builtin_amdgcn_exp2f(mrun - mn);
            mrun = mn;
            float rs = 0.f;
#pragma unroll
            for (int r = 0; r < 16; ++r) { p0[r] = __builtin_amdgcn_exp2f(p0[r] - mn); p1[r] = __builtin_amdgcn_exp2f(p1[r] - mn); rs += p0[r] + p1[r]; }
            lrun = lrun * alpha + rs;
#pragma unroll
            for (int r = 0; r < 16; ++r) { o[0][r] *= alpha; o[1][r] *= alpha; }
            bf16x8 pf[4];
#pragma unroll
            for (int s4 = 0; s4 < 4; ++s4) {
                u32x4 w;
                if (s4 < 2) { w.x = cvtpk(p0[8 * s4 + 0], p0[8 * s4 + 1]); w.y = cvtpk(p0[8 * s4 + 2], p0[8 * s4 + 3]); w.z = cvtpk(p0[8 * s4 + 4], p0[8 * s4 + 5]); w.w = cvtpk(p0[8 * s4 + 6], p0[8 * s4 + 7]); }
                else { const int q = s4 - 2; w.x = cvtpk(p1[8 * q + 0], p1[8 * q + 1]); w.y = cvtpk(p1[8 * q + 2], p1[8 * q + 3]); w.z = cvtpk(p1[8 * q + 4], p1[8 * q + 5]); w.w = cvtpk(p1[8 * q + 6], p1[8 * q + 7]); }
                pf[s4] = __builtin_bit_cast(bf16x8, w);
            }
#pragma unroll
            for (int dblk = 0; dblk < 2; ++dblk)
#pragma unroll
                for (int s4 = 0; s4 < 4; ++s4) {
                    const s16x4 lo = vtr(lds + base + 8192 + dblk * 4096 + vrd + (16 * s4) * 64);
                    const s16x4 hh = vtr(lds + base + 8192 + dblk * 4096 + vrd + (16 * s4 + 8) * 64);
                    const bf16x8 vf = {lo[0], lo[1], lo[2], lo[3], hh[0], hh[1], hh[2], hh[3]};
                    o[dblk] = mfma32(vf, pf[s4], o[dblk]);
                }
        }
        if (s + 1 < ntile) { *(LAS u32x4*)(lds + (16384 - base) + kdst) = kreg; *(LAS u32x4*)(lds + (16384 - base) + vdst) = vreg; }
        __syncthreads();
    }
#undef ATT_SRC
    {
        const float lt = lrun + __shfl_xor(lrun, 32), inv = 1.f / lt;
        bf16* op = Obuf + (size_t)tokq * 512 + head * 64;
#pragma unroll
        for (int dblk = 0; dblk < 2; ++dblk)
#pragma unroll
            for (int r4 = 0; r4 < 4; ++r4) {
                u32x2 w; w.x = cvtpk(o[dblk][4 * r4] * inv, o[dblk][4 * r4 + 1] * inv); w.y = cvtpk(o[dblk][4 * r4 + 2] * inv, o[dblk][4 * r4 + 3] * inv);
                *(u32x2*)(op + 32 * dblk + 8 * r4 + 4 * hi) = w;
            }
    }
}

__device__ __forceinline__ void gmlp_item(const bf16* Z, const float* lng, const float* lnb, const bf16* WsT, const float* bs, bf16* Abuf, ldsp lds, int ch, int g) {
    const int tid = threadIdx.x, lane = tid & 63, wave = __builtin_amdgcn_readfirstlane(tid >> 6), fr = lane & 15, fq = lane >> 4;
    const int tok0 = ch * 128;
    LAS bf16* VT = (LAS bf16*)lds;
    f32x4 gA = *(const f32x4*)(lng + lane * 8), gB = *(const f32x4*)(lng + lane * 8 + 4), bA = *(const f32x4*)(lnb + lane * 8), bB = *(const f32x4*)(lnb + lane * 8 + 4);
#pragma unroll
    for (int rnd = 0; rnd < 2; ++rnd) {
        float y[8][8];
#pragma unroll
        for (int j = 0; j < 8; ++j) {
            const int tok = tok0 + wave * 16 + rnd * 8 + j;
            const u32x4 raw = *(const u32x4*)(Z + (size_t)tok * DIN + ZV + lane * 8);
            float x[8] = {bflo(raw.x), bfhi(raw.x), bflo(raw.y), bfhi(raw.y), bflo(raw.z), bfhi(raw.z), bflo(raw.w), bfhi(raw.w)};
            float s = 0.f;
#pragma unroll
            for (int i = 0; i < 8; ++i) s += x[i];
            const float mu = wave_sum(s) * (1.f / 512.f);
            float q = 0.f;
#pragma unroll
            for (int i = 0; i < 8; ++i) { x[i] -= mu; q += x[i] * x[i]; }
            const float rstd = rsqrtf(wave_sum(q) * (1.f / 512.f) + 1e-6f);
            y[j][0] = x[0] * rstd * gA[0] + bA[0]; y[j][1] = x[1] * rstd * gA[1] + bA[1]; y[j][2] = x[2] * rstd * gA[2] + bA[2]; y[j][3] = x[3] * rstd * gA[3] + bA[3];
            y[j][4] = x[4] * rstd * gB[0] + bB[0]; y[j][5] = x[5] * rstd * gB[1] + bB[1]; y[j][6] = x[6] * rstd * gB[2] + bB[2]; y[j][7] = x[7] * rstd * gB[3] + bB[3];
        }
        if ((lane >> 4) == g) {
#pragma unroll
            for (int i = 0; i < 8; ++i) {
                u32x4 w; w.x = cvtpk(y[0][i], y[1][i]); w.y = cvtpk(y[2][i], y[3][i]); w.z = cvtpk(y[4][i], y[5][i]); w.w = cvtpk(y[6][i], y[7][i]);
                *(LAS u32x4*)(VT + (8 * (lane & 15) + i) * 136 + wave * 16 + rnd * 8) = w;
            }
        }
    }
    __syncthreads();
    const int wm = wave >> 1, wn = wave & 1;
    f32x4 acc[2][4];
#pragma unroll
    for (int m = 0; m < 2; ++m)
#pragma unroll
        for (int n = 0; n < 4; ++n) acc[m][n] = (f32x4){0.f, 0.f, 0.f, 0.f};
#pragma unroll
    for (int ks = 0; ks < 4; ++ks) {
        bf16x8 af[2], bfr[4];
#pragma unroll
        for (int m = 0; m < 2; ++m) af[m] = *(const bf16x8*)(WsT + (size_t)g * 16384 + (32 * wm + 16 * m + fr) * 128 + 32 * ks + 8 * fq);
#pragma unroll
        for (int n = 0; n < 4; ++n) bfr[n] = *(LAS const bf16x8*)(VT + (64 * wn + 16 * n + fr) * 136 + 32 * ks + 8 * fq);
#pragma unroll
        for (int m = 0; m < 2; ++m)
#pragma unroll
            for (int n = 0; n < 4; ++n) acc[m][n] = mfma16(bfr[n], af[m], acc[m][n]);
    }
#pragma unroll
    for (int m = 0; m < 2; ++m) {
        const int p = 32 * wm + 16 * m + fr, tok = tok0 + p; const float bias = bs[g * 128 + p];
#pragma unroll
        for (int n = 0; n < 4; ++n) {
            const int c = g * 128 + 64 * wn + 16 * n + 4 * fq;
            const u32x2 uw = *(const u32x2*)(Z + (size_t)tok * DIN + ZU + c);
            u32x2 w; w.x = cvtpk(bflo(uw.x) * (acc[m][n][0] + bias), bfhi(uw.x) * (acc[m][n][1] + bias)); w.y = cvtpk(bflo(uw.y) * (acc[m][n][2] + bias), bfhi(uw.y) * (acc[m][n][3] + bias));
            *(u32x2*)(Abuf + (size_t)tok * 512 + c) = w;
        }
    }
    __syncthreads();
}

__device__ __forceinline__ void phase_mixers(const Args& a, ldsp lds, int G, int vcu) {
    unsigned char* ws = a.ws;
    const bf16* Z = (const bf16*)(ws + WS_Z);
    for (int it = vcu; it < 512; it += G) {
        const int qh = it & 1, hk = (it >> 1) & 1, nb = (it >> 2) & 63, b = it >> 8;
        attn_item(Z, (const bf16*)(ws + WS_KVC), a.in[I_SINK], (bf16*)(ws + WS_O), lds, b, nb, hk, qh);
    }
    for (int it = vcu; it < 512; it += G) {
        gmlp_item(Z, a.in[I_LNG], a.in[I_LNB], (const bf16*)(ws + WS_WST), a.in[I_GBS], (bf16*)(ws + WS_A), lds, it >> 2, it & 3);
    }
}

#define KI_BEFORE(ka, ia, kb, ib) (((ka) > (kb)) || ((ka) == (kb) && (ia) < (ib)))
#define KI_CAS(K, I, p, q) do { const bool sw_ = KI_BEFORE(K[q], I[q], K[p], I[p]); const float kp_ = sw_ ? K[q] : K[p], kq_ = sw_ ? K[p] : K[q]; const int ip_ = sw_ ? I[q] : I[p], iq_ = sw_ ? I[p] : I[q]; \
        K[p] = kp_; I[p] = ip_; K[q] = kq_; I[q] = iq_; } while (0)
#define KI_SORT8(K, I) do { KI_CAS(K, I, 0, 1); KI_CAS(K, I, 2, 3); KI_CAS(K, I, 4, 5); KI_CAS(K, I, 6, 7); \
        KI_CAS(K, I, 0, 2); KI_CAS(K, I, 1, 3); KI_CAS(K, I, 4, 6); KI_CAS(K, I, 5, 7); \
        KI_CAS(K, I, 1, 2); KI_CAS(K, I, 5, 6); KI_CAS(K, I, 0, 4); KI_CAS(K, I, 3, 7); \
        KI_CAS(K, I, 1, 5); KI_CAS(K, I, 2, 6); KI_CAS(K, I, 1, 4); KI_CAS(K, I, 3, 6); \
        KI_CAS(K, I, 2, 4); KI_CAS(K, I, 3, 5); KI_CAS(K, I, 3, 4); } while (0)
#define KI_MERGE8(KA, IA, KB, IB) do { \
        _Pragma("unroll") for (int r_ = 0; r_ < 8; ++r_) { const bool tb_ = KI_BEFORE(KB[7 - r_], IB[7 - r_], KA[r_], IA[r_]); KA[r_] = tb_ ? KB[7 - r_] : KA[r_]; IA[r_] = tb_ ? IB[7 - r_] : IA[r_]; } \
        KI_CAS(KA, IA, 0, 4); KI_CAS(KA, IA, 1, 5); KI_CAS(KA, IA, 2, 6); KI_CAS(KA, IA, 3, 7); \
        KI_CAS(KA, IA, 0, 2); KI_CAS(KA, IA, 1, 3); KI_CAS(KA, IA, 4, 6); KI_CAS(KA, IA, 5, 7); \
        KI_CAS(KA, IA, 0, 1); KI_CAS(KA, IA, 2, 3); KI_CAS(KA, IA, 4, 5); KI_CAS(KA, IA, 6, 7); } while (0)
__device__ __forceinline__ void router_item(const Args& a, ldsp lds, int it) {
    const int tid = threadIdx.x, lane = tid & 63, wave = __builtin_amdgcn_readfirstlane(tid >> 6), fr = lane & 15, fq = lane >> 4;
    unsigned char* ws = a.ws;
    const int t0 = it * 64, b = t0 >> 13;
    const bf16* X1 = (const bf16*)(ws + WS_X1); const float* adaf = (const float*)(ws + WS_ADAF) + b * 6144;
    const float* g2 = a.in[I_N2G]; bf16* H2 = (bf16*)(ws + WS_H2);
    {
        f32x4 gm[2][2], sh[2][2];
#pragma unroll
        for (int j = 0; j < 2; ++j)
#pragma unroll
            for (int h = 0; h < 2; ++h) {
                const int c = 8 * lane + 512 * j + 4 * h;
                const f32x4 gg = *(const f32x4*)(g2 + c), sc = *(const f32x4*)(adaf + 4 * 1024 + c);
                gm[j][h] = gg * (sc + 1.f); sh[j][h] = *(const f32x4*)(adaf + 3 * 1024 + c);
            }
#pragma unroll
        for (int half = 0; half < 2; ++half) {
            f32x4 x[4][2][2];
#pragma unroll
            for (int tt = 0; tt < 4; ++tt)
#pragma unroll
                for (int j = 0; j < 2; ++j) {
                    const u32x4 w = *(const u32x4*)(X1 + (size_t)(t0 + wave * 8 + half * 4 + tt) * D + 8 * lane + 512 * j);
                    x[tt][j][0] = (f32x4){bflo(w.x), bfhi(w.x), bflo(w.y), bfhi(w.y)}; x[tt][j][1] = (f32x4){bflo(w.z), bfhi(w.z), bflo(w.w), bfhi(w.w)};
                }
#pragma unroll
            for (int tt = 0; tt < 4; ++tt) {
                const int row = wave * 8 + half * 4 + tt, tok = t0 + row;
                float ss = 0.f;
#pragma unroll
                for (int j = 0; j < 2; ++j)
#pragma unroll
                    for (int h = 0; h < 2; ++h) { const f32x4 v = x[tt][j][h]; ss += (v[0] * v[0] + v[1] * v[1]) + (v[2] * v[2] + v[3] * v[3]); }
                const float r = rsqrtf(wave_sum(ss) * (1.f / D) + 1e-6f);
#pragma unroll
                for (int j = 0; j < 2; ++j) {
                    const f32x4 h0 = (x[tt][j][0] * r) * gm[j][0] + sh[j][0], h1 = (x[tt][j][1] * r) * gm[j][1] + sh[j][1];
                    u32x4 w; w.x = cvtpk(h0[0], h0[1]); w.y = cvtpk(h0[2], h0[3]); w.z = cvtpk(h1[0], h1[1]); w.w = cvtpk(h1[2], h1[3]);
                    *(u32x4*)(H2 + (size_t)tok * D + 8 * lane + 512 * j) = w;
                    const int kc = lane + 64 * j;
                    *(LAS u32x4*)(lds + kc * 1024 + ((row ^ (kc & 7)) * 16)) = w;
                }
            }
        }
    }
    __syncthreads();
    f32x4 acc[4][2];
#pragma unroll
    for (int m = 0; m < 4; ++m)
#pragma unroll
        for (int n = 0; n < 2; ++n) acc[m][n] = (f32x4){0.f, 0.f, 0.f, 0.f};
    const bf16* RwT = (const bf16*)(ws + WS_RWT) + (size_t)(32 * wave + fr) * D + 8 * fq;
#pragma unroll 8
    for (int ks = 0; ks < 32; ++ks) {
        const int kc = 4 * ks + fq;
        bf16x8 af[4], bfr[2];
#pragma unroll
        for (int n = 0; n < 2; ++n) bfr[n] = *(const bf16x8*)(RwT + (size_t)(16 * n) * D + 32 * ks);
#pragma unroll
        for (int m = 0; m < 4; ++m) af[m] = *(LAS const bf16x8*)(lds + kc * 1024 + (((16 * m + fr) ^ (kc & 7)) * 16));
#pragma unroll
        for (int m = 0; m < 4; ++m)
#pragma unroll
            for (int n = 0; n < 2; ++n) acc[m][n] = mfma16(af[m], bfr[n], acc[m][n]);
    }
    __syncthreads();
    LAS float* LG = (LAS float*)lds;
#pragma unroll
    for (int m = 0; m < 4; ++m)
#pragma unroll
        for (int n = 0; n < 2; ++n)
#pragma unroll
            for (int reg = 0; reg < 4; ++reg) LG[(32 * wave + 16 * n + fr) * 65 + 16 * m + 4 * fq + reg] = acc[m][n][reg];
    __syncthreads();
    LAS float* CK = (LAS float*)(lds + 69632); LAS int* CI = (LAS int*)(lds + 69632 + 16384);
    const float* rb = a.in[I_RB];
    float bk[8]; int bi[8];
#pragma unroll
    for (int q = 0; q < 4; ++q) {
        float gk[8]; int gi[8];
#pragma unroll
        for (int j = 0; j < 8; ++j) { const int e = 32 * wave + 8 * q + j; gk[j] = sigmoid_f(LG[e * 65 + lane]) + rb[e]; gi[j] = e; }
        KI_SORT8(gk, gi);
        if (q == 0) {
#pragma unroll
            for (int j = 0; j < 8; ++j) { bk[j] = gk[j]; bi[j] = gi[j]; }
        } else KI_MERGE8(bk, bi, gk, gi);
    }
#pragma unroll
    for (int r = 0; r < 8; ++r) { CK[(wave * 8 + r) * 64 + lane] = bk[r]; CI[(wave * 8 + r) * 64 + lane] = bi[r]; }
    __syncthreads();
#define RT_LEVEL(lvl) do { if ((wave & (2 * (lvl) - 1)) == 0) { float ok_[8]; int oi_[8]; \
            _Pragma("unroll") for (int r = 0; r < 8; ++r) { ok_[r] = CK[((wave + (lvl)) * 8 + r) * 64 + lane]; oi_[r] = CI[((wave + (lvl)) * 8 + r) * 64 + lane]; } \
            KI_MERGE8(bk, bi, ok_, oi_); \
            if ((lvl) < 4) { _Pragma("unroll") for (int r = 0; r < 8; ++r) { CK[(wave * 8 + r) * 64 + lane] = bk[r]; CI[(wave * 8 + r) * 64 + lane] = bi[r]; } } } \
        __syncthreads(); } while (0)
    RT_LEVEL(1); RT_LEVEL(2); RT_LEVEL(4);
#undef RT_LEVEL
    LAS unsigned* hist = (LAS unsigned*)(lds + 102400); LAS unsigned* hbase = hist + 256;
    if (tid < 256) hist[tid] = 0u;
    __syncthreads();
    unsigned* cnt = (unsigned*)(ws + WS_CTL) + CW_CNT; int* list = (int*)(ws + WS_LIST); float* gatew = (float*)(ws + WS_GATEW);
    unsigned rank[8];
    if (wave == 0) {
        const int tok = t0 + lane;
        float sel[8], ssum = 0.f;
#pragma unroll
        for (int r = 0; r < 8; ++r) { sel[r] = sigmoid_f(LG[bi[r] * 65 + lane]); ssum += sel[r]; }
#pragma unroll
        for (int r = 0; r < 8; ++r) rank[r] = __hip_atomic_fetch_add(&hist[bi[r]], 1u, __ATOMIC_RELAXED, __HIP_MEMORY_SCOPE_WORKGROUP);
        const float sc = 2.5f / ssum;
        f32x4 g0 = {sel[0] * sc, sel[1] * sc, sel[2] * sc, sel[3] * sc}, g1 = {sel[4] * sc, sel[5] * sc, sel[6] * sc, sel[7] * sc};
        *(f32x4*)(gatew + tok * 8) = g0; *(f32x4*)(gatew + tok * 8 + 4) = g1;
    }
    __syncthreads();
    if (tid < 256) { const unsigned h = hist[tid]; if (h) hbase[tid] = atomicAdd(cnt + 32 * tid, h); }
    __syncthreads();
    if (wave == 0) {
        const int tok = t0 + lane;
#pragma unroll
        for (int r = 0; r < 8; ++r) list[(size_t)bi[r] * LISTCAP + hbase[bi[r]] + rank[r]] = tok * NSLOT + r;
    }
    __syncthreads();
}

__device__ __forceinline__ void moe_tile(const Args& a, ldsp lds, int e, int mt, int nrows, int ntl) {
    const int tid = threadIdx.x, lane = tid & 63, wave = __builtin_amdgcn_readfirstlane(tid >> 6), fr = lane & 15, fq = lane >> 4;
    unsigned char* ws = a.ws;
    constexpr int ASTG = 0, BSTG = 16384, ACT = 49152, SLOTS = 114688, GWO = 115200;
    const bf16* H2 = (const bf16*)(ws + WS_H2);
    const float* Wg = (e < NEXP) ? a.in[I_EG] + (size_t)e * 262144 : a.in[I_SG];
    const float* Wu = (e < NEXP) ? a.in[I_EU] + (size_t)e * 262144 : a.in[I_SU];
    const float* Wd = (e < NEXP) ? a.in[I_ED] + (size_t)e * 262144 : a.in[I_SD];
    if (tid < 128) {
        int slot = -1; float gw = 0.f;
        if (tid < nrows) {
            if (e < NEXP) { slot = ((const int*)(ws + WS_LIST))[(size_t)e * LISTCAP + mt * 128 + tid]; gw = ((const float*)(ws + WS_GATEW))[(slot / NSLOT) * 8 + (slot % NSLOT)]; }
            else { slot = (mt * 128 + tid) * NSLOT + 8; gw = 1.f; }
        }
        ((LAS int*)(lds + SLOTS))[tid] = slot; ((LAS float*)(lds + GWO))[tid] = gw;
    }
    __syncthreads();
    const int wr = wave >> 2, wc = wave & 3;
    const int arow = tid >> 2, akc = tid & 3;
    const int aslot = ((LAS const int*)(lds + SLOTS))[arow];
    const bf16* asrc = H2 + (size_t)((aslot < 0 ? 0 : aslot) / NSLOT) * D + akc * 8;
    const int awr = ASTG + akc * 2048 + ((arow ^ (akc << 1)) * 16);
    const int ng = lane, kq = wave;
    const float* srcg = Wg + (size_t)(4 * kq) * 256 + 4 * ng;
    const float* srcu = Wu + (size_t)(4 * kq) * 256 + 4 * ng;
    const float* src2 = Wd + (size_t)(4 * kq) * 1024 + 4 * ng;
    int bwr2[4];
#pragma unroll
    for (int i = 0; i < 4; ++i) { const int rho2 = 4 * ng + i; bwr2[i] = BSTG + (kq >> 1) * 4096 + ((rho2 ^ ((rho2 >> 3) & 3)) * 16) + (kq & 1) * 8; }
    int ard[4], brd[4], rowm[4];
#pragma unroll
    for (int m = 0; m < 4; ++m) { rowm[m] = 64 * wr + 16 * m + fr; ard[m] = fq * 2048 + ((rowm[m] ^ (fq << 1)) * 16); }
#pragma unroll
    for (int n = 0; n < 4; ++n) { const int rho = 64 * wc + 16 * n + fr; brd[n] = BSTG + fq * 4096 + ((rho ^ ((rho >> 3) & 3)) * 16); }
    bf16* contrib = (bf16*)(ws + WS_CONTRIB);
    f32x4 acc[4][4];
    f32x4 B0[4], B1[4], B2[4], B3[4]; u32x4 A0, A1, A2, A3;
#define G1_LOAD(s_, BR, AR) do { const int s0_ = (s_); const int ss_ = s0_ < 63 ? s0_ : 63; \
        const float* bp_ = ((ss_ < 32) ? srcg : srcu) + (size_t)(32 * (ss_ & 31)) * 256; \
        AR = *(const u32x4*)(asrc + 32 * (ss_ & 31)); \
        _Pragma("unroll") for (int j = 0; j < 4; ++j) BR[j] = *(const f32x4*)(bp_ + j * 256); } while (0)
#define G1_WRITE(BR, AR, buf_) do { \
        *(LAS u32x4*)(lds + (buf_) * 8192 + awr) = AR; \
        _Pragma("unroll") for (int i = 0; i < 4; ++i) { u32x2 w_; w_.x = cvtpk(BR[0][i], BR[1][i]); w_.y = cvtpk(BR[2][i], BR[3][i]); *(LAS u32x2*)(lds + (buf_) * 16384 + bwr2[i]) = w_; } } while (0)
#define MOE_COMPUTE(abase_, buf_) do { \
        bf16x8 af_[4], bf_[4]; \
        _Pragma("unroll") for (int m = 0; m < 4; ++m) af_[m] = *(LAS const bf16x8*)(lds + (abase_) + ard[m]); \
        _Pragma("unroll") for (int n = 0; n < 4; ++n) bf_[n] = *(LAS const bf16x8*)(lds + (buf_) * 16384 + brd[n]); \
        _Pragma("unroll") for (int m = 0; m < 4; ++m) _Pragma("unroll") for (int n = 0; n < 4; ++n) acc[m][n] = mfma16(bf_[n], af_[m], acc[m][n]); } while (0)
#define ACC_ZERO() do { _Pragma("unroll") for (int m = 0; m < 4; ++m) _Pragma("unroll") for (int n = 0; n < 4; ++n) acc[m][n] = (f32x4){0.f, 0.f, 0.f, 0.f}; } while (0)
    G1_LOAD(0, B0, A0); G1_LOAD(1, B1, A1); G1_LOAD(2, B2, A2);
    G1_WRITE(B0, A0, 0);
    __syncthreads();
    for (int s = 0; s < 64; s += 4) {
        if ((s & 31) == 0) ACC_ZERO();
        G1_LOAD(s + 3, B3, A3); MOE_COMPUTE(0, 0); G1_WRITE(B1, A1, 1); __syncthreads();
        G1_LOAD(s + 4, B0, A0); MOE_COMPUTE(8192, 1); G1_WRITE(B2, A2, 0); __syncthreads();
        G1_LOAD(s + 5, B1, A1); MOE_COMPUTE(0, 0); G1_WRITE(B3, A3, 1); __syncthreads();
        G1_LOAD(s + 6, B2, A2); MOE_COMPUTE(8192, 1);
        if (s == 28) {
#pragma unroll
            for (int m = 0; m < 4; ++m)
#pragma unroll
                for (int n = 0; n < 4; ++n) {
                    const f32x4 gv = acc[m][n];
                    u32x2 w; w.x = cvtpk(silu_f(gv[0]), silu_f(gv[1])); w.y = cvtpk(silu_f(gv[2]), silu_f(gv[3]));
                    const int kc = 8 * wc + 2 * n + (fq >> 1);
                    *(LAS u32x2*)(lds + ACT + kc * 2048 + ((rowm[m] ^ ((kc & 3) << 1)) * 16) + (fq & 1) * 8) = w;
                }
        } else if (s == 60) {
#pragma unroll
            for (int m = 0; m < 4; ++m)
#pragma unroll
                for (int n = 0; n < 4; ++n) {
                    const f32x4 uv = acc[m][n];
                    const int kc = 8 * wc + 2 * n + (fq >> 1);
                    LAS u32x2* ap = (LAS u32x2*)(lds + ACT + kc * 2048 + ((rowm[m] ^ ((kc & 3) << 1)) * 16) + (fq & 1) * 8);
                    const u32x2 g = *ap;
                    u32x2 w; w.x = cvtpk(bflo(g.x) * uv[0], bfhi(g.x) * uv[1]); w.y = cvtpk(bflo(g.y) * uv[2], bfhi(g.y) * uv[3]);
                    *ap = w;
                }
        }
        G1_WRITE(B0, A0, 0); __syncthreads();
    }
#define G2_LOAD(s_, BR) do { const int s0_ = (s_); const int t_ = s0_ < 31 ? s0_ : 31; \
        const float* bp_ = src2 + (size_t)(32 * (t_ & 7)) * 1024 + 256 * (t_ >> 3); \
        _Pragma("unroll") for (int j = 0; j < 4; ++j) BR[j] = *(const f32x4*)(bp_ + j * 1024); } while (0)
#define G2_WRITE(BR, buf_) do { \
        _Pragma("unroll") for (int i = 0; i < 4; ++i) { u32x2 w_; w_.x = cvtpk(BR[0][i], BR[1][i]); w_.y = cvtpk(BR[2][i], BR[3][i]); *(LAS u32x2*)(lds + (buf_) * 16384 + bwr2[i]) = w_; } } while (0)
    G2_LOAD(0, B0); G2_LOAD(1, B1); G2_LOAD(2, B2);
    G2_WRITE(B0, 0);
    __syncthreads();
    for (int s = 0; s < 32; s += 4) {
        if ((s & 7) == 0) ACC_ZERO();
        G2_LOAD(s + 3, B3); MOE_COMPUTE(ACT + (s & 7) * 8192, 0); G2_WRITE(B1, 1); __syncthreads();
        G2_LOAD(s + 4, B0); MOE_COMPUTE(ACT + ((s + 1) & 7) * 8192, 1); G2_WRITE(B2, 0); __syncthreads();
        G2_LOAD(s + 5, B1); MOE_COMPUTE(ACT + ((s + 2) & 7) * 8192, 0); G2_WRITE(B3, 1); __syncthreads();
        G2_LOAD(s + 6, B2); MOE_COMPUTE(ACT + ((s + 3) & 7) * 8192, 1);
        if ((s & 7) == 4) {
            const int q = s >> 3;
#pragma unroll
            for (int m = 0; m < 4; ++m) {
                const int slot = ((LAS const int*)(lds + SLOTS))[rowm[m]]; const float gw = ((LAS const float*)(lds + GWO))[rowm[m]];
                if (slot >= 0) {
                    bf16* cp = contrib + (size_t)slot * D + q * 256 + 64 * wc + 4 * fq;
#pragma unroll
                    for (int n = 0; n < 4; ++n) { const f32x4 v = acc[m][n] * gw; u32x2 w; w.x = cvtpk(v[0], v[1]); w.y = cvtpk(v[2], v[3]); *(u32x2*)(cp + 16 * n) = w; }
                }
            }
        }
        G2_WRITE(B0, 0); __syncthreads();
    }
#undef G1_LOAD
#undef G1_WRITE
#undef G2_LOAD
#undef G2_WRITE
#undef ACC_ZERO
#undef MOE_COMPUTE
}

__device__ __forceinline__ void moe_decode(int j, int total, LAS const int* pre, const unsigned* cnt, int& e, int& mt, int& nrows) {
    if (j < total) {
        int lo = 0, hi = NEXP;
        while (hi - lo > 1) { const int mid = (lo + hi) >> 1; if (pre[mid] <= j) lo = mid; else hi = mid; }
        e = lo; mt = j - pre[e]; const int c = (int)cnt[32 * e] - mt * 128; nrows = c < 128 ? c : 128;
    } else { e = NEXP; mt = j - total; nrows = 128; }
}
__device__ __forceinline__ void phase_moe(const Args& a, ldsp lds, int G, int vcu) {
    const int tid = threadIdx.x, lane = tid & 63, wave = __builtin_amdgcn_readfirstlane(tid >> 6), fr = lane & 15, fq = lane >> 4;
    unsigned char* ws = a.ws;
    constexpr int ASTG = 0, BSTG = 16384, ACT = 49152, SLOTS = 114688, GWO = 115712;
    const unsigned* cnt = (const unsigned*)(ws + WS_CTL) + CW_CNT;
    LAS int* pre = (LAS int*)(lds + MISC_OFF + 512);
    if (tid == 0) { int s = 0; for (int e = 0; e < NEXP; ++e) { pre[e] = s; s += (int)((cnt[32 * e] + 127u) >> 7); } pre[NEXP] = s; }
    __syncthreads();
    const int total = pre[NEXP], ntiles = total + T / 128;
    if (vcu >= ntiles) return;
#define STAGE_SLOTS(j_, b_) do { int e_, mt_, nr_; moe_decode((j_), total, pre, cnt, e_, mt_, nr_); \
        int slot_ = -1; float gw_ = 0.f; \
        if (tid < nr_) { if (e_ < NEXP) { slot_ = ((const int*)(ws + WS_LIST))[(size_t)e_ * LISTCAP + mt_ * 128 + tid]; gw_ = ((const float*)(ws + WS_GATEW))[(slot_ / NSLOT) * 8 + (slot_ % NSLOT)]; } \
                         else { slot_ = (mt_ * 128 + tid) * NSLOT + 8; gw_ = 1.f; } } \
        ((LAS int*)(lds + SLOTS))[(b_) * 128 + tid] = slot_; ((LAS float*)(lds + GWO))[(b_) * 128 + tid] = gw_; } while (0)
    if (wave >= 4) {
        const int lt = tid - 256;
        const bf16* H2 = (const bf16*)(ws + WS_H2);
        const int arow = lt >> 1, ahalf = lt & 1;
        const int awr0 = ASTG + (2 * ahalf) * 2048 + ((arow ^ ((2 * ahalf) << 1)) * 16), awr1 = ASTG + (2 * ahalf + 1) * 2048 + ((arow ^ ((2 * ahalf + 1) << 1)) * 16);
        const int ng = lt & 63, kq = lt >> 6;
        const int loff256 = (8 * kq) * 256 + 4 * ng, loff1024 = (8 * kq) * 1024 + 4 * ng;
        const int bw = BSTG + kq * 4096 + (4 * ng) * 16, bx = ((4 * ng) >> 3) & 3;
        f32x4 B0[8], B1[8], B2[8], B3[8]; u32x4 A0[2], A1[2], A2[2], A3[2];
        __syncthreads();
        int j = vcu, it = 0, e, mt, nrows;
        moe_decode(j, total, pre, cnt, e, mt, nrows);
        const float* Wg = (e < NEXP) ? a.in[I_EG] + (size_t)e * 262144 : a.in[I_SG];
        const float* Wu = (e < NEXP) ? a.in[I_EU] + (size_t)e * 262144 : a.in[I_SU];
        const float* Wd = (e < NEXP) ? a.in[I_ED] + (size_t)e * 262144 : a.in[I_SD];
        int aslot = ((LAS const int*)(lds + SLOTS))[arow];
        const bf16* asrc = H2 + (size_t)((aslot < 0 ? 0 : aslot) / NSLOT) * D + 16 * ahalf;
#define L_LOADB1(WG_, WU_, WD_, s_, BR) do { const int ss_ = (s_); const int t_ = ss_ - 64; \
            const float* bp_ = (ss_ < 32) ? (WG_) + loff256 + (size_t)(32 * ss_) * 256 : (ss_ < 64) ? (WU_) + loff256 + (size_t)(32 * (ss_ - 32)) * 256 : (WD_) + loff1024 + (size_t)(32 * (t_ & 7)) * 1024 + 256 * (t_ >> 3); \
            const int str_ = (ss_ < 64) ? 256 : 1024;        \
            _Pragma("unroll") for (int jj = 0; jj < 8; ++jj) BR[jj] = *(const f32x4*)(bp_ + jj * str_); } while (0)
#define L_LOADA2(AP_, s_, AR, AS) do { const int ss_ = (s_); const int sa_ = ss_ < 62 ? ss_ : 62; \
            AR[0] = *(const u32x4*)((AP_) + 32 * (sa_ & 31)); AR[1] = *(const u32x4*)((AP_) + 32 * (sa_ & 31) + 8); \
            AS[0] = *(const u32x4*)((AP_) + 32 * (sa_ & 31) + 32); AS[1] = *(const u32x4*)((AP_) + 32 * (sa_ & 31) + 40); } while (0)
#define L_LOAD2(s_, BR) do { const int s0_ = (s_); const int t_ = s0_ < 31 ? s0_ : 31; \
            const float* bp_ = Wd + loff1024 + (size_t)(32 * (t_ & 7)) * 1024 + 256 * (t_ >> 3); \
            _Pragma("unroll") for (int jj = 0; jj < 8; ++jj) BR[jj] = *(const f32x4*)(bp_ + jj * 1024); } while (0)
#define L_WRITEB(BR, buf_) do { _Pragma("unroll") for (int i = 0; i < 4; ++i) { u32x4 w_; w_.x = cvtpk(BR[0][i], BR[1][i]); w_.y = cvtpk(BR[2][i], BR[3][i]); w_.z = cvtpk(BR[4][i], BR[5][i]); w_.w = cvtpk(BR[6][i], BR[7][i]); \
            *(LAS u32x4*)(lds + (buf_) * 16384 + bw + ((i ^ bx) * 16)) = w_; } } while (0)
#define L_WRITEA(AR, buf_) do { *(LAS u32x4*)(lds + (buf_) * 8192 + awr0) = AR[0]; *(LAS u32x4*)(lds + (buf_) * 8192 + awr1) = AR[1]; } while (0)
        L_LOADA2(asrc, 0, A0, A1); L_LOADB1(Wg, Wu, Wd, 0, B0); L_LOADB1(Wg, Wu, Wd, 1, B1); L_LOADA2(asrc, 2, A2, A3); L_LOADB1(Wg, Wu, Wd, 2, B2);
        for (;;) {
            L_WRITEA(A0, 0); L_WRITEB(B0, 0);
            __syncthreads();
            for (int s = 0; s < 64; s += 4) {
                L_LOADB1(Wg, Wu, Wd, s + 3, B3); L_WRITEA(A1, 1); L_WRITEB(B1, 1); __syncthreads();
                L_LOADB1(Wg, Wu, Wd, s + 4, B0); L_LOADA2(asrc, s + 4, A0, A1); L_WRITEA(A2, 0); L_WRITEB(B2, 0); __syncthreads();
                L_LOADB1(Wg, Wu, Wd, s + 5, B1); L_WRITEA(A3, 1); L_WRITEB(B3, 1); __syncthreads();
                L_LOADB1(Wg, Wu, Wd, s + 6, B2); L_LOADA2(asrc, s + 6, A2, A3); L_WRITEA(A0, 0); L_WRITEB(B0, 0); __syncthreads();
            }
            for (int s = 0; s < 28; s += 4) {
                L_LOAD2(s + 3, B3); L_WRITEB(B1, 1); __syncthreads();
                L_LOAD2(s + 4, B0); L_WRITEB(B2, 0); __syncthreads();
                L_LOAD2(s + 5, B1); L_WRITEB(B3, 1); __syncthreads();
                L_LOAD2(s + 6, B2); L_WRITEB(B0, 0); __syncthreads();
            }
            const int jn = j + G; const bool more = jn < ntiles;
            int en = e, mtn = mt, nrn = nrows; if (more) moe_decode(jn, total, pre, cnt, en, mtn, nrn);
            const float* Wgn = (en < NEXP) ? a.in[I_EG] + (size_t)en * 262144 : a.in[I_SG];
            const float* Wun = (en < NEXP) ? a.in[I_EU] + (size_t)en * 262144 : a.in[I_SU];
            const float* Wdn = (en < NEXP) ? a.in[I_ED] + (size_t)en * 262144 : a.in[I_SD];
            const int aslotn = more ? ((LAS const int*)(lds + SLOTS))[(it ^ 1) * 128 + arow] : aslot;
            const bf16* asrcn = H2 + (size_t)((aslotn < 0 ? 0 : aslotn) / NSLOT) * D + 16 * ahalf;
            L_LOAD2(31, B3); L_WRITEB(B1, 1); __syncthreads();
            L_LOADB1(Wgn, Wun, Wdn, 0, B0); L_LOADA2(asrcn, 0, A0, A1); L_WRITEB(B2, 0); __syncthreads();
            L_LOADB1(Wgn, Wun, Wdn, 1, B1); L_WRITEB(B3, 1); __syncthreads();
            L_LOADB1(Wgn, Wun, Wdn, 2, B2); L_LOADA2(asrcn, 2, A2, A3); __syncthreads();
            if (!more) break;
            j = jn; it ^= 1; e = en; mt = mtn; nrows = nrn; Wg = Wgn; Wu = Wun; Wd = Wdn; aslot = aslotn; asrc = asrcn;
        }
#undef L_LOADB1
#undef L_LOADA2
#undef L_LOAD2
#undef L_WRITEB
#undef L_WRITEA
    } else {
        const int wr = wave >> 1, wc = wave & 1;
        int rowm[4], ard[4], brd[8];
#pragma unroll
        for (int m = 0; m < 4; ++m) { rowm[m] = 64 * wr + 16 * m + fr; ard[m] = fq * 2048 + ((rowm[m] ^ (fq << 1)) * 16); }
#pragma unroll
        for (int n = 0; n < 8; ++n) { const int rho = 128 * wc + 16 * n + fr; brd[n] = BSTG + fq * 4096 + ((rho ^ ((rho >> 3) & 3)) * 16); }
        bf16* contrib = (bf16*)(ws + WS_CONTRIB);
        f32x4 acc[4][8];
#define M_COMPUTE(abase_, buf_) do { \
            _Pragma("unroll") for (int nh = 0; nh < 2; ++nh) { bf16x8 af_[4], bf_[4]; \
                _Pragma("unroll") for (int m = 0; m < 4; ++m) af_[m] = *(LAS const bf16x8*)(lds + (abase_) + ard[m]); \
                _Pragma("unroll") for (int n = 0; n < 4; ++n) bf_[n] = *(LAS const bf16x8*)(lds + (buf_) * 16384 + brd[4 * nh + n]); \
                _Pragma("unroll") for (int m = 0; m < 4; ++m) _Pragma("unroll") for (int n = 0; n < 4; ++n) acc[m][4 * nh + n] = mfma16(bf_[n], af_[m], acc[m][4 * nh + n]); } } while (0)
#define M_ZERO() do { _Pragma("unroll") for (int m = 0; m < 4; ++m) _Pragma("unroll") for (int n = 0; n < 8; ++n) acc[m][n] = (f32x4){0.f, 0.f, 0.f, 0.f}; } while (0)
        if (tid < 128) STAGE_SLOTS(vcu, 0);
        __syncthreads();
        int it = 0;
        for (int j = vcu; j < ntiles; j += G, it ^= 1) {
            if (tid < 128 && j + G < ntiles) STAGE_SLOTS(j + G, it ^ 1);
            __syncthreads();
            for (int s = 0; s < 64; s += 4) {
                if ((s & 31) == 0) M_ZERO();
                M_COMPUTE(0, 0); __syncthreads();
                M_COMPUTE(8192, 1); __syncthreads();
                M_COMPUTE(0, 0); __syncthreads();
                M_COMPUTE(8192, 1);
                if (s == 28) {
#pragma unroll
                    for (int m = 0; m < 4; ++m)
#pragma unroll
                        for (int n = 0; n < 8; ++n) {
                            const f32x4 gv = acc[m][n];
                            u32x2 w; w.x = cvtpk(silu_f(gv[0]), silu_f(gv[1])); w.y = cvtpk(silu_f(gv[2]), silu_f(gv[3]));
                            const int kc = 16 * wc + 2 * n + (fq >> 1);
                            *(LAS u32x2*)(lds + ACT + kc * 2048 + ((rowm[m] ^ ((kc & 3) << 1)) * 16) + (fq & 1) * 8) = w;
                        }
                } else if (s == 60) {
#pragma unroll
                    for (int m = 0; m < 4; ++m)
#pragma unroll
                        for (int n = 0; n < 8; ++n) {
                            const f32x4 uv = acc[m][n];
                            const int kc = 16 * wc + 2 * n + (fq >> 1);
                            LAS u32x2* ap = (LAS u32x2*)(lds + ACT + kc * 2048 + ((rowm[m] ^ ((kc & 3) << 1)) * 16) + (fq & 1) * 8);
                            const u32x2 g = *ap;
                            u32x2 w; w.x = cvtpk(bflo(g.x) * uv[0], bfhi(g.x) * uv[1]); w.y = cvtpk(bflo(g.y) * uv[2], bfhi(g.y) * uv[3]);
                            *ap = w;
                        }
                }
                __syncthreads();
            }
            for (int s = 0; s < 32; s += 4) {
                if ((s & 7) == 0) M_ZERO();
                M_COMPUTE(ACT + (s & 7) * 8192, 0); __syncthreads();
                M_COMPUTE(ACT + ((s + 1) & 7) * 8192, 1); __syncthreads();
                M_COMPUTE(ACT + ((s + 2) & 7) * 8192, 0); __syncthreads();
                M_COMPUTE(ACT + ((s + 3) & 7) * 8192, 1);
                if ((s & 7) == 4) {
                    const int q = s >> 3;
#pragma unroll
                    for (int m = 0; m < 4; ++m) {
                        const int slot = ((LAS const int*)(lds + SLOTS))[it * 128 + rowm[m]]; const float gw = ((LAS const float*)(lds + GWO))[it * 128 + rowm[m]];
                        if (slot >= 0) {
                            bf16* cp = contrib + (size_t)slot * D + q * 256 + 128 * wc + 4 * fq;
#pragma unroll
                            for (int n = 0; n < 8; ++n) { const f32x4 v = acc[m][n] * gw; u32x2 w; w.x = cvtpk(v[0], v[1]); w.y = cvtpk(v[2], v[3]); *(u32x2*)(cp + 16 * n) = w; }
                        }
                    }
                }
                __syncthreads();
            }
        }
#undef M_COMPUTE
#undef M_ZERO
    }
#undef STAGE_SLOTS
}

__device__ __forceinline__ void phase_combine(const Args& a, int G) {
    const int tid = threadIdx.x, lane = tid & 63, wave = __builtin_amdgcn_readfirstlane(tid >> 6), blk = blockIdx.x;
    unsigned char* ws = a.ws;
    const bf16* X1 = (const bf16*)(ws + WS_X1); const bf16* contrib = (const bf16*)(ws + WS_CONTRIB); const float* fg = a.in[I_FG];
    for (int t = blk * NWAVES + wave; t < T; t += G * NWAVES) {
        const float* g2 = (const float*)(ws + WS_ADAF) + (t >> 13) * 6144 + 5 * 1024;
        f32x4 xv[2][2]; float ss = 0.f;
#pragma unroll
        for (int j = 0; j < 2; ++j) {
            const int c = 8 * lane + 512 * j;
            float sm[8] = {0.f, 0.f, 0.f, 0.f, 0.f, 0.f, 0.f, 0.f};
#pragma unroll
            for (int k = 0; k < NSLOT; ++k) {
                const u32x4 w = *(const u32x4*)(contrib + ((size_t)t * NSLOT + k) * D + c);
                sm[0] += bflo(w.x); sm[1] += bfhi(w.x); sm[2] += bflo(w.y); sm[3] += bfhi(w.y); sm[4] += bflo(w.z); sm[5] += bfhi(w.z); sm[6] += bflo(w.w); sm[7] += bfhi(w.w);
            }
            const u32x4 xw = *(const u32x4*)(X1 + (size_t)t * D + c);
#pragma unroll
            for (int h = 0; h < 2; ++h) {
                const f32x4 x1 = h == 0 ? (f32x4){bflo(xw.x), bfhi(xw.x), bflo(xw.y), bfhi(xw.y)} : (f32x4){bflo(xw.z), bfhi(xw.z), bflo(xw.w), bfhi(xw.w)};
                const f32x4 gg = *(const f32x4*)(g2 + c + 4 * h);
                const f32x4 mv = {sm[4 * h], sm[4 * h + 1], sm[4 * h + 2], sm[4 * h + 3]};
                const f32x4 v = x1 + gg * mv; xv[j][h] = v; ss += (v[0] * v[0] + v[1] * v[1]) + (v[2] * v[2] + v[3] * v[3]);
            }
        }
        const float r = rsqrtf(wave_sum(ss) * (1.f / D) + 1e-6f);
#pragma unroll
        for (int j = 0; j < 2; ++j)
#pragma unroll
            for (int h = 0; h < 2; ++h) { const int c = 8 * lane + 512 * j + 4 * h; *(f32x4*)(a.out + (size_t)t * D + c) = (xv[j][h] * r) * *(const f32x4*)(fg + c); }
    }
}

constexpr int NPH = 9;
#ifndef N_LAUNCHES
#define N_LAUNCHES 1
#endif
__global__ void __launch_bounds__(NWAVES * 64, 2) mega(Args a) {
    extern __shared__ __attribute__((aligned(16))) unsigned char lds_raw[];
    ldsp lds = (ldsp)lds_raw;
    const int tid = threadIdx.x, G = gridDim.x, bx = blockIdx.x;
    int vcu = (G % 8 == 0) ? (bx % 8) * (G / 8) + bx / 8 : bx;
    unsigned char* ws = a.ws;
    for (int u = tid; u < (LDS_BYTES - MISC_OFF) / 4; u += NWAVES * 64) ((LAS unsigned*)(lds + MISC_OFF))[u] = 0u;
    __syncthreads();
    volatile LAS unsigned* MISC = (volatile LAS unsigned*)(lds + MISC_OFF);
    XcdBarrier bar; bar.bar = (unsigned*)(ws + WS_CTL) + CW_BAR; bar.x = 0; bar.st = nullptr;
    if (N_LAUNCHES == 1) {
        bar = xcd_barrier_post((unsigned*)(ws + WS_CTL) + CW_BAR, MISC + 8);
        if (tid == 0) MISC[16] = atomicAdd((unsigned*)(ws + WS_CTL) + CW_XRANK + 64 * bar.x, 1u);
    }
    const int lo = a.ph_lo, hi = a.ph_hi;
#ifndef PH_MASK
#define PH_MASK 0x1ff
#endif
#define IN(k) (((PH_MASK >> (k)) & 1) && lo <= (k) && (k) < hi)
#define SEAM(k) do { if (IN(k) && IN((k) + 1)) xcd_barrier(bar); } while (0)
#ifndef PH_DUP
#define PH_DUP -1
#endif
#define REP(k) for (int rep_ = 0; rep_ < ((PH_DUP == (k)) ? 2 : 1); ++rep_)
    if (IN(0)) REP(0) { phase_prep(a, lds, G); } SEAM(0);
    if (N_LAUNCHES == 1 && IN(0) && IN(1)) {
        unsigned basex = 0;
        for (unsigned j = 0; j < bar.x; ++j) basex += xb_ld(&bar.bar[XB_XCNT(j)]);
        vcu = (int)(basex + MISC[16]);
    }
    if (IN(1)) REP(1) { phase_hnorm(a, lds, G); } SEAM(1);
    if (IN(2)) REP(2) {
        pg8::Gemm g{(const pg8::bf16_t*)(ws + WS_H), (const pg8::bf16_t*)(ws + WS_WINT), MH, DIN, D};
        WinOrder S; S.init(G, bx);
        EpiWin E{(bf16*)(ws + WS_Z), (bf16*)(ws + WS_KVC), (const float*)(ws + WS_ROPE)};
        pg8::gemm_phase<EpiWin, WinOrder, true, true>(lds, g, S, E);
    } SEAM(2);
    if (IN(3)) REP(3) { phase_mixers(a, lds, G, vcu); } SEAM(3);
    if (IN(4)) REP(4) {
        { pg8::Gemm g{(const pg8::bf16_t*)(ws + WS_A), (const pg8::bf16_t*)(ws + WS_WAT), T, D, 512};
          pg8::StaticOrder S; S.init(T, D, G, bx);
          EpiMergeA E{(const bf16*)(ws + WS_Z), (bf16*)(ws + WS_Y)};
          pg8::gemm_phase<EpiMergeA, pg8::StaticOrder, true, true>(lds, g, S, E); }
        { pg8::Gemm g{(const pg8::bf16_t*)(ws + WS_O), (const pg8::bf16_t*)(ws + WS_WBT), T, D, 512};
          pg8::StaticOrder S; S.init(T, D, G, bx);
          EpiMergeB E{(const bf16*)(ws + WS_Z), (bf16*)(ws + WS_Y)};
          pg8::gemm_phase<EpiMergeB, pg8::StaticOrder, true, true>(lds, g, S, E); }
    } SEAM(4);
    if (IN(5)) REP(5) {
        pg8::Gemm g{(const pg8::bf16_t*)(ws + WS_Y), (const pg8::bf16_t*)(ws + WS_WOT), T, D, D};
        pg8::StaticOrder S; S.init(T, D, G, bx);
        EpiWo E{a.in[I_X], (const float*)(ws + WS_ADAF), (bf16*)(ws + WS_X1)};
        pg8::gemm_phase<EpiWo, pg8::StaticOrder, true, true>(lds, g, S, E);
    } SEAM(5);
    if (IN(6)) { for (int it = vcu; it < T / 64; it += G) router_item(a, lds, it); } SEAM(6);
    if (IN(7)) REP(7) { phase_moe(a, lds, G, vcu); } SEAM(7);
    if (IN(8)) REP(8) { phase_combine(a, G); }
#undef IN
#undef SEAM
}

extern "C" void kernel_launch(void* const* d_in, const int* in_sizes, int n_in, void* d_out, int out_size, void* d_ws, size_t ws_size, hipStream_t stream) {
    static int grid = 0;
    if (grid == 0) {
        if (n_in != 26 || out_size != T * D || ws_size < WS_END) { fprintf(stderr, "kernel_launch: unexpected shapes (n_in %d, out %d, ws %zu)\n", n_in, out_size, ws_size); grid = -1; return; }
        int dev = 0, cus = 0, per_cu = 0;
        (void)hipGetDevice(&dev); (void)hipDeviceGetAttribute(&cus, hipDeviceAttributeMultiprocessorCount, dev);
        (void)hipFuncSetAttribute((const void*)mega, hipFuncAttributeMaxDynamicSharedMemorySize, LDS_BYTES);
        (void)hipOccupancyMaxActiveBlocksPerMultiprocessor(&per_cu, (const void*)mega, NWAVES * 64, LDS_BYTES);
        (void)hipGetLastError();
        if (per_cu < 1) { fprintf(stderr, "kernel_launch: occupancy query says %d blocks per CU\n", per_cu); per_cu = 1; }
        grid = cus;
    }
    if (grid < 0) return;
    (void)hipMemsetAsync((char*)d_ws + WS_CTL, 0, CTL_ZERO_BYTES, stream);
    Args a{};
    for (int i = 0; i < 26; ++i) a.in[i] = (const float*)d_in[i];
    a.out = (float*)d_out; a.ws = (unsigned char*)d_ws;
    if (N_LAUNCHES == 1) {
        a.ph_lo = 0; a.ph_hi = NPH;
        void* kargs[] = {&a};
        hipError_t e = hipLaunchCooperativeKernel((const void*)mega, dim3(grid), dim3(NWAVES * 64), kargs, LDS_BYTES, stream);
        if (e != hipSuccess) fprintf(stderr, "kernel_launch: cooperative launch failed: %s (grid %d)\n", hipGetErrorString(e), grid);
    } else {
#ifndef HOST_DUP
#define HOST_DUP -1
#endif
        for (int li = 0; li < NPH; ++li) {
            a.ph_lo = li; a.ph_hi = li + 1;
            hipLaunchKernelGGL(mega, dim3(grid), dim3(NWAVES * 64), LDS_BYTES, stream, a);
            if (li == HOST_DUP) {
                if (li == 6) (void)hipMemsetAsync((char*)d_ws + WS_CTL, 0, CTL_ZERO_BYTES, stream);
                hipLaunchKernelGGL(mega, dim3(grid), dim3(NWAVES * 64), LDS_BYTES, stream, a);
            }
        }
    }
}
```

```cpp
#include <hip/hip_runtime.h>
#include <cstdio>
#include <cstdint>
#include <type_traits>
namespace pg8 {
#define PG8_LAS __attribute__((address_space(3)))
typedef unsigned short bf16_t;
typedef short bf16x8 __attribute__((ext_vector_type(8)));
typedef float f32x4 __attribute__((ext_vector_type(4)));
typedef unsigned u32x4 __attribute__((ext_vector_type(4)));
constexpr int BM = 256, BK = 64, HALF = 128, HTB = HALF * BK * 2  , STAGE_BYTES = 8 * HTB, NXCD = 8, WGM = 8;

__host__ __device__ __forceinline__ int lds_byte(int r, int c) { const int st = (r >> 4) * 2 + (c >> 5), rr = r & 15, cc = c & 31, ob = rr * 64 + cc * 2; return st * 1024 + (ob ^ (((ob >> 9) & 1) << 5)); }
__host__ __device__ __forceinline__ void stage_rc(int b, int& R, int& C) { const int st = b / 1024, sb = b % 1024, swz = sb ^ (((sb >> 9) & 1) << 5); R = (st >> 1) * 16 + swz / 64; C = (st & 1) * 32 + (swz % 64) / 2; }
__host__ __device__ __forceinline__ int perm32(int rho) { const int n = rho >> 4, i = rho & 15; return 8 * (i >> 2) + 4 * n + (i & 3); }

struct Unit { int pm, pn; };
struct Gemm { const bf16_t* A; const bf16_t* Bt; int M, N, K; };

struct StaticOrder {
    int nM, nN, nwg, G, c;
    __host__ __device__ void init(int M, int N, int G_, int c_) { nM = M / BM; nN = N / BM; nwg = nM * nN; G = G_; c = c_; }
    __host__ __device__ bool next(int i, Unit& u) const {
        const long L = (long)i * G + c; if (L >= nwg) return false;
        int wgid = (int)L; { const int q = nwg / NXCD, r = nwg % NXCD, xcd = wgid % NXCD, off = wgid / NXCD; wgid = (xcd < r ? xcd * (q + 1) : r * (q + 1) + (xcd - r) * q) + off; }
        const int nig = WGM * nN, gid = wgid / nig, fm = gid * WGM, gsz = (nM - fm) < WGM ? (nM - fm) : WGM;
        u.pm = fm + ((wgid % nig) % gsz); u.pn = (wgid % nig) / gsz; return true;
    }
    __device__ __forceinline__ void a_ready(const Unit&) const {}
    __device__ __forceinline__ void done(const Unit&) const {}
};

__device__ __forceinline__ unsigned cvt_pk_bf16(float lo, float hi) { unsigned r; asm volatile("v_cvt_pk_bf16_f32 %0, %1, %2" : "=v"(r) : "v"(lo), "v"(hi)); return r; }
template <class Epi, class Sched, bool ALIGN_EPI = false, bool SP2 = false>
__device__ __forceinline__ void gemm_phase(PG8_LAS unsigned char* lds, const Gemm g, const Sched& S, const Epi& E) {
    const int tid = threadIdx.x, wid = __builtin_amdgcn_readfirstlane(tid >> 6), lane = tid & 63, wr = wid >> 2, wc = wid & 3, fr = lane & 15, fq = lane >> 4;
    const int K = g.K, nt = K / BK;
    unsigned voffA[2], voffB[2];
#pragma unroll
    for (int i = 0; i < 2; ++i) { int R, C; stage_rc(tid * 16 + i * 8192, R, C); const int Rb = Epi::PERM ? ((R & ~31) + perm32(R & 31)) : R;
        voffA[i] = (unsigned)(R * K + C) * 2u; voffB[i] = (unsigned)(Rb * K + C) * 2u; }
    const size_t kstep = (size_t)(BK * 2);
    const size_t hstep = (size_t)HALF * K * 2;
    const size_t tstep = 2 * hstep;
    const unsigned ldsw = (unsigned)wid * 1024u;
    const int aoff = lds_byte(wr * 64 + fr, fq * 8), boff = lds_byte(wc * 32 + fr, fq * 8);
#define PG8_SA(b, h) (((b) * 2 + (h)) * HTB)
#define PG8_SB(b, h) ((4 + (b) * 2 + (h)) * HTB)
#define PG8_STAGE(bufoff, gbase, voff) do { _Pragma("unroll") for (int _i = 0; _i < 2; ++_i) \
        __builtin_amdgcn_global_load_lds((const unsigned*)((const char*)(gbase) + (voff)[_i]), (PG8_LAS unsigned*)(lds + (bufoff) + ldsw + _i * 8192), 16, 0, 0); } while (0)
#define PG8_LDA(dst, b, h) do { _Pragma("unroll") for (int m = 0; m < 4; ++m) _Pragma("unroll") for (int k = 0; k < 2; ++k) dst[m][k] = *(const PG8_LAS bf16x8*)(lds + PG8_SA(b, h) + aoff + m * 2048 + k * 1024); } while (0)
#define PG8_LDB(dst, b, h) do { _Pragma("unroll") for (int n = 0; n < 2; ++n) _Pragma("unroll") for (int k = 0; k < 2; ++k) dst[n][k] = *(const PG8_LAS bf16x8*)(lds + PG8_SB(b, h) + boff + n * 2048 + k * 1024); } while (0)
#define PG8_MMA(ai, bj, At, Bt) do { __builtin_amdgcn_s_setprio(1); _Pragma("unroll") for (int m = 0; m < 4; ++m) _Pragma("unroll") for (int n = 0; n < 2; ++n) _Pragma("unroll") for (int k = 0; k < 2; ++k) \
        acc[ai][bj][m][n] = __builtin_amdgcn_mfma_f32_16x16x32_bf16(Bt[n][k], At[m][k], acc[ai][bj][m][n], 0, 0, 0); __builtin_amdgcn_s_setprio(0); } while (0)
#define PG8_WAIT_V(n) asm volatile("s_waitcnt vmcnt(" #n ")" ::: "memory")
#define PG8_WAIT_L(n) asm volatile("s_waitcnt lgkmcnt(" #n ")" ::: "memory")
#define PG8_BAR __builtin_amdgcn_s_barrier()
#define PG8_SCHED __builtin_amdgcn_sched_barrier(0)
    Unit cur, nxt; int ui = 0;
    if (!S.next(0, cur)) return;
    f32x4 acc[2][2][4][2];
#pragma unroll
    for (int a = 0; a < 2; ++a)
#pragma unroll
        for (int b = 0; b < 2; ++b)
#pragma unroll
            for (int m = 0; m < 4; ++m)
#pragma unroll
                for (int n = 0; n < 2; ++n) acc[a][b][m][n] = (f32x4){0.f, 0.f, 0.f, 0.f};
    bf16x8 At[4][2], B0[2][2], B1[2][2];
    const char* cA = (const char*)g.A + (size_t)cur.pm * tstep; const char* cB = (const char*)g.Bt + (size_t)cur.pn * tstep;
    S.a_ready(cur);
    if constexpr (SP2) {
        PG8_STAGE(PG8_SB(0, 0), cB, voffB); PG8_STAGE(PG8_SB(0, 1), cB + hstep, voffB); PG8_STAGE(PG8_SA(0, 0), cA, voffA); PG8_STAGE(PG8_SA(0, 1), cA + hstep, voffA);
        if (wr == 1) PG8_BAR;
        PG8_WAIT_V(2); PG8_BAR;
        PG8_STAGE(PG8_SB(1, 0), cB + kstep, voffB); PG8_STAGE(PG8_SA(1, 0), cA + kstep, voffA); PG8_STAGE(PG8_SB(1, 1), cB + hstep + kstep, voffB);
        PG8_WAIT_V(6); PG8_BAR;
    } else {
        PG8_STAGE(PG8_SB(0, 0), cB, voffB); PG8_STAGE(PG8_SA(0, 0), cA, voffA); PG8_STAGE(PG8_SB(0, 1), cB + hstep, voffB); PG8_STAGE(PG8_SA(0, 1), cA + hstep, voffA);
        if (wr == 1) PG8_BAR;
        PG8_WAIT_V(4); PG8_BAR;
        PG8_STAGE(PG8_SB(1, 0), cB + kstep, voffB); PG8_STAGE(PG8_SA(1, 0), cA + kstep, voffA); PG8_STAGE(PG8_SB(1, 1), cB + hstep + kstep, voffB);
        PG8_WAIT_V(6); PG8_BAR;
    }
    for (;;) {
        const bool has_next = S.next(ui + 1, nxt);
        const char* nA = has_next ? (const char*)g.A + (size_t)nxt.pm * tstep : cA; const char* nB = has_next ? (const char*)g.Bt + (size_t)nxt.pn * tstep : cB;
        for (int t = 0; t < nt; t += 2) {
            const bool last = (t == nt - 2);
            const char* a1 = cA + (size_t)(t + 1) * kstep;
            const char* a2 = last ? nA : cA + (size_t)(t + 2) * kstep; const char* b2 = last ? nB : cB + (size_t)(t + 2) * kstep;
            const char* a3 = a2 + kstep; const char* b3 = b2 + kstep;
            if (last && has_next) S.a_ready(nxt);
            if constexpr (SP2) {
            PG8_LDB(B0, 0, 0); PG8_LDB(B1, 0, 1); PG8_SCHED; PG8_LDA(At, 0, 0); PG8_STAGE(PG8_SA(1, 1), a1 + hstep, voffA);
            PG8_WAIT_V(8); PG8_WAIT_L(0); PG8_BAR; PG8_MMA(0, 0, At, B0); PG8_MMA(0, 1, At, B1); PG8_BAR; PG8_SCHED;
            PG8_LDA(At, 0, 1); PG8_STAGE(PG8_SB(0, 0), b2, voffB); PG8_STAGE(PG8_SB(0, 1), b2 + hstep, voffB); PG8_STAGE(PG8_SA(0, 0), a2, voffA);
            PG8_WAIT_V(8); PG8_WAIT_L(0); PG8_BAR; PG8_MMA(1, 0, At, B0); PG8_MMA(1, 1, At, B1); PG8_BAR; PG8_SCHED;
            PG8_LDB(B0, 1, 0); PG8_LDB(B1, 1, 1); PG8_SCHED; PG8_LDA(At, 1, 0); PG8_STAGE(PG8_SA(0, 1), a2 + hstep, voffA);
            PG8_WAIT_V(8); PG8_WAIT_L(0); PG8_BAR; PG8_MMA(0, 0, At, B0); PG8_MMA(0, 1, At, B1); PG8_BAR; PG8_SCHED;
            PG8_LDA(At, 1, 1); PG8_STAGE(PG8_SB(1, 0), b3, voffB); PG8_STAGE(PG8_SB(1, 1), b3 + hstep, voffB); PG8_STAGE(PG8_SA(1, 0), a3, voffA);
            PG8_WAIT_V(8); PG8_WAIT_L(0); PG8_BAR; PG8_MMA(1, 0, At, B0); PG8_MMA(1, 1, At, B1); PG8_BAR; PG8_SCHED;
            } else {
            PG8_LDB(B0, 0, 0); PG8_SCHED; PG8_LDA(At, 0, 0); PG8_STAGE(PG8_SA(1, 1), a1 + hstep, voffA);
            PG8_WAIT_L(8); PG8_BAR; PG8_WAIT_L(0); PG8_MMA(0, 0, At, B0); PG8_BAR; PG8_SCHED;
            PG8_LDB(B1, 0, 1); PG8_STAGE(PG8_SB(0, 0), b2, voffB);
            PG8_BAR; PG8_WAIT_L(0); PG8_MMA(0, 1, At, B1); PG8_BAR;
            PG8_LDA(At, 0, 1); PG8_STAGE(PG8_SA(0, 0), a2, voffA);
            PG8_BAR; PG8_WAIT_L(0); PG8_MMA(1, 0, At, B0); PG8_BAR; PG8_SCHED;
            PG8_STAGE(PG8_SB(0, 1), b2 + hstep, voffB);
            PG8_WAIT_V(6); PG8_BAR; PG8_MMA(1, 1, At, B1); PG8_BAR;
            PG8_LDB(B0, 1, 0); PG8_SCHED; PG8_LDA(At, 1, 0); PG8_STAGE(PG8_SA(0, 1), a2 + hstep, voffA);
            PG8_WAIT_L(8); PG8_BAR; PG8_WAIT_L(0); PG8_MMA(0, 0, At, B0); PG8_BAR; PG8_SCHED;
            PG8_LDB(B1, 1, 1); PG8_STAGE(PG8_SB(1, 0), b3, voffB);
            PG8_BAR; PG8_WAIT_L(0); PG8_MMA(0, 1, At, B1); PG8_BAR;
            PG8_LDA(At, 1, 1); PG8_STAGE(PG8_SA(1, 0), a3, voffA);
            PG8_BAR; PG8_WAIT_L(0); PG8_MMA(1, 0, At, B0); PG8_BAR; PG8_SCHED;
            PG8_STAGE(PG8_SB(1, 1), b3 + hstep, voffB);
            PG8_WAIT_V(6); PG8_BAR; PG8_MMA(1, 1, At, B1); PG8_BAR;
            }
        }
        if constexpr (ALIGN_EPI) { if (wr == 0) PG8_BAR; }
        if constexpr (!Epi::AFTER_DRAIN) { E(acc, cur, wr, wc, fr, fq); S.done(cur); }
        if (!has_next) break;
#pragma unroll
        for (int a = 0; a < 2; ++a)
#pragma unroll
            for (int b = 0; b < 2; ++b)
#pragma unroll
                for (int m = 0; m < 4; ++m)
#pragma unroll
                    for (int n = 0; n < 2; ++n) acc[a][b][m][n] = (f32x4){0.f, 0.f, 0.f, 0.f};
        cur = nxt; cA = nA; cB = nB; ++ui;
        if constexpr (ALIGN_EPI) { if (wr == 1) PG8_BAR; }
    }
    PG8_WAIT_V(0);
    if constexpr (!ALIGN_EPI) { if (wr == 0) PG8_BAR; }
    PG8_BAR;
    if constexpr (Epi::AFTER_DRAIN) { E.fused(acc, cur, wr, wc, fr, fq, lds, wid, lane); S.done(cur); }
#undef PG8_SA
#undef PG8_SB
#undef PG8_STAGE
#undef PG8_LDA
#undef PG8_LDB
#undef PG8_MMA
#undef PG8_WAIT_V
#undef PG8_WAIT_L
#undef PG8_BAR
#undef PG8_SCHED
}
}
#define GAS __attribute__((address_space(1)))
#define LAS __attribute__((address_space(3)))
typedef unsigned short bf16;
typedef unsigned v4u __attribute__((ext_vector_type(4)));
typedef float f32x4 __attribute__((ext_vector_type(4)));
typedef short bf16x8 __attribute__((ext_vector_type(8)));
typedef GAS unsigned gu32;
typedef GAS unsigned long long gu64;
#define RLX_AGENT __ATOMIC_RELAXED, __HIP_MEMORY_SCOPE_AGENT
#define LDS_WAIT() asm volatile("s_waitcnt lgkmcnt(0)" ::: "memory")
#define VM_WAIT() asm volatile("s_waitcnt vmcnt(0)" ::: "memory")
__device__ __forceinline__ unsigned long long rt() { return __builtin_amdgcn_s_memrealtime(); }
__device__ __forceinline__ unsigned f2bf(float f) { unsigned u = __builtin_bit_cast(unsigned, f); return (u + 0x7fffu + ((u >> 16) & 1u)) >> 16; }
__device__ __forceinline__ unsigned pk2(float lo, float hi) { return f2bf(lo) | (f2bf(hi) << 16); }

#define XB_TMO      128
#define XB_XCNT(j)  (256  + 64 * (j))
#define XB_XSUB(j)  (1280 + 64 * (j))
#define XB_XGEN(j)  (2304 + 64 * (j))
#define XB_TOP      3328
#define XB_TOPGEN   3392
#define XCD_BAR_WORDS 3456
#define XB_SPIN_CAP (1u << 18)

__device__ __forceinline__ unsigned xb_ld(unsigned* p)              { return __hip_atomic_load(p, __ATOMIC_RELAXED, __HIP_MEMORY_SCOPE_AGENT); }
__device__ __forceinline__ unsigned xb_add(unsigned* p, unsigned v) { return __hip_atomic_fetch_add(p, v, __ATOMIC_RELAXED, __HIP_MEMORY_SCOPE_AGENT); }
__device__ __forceinline__ unsigned xb_xcc_id() { return (unsigned)__builtin_amdgcn_s_getreg((3 << 11) | 20) & 0xFu; }
#define XB_SPIN(cond, bar) do { unsigned _sp = 0; while (cond) { __builtin_amdgcn_s_sleep(1); \
    if ((++_sp & 255u) == 0u) { if (xb_ld(&(bar)[XB_TMO])) break; if (_sp > XB_SPIN_CAP) { atomicAdd(&(bar)[XB_TMO], 1u); break; } } } } while (0)

struct XcdBarrier {
    unsigned* bar; unsigned x;
    volatile LAS unsigned* st;
};

__device__ __forceinline__ XcdBarrier xcd_barrier_post(unsigned* bar, volatile LAS unsigned* st) {
    XcdBarrier b; b.bar = bar; b.x = xb_xcc_id(); b.st = st;
    if (threadIdx.x == 0) (void)xb_add(&bar[XB_XCNT(b.x)], 1u);
    return b;
}
__device__ __forceinline__ void xcd_barrier_complete(unsigned* bar, unsigned x, unsigned& nloc, unsigned& nx) {
    const unsigned G = gridDim.x * gridDim.y * gridDim.z;
    unsigned sum, cnt, mine, sp = 0u;
    for (;;) {
        sum = 0u; cnt = 0u; mine = 0u;
#pragma unroll
        for (unsigned j = 0; j < 16; ++j) { const unsigned c = xb_ld(&bar[XB_XCNT(j)]); sum += c; cnt += (c > 0u) ? 1u : 0u; mine = (j == x) ? c : mine; }
        if (sum == G) break;
        __builtin_amdgcn_s_sleep(1);
        if ((++sp & 255u) == 0u) { if (xb_ld(&bar[XB_TMO])) break; if (sp > XB_SPIN_CAP) { atomicAdd(&bar[XB_TMO], 1u); break; } }
    }
    nloc = mine > 0u ? mine : 1u; nx = cnt > 0u ? cnt : 1u;
}

__device__ __forceinline__ void xcd_barrier(const XcdBarrier& b) {
    asm volatile("s_waitcnt vmcnt(0)" ::: "memory");
    __syncthreads();
    if (threadIdx.x == 0) {
        unsigned* bar = b.bar;
        __builtin_amdgcn_s_waitcnt(0);
        unsigned nloc = b.st[0], nx = b.st[1];
        if (nloc == 0u) { xcd_barrier_complete(bar, b.x, nloc, nx); b.st[0] = nloc; b.st[1] = nx; }
        const unsigned old = xb_add(&bar[XB_XSUB(b.x)], 1u);
        const unsigned gen = old / nloc;
        if (old + 1u == (gen + 1u) * nloc) {
            __builtin_amdgcn_fence(__ATOMIC_RELEASE, "agent");
            asm volatile("s_waitcnt vmcnt(0)" ::: "memory");
            const unsigned og = xb_add(&bar[XB_TOP], 1u);
            const unsigned tg = og / nx;
            if (og + 1u == (tg + 1u) * nx) xb_add(&bar[XB_TOPGEN], 1u);
            else XB_SPIN(xb_ld(&bar[XB_TOPGEN]) == tg, bar);
            __builtin_amdgcn_fence(__ATOMIC_ACQUIRE, "agent");
            xb_add(&bar[XB_XGEN(b.x)], 1u);
            asm volatile("s_waitcnt vmcnt(0)" ::: "memory");
        } else {
            XB_SPIN(xb_ld(&bar[XB_XGEN(b.x)]) == gen, bar);
            __builtin_amdgcn_fence(__ATOMIC_ACQUIRE, "agent");
            asm volatile("s_waitcnt vmcnt(0)" ::: "memory");
        }
    }
    __syncthreads();
}

constexpr int T = 16384, D = 1024, SEQ = 8192, NCTX = 256, TCX = 512, DIN = 3840, MH = T + TCX;
constexpr int ZU = 0, ZV = 512, ZQ = 1024, ZK = 1536, ZVA = 1664, ZGA = 1792, ZGB = 2816;
constexpr int NEXP = 256, NSLOT = 9, LISTCAP = 16384;
constexpr float LOG2E = 1.4426950408889634f;
constexpr float QSCALE = 0.125f * LOG2E;
constexpr size_t MiB = 1u << 20;
constexpr size_t WS_CTL = 0, CTL_ZERO_BYTES = 1 * MiB;
constexpr size_t WS_ADAP = 1 * MiB;
constexpr size_t WS_ADAF = 2 * MiB;
constexpr size_t WS_ROPE = 2 * MiB + 128 * 1024;
constexpr size_t WS_WST = 2 * MiB + 256 * 1024;
constexpr size_t WS_RWT = 3 * MiB;
constexpr size_t WS_WINT = 4 * MiB;
constexpr size_t WS_WAT = 12 * MiB, WS_WBT = 13 * MiB, WS_WOT = 14 * MiB;
constexpr size_t WS_KVC = 16 * MiB;
constexpr size_t WS_GATEW = 17 * MiB;
constexpr size_t WS_H = 18 * MiB;
constexpr size_t WS_Z = 52 * MiB;
constexpr size_t WS_A = 172 * MiB, WS_O = 188 * MiB;
constexpr size_t WS_TMP = 204 * MiB;
constexpr size_t WS_Y = 268 * MiB;
constexpr size_t WS_X1 = 300 * MiB;
constexpr size_t WS_H2 = 364 * MiB;
constexpr size_t WS_LIST = 396 * MiB;
constexpr size_t WS_CONTRIB = 414 * MiB;
constexpr size_t WS_END = 704 * MiB;
constexpr int CW_BAR = 4096;
constexpr int CW_CNT = 16384;
constexpr int CW_XRANK = 32768;
constexpr int SCR_BYTES = 148480;
constexpr int MISC_OFF = SCR_BYTES;
constexpr int LDS_BYTES = 152 * 1024;
constexpr int NWAVES = 8;

typedef float f32x2_t __attribute__((ext_vector_type(2)));
typedef __bf16 bf16x2_t __attribute__((ext_vector_type(2)));
typedef float f32x16 __attribute__((ext_vector_type(16)));
typedef short s16x4 __attribute__((ext_vector_type(4)));
typedef short v4i16_t __attribute__((ext_vector_type(4)));
typedef unsigned u32x2 __attribute__((ext_vector_type(2)));
typedef unsigned u32x4 __attribute__((ext_vector_type(4)));
typedef LAS unsigned char* ldsp;

__device__ __forceinline__ unsigned cvtpk(float lo, float hi) { f32x2_t v = {lo, hi}; bf16x2_t b = __builtin_convertvector(v, bf16x2_t); return __builtin_bit_cast(unsigned, b); }
__device__ __forceinline__ float bf2f(unsigned short u) { return __uint_as_float((unsigned)u << 16); }
__device__ __forceinline__ float bflo(unsigned w) { return __uint_as_float(w << 16); }
__device__ __forceinline__ float bfhi(unsigned w) { return __uint_as_float(w & 0xffff0000u); }
__device__ __forceinline__ float wave_sum(float v) {
#pragma unroll
    for (int o = 1; o < 64; o <<= 1) v += __shfl_xor(v, o);
    return v;
}
__device__ __forceinline__ float sigmoid_f(float x) { return __builtin_amdgcn_rcpf(1.f + __builtin_amdgcn_exp2f(-x * LOG2E)); }
__device__ __forceinline__ float silu_f(float x) { return x * sigmoid_f(x); }
__device__ __forceinline__ float gelu_f(float x) { const float u = 0.7978845608028654f * (x + 0.044715f * x * x * x); return x * sigmoid_f(2.f * u); }
__device__ __forceinline__ f32x16 mfma32(bf16x8 a, bf16x8 b, f32x16 c) { return __builtin_amdgcn_mfma_f32_32x32x16_bf16(a, b, c, 0, 0, 0); }
__device__ __forceinline__ f32x4 mfma16(bf16x8 a, bf16x8 b, f32x4 c) { return __builtin_amdgcn_mfma_f32_16x16x32_bf16(a, b, c, 0, 0, 0); }

struct Args { const float* in[26]; float* out; unsigned char* ws; int ph_lo, ph_hi; };
enum { I_X = 0, I_C, I_CTX, I_CCTX, I_ADAW, I_ADAB, I_N1G, I_N2G, I_WIN, I_LNG, I_LNB, I_GWS, I_GBS, I_SINK, I_WA, I_WB, I_WO, I_RW, I_RB, I_EG, I_EU, I_ED, I_SG, I_SU, I_SD, I_FG };

__device__ __forceinline__ void p0_transpose_item(const float* W, int K, int N, bf16* WT, LAS float* scr, int item, int lane) {
    const int nblk = N / 32, kb = item / nblk, nb = item % nblk, k0 = 64 * kb, n0 = 32 * nb;
#pragma unroll 8
    for (int i = 0; i < 32; ++i) { const int kk = 2 * i + (lane >> 5); scr[kk * 33 + (lane & 31)] = W[(size_t)(k0 + kk) * N + n0 + (lane & 31)]; }
    LDS_WAIT(); asm volatile("" ::: "memory");
    const int c = lane & 7;
#pragma unroll
    for (int j = 0; j < 4; ++j) { const int n = (lane >> 3) + 8 * j; const LAS float* s = scr + (8 * c) * 33 + n;
        v4u o; o.x = pk2(s[0 * 33], s[1 * 33]); o.y = pk2(s[2 * 33], s[3 * 33]); o.z = pk2(s[4 * 33], s[5 * 33]); o.w = pk2(s[6 * 33], s[7 * 33]);
        *(GAS v4u*)(WT + (size_t)(n0 + n) * K + k0 + 8 * c) = o; }
    LDS_WAIT(); asm volatile("" ::: "memory");
}

__device__ __forceinline__ void phase_prep(const Args& a, ldsp lds, int G) {
    const int tid = threadIdx.x, lane = tid & 63, wave = __builtin_amdgcn_readfirstlane(tid >> 6), blk = blockIdx.x;
    unsigned char* ws = a.ws;
    if (blk < 192) {
        const int cb = blk % 24, kc = blk / 24, col = cb * 256 + lane * 4, k0 = kc * 128 + wave * 16;
        const float* c = a.in[I_C]; const float* cc = a.in[I_CCTX]; const float* aw = a.in[I_ADAW];
        f32x4 a0 = {0.f, 0.f, 0.f, 0.f}, a1 = a0, a2 = a0;
#pragma unroll 4
        for (int k = 0; k < 16; ++k) {
            const int kk = k0 + k;
            const float s0 = silu_f(c[kk]), s1 = silu_f(c[1024 + kk]), s2 = silu_f(cc[kk]);
            const f32x4 w = *(const f32x4*)(aw + (size_t)kk * 6144 + col);
            a0 += w * s0; a1 += w * s1; a2 += w * s2;
        }
        LAS float* red = (LAS float*)lds;
        *(LAS f32x4*)(red + (wave * 3 + 0) * 256 + lane * 4) = a0;
        *(LAS f32x4*)(red + (wave * 3 + 1) * 256 + lane * 4) = a1;
        *(LAS f32x4*)(red + (wave * 3 + 2) * 256 + lane * 4) = a2;
        __syncthreads();
        float* adap = (float*)(ws + WS_ADAP);
        for (int idx = tid; idx < 768; idx += 512) {
            const int v = idx >> 8, cl = idx & 255; float s = 0.f;
#pragma unroll
            for (int w = 0; w < 8; ++w) s += red[(w * 3 + v) * 256 + cl];
            adap[(size_t)(kc * 3 + v) * 6144 + cb * 256 + cl] = s;
        }
        __syncthreads();
    }
    {
        LAS float* scr = (LAS float*)(lds + wave * 8704);
        const int gw = blk * NWAVES + wave, NGW = G * NWAVES;
        constexpr int I_1 = 16 * 120, I_2 = 8 * 32, I_3 = 8 * 32, I_4 = 16 * 32, I_5 = 16 * 8;
        for (int it = gw; it < I_1 + I_2 + I_3 + I_4 + I_5; it += NGW) {
            int r = it;
            if (r < I_1) { p0_transpose_item(a.in[I_WIN], 1024, 3840, (bf16*)(ws + WS_WINT), scr, r, lane); continue; } r -= I_1;
            if (r < I_2) { p0_transpose_item(a.in[I_WA], 512, 1024, (bf16*)(ws + WS_WAT), scr, r, lane); continue; } r -= I_2;
            if (r < I_3) { p0_transpose_item(a.in[I_WB], 512, 1024, (bf16*)(ws + WS_WBT), scr, r, lane); continue; } r -= I_3;
            if (r < I_4) { p0_transpose_item(a.in[I_WO], 1024, 1024, (bf16*)(ws + WS_WOT), scr, r, lane); continue; } r -= I_4;
            p0_transpose_item(a.in[I_RW], 1024, 256, (bf16*)(ws + WS_RWT), scr, r, lane);
        }
    }
    {
        const int gt = blk * 512 + tid, NT = G * 512;
        const float* gws = a.in[I_GWS]; bf16* wst = (bf16*)(ws + WS_WST);
        for (int i = gt; i < 8192; i += NT) {
            const f32x4 x0 = *(const f32x4*)(gws + i * 8), x1 = *(const f32x4*)(gws + i * 8 + 4);
            v4u o; o.x = cvtpk(x0[0], x0[1]); o.y = cvtpk(x0[2], x0[3]); o.z = cvtpk(x1[0], x1[1]); o.w = cvtpk(x1[2], x1[3]);
            *(v4u*)(wst + i * 8) = o;
        }
        float* rope = (float*)(ws + WS_ROPE);
        for (int i = gt; i < 2048; i += NT) {
            const int pos = i >> 4, f = i & 15;
            const float inv = __builtin_amdgcn_exp2f(-(float)f * (13.287712379549449f / 16.f));
            const float ang = (float)pos * inv;
            double rev = (double)ang * 0.15915494309189535; rev -= floor(rev);
            rope[pos * 32 + f] = __builtin_amdgcn_cosf((float)rev);
            rope[pos * 32 + 16 + f] = __builtin_amdgcn_sinf((float)rev);
        }
    }
}

__device__ __forceinline__ void phase_hnorm(const Args& a, ldsp lds, int G) {
    const int tid = threadIdx.x, lane = tid & 63, wave = __builtin_amdgcn_readfirstlane(tid >> 6), blk = blockIdx.x;
    unsigned char* ws = a.ws;
    const float* adap = (const float*)(ws + WS_ADAP); const float* adab = a.in[I_ADAB];
    LAS float* modv = (LAS float*)lds;
    for (int idx = tid; idx < 3 * 2048; idx += 512) {
        const int v = idx >> 11, j = idx & 2047; float s = adab[j];
#pragma unroll
        for (int kc = 0; kc < 8; ++kc) s += adap[(size_t)(kc * 3 + v) * 6144 + j];
        modv[idx] = (j >= 1024) ? s + 1.f : s;
    }
    { float* adaf = (float*)(ws + WS_ADAF);
      for (int idx = blk * 512 + tid; idx < 3 * 6144; idx += G * 512) {
          const int v = idx / 6144, j = idx % 6144; float s = adab[j];
#pragma unroll
          for (int kc = 0; kc < 8; ++kc) s += adap[(size_t)(kc * 3 + v) * 6144 + j];
          adaf[idx] = s; } }
    __syncthreads();
    const float* g1 = a.in[I_N1G]; bf16* H = (bf16*)(ws + WS_H);
    for (int t = blk * NWAVES + wave; t < MH; t += G * NWAVES) {
        const float* xr = (t < T) ? a.in[I_X] + (size_t)t * D : a.in[I_CTX] + (size_t)(t - T) * D;
        const int v = (t < T) ? (t >> 13) : 2;
        f32x4 x[4]; float ss = 0.f;
#pragma unroll
        for (int j = 0; j < 4; ++j) { x[j] = *(const f32x4*)(xr + 4 * lane + 256 * j); ss += (x[j][0] * x[j][0] + x[j][1] * x[j][1]) + (x[j][2] * x[j][2] + x[j][3] * x[j][3]); }
        const float r = rsqrtf(wave_sum(ss) * (1.f / D) + 1e-6f);
#pragma unroll
        for (int j = 0; j < 4; ++j) {
            const int col = 4 * lane + 256 * j;
            const f32x4 g = *(const f32x4*)(g1 + col);
            const f32x4 sh = *(LAS f32x4*)(modv + v * 2048 + col), sc = *(LAS f32x4*)(modv + v * 2048 + 1024 + col);
            const f32x4 h = (x[j] * r) * g * sc + sh;
            u32x2 o; o.x = cvtpk(h[0], h[1]); o.y = cvtpk(h[2], h[3]);
            *(u32x2*)(H + (size_t)t * D + col) = o;
        }
    }
}

struct WinOrder {
    pg8::StaticOrder so;
    __device__ void init(int G, int c) { so.init(T, DIN, G, c); }
    __device__ bool next(int i, pg8::Unit& u) const {
        const long L = (long)i * so.G + so.c;
        if (L < 960) return so.next(i, u);
        if (L < 962) { u.pm = 64 + (int)(L - 960); u.pn = 6; return true; }
        return false;
    }
    __device__ __forceinline__ void a_ready(const pg8::Unit&) const {}
    __device__ __forceinline__ void done(const pg8::Unit&) const {}
};
struct EpiWin {
    static constexpr bool PERM = false, AFTER_DRAIN = false;
    bf16* Z; bf16* KVC; const float* rope;
    __device__ __forceinline__ void operator()(const pg8::f32x4 (&acc)[2][2][4][2], const pg8::Unit& u, int wr, int wc, int fr, int fq) const {
        const int row0 = u.pm * 256 + wr * 64 + fr, colb = u.pn * 256 + wc * 32 + 4 * fq, pn = u.pn;
        if (u.pm >= 64) {
#pragma unroll
            for (int ai = 0; ai < 2; ++ai)
#pragma unroll
                for (int m = 0; m < 4; ++m) { bf16* rp = KVC + (size_t)(row0 + ai * 128 + m * 16 - T) * 256 + (colb - ZK);
#pragma unroll
                    for (int bj = 0; bj < 2; ++bj)
#pragma unroll
                        for (int n = 0; n < 2; ++n) { const pg8::f32x4 v = acc[ai][bj][m][n]; u32x2 o; o.x = cvtpk(v[0], v[1]); o.y = cvtpk(v[2], v[3]); *(u32x2*)(rp + bj * 128 + n * 16) = o; } }
            return;
        }
#pragma unroll
        for (int ai = 0; ai < 2; ++ai)
#pragma unroll
            for (int m = 0; m < 4; ++m) {
                const int r = row0 + ai * 128 + m * 16; bf16* rp = Z + (size_t)r * DIN + colb;
                if (pn <= 3) {
#pragma unroll
                    for (int bj = 0; bj < 2; ++bj)
#pragma unroll
                        for (int n = 0; n < 2; ++n) { const pg8::f32x4 v = acc[ai][bj][m][n]; u32x2 o; o.x = cvtpk(gelu_f(v[0]), gelu_f(v[1])); o.y = cvtpk(gelu_f(v[2]), gelu_f(v[3])); *(u32x2*)(rp + bj * 128 + n * 16) = o; }
                } else if (pn <= 6) {
                    const int pos = (wc & 1) ? (r & 63) : ((r & 8191) >> 6);
                    const pg8::f32x4 cs = *(const pg8::f32x4*)(rope + pos * 32 + 4 * fq), sn = *(const pg8::f32x4*)(rope + pos * 32 + 16 + 4 * fq);
                    const float sc = (pn < 6) ? QSCALE : 1.f;
#pragma unroll
                    for (int bj = 0; bj < 2; ++bj) {
                        const pg8::f32x4 x1 = acc[ai][bj][m][0], x2 = acc[ai][bj][m][1];
                        pg8::f32x4 o1, o2;
                        if (pn == 6 && bj == 1) { o1 = x1; o2 = x2; }
                        else { o1 = (x1 * cs - x2 * sn) * sc; o2 = (x2 * cs + x1 * sn) * sc; }
                        u32x2 w1, w2; w1.x = cvtpk(o1[0], o1[1]); w1.y = cvtpk(o1[2], o1[3]); w2.x = cvtpk(o2[0], o2[1]); w2.y = cvtpk(o2[2], o2[3]);
                        *(u32x2*)(rp + bj * 128) = w1; *(u32x2*)(rp + bj * 128 + 16) = w2;
                    }
                } else {
#pragma unroll
                    for (int bj = 0; bj < 2; ++bj)
#pragma unroll
                        for (int n = 0; n < 2; ++n) { const pg8::f32x4 v = acc[ai][bj][m][n]; u32x2 o; o.x = cvtpk(sigmoid_f(v[0]), sigmoid_f(v[1])); o.y = cvtpk(sigmoid_f(v[2]), sigmoid_f(v[3])); *(u32x2*)(rp + bj * 128 + n * 16) = o; }
                }
            }
    }
};
struct EpiMergeA {
    static constexpr bool PERM = true, AFTER_DRAIN = false;
    const bf16* Z; bf16* Y;
    __device__ __forceinline__ void operator()(const pg8::f32x4 (&acc)[2][2][4][2], const pg8::Unit& u, int wr, int wc, int fr, int fq) const {
        const int row0 = u.pm * 256 + wr * 64 + fr, col0 = u.pn * 256 + wc * 32 + 8 * fq;
#pragma unroll
        for (int ai = 0; ai < 2; ++ai)
#pragma unroll
            for (int m = 0; m < 4; ++m) { const int r = row0 + ai * 128 + m * 16;
#pragma unroll
                for (int bj = 0; bj < 2; ++bj) { const int c = col0 + bj * 128;
                    const u32x4 g = *(const u32x4*)(Z + (size_t)r * DIN + ZGA + c);
                    const pg8::f32x4 v0 = acc[ai][bj][m][0], v1 = acc[ai][bj][m][1];
                    u32x4 o;
                    o.x = cvtpk(v0[0] * bflo(g.x), v0[1] * bfhi(g.x)); o.y = cvtpk(v0[2] * bflo(g.y), v0[3] * bfhi(g.y));
                    o.z = cvtpk(v1[0] * bflo(g.z), v1[1] * bfhi(g.z)); o.w = cvtpk(v1[2] * bflo(g.w), v1[3] * bfhi(g.w));
                    *(u32x4*)(Y + (size_t)r * D + c) = o; } }
    }
};
struct EpiMergeB {
    static constexpr bool PERM = true, AFTER_DRAIN = false;
    const bf16* Z; bf16* Y;
    __device__ __forceinline__ void operator()(const pg8::f32x4 (&acc)[2][2][4][2], const pg8::Unit& u, int wr, int wc, int fr, int fq) const {
        const int row0 = u.pm * 256 + wr * 64 + fr, col0 = u.pn * 256 + wc * 32 + 8 * fq;
#pragma unroll
        for (int ai = 0; ai < 2; ++ai)
#pragma unroll
            for (int m = 0; m < 4; ++m) { const int r = row0 + ai * 128 + m * 16;
#pragma unroll
                for (int bj = 0; bj < 2; ++bj) { const int c = col0 + bj * 128;
                    const u32x4 g = *(const u32x4*)(Z + (size_t)r * DIN + ZGB + c);
                    const u32x4 tp = *(const u32x4*)(Y + (size_t)r * D + c);
                    const pg8::f32x4 t0 = {bflo(tp.x), bfhi(tp.x), bflo(tp.y), bfhi(tp.y)}, t1 = {bflo(tp.z), bfhi(tp.z), bflo(tp.w), bfhi(tp.w)};
                    const pg8::f32x4 v0 = acc[ai][bj][m][0], v1 = acc[ai][bj][m][1];
                    u32x4 o;
                    o.x = cvtpk(t0[0] + v0[0] * bflo(g.x), t0[1] + v0[1] * bfhi(g.x)); o.y = cvtpk(t0[2] + v0[2] * bflo(g.y), t0[3] + v0[3] * bfhi(g.y));
                    o.z = cvtpk(t1[0] + v1[0] * bflo(g.z), t1[1] + v1[1] * bfhi(g.z)); o.w = cvtpk(t1[2] + v1[2] * bflo(g.w), t1[3] + v1[3] * bfhi(g.w));
                    *(u32x4*)(Y + (size_t)r * D + c) = o; } }
    }
};
struct EpiWo {
    static constexpr bool PERM = true, AFTER_DRAIN = false;
    const float* x; const float* adaf; bf16* X1;
    __device__ __forceinline__ void operator()(const pg8::f32x4 (&acc)[2][2][4][2], const pg8::Unit& u, int wr, int wc, int fr, int fq) const {
        const int row0 = u.pm * 256 + wr * 64 + fr, col0 = u.pn * 256 + wc * 32 + 8 * fq;
        const float* g1 = adaf + (u.pm >= 32 ? 6144 : 0) + 2048;
#pragma unroll
        for (int bj = 0; bj < 2; ++bj) { const int c = col0 + bj * 128;
            const pg8::f32x4 ga = *(const pg8::f32x4*)(g1 + c), gb = *(const pg8::f32x4*)(g1 + c + 4);
#pragma unroll
            for (int ai = 0; ai < 2; ++ai)
#pragma unroll
                for (int m = 0; m < 4; ++m) { const int r = row0 + ai * 128 + m * 16;
                    const pg8::f32x4 x0 = *(const pg8::f32x4*)(x + (size_t)r * D + c), x1 = *(const pg8::f32x4*)(x + (size_t)r * D + c + 4);
                    const pg8::f32x4 o0 = x0 + ga * acc[ai][bj][m][0], o1 = x1 + gb * acc[ai][bj][m][1];
                    u32x4 w; w.x = cvtpk(o0[0], o0[1]); w.y = cvtpk(o0[2], o0[3]); w.z = cvtpk(o1[0], o1[1]); w.w = cvtpk(o1[2], o1[3]);
                    *(u32x4*)(X1 + (size_t)r * D + c) = w; } }
    }
};


__device__ __forceinline__ s16x4 vtr(LAS const unsigned char* p) { return __builtin_bit_cast(s16x4, __builtin_amdgcn_ds_read_tr16_b64_v4i16((LAS v4i16_t*)p)); }

__device__ __forceinline__ void attn_item(const bf16* Z, const bf16* KVC, const float* sink, bf16* Obuf, ldsp lds, int b, int nb, int hk, int qh) {
    const int tid = threadIdx.x, lane = tid & 63, wave = __builtin_amdgcn_readfirstlane(tid >> 6), r32 = lane & 31, hi = lane >> 5;
    const int rq = wave >> 1, head = hk * 4 + rq;
    const int iq = qh * 64 + (wave & 1) * 32 + r32;
    const int wlo = (nb == 0) ? 2 : qh, whi = (nb == 63) ? 4 : 5 + qh, nwin = whi - wlo, ntile = nwin + 4;
    const int tokq = b * SEQ + nb * 128 + iq;
    bf16x8 qr[4];
#pragma unroll
    for (int d0 = 0; d0 < 4; ++d0) qr[d0] = *(const bf16x8*)(Z + (size_t)tokq * DIN + ZQ + head * 64 + d0 * 16 + hi * 8);
    float mrun = sink[head] * LOG2E, lrun = (hi == 0) ? 1.f : 0.f;
    f32x16 o[2];
#pragma unroll
    for (int j = 0; j < 2; ++j)
#pragma unroll
        for (int r = 0; r < 16; ++r) o[j][r] = 0.f;
    const int kdst = wave * 1024 + lane * 16, vdst = 8192 + (wave >> 2) * 4096 + lane * 64 + (wave & 3) * 16;
#define ATT_SRC(s, kp, vp) do { const int tl_ = (s) < nwin ? wlo + (s) : 6 + (s) - nwin; \
        if (tl_ < 6) { const int tok_ = b * SEQ + (nb - 1 + (tl_ >> 1)) * 128 + (tl_ & 1) * 64 + lane; kp = Z + (size_t)tok_ * DIN + ZK + hk * 64 + wave * 8; vp = Z + (size_t)tok_ * DIN + ZVA + hk * 64 + wave * 8; } \
        else { const int row_ = b * NCTX + (tl_ - 6) * 64 + lane; kp = KVC + (size_t)row_ * 256 + hk * 64 + wave * 8; vp = KVC + (size_t)row_ * 256 + 128 + hk * 64 + wave * 8; } } while (0)
    u32x4 kreg, vreg;
    { const bf16 *kp, *vp; ATT_SRC(0, kp, vp); kreg = *(const u32x4*)kp; vreg = *(const u32x4*)vp; }
    *(LAS u32x4*)(lds + kdst) = kreg; *(LAS u32x4*)(lds + vdst) = vreg;
    __syncthreads();
    const int vrd = ((lane & 15) >> 2) * 64 + ((lane >> 4) & 1) * 32 + (lane & 3) * 8 + hi * 256;
    for (int s = 0; s < ntile; ++s) {
        const int base = (s & 1) * 16384;
        const int tl = s < nwin ? wlo + s : 6 + s - nwin;
        if (s + 1 < ntile) { const bf16 *kp, *vp; ATT_SRC(s + 1, kp, vp); kreg = *(const u32x4*)kp; vreg = *(const u32x4*)vp; }
        {
            f32x16 p0, p1;
#pragma unroll
            for (int r = 0; r < 16; ++r) { p0[r] = 0.f; p1[r] = 0.f; }
#pragma unroll
            for (int d0 = 0; d0 < 4; ++d0) {
                const bf16x8 k0 = *(LAS const bf16x8*)(lds + base + (2 * d0 + hi) * 1024 + r32 * 16);
                const bf16x8 k1 = *(LAS const bf16x8*)(lds + base + (2 * d0 + hi) * 1024 + (r32 + 32) * 16);
                p0 = mfma32(k0, qr[d0], p0); p1 = mfma32(k1, qr[d0], p1);
            }
            if (tl < 2) {
                const int j0 = (tl & 1) * 64 + 4 * hi;
#pragma unroll
                for (int r = 0; r < 16; ++r) { const int j = j0 + (r & 3) + 8 * (r >> 2); if (j < iq) p0[r] = -INFINITY; if (j + 32 < iq) p1[r] = -INFINITY; }
            } else if (tl == 4 || tl == 5) {
                const int j0 = (tl & 1) * 64 + 4 * hi;
#pragma unroll
                for (int r = 0; r < 16; ++r) { const int j = j0 + (r & 3) + 8 * (r >> 2); if (j > iq) p0[r] = -INFINITY; if (j + 32 > iq) p1[r] = -INFINITY; }
            }
            float mx = fmaxf(p0[0], p1[0]);
#pragma unroll
            for (int r = 1; r < 16; ++r) mx = fmaxf(mx, fmaxf(p0[r], p1[r]));
            mx = fmaxf(mx, __shfl_xor(mx, 32));
            const float mn = fmaxf(mrun, mx), alpha = __builtin_amdgcn_exp2f(mrun - mn);
            mrun = mn;
            float rs = 0.f;
#pragma unroll
            for (int r = 0; r < 16; ++r) { p0[r] = __builtin_amdgcn_exp2f(p0[r] - mn); p1[r] = __builtin_amdgcn_exp2f(p1[r] - mn); rs += p0[r] + p1[r]; }
            lrun = lrun * alpha + rs;
#pragma unroll
            for (int r = 0; r < 16; ++r) { o[0][r] *= alpha; o[1][r] *= alpha; }
            bf16x8 pf[4];
#pragma unroll
            for (int s4 = 0; s4 < 4; ++s4) {
                u32x4 w;
                if (s4 < 2) { w.x = cvtpk(p0[8 * s4 + 0], p0[8 * s4 + 1]); w.y = cvtpk(p0[8 * s4 + 2], p0[8 * s4 + 3]); w.z = cvtpk(p0[8 * s4 + 4], p0[8 * s4 + 5]); w.w = cvtpk(p0[8 * s4 + 6], p0[8 * s4 + 7]); }
                else { const int q = s4 - 2; w.x = cvtpk(p1[8 * q + 0], p1[8 * q + 1]); w.y = cvtpk(p1[8 * q + 2], p1[8 * q + 3]); w.z = cvtpk(p1[8 * q + 4], p1[8 * q + 5]); w.w = cvtpk(p1[8 * q + 6], p1[8 * q + 7]); }
                pf[s4] = __builtin_bit_cast(bf16x8, w);
            }
#pragma unroll
            for (int dblk = 0; dblk < 2; ++dblk)
#pragma unroll
                for (int s4 = 0; s4 < 4; ++s4) {
                    const s16x4 lo = vtr(lds + base + 8192 + dblk * 4096 + vrd + (16 * s4) * 64);
                    const s16x4 hh = vtr(lds + base + 8192 + dblk * 4096 + vrd + (16 * s4 + 8) * 64);
                    const bf16x8 vf = {lo[0], lo[1], lo[2], lo[3], hh[0], hh[1], hh[2], hh[3]};
                    o[dblk] = mfma32(vf, pf[s4], o[dblk]);
                }
        }
        if (s + 1 < ntile) { *(LAS u32x4*)(lds + (16384 - base) + kdst) = kreg; *(LAS u32x4*)(lds + (16384 - base) + vdst) = vreg; }
        __syncthreads();
    }
#undef ATT_SRC
    {
        const float lt = lrun + __shfl_xor(lrun, 32), inv = 1.f / lt;
        bf16* op = Obuf + (size_t)tokq * 512 + head * 64;
#pragma unroll
        for (int dblk = 0; dblk < 2; ++dblk)
#pragma unroll
            for (int r4 = 0; r4 < 4; ++r4) {
                u32x2 w; w.x = cvtpk(o[dblk][4 * r4] * inv, o[dblk][4 * r4 + 1] * inv); w.y = cvtpk(o[dblk][4 * r4 + 2] * inv, o[dblk][4 * r4 + 3] * inv);
                *(u32x2*)(op + 32 * dblk + 8 * r4 + 4 * hi) = w;
            }
    }
}

__device__ __forceinline__ void gmlp_item(const bf16* Z, const float* lng, const float* lnb, const bf16* WsT, const float* bs, bf16* Abuf, ldsp lds, int ch, int gp) {
    const int tid = threadIdx.x, lane = tid & 63, wave = __builtin_amdgcn_readfirstlane(tid >> 6), fr = lane & 15, fq = lane >> 4;
    const int tok0 = ch * 128;
    LAS bf16* VT = (LAS bf16*)lds;
    f32x4 gA = *(const f32x4*)(lng + lane * 8), gB = *(const f32x4*)(lng + lane * 8 + 4), bA = *(const f32x4*)(lnb + lane * 8), bB = *(const f32x4*)(lnb + lane * 8 + 4);
#pragma unroll
    for (int rnd = 0; rnd < 2; ++rnd) {
        float y[8][8];
#pragma unroll
        for (int j = 0; j < 8; ++j) {
            const int tok = tok0 + wave * 16 + rnd * 8 + j;
            const u32x4 raw = *(const u32x4*)(Z + (size_t)tok * DIN + ZV + lane * 8);
            float x[8] = {bflo(raw.x), bfhi(raw.x), bflo(raw.y), bfhi(raw.y), bflo(raw.z), bfhi(raw.z), bflo(raw.w), bfhi(raw.w)};
            float s = 0.f;
#pragma unroll
            for (int i = 0; i < 8; ++i) s += x[i];
            const float mu = wave_sum(s) * (1.f / 512.f);
            float q = 0.f;
#pragma unroll
            for (int i = 0; i < 8; ++i) { x[i] -= mu; q += x[i] * x[i]; }
            const float rstd = rsqrtf(wave_sum(q) * (1.f / 512.f) + 1e-6f);
            y[j][0] = x[0] * rstd * gA[0] + bA[0]; y[j][1] = x[1] * rstd * gA[1] + bA[1]; y[j][2] = x[2] * rstd * gA[2] + bA[2]; y[j][3] = x[3] * rstd * gA[3] + bA[3];
            y[j][4] = x[4] * rstd * gB[0] + bB[0]; y[j][5] = x[5] * rstd * gB[1] + bB[1]; y[j][6] = x[6] * rstd * gB[2] + bB[2]; y[j][7] = x[7] * rstd * gB[3] + bB[3];
        }
        if ((lane >> 5) == gp) {
            const int gl = (lane >> 4) & 1;
#pragma unroll
            for (int i = 0; i < 8; ++i) {
                u32x4 w; w.x = cvtpk(y[0][i], y[1][i]); w.y = cvtpk(y[2][i], y[3][i]); w.z = cvtpk(y[4][i], y[5][i]); w.w = cvtpk(y[6][i], y[7][i]);
                *(LAS u32x4*)(VT + gl * (128 * 136) + (8 * (lane & 15) + i) * 136 + wave * 16 + rnd * 8) = w;
            }
        }
    }
    __syncthreads();
    const int wm = wave >> 1, wn = wave & 1;
#pragma unroll
    for (int gl = 0; gl < 2; ++gl) {
        const int g = 2 * gp + gl;
        f32x4 acc[2][4];
#pragma unroll
        for (int m = 0; m < 2; ++m)
#pragma unroll
            for (int n = 0; n < 4; ++n) acc[m][n] = (f32x4){0.f, 0.f, 0.f, 0.f};
#pragma unroll
        for (int ks = 0; ks < 4; ++ks) {
            bf16x8 af[2], bfr[4];
#pragma unroll
            for (int m = 0; m < 2; ++m) af[m] = *(const bf16x8*)(WsT + (size_t)g * 16384 + (32 * wm + 16 * m + fr) * 128 + 32 * ks + 8 * fq);
#pragma unroll
            for (int n = 0; n < 4; ++n) bfr[n] = *(LAS const bf16x8*)(VT + gl * (128 * 136) + (64 * wn + 16 * n + fr) * 136 + 32 * ks + 8 * fq);
#pragma unroll
            for (int m = 0; m < 2; ++m)
#pragma unroll
                for (int n = 0; n < 4; ++n) acc[m][n] = mfma16(bfr[n], af[m], acc[m][n]);
        }
#pragma unroll
        for (int m = 0; m < 2; ++m) {
            const int p = 32 * wm + 16 * m + fr, tok = tok0 + p; const float bias = bs[g * 128 + p];
#pragma unroll
            for (int n = 0; n < 4; ++n) {
                const int c = g * 128 + 64 * wn + 16 * n + 4 * fq;
                const u32x2 uw = *(const u32x2*)(Z + (size_t)tok * DIN + ZU + c);
                u32x2 w; w.x = cvtpk(bflo(uw.x) * (acc[m][n][0] + bias), bfhi(uw.x) * (acc[m][n][1] + bias)); w.y = cvtpk(bflo(uw.y) * (acc[m][n][2] + bias), bfhi(uw.y) * (acc[m][n][3] + bias));
                *(u32x2*)(Abuf + (size_t)tok * 512 + c) = w;
            }
        }
    }
    __syncthreads();
}

__device__ __forceinline__ void phase_mixers(const Args& a, ldsp lds, int G, int vcu) {
    unsigned char* ws = a.ws;
    const bf16* Z = (const bf16*)(ws + WS_Z);
    for (int it = vcu; it < 512; it += G) {
        const int qh = it & 1, hk = (it >> 1) & 1, nb = (it >> 2) & 63, b = it >> 8;
        attn_item(Z, (const bf16*)(ws + WS_KVC), a.in[I_SINK], (bf16*)(ws + WS_O), lds, b, nb, hk, qh);
    }
    for (int it = vcu; it < 256; it += G) {
        gmlp_item(Z, a.in[I_LNG], a.in[I_LNB], (const bf16*)(ws + WS_WST), a.in[I_GBS], (bf16*)(ws + WS_A), lds, it >> 1, it & 1);
    }
}

#define KI_BEFORE(ka, ia, kb, ib) (((ka) > (kb)) || ((ka) == (kb) && (ia) < (ib)))
#define KI_CAS(K, I, p, q) do { const bool sw_ = KI_BEFORE(K[q], I[q], K[p], I[p]); const float kp_ = sw_ ? K[q] : K[p], kq_ = sw_ ? K[p] : K[q]; const int ip_ = sw_ ? I[q] : I[p], iq_ = sw_ ? I[p] : I[q]; \
        K[p] = kp_; I[p] = ip_; K[q] = kq_; I[q] = iq_; } while (0)
#define KI_SORT8(K, I) do { KI_CAS(K, I, 0, 1); KI_CAS(K, I, 2, 3); KI_CAS(K, I, 4, 5); KI_CAS(K, I, 6, 7); \
        KI_CAS(K, I, 0, 2); KI_CAS(K, I, 1, 3); KI_CAS(K, I, 4, 6); KI_CAS(K, I, 5, 7); \
        KI_CAS(K, I, 1, 2); KI_CAS(K, I, 5, 6); KI_CAS(K, I, 0, 4); KI_CAS(K, I, 3, 7); \
        KI_CAS(K, I, 1, 5); KI_CAS(K, I, 2, 6); KI_CAS(K, I, 1, 4); KI_CAS(K, I, 3, 6); \
        KI_CAS(K, I, 2, 4); KI_CAS(K, I, 3, 5); KI_CAS(K, I, 3, 4); } while (0)
#define KI_MERGE8(KA, IA, KB, IB) do { \
        _Pragma("unroll") for (int r_ = 0; r_ < 8; ++r_) { const bool tb_ = KI_BEFORE(KB[7 - r_], IB[7 - r_], KA[r_], IA[r_]); KA[r_] = tb_ ? KB[7 - r_] : KA[r_]; IA[r_] = tb_ ? IB[7 - r_] : IA[r_]; } \
        KI_CAS(KA, IA, 0, 4); KI_CAS(KA, IA, 1, 5); KI_CAS(KA, IA, 2, 6); KI_CAS(KA, IA, 3, 7); \
        KI_CAS(KA, IA, 0, 2); KI_CAS(KA, IA, 1, 3); KI_CAS(KA, IA, 4, 6); KI_CAS(KA, IA, 5, 7); \
        KI_CAS(KA, IA, 0, 1); KI_CAS(KA, IA, 2, 3); KI_CAS(KA, IA, 4, 5); KI_CAS(KA, IA, 6, 7); } while (0)
__device__ __forceinline__ void router_item(const Args& a, ldsp lds, int it) {
    const int tid = threadIdx.x, lane = tid & 63, wave = __builtin_amdgcn_readfirstlane(tid >> 6), fr = lane & 15, fq = lane >> 4;
    unsigned char* ws = a.ws;
    const int t0 = it * 64, b = t0 >> 13;
    const bf16* X1 = (const bf16*)(ws + WS_X1); const float* adaf = (const float*)(ws + WS_ADAF) + b * 6144;
    const float* g2 = a.in[I_N2G]; bf16* H2 = (bf16*)(ws + WS_H2);
    {
        f32x4 gm[2][2], sh[2][2];
#pragma unroll
        for (int j = 0; j < 2; ++j)
#pragma unroll
            for (int h = 0; h < 2; ++h) {
                const int c = 8 * lane + 512 * j + 4 * h;
                const f32x4 gg = *(const f32x4*)(g2 + c), sc = *(const f32x4*)(adaf + 4 * 1024 + c);
                gm[j][h] = gg * (sc + 1.f); sh[j][h] = *(const f32x4*)(adaf + 3 * 1024 + c);
            }
#pragma unroll
        for (int half = 0; half < 2; ++half) {
            f32x4 x[4][2][2];
#pragma unroll
            for (int tt = 0; tt < 4; ++tt)
#pragma unroll
                for (int j = 0; j < 2; ++j) {
                    const u32x4 w = *(const u32x4*)(X1 + (size_t)(t0 + wave * 8 + half * 4 + tt) * D + 8 * lane + 512 * j);
                    x[tt][j][0] = (f32x4){bflo(w.x), bfhi(w.x), bflo(w.y), bfhi(w.y)}; x[tt][j][1] = (f32x4){bflo(w.z), bfhi(w.z), bflo(w.w), bfhi(w.w)};
                }
#pragma unroll
            for (int tt = 0; tt < 4; ++tt) {
                const int row = wave * 8 + half * 4 + tt, tok = t0 + row;
                float ss = 0.f;
#pragma unroll
                for (int j = 0; j < 2; ++j)
#pragma unroll
                    for (int h = 0; h < 2; ++h) { const f32x4 v = x[tt][j][h]; ss += (v[0] * v[0] + v[1] * v[1]) + (v[2] * v[2] + v[3] * v[3]); }
                const float r = rsqrtf(wave_sum(ss) * (1.f / D) + 1e-6f);
#pragma unroll
                for (int j = 0; j < 2; ++j) {
                    const f32x4 h0 = (x[tt][j][0] * r) * gm[j][0] + sh[j][0], h1 = (x[tt][j][1] * r) * gm[j][1] + sh[j][1];
                    u32x4 w; w.x = cvtpk(h0[0], h0[1]); w.y = cvtpk(h0[2], h0[3]); w.z = cvtpk(h1[0], h1[1]); w.w = cvtpk(h1[2], h1[3]);
                    *(u32x4*)(H2 + (size_t)tok * D + 8 * lane + 512 * j) = w;
                    const int kc = lane + 64 * j;
                    *(LAS u32x4*)(lds + kc * 1024 + ((row ^ (kc & 7)) * 16)) = w;
                }
            }
        }
    }
    __syncthreads();
    f32x4 acc[4][2];
#pragma unroll
    for (int m = 0; m < 4; ++m)
#pragma unroll
        for (int n = 0; n < 2; ++n) acc[m][n] = (f32x4){0.f, 0.f, 0.f, 0.f};
    const bf16* RwT = (const bf16*)(ws + WS_RWT) + (size_t)(32 * wave + fr) * D + 8 * fq;
#pragma unroll 8
    for (int ks = 0; ks < 32; ++ks) {
        const int kc = 4 * ks + fq;
        bf16x8 af[4], bfr[2];
#pragma unroll
        for (int n = 0; n < 2; ++n) bfr[n] = *(const bf16x8*)(RwT + (size_t)(16 * n) * D + 32 * ks);
#pragma unroll
        for (int m = 0; m < 4; ++m) af[m] = *(LAS const bf16x8*)(lds + kc * 1024 + (((16 * m + fr) ^ (kc & 7)) * 16));
#pragma unroll
        for (int m = 0; m < 4; ++m)
#pragma unroll
            for (int n = 0; n < 2; ++n) acc[m][n] = mfma16(af[m], bfr[n], acc[m][n]);
    }
    __syncthreads();
    LAS float* LG = (LAS float*)lds;
#pragma unroll
    for (int m = 0; m < 4; ++m)
#pragma unroll
        for (int n = 0; n < 2; ++n)
#pragma unroll
            for (int reg = 0; reg < 4; ++reg) LG[(32 * wave + 16 * n + fr) * 65 + 16 * m + 4 * fq + reg] = acc[m][n][reg];
    __syncthreads();
    LAS float* CK = (LAS float*)(lds + 69632); LAS int* CI = (LAS int*)(lds + 69632 + 16384);
    const float* rb = a.in[I_RB];
    float bk[8]; int bi[8];
#pragma unroll
    for (int q = 0; q < 4; ++q) {
        float gk[8]; int gi[8];
#pragma unroll
        for (int j = 0; j < 8; ++j) { const int e = 32 * wave + 8 * q + j; gk[j] = sigmoid_f(LG[e * 65 + lane]) + rb[e]; gi[j] = e; }
        KI_SORT8(gk, gi);
        if (q == 0) {
#pragma unroll
            for (int j = 0; j < 8; ++j) { bk[j] = gk[j]; bi[j] = gi[j]; }
        } else KI_MERGE8(bk, bi, gk, gi);
    }
#pragma unroll
    for (int r = 0; r < 8; ++r) { CK[(wave * 8 + r) * 64 + lane] = bk[r]; CI[(wave * 8 + r) * 64 + lane] = bi[r]; }
    __syncthreads();
#define RT_LEVEL(lvl) do { if ((wave & (2 * (lvl) - 1)) == 0) { float ok_[8]; int oi_[8]; \
            _Pragma("unroll") for (int r = 0; r < 8; ++r) { ok_[r] = CK[((wave + (lvl)) * 8 + r) * 64 + lane]; oi_[r] = CI[((wave + (lvl)) * 8 + r) * 64 + lane]; } \
            KI_MERGE8(bk, bi, ok_, oi_); \
            if ((lvl) < 4) { _Pragma("unroll") for (int r = 0; r < 8; ++r) { CK[(wave * 8 + r) * 64 + lane] = bk[r]; CI[(wave * 8 + r) * 64 + lane] = bi[r]; } } } \
        __syncthreads(); } while (0)
    RT_LEVEL(1); RT_LEVEL(2); RT_LEVEL(4);
#undef RT_LEVEL
    LAS unsigned* hist = (LAS unsigned*)(lds + 102400); LAS unsigned* hbase = hist + 256;
    if (tid < 256) hist[tid] = 0u;
    __syncthreads();
    unsigned* cnt = (unsigned*)(ws + WS_CTL) + CW_CNT; int* list = (int*)(ws + WS_LIST); float* gatew = (float*)(ws + WS_GATEW);
    unsigned rank[8];
    if (wave == 0) {
        const int tok = t0 + lane;
        float sel[8], ssum = 0.f;
#pragma unroll
        for (int r = 0; r < 8; ++r) { sel[r] = sigmoid_f(LG[bi[r] * 65 + lane]); ssum += sel[r]; }
#pragma unroll
        for (int r = 0; r < 8; ++r) rank[r] = __hip_atomic_fetch_add(&hist[bi[r]], 1u, __ATOMIC_RELAXED, __HIP_MEMORY_SCOPE_WORKGROUP);
        const float sc = 2.5f / ssum;
        f32x4 g0 = {sel[0] * sc, sel[1] * sc, sel[2] * sc, sel[3] * sc}, g1 = {sel[4] * sc, sel[5] * sc, sel[6] * sc, sel[7] * sc};
        *(f32x4*)(gatew + tok * 8) = g0; *(f32x4*)(gatew + tok * 8 + 4) = g1;
    }
    __syncthreads();
    if (tid < 256) { const unsigned h = hist[tid]; if (h) hbase[tid] = atomicAdd(cnt + 32 * tid, h); }
    __syncthreads();
    if (wave == 0) {
        const int tok = t0 + lane;
#pragma unroll
        for (int r = 0; r < 8; ++r) list[(size_t)bi[r] * LISTCAP + hbase[bi[r]] + rank[r]] = tok * NSLOT + r;
    }
    __syncthreads();
}

__device__ __forceinline__ void moe_tile(const Args& a, ldsp lds, int e, int mt, int nrows, int ntl) {
    const int tid = threadIdx.x, lane = tid & 63, wave = __builtin_amdgcn_readfirstlane(tid >> 6), fr = lane & 15, fq = lane >> 4;
    unsigned char* ws = a.ws;
    constexpr int ASTG = 0, BSTG = 16384, ACT = 49152, SLOTS = 114688, GWO = 115200;
    const bf16* H2 = (const bf16*)(ws + WS_H2);
    const float* Wg = (e < NEXP) ? a.in[I_EG] + (size_t)e * 262144 : a.in[I_SG];
    const float* Wu = (e < NEXP) ? a.in[I_EU] + (size_t)e * 262144 : a.in[I_SU];
    const float* Wd = (e < NEXP) ? a.in[I_ED] + (size_t)e * 262144 : a.in[I_SD];
    if (tid < 128) {
        int slot = -1; float gw = 0.f;
        if (tid < nrows) {
            if (e < NEXP) { slot = ((const int*)(ws + WS_LIST))[(size_t)e * LISTCAP + mt * 128 + tid]; gw = ((const float*)(ws + WS_GATEW))[(slot / NSLOT) * 8 + (slot % NSLOT)]; }
            else { slot = (mt * 128 + tid) * NSLOT + 8; gw = 1.f; }
        }
        ((LAS int*)(lds + SLOTS))[tid] = slot; ((LAS float*)(lds + GWO))[tid] = gw;
    }
    __syncthreads();
    const int wr = wave >> 2, wc = wave & 3;
    const int arow = tid >> 2, akc = tid & 3;
    const int aslot = ((LAS const int*)(lds + SLOTS))[arow];
    const bf16* asrc = H2 + (size_t)((aslot < 0 ? 0 : aslot) / NSLOT) * D + akc * 8;
    const int awr = ASTG + akc * 2048 + ((arow ^ (akc << 1)) * 16);
    const int ng = lane, kq = wave;
    const float* srcg = Wg + (size_t)(4 * kq) * 256 + 4 * ng;
    const float* srcu = Wu + (size_t)(4 * kq) * 256 + 4 * ng;
    const float* src2 = Wd + (size_t)(4 * kq) * 1024 + 4 * ng;
    int bwr2[4];
#pragma unroll
    for (int i = 0; i < 4; ++i) { const int rho2 = 4 * ng + i; bwr2[i] = BSTG + (kq >> 1) * 4096 + ((rho2 ^ ((rho2 >> 3) & 3)) * 16) + (kq & 1) * 8; }
    int ard[4], brd[4], rowm[4];
#pragma unroll
    for (int m = 0; m < 4; ++m) { rowm[m] = 64 * wr + 16 * m + fr; ard[m] = fq * 2048 + ((rowm[m] ^ (fq << 1)) * 16); }
#pragma unroll
    for (int n = 0; n < 4; ++n) { const int rho = 64 * wc + 16 * n + fr; brd[n] = BSTG + fq * 4096 + ((rho ^ ((rho >> 3) & 3)) * 16); }
    bf16* contrib = (bf16*)(ws + WS_CONTRIB);
    f32x4 acc[4][4];
    f32x4 B0[4], B1[4], B2[4], B3[4]; u32x4 A0, A1, A2, A3;
#define G1_LOAD(s_, BR, AR) do { const int s0_ = (s_); const int ss_ = s0_ < 63 ? s0_ : 63; \
        const float* bp_ = ((ss_ < 32) ? srcg : srcu) + (size_t)(32 * (ss_ & 31)) * 256; \
        AR = *(const u32x4*)(asrc + 32 * (ss_ & 31)); \
        _Pragma("unroll") for (int j = 0; j < 4; ++j) BR[j] = *(const f32x4*)(bp_ + j * 256); } while (0)
#define G1_WRITE(BR, AR, buf_) do { \
        *(LAS u32x4*)(lds + (buf_) * 8192 + awr) = AR; \
        _Pragma("unroll") for (int i = 0; i < 4; ++i) { u32x2 w_; w_.x = cvtpk(BR[0][i], BR[1][i]); w_.y = cvtpk(BR[2][i], BR[3][i]); *(LAS u32x2*)(lds + (buf_) * 16384 + bwr2[i]) = w_; } } while (0)
#define MOE_COMPUTE(abase_, buf_) do { \
        bf16x8 af_[4], bf_[4]; \
        _Pragma("unroll") for (int m = 0; m < 4; ++m) af_[m] = *(LAS const bf16x8*)(lds + (abase_) + ard[m]); \
        _Pragma("unroll") for (int n = 0; n < 4; ++n) bf_[n] = *(LAS const bf16x8*)(lds + (buf_) * 16384 + brd[n]); \
        _Pragma("unroll") for (int m = 0; m < 4; ++m) _Pragma("unroll") for (int n = 0; n < 4; ++n) acc[m][n] = mfma16(bf_[n], af_[m], acc[m][n]); } while (0)
#define ACC_ZERO() do { _Pragma("unroll") for (int m = 0; m < 4; ++m) _Pragma("unroll") for (int n = 0; n < 4; ++n) acc[m][n] = (f32x4){0.f, 0.f, 0.f, 0.f}; } while (0)
    G1_LOAD(0, B0, A0); G1_LOAD(1, B1, A1); G1_LOAD(2, B2, A2);
    G1_WRITE(B0, A0, 0);
    __syncthreads();
    for (int s = 0; s < 64; s += 4) {
        if ((s & 31) == 0) ACC_ZERO();
        G1_LOAD(s + 3, B3, A3); MOE_COMPUTE(0, 0); G1_WRITE(B1, A1, 1); __syncthreads();
        G1_LOAD(s + 4, B0, A0); MOE_COMPUTE(8192, 1); G1_WRITE(B2, A2, 0); __syncthreads();
        G1_LOAD(s + 5, B1, A1); MOE_COMPUTE(0, 0); G1_WRITE(B3, A3, 1); __syncthreads();
        G1_LOAD(s + 6, B2, A2); MOE_COMPUTE(8192, 1);
        if (s == 28) {
#pragma unroll
            for (int m = 0; m < 4; ++m)
#pragma unroll
                for (int n = 0; n < 4; ++n) {
                    const f32x4 gv = acc[m][n];
                    u32x2 w; w.x = cvtpk(silu_f(gv[0]), silu_f(gv[1])); w.y = cvtpk(silu_f(gv[2]), silu_f(gv[3]));
                    const int kc = 8 * wc + 2 * n + (fq >> 1);
                    *(LAS u32x2*)(lds + ACT + kc * 2048 + ((rowm[m] ^ ((kc & 3) << 1)) * 16) + (fq & 1) * 8) = w;
                }
        } else if (s == 60) {
#pragma unroll
            for (int m = 0; m < 4; ++m)
#pragma unroll
                for (int n = 0; n < 4; ++n) {
                    const f32x4 uv = acc[m][n];
                    const int kc = 8 * wc + 2 * n + (fq >> 1);
                    LAS u32x2* ap = (LAS u32x2*)(lds + ACT + kc * 2048 + ((rowm[m] ^ ((kc & 3) << 1)) * 16) + (fq & 1) * 8);
                    const u32x2 g = *ap;
                    u32x2 w; w.x = cvtpk(bflo(g.x) * uv[0], bfhi(g.x) * uv[1]); w.y = cvtpk(bflo(g.y) * uv[2], bfhi(g.y) * uv[3]);
                    *ap = w;
                }
        }
        G1_WRITE(B0, A0, 0); __syncthreads();
    }
#define G2_LOAD(s_, BR) do { const int s0_ = (s_); const int t_ = s0_ < 31 ? s0_ : 31; \
        const float* bp_ = src2 + (size_t)(32 * (t_ & 7)) * 1024 + 256 * (t_ >> 3); \
        _Pragma("unroll") for (int j = 0; j < 4; ++j) BR[j] = *(const f32x4*)(bp_ + j * 1024); } while (0)
#define G2_WRITE(BR, buf_) do { \
        _Pragma("unroll") for (int i = 0; i < 4; ++i) { u32x2 w_; w_.x = cvtpk(BR[0][i], BR[1][i]); w_.y = cvtpk(BR[2][i], BR[3][i]); *(LAS u32x2*)(lds + (buf_) * 16384 + bwr2[i]) = w_; } } while (0)
    G2_LOAD(0, B0); G2_LOAD(1, B1); G2_LOAD(2, B2);
    G2_WRITE(B0, 0);
    __syncthreads();
    for (int s = 0; s < 32; s += 4) {
        if ((s & 7) == 0) ACC_ZERO();
        G2_LOAD(s + 3, B3); MOE_COMPUTE(ACT + (s & 7) * 8192, 0); G2_WRITE(B1, 1); __syncthreads();
        G2_LOAD(s + 4, B0); MOE_COMPUTE(ACT + ((s + 1) & 7) * 8192, 1); G2_WRITE(B2, 0); __syncthreads();
        G2_LOAD(s + 5, B1); MOE_COMPUTE(ACT + ((s + 2) & 7) * 8192, 0); G2_WRITE(B3, 1); __syncthreads();
        G2_LOAD(s + 6, B2); MOE_COMPUTE(ACT + ((s + 3) & 7) * 8192, 1);
        if ((s & 7) == 4) {
            const int q = s >> 3;
#pragma unroll
            for (int m = 0; m < 4; ++m) {
                const int slot = ((LAS const int*)(lds + SLOTS))[rowm[m]]; const float gw = ((LAS const float*)(lds + GWO))[rowm[m]];
                if (slot >= 0) {
                    bf16* cp = contrib + (size_t)slot * D + q * 256 + 64 * wc + 4 * fq;
#pragma unroll
                    for (int n = 0; n < 4; ++n) { const f32x4 v = acc[m][n] * gw; u32x2 w; w.x = cvtpk(v[0], v[1]); w.y = cvtpk(v[2], v[3]); *(u32x2*)(cp + 16 * n) = w; }
                }
            }
        }
        G2_WRITE(B0, 0); __syncthreads();
    }
#undef G1_LOAD
#undef G1_WRITE
#undef G2_LOAD
#undef G2_WRITE
#undef ACC_ZERO
#undef MOE_COMPUTE
}

__device__ __forceinline__ void moe_decode(int j, int total, LAS const int* pre, const unsigned* cnt, int& e, int& mt, int& nrows) {
    if (j < total) {
        int lo = 0, hi = NEXP;
        while (hi - lo > 1) { const int mid = (lo + hi) >> 1; if (pre[mid] <= j) lo = mid; else hi = mid; }
        e = lo; mt = j - pre[e]; const int c = (int)cnt[32 * e] - mt * 128; nrows = c < 128 ? c : 128;
    } else { e = NEXP; mt = j - total; nrows = 128; }
}
__device__ __forceinline__ void phase_moe(const Args& a, ldsp lds, int G, int vcu) {
    const int tid = threadIdx.x, lane = tid & 63, wave = __builtin_amdgcn_readfirstlane(tid >> 6), fr = lane & 15, fq = lane >> 4;
    unsigned char* ws = a.ws;
    constexpr int ASTG = 0, BSTG = 16384, ACT = 49152, SLOTS = 114688, GWO = 115712;
    const unsigned* cnt = (const unsigned*)(ws + WS_CTL) + CW_CNT;
    LAS int* pre = (LAS int*)(lds + MISC_OFF + 512);
    if (tid == 0) { int s = 0; for (int e = 0; e < NEXP; ++e) { pre[e] = s; s += (int)((cnt[32 * e] + 127u) >> 7); } pre[NEXP] = s; }
    __syncthreads();
    const int total = pre[NEXP], ntiles = total + T / 128;
    if (vcu >= ntiles) return;
#define STAGE_SLOTS(j_, b_) do { int e_, mt_, nr_; moe_decode((j_), total, pre, cnt, e_, mt_, nr_); \
        int slot_ = -1; float gw_ = 0.f; \
        if (tid < nr_) { if (e_ < NEXP) { slot_ = ((const int*)(ws + WS_LIST))[(size_t)e_ * LISTCAP + mt_ * 128 + tid]; gw_ = ((const float*)(ws + WS_GATEW))[(slot_ / NSLOT) * 8 + (slot_ % NSLOT)]; } \
                         else { slot_ = (mt_ * 128 + tid) * NSLOT + 8; gw_ = 1.f; } } \
        ((LAS int*)(lds + SLOTS))[(b_) * 128 + tid] = slot_; ((LAS float*)(lds + GWO))[(b_) * 128 + tid] = gw_; } while (0)
    if (wave >= 4) {
        const int lt = tid - 256;
        const bf16* H2 = (const bf16*)(ws + WS_H2);
        const int arow = lt >> 1, ahalf = lt & 1;
        const int awr0 = ASTG + (2 * ahalf) * 2048 + ((arow ^ ((2 * ahalf) << 1)) * 16), awr1 = ASTG + (2 * ahalf + 1) * 2048 + ((arow ^ ((2 * ahalf + 1) << 1)) * 16);
        const int ng = lt & 63, kq = lt >> 6;
        const int loff256 = (8 * kq) * 256 + 4 * ng, loff1024 = (8 * kq) * 1024 + 4 * ng;
        const int bw = BSTG + kq * 4096 + (4 * ng) * 16, bx = ((4 * ng) >> 3) & 3;
        f32x4 B0[8], B1[8], B2[8], B3[8]; u32x4 A0[2], A1[2], A2[2], A3[2];
        __syncthreads();
        int j = vcu, it = 0, e, mt, nrows;
        moe_decode(j, total, pre, cnt, e, mt, nrows);
        const float* Wg = (e < NEXP) ? a.in[I_EG] + (size_t)e * 262144 : a.in[I_SG];
        const float* Wu = (e < NEXP) ? a.in[I_EU] + (size_t)e * 262144 : a.in[I_SU];
        const float* Wd = (e < NEXP) ? a.in[I_ED] + (size_t)e * 262144 : a.in[I_SD];
        int aslot = ((LAS const int*)(lds + SLOTS))[arow];
        const bf16* asrc = H2 + (size_t)((aslot < 0 ? 0 : aslot) / NSLOT) * D + 16 * ahalf;
#define L_LOADB1(WG_, WU_, WD_, s_, BR) do { const int ss_ = (s_); const int t_ = ss_ - 64; \
            const float* bp_ = (ss_ < 32) ? (WG_) + loff256 + (size_t)(32 * ss_) * 256 : (ss_ < 64) ? (WU_) + loff256 + (size_t)(32 * (ss_ - 32)) * 256 : (WD_) + loff1024 + (size_t)(32 * (t_ & 7)) * 1024 + 256 * (t_ >> 3); \
            const int str_ = (ss_ < 64) ? 256 : 1024;        \
            _Pragma("unroll") for (int jj = 0; jj < 8; ++jj) BR[jj] = *(const f32x4*)(bp_ + jj * str_); } while (0)
#define L_LOADA2(AP_, s_, AR, AS) do { const int ss_ = (s_); const int sa_ = ss_ < 62 ? ss_ : 62; \
            AR[0] = *(const u32x4*)((AP_) + 32 * (sa_ & 31)); AR[1] = *(const u32x4*)((AP_) + 32 * (sa_ & 31) + 8); \
            AS[0] = *(const u32x4*)((AP_) + 32 * (sa_ & 31) + 32); AS[1] = *(const u32x4*)((AP_) + 32 * (sa_ & 31) + 40); } while (0)
#define L_LOAD2(s_, BR) do { const int s0_ = (s_); const int t_ = s0_ < 31 ? s0_ : 31; \
            const float* bp_ = Wd + loff1024 + (size_t)(32 * (t_ & 7)) * 1024 + 256 * (t_ >> 3); \
            _Pragma("unroll") for (int jj = 0; jj < 8; ++jj) BR[jj] = *(const f32x4*)(bp_ + jj * 1024); } while (0)
#define L_WRITEB(BR, buf_) do { _Pragma("unroll") for (int i = 0; i < 4; ++i) { u32x4 w_; w_.x = cvtpk(BR[0][i], BR[1][i]); w_.y = cvtpk(BR[2][i], BR[3][i]); w_.z = cvtpk(BR[4][i], BR[5][i]); w_.w = cvtpk(BR[6][i], BR[7][i]); \
            *(LAS u32x4*)(lds + (buf_) * 16384 + bw + ((i ^ bx) * 16)) = w_; } } while (0)
#define L_WRITEA(AR, buf_) do { *(LAS u32x4*)(lds + (buf_) * 8192 + awr0) = AR[0]; *(LAS u32x4*)(lds + (buf_) * 8192 + awr1) = AR[1]; } while (0)
        L_LOADA2(asrc, 0, A0, A1); L_LOADB1(Wg, Wu, Wd, 0, B0); L_LOADB1(Wg, Wu, Wd, 1, B1); L_LOADA2(asrc, 2, A2, A3); L_LOADB1(Wg, Wu, Wd, 2, B2);
        for (;;) {
            L_WRITEA(A0, 0); L_WRITEB(B0, 0);
            __syncthreads();
            for (int s = 0; s < 64; s += 4) {
                L_LOADB1(Wg, Wu, Wd, s + 3, B3); L_WRITEA(A1, 1); L_WRITEB(B1, 1); __syncthreads();
                L_LOADB1(Wg, Wu, Wd, s + 4, B0); L_LOADA2(asrc, s + 4, A0, A1); L_WRITEA(A2, 0); L_WRITEB(B2, 0); __syncthreads();
                L_LOADB1(Wg, Wu, Wd, s + 5, B1); L_WRITEA(A3, 1); L_WRITEB(B3, 1); __syncthreads();
                L_LOADB1(Wg, Wu, Wd, s + 6, B2); L_LOADA2(asrc, s + 6, A2, A3); L_WRITEA(A0, 0); L_WRITEB(B0, 0); __syncthreads();
            }
            for (int s = 0; s < 28; s += 4) {
                L_LOAD2(s + 3, B3); L_WRITEB(B1, 1); __syncthreads();
                L_LOAD2(s + 4, B0); L_WRITEB(B2, 0); __syncthreads();
                L_LOAD2(s + 5, B1); L_WRITEB(B3, 1); __syncthreads();
                L_LOAD2(s + 6, B2); L_WRITEB(B0, 0); __syncthreads();
            }
            const int jn = j + G; const bool more = jn < ntiles;
            int en = e, mtn = mt, nrn = nrows; if (more) moe_decode(jn, total, pre, cnt, en, mtn, nrn);
            const float* Wgn = (en < NEXP) ? a.in[I_EG] + (size_t)en * 262144 : a.in[I_SG];
            const float* Wun = (en < NEXP) ? a.in[I_EU] + (size_t)en * 262144 : a.in[I_SU];
            const float* Wdn = (en < NEXP) ? a.in[I_ED] + (size_t)en * 262144 : a.in[I_SD];
            const int aslotn = more ? ((LAS const int*)(lds + SLOTS))[(it ^ 1) * 128 + arow] : aslot;
            const bf16* asrcn = H2 + (size_t)((aslotn < 0 ? 0 : aslotn) / NSLOT) * D + 16 * ahalf;
            L_LOAD2(31, B3); L_WRITEB(B1, 1); __syncthreads();
            L_LOADB1(Wgn, Wun, Wdn, 0, B0); L_LOADA2(asrcn, 0, A0, A1); L_WRITEB(B2, 0); __syncthreads();
            L_LOADB1(Wgn, Wun, Wdn, 1, B1); L_WRITEB(B3, 1); __syncthreads();
            L_LOADB1(Wgn, Wun, Wdn, 2, B2); L_LOADA2(asrcn, 2, A2, A3); __syncthreads();
            if (!more) break;
            j = jn; it ^= 1; e = en; mt = mtn; nrows = nrn; Wg = Wgn; Wu = Wun; Wd = Wdn; aslot = aslotn; asrc = asrcn;
        }
#undef L_LOADB1
#undef L_LOADA2
#undef L_LOAD2
#undef L_WRITEB
#undef L_WRITEA
    } else {
        const int wr = wave >> 1, wc = wave & 1;
        int rowm[4], ard[4], brd[8];
#pragma unroll
        for (int m = 0; m < 4; ++m) { rowm[m] = 64 * wr + 16 * m + fr; ard[m] = fq * 2048 + ((rowm[m] ^ (fq << 1)) * 16); }
#pragma unroll
        for (int n = 0; n < 8; ++n) { const int rho = 128 * wc + 16 * n + fr; brd[n] = BSTG + fq * 4096 + ((rho ^ ((rho >> 3) & 3)) * 16); }
        bf16* contrib = (bf16*)(ws + WS_CONTRIB);
        f32x4 acc[4][8];
#define M_COMPUTE(abase_, buf_) do { \
            _Pragma("unroll") for (int nh = 0; nh < 2; ++nh) { bf16x8 af_[4], bf_[4]; \
                _Pragma("unroll") for (int m = 0; m < 4; ++m) af_[m] = *(LAS const bf16x8*)(lds + (abase_) + ard[m]); \
                _Pragma("unroll") for (int n = 0; n < 4; ++n) bf_[n] = *(LAS const bf16x8*)(lds + (buf_) * 16384 + brd[4 * nh + n]); \
                _Pragma("unroll") for (int m = 0; m < 4; ++m) _Pragma("unroll") for (int n = 0; n < 4; ++n) acc[m][4 * nh + n] = mfma16(bf_[n], af_[m], acc[m][4 * nh + n]); } } while (0)
#define M_ZERO() do { _Pragma("unroll") for (int m = 0; m < 4; ++m) _Pragma("unroll") for (int n = 0; n < 8; ++n) acc[m][n] = (f32x4){0.f, 0.f, 0.f, 0.f}; } while (0)
        if (tid < 128) STAGE_SLOTS(vcu, 0);
        __syncthreads();
        int it = 0;
        for (int j = vcu; j < ntiles; j += G, it ^= 1) {
            if (tid < 128 && j + G < ntiles) STAGE_SLOTS(j + G, it ^ 1);
            __syncthreads();
            for (int s = 0; s < 64; s += 4) {
                if ((s & 31) == 0) M_ZERO();
                M_COMPUTE(0, 0); __syncthreads();
                M_COMPUTE(8192, 1); __syncthreads();
                M_COMPUTE(0, 0); __syncthreads();
                M_COMPUTE(8192, 1);
                if (s == 28) {
#pragma unroll
                    for (int m = 0; m < 4; ++m)
#pragma unroll
                        for (int n = 0; n < 8; ++n) {
                            const f32x4 gv = acc[m][n];
                            u32x2 w; w.x = cvtpk(silu_f(gv[0]), silu_f(gv[1])); w.y = cvtpk(silu_f(gv[2]), silu_f(gv[3]));
                            const int kc = 16 * wc + 2 * n + (fq >> 1);
                            *(LAS u32x2*)(lds + ACT + kc * 2048 + ((rowm[m] ^ ((kc & 3) << 1)) * 16) + (fq & 1) * 8) = w;
                        }
                } else if (s == 60) {
#pragma unroll
                    for (int m = 0; m < 4; ++m)
#pragma unroll
                        for (int n = 0; n < 8; ++n) {
                            const f32x4 uv = acc[m][n];
                            const int kc = 16 * wc + 2 * n + (fq >> 1);
                            LAS u32x2* ap = (LAS u32x2*)(lds + ACT + kc * 2048 + ((rowm[m] ^ ((kc & 3) << 1)) * 16) + (fq & 1) * 8);
                            const u32x2 g = *ap;
                            u32x2 w; w.x = cvtpk(bflo(g.x) * uv[0], bfhi(g.x) * uv[1]); w.y = cvtpk(bflo(g.y) * uv[2], bfhi(g.y) * uv[3]);
                            *ap = w;
                        }
                }
                __syncthreads();
            }
            for (int s = 0; s < 32; s += 4) {
                if ((s & 7) == 0) M_ZERO();
                M_COMPUTE(ACT + (s & 7) * 8192, 0); __syncthreads();
                M_COMPUTE(ACT + ((s + 1) & 7) * 8192, 1); __syncthreads();
                M_COMPUTE(ACT + ((s + 2) & 7) * 8192, 0); __syncthreads();
                M_COMPUTE(ACT + ((s + 3) & 7) * 8192, 1);
                if ((s & 7) == 4) {
                    const int q = s >> 3;
#pragma unroll
                    for (int m = 0; m < 4; ++m) {
                        const int slot = ((LAS const int*)(lds + SLOTS))[it * 128 + rowm[m]]; const float gw = ((LAS const float*)(lds + GWO))[it * 128 + rowm[m]];
                        if (slot >= 0) {
                            bf16* cp = contrib + (size_t)slot * D + q * 256 + 128 * wc + 4 * fq;
#pragma unroll
                            for (int n = 0; n < 8; ++n) { const f32x4 v = acc[m][n] * gw; u32x2 w; w.x = cvtpk(v[0], v[1]); w.y = cvtpk(v[2], v[3]); *(u32x2*)(cp + 16 * n) = w; }
                        }
                    }
                }
                __syncthreads();
            }
        }
#undef M_COMPUTE
#undef M_ZERO
    }
#undef STAGE_SLOTS
}

__device__ __forceinline__ void phase_combine(const Args& a, int G) {
    const int tid = threadIdx.x, lane = tid & 63, wave = __builtin_amdgcn_readfirstlane(tid >> 6), blk = blockIdx.x;
    unsigned char* ws = a.ws;
    const bf16* X1 = (const bf16*)(ws + WS_X1); const bf16* contrib = (const bf16*)(ws + WS_CONTRIB); const float* fg = a.in[I_FG];
    for (int t = blk * NWAVES + wave; t < T; t += G * NWAVES) {
        const float* g2 = (const float*)(ws + WS_ADAF) + (t >> 13) * 6144 + 5 * 1024;
        f32x4 xv[2][2]; float ss = 0.f;
#pragma unroll
        for (int j = 0; j < 2; ++j) {
            const int c = 8 * lane + 512 * j;
            float sm[8] = {0.f, 0.f, 0.f, 0.f, 0.f, 0.f, 0.f, 0.f};
#pragma unroll
            for (int k = 0; k < NSLOT; ++k) {
                const u32x4 w = *(const u32x4*)(contrib + ((size_t)t * NSLOT + k) * D + c);
                sm[0] += bflo(w.x); sm[1] += bfhi(w.x); sm[2] += bflo(w.y); sm[3] += bfhi(w.y); sm[4] += bflo(w.z); sm[5] += bfhi(w.z); sm[6] += bflo(w.w); sm[7] += bfhi(w.w);
            }
            const u32x4 xw = *(const u32x4*)(X1 + (size_t)t * D + c);
#pragma unroll
            for (int h = 0; h < 2; ++h) {
                const f32x4 x1 = h == 0 ? (f32x4){bflo(xw.x), bfhi(xw.x), bflo(xw.y), bfhi(xw.y)} : (f32x4){bflo(xw.z), bfhi(xw.z), bflo(xw.w), bfhi(xw.w)};
                const f32x4 gg = *(const f32x4*)(g2 + c + 4 * h);
                const f32x4 mv = {sm[4 * h], sm[4 * h + 1], sm[4 * h + 2], sm[4 * h + 3]};
                const f32x4 v = x1 + gg * mv; xv[j][h] = v; ss += (v[0] * v[0] + v[1] * v[1]) + (v[2] * v[2] + v[3] * v[3]);
            }
        }
        const float r = rsqrtf(wave_sum(ss) * (1.f / D) + 1e-6f);
#pragma unroll
        for (int j = 0; j < 2; ++j)
#pragma unroll
            for (int h = 0; h < 2; ++h) { const int c = 8 * lane + 512 * j + 4 * h; *(f32x4*)(a.out + (size_t)t * D + c) = (xv[j][h] * r) * *(const f32x4*)(fg + c); }
    }
}

constexpr int NPH = 9;
#ifndef N_LAUNCHES
#define N_LAUNCHES 1
#endif
__global__ void __launch_bounds__(NWAVES * 64, 2) mega(Args a) {
    extern __shared__ __attribute__((aligned(16))) unsigned char lds_raw[];
    ldsp lds = (ldsp)lds_raw;
    const int tid = threadIdx.x, G = gridDim.x, bx = blockIdx.x;
    int vcu = (G % 8 == 0) ? (bx % 8) * (G / 8) + bx / 8 : bx;
    unsigned char* ws = a.ws;
    for (int u = tid; u < (LDS_BYTES - MISC_OFF) / 4; u += NWAVES * 64) ((LAS unsigned*)(lds + MISC_OFF))[u] = 0u;
    __syncthreads();
    volatile LAS unsigned* MISC = (volatile LAS unsigned*)(lds + MISC_OFF);
    XcdBarrier bar; bar.bar = (unsigned*)(ws + WS_CTL) + CW_BAR; bar.x = 0; bar.st = nullptr;
    if (N_LAUNCHES == 1) {
        bar = xcd_barrier_post((unsigned*)(ws + WS_CTL) + CW_BAR, MISC + 8);
        if (tid == 0) MISC[16] = atomicAdd((unsigned*)(ws + WS_CTL) + CW_XRANK + 64 * bar.x, 1u);
    }
    const int lo = a.ph_lo, hi = a.ph_hi;
#ifndef PH_MASK
#define PH_MASK 0x1ff
#endif
#define IN(k) (((PH_MASK >> (k)) & 1) && lo <= (k) && (k) < hi)
#define SEAM(k) do { if (IN(k) && IN((k) + 1)) xcd_barrier(bar); } while (0)
#ifndef PH_DUP
#define PH_DUP -1
#endif
#define REP(k) for (int rep_ = 0; rep_ < ((PH_DUP == (k)) ? 2 : 1); ++rep_)
    if (IN(0)) REP(0) { phase_prep(a, lds, G); } SEAM(0);
    if (N_LAUNCHES == 1 && IN(0) && IN(1)) {
        unsigned basex = 0;
        for (unsigned j = 0; j < bar.x; ++j) basex += xb_ld(&bar.bar[XB_XCNT(j)]);
        vcu = (int)(basex + MISC[16]);
    }
    if (IN(1)) REP(1) { phase_hnorm(a, lds, G); } SEAM(1);
    if (IN(2)) REP(2) {
        pg8::Gemm g{(const pg8::bf16_t*)(ws + WS_H), (const pg8::bf16_t*)(ws + WS_WINT), MH, DIN, D};
        WinOrder S; S.init(G, bx);
        EpiWin E{(bf16*)(ws + WS_Z), (bf16*)(ws + WS_KVC), (const float*)(ws + WS_ROPE)};
        pg8::gemm_phase<EpiWin, WinOrder, true, true>(lds, g, S, E);
    } SEAM(2);
    if (IN(3)) REP(3) { phase_mixers(a, lds, G, vcu); } SEAM(3);
    if (IN(4)) REP(4) {
        { pg8::Gemm g{(const pg8::bf16_t*)(ws + WS_A), (const pg8::bf16_t*)(ws + WS_WAT), T, D, 512};
          pg8::StaticOrder S; S.init(T, D, G, bx);
          EpiMergeA E{(const bf16*)(ws + WS_Z), (bf16*)(ws + WS_Y)};
          pg8::gemm_phase<EpiMergeA, pg8::StaticOrder, true, true>(lds, g, S, E); }
        { pg8::Gemm g{(const pg8::bf16_t*)(ws + WS_O), (const pg8::bf16_t*)(ws + WS_WBT), T, D, 512};
          pg8::StaticOrder S; S.init(T, D, G, bx);
          EpiMergeB E{(const bf16*)(ws + WS_Z), (bf16*)(ws + WS_Y)};
          pg8::gemm_phase<EpiMergeB, pg8::StaticOrder, true, true>(lds, g, S, E); }
    } SEAM(4);
    if (IN(5)) REP(5) {
        pg8::Gemm g{(const pg8::bf16_t*)(ws + WS_Y), (const pg8::bf16_t*)(ws + WS_WOT), T, D, D};
        pg8::StaticOrder S; S.init(T, D, G, bx);
        EpiWo E{a.in[I_X], (const float*)(ws + WS_ADAF), (bf16*)(ws + WS_X1)};
        pg8::gemm_phase<EpiWo, pg8::StaticOrder, true, true>(lds, g, S, E);
    } SEAM(5);
    if (IN(6)) { for (int it = vcu; it < T / 64; it += G) router_item(a, lds, it); } SEAM(6);
    if (IN(7)) REP(7) { phase_moe(a, lds, G, vcu); } SEAM(7);
    if (IN(8)) REP(8) { phase_combine(a, G); }
#undef IN
#undef SEAM
}

extern "C" void kernel_launch(void* const* d_in, const int* in_sizes, int n_in, void* d_out, int out_size, void* d_ws, size_t ws_size, hipStream_t stream) {
    static int grid = 0;
    if (grid == 0) {
        if (n_in != 26 || out_size != T * D || ws_size < WS_END) { fprintf(stderr, "kernel_launch: unexpected shapes (n_in %d, out %d, ws %zu)\n", n_in, out_size, ws_size); grid = -1; return; }
        int dev = 0, cus = 0, per_cu = 0;
        (void)hipGetDevice(&dev); (void)hipDeviceGetAttribute(&cus, hipDeviceAttributeMultiprocessorCount, dev);
        (void)hipFuncSetAttribute((const void*)mega, hipFuncAttributeMaxDynamicSharedMemorySize, LDS_BYTES);
        (void)hipOccupancyMaxActiveBlocksPerMultiprocessor(&per_cu, (const void*)mega, NWAVES * 64, LDS_BYTES);
        (void)hipGetLastError();
        if (per_cu < 1) { fprintf(stderr, "kernel_launch: occupancy query says %d blocks per CU\n", per_cu); per_cu = 1; }
        grid = cus;
    }
    if (grid < 0) return;
    (void)hipMemsetAsync((char*)d_ws + WS_CTL, 0, CTL_ZERO_BYTES, stream);
    Args a{};
    for (int i = 0; i < 26; ++i) a.in[i] = (const float*)d_in[i];
    a.out = (float*)d_out; a.ws = (unsigned char*)d_ws;
    if (N_LAUNCHES == 1) {
        a.ph_lo = 0; a.ph_hi = NPH;
        void* kargs[] = {&a};
        hipError_t e = hipLaunchCooperativeKernel((const void*)mega, dim3(grid), dim3(NWAVES * 64), kargs, LDS_BYTES, stream);
        if (e != hipSuccess) fprintf(stderr, "kernel_launch: cooperative launch failed: %s (grid %d)\n", hipGetErrorString(e), grid);
    } else {
#ifndef HOST_DUP
#define HOST_DUP -1
#endif
        for (int li = 0; li < NPH; ++li) {
            a.ph_lo = li; a.ph_hi = li + 1;
            hipLaunchKernelGGL(mega, dim3(grid), dim3(NWAVES * 64), LDS_BYTES, stream, a);
            if (li == HOST_DUP) {
                if (li == 6) (void)hipMemsetAsync((char*)d_ws + WS_CTL, 0, CTL_ZERO_BYTES, stream);
                hipLaunchKernelGGL(mega, dim3(grid), dim3(NWAVES * 64), LDS_BYTES, stream, a);
            }
        }
    }
}
```

```cpp
#include <hip/hip_runtime.h>
#include <cstdio>
#include <cstdint>
#include <type_traits>
namespace pg8 {
#define PG8_LAS __attribute__((address_space(3)))
typedef unsigned short bf16_t;
typedef short bf16x8 __attribute__((ext_vector_type(8)));
typedef float f32x4 __attribute__((ext_vector_type(4)));
typedef unsigned u32x4 __attribute__((ext_vector_type(4)));
constexpr int BM = 256, BK = 64, HALF = 128, HTB = HALF * BK * 2  , STAGE_BYTES = 8 * HTB, NXCD = 8, WGM = 8;

__host__ __device__ __forceinline__ int lds_byte(int r, int c) { const int st = (r >> 4) * 2 + (c >> 5), rr = r & 15, cc = c & 31, ob = rr * 64 + cc * 2; return st * 1024 + (ob ^ (((ob >> 9) & 1) << 5)); }
__host__ __device__ __forceinline__ void stage_rc(int b, int& R, int& C) { const int st = b / 1024, sb = b % 1024, swz = sb ^ (((sb >> 9) & 1) << 5); R = (st >> 1) * 16 + swz / 64; C = (st & 1) * 32 + (swz % 64) / 2; }
__host__ __device__ __forceinline__ int perm32(int rho) { const int n = rho >> 4, i = rho & 15; return 8 * (i >> 2) + 4 * n + (i & 3); }

struct Unit { int pm, pn; };
struct Gemm { const bf16_t* A; const bf16_t* Bt; int M, N, K; };

struct StaticOrder {
    int nM, nN, nwg, G, c;
    __host__ __device__ void init(int M, int N, int G_, int c_) { nM = M / BM; nN = N / BM; nwg = nM * nN; G = G_; c = c_; }
    __host__ __device__ bool next(int i, Unit& u) const {
        const long L = (long)i * G + c; if (L >= nwg) return false;
        int wgid = (int)L; { const int q = nwg / NXCD, r = nwg % NXCD, xcd = wgid % NXCD, off = wgid / NXCD; wgid = (xcd < r ? xcd * (q + 1) : r * (q + 1) + (xcd - r) * q) + off; }
        const int nig = WGM * nN, gid = wgid / nig, fm = gid * WGM, gsz = (nM - fm) < WGM ? (nM - fm) : WGM;
        u.pm = fm + ((wgid % nig) % gsz); u.pn = (wgid % nig) / gsz; return true;
    }
    __device__ __forceinline__ void a_ready(const Unit&) const {}
    __device__ __forceinline__ void done(const Unit&) const {}
};

__device__ __forceinline__ unsigned cvt_pk_bf16(float lo, float hi) { unsigned r; asm volatile("v_cvt_pk_bf16_f32 %0, %1, %2" : "=v"(r) : "v"(lo), "v"(hi)); return r; }
template <class Epi, class Sched, bool ALIGN_EPI = false, bool SP2 = false>
__device__ __forceinline__ void gemm_phase(PG8_LAS unsigned char* lds, const Gemm g, const Sched& S, const Epi& E) {
    const int tid = threadIdx.x, wid = __builtin_amdgcn_readfirstlane(tid >> 6), lane = tid & 63, wr = wid >> 2, wc = wid & 3, fr = lane & 15, fq = lane >> 4;
    const int K = g.K, nt = K / BK;
    unsigned voffA[2], voffB[2];
#pragma unroll
    for (int i = 0; i < 2; ++i) { int R, C; stage_rc(tid * 16 + i * 8192, R, C); const int Rb = Epi::PERM ? ((R & ~31) + perm32(R & 31)) : R;
        voffA[i] = (unsigned)(R * K + C) * 2u; voffB[i] = (unsigned)(Rb * K + C) * 2u; }
    const size_t kstep = (size_t)(BK * 2);
    const size_t hstep = (size_t)HALF * K * 2;
    const size_t tstep = 2 * hstep;
    const unsigned ldsw = (unsigned)wid * 1024u;
    const int aoff = lds_byte(wr * 64 + fr, fq * 8), boff = lds_byte(wc * 32 + fr, fq * 8);
#define PG8_SA(b, h) (((b) * 2 + (h)) * HTB)
#define PG8_SB(b, h) ((4 + (b) * 2 + (h)) * HTB)
#define PG8_STAGE(bufoff, gbase, voff) do { _Pragma("unroll") for (int _i = 0; _i < 2; ++_i) \
        __builtin_amdgcn_global_load_lds((const unsigned*)((const char*)(gbase) + (voff)[_i]), (PG8_LAS unsigned*)(lds + (bufoff) + ldsw + _i * 8192), 16, 0, 0); } while (0)
#define PG8_LDA(dst, b, h) do { _Pragma("unroll") for (int m = 0; m < 4; ++m) _Pragma("unroll") for (int k = 0; k < 2; ++k) dst[m][k] = *(const PG8_LAS bf16x8*)(lds + PG8_SA(b, h) + aoff + m * 2048 + k * 1024); } while (0)
#define PG8_LDB(dst, b, h) do { _Pragma("unroll") for (int n = 0; n < 2; ++n) _Pragma("unroll") for (int k = 0; k < 2; ++k) dst[n][k] = *(const PG8_LAS bf16x8*)(lds + PG8_SB(b, h) + boff + n * 2048 + k * 1024); } while (0)
#define PG8_MMA(ai, bj, At, Bt) do { __builtin_amdgcn_s_setprio(1); _Pragma("unroll") for (int m = 0; m < 4; ++m) _Pragma("unroll") for (int n = 0; n < 2; ++n) _Pragma("unroll") for (int k = 0; k < 2; ++k) \
        acc[ai][bj][m][n] = __builtin_amdgcn_mfma_f32_16x16x32_bf16(Bt[n][k], At[m][k], acc[ai][bj][m][n], 0, 0, 0); __builtin_amdgcn_s_setprio(0); } while (0)
#define PG8_WAIT_V(n) asm volatile("s_waitcnt vmcnt(" #n ")" ::: "memory")
#define PG8_WAIT_L(n) asm volatile("s_waitcnt lgkmcnt(" #n ")" ::: "memory")
#define PG8_BAR __builtin_amdgcn_s_barrier()
#define PG8_SCHED __builtin_amdgcn_sched_barrier(0)
    Unit cur, nxt; int ui = 0;
    if (!S.next(0, cur)) return;
    f32x4 acc[2][2][4][2];
#pragma unroll
    for (int a = 0; a < 2; ++a)
#pragma unroll
        for (int b = 0; b < 2; ++b)
#pragma unroll
            for (int m = 0; m < 4; ++m)
#pragma unroll
                for (int n = 0; n < 2; ++n) acc[a][b][m][n] = (f32x4){0.f, 0.f, 0.f, 0.f};
    bf16x8 At[4][2], B0[2][2], B1[2][2];
    const char* cA = (const char*)g.A + (size_t)cur.pm * tstep; const char* cB = (const char*)g.Bt + (size_t)cur.pn * tstep;
    S.a_ready(cur);
    if constexpr (SP2) {
        PG8_STAGE(PG8_SB(0, 0), cB, voffB); PG8_STAGE(PG8_SB(0, 1), cB + hstep, voffB); PG8_STAGE(PG8_SA(0, 0), cA, voffA); PG8_STAGE(PG8_SA(0, 1), cA + hstep, voffA);
        if (wr == 1) PG8_BAR;
        PG8_WAIT_V(2); PG8_BAR;
        PG8_STAGE(PG8_SB(1, 0), cB + kstep, voffB); PG8_STAGE(PG8_SA(1, 0), cA + kstep, voffA); PG8_STAGE(PG8_SB(1, 1), cB + hstep + kstep, voffB);
        PG8_WAIT_V(6); PG8_BAR;
    } else {
        PG8_STAGE(PG8_SB(0, 0), cB, voffB); PG8_STAGE(PG8_SA(0, 0), cA, voffA); PG8_STAGE(PG8_SB(0, 1), cB + hstep, voffB); PG8_STAGE(PG8_SA(0, 1), cA + hstep, voffA);
        if (wr == 1) PG8_BAR;
        PG8_WAIT_V(4); PG8_BAR;
        PG8_STAGE(PG8_SB(1, 0), cB + kstep, voffB); PG8_STAGE(PG8_SA(1, 0), cA + kstep, voffA); PG8_STAGE(PG8_SB(1, 1), cB + hstep + kstep, voffB);
        PG8_WAIT_V(6); PG8_BAR;
    }
    for (;;) {
        const bool has_next = S.next(ui + 1, nxt);
        const char* nA = has_next ? (const char*)g.A + (size_t)nxt.pm * tstep : cA; const char* nB = has_next ? (const char*)g.Bt + (size_t)nxt.pn * tstep : cB;
        for (int t = 0; t < nt; t += 2) {
            const bool last = (t == nt - 2);
            const char* a1 = cA + (size_t)(t + 1) * kstep;
            const char* a2 = last ? nA : cA + (size_t)(t + 2) * kstep; const char* b2 = last ? nB : cB + (size_t)(t + 2) * kstep;
            const char* a3 = a2 + kstep; const char* b3 = b2 + kstep;
            if (last && has_next) S.a_ready(nxt);
            if constexpr (SP2) {
            PG8_LDB(B0, 0, 0); PG8_LDB(B1, 0, 1); PG8_SCHED; PG8_LDA(At, 0, 0); PG8_STAGE(PG8_SA(1, 1), a1 + hstep, voffA);
            PG8_WAIT_V(8); PG8_WAIT_L(0); PG8_BAR; PG8_MMA(0, 0, At, B0); PG8_MMA(0, 1, At, B1); PG8_BAR; PG8_SCHED;
            PG8_LDA(At, 0, 1); PG8_STAGE(PG8_SB(0, 0), b2, voffB); PG8_STAGE(PG8_SB(0, 1), b2 + hstep, voffB); PG8_STAGE(PG8_SA(0, 0), a2, voffA);
            PG8_WAIT_V(8); PG8_WAIT_L(0); PG8_BAR; PG8_MMA(1, 0, At, B0); PG8_MMA(1, 1, At, B1); PG8_BAR; PG8_SCHED;
            PG8_LDB(B0, 1, 0); PG8_LDB(B1, 1, 1); PG8_SCHED; PG8_LDA(At, 1, 0); PG8_STAGE(PG8_SA(0, 1), a2 + hstep, voffA);
            PG8_WAIT_V(8); PG8_WAIT_L(0); PG8_BAR; PG8_MMA(0, 0, At, B0); PG8_MMA(0, 1, At, B1); PG8_BAR; PG8_SCHED;
            PG8_LDA(At, 1, 1); PG8_STAGE(PG8_SB(1, 0), b3, voffB); PG8_STAGE(PG8_SB(1, 1), b3 + hstep, voffB); PG8_STAGE(PG8_SA(1, 0), a3, voffA);
            PG8_WAIT_V(8); PG8_WAIT_L(0); PG8_BAR; PG8_MMA(1, 0, At, B0); PG8_MMA(1, 1, At, B1); PG8_BAR; PG8_SCHED;
            } else {
            PG8_LDB(B0, 0, 0); PG8_SCHED; PG8_LDA(At, 0, 0); PG8_STAGE(PG8_SA(1, 1), a1 + hstep, voffA);
            PG8_WAIT_L(8); PG8_BAR; PG8_WAIT_L(0); PG8_MMA(0, 0, At, B0); PG8_BAR; PG8_SCHED;
            PG8_LDB(B1, 0, 1); PG8_STAGE(PG8_SB(0, 0), b2, voffB);
            PG8_BAR; PG8_WAIT_L(0); PG8_MMA(0, 1, At, B1); PG8_BAR;
            PG8_LDA(At, 0, 1); PG8_STAGE(PG8_SA(0, 0), a2, voffA);
            PG8_BAR; PG8_WAIT_L(0); PG8_MMA(1, 0, At, B0); PG8_BAR; PG8_SCHED;
            PG8_STAGE(PG8_SB(0, 1), b2 + hstep, voffB);
            PG8_WAIT_V(6); PG8_BAR; PG8_MMA(1, 1, At, B1); PG8_BAR;
            PG8_LDB(B0, 1, 0); PG8_SCHED; PG8_LDA(At, 1, 0); PG8_STAGE(PG8_SA(0, 1), a2 + hstep, voffA);
            PG8_WAIT_L(8); PG8_BAR; PG8_WAIT_L(0); PG8_MMA(0, 0, At, B0); PG8_BAR; PG8_SCHED;
            PG8_LDB(B1, 1, 1); PG8_STAGE(PG8_SB(1, 0), b3, voffB);
            PG8_BAR; PG8_WAIT_L(0); PG8_MMA(0, 1, At, B1); PG8_BAR;
            PG8_LDA(At, 1, 1); PG8_STAGE(PG8_SA(1, 0), a3, voffA);
            PG8_BAR; PG8_WAIT_L(0); PG8_MMA(1, 0, At, B0); PG8_BAR; PG8_SCHED;
            PG8_STAGE(PG8_SB(1, 1), b3 + hstep, voffB);
            PG8_WAIT_V(6); PG8_BAR; PG8_MMA(1, 1, At, B1); PG8_BAR;
            }
        }
        if constexpr (ALIGN_EPI) { if (wr == 0) PG8_BAR; }
        if constexpr (!Epi::AFTER_DRAIN) { E(acc, cur, wr, wc, fr, fq); S.done(cur); }
        if (!has_next) break;
#pragma unroll
        for (int a = 0; a < 2; ++a)
#pragma unroll
            for (int b = 0; b < 2; ++b)
#pragma unroll
                for (int m = 0; m < 4; ++m)
#pragma unroll
                    for (int n = 0; n < 2; ++n) acc[a][b][m][n] = (f32x4){0.f, 0.f, 0.f, 0.f};
        cur = nxt; cA = nA; cB = nB; ++ui;
        if constexpr (ALIGN_EPI) { if (wr == 1) PG8_BAR; }
    }
    PG8_WAIT_V(0);
    if constexpr (!ALIGN_EPI) { if (wr == 0) PG8_BAR; }
    PG8_BAR;
    if constexpr (Epi::AFTER_DRAIN) { E.fused(acc, cur, wr, wc, fr, fq, lds, wid, lane); S.done(cur); }
#undef PG8_SA
#undef PG8_SB
#undef PG8_STAGE
#undef PG8_LDA
#undef PG8_LDB
#undef PG8_MMA
#undef PG8_WAIT_V
#undef PG8_WAIT_L
#undef PG8_BAR
#undef PG8_SCHED
}
}
#define GAS __attribute__((address_space(1)))
#define LAS __attribute__((address_space(3)))
typedef unsigned short bf16;
typedef unsigned v4u __attribute__((ext_vector_type(4)));
typedef float f32x4 __attribute__((ext_vector_type(4)));
typedef short bf16x8 __attribute__((ext_vector_type(8)));
typedef GAS unsigned gu32;
typedef GAS unsigned long long gu64;
#define RLX_AGENT __ATOMIC_RELAXED, __HIP_MEMORY_SCOPE_AGENT
#define LDS_WAIT() asm volatile("s_waitcnt lgkmcnt(0)" ::: "memory")
#define VM_WAIT() asm volatile("s_waitcnt vmcnt(0)" ::: "memory")
__device__ __forceinline__ unsigned long long rt() { return __builtin_amdgcn_s_memrealtime(); }
__device__ __forceinline__ unsigned f2bf(float f) { unsigned u = __builtin_bit_cast(unsigned, f); return (u + 0x7fffu + ((u >> 16) & 1u)) >> 16; }
__device__ __forceinline__ unsigned pk2(float lo, float hi) { return f2bf(lo) | (f2bf(hi) << 16); }

#define XB_TMO      128
#define XB_XCNT(j)  (256  + 64 * (j))
#define XB_XSUB(j)  (1280 + 64 * (j))
#define XB_XGEN(j)  (2304 + 64 * (j))
#define XB_TOP      3328
#define XB_TOPGEN   3392
#define XCD_BAR_WORDS 3456
#define XB_SPIN_CAP (1u << 18)

__device__ __forceinline__ unsigned xb_ld(unsigned* p)              { return __hip_atomic_load(p, __ATOMIC_RELAXED, __HIP_MEMORY_SCOPE_AGENT); }
__device__ __forceinline__ unsigned xb_add(unsigned* p, unsigned v) { return __hip_atomic_fetch_add(p, v, __ATOMIC_RELAXED, __HIP_MEMORY_SCOPE_AGENT); }
__device__ __forceinline__ unsigned xb_xcc_id() { return (unsigned)__builtin_amdgcn_s_getreg((3 << 11) | 20) & 0xFu; }
#define XB_SPIN(cond, bar) do { unsigned _sp = 0; while (cond) { __builtin_amdgcn_s_sleep(1); \
    if ((++_sp & 255u) == 0u) { if (xb_ld(&(bar)[XB_TMO])) break; if (_sp > XB_SPIN_CAP) { atomicAdd(&(bar)[XB_TMO], 1u); break; } } } } while (0)

struct XcdBarrier {
    unsigned* bar; unsigned x;
    volatile LAS unsigned* st;
};

__device__ __forceinline__ XcdBarrier xcd_barrier_post(unsigned* bar, volatile LAS unsigned* st) {
    XcdBarrier b; b.bar = bar; b.x = xb_xcc_id(); b.st = st;
    if (threadIdx.x == 0) (void)xb_add(&bar[XB_XCNT(b.x)], 1u);
    return b;
}
__device__ __forceinline__ void xcd_barrier_complete(unsigned* bar, unsigned x, unsigned& nloc, unsigned& nx) {
    const unsigned G = gridDim.x * gridDim.y * gridDim.z;
    unsigned sum, cnt, mine, sp = 0u;
    for (;;) {
        sum = 0u; cnt = 0u; mine = 0u;
#pragma unroll
        for (unsigned j = 0; j < 16; ++j) { const unsigned c = xb_ld(&bar[XB_XCNT(j)]); sum += c; cnt += (c > 0u) ? 1u : 0u; mine = (j == x) ? c : mine; }
        if (sum == G) break;
        __builtin_amdgcn_s_sleep(1);
        if ((++sp & 255u) == 0u) { if (xb_ld(&bar[XB_TMO])) break; if (sp > XB_SPIN_CAP) { atomicAdd(&bar[XB_TMO], 1u); break; } }
    }
    nloc = mine > 0u ? mine : 1u; nx = cnt > 0u ? cnt : 1u;
}

__device__ __forceinline__ void xcd_barrier(const XcdBarrier& b) {
    asm volatile("s_waitcnt vmcnt(0)" ::: "memory");
    __syncthreads();
    if (threadIdx.x == 0) {
        unsigned* bar = b.bar;
        __builtin_amdgcn_s_waitcnt(0);
        unsigned nloc = b.st[0], nx = b.st[1];
        if (nloc == 0u) { xcd_barrier_complete(bar, b.x, nloc, nx); b.st[0] = nloc; b.st[1] = nx; }
        const unsigned old = xb_add(&bar[XB_XSUB(b.x)], 1u);
        const unsigned gen = old / nloc;
        if (old + 1u == (gen + 1u) * nloc) {
            __builtin_amdgcn_fence(__ATOMIC_RELEASE, "agent");
            asm volatile("s_waitcnt vmcnt(0)" ::: "memory");
            const unsigned og = xb_add(&bar[XB_TOP], 1u);
            const unsigned tg = og / nx;
            if (og + 1u == (tg + 1u) * nx) xb_add(&bar[XB_TOPGEN], 1u);
            else XB_SPIN(xb_ld(&bar[XB_TOPGEN]) == tg, bar);
            __builtin_amdgcn_fence(__ATOMIC_ACQUIRE, "agent");
            xb_add(&bar[XB_XGEN(b.x)], 1u);
            asm volatile("s_waitcnt vmcnt(0)" ::: "memory");
        } else {
            XB_SPIN(xb_ld(&bar[XB_XGEN(b.x)]) == gen, bar);
            __builtin_amdgcn_fence(__ATOMIC_ACQUIRE, "agent");
            asm volatile("s_waitcnt vmcnt(0)" ::: "memory");
        }
    }
    __syncthreads();
}

constexpr int T = 16384, D = 1024, SEQ = 8192, NCTX = 256, TCX = 512, DIN = 3840, MH = T + TCX;
constexpr int ZU = 0, ZV = 512, ZQ = 1024, ZK = 1536, ZVA = 1664, ZGA = 1792, ZGB = 2816;
constexpr int NEXP = 256, NSLOT = 9, LISTCAP = 16384;
constexpr float LOG2E = 1.4426950408889634f;
constexpr float QSCALE = 0.125f * LOG2E;
constexpr size_t MiB = 1u << 20;
constexpr size_t WS_CTL = 0, CTL_ZERO_BYTES = 1 * MiB;
constexpr size_t WS_ADAP = 1 * MiB;
constexpr size_t WS_ADAF = 2 * MiB;
constexpr size_t WS_ROPE = 2 * MiB + 128 * 1024;
constexpr size_t WS_WST = 2 * MiB + 256 * 1024;
constexpr size_t WS_RWT = 3 * MiB;
constexpr size_t WS_WINT = 4 * MiB;
constexpr size_t WS_WAT = 12 * MiB, WS_WBT = 13 * MiB, WS_WOT = 14 * MiB;
constexpr size_t WS_KVC = 16 * MiB;
constexpr size_t WS_GATEW = 17 * MiB;
constexpr size_t WS_H = 18 * MiB;
constexpr size_t WS_Z = 52 * MiB;
constexpr size_t WS_A = 172 * MiB, WS_O = 188 * MiB;
constexpr size_t WS_TMP = 204 * MiB;
constexpr size_t WS_Y = 268 * MiB;
constexpr size_t WS_X1 = 300 * MiB;
constexpr size_t WS_H2 = 364 * MiB;
constexpr size_t WS_LIST = 396 * MiB;
constexpr size_t WS_CONTRIB = 414 * MiB;
constexpr float CONTRIB_SCALE = 16.f;
constexpr size_t WS_END = 704 * MiB;
constexpr int CW_BAR = 4096;
constexpr int CW_CNT = 16384;
constexpr int CW_XRANK = 32768;
constexpr int SCR_BYTES = 148480;
constexpr int MISC_OFF = SCR_BYTES;
constexpr int LDS_BYTES = 152 * 1024;
constexpr int NWAVES = 8;

typedef float f32x2_t __attribute__((ext_vector_type(2)));
typedef __bf16 bf16x2_t __attribute__((ext_vector_type(2)));
typedef float f32x16 __attribute__((ext_vector_type(16)));
typedef short s16x4 __attribute__((ext_vector_type(4)));
typedef short v4i16_t __attribute__((ext_vector_type(4)));
typedef unsigned u32x2 __attribute__((ext_vector_type(2)));
typedef unsigned u32x4 __attribute__((ext_vector_type(4)));
typedef LAS unsigned char* ldsp;

__device__ __forceinline__ unsigned cvtpk(float lo, float hi) { f32x2_t v = {lo, hi}; bf16x2_t b = __builtin_convertvector(v, bf16x2_t); return __builtin_bit_cast(unsigned, b); }
__device__ __forceinline__ float bf2f(unsigned short u) { return __uint_as_float((unsigned)u << 16); }
__device__ __forceinline__ float bflo(unsigned w) { return __uint_as_float(w << 16); }
__device__ __forceinline__ float bfhi(unsigned w) { return __uint_as_float(w & 0xffff0000u); }
__device__ __forceinline__ float wave_sum(float v) {
#pragma unroll
    for (int o = 1; o < 64; o <<= 1) v += __shfl_xor(v, o);
    return v;
}
__device__ __forceinline__ float sigmoid_f(float x) { return __builtin_amdgcn_rcpf(1.f + __builtin_amdgcn_exp2f(-x * LOG2E)); }
__device__ __forceinline__ float silu_f(float x) { return x * sigmoid_f(x); }
__device__ __forceinline__ float gelu_f(float x) { const float u = 0.7978845608028654f * (x + 0.044715f * x * x * x); return x * sigmoid_f(2.f * u); }
__device__ __forceinline__ f32x16 mfma32(bf16x8 a, bf16x8 b, f32x16 c) { return __builtin_amdgcn_mfma_f32_32x32x16_bf16(a, b, c, 0, 0, 0); }
__device__ __forceinline__ f32x4 mfma16(bf16x8 a, bf16x8 b, f32x4 c) { return __builtin_amdgcn_mfma_f32_16x16x32_bf16(a, b, c, 0, 0, 0); }

struct Args { const float* in[26]; float* out; unsigned char* ws; int ph_lo, ph_hi; };
enum { I_X = 0, I_C, I_CTX, I_CCTX, I_ADAW, I_ADAB, I_N1G, I_N2G, I_WIN, I_LNG, I_LNB, I_GWS, I_GBS, I_SINK, I_WA, I_WB, I_WO, I_RW, I_RB, I_EG, I_EU, I_ED, I_SG, I_SU, I_SD, I_FG };

__device__ __forceinline__ void p0_transpose_item(const float* W, int K, int N, bf16* WT, LAS float* scr, int item, int lane) {
    const int nblk = N / 32, kb = item / nblk, nb = item % nblk, k0 = 64 * kb, n0 = 32 * nb;
#pragma unroll 8
    for (int i = 0; i < 32; ++i) { const int kk = 2 * i + (lane >> 5); scr[kk * 33 + (lane & 31)] = W[(size_t)(k0 + kk) * N + n0 + (lane & 31)]; }
    LDS_WAIT(); asm volatile("" ::: "memory");
    const int c = lane & 7;
#pragma unroll
    for (int j = 0; j < 4; ++j) { const int n = (lane >> 3) + 8 * j; const LAS float* s = scr + (8 * c) * 33 + n;
        v4u o; o.x = pk2(s[0 * 33], s[1 * 33]); o.y = pk2(s[2 * 33], s[3 * 33]); o.z = pk2(s[4 * 33], s[5 * 33]); o.w = pk2(s[6 * 33], s[7 * 33]);
        *(GAS v4u*)(WT + (size_t)(n0 + n) * K + k0 + 8 * c) = o; }
    LDS_WAIT(); asm volatile("" ::: "memory");
}

__device__ __forceinline__ void phase_prep(const Args& a, ldsp lds, int G) {
    const int tid = threadIdx.x, lane = tid & 63, wave = __builtin_amdgcn_readfirstlane(tid >> 6), blk = blockIdx.x;
    unsigned char* ws = a.ws;
    if (blk < 192) {
        const int cb = blk % 24, kc = blk / 24, col = cb * 256 + lane * 4, k0 = kc * 128 + wave * 16;
        const float* c = a.in[I_C]; const float* cc = a.in[I_CCTX]; const float* aw = a.in[I_ADAW];
        f32x4 a0 = {0.f, 0.f, 0.f, 0.f}, a1 = a0, a2 = a0;
#pragma unroll 4
        for (int k = 0; k < 16; ++k) {
            const int kk = k0 + k;
            const float s0 = silu_f(c[kk]), s1 = silu_f(c[1024 + kk]), s2 = silu_f(cc[kk]);
            const f32x4 w = *(const f32x4*)(aw + (size_t)kk * 6144 + col);
            a0 += w * s0; a1 += w * s1; a2 += w * s2;
        }
        LAS float* red = (LAS float*)lds;
        *(LAS f32x4*)(red + (wave * 3 + 0) * 256 + lane * 4) = a0;
        *(LAS f32x4*)(red + (wave * 3 + 1) * 256 + lane * 4) = a1;
        *(LAS f32x4*)(red + (wave * 3 + 2) * 256 + lane * 4) = a2;
        __syncthreads();
        float* adap = (float*)(ws + WS_ADAP);
        for (int idx = tid; idx < 768; idx += 512) {
            const int v = idx >> 8, cl = idx & 255; float s = 0.f;
#pragma unroll
            for (int w = 0; w < 8; ++w) s += red[(w * 3 + v) * 256 + cl];
            adap[(size_t)(kc * 3 + v) * 6144 + cb * 256 + cl] = s;
        }
        __syncthreads();
    }
    {
        LAS float* scr = (LAS float*)(lds + wave * 8704);
        const int gw = blk * NWAVES + wave, NGW = G * NWAVES;
        constexpr int I_1 = 16 * 120, I_2 = 8 * 32, I_3 = 8 * 32, I_4 = 16 * 32, I_5 = 16 * 8;
        for (int it = gw; it < I_1 + I_2 + I_3 + I_4 + I_5; it += NGW) {
            int r = it;
            if (r < I_1) { p0_transpose_item(a.in[I_WIN], 1024, 3840, (bf16*)(ws + WS_WINT), scr, r, lane); continue; } r -= I_1;
            if (r < I_2) { p0_transpose_item(a.in[I_WA], 512, 1024, (bf16*)(ws + WS_WAT), scr, r, lane); continue; } r -= I_2;
            if (r < I_3) { p0_transpose_item(a.in[I_WB], 512, 1024, (bf16*)(ws + WS_WBT), scr, r, lane); continue; } r -= I_3;
            if (r < I_4) { p0_transpose_item(a.in[I_WO], 1024, 1024, (bf16*)(ws + WS_WOT), scr, r, lane); continue; } r -= I_4;
            p0_transpose_item(a.in[I_RW], 1024, 256, (bf16*)(ws + WS_RWT), scr, r, lane);
        }
    }
    {
        const int gt = blk * 512 + tid, NT = G * 512;
        const float* gws = a.in[I_GWS]; bf16* wst = (bf16*)(ws + WS_WST);
        for (int i = gt; i < 8192; i += NT) {
            const f32x4 x0 = *(const f32x4*)(gws + i * 8), x1 = *(const f32x4*)(gws + i * 8 + 4);
            v4u o; o.x = cvtpk(x0[0], x0[1]); o.y = cvtpk(x0[2], x0[3]); o.z = cvtpk(x1[0], x1[1]); o.w = cvtpk(x1[2], x1[3]);
            *(v4u*)(wst + i * 8) = o;
        }
        float* rope = (float*)(ws + WS_ROPE);
        for (int i = gt; i < 2048; i += NT) {
            const int pos = i >> 4, f = i & 15;
            const float inv = __builtin_amdgcn_exp2f(-(float)f * (13.287712379549449f / 16.f));
            const float ang = (float)pos * inv;
            double rev = (double)ang * 0.15915494309189535; rev -= floor(rev);
            rope[pos * 32 + f] = __builtin_amdgcn_cosf((float)rev);
            rope[pos * 32 + 16 + f] = __builtin_amdgcn_sinf((float)rev);
        }
    }
}

__device__ __forceinline__ void phase_hnorm(const Args& a, ldsp lds, int G) {
    const int tid = threadIdx.x, lane = tid & 63, wave = __builtin_amdgcn_readfirstlane(tid >> 6), blk = blockIdx.x;
    unsigned char* ws = a.ws;
    const float* adap = (const float*)(ws + WS_ADAP); const float* adab = a.in[I_ADAB];
    LAS float* modv = (LAS float*)lds;
    for (int idx = tid; idx < 3 * 2048; idx += 512) {
        const int v = idx >> 11, j = idx & 2047; float s = adab[j];
#pragma unroll
        for (int kc = 0; kc < 8; ++kc) s += adap[(size_t)(kc * 3 + v) * 6144 + j];
        modv[idx] = (j >= 1024) ? s + 1.f : s;
    }
    { float* adaf = (float*)(ws + WS_ADAF);
      for (int idx = blk * 512 + tid; idx < 3 * 6144; idx += G * 512) {
          const int v = idx / 6144, j = idx % 6144; float s = adab[j];
#pragma unroll
          for (int kc = 0; kc < 8; ++kc) s += adap[(size_t)(kc * 3 + v) * 6144 + j];
          adaf[idx] = s; } }
    __syncthreads();
    const float* g1 = a.in[I_N1G]; bf16* H = (bf16*)(ws + WS_H);
    for (int t = blk * NWAVES + wave; t < MH; t += G * NWAVES) {
        const float* xr = (t < T) ? a.in[I_X] + (size_t)t * D : a.in[I_CTX] + (size_t)(t - T) * D;
        const int v = (t < T) ? (t >> 13) : 2;
        f32x4 x[4]; float ss = 0.f;
#pragma unroll
        for (int j = 0; j < 4; ++j) { x[j] = *(const f32x4*)(xr + 4 * lane + 256 * j); ss += (x[j][0] * x[j][0] + x[j][1] * x[j][1]) + (x[j][2] * x[j][2] + x[j][3] * x[j][3]); }
        const float r = rsqrtf(wave_sum(ss) * (1.f / D) + 1e-6f);
#pragma unroll
        for (int j = 0; j < 4; ++j) {
            const int col = 4 * lane + 256 * j;
            const f32x4 g = *(const f32x4*)(g1 + col);
            const f32x4 sh = *(LAS f32x4*)(modv + v * 2048 + col), sc = *(LAS f32x4*)(modv + v * 2048 + 1024 + col);
            const f32x4 h = (x[j] * r) * g * sc + sh;
            u32x2 o; o.x = cvtpk(h[0], h[1]); o.y = cvtpk(h[2], h[3]);
            *(u32x2*)(H + (size_t)t * D + col) = o;
        }
    }
}

struct WinOrder {
    pg8::StaticOrder so;
    __device__ void init(int G, int c) { so.init(T, DIN, G, c); }
    __device__ bool next(int i, pg8::Unit& u) const {
        const long L = (long)i * so.G + so.c;
        if (L < 960) return so.next(i, u);
        if (L < 962) { u.pm = 64 + (int)(L - 960); u.pn = 6; return true; }
        return false;
    }
    __device__ __forceinline__ void a_ready(const pg8::Unit&) const {}
    __device__ __forceinline__ void done(const pg8::Unit&) const {}
};
struct EpiWin {
    static constexpr bool PERM = false, AFTER_DRAIN = false;
    bf16* Z; bf16* KVC; const float* rope;
    __device__ __forceinline__ void operator()(const pg8::f32x4 (&acc)[2][2][4][2], const pg8::Unit& u, int wr, int wc, int fr, int fq) const {
        const int row0 = u.pm * 256 + wr * 64 + fr, colb = u.pn * 256 + wc * 32 + 4 * fq, pn = u.pn;
        if (u.pm >= 64) {
#pragma unroll
            for (int ai = 0; ai < 2; ++ai)
#pragma unroll
                for (int m = 0; m < 4; ++m) { bf16* rp = KVC + (size_t)(row0 + ai * 128 + m * 16 - T) * 256 + (colb - ZK);
#pragma unroll
                    for (int bj = 0; bj < 2; ++bj)
#pragma unroll
                        for (int n = 0; n < 2; ++n) { const pg8::f32x4 v = acc[ai][bj][m][n]; u32x2 o; o.x = cvtpk(v[0], v[1]); o.y = cvtpk(v[2], v[3]); *(u32x2*)(rp + bj * 128 + n * 16) = o; } }
            return;
        }
#pragma unroll
        for (int ai = 0; ai < 2; ++ai)
#pragma unroll
            for (int m = 0; m < 4; ++m) {
                const int r = row0 + ai * 128 + m * 16; bf16* rp = Z + (size_t)r * DIN + colb;
                if (pn <= 3) {
#pragma unroll
                    for (int bj = 0; bj < 2; ++bj)
#pragma unroll
                        for (int n = 0; n < 2; ++n) { const pg8::f32x4 v = acc[ai][bj][m][n]; u32x2 o; o.x = cvtpk(gelu_f(v[0]), gelu_f(v[1])); o.y = cvtpk(gelu_f(v[2]), gelu_f(v[3])); *(u32x2*)(rp + bj * 128 + n * 16) = o; }
                } else if (pn <= 6) {
                    const int pos = (wc & 1) ? (r & 63) : ((r & 8191) >> 6);
                    const pg8::f32x4 cs = *(const pg8::f32x4*)(rope + pos * 32 + 4 * fq), sn = *(const pg8::f32x4*)(rope + pos * 32 + 16 + 4 * fq);
                    const float sc = (pn < 6) ? QSCALE : 1.f;
#pragma unroll
                    for (int bj = 0; bj < 2; ++bj) {
                        const pg8::f32x4 x1 = acc[ai][bj][m][0], x2 = acc[ai][bj][m][1];
                        pg8::f32x4 o1, o2;
                        if (pn == 6 && bj == 1) { o1 = x1; o2 = x2; }
                        else { o1 = (x1 * cs - x2 * sn) * sc; o2 = (x2 * cs + x1 * sn) * sc; }
                        u32x2 w1, w2; w1.x = cvtpk(o1[0], o1[1]); w1.y = cvtpk(o1[2], o1[3]); w2.x = cvtpk(o2[0], o2[1]); w2.y = cvtpk(o2[2], o2[3]);
                        *(u32x2*)(rp + bj * 128) = w1; *(u32x2*)(rp + bj * 128 + 16) = w2;
                    }
                } else {
#pragma unroll
                    for (int bj = 0; bj < 2; ++bj)
#pragma unroll
                        for (int n = 0; n < 2; ++n) { const pg8::f32x4 v = acc[ai][bj][m][n]; u32x2 o; o.x = cvtpk(sigmoid_f(v[0]), sigmoid_f(v[1])); o.y = cvtpk(sigmoid_f(v[2]), sigmoid_f(v[3])); *(u32x2*)(rp + bj * 128 + n * 16) = o; }
                }
            }
    }
};
struct EpiMergeA {
    static constexpr bool PERM = true, AFTER_DRAIN = false;
    const bf16* Z; bf16* Y;
    __device__ __forceinline__ void operator()(const pg8::f32x4 (&acc)[2][2][4][2], const pg8::Unit& u, int wr, int wc, int fr, int fq) const {
        const int row0 = u.pm * 256 + wr * 64 + fr, col0 = u.pn * 256 + wc * 32 + 8 * fq;
#pragma unroll
        for (int ai = 0; ai < 2; ++ai)
#pragma unroll
            for (int m = 0; m < 4; ++m) { const int r = row0 + ai * 128 + m * 16;
#pragma unroll
                for (int bj = 0; bj < 2; ++bj) { const int c = col0 + bj * 128;
                    const u32x4 g = *(const u32x4*)(Z + (size_t)r * DIN + ZGA + c);
                    const pg8::f32x4 v0 = acc[ai][bj][m][0], v1 = acc[ai][bj][m][1];
                    u32x4 o;
                    o.x = cvtpk(v0[0] * bflo(g.x), v0[1] * bfhi(g.x)); o.y = cvtpk(v0[2] * bflo(g.y), v0[3] * bfhi(g.y));
                    o.z = cvtpk(v1[0] * bflo(g.z), v1[1] * bfhi(g.z)); o.w = cvtpk(v1[2] * bflo(g.w), v1[3] * bfhi(g.w));
                    *(u32x4*)(Y + (size_t)r * D + c) = o; } }
    }
};
struct EpiMergeB {
    static constexpr bool PERM = true, AFTER_DRAIN = false;
    const bf16* Z; bf16* Y;
    __device__ __forceinline__ void operator()(const pg8::f32x4 (&acc)[2][2][4][2], const pg8::Unit& u, int wr, int wc, int fr, int fq) const {
        const int row0 = u.pm * 256 + wr * 64 + fr, col0 = u.pn * 256 + wc * 32 + 8 * fq;
#pragma unroll
        for (int ai = 0; ai < 2; ++ai)
#pragma unroll
            for (int m = 0; m < 4; ++m) { const int r = row0 + ai * 128 + m * 16;
#pragma unroll
                for (int bj = 0; bj < 2; ++bj) { const int c = col0 + bj * 128;
                    const u32x4 g = *(const u32x4*)(Z + (size_t)r * DIN + ZGB + c);
                    const u32x4 tp = *(const u32x4*)(Y + (size_t)r * D + c);
                    const pg8::f32x4 t0 = {bflo(tp.x), bfhi(tp.x), bflo(tp.y), bfhi(tp.y)}, t1 = {bflo(tp.z), bfhi(tp.z), bflo(tp.w), bfhi(tp.w)};
                    const pg8::f32x4 v0 = acc[ai][bj][m][0], v1 = acc[ai][bj][m][1];
                    u32x4 o;
                    o.x = cvtpk(t0[0] + v0[0] * bflo(g.x), t0[1] + v0[1] * bfhi(g.x)); o.y = cvtpk(t0[2] + v0[2] * bflo(g.y), t0[3] + v0[3] * bfhi(g.y));
                    o.z = cvtpk(t1[0] + v1[0] * bflo(g.z), t1[1] + v1[1] * bfhi(g.z)); o.w = cvtpk(t1[2] + v1[2] * bflo(g.w), t1[3] + v1[3] * bfhi(g.w));
                    *(u32x4*)(Y + (size_t)r * D + c) = o; } }
    }
};
struct EpiWo {
    static constexpr bool PERM = true, AFTER_DRAIN = false;
    const float* x; const float* adaf; bf16* X1;
    __device__ __forceinline__ void operator()(const pg8::f32x4 (&acc)[2][2][4][2], const pg8::Unit& u, int wr, int wc, int fr, int fq) const {
        const int row0 = u.pm * 256 + wr * 64 + fr, col0 = u.pn * 256 + wc * 32 + 8 * fq;
        const float* g1 = adaf + (u.pm >= 32 ? 6144 : 0) + 2048;
#pragma unroll
        for (int bj = 0; bj < 2; ++bj) { const int c = col0 + bj * 128;
            const pg8::f32x4 ga = *(const pg8::f32x4*)(g1 + c), gb = *(const pg8::f32x4*)(g1 + c + 4);
#pragma unroll
            for (int ai = 0; ai < 2; ++ai)
#pragma unroll
                for (int m = 0; m < 4; ++m) { const int r = row0 + ai * 128 + m * 16;
                    const pg8::f32x4 x0 = *(const pg8::f32x4*)(x + (size_t)r * D + c), x1 = *(const pg8::f32x4*)(x + (size_t)r * D + c + 4);
                    const pg8::f32x4 o0 = x0 + ga * acc[ai][bj][m][0], o1 = x1 + gb * acc[ai][bj][m][1];
                    u32x4 w; w.x = cvtpk(o0[0], o0[1]); w.y = cvtpk(o0[2], o0[3]); w.z = cvtpk(o1[0], o1[1]); w.w = cvtpk(o1[2], o1[3]);
                    *(u32x4*)(X1 + (size_t)r * D + c) = w; } }
    }
};


__device__ __forceinline__ s16x4 vtr(LAS const unsigned char* p) { return __builtin_bit_cast(s16x4, __builtin_amdgcn_ds_read_tr16_b64_v4i16((LAS v4i16_t*)p)); }

__device__ __forceinline__ void attn_item(const bf16* Z, const bf16* KVC, const float* sink, bf16* Obuf, ldsp lds, int b, int nb, int hk, int qh) {
    const int tid = threadIdx.x, lane = tid & 63, wave = __builtin_amdgcn_readfirstlane(tid >> 6), r32 = lane & 31, hi = lane >> 5;
    const int rq = wave >> 1, head = hk * 4 + rq;
    const int iq = qh * 64 + (wave & 1) * 32 + r32;
    const int wlo = (nb == 0) ? 2 : qh, whi = (nb == 63) ? 4 : 5 + qh, nwin = whi - wlo, ntile = nwin + 4;
    const int tokq = b * SEQ + nb * 128 + iq;
    bf16x8 qr[4];
#pragma unroll
    for (int d0 = 0; d0 < 4; ++d0) qr[d0] = *(const bf16x8*)(Z + (size_t)tokq * DIN + ZQ + head * 64 + d0 * 16 + hi * 8);
    float mrun = sink[head] * LOG2E, lrun = (hi == 0) ? 1.f : 0.f;
    f32x16 o[2];
#pragma unroll
    for (int j = 0; j < 2; ++j)
#pragma unroll
        for (int r = 0; r < 16; ++r) o[j][r] = 0.f;
    const int kdst = wave * 1024 + lane * 16, vdst = 8192 + (wave >> 2) * 4096 + lane * 64 + (wave & 3) * 16;
#define ATT_SRC(s, kp, vp) do { const int tl_ = (s) < nwin ? wlo + (s) : 6 + (s) - nwin; \
        if (tl_ < 6) { const int tok_ = b * SEQ + (nb - 1 + (tl_ >> 1)) * 128 + (tl_ & 1) * 64 + lane; kp = Z + (size_t)tok_ * DIN + ZK + hk * 64 + wave * 8; vp = Z + (size_t)tok_ * DIN + ZVA + hk * 64 + wave * 8; } \
        else { const int row_ = b * NCTX + (tl_ - 6) * 64 + lane; kp = KVC + (size_t)row_ * 256 + hk * 64 + wave * 8; vp = KVC + (size_t)row_ * 256 + 128 + hk * 64 + wave * 8; } } while (0)
    u32x4 kreg, vreg;
    { const bf16 *kp, *vp; ATT_SRC(0, kp, vp); kreg = *(const u32x4*)kp; vreg = *(const u32x4*)vp; }
    *(LAS u32x4*)(lds + kdst) = kreg; *(LAS u32x4*)(lds + vdst) = vreg;
    __syncthreads();
    const int vrd = ((lane & 15) >> 2) * 64 + ((lane >> 4) & 1) * 32 + (lane & 3) * 8 + hi * 256;
    for (int s = 0; s < ntile; ++s) {
        const int base = (s & 1) * 16384;
        const int tl = s < nwin ? wlo + s : 6 + s - nwin;
        if (s + 1 < ntile) { const bf16 *kp, *vp; ATT_SRC(s + 1, kp, vp); kreg = *(const u32x4*)kp; vreg = *(const u32x4*)vp; }
        {
            f32x16 p0, p1;
#pragma unroll
            for (int r = 0; r < 16; ++r) { p0[r] = 0.f; p1[r] = 0.f; }
#pragma unroll
            for (int d0 = 0; d0 < 4; ++d0) {
                const bf16x8 k0 = *(LAS const bf16x8*)(lds + base + (2 * d0 + hi) * 1024 + r32 * 16);
                const bf16x8 k1 = *(LAS const bf16x8*)(lds + base + (2 * d0 + hi) * 1024 + (r32 + 32) * 16);
                p0 = mfma32(k0, qr[d0], p0); p1 = mfma32(k1, qr[d0], p1);
            }
            if (tl < 2) {
                const int j0 = (tl & 1) * 64 + 4 * hi;
#pragma unroll
                for (int r = 0; r < 16; ++r) { const int j = j0 + (r & 3) + 8 * (r >> 2); if (j < iq) p0[r] = -INFINITY; if (j + 32 < iq) p1[r] = -INFINITY; }
            } else if (tl == 4 || tl == 5) {
                const int j0 = (tl & 1) * 64 + 4 * hi;
#pragma unroll
                for (int r = 0; r < 16; ++r) { const int j = j0 + (r & 3) + 8 * (r >> 2); if (j > iq) p0[r] = -INFINITY; if (j + 32 > iq) p1[r] = -INFINITY; }
            }
            float mx = fmaxf(p0[0], p1[0]);
#pragma unroll
            for (int r = 1; r < 16; ++r) mx = fmaxf(mx, fmaxf(p0[r], p1[r]));
            mx = fmaxf(mx, __shfl_xor(mx, 32));
            const float mn = fmaxf(mrun, mx), alpha = __builtin_amdgcn_exp2f(mrun - mn);
            mrun = mn;
            float rs = 0.f;
#pragma unroll
            for (int r = 0; r < 16; ++r) { p0[r] = __builtin_amdgcn_exp2f(p0[r] - mn); p1[r] = __builtin_amdgcn_exp2f(p1[r] - mn); rs += p0[r] + p1[r]; }
            lrun = lrun * alpha + rs;
#pragma unroll
            for (int r = 0; r < 16; ++r) { o[0][r] *= alpha; o[1][r] *= alpha; }
            bf16x8 pf[4];
#pragma unroll
            for (int s4 = 0; s4 < 4; ++s4) {
                u32x4 w;
                if (s4 < 2) { w.x = cvtpk(p0[8 * s4 + 0], p0[8 * s4 + 1]); w.y = cvtpk(p0[8 * s4 + 2], p0[8 * s4 + 3]); w.z = cvtpk(p0[8 * s4 + 4], p0[8 * s4 + 5]); w.w = cvtpk(p0[8 * s4 + 6], p0[8 * s4 + 7]); }
                else { const int q = s4 - 2; w.x = cvtpk(p1[8 * q + 0], p1[8 * q + 1]); w.y = cvtpk(p1[8 * q + 2], p1[8 * q + 3]); w.z = cvtpk(p1[8 * q + 4], p1[8 * q + 5]); w.w = cvtpk(p1[8 * q + 6], p1[8 * q + 7]); }
                pf[s4] = __builtin_bit_cast(bf16x8, w);
            }
#pragma unroll
            for (int dblk = 0; dblk < 2; ++dblk)
#pragma unroll
                for (int s4 = 0; s4 < 4; ++s4) {
                    const s16x4 lo = vtr(lds + base + 8192 + dblk * 4096 + vrd + (16 * s4) * 64);
                    const s16x4 hh = vtr(lds + base + 8192 + dblk * 4096 + vrd + (16 * s4 + 8) * 64);
                    const bf16x8 vf = {lo[0], lo[1], lo[2], lo[3], hh[0], hh[1], hh[2], hh[3]};
                    o[dblk] = mfma32(vf, pf[s4], o[dblk]);
                }
        }
        if (s + 1 < ntile) { *(LAS u32x4*)(lds + (16384 - base) + kdst) = kreg; *(LAS u32x4*)(lds + (16384 - base) + vdst) = vreg; }
        __syncthreads();
    }
#undef ATT_SRC
    {
        const float lt = lrun + __shfl_xor(lrun, 32), inv = 1.f / lt;
        bf16* op = Obuf + (size_t)tokq * 512 + head * 64;
#pragma unroll
        for (int dblk = 0; dblk < 2; ++dblk)
#pragma unroll
            for (int r4 = 0; r4 < 4; ++r4) {
                u32x2 w; w.x = cvtpk(o[dblk][4 * r4] * inv, o[dblk][4 * r4 + 1] * inv); w.y = cvtpk(o[dblk][4 * r4 + 2] * inv, o[dblk][4 * r4 + 3] * inv);
                *(u32x2*)(op + 32 * dblk + 8 * r4 + 4 * hi) = w;
            }
    }
}

__device__ __forceinline__ void gmlp_item(const bf16* Z, const float* lng, const float* lnb, const bf16* WsT, const float* bs, bf16* Abuf, ldsp lds, int ch, int gp) {
    const int tid = threadIdx.x, lane = tid & 63, wave = __builtin_amdgcn_readfirstlane(tid >> 6), fr = lane & 15, fq = lane >> 4;
    const int tok0 = ch * 128;
    LAS bf16* VT = (LAS bf16*)lds;
    f32x4 gA = *(const f32x4*)(lng + lane * 8), gB = *(const f32x4*)(lng + lane * 8 + 4), bA = *(const f32x4*)(lnb + lane * 8), bB = *(const f32x4*)(lnb + lane * 8 + 4);
#pragma unroll
    for (int rnd = 0; rnd < 2; ++rnd) {
        float y[8][8];
#pragma unroll
        for (int j = 0; j < 8; ++j) {
            const int tok = tok0 + wave * 16 + rnd * 8 + j;
            const u32x4 raw = *(const u32x4*)(Z + (size_t)tok * DIN + ZV + lane * 8);
            float x[8] = {bflo(raw.x), bfhi(raw.x), bflo(raw.y), bfhi(raw.y), bflo(raw.z), bfhi(raw.z), bflo(raw.w), bfhi(raw.w)};
            float s = 0.f;
#pragma unroll
            for (int i = 0; i < 8; ++i) s += x[i];
            const float mu = wave_sum(s) * (1.f / 512.f);
            float q = 0.f;
#pragma unroll
            for (int i = 0; i < 8; ++i) { x[i] -= mu; q += x[i] * x[i]; }
            const float rstd = rsqrtf(wave_sum(q) * (1.f / 512.f) + 1e-6f);
            y[j][0] = x[0] * rstd * gA[0] + bA[0]; y[j][1] = x[1] * rstd * gA[1] + bA[1]; y[j][2] = x[2] * rstd * gA[2] + bA[2]; y[j][3] = x[3] * rstd * gA[3] + bA[3];
            y[j][4] = x[4] * rstd * gB[0] + bB[0]; y[j][5] = x[5] * rstd * gB[1] + bB[1]; y[j][6] = x[6] * rstd * gB[2] + bB[2]; y[j][7] = x[7] * rstd * gB[3] + bB[3];
        }
        if ((lane >> 5) == gp) {
            const int gl = (lane >> 4) & 1;
#pragma unroll
            for (int i = 0; i < 8; ++i) {
                u32x4 w; w.x = cvtpk(y[0][i], y[1][i]); w.y = cvtpk(y[2][i], y[3][i]); w.z = cvtpk(y[4][i], y[5][i]); w.w = cvtpk(y[6][i], y[7][i]);
                *(LAS u32x4*)(VT + gl * (128 * 136) + (8 * (lane & 15) + i) * 136 + wave * 16 + rnd * 8) = w;
            }
        }
    }
    __syncthreads();
    const int wm = wave >> 1, wn = wave & 1;
#pragma unroll
    for (int gl = 0; gl < 2; ++gl) {
        const int g = 2 * gp + gl;
        f32x4 acc[2][4];
#pragma unroll
        for (int m = 0; m < 2; ++m)
#pragma unroll
            for (int n = 0; n < 4; ++n) acc[m][n] = (f32x4){0.f, 0.f, 0.f, 0.f};
#pragma unroll
        for (int ks = 0; ks < 4; ++ks) {
            bf16x8 af[2], bfr[4];
#pragma unroll
            for (int m = 0; m < 2; ++m) af[m] = *(const bf16x8*)(WsT + (size_t)g * 16384 + (32 * wm + 16 * m + fr) * 128 + 32 * ks + 8 * fq);
#pragma unroll
            for (int n = 0; n < 4; ++n) bfr[n] = *(LAS const bf16x8*)(VT + gl * (128 * 136) + (64 * wn + 16 * n + fr) * 136 + 32 * ks + 8 * fq);
#pragma unroll
            for (int m = 0; m < 2; ++m)
#pragma unroll
                for (int n = 0; n < 4; ++n) acc[m][n] = mfma16(bfr[n], af[m], acc[m][n]);
        }
#pragma unroll
        for (int m = 0; m < 2; ++m) {
            const int p = 32 * wm + 16 * m + fr, tok = tok0 + p; const float bias = bs[g * 128 + p];
#pragma unroll
            for (int n = 0; n < 4; ++n) {
                const int c = g * 128 + 64 * wn + 16 * n + 4 * fq;
                const u32x2 uw = *(const u32x2*)(Z + (size_t)tok * DIN + ZU + c);
                u32x2 w; w.x = cvtpk(bflo(uw.x) * (acc[m][n][0] + bias), bfhi(uw.x) * (acc[m][n][1] + bias)); w.y = cvtpk(bflo(uw.y) * (acc[m][n][2] + bias), bfhi(uw.y) * (acc[m][n][3] + bias));
                *(u32x2*)(Abuf + (size_t)tok * 512 + c) = w;
            }
        }
    }
    __syncthreads();
}

__device__ __forceinline__ void phase_mixers(const Args& a, ldsp lds, int G, int vcu) {
    unsigned char* ws = a.ws;
    const bf16* Z = (const bf16*)(ws + WS_Z);
    for (int it = vcu; it < 512; it += G) {
        const int qh = it & 1, hk = (it >> 1) & 1, nb = (it >> 2) & 63, b = it >> 8;
        attn_item(Z, (const bf16*)(ws + WS_KVC), a.in[I_SINK], (bf16*)(ws + WS_O), lds, b, nb, hk, qh);
    }
    for (int it = vcu; it < 256; it += G) {
        gmlp_item(Z, a.in[I_LNG], a.in[I_LNB], (const bf16*)(ws + WS_WST), a.in[I_GBS], (bf16*)(ws + WS_A), lds, it >> 1, it & 1);
    }
}

#define KI_BEFORE(ka, ia, kb, ib) (((ka) > (kb)) || ((ka) == (kb) && (ia) < (ib)))
#define KI_CAS(K, I, p, q) do { const bool sw_ = KI_BEFORE(K[q], I[q], K[p], I[p]); const float kp_ = sw_ ? K[q] : K[p], kq_ = sw_ ? K[p] : K[q]; const int ip_ = sw_ ? I[q] : I[p], iq_ = sw_ ? I[p] : I[q]; \
        K[p] = kp_; I[p] = ip_; K[q] = kq_; I[q] = iq_; } while (0)
#define KI_SORT8(K, I) do { KI_CAS(K, I, 0, 1); KI_CAS(K, I, 2, 3); KI_CAS(K, I, 4, 5); KI_CAS(K, I, 6, 7); \
        KI_CAS(K, I, 0, 2); KI_CAS(K, I, 1, 3); KI_CAS(K, I, 4, 6); KI_CAS(K, I, 5, 7); \
        KI_CAS(K, I, 1, 2); KI_CAS(K, I, 5, 6); KI_CAS(K, I, 0, 4); KI_CAS(K, I, 3, 7); \
        KI_CAS(K, I, 1, 5); KI_CAS(K, I, 2, 6); KI_CAS(K, I, 1, 4); KI_CAS(K, I, 3, 6); \
        KI_CAS(K, I, 2, 4); KI_CAS(K, I, 3, 5); KI_CAS(K, I, 3, 4); } while (0)
#define KI_MERGE8(KA, IA, KB, IB) do { \
        _Pragma("unroll") for (int r_ = 0; r_ < 8; ++r_) { const bool tb_ = KI_BEFORE(KB[7 - r_], IB[7 - r_], KA[r_], IA[r_]); KA[r_] = tb_ ? KB[7 - r_] : KA[r_]; IA[r_] = tb_ ? IB[7 - r_] : IA[r_]; } \
        KI_CAS(KA, IA, 0, 4); KI_CAS(KA, IA, 1, 5); KI_CAS(KA, IA, 2, 6); KI_CAS(KA, IA, 3, 7); \
        KI_CAS(KA, IA, 0, 2); KI_CAS(KA, IA, 1, 3); KI_CAS(KA, IA, 4, 6); KI_CAS(KA, IA, 5, 7); \
        KI_CAS(KA, IA, 0, 1); KI_CAS(KA, IA, 2, 3); KI_CAS(KA, IA, 4, 5); KI_CAS(KA, IA, 6, 7); } while (0)
__device__ __forceinline__ void router_item(const Args& a, ldsp lds, int it) {
    const int tid = threadIdx.x, lane = tid & 63, wave = __builtin_amdgcn_readfirstlane(tid >> 6), fr = lane & 15, fq = lane >> 4;
    unsigned char* ws = a.ws;
    const int t0 = it * 64, b = t0 >> 13;
    const bf16* X1 = (const bf16*)(ws + WS_X1); const float* adaf = (const float*)(ws + WS_ADAF) + b * 6144;
    const float* g2 = a.in[I_N2G]; bf16* H2 = (bf16*)(ws + WS_H2);
    {
        f32x4 gm[2][2], sh[2][2];
#pragma unroll
        for (int j = 0; j < 2; ++j)
#pragma unroll
            for (int h = 0; h < 2; ++h) {
                const int c = 8 * lane + 512 * j + 4 * h;
                const f32x4 gg = *(const f32x4*)(g2 + c), sc = *(const f32x4*)(adaf + 4 * 1024 + c);
                gm[j][h] = gg * (sc + 1.f); sh[j][h] = *(const f32x4*)(adaf + 3 * 1024 + c);
            }
#pragma unroll
        for (int half = 0; half < 2; ++half) {
            f32x4 x[4][2][2];
#pragma unroll
            for (int tt = 0; tt < 4; ++tt)
#pragma unroll
                for (int j = 0; j < 2; ++j) {
                    const u32x4 w = *(const u32x4*)(X1 + (size_t)(t0 + wave * 8 + half * 4 + tt) * D + 8 * lane + 512 * j);
                    x[tt][j][0] = (f32x4){bflo(w.x), bfhi(w.x), bflo(w.y), bfhi(w.y)}; x[tt][j][1] = (f32x4){bflo(w.z), bfhi(w.z), bflo(w.w), bfhi(w.w)};
                }
#pragma unroll
            for (int tt = 0; tt < 4; ++tt) {
                const int row = wave * 8 + half * 4 + tt, tok = t0 + row;
                float ss = 0.f;
#pragma unroll
                for (int j = 0; j < 2; ++j)
#pragma unroll
                    for (int h = 0; h < 2; ++h) { const f32x4 v = x[tt][j][h]; ss += (v[0] * v[0] + v[1] * v[1]) + (v[2] * v[2] + v[3] * v[3]); }
                const float r = rsqrtf(wave_sum(ss) * (1.f / D) + 1e-6f);
#pragma unroll
                for (int j = 0; j < 2; ++j) {
                    const f32x4 h0 = (x[tt][j][0] * r) * gm[j][0] + sh[j][0], h1 = (x[tt][j][1] * r) * gm[j][1] + sh[j][1];
                    u32x4 w; w.x = cvtpk(h0[0], h0[1]); w.y = cvtpk(h0[2], h0[3]); w.z = cvtpk(h1[0], h1[1]); w.w = cvtpk(h1[2], h1[3]);
                    *(u32x4*)(H2 + (size_t)tok * D + 8 * lane + 512 * j) = w;
                    const int kc = lane + 64 * j;
                    *(LAS u32x4*)(lds + kc * 1024 + ((row ^ (kc & 7)) * 16)) = w;
                }
            }
        }
    }
    __syncthreads();
    f32x4 acc[4][2];
#pragma unroll
    for (int m = 0; m < 4; ++m)
#pragma unroll
        for (int n = 0; n < 2; ++n) acc[m][n] = (f32x4){0.f, 0.f, 0.f, 0.f};
    const bf16* RwT = (const bf16*)(ws + WS_RWT) + (size_t)(32 * wave + fr) * D + 8 * fq;
#pragma unroll 8
    for (int ks = 0; ks < 32; ++ks) {
        const int kc = 4 * ks + fq;
        bf16x8 af[4], bfr[2];
#pragma unroll
        for (int n = 0; n < 2; ++n) bfr[n] = *(const bf16x8*)(RwT + (size_t)(16 * n) * D + 32 * ks);
#pragma unroll
        for (int m = 0; m < 4; ++m) af[m] = *(LAS const bf16x8*)(lds + kc * 1024 + (((16 * m + fr) ^ (kc & 7)) * 16));
#pragma unroll
        for (int m = 0; m < 4; ++m)
#pragma unroll
            for (int n = 0; n < 2; ++n) acc[m][n] = mfma16(af[m], bfr[n], acc[m][n]);
    }
    __syncthreads();
    LAS float* LG = (LAS float*)lds;
#pragma unroll
    for (int m = 0; m < 4; ++m)
#pragma unroll
        for (int n = 0; n < 2; ++n)
#pragma unroll
            for (int reg = 0; reg < 4; ++reg) LG[(32 * wave + 16 * n + fr) * 65 + 16 * m + 4 * fq + reg] = acc[m][n][reg];
    __syncthreads();
    LAS float* CK = (LAS float*)(lds + 69632); LAS int* CI = (LAS int*)(lds + 69632 + 16384);
    const float* rb = a.in[I_RB];
    float bk[8]; int bi[8];
#pragma unroll
    for (int q = 0; q < 4; ++q) {
        float gk[8]; int gi[8];
#pragma unroll
        for (int j = 0; j < 8; ++j) { const int e = 32 * wave + 8 * q + j; gk[j] = sigmoid_f(LG[e * 65 + lane]) + rb[e]; gi[j] = e; }
        KI_SORT8(gk, gi);
        if (q == 0) {
#pragma unroll
            for (int j = 0; j < 8; ++j) { bk[j] = gk[j]; bi[j] = gi[j]; }
        } else KI_MERGE8(bk, bi, gk, gi);
    }
#pragma unroll
    for (int r = 0; r < 8; ++r) { CK[(wave * 8 + r) * 64 + lane] = bk[r]; CI[(wave * 8 + r) * 64 + lane] = bi[r]; }
    __syncthreads();
#define RT_LEVEL(lvl) do { if ((wave & (2 * (lvl) - 1)) == 0) { float ok_[8]; int oi_[8]; \
            _Pragma("unroll") for (int r = 0; r < 8; ++r) { ok_[r] = CK[((wave + (lvl)) * 8 + r) * 64 + lane]; oi_[r] = CI[((wave + (lvl)) * 8 + r) * 64 + lane]; } \
            KI_MERGE8(bk, bi, ok_, oi_); \
            if ((lvl) < 4) { _Pragma("unroll") for (int r = 0; r < 8; ++r) { CK[(wave * 8 + r) * 64 + lane] = bk[r]; CI[(wave * 8 + r) * 64 + lane] = bi[r]; } } } \
        __syncthreads(); } while (0)
    RT_LEVEL(1); RT_LEVEL(2); RT_LEVEL(4);
#undef RT_LEVEL
    LAS unsigned* hist = (LAS unsigned*)(lds + 102400); LAS unsigned* hbase = hist + 256;
    if (tid < 256) hist[tid] = 0u;
    __syncthreads();
    unsigned* cnt = (unsigned*)(ws + WS_CTL) + CW_CNT; int* list = (int*)(ws + WS_LIST); float* gatew = (float*)(ws + WS_GATEW);
    unsigned rank[8];
    if (wave == 0) {
        const int tok = t0 + lane;
        float sel[8], ssum = 0.f;
#pragma unroll
        for (int r = 0; r < 8; ++r) { sel[r] = sigmoid_f(LG[bi[r] * 65 + lane]); ssum += sel[r]; }
#pragma unroll
        for (int r = 0; r < 8; ++r) rank[r] = __hip_atomic_fetch_add(&hist[bi[r]], 1u, __ATOMIC_RELAXED, __HIP_MEMORY_SCOPE_WORKGROUP);
        const float sc = 2.5f / ssum;
        f32x4 g0 = {sel[0] * sc, sel[1] * sc, sel[2] * sc, sel[3] * sc}, g1 = {sel[4] * sc, sel[5] * sc, sel[6] * sc, sel[7] * sc};
        *(f32x4*)(gatew + tok * 8) = g0; *(f32x4*)(gatew + tok * 8 + 4) = g1;
    }
    __syncthreads();
    if (tid < 256) { const unsigned h = hist[tid]; if (h) hbase[tid] = atomicAdd(cnt + 32 * tid, h); }
    __syncthreads();
    if (wave == 0) {
        const int tok = t0 + lane;
#pragma unroll
        for (int r = 0; r < 8; ++r) list[(size_t)bi[r] * LISTCAP + hbase[bi[r]] + rank[r]] = tok * NSLOT + r;
    }
    __syncthreads();
}

__device__ __forceinline__ void moe_tile(const Args& a, ldsp lds, int e, int mt, int nrows, int ntl) {
    const int tid = threadIdx.x, lane = tid & 63, wave = __builtin_amdgcn_readfirstlane(tid >> 6), fr = lane & 15, fq = lane >> 4;
    unsigned char* ws = a.ws;
    constexpr int ASTG = 0, BSTG = 16384, ACT = 49152, SLOTS = 114688, GWO = 115200;
    const bf16* H2 = (const bf16*)(ws + WS_H2);
    const float* Wg = (e < NEXP) ? a.in[I_EG] + (size_t)e * 262144 : a.in[I_SG];
    const float* Wu = (e < NEXP) ? a.in[I_EU] + (size_t)e * 262144 : a.in[I_SU];
    const float* Wd = (e < NEXP) ? a.in[I_ED] + (size_t)e * 262144 : a.in[I_SD];
    if (tid < 128) {
        int slot = -1; float gw = 0.f;
        if (tid < nrows) {
            if (e < NEXP) { slot = ((const int*)(ws + WS_LIST))[(size_t)e * LISTCAP + mt * 128 + tid]; gw = ((const float*)(ws + WS_GATEW))[(slot / NSLOT) * 8 + (slot % NSLOT)]; }
            else { slot = (mt * 128 + tid) * NSLOT + 8; gw = 1.f; }
        }
        ((LAS int*)(lds + SLOTS))[tid] = slot; ((LAS float*)(lds + GWO))[tid] = gw;
    }
    __syncthreads();
    const int wr = wave >> 2, wc = wave & 3;
    const int arow = tid >> 2, akc = tid & 3;
    const int aslot = ((LAS const int*)(lds + SLOTS))[arow];
    const bf16* asrc = H2 + (size_t)((aslot < 0 ? 0 : aslot) / NSLOT) * D + akc * 8;
    const int awr = ASTG + akc * 2048 + ((arow ^ (akc << 1)) * 16);
    const int ng = lane, kq = wave;
    const float* srcg = Wg + (size_t)(4 * kq) * 256 + 4 * ng;
    const float* srcu = Wu + (size_t)(4 * kq) * 256 + 4 * ng;
    const float* src2 = Wd + (size_t)(4 * kq) * 1024 + 4 * ng;
    int bwr2[4];
#pragma unroll
    for (int i = 0; i < 4; ++i) { const int rho2 = 4 * ng + i; bwr2[i] = BSTG + (kq >> 1) * 4096 + ((rho2 ^ ((rho2 >> 3) & 3)) * 16) + (kq & 1) * 8; }
    int ard[4], brd[4], rowm[4];
#pragma unroll
    for (int m = 0; m < 4; ++m) { rowm[m] = 64 * wr + 16 * m + fr; ard[m] = fq * 2048 + ((rowm[m] ^ (fq << 1)) * 16); }
#pragma unroll
    for (int n = 0; n < 4; ++n) { const int rho = 64 * wc + 16 * n + fr; brd[n] = BSTG + fq * 4096 + ((rho ^ ((rho >> 3) & 3)) * 16); }
    bf16* contrib = (bf16*)(ws + WS_CONTRIB);
    f32x4 acc[4][4];
    f32x4 B0[4], B1[4], B2[4], B3[4]; u32x4 A0, A1, A2, A3;
#define G1_LOAD(s_, BR, AR) do { const int s0_ = (s_); const int ss_ = s0_ < 63 ? s0_ : 63; \
        const float* bp_ = ((ss_ < 32) ? srcg : srcu) + (size_t)(32 * (ss_ & 31)) * 256; \
        AR = *(const u32x4*)(asrc + 32 * (ss_ & 31)); \
        _Pragma("unroll") for (int j = 0; j < 4; ++j) BR[j] = *(const f32x4*)(bp_ + j * 256); } while (0)
#define G1_WRITE(BR, AR, buf_) do { \
        *(LAS u32x4*)(lds + (buf_) * 8192 + awr) = AR; \
        _Pragma("unroll") for (int i = 0; i < 4; ++i) { u32x2 w_; w_.x = cvtpk(BR[0][i], BR[1][i]); w_.y = cvtpk(BR[2][i], BR[3][i]); *(LAS u32x2*)(lds + (buf_) * 16384 + bwr2[i]) = w_; } } while (0)
#define MOE_COMPUTE(abase_, buf_) do { \
        bf16x8 af_[4], bf_[4]; \
        _Pragma("unroll") for (int m = 0; m < 4; ++m) af_[m] = *(LAS const bf16x8*)(lds + (abase_) + ard[m]); \
        _Pragma("unroll") for (int n = 0; n < 4; ++n) bf_[n] = *(LAS const bf16x8*)(lds + (buf_) * 16384 + brd[n]); \
        _Pragma("unroll") for (int m = 0; m < 4; ++m) _Pragma("unroll") for (int n = 0; n < 4; ++n) acc[m][n] = mfma16(bf_[n], af_[m], acc[m][n]); } while (0)
#define ACC_ZERO() do { _Pragma("unroll") for (int m = 0; m < 4; ++m) _Pragma("unroll") for (int n = 0; n < 4; ++n) acc[m][n] = (f32x4){0.f, 0.f, 0.f, 0.f}; } while (0)
    G1_LOAD(0, B0, A0); G1_LOAD(1, B1, A1); G1_LOAD(2, B2, A2);
    G1_WRITE(B0, A0, 0);
    __syncthreads();
    for (int s = 0; s < 64; s += 4) {
        if ((s & 31) == 0) ACC_ZERO();
        G1_LOAD(s + 3, B3, A3); MOE_COMPUTE(0, 0); G1_WRITE(B1, A1, 1); __syncthreads();
        G1_LOAD(s + 4, B0, A0); MOE_COMPUTE(8192, 1); G1_WRITE(B2, A2, 0); __syncthreads();
        G1_LOAD(s + 5, B1, A1); MOE_COMPUTE(0, 0); G1_WRITE(B3, A3, 1); __syncthreads();
        G1_LOAD(s + 6, B2, A2); MOE_COMPUTE(8192, 1);
        if (s == 28) {
#pragma unroll
            for (int m = 0; m < 4; ++m)
#pragma unroll
                for (int n = 0; n < 4; ++n) {
                    const f32x4 gv = acc[m][n];
                    u32x2 w; w.x = cvtpk(silu_f(gv[0]), silu_f(gv[1])); w.y = cvtpk(silu_f(gv[2]), silu_f(gv[3]));
                    const int kc = 8 * wc + 2 * n + (fq >> 1);
                    *(LAS u32x2*)(lds + ACT + kc * 2048 + ((rowm[m] ^ ((kc & 3) << 1)) * 16) + (fq & 1) * 8) = w;
                }
        } else if (s == 60) {
#pragma unroll
            for (int m = 0; m < 4; ++m)
#pragma unroll
                for (int n = 0; n < 4; ++n) {
                    const f32x4 uv = acc[m][n];
                    const int kc = 8 * wc + 2 * n + (fq >> 1);
                    LAS u32x2* ap = (LAS u32x2*)(lds + ACT + kc * 2048 + ((rowm[m] ^ ((kc & 3) << 1)) * 16) + (fq & 1) * 8);
                    const u32x2 g = *ap;
                    u32x2 w; w.x = cvtpk(bflo(g.x) * uv[0], bfhi(g.x) * uv[1]); w.y = cvtpk(bflo(g.y) * uv[2], bfhi(g.y) * uv[3]);
                    *ap = w;
                }
        }
        G1_WRITE(B0, A0, 0); __syncthreads();
    }
#define G2_LOAD(s_, BR) do { const int s0_ = (s_); const int t_ = s0_ < 31 ? s0_ : 31; \
        const float* bp_ = src2 + (size_t)(32 * (t_ & 7)) * 1024 + 256 * (t_ >> 3); \
        _Pragma("unroll") for (int j = 0; j < 4; ++j) BR[j] = *(const f32x4*)(bp_ + j * 1024); } while (0)
#define G2_WRITE(BR, buf_) do { \
        _Pragma("unroll") for (int i = 0; i < 4; ++i) { u32x2 w_; w_.x = cvtpk(BR[0][i], BR[1][i]); w_.y = cvtpk(BR[2][i], BR[3][i]); *(LAS u32x2*)(lds + (buf_) * 16384 + bwr2[i]) = w_; } } while (0)
    G2_LOAD(0, B0); G2_LOAD(1, B1); G2_LOAD(2, B2);
    G2_WRITE(B0, 0);
    __syncthreads();
    for (int s = 0; s < 32; s += 4) {
        if ((s & 7) == 0) ACC_ZERO();
        G2_LOAD(s + 3, B3); MOE_COMPUTE(ACT + (s & 7) * 8192, 0); G2_WRITE(B1, 1); __syncthreads();
        G2_LOAD(s + 4, B0); MOE_COMPUTE(ACT + ((s + 1) & 7) * 8192, 1); G2_WRITE(B2, 0); __syncthreads();
        G2_LOAD(s + 5, B1); MOE_COMPUTE(ACT + ((s + 2) & 7) * 8192, 0); G2_WRITE(B3, 1); __syncthreads();
        G2_LOAD(s + 6, B2); MOE_COMPUTE(ACT + ((s + 3) & 7) * 8192, 1);
        if ((s & 7) == 4) {
            const int q = s >> 3;
#pragma unroll
            for (int m = 0; m < 4; ++m) {
                const int slot = ((LAS const int*)(lds + SLOTS))[rowm[m]]; const float gw = ((LAS const float*)(lds + GWO))[rowm[m]];
                if (slot >= 0) {
                    bf16* cp = contrib + (size_t)slot * D + q * 256 + 64 * wc + 4 * fq;
#pragma unroll
                    for (int n = 0; n < 4; ++n) { const f32x4 v = acc[m][n] * gw; u32x2 w; w.x = cvtpk(v[0], v[1]); w.y = cvtpk(v[2], v[3]); *(u32x2*)(cp + 16 * n) = w; }
                }
            }
        }
        G2_WRITE(B0, 0); __syncthreads();
    }
#undef G1_LOAD
#undef G1_WRITE
#undef G2_LOAD
#undef G2_WRITE
#undef ACC_ZERO
#undef MOE_COMPUTE
}

__device__ __forceinline__ void moe_decode(int j, int total, LAS const int* pre, const unsigned* cnt, int& e, int& mt, int& nrows) {
    if (j < total) {
        int lo = 0, hi = NEXP;
        while (hi - lo > 1) { const int mid = (lo + hi) >> 1; if (pre[mid] <= j) lo = mid; else hi = mid; }
        e = lo; mt = j - pre[e]; const int c = (int)cnt[32 * e] - mt * 128; nrows = c < 128 ? c : 128;
    } else { e = NEXP; mt = j - total; nrows = 128; }
}
__device__ __forceinline__ void phase_moe(const Args& a, ldsp lds, int G, int vcu) {
    const int tid = threadIdx.x, lane = tid & 63, wave = __builtin_amdgcn_readfirstlane(tid >> 6), fr = lane & 15, fq = lane >> 4;
    unsigned char* ws = a.ws;
    constexpr int ASTG = 0, BSTG = 16384, ACT = 49152, SLOTS = 114688, GWO = 115712;
    const unsigned* cnt = (const unsigned*)(ws + WS_CTL) + CW_CNT;
    LAS int* pre = (LAS int*)(lds + MISC_OFF + 512);
    if (tid == 0) { int s = 0; for (int e = 0; e < NEXP; ++e) { pre[e] = s; s += (int)((cnt[32 * e] + 127u) >> 7); } pre[NEXP] = s; }
    __syncthreads();
    const int total = pre[NEXP], ntiles = total + T / 128;
    if (vcu >= ntiles) return;
#define STAGE_SLOTS(j_, b_) do { int e_, mt_, nr_; moe_decode((j_), total, pre, cnt, e_, mt_, nr_); \
        int slot_ = -1; float gw_ = 0.f; \
        if (tid < nr_) { if (e_ < NEXP) { slot_ = ((const int*)(ws + WS_LIST))[(size_t)e_ * LISTCAP + mt_ * 128 + tid]; gw_ = ((const float*)(ws + WS_GATEW))[(slot_ / NSLOT) * 8 + (slot_ % NSLOT)]; } \
                         else { slot_ = (mt_ * 128 + tid) * NSLOT + 8; gw_ = 1.f; } } \
        ((LAS int*)(lds + SLOTS))[(b_) * 128 + tid] = slot_; ((LAS float*)(lds + GWO))[(b_) * 128 + tid] = gw_; } while (0)
    if (wave >= 4) {
        const int lt = tid - 256;
        const bf16* H2 = (const bf16*)(ws + WS_H2);
        const int arow = lt >> 1, ahalf = lt & 1;
        const int awr0 = ASTG + (2 * ahalf) * 2048 + ((arow ^ ((2 * ahalf) << 1)) * 16), awr1 = ASTG + (2 * ahalf + 1) * 2048 + ((arow ^ ((2 * ahalf + 1) << 1)) * 16);
        const int ng = lt & 63, kq = lt >> 6;
        const int loff256 = (8 * kq) * 256 + 4 * ng, loff1024 = (8 * kq) * 1024 + 4 * ng;
        const int bw = BSTG + kq * 4096 + (4 * ng) * 16, bx = ((4 * ng) >> 3) & 3;
        f32x4 B0[8], B1[8], B2[8], B3[8]; u32x4 A0[2], A1[2], A2[2], A3[2];
        __syncthreads();
        int j = vcu, it = 0, e, mt, nrows;
        moe_decode(j, total, pre, cnt, e, mt, nrows);
        const float* Wg = (e < NEXP) ? a.in[I_EG] + (size_t)e * 262144 : a.in[I_SG];
        const float* Wu = (e < NEXP) ? a.in[I_EU] + (size_t)e * 262144 : a.in[I_SU];
        const float* Wd = (e < NEXP) ? a.in[I_ED] + (size_t)e * 262144 : a.in[I_SD];
        int aslot = ((LAS const int*)(lds + SLOTS))[arow];
        const bf16* asrc = H2 + (size_t)((aslot < 0 ? 0 : aslot) / NSLOT) * D + 16 * ahalf;
#define L_LOADB1(WG_, WU_, WD_, s_, BR) do { const int ss_ = (s_); const int t_ = ss_ - 64; \
            const float* bp_ = (ss_ < 32) ? (WG_) + loff256 + (size_t)(32 * ss_) * 256 : (ss_ < 64) ? (WU_) + loff256 + (size_t)(32 * (ss_ - 32)) * 256 : (WD_) + loff1024 + (size_t)(32 * (t_ & 7)) * 1024 + 256 * (t_ >> 3); \
            const int str_ = (ss_ < 64) ? 256 : 1024;        \
            _Pragma("unroll") for (int jj = 0; jj < 8; ++jj) BR[jj] = *(const f32x4*)(bp_ + jj * str_); } while (0)
#define L_LOADA2(AP_, s_, AR, AS) do { const int ss_ = (s_); const int sa_ = ss_ < 62 ? ss_ : 62; \
            AR[0] = *(const u32x4*)((AP_) + 32 * (sa_ & 31)); AR[1] = *(const u32x4*)((AP_) + 32 * (sa_ & 31) + 8); \
            AS[0] = *(const u32x4*)((AP_) + 32 * (sa_ & 31) + 32); AS[1] = *(const u32x4*)((AP_) + 32 * (sa_ & 31) + 40); } while (0)
#define L_LOAD2(s_, BR) do { const int s0_ = (s_); const int t_ = s0_ < 31 ? s0_ : 31; \
            const float* bp_ = Wd + loff1024 + (size_t)(32 * (t_ & 7)) * 1024 + 256 * (t_ >> 3); \
            _Pragma("unroll") for (int jj = 0; jj < 8; ++jj) BR[jj] = *(const f32x4*)(bp_ + jj * 1024); } while (0)
#define L_WRITEB(BR, buf_) do { _Pragma("unroll") for (int i = 0; i < 4; ++i) { u32x4 w_; w_.x = cvtpk(BR[0][i], BR[1][i]); w_.y = cvtpk(BR[2][i], BR[3][i]); w_.z = cvtpk(BR[4][i], BR[5][i]); w_.w = cvtpk(BR[6][i], BR[7][i]); \
            *(LAS u32x4*)(lds + (buf_) * 16384 + bw + ((i ^ bx) * 16)) = w_; } } while (0)
#define L_WRITEA(AR, buf_) do { *(LAS u32x4*)(lds + (buf_) * 8192 + awr0) = AR[0]; *(LAS u32x4*)(lds + (buf_) * 8192 + awr1) = AR[1]; } while (0)
        L_LOADA2(asrc, 0, A0, A1); L_LOADB1(Wg, Wu, Wd, 0, B0); L_LOADB1(Wg, Wu, Wd, 1, B1); L_LOADA2(asrc, 2, A2, A3); L_LOADB1(Wg, Wu, Wd, 2, B2);
        for (;;) {
            L_WRITEA(A0, 0); L_WRITEB(B0, 0);
            __syncthreads();
            for (int s = 0; s < 64; s += 4) {
                L_LOADB1(Wg, Wu, Wd, s + 3, B3); L_WRITEA(A1, 1); L_WRITEB(B1, 1); __syncthreads();
                L_LOADB1(Wg, Wu, Wd, s + 4, B0); L_LOADA2(asrc, s + 4, A0, A1); L_WRITEA(A2, 0); L_WRITEB(B2, 0); __syncthreads();
                L_LOADB1(Wg, Wu, Wd, s + 5, B1); L_WRITEA(A3, 1); L_WRITEB(B3, 1); __syncthreads();
                L_LOADB1(Wg, Wu, Wd, s + 6, B2); L_LOADA2(asrc, s + 6, A2, A3); L_WRITEA(A0, 0); L_WRITEB(B0, 0); __syncthreads();
            }
            for (int s = 0; s < 28; s += 4) {
                L_LOAD2(s + 3, B3); L_WRITEB(B1, 1); __syncthreads();
                L_LOAD2(s + 4, B0); L_WRITEB(B2, 0); __syncthreads();
                L_LOAD2(s + 5, B1); L_WRITEB(B3, 1); __syncthreads();
                L_LOAD2(s + 6, B2); L_WRITEB(B0, 0); __syncthreads();
            }
            const int jn = j + G; const bool more = jn < ntiles;
            int en = e, mtn = mt, nrn = nrows; if (more) moe_decode(jn, total, pre, cnt, en, mtn, nrn);
            const float* Wgn = (en < NEXP) ? a.in[I_EG] + (size_t)en * 262144 : a.in[I_SG];
            const float* Wun = (en < NEXP) ? a.in[I_EU] + (size_t)en * 262144 : a.in[I_SU];
            const float* Wdn = (en < NEXP) ? a.in[I_ED] + (size_t)en * 262144 : a.in[I_SD];
            const int aslotn = more ? ((LAS const int*)(lds + SLOTS))[(it ^ 1) * 128 + arow] : aslot;
            const bf16* asrcn = H2 + (size_t)((aslotn < 0 ? 0 : aslotn) / NSLOT) * D + 16 * ahalf;
            L_LOAD2(31, B3); L_WRITEB(B1, 1); __syncthreads();
            L_LOADB1(Wgn, Wun, Wdn, 0, B0); L_LOADA2(asrcn, 0, A0, A1); L_WRITEB(B2, 0); __syncthreads();
            L_LOADB1(Wgn, Wun, Wdn, 1, B1); L_WRITEB(B3, 1); __syncthreads();
            L_LOADB1(Wgn, Wun, Wdn, 2, B2); L_LOADA2(asrcn, 2, A2, A3); __syncthreads();
            if (!more) break;
            j = jn; it ^= 1; e = en; mt = mtn; nrows = nrn; Wg = Wgn; Wu = Wun; Wd = Wdn; aslot = aslotn; asrc = asrcn;
        }
#undef L_LOADB1
#undef L_LOADA2
#undef L_LOAD2
#undef L_WRITEB
#undef L_WRITEA
    } else {
        const int wr = wave >> 1, wc = wave & 1;
        int rowm[4], ard[4], brd[8];
#pragma unroll
        for (int m = 0; m < 4; ++m) { rowm[m] = 64 * wr + 16 * m + fr; ard[m] = fq * 2048 + ((rowm[m] ^ (fq << 1)) * 16); }
#pragma unroll
        for (int n = 0; n < 8; ++n) { const int rho = 128 * wc + 16 * n + fr; brd[n] = BSTG + fq * 4096 + ((rho ^ ((rho >> 3) & 3)) * 16); }
        unsigned char* contrib = ws + WS_CONTRIB;
        f32x4 acc[4][8];
#define M_COMPUTE(abase_, buf_) do { \
            _Pragma("unroll") for (int nh = 0; nh < 2; ++nh) { bf16x8 af_[4], bf_[4]; \
                _Pragma("unroll") for (int m = 0; m < 4; ++m) af_[m] = *(LAS const bf16x8*)(lds + (abase_) + ard[m]); \
                _Pragma("unroll") for (int n = 0; n < 4; ++n) bf_[n] = *(LAS const bf16x8*)(lds + (buf_) * 16384 + brd[4 * nh + n]); \
                _Pragma("unroll") for (int m = 0; m < 4; ++m) _Pragma("unroll") for (int n = 0; n < 4; ++n) acc[m][4 * nh + n] = mfma16(bf_[n], af_[m], acc[m][4 * nh + n]); } } while (0)
#define M_ZERO() do { _Pragma("unroll") for (int m = 0; m < 4; ++m) _Pragma("unroll") for (int n = 0; n < 8; ++n) acc[m][n] = (f32x4){0.f, 0.f, 0.f, 0.f}; } while (0)
        if (tid < 128) STAGE_SLOTS(vcu, 0);
        __syncthreads();
        int it = 0;
        for (int j = vcu; j < ntiles; j += G, it ^= 1) {
            if (tid < 128 && j + G < ntiles) STAGE_SLOTS(j + G, it ^ 1);
            __syncthreads();
            for (int s = 0; s < 64; s += 4) {
                if ((s & 31) == 0) M_ZERO();
                M_COMPUTE(0, 0); __syncthreads();
                M_COMPUTE(8192, 1); __syncthreads();
                M_COMPUTE(0, 0); __syncthreads();
                M_COMPUTE(8192, 1);
                if (s == 28) {
#pragma unroll
                    for (int m = 0; m < 4; ++m)
#pragma unroll
                        for (int n = 0; n < 8; ++n) {
                            const f32x4 gv = acc[m][n];
                            u32x2 w; w.x = cvtpk(silu_f(gv[0]), silu_f(gv[1])); w.y = cvtpk(silu_f(gv[2]), silu_f(gv[3]));
                            const int kc = 16 * wc + 2 * n + (fq >> 1);
                            *(LAS u32x2*)(lds + ACT + kc * 2048 + ((rowm[m] ^ ((kc & 3) << 1)) * 16) + (fq & 1) * 8) = w;
                        }
                } else if (s == 60) {
#pragma unroll
                    for (int m = 0; m < 4; ++m)
#pragma unroll
                        for (int n = 0; n < 8; ++n) {
                            const f32x4 uv = acc[m][n];
                            const int kc = 16 * wc + 2 * n + (fq >> 1);
                            LAS u32x2* ap = (LAS u32x2*)(lds + ACT + kc * 2048 + ((rowm[m] ^ ((kc & 3) << 1)) * 16) + (fq & 1) * 8);
                            const u32x2 g = *ap;
                            u32x2 w; w.x = cvtpk(bflo(g.x) * uv[0], bfhi(g.x) * uv[1]); w.y = cvtpk(bflo(g.y) * uv[2], bfhi(g.y) * uv[3]);
                            *ap = w;
                        }
                }
                __syncthreads();
            }
            for (int s = 0; s < 32; s += 4) {
                if ((s & 7) == 0) M_ZERO();
                M_COMPUTE(ACT + (s & 7) * 8192, 0); __syncthreads();
                M_COMPUTE(ACT + ((s + 1) & 7) * 8192, 1); __syncthreads();
                M_COMPUTE(ACT + ((s + 2) & 7) * 8192, 0); __syncthreads();
                M_COMPUTE(ACT + ((s + 3) & 7) * 8192, 1);
                if ((s & 7) == 4) {
                    const int q = s >> 3;
#pragma unroll
                    for (int m = 0; m < 4; ++m) {
                        const int slot = ((LAS const int*)(lds + SLOTS))[it * 128 + rowm[m]]; const float gw = ((LAS const float*)(lds + GWO))[it * 128 + rowm[m]];
                        if (slot >= 0) {
                            unsigned char* cp = contrib + (size_t)slot * D + q * 256 + 128 * wc + 4 * fq;
                            const float gs = gw * CONTRIB_SCALE;
#pragma unroll
                            for (int n = 0; n < 8; ++n) { const f32x4 v = acc[m][n] * gs; int w = 0; w = __builtin_amdgcn_cvt_pk_fp8_f32(v[0], v[1], w, false); w = __builtin_amdgcn_cvt_pk_fp8_f32(v[2], v[3], w, true); *(int*)(cp + 16 * n) = w; }
                        }
                    }
                }
                __syncthreads();
            }
        }
#undef M_COMPUTE
#undef M_ZERO
    }
#undef STAGE_SLOTS
}

__device__ __forceinline__ void phase_combine(const Args& a, int G) {
    const int tid = threadIdx.x, lane = tid & 63, wave = __builtin_amdgcn_readfirstlane(tid >> 6), blk = blockIdx.x;
    unsigned char* ws = a.ws;
    const bf16* X1 = (const bf16*)(ws + WS_X1); const unsigned char* contrib = ws + WS_CONTRIB; const float* fg = a.in[I_FG];
    for (int t = blk * NWAVES + wave; t < T; t += G * NWAVES) {
        const float* g2 = (const float*)(ws + WS_ADAF) + (t >> 13) * 6144 + 5 * 1024;
        const int c = 16 * lane;
        float sm[16];
#pragma unroll
        for (int i = 0; i < 16; ++i) sm[i] = 0.f;
#pragma unroll
        for (int k = 0; k < NSLOT; ++k) {
            const u32x4 w = *(const u32x4*)(contrib + ((size_t)t * NSLOT + k) * D + c);
#pragma unroll
            for (int q = 0; q < 4; ++q) {
                const f32x2_t lo = __builtin_amdgcn_cvt_pk_f32_fp8((int)w[q], false), hi = __builtin_amdgcn_cvt_pk_f32_fp8((int)w[q], true);
                sm[4 * q] += lo[0]; sm[4 * q + 1] += lo[1]; sm[4 * q + 2] += hi[0]; sm[4 * q + 3] += hi[1];
            }
        }
        const u32x4 xa = *(const u32x4*)(X1 + (size_t)t * D + c), xb = *(const u32x4*)(X1 + (size_t)t * D + c + 8);
        const float x1[16] = {bflo(xa.x), bfhi(xa.x), bflo(xa.y), bfhi(xa.y), bflo(xa.z), bfhi(xa.z), bflo(xa.w), bfhi(xa.w), bflo(xb.x), bfhi(xb.x), bflo(xb.y), bfhi(xb.y), bflo(xb.z), bfhi(xb.z), bflo(xb.w), bfhi(xb.w)};
        f32x4 xv[4]; float ss = 0.f;
#pragma unroll
        for (int h = 0; h < 4; ++h) {
            const f32x4 gg = *(const f32x4*)(g2 + c + 4 * h);
            const f32x4 xx = {x1[4 * h], x1[4 * h + 1], x1[4 * h + 2], x1[4 * h + 3]};
            const f32x4 mv = {sm[4 * h], sm[4 * h + 1], sm[4 * h + 2], sm[4 * h + 3]};
            const f32x4 v = xx + gg * (mv * (1.f / CONTRIB_SCALE)); xv[h] = v; ss += (v[0] * v[0] + v[1] * v[1]) + (v[2] * v[2] + v[3] * v[3]);
        }
        const float r = rsqrtf(wave_sum(ss) * (1.f / D) + 1e-6f);
#pragma unroll
        for (int h = 0; h < 4; ++h) *(f32x4*)(a.out + (size_t)t * D + c + 4 * h) = (xv[h] * r) * *(const f32x4*)(fg + c + 4 * h);
    }
}

constexpr int NPH = 9;
#ifndef N_LAUNCHES
#define N_LAUNCHES 1
#endif
__global__ void __launch_bounds__(NWAVES * 64, 2) mega(Args a) {
    extern __shared__ __attribute__((aligned(16))) unsigned char lds_raw[];
    ldsp lds = (ldsp)lds_raw;
    const int tid = threadIdx.x, G = gridDim.x, bx = blockIdx.x;
    int vcu = (G % 8 == 0) ? (bx % 8) * (G / 8) + bx / 8 : bx;
    unsigned char* ws = a.ws;
    for (int u = tid; u < (LDS_BYTES - MISC_OFF) / 4; u += NWAVES * 64) ((LAS unsigned*)(lds + MISC_OFF))[u] = 0u;
    __syncthreads();
    volatile LAS unsigned* MISC = (volatile LAS unsigned*)(lds + MISC_OFF);
    XcdBarrier bar; bar.bar = (unsigned*)(ws + WS_CTL) + CW_BAR; bar.x = 0; bar.st = nullptr;
    if (N_LAUNCHES == 1) {
        bar = xcd_barrier_post((unsigned*)(ws + WS_CTL) + CW_BAR, MISC + 8);
        if (tid == 0) MISC[16] = atomicAdd((unsigned*)(ws + WS_CTL) + CW_XRANK + 64 * bar.x, 1u);
    }
    const int lo = a.ph_lo, hi = a.ph_hi;
#ifndef PH_MASK
#define PH_MASK 0x1ff
#endif
#define IN(k) (((PH_MASK >> (k)) & 1) && lo <= (k) && (k) < hi)
#define SEAM(k) do { if (IN(k) && IN((k) + 1)) xcd_barrier(bar); } while (0)
#ifndef PH_DUP
#define PH_DUP -1
#endif
#define REP(k) for (int rep_ = 0; rep_ < ((PH_DUP == (k)) ? 2 : 1); ++rep_)
    if (IN(0)) REP(0) { phase_prep(a, lds, G); } SEAM(0);
    if (N_LAUNCHES == 1 && IN(0) && IN(1)) {
        unsigned basex = 0;
        for (unsigned j = 0; j < bar.x; ++j) basex += xb_ld(&bar.bar[XB_XCNT(j)]);
        vcu = (int)(basex + MISC[16]);
    }
    if (IN(1)) REP(1) { phase_hnorm(a, lds, G); } SEAM(1);
    if (IN(2)) REP(2) {
        pg8::Gemm g{(const pg8::bf16_t*)(ws + WS_H), (const pg8::bf16_t*)(ws + WS_WINT), MH, DIN, D};
        WinOrder S; S.init(G, bx);
        EpiWin E{(bf16*)(ws + WS_Z), (bf16*)(ws + WS_KVC), (const float*)(ws + WS_ROPE)};
        pg8::gemm_phase<EpiWin, WinOrder, true, true>(lds, g, S, E);
    } SEAM(2);
    if (IN(3)) REP(3) { phase_mixers(a, lds, G, vcu); } SEAM(3);
    if (IN(4)) REP(4) {
        { pg8::Gemm g{(const pg8::bf16_t*)(ws + WS_A), (const pg8::bf16_t*)(ws + WS_WAT), T, D, 512};
          pg8::StaticOrder S; S.init(T, D, G, bx);
          EpiMergeA E{(const bf16*)(ws + WS_Z), (bf16*)(ws + WS_Y)};
          pg8::gemm_phase<EpiMergeA, pg8::StaticOrder, true, true>(lds, g, S, E); }
        { pg8::Gemm g{(const pg8::bf16_t*)(ws + WS_O), (const pg8::bf16_t*)(ws + WS_WBT), T, D, 512};
          pg8::StaticOrder S; S.init(T, D, G, bx);
          EpiMergeB E{(const bf16*)(ws + WS_Z), (bf16*)(ws + WS_Y)};
          pg8::gemm_phase<EpiMergeB, pg8::StaticOrder, true, true>(lds, g, S, E); }
    } SEAM(4);
    if (IN(5)) REP(5) {
        pg8::Gemm g{(const pg8::bf16_t*)(ws + WS_Y), (const pg8::bf16_t*)(ws + WS_WOT), T, D, D};
        pg8::StaticOrder S; S.init(T, D, G, bx);
        EpiWo E{a.in[I_X], (const float*)(ws + WS_ADAF), (bf16*)(ws + WS_X1)};
        pg8::gemm_phase<EpiWo, pg8::StaticOrder, true, true>(lds, g, S, E);
    } SEAM(5);
    if (IN(6)) { for (int it = vcu; it < T / 64; it += G) router_item(a, lds, it); } SEAM(6);
    if (IN(7)) REP(7) { phase_moe(a, lds, G, vcu); } SEAM(7);
    if (IN(8)) REP(8) { phase_combine(a, G); }
#undef IN
#undef SEAM
}

extern "C" void kernel_launch(void* const* d_in, const int* in_sizes, int n_in, void* d_out, int out_size, void* d_ws, size_t ws_size, hipStream_t stream) {
    static int grid = 0;
    if (grid == 0) {
        if (n_in != 26 || out_size != T * D || ws_size < WS_END) { fprintf(stderr, "kernel_launch: unexpected shapes (n_in %d, out %d, ws %zu)\n", n_in, out_size, ws_size); grid = -1; return; }
        int dev = 0, cus = 0, per_cu = 0;
        (void)hipGetDevice(&dev); (void)hipDeviceGetAttribute(&cus, hipDeviceAttributeMultiprocessorCount, dev);
        (void)hipFuncSetAttribute((const void*)mega, hipFuncAttributeMaxDynamicSharedMemorySize, LDS_BYTES);
        (void)hipOccupancyMaxActiveBlocksPerMultiprocessor(&per_cu, (const void*)mega, NWAVES * 64, LDS_BYTES);
        (void)hipGetLastError();
        if (per_cu < 1) { fprintf(stderr, "kernel_launch: occupancy query says %d blocks per CU\n", per_cu); per_cu = 1; }
        grid = cus;
    }
    if (grid < 0) return;
    (void)hipMemsetAsync((char*)d_ws + WS_CTL, 0, CTL_ZERO_BYTES, stream);
    Args a{};
    for (int i = 0; i < 26; ++i) a.in[i] = (const float*)d_in[i];
    a.out = (float*)d_out; a.ws = (unsigned char*)d_ws;
    if (N_LAUNCHES == 1) {
        a.ph_lo = 0; a.ph_hi = NPH;
        void* kargs[] = {&a};
        hipError_t e = hipLaunchCooperativeKernel((const void*)mega, dim3(grid), dim3(NWAVES * 64), kargs, LDS_BYTES, stream);
        if (e != hipSuccess) fprintf(stderr, "kernel_launch: cooperative launch failed: %s (grid %d)\n", hipGetErrorString(e), grid);
    } else {
#ifndef HOST_DUP
#define HOST_DUP -1
#endif
        for (int li = 0; li < NPH; ++li) {
            a.ph_lo = li; a.ph_hi = li + 1;
            hipLaunchKernelGGL(mega, dim3(grid), dim3(NWAVES * 64), LDS_BYTES, stream, a);
            if (li == HOST_DUP) {
                if (li == 6) (void)hipMemsetAsync((char*)d_ws + WS_CTL, 0, CTL_ZERO_BYTES, stream);
                hipLaunchKernelGGL(mega, dim3(grid), dim3(NWAVES * 64), LDS_BYTES, stream, a);
            }
        }
    }
}
```

```cpp
#include <hip/hip_runtime.h>
#include <cstdio>
#include <cstdint>
#include <type_traits>
namespace pg8 {
#define PG8_LAS __attribute__((address_space(3)))
typedef unsigned short bf16_t;
typedef short bf16x8 __attribute__((ext_vector_type(8)));
typedef float f32x4 __attribute__((ext_vector_type(4)));
typedef unsigned u32x4 __attribute__((ext_vector_type(4)));
constexpr int BM = 256, BK = 64, HALF = 128, HTB = HALF * BK * 2  , STAGE_BYTES = 8 * HTB, NXCD = 8, WGM = 8;

__host__ __device__ __forceinline__ int lds_byte(int r, int c) { const int st = (r >> 4) * 2 + (c >> 5), rr = r & 15, cc = c & 31, ob = rr * 64 + cc * 2; return st * 1024 + (ob ^ (((ob >> 9) & 1) << 5)); }
__host__ __device__ __forceinline__ void stage_rc(int b, int& R, int& C) { const int st = b / 1024, sb = b % 1024, swz = sb ^ (((sb >> 9) & 1) << 5); R = (st >> 1) * 16 + swz / 64; C = (st & 1) * 32 + (swz % 64) / 2; }
__host__ __device__ __forceinline__ int perm32(int rho) { const int n = rho >> 4, i = rho & 15; return 8 * (i >> 2) + 4 * n + (i & 3); }

struct Unit { int pm, pn; };
struct Gemm { const bf16_t* A; const bf16_t* Bt; int M, N, K; };

struct StaticOrder {
    int nM, nN, nwg, G, c;
    __host__ __device__ void init(int M, int N, int G_, int c_) { nM = M / BM; nN = N / BM; nwg = nM * nN; G = G_; c = c_; }
    __host__ __device__ bool next(int i, Unit& u) const {
        const long L = (long)i * G + c; if (L >= nwg) return false;
        int wgid = (int)L; { const int q = nwg / NXCD, r = nwg % NXCD, xcd = wgid % NXCD, off = wgid / NXCD; wgid = (xcd < r ? xcd * (q + 1) : r * (q + 1) + (xcd - r) * q) + off; }
        const int nig = WGM * nN, gid = wgid / nig, fm = gid * WGM, gsz = (nM - fm) < WGM ? (nM - fm) : WGM;
        u.pm = fm + ((wgid % nig) % gsz); u.pn = (wgid % nig) / gsz; return true;
    }
    __device__ __forceinline__ void a_ready(const Unit&) const {}
    __device__ __forceinline__ void done(const Unit&) const {}
};

__device__ __forceinline__ unsigned cvt_pk_bf16(float lo, float hi) { unsigned r; asm volatile("v_cvt_pk_bf16_f32 %0, %1, %2" : "=v"(r) : "v"(lo), "v"(hi)); return r; }
template <class Epi, class Sched, bool ALIGN_EPI = false, bool SP2 = false>
__device__ __forceinline__ void gemm_phase(PG8_LAS unsigned char* lds, const Gemm g, const Sched& S, const Epi& E) {
    const int tid = threadIdx.x, wid = __builtin_amdgcn_readfirstlane(tid >> 6), lane = tid & 63, wr = wid >> 2, wc = wid & 3, fr = lane & 15, fq = lane >> 4;
    const int K = g.K, nt = K / BK;
    unsigned voffA[2], voffB[2];
#pragma unroll
    for (int i = 0; i < 2; ++i) { int R, C; stage_rc(tid * 16 + i * 8192, R, C); const int Rb = Epi::PERM ? ((R & ~31) + perm32(R & 31)) : R;
        voffA[i] = (unsigned)(R * K + C) * 2u; voffB[i] = (unsigned)(Rb * K + C) * 2u; }
    const size_t kstep = (size_t)(BK * 2);
    const size_t hstep = (size_t)HALF * K * 2;
    const size_t tstep = 2 * hstep;
    const unsigned ldsw = (unsigned)wid * 1024u;
    const int aoff = lds_byte(wr * 64 + fr, fq * 8), boff = lds_byte(wc * 32 + fr, fq * 8);
#define PG8_SA(b, h) (((b) * 2 + (h)) * HTB)
#define PG8_SB(b, h) ((4 + (b) * 2 + (h)) * HTB)
#define PG8_STAGE(bufoff, gbase, voff) do { _Pragma("unroll") for (int _i = 0; _i < 2; ++_i) \
        __builtin_amdgcn_global_load_lds((const unsigned*)((const char*)(gbase) + (voff)[_i]), (PG8_LAS unsigned*)(lds + (bufoff) + ldsw + _i * 8192), 16, 0, 0); } while (0)
#define PG8_LDA(dst, b, h) do { _Pragma("unroll") for (int m = 0; m < 4; ++m) _Pragma("unroll") for (int k = 0; k < 2; ++k) dst[m][k] = *(const PG8_LAS bf16x8*)(lds + PG8_SA(b, h) + aoff + m * 2048 + k * 1024); } while (0)
#define PG8_LDB(dst, b, h) do { _Pragma("unroll") for (int n = 0; n < 2; ++n) _Pragma("unroll") for (int k = 0; k < 2; ++k) dst[n][k] = *(const PG8_LAS bf16x8*)(lds + PG8_SB(b, h) + boff + n * 2048 + k * 1024); } while (0)
#define PG8_MMA(ai, bj, At, Bt) do { __builtin_amdgcn_s_setprio(1); _Pragma("unroll") for (int m = 0; m < 4; ++m) _Pragma("unroll") for (int n = 0; n < 2; ++n) _Pragma("unroll") for (int k = 0; k < 2; ++k) \
        acc[ai][bj][m][n] = __builtin_amdgcn_mfma_f32_16x16x32_bf16(Bt[n][k], At[m][k], acc[ai][bj][m][n], 0, 0, 0); __builtin_amdgcn_s_setprio(0); } while (0)
#define PG8_WAIT_V(n) asm volatile("s_waitcnt vmcnt(" #n ")" ::: "memory")
#define PG8_WAIT_L(n) asm volatile("s_waitcnt lgkmcnt(" #n ")" ::: "memory")
#define PG8_BAR __builtin_amdgcn_s_barrier()
#define PG8_SCHED __builtin_amdgcn_sched_barrier(0)
    Unit cur, nxt; int ui = 0;
    if (!S.next(0, cur)) return;
    f32x4 acc[2][2][4][2];
#pragma unroll
    for (int a = 0; a < 2; ++a)
#pragma unroll
        for (int b = 0; b < 2; ++b)
#pragma unroll
            for (int m = 0; m < 4; ++m)
#pragma unroll
                for (int n = 0; n < 2; ++n) acc[a][b][m][n] = (f32x4){0.f, 0.f, 0.f, 0.f};
    bf16x8 At[4][2], B0[2][2], B1[2][2];
    const char* cA = (const char*)g.A + (size_t)cur.pm * tstep; const char* cB = (const char*)g.Bt + (size_t)cur.pn * tstep;
    S.a_ready(cur);
    if constexpr (SP2) {
        PG8_STAGE(PG8_SB(0, 0), cB, voffB); PG8_STAGE(PG8_SB(0, 1), cB + hstep, voffB); PG8_STAGE(PG8_SA(0, 0), cA, voffA); PG8_STAGE(PG8_SA(0, 1), cA + hstep, voffA);
        if (wr == 1) PG8_BAR;
        PG8_WAIT_V(2); PG8_BAR;
        PG8_STAGE(PG8_SB(1, 0), cB + kstep, voffB); PG8_STAGE(PG8_SA(1, 0), cA + kstep, voffA); PG8_STAGE(PG8_SB(1, 1), cB + hstep + kstep, voffB);
        PG8_WAIT_V(6); PG8_BAR;
    } else {
        PG8_STAGE(PG8_SB(0, 0), cB, voffB); PG8_STAGE(PG8_SA(0, 0), cA, voffA); PG8_STAGE(PG8_SB(0, 1), cB + hstep, voffB); PG8_STAGE(PG8_SA(0, 1), cA + hstep, voffA);
        if (wr == 1) PG8_BAR;
        PG8_WAIT_V(4); PG8_BAR;
        PG8_STAGE(PG8_SB(1, 0), cB + kstep, voffB); PG8_STAGE(PG8_SA(1, 0), cA + kstep, voffA); PG8_STAGE(PG8_SB(1, 1), cB + hstep + kstep, voffB);
        PG8_WAIT_V(6); PG8_BAR;
    }
    for (;;) {
        const bool has_next = S.next(ui + 1, nxt);
        const char* nA = has_next ? (const char*)g.A + (size_t)nxt.pm * tstep : cA; const char* nB = has_next ? (const char*)g.Bt + (size_t)nxt.pn * tstep : cB;
        for (int t = 0; t < nt; t += 2) {
            const bool last = (t == nt - 2);
            const char* a1 = cA + (size_t)(t + 1) * kstep;
            const char* a2 = last ? nA : cA + (size_t)(t + 2) * kstep; const char* b2 = last ? nB : cB + (size_t)(t + 2) * kstep;
            const char* a3 = a2 + kstep; const char* b3 = b2 + kstep;
            if (last && has_next) S.a_ready(nxt);
            if constexpr (SP2) {
            PG8_LDB(B0, 0, 0); PG8_LDB(B1, 0, 1); PG8_SCHED; PG8_LDA(At, 0, 0); PG8_STAGE(PG8_SA(1, 1), a1 + hstep, voffA);
            PG8_WAIT_V(8); PG8_WAIT_L(0); PG8_BAR; PG8_MMA(0, 0, At, B0); PG8_MMA(0, 1, At, B1); PG8_BAR; PG8_SCHED;
            PG8_LDA(At, 0, 1); PG8_STAGE(PG8_SB(0, 0), b2, voffB); PG8_STAGE(PG8_SB(0, 1), b2 + hstep, voffB); PG8_STAGE(PG8_SA(0, 0), a2, voffA);
            PG8_WAIT_V(8); PG8_WAIT_L(0); PG8_BAR; PG8_MMA(1, 0, At, B0); PG8_MMA(1, 1, At, B1); PG8_BAR; PG8_SCHED;
            PG8_LDB(B0, 1, 0); PG8_LDB(B1, 1, 1); PG8_SCHED; PG8_LDA(At, 1, 0); PG8_STAGE(PG8_SA(0, 1), a2 + hstep, voffA);
            PG8_WAIT_V(8); PG8_WAIT_L(0); PG8_BAR; PG8_MMA(0, 0, At, B0); PG8_MMA(0, 1, At, B1); PG8_BAR; PG8_SCHED;
            PG8_LDA(At, 1, 1); PG8_STAGE(PG8_SB(1, 0), b3, voffB); PG8_STAGE(PG8_SB(1, 1), b3 + hstep, voffB); PG8_STAGE(PG8_SA(1, 0), a3, voffA);
            PG8_WAIT_V(8); PG8_WAIT_L(0); PG8_BAR; PG8_MMA(1, 0, At, B0); PG8_MMA(1, 1, At, B1); PG8_BAR; PG8_SCHED;
            } else {
            PG8_LDB(B0, 0, 0); PG8_SCHED; PG8_LDA(At, 0, 0); PG8_STAGE(PG8_SA(1, 1), a1 + hstep, voffA);
            PG8_WAIT_L(8); PG8_BAR; PG8_WAIT_L(0); PG8_MMA(0, 0, At, B0); PG8_BAR; PG8_SCHED;
            PG8_LDB(B1, 0, 1); PG8_STAGE(PG8_SB(0, 0), b2, voffB);
            PG8_BAR; PG8_WAIT_L(0); PG8_MMA(0, 1, At, B1); PG8_BAR;
            PG8_LDA(At, 0, 1); PG8_STAGE(PG8_SA(0, 0), a2, voffA);
            PG8_BAR; PG8_WAIT_L(0); PG8_MMA(1, 0, At, B0); PG8_BAR; PG8_SCHED;
            PG8_STAGE(PG8_SB(0, 1), b2 + hstep, voffB);
            PG8_WAIT_V(6); PG8_BAR; PG8_MMA(1, 1, At, B1); PG8_BAR;
            PG8_LDB(B0, 1, 0); PG8_SCHED; PG8_LDA(At, 1, 0); PG8_STAGE(PG8_SA(0, 1), a2 + hstep, voffA);
            PG8_WAIT_L(8); PG8_BAR; PG8_WAIT_L(0); PG8_MMA(0, 0, At, B0); PG8_BAR; PG8_SCHED;
            PG8_LDB(B1, 1, 1); PG8_STAGE(PG8_SB(1, 0), b3, voffB);
            PG8_BAR; PG8_WAIT_L(0); PG8_MMA(0, 1, At, B1); PG8_BAR;
            PG8_LDA(At, 1, 1); PG8_STAGE(PG8_SA(1, 0), a3, voffA);
            PG8_BAR; PG8_WAIT_L(0); PG8_MMA(1, 0, At, B0); PG8_BAR; PG8_SCHED;
            PG8_STAGE(PG8_SB(1, 1), b3 + hstep, voffB);
            PG8_WAIT_V(6); PG8_BAR; PG8_MMA(1, 1, At, B1); PG8_BAR;
            }
        }
        if constexpr (ALIGN_EPI) { if (wr == 0) PG8_BAR; }
        if constexpr (!Epi::AFTER_DRAIN) { E(acc, cur, wr, wc, fr, fq); S.done(cur); }
        if (!has_next) break;
#pragma unroll
        for (int a = 0; a < 2; ++a)
#pragma unroll
            for (int b = 0; b < 2; ++b)
#pragma unroll
                for (int m = 0; m < 4; ++m)
#pragma unroll
                    for (int n = 0; n < 2; ++n) acc[a][b][m][n] = (f32x4){0.f, 0.f, 0.f, 0.f};
        cur = nxt; cA = nA; cB = nB; ++ui;
        if constexpr (ALIGN_EPI) { if (wr == 1) PG8_BAR; }
    }
    PG8_WAIT_V(0);
    if constexpr (!ALIGN_EPI) { if (wr == 0) PG8_BAR; }
    PG8_BAR;
    if constexpr (Epi::AFTER_DRAIN) { E.fused(acc, cur, wr, wc, fr, fq, lds, wid, lane); S.done(cur); }
#undef PG8_SA
#undef PG8_SB
#undef PG8_STAGE
#undef PG8_LDA
#undef PG8_LDB
#undef PG8_MMA
#undef PG8_WAIT_V
#undef PG8_WAIT_L
#undef PG8_BAR
#undef PG8_SCHED
}
}
#define GAS __attribute__((address_space(1)))
#define LAS __attribute__((address_space(3)))
typedef unsigned short bf16;
typedef unsigned v4u __attribute__((ext_vector_type(4)));
typedef float f32x4 __attribute__((ext_vector_type(4)));
typedef short bf16x8 __attribute__((ext_vector_type(8)));
typedef GAS unsigned gu32;
typedef GAS unsigned long long gu64;
#define RLX_AGENT __ATOMIC_RELAXED, __HIP_MEMORY_SCOPE_AGENT
#define LDS_WAIT() asm volatile("s_waitcnt lgkmcnt(0)" ::: "memory")
#define VM_WAIT() asm volatile("s_waitcnt vmcnt(0)" ::: "memory")
__device__ __forceinline__ unsigned long long rt() { return __builtin_amdgcn_s_memrealtime(); }
__device__ __forceinline__ unsigned f2bf(float f) { unsigned u = __builtin_bit_cast(unsigned, f); return (u + 0x7fffu + ((u >> 16) & 1u)) >> 16; }
__device__ __forceinline__ unsigned pk2(float lo, float hi) { return f2bf(lo) | (f2bf(hi) << 16); }

#define XB_TMO      128
#define XB_XCNT(j)  (256  + 64 * (j))
#define XB_XSUB(j)  (1280 + 64 * (j))
#define XB_XGEN(j)  (2304 + 64 * (j))
#define XB_TOP      3328
#define XB_TOPGEN   3392
#define XCD_BAR_WORDS 3456
#define XB_SPIN_CAP (1u << 18)

__device__ __forceinline__ unsigned xb_ld(unsigned* p)              { return __hip_atomic_load(p, __ATOMIC_RELAXED, __HIP_MEMORY_SCOPE_AGENT); }
__device__ __forceinline__ unsigned xb_add(unsigned* p, unsigned v) { return __hip_atomic_fetch_add(p, v, __ATOMIC_RELAXED, __HIP_MEMORY_SCOPE_AGENT); }
__device__ __forceinline__ unsigned xb_xcc_id() { return (unsigned)__builtin_amdgcn_s_getreg((3 << 11) | 20) & 0xFu; }
#define XB_SPIN(cond, bar) do { unsigned _sp = 0; while (cond) { __builtin_amdgcn_s_sleep(1); \
    if ((++_sp & 255u) == 0u) { if (xb_ld(&(bar)[XB_TMO])) break; if (_sp > XB_SPIN_CAP) { atomicAdd(&(bar)[XB_TMO], 1u); break; } } } } while (0)

struct XcdBarrier {
    unsigned* bar; unsigned x;
    volatile LAS unsigned* st;
};

__device__ __forceinline__ XcdBarrier xcd_barrier_post(unsigned* bar, volatile LAS unsigned* st) {
    XcdBarrier b; b.bar = bar; b.x = xb_xcc_id(); b.st = st;
    if (threadIdx.x == 0) (void)xb_add(&bar[XB_XCNT(b.x)], 1u);
    return b;
}
__device__ __forceinline__ void xcd_barrier_complete(unsigned* bar, unsigned x, unsigned& nloc, unsigned& nx) {
    const unsigned G = gridDim.x * gridDim.y * gridDim.z;
    unsigned sum, cnt, mine, sp = 0u;
    for (;;) {
        sum = 0u; cnt = 0u; mine = 0u;
#pragma unroll
        for (unsigned j = 0; j < 16; ++j) { const unsigned c = xb_ld(&bar[XB_XCNT(j)]); sum += c; cnt += (c > 0u) ? 1u : 0u; mine = (j == x) ? c : mine; }
        if (sum == G) break;
        __builtin_amdgcn_s_sleep(1);
        if ((++sp & 255u) == 0u) { if (xb_ld(&bar[XB_TMO])) break; if (sp > XB_SPIN_CAP) { atomicAdd(&bar[XB_TMO], 1u); break; } }
    }
    nloc = mine > 0u ? mine : 1u; nx = cnt > 0u ? cnt : 1u;
}

__device__ __forceinline__ void xcd_barrier(const XcdBarrier& b) {
    asm volatile("s_waitcnt vmcnt(0)" ::: "memory");
    __syncthreads();
    if (threadIdx.x == 0) {
        unsigned* bar = b.bar;
        __builtin_amdgcn_s_waitcnt(0);
        unsigned nloc = b.st[0], nx = b.st[1];
        if (nloc == 0u) { xcd_barrier_complete(bar, b.x, nloc, nx); b.st[0] = nloc; b.st[1] = nx; }
        const unsigned old = xb_add(&bar[XB_XSUB(b.x)], 1u);
        const unsigned gen = old / nloc;
        if (old + 1u == (gen + 1u) * nloc) {
            __builtin_amdgcn_fence(__ATOMIC_RELEASE, "agent");
            asm volatile("s_waitcnt vmcnt(0)" ::: "memory");
            const unsigned og = xb_add(&bar[XB_TOP], 1u);
            const unsigned tg = og / nx;
            if (og + 1u == (tg + 1u) * nx) xb_add(&bar[XB_TOPGEN], 1u);
            else XB_SPIN(xb_ld(&bar[XB_TOPGEN]) == tg, bar);
            __builtin_amdgcn_fence(__ATOMIC_ACQUIRE, "agent");
            xb_add(&bar[XB_XGEN(b.x)], 1u);
            asm volatile("s_waitcnt vmcnt(0)" ::: "memory");
        } else {
            XB_SPIN(xb_ld(&bar[XB_XGEN(b.x)]) == gen, bar);
            __builtin_amdgcn_fence(__ATOMIC_ACQUIRE, "agent");
            asm volatile("s_waitcnt vmcnt(0)" ::: "memory");
        }
    }
    __syncthreads();
}

constexpr int T = 16384, D = 1024, SEQ = 8192, NCTX = 256, TCX = 512, DIN = 3840, MH = T + TCX;
constexpr int ZU = 0, ZV = 512, ZQ = 1024, ZK = 1536, ZVA = 1664, ZGA = 1792, ZGB = 2816;
constexpr int NEXP = 256, NSLOT = 9, LISTCAP = 16384;
constexpr float LOG2E = 1.4426950408889634f;
constexpr float QSCALE = 0.125f * LOG2E;
constexpr size_t MiB = 1u << 20;
constexpr size_t WS_CTL = 0, CTL_ZERO_BYTES = 1 * MiB;
constexpr size_t WS_ADAP = 1 * MiB;
constexpr size_t WS_ADAF = 2 * MiB;
constexpr size_t WS_ROPE = 2 * MiB + 128 * 1024;
constexpr size_t WS_WST = 2 * MiB + 256 * 1024;
constexpr size_t WS_RWT = 3 * MiB;
constexpr size_t WS_WINT = 4 * MiB;
constexpr size_t WS_WAT = 12 * MiB, WS_WBT = 13 * MiB, WS_WOT = 14 * MiB;
constexpr size_t WS_KVC = 16 * MiB;
constexpr size_t WS_GATEW = 17 * MiB;
constexpr size_t WS_H = 18 * MiB;
constexpr size_t WS_Z = 52 * MiB;
constexpr size_t WS_A = 172 * MiB, WS_O = 188 * MiB;
constexpr size_t WS_TMP = 204 * MiB;
constexpr size_t WS_Y = 268 * MiB;
constexpr size_t WS_X1 = 300 * MiB;
constexpr size_t WS_H2 = 364 * MiB;
constexpr size_t WS_LIST = 396 * MiB;
constexpr size_t WS_CONTRIB = 414 * MiB;
constexpr float CONTRIB_SCALE = 16.f;
constexpr size_t WS_END = 704 * MiB;
constexpr int CW_BAR = 4096;
constexpr int CW_CNT = 16384;
constexpr int CW_XRANK = 32768;
constexpr int SCR_BYTES = 148480;
constexpr int MISC_OFF = SCR_BYTES;
constexpr int LDS_BYTES = 152 * 1024;
constexpr int NWAVES = 8;

typedef float f32x2_t __attribute__((ext_vector_type(2)));
typedef __bf16 bf16x2_t __attribute__((ext_vector_type(2)));
typedef float f32x16 __attribute__((ext_vector_type(16)));
typedef short s16x4 __attribute__((ext_vector_type(4)));
typedef short v4i16_t __attribute__((ext_vector_type(4)));
typedef unsigned u32x2 __attribute__((ext_vector_type(2)));
typedef unsigned u32x4 __attribute__((ext_vector_type(4)));
typedef LAS unsigned char* ldsp;

__device__ __forceinline__ unsigned cvtpk(float lo, float hi) { f32x2_t v = {lo, hi}; bf16x2_t b = __builtin_convertvector(v, bf16x2_t); return __builtin_bit_cast(unsigned, b); }
__device__ __forceinline__ float bf2f(unsigned short u) { return __uint_as_float((unsigned)u << 16); }
__device__ __forceinline__ float bflo(unsigned w) { return __uint_as_float(w << 16); }
__device__ __forceinline__ float bfhi(unsigned w) { return __uint_as_float(w & 0xffff0000u); }
__device__ __forceinline__ float wave_sum(float v) {
#pragma unroll
    for (int o = 1; o < 64; o <<= 1) v += __shfl_xor(v, o);
    return v;
}
__device__ __forceinline__ float sigmoid_f(float x) { return __builtin_amdgcn_rcpf(1.f + __builtin_amdgcn_exp2f(-x * LOG2E)); }
__device__ __forceinline__ float silu_f(float x) { return x * sigmoid_f(x); }
__device__ __forceinline__ float gelu_f(float x) { const float u = 0.7978845608028654f * (x + 0.044715f * x * x * x); return x * sigmoid_f(2.f * u); }
__device__ __forceinline__ f32x16 mfma32(bf16x8 a, bf16x8 b, f32x16 c) { return __builtin_amdgcn_mfma_f32_32x32x16_bf16(a, b, c, 0, 0, 0); }
__device__ __forceinline__ f32x4 mfma16(bf16x8 a, bf16x8 b, f32x4 c) { return __builtin_amdgcn_mfma_f32_16x16x32_bf16(a, b, c, 0, 0, 0); }

struct Args { const float* in[26]; float* out; unsigned char* ws; int ph_lo, ph_hi; };
enum { I_X = 0, I_C, I_CTX, I_CCTX, I_ADAW, I_ADAB, I_N1G, I_N2G, I_WIN, I_LNG, I_LNB, I_GWS, I_GBS, I_SINK, I_WA, I_WB, I_WO, I_RW, I_RB, I_EG, I_EU, I_ED, I_SG, I_SU, I_SD, I_FG };

__device__ __forceinline__ void p0_transpose_item(const float* W, int K, int N, bf16* WT, LAS float* scr, int item, int lane) {
    const int nblk = N / 32, kb = item / nblk, nb = item % nblk, k0 = 64 * kb, n0 = 32 * nb;
#pragma unroll 8
    for (int i = 0; i < 32; ++i) { const int kk = 2 * i + (lane >> 5); scr[kk * 33 + (lane & 31)] = W[(size_t)(k0 + kk) * N + n0 + (lane & 31)]; }
    LDS_WAIT(); asm volatile("" ::: "memory");
    const int c = lane & 7;
#pragma unroll
    for (int j = 0; j < 4; ++j) { const int n = (lane >> 3) + 8 * j; const LAS float* s = scr + (8 * c) * 33 + n;
        v4u o; o.x = pk2(s[0 * 33], s[1 * 33]); o.y = pk2(s[2 * 33], s[3 * 33]); o.z = pk2(s[4 * 33], s[5 * 33]); o.w = pk2(s[6 * 33], s[7 * 33]);
        *(GAS v4u*)(WT + (size_t)(n0 + n) * K + k0 + 8 * c) = o; }
    LDS_WAIT(); asm volatile("" ::: "memory");
}

__device__ __forceinline__ void phase_prep(const Args& a, ldsp lds, int G) {
    const int tid = threadIdx.x, lane = tid & 63, wave = __builtin_amdgcn_readfirstlane(tid >> 6), blk = blockIdx.x;
    unsigned char* ws = a.ws;
    if (blk < 192) {
        const int cb = blk % 24, kc = blk / 24, col = cb * 256 + lane * 4, k0 = kc * 128 + wave * 16;
        const float* c = a.in[I_C]; const float* cc = a.in[I_CCTX]; const float* aw = a.in[I_ADAW];
        f32x4 a0 = {0.f, 0.f, 0.f, 0.f}, a1 = a0, a2 = a0;
#pragma unroll 4
        for (int k = 0; k < 16; ++k) {
            const int kk = k0 + k;
            const float s0 = silu_f(c[kk]), s1 = silu_f(c[1024 + kk]), s2 = silu_f(cc[kk]);
            const f32x4 w = *(const f32x4*)(aw + (size_t)kk * 6144 + col);
            a0 += w * s0; a1 += w * s1; a2 += w * s2;
        }
        LAS float* red = (LAS float*)lds;
        *(LAS f32x4*)(red + (wave * 3 + 0) * 256 + lane * 4) = a0;
        *(LAS f32x4*)(red + (wave * 3 + 1) * 256 + lane * 4) = a1;
        *(LAS f32x4*)(red + (wave * 3 + 2) * 256 + lane * 4) = a2;
        __syncthreads();
        float* adap = (float*)(ws + WS_ADAP);
        for (int idx = tid; idx < 768; idx += 512) {
            const int v = idx >> 8, cl = idx & 255; float s = 0.f;
#pragma unroll
            for (int w = 0; w < 8; ++w) s += red[(w * 3 + v) * 256 + cl];
            adap[(size_t)(kc * 3 + v) * 6144 + cb * 256 + cl] = s;
        }
        __syncthreads();
    }
    {
        LAS float* scr = (LAS float*)(lds + wave * 8704);
        const int gw = blk * NWAVES + wave, NGW = G * NWAVES;
        constexpr int I_1 = 16 * 120, I_2 = 8 * 32, I_3 = 8 * 32, I_4 = 16 * 32, I_5 = 16 * 8;
        for (int it = gw; it < I_1 + I_2 + I_3 + I_4 + I_5; it += NGW) {
            int r = it;
            if (r < I_1) { p0_transpose_item(a.in[I_WIN], 1024, 3840, (bf16*)(ws + WS_WINT), scr, r, lane); continue; } r -= I_1;
            if (r < I_2) { p0_transpose_item(a.in[I_WA], 512, 1024, (bf16*)(ws + WS_WAT), scr, r, lane); continue; } r -= I_2;
            if (r < I_3) { p0_transpose_item(a.in[I_WB], 512, 1024, (bf16*)(ws + WS_WBT), scr, r, lane); continue; } r -= I_3;
            if (r < I_4) { p0_transpose_item(a.in[I_WO], 1024, 1024, (bf16*)(ws + WS_WOT), scr, r, lane); continue; } r -= I_4;
            p0_transpose_item(a.in[I_RW], 1024, 256, (bf16*)(ws + WS_RWT), scr, r, lane);
        }
    }
    {
        const int gt = blk * 512 + tid, NT = G * 512;
        const float* gws = a.in[I_GWS]; bf16* wst = (bf16*)(ws + WS_WST);
        for (int i = gt; i < 8192; i += NT) {
            const f32x4 x0 = *(const f32x4*)(gws + i * 8), x1 = *(const f32x4*)(gws + i * 8 + 4);
            v4u o; o.x = cvtpk(x0[0], x0[1]); o.y = cvtpk(x0[2], x0[3]); o.z = cvtpk(x1[0], x1[1]); o.w = cvtpk(x1[2], x1[3]);
            *(v4u*)(wst + i * 8) = o;
        }
        float* rope = (float*)(ws + WS_ROPE);
        for (int i = gt; i < 2048; i += NT) {
            const int pos = i >> 4, f = i & 15;
            const float inv = __builtin_amdgcn_exp2f(-(float)f * (13.287712379549449f / 16.f));
            const float ang = (float)pos * inv;
            double rev = (double)ang * 0.15915494309189535; rev -= floor(rev);
            rope[pos * 32 + f] = __builtin_amdgcn_cosf((float)rev);
            rope[pos * 32 + 16 + f] = __builtin_amdgcn_sinf((float)rev);
        }
    }
}

__device__ __forceinline__ void phase_hnorm(const Args& a, ldsp lds, int G) {
    const int tid = threadIdx.x, lane = tid & 63, wave = __builtin_amdgcn_readfirstlane(tid >> 6), blk = blockIdx.x;
    unsigned char* ws = a.ws;
    const float* adap = (const float*)(ws + WS_ADAP); const float* adab = a.in[I_ADAB];
    LAS float* modv = (LAS float*)lds;
    for (int idx = tid; idx < 3 * 2048; idx += 512) {
        const int v = idx >> 11, j = idx & 2047; float s = adab[j];
#pragma unroll
        for (int kc = 0; kc < 8; ++kc) s += adap[(size_t)(kc * 3 + v) * 6144 + j];
        modv[idx] = (j >= 1024) ? s + 1.f : s;
    }
    { float* adaf = (float*)(ws + WS_ADAF);
      for (int idx = blk * 512 + tid; idx < 3 * 6144; idx += G * 512) {
          const int v = idx / 6144, j = idx % 6144; float s = adab[j];
#pragma unroll
          for (int kc = 0; kc < 8; ++kc) s += adap[(size_t)(kc * 3 + v) * 6144 + j];
          adaf[idx] = s; } }
    __syncthreads();
    const float* g1 = a.in[I_N1G]; bf16* H = (bf16*)(ws + WS_H);
    for (int t = blk * NWAVES + wave; t < MH; t += G * NWAVES) {
        const float* xr = (t < T) ? a.in[I_X] + (size_t)t * D : a.in[I_CTX] + (size_t)(t - T) * D;
        const int v = (t < T) ? (t >> 13) : 2;
        f32x4 x[4]; float ss = 0.f;
#pragma unroll
        for (int j = 0; j < 4; ++j) { x[j] = *(const f32x4*)(xr + 4 * lane + 256 * j); ss += (x[j][0] * x[j][0] + x[j][1] * x[j][1]) + (x[j][2] * x[j][2] + x[j][3] * x[j][3]); }
        const float r = rsqrtf(wave_sum(ss) * (1.f / D) + 1e-6f);
#pragma unroll
        for (int j = 0; j < 4; ++j) {
            const int col = 4 * lane + 256 * j;
            const f32x4 g = *(const f32x4*)(g1 + col);
            const f32x4 sh = *(LAS f32x4*)(modv + v * 2048 + col), sc = *(LAS f32x4*)(modv + v * 2048 + 1024 + col);
            const f32x4 h = (x[j] * r) * g * sc + sh;
            u32x2 o; o.x = cvtpk(h[0], h[1]); o.y = cvtpk(h[2], h[3]);
            *(u32x2*)(H + (size_t)t * D + col) = o;
        }
    }
}

struct WinOrder {
    pg8::StaticOrder so;
    __device__ void init(int G, int c) { so.init(T, DIN, G, c); }
    __device__ bool next(int i, pg8::Unit& u) const {
        const long L = (long)i * so.G + so.c;
        if (L < 960) return so.next(i, u);
        if (L < 962) { u.pm = 64 + (int)(L - 960); u.pn = 6; return true; }
        return false;
    }
    __device__ __forceinline__ void a_ready(const pg8::Unit&) const {}
    __device__ __forceinline__ void done(const pg8::Unit&) const {}
};
struct EpiWin {
    static constexpr bool PERM = false, AFTER_DRAIN = false;
    bf16* Z; bf16* KVC; const float* rope;
    __device__ __forceinline__ void operator()(const pg8::f32x4 (&acc)[2][2][4][2], const pg8::Unit& u, int wr, int wc, int fr, int fq) const {
        const int row0 = u.pm * 256 + wr * 64 + fr, colb = u.pn * 256 + wc * 32 + 4 * fq, pn = u.pn;
        if (u.pm >= 64) {
#pragma unroll
            for (int ai = 0; ai < 2; ++ai)
#pragma unroll
                for (int m = 0; m < 4; ++m) { bf16* rp = KVC + (size_t)(row0 + ai * 128 + m * 16 - T) * 256 + (colb - ZK);
#pragma unroll
                    for (int bj = 0; bj < 2; ++bj)
#pragma unroll
                        for (int n = 0; n < 2; ++n) { const pg8::f32x4 v = acc[ai][bj][m][n]; u32x2 o; o.x = cvtpk(v[0], v[1]); o.y = cvtpk(v[2], v[3]); *(u32x2*)(rp + bj * 128 + n * 16) = o; } }
            return;
        }
#pragma unroll
        for (int ai = 0; ai < 2; ++ai)
#pragma unroll
            for (int m = 0; m < 4; ++m) {
                const int r = row0 + ai * 128 + m * 16; bf16* rp = Z + (size_t)r * DIN + colb;
                if (pn <= 3) {
#pragma unroll
                    for (int bj = 0; bj < 2; ++bj)
#pragma unroll
                        for (int n = 0; n < 2; ++n) { const pg8::f32x4 v = acc[ai][bj][m][n]; u32x2 o; o.x = cvtpk(gelu_f(v[0]), gelu_f(v[1])); o.y = cvtpk(gelu_f(v[2]), gelu_f(v[3])); *(u32x2*)(rp + bj * 128 + n * 16) = o; }
                } else if (pn <= 6) {
                    const int pos = (wc & 1) ? (r & 63) : ((r & 8191) >> 6);
                    const pg8::f32x4 cs = *(const pg8::f32x4*)(rope + pos * 32 + 4 * fq), sn = *(const pg8::f32x4*)(rope + pos * 32 + 16 + 4 * fq);
                    const float sc = (pn < 6) ? QSCALE : 1.f;
#pragma unroll
                    for (int bj = 0; bj < 2; ++bj) {
                        const pg8::f32x4 x1 = acc[ai][bj][m][0], x2 = acc[ai][bj][m][1];
                        pg8::f32x4 o1, o2;
                        if (pn == 6 && bj == 1) { o1 = x1; o2 = x2; }
                        else { o1 = (x1 * cs - x2 * sn) * sc; o2 = (x2 * cs + x1 * sn) * sc; }
                        u32x2 w1, w2; w1.x = cvtpk(o1[0], o1[1]); w1.y = cvtpk(o1[2], o1[3]); w2.x = cvtpk(o2[0], o2[1]); w2.y = cvtpk(o2[2], o2[3]);
                        *(u32x2*)(rp + bj * 128) = w1; *(u32x2*)(rp + bj * 128 + 16) = w2;
                    }
                } else {
#pragma unroll
                    for (int bj = 0; bj < 2; ++bj)
#pragma unroll
                        for (int n = 0; n < 2; ++n) { const pg8::f32x4 v = acc[ai][bj][m][n]; u32x2 o; o.x = cvtpk(sigmoid_f(v[0]), sigmoid_f(v[1])); o.y = cvtpk(sigmoid_f(v[2]), sigmoid_f(v[3])); *(u32x2*)(rp + bj * 128 + n * 16) = o; }
                }
            }
    }
};
struct EpiMergeA {
    static constexpr bool PERM = true, AFTER_DRAIN = false;
    const bf16* Z; bf16* Y;
    __device__ __forceinline__ void operator()(const pg8::f32x4 (&acc)[2][2][4][2], const pg8::Unit& u, int wr, int wc, int fr, int fq) const {
        const int row0 = u.pm * 256 + wr * 64 + fr, col0 = u.pn * 256 + wc * 32 + 8 * fq;
#pragma unroll
        for (int ai = 0; ai < 2; ++ai)
#pragma unroll
            for (int m = 0; m < 4; ++m) { const int r = row0 + ai * 128 + m * 16;
#pragma unroll
                for (int bj = 0; bj < 2; ++bj) { const int c = col0 + bj * 128;
                    const u32x4 g = *(const u32x4*)(Z + (size_t)r * DIN + ZGA + c);
                    const pg8::f32x4 v0 = acc[ai][bj][m][0], v1 = acc[ai][bj][m][1];
                    u32x4 o;
                    o.x = cvtpk(v0[0] * bflo(g.x), v0[1] * bfhi(g.x)); o.y = cvtpk(v0[2] * bflo(g.y), v0[3] * bfhi(g.y));
                    o.z = cvtpk(v1[0] * bflo(g.z), v1[1] * bfhi(g.z)); o.w = cvtpk(v1[2] * bflo(g.w), v1[3] * bfhi(g.w));
                    *(u32x4*)(Y + (size_t)r * D + c) = o; } }
    }
};
struct EpiMergeB {
    static constexpr bool PERM = true, AFTER_DRAIN = false;
    const bf16* Z; bf16* Y;
    __device__ __forceinline__ void operator()(const pg8::f32x4 (&acc)[2][2][4][2], const pg8::Unit& u, int wr, int wc, int fr, int fq) const {
        const int row0 = u.pm * 256 + wr * 64 + fr, col0 = u.pn * 256 + wc * 32 + 8 * fq;
#pragma unroll
        for (int ai = 0; ai < 2; ++ai)
#pragma unroll
            for (int m = 0; m < 4; ++m) { const int r = row0 + ai * 128 + m * 16;
#pragma unroll
                for (int bj = 0; bj < 2; ++bj) { const int c = col0 + bj * 128;
                    const u32x4 g = *(const u32x4*)(Z + (size_t)r * DIN + ZGB + c);
                    const u32x4 tp = *(const u32x4*)(Y + (size_t)r * D + c);
                    const pg8::f32x4 t0 = {bflo(tp.x), bfhi(tp.x), bflo(tp.y), bfhi(tp.y)}, t1 = {bflo(tp.z), bfhi(tp.z), bflo(tp.w), bfhi(tp.w)};
                    const pg8::f32x4 v0 = acc[ai][bj][m][0], v1 = acc[ai][bj][m][1];
                    u32x4 o;
                    o.x = cvtpk(t0[0] + v0[0] * bflo(g.x), t0[1] + v0[1] * bfhi(g.x)); o.y = cvtpk(t0[2] + v0[2] * bflo(g.y), t0[3] + v0[3] * bfhi(g.y));
                    o.z = cvtpk(t1[0] + v1[0] * bflo(g.z), t1[1] + v1[1] * bfhi(g.z)); o.w = cvtpk(t1[2] + v1[2] * bflo(g.w), t1[3] + v1[3] * bfhi(g.w));
                    *(u32x4*)(Y + (size_t)r * D + c) = o; } }
    }
};
struct EpiWo {
    static constexpr bool PERM = true, AFTER_DRAIN = false;
    const float* x; const float* adaf; bf16* X1;
    __device__ __forceinline__ void operator()(const pg8::f32x4 (&acc)[2][2][4][2], const pg8::Unit& u, int wr, int wc, int fr, int fq) const {
        const int row0 = u.pm * 256 + wr * 64 + fr, col0 = u.pn * 256 + wc * 32 + 8 * fq;
        const float* g1 = adaf + (u.pm >= 32 ? 6144 : 0) + 2048;
#pragma unroll
        for (int bj = 0; bj < 2; ++bj) { const int c = col0 + bj * 128;
            const pg8::f32x4 ga = *(const pg8::f32x4*)(g1 + c), gb = *(const pg8::f32x4*)(g1 + c + 4);
#pragma unroll
            for (int ai = 0; ai < 2; ++ai)
#pragma unroll
                for (int m = 0; m < 4; ++m) { const int r = row0 + ai * 128 + m * 16;
                    const pg8::f32x4 x0 = *(const pg8::f32x4*)(x + (size_t)r * D + c), x1 = *(const pg8::f32x4*)(x + (size_t)r * D + c + 4);
                    const pg8::f32x4 o0 = x0 + ga * acc[ai][bj][m][0], o1 = x1 + gb * acc[ai][bj][m][1];
                    u32x4 w; w.x = cvtpk(o0[0], o0[1]); w.y = cvtpk(o0[2], o0[3]); w.z = cvtpk(o1[0], o1[1]); w.w = cvtpk(o1[2], o1[3]);
                    *(u32x4*)(X1 + (size_t)r * D + c) = w; } }
    }
};


__device__ __forceinline__ s16x4 vtr(LAS const unsigned char* p) { return __builtin_bit_cast(s16x4, __builtin_amdgcn_ds_read_tr16_b64_v4i16((LAS v4i16_t*)p)); }

__device__ __forceinline__ void attn_item(const bf16* Z, const bf16* KVC, const float* sink, bf16* Obuf, ldsp lds, int b, int nb, int hk, int qh) {
    const int tid = threadIdx.x, lane = tid & 63, wave = __builtin_amdgcn_readfirstlane(tid >> 6), r32 = lane & 31, hi = lane >> 5;
    const int rq = wave >> 1, head = hk * 4 + rq;
    const int iq = qh * 64 + (wave & 1) * 32 + r32;
    const int wlo = (nb == 0) ? 2 : qh, whi = (nb == 63) ? 4 : 5 + qh, nwin = whi - wlo, ntile = nwin + 4;
    const int tokq = b * SEQ + nb * 128 + iq;
    bf16x8 qr[4];
#pragma unroll
    for (int d0 = 0; d0 < 4; ++d0) qr[d0] = *(const bf16x8*)(Z + (size_t)tokq * DIN + ZQ + head * 64 + d0 * 16 + hi * 8);
    float mrun = sink[head] * LOG2E, lrun = (hi == 0) ? 1.f : 0.f;
    f32x16 o[2];
#pragma unroll
    for (int j = 0; j < 2; ++j)
#pragma unroll
        for (int r = 0; r < 16; ++r) o[j][r] = 0.f;
    const int kdst = wave * 1024 + lane * 16, vdst = 8192 + (wave >> 2) * 4096 + lane * 64 + (wave & 3) * 16;
#define ATT_SRC(s, kp, vp) do { const int tl_ = (s) < nwin ? wlo + (s) : 6 + (s) - nwin; \
        if (tl_ < 6) { const int tok_ = b * SEQ + (nb - 1 + (tl_ >> 1)) * 128 + (tl_ & 1) * 64 + lane; kp = Z + (size_t)tok_ * DIN + ZK + hk * 64 + wave * 8; vp = Z + (size_t)tok_ * DIN + ZVA + hk * 64 + wave * 8; } \
        else { const int row_ = b * NCTX + (tl_ - 6) * 64 + lane; kp = KVC + (size_t)row_ * 256 + hk * 64 + wave * 8; vp = KVC + (size_t)row_ * 256 + 128 + hk * 64 + wave * 8; } } while (0)
    u32x4 kreg, vreg;
    { const bf16 *kp, *vp; ATT_SRC(0, kp, vp); kreg = *(const u32x4*)kp; vreg = *(const u32x4*)vp; }
    *(LAS u32x4*)(lds + kdst) = kreg; *(LAS u32x4*)(lds + vdst) = vreg;
    __syncthreads();
    const int vrd = ((lane & 15) >> 2) * 64 + ((lane >> 4) & 1) * 32 + (lane & 3) * 8 + hi * 256;
    for (int s = 0; s < ntile; ++s) {
        const int base = (s & 1) * 16384;
        const int tl = s < nwin ? wlo + s : 6 + s - nwin;
        if (s + 1 < ntile) { const bf16 *kp, *vp; ATT_SRC(s + 1, kp, vp); kreg = *(const u32x4*)kp; vreg = *(const u32x4*)vp; }
        {
            f32x16 p0, p1;
#pragma unroll
            for (int r = 0; r < 16; ++r) { p0[r] = 0.f; p1[r] = 0.f; }
#pragma unroll
            for (int d0 = 0; d0 < 4; ++d0) {
                const bf16x8 k0 = *(LAS const bf16x8*)(lds + base + (2 * d0 + hi) * 1024 + r32 * 16);
                const bf16x8 k1 = *(LAS const bf16x8*)(lds + base + (2 * d0 + hi) * 1024 + (r32 + 32) * 16);
                p0 = mfma32(k0, qr[d0], p0); p1 = mfma32(k1, qr[d0], p1);
            }
            if (tl < 2) {
                const int j0 = (tl & 1) * 64 + 4 * hi;
#pragma unroll
                for (int r = 0; r < 16; ++r) { const int j = j0 + (r & 3) + 8 * (r >> 2); if (j < iq) p0[r] = -INFINITY; if (j + 32 < iq) p1[r] = -INFINITY; }
            } else if (tl == 4 || tl == 5) {
                const int j0 = (tl & 1) * 64 + 4 * hi;
#pragma unroll
                for (int r = 0; r < 16; ++r) { const int j = j0 + (r & 3) + 8 * (r >> 2); if (j > iq) p0[r] = -INFINITY; if (j + 32 > iq) p1[r] = -INFINITY; }
            }
            float mx = fmaxf(p0[0], p1[0]);
#pragma unroll
            for (int r = 1; r < 16; ++r) mx = fmaxf(mx, fmaxf(p0[r], p1[r]));
            mx = fmaxf(mx, __shfl_xor(mx, 32));
            const float mn = fmaxf(mrun, mx), alpha = __builtin_amdgcn_exp2f(mrun - mn);
            mrun = mn;
            float rs = 0.f;
#pragma unroll
            for (int r = 0; r < 16; ++r) { p0[r] = __builtin_amdgcn_exp2f(p0[r] - mn); p1[r] = __builtin_amdgcn_exp2f(p1[r] - mn); rs += p0[r] + p1[r]; }
            lrun = lrun * alpha + rs;
#pragma unroll
            for (int r = 0; r < 16; ++r) { o[0][r] *= alpha; o[1][r] *= alpha; }
            bf16x8 pf[4];
#pragma unroll
            for (int s4 = 0; s4 < 4; ++s4) {
                u32x4 w;
                if (s4 < 2) { w.x = cvtpk(p0[8 * s4 + 0], p0[8 * s4 + 1]); w.y = cvtpk(p0[8 * s4 + 2], p0[8 * s4 + 3]); w.z = cvtpk(p0[8 * s4 + 4], p0[8 * s4 + 5]); w.w = cvtpk(p0[8 * s4 + 6], p0[8 * s4 + 7]); }
                else { const int q = s4 - 2; w.x = cvtpk(p1[8 * q + 0], p1[8 * q + 1]); w.y = cvtpk(p1[8 * q + 2], p1[8 * q + 3]); w.z = cvtpk(p1[8 * q + 4], p1[8 * q + 5]); w.w = cvtpk(p1[8 * q + 6], p1[8 * q + 7]); }
                pf[s4] = __builtin_bit_cast(bf16x8, w);
            }
#pragma unroll
            for (int dblk = 0; dblk < 2; ++dblk)
#pragma unroll
                for (int s4 = 0; s4 < 4; ++s4) {
                    const s16x4 lo = vtr(lds + base + 8192 + dblk * 4096 + vrd + (16 * s4) * 64);
                    const s16x4 hh = vtr(lds + base + 8192 + dblk * 4096 + vrd + (16 * s4 + 8) * 64);
                    const bf16x8 vf = {lo[0], lo[1], lo[2], lo[3], hh[0], hh[1], hh[2], hh[3]};
                    o[dblk] = mfma32(vf, pf[s4], o[dblk]);
                }
        }
        if (s + 1 < ntile) { *(LAS u32x4*)(lds + (16384 - base) + kdst) = kreg; *(LAS u32x4*)(lds + (16384 - base) + vdst) = vreg; }
        __syncthreads();
    }
#undef ATT_SRC
    {
        const float lt = lrun + __shfl_xor(lrun, 32), inv = 1.f / lt;
        bf16* op = Obuf + (size_t)tokq * 512 + head * 64;
#pragma unroll
        for (int dblk = 0; dblk < 2; ++dblk)
#pragma unroll
            for (int r4 = 0; r4 < 4; ++r4) {
                u32x2 w; w.x = cvtpk(o[dblk][4 * r4] * inv, o[dblk][4 * r4 + 1] * inv); w.y = cvtpk(o[dblk][4 * r4 + 2] * inv, o[dblk][4 * r4 + 3] * inv);
                *(u32x2*)(op + 32 * dblk + 8 * r4 + 4 * hi) = w;
            }
    }
}

__device__ __forceinline__ void gmlp_item(const bf16* Z, const float* lng, const float* lnb, const bf16* WsT, const float* bs, bf16* Abuf, ldsp lds, int ch, int gp) {
    const int tid = threadIdx.x, lane = tid & 63, wave = __builtin_amdgcn_readfirstlane(tid >> 6), fr = lane & 15, fq = lane >> 4;
    const int tok0 = ch * 128;
    LAS bf16* VT = (LAS bf16*)lds;
    f32x4 gA = *(const f32x4*)(lng + lane * 8), gB = *(const f32x4*)(lng + lane * 8 + 4), bA = *(const f32x4*)(lnb + lane * 8), bB = *(const f32x4*)(lnb + lane * 8 + 4);
#pragma unroll
    for (int rnd = 0; rnd < 2; ++rnd) {
        float y[8][8];
#pragma unroll
        for (int j = 0; j < 8; ++j) {
            const int tok = tok0 + wave * 16 + rnd * 8 + j;
            const u32x4 raw = *(const u32x4*)(Z + (size_t)tok * DIN + ZV + lane * 8);
            float x[8] = {bflo(raw.x), bfhi(raw.x), bflo(raw.y), bfhi(raw.y), bflo(raw.z), bfhi(raw.z), bflo(raw.w), bfhi(raw.w)};
            float s = 0.f;
#pragma unroll
            for (int i = 0; i < 8; ++i) s += x[i];
            const float mu = wave_sum(s) * (1.f / 512.f);
            float q = 0.f;
#pragma unroll
            for (int i = 0; i < 8; ++i) { x[i] -= mu; q += x[i] * x[i]; }
            const float rstd = rsqrtf(wave_sum(q) * (1.f / 512.f) + 1e-6f);
            y[j][0] = x[0] * rstd * gA[0] + bA[0]; y[j][1] = x[1] * rstd * gA[1] + bA[1]; y[j][2] = x[2] * rstd * gA[2] + bA[2]; y[j][3] = x[3] * rstd * gA[3] + bA[3];
            y[j][4] = x[4] * rstd * gB[0] + bB[0]; y[j][5] = x[5] * rstd * gB[1] + bB[1]; y[j][6] = x[6] * rstd * gB[2] + bB[2]; y[j][7] = x[7] * rstd * gB[3] + bB[3];
        }
        if ((lane >> 5) == gp) {
            const int gl = (lane >> 4) & 1;
#pragma unroll
            for (int i = 0; i < 8; ++i) {
                u32x4 w; w.x = cvtpk(y[0][i], y[1][i]); w.y = cvtpk(y[2][i], y[3][i]); w.z = cvtpk(y[4][i], y[5][i]); w.w = cvtpk(y[6][i], y[7][i]);
                *(LAS u32x4*)(VT + gl * (128 * 136) + (8 * (lane & 15) + i) * 136 + wave * 16 + rnd * 8) = w;
            }
        }
    }
    __syncthreads();
    const int wm = wave >> 1, wn = wave & 1;
#pragma unroll
    for (int gl = 0; gl < 2; ++gl) {
        const int g = 2 * gp + gl;
        f32x4 acc[2][4];
#pragma unroll
        for (int m = 0; m < 2; ++m)
#pragma unroll
            for (int n = 0; n < 4; ++n) acc[m][n] = (f32x4){0.f, 0.f, 0.f, 0.f};
#pragma unroll
        for (int ks = 0; ks < 4; ++ks) {
            bf16x8 af[2], bfr[4];
#pragma unroll
            for (int m = 0; m < 2; ++m) af[m] = *(const bf16x8*)(WsT + (size_t)g * 16384 + (32 * wm + 16 * m + fr) * 128 + 32 * ks + 8 * fq);
#pragma unroll
            for (int n = 0; n < 4; ++n) bfr[n] = *(LAS const bf16x8*)(VT + gl * (128 * 136) + (64 * wn + 16 * n + fr) * 136 + 32 * ks + 8 * fq);
#pragma unroll
            for (int m = 0; m < 2; ++m)
#pragma unroll
                for (int n = 0; n < 4; ++n) acc[m][n] = mfma16(bfr[n], af[m], acc[m][n]);
        }
#pragma unroll
        for (int m = 0; m < 2; ++m) {
            const int p = 32 * wm + 16 * m + fr, tok = tok0 + p; const float bias = bs[g * 128 + p];
#pragma unroll
            for (int n = 0; n < 4; ++n) {
                const int c = g * 128 + 64 * wn + 16 * n + 4 * fq;
                const u32x2 uw = *(const u32x2*)(Z + (size_t)tok * DIN + ZU + c);
                u32x2 w; w.x = cvtpk(bflo(uw.x) * (acc[m][n][0] + bias), bfhi(uw.x) * (acc[m][n][1] + bias)); w.y = cvtpk(bflo(uw.y) * (acc[m][n][2] + bias), bfhi(uw.y) * (acc[m][n][3] + bias));
                *(u32x2*)(Abuf + (size_t)tok * 512 + c) = w;
            }
        }
    }
    __syncthreads();
}

__device__ __forceinline__ void phase_mixers(const Args& a, ldsp lds, int G, int vcu) {
    unsigned char* ws = a.ws;
    const bf16* Z = (const bf16*)(ws + WS_Z);
    for (int it = vcu; it < 512; it += G) {
        const int qh = it & 1, hk = (it >> 1) & 1, nb = (it >> 2) & 63, b = it >> 8;
        attn_item(Z, (const bf16*)(ws + WS_KVC), a.in[I_SINK], (bf16*)(ws + WS_O), lds, b, nb, hk, qh);
    }
    for (int it = vcu; it < 256; it += G) {
        gmlp_item(Z, a.in[I_LNG], a.in[I_LNB], (const bf16*)(ws + WS_WST), a.in[I_GBS], (bf16*)(ws + WS_A), lds, it >> 1, it & 1);
    }
}

#define KI_BEFORE(ka, ia, kb, ib) (((ka) > (kb)) || ((ka) == (kb) && (ia) < (ib)))
#define KI_CAS(K, I, p, q) do { const bool sw_ = KI_BEFORE(K[q], I[q], K[p], I[p]); const float kp_ = sw_ ? K[q] : K[p], kq_ = sw_ ? K[p] : K[q]; const int ip_ = sw_ ? I[q] : I[p], iq_ = sw_ ? I[p] : I[q]; \
        K[p] = kp_; I[p] = ip_; K[q] = kq_; I[q] = iq_; } while (0)
#define KI_SORT8(K, I) do { KI_CAS(K, I, 0, 1); KI_CAS(K, I, 2, 3); KI_CAS(K, I, 4, 5); KI_CAS(K, I, 6, 7); \
        KI_CAS(K, I, 0, 2); KI_CAS(K, I, 1, 3); KI_CAS(K, I, 4, 6); KI_CAS(K, I, 5, 7); \
        KI_CAS(K, I, 1, 2); KI_CAS(K, I, 5, 6); KI_CAS(K, I, 0, 4); KI_CAS(K, I, 3, 7); \
        KI_CAS(K, I, 1, 5); KI_CAS(K, I, 2, 6); KI_CAS(K, I, 1, 4); KI_CAS(K, I, 3, 6); \
        KI_CAS(K, I, 2, 4); KI_CAS(K, I, 3, 5); KI_CAS(K, I, 3, 4); } while (0)
#define KI_MERGE8(KA, IA, KB, IB) do { \
        _Pragma("unroll") for (int r_ = 0; r_ < 8; ++r_) { const bool tb_ = KI_BEFORE(KB[7 - r_], IB[7 - r_], KA[r_], IA[r_]); KA[r_] = tb_ ? KB[7 - r_] : KA[r_]; IA[r_] = tb_ ? IB[7 - r_] : IA[r_]; } \
        KI_CAS(KA, IA, 0, 4); KI_CAS(KA, IA, 1, 5); KI_CAS(KA, IA, 2, 6); KI_CAS(KA, IA, 3, 7); \
        KI_CAS(KA, IA, 0, 2); KI_CAS(KA, IA, 1, 3); KI_CAS(KA, IA, 4, 6); KI_CAS(KA, IA, 5, 7); \
        KI_CAS(KA, IA, 0, 1); KI_CAS(KA, IA, 2, 3); KI_CAS(KA, IA, 4, 5); KI_CAS(KA, IA, 6, 7); } while (0)
__device__ __forceinline__ void router_item(const Args& a, ldsp lds, int it) {
    const int tid = threadIdx.x, lane = tid & 63, wave = __builtin_amdgcn_readfirstlane(tid >> 6), fr = lane & 15, fq = lane >> 4;
    unsigned char* ws = a.ws;
    const int t0 = it * 64, b = t0 >> 13;
    const bf16* X1 = (const bf16*)(ws + WS_X1); const float* adaf = (const float*)(ws + WS_ADAF) + b * 6144;
    const float* g2 = a.in[I_N2G]; unsigned char* H2 = ws + WS_H2;
    {
        f32x4 gm[2][2], sh[2][2];
#pragma unroll
        for (int j = 0; j < 2; ++j)
#pragma unroll
            for (int h = 0; h < 2; ++h) {
                const int c = 8 * lane + 512 * j + 4 * h;
                const f32x4 gg = *(const f32x4*)(g2 + c), sc = *(const f32x4*)(adaf + 4 * 1024 + c);
                gm[j][h] = gg * (sc + 1.f); sh[j][h] = *(const f32x4*)(adaf + 3 * 1024 + c);
            }
#pragma unroll
        for (int half = 0; half < 2; ++half) {
            f32x4 x[4][2][2];
#pragma unroll
            for (int tt = 0; tt < 4; ++tt)
#pragma unroll
                for (int j = 0; j < 2; ++j) {
                    const u32x4 w = *(const u32x4*)(X1 + (size_t)(t0 + wave * 8 + half * 4 + tt) * D + 8 * lane + 512 * j);
                    x[tt][j][0] = (f32x4){bflo(w.x), bfhi(w.x), bflo(w.y), bfhi(w.y)}; x[tt][j][1] = (f32x4){bflo(w.z), bfhi(w.z), bflo(w.w), bfhi(w.w)};
                }
#pragma unroll
            for (int tt = 0; tt < 4; ++tt) {
                const int row = wave * 8 + half * 4 + tt, tok = t0 + row;
                float ss = 0.f;
#pragma unroll
                for (int j = 0; j < 2; ++j)
#pragma unroll
                    for (int h = 0; h < 2; ++h) { const f32x4 v = x[tt][j][h]; ss += (v[0] * v[0] + v[1] * v[1]) + (v[2] * v[2] + v[3] * v[3]); }
                const float r = rsqrtf(wave_sum(ss) * (1.f / D) + 1e-6f);
#pragma unroll
                for (int j = 0; j < 2; ++j) {
                    const f32x4 h0 = (x[tt][j][0] * r) * gm[j][0] + sh[j][0], h1 = (x[tt][j][1] * r) * gm[j][1] + sh[j][1];
                    u32x4 w; w.x = cvtpk(h0[0], h0[1]); w.y = cvtpk(h0[2], h0[3]); w.z = cvtpk(h1[0], h1[1]); w.w = cvtpk(h1[2], h1[3]);
                    { int f0 = 0, f1 = 0;
                      f0 = __builtin_amdgcn_cvt_pk_fp8_f32(h0[0], h0[1], f0, false); f0 = __builtin_amdgcn_cvt_pk_fp8_f32(h0[2], h0[3], f0, true);
                      f1 = __builtin_amdgcn_cvt_pk_fp8_f32(h1[0], h1[1], f1, false); f1 = __builtin_amdgcn_cvt_pk_fp8_f32(h1[2], h1[3], f1, true);
                      u32x2 w8; w8.x = (unsigned)f0; w8.y = (unsigned)f1; *(u32x2*)(H2 + (size_t)tok * D + 8 * lane + 512 * j) = w8; }
                    const int kc = lane + 64 * j;
                    *(LAS u32x4*)(lds + kc * 1024 + ((row ^ (kc & 7)) * 16)) = w;
                }
            }
        }
    }
    __syncthreads();
    f32x4 acc[4][2];
#pragma unroll
    for (int m = 0; m < 4; ++m)
#pragma unroll
        for (int n = 0; n < 2; ++n) acc[m][n] = (f32x4){0.f, 0.f, 0.f, 0.f};
    const bf16* RwT = (const bf16*)(ws + WS_RWT) + (size_t)(32 * wave + fr) * D + 8 * fq;
#pragma unroll 8
    for (int ks = 0; ks < 32; ++ks) {
        const int kc = 4 * ks + fq;
        bf16x8 af[4], bfr[2];
#pragma unroll
        for (int n = 0; n < 2; ++n) bfr[n] = *(const bf16x8*)(RwT + (size_t)(16 * n) * D + 32 * ks);
#pragma unroll
        for (int m = 0; m < 4; ++m) af[m] = *(LAS const bf16x8*)(lds + kc * 1024 + (((16 * m + fr) ^ (kc & 7)) * 16));
#pragma unroll
        for (int m = 0; m < 4; ++m)
#pragma unroll
            for (int n = 0; n < 2; ++n) acc[m][n] = mfma16(af[m], bfr[n], acc[m][n]);
    }
    __syncthreads();
    LAS float* LG = (LAS float*)lds;
#pragma unroll
    for (int m = 0; m < 4; ++m)
#pragma unroll
        for (int n = 0; n < 2; ++n)
#pragma unroll
            for (int reg = 0; reg < 4; ++reg) LG[(32 * wave + 16 * n + fr) * 65 + 16 * m + 4 * fq + reg] = acc[m][n][reg];
    __syncthreads();
    LAS float* CK = (LAS float*)(lds + 69632); LAS int* CI = (LAS int*)(lds + 69632 + 16384);
    const float* rb = a.in[I_RB];
    float bk[8]; int bi[8];
#pragma unroll
    for (int q = 0; q < 4; ++q) {
        float gk[8]; int gi[8];
#pragma unroll
        for (int j = 0; j < 8; ++j) { const int e = 32 * wave + 8 * q + j; gk[j] = sigmoid_f(LG[e * 65 + lane]) + rb[e]; gi[j] = e; }
        KI_SORT8(gk, gi);
        if (q == 0) {
#pragma unroll
            for (int j = 0; j < 8; ++j) { bk[j] = gk[j]; bi[j] = gi[j]; }
        } else KI_MERGE8(bk, bi, gk, gi);
    }
#pragma unroll
    for (int r = 0; r < 8; ++r) { CK[(wave * 8 + r) * 64 + lane] = bk[r]; CI[(wave * 8 + r) * 64 + lane] = bi[r]; }
    __syncthreads();
#define RT_LEVEL(lvl) do { if ((wave & (2 * (lvl) - 1)) == 0) { float ok_[8]; int oi_[8]; \
            _Pragma("unroll") for (int r = 0; r < 8; ++r) { ok_[r] = CK[((wave + (lvl)) * 8 + r) * 64 + lane]; oi_[r] = CI[((wave + (lvl)) * 8 + r) * 64 + lane]; } \
            KI_MERGE8(bk, bi, ok_, oi_); \
            if ((lvl) < 4) { _Pragma("unroll") for (int r = 0; r < 8; ++r) { CK[(wave * 8 + r) * 64 + lane] = bk[r]; CI[(wave * 8 + r) * 64 + lane] = bi[r]; } } } \
        __syncthreads(); } while (0)
    RT_LEVEL(1); RT_LEVEL(2); RT_LEVEL(4);
#undef RT_LEVEL
    LAS unsigned* hist = (LAS unsigned*)(lds + 102400); LAS unsigned* hbase = hist + 256;
    if (tid < 256) hist[tid] = 0u;
    __syncthreads();
    unsigned* cnt = (unsigned*)(ws + WS_CTL) + CW_CNT; int* list = (int*)(ws + WS_LIST); float* gatew = (float*)(ws + WS_GATEW);
    unsigned rank[8];
    if (wave == 0) {
        const int tok = t0 + lane;
        float sel[8], ssum = 0.f;
#pragma unroll
        for (int r = 0; r < 8; ++r) { sel[r] = sigmoid_f(LG[bi[r] * 65 + lane]); ssum += sel[r]; }
#pragma unroll
        for (int r = 0; r < 8; ++r) rank[r] = __hip_atomic_fetch_add(&hist[bi[r]], 1u, __ATOMIC_RELAXED, __HIP_MEMORY_SCOPE_WORKGROUP);
        const float sc = 2.5f / ssum;
        f32x4 g0 = {sel[0] * sc, sel[1] * sc, sel[2] * sc, sel[3] * sc}, g1 = {sel[4] * sc, sel[5] * sc, sel[6] * sc, sel[7] * sc};
        *(f32x4*)(gatew + tok * 8) = g0; *(f32x4*)(gatew + tok * 8 + 4) = g1;
    }
    __syncthreads();
    if (tid < 256) { const unsigned h = hist[tid]; if (h) hbase[tid] = atomicAdd(cnt + 32 * tid, h); }
    __syncthreads();
    if (wave == 0) {
        const int tok = t0 + lane;
#pragma unroll
        for (int r = 0; r < 8; ++r) list[(size_t)bi[r] * LISTCAP + hbase[bi[r]] + rank[r]] = tok * NSLOT + r;
    }
    __syncthreads();
}

__device__ __forceinline__ void moe_tile(const Args& a, ldsp lds, int e, int mt, int nrows, int ntl) {
    const int tid = threadIdx.x, lane = tid & 63, wave = __builtin_amdgcn_readfirstlane(tid >> 6), fr = lane & 15, fq = lane >> 4;
    unsigned char* ws = a.ws;
    constexpr int ASTG = 0, BSTG = 16384, ACT = 49152, SLOTS = 114688, GWO = 115200;
    const bf16* H2 = (const bf16*)(ws + WS_H2);
    const float* Wg = (e < NEXP) ? a.in[I_EG] + (size_t)e * 262144 : a.in[I_SG];
    const float* Wu = (e < NEXP) ? a.in[I_EU] + (size_t)e * 262144 : a.in[I_SU];
    const float* Wd = (e < NEXP) ? a.in[I_ED] + (size_t)e * 262144 : a.in[I_SD];
    if (tid < 128) {
        int slot = -1; float gw = 0.f;
        if (tid < nrows) {
            if (e < NEXP) { slot = ((const int*)(ws + WS_LIST))[(size_t)e * LISTCAP + mt * 128 + tid]; gw = ((const float*)(ws + WS_GATEW))[(slot / NSLOT) * 8 + (slot % NSLOT)]; }
            else { slot = (mt * 128 + tid) * NSLOT + 8; gw = 1.f; }
        }
        ((LAS int*)(lds + SLOTS))[tid] = slot; ((LAS float*)(lds + GWO))[tid] = gw;
    }
    __syncthreads();
    const int wr = wave >> 2, wc = wave & 3;
    const int arow = tid >> 2, akc = tid & 3;
    const int aslot = ((LAS const int*)(lds + SLOTS))[arow];
    const bf16* asrc = H2 + (size_t)((aslot < 0 ? 0 : aslot) / NSLOT) * D + akc * 8;
    const int awr = ASTG + akc * 2048 + ((arow ^ (akc << 1)) * 16);
    const int ng = lane, kq = wave;
    const float* srcg = Wg + (size_t)(4 * kq) * 256 + 4 * ng;
    const float* srcu = Wu + (size_t)(4 * kq) * 256 + 4 * ng;
    const float* src2 = Wd + (size_t)(4 * kq) * 1024 + 4 * ng;
    int bwr2[4];
#pragma unroll
    for (int i = 0; i < 4; ++i) { const int rho2 = 4 * ng + i; bwr2[i] = BSTG + (kq >> 1) * 4096 + ((rho2 ^ ((rho2 >> 3) & 3)) * 16) + (kq & 1) * 8; }
    int ard[4], brd[4], rowm[4];
#pragma unroll
    for (int m = 0; m < 4; ++m) { rowm[m] = 64 * wr + 16 * m + fr; ard[m] = fq * 2048 + ((rowm[m] ^ (fq << 1)) * 16); }
#pragma unroll
    for (int n = 0; n < 4; ++n) { const int rho = 64 * wc + 16 * n + fr; brd[n] = BSTG + fq * 4096 + ((rho ^ ((rho >> 3) & 3)) * 16); }
    bf16* contrib = (bf16*)(ws + WS_CONTRIB);
    f32x4 acc[4][4];
    f32x4 B0[4], B1[4], B2[4], B3[4]; u32x4 A0, A1, A2, A3;
#define G1_LOAD(s_, BR, AR) do { const int s0_ = (s_); const int ss_ = s0_ < 63 ? s0_ : 63; \
        const float* bp_ = ((ss_ < 32) ? srcg : srcu) + (size_t)(32 * (ss_ & 31)) * 256; \
        AR = *(const u32x4*)(asrc + 32 * (ss_ & 31)); \
        _Pragma("unroll") for (int j = 0; j < 4; ++j) BR[j] = *(const f32x4*)(bp_ + j * 256); } while (0)
#define G1_WRITE(BR, AR, buf_) do { \
        *(LAS u32x4*)(lds + (buf_) * 8192 + awr) = AR; \
        _Pragma("unroll") for (int i = 0; i < 4; ++i) { u32x2 w_; w_.x = cvtpk(BR[0][i], BR[1][i]); w_.y = cvtpk(BR[2][i], BR[3][i]); *(LAS u32x2*)(lds + (buf_) * 16384 + bwr2[i]) = w_; } } while (0)
#define MOE_COMPUTE(abase_, buf_) do { \
        bf16x8 af_[4], bf_[4]; \
        _Pragma("unroll") for (int m = 0; m < 4; ++m) af_[m] = *(LAS const bf16x8*)(lds + (abase_) + ard[m]); \
        _Pragma("unroll") for (int n = 0; n < 4; ++n) bf_[n] = *(LAS const bf16x8*)(lds + (buf_) * 16384 + brd[n]); \
        _Pragma("unroll") for (int m = 0; m < 4; ++m) _Pragma("unroll") for (int n = 0; n < 4; ++n) acc[m][n] = mfma16(bf_[n], af_[m], acc[m][n]); } while (0)
#define ACC_ZERO() do { _Pragma("unroll") for (int m = 0; m < 4; ++m) _Pragma("unroll") for (int n = 0; n < 4; ++n) acc[m][n] = (f32x4){0.f, 0.f, 0.f, 0.f}; } while (0)
    G1_LOAD(0, B0, A0); G1_LOAD(1, B1, A1); G1_LOAD(2, B2, A2);
    G1_WRITE(B0, A0, 0);
    __syncthreads();
    for (int s = 0; s < 64; s += 4) {
        if ((s & 31) == 0) ACC_ZERO();
        G1_LOAD(s + 3, B3, A3); MOE_COMPUTE(0, 0); G1_WRITE(B1, A1, 1); __syncthreads();
        G1_LOAD(s + 4, B0, A0); MOE_COMPUTE(8192, 1); G1_WRITE(B2, A2, 0); __syncthreads();
        G1_LOAD(s + 5, B1, A1); MOE_COMPUTE(0, 0); G1_WRITE(B3, A3, 1); __syncthreads();
        G1_LOAD(s + 6, B2, A2); MOE_COMPUTE(8192, 1);
        if (s == 28) {
#pragma unroll
            for (int m = 0; m < 4; ++m)
#pragma unroll
                for (int n = 0; n < 4; ++n) {
                    const f32x4 gv = acc[m][n];
                    u32x2 w; w.x = cvtpk(silu_f(gv[0]), silu_f(gv[1])); w.y = cvtpk(silu_f(gv[2]), silu_f(gv[3]));
                    const int kc = 8 * wc + 2 * n + (fq >> 1);
                    *(LAS u32x2*)(lds + ACT + kc * 2048 + ((rowm[m] ^ ((kc & 3) << 1)) * 16) + (fq & 1) * 8) = w;
                }
        } else if (s == 60) {
#pragma unroll
            for (int m = 0; m < 4; ++m)
#pragma unroll
                for (int n = 0; n < 4; ++n) {
                    const f32x4 uv = acc[m][n];
                    const int kc = 8 * wc + 2 * n + (fq >> 1);
                    LAS u32x2* ap = (LAS u32x2*)(lds + ACT + kc * 2048 + ((rowm[m] ^ ((kc & 3) << 1)) * 16) + (fq & 1) * 8);
                    const u32x2 g = *ap;
                    u32x2 w; w.x = cvtpk(bflo(g.x) * uv[0], bfhi(g.x) * uv[1]); w.y = cvtpk(bflo(g.y) * uv[2], bfhi(g.y) * uv[3]);
                    *ap = w;
                }
        }
        G1_WRITE(B0, A0, 0); __syncthreads();
    }
#define G2_LOAD(s_, BR) do { const int s0_ = (s_); const int t_ = s0_ < 31 ? s0_ : 31; \
        const float* bp_ = src2 + (size_t)(32 * (t_ & 7)) * 1024 + 256 * (t_ >> 3); \
        _Pragma("unroll") for (int j = 0; j < 4; ++j) BR[j] = *(const f32x4*)(bp_ + j * 1024); } while (0)
#define G2_WRITE(BR, buf_) do { \
        _Pragma("unroll") for (int i = 0; i < 4; ++i) { u32x2 w_; w_.x = cvtpk(BR[0][i], BR[1][i]); w_.y = cvtpk(BR[2][i], BR[3][i]); *(LAS u32x2*)(lds + (buf_) * 16384 + bwr2[i]) = w_; } } while (0)
    G2_LOAD(0, B0); G2_LOAD(1, B1); G2_LOAD(2, B2);
    G2_WRITE(B0, 0);
    __syncthreads();
    for (int s = 0; s < 32; s += 4) {
        if ((s & 7) == 0) ACC_ZERO();
        G2_LOAD(s + 3, B3); MOE_COMPUTE(ACT + (s & 7) * 8192, 0); G2_WRITE(B1, 1); __syncthreads();
        G2_LOAD(s + 4, B0); MOE_COMPUTE(ACT + ((s + 1) & 7) * 8192, 1); G2_WRITE(B2, 0); __syncthreads();
        G2_LOAD(s + 5, B1); MOE_COMPUTE(ACT + ((s + 2) & 7) * 8192, 0); G2_WRITE(B3, 1); __syncthreads();
        G2_LOAD(s + 6, B2); MOE_COMPUTE(ACT + ((s + 3) & 7) * 8192, 1);
        if ((s & 7) == 4) {
            const int q = s >> 3;
#pragma unroll
            for (int m = 0; m < 4; ++m) {
                const int slot = ((LAS const int*)(lds + SLOTS))[rowm[m]]; const float gw = ((LAS const float*)(lds + GWO))[rowm[m]];
                if (slot >= 0) {
                    bf16* cp = contrib + (size_t)slot * D + q * 256 + 64 * wc + 4 * fq;
#pragma unroll
                    for (int n = 0; n < 4; ++n) { const f32x4 v = acc[m][n] * gw; u32x2 w; w.x = cvtpk(v[0], v[1]); w.y = cvtpk(v[2], v[3]); *(u32x2*)(cp + 16 * n) = w; }
                }
            }
        }
        G2_WRITE(B0, 0); __syncthreads();
    }
#undef G1_LOAD
#undef G1_WRITE
#undef G2_LOAD
#undef G2_WRITE
#undef ACC_ZERO
#undef MOE_COMPUTE
}

__device__ __forceinline__ void moe_decode(int j, int total, LAS const int* pre, const unsigned* cnt, int& e, int& mt, int& nrows) {
    if (j < total) {
        int lo = 0, hi = NEXP;
        while (hi - lo > 1) { const int mid = (lo + hi) >> 1; if (pre[mid] <= j) lo = mid; else hi = mid; }
        e = lo; mt = j - pre[e]; const int c = (int)cnt[32 * e] - mt * 128; nrows = c < 128 ? c : 128;
    } else { e = NEXP; mt = j - total; nrows = 128; }
}
__device__ __forceinline__ void phase_moe(const Args& a, ldsp lds, int G, int vcu) {
    const int tid = threadIdx.x, lane = tid & 63, wave = __builtin_amdgcn_readfirstlane(tid >> 6), fr = lane & 15, fq = lane >> 4;
    unsigned char* ws = a.ws;
    constexpr int ASTG = 0, BSTG = 16384, ACT = 49152, SLOTS = 114688, GWO = 115712;
    const unsigned* cnt = (const unsigned*)(ws + WS_CTL) + CW_CNT;
    LAS int* pre = (LAS int*)(lds + MISC_OFF + 512);
    if (tid == 0) { int s = 0; for (int e = 0; e < NEXP; ++e) { pre[e] = s; s += (int)((cnt[32 * e] + 127u) >> 7); } pre[NEXP] = s; }
    __syncthreads();
    const int total = pre[NEXP], ntiles = total + T / 128;
    if (vcu >= ntiles) return;
#define STAGE_SLOTS(j_, b_) do { int e_, mt_, nr_; moe_decode((j_), total, pre, cnt, e_, mt_, nr_); \
        int slot_ = -1; float gw_ = 0.f; \
        if (tid < nr_) { if (e_ < NEXP) { slot_ = ((const int*)(ws + WS_LIST))[(size_t)e_ * LISTCAP + mt_ * 128 + tid]; gw_ = ((const float*)(ws + WS_GATEW))[(slot_ / NSLOT) * 8 + (slot_ % NSLOT)]; } \
                         else { slot_ = (mt_ * 128 + tid) * NSLOT + 8; gw_ = 1.f; } } \
        ((LAS int*)(lds + SLOTS))[(b_) * 128 + tid] = slot_; ((LAS float*)(lds + GWO))[(b_) * 128 + tid] = gw_; } while (0)
    if (wave >= 4) {
        const int lt = tid - 256;
        const unsigned char* H2 = ws + WS_H2;
        const int arow = lt >> 1, ahalf = lt & 1;
        const int awr0 = ASTG + (2 * ahalf) * 2048 + ((arow ^ ((2 * ahalf) << 1)) * 16), awr1 = ASTG + (2 * ahalf + 1) * 2048 + ((arow ^ ((2 * ahalf + 1) << 1)) * 16);
        const int ng = lt & 63, kq = lt >> 6;
        const int loff256 = (8 * kq) * 256 + 4 * ng, loff1024 = (8 * kq) * 1024 + 4 * ng;
        const int bw = BSTG + kq * 4096 + (4 * ng) * 16, bx = ((4 * ng) >> 3) & 3;
        f32x4 B0[8], B1[8], B2[8], B3[8]; u32x4 A0, A1, A2, A3, A4, A5, A6, A7;
        __syncthreads();
        int j = vcu, it = 0, e, mt, nrows;
        moe_decode(j, total, pre, cnt, e, mt, nrows);
        const float* Wg = (e < NEXP) ? a.in[I_EG] + (size_t)e * 262144 : a.in[I_SG];
        const float* Wu = (e < NEXP) ? a.in[I_EU] + (size_t)e * 262144 : a.in[I_SU];
        const float* Wd = (e < NEXP) ? a.in[I_ED] + (size_t)e * 262144 : a.in[I_SD];
        int aslot = ((LAS const int*)(lds + SLOTS))[arow];
        const unsigned char* asrc = H2 + (size_t)((aslot < 0 ? 0 : aslot) / NSLOT) * D + 16 * ahalf;
#define L_LOADB1(WG_, WU_, WD_, s_, BR) do { const int ss_ = (s_); const int t_ = ss_ - 64; \
            const float* bp_ = (ss_ < 32) ? (WG_) + loff256 + (size_t)(32 * ss_) * 256 : (ss_ < 64) ? (WU_) + loff256 + (size_t)(32 * (ss_ - 32)) * 256 : (WD_) + loff1024 + (size_t)(32 * (t_ & 7)) * 1024 + 256 * (t_ >> 3); \
            const int str_ = (ss_ < 64) ? 256 : 1024;        \
            _Pragma("unroll") for (int jj = 0; jj < 8; ++jj) BR[jj] = *(const f32x4*)(bp_ + jj * str_); } while (0)
#define L_LOADA4(AP_, s_, R0, R1, R2, R3) do { const int ss_ = (s_); const int sa_ = ss_ < 60 ? ss_ : 60; const unsigned char* p_ = (AP_) + 32 * (sa_ & 31); \
            R0 = *(const u32x4*)(p_); R1 = *(const u32x4*)(p_ + 32); R2 = *(const u32x4*)(p_ + 64); R3 = *(const u32x4*)(p_ + 96); } while (0)
#define L_LOAD2(s_, BR) do { const int s0_ = (s_); const int t_ = s0_ < 31 ? s0_ : 31; \
            const float* bp_ = Wd + loff1024 + (size_t)(32 * (t_ & 7)) * 1024 + 256 * (t_ >> 3); \
            _Pragma("unroll") for (int jj = 0; jj < 8; ++jj) BR[jj] = *(const f32x4*)(bp_ + jj * 1024); } while (0)
#define L_WRITEB(BR, buf_) do { _Pragma("unroll") for (int i = 0; i < 4; ++i) { u32x4 w_; w_.x = cvtpk(BR[0][i], BR[1][i]); w_.y = cvtpk(BR[2][i], BR[3][i]); w_.z = cvtpk(BR[4][i], BR[5][i]); w_.w = cvtpk(BR[6][i], BR[7][i]); \
            *(LAS u32x4*)(lds + (buf_) * 16384 + bw + ((i ^ bx) * 16)) = w_; } } while (0)
#define L_CVT8(w_, o0, o1) do { const f32x2_t l_ = __builtin_amdgcn_cvt_pk_f32_fp8((int)(w_), false), h_ = __builtin_amdgcn_cvt_pk_f32_fp8((int)(w_), true); o0 = cvtpk(l_[0], l_[1]); o1 = cvtpk(h_[0], h_[1]); } while (0)
#define L_WRITEA(AR, buf_) do { u32x4 c0_, c1_; L_CVT8(AR.x, c0_.x, c0_.y); L_CVT8(AR.y, c0_.z, c0_.w); L_CVT8(AR.z, c1_.x, c1_.y); L_CVT8(AR.w, c1_.z, c1_.w); \
            *(LAS u32x4*)(lds + (buf_) * 8192 + awr0) = c0_; *(LAS u32x4*)(lds + (buf_) * 8192 + awr1) = c1_; } while (0)
        L_LOADA4(asrc, 0, A0, A1, A2, A3); L_LOADB1(Wg, Wu, Wd, 0, B0); L_LOADB1(Wg, Wu, Wd, 1, B1); L_LOADB1(Wg, Wu, Wd, 2, B2); L_LOADA4(asrc, 4, A4, A5, A6, A7);
        for (;;) {
            L_WRITEA(A0, 0); L_WRITEB(B0, 0);
            __syncthreads();
            for (int s = 0; s < 64; s += 8) {
                L_LOADB1(Wg, Wu, Wd, s + 3, B3); L_WRITEA(A1, 1); L_WRITEB(B1, 1); __syncthreads();
                L_LOADB1(Wg, Wu, Wd, s + 4, B0); L_WRITEA(A2, 0); L_WRITEB(B2, 0); __syncthreads();
                L_LOADB1(Wg, Wu, Wd, s + 5, B1); L_WRITEA(A3, 1); L_WRITEB(B3, 1); __syncthreads();
                L_LOADB1(Wg, Wu, Wd, s + 6, B2); L_LOADA4(asrc, s + 8, A0, A1, A2, A3); L_WRITEA(A4, 0); L_WRITEB(B0, 0); __syncthreads();
                L_LOADB1(Wg, Wu, Wd, s + 7, B3); L_WRITEA(A5, 1); L_WRITEB(B1, 1); __syncthreads();
                L_LOADB1(Wg, Wu, Wd, s + 8, B0); L_WRITEA(A6, 0); L_WRITEB(B2, 0); __syncthreads();
                L_LOADB1(Wg, Wu, Wd, s + 9, B1); L_WRITEA(A7, 1); L_WRITEB(B3, 1); __syncthreads();
                L_LOADB1(Wg, Wu, Wd, s + 10, B2); L_LOADA4(asrc, s + 12, A4, A5, A6, A7); L_WRITEA(A0, 0); L_WRITEB(B0, 0); __syncthreads();
            }
            for (int s = 0; s < 28; s += 4) {
                L_LOAD2(s + 3, B3); L_WRITEB(B1, 1); __syncthreads();
                L_LOAD2(s + 4, B0); L_WRITEB(B2, 0); __syncthreads();
                L_LOAD2(s + 5, B1); L_WRITEB(B3, 1); __syncthreads();
                L_LOAD2(s + 6, B2); L_WRITEB(B0, 0); __syncthreads();
            }
            const int jn = j + G; const bool more = jn < ntiles;
            int en = e, mtn = mt, nrn = nrows; if (more) moe_decode(jn, total, pre, cnt, en, mtn, nrn);
            const float* Wgn = (en < NEXP) ? a.in[I_EG] + (size_t)en * 262144 : a.in[I_SG];
            const float* Wun = (en < NEXP) ? a.in[I_EU] + (size_t)en * 262144 : a.in[I_SU];
            const float* Wdn = (en < NEXP) ? a.in[I_ED] + (size_t)en * 262144 : a.in[I_SD];
            const int aslotn = more ? ((LAS const int*)(lds + SLOTS))[(it ^ 1) * 128 + arow] : aslot;
            const unsigned char* asrcn = H2 + (size_t)((aslotn < 0 ? 0 : aslotn) / NSLOT) * D + 16 * ahalf;
            L_LOAD2(31, B3); L_WRITEB(B1, 1); __syncthreads();
            L_LOADB1(Wgn, Wun, Wdn, 0, B0); L_LOADA4(asrcn, 0, A0, A1, A2, A3); L_WRITEB(B2, 0); __syncthreads();
            L_LOADB1(Wgn, Wun, Wdn, 1, B1); L_WRITEB(B3, 1); __syncthreads();
            L_LOADB1(Wgn, Wun, Wdn, 2, B2); L_LOADA4(asrcn, 4, A4, A5, A6, A7); __syncthreads();
            if (!more) break;
            j = jn; it ^= 1; e = en; mt = mtn; nrows = nrn; Wg = Wgn; Wu = Wun; Wd = Wdn; aslot = aslotn; asrc = asrcn;
        }
#undef L_LOADB1
#undef L_LOADA4
#undef L_CVT8
#undef L_LOAD2
#undef L_WRITEB
#undef L_WRITEA
    } else {
        const int wr = wave >> 1, wc = wave & 1;
        int rowm[4], ard[4], brd[8];
#pragma unroll
        for (int m = 0; m < 4; ++m) { rowm[m] = 64 * wr + 16 * m + fr; ard[m] = fq * 2048 + ((rowm[m] ^ (fq << 1)) * 16); }
#pragma unroll
        for (int n = 0; n < 8; ++n) { const int rho = 128 * wc + 16 * n + fr; brd[n] = BSTG + fq * 4096 + ((rho ^ ((rho >> 3) & 3)) * 16); }
        unsigned char* contrib = ws + WS_CONTRIB;
        f32x4 acc[4][8];
#define M_COMPUTE(abase_, buf_) do { \
            _Pragma("unroll") for (int nh = 0; nh < 2; ++nh) { bf16x8 af_[4], bf_[4]; \
                _Pragma("unroll") for (int m = 0; m < 4; ++m) af_[m] = *(LAS const bf16x8*)(lds + (abase_) + ard[m]); \
                _Pragma("unroll") for (int n = 0; n < 4; ++n) bf_[n] = *(LAS const bf16x8*)(lds + (buf_) * 16384 + brd[4 * nh + n]); \
                _Pragma("unroll") for (int m = 0; m < 4; ++m) _Pragma("unroll") for (int n = 0; n < 4; ++n) acc[m][4 * nh + n] = mfma16(bf_[n], af_[m], acc[m][4 * nh + n]); } } while (0)
#define M_ZERO() do { _Pragma("unroll") for (int m = 0; m < 4; ++m) _Pragma("unroll") for (int n = 0; n < 8; ++n) acc[m][n] = (f32x4){0.f, 0.f, 0.f, 0.f}; } while (0)
        if (tid < 128) STAGE_SLOTS(vcu, 0);
        __syncthreads();
        int it = 0;
        for (int j = vcu; j < ntiles; j += G, it ^= 1) {
            if (tid < 128 && j + G < ntiles) STAGE_SLOTS(j + G, it ^ 1);
            __syncthreads();
            for (int s = 0; s < 64; s += 4) {
                if ((s & 31) == 0) M_ZERO();
                M_COMPUTE(0, 0); __syncthreads();
                M_COMPUTE(8192, 1); __syncthreads();
                M_COMPUTE(0, 0); __syncthreads();
                M_COMPUTE(8192, 1);
                if (s == 28) {
#pragma unroll
                    for (int m = 0; m < 4; ++m)
#pragma unroll
                        for (int n = 0; n < 8; ++n) {
                            const f32x4 gv = acc[m][n];
                            u32x2 w; w.x = cvtpk(silu_f(gv[0]), silu_f(gv[1])); w.y = cvtpk(silu_f(gv[2]), silu_f(gv[3]));
                            const int kc = 16 * wc + 2 * n + (fq >> 1);
                            *(LAS u32x2*)(lds + ACT + kc * 2048 + ((rowm[m] ^ ((kc & 3) << 1)) * 16) + (fq & 1) * 8) = w;
                        }
                } else if (s == 60) {
#pragma unroll
                    for (int m = 0; m < 4; ++m)
#pragma unroll
                        for (int n = 0; n < 8; ++n) {
                            const f32x4 uv = acc[m][n];
                            const int kc = 16 * wc + 2 * n + (fq >> 1);
                            LAS u32x2* ap = (LAS u32x2*)(lds + ACT + kc * 2048 + ((rowm[m] ^ ((kc & 3) << 1)) * 16) + (fq & 1) * 8);
                            const u32x2 g = *ap;
                            u32x2 w; w.x = cvtpk(bflo(g.x) * uv[0], bfhi(g.x) * uv[1]); w.y = cvtpk(bflo(g.y) * uv[2], bfhi(g.y) * uv[3]);
                            *ap = w;
                        }
                }
                __syncthreads();
            }
            for (int s = 0; s < 32; s += 4) {
                if ((s & 7) == 0) M_ZERO();
                M_COMPUTE(ACT + (s & 7) * 8192, 0); __syncthreads();
                M_COMPUTE(ACT + ((s + 1) & 7) * 8192, 1); __syncthreads();
                M_COMPUTE(ACT + ((s + 2) & 7) * 8192, 0); __syncthreads();
                M_COMPUTE(ACT + ((s + 3) & 7) * 8192, 1);
                if ((s & 7) == 4) {
                    const int q = s >> 3;
#pragma unroll
                    for (int m = 0; m < 4; ++m) {
                        const int slot = ((LAS const int*)(lds + SLOTS))[it * 128 + rowm[m]]; const float gw = ((LAS const float*)(lds + GWO))[it * 128 + rowm[m]];
                        if (slot >= 0) {
                            unsigned char* cp = contrib + (size_t)slot * D + q * 256 + 128 * wc + 4 * fq;
                            const float gs = gw * CONTRIB_SCALE;
#pragma unroll
                            for (int n = 0; n < 8; ++n) { const f32x4 v = acc[m][n] * gs; int w = 0; w = __builtin_amdgcn_cvt_pk_fp8_f32(v[0], v[1], w, false); w = __builtin_amdgcn_cvt_pk_fp8_f32(v[2], v[3], w, true); *(int*)(cp + 16 * n) = w; }
                        }
                    }
                }
                __syncthreads();
            }
        }
#undef M_COMPUTE
#undef M_ZERO
    }
#undef STAGE_SLOTS
}

__device__ __forceinline__ void phase_combine(const Args& a, int G) {
    const int tid = threadIdx.x, lane = tid & 63, wave = __builtin_amdgcn_readfirstlane(tid >> 6), blk = blockIdx.x;
    unsigned char* ws = a.ws;
    const bf16* X1 = (const bf16*)(ws + WS_X1); const unsigned char* contrib = ws + WS_CONTRIB; const float* fg = a.in[I_FG];
    for (int t = blk * NWAVES + wave; t < T; t += G * NWAVES) {
        const float* g2 = (const float*)(ws + WS_ADAF) + (t >> 13) * 6144 + 5 * 1024;
        const int c = 16 * lane;
        float sm[16];
#pragma unroll
        for (int i = 0; i < 16; ++i) sm[i] = 0.f;
#pragma unroll
        for (int k = 0; k < NSLOT; ++k) {
            const u32x4 w = *(const u32x4*)(contrib + ((size_t)t * NSLOT + k) * D + c);
#pragma unroll
            for (int q = 0; q < 4; ++q) {
                const f32x2_t lo = __builtin_amdgcn_cvt_pk_f32_fp8((int)w[q], false), hi = __builtin_amdgcn_cvt_pk_f32_fp8((int)w[q], true);
                sm[4 * q] += lo[0]; sm[4 * q + 1] += lo[1]; sm[4 * q + 2] += hi[0]; sm[4 * q + 3] += hi[1];
            }
        }
        const u32x4 xa = *(const u32x4*)(X1 + (size_t)t * D + c), xb = *(const u32x4*)(X1 + (size_t)t * D + c + 8);
        const float x1[16] = {bflo(xa.x), bfhi(xa.x), bflo(xa.y), bfhi(xa.y), bflo(xa.z), bfhi(xa.z), bflo(xa.w), bfhi(xa.w), bflo(xb.x), bfhi(xb.x), bflo(xb.y), bfhi(xb.y), bflo(xb.z), bfhi(xb.z), bflo(xb.w), bfhi(xb.w)};
        f32x4 xv[4]; float ss = 0.f;
#pragma unroll
        for (int h = 0; h < 4; ++h) {
            const f32x4 gg = *(const f32x4*)(g2 + c + 4 * h);
            const f32x4 xx = {x1[4 * h], x1[4 * h + 1], x1[4 * h + 2], x1[4 * h + 3]};
            const f32x4 mv = {sm[4 * h], sm[4 * h + 1], sm[4 * h + 2], sm[4 * h + 3]};
            const f32x4 v = xx + gg * (mv * (1.f / CONTRIB_SCALE)); xv[h] = v; ss += (v[0] * v[0] + v[1] * v[1]) + (v[2] * v[2] + v[3] * v[3]);
        }
        const float r = rsqrtf(wave_sum(ss) * (1.f / D) + 1e-6f);
#pragma unroll
        for (int h = 0; h < 4; ++h) *(f32x4*)(a.out + (size_t)t * D + c + 4 * h) = (xv[h] * r) * *(const f32x4*)(fg + c + 4 * h);
    }
}

constexpr int NPH = 9;
#ifndef N_LAUNCHES
#define N_LAUNCHES 1
#endif
__global__ void __launch_bounds__(NWAVES * 64, 2) mega(Args a) {
    extern __shared__ __attribute__((aligned(16))) unsigned char lds_raw[];
    ldsp lds = (ldsp)lds_raw;
    const int tid = threadIdx.x, G = gridDim.x, bx = blockIdx.x;
    int vcu = (G % 8 == 0) ? (bx % 8) * (G / 8) + bx / 8 : bx;
    unsigned char* ws = a.ws;
    for (int u = tid; u < (LDS_BYTES - MISC_OFF) / 4; u += NWAVES * 64) ((LAS unsigned*)(lds + MISC_OFF))[u] = 0u;
    __syncthreads();
    volatile LAS unsigned* MISC = (volatile LAS unsigned*)(lds + MISC_OFF);
    XcdBarrier bar; bar.bar = (unsigned*)(ws + WS_CTL) + CW_BAR; bar.x = 0; bar.st = nullptr;
    if (N_LAUNCHES == 1) {
        bar = xcd_barrier_post((unsigned*)(ws + WS_CTL) + CW_BAR, MISC + 8);
        if (tid == 0) MISC[16] = atomicAdd((unsigned*)(ws + WS_CTL) + CW_XRANK + 64 * bar.x, 1u);
    }
    const int lo = a.ph_lo, hi = a.ph_hi;
#ifndef PH_MASK
#define PH_MASK 0x1ff
#endif
#define IN(k) (((PH_MASK >> (k)) & 1) && lo <= (k) && (k) < hi)
#define SEAM(k) do { if (IN(k) && IN((k) + 1)) xcd_barrier(bar); } while (0)
#ifndef PH_DUP
#define PH_DUP -1
#endif
#define REP(k) for (int rep_ = 0; rep_ < ((PH_DUP == (k)) ? 2 : 1); ++rep_)
    if (IN(0)) REP(0) { phase_prep(a, lds, G); } SEAM(0);
    if (N_LAUNCHES == 1 && IN(0) && IN(1)) {
        unsigned basex = 0;
        for (unsigned j = 0; j < bar.x; ++j) basex += xb_ld(&bar.bar[XB_XCNT(j)]);
        vcu = (int)(basex + MISC[16]);
    }
    if (IN(1)) REP(1) { phase_hnorm(a, lds, G); } SEAM(1);
    if (IN(2)) REP(2) {
        pg8::Gemm g{(const pg8::bf16_t*)(ws + WS_H), (const pg8::bf16_t*)(ws + WS_WINT), MH, DIN, D};
        WinOrder S; S.init(G, bx);
        EpiWin E{(bf16*)(ws + WS_Z), (bf16*)(ws + WS_KVC), (const float*)(ws + WS_ROPE)};
        pg8::gemm_phase<EpiWin, WinOrder, true, true>(lds, g, S, E);
    } SEAM(2);
    if (IN(3)) REP(3) { phase_mixers(a, lds, G, vcu); } SEAM(3);
    if (IN(4)) REP(4) {
        { pg8::Gemm g{(const pg8::bf16_t*)(ws + WS_A), (const pg8::bf16_t*)(ws + WS_WAT), T, D, 512};
          pg8::StaticOrder S; S.init(T, D, G, bx);
          EpiMergeA E{(const bf16*)(ws + WS_Z), (bf16*)(ws + WS_Y)};
          pg8::gemm_phase<EpiMergeA, pg8::StaticOrder, true, true>(lds, g, S, E); }
        { pg8::Gemm g{(const pg8::bf16_t*)(ws + WS_O), (const pg8::bf16_t*)(ws + WS_WBT), T, D, 512};
          pg8::StaticOrder S; S.init(T, D, G, bx);
          EpiMergeB E{(const bf16*)(ws + WS_Z), (bf16*)(ws + WS_Y)};
          pg8::gemm_phase<EpiMergeB, pg8::StaticOrder, true, true>(lds, g, S, E); }
    } SEAM(4);
    if (IN(5)) REP(5) {
        pg8::Gemm g{(const pg8::bf16_t*)(ws + WS_Y), (const pg8::bf16_t*)(ws + WS_WOT), T, D, D};
        pg8::StaticOrder S; S.init(T, D, G, bx);
        EpiWo E{a.in[I_X], (const float*)(ws + WS_ADAF), (bf16*)(ws + WS_X1)};
        pg8::gemm_phase<EpiWo, pg8::StaticOrder, true, true>(lds, g, S, E);
    } SEAM(5);
    if (IN(6)) { for (int it = vcu; it < T / 64; it += G) router_item(a, lds, it); } SEAM(6);
    if (IN(7)) REP(7) { phase_moe(a, lds, G, vcu); } SEAM(7);
    if (IN(8)) REP(8) { phase_combine(a, G); }
#undef IN
#undef SEAM
}

extern "C" void kernel_launch(void* const* d_in, const int* in_sizes, int n_in, void* d_out, int out_size, void* d_ws, size_t ws_size, hipStream_t stream) {
    static int grid = 0;
    if (grid == 0) {
        if (n_in != 26 || out_size != T * D || ws_size < WS_END) { fprintf(stderr, "kernel_launch: unexpected shapes (n_in %d, out %d, ws %zu)\n", n_in, out_size, ws_size); grid = -1; return; }
        int dev = 0, cus = 0, per_cu = 0;
        (void)hipGetDevice(&dev); (void)hipDeviceGetAttribute(&cus, hipDeviceAttributeMultiprocessorCount, dev);
        (void)hipFuncSetAttribute((const void*)mega, hipFuncAttributeMaxDynamicSharedMemorySize, LDS_BYTES);
        (void)hipOccupancyMaxActiveBlocksPerMultiprocessor(&per_cu, (const void*)mega, NWAVES * 64, LDS_BYTES);
        (void)hipGetLastError();
        if (per_cu < 1) { fprintf(stderr, "kernel_launch: occupancy query says %d blocks per CU\n", per_cu); per_cu = 1; }
        grid = cus;
    }
    if (grid < 0) return;
    (void)hipMemsetAsync((char*)d_ws + WS_CTL, 0, CTL_ZERO_BYTES, stream);
    Args a{};
    for (int i = 0; i < 26; ++i) a.in[i] = (const float*)d_in[i];
    a.out = (float*)d_out; a.ws = (unsigned char*)d_ws;
    if (N_LAUNCHES == 1) {
        a.ph_lo = 0; a.ph_hi = NPH;
        void* kargs[] = {&a};
        hipError_t e = hipLaunchCooperativeKernel((const void*)mega, dim3(grid), dim3(NWAVES * 64), kargs, LDS_BYTES, stream);
        if (e != hipSuccess) fprintf(stderr, "kernel_launch: cooperative launch failed: %s (grid %d)\n", hipGetErrorString(e), grid);
    } else {
#ifndef HOST_DUP
#define HOST_DUP -1
#endif
        for (int li = 0; li < NPH; ++li) {
            a.ph_lo = li; a.ph_hi = li + 1;
            hipLaunchKernelGGL(mega, dim3(grid), dim3(NWAVES * 64), LDS_BYTES, stream, a);
            if (li == HOST_DUP) {
                if (li == 6) (void)hipMemsetAsync((char*)d_ws + WS_CTL, 0, CTL_ZERO_BYTES, stream);
                hipLaunchKernelGGL(mega, dim3(grid), dim3(NWAVES * 64), LDS_BYTES, stream, a);
            }
        }
    }
}
```

```cpp
#include <hip/hip_runtime.h>
#include <cstdio>
#include <cstdint>
#include <type_traits>
namespace pg8 {
#define PG8_LAS __attribute__((address_space(3)))
typedef unsigned short bf16_t;
typedef short bf16x8 __attribute__((ext_vector_type(8)));
typedef float f32x4 __attribute__((ext_vector_type(4)));
typedef unsigned u32x4 __attribute__((ext_vector_type(4)));
constexpr int BM = 256, BK = 64, HALF = 128, HTB = HALF * BK * 2  , STAGE_BYTES = 8 * HTB, NXCD = 8, WGM = 8;

__host__ __device__ __forceinline__ int lds_byte(int r, int c) { const int st = (r >> 4) * 2 + (c >> 5), rr = r & 15, cc = c & 31, ob = rr * 64 + cc * 2; return st * 1024 + (ob ^ (((ob >> 9) & 1) << 5)); }
__host__ __device__ __forceinline__ void stage_rc(int b, int& R, int& C) { const int st = b / 1024, sb = b % 1024, swz = sb ^ (((sb >> 9) & 1) << 5); R = (st >> 1) * 16 + swz / 64; C = (st & 1) * 32 + (swz % 64) / 2; }
__host__ __device__ __forceinline__ int perm32(int rho) { const int n = rho >> 4, i = rho & 15; return 8 * (i >> 2) + 4 * n + (i & 3); }

struct Unit { int pm, pn; };
struct Gemm { const bf16_t* A; const bf16_t* Bt; int M, N, K; };

struct StaticOrder {
    int nM, nN, nwg, G, c;
    __host__ __device__ void init(int M, int N, int G_, int c_) { nM = M / BM; nN = N / BM; nwg = nM * nN; G = G_; c = c_; }
    __host__ __device__ bool next(int i, Unit& u) const {
        const long L = (long)i * G + c; if (L >= nwg) return false;
        int wgid = (int)L; { const int q = nwg / NXCD, r = nwg % NXCD, xcd = wgid % NXCD, off = wgid / NXCD; wgid = (xcd < r ? xcd * (q + 1) : r * (q + 1) + (xcd - r) * q) + off; }
        const int nig = WGM * nN, gid = wgid / nig, fm = gid * WGM, gsz = (nM - fm) < WGM ? (nM - fm) : WGM;
        u.pm = fm + ((wgid % nig) % gsz); u.pn = (wgid % nig) / gsz; return true;
    }
    __device__ __forceinline__ void a_ready(const Unit&) const {}
    __device__ __forceinline__ void done(const Unit&) const {}
};

__device__ __forceinline__ unsigned cvt_pk_bf16(float lo, float hi) { unsigned r; asm volatile("v_cvt_pk_bf16_f32 %0, %1, %2" : "=v"(r) : "v"(lo), "v"(hi)); return r; }
template <class Epi, class Sched, bool ALIGN_EPI = false, bool SP2 = false>
__device__ __forceinline__ void gemm_phase(PG8_LAS unsigned char* lds, const Gemm g, const Sched& S, const Epi& E) {
    const int tid = threadIdx.x, wid = __builtin_amdgcn_readfirstlane(tid >> 6), lane = tid & 63, wr = wid >> 2, wc = wid & 3, fr = lane & 15, fq = lane >> 4;
    const int K = g.K, nt = K / BK;
    unsigned voffA[2], voffB[2];
#pragma unroll
    for (int i = 0; i < 2; ++i) { int R, C; stage_rc(tid * 16 + i * 8192, R, C); const int Rb = Epi::PERM ? ((R & ~31) + perm32(R & 31)) : R;
        voffA[i] = (unsigned)(R * K + C) * 2u; voffB[i] = (unsigned)(Rb * K + C) * 2u; }
    const size_t kstep = (size_t)(BK * 2);
    const size_t hstep = (size_t)HALF * K * 2;
    const size_t tstep = 2 * hstep;
    const unsigned ldsw = (unsigned)wid * 1024u;
    const int aoff = lds_byte(wr * 64 + fr, fq * 8), boff = lds_byte(wc * 32 + fr, fq * 8);
#define PG8_SA(b, h) (((b) * 2 + (h)) * HTB)
#define PG8_SB(b, h) ((4 + (b) * 2 + (h)) * HTB)
#define PG8_STAGE(bufoff, gbase, voff) do { _Pragma("unroll") for (int _i = 0; _i < 2; ++_i) \
        __builtin_amdgcn_global_load_lds((const unsigned*)((const char*)(gbase) + (voff)[_i]), (PG8_LAS unsigned*)(lds + (bufoff) + ldsw + _i * 8192), 16, 0, 0); } while (0)
#define PG8_LDA(dst, b, h) do { _Pragma("unroll") for (int m = 0; m < 4; ++m) _Pragma("unroll") for (int k = 0; k < 2; ++k) dst[m][k] = *(const PG8_LAS bf16x8*)(lds + PG8_SA(b, h) + aoff + m * 2048 + k * 1024); } while (0)
#define PG8_LDB(dst, b, h) do { _Pragma("unroll") for (int n = 0; n < 2; ++n) _Pragma("unroll") for (int k = 0; k < 2; ++k) dst[n][k] = *(const PG8_LAS bf16x8*)(lds + PG8_SB(b, h) + boff + n * 2048 + k * 1024); } while (0)
#define PG8_MMA(ai, bj, At, Bt) do { __builtin_amdgcn_s_setprio(1); _Pragma("unroll") for (int m = 0; m < 4; ++m) _Pragma("unroll") for (int n = 0; n < 2; ++n) _Pragma("unroll") for (int k = 0; k < 2; ++k) \
        acc[ai][bj][m][n] = __builtin_amdgcn_mfma_f32_16x16x32_bf16(Bt[n][k], At[m][k], acc[ai][bj][m][n], 0, 0, 0); __builtin_amdgcn_s_setprio(0); } while (0)
#define PG8_WAIT_V(n) asm volatile("s_waitcnt vmcnt(" #n ")" ::: "memory")
#define PG8_WAIT_L(n) asm volatile("s_waitcnt lgkmcnt(" #n ")" ::: "memory")
#define PG8_BAR __builtin_amdgcn_s_barrier()
#define PG8_SCHED __builtin_amdgcn_sched_barrier(0)
    Unit cur, nxt; int ui = 0;
    if (!S.next(0, cur)) return;
    f32x4 acc[2][2][4][2];
#pragma unroll
    for (int a = 0; a < 2; ++a)
#pragma unroll
        for (int b = 0; b < 2; ++b)
#pragma unroll
            for (int m = 0; m < 4; ++m)
#pragma unroll
                for (int n = 0; n < 2; ++n) acc[a][b][m][n] = (f32x4){0.f, 0.f, 0.f, 0.f};
    bf16x8 At[4][2], B0[2][2], B1[2][2];
    const char* cA = (const char*)g.A + (size_t)cur.pm * tstep; const char* cB = (const char*)g.Bt + (size_t)cur.pn * tstep;
    S.a_ready(cur);
    if constexpr (SP2) {
        PG8_STAGE(PG8_SB(0, 0), cB, voffB); PG8_STAGE(PG8_SB(0, 1), cB + hstep, voffB); PG8_STAGE(PG8_SA(0, 0), cA, voffA); PG8_STAGE(PG8_SA(0, 1), cA + hstep, voffA);
        if (wr == 1) PG8_BAR;
        PG8_WAIT_V(2); PG8_BAR;
        PG8_STAGE(PG8_SB(1, 0), cB + kstep, voffB); PG8_STAGE(PG8_SA(1, 0), cA + kstep, voffA); PG8_STAGE(PG8_SB(1, 1), cB + hstep + kstep, voffB);
        PG8_WAIT_V(6); PG8_BAR;
    } else {
        PG8_STAGE(PG8_SB(0, 0), cB, voffB); PG8_STAGE(PG8_SA(0, 0), cA, voffA); PG8_STAGE(PG8_SB(0, 1), cB + hstep, voffB); PG8_STAGE(PG8_SA(0, 1), cA + hstep, voffA);
        if (wr == 1) PG8_BAR;
        PG8_WAIT_V(4); PG8_BAR;
        PG8_STAGE(PG8_SB(1, 0), cB + kstep, voffB); PG8_STAGE(PG8_SA(1, 0), cA + kstep, voffA); PG8_STAGE(PG8_SB(1, 1), cB + hstep + kstep, voffB);
        PG8_WAIT_V(6); PG8_BAR;
    }
    for (;;) {
        const bool has_next = S.next(ui + 1, nxt);
        const char* nA = has_next ? (const char*)g.A + (size_t)nxt.pm * tstep : cA; const char* nB = has_next ? (const char*)g.Bt + (size_t)nxt.pn * tstep : cB;
        for (int t = 0; t < nt; t += 2) {
            const bool last = (t == nt - 2);
            const char* a1 = cA + (size_t)(t + 1) * kstep;
            const char* a2 = last ? nA : cA + (size_t)(t + 2) * kstep; const char* b2 = last ? nB : cB + (size_t)(t + 2) * kstep;
            const char* a3 = a2 + kstep; const char* b3 = b2 + kstep;
            if (last && has_next) S.a_ready(nxt);
            if constexpr (SP2) {
            PG8_LDB(B0, 0, 0); PG8_LDB(B1, 0, 1); PG8_SCHED; PG8_LDA(At, 0, 0); PG8_STAGE(PG8_SA(1, 1), a1 + hstep, voffA);
            PG8_WAIT_V(8); PG8_WAIT_L(0); PG8_BAR; PG8_MMA(0, 0, At, B0); PG8_MMA(0, 1, At, B1); PG8_BAR; PG8_SCHED;
            PG8_LDA(At, 0, 1); PG8_STAGE(PG8_SB(0, 0), b2, voffB); PG8_STAGE(PG8_SB(0, 1), b2 + hstep, voffB); PG8_STAGE(PG8_SA(0, 0), a2, voffA);
            PG8_WAIT_V(8); PG8_WAIT_L(0); PG8_BAR; PG8_MMA(1, 0, At, B0); PG8_MMA(1, 1, At, B1); PG8_BAR; PG8_SCHED;
            PG8_LDB(B0, 1, 0); PG8_LDB(B1, 1, 1); PG8_SCHED; PG8_LDA(At, 1, 0); PG8_STAGE(PG8_SA(0, 1), a2 + hstep, voffA);
            PG8_WAIT_V(8); PG8_WAIT_L(0); PG8_BAR; PG8_MMA(0, 0, At, B0); PG8_MMA(0, 1, At, B1); PG8_BAR; PG8_SCHED;
            PG8_LDA(At, 1, 1); PG8_STAGE(PG8_SB(1, 0), b3, voffB); PG8_STAGE(PG8_SB(1, 1), b3 + hstep, voffB); PG8_STAGE(PG8_SA(1, 0), a3, voffA);
            PG8_WAIT_V(8); PG8_WAIT_L(0); PG8_BAR; PG8_MMA(1, 0, At, B0); PG8_MMA(1, 1, At, B1); PG8_BAR; PG8_SCHED;
            } else {
            PG8_LDB(B0, 0, 0); PG8_SCHED; PG8_LDA(At, 0, 0); PG8_STAGE(PG8_SA(1, 1), a1 + hstep, voffA);
            PG8_WAIT_L(8); PG8_BAR; PG8_WAIT_L(0); PG8_MMA(0, 0, At, B0); PG8_BAR; PG8_SCHED;
            PG8_LDB(B1, 0, 1); PG8_STAGE(PG8_SB(0, 0), b2, voffB);
            PG8_BAR; PG8_WAIT_L(0); PG8_MMA(0, 1, At, B1); PG8_BAR;
            PG8_LDA(At, 0, 1); PG8_STAGE(PG8_SA(0, 0), a2, voffA);
            PG8_BAR; PG8_WAIT_L(0); PG8_MMA(1, 0, At, B0); PG8_BAR; PG8_SCHED;
            PG8_STAGE(PG8_SB(0, 1), b2 + hstep, voffB);
            PG8_WAIT_V(6); PG8_BAR; PG8_MMA(1, 1, At, B1); PG8_BAR;
            PG8_LDB(B0, 1, 0); PG8_SCHED; PG8_LDA(At, 1, 0); PG8_STAGE(PG8_SA(0, 1), a2 + hstep, voffA);
            PG8_WAIT_L(8); PG8_BAR; PG8_WAIT_L(0); PG8_MMA(0, 0, At, B0); PG8_BAR; PG8_SCHED;
            PG8_LDB(B1, 1, 1); PG8_STAGE(PG8_SB(1, 0), b3, voffB);
            PG8_BAR; PG8_WAIT_L(0); PG8_MMA(0, 1, At, B1); PG8_BAR;
            PG8_LDA(At, 1, 1); PG8_STAGE(PG8_SA(1, 0), a3, voffA);
            PG8_BAR; PG8_WAIT_L(0); PG8_MMA(1, 0, At, B0); PG8_BAR; PG8_SCHED;
            PG8_STAGE(PG8_SB(1, 1), b3 + hstep, voffB);
            PG8_WAIT_V(6); PG8_BAR; PG8_MMA(1, 1, At, B1); PG8_BAR;
            }
        }
        if constexpr (ALIGN_EPI) { if (wr == 0) PG8_BAR; }
        if constexpr (!Epi::AFTER_DRAIN) { E(acc, cur, wr, wc, fr, fq); S.done(cur); }
        if (!has_next) break;
#pragma unroll
        for (int a = 0; a < 2; ++a)
#pragma unroll
            for (int b = 0; b < 2; ++b)
#pragma unroll
                for (int m = 0; m < 4; ++m)
#pragma unroll
                    for (int n = 0; n < 2; ++n) acc[a][b][m][n] = (f32x4){0.f, 0.f, 0.f, 0.f};
        cur = nxt; cA = nA; cB = nB; ++ui;
        if constexpr (ALIGN_EPI) { if (wr == 1) PG8_BAR; }
    }
    PG8_WAIT_V(0);
    if constexpr (!ALIGN_EPI) { if (wr == 0) PG8_BAR; }
    PG8_BAR;
    if constexpr (Epi::AFTER_DRAIN) { E.fused(acc, cur, wr, wc, fr, fq, lds, wid, lane); S.done(cur); }
#undef PG8_SA
#undef PG8_SB
#undef PG8_STAGE
#undef PG8_LDA
#undef PG8_LDB
#undef PG8_MMA
#undef PG8_WAIT_V
#undef PG8_WAIT_L
#undef PG8_BAR
#undef PG8_SCHED
}
}
#define GAS __attribute__((address_space(1)))
#define LAS __attribute__((address_space(3)))
typedef unsigned short bf16;
typedef unsigned v4u __attribute__((ext_vector_type(4)));
typedef float f32x4 __attribute__((ext_vector_type(4)));
typedef short bf16x8 __attribute__((ext_vector_type(8)));
typedef GAS unsigned gu32;
typedef GAS unsigned long long gu64;
#define RLX_AGENT __ATOMIC_RELAXED, __HIP_MEMORY_SCOPE_AGENT
#define LDS_WAIT() asm volatile("s_waitcnt lgkmcnt(0)" ::: "memory")
#define VM_WAIT() asm volatile("s_waitcnt vmcnt(0)" ::: "memory")
__device__ __forceinline__ unsigned long long rt() { return __builtin_amdgcn_s_memrealtime(); }
__device__ __forceinline__ unsigned f2bf(float f) { unsigned u = __builtin_bit_cast(unsigned, f); return (u + 0x7fffu + ((u >> 16) & 1u)) >> 16; }
__device__ __forceinline__ unsigned pk2(float lo, float hi) { return f2bf(lo) | (f2bf(hi) << 16); }

#define XB_TMO      128
#define XB_XCNT(j)  (256  + 64 * (j))
#define XB_XSUB(j)  (1280 + 64 * (j))
#define XB_XGEN(j)  (2304 + 64 * (j))
#define XB_TOP      3328
#define XB_TOPGEN   3392
#define XCD_BAR_WORDS 3456
#define XB_SPIN_CAP (1u << 18)

__device__ __forceinline__ unsigned xb_ld(unsigned* p)              { return __hip_atomic_load(p, __ATOMIC_RELAXED, __HIP_MEMORY_SCOPE_AGENT); }
__device__ __forceinline__ unsigned xb_add(unsigned* p, unsigned v) { return __hip_atomic_fetch_add(p, v, __ATOMIC_RELAXED, __HIP_MEMORY_SCOPE_AGENT); }
__device__ __forceinline__ unsigned xb_xcc_id() { return (unsigned)__builtin_amdgcn_s_getreg((3 << 11) | 20) & 0xFu; }
#define XB_SPIN(cond, bar) do { unsigned _sp = 0; while (cond) { __builtin_amdgcn_s_sleep(1); \
    if ((++_sp & 255u) == 0u) { if (xb_ld(&(bar)[XB_TMO])) break; if (_sp > XB_SPIN_CAP) { atomicAdd(&(bar)[XB_TMO], 1u); break; } } } } while (0)

struct XcdBarrier {
    unsigned* bar; unsigned x;
    volatile LAS unsigned* st;
};

__device__ __forceinline__ XcdBarrier xcd_barrier_post(unsigned* bar, volatile LAS unsigned* st) {
    XcdBarrier b; b.bar = bar; b.x = xb_xcc_id(); b.st = st;
    if (threadIdx.x == 0) (void)xb_add(&bar[XB_XCNT(b.x)], 1u);
    return b;
}
__device__ __forceinline__ void xcd_barrier_complete(unsigned* bar, unsigned x, unsigned& nloc, unsigned& nx) {
    const unsigned G = gridDim.x * gridDim.y * gridDim.z;
    unsigned sum, cnt, mine, sp = 0u;
    for (;;) {
        sum = 0u; cnt = 0u; mine = 0u;
#pragma unroll
        for (unsigned j = 0; j < 16; ++j) { const unsigned c = xb_ld(&bar[XB_XCNT(j)]); sum += c; cnt += (c > 0u) ? 1u : 0u; mine = (j == x) ? c : mine; }
        if (sum == G) break;
        __builtin_amdgcn_s_sleep(1);
        if ((++sp & 255u) == 0u) { if (xb_ld(&bar[XB_TMO])) break; if (sp > XB_SPIN_CAP) { atomicAdd(&bar[XB_TMO], 1u); break; } }
    }
    nloc = mine > 0u ? mine : 1u; nx = cnt > 0u ? cnt : 1u;
}

__device__ __forceinline__ void xcd_barrier(const XcdBarrier& b) {
    asm volatile("s_waitcnt vmcnt(0)" ::: "memory");
    __syncthreads();
    if (threadIdx.x == 0) {
        unsigned* bar = b.bar;
        __builtin_amdgcn_s_waitcnt(0);
        unsigned nloc = b.st[0], nx = b.st[1];
        if (nloc == 0u) { xcd_barrier_complete(bar, b.x, nloc, nx); b.st[0] = nloc; b.st[1] = nx; }
        const unsigned old = xb_add(&bar[XB_XSUB(b.x)], 1u);
        const unsigned gen = old / nloc;
        if (old + 1u == (gen + 1u) * nloc) {
            __builtin_amdgcn_fence(__ATOMIC_RELEASE, "agent");
            asm volatile("s_waitcnt vmcnt(0)" ::: "memory");
            const unsigned og = xb_add(&bar[XB_TOP], 1u);
            const unsigned tg = og / nx;
            if (og + 1u == (tg + 1u) * nx) xb_add(&bar[XB_TOPGEN], 1u);
            else XB_SPIN(xb_ld(&bar[XB_TOPGEN]) == tg, bar);
            __builtin_amdgcn_fence(__ATOMIC_ACQUIRE, "agent");
            xb_add(&bar[XB_XGEN(b.x)], 1u);
            asm volatile("s_waitcnt vmcnt(0)" ::: "memory");
        } else {
            XB_SPIN(xb_ld(&bar[XB_XGEN(b.x)]) == gen, bar);
            __builtin_amdgcn_fence(__ATOMIC_ACQUIRE, "agent");
            asm volatile("s_waitcnt vmcnt(0)" ::: "memory");
        }
    }
    __syncthreads();
}

constexpr int T = 16384, D = 1024, SEQ = 8192, NCTX = 256, TCX = 512, DIN = 3840, MH = T + TCX;
constexpr int ZU = 0, ZV = 512, ZQ = 1024, ZK = 1536, ZVA = 1664, ZGA = 1792, ZGB = 2816;
constexpr int NEXP = 256, NSLOT = 9, LISTCAP = 16384, MOE_MAXT = 24;
constexpr float LOG2E = 1.4426950408889634f;
constexpr float QSCALE = 0.125f * LOG2E;
constexpr size_t MiB = 1u << 20;
constexpr size_t WS_CTL = 0, CTL_ZERO_BYTES = 1 * MiB;
constexpr size_t WS_ADAP = 1 * MiB;
constexpr size_t WS_ADAF = 2 * MiB;
constexpr size_t WS_ROPE = 2 * MiB + 128 * 1024;
constexpr size_t WS_WST = 2 * MiB + 256 * 1024;
constexpr size_t WS_RWT = 3 * MiB;
constexpr size_t WS_WINT = 4 * MiB;
constexpr size_t WS_WAT = 12 * MiB, WS_WBT = 13 * MiB, WS_WOT = 14 * MiB;
constexpr size_t WS_KVC = 16 * MiB;
constexpr size_t WS_GATEW = 17 * MiB;
constexpr size_t WS_H = 18 * MiB;
constexpr size_t WS_Z = 52 * MiB;
constexpr size_t WS_A = 172 * MiB, WS_O = 188 * MiB;
constexpr size_t WS_TMP = 204 * MiB;
constexpr size_t WS_Y = 268 * MiB;
constexpr size_t WS_X1 = 300 * MiB;
constexpr size_t WS_H2 = 364 * MiB;
constexpr size_t WS_LIST = 396 * MiB;
constexpr size_t WS_CONTRIB = 414 * MiB;
constexpr float CONTRIB_SCALE = 16.f;
constexpr size_t WS_END = 704 * MiB;
constexpr int CW_BAR = 4096;
constexpr int CW_CNT = 16384;
constexpr int CW_XRANK = 32768;
constexpr int SCR_BYTES = 148480;
constexpr int MISC_OFF = SCR_BYTES;
constexpr int LDS_BYTES = 152 * 1024;
constexpr int NWAVES = 8;

typedef float f32x2_t __attribute__((ext_vector_type(2)));
typedef __bf16 bf16x2_t __attribute__((ext_vector_type(2)));
typedef float f32x16 __attribute__((ext_vector_type(16)));
typedef short s16x4 __attribute__((ext_vector_type(4)));
typedef short v4i16_t __attribute__((ext_vector_type(4)));
typedef unsigned u32x2 __attribute__((ext_vector_type(2)));
typedef unsigned u32x4 __attribute__((ext_vector_type(4)));
typedef LAS unsigned char* ldsp;

__device__ __forceinline__ unsigned cvtpk(float lo, float hi) { f32x2_t v = {lo, hi}; bf16x2_t b = __builtin_convertvector(v, bf16x2_t); return __builtin_bit_cast(unsigned, b); }
__device__ __forceinline__ float bf2f(unsigned short u) { return __uint_as_float((unsigned)u << 16); }
__device__ __forceinline__ float bflo(unsigned w) { return __uint_as_float(w << 16); }
__device__ __forceinline__ float bfhi(unsigned w) { return __uint_as_float(w & 0xffff0000u); }
__device__ __forceinline__ float wave_sum(float v) {
#pragma unroll
    for (int o = 1; o < 64; o <<= 1) v += __shfl_xor(v, o);
    return v;
}
__device__ __forceinline__ float sigmoid_f(float x) { return __builtin_amdgcn_rcpf(1.f + __builtin_amdgcn_exp2f(-x * LOG2E)); }
__device__ __forceinline__ float silu_f(float x) { return x * sigmoid_f(x); }
__device__ __forceinline__ float gelu_f(float x) { const float u = 0.7978845608028654f * (x + 0.044715f * x * x * x); return x * sigmoid_f(2.f * u); }
__device__ __forceinline__ f32x16 mfma32(bf16x8 a, bf16x8 b, f32x16 c) { return __builtin_amdgcn_mfma_f32_32x32x16_bf16(a, b, c, 0, 0, 0); }
__device__ __forceinline__ f32x4 mfma16(bf16x8 a, bf16x8 b, f32x4 c) { return __builtin_amdgcn_mfma_f32_16x16x32_bf16(a, b, c, 0, 0, 0); }

struct Args { const float* in[26]; float* out; unsigned char* ws; int ph_lo, ph_hi; };
enum { I_X = 0, I_C, I_CTX, I_CCTX, I_ADAW, I_ADAB, I_N1G, I_N2G, I_WIN, I_LNG, I_LNB, I_GWS, I_GBS, I_SINK, I_WA, I_WB, I_WO, I_RW, I_RB, I_EG, I_EU, I_ED, I_SG, I_SU, I_SD, I_FG };

__device__ __forceinline__ void p0_transpose_item(const float* W, int K, int N, bf16* WT, LAS float* scr, int item, int lane) {
    const int nblk = N / 32, kb = item / nblk, nb = item % nblk, k0 = 64 * kb, n0 = 32 * nb;
#pragma unroll 8
    for (int i = 0; i < 32; ++i) { const int kk = 2 * i + (lane >> 5); scr[kk * 33 + (lane & 31)] = W[(size_t)(k0 + kk) * N + n0 + (lane & 31)]; }
    LDS_WAIT(); asm volatile("" ::: "memory");
    const int c = lane & 7;
#pragma unroll
    for (int j = 0; j < 4; ++j) { const int n = (lane >> 3) + 8 * j; const LAS float* s = scr + (8 * c) * 33 + n;
        v4u o; o.x = pk2(s[0 * 33], s[1 * 33]); o.y = pk2(s[2 * 33], s[3 * 33]); o.z = pk2(s[4 * 33], s[5 * 33]); o.w = pk2(s[6 * 33], s[7 * 33]);
        *(GAS v4u*)(WT + (size_t)(n0 + n) * K + k0 + 8 * c) = o; }
    LDS_WAIT(); asm volatile("" ::: "memory");
}

__device__ __forceinline__ void phase_prep(const Args& a, ldsp lds, int G) {
    const int tid = threadIdx.x, lane = tid & 63, wave = __builtin_amdgcn_readfirstlane(tid >> 6), blk = blockIdx.x;
    unsigned char* ws = a.ws;
    if (blk < 192) {
        const int cb = blk % 24, kc = blk / 24, col = cb * 256 + lane * 4, k0 = kc * 128 + wave * 16;
        const float* c = a.in[I_C]; const float* cc = a.in[I_CCTX]; const float* aw = a.in[I_ADAW];
        f32x4 a0 = {0.f, 0.f, 0.f, 0.f}, a1 = a0, a2 = a0;
#pragma unroll 4
        for (int k = 0; k < 16; ++k) {
            const int kk = k0 + k;
            const float s0 = silu_f(c[kk]), s1 = silu_f(c[1024 + kk]), s2 = silu_f(cc[kk]);
            const f32x4 w = *(const f32x4*)(aw + (size_t)kk * 6144 + col);
            a0 += w * s0; a1 += w * s1; a2 += w * s2;
        }
        LAS float* red = (LAS float*)lds;
        *(LAS f32x4*)(red + (wave * 3 + 0) * 256 + lane * 4) = a0;
        *(LAS f32x4*)(red + (wave * 3 + 1) * 256 + lane * 4) = a1;
        *(LAS f32x4*)(red + (wave * 3 + 2) * 256 + lane * 4) = a2;
        __syncthreads();
        float* adap = (float*)(ws + WS_ADAP);
        for (int idx = tid; idx < 768; idx += 512) {
            const int v = idx >> 8, cl = idx & 255; float s = 0.f;
#pragma unroll
            for (int w = 0; w < 8; ++w) s += red[(w * 3 + v) * 256 + cl];
            adap[(size_t)(kc * 3 + v) * 6144 + cb * 256 + cl] = s;
        }
        __syncthreads();
    }
    {
        LAS float* scr = (LAS float*)(lds + wave * 8704);
        const int gw = blk * NWAVES + wave, NGW = G * NWAVES;
        constexpr int I_1 = 16 * 120, I_2 = 8 * 32, I_3 = 8 * 32, I_4 = 16 * 32, I_5 = 16 * 8;
        for (int it = gw; it < I_1 + I_2 + I_3 + I_4 + I_5; it += NGW) {
            int r = it;
            if (r < I_1) { p0_transpose_item(a.in[I_WIN], 1024, 3840, (bf16*)(ws + WS_WINT), scr, r, lane); continue; } r -= I_1;
            if (r < I_2) { p0_transpose_item(a.in[I_WA], 512, 1024, (bf16*)(ws + WS_WAT), scr, r, lane); continue; } r -= I_2;
            if (r < I_3) { p0_transpose_item(a.in[I_WB], 512, 1024, (bf16*)(ws + WS_WBT), scr, r, lane); continue; } r -= I_3;
            if (r < I_4) { p0_transpose_item(a.in[I_WO], 1024, 1024, (bf16*)(ws + WS_WOT), scr, r, lane); continue; } r -= I_4;
            p0_transpose_item(a.in[I_RW], 1024, 256, (bf16*)(ws + WS_RWT), scr, r, lane);
        }
    }
    {
        const int gt = blk * 512 + tid, NT = G * 512;
        const float* gws = a.in[I_GWS]; bf16* wst = (bf16*)(ws + WS_WST);
        for (int i = gt; i < 8192; i += NT) {
            const f32x4 x0 = *(const f32x4*)(gws + i * 8), x1 = *(const f32x4*)(gws + i * 8 + 4);
            v4u o; o.x = cvtpk(x0[0], x0[1]); o.y = cvtpk(x0[2], x0[3]); o.z = cvtpk(x1[0], x1[1]); o.w = cvtpk(x1[2], x1[3]);
            *(v4u*)(wst + i * 8) = o;
        }
        float* rope = (float*)(ws + WS_ROPE);
        for (int i = gt; i < 2048; i += NT) {
            const int pos = i >> 4, f = i & 15;
            const float inv = __builtin_amdgcn_exp2f(-(float)f * (13.287712379549449f / 16.f));
            const float ang = (float)pos * inv;
            double rev = (double)ang * 0.15915494309189535; rev -= floor(rev);
            rope[pos * 32 + f] = __builtin_amdgcn_cosf((float)rev);
            rope[pos * 32 + 16 + f] = __builtin_amdgcn_sinf((float)rev);
        }
    }
}

__device__ __forceinline__ void phase_hnorm(const Args& a, ldsp lds, int G) {
    const int tid = threadIdx.x, lane = tid & 63, wave = __builtin_amdgcn_readfirstlane(tid >> 6), blk = blockIdx.x;
    unsigned char* ws = a.ws;
    const float* adap = (const float*)(ws + WS_ADAP); const float* adab = a.in[I_ADAB];
    LAS float* modv = (LAS float*)lds;
    for (int idx = tid; idx < 3 * 2048; idx += 512) {
        const int v = idx >> 11, j = idx & 2047; float s = adab[j];
#pragma unroll
        for (int kc = 0; kc < 8; ++kc) s += adap[(size_t)(kc * 3 + v) * 6144 + j];
        modv[idx] = (j >= 1024) ? s + 1.f : s;
    }
    { float* adaf = (float*)(ws + WS_ADAF);
      for (int idx = blk * 512 + tid; idx < 3 * 6144; idx += G * 512) {
          const int v = idx / 6144, j = idx % 6144; float s = adab[j];
#pragma unroll
          for (int kc = 0; kc < 8; ++kc) s += adap[(size_t)(kc * 3 + v) * 6144 + j];
          adaf[idx] = s; } }
    __syncthreads();
    const float* g1 = a.in[I_N1G]; bf16* H = (bf16*)(ws + WS_H);
    for (int t = blk * NWAVES + wave; t < MH; t += G * NWAVES) {
        const float* xr = (t < T) ? a.in[I_X] + (size_t)t * D : a.in[I_CTX] + (size_t)(t - T) * D;
        const int v = (t < T) ? (t >> 13) : 2;
        f32x4 x[4]; float ss = 0.f;
#pragma unroll
        for (int j = 0; j < 4; ++j) { x[j] = *(const f32x4*)(xr + 4 * lane + 256 * j); ss += (x[j][0] * x[j][0] + x[j][1] * x[j][1]) + (x[j][2] * x[j][2] + x[j][3] * x[j][3]); }
        const float r = rsqrtf(wave_sum(ss) * (1.f / D) + 1e-6f);
#pragma unroll
        for (int j = 0; j < 4; ++j) {
            const int col = 4 * lane + 256 * j;
            const f32x4 g = *(const f32x4*)(g1 + col);
            const f32x4 sh = *(LAS f32x4*)(modv + v * 2048 + col), sc = *(LAS f32x4*)(modv + v * 2048 + 1024 + col);
            const f32x4 h = (x[j] * r) * g * sc + sh;
            u32x2 o; o.x = cvtpk(h[0], h[1]); o.y = cvtpk(h[2], h[3]);
            *(u32x2*)(H + (size_t)t * D + col) = o;
        }
    }
}

struct WinOrder {
    pg8::StaticOrder so;
    __device__ void init(int G, int c) { so.init(T, DIN, G, c); }
    __device__ bool next(int i, pg8::Unit& u) const {
        const long L = (long)i * so.G + so.c;
        if (L < 960) return so.next(i, u);
        if (L < 962) { u.pm = 64 + (int)(L - 960); u.pn = 6; return true; }
        return false;
    }
    __device__ __forceinline__ void a_ready(const pg8::Unit&) const {}
    __device__ __forceinline__ void done(const pg8::Unit&) const {}
};
struct EpiWin {
    static constexpr bool PERM = false, AFTER_DRAIN = false;
    bf16* Z; bf16* KVC; const float* rope;
    __device__ __forceinline__ void operator()(const pg8::f32x4 (&acc)[2][2][4][2], const pg8::Unit& u, int wr, int wc, int fr, int fq) const {
        const int row0 = u.pm * 256 + wr * 64 + fr, colb = u.pn * 256 + wc * 32 + 4 * fq, pn = u.pn;
        if (u.pm >= 64) {
#pragma unroll
            for (int ai = 0; ai < 2; ++ai)
#pragma unroll
                for (int m = 0; m < 4; ++m) { bf16* rp = KVC + (size_t)(row0 + ai * 128 + m * 16 - T) * 256 + (colb - ZK);
#pragma unroll
                    for (int bj = 0; bj < 2; ++bj)
#pragma unroll
                        for (int n = 0; n < 2; ++n) { const pg8::f32x4 v = acc[ai][bj][m][n]; u32x2 o; o.x = cvtpk(v[0], v[1]); o.y = cvtpk(v[2], v[3]); *(u32x2*)(rp + bj * 128 + n * 16) = o; } }
            return;
        }
#pragma unroll
        for (int ai = 0; ai < 2; ++ai)
#pragma unroll
            for (int m = 0; m < 4; ++m) {
                const int r = row0 + ai * 128 + m * 16; bf16* rp = Z + (size_t)r * DIN + colb;
                if (pn <= 3) {
#pragma unroll
                    for (int bj = 0; bj < 2; ++bj)
#pragma unroll
                        for (int n = 0; n < 2; ++n) { const pg8::f32x4 v = acc[ai][bj][m][n]; u32x2 o; o.x = cvtpk(gelu_f(v[0]), gelu_f(v[1])); o.y = cvtpk(gelu_f(v[2]), gelu_f(v[3])); *(u32x2*)(rp + bj * 128 + n * 16) = o; }
                } else if (pn <= 6) {
                    const int pos = (wc & 1) ? (r & 63) : ((r & 8191) >> 6);
                    const pg8::f32x4 cs = *(const pg8::f32x4*)(rope + pos * 32 + 4 * fq), sn = *(const pg8::f32x4*)(rope + pos * 32 + 16 + 4 * fq);
                    const float sc = (pn < 6) ? QSCALE : 1.f;
#pragma unroll
                    for (int bj = 0; bj < 2; ++bj) {
                        const pg8::f32x4 x1 = acc[ai][bj][m][0], x2 = acc[ai][bj][m][1];
                        pg8::f32x4 o1, o2;
                        if (pn == 6 && bj == 1) { o1 = x1; o2 = x2; }
                        else { o1 = (x1 * cs - x2 * sn) * sc; o2 = (x2 * cs + x1 * sn) * sc; }
                        u32x2 w1, w2; w1.x = cvtpk(o1[0], o1[1]); w1.y = cvtpk(o1[2], o1[3]); w2.x = cvtpk(o2[0], o2[1]); w2.y = cvtpk(o2[2], o2[3]);
                        *(u32x2*)(rp + bj * 128) = w1; *(u32x2*)(rp + bj * 128 + 16) = w2;
                    }
                } else {
#pragma unroll
                    for (int bj = 0; bj < 2; ++bj)
#pragma unroll
                        for (int n = 0; n < 2; ++n) { const pg8::f32x4 v = acc[ai][bj][m][n]; u32x2 o; o.x = cvtpk(sigmoid_f(v[0]), sigmoid_f(v[1])); o.y = cvtpk(sigmoid_f(v[2]), sigmoid_f(v[3])); *(u32x2*)(rp + bj * 128 + n * 16) = o; }
                }
            }
    }
};
struct EpiMergeA {
    static constexpr bool PERM = true, AFTER_DRAIN = false;
    const bf16* Z; bf16* Y;
    __device__ __forceinline__ void operator()(const pg8::f32x4 (&acc)[2][2][4][2], const pg8::Unit& u, int wr, int wc, int fr, int fq) const {
        const int row0 = u.pm * 256 + wr * 64 + fr, col0 = u.pn * 256 + wc * 32 + 8 * fq;
#pragma unroll
        for (int ai = 0; ai < 2; ++ai)
#pragma unroll
            for (int m = 0; m < 4; ++m) { const int r = row0 + ai * 128 + m * 16;
#pragma unroll
                for (int bj = 0; bj < 2; ++bj) { const int c = col0 + bj * 128;
                    const u32x4 g = *(const u32x4*)(Z + (size_t)r * DIN + ZGA + c);
                    const pg8::f32x4 v0 = acc[ai][bj][m][0], v1 = acc[ai][bj][m][1];
                    u32x4 o;
                    o.x = cvtpk(v0[0] * bflo(g.x), v0[1] * bfhi(g.x)); o.y = cvtpk(v0[2] * bflo(g.y), v0[3] * bfhi(g.y));
                    o.z = cvtpk(v1[0] * bflo(g.z), v1[1] * bfhi(g.z)); o.w = cvtpk(v1[2] * bflo(g.w), v1[3] * bfhi(g.w));
                    *(u32x4*)(Y + (size_t)r * D + c) = o; } }
    }
};
struct EpiMergeB {
    static constexpr bool PERM = true, AFTER_DRAIN = false;
    const bf16* Z; bf16* Y;
    __device__ __forceinline__ void operator()(const pg8::f32x4 (&acc)[2][2][4][2], const pg8::Unit& u, int wr, int wc, int fr, int fq) const {
        const int row0 = u.pm * 256 + wr * 64 + fr, col0 = u.pn * 256 + wc * 32 + 8 * fq;
#pragma unroll
        for (int ai = 0; ai < 2; ++ai)
#pragma unroll
            for (int m = 0; m < 4; ++m) { const int r = row0 + ai * 128 + m * 16;
#pragma unroll
                for (int bj = 0; bj < 2; ++bj) { const int c = col0 + bj * 128;
                    const u32x4 g = *(const u32x4*)(Z + (size_t)r * DIN + ZGB + c);
                    const u32x4 tp = *(const u32x4*)(Y + (size_t)r * D + c);
                    const pg8::f32x4 t0 = {bflo(tp.x), bfhi(tp.x), bflo(tp.y), bfhi(tp.y)}, t1 = {bflo(tp.z), bfhi(tp.z), bflo(tp.w), bfhi(tp.w)};
                    const pg8::f32x4 v0 = acc[ai][bj][m][0], v1 = acc[ai][bj][m][1];
                    u32x4 o;
                    o.x = cvtpk(t0[0] + v0[0] * bflo(g.x), t0[1] + v0[1] * bfhi(g.x)); o.y = cvtpk(t0[2] + v0[2] * bflo(g.y), t0[3] + v0[3] * bfhi(g.y));
                    o.z = cvtpk(t1[0] + v1[0] * bflo(g.z), t1[1] + v1[1] * bfhi(g.z)); o.w = cvtpk(t1[2] + v1[2] * bflo(g.w), t1[3] + v1[3] * bfhi(g.w));
                    *(u32x4*)(Y + (size_t)r * D + c) = o; } }
    }
};
struct EpiWo {
    static constexpr bool PERM = true, AFTER_DRAIN = false;
    const float* x; const float* adaf; bf16* X1;
    __device__ __forceinline__ void operator()(const pg8::f32x4 (&acc)[2][2][4][2], const pg8::Unit& u, int wr, int wc, int fr, int fq) const {
        const int row0 = u.pm * 256 + wr * 64 + fr, col0 = u.pn * 256 + wc * 32 + 8 * fq;
        const float* g1 = adaf + (u.pm >= 32 ? 6144 : 0) + 2048;
#pragma unroll
        for (int bj = 0; bj < 2; ++bj) { const int c = col0 + bj * 128;
            const pg8::f32x4 ga = *(const pg8::f32x4*)(g1 + c), gb = *(const pg8::f32x4*)(g1 + c + 4);
#pragma unroll
            for (int ai = 0; ai < 2; ++ai)
#pragma unroll
                for (int m = 0; m < 4; ++m) { const int r = row0 + ai * 128 + m * 16;
                    const pg8::f32x4 x0 = *(const pg8::f32x4*)(x + (size_t)r * D + c), x1 = *(const pg8::f32x4*)(x + (size_t)r * D + c + 4);
                    const pg8::f32x4 o0 = x0 + ga * acc[ai][bj][m][0], o1 = x1 + gb * acc[ai][bj][m][1];
                    u32x4 w; w.x = cvtpk(o0[0], o0[1]); w.y = cvtpk(o0[2], o0[3]); w.z = cvtpk(o1[0], o1[1]); w.w = cvtpk(o1[2], o1[3]);
                    *(u32x4*)(X1 + (size_t)r * D + c) = w; } }
    }
};


__device__ __forceinline__ s16x4 vtr(LAS const unsigned char* p) { return __builtin_bit_cast(s16x4, __builtin_amdgcn_ds_read_tr16_b64_v4i16((LAS v4i16_t*)p)); }

__device__ __forceinline__ void attn_item(const bf16* Z, const bf16* KVC, const float* sink, bf16* Obuf, ldsp lds, int b, int nb, int hk, int qh) {
    const int tid = threadIdx.x, lane = tid & 63, wave = __builtin_amdgcn_readfirstlane(tid >> 6), r32 = lane & 31, hi = lane >> 5;
    const int rq = wave >> 1, head = hk * 4 + rq;
    const int iq = qh * 64 + (wave & 1) * 32 + r32;
    const int wlo = (nb == 0) ? 2 : qh, whi = (nb == 63) ? 4 : 5 + qh, nwin = whi - wlo, ntile = nwin + 4;
    const int tokq = b * SEQ + nb * 128 + iq;
    bf16x8 qr[4];
#pragma unroll
    for (int d0 = 0; d0 < 4; ++d0) qr[d0] = *(const bf16x8*)(Z + (size_t)tokq * DIN + ZQ + head * 64 + d0 * 16 + hi * 8);
    float mrun = sink[head] * LOG2E, lrun = (hi == 0) ? 1.f : 0.f;
    f32x16 o[2];
#pragma unroll
    for (int j = 0; j < 2; ++j)
#pragma unroll
        for (int r = 0; r < 16; ++r) o[j][r] = 0.f;
    const int kdst = wave * 1024 + lane * 16, vdst = 8192 + (wave >> 2) * 4096 + lane * 64 + (wave & 3) * 16;
#define ATT_SRC(s, kp, vp) do { const int tl_ = (s) < nwin ? wlo + (s) : 6 + (s) - nwin; \
        if (tl_ < 6) { const int tok_ = b * SEQ + (nb - 1 + (tl_ >> 1)) * 128 + (tl_ & 1) * 64 + lane; kp = Z + (size_t)tok_ * DIN + ZK + hk * 64 + wave * 8; vp = Z + (size_t)tok_ * DIN + ZVA + hk * 64 + wave * 8; } \
        else { const int row_ = b * NCTX + (tl_ - 6) * 64 + lane; kp = KVC + (size_t)row_ * 256 + hk * 64 + wave * 8; vp = KVC + (size_t)row_ * 256 + 128 + hk * 64 + wave * 8; } } while (0)
    u32x4 kreg, vreg;
    { const bf16 *kp, *vp; ATT_SRC(0, kp, vp); kreg = *(const u32x4*)kp; vreg = *(const u32x4*)vp; }
    *(LAS u32x4*)(lds + kdst) = kreg; *(LAS u32x4*)(lds + vdst) = vreg;
    __syncthreads();
    const int vrd = ((lane & 15) >> 2) * 64 + ((lane >> 4) & 1) * 32 + (lane & 3) * 8 + hi * 256;
    for (int s = 0; s < ntile; ++s) {
        const int base = (s & 1) * 16384;
        const int tl = s < nwin ? wlo + s : 6 + s - nwin;
        if (s + 1 < ntile) { const bf16 *kp, *vp; ATT_SRC(s + 1, kp, vp); kreg = *(const u32x4*)kp; vreg = *(const u32x4*)vp; }
        {
            f32x16 p0, p1;
#pragma unroll
            for (int r = 0; r < 16; ++r) { p0[r] = 0.f; p1[r] = 0.f; }
#pragma unroll
            for (int d0 = 0; d0 < 4; ++d0) {
                const bf16x8 k0 = *(LAS const bf16x8*)(lds + base + (2 * d0 + hi) * 1024 + r32 * 16);
                const bf16x8 k1 = *(LAS const bf16x8*)(lds + base + (2 * d0 + hi) * 1024 + (r32 + 32) * 16);
                p0 = mfma32(k0, qr[d0], p0); p1 = mfma32(k1, qr[d0], p1);
            }
            if (tl < 2) {
                const int j0 = (tl & 1) * 64 + 4 * hi;
#pragma unroll
                for (int r = 0; r < 16; ++r) { const int j = j0 + (r & 3) + 8 * (r >> 2); if (j < iq) p0[r] = -INFINITY; if (j + 32 < iq) p1[r] = -INFINITY; }
            } else if (tl == 4 || tl == 5) {
                const int j0 = (tl & 1) * 64 + 4 * hi;
#pragma unroll
                for (int r = 0; r < 16; ++r) { const int j = j0 + (r & 3) + 8 * (r >> 2); if (j > iq) p0[r] = -INFINITY; if (j + 32 > iq) p1[r] = -INFINITY; }
            }
            float mx = fmaxf(p0[0], p1[0]);
#pragma unroll
            for (int r = 1; r < 16; ++r) mx = fmaxf(mx, fmaxf(p0[r], p1[r]));
            mx = fmaxf(mx, __shfl_xor(mx, 32));
            const float mn = fmaxf(mrun, mx), alpha = __builtin_amdgcn_exp2f(mrun - mn);
            mrun = mn;
            float rs = 0.f;
#pragma unroll
            for (int r = 0; r < 16; ++r) { p0[r] = __builtin_amdgcn_exp2f(p0[r] - mn); p1[r] = __builtin_amdgcn_exp2f(p1[r] - mn); rs += p0[r] + p1[r]; }
            lrun = lrun * alpha + rs;
#pragma unroll
            for (int r = 0; r < 16; ++r) { o[0][r] *= alpha; o[1][r] *= alpha; }
            bf16x8 pf[4];
#pragma unroll
            for (int s4 = 0; s4 < 4; ++s4) {
                u32x4 w;
                if (s4 < 2) { w.x = cvtpk(p0[8 * s4 + 0], p0[8 * s4 + 1]); w.y = cvtpk(p0[8 * s4 + 2], p0[8 * s4 + 3]); w.z = cvtpk(p0[8 * s4 + 4], p0[8 * s4 + 5]); w.w = cvtpk(p0[8 * s4 + 6], p0[8 * s4 + 7]); }
                else { const int q = s4 - 2; w.x = cvtpk(p1[8 * q + 0], p1[8 * q + 1]); w.y = cvtpk(p1[8 * q + 2], p1[8 * q + 3]); w.z = cvtpk(p1[8 * q + 4], p1[8 * q + 5]); w.w = cvtpk(p1[8 * q + 6], p1[8 * q + 7]); }
                pf[s4] = __builtin_bit_cast(bf16x8, w);
            }
#pragma unroll
            for (int dblk = 0; dblk < 2; ++dblk)
#pragma unroll
                for (int s4 = 0; s4 < 4; ++s4) {
                    const s16x4 lo = vtr(lds + base + 8192 + dblk * 4096 + vrd + (16 * s4) * 64);
                    const s16x4 hh = vtr(lds + base + 8192 + dblk * 4096 + vrd + (16 * s4 + 8) * 64);
                    const bf16x8 vf = {lo[0], lo[1], lo[2], lo[3], hh[0], hh[1], hh[2], hh[3]};
                    o[dblk] = mfma32(vf, pf[s4], o[dblk]);
                }
        }
        if (s + 1 < ntile) { *(LAS u32x4*)(lds + (16384 - base) + kdst) = kreg; *(LAS u32x4*)(lds + (16384 - base) + vdst) = vreg; }
        __syncthreads();
    }
#undef ATT_SRC
    {
        const float lt = lrun + __shfl_xor(lrun, 32), inv = 1.f / lt;
        bf16* op = Obuf + (size_t)tokq * 512 + head * 64;
#pragma unroll
        for (int dblk = 0; dblk < 2; ++dblk)
#pragma unroll
            for (int r4 = 0; r4 < 4; ++r4) {
                u32x2 w; w.x = cvtpk(o[dblk][4 * r4] * inv, o[dblk][4 * r4 + 1] * inv); w.y = cvtpk(o[dblk][4 * r4 + 2] * inv, o[dblk][4 * r4 + 3] * inv);
                *(u32x2*)(op + 32 * dblk + 8 * r4 + 4 * hi) = w;
            }
    }
}

__device__ __forceinline__ void gmlp_item(const bf16* Z, const float* lng, const float* lnb, const bf16* WsT, const float* bs, bf16* Abuf, ldsp lds, int ch, int gp) {
    const int tid = threadIdx.x, lane = tid & 63, wave = __builtin_amdgcn_readfirstlane(tid >> 6), fr = lane & 15, fq = lane >> 4;
    const int tok0 = ch * 128;
    LAS bf16* VT = (LAS bf16*)lds;
    f32x4 gA = *(const f32x4*)(lng + lane * 8), gB = *(const f32x4*)(lng + lane * 8 + 4), bA = *(const f32x4*)(lnb + lane * 8), bB = *(const f32x4*)(lnb + lane * 8 + 4);
#pragma unroll
    for (int rnd = 0; rnd < 2; ++rnd) {
        float y[8][8];
#pragma unroll
        for (int j = 0; j < 8; ++j) {
            const int tok = tok0 + wave * 16 + rnd * 8 + j;
            const u32x4 raw = *(const u32x4*)(Z + (size_t)tok * DIN + ZV + lane * 8);
            float x[8] = {bflo(raw.x), bfhi(raw.x), bflo(raw.y), bfhi(raw.y), bflo(raw.z), bfhi(raw.z), bflo(raw.w), bfhi(raw.w)};
            float s = 0.f;
#pragma unroll
            for (int i = 0; i < 8; ++i) s += x[i];
            const float mu = wave_sum(s) * (1.f / 512.f);
            float q = 0.f;
#pragma unroll
            for (int i = 0; i < 8; ++i) { x[i] -= mu; q += x[i] * x[i]; }
            const float rstd = rsqrtf(wave_sum(q) * (1.f / 512.f) + 1e-6f);
            y[j][0] = x[0] * rstd * gA[0] + bA[0]; y[j][1] = x[1] * rstd * gA[1] + bA[1]; y[j][2] = x[2] * rstd * gA[2] + bA[2]; y[j][3] = x[3] * rstd * gA[3] + bA[3];
            y[j][4] = x[4] * rstd * gB[0] + bB[0]; y[j][5] = x[5] * rstd * gB[1] + bB[1]; y[j][6] = x[6] * rstd * gB[2] + bB[2]; y[j][7] = x[7] * rstd * gB[3] + bB[3];
        }
        if ((lane >> 5) == gp) {
            const int gl = (lane >> 4) & 1;
#pragma unroll
            for (int i = 0; i < 8; ++i) {
                u32x4 w; w.x = cvtpk(y[0][i], y[1][i]); w.y = cvtpk(y[2][i], y[3][i]); w.z = cvtpk(y[4][i], y[5][i]); w.w = cvtpk(y[6][i], y[7][i]);
                *(LAS u32x4*)(VT + gl * (128 * 136) + (8 * (lane & 15) + i) * 136 + wave * 16 + rnd * 8) = w;
            }
        }
    }
    __syncthreads();
    const int wm = wave >> 1, wn = wave & 1;
#pragma unroll
    for (int gl = 0; gl < 2; ++gl) {
        const int g = 2 * gp + gl;
        f32x4 acc[2][4];
#pragma unroll
        for (int m = 0; m < 2; ++m)
#pragma unroll
            for (int n = 0; n < 4; ++n) acc[m][n] = (f32x4){0.f, 0.f, 0.f, 0.f};
#pragma unroll
        for (int ks = 0; ks < 4; ++ks) {
            bf16x8 af[2], bfr[4];
#pragma unroll
            for (int m = 0; m < 2; ++m) af[m] = *(const bf16x8*)(WsT + (size_t)g * 16384 + (32 * wm + 16 * m + fr) * 128 + 32 * ks + 8 * fq);
#pragma unroll
            for (int n = 0; n < 4; ++n) bfr[n] = *(LAS const bf16x8*)(VT + gl * (128 * 136) + (64 * wn + 16 * n + fr) * 136 + 32 * ks + 8 * fq);
#pragma unroll
            for (int m = 0; m < 2; ++m)
#pragma unroll
                for (int n = 0; n < 4; ++n) acc[m][n] = mfma16(bfr[n], af[m], acc[m][n]);
        }
#pragma unroll
        for (int m = 0; m < 2; ++m) {
            const int p = 32 * wm + 16 * m + fr, tok = tok0 + p; const float bias = bs[g * 128 + p];
#pragma unroll
            for (int n = 0; n < 4; ++n) {
                const int c = g * 128 + 64 * wn + 16 * n + 4 * fq;
                const u32x2 uw = *(const u32x2*)(Z + (size_t)tok * DIN + ZU + c);
                u32x2 w; w.x = cvtpk(bflo(uw.x) * (acc[m][n][0] + bias), bfhi(uw.x) * (acc[m][n][1] + bias)); w.y = cvtpk(bflo(uw.y) * (acc[m][n][2] + bias), bfhi(uw.y) * (acc[m][n][3] + bias));
                *(u32x2*)(Abuf + (size_t)tok * 512 + c) = w;
            }
        }
    }
    __syncthreads();
}

__device__ __forceinline__ void phase_mixers(const Args& a, ldsp lds, int G, int vcu) {
    unsigned char* ws = a.ws;
    const bf16* Z = (const bf16*)(ws + WS_Z);
    for (int it = vcu; it < 512; it += G) {
        const int qh = it & 1, hk = (it >> 1) & 1, nb = (it >> 2) & 63, b = it >> 8;
        attn_item(Z, (const bf16*)(ws + WS_KVC), a.in[I_SINK], (bf16*)(ws + WS_O), lds, b, nb, hk, qh);
    }
    for (int it = vcu; it < 256; it += G) {
        gmlp_item(Z, a.in[I_LNG], a.in[I_LNB], (const bf16*)(ws + WS_WST), a.in[I_GBS], (bf16*)(ws + WS_A), lds, it >> 1, it & 1);
    }
}

#define KI_BEFORE(ka, ia, kb, ib) (((ka) > (kb)) || ((ka) == (kb) && (ia) < (ib)))
#define KI_CAS(K, I, p, q) do { const bool sw_ = KI_BEFORE(K[q], I[q], K[p], I[p]); const float kp_ = sw_ ? K[q] : K[p], kq_ = sw_ ? K[p] : K[q]; const int ip_ = sw_ ? I[q] : I[p], iq_ = sw_ ? I[p] : I[q]; \
        K[p] = kp_; I[p] = ip_; K[q] = kq_; I[q] = iq_; } while (0)
#define KI_SORT8(K, I) do { KI_CAS(K, I, 0, 1); KI_CAS(K, I, 2, 3); KI_CAS(K, I, 4, 5); KI_CAS(K, I, 6, 7); \
        KI_CAS(K, I, 0, 2); KI_CAS(K, I, 1, 3); KI_CAS(K, I, 4, 6); KI_CAS(K, I, 5, 7); \
        KI_CAS(K, I, 1, 2); KI_CAS(K, I, 5, 6); KI_CAS(K, I, 0, 4); KI_CAS(K, I, 3, 7); \
        KI_CAS(K, I, 1, 5); KI_CAS(K, I, 2, 6); KI_CAS(K, I, 1, 4); KI_CAS(K, I, 3, 6); \
        KI_CAS(K, I, 2, 4); KI_CAS(K, I, 3, 5); KI_CAS(K, I, 3, 4); } while (0)
#define KI_MERGE8(KA, IA, KB, IB) do { \
        _Pragma("unroll") for (int r_ = 0; r_ < 8; ++r_) { const bool tb_ = KI_BEFORE(KB[7 - r_], IB[7 - r_], KA[r_], IA[r_]); KA[r_] = tb_ ? KB[7 - r_] : KA[r_]; IA[r_] = tb_ ? IB[7 - r_] : IA[r_]; } \
        KI_CAS(KA, IA, 0, 4); KI_CAS(KA, IA, 1, 5); KI_CAS(KA, IA, 2, 6); KI_CAS(KA, IA, 3, 7); \
        KI_CAS(KA, IA, 0, 2); KI_CAS(KA, IA, 1, 3); KI_CAS(KA, IA, 4, 6); KI_CAS(KA, IA, 5, 7); \
        KI_CAS(KA, IA, 0, 1); KI_CAS(KA, IA, 2, 3); KI_CAS(KA, IA, 4, 5); KI_CAS(KA, IA, 6, 7); } while (0)
__device__ __forceinline__ void router_item(const Args& a, ldsp lds, int it) {
    const int tid = threadIdx.x, lane = tid & 63, wave = __builtin_amdgcn_readfirstlane(tid >> 6), fr = lane & 15, fq = lane >> 4;
    unsigned char* ws = a.ws;
    const int t0 = it * 64, b = t0 >> 13;
    const bf16* X1 = (const bf16*)(ws + WS_X1); const float* adaf = (const float*)(ws + WS_ADAF) + b * 6144;
    const float* g2 = a.in[I_N2G]; unsigned char* H2 = ws + WS_H2;
    {
        f32x4 gm[2][2], sh[2][2];
#pragma unroll
        for (int j = 0; j < 2; ++j)
#pragma unroll
            for (int h = 0; h < 2; ++h) {
                const int c = 8 * lane + 512 * j + 4 * h;
                const f32x4 gg = *(const f32x4*)(g2 + c), sc = *(const f32x4*)(adaf + 4 * 1024 + c);
                gm[j][h] = gg * (sc + 1.f); sh[j][h] = *(const f32x4*)(adaf + 3 * 1024 + c);
            }
#pragma unroll
        for (int half = 0; half < 2; ++half) {
            f32x4 x[4][2][2];
#pragma unroll
            for (int tt = 0; tt < 4; ++tt)
#pragma unroll
                for (int j = 0; j < 2; ++j) {
                    const u32x4 w = *(const u32x4*)(X1 + (size_t)(t0 + wave * 8 + half * 4 + tt) * D + 8 * lane + 512 * j);
                    x[tt][j][0] = (f32x4){bflo(w.x), bfhi(w.x), bflo(w.y), bfhi(w.y)}; x[tt][j][1] = (f32x4){bflo(w.z), bfhi(w.z), bflo(w.w), bfhi(w.w)};
                }
#pragma unroll
            for (int tt = 0; tt < 4; ++tt) {
                const int row = wave * 8 + half * 4 + tt, tok = t0 + row;
                float ss = 0.f;
#pragma unroll
                for (int j = 0; j < 2; ++j)
#pragma unroll
                    for (int h = 0; h < 2; ++h) { const f32x4 v = x[tt][j][h]; ss += (v[0] * v[0] + v[1] * v[1]) + (v[2] * v[2] + v[3] * v[3]); }
                const float r = rsqrtf(wave_sum(ss) * (1.f / D) + 1e-6f);
#pragma unroll
                for (int j = 0; j < 2; ++j) {
                    const f32x4 h0 = (x[tt][j][0] * r) * gm[j][0] + sh[j][0], h1 = (x[tt][j][1] * r) * gm[j][1] + sh[j][1];
                    u32x4 w; w.x = cvtpk(h0[0], h0[1]); w.y = cvtpk(h0[2], h0[3]); w.z = cvtpk(h1[0], h1[1]); w.w = cvtpk(h1[2], h1[3]);
                    { int f0 = 0, f1 = 0;
                      f0 = __builtin_amdgcn_cvt_pk_fp8_f32(h0[0], h0[1], f0, false); f0 = __builtin_amdgcn_cvt_pk_fp8_f32(h0[2], h0[3], f0, true);
                      f1 = __builtin_amdgcn_cvt_pk_fp8_f32(h1[0], h1[1], f1, false); f1 = __builtin_amdgcn_cvt_pk_fp8_f32(h1[2], h1[3], f1, true);
                      u32x2 w8; w8.x = (unsigned)f0; w8.y = (unsigned)f1; *(u32x2*)(H2 + (size_t)tok * D + 8 * lane + 512 * j) = w8; }
                    const int kc = lane + 64 * j;
                    *(LAS u32x4*)(lds + kc * 1024 + ((row ^ (kc & 7)) * 16)) = w;
                }
            }
        }
    }
    __syncthreads();
    f32x4 acc[4][2];
#pragma unroll
    for (int m = 0; m < 4; ++m)
#pragma unroll
        for (int n = 0; n < 2; ++n) acc[m][n] = (f32x4){0.f, 0.f, 0.f, 0.f};
    const bf16* RwT = (const bf16*)(ws + WS_RWT) + (size_t)(32 * wave + fr) * D + 8 * fq;
#pragma unroll 8
    for (int ks = 0; ks < 32; ++ks) {
        const int kc = 4 * ks + fq;
        bf16x8 af[4], bfr[2];
#pragma unroll
        for (int n = 0; n < 2; ++n) bfr[n] = *(const bf16x8*)(RwT + (size_t)(16 * n) * D + 32 * ks);
#pragma unroll
        for (int m = 0; m < 4; ++m) af[m] = *(LAS const bf16x8*)(lds + kc * 1024 + (((16 * m + fr) ^ (kc & 7)) * 16));
#pragma unroll
        for (int m = 0; m < 4; ++m)
#pragma unroll
            for (int n = 0; n < 2; ++n) acc[m][n] = mfma16(af[m], bfr[n], acc[m][n]);
    }
    __syncthreads();
    LAS float* LG = (LAS float*)lds;
#pragma unroll
    for (int m = 0; m < 4; ++m)
#pragma unroll
        for (int n = 0; n < 2; ++n)
#pragma unroll
            for (int reg = 0; reg < 4; ++reg) LG[(32 * wave + 16 * n + fr) * 65 + 16 * m + 4 * fq + reg] = acc[m][n][reg];
    __syncthreads();
    LAS float* CK = (LAS float*)(lds + 69632); LAS int* CI = (LAS int*)(lds + 69632 + 16384);
    const float* rb = a.in[I_RB];
    float bk[8]; int bi[8];
#pragma unroll
    for (int q = 0; q < 4; ++q) {
        float gk[8]; int gi[8];
#pragma unroll
        for (int j = 0; j < 8; ++j) { const int e = 32 * wave + 8 * q + j; gk[j] = sigmoid_f(LG[e * 65 + lane]) + rb[e]; gi[j] = e; }
        KI_SORT8(gk, gi);
        if (q == 0) {
#pragma unroll
            for (int j = 0; j < 8; ++j) { bk[j] = gk[j]; bi[j] = gi[j]; }
        } else KI_MERGE8(bk, bi, gk, gi);
    }
#pragma unroll
    for (int r = 0; r < 8; ++r) { CK[(wave * 8 + r) * 64 + lane] = bk[r]; CI[(wave * 8 + r) * 64 + lane] = bi[r]; }
    __syncthreads();
#define RT_LEVEL(lvl) do { if ((wave & (2 * (lvl) - 1)) == 0) { float ok_[8]; int oi_[8]; \
            _Pragma("unroll") for (int r = 0; r < 8; ++r) { ok_[r] = CK[((wave + (lvl)) * 8 + r) * 64 + lane]; oi_[r] = CI[((wave + (lvl)) * 8 + r) * 64 + lane]; } \
            KI_MERGE8(bk, bi, ok_, oi_); \
            if ((lvl) < 4) { _Pragma("unroll") for (int r = 0; r < 8; ++r) { CK[(wave * 8 + r) * 64 + lane] = bk[r]; CI[(wave * 8 + r) * 64 + lane] = bi[r]; } } } \
        __syncthreads(); } while (0)
    RT_LEVEL(1); RT_LEVEL(2); RT_LEVEL(4);
#undef RT_LEVEL
    LAS unsigned* hist = (LAS unsigned*)(lds + 102400); LAS unsigned* hbase = hist + 256;
    if (tid < 256) hist[tid] = 0u;
    __syncthreads();
    unsigned* cnt = (unsigned*)(ws + WS_CTL) + CW_CNT; int* list = (int*)(ws + WS_LIST); float* gatew = (float*)(ws + WS_GATEW);
    unsigned rank[8];
    if (wave == 0) {
        const int tok = t0 + lane;
        float sel[8], ssum = 0.f;
#pragma unroll
        for (int r = 0; r < 8; ++r) { sel[r] = sigmoid_f(LG[bi[r] * 65 + lane]); ssum += sel[r]; }
#pragma unroll
        for (int r = 0; r < 8; ++r) rank[r] = __hip_atomic_fetch_add(&hist[bi[r]], 1u, __ATOMIC_RELAXED, __HIP_MEMORY_SCOPE_WORKGROUP);
        const float sc = 2.5f / ssum;
        f32x4 g0 = {sel[0] * sc, sel[1] * sc, sel[2] * sc, sel[3] * sc}, g1 = {sel[4] * sc, sel[5] * sc, sel[6] * sc, sel[7] * sc};
        *(f32x4*)(gatew + tok * 8) = g0; *(f32x4*)(gatew + tok * 8 + 4) = g1;
    }
    __syncthreads();
    if (tid < 256) { const unsigned h = hist[tid]; if (h) hbase[tid] = atomicAdd(cnt + 32 * tid, h); }
    __syncthreads();
    if (wave == 0) {
        const int tok = t0 + lane;
#pragma unroll
        for (int r = 0; r < 8; ++r) list[(size_t)bi[r] * LISTCAP + hbase[bi[r]] + rank[r]] = tok * NSLOT + r;
    }
    __syncthreads();
}

__device__ __forceinline__ void moe_tile(const Args& a, ldsp lds, int e, int mt, int nrows, int ntl) {
    const int tid = threadIdx.x, lane = tid & 63, wave = __builtin_amdgcn_readfirstlane(tid >> 6), fr = lane & 15, fq = lane >> 4;
    unsigned char* ws = a.ws;
    constexpr int ASTG = 0, BSTG = 16384, ACT = 49152, SLOTS = 114688, GWO = 115200;
    const bf16* H2 = (const bf16*)(ws + WS_H2);
    const float* Wg = (e < NEXP) ? a.in[I_EG] + (size_t)e * 262144 : a.in[I_SG];
    const float* Wu = (e < NEXP) ? a.in[I_EU] + (size_t)e * 262144 : a.in[I_SU];
    const float* Wd = (e < NEXP) ? a.in[I_ED] + (size_t)e * 262144 : a.in[I_SD];
    if (tid < 128) {
        int slot = -1; float gw = 0.f;
        if (tid < nrows) {
            if (e < NEXP) { slot = ((const int*)(ws + WS_LIST))[(size_t)e * LISTCAP + mt * 128 + tid]; gw = ((const float*)(ws + WS_GATEW))[(slot / NSLOT) * 8 + (slot % NSLOT)]; }
            else { slot = (mt * 128 + tid) * NSLOT + 8; gw = 1.f; }
        }
        ((LAS int*)(lds + SLOTS))[tid] = slot; ((LAS float*)(lds + GWO))[tid] = gw;
    }
    __syncthreads();
    const int wr = wave >> 2, wc = wave & 3;
    const int arow = tid >> 2, akc = tid & 3;
    const int aslot = ((LAS const int*)(lds + SLOTS))[arow];
    const bf16* asrc = H2 + (size_t)((aslot < 0 ? 0 : aslot) / NSLOT) * D + akc * 8;
    const int awr = ASTG + akc * 2048 + ((arow ^ (akc << 1)) * 16);
    const int ng = lane, kq = wave;
    const float* srcg = Wg + (size_t)(4 * kq) * 256 + 4 * ng;
    const float* srcu = Wu + (size_t)(4 * kq) * 256 + 4 * ng;
    const float* src2 = Wd + (size_t)(4 * kq) * 1024 + 4 * ng;
    int bwr2[4];
#pragma unroll
    for (int i = 0; i < 4; ++i) { const int rho2 = 4 * ng + i; bwr2[i] = BSTG + (kq >> 1) * 4096 + ((rho2 ^ ((rho2 >> 3) & 3)) * 16) + (kq & 1) * 8; }
    int ard[4], brd[4], rowm[4];
#pragma unroll
    for (int m = 0; m < 4; ++m) { rowm[m] = 64 * wr + 16 * m + fr; ard[m] = fq * 2048 + ((rowm[m] ^ (fq << 1)) * 16); }
#pragma unroll
    for (int n = 0; n < 4; ++n) { const int rho = 64 * wc + 16 * n + fr; brd[n] = BSTG + fq * 4096 + ((rho ^ ((rho >> 3) & 3)) * 16); }
    bf16* contrib = (bf16*)(ws + WS_CONTRIB);
    f32x4 acc[4][4];
    f32x4 B0[4], B1[4], B2[4], B3[4]; u32x4 A0, A1, A2, A3;
#define G1_LOAD(s_, BR, AR) do { const int s0_ = (s_); const int ss_ = s0_ < 63 ? s0_ : 63; \
        const float* bp_ = ((ss_ < 32) ? srcg : srcu) + (size_t)(32 * (ss_ & 31)) * 256; \
        AR = *(const u32x4*)(asrc + 32 * (ss_ & 31)); \
        _Pragma("unroll") for (int j = 0; j < 4; ++j) BR[j] = *(const f32x4*)(bp_ + j * 256); } while (0)
#define G1_WRITE(BR, AR, buf_) do { \
        *(LAS u32x4*)(lds + (buf_) * 8192 + awr) = AR; \
        _Pragma("unroll") for (int i = 0; i < 4; ++i) { u32x2 w_; w_.x = cvtpk(BR[0][i], BR[1][i]); w_.y = cvtpk(BR[2][i], BR[3][i]); *(LAS u32x2*)(lds + (buf_) * 16384 + bwr2[i]) = w_; } } while (0)
#define MOE_COMPUTE(abase_, buf_) do { \
        bf16x8 af_[4], bf_[4]; \
        _Pragma("unroll") for (int m = 0; m < 4; ++m) af_[m] = *(LAS const bf16x8*)(lds + (abase_) + ard[m]); \
        _Pragma("unroll") for (int n = 0; n < 4; ++n) bf_[n] = *(LAS const bf16x8*)(lds + (buf_) * 16384 + brd[n]); \
        _Pragma("unroll") for (int m = 0; m < 4; ++m) _Pragma("unroll") for (int n = 0; n < 4; ++n) acc[m][n] = mfma16(bf_[n], af_[m], acc[m][n]); } while (0)
#define ACC_ZERO() do { _Pragma("unroll") for (int m = 0; m < 4; ++m) _Pragma("unroll") for (int n = 0; n < 4; ++n) acc[m][n] = (f32x4){0.f, 0.f, 0.f, 0.f}; } while (0)
    G1_LOAD(0, B0, A0); G1_LOAD(1, B1, A1); G1_LOAD(2, B2, A2);
    G1_WRITE(B0, A0, 0);
    __syncthreads();
    for (int s = 0; s < 64; s += 4) {
        if ((s & 31) == 0) ACC_ZERO();
        G1_LOAD(s + 3, B3, A3); MOE_COMPUTE(0, 0); G1_WRITE(B1, A1, 1); __syncthreads();
        G1_LOAD(s + 4, B0, A0); MOE_COMPUTE(8192, 1); G1_WRITE(B2, A2, 0); __syncthreads();
        G1_LOAD(s + 5, B1, A1); MOE_COMPUTE(0, 0); G1_WRITE(B3, A3, 1); __syncthreads();
        G1_LOAD(s + 6, B2, A2); MOE_COMPUTE(8192, 1);
        if (s == 28) {
#pragma unroll
            for (int m = 0; m < 4; ++m)
#pragma unroll
                for (int n = 0; n < 4; ++n) {
                    const f32x4 gv = acc[m][n];
                    u32x2 w; w.x = cvtpk(silu_f(gv[0]), silu_f(gv[1])); w.y = cvtpk(silu_f(gv[2]), silu_f(gv[3]));
                    const int kc = 8 * wc + 2 * n + (fq >> 1);
                    *(LAS u32x2*)(lds + ACT + kc * 2048 + ((rowm[m] ^ ((kc & 3) << 1)) * 16) + (fq & 1) * 8) = w;
                }
        } else if (s == 60) {
#pragma unroll
            for (int m = 0; m < 4; ++m)
#pragma unroll
                for (int n = 0; n < 4; ++n) {
                    const f32x4 uv = acc[m][n];
                    const int kc = 8 * wc + 2 * n + (fq >> 1);
                    LAS u32x2* ap = (LAS u32x2*)(lds + ACT + kc * 2048 + ((rowm[m] ^ ((kc & 3) << 1)) * 16) + (fq & 1) * 8);
                    const u32x2 g = *ap;
                    u32x2 w; w.x = cvtpk(bflo(g.x) * uv[0], bfhi(g.x) * uv[1]); w.y = cvtpk(bflo(g.y) * uv[2], bfhi(g.y) * uv[3]);
                    *ap = w;
                }
        }
        G1_WRITE(B0, A0, 0); __syncthreads();
    }
#define G2_LOAD(s_, BR) do { const int s0_ = (s_); const int t_ = s0_ < 31 ? s0_ : 31; \
        const float* bp_ = src2 + (size_t)(32 * (t_ & 7)) * 1024 + 256 * (t_ >> 3); \
        _Pragma("unroll") for (int j = 0; j < 4; ++j) BR[j] = *(const f32x4*)(bp_ + j * 1024); } while (0)
#define G2_WRITE(BR, buf_) do { \
        _Pragma("unroll") for (int i = 0; i < 4; ++i) { u32x2 w_; w_.x = cvtpk(BR[0][i], BR[1][i]); w_.y = cvtpk(BR[2][i], BR[3][i]); *(LAS u32x2*)(lds + (buf_) * 16384 + bwr2[i]) = w_; } } while (0)
    G2_LOAD(0, B0); G2_LOAD(1, B1); G2_LOAD(2, B2);
    G2_WRITE(B0, 0);
    __syncthreads();
    for (int s = 0; s < 32; s += 4) {
        if ((s & 7) == 0) ACC_ZERO();
        G2_LOAD(s + 3, B3); MOE_COMPUTE(ACT + (s & 7) * 8192, 0); G2_WRITE(B1, 1); __syncthreads();
        G2_LOAD(s + 4, B0); MOE_COMPUTE(ACT + ((s + 1) & 7) * 8192, 1); G2_WRITE(B2, 0); __syncthreads();
        G2_LOAD(s + 5, B1); MOE_COMPUTE(ACT + ((s + 2) & 7) * 8192, 0); G2_WRITE(B3, 1); __syncthreads();
        G2_LOAD(s + 6, B2); MOE_COMPUTE(ACT + ((s + 3) & 7) * 8192, 1);
        if ((s & 7) == 4) {
            const int q = s >> 3;
#pragma unroll
            for (int m = 0; m < 4; ++m) {
                const int slot = ((LAS const int*)(lds + SLOTS))[rowm[m]]; const float gw = ((LAS const float*)(lds + GWO))[rowm[m]];
                if (slot >= 0) {
                    bf16* cp = contrib + (size_t)slot * D + q * 256 + 64 * wc + 4 * fq;
#pragma unroll
                    for (int n = 0; n < 4; ++n) { const f32x4 v = acc[m][n] * gw; u32x2 w; w.x = cvtpk(v[0], v[1]); w.y = cvtpk(v[2], v[3]); *(u32x2*)(cp + 16 * n) = w; }
                }
            }
        }
        G2_WRITE(B0, 0); __syncthreads();
    }
#undef G1_LOAD
#undef G1_WRITE
#undef G2_LOAD
#undef G2_WRITE
#undef ACC_ZERO
#undef MOE_COMPUTE
}

__device__ __forceinline__ void moe_decode(int j, int total, LAS const int* pre, LAS const int* cnt, int& e, int& mt, int& nrows) {
    if (j < total) {
        int lo = 0, hi = NEXP;
        while (hi - lo > 1) { const int mid = (lo + hi) >> 1; if (pre[mid] <= j) lo = mid; else hi = mid; }
        e = lo; mt = j - pre[e]; const int c = cnt[e] - mt * 128; nrows = c < 128 ? c : 128;
    } else { e = NEXP; mt = j - total; nrows = 128; }
}
__device__ __forceinline__ void phase_moe(const Args& a, ldsp lds, int G, int vcu) {
    const int tid = threadIdx.x, lane = tid & 63, wave = __builtin_amdgcn_readfirstlane(tid >> 6), fr = lane & 15, fq = lane >> 4;
    unsigned char* ws = a.ws;
    constexpr int ASTG = 0, BSTG = 16384, ACT = 49152, SLOTS = 114688, GWO = SLOTS + MOE_MAXT * 512;
    static_assert(GWO + MOE_MAXT * 512 <= SCR_BYTES, "slot lists overflow the scratch image");
    LAS int* pre = (LAS int*)(lds + MISC_OFF + 512);
    LAS int* cnt = (LAS int*)(lds + MISC_OFF + 2048);
    LAS int* wtot = (LAS int*)(lds + MISC_OFF + 3072);
    int myv = 0, myx = 0;
    if (tid < NEXP) {
        const int c = (int)((const unsigned*)(ws + WS_CTL) + CW_CNT)[32 * tid];
        cnt[tid] = c; myv = (c + 127) >> 7; myx = myv;
#pragma unroll
        for (int o = 1; o < 64; o <<= 1) { const int y = __shfl_up(myx, o); if (lane >= o) myx += y; }
        if (lane == 63) wtot[wave] = myx;
    }
    __syncthreads();
    if (tid < NEXP) { int base = 0; for (int w = 0; w < wave; ++w) base += wtot[w]; pre[tid] = base + myx - myv; if (tid == NEXP - 1) pre[NEXP] = base + myx; }
    __syncthreads();
    const int total = pre[NEXP], ntiles = total + T / 128;
    if (vcu >= ntiles) return;
    for (int tt = tid >> 7; vcu + tt * G < ntiles; tt += 4) {
        const int r = tid & 127; int e_, mt_, nr_; moe_decode(vcu + tt * G, total, pre, cnt, e_, mt_, nr_);
        int slot_ = -1; float gw_ = 0.f;
        if (r < nr_) { if (e_ < NEXP) { slot_ = ((const int*)(ws + WS_LIST))[(size_t)e_ * LISTCAP + mt_ * 128 + r]; gw_ = ((const float*)(ws + WS_GATEW))[(slot_ / NSLOT) * 8 + (slot_ % NSLOT)]; }
                       else { slot_ = (mt_ * 128 + r) * NSLOT + 8; gw_ = 1.f; } }
        ((LAS int*)(lds + SLOTS))[tt * 128 + r] = slot_; ((LAS float*)(lds + GWO))[tt * 128 + r] = gw_;
    }
    __syncthreads();
    if (wave >= 4) {
        const int lt = tid - 256;
        const unsigned char* H2 = ws + WS_H2;
        const int arow = lt >> 1, ahalf = lt & 1;
        const int awr0 = ASTG + (2 * ahalf) * 2048 + ((arow ^ ((2 * ahalf) << 1)) * 16), awr1 = ASTG + (2 * ahalf + 1) * 2048 + ((arow ^ ((2 * ahalf + 1) << 1)) * 16);
        const int ng = lt & 63, kq = lt >> 6;
        const int loff256 = (8 * kq) * 256 + 4 * ng, loff1024 = (8 * kq) * 1024 + 4 * ng;
        const int bw = BSTG + kq * 4096 + (4 * ng) * 16, bx = ((4 * ng) >> 3) & 3;
        f32x4 B0[8], B1[8], B2[8], B3[8]; u32x4 A0, A1, A2, A3, A4, A5, A6, A7;
        int j = vcu, it = 0, e, mt, nrows;
        moe_decode(j, total, pre, cnt, e, mt, nrows);
        const float* Wg = (e < NEXP) ? a.in[I_EG] + (size_t)e * 262144 : a.in[I_SG];
        const float* Wu = (e < NEXP) ? a.in[I_EU] + (size_t)e * 262144 : a.in[I_SU];
        const float* Wd = (e < NEXP) ? a.in[I_ED] + (size_t)e * 262144 : a.in[I_SD];
        int aslot = ((LAS const int*)(lds + SLOTS))[arow];
        const unsigned char* asrc = H2 + (size_t)((aslot < 0 ? 0 : aslot) / NSLOT) * D + 16 * ahalf;
#define L_LOADB1(WG_, WU_, WD_, s_, BR) do { const int ss_ = (s_); const int t_ = ss_ - 64; \
            const float* bp_ = (ss_ < 32) ? (WG_) + loff256 + (size_t)(32 * ss_) * 256 : (ss_ < 64) ? (WU_) + loff256 + (size_t)(32 * (ss_ - 32)) * 256 : (WD_) + loff1024 + (size_t)(32 * (t_ & 7)) * 1024 + 256 * (t_ >> 3); \
            const int str_ = (ss_ < 64) ? 256 : 1024;        \
            _Pragma("unroll") for (int jj = 0; jj < 8; ++jj) BR[jj] = *(const f32x4*)(bp_ + jj * str_); } while (0)
#define L_LOADA4(AP_, s_, R0, R1, R2, R3) do { const int ss_ = (s_); const int sa_ = ss_ < 60 ? ss_ : 60; const unsigned char* p_ = (AP_) + 32 * (sa_ & 31); \
            R0 = *(const u32x4*)(p_); R1 = *(const u32x4*)(p_ + 32); R2 = *(const u32x4*)(p_ + 64); R3 = *(const u32x4*)(p_ + 96); } while (0)
#define L_LOAD2(s_, BR) do { const int s0_ = (s_); const int t_ = s0_ < 31 ? s0_ : 31; \
            const float* bp_ = Wd + loff1024 + (size_t)(32 * (t_ & 7)) * 1024 + 256 * (t_ >> 3); \
            _Pragma("unroll") for (int jj = 0; jj < 8; ++jj) BR[jj] = *(const f32x4*)(bp_ + jj * 1024); } while (0)
#define L_WRITEB(BR, buf_) do { _Pragma("unroll") for (int i = 0; i < 4; ++i) { u32x4 w_; w_.x = cvtpk(BR[0][i], BR[1][i]); w_.y = cvtpk(BR[2][i], BR[3][i]); w_.z = cvtpk(BR[4][i], BR[5][i]); w_.w = cvtpk(BR[6][i], BR[7][i]); \
            *(LAS u32x4*)(lds + (buf_) * 16384 + bw + ((i ^ bx) * 16)) = w_; } } while (0)
#define L_CVT8(w_, o0, o1) do { const f32x2_t l_ = __builtin_amdgcn_cvt_pk_f32_fp8((int)(w_), false), h_ = __builtin_amdgcn_cvt_pk_f32_fp8((int)(w_), true); o0 = cvtpk(l_[0], l_[1]); o1 = cvtpk(h_[0], h_[1]); } while (0)
#define L_WRITEA(AR, buf_) do { u32x4 c0_, c1_; L_CVT8(AR.x, c0_.x, c0_.y); L_CVT8(AR.y, c0_.z, c0_.w); L_CVT8(AR.z, c1_.x, c1_.y); L_CVT8(AR.w, c1_.z, c1_.w); \
            *(LAS u32x4*)(lds + (buf_) * 8192 + awr0) = c0_; *(LAS u32x4*)(lds + (buf_) * 8192 + awr1) = c1_; } while (0)
        L_LOADA4(asrc, 0, A0, A1, A2, A3); L_LOADB1(Wg, Wu, Wd, 0, B0); L_LOADB1(Wg, Wu, Wd, 1, B1); L_LOADB1(Wg, Wu, Wd, 2, B2); L_LOADA4(asrc, 4, A4, A5, A6, A7);
        for (;;) {
            L_WRITEA(A0, 0); L_WRITEB(B0, 0);
            __syncthreads();
            for (int s = 0; s < 64; s += 8) {
                L_LOADB1(Wg, Wu, Wd, s + 3, B3); L_WRITEA(A1, 1); L_WRITEB(B1, 1); __syncthreads();
                L_LOADB1(Wg, Wu, Wd, s + 4, B0); L_WRITEA(A2, 0); L_WRITEB(B2, 0); __syncthreads();
                L_LOADB1(Wg, Wu, Wd, s + 5, B1); L_WRITEA(A3, 1); L_WRITEB(B3, 1); __syncthreads();
                L_LOADB1(Wg, Wu, Wd, s + 6, B2); L_LOADA4(asrc, s + 8, A0, A1, A2, A3); L_WRITEA(A4, 0); L_WRITEB(B0, 0); __syncthreads();
                L_LOADB1(Wg, Wu, Wd, s + 7, B3); L_WRITEA(A5, 1); L_WRITEB(B1, 1); __syncthreads();
                L_LOADB1(Wg, Wu, Wd, s + 8, B0); L_WRITEA(A6, 0); L_WRITEB(B2, 0); __syncthreads();
                L_LOADB1(Wg, Wu, Wd, s + 9, B1); L_WRITEA(A7, 1); L_WRITEB(B3, 1); __syncthreads();
                L_LOADB1(Wg, Wu, Wd, s + 10, B2); L_LOADA4(asrc, s + 12, A4, A5, A6, A7); L_WRITEA(A0, 0); L_WRITEB(B0, 0); __syncthreads();
            }
            for (int s = 0; s < 28; s += 4) {
                L_LOAD2(s + 3, B3); L_WRITEB(B1, 1); __syncthreads();
                L_LOAD2(s + 4, B0); L_WRITEB(B2, 0); __syncthreads();
                L_LOAD2(s + 5, B1); L_WRITEB(B3, 1); __syncthreads();
                L_LOAD2(s + 6, B2); L_WRITEB(B0, 0); __syncthreads();
            }
            const int jn = j + G; const bool more = jn < ntiles;
            int en = e, mtn = mt, nrn = nrows; if (more) moe_decode(jn, total, pre, cnt, en, mtn, nrn);
            const float* Wgn = (en < NEXP) ? a.in[I_EG] + (size_t)en * 262144 : a.in[I_SG];
            const float* Wun = (en < NEXP) ? a.in[I_EU] + (size_t)en * 262144 : a.in[I_SU];
            const float* Wdn = (en < NEXP) ? a.in[I_ED] + (size_t)en * 262144 : a.in[I_SD];
            const int aslotn = more ? ((LAS const int*)(lds + SLOTS))[(it + 1) * 128 + arow] : aslot;
            const unsigned char* asrcn = H2 + (size_t)((aslotn < 0 ? 0 : aslotn) / NSLOT) * D + 16 * ahalf;
            L_LOAD2(31, B3); L_WRITEB(B1, 1); __syncthreads();
            L_LOADB1(Wgn, Wun, Wdn, 0, B0); L_LOADA4(asrcn, 0, A0, A1, A2, A3); L_WRITEB(B2, 0); __syncthreads();
            L_LOADB1(Wgn, Wun, Wdn, 1, B1); L_WRITEB(B3, 1); __syncthreads();
            L_LOADB1(Wgn, Wun, Wdn, 2, B2); L_LOADA4(asrcn, 4, A4, A5, A6, A7); __syncthreads();
            if (!more) break;
            j = jn; ++it; e = en; mt = mtn; nrows = nrn; Wg = Wgn; Wu = Wun; Wd = Wdn; aslot = aslotn; asrc = asrcn;
        }
#undef L_LOADB1
#undef L_LOADA4
#undef L_CVT8
#undef L_LOAD2
#undef L_WRITEB
#undef L_WRITEA
    } else {
        const int wr = wave >> 1, wc = wave & 1;
        int rowm[4], ard[4], brd[8];
#pragma unroll
        for (int m = 0; m < 4; ++m) { rowm[m] = 64 * wr + 16 * m + fr; ard[m] = fq * 2048 + ((rowm[m] ^ (fq << 1)) * 16); }
#pragma unroll
        for (int n = 0; n < 8; ++n) { const int rho = 128 * wc + 16 * n + fr; brd[n] = BSTG + fq * 4096 + ((rho ^ ((rho >> 3) & 3)) * 16); }
        unsigned char* contrib = ws + WS_CONTRIB;
        f32x4 acc[4][8];
#define M_COMPUTE(abase_, buf_) do { \
            _Pragma("unroll") for (int nh = 0; nh < 2; ++nh) { bf16x8 af_[4], bf_[4]; \
                _Pragma("unroll") for (int m = 0; m < 4; ++m) af_[m] = *(LAS const bf16x8*)(lds + (abase_) + ard[m]); \
                _Pragma("unroll") for (int n = 0; n < 4; ++n) bf_[n] = *(LAS const bf16x8*)(lds + (buf_) * 16384 + brd[4 * nh + n]); \
                _Pragma("unroll") for (int m = 0; m < 4; ++m) _Pragma("unroll") for (int n = 0; n < 4; ++n) acc[m][4 * nh + n] = mfma16(bf_[n], af_[m], acc[m][4 * nh + n]); } } while (0)
#define M_ZERO() do { _Pragma("unroll") for (int m = 0; m < 4; ++m) _Pragma("unroll") for (int n = 0; n < 8; ++n) acc[m][n] = (f32x4){0.f, 0.f, 0.f, 0.f}; } while (0)
        int it = 0;
        for (int j = vcu; j < ntiles; j += G, ++it) {
            __syncthreads();
            for (int s = 0; s < 64; s += 4) {
                if ((s & 31) == 0) M_ZERO();
                M_COMPUTE(0, 0); __syncthreads();
                M_COMPUTE(8192, 1); __syncthreads();
                M_COMPUTE(0, 0); __syncthreads();
                M_COMPUTE(8192, 1);
                if (s == 28) {
#pragma unroll
                    for (int m = 0; m < 4; ++m)
#pragma unroll
                        for (int n = 0; n < 8; ++n) {
                            const f32x4 gv = acc[m][n];
                            u32x2 w; w.x = cvtpk(silu_f(gv[0]), silu_f(gv[1])); w.y = cvtpk(silu_f(gv[2]), silu_f(gv[3]));
                            const int kc = 16 * wc + 2 * n + (fq >> 1);
                            *(LAS u32x2*)(lds + ACT + kc * 2048 + ((rowm[m] ^ ((kc & 3) << 1)) * 16) + (fq & 1) * 8) = w;
                        }
                } else if (s == 60) {
#pragma unroll
                    for (int m = 0; m < 4; ++m)
#pragma unroll
                        for (int n = 0; n < 8; ++n) {
                            const f32x4 uv = acc[m][n];
                            const int kc = 16 * wc + 2 * n + (fq >> 1);
                            LAS u32x2* ap = (LAS u32x2*)(lds + ACT + kc * 2048 + ((rowm[m] ^ ((kc & 3) << 1)) * 16) + (fq & 1) * 8);
                            const u32x2 g = *ap;
                            u32x2 w; w.x = cvtpk(bflo(g.x) * uv[0], bfhi(g.x) * uv[1]); w.y = cvtpk(bflo(g.y) * uv[2], bfhi(g.y) * uv[3]);
                            *ap = w;
                        }
                }
                __syncthreads();
            }
            for (int s = 0; s < 32; s += 4) {
                if ((s & 7) == 0) M_ZERO();
                M_COMPUTE(ACT + (s & 7) * 8192, 0); __syncthreads();
                M_COMPUTE(ACT + ((s + 1) & 7) * 8192, 1); __syncthreads();
                M_COMPUTE(ACT + ((s + 2) & 7) * 8192, 0); __syncthreads();
                M_COMPUTE(ACT + ((s + 3) & 7) * 8192, 1);
                if ((s & 7) == 4) {
                    const int q = s >> 3;
#pragma unroll
                    for (int m = 0; m < 4; ++m) {
                        const int slot = ((LAS const int*)(lds + SLOTS))[it * 128 + rowm[m]]; const float gw = ((LAS const float*)(lds + GWO))[it * 128 + rowm[m]];
                        if (slot >= 0) {
                            unsigned char* cp = contrib + (size_t)slot * D + q * 256 + 128 * wc + 4 * fq;
                            const float gs = gw * CONTRIB_SCALE;
#pragma unroll
                            for (int n = 0; n < 8; ++n) { const f32x4 v = acc[m][n] * gs; int w = 0; w = __builtin_amdgcn_cvt_pk_fp8_f32(v[0], v[1], w, false); w = __builtin_amdgcn_cvt_pk_fp8_f32(v[2], v[3], w, true); *(int*)(cp + 16 * n) = w; }
                        }
                    }
                }
                __syncthreads();
            }
        }
#undef M_COMPUTE
#undef M_ZERO
    }
}

__device__ __forceinline__ void phase_combine(const Args& a, int G) {
    const int tid = threadIdx.x, lane = tid & 63, wave = __builtin_amdgcn_readfirstlane(tid >> 6), blk = blockIdx.x;
    unsigned char* ws = a.ws;
    const bf16* X1 = (const bf16*)(ws + WS_X1); const unsigned char* contrib = ws + WS_CONTRIB; const float* fg = a.in[I_FG];
    for (int t = blk * NWAVES + wave; t < T; t += G * NWAVES) {
        const float* g2 = (const float*)(ws + WS_ADAF) + (t >> 13) * 6144 + 5 * 1024;
        const int c = 16 * lane;
        float sm[16];
#pragma unroll
        for (int i = 0; i < 16; ++i) sm[i] = 0.f;
#pragma unroll
        for (int k = 0; k < NSLOT; ++k) {
            const u32x4 w = *(const u32x4*)(contrib + ((size_t)t * NSLOT + k) * D + c);
#pragma unroll
            for (int q = 0; q < 4; ++q) {
                const f32x2_t lo = __builtin_amdgcn_cvt_pk_f32_fp8((int)w[q], false), hi = __builtin_amdgcn_cvt_pk_f32_fp8((int)w[q], true);
                sm[4 * q] += lo[0]; sm[4 * q + 1] += lo[1]; sm[4 * q + 2] += hi[0]; sm[4 * q + 3] += hi[1];
            }
        }
        const u32x4 xa = *(const u32x4*)(X1 + (size_t)t * D + c), xb = *(const u32x4*)(X1 + (size_t)t * D + c + 8);
        const float x1[16] = {bflo(xa.x), bfhi(xa.x), bflo(xa.y), bfhi(xa.y), bflo(xa.z), bfhi(xa.z), bflo(xa.w), bfhi(xa.w), bflo(xb.x), bfhi(xb.x), bflo(xb.y), bfhi(xb.y), bflo(xb.z), bfhi(xb.z), bflo(xb.w), bfhi(xb.w)};
        f32x4 xv[4]; float ss = 0.f;
#pragma unroll
        for (int h = 0; h < 4; ++h) {
            const f32x4 gg = *(const f32x4*)(g2 + c + 4 * h);
            const f32x4 xx = {x1[4 * h], x1[4 * h + 1], x1[4 * h + 2], x1[4 * h + 3]};
            const f32x4 mv = {sm[4 * h], sm[4 * h + 1], sm[4 * h + 2], sm[4 * h + 3]};
            const f32x4 v = xx + gg * (mv * (1.f / CONTRIB_SCALE)); xv[h] = v; ss += (v[0] * v[0] + v[1] * v[1]) + (v[2] * v[2] + v[3] * v[3]);
        }
        const float r = rsqrtf(wave_sum(ss) * (1.f / D) + 1e-6f);
#pragma unroll
        for (int h = 0; h < 4; ++h) *(f32x4*)(a.out + (size_t)t * D + c + 4 * h) = (xv[h] * r) * *(const f32x4*)(fg + c + 4 * h);
    }
}

constexpr int NPH = 9;
#ifndef N_LAUNCHES
#define N_LAUNCHES 1
#endif
__global__ void __launch_bounds__(NWAVES * 64, 2) mega(Args a) {
    extern __shared__ __attribute__((aligned(16))) unsigned char lds_raw[];
    ldsp lds = (ldsp)lds_raw;
    const int tid = threadIdx.x, G = gridDim.x, bx = blockIdx.x;
    int vcu = (G % 8 == 0) ? (bx % 8) * (G / 8) + bx / 8 : bx;
    unsigned char* ws = a.ws;
    for (int u = tid; u < (LDS_BYTES - MISC_OFF) / 4; u += NWAVES * 64) ((LAS unsigned*)(lds + MISC_OFF))[u] = 0u;
    __syncthreads();
    volatile LAS unsigned* MISC = (volatile LAS unsigned*)(lds + MISC_OFF);
    XcdBarrier bar; bar.bar = (unsigned*)(ws + WS_CTL) + CW_BAR; bar.x = 0; bar.st = nullptr;
    if (N_LAUNCHES == 1) {
        bar = xcd_barrier_post((unsigned*)(ws + WS_CTL) + CW_BAR, MISC + 8);
        if (tid == 0) MISC[16] = atomicAdd((unsigned*)(ws + WS_CTL) + CW_XRANK + 64 * bar.x, 1u);
    }
    const int lo = a.ph_lo, hi = a.ph_hi;
#ifndef PH_MASK
#define PH_MASK 0x1ff
#endif
#define IN(k) (((PH_MASK >> (k)) & 1) && lo <= (k) && (k) < hi)
#define SEAM(k) do { if (IN(k) && IN((k) + 1)) xcd_barrier(bar); } while (0)
#ifndef PH_DUP
#define PH_DUP -1
#endif
#define REP(k) for (int rep_ = 0; rep_ < ((PH_DUP == (k)) ? 2 : 1); ++rep_)
    if (IN(0)) REP(0) { phase_prep(a, lds, G); } SEAM(0);
    if (N_LAUNCHES == 1 && IN(0) && IN(1)) {
        unsigned basex = 0;
        for (unsigned j = 0; j < bar.x; ++j) basex += xb_ld(&bar.bar[XB_XCNT(j)]);
        vcu = (int)(basex + MISC[16]);
    }
    if (IN(1)) REP(1) { phase_hnorm(a, lds, G); } SEAM(1);
    if (IN(2)) REP(2) {
        pg8::Gemm g{(const pg8::bf16_t*)(ws + WS_H), (const pg8::bf16_t*)(ws + WS_WINT), MH, DIN, D};
        WinOrder S; S.init(G, bx);
        EpiWin E{(bf16*)(ws + WS_Z), (bf16*)(ws + WS_KVC), (const float*)(ws + WS_ROPE)};
        pg8::gemm_phase<EpiWin, WinOrder, true, true>(lds, g, S, E);
    } SEAM(2);
    if (IN(3)) REP(3) { phase_mixers(a, lds, G, vcu); } SEAM(3);
    if (IN(4)) REP(4) {
        { pg8::Gemm g{(const pg8::bf16_t*)(ws + WS_A), (const pg8::bf16_t*)(ws + WS_WAT), T, D, 512};
          pg8::StaticOrder S; S.init(T, D, G, bx);
          EpiMergeA E{(const bf16*)(ws + WS_Z), (bf16*)(ws + WS_Y)};
          pg8::gemm_phase<EpiMergeA, pg8::StaticOrder, true, true>(lds, g, S, E); }
        { pg8::Gemm g{(const pg8::bf16_t*)(ws + WS_O), (const pg8::bf16_t*)(ws + WS_WBT), T, D, 512};
          pg8::StaticOrder S; S.init(T, D, G, bx);
          EpiMergeB E{(const bf16*)(ws + WS_Z), (bf16*)(ws + WS_Y)};
          pg8::gemm_phase<EpiMergeB, pg8::StaticOrder, true, true>(lds, g, S, E); }
    } SEAM(4);
    if (IN(5)) REP(5) {
        pg8::Gemm g{(const pg8::bf16_t*)(ws + WS_Y), (const pg8::bf16_t*)(ws + WS_WOT), T, D, D};
        pg8::StaticOrder S; S.init(T, D, G, bx);
        EpiWo E{a.in[I_X], (const float*)(ws + WS_ADAF), (bf16*)(ws + WS_X1)};
        pg8::gemm_phase<EpiWo, pg8::StaticOrder, true, true>(lds, g, S, E);
    } SEAM(5);
    if (IN(6)) { for (int it = vcu; it < T / 64; it += G) router_item(a, lds, it); } SEAM(6);
    if (IN(7)) REP(7) { phase_moe(a, lds, G, vcu); } SEAM(7);
    if (IN(8)) REP(8) { phase_combine(a, G); }
#undef IN
#undef SEAM
}

extern "C" void kernel_launch(void* const* d_in, const int* in_sizes, int n_in, void* d_out, int out_size, void* d_ws, size_t ws_size, hipStream_t stream) {
    static int grid = 0;
    if (grid == 0) {
        if (n_in != 26 || out_size != T * D || ws_size < WS_END) { fprintf(stderr, "kernel_launch: unexpected shapes (n_in %d, out %d, ws %zu)\n", n_in, out_size, ws_size); grid = -1; return; }
        int dev = 0, cus = 0, per_cu = 0;
        (void)hipGetDevice(&dev); (void)hipDeviceGetAttribute(&cus, hipDeviceAttributeMultiprocessorCount, dev);
        (void)hipFuncSetAttribute((const void*)mega, hipFuncAttributeMaxDynamicSharedMemorySize, LDS_BYTES);
        (void)hipOccupancyMaxActiveBlocksPerMultiprocessor(&per_cu, (const void*)mega, NWAVES * 64, LDS_BYTES);
        (void)hipGetLastError();
        if (per_cu < 1) { fprintf(stderr, "kernel_launch: occupancy query says %d blocks per CU\n", per_cu); per_cu = 1; }
        if (cus * MOE_MAXT < T * 8 / 128 + NEXP + T / 128) { fprintf(stderr, "kernel_launch: %d CUs are too few for the expert tile tables\n", cus); grid = -1; return; }
        grid = cus;
    }
    if (grid < 0) return;
    (void)hipMemsetAsync((char*)d_ws + WS_CTL, 0, CTL_ZERO_BYTES, stream);
    Args a{};
    for (int i = 0; i < 26; ++i) a.in[i] = (const float*)d_in[i];
    a.out = (float*)d_out; a.ws = (unsigned char*)d_ws;
    if (N_LAUNCHES == 1) {
        a.ph_lo = 0; a.ph_hi = NPH;
        void* kargs[] = {&a};
        hipError_t e = hipLaunchCooperativeKernel((const void*)mega, dim3(grid), dim3(NWAVES * 64), kargs, LDS_BYTES, stream);
        if (e != hipSuccess) fprintf(stderr, "kernel_launch: cooperative launch failed: %s (grid %d)\n", hipGetErrorString(e), grid);
    } else {
#ifndef HOST_DUP
#define HOST_DUP -1
#endif
        for (int li = 0; li < NPH; ++li) {
            a.ph_lo = li; a.ph_hi = li + 1;
            hipLaunchKernelGGL(mega, dim3(grid), dim3(NWAVES * 64), LDS_BYTES, stream, a);
            if (li == HOST_DUP) {
                if (li == 6) (void)hipMemsetAsync((char*)d_ws + WS_CTL, 0, CTL_ZERO_BYTES, stream);
                hipLaunchKernelGGL(mega, dim3(grid), dim3(NWAVES * 64), LDS_BYTES, stream, a);
            }
        }
    }
}
```

```cpp
#include <hip/hip_runtime.h>
#include <cstdio>
#include <cstdint>
#include <type_traits>
namespace pg8 {
#define PG8_LAS __attribute__((address_space(3)))
typedef unsigned short bf16_t;
typedef short bf16x8 __attribute__((ext_vector_type(8)));
typedef float f32x4 __attribute__((ext_vector_type(4)));
typedef unsigned u32x4 __attribute__((ext_vector_type(4)));
constexpr int BM = 256, BK = 64, HALF = 128, HTB = HALF * BK * 2  , STAGE_BYTES = 8 * HTB, NXCD = 8, WGM = 8;

__host__ __device__ __forceinline__ int lds_byte(int r, int c) { const int st = (r >> 4) * 2 + (c >> 5), rr = r & 15, cc = c & 31, ob = rr * 64 + cc * 2; return st * 1024 + (ob ^ (((ob >> 9) & 1) << 5)); }
__host__ __device__ __forceinline__ void stage_rc(int b, int& R, int& C) { const int st = b / 1024, sb = b % 1024, swz = sb ^ (((sb >> 9) & 1) << 5); R = (st >> 1) * 16 + swz / 64; C = (st & 1) * 32 + (swz % 64) / 2; }
__host__ __device__ __forceinline__ int perm32(int rho) { const int n = rho >> 4, i = rho & 15; return 8 * (i >> 2) + 4 * n + (i & 3); }

struct Unit { int pm, pn; };
struct Gemm { const bf16_t* A; const bf16_t* Bt; int M, N, K; };

struct StaticOrder {
    int nM, nN, nwg, G, c;
    __host__ __device__ void init(int M, int N, int G_, int c_) { nM = M / BM; nN = N / BM; nwg = nM * nN; G = G_; c = c_; }
    __host__ __device__ bool next(int i, Unit& u) const {
        const long L = (long)i * G + c; if (L >= nwg) return false;
        int wgid = (int)L; { const int q = nwg / NXCD, r = nwg % NXCD, xcd = wgid % NXCD, off = wgid / NXCD; wgid = (xcd < r ? xcd * (q + 1) : r * (q + 1) + (xcd - r) * q) + off; }
        const int nig = WGM * nN, gid = wgid / nig, fm = gid * WGM, gsz = (nM - fm) < WGM ? (nM - fm) : WGM;
        u.pm = fm + ((wgid % nig) % gsz); u.pn = (wgid % nig) / gsz; return true;
    }
    __device__ __forceinline__ void a_ready(const Unit&) const {}
    __device__ __forceinline__ void done(const Unit&) const {}
};

__device__ __forceinline__ unsigned cvt_pk_bf16(float lo, float hi) { unsigned r; asm volatile("v_cvt_pk_bf16_f32 %0, %1, %2" : "=v"(r) : "v"(lo), "v"(hi)); return r; }
template <class Epi, class Sched, bool ALIGN_EPI = false, bool SP2 = false>
__device__ __forceinline__ void gemm_phase(PG8_LAS unsigned char* lds, const Gemm g, const Sched& S, const Epi& E) {
    const int tid = threadIdx.x, wid = __builtin_amdgcn_readfirstlane(tid >> 6), lane = tid & 63, wr = wid >> 2, wc = wid & 3, fr = lane & 15, fq = lane >> 4;
    const int K = g.K, nt = K / BK;
    unsigned voffA[2], voffB[2];
#pragma unroll
    for (int i = 0; i < 2; ++i) { int R, C; stage_rc(tid * 16 + i * 8192, R, C); const int Rb = Epi::PERM ? ((R & ~31) + perm32(R & 31)) : R;
        voffA[i] = (unsigned)(R * K + C) * 2u; voffB[i] = (unsigned)(Rb * K + C) * 2u; }
    const size_t kstep = (size_t)(BK * 2);
    const size_t hstep = (size_t)HALF * K * 2;
    const size_t tstep = 2 * hstep;
    const unsigned ldsw = (unsigned)wid * 1024u;
    const int aoff = lds_byte(wr * 64 + fr, fq * 8), boff = lds_byte(wc * 32 + fr, fq * 8);
#define PG8_SA(b, h) (((b) * 2 + (h)) * HTB)
#define PG8_SB(b, h) ((4 + (b) * 2 + (h)) * HTB)
#define PG8_STAGE(bufoff, gbase, voff) do { _Pragma("unroll") for (int _i = 0; _i < 2; ++_i) \
        __builtin_amdgcn_global_load_lds((const unsigned*)((const char*)(gbase) + (voff)[_i]), (PG8_LAS unsigned*)(lds + (bufoff) + ldsw + _i * 8192), 16, 0, 0); } while (0)
#define PG8_LDA(dst, b, h) do { _Pragma("unroll") for (int m = 0; m < 4; ++m) _Pragma("unroll") for (int k = 0; k < 2; ++k) dst[m][k] = *(const PG8_LAS bf16x8*)(lds + PG8_SA(b, h) + aoff + m * 2048 + k * 1024); } while (0)
#define PG8_LDB(dst, b, h) do { _Pragma("unroll") for (int n = 0; n < 2; ++n) _Pragma("unroll") for (int k = 0; k < 2; ++k) dst[n][k] = *(const PG8_LAS bf16x8*)(lds + PG8_SB(b, h) + boff + n * 2048 + k * 1024); } while (0)
#define PG8_MMA(ai, bj, At, Bt) do { __builtin_amdgcn_s_setprio(1); _Pragma("unroll") for (int m = 0; m < 4; ++m) _Pragma("unroll") for (int n = 0; n < 2; ++n) _Pragma("unroll") for (int k = 0; k < 2; ++k) \
        acc[ai][bj][m][n] = __builtin_amdgcn_mfma_f32_16x16x32_bf16(Bt[n][k], At[m][k], acc[ai][bj][m][n], 0, 0, 0); __builtin_amdgcn_s_setprio(0); } while (0)
#define PG8_WAIT_V(n) asm volatile("s_waitcnt vmcnt(" #n ")" ::: "memory")
#define PG8_WAIT_L(n) asm volatile("s_waitcnt lgkmcnt(" #n ")" ::: "memory")
#define PG8_BAR __builtin_amdgcn_s_barrier()
#define PG8_SCHED __builtin_amdgcn_sched_barrier(0)
    Unit cur, nxt; int ui = 0;
    if (!S.next(0, cur)) return;
    f32x4 acc[2][2][4][2];
#pragma unroll
    for (int a = 0; a < 2; ++a)
#pragma unroll
        for (int b = 0; b < 2; ++b)
#pragma unroll
            for (int m = 0; m < 4; ++m)
#pragma unroll
                for (int n = 0; n < 2; ++n) acc[a][b][m][n] = (f32x4){0.f, 0.f, 0.f, 0.f};
    bf16x8 At[4][2], B0[2][2], B1[2][2];
    const char* cA = (const char*)g.A + (size_t)cur.pm * tstep; const char* cB = (const char*)g.Bt + (size_t)cur.pn * tstep;
    S.a_ready(cur);
    if constexpr (SP2) {
        PG8_STAGE(PG8_SB(0, 0), cB, voffB); PG8_STAGE(PG8_SB(0, 1), cB + hstep, voffB); PG8_STAGE(PG8_SA(0, 0), cA, voffA); PG8_STAGE(PG8_SA(0, 1), cA + hstep, voffA);
        if (wr == 1) PG8_BAR;
        PG8_WAIT_V(2); PG8_BAR;
        PG8_STAGE(PG8_SB(1, 0), cB + kstep, voffB); PG8_STAGE(PG8_SA(1, 0), cA + kstep, voffA); PG8_STAGE(PG8_SB(1, 1), cB + hstep + kstep, voffB);
        PG8_WAIT_V(6); PG8_BAR;
    } else {
        PG8_STAGE(PG8_SB(0, 0), cB, voffB); PG8_STAGE(PG8_SA(0, 0), cA, voffA); PG8_STAGE(PG8_SB(0, 1), cB + hstep, voffB); PG8_STAGE(PG8_SA(0, 1), cA + hstep, voffA);
        if (wr == 1) PG8_BAR;
        PG8_WAIT_V(4); PG8_BAR;
        PG8_STAGE(PG8_SB(1, 0), cB + kstep, voffB); PG8_STAGE(PG8_SA(1, 0), cA + kstep, voffA); PG8_STAGE(PG8_SB(1, 1), cB + hstep + kstep, voffB);
        PG8_WAIT_V(6); PG8_BAR;
    }
    for (;;) {
        const bool has_next = S.next(ui + 1, nxt);
        const char* nA = has_next ? (const char*)g.A + (size_t)nxt.pm * tstep : cA; const char* nB = has_next ? (const char*)g.Bt + (size_t)nxt.pn * tstep : cB;
        for (int t = 0; t < nt; t += 2) {
            const bool last = (t == nt - 2);
            const char* a1 = cA + (size_t)(t + 1) * kstep;
            const char* a2 = last ? nA : cA + (size_t)(t + 2) * kstep; const char* b2 = last ? nB : cB + (size_t)(t + 2) * kstep;
            const char* a3 = a2 + kstep; const char* b3 = b2 + kstep;
            if (last && has_next) S.a_ready(nxt);
            if constexpr (SP2) {
            PG8_LDB(B0, 0, 0); PG8_LDB(B1, 0, 1); PG8_SCHED; PG8_LDA(At, 0, 0); PG8_STAGE(PG8_SA(1, 1), a1 + hstep, voffA);
            PG8_WAIT_V(8); PG8_WAIT_L(0); PG8_BAR; PG8_MMA(0, 0, At, B0); PG8_MMA(0, 1, At, B1); PG8_BAR; PG8_SCHED;
            PG8_LDA(At, 0, 1); PG8_STAGE(PG8_SB(0, 0), b2, voffB); PG8_STAGE(PG8_SB(0, 1), b2 + hstep, voffB); PG8_STAGE(PG8_SA(0, 0), a2, voffA);
            PG8_WAIT_V(8); PG8_WAIT_L(0); PG8_BAR; PG8_MMA(1, 0, At, B0); PG8_MMA(1, 1, At, B1); PG8_BAR; PG8_SCHED;
            PG8_LDB(B0, 1, 0); PG8_LDB(B1, 1, 1); PG8_SCHED; PG8_LDA(At, 1, 0); PG8_STAGE(PG8_SA(0, 1), a2 + hstep, voffA);
            PG8_WAIT_V(8); PG8_WAIT_L(0); PG8_BAR; PG8_MMA(0, 0, At, B0); PG8_MMA(0, 1, At, B1); PG8_BAR; PG8_SCHED;
            PG8_LDA(At, 1, 1); PG8_STAGE(PG8_SB(1, 0), b3, voffB); PG8_STAGE(PG8_SB(1, 1), b3 + hstep, voffB); PG8_STAGE(PG8_SA(1, 0), a3, voffA);
            PG8_WAIT_V(8); PG8_WAIT_L(0); PG8_BAR; PG8_MMA(1, 0, At, B0); PG8_MMA(1, 1, At, B1); PG8_BAR; PG8_SCHED;
            } else {
            PG8_LDB(B0, 0, 0); PG8_SCHED; PG8_LDA(At, 0, 0); PG8_STAGE(PG8_SA(1, 1), a1 + hstep, voffA);
            PG8_WAIT_L(8); PG8_BAR; PG8_WAIT_L(0); PG8_MMA(0, 0, At, B0); PG8_BAR; PG8_SCHED;
            PG8_LDB(B1, 0, 1); PG8_STAGE(PG8_SB(0, 0), b2, voffB);
            PG8_BAR; PG8_WAIT_L(0); PG8_MMA(0, 1, At, B1); PG8_BAR;
            PG8_LDA(At, 0, 1); PG8_STAGE(PG8_SA(0, 0), a2, voffA);
            PG8_BAR; PG8_WAIT_L(0); PG8_MMA(1, 0, At, B0); PG8_BAR; PG8_SCHED;
            PG8_STAGE(PG8_SB(0, 1), b2 + hstep, voffB);
            PG8_WAIT_V(6); PG8_BAR; PG8_MMA(1, 1, At, B1); PG8_BAR;
            PG8_LDB(B0, 1, 0); PG8_SCHED; PG8_LDA(At, 1, 0); PG8_STAGE(PG8_SA(0, 1), a2 + hstep, voffA);
            PG8_WAIT_L(8); PG8_BAR; PG8_WAIT_L(0); PG8_MMA(0, 0, At, B0); PG8_BAR; PG8_SCHED;
            PG8_LDB(B1, 1, 1); PG8_STAGE(PG8_SB(1, 0), b3, voffB);
            PG8_BAR; PG8_WAIT_L(0); PG8_MMA(0, 1, At, B1); PG8_BAR;
            PG8_LDA(At, 1, 1); PG8_STAGE(PG8_SA(1, 0), a3, voffA);
            PG8_BAR; PG8_WAIT_L(0); PG8_MMA(1, 0, At, B0); PG8_BAR; PG8_SCHED;
            PG8_STAGE(PG8_SB(1, 1), b3 + hstep, voffB);
            PG8_WAIT_V(6); PG8_BAR; PG8_MMA(1, 1, At, B1); PG8_BAR;
            }
        }
        if constexpr (ALIGN_EPI) { if (wr == 0) PG8_BAR; }
        if constexpr (!Epi::AFTER_DRAIN) { E(acc, cur, wr, wc, fr, fq); S.done(cur); }
        if (!has_next) break;
#pragma unroll
        for (int a = 0; a < 2; ++a)
#pragma unroll
            for (int b = 0; b < 2; ++b)
#pragma unroll
                for (int m = 0; m < 4; ++m)
#pragma unroll
                    for (int n = 0; n < 2; ++n) acc[a][b][m][n] = (f32x4){0.f, 0.f, 0.f, 0.f};
        cur = nxt; cA = nA; cB = nB; ++ui;
        if constexpr (ALIGN_EPI) { if (wr == 1) PG8_BAR; }
    }
    PG8_WAIT_V(0);
    if constexpr (!ALIGN_EPI) { if (wr == 0) PG8_BAR; }
    PG8_BAR;
    if constexpr (Epi::AFTER_DRAIN) { E.fused(acc, cur, wr, wc, fr, fq, lds, wid, lane); S.done(cur); }
#undef PG8_SA
#undef PG8_SB
#undef PG8_STAGE
#undef PG8_LDA
#undef PG8_LDB
#undef PG8_MMA
#undef PG8_WAIT_V
#undef PG8_WAIT_L
#undef PG8_BAR
#undef PG8_SCHED
}
}
#define GAS __attribute__((address_space(1)))
#define LAS __attribute__((address_space(3)))
typedef unsigned short bf16;
typedef unsigned v4u __attribute__((ext_vector_type(4)));
typedef float f32x4 __attribute__((ext_vector_type(4)));
typedef short bf16x8 __attribute__((ext_vector_type(8)));
typedef GAS unsigned gu32;
typedef GAS unsigned long long gu64;
#define RLX_AGENT __ATOMIC_RELAXED, __HIP_MEMORY_SCOPE_AGENT
#define LDS_WAIT() asm volatile("s_waitcnt lgkmcnt(0)" ::: "memory")
#define VM_WAIT() asm volatile("s_waitcnt vmcnt(0)" ::: "memory")
__device__ __forceinline__ unsigned long long rt() { return __builtin_amdgcn_s_memrealtime(); }
__device__ __forceinline__ unsigned f2bf(float f) { unsigned u = __builtin_bit_cast(unsigned, f); return (u + 0x7fffu + ((u >> 16) & 1u)) >> 16; }
__device__ __forceinline__ unsigned pk2(float lo, float hi) { return f2bf(lo) | (f2bf(hi) << 16); }

#define XB_TMO      128
#define XB_XCNT(j)  (256  + 64 * (j))
#define XB_XSUB(j)  (1280 + 64 * (j))
#define XB_XGEN(j)  (2304 + 64 * (j))
#define XB_TOP      3328
#define XB_TOPGEN   3392
#define XCD_BAR_WORDS 3456
#define XB_SPIN_CAP (1u << 18)

__device__ __forceinline__ unsigned xb_ld(unsigned* p)              { return __hip_atomic_load(p, __ATOMIC_RELAXED, __HIP_MEMORY_SCOPE_AGENT); }
__device__ __forceinline__ unsigned xb_add(unsigned* p, unsigned v) { return __hip_atomic_fetch_add(p, v, __ATOMIC_RELAXED, __HIP_MEMORY_SCOPE_AGENT); }
__device__ __forceinline__ unsigned xb_xcc_id() { return (unsigned)__builtin_amdgcn_s_getreg((3 << 11) | 20) & 0xFu; }
#define XB_SPIN(cond, bar) do { unsigned _sp = 0; while (cond) { __builtin_amdgcn_s_sleep(1); \
    if ((++_sp & 255u) == 0u) { if (xb_ld(&(bar)[XB_TMO])) break; if (_sp > XB_SPIN_CAP) { atomicAdd(&(bar)[XB_TMO], 1u); break; } } } } while (0)

struct XcdBarrier {
    unsigned* bar; unsigned x;
    volatile LAS unsigned* st;
};

__device__ __forceinline__ XcdBarrier xcd_barrier_post(unsigned* bar, volatile LAS unsigned* st) {
    XcdBarrier b; b.bar = bar; b.x = xb_xcc_id(); b.st = st;
    if (threadIdx.x == 0) (void)xb_add(&bar[XB_XCNT(b.x)], 1u);
    return b;
}
__device__ __forceinline__ void xcd_barrier_complete(unsigned* bar, unsigned x, unsigned& nloc, unsigned& nx) {
    const unsigned G = gridDim.x * gridDim.y * gridDim.z;
    unsigned sum, cnt, mine, sp = 0u;
    for (;;) {
        sum = 0u; cnt = 0u; mine = 0u;
#pragma unroll
        for (unsigned j = 0; j < 16; ++j) { const unsigned c = xb_ld(&bar[XB_XCNT(j)]); sum += c; cnt += (c > 0u) ? 1u : 0u; mine = (j == x) ? c : mine; }
        if (sum == G) break;
        __builtin_amdgcn_s_sleep(1);
        if ((++sp & 255u) == 0u) { if (xb_ld(&bar[XB_TMO])) break; if (sp > XB_SPIN_CAP) { atomicAdd(&bar[XB_TMO], 1u); break; } }
    }
    nloc = mine > 0u ? mine : 1u; nx = cnt > 0u ? cnt : 1u;
}

__device__ __forceinline__ void xcd_barrier(const XcdBarrier& b) {
    asm volatile("s_waitcnt vmcnt(0)" ::: "memory");
    __syncthreads();
    if (threadIdx.x == 0) {
        unsigned* bar = b.bar;
        __builtin_amdgcn_s_waitcnt(0);
        unsigned nloc = b.st[0], nx = b.st[1];
        if (nloc == 0u) { xcd_barrier_complete(bar, b.x, nloc, nx); b.st[0] = nloc; b.st[1] = nx; }
        const unsigned old = xb_add(&bar[XB_XSUB(b.x)], 1u);
        const unsigned gen = old / nloc;
        if (old + 1u == (gen + 1u) * nloc) {
            __builtin_amdgcn_fence(__ATOMIC_RELEASE, "agent");
            asm volatile("s_waitcnt vmcnt(0)" ::: "memory");
            const unsigned og = xb_add(&bar[XB_TOP], 1u);
            const unsigned tg = og / nx;
            if (og + 1u == (tg + 1u) * nx) xb_add(&bar[XB_TOPGEN], 1u);
            else XB_SPIN(xb_ld(&bar[XB_TOPGEN]) == tg, bar);
            __builtin_amdgcn_fence(__ATOMIC_ACQUIRE, "agent");
            xb_add(&bar[XB_XGEN(b.x)], 1u);
            asm volatile("s_waitcnt vmcnt(0)" ::: "memory");
        } else {
            XB_SPIN(xb_ld(&bar[XB_XGEN(b.x)]) == gen, bar);
            __builtin_amdgcn_fence(__ATOMIC_ACQUIRE, "agent");
            asm volatile("s_waitcnt vmcnt(0)" ::: "memory");
        }
    }
    __syncthreads();
}

constexpr int T = 16384, D = 1024, SEQ = 8192, NCTX = 256, TCX = 512, DIN = 3840, MH = T + TCX;
constexpr int ZU = 0, ZV = 512, ZQ = 1024, ZK = 1536, ZVA = 1664, ZGA = 1792, ZGB = 2816;
constexpr int NEXP = 256, NSLOT = 9, LISTCAP = 16384, MOE_MAXT = 24;
constexpr float LOG2E = 1.4426950408889634f;
constexpr float QSCALE = 0.125f * LOG2E;
constexpr size_t MiB = 1u << 20;
constexpr size_t WS_CTL = 0, CTL_ZERO_BYTES = 1 * MiB;
constexpr size_t WS_ADAP = 1 * MiB;
constexpr size_t WS_ADAF = 2 * MiB;
constexpr size_t WS_ROPE = 2 * MiB + 128 * 1024;
constexpr size_t WS_WST = 2 * MiB + 256 * 1024;
constexpr size_t WS_RWT = 3 * MiB;
constexpr size_t WS_WINT = 4 * MiB;
constexpr size_t WS_WAT = 12 * MiB, WS_WBT = 13 * MiB, WS_WOT = 14 * MiB;
constexpr size_t WS_KVC = 16 * MiB;
constexpr size_t WS_GATEW = 17 * MiB;
constexpr size_t WS_H = 18 * MiB;
constexpr size_t WS_Z = 52 * MiB;
constexpr size_t WS_A = 172 * MiB, WS_O = 188 * MiB;
constexpr size_t WS_TMP = 204 * MiB;
constexpr size_t WS_Y = 268 * MiB;
constexpr size_t WS_X1 = 300 * MiB;
constexpr size_t WS_H2 = 364 * MiB;
constexpr size_t WS_LIST = 396 * MiB;
constexpr size_t WS_CONTRIB = 414 * MiB;
constexpr float CONTRIB_SCALE = 16.f;
constexpr size_t WS_END = 704 * MiB;
constexpr int CW_BAR = 4096;
constexpr int CW_CNT = 16384;
constexpr int CW_XRANK = 32768;
constexpr int SCR_BYTES = 148480;
constexpr int MISC_OFF = SCR_BYTES;
constexpr int LDS_BYTES = 152 * 1024;
constexpr int NWAVES = 8;

typedef float f32x2_t __attribute__((ext_vector_type(2)));
typedef __bf16 bf16x2_t __attribute__((ext_vector_type(2)));
typedef float f32x16 __attribute__((ext_vector_type(16)));
typedef short s16x4 __attribute__((ext_vector_type(4)));
typedef short v4i16_t __attribute__((ext_vector_type(4)));
typedef unsigned u32x2 __attribute__((ext_vector_type(2)));
typedef unsigned u32x4 __attribute__((ext_vector_type(4)));
typedef LAS unsigned char* ldsp;

__device__ __forceinline__ unsigned cvtpk(float lo, float hi) { f32x2_t v = {lo, hi}; bf16x2_t b = __builtin_convertvector(v, bf16x2_t); return __builtin_bit_cast(unsigned, b); }
__device__ __forceinline__ float bf2f(unsigned short u) { return __uint_as_float((unsigned)u << 16); }
__device__ __forceinline__ float bflo(unsigned w) { return __uint_as_float(w << 16); }
__device__ __forceinline__ float bfhi(unsigned w) { return __uint_as_float(w & 0xffff0000u); }
__device__ __forceinline__ float wave_sum(float v) {
#pragma unroll
    for (int o = 1; o < 64; o <<= 1) v += __shfl_xor(v, o);
    return v;
}
__device__ __forceinline__ float sigmoid_f(float x) { return __builtin_amdgcn_rcpf(1.f + __builtin_amdgcn_exp2f(-x * LOG2E)); }
__device__ __forceinline__ float silu_f(float x) { return x * sigmoid_f(x); }
__device__ __forceinline__ float gelu_f(float x) { const float u = 0.7978845608028654f * (x + 0.044715f * x * x * x); return x * sigmoid_f(2.f * u); }
__device__ __forceinline__ f32x16 mfma32(bf16x8 a, bf16x8 b, f32x16 c) { return __builtin_amdgcn_mfma_f32_32x32x16_bf16(a, b, c, 0, 0, 0); }
__device__ __forceinline__ f32x4 mfma16(bf16x8 a, bf16x8 b, f32x4 c) { return __builtin_amdgcn_mfma_f32_16x16x32_bf16(a, b, c, 0, 0, 0); }

struct Args { const float* in[26]; float* out; unsigned char* ws; int ph_lo, ph_hi; };
enum { I_X = 0, I_C, I_CTX, I_CCTX, I_ADAW, I_ADAB, I_N1G, I_N2G, I_WIN, I_LNG, I_LNB, I_GWS, I_GBS, I_SINK, I_WA, I_WB, I_WO, I_RW, I_RB, I_EG, I_EU, I_ED, I_SG, I_SU, I_SD, I_FG };

__device__ __forceinline__ void p0_transpose_item(const float* W, int K, int N, bf16* WT, LAS float* scr, int item, int lane) {
    const int nblk = N / 32, kb = item / nblk, nb = item % nblk, k0 = 64 * kb, n0 = 32 * nb;
#pragma unroll 8
    for (int i = 0; i < 32; ++i) { const int kk = 2 * i + (lane >> 5); scr[kk * 33 + (lane & 31)] = W[(size_t)(k0 + kk) * N + n0 + (lane & 31)]; }
    LDS_WAIT(); asm volatile("" ::: "memory");
    const int c = lane & 7;
#pragma unroll
    for (int j = 0; j < 4; ++j) { const int n = (lane >> 3) + 8 * j; const LAS float* s = scr + (8 * c) * 33 + n;
        v4u o; o.x = pk2(s[0 * 33], s[1 * 33]); o.y = pk2(s[2 * 33], s[3 * 33]); o.z = pk2(s[4 * 33], s[5 * 33]); o.w = pk2(s[6 * 33], s[7 * 33]);
        *(GAS v4u*)(WT + (size_t)(n0 + n) * K + k0 + 8 * c) = o; }
    LDS_WAIT(); asm volatile("" ::: "memory");
}

__device__ __forceinline__ void phase_prep(const Args& a, ldsp lds, int G) {
    const int tid = threadIdx.x, lane = tid & 63, wave = __builtin_amdgcn_readfirstlane(tid >> 6), blk = blockIdx.x;
    unsigned char* ws = a.ws;
    if (blk < 192) {
        const int cb = blk % 24, kc = blk / 24, col = cb * 256 + lane * 4, k0 = kc * 128 + wave * 16;
        const float* c = a.in[I_C]; const float* cc = a.in[I_CCTX]; const float* aw = a.in[I_ADAW];
        f32x4 a0 = {0.f, 0.f, 0.f, 0.f}, a1 = a0, a2 = a0;
#pragma unroll 4
        for (int k = 0; k < 16; ++k) {
            const int kk = k0 + k;
            const float s0 = silu_f(c[kk]), s1 = silu_f(c[1024 + kk]), s2 = silu_f(cc[kk]);
            const f32x4 w = *(const f32x4*)(aw + (size_t)kk * 6144 + col);
            a0 += w * s0; a1 += w * s1; a2 += w * s2;
        }
        LAS float* red = (LAS float*)lds;
        *(LAS f32x4*)(red + (wave * 3 + 0) * 256 + lane * 4) = a0;
        *(LAS f32x4*)(red + (wave * 3 + 1) * 256 + lane * 4) = a1;
        *(LAS f32x4*)(red + (wave * 3 + 2) * 256 + lane * 4) = a2;
        __syncthreads();
        float* adap = (float*)(ws + WS_ADAP);
        for (int idx = tid; idx < 768; idx += 512) {
            const int v = idx >> 8, cl = idx & 255; float s = 0.f;
#pragma unroll
            for (int w = 0; w < 8; ++w) s += red[(w * 3 + v) * 256 + cl];
            adap[(size_t)(kc * 3 + v) * 6144 + cb * 256 + cl] = s;
        }
        __syncthreads();
    }
    {
        LAS float* scr = (LAS float*)(lds + wave * 8704);
        const int gw = blk * NWAVES + wave, NGW = G * NWAVES;
        constexpr int I_1 = 16 * 120, I_2 = 8 * 32, I_3 = 8 * 32, I_4 = 16 * 32, I_5 = 16 * 8;
        for (int it = gw; it < I_1 + I_2 + I_3 + I_4 + I_5; it += NGW) {
            int r = it;
            if (r < I_1) { p0_transpose_item(a.in[I_WIN], 1024, 3840, (bf16*)(ws + WS_WINT), scr, r, lane); continue; } r -= I_1;
            if (r < I_2) { p0_transpose_item(a.in[I_WA], 512, 1024, (bf16*)(ws + WS_WAT), scr, r, lane); continue; } r -= I_2;
            if (r < I_3) { p0_transpose_item(a.in[I_WB], 512, 1024, (bf16*)(ws + WS_WBT), scr, r, lane); continue; } r -= I_3;
            if (r < I_4) { p0_transpose_item(a.in[I_WO], 1024, 1024, (bf16*)(ws + WS_WOT), scr, r, lane); continue; } r -= I_4;
            p0_transpose_item(a.in[I_RW], 1024, 256, (bf16*)(ws + WS_RWT), scr, r, lane);
        }
    }
    {
        const int gt = blk * 512 + tid, NT = G * 512;
        const float* gws = a.in[I_GWS]; bf16* wst = (bf16*)(ws + WS_WST);
        for (int i = gt; i < 8192; i += NT) {
            const f32x4 x0 = *(const f32x4*)(gws + i * 8), x1 = *(const f32x4*)(gws + i * 8 + 4);
            v4u o; o.x = cvtpk(x0[0], x0[1]); o.y = cvtpk(x0[2], x0[3]); o.z = cvtpk(x1[0], x1[1]); o.w = cvtpk(x1[2], x1[3]);
            *(v4u*)(wst + i * 8) = o;
        }
        float* rope = (float*)(ws + WS_ROPE);
        for (int i = gt; i < 2048; i += NT) {
            const int pos = i >> 4, f = i & 15;
            const float inv = __builtin_amdgcn_exp2f(-(float)f * (13.287712379549449f / 16.f));
            const float ang = (float)pos * inv;
            double rev = (double)ang * 0.15915494309189535; rev -= floor(rev);
            rope[pos * 32 + f] = __builtin_amdgcn_cosf((float)rev);
            rope[pos * 32 + 16 + f] = __builtin_amdgcn_sinf((float)rev);
        }
    }
}

__device__ __forceinline__ void phase_hnorm(const Args& a, ldsp lds, int G) {
    const int tid = threadIdx.x, lane = tid & 63, wave = __builtin_amdgcn_readfirstlane(tid >> 6), blk = blockIdx.x;
    unsigned char* ws = a.ws;
    const float* adap = (const float*)(ws + WS_ADAP); const float* adab = a.in[I_ADAB];
    LAS float* modv = (LAS float*)lds;
    for (int idx = tid; idx < 3 * 2048; idx += 512) {
        const int v = idx >> 11, j = idx & 2047; float s = adab[j];
#pragma unroll
        for (int kc = 0; kc < 8; ++kc) s += adap[(size_t)(kc * 3 + v) * 6144 + j];
        modv[idx] = (j >= 1024) ? s + 1.f : s;
    }
    { float* adaf = (float*)(ws + WS_ADAF);
      for (int idx = blk * 512 + tid; idx < 3 * 6144; idx += G * 512) {
          const int v = idx / 6144, j = idx % 6144; float s = adab[j];
#pragma unroll
          for (int kc = 0; kc < 8; ++kc) s += adap[(size_t)(kc * 3 + v) * 6144 + j];
          adaf[idx] = s; } }
    __syncthreads();
    const float* g1 = a.in[I_N1G]; bf16* H = (bf16*)(ws + WS_H);
    for (int t = blk * NWAVES + wave; t < MH; t += G * NWAVES) {
        const float* xr = (t < T) ? a.in[I_X] + (size_t)t * D : a.in[I_CTX] + (size_t)(t - T) * D;
        const int v = (t < T) ? (t >> 13) : 2;
        f32x4 x[4]; float ss = 0.f;
#pragma unroll
        for (int j = 0; j < 4; ++j) { x[j] = *(const f32x4*)(xr + 4 * lane + 256 * j); ss += (x[j][0] * x[j][0] + x[j][1] * x[j][1]) + (x[j][2] * x[j][2] + x[j][3] * x[j][3]); }
        const float r = rsqrtf(wave_sum(ss) * (1.f / D) + 1e-6f);
#pragma unroll
        for (int j = 0; j < 4; ++j) {
            const int col = 4 * lane + 256 * j;
            const f32x4 g = *(const f32x4*)(g1 + col);
            const f32x4 sh = *(LAS f32x4*)(modv + v * 2048 + col), sc = *(LAS f32x4*)(modv + v * 2048 + 1024 + col);
            const f32x4 h = (x[j] * r) * g * sc + sh;
            u32x2 o; o.x = cvtpk(h[0], h[1]); o.y = cvtpk(h[2], h[3]);
            *(u32x2*)(H + (size_t)t * D + col) = o;
        }
    }
}

struct WinOrder {
    pg8::StaticOrder so;
    __device__ void init(int G, int c) { so.init(T, DIN, G, c); }
    __device__ bool next(int i, pg8::Unit& u) const {
        const long L = (long)i * so.G + so.c;
        if (L < 960) return so.next(i, u);
        if (L < 962) { u.pm = 64 + (int)(L - 960); u.pn = 6; return true; }
        return false;
    }
    __device__ __forceinline__ void a_ready(const pg8::Unit&) const {}
    __device__ __forceinline__ void done(const pg8::Unit&) const {}
};
struct EpiWin {
    static constexpr bool PERM = false, AFTER_DRAIN = false;
    bf16* Z; bf16* KVC; const float* rope;
    __device__ __forceinline__ void operator()(const pg8::f32x4 (&acc)[2][2][4][2], const pg8::Unit& u, int wr, int wc, int fr, int fq) const {
        const int row0 = u.pm * 256 + wr * 64 + fr, colb = u.pn * 256 + wc * 32 + 4 * fq, pn = u.pn;
        if (u.pm >= 64) {
#pragma unroll
            for (int ai = 0; ai < 2; ++ai)
#pragma unroll
                for (int m = 0; m < 4; ++m) { bf16* rp = KVC + (size_t)(row0 + ai * 128 + m * 16 - T) * 256 + (colb - ZK);
#pragma unroll
                    for (int bj = 0; bj < 2; ++bj)
#pragma unroll
                        for (int n = 0; n < 2; ++n) { const pg8::f32x4 v = acc[ai][bj][m][n]; u32x2 o; o.x = cvtpk(v[0], v[1]); o.y = cvtpk(v[2], v[3]); *(u32x2*)(rp + bj * 128 + n * 16) = o; } }
            return;
        }
#pragma unroll
        for (int ai = 0; ai < 2; ++ai)
#pragma unroll
            for (int m = 0; m < 4; ++m) {
                const int r = row0 + ai * 128 + m * 16; bf16* rp = Z + (size_t)r * DIN + colb;
                if (pn <= 3) {
#pragma unroll
                    for (int bj = 0; bj < 2; ++bj)
#pragma unroll
                        for (int n = 0; n < 2; ++n) { const pg8::f32x4 v = acc[ai][bj][m][n]; u32x2 o; o.x = cvtpk(gelu_f(v[0]), gelu_f(v[1])); o.y = cvtpk(gelu_f(v[2]), gelu_f(v[3])); *(u32x2*)(rp + bj * 128 + n * 16) = o; }
                } else if (pn <= 6) {
                    const int pos = (wc & 1) ? (r & 63) : ((r & 8191) >> 6);
                    const pg8::f32x4 cs = *(const pg8::f32x4*)(rope + pos * 32 + 4 * fq), sn = *(const pg8::f32x4*)(rope + pos * 32 + 16 + 4 * fq);
                    const float sc = (pn < 6) ? QSCALE : 1.f;
#pragma unroll
                    for (int bj = 0; bj < 2; ++bj) {
                        const pg8::f32x4 x1 = acc[ai][bj][m][0], x2 = acc[ai][bj][m][1];
                        pg8::f32x4 o1, o2;
                        if (pn == 6 && bj == 1) { o1 = x1; o2 = x2; }
                        else { o1 = (x1 * cs - x2 * sn) * sc; o2 = (x2 * cs + x1 * sn) * sc; }
                        u32x2 w1, w2; w1.x = cvtpk(o1[0], o1[1]); w1.y = cvtpk(o1[2], o1[3]); w2.x = cvtpk(o2[0], o2[1]); w2.y = cvtpk(o2[2], o2[3]);
                        *(u32x2*)(rp + bj * 128) = w1; *(u32x2*)(rp + bj * 128 + 16) = w2;
                    }
                } else {
#pragma unroll
                    for (int bj = 0; bj < 2; ++bj)
#pragma unroll
                        for (int n = 0; n < 2; ++n) { const pg8::f32x4 v = acc[ai][bj][m][n]; u32x2 o; o.x = cvtpk(sigmoid_f(v[0]), sigmoid_f(v[1])); o.y = cvtpk(sigmoid_f(v[2]), sigmoid_f(v[3])); *(u32x2*)(rp + bj * 128 + n * 16) = o; }
                }
            }
    }
};
struct EpiMergeA {
    static constexpr bool PERM = true, AFTER_DRAIN = false;
    const bf16* Z; bf16* Y;
    __device__ __forceinline__ void operator()(const pg8::f32x4 (&acc)[2][2][4][2], const pg8::Unit& u, int wr, int wc, int fr, int fq) const {
        const int row0 = u.pm * 256 + wr * 64 + fr, col0 = u.pn * 256 + wc * 32 + 8 * fq;
#pragma unroll
        for (int ai = 0; ai < 2; ++ai)
#pragma unroll
            for (int m = 0; m < 4; ++m) { const int r = row0 + ai * 128 + m * 16;
#pragma unroll
                for (int bj = 0; bj < 2; ++bj) { const int c = col0 + bj * 128;
                    const u32x4 g = *(const u32x4*)(Z + (size_t)r * DIN + ZGA + c);
                    const pg8::f32x4 v0 = acc[ai][bj][m][0], v1 = acc[ai][bj][m][1];
                    u32x4 o;
                    o.x = cvtpk(v0[0] * bflo(g.x), v0[1] * bfhi(g.x)); o.y = cvtpk(v0[2] * bflo(g.y), v0[3] * bfhi(g.y));
                    o.z = cvtpk(v1[0] * bflo(g.z), v1[1] * bfhi(g.z)); o.w = cvtpk(v1[2] * bflo(g.w), v1[3] * bfhi(g.w));
                    *(u32x4*)(Y + (size_t)r * D + c) = o; } }
    }
};
struct EpiMergeB {
    static constexpr bool PERM = true, AFTER_DRAIN = false;
    const bf16* Z; bf16* Y;
    __device__ __forceinline__ void operator()(const pg8::f32x4 (&acc)[2][2][4][2], const pg8::Unit& u, int wr, int wc, int fr, int fq) const {
        const int row0 = u.pm * 256 + wr * 64 + fr, col0 = u.pn * 256 + wc * 32 + 8 * fq;
#pragma unroll
        for (int ai = 0; ai < 2; ++ai)
#pragma unroll
            for (int m = 0; m < 4; ++m) { const int r = row0 + ai * 128 + m * 16;
#pragma unroll
                for (int bj = 0; bj < 2; ++bj) { const int c = col0 + bj * 128;
                    const u32x4 g = *(const u32x4*)(Z + (size_t)r * DIN + ZGB + c);
                    const u32x4 tp = *(const u32x4*)(Y + (size_t)r * D + c);
                    const pg8::f32x4 t0 = {bflo(tp.x), bfhi(tp.x), bflo(tp.y), bfhi(tp.y)}, t1 = {bflo(tp.z), bfhi(tp.z), bflo(tp.w), bfhi(tp.w)};
                    const pg8::f32x4 v0 = acc[ai][bj][m][0], v1 = acc[ai][bj][m][1];
                    u32x4 o;
                    o.x = cvtpk(t0[0] + v0[0] * bflo(g.x), t0[1] + v0[1] * bfhi(g.x)); o.y = cvtpk(t0[2] + v0[2] * bflo(g.y), t0[3] + v0[3] * bfhi(g.y));
                    o.z = cvtpk(t1[0] + v1[0] * bflo(g.z), t1[1] + v1[1] * bfhi(g.z)); o.w = cvtpk(t1[2] + v1[2] * bflo(g.w), t1[3] + v1[3] * bfhi(g.w));
                    *(u32x4*)(Y + (size_t)r * D + c) = o; } }
    }
};
struct EpiWo {
    static constexpr bool PERM = true, AFTER_DRAIN = false;
    const float* x; const float* adaf; bf16* X1;
    __device__ __forceinline__ void operator()(const pg8::f32x4 (&acc)[2][2][4][2], const pg8::Unit& u, int wr, int wc, int fr, int fq) const {
        const int row0 = u.pm * 256 + wr * 64 + fr, col0 = u.pn * 256 + wc * 32 + 8 * fq;
        const float* g1 = adaf + (u.pm >= 32 ? 6144 : 0) + 2048;
#pragma unroll
        for (int bj = 0; bj < 2; ++bj) { const int c = col0 + bj * 128;
            const pg8::f32x4 ga = *(const pg8::f32x4*)(g1 + c), gb = *(const pg8::f32x4*)(g1 + c + 4);
#pragma unroll
            for (int ai = 0; ai < 2; ++ai)
#pragma unroll
                for (int m = 0; m < 4; ++m) { const int r = row0 + ai * 128 + m * 16;
                    const pg8::f32x4 x0 = *(const pg8::f32x4*)(x + (size_t)r * D + c), x1 = *(const pg8::f32x4*)(x + (size_t)r * D + c + 4);
                    const pg8::f32x4 o0 = x0 + ga * acc[ai][bj][m][0], o1 = x1 + gb * acc[ai][bj][m][1];
                    u32x4 w; w.x = cvtpk(o0[0], o0[1]); w.y = cvtpk(o0[2], o0[3]); w.z = cvtpk(o1[0], o1[1]); w.w = cvtpk(o1[2], o1[3]);
                    *(u32x4*)(X1 + (size_t)r * D + c) = w; } }
    }
};


__device__ __forceinline__ s16x4 vtr(LAS const unsigned char* p) { return __builtin_bit_cast(s16x4, __builtin_amdgcn_ds_read_tr16_b64_v4i16((LAS v4i16_t*)p)); }

__device__ __forceinline__ void attn_item(const bf16* Z, const bf16* KVC, const float* sink, bf16* Obuf, ldsp lds, int b, int nb, int hk, int qh) {
    const int tid = threadIdx.x, lane = tid & 63, wave = __builtin_amdgcn_readfirstlane(tid >> 6), r32 = lane & 31, hi = lane >> 5;
    const int rq = wave >> 1, head = hk * 4 + rq;
    const int iq = qh * 64 + (wave & 1) * 32 + r32;
    const int wlo = (nb == 0) ? 2 : qh, whi = (nb == 63) ? 4 : 5 + qh, nwin = whi - wlo, ntile = nwin + 4;
    const int tokq = b * SEQ + nb * 128 + iq;
    bf16x8 qr[4];
#pragma unroll
    for (int d0 = 0; d0 < 4; ++d0) qr[d0] = *(const bf16x8*)(Z + (size_t)tokq * DIN + ZQ + head * 64 + d0 * 16 + hi * 8);
    float mrun = sink[head] * LOG2E, lrun = (hi == 0) ? 1.f : 0.f;
    f32x16 o[2];
#pragma unroll
    for (int j = 0; j < 2; ++j)
#pragma unroll
        for (int r = 0; r < 16; ++r) o[j][r] = 0.f;
    const int kdst = wave * 1024 + lane * 16, vdst = 8192 + (wave >> 2) * 4096 + lane * 64 + (wave & 3) * 16;
#define ATT_SRC(s, kp, vp) do { const int tl_ = (s) < nwin ? wlo + (s) : 6 + (s) - nwin; \
        if (tl_ < 6) { const int tok_ = b * SEQ + (nb - 1 + (tl_ >> 1)) * 128 + (tl_ & 1) * 64 + lane; kp = Z + (size_t)tok_ * DIN + ZK + hk * 64 + wave * 8; vp = Z + (size_t)tok_ * DIN + ZVA + hk * 64 + wave * 8; } \
        else { const int row_ = b * NCTX + (tl_ - 6) * 64 + lane; kp = KVC + (size_t)row_ * 256 + hk * 64 + wave * 8; vp = KVC + (size_t)row_ * 256 + 128 + hk * 64 + wave * 8; } } while (0)
    u32x4 kreg, vreg;
    { const bf16 *kp, *vp; ATT_SRC(0, kp, vp); kreg = *(const u32x4*)kp; vreg = *(const u32x4*)vp; }
    *(LAS u32x4*)(lds + kdst) = kreg; *(LAS u32x4*)(lds + vdst) = vreg;
    __syncthreads();
    const int vrd = ((lane & 15) >> 2) * 64 + ((lane >> 4) & 1) * 32 + (lane & 3) * 8 + hi * 256;
    for (int s = 0; s < ntile; ++s) {
        const int base = (s & 1) * 16384;
        const int tl = s < nwin ? wlo + s : 6 + s - nwin;
        if (s + 1 < ntile) { const bf16 *kp, *vp; ATT_SRC(s + 1, kp, vp); kreg = *(const u32x4*)kp; vreg = *(const u32x4*)vp; }
        {
            f32x16 p0, p1;
#pragma unroll
            for (int r = 0; r < 16; ++r) { p0[r] = 0.f; p1[r] = 0.f; }
#pragma unroll
            for (int d0 = 0; d0 < 4; ++d0) {
                const bf16x8 k0 = *(LAS const bf16x8*)(lds + base + (2 * d0 + hi) * 1024 + r32 * 16);
                const bf16x8 k1 = *(LAS const bf16x8*)(lds + base + (2 * d0 + hi) * 1024 + (r32 + 32) * 16);
                p0 = mfma32(k0, qr[d0], p0); p1 = mfma32(k1, qr[d0], p1);
            }
            if (tl < 2) {
                const int j0 = (tl & 1) * 64 + 4 * hi;
#pragma unroll
                for (int r = 0; r < 16; ++r) { const int j = j0 + (r & 3) + 8 * (r >> 2); if (j < iq) p0[r] = -INFINITY; if (j + 32 < iq) p1[r] = -INFINITY; }
            } else if (tl == 4 || tl == 5) {
                const int j0 = (tl & 1) * 64 + 4 * hi;
#pragma unroll
                for (int r = 0; r < 16; ++r) { const int j = j0 + (r & 3) + 8 * (r >> 2); if (j > iq) p0[r] = -INFINITY; if (j + 32 > iq) p1[r] = -INFINITY; }
            }
            float mx = fmaxf(p0[0], p1[0]);
#pragma unroll
            for (int r = 1; r < 16; ++r) mx = fmaxf(mx, fmaxf(p0[r], p1[r]));
            mx = fmaxf(mx, __shfl_xor(mx, 32));
            const float mn = fmaxf(mrun, mx), alpha = __builtin_amdgcn_exp2f(mrun - mn);
            mrun = mn;
            float rs = 0.f;
#pragma unroll
            for (int r = 0; r < 16; ++r) { p0[r] = __builtin_amdgcn_exp2f(p0[r] - mn); p1[r] = __builtin_amdgcn_exp2f(p1[r] - mn); rs += p0[r] + p1[r]; }
            lrun = lrun * alpha + rs;
#pragma unroll
            for (int r = 0; r < 16; ++r) { o[0][r] *= alpha; o[1][r] *= alpha; }
            bf16x8 pf[4];
#pragma unroll
            for (int s4 = 0; s4 < 4; ++s4) {
                u32x4 w;
                if (s4 < 2) { w.x = cvtpk(p0[8 * s4 + 0], p0[8 * s4 + 1]); w.y = cvtpk(p0[8 * s4 + 2], p0[8 * s4 + 3]); w.z = cvtpk(p0[8 * s4 + 4], p0[8 * s4 + 5]); w.w = cvtpk(p0[8 * s4 + 6], p0[8 * s4 + 7]); }
                else { const int q = s4 - 2; w.x = cvtpk(p1[8 * q + 0], p1[8 * q + 1]); w.y = cvtpk(p1[8 * q + 2], p1[8 * q + 3]); w.z = cvtpk(p1[8 * q + 4], p1[8 * q + 5]); w.w = cvtpk(p1[8 * q + 6], p1[8 * q + 7]); }
                pf[s4] = __builtin_bit_cast(bf16x8, w);
            }
#pragma unroll
            for (int dblk = 0; dblk < 2; ++dblk)
#pragma unroll
                for (int s4 = 0; s4 < 4; ++s4) {
                    const s16x4 lo = vtr(lds + base + 8192 + dblk * 4096 + vrd + (16 * s4) * 64);
                    const s16x4 hh = vtr(lds + base + 8192 + dblk * 4096 + vrd + (16 * s4 + 8) * 64);
                    const bf16x8 vf = {lo[0], lo[1], lo[2], lo[3], hh[0], hh[1], hh[2], hh[3]};
                    o[dblk] = mfma32(vf, pf[s4], o[dblk]);
                }
        }
        if (s + 1 < ntile) { *(LAS u32x4*)(lds + (16384 - base) + kdst) = kreg; *(LAS u32x4*)(lds + (16384 - base) + vdst) = vreg; }
        __syncthreads();
    }
#undef ATT_SRC
    {
        const float lt = lrun + __shfl_xor(lrun, 32), inv = 1.f / lt;
        bf16* op = Obuf + (size_t)tokq * 512 + head * 64;
#pragma unroll
        for (int dblk = 0; dblk < 2; ++dblk)
#pragma unroll
            for (int r4 = 0; r4 < 4; ++r4) {
                u32x2 w; w.x = cvtpk(o[dblk][4 * r4] * inv, o[dblk][4 * r4 + 1] * inv); w.y = cvtpk(o[dblk][4 * r4 + 2] * inv, o[dblk][4 * r4 + 3] * inv);
                *(u32x2*)(op + 32 * dblk + 8 * r4 + 4 * hi) = w;
            }
    }
}

__device__ __forceinline__ void gmlp_item(const bf16* Z, const float* lng, const float* lnb, const bf16* WsT, const float* bs, bf16* Abuf, ldsp lds, int ch, int gp) {
    const int tid = threadIdx.x, lane = tid & 63, wave = __builtin_amdgcn_readfirstlane(tid >> 6), fr = lane & 15, fq = lane >> 4;
    const int tok0 = ch * 128;
    LAS bf16* VT = (LAS bf16*)lds;
    f32x4 gA = *(const f32x4*)(lng + lane * 8), gB = *(const f32x4*)(lng + lane * 8 + 4), bA = *(const f32x4*)(lnb + lane * 8), bB = *(const f32x4*)(lnb + lane * 8 + 4);
#pragma unroll
    for (int rnd = 0; rnd < 2; ++rnd) {
        float y[8][8];
#pragma unroll
        for (int j = 0; j < 8; ++j) {
            const int tok = tok0 + wave * 16 + rnd * 8 + j;
            const u32x4 raw = *(const u32x4*)(Z + (size_t)tok * DIN + ZV + lane * 8);
            float x[8] = {bflo(raw.x), bfhi(raw.x), bflo(raw.y), bfhi(raw.y), bflo(raw.z), bfhi(raw.z), bflo(raw.w), bfhi(raw.w)};
            float s = 0.f;
#pragma unroll
            for (int i = 0; i < 8; ++i) s += x[i];
            const float mu = wave_sum(s) * (1.f / 512.f);
            float q = 0.f;
#pragma unroll
            for (int i = 0; i < 8; ++i) { x[i] -= mu; q += x[i] * x[i]; }
            const float rstd = rsqrtf(wave_sum(q) * (1.f / 512.f) + 1e-6f);
            y[j][0] = x[0] * rstd * gA[0] + bA[0]; y[j][1] = x[1] * rstd * gA[1] + bA[1]; y[j][2] = x[2] * rstd * gA[2] + bA[2]; y[j][3] = x[3] * rstd * gA[3] + bA[3];
            y[j][4] = x[4] * rstd * gB[0] + bB[0]; y[j][5] = x[5] * rstd * gB[1] + bB[1]; y[j][6] = x[6] * rstd * gB[2] + bB[2]; y[j][7] = x[7] * rstd * gB[3] + bB[3];
        }
        if ((lane >> 5) == gp) {
            const int gl = (lane >> 4) & 1;
#pragma unroll
            for (int i = 0; i < 8; ++i) {
                u32x4 w; w.x = cvtpk(y[0][i], y[1][i]); w.y = cvtpk(y[2][i], y[3][i]); w.z = cvtpk(y[4][i], y[5][i]); w.w = cvtpk(y[6][i], y[7][i]);
                *(LAS u32x4*)(VT + gl * (128 * 136) + (8 * (lane & 15) + i) * 136 + wave * 16 + rnd * 8) = w;
            }
        }
    }
    __syncthreads();
    const int wm = wave >> 1, wn = wave & 1;
#pragma unroll
    for (int gl = 0; gl < 2; ++gl) {
        const int g = 2 * gp + gl;
        f32x4 acc[2][4];
#pragma unroll
        for (int m = 0; m < 2; ++m)
#pragma unroll
            for (int n = 0; n < 4; ++n) acc[m][n] = (f32x4){0.f, 0.f, 0.f, 0.f};
#pragma unroll
        for (int ks = 0; ks < 4; ++ks) {
            bf16x8 af[2], bfr[4];
#pragma unroll
            for (int m = 0; m < 2; ++m) af[m] = *(const bf16x8*)(WsT + (size_t)g * 16384 + (32 * wm + 16 * m + fr) * 128 + 32 * ks + 8 * fq);
#pragma unroll
            for (int n = 0; n < 4; ++n) bfr[n] = *(LAS const bf16x8*)(VT + gl * (128 * 136) + (64 * wn + 16 * n + fr) * 136 + 32 * ks + 8 * fq);
#pragma unroll
            for (int m = 0; m < 2; ++m)
#pragma unroll
                for (int n = 0; n < 4; ++n) acc[m][n] = mfma16(bfr[n], af[m], acc[m][n]);
        }
#pragma unroll
        for (int m = 0; m < 2; ++m) {
            const int p = 32 * wm + 16 * m + fr, tok = tok0 + p; const float bias = bs[g * 128 + p];
#pragma unroll
            for (int n = 0; n < 4; ++n) {
                const int c = g * 128 + 64 * wn + 16 * n + 4 * fq;
                const u32x2 uw = *(const u32x2*)(Z + (size_t)tok * DIN + ZU + c);
                u32x2 w; w.x = cvtpk(bflo(uw.x) * (acc[m][n][0] + bias), bfhi(uw.x) * (acc[m][n][1] + bias)); w.y = cvtpk(bflo(uw.y) * (acc[m][n][2] + bias), bfhi(uw.y) * (acc[m][n][3] + bias));
                *(u32x2*)(Abuf + (size_t)tok * 512 + c) = w;
            }
        }
    }
    __syncthreads();
}

__device__ __forceinline__ void phase_mixers(const Args& a, ldsp lds, int G, int vcu) {
    unsigned char* ws = a.ws;
    const bf16* Z = (const bf16*)(ws + WS_Z);
    for (int it = vcu; it < 512; it += G) {
        const int qh = it & 1, hk = (it >> 1) & 1, nb = (it >> 2) & 63, b = it >> 8;
        attn_item(Z, (const bf16*)(ws + WS_KVC), a.in[I_SINK], (bf16*)(ws + WS_O), lds, b, nb, hk, qh);
    }
    for (int it = vcu; it < 256; it += G) {
        gmlp_item(Z, a.in[I_LNG], a.in[I_LNB], (const bf16*)(ws + WS_WST), a.in[I_GBS], (bf16*)(ws + WS_A), lds, it >> 1, it & 1);
    }
}

#define KI_BEFORE(ka, ia, kb, ib) (((ka) > (kb)) || ((ka) == (kb) && (ia) < (ib)))
#define KI_CAS(K, I, p, q) do { const bool sw_ = KI_BEFORE(K[q], I[q], K[p], I[p]); const float kp_ = sw_ ? K[q] : K[p], kq_ = sw_ ? K[p] : K[q]; const int ip_ = sw_ ? I[q] : I[p], iq_ = sw_ ? I[p] : I[q]; \
        K[p] = kp_; I[p] = ip_; K[q] = kq_; I[q] = iq_; } while (0)
#define KI_SORT8(K, I) do { KI_CAS(K, I, 0, 1); KI_CAS(K, I, 2, 3); KI_CAS(K, I, 4, 5); KI_CAS(K, I, 6, 7); \
        KI_CAS(K, I, 0, 2); KI_CAS(K, I, 1, 3); KI_CAS(K, I, 4, 6); KI_CAS(K, I, 5, 7); \
        KI_CAS(K, I, 1, 2); KI_CAS(K, I, 5, 6); KI_CAS(K, I, 0, 4); KI_CAS(K, I, 3, 7); \
        KI_CAS(K, I, 1, 5); KI_CAS(K, I, 2, 6); KI_CAS(K, I, 1, 4); KI_CAS(K, I, 3, 6); \
        KI_CAS(K, I, 2, 4); KI_CAS(K, I, 3, 5); KI_CAS(K, I, 3, 4); } while (0)
#define KI_MERGE8(KA, IA, KB, IB) do { \
        _Pragma("unroll") for (int r_ = 0; r_ < 8; ++r_) { const bool tb_ = KI_BEFORE(KB[7 - r_], IB[7 - r_], KA[r_], IA[r_]); KA[r_] = tb_ ? KB[7 - r_] : KA[r_]; IA[r_] = tb_ ? IB[7 - r_] : IA[r_]; } \
        KI_CAS(KA, IA, 0, 4); KI_CAS(KA, IA, 1, 5); KI_CAS(KA, IA, 2, 6); KI_CAS(KA, IA, 3, 7); \
        KI_CAS(KA, IA, 0, 2); KI_CAS(KA, IA, 1, 3); KI_CAS(KA, IA, 4, 6); KI_CAS(KA, IA, 5, 7); \
        KI_CAS(KA, IA, 0, 1); KI_CAS(KA, IA, 2, 3); KI_CAS(KA, IA, 4, 5); KI_CAS(KA, IA, 6, 7); } while (0)
__device__ __forceinline__ void router_item(const Args& a, ldsp lds, int it) {
    const int tid = threadIdx.x, lane = tid & 63, wave = __builtin_amdgcn_readfirstlane(tid >> 6), fr = lane & 15, fq = lane >> 4;
    unsigned char* ws = a.ws;
    const int t0 = it * 64, b = t0 >> 13;
    const bf16* X1 = (const bf16*)(ws + WS_X1); const float* adaf = (const float*)(ws + WS_ADAF) + b * 6144;
    const float* g2 = a.in[I_N2G]; unsigned char* H2 = ws + WS_H2;
    {
        f32x4 gm[2][2], sh[2][2];
#pragma unroll
        for (int j = 0; j < 2; ++j)
#pragma unroll
            for (int h = 0; h < 2; ++h) {
                const int c = 8 * lane + 512 * j + 4 * h;
                const f32x4 gg = *(const f32x4*)(g2 + c), sc = *(const f32x4*)(adaf + 4 * 1024 + c);
                gm[j][h] = gg * (sc + 1.f); sh[j][h] = *(const f32x4*)(adaf + 3 * 1024 + c);
            }
#pragma unroll
        for (int half = 0; half < 2; ++half) {
            f32x4 x[4][2][2];
#pragma unroll
            for (int tt = 0; tt < 4; ++tt)
#pragma unroll
                for (int j = 0; j < 2; ++j) {
                    const u32x4 w = *(const u32x4*)(X1 + (size_t)(t0 + wave * 8 + half * 4 + tt) * D + 8 * lane + 512 * j);
                    x[tt][j][0] = (f32x4){bflo(w.x), bfhi(w.x), bflo(w.y), bfhi(w.y)}; x[tt][j][1] = (f32x4){bflo(w.z), bfhi(w.z), bflo(w.w), bfhi(w.w)};
                }
#pragma unroll
            for (int tt = 0; tt < 4; ++tt) {
                const int row = wave * 8 + half * 4 + tt, tok = t0 + row;
                float ss = 0.f;
#pragma unroll
                for (int j = 0; j < 2; ++j)
#pragma unroll
                    for (int h = 0; h < 2; ++h) { const f32x4 v = x[tt][j][h]; ss += (v[0] * v[0] + v[1] * v[1]) + (v[2] * v[2] + v[3] * v[3]); }
                const float r = rsqrtf(wave_sum(ss) * (1.f / D) + 1e-6f);
#pragma unroll
                for (int j = 0; j < 2; ++j) {
                    const f32x4 h0 = (x[tt][j][0] * r) * gm[j][0] + sh[j][0], h1 = (x[tt][j][1] * r) * gm[j][1] + sh[j][1];
                    u32x4 w; w.x = cvtpk(h0[0], h0[1]); w.y = cvtpk(h0[2], h0[3]); w.z = cvtpk(h1[0], h1[1]); w.w = cvtpk(h1[2], h1[3]);
                    { int f0 = 0, f1 = 0;
                      f0 = __builtin_amdgcn_cvt_pk_fp8_f32(h0[0], h0[1], f0, false); f0 = __builtin_amdgcn_cvt_pk_fp8_f32(h0[2], h0[3], f0, true);
                      f1 = __builtin_amdgcn_cvt_pk_fp8_f32(h1[0], h1[1], f1, false); f1 = __builtin_amdgcn_cvt_pk_fp8_f32(h1[2], h1[3], f1, true);
                      u32x2 w8; w8.x = (unsigned)f0; w8.y = (unsigned)f1; *(u32x2*)(H2 + (size_t)tok * D + 8 * lane + 512 * j) = w8; }
                    const int kc = lane + 64 * j;
                    *(LAS u32x4*)(lds + kc * 1024 + ((row ^ (kc & 7)) * 16)) = w;
                }
            }
        }
    }
    __syncthreads();
    f32x4 acc[4][2];
#pragma unroll
    for (int m = 0; m < 4; ++m)
#pragma unroll
        for (int n = 0; n < 2; ++n) acc[m][n] = (f32x4){0.f, 0.f, 0.f, 0.f};
    const bf16* RwT = (const bf16*)(ws + WS_RWT) + (size_t)(32 * wave + fr) * D + 8 * fq;
#pragma unroll 8
    for (int ks = 0; ks < 32; ++ks) {
        const int kc = 4 * ks + fq;
        bf16x8 af[4], bfr[2];
#pragma unroll
        for (int n = 0; n < 2; ++n) bfr[n] = *(const bf16x8*)(RwT + (size_t)(16 * n) * D + 32 * ks);
#pragma unroll
        for (int m = 0; m < 4; ++m) af[m] = *(LAS const bf16x8*)(lds + kc * 1024 + (((16 * m + fr) ^ (kc & 7)) * 16));
#pragma unroll
        for (int m = 0; m < 4; ++m)
#pragma unroll
            for (int n = 0; n < 2; ++n) acc[m][n] = mfma16(af[m], bfr[n], acc[m][n]);
    }
    __syncthreads();
    LAS float* LG = (LAS float*)lds;
#pragma unroll
    for (int m = 0; m < 4; ++m)
#pragma unroll
        for (int n = 0; n < 2; ++n)
#pragma unroll
            for (int reg = 0; reg < 4; ++reg) LG[(32 * wave + 16 * n + fr) * 65 + 16 * m + 4 * fq + reg] = acc[m][n][reg];
    __syncthreads();
    LAS float* CK = (LAS float*)(lds + 69632); LAS int* CI = (LAS int*)(lds + 69632 + 16384);
    const float* rb = a.in[I_RB];
    float bk[8]; int bi[8];
#pragma unroll
    for (int q = 0; q < 4; ++q) {
        float gk[8]; int gi[8];
#pragma unroll
        for (int j = 0; j < 8; ++j) { const int e = 32 * wave + 8 * q + j; gk[j] = sigmoid_f(LG[e * 65 + lane]) + rb[e]; gi[j] = e; }
        KI_SORT8(gk, gi);
        if (q == 0) {
#pragma unroll
            for (int j = 0; j < 8; ++j) { bk[j] = gk[j]; bi[j] = gi[j]; }
        } else KI_MERGE8(bk, bi, gk, gi);
    }
#pragma unroll
    for (int r = 0; r < 8; ++r) { CK[(wave * 8 + r) * 64 + lane] = bk[r]; CI[(wave * 8 + r) * 64 + lane] = bi[r]; }
    __syncthreads();
#define RT_LEVEL(lvl) do { if ((wave & (2 * (lvl) - 1)) == 0) { float ok_[8]; int oi_[8]; \
            _Pragma("unroll") for (int r = 0; r < 8; ++r) { ok_[r] = CK[((wave + (lvl)) * 8 + r) * 64 + lane]; oi_[r] = CI[((wave + (lvl)) * 8 + r) * 64 + lane]; } \
            KI_MERGE8(bk, bi, ok_, oi_); \
            if ((lvl) < 4) { _Pragma("unroll") for (int r = 0; r < 8; ++r) { CK[(wave * 8 + r) * 64 + lane] = bk[r]; CI[(wave * 8 + r) * 64 + lane] = bi[r]; } } } \
        __syncthreads(); } while (0)
    RT_LEVEL(1); RT_LEVEL(2); RT_LEVEL(4);
#undef RT_LEVEL
    LAS unsigned* hist = (LAS unsigned*)(lds + 102400); LAS unsigned* hbase = hist + 256;
    if (tid < 256) hist[tid] = 0u;
    __syncthreads();
    unsigned* cnt = (unsigned*)(ws + WS_CTL) + CW_CNT; int* list = (int*)(ws + WS_LIST); float* gatew = (float*)(ws + WS_GATEW);
    unsigned rank[8];
    if (wave == 0) {
        const int tok = t0 + lane;
        float sel[8], ssum = 0.f;
#pragma unroll
        for (int r = 0; r < 8; ++r) { sel[r] = sigmoid_f(LG[bi[r] * 65 + lane]); ssum += sel[r]; }
#pragma unroll
        for (int r = 0; r < 8; ++r) rank[r] = __hip_atomic_fetch_add(&hist[bi[r]], 1u, __ATOMIC_RELAXED, __HIP_MEMORY_SCOPE_WORKGROUP);
        const float sc = 2.5f / ssum;
        f32x4 g0 = {sel[0] * sc, sel[1] * sc, sel[2] * sc, sel[3] * sc}, g1 = {sel[4] * sc, sel[5] * sc, sel[6] * sc, sel[7] * sc};
        *(f32x4*)(gatew + tok * 8) = g0; *(f32x4*)(gatew + tok * 8 + 4) = g1;
    }
    __syncthreads();
    if (tid < 256) { const unsigned h = hist[tid]; if (h) hbase[tid] = atomicAdd(cnt + 32 * tid, h); }
    __syncthreads();
    if (wave == 0) {
        const int tok = t0 + lane;
#pragma unroll
        for (int r = 0; r < 8; ++r) list[(size_t)bi[r] * LISTCAP + hbase[bi[r]] + rank[r]] = tok * NSLOT + r;
    }
    __syncthreads();
}

__device__ __forceinline__ void moe_tile(const Args& a, ldsp lds, int e, int mt, int nrows, int ntl) {
    const int tid = threadIdx.x, lane = tid & 63, wave = __builtin_amdgcn_readfirstlane(tid >> 6), fr = lane & 15, fq = lane >> 4;
    unsigned char* ws = a.ws;
    constexpr int ASTG = 0, BSTG = 16384, ACT = 49152, SLOTS = 114688, GWO = 115200;
    const bf16* H2 = (const bf16*)(ws + WS_H2);
    const float* Wg = (e < NEXP) ? a.in[I_EG] + (size_t)e * 262144 : a.in[I_SG];
    const float* Wu = (e < NEXP) ? a.in[I_EU] + (size_t)e * 262144 : a.in[I_SU];
    const float* Wd = (e < NEXP) ? a.in[I_ED] + (size_t)e * 262144 : a.in[I_SD];
    if (tid < 128) {
        int slot = -1; float gw = 0.f;
        if (tid < nrows) {
            if (e < NEXP) { slot = ((const int*)(ws + WS_LIST))[(size_t)e * LISTCAP + mt * 128 + tid]; gw = ((const float*)(ws + WS_GATEW))[(slot / NSLOT) * 8 + (slot % NSLOT)]; }
            else { slot = (mt * 128 + tid) * NSLOT + 8; gw = 1.f; }
        }
        ((LAS int*)(lds + SLOTS))[tid] = slot; ((LAS float*)(lds + GWO))[tid] = gw;
    }
    __syncthreads();
    const int wr = wave >> 2, wc = wave & 3;
    const int arow = tid >> 2, akc = tid & 3;
    const int aslot = ((LAS const int*)(lds + SLOTS))[arow];
    const bf16* asrc = H2 + (size_t)((aslot < 0 ? 0 : aslot) / NSLOT) * D + akc * 8;
    const int awr = ASTG + akc * 2048 + ((arow ^ (akc << 1)) * 16);
    const int ng = lane, kq = wave;
    const float* srcg = Wg + (size_t)(4 * kq) * 256 + 4 * ng;
    const float* srcu = Wu + (size_t)(4 * kq) * 256 + 4 * ng;
    const float* src2 = Wd + (size_t)(4 * kq) * 1024 + 4 * ng;
    int bwr2[4];
#pragma unroll
    for (int i = 0; i < 4; ++i) { const int rho2 = 4 * ng + i; bwr2[i] = BSTG + (kq >> 1) * 4096 + ((rho2 ^ ((rho2 >> 3) & 3)) * 16) + (kq & 1) * 8; }
    int ard[4], brd[4], rowm[4];
#pragma unroll
    for (int m = 0; m < 4; ++m) { rowm[m] = 64 * wr + 16 * m + fr; ard[m] = fq * 2048 + ((rowm[m] ^ (fq << 1)) * 16); }
#pragma unroll
    for (int n = 0; n < 4; ++n) { const int rho = 64 * wc + 16 * n + fr; brd[n] = BSTG + fq * 4096 + ((rho ^ ((rho >> 3) & 3)) * 16); }
    bf16* contrib = (bf16*)(ws + WS_CONTRIB);
    f32x4 acc[4][4];
    f32x4 B0[4], B1[4], B2[4], B3[4]; u32x4 A0, A1, A2, A3;
#define G1_LOAD(s_, BR, AR) do { const int s0_ = (s_); const int ss_ = s0_ < 63 ? s0_ : 63; \
        const float* bp_ = ((ss_ < 32) ? srcg : srcu) + (size_t)(32 * (ss_ & 31)) * 256; \
        AR = *(const u32x4*)(asrc + 32 * (ss_ & 31)); \
        _Pragma("unroll") for (int j = 0; j < 4; ++j) BR[j] = *(const f32x4*)(bp_ + j * 256); } while (0)
#define G1_WRITE(BR, AR, buf_) do { \
        *(LAS u32x4*)(lds + (buf_) * 8192 + awr) = AR; \
        _Pragma("unroll") for (int i = 0; i < 4; ++i) { u32x2 w_; w_.x = cvtpk(BR[0][i], BR[1][i]); w_.y = cvtpk(BR[2][i], BR[3][i]); *(LAS u32x2*)(lds + (buf_) * 16384 + bwr2[i]) = w_; } } while (0)
#define MOE_COMPUTE(abase_, buf_) do { \
        bf16x8 af_[4], bf_[4]; \
        _Pragma("unroll") for (int m = 0; m < 4; ++m) af_[m] = *(LAS const bf16x8*)(lds + (abase_) + ard[m]); \
        _Pragma("unroll") for (int n = 0; n < 4; ++n) bf_[n] = *(LAS const bf16x8*)(lds + (buf_) * 16384 + brd[n]); \
        _Pragma("unroll") for (int m = 0; m < 4; ++m) _Pragma("unroll") for (int n = 0; n < 4; ++n) acc[m][n] = mfma16(bf_[n], af_[m], acc[m][n]); } while (0)
#define ACC_ZERO() do { _Pragma("unroll") for (int m = 0; m < 4; ++m) _Pragma("unroll") for (int n = 0; n < 4; ++n) acc[m][n] = (f32x4){0.f, 0.f, 0.f, 0.f}; } while (0)
    G1_LOAD(0, B0, A0); G1_LOAD(1, B1, A1); G1_LOAD(2, B2, A2);
    G1_WRITE(B0, A0, 0);
    __syncthreads();
    for (int s = 0; s < 64; s += 4) {
        if ((s & 31) == 0) ACC_ZERO();
        G1_LOAD(s + 3, B3, A3); MOE_COMPUTE(0, 0); G1_WRITE(B1, A1, 1); __syncthreads();
        G1_LOAD(s + 4, B0, A0); MOE_COMPUTE(8192, 1); G1_WRITE(B2, A2, 0); __syncthreads();
        G1_LOAD(s + 5, B1, A1); MOE_COMPUTE(0, 0); G1_WRITE(B3, A3, 1); __syncthreads();
        G1_LOAD(s + 6, B2, A2); MOE_COMPUTE(8192, 1);
        if (s == 28) {
#pragma unroll
            for (int m = 0; m < 4; ++m)
#pragma unroll
                for (int n = 0; n < 4; ++n) {
                    const f32x4 gv = acc[m][n];
                    u32x2 w; w.x = cvtpk(silu_f(gv[0]), silu_f(gv[1])); w.y = cvtpk(silu_f(gv[2]), silu_f(gv[3]));
                    const int kc = 8 * wc + 2 * n + (fq >> 1);
                    *(LAS u32x2*)(lds + ACT + kc * 2048 + ((rowm[m] ^ ((kc & 3) << 1)) * 16) + (fq & 1) * 8) = w;
                }
        } else if (s == 60) {
#pragma unroll
            for (int m = 0; m < 4; ++m)
#pragma unroll
                for (int n = 0; n < 4; ++n) {
                    const f32x4 uv = acc[m][n];
                    const int kc = 8 * wc + 2 * n + (fq >> 1);
                    LAS u32x2* ap = (LAS u32x2*)(lds + ACT + kc * 2048 + ((rowm[m] ^ ((kc & 3) << 1)) * 16) + (fq & 1) * 8);
                    const u32x2 g = *ap;
                    u32x2 w; w.x = cvtpk(bflo(g.x) * uv[0], bfhi(g.x) * uv[1]); w.y = cvtpk(bflo(g.y) * uv[2], bfhi(g.y) * uv[3]);
                    *ap = w;
                }
        }
        G1_WRITE(B0, A0, 0); __syncthreads();
    }
#define G2_LOAD(s_, BR) do { const int s0_ = (s_); const int t_ = s0_ < 31 ? s0_ : 31; \
        const float* bp_ = src2 + (size_t)(32 * (t_ & 7)) * 1024 + 256 * (t_ >> 3); \
        _Pragma("unroll") for (int j = 0; j < 4; ++j) BR[j] = *(const f32x4*)(bp_ + j * 1024); } while (0)
#define G2_WRITE(BR, buf_) do { \
        _Pragma("unroll") for (int i = 0; i < 4; ++i) { u32x2 w_; w_.x = cvtpk(BR[0][i], BR[1][i]); w_.y = cvtpk(BR[2][i], BR[3][i]); *(LAS u32x2*)(lds + (buf_) * 16384 + bwr2[i]) = w_; } } while (0)
    G2_LOAD(0, B0); G2_LOAD(1, B1); G2_LOAD(2, B2);
    G2_WRITE(B0, 0);
    __syncthreads();
    for (int s = 0; s < 32; s += 4) {
        if ((s & 7) == 0) ACC_ZERO();
        G2_LOAD(s + 3, B3); MOE_COMPUTE(ACT + (s & 7) * 8192, 0); G2_WRITE(B1, 1); __syncthreads();
        G2_LOAD(s + 4, B0); MOE_COMPUTE(ACT + ((s + 1) & 7) * 8192, 1); G2_WRITE(B2, 0); __syncthreads();
        G2_LOAD(s + 5, B1); MOE_COMPUTE(ACT + ((s + 2) & 7) * 8192, 0); G2_WRITE(B3, 1); __syncthreads();
        G2_LOAD(s + 6, B2); MOE_COMPUTE(ACT + ((s + 3) & 7) * 8192, 1);
        if ((s & 7) == 4) {
            const int q = s >> 3;
#pragma unroll
            for (int m = 0; m < 4; ++m) {
                const int slot = ((LAS const int*)(lds + SLOTS))[rowm[m]]; const float gw = ((LAS const float*)(lds + GWO))[rowm[m]];
                if (slot >= 0) {
                    bf16* cp = contrib + (size_t)slot * D + q * 256 + 64 * wc + 4 * fq;
#pragma unroll
                    for (int n = 0; n < 4; ++n) { const f32x4 v = acc[m][n] * gw; u32x2 w; w.x = cvtpk(v[0], v[1]); w.y = cvtpk(v[2], v[3]); *(u32x2*)(cp + 16 * n) = w; }
                }
            }
        }
        G2_WRITE(B0, 0); __syncthreads();
    }
#undef G1_LOAD
#undef G1_WRITE
#undef G2_LOAD
#undef G2_WRITE
#undef ACC_ZERO
#undef MOE_COMPUTE
}

__device__ __forceinline__ const float* uni_ptr(const float* p) {
    const unsigned long long v = (unsigned long long)p;
    const unsigned lo = __builtin_amdgcn_readfirstlane((unsigned)v), hi = __builtin_amdgcn_readfirstlane((unsigned)(v >> 32));
    return (const float*)(((unsigned long long)hi << 32) | lo);
}
__device__ __forceinline__ void moe_decode(int j, int total, LAS const int* pre, LAS const int* cnt, int& e, int& mt, int& nrows) {
    if (j < total) {
        int lo = 0, hi = NEXP;
        while (hi - lo > 1) { const int mid = (lo + hi) >> 1; if (pre[mid] <= j) lo = mid; else hi = mid; }
        e = lo; mt = j - pre[e]; const int c = cnt[e] - mt * 128; nrows = c < 128 ? c : 128;
    } else { e = NEXP; mt = j - total; nrows = 128; }
}
__device__ __forceinline__ void phase_moe(const Args& a, ldsp lds, int G, int vcu) {
    const int tid = threadIdx.x, lane = tid & 63, wave = __builtin_amdgcn_readfirstlane(tid >> 6), fr = lane & 15, fq = lane >> 4;
    unsigned char* ws = a.ws;
    constexpr int ASTG = 0, BSTG = 16384, ACT = 49152, SLOTS = 114688, GWO = SLOTS + MOE_MAXT * 512;
    static_assert(GWO + MOE_MAXT * 512 <= SCR_BYTES, "slot lists overflow the scratch image");
    LAS int* pre = (LAS int*)(lds + MISC_OFF + 512);
    LAS int* cnt = (LAS int*)(lds + MISC_OFF + 2048);
    LAS int* wtot = (LAS int*)(lds + MISC_OFF + 3072);
    int myv = 0, myx = 0;
    if (tid < NEXP) {
        const int c = (int)((const unsigned*)(ws + WS_CTL) + CW_CNT)[32 * tid];
        cnt[tid] = c; myv = (c + 127) >> 7; myx = myv;
#pragma unroll
        for (int o = 1; o < 64; o <<= 1) { const int y = __shfl_up(myx, o); if (lane >= o) myx += y; }
        if (lane == 63) wtot[wave] = myx;
    }
    __syncthreads();
    if (tid < NEXP) { int base = 0; for (int w = 0; w < wave; ++w) base += wtot[w]; pre[tid] = base + myx - myv; if (tid == NEXP - 1) pre[NEXP] = base + myx; }
    __syncthreads();
    const int total = pre[NEXP], ntiles = total + T / 128;
    if (vcu >= ntiles) return;
    for (int tt = tid >> 7; vcu + tt * G < ntiles; tt += 4) {
        const int r = tid & 127; int e_, mt_, nr_; moe_decode(vcu + tt * G, total, pre, cnt, e_, mt_, nr_);
        int slot_ = -1; float gw_ = 0.f;
        if (r < nr_) { if (e_ < NEXP) { slot_ = ((const int*)(ws + WS_LIST))[(size_t)e_ * LISTCAP + mt_ * 128 + r]; gw_ = ((const float*)(ws + WS_GATEW))[(slot_ / NSLOT) * 8 + (slot_ % NSLOT)]; }
                       else { slot_ = (mt_ * 128 + r) * NSLOT + 8; gw_ = 1.f; } }
        ((LAS int*)(lds + SLOTS))[tt * 128 + r] = slot_; ((LAS float*)(lds + GWO))[tt * 128 + r] = gw_;
    }
    __syncthreads();
    if (wave >= 4) {
        const int lt = tid - 256;
        const unsigned char* H2 = ws + WS_H2;
        const int arow = lt >> 1, ahalf = lt & 1;
        const int awr0 = ASTG + (2 * ahalf) * 2048 + ((arow ^ ((2 * ahalf) << 1)) * 16), awr1 = ASTG + (2 * ahalf + 1) * 2048 + ((arow ^ ((2 * ahalf + 1) << 1)) * 16);
        const int ng = lt & 63, kq = lt >> 6;
        const int loff256 = (8 * kq) * 256 + 4 * ng, loff1024 = (8 * kq) * 1024 + 4 * ng;
        const int bw = BSTG + kq * 4096 + (4 * ng) * 16, bx = ((4 * ng) >> 3) & 3;
        f32x4 B0[8], B1[8], B2[8], B3[8]; u32x4 A0, A1, A2, A3, A4, A5, A6, A7;
        int j = vcu, it = 0, e, mt, nrows;
        moe_decode(j, total, pre, cnt, e, mt, nrows);
#ifndef MOE_AUX
#define MOE_AUX 16
#endif
#define W_RSRC(eo_, pe_, ps_) __builtin_amdgcn_make_buffer_rsrc((void*)uni_ptr(((eo_) < NEXP) ? a.in[pe_] + (size_t)(eo_) * 262144 : a.in[ps_]), 0, 1 << 20, 0x00020000)
        const int eu0 = __builtin_amdgcn_readfirstlane(e);
        __amdgpu_buffer_rsrc_t Wg = W_RSRC(eu0, I_EG, I_SG), Wu = W_RSRC(eu0, I_EU, I_SU), Wd = W_RSRC(eu0, I_ED, I_SD);
        int aslot = ((LAS const int*)(lds + SLOTS))[arow];
        const unsigned char* asrc = H2 + (size_t)((aslot < 0 ? 0 : aslot) / NSLOT) * D + 16 * ahalf;
#define L_LOADB1(WG_, WU_, WD_, s_, BR) do { const int ss_ = (s_); const int t_ = ss_ - 64; \
            const __amdgpu_buffer_rsrc_t r_ = (ss_ < 32) ? (WG_) : (ss_ < 64) ? (WU_) : (WD_); \
            const int vo_ = (ss_ < 64) ? 4 * loff256 : 4 * loff1024; \
            const int so_ = (ss_ < 32) ? (32 * ss_) * 1024 : (ss_ < 64) ? (32 * (ss_ - 32)) * 1024 : (32 * (t_ & 7)) * 4096 + 1024 * (t_ >> 3); \
            const int str_ = (ss_ < 64) ? 1024 : 4096;        \
            _Pragma("unroll") for (int jj = 0; jj < 8; ++jj) BR[jj] = __builtin_bit_cast(f32x4, __builtin_amdgcn_raw_buffer_load_b128(r_, vo_, so_ + jj * str_, MOE_AUX)); } while (0)
#define L_LOADA4(AP_, s_, R0, R1, R2, R3) do { const int ss_ = (s_); const int sa_ = ss_ < 60 ? ss_ : 60; const unsigned char* p_ = (AP_) + 32 * (sa_ & 31); \
            R0 = *(const u32x4*)(p_); R1 = *(const u32x4*)(p_ + 32); R2 = *(const u32x4*)(p_ + 64); R3 = *(const u32x4*)(p_ + 96); } while (0)
#define L_LOAD2(s_, BR) do { const int s0_ = (s_); const int t_ = s0_ < 31 ? s0_ : 31; \
            const int so_ = (32 * (t_ & 7)) * 4096 + 1024 * (t_ >> 3); \
            _Pragma("unroll") for (int jj = 0; jj < 8; ++jj) BR[jj] = __builtin_bit_cast(f32x4, __builtin_amdgcn_raw_buffer_load_b128(Wd, 4 * loff1024, so_ + jj * 4096, MOE_AUX)); } while (0)
#define L_WRITEB(BR, buf_) do { _Pragma("unroll") for (int i = 0; i < 4; ++i) { u32x4 w_; w_.x = cvtpk(BR[0][i], BR[1][i]); w_.y = cvtpk(BR[2][i], BR[3][i]); w_.z = cvtpk(BR[4][i], BR[5][i]); w_.w = cvtpk(BR[6][i], BR[7][i]); \
            *(LAS u32x4*)(lds + (buf_) * 16384 + bw + ((i ^ bx) * 16)) = w_; } } while (0)
#define L_CVT8(w_, o0, o1) do { const f32x2_t l_ = __builtin_amdgcn_cvt_pk_f32_fp8((int)(w_), false), h_ = __builtin_amdgcn_cvt_pk_f32_fp8((int)(w_), true); o0 = cvtpk(l_[0], l_[1]); o1 = cvtpk(h_[0], h_[1]); } while (0)
#define L_WRITEA(AR, buf_) do { u32x4 c0_, c1_; L_CVT8(AR.x, c0_.x, c0_.y); L_CVT8(AR.y, c0_.z, c0_.w); L_CVT8(AR.z, c1_.x, c1_.y); L_CVT8(AR.w, c1_.z, c1_.w); \
            *(LAS u32x4*)(lds + (buf_) * 8192 + awr0) = c0_; *(LAS u32x4*)(lds + (buf_) * 8192 + awr1) = c1_; } while (0)
        L_LOADA4(asrc, 0, A0, A1, A2, A3); L_LOADB1(Wg, Wu, Wd, 0, B0); L_LOADB1(Wg, Wu, Wd, 1, B1); L_LOADB1(Wg, Wu, Wd, 2, B2); L_LOADA4(asrc, 4, A4, A5, A6, A7);
        for (;;) {
            L_WRITEA(A0, 0); L_WRITEB(B0, 0);
            __syncthreads();
            for (int s = 0; s < 64; s += 8) {
                L_LOADB1(Wg, Wu, Wd, s + 3, B3); L_WRITEA(A1, 1); L_WRITEB(B1, 1); __syncthreads();
                L_LOADB1(Wg, Wu, Wd, s + 4, B0); L_WRITEA(A2, 0); L_WRITEB(B2, 0); __syncthreads();
                L_LOADB1(Wg, Wu, Wd, s + 5, B1); L_WRITEA(A3, 1); L_WRITEB(B3, 1); __syncthreads();
                L_LOADB1(Wg, Wu, Wd, s + 6, B2); L_LOADA4(asrc, s + 8, A0, A1, A2, A3); L_WRITEA(A4, 0); L_WRITEB(B0, 0); __syncthreads();
                L_LOADB1(Wg, Wu, Wd, s + 7, B3); L_WRITEA(A5, 1); L_WRITEB(B1, 1); __syncthreads();
                L_LOADB1(Wg, Wu, Wd, s + 8, B0); L_WRITEA(A6, 0); L_WRITEB(B2, 0); __syncthreads();
                L_LOADB1(Wg, Wu, Wd, s + 9, B1); L_WRITEA(A7, 1); L_WRITEB(B3, 1); __syncthreads();
                L_LOADB1(Wg, Wu, Wd, s + 10, B2); L_LOADA4(asrc, s + 12, A4, A5, A6, A7); L_WRITEA(A0, 0); L_WRITEB(B0, 0); __syncthreads();
            }
            for (int s = 0; s < 28; s += 4) {
                L_LOAD2(s + 3, B3); L_WRITEB(B1, 1); __syncthreads();
                L_LOAD2(s + 4, B0); L_WRITEB(B2, 0); __syncthreads();
                L_LOAD2(s + 5, B1); L_WRITEB(B3, 1); __syncthreads();
                L_LOAD2(s + 6, B2); L_WRITEB(B0, 0); __syncthreads();
            }
            const int jn = j + G; const bool more = jn < ntiles;
            int en = e, mtn = mt, nrn = nrows; if (more) moe_decode(jn, total, pre, cnt, en, mtn, nrn);
            const int eun = __builtin_amdgcn_readfirstlane(en);
            const __amdgpu_buffer_rsrc_t Wgn = W_RSRC(eun, I_EG, I_SG), Wun = W_RSRC(eun, I_EU, I_SU), Wdn = W_RSRC(eun, I_ED, I_SD);
            const int aslotn = more ? ((LAS const int*)(lds + SLOTS))[(it + 1) * 128 + arow] : aslot;
            const unsigned char* asrcn = H2 + (size_t)((aslotn < 0 ? 0 : aslotn) / NSLOT) * D + 16 * ahalf;
            L_LOAD2(31, B3); L_WRITEB(B1, 1); __syncthreads();
            L_LOADB1(Wgn, Wun, Wdn, 0, B0); L_LOADA4(asrcn, 0, A0, A1, A2, A3); L_WRITEB(B2, 0); __syncthreads();
            L_LOADB1(Wgn, Wun, Wdn, 1, B1); L_WRITEB(B3, 1); __syncthreads();
            L_LOADB1(Wgn, Wun, Wdn, 2, B2); L_LOADA4(asrcn, 4, A4, A5, A6, A7); __syncthreads();
            if (!more) break;
            j = jn; ++it; e = en; mt = mtn; nrows = nrn; Wg = Wgn; Wu = Wun; Wd = Wdn; aslot = aslotn; asrc = asrcn;
        }
#undef L_LOADB1
#undef W_RSRC
#undef L_LOADA4
#undef L_CVT8
#undef L_LOAD2
#undef L_WRITEB
#undef L_WRITEA
    } else {
        const int wr = wave >> 1, wc = wave & 1;
        int rowm[4], ard[4], brd[8];
#pragma unroll
        for (int m = 0; m < 4; ++m) { rowm[m] = 64 * wr + 16 * m + fr; ard[m] = fq * 2048 + ((rowm[m] ^ (fq << 1)) * 16); }
#pragma unroll
        for (int n = 0; n < 8; ++n) { const int rho = 128 * wc + 16 * n + fr; brd[n] = BSTG + fq * 4096 + ((rho ^ ((rho >> 3) & 3)) * 16); }
        unsigned char* contrib = ws + WS_CONTRIB;
        f32x4 acc[4][8];
#define M_COMPUTE(abase_, buf_) do { \
            _Pragma("unroll") for (int nh = 0; nh < 2; ++nh) { bf16x8 af_[4], bf_[4]; \
                _Pragma("unroll") for (int m = 0; m < 4; ++m) af_[m] = *(LAS const bf16x8*)(lds + (abase_) + ard[m]); \
                _Pragma("unroll") for (int n = 0; n < 4; ++n) bf_[n] = *(LAS const bf16x8*)(lds + (buf_) * 16384 + brd[4 * nh + n]); \
                _Pragma("unroll") for (int m = 0; m < 4; ++m) _Pragma("unroll") for (int n = 0; n < 4; ++n) acc[m][4 * nh + n] = mfma16(bf_[n], af_[m], acc[m][4 * nh + n]); } } while (0)
#define M_ZERO() do { _Pragma("unroll") for (int m = 0; m < 4; ++m) _Pragma("unroll") for (int n = 0; n < 8; ++n) acc[m][n] = (f32x4){0.f, 0.f, 0.f, 0.f}; } while (0)
        int it = 0;
        for (int j = vcu; j < ntiles; j += G, ++it) {
            __syncthreads();
            for (int s = 0; s < 64; s += 4) {
                if ((s & 31) == 0) M_ZERO();
                M_COMPUTE(0, 0); __syncthreads();
                M_COMPUTE(8192, 1); __syncthreads();
                M_COMPUTE(0, 0); __syncthreads();
                M_COMPUTE(8192, 1);
                if (s == 28) {
#pragma unroll
                    for (int m = 0; m < 4; ++m)
#pragma unroll
                        for (int n = 0; n < 8; ++n) {
                            const f32x4 gv = acc[m][n];
                            u32x2 w; w.x = cvtpk(silu_f(gv[0]), silu_f(gv[1])); w.y = cvtpk(silu_f(gv[2]), silu_f(gv[3]));
                            const int kc = 16 * wc + 2 * n + (fq >> 1);
                            *(LAS u32x2*)(lds + ACT + kc * 2048 + ((rowm[m] ^ ((kc & 3) << 1)) * 16) + (fq & 1) * 8) = w;
                        }
                } else if (s == 60) {
#pragma unroll
                    for (int m = 0; m < 4; ++m)
#pragma unroll
                        for (int n = 0; n < 8; ++n) {
                            const f32x4 uv = acc[m][n];
                            const int kc = 16 * wc + 2 * n + (fq >> 1);
                            LAS u32x2* ap = (LAS u32x2*)(lds + ACT + kc * 2048 + ((rowm[m] ^ ((kc & 3) << 1)) * 16) + (fq & 1) * 8);
                            const u32x2 g = *ap;
                            u32x2 w; w.x = cvtpk(bflo(g.x) * uv[0], bfhi(g.x) * uv[1]); w.y = cvtpk(bflo(g.y) * uv[2], bfhi(g.y) * uv[3]);
                            *ap = w;
                        }
                }
                __syncthreads();
            }
            for (int s = 0; s < 32; s += 4) {
                if ((s & 7) == 0) M_ZERO();
                M_COMPUTE(ACT + (s & 7) * 8192, 0); __syncthreads();
                M_COMPUTE(ACT + ((s + 1) & 7) * 8192, 1); __syncthreads();
                M_COMPUTE(ACT + ((s + 2) & 7) * 8192, 0); __syncthreads();
                M_COMPUTE(ACT + ((s + 3) & 7) * 8192, 1);
                if ((s & 7) == 4) {
                    const int q = s >> 3;
#pragma unroll
                    for (int m = 0; m < 4; ++m) {
                        const int slot = ((LAS const int*)(lds + SLOTS))[it * 128 + rowm[m]]; const float gw = ((LAS const float*)(lds + GWO))[it * 128 + rowm[m]];
                        if (slot >= 0) {
                            unsigned char* cp = contrib + (size_t)slot * D + q * 256 + 128 * wc + 4 * fq;
                            const float gs = gw * CONTRIB_SCALE;
#pragma unroll
                            for (int n = 0; n < 8; ++n) { const f32x4 v = acc[m][n] * gs; int w = 0; w = __builtin_amdgcn_cvt_pk_fp8_f32(v[0], v[1], w, false); w = __builtin_amdgcn_cvt_pk_fp8_f32(v[2], v[3], w, true); *(int*)(cp + 16 * n) = w; }
                        }
                    }
                }
                __syncthreads();
            }
        }
#undef M_COMPUTE
#undef M_ZERO
    }
}

__device__ __forceinline__ void phase_combine(const Args& a, int G) {
    const int tid = threadIdx.x, lane = tid & 63, wave = __builtin_amdgcn_readfirstlane(tid >> 6), blk = blockIdx.x;
    unsigned char* ws = a.ws;
    const bf16* X1 = (const bf16*)(ws + WS_X1); const unsigned char* contrib = ws + WS_CONTRIB; const float* fg = a.in[I_FG];
    for (int t = blk * NWAVES + wave; t < T; t += G * NWAVES) {
        const float* g2 = (const float*)(ws + WS_ADAF) + (t >> 13) * 6144 + 5 * 1024;
        const int c = 16 * lane;
        float sm[16];
#pragma unroll
        for (int i = 0; i < 16; ++i) sm[i] = 0.f;
#pragma unroll
        for (int k = 0; k < NSLOT; ++k) {
            const u32x4 w = *(const u32x4*)(contrib + ((size_t)t * NSLOT + k) * D + c);
#pragma unroll
            for (int q = 0; q < 4; ++q) {
                const f32x2_t lo = __builtin_amdgcn_cvt_pk_f32_fp8((int)w[q], false), hi = __builtin_amdgcn_cvt_pk_f32_fp8((int)w[q], true);
                sm[4 * q] += lo[0]; sm[4 * q + 1] += lo[1]; sm[4 * q + 2] += hi[0]; sm[4 * q + 3] += hi[1];
            }
        }
        const u32x4 xa = *(const u32x4*)(X1 + (size_t)t * D + c), xb = *(const u32x4*)(X1 + (size_t)t * D + c + 8);
        const float x1[16] = {bflo(xa.x), bfhi(xa.x), bflo(xa.y), bfhi(xa.y), bflo(xa.z), bfhi(xa.z), bflo(xa.w), bfhi(xa.w), bflo(xb.x), bfhi(xb.x), bflo(xb.y), bfhi(xb.y), bflo(xb.z), bfhi(xb.z), bflo(xb.w), bfhi(xb.w)};
        f32x4 xv[4]; float ss = 0.f;
#pragma unroll
        for (int h = 0; h < 4; ++h) {
            const f32x4 gg = *(const f32x4*)(g2 + c + 4 * h);
            const f32x4 xx = {x1[4 * h], x1[4 * h + 1], x1[4 * h + 2], x1[4 * h + 3]};
            const f32x4 mv = {sm[4 * h], sm[4 * h + 1], sm[4 * h + 2], sm[4 * h + 3]};
            const f32x4 v = xx + gg * (mv * (1.f / CONTRIB_SCALE)); xv[h] = v; ss += (v[0] * v[0] + v[1] * v[1]) + (v[2] * v[2] + v[3] * v[3]);
        }
        const float r = rsqrtf(wave_sum(ss) * (1.f / D) + 1e-6f);
#pragma unroll
        for (int h = 0; h < 4; ++h) *(f32x4*)(a.out + (size_t)t * D + c + 4 * h) = (xv[h] * r) * *(const f32x4*)(fg + c + 4 * h);
    }
}

constexpr int NPH = 9;
#ifndef N_LAUNCHES
#define N_LAUNCHES 1
#endif
__global__ void __launch_bounds__(NWAVES * 64, 2) mega(Args a) {
    extern __shared__ __attribute__((aligned(16))) unsigned char lds_raw[];
    ldsp lds = (ldsp)lds_raw;
    const int tid = threadIdx.x, G = gridDim.x, bx = blockIdx.x;
    int vcu = (G % 8 == 0) ? (bx % 8) * (G / 8) + bx / 8 : bx;
    unsigned char* ws = a.ws;
    for (int u = tid; u < (LDS_BYTES - MISC_OFF) / 4; u += NWAVES * 64) ((LAS unsigned*)(lds + MISC_OFF))[u] = 0u;
    __syncthreads();
    volatile LAS unsigned* MISC = (volatile LAS unsigned*)(lds + MISC_OFF);
    XcdBarrier bar; bar.bar = (unsigned*)(ws + WS_CTL) + CW_BAR; bar.x = 0; bar.st = nullptr;
    if (N_LAUNCHES == 1) {
        bar = xcd_barrier_post((unsigned*)(ws + WS_CTL) + CW_BAR, MISC + 8);
        if (tid == 0) MISC[16] = atomicAdd((unsigned*)(ws + WS_CTL) + CW_XRANK + 64 * bar.x, 1u);
    }
    const int lo = a.ph_lo, hi = a.ph_hi;
#ifndef PH_MASK
#define PH_MASK 0x1ff
#endif
#define IN(k) (((PH_MASK >> (k)) & 1) && lo <= (k) && (k) < hi)
#define SEAM(k) do { if (IN(k) && IN((k) + 1)) xcd_barrier(bar); } while (0)
#ifndef PH_DUP
#define PH_DUP -1
#endif
#define REP(k) for (int rep_ = 0; rep_ < ((PH_DUP == (k)) ? 2 : 1); ++rep_)
    if (IN(0)) REP(0) { phase_prep(a, lds, G); } SEAM(0);
    if (N_LAUNCHES == 1 && IN(0) && IN(1)) {
        unsigned basex = 0;
        for (unsigned j = 0; j < bar.x; ++j) basex += xb_ld(&bar.bar[XB_XCNT(j)]);
        vcu = (int)(basex + MISC[16]);
    }
    if (IN(1)) REP(1) { phase_hnorm(a, lds, G); } SEAM(1);
    if (IN(2)) REP(2) {
        pg8::Gemm g{(const pg8::bf16_t*)(ws + WS_H), (const pg8::bf16_t*)(ws + WS_WINT), MH, DIN, D};
        WinOrder S; S.init(G, bx);
        EpiWin E{(bf16*)(ws + WS_Z), (bf16*)(ws + WS_KVC), (const float*)(ws + WS_ROPE)};
        pg8::gemm_phase<EpiWin, WinOrder, true, true>(lds, g, S, E);
    } SEAM(2);
    if (IN(3)) REP(3) { phase_mixers(a, lds, G, vcu); } SEAM(3);
    if (IN(4)) REP(4) {
        { pg8::Gemm g{(const pg8::bf16_t*)(ws + WS_A), (const pg8::bf16_t*)(ws + WS_WAT), T, D, 512};
          pg8::StaticOrder S; S.init(T, D, G, bx);
          EpiMergeA E{(const bf16*)(ws + WS_Z), (bf16*)(ws + WS_Y)};
          pg8::gemm_phase<EpiMergeA, pg8::StaticOrder, true, true>(lds, g, S, E); }
        { pg8::Gemm g{(const pg8::bf16_t*)(ws + WS_O), (const pg8::bf16_t*)(ws + WS_WBT), T, D, 512};
          pg8::StaticOrder S; S.init(T, D, G, bx);
          EpiMergeB E{(const bf16*)(ws + WS_Z), (bf16*)(ws + WS_Y)};
          pg8::gemm_phase<EpiMergeB, pg8::StaticOrder, true, true>(lds, g, S, E); }
    } SEAM(4);
    if (IN(5)) REP(5) {
        pg8::Gemm g{(const pg8::bf16_t*)(ws + WS_Y), (const pg8::bf16_t*)(ws + WS_WOT), T, D, D};
        pg8::StaticOrder S; S.init(T, D, G, bx);
        EpiWo E{a.in[I_X], (const float*)(ws + WS_ADAF), (bf16*)(ws + WS_X1)};
        pg8::gemm_phase<EpiWo, pg8::StaticOrder, true, true>(lds, g, S, E);
    } SEAM(5);
    if (IN(6)) { for (int it = vcu; it < T / 64; it += G) router_item(a, lds, it); } SEAM(6);
    if (IN(7)) REP(7) { phase_moe(a, lds, G, vcu); } SEAM(7);
    if (IN(8)) REP(8) { phase_combine(a, G); }
#undef IN
#undef SEAM
}

extern "C" void kernel_launch(void* const* d_in, const int* in_sizes, int n_in, void* d_out, int out_size, void* d_ws, size_t ws_size, hipStream_t stream) {
    static int grid = 0;
    if (grid == 0) {
        if (n_in != 26 || out_size != T * D || ws_size < WS_END) { fprintf(stderr, "kernel_launch: unexpected shapes (n_in %d, out %d, ws %zu)\n", n_in, out_size, ws_size); grid = -1; return; }
        int dev = 0, cus = 0, per_cu = 0;
        (void)hipGetDevice(&dev); (void)hipDeviceGetAttribute(&cus, hipDeviceAttributeMultiprocessorCount, dev);
        (void)hipFuncSetAttribute((const void*)mega, hipFuncAttributeMaxDynamicSharedMemorySize, LDS_BYTES);
        (void)hipOccupancyMaxActiveBlocksPerMultiprocessor(&per_cu, (const void*)mega, NWAVES * 64, LDS_BYTES);
        (void)hipGetLastError();
        if (per_cu < 1) { fprintf(stderr, "kernel_launch: occupancy query says %d blocks per CU\n", per_cu); per_cu = 1; }
        if (cus * MOE_MAXT < T * 8 / 128 + NEXP + T / 128) { fprintf(stderr, "kernel_launch: %d CUs are too few for the expert tile tables\n", cus); grid = -1; return; }
        grid = cus;
    }
    if (grid < 0) return;
    (void)hipMemsetAsync((char*)d_ws + WS_CTL, 0, CTL_ZERO_BYTES, stream);
    Args a{};
    for (int i = 0; i < 26; ++i) a.in[i] = (const float*)d_in[i];
    a.out = (float*)d_out; a.ws = (unsigned char*)d_ws;
    if (N_LAUNCHES == 1) {
        a.ph_lo = 0; a.ph_hi = NPH;
        void* kargs[] = {&a};
        hipError_t e = hipLaunchCooperativeKernel((const void*)mega, dim3(grid), dim3(NWAVES * 64), kargs, LDS_BYTES, stream);
        if (e != hipSuccess) fprintf(stderr, "kernel_launch: cooperative launch failed: %s (grid %d)\n", hipGetErrorString(e), grid);
    } else {
#ifndef HOST_DUP
#define HOST_DUP -1
#endif
        for (int li = 0; li < NPH; ++li) {
            a.ph_lo = li; a.ph_hi = li + 1;
            hipLaunchKernelGGL(mega, dim3(grid), dim3(NWAVES * 64), LDS_BYTES, stream, a);
            if (li == HOST_DUP) {
                if (li == 6) (void)hipMemsetAsync((char*)d_ws + WS_CTL, 0, CTL_ZERO_BYTES, stream);
                hipLaunchKernelGGL(mega, dim3(grid), dim3(NWAVES * 64), LDS_BYTES, stream, a);
            }
        }
    }
}
```

```cpp
#include <hip/hip_runtime.h>
#include <cstdio>
#include <cstdint>
#include <type_traits>
namespace pg8 {
#define PG8_LAS __attribute__((address_space(3)))
typedef unsigned short bf16_t;
typedef short bf16x8 __attribute__((ext_vector_type(8)));
typedef float f32x4 __attribute__((ext_vector_type(4)));
typedef unsigned u32x4 __attribute__((ext_vector_type(4)));
constexpr int BM = 256, BK = 64, HALF = 128, HTB = HALF * BK * 2  , STAGE_BYTES = 8 * HTB, NXCD = 8, WGM = 8;

__host__ __device__ __forceinline__ int lds_byte(int r, int c) { const int st = (r >> 4) * 2 + (c >> 5), rr = r & 15, cc = c & 31, ob = rr * 64 + cc * 2; return st * 1024 + (ob ^ (((ob >> 9) & 1) << 5)); }
__host__ __device__ __forceinline__ void stage_rc(int b, int& R, int& C) { const int st = b / 1024, sb = b % 1024, swz = sb ^ (((sb >> 9) & 1) << 5); R = (st >> 1) * 16 + swz / 64; C = (st & 1) * 32 + (swz % 64) / 2; }
__host__ __device__ __forceinline__ int perm32(int rho) { const int n = rho >> 4, i = rho & 15; return 8 * (i >> 2) + 4 * n + (i & 3); }

struct Unit { int pm, pn; };
struct Gemm { const bf16_t* A; const bf16_t* Bt; int M, N, K; };

struct StaticOrder {
    int nM, nN, nwg, G, c;
    __host__ __device__ void init(int M, int N, int G_, int c_) { nM = M / BM; nN = N / BM; nwg = nM * nN; G = G_; c = c_; }
    __host__ __device__ bool next(int i, Unit& u) const {
        const long L = (long)i * G + c; if (L >= nwg) return false;
        int wgid = (int)L; { const int q = nwg / NXCD, r = nwg % NXCD, xcd = wgid % NXCD, off = wgid / NXCD; wgid = (xcd < r ? xcd * (q + 1) : r * (q + 1) + (xcd - r) * q) + off; }
        const int nig = WGM * nN, gid = wgid / nig, fm = gid * WGM, gsz = (nM - fm) < WGM ? (nM - fm) : WGM;
        u.pm = fm + ((wgid % nig) % gsz); u.pn = (wgid % nig) / gsz; return true;
    }
    __device__ __forceinline__ void a_ready(const Unit&) const {}
    __device__ __forceinline__ void done(const Unit&) const {}
};

__device__ __forceinline__ unsigned cvt_pk_bf16(float lo, float hi) { unsigned r; asm volatile("v_cvt_pk_bf16_f32 %0, %1, %2" : "=v"(r) : "v"(lo), "v"(hi)); return r; }
template <class Epi, class Sched, bool ALIGN_EPI = false, bool SP2 = false>
__device__ __forceinline__ void gemm_phase(PG8_LAS unsigned char* lds, const Gemm g, const Sched& S, const Epi& E) {
    const int tid = threadIdx.x, wid = __builtin_amdgcn_readfirstlane(tid >> 6), lane = tid & 63, wr = wid >> 2, wc = wid & 3, fr = lane & 15, fq = lane >> 4;
    const int K = g.K, nt = K / BK;
    unsigned voffA[2], voffB[2];
#pragma unroll
    for (int i = 0; i < 2; ++i) { int R, C; stage_rc(tid * 16 + i * 8192, R, C); const int Rb = Epi::PERM ? ((R & ~31) + perm32(R & 31)) : R;
        voffA[i] = (unsigned)(R * K + C) * 2u; voffB[i] = (unsigned)(Rb * K + C) * 2u; }
    const size_t kstep = (size_t)(BK * 2);
    const size_t hstep = (size_t)HALF * K * 2;
    const size_t tstep = 2 * hstep;
    const unsigned ldsw = (unsigned)wid * 1024u;
    const int aoff = lds_byte(wr * 64 + fr, fq * 8), boff = lds_byte(wc * 32 + fr, fq * 8);
#define PG8_SA(b, h) (((b) * 2 + (h)) * HTB)
#define PG8_SB(b, h) ((4 + (b) * 2 + (h)) * HTB)
#define PG8_STAGE(bufoff, gbase, voff) do { _Pragma("unroll") for (int _i = 0; _i < 2; ++_i) \
        __builtin_amdgcn_global_load_lds((const unsigned*)((const char*)(gbase) + (voff)[_i]), (PG8_LAS unsigned*)(lds + (bufoff) + ldsw + _i * 8192), 16, 0, 0); } while (0)
#define PG8_LDA(dst, b, h) do { _Pragma("unroll") for (int m = 0; m < 4; ++m) _Pragma("unroll") for (int k = 0; k < 2; ++k) dst[m][k] = *(const PG8_LAS bf16x8*)(lds + PG8_SA(b, h) + aoff + m * 2048 + k * 1024); } while (0)
#define PG8_LDB(dst, b, h) do { _Pragma("unroll") for (int n = 0; n < 2; ++n) _Pragma("unroll") for (int k = 0; k < 2; ++k) dst[n][k] = *(const PG8_LAS bf16x8*)(lds + PG8_SB(b, h) + boff + n * 2048 + k * 1024); } while (0)
#define PG8_MMA(ai, bj, At, Bt) do { __builtin_amdgcn_s_setprio(1); _Pragma("unroll") for (int m = 0; m < 4; ++m) _Pragma("unroll") for (int n = 0; n < 2; ++n) _Pragma("unroll") for (int k = 0; k < 2; ++k) \
        acc[ai][bj][m][n] = __builtin_amdgcn_mfma_f32_16x16x32_bf16(Bt[n][k], At[m][k], acc[ai][bj][m][n], 0, 0, 0); __builtin_amdgcn_s_setprio(0); } while (0)
#define PG8_WAIT_V(n) asm volatile("s_waitcnt vmcnt(" #n ")" ::: "memory")
#define PG8_WAIT_L(n) asm volatile("s_waitcnt lgkmcnt(" #n ")" ::: "memory")
#define PG8_BAR __builtin_amdgcn_s_barrier()
#define PG8_SCHED __builtin_amdgcn_sched_barrier(0)
    Unit cur, nxt; int ui = 0;
    if (!S.next(0, cur)) return;
    f32x4 acc[2][2][4][2];
#pragma unroll
    for (int a = 0; a < 2; ++a)
#pragma unroll
        for (int b = 0; b < 2; ++b)
#pragma unroll
            for (int m = 0; m < 4; ++m)
#pragma unroll
                for (int n = 0; n < 2; ++n) acc[a][b][m][n] = (f32x4){0.f, 0.f, 0.f, 0.f};
    bf16x8 At[4][2], B0[2][2], B1[2][2];
    const char* cA = (const char*)g.A + (size_t)cur.pm * tstep; const char* cB = (const char*)g.Bt + (size_t)cur.pn * tstep;
    S.a_ready(cur);
    if constexpr (SP2) {
        PG8_STAGE(PG8_SB(0, 0), cB, voffB); PG8_STAGE(PG8_SB(0, 1), cB + hstep, voffB); PG8_STAGE(PG8_SA(0, 0), cA, voffA); PG8_STAGE(PG8_SA(0, 1), cA + hstep, voffA);
        if (wr == 1) PG8_BAR;
        PG8_WAIT_V(2); PG8_BAR;
        PG8_STAGE(PG8_SB(1, 0), cB + kstep, voffB); PG8_STAGE(PG8_SA(1, 0), cA + kstep, voffA); PG8_STAGE(PG8_SB(1, 1), cB + hstep + kstep, voffB);
        PG8_WAIT_V(6); PG8_BAR;
    } else {
        PG8_STAGE(PG8_SB(0, 0), cB, voffB); PG8_STAGE(PG8_SA(0, 0), cA, voffA); PG8_STAGE(PG8_SB(0, 1), cB + hstep, voffB); PG8_STAGE(PG8_SA(0, 1), cA + hstep, voffA);
        if (wr == 1) PG8_BAR;
        PG8_WAIT_V(4); PG8_BAR;
        PG8_STAGE(PG8_SB(1, 0), cB + kstep, voffB); PG8_STAGE(PG8_SA(1, 0), cA + kstep, voffA); PG8_STAGE(PG8_SB(1, 1), cB + hstep + kstep, voffB);
        PG8_WAIT_V(6); PG8_BAR;
    }
    for (;;) {
        const bool has_next = S.next(ui + 1, nxt);
        const char* nA = has_next ? (const char*)g.A + (size_t)nxt.pm * tstep : cA; const char* nB = has_next ? (const char*)g.Bt + (size_t)nxt.pn * tstep : cB;
        for (int t = 0; t < nt; t += 2) {
            const bool last = (t == nt - 2);
            const char* a1 = cA + (size_t)(t + 1) * kstep;
            const char* a2 = last ? nA : cA + (size_t)(t + 2) * kstep; const char* b2 = last ? nB : cB + (size_t)(t + 2) * kstep;
            const char* a3 = a2 + kstep; const char* b3 = b2 + kstep;
            if (last && has_next) S.a_ready(nxt);
            if constexpr (SP2) {
            PG8_LDB(B0, 0, 0); PG8_LDB(B1, 0, 1); PG8_SCHED; PG8_LDA(At, 0, 0); PG8_STAGE(PG8_SA(1, 1), a1 + hstep, voffA);
            PG8_WAIT_V(8); PG8_WAIT_L(0); PG8_BAR; PG8_MMA(0, 0, At, B0); PG8_MMA(0, 1, At, B1); PG8_BAR; PG8_SCHED;
            PG8_LDA(At, 0, 1); PG8_STAGE(PG8_SB(0, 0), b2, voffB); PG8_STAGE(PG8_SB(0, 1), b2 + hstep, voffB); PG8_STAGE(PG8_SA(0, 0), a2, voffA);
            PG8_WAIT_V(8); PG8_WAIT_L(0); PG8_BAR; PG8_MMA(1, 0, At, B0); PG8_MMA(1, 1, At, B1); PG8_BAR; PG8_SCHED;
            PG8_LDB(B0, 1, 0); PG8_LDB(B1, 1, 1); PG8_SCHED; PG8_LDA(At, 1, 0); PG8_STAGE(PG8_SA(0, 1), a2 + hstep, voffA);
            PG8_WAIT_V(8); PG8_WAIT_L(0); PG8_BAR; PG8_MMA(0, 0, At, B0); PG8_MMA(0, 1, At, B1); PG8_BAR; PG8_SCHED;
            PG8_LDA(At, 1, 1); PG8_STAGE(PG8_SB(1, 0), b3, voffB); PG8_STAGE(PG8_SB(1, 1), b3 + hstep, voffB); PG8_STAGE(PG8_SA(1, 0), a3, voffA);
            PG8_WAIT_V(8); PG8_WAIT_L(0); PG8_BAR; PG8_MMA(1, 0, At, B0); PG8_MMA(1, 1, At, B1); PG8_BAR; PG8_SCHED;
            } else {
            PG8_LDB(B0, 0, 0); PG8_SCHED; PG8_LDA(At, 0, 0); PG8_STAGE(PG8_SA(1, 1), a1 + hstep, voffA);
            PG8_WAIT_L(8); PG8_BAR; PG8_WAIT_L(0); PG8_MMA(0, 0, At, B0); PG8_BAR; PG8_SCHED;
            PG8_LDB(B1, 0, 1); PG8_STAGE(PG8_SB(0, 0), b2, voffB);
            PG8_BAR; PG8_WAIT_L(0); PG8_MMA(0, 1, At, B1); PG8_BAR;
            PG8_LDA(At, 0, 1); PG8_STAGE(PG8_SA(0, 0), a2, voffA);
            PG8_BAR; PG8_WAIT_L(0); PG8_MMA(1, 0, At, B0); PG8_BAR; PG8_SCHED;
            PG8_STAGE(PG8_SB(0, 1), b2 + hstep, voffB);
            PG8_WAIT_V(6); PG8_BAR; PG8_MMA(1, 1, At, B1); PG8_BAR;
            PG8_LDB(B0, 1, 0); PG8_SCHED; PG8_LDA(At, 1, 0); PG8_STAGE(PG8_SA(0, 1), a2 + hstep, voffA);
            PG8_WAIT_L(8); PG8_BAR; PG8_WAIT_L(0); PG8_MMA(0, 0, At, B0); PG8_BAR; PG8_SCHED;
            PG8_LDB(B1, 1, 1); PG8_STAGE(PG8_SB(1, 0), b3, voffB);
            PG8_BAR; PG8_WAIT_L(0); PG8_MMA(0, 1, At, B1); PG8_BAR;
            PG8_LDA(At, 1, 1); PG8_STAGE(PG8_SA(1, 0), a3, voffA);
            PG8_BAR; PG8_WAIT_L(0); PG8_MMA(1, 0, At, B0); PG8_BAR; PG8_SCHED;
            PG8_STAGE(PG8_SB(1, 1), b3 + hstep, voffB);
            PG8_WAIT_V(6); PG8_BAR; PG8_MMA(1, 1, At, B1); PG8_BAR;
            }
        }
        if constexpr (ALIGN_EPI) { if (wr == 0) PG8_BAR; }
        if constexpr (!Epi::AFTER_DRAIN) { E(acc, cur, wr, wc, fr, fq); S.done(cur); }
        if (!has_next) break;
#pragma unroll
        for (int a = 0; a < 2; ++a)
#pragma unroll
            for (int b = 0; b < 2; ++b)
#pragma unroll
                for (int m = 0; m < 4; ++m)
#pragma unroll
                    for (int n = 0; n < 2; ++n) acc[a][b][m][n] = (f32x4){0.f, 0.f, 0.f, 0.f};
        cur = nxt; cA = nA; cB = nB; ++ui;
        if constexpr (ALIGN_EPI) { if (wr == 1) PG8_BAR; }
    }
    PG8_WAIT_V(0);
    if constexpr (!ALIGN_EPI) { if (wr == 0) PG8_BAR; }
    PG8_BAR;
    if constexpr (Epi::AFTER_DRAIN) { E.fused(acc, cur, wr, wc, fr, fq, lds, wid, lane); S.done(cur); }
#undef PG8_SA
#undef PG8_SB
#undef PG8_STAGE
#undef PG8_LDA
#undef PG8_LDB
#undef PG8_MMA
#undef PG8_WAIT_V
#undef PG8_WAIT_L
#undef PG8_BAR
#undef PG8_SCHED
}
}
#define GAS __attribute__((address_space(1)))
#define LAS __attribute__((address_space(3)))
typedef unsigned short bf16;
typedef unsigned v4u __attribute__((ext_vector_type(4)));
typedef float f32x4 __attribute__((ext_vector_type(4)));
typedef short bf16x8 __attribute__((ext_vector_type(8)));
typedef GAS unsigned gu32;
typedef GAS unsigned long long gu64;
#define RLX_AGENT __ATOMIC_RELAXED, __HIP_MEMORY_SCOPE_AGENT
#define LDS_WAIT() asm volatile("s_waitcnt lgkmcnt(0)" ::: "memory")
#define VM_WAIT() asm volatile("s_waitcnt vmcnt(0)" ::: "memory")
__device__ __forceinline__ unsigned long long rt() { return __builtin_amdgcn_s_memrealtime(); }
__device__ __forceinline__ unsigned f2bf(float f) { unsigned u = __builtin_bit_cast(unsigned, f); return (u + 0x7fffu + ((u >> 16) & 1u)) >> 16; }
__device__ __forceinline__ unsigned pk2(float lo, float hi) { return f2bf(lo) | (f2bf(hi) << 16); }

#define XB_TMO      128
#define XB_XCNT(j)  (256  + 64 * (j))
#define XB_XSUB(j)  (1280 + 64 * (j))
#define XB_XGEN(j)  (2304 + 64 * (j))
#define XB_TOP      3328
#define XB_TOPGEN   3392
#define XCD_BAR_WORDS 3456
#define XB_SPIN_CAP (1u << 18)

__device__ __forceinline__ unsigned xb_ld(unsigned* p)              { return __hip_atomic_load(p, __ATOMIC_RELAXED, __HIP_MEMORY_SCOPE_AGENT); }
__device__ __forceinline__ unsigned xb_add(unsigned* p, unsigned v) { return __hip_atomic_fetch_add(p, v, __ATOMIC_RELAXED, __HIP_MEMORY_SCOPE_AGENT); }
__device__ __forceinline__ unsigned xb_xcc_id() { return (unsigned)__builtin_amdgcn_s_getreg((3 << 11) | 20) & 0xFu; }
#define XB_SPIN(cond, bar) do { unsigned _sp = 0; while (cond) { __builtin_amdgcn_s_sleep(1); \
    if ((++_sp & 255u) == 0u) { if (xb_ld(&(bar)[XB_TMO])) break; if (_sp > XB_SPIN_CAP) { atomicAdd(&(bar)[XB_TMO], 1u); break; } } } } while (0)

struct XcdBarrier {
    unsigned* bar; unsigned x;
    volatile LAS unsigned* st;
};

__device__ __forceinline__ XcdBarrier xcd_barrier_post(unsigned* bar, volatile LAS unsigned* st) {
    XcdBarrier b; b.bar = bar; b.x = xb_xcc_id(); b.st = st;
    if (threadIdx.x == 0) (void)xb_add(&bar[XB_XCNT(b.x)], 1u);
    return b;
}
__device__ __forceinline__ void xcd_barrier_complete(unsigned* bar, unsigned x, unsigned& nloc, unsigned& nx) {
    const unsigned G = gridDim.x * gridDim.y * gridDim.z;
    unsigned sum, cnt, mine, sp = 0u;
    for (;;) {
        sum = 0u; cnt = 0u; mine = 0u;
#pragma unroll
        for (unsigned j = 0; j < 16; ++j) { const unsigned c = xb_ld(&bar[XB_XCNT(j)]); sum += c; cnt += (c > 0u) ? 1u : 0u; mine = (j == x) ? c : mine; }
        if (sum == G) break;
        __builtin_amdgcn_s_sleep(1);
        if ((++sp & 255u) == 0u) { if (xb_ld(&bar[XB_TMO])) break; if (sp > XB_SPIN_CAP) { atomicAdd(&bar[XB_TMO], 1u); break; } }
    }
    nloc = mine > 0u ? mine : 1u; nx = cnt > 0u ? cnt : 1u;
}

__device__ __forceinline__ void xcd_barrier(const XcdBarrier& b) {
    asm volatile("s_waitcnt vmcnt(0)" ::: "memory");
    __syncthreads();
    if (threadIdx.x == 0) {
        unsigned* bar = b.bar;
        __builtin_amdgcn_s_waitcnt(0);
        unsigned nloc = b.st[0], nx = b.st[1];
        if (nloc == 0u) { xcd_barrier_complete(bar, b.x, nloc, nx); b.st[0] = nloc; b.st[1] = nx; }
        const unsigned old = xb_add(&bar[XB_XSUB(b.x)], 1u);
        const unsigned gen = old / nloc;
        if (old + 1u == (gen + 1u) * nloc) {
            __builtin_amdgcn_fence(__ATOMIC_RELEASE, "agent");
            asm volatile("s_waitcnt vmcnt(0)" ::: "memory");
            const unsigned og = xb_add(&bar[XB_TOP], 1u);
            const unsigned tg = og / nx;
            if (og + 1u == (tg + 1u) * nx) xb_add(&bar[XB_TOPGEN], 1u);
            else XB_SPIN(xb_ld(&bar[XB_TOPGEN]) == tg, bar);
            __builtin_amdgcn_fence(__ATOMIC_ACQUIRE, "agent");
            xb_add(&bar[XB_XGEN(b.x)], 1u);
            asm volatile("s_waitcnt vmcnt(0)" ::: "memory");
        } else {
            XB_SPIN(xb_ld(&bar[XB_XGEN(b.x)]) == gen, bar);
            __builtin_amdgcn_fence(__ATOMIC_ACQUIRE, "agent");
            asm volatile("s_waitcnt vmcnt(0)" ::: "memory");
        }
    }
    __syncthreads();
}

constexpr int T = 16384, D = 1024, SEQ = 8192, NCTX = 256, TCX = 512, DIN = 3840, MH = T + TCX;
constexpr int ZU = 0, ZV = 512, ZQ = 1024, ZK = 1536, ZVA = 1664, ZGA = 1792, ZGB = 2816;
constexpr int NEXP = 256, NSLOT = 9, LISTCAP = 16384, MOE_MAXT = 24;
constexpr float LOG2E = 1.4426950408889634f;
constexpr float QSCALE = 0.125f * LOG2E;
constexpr size_t MiB = 1u << 20;
constexpr size_t WS_CTL = 0, CTL_ZERO_BYTES = 1 * MiB;
constexpr size_t WS_ADAP = 1 * MiB;
constexpr size_t WS_ADAF = 2 * MiB;
constexpr size_t WS_ROPE = 2 * MiB + 128 * 1024;
constexpr size_t WS_WST = 2 * MiB + 256 * 1024;
constexpr size_t WS_RWT = 3 * MiB;
constexpr size_t WS_WINT = 4 * MiB;
constexpr size_t WS_WAT = 12 * MiB, WS_WBT = 13 * MiB, WS_WOT = 14 * MiB;
constexpr size_t WS_KVC = 16 * MiB;
constexpr size_t WS_GATEW = 17 * MiB;
constexpr size_t WS_H = 18 * MiB;
constexpr size_t WS_Z = 52 * MiB;
constexpr size_t WS_A = 172 * MiB, WS_O = 188 * MiB;
constexpr size_t WS_TMP = 204 * MiB;
constexpr size_t WS_Y = 268 * MiB;
constexpr size_t WS_X1 = 300 * MiB;
constexpr size_t WS_H2 = 364 * MiB;
constexpr size_t WS_LIST = 396 * MiB;
constexpr size_t WS_CONTRIB = 414 * MiB;
constexpr float CONTRIB_SCALE = 16.f;
constexpr size_t WS_END = 704 * MiB;
constexpr int CW_BAR = 4096;
constexpr int CW_CNT = 16384;
constexpr int CW_XRANK = 32768;
constexpr int SCR_BYTES = 148480;
constexpr int MISC_OFF = SCR_BYTES;
constexpr int LDS_BYTES = 152 * 1024;
constexpr int NWAVES = 8;

typedef float f32x2_t __attribute__((ext_vector_type(2)));
typedef __bf16 bf16x2_t __attribute__((ext_vector_type(2)));
typedef float f32x16 __attribute__((ext_vector_type(16)));
typedef short s16x4 __attribute__((ext_vector_type(4)));
typedef short v4i16_t __attribute__((ext_vector_type(4)));
typedef unsigned u32x2 __attribute__((ext_vector_type(2)));
typedef unsigned u32x4 __attribute__((ext_vector_type(4)));
typedef LAS unsigned char* ldsp;

__device__ __forceinline__ unsigned cvtpk(float lo, float hi) { f32x2_t v = {lo, hi}; bf16x2_t b = __builtin_convertvector(v, bf16x2_t); return __builtin_bit_cast(unsigned, b); }
__device__ __forceinline__ float bf2f(unsigned short u) { return __uint_as_float((unsigned)u << 16); }
__device__ __forceinline__ float bflo(unsigned w) { return __uint_as_float(w << 16); }
__device__ __forceinline__ float bfhi(unsigned w) { return __uint_as_float(w & 0xffff0000u); }
__device__ __forceinline__ float wave_sum(float v) {
#pragma unroll
    for (int o = 1; o < 64; o <<= 1) v += __shfl_xor(v, o);
    return v;
}
__device__ __forceinline__ float sigmoid_f(float x) { return __builtin_amdgcn_rcpf(1.f + __builtin_amdgcn_exp2f(-x * LOG2E)); }
__device__ __forceinline__ float silu_f(float x) { return x * sigmoid_f(x); }
__device__ __forceinline__ float gelu_f(float x) { const float u = 0.7978845608028654f * (x + 0.044715f * x * x * x); return x * sigmoid_f(2.f * u); }
__device__ __forceinline__ f32x16 mfma32(bf16x8 a, bf16x8 b, f32x16 c) { return __builtin_amdgcn_mfma_f32_32x32x16_bf16(a, b, c, 0, 0, 0); }
__device__ __forceinline__ f32x4 mfma16(bf16x8 a, bf16x8 b, f32x4 c) { return __builtin_amdgcn_mfma_f32_16x16x32_bf16(a, b, c, 0, 0, 0); }

struct Args { const float* in[26]; float* out; unsigned char* ws; int ph_lo, ph_hi; };
enum { I_X = 0, I_C, I_CTX, I_CCTX, I_ADAW, I_ADAB, I_N1G, I_N2G, I_WIN, I_LNG, I_LNB, I_GWS, I_GBS, I_SINK, I_WA, I_WB, I_WO, I_RW, I_RB, I_EG, I_EU, I_ED, I_SG, I_SU, I_SD, I_FG };

__device__ __forceinline__ void p0_transpose_item(const float* W, int K, int N, bf16* WT, LAS float* scr, int item, int lane) {
    const int nblk = N / 32, kb = item / nblk, nb = item % nblk, k0 = 64 * kb, n0 = 32 * nb;
#pragma unroll 8
    for (int i = 0; i < 32; ++i) { const int kk = 2 * i + (lane >> 5); scr[kk * 33 + (lane & 31)] = W[(size_t)(k0 + kk) * N + n0 + (lane & 31)]; }
    LDS_WAIT(); asm volatile("" ::: "memory");
    const int c = lane & 7;
#pragma unroll
    for (int j = 0; j < 4; ++j) { const int n = (lane >> 3) + 8 * j; const LAS float* s = scr + (8 * c) * 33 + n;
        v4u o; o.x = pk2(s[0 * 33], s[1 * 33]); o.y = pk2(s[2 * 33], s[3 * 33]); o.z = pk2(s[4 * 33], s[5 * 33]); o.w = pk2(s[6 * 33], s[7 * 33]);
        *(GAS v4u*)(WT + (size_t)(n0 + n) * K + k0 + 8 * c) = o; }
    LDS_WAIT(); asm volatile("" ::: "memory");
}

__device__ __forceinline__ void phase_prep(const Args& a, ldsp lds, int G) {
    const int tid = threadIdx.x, lane = tid & 63, wave = __builtin_amdgcn_readfirstlane(tid >> 6), blk = blockIdx.x;
    unsigned char* ws = a.ws;
    if (blk < 192) {
        const int cb = blk % 24, kc = blk / 24, col = cb * 256 + lane * 4, k0 = kc * 128 + wave * 16;
        const float* c = a.in[I_C]; const float* cc = a.in[I_CCTX]; const float* aw = a.in[I_ADAW];
        f32x4 a0 = {0.f, 0.f, 0.f, 0.f}, a1 = a0, a2 = a0;
#pragma unroll 4
        for (int k = 0; k < 16; ++k) {
            const int kk = k0 + k;
            const float s0 = silu_f(c[kk]), s1 = silu_f(c[1024 + kk]), s2 = silu_f(cc[kk]);
            const f32x4 w = *(const f32x4*)(aw + (size_t)kk * 6144 + col);
            a0 += w * s0; a1 += w * s1; a2 += w * s2;
        }
        LAS float* red = (LAS float*)lds;
        *(LAS f32x4*)(red + (wave * 3 + 0) * 256 + lane * 4) = a0;
        *(LAS f32x4*)(red + (wave * 3 + 1) * 256 + lane * 4) = a1;
        *(LAS f32x4*)(red + (wave * 3 + 2) * 256 + lane * 4) = a2;
        __syncthreads();
        float* adap = (float*)(ws + WS_ADAP);
        for (int idx = tid; idx < 768; idx += 512) {
            const int v = idx >> 8, cl = idx & 255; float s = 0.f;
#pragma unroll
            for (int w = 0; w < 8; ++w) s += red[(w * 3 + v) * 256 + cl];
            adap[(size_t)(kc * 3 + v) * 6144 + cb * 256 + cl] = s;
        }
        __syncthreads();
    }
    {
        LAS float* scr = (LAS float*)(lds + wave * 8704);
        const int gw = blk * NWAVES + wave, NGW = G * NWAVES;
        constexpr int I_1 = 16 * 120, I_2 = 8 * 32, I_3 = 8 * 32, I_4 = 16 * 32, I_5 = 16 * 8;
        for (int it = gw; it < I_1 + I_2 + I_3 + I_4 + I_5; it += NGW) {
            int r = it;
            if (r < I_1) { p0_transpose_item(a.in[I_WIN], 1024, 3840, (bf16*)(ws + WS_WINT), scr, r, lane); continue; } r -= I_1;
            if (r < I_2) { p0_transpose_item(a.in[I_WA], 512, 1024, (bf16*)(ws + WS_WAT), scr, r, lane); continue; } r -= I_2;
            if (r < I_3) { p0_transpose_item(a.in[I_WB], 512, 1024, (bf16*)(ws + WS_WBT), scr, r, lane); continue; } r -= I_3;
            if (r < I_4) { p0_transpose_item(a.in[I_WO], 1024, 1024, (bf16*)(ws + WS_WOT), scr, r, lane); continue; } r -= I_4;
            p0_transpose_item(a.in[I_RW], 1024, 256, (bf16*)(ws + WS_RWT), scr, r, lane);
        }
    }
    {
        const int gt = blk * 512 + tid, NT = G * 512;
        const float* gws = a.in[I_GWS]; bf16* wst = (bf16*)(ws + WS_WST);
        for (int i = gt; i < 8192; i += NT) {
            const f32x4 x0 = *(const f32x4*)(gws + i * 8), x1 = *(const f32x4*)(gws + i * 8 + 4);
            v4u o; o.x = cvtpk(x0[0], x0[1]); o.y = cvtpk(x0[2], x0[3]); o.z = cvtpk(x1[0], x1[1]); o.w = cvtpk(x1[2], x1[3]);
            *(v4u*)(wst + i * 8) = o;
        }
        float* rope = (float*)(ws + WS_ROPE);
        for (int i = gt; i < 2048; i += NT) {
            const int pos = i >> 4, f = i & 15;
            const float inv = __builtin_amdgcn_exp2f(-(float)f * (13.287712379549449f / 16.f));
            const float ang = (float)pos * inv;
            double rev = (double)ang * 0.15915494309189535; rev -= floor(rev);
            rope[pos * 32 + f] = __builtin_amdgcn_cosf((float)rev);
            rope[pos * 32 + 16 + f] = __builtin_amdgcn_sinf((float)rev);
        }
    }
}

__device__ __forceinline__ void phase_hnorm(const Args& a, ldsp lds, int G) {
    const int tid = threadIdx.x, lane = tid & 63, wave = __builtin_amdgcn_readfirstlane(tid >> 6), blk = blockIdx.x;
    unsigned char* ws = a.ws;
    const float* adap = (const float*)(ws + WS_ADAP); const float* adab = a.in[I_ADAB];
    LAS float* modv = (LAS float*)lds;
    for (int idx = tid; idx < 3 * 2048; idx += 512) {
        const int v = idx >> 11, j = idx & 2047; float s = adab[j];
#pragma unroll
        for (int kc = 0; kc < 8; ++kc) s += adap[(size_t)(kc * 3 + v) * 6144 + j];
        modv[idx] = (j >= 1024) ? s + 1.f : s;
    }
    { float* adaf = (float*)(ws + WS_ADAF);
      for (int idx = blk * 512 + tid; idx < 3 * 6144; idx += G * 512) {
          const int v = idx / 6144, j = idx % 6144; float s = adab[j];
#pragma unroll
          for (int kc = 0; kc < 8; ++kc) s += adap[(size_t)(kc * 3 + v) * 6144 + j];
          adaf[idx] = s; } }
    __syncthreads();
    const float* g1 = a.in[I_N1G]; bf16* H = (bf16*)(ws + WS_H);
    for (int t = blk * NWAVES + wave; t < MH; t += G * NWAVES) {
        const float* xr = (t < T) ? a.in[I_X] + (size_t)t * D : a.in[I_CTX] + (size_t)(t - T) * D;
        const int v = (t < T) ? (t >> 13) : 2;
        f32x4 x[4]; float ss = 0.f;
#pragma unroll
        for (int j = 0; j < 4; ++j) { x[j] = *(const f32x4*)(xr + 4 * lane + 256 * j); ss += (x[j][0] * x[j][0] + x[j][1] * x[j][1]) + (x[j][2] * x[j][2] + x[j][3] * x[j][3]); }
        const float r = rsqrtf(wave_sum(ss) * (1.f / D) + 1e-6f);
#pragma unroll
        for (int j = 0; j < 4; ++j) {
            const int col = 4 * lane + 256 * j;
            const f32x4 g = *(const f32x4*)(g1 + col);
            const f32x4 sh = *(LAS f32x4*)(modv + v * 2048 + col), sc = *(LAS f32x4*)(modv + v * 2048 + 1024 + col);
            const f32x4 h = (x[j] * r) * g * sc + sh;
            u32x2 o; o.x = cvtpk(h[0], h[1]); o.y = cvtpk(h[2], h[3]);
            *(u32x2*)(H + (size_t)t * D + col) = o;
        }
    }
}

struct WinOrder {
    pg8::StaticOrder so;
    __device__ void init(int G, int c) { so.init(T, DIN, G, c); }
    __device__ bool next(int i, pg8::Unit& u) const {
        const long L = (long)i * so.G + so.c;
        if (L < 960) return so.next(i, u);
        if (L < 962) { u.pm = 64 + (int)(L - 960); u.pn = 6; return true; }
        return false;
    }
    __device__ __forceinline__ void a_ready(const pg8::Unit&) const {}
    __device__ __forceinline__ void done(const pg8::Unit&) const {}
};
struct EpiWin {
    static constexpr bool PERM = false, AFTER_DRAIN = false;
    bf16* Z; bf16* KVC; const float* rope;
    __device__ __forceinline__ void operator()(const pg8::f32x4 (&acc)[2][2][4][2], const pg8::Unit& u, int wr, int wc, int fr, int fq) const {
        const int row0 = u.pm * 256 + wr * 64 + fr, colb = u.pn * 256 + wc * 32 + 4 * fq, pn = u.pn;
        if (u.pm >= 64) {
#pragma unroll
            for (int ai = 0; ai < 2; ++ai)
#pragma unroll
                for (int m = 0; m < 4; ++m) { bf16* rp = KVC + (size_t)(row0 + ai * 128 + m * 16 - T) * 256 + (colb - ZK);
#pragma unroll
                    for (int bj = 0; bj < 2; ++bj)
#pragma unroll
                        for (int n = 0; n < 2; ++n) { const pg8::f32x4 v = acc[ai][bj][m][n]; u32x2 o; o.x = cvtpk(v[0], v[1]); o.y = cvtpk(v[2], v[3]); *(u32x2*)(rp + bj * 128 + n * 16) = o; } }
            return;
        }
#pragma unroll
        for (int ai = 0; ai < 2; ++ai)
#pragma unroll
            for (int m = 0; m < 4; ++m) {
                const int r = row0 + ai * 128 + m * 16; bf16* rp = Z + (size_t)r * DIN + colb;
                if (pn <= 3) {
#pragma unroll
                    for (int bj = 0; bj < 2; ++bj)
#pragma unroll
                        for (int n = 0; n < 2; ++n) { const pg8::f32x4 v = acc[ai][bj][m][n]; u32x2 o; o.x = cvtpk(gelu_f(v[0]), gelu_f(v[1])); o.y = cvtpk(gelu_f(v[2]), gelu_f(v[3])); *(u32x2*)(rp + bj * 128 + n * 16) = o; }
                } else if (pn <= 6) {
                    const int pos = (wc & 1) ? (r & 63) : ((r & 8191) >> 6);
                    const pg8::f32x4 cs = *(const pg8::f32x4*)(rope + pos * 32 + 4 * fq), sn = *(const pg8::f32x4*)(rope + pos * 32 + 16 + 4 * fq);
                    const float sc = (pn < 6) ? QSCALE : 1.f;
#pragma unroll
                    for (int bj = 0; bj < 2; ++bj) {
                        const pg8::f32x4 x1 = acc[ai][bj][m][0], x2 = acc[ai][bj][m][1];
                        pg8::f32x4 o1, o2;
                        if (pn == 6 && bj == 1) { o1 = x1; o2 = x2; }
                        else { o1 = (x1 * cs - x2 * sn) * sc; o2 = (x2 * cs + x1 * sn) * sc; }
                        u32x2 w1, w2; w1.x = cvtpk(o1[0], o1[1]); w1.y = cvtpk(o1[2], o1[3]); w2.x = cvtpk(o2[0], o2[1]); w2.y = cvtpk(o2[2], o2[3]);
                        *(u32x2*)(rp + bj * 128) = w1; *(u32x2*)(rp + bj * 128 + 16) = w2;
                    }
                } else {
#pragma unroll
                    for (int bj = 0; bj < 2; ++bj)
#pragma unroll
                        for (int n = 0; n < 2; ++n) { const pg8::f32x4 v = acc[ai][bj][m][n]; u32x2 o; o.x = cvtpk(sigmoid_f(v[0]), sigmoid_f(v[1])); o.y = cvtpk(sigmoid_f(v[2]), sigmoid_f(v[3])); *(u32x2*)(rp + bj * 128 + n * 16) = o; }
                }
            }
    }
};
struct EpiMergeA {
    static constexpr bool PERM = true, AFTER_DRAIN = false;
    const bf16* Z; bf16* Y;
    __device__ __forceinline__ void operator()(const pg8::f32x4 (&acc)[2][2][4][2], const pg8::Unit& u, int wr, int wc, int fr, int fq) const {
        const int row0 = u.pm * 256 + wr * 64 + fr, col0 = u.pn * 256 + wc * 32 + 8 * fq;
#pragma unroll
        for (int ai = 0; ai < 2; ++ai)
#pragma unroll
            for (int m = 0; m < 4; ++m) { const int r = row0 + ai * 128 + m * 16;
#pragma unroll
                for (int bj = 0; bj < 2; ++bj) { const int c = col0 + bj * 128;
                    const u32x4 g = *(const u32x4*)(Z + (size_t)r * DIN + ZGA + c);
                    const pg8::f32x4 v0 = acc[ai][bj][m][0], v1 = acc[ai][bj][m][1];
                    u32x4 o;
                    o.x = cvtpk(v0[0] * bflo(g.x), v0[1] * bfhi(g.x)); o.y = cvtpk(v0[2] * bflo(g.y), v0[3] * bfhi(g.y));
                    o.z = cvtpk(v1[0] * bflo(g.z), v1[1] * bfhi(g.z)); o.w = cvtpk(v1[2] * bflo(g.w), v1[3] * bfhi(g.w));
                    *(u32x4*)(Y + (size_t)r * D + c) = o; } }
    }
};
struct EpiMergeB {
    static constexpr bool PERM = true, AFTER_DRAIN = false;
    const bf16* Z; bf16* Y;
    __device__ __forceinline__ void operator()(const pg8::f32x4 (&acc)[2][2][4][2], const pg8::Unit& u, int wr, int wc, int fr, int fq) const {
        const int row0 = u.pm * 256 + wr * 64 + fr, col0 = u.pn * 256 + wc * 32 + 8 * fq;
#pragma unroll
        for (int ai = 0; ai < 2; ++ai)
#pragma unroll
            for (int m = 0; m < 4; ++m) { const int r = row0 + ai * 128 + m * 16;
#pragma unroll
                for (int bj = 0; bj < 2; ++bj) { const int c = col0 + bj * 128;
                    const u32x4 g = *(const u32x4*)(Z + (size_t)r * DIN + ZGB + c);
                    const u32x4 tp = *(const u32x4*)(Y + (size_t)r * D + c);
                    const pg8::f32x4 t0 = {bflo(tp.x), bfhi(tp.x), bflo(tp.y), bfhi(tp.y)}, t1 = {bflo(tp.z), bfhi(tp.z), bflo(tp.w), bfhi(tp.w)};
                    const pg8::f32x4 v0 = acc[ai][bj][m][0], v1 = acc[ai][bj][m][1];
                    u32x4 o;
                    o.x = cvtpk(t0[0] + v0[0] * bflo(g.x), t0[1] + v0[1] * bfhi(g.x)); o.y = cvtpk(t0[2] + v0[2] * bflo(g.y), t0[3] + v0[3] * bfhi(g.y));
                    o.z = cvtpk(t1[0] + v1[0] * bflo(g.z), t1[1] + v1[1] * bfhi(g.z)); o.w = cvtpk(t1[2] + v1[2] * bflo(g.w), t1[3] + v1[3] * bfhi(g.w));
                    *(u32x4*)(Y + (size_t)r * D + c) = o; } }
    }
};
struct EpiWo {
    static constexpr bool PERM = true, AFTER_DRAIN = false;
    const float* x; const float* adaf; bf16* X1;
    __device__ __forceinline__ void operator()(const pg8::f32x4 (&acc)[2][2][4][2], const pg8::Unit& u, int wr, int wc, int fr, int fq) const {
        const int row0 = u.pm * 256 + wr * 64 + fr, col0 = u.pn * 256 + wc * 32 + 8 * fq;
        const float* g1 = adaf + (u.pm >= 32 ? 6144 : 0) + 2048;
#pragma unroll
        for (int bj = 0; bj < 2; ++bj) { const int c = col0 + bj * 128;
            const pg8::f32x4 ga = *(const pg8::f32x4*)(g1 + c), gb = *(const pg8::f32x4*)(g1 + c + 4);
#pragma unroll
            for (int ai = 0; ai < 2; ++ai)
#pragma unroll
                for (int m = 0; m < 4; ++m) { const int r = row0 + ai * 128 + m * 16;
                    const pg8::f32x4 x0 = *(const pg8::f32x4*)(x + (size_t)r * D + c), x1 = *(const pg8::f32x4*)(x + (size_t)r * D + c + 4);
                    const pg8::f32x4 o0 = x0 + ga * acc[ai][bj][m][0], o1 = x1 + gb * acc[ai][bj][m][1];
                    u32x4 w; w.x = cvtpk(o0[0], o0[1]); w.y = cvtpk(o0[2], o0[3]); w.z = cvtpk(o1[0], o1[1]); w.w = cvtpk(o1[2], o1[3]);
                    *(u32x4*)(X1 + (size_t)r * D + c) = w; } }
    }
};


__device__ __forceinline__ s16x4 vtr(LAS const unsigned char* p) { return __builtin_bit_cast(s16x4, __builtin_amdgcn_ds_read_tr16_b64_v4i16((LAS v4i16_t*)p)); }

__device__ __forceinline__ void attn_item(const bf16* Z, const bf16* KVC, const float* sink, bf16* Obuf, ldsp lds, int b, int nb, int hk, int qh) {
    const int tid = threadIdx.x, lane = tid & 63, wave = __builtin_amdgcn_readfirstlane(tid >> 6), r32 = lane & 31, hi = lane >> 5;
    const int rq = wave >> 1, head = hk * 4 + rq;
    const int iq = qh * 64 + (wave & 1) * 32 + r32;
    const int wlo = (nb == 0) ? 2 : qh, whi = (nb == 63) ? 4 : 5 + qh, nwin = whi - wlo, ntile = nwin + 4;
    const int tokq = b * SEQ + nb * 128 + iq;
    bf16x8 qr[4];
#pragma unroll
    for (int d0 = 0; d0 < 4; ++d0) qr[d0] = *(const bf16x8*)(Z + (size_t)tokq * DIN + ZQ + head * 64 + d0 * 16 + hi * 8);
    float mrun = sink[head] * LOG2E, lrun = (hi == 0) ? 1.f : 0.f;
    f32x16 o[2];
#pragma unroll
    for (int j = 0; j < 2; ++j)
#pragma unroll
        for (int r = 0; r < 16; ++r) o[j][r] = 0.f;
    const int kdst = wave * 1024 + lane * 16, vdst = 8192 + (wave >> 2) * 4096 + lane * 64 + (wave & 3) * 16;
#define ATT_SRC(s, kp, vp) do { const int tl_ = (s) < nwin ? wlo + (s) : 6 + (s) - nwin; \
        if (tl_ < 6) { const int tok_ = b * SEQ + (nb - 1 + (tl_ >> 1)) * 128 + (tl_ & 1) * 64 + lane; kp = Z + (size_t)tok_ * DIN + ZK + hk * 64 + wave * 8; vp = Z + (size_t)tok_ * DIN + ZVA + hk * 64 + wave * 8; } \
        else { const int row_ = b * NCTX + (tl_ - 6) * 64 + lane; kp = KVC + (size_t)row_ * 256 + hk * 64 + wave * 8; vp = KVC + (size_t)row_ * 256 + 128 + hk * 64 + wave * 8; } } while (0)
    u32x4 kreg, vreg;
    { const bf16 *kp, *vp; ATT_SRC(0, kp, vp); kreg = *(const u32x4*)kp; vreg = *(const u32x4*)vp; }
    *(LAS u32x4*)(lds + kdst) = kreg; *(LAS u32x4*)(lds + vdst) = vreg;
    __syncthreads();
    const int vrd = ((lane & 15) >> 2) * 64 + ((lane >> 4) & 1) * 32 + (lane & 3) * 8 + hi * 256;
    for (int s = 0; s < ntile; ++s) {
        const int base = (s & 1) * 16384;
        const int tl = s < nwin ? wlo + s : 6 + s - nwin;
        if (s + 1 < ntile) { const bf16 *kp, *vp; ATT_SRC(s + 1, kp, vp); kreg = *(const u32x4*)kp; vreg = *(const u32x4*)vp; }
        {
            f32x16 p0, p1;
#pragma unroll
            for (int r = 0; r < 16; ++r) { p0[r] = 0.f; p1[r] = 0.f; }
#pragma unroll
            for (int d0 = 0; d0 < 4; ++d0) {
                const bf16x8 k0 = *(LAS const bf16x8*)(lds + base + (2 * d0 + hi) * 1024 + r32 * 16);
                const bf16x8 k1 = *(LAS const bf16x8*)(lds + base + (2 * d0 + hi) * 1024 + (r32 + 32) * 16);
                p0 = mfma32(k0, qr[d0], p0); p1 = mfma32(k1, qr[d0], p1);
            }
            if (tl < 2) {
                const int j0 = (tl & 1) * 64 + 4 * hi;
#pragma unroll
                for (int r = 0; r < 16; ++r) { const int j = j0 + (r & 3) + 8 * (r >> 2); if (j < iq) p0[r] = -INFINITY; if (j + 32 < iq) p1[r] = -INFINITY; }
            } else if (tl == 4 || tl == 5) {
                const int j0 = (tl & 1) * 64 + 4 * hi;
#pragma unroll
                for (int r = 0; r < 16; ++r) { const int j = j0 + (r & 3) + 8 * (r >> 2); if (j > iq) p0[r] = -INFINITY; if (j + 32 > iq) p1[r] = -INFINITY; }
            }
            float mx = fmaxf(p0[0], p1[0]);
#pragma unroll
            for (int r = 1; r < 16; ++r) mx = fmaxf(mx, fmaxf(p0[r], p1[r]));
            mx = fmaxf(mx, __shfl_xor(mx, 32));
            const float mn = fmaxf(mrun, mx), alpha = __builtin_amdgcn_exp2f(mrun - mn);
            mrun = mn;
            float rs = 0.f;
#pragma unroll
            for (int r = 0; r < 16; ++r) { p0[r] = __builtin_amdgcn_exp2f(p0[r] - mn); p1[r] = __builtin_amdgcn_exp2f(p1[r] - mn); rs += p0[r] + p1[r]; }
            lrun = lrun * alpha + rs;
#pragma unroll
            for (int r = 0; r < 16; ++r) { o[0][r] *= alpha; o[1][r] *= alpha; }
            bf16x8 pf[4];
#pragma unroll
            for (int s4 = 0; s4 < 4; ++s4) {
                u32x4 w;
                if (s4 < 2) { w.x = cvtpk(p0[8 * s4 + 0], p0[8 * s4 + 1]); w.y = cvtpk(p0[8 * s4 + 2], p0[8 * s4 + 3]); w.z = cvtpk(p0[8 * s4 + 4], p0[8 * s4 + 5]); w.w = cvtpk(p0[8 * s4 + 6], p0[8 * s4 + 7]); }
                else { const int q = s4 - 2; w.x = cvtpk(p1[8 * q + 0], p1[8 * q + 1]); w.y = cvtpk(p1[8 * q + 2], p1[8 * q + 3]); w.z = cvtpk(p1[8 * q + 4], p1[8 * q + 5]); w.w = cvtpk(p1[8 * q + 6], p1[8 * q + 7]); }
                pf[s4] = __builtin_bit_cast(bf16x8, w);
            }
#pragma unroll
            for (int dblk = 0; dblk < 2; ++dblk)
#pragma unroll
                for (int s4 = 0; s4 < 4; ++s4) {
                    const s16x4 lo = vtr(lds + base + 8192 + dblk * 4096 + vrd + (16 * s4) * 64);
                    const s16x4 hh = vtr(lds + base + 8192 + dblk * 4096 + vrd + (16 * s4 + 8) * 64);
                    const bf16x8 vf = {lo[0], lo[1], lo[2], lo[3], hh[0], hh[1], hh[2], hh[3]};
                    o[dblk] = mfma32(vf, pf[s4], o[dblk]);
                }
        }
        if (s + 1 < ntile) { *(LAS u32x4*)(lds + (16384 - base) + kdst) = kreg; *(LAS u32x4*)(lds + (16384 - base) + vdst) = vreg; }
        __syncthreads();
    }
#undef ATT_SRC
    {
        const float lt = lrun + __shfl_xor(lrun, 32), inv = 1.f / lt;
        bf16* op = Obuf + (size_t)tokq * 512 + head * 64;
#pragma unroll
        for (int dblk = 0; dblk < 2; ++dblk)
#pragma unroll
            for (int r4 = 0; r4 < 4; ++r4) {
                u32x2 w; w.x = cvtpk(o[dblk][4 * r4] * inv, o[dblk][4 * r4 + 1] * inv); w.y = cvtpk(o[dblk][4 * r4 + 2] * inv, o[dblk][4 * r4 + 3] * inv);
                *(u32x2*)(op + 32 * dblk + 8 * r4 + 4 * hi) = w;
            }
    }
}

__device__ __forceinline__ void gmlp_item(const bf16* Z, const float* lng, const float* lnb, const bf16* WsT, const float* bs, bf16* Abuf, ldsp lds, int ch, int gp) {
    const int tid = threadIdx.x, lane = tid & 63, wave = __builtin_amdgcn_readfirstlane(tid >> 6), fr = lane & 15, fq = lane >> 4;
    const int tok0 = ch * 128;
    LAS bf16* VT = (LAS bf16*)lds;
    f32x4 gA = *(const f32x4*)(lng + lane * 8), gB = *(const f32x4*)(lng + lane * 8 + 4), bA = *(const f32x4*)(lnb + lane * 8), bB = *(const f32x4*)(lnb + lane * 8 + 4);
#pragma unroll
    for (int rnd = 0; rnd < 2; ++rnd) {
        float y[8][8];
#pragma unroll
        for (int j = 0; j < 8; ++j) {
            const int tok = tok0 + wave * 16 + rnd * 8 + j;
            const u32x4 raw = *(const u32x4*)(Z + (size_t)tok * DIN + ZV + lane * 8);
            float x[8] = {bflo(raw.x), bfhi(raw.x), bflo(raw.y), bfhi(raw.y), bflo(raw.z), bfhi(raw.z), bflo(raw.w), bfhi(raw.w)};
            float s = 0.f;
#pragma unroll
            for (int i = 0; i < 8; ++i) s += x[i];
            const float mu = wave_sum(s) * (1.f / 512.f);
            float q = 0.f;
#pragma unroll
            for (int i = 0; i < 8; ++i) { x[i] -= mu; q += x[i] * x[i]; }
            const float rstd = rsqrtf(wave_sum(q) * (1.f / 512.f) + 1e-6f);
            y[j][0] = x[0] * rstd * gA[0] + bA[0]; y[j][1] = x[1] * rstd * gA[1] + bA[1]; y[j][2] = x[2] * rstd * gA[2] + bA[2]; y[j][3] = x[3] * rstd * gA[3] + bA[3];
            y[j][4] = x[4] * rstd * gB[0] + bB[0]; y[j][5] = x[5] * rstd * gB[1] + bB[1]; y[j][6] = x[6] * rstd * gB[2] + bB[2]; y[j][7] = x[7] * rstd * gB[3] + bB[3];
        }
        if ((lane >> 5) == gp) {
            const int gl = (lane >> 4) & 1;
#pragma unroll
            for (int i = 0; i < 8; ++i) {
                u32x4 w; w.x = cvtpk(y[0][i], y[1][i]); w.y = cvtpk(y[2][i], y[3][i]); w.z = cvtpk(y[4][i], y[5][i]); w.w = cvtpk(y[6][i], y[7][i]);
                *(LAS u32x4*)(VT + gl * (128 * 136) + (8 * (lane & 15) + i) * 136 + wave * 16 + rnd * 8) = w;
            }
        }
    }
    __syncthreads();
    const int wm = wave >> 1, wn = wave & 1;
#pragma unroll
    for (int gl = 0; gl < 2; ++gl) {
        const int g = 2 * gp + gl;
        f32x4 acc[2][4];
#pragma unroll
        for (int m = 0; m < 2; ++m)
#pragma unroll
            for (int n = 0; n < 4; ++n) acc[m][n] = (f32x4){0.f, 0.f, 0.f, 0.f};
#pragma unroll
        for (int ks = 0; ks < 4; ++ks) {
            bf16x8 af[2], bfr[4];
#pragma unroll
            for (int m = 0; m < 2; ++m) af[m] = *(const bf16x8*)(WsT + (size_t)g * 16384 + (32 * wm + 16 * m + fr) * 128 + 32 * ks + 8 * fq);
#pragma unroll
            for (int n = 0; n < 4; ++n) bfr[n] = *(LAS const bf16x8*)(VT + gl * (128 * 136) + (64 * wn + 16 * n + fr) * 136 + 32 * ks + 8 * fq);
#pragma unroll
            for (int m = 0; m < 2; ++m)
#pragma unroll
                for (int n = 0; n < 4; ++n) acc[m][n] = mfma16(bfr[n], af[m], acc[m][n]);
        }
#pragma unroll
        for (int m = 0; m < 2; ++m) {
            const int p = 32 * wm + 16 * m + fr, tok = tok0 + p; const float bias = bs[g * 128 + p];
#pragma unroll
            for (int n = 0; n < 4; ++n) {
                const int c = g * 128 + 64 * wn + 16 * n + 4 * fq;
                const u32x2 uw = *(const u32x2*)(Z + (size_t)tok * DIN + ZU + c);
                u32x2 w; w.x = cvtpk(bflo(uw.x) * (acc[m][n][0] + bias), bfhi(uw.x) * (acc[m][n][1] + bias)); w.y = cvtpk(bflo(uw.y) * (acc[m][n][2] + bias), bfhi(uw.y) * (acc[m][n][3] + bias));
                *(u32x2*)(Abuf + (size_t)tok * 512 + c) = w;
            }
        }
    }
    __syncthreads();
}

__device__ __forceinline__ void phase_mixers(const Args& a, ldsp lds, int G, int vcu) {
    unsigned char* ws = a.ws;
    const bf16* Z = (const bf16*)(ws + WS_Z);
    for (int it = vcu; it < 512; it += G) {
        const int qh = it & 1, hk = (it >> 1) & 1, nb = (it >> 2) & 63, b = it >> 8;
        attn_item(Z, (const bf16*)(ws + WS_KVC), a.in[I_SINK], (bf16*)(ws + WS_O), lds, b, nb, hk, qh);
    }
    for (int it = vcu; it < 256; it += G) {
        gmlp_item(Z, a.in[I_LNG], a.in[I_LNB], (const bf16*)(ws + WS_WST), a.in[I_GBS], (bf16*)(ws + WS_A), lds, it >> 1, it & 1);
    }
}

#define KI_BEFORE(ka, ia, kb, ib) (((ka) > (kb)) || ((ka) == (kb) && (ia) < (ib)))
#define KI_CAS(K, I, p, q) do { const bool sw_ = KI_BEFORE(K[q], I[q], K[p], I[p]); const float kp_ = sw_ ? K[q] : K[p], kq_ = sw_ ? K[p] : K[q]; const int ip_ = sw_ ? I[q] : I[p], iq_ = sw_ ? I[p] : I[q]; \
        K[p] = kp_; I[p] = ip_; K[q] = kq_; I[q] = iq_; } while (0)
#define KI_SORT8(K, I) do { KI_CAS(K, I, 0, 1); KI_CAS(K, I, 2, 3); KI_CAS(K, I, 4, 5); KI_CAS(K, I, 6, 7); \
        KI_CAS(K, I, 0, 2); KI_CAS(K, I, 1, 3); KI_CAS(K, I, 4, 6); KI_CAS(K, I, 5, 7); \
        KI_CAS(K, I, 1, 2); KI_CAS(K, I, 5, 6); KI_CAS(K, I, 0, 4); KI_CAS(K, I, 3, 7); \
        KI_CAS(K, I, 1, 5); KI_CAS(K, I, 2, 6); KI_CAS(K, I, 1, 4); KI_CAS(K, I, 3, 6); \
        KI_CAS(K, I, 2, 4); KI_CAS(K, I, 3, 5); KI_CAS(K, I, 3, 4); } while (0)
#define KI_MERGE8(KA, IA, KB, IB) do { \
        _Pragma("unroll") for (int r_ = 0; r_ < 8; ++r_) { const bool tb_ = KI_BEFORE(KB[7 - r_], IB[7 - r_], KA[r_], IA[r_]); KA[r_] = tb_ ? KB[7 - r_] : KA[r_]; IA[r_] = tb_ ? IB[7 - r_] : IA[r_]; } \
        KI_CAS(KA, IA, 0, 4); KI_CAS(KA, IA, 1, 5); KI_CAS(KA, IA, 2, 6); KI_CAS(KA, IA, 3, 7); \
        KI_CAS(KA, IA, 0, 2); KI_CAS(KA, IA, 1, 3); KI_CAS(KA, IA, 4, 6); KI_CAS(KA, IA, 5, 7); \
        KI_CAS(KA, IA, 0, 1); KI_CAS(KA, IA, 2, 3); KI_CAS(KA, IA, 4, 5); KI_CAS(KA, IA, 6, 7); } while (0)
__device__ __forceinline__ void router_item(const Args& a, ldsp lds, int it) {
    const int tid = threadIdx.x, lane = tid & 63, wave = __builtin_amdgcn_readfirstlane(tid >> 6), fr = lane & 15, fq = lane >> 4;
    unsigned char* ws = a.ws;
    const int t0 = it * 64, b = t0 >> 13;
    const bf16* X1 = (const bf16*)(ws + WS_X1); const float* adaf = (const float*)(ws + WS_ADAF) + b * 6144;
    const float* g2 = a.in[I_N2G]; unsigned char* H2 = ws + WS_H2;
    {
        f32x4 gm[2][2], sh[2][2];
#pragma unroll
        for (int j = 0; j < 2; ++j)
#pragma unroll
            for (int h = 0; h < 2; ++h) {
                const int c = 8 * lane + 512 * j + 4 * h;
                const f32x4 gg = *(const f32x4*)(g2 + c), sc = *(const f32x4*)(adaf + 4 * 1024 + c);
                gm[j][h] = gg * (sc + 1.f); sh[j][h] = *(const f32x4*)(adaf + 3 * 1024 + c);
            }
#pragma unroll
        for (int half = 0; half < 2; ++half) {
            f32x4 x[4][2][2];
#pragma unroll
            for (int tt = 0; tt < 4; ++tt)
#pragma unroll
                for (int j = 0; j < 2; ++j) {
                    const u32x4 w = *(const u32x4*)(X1 + (size_t)(t0 + wave * 8 + half * 4 + tt) * D + 8 * lane + 512 * j);
                    x[tt][j][0] = (f32x4){bflo(w.x), bfhi(w.x), bflo(w.y), bfhi(w.y)}; x[tt][j][1] = (f32x4){bflo(w.z), bfhi(w.z), bflo(w.w), bfhi(w.w)};
                }
#pragma unroll
            for (int tt = 0; tt < 4; ++tt) {
                const int row = wave * 8 + half * 4 + tt, tok = t0 + row;
                float ss = 0.f;
#pragma unroll
                for (int j = 0; j < 2; ++j)
#pragma unroll
                    for (int h = 0; h < 2; ++h) { const f32x4 v = x[tt][j][h]; ss += (v[0] * v[0] + v[1] * v[1]) + (v[2] * v[2] + v[3] * v[3]); }
                const float r = rsqrtf(wave_sum(ss) * (1.f / D) + 1e-6f);
#pragma unroll
                for (int j = 0; j < 2; ++j) {
                    const f32x4 h0 = (x[tt][j][0] * r) * gm[j][0] + sh[j][0], h1 = (x[tt][j][1] * r) * gm[j][1] + sh[j][1];
                    u32x4 w; w.x = cvtpk(h0[0], h0[1]); w.y = cvtpk(h0[2], h0[3]); w.z = cvtpk(h1[0], h1[1]); w.w = cvtpk(h1[2], h1[3]);
                    { int f0 = 0, f1 = 0;
                      f0 = __builtin_amdgcn_cvt_pk_fp8_f32(h0[0], h0[1], f0, false); f0 = __builtin_amdgcn_cvt_pk_fp8_f32(h0[2], h0[3], f0, true);
                      f1 = __builtin_amdgcn_cvt_pk_fp8_f32(h1[0], h1[1], f1, false); f1 = __builtin_amdgcn_cvt_pk_fp8_f32(h1[2], h1[3], f1, true);
                      u32x2 w8; w8.x = (unsigned)f0; w8.y = (unsigned)f1; *(u32x2*)(H2 + (size_t)tok * D + 8 * lane + 512 * j) = w8; }
                    const int kc = lane + 64 * j;
                    *(LAS u32x4*)(lds + kc * 1024 + ((row ^ (kc & 7)) * 16)) = w;
                }
            }
        }
    }
    __syncthreads();
    f32x4 acc[4][2];
#pragma unroll
    for (int m = 0; m < 4; ++m)
#pragma unroll
        for (int n = 0; n < 2; ++n) acc[m][n] = (f32x4){0.f, 0.f, 0.f, 0.f};
    const bf16* RwT = (const bf16*)(ws + WS_RWT) + (size_t)(32 * wave + fr) * D + 8 * fq;
#pragma unroll 8
    for (int ks = 0; ks < 32; ++ks) {
        const int kc = 4 * ks + fq;
        bf16x8 af[4], bfr[2];
#pragma unroll
        for (int n = 0; n < 2; ++n) bfr[n] = *(const bf16x8*)(RwT + (size_t)(16 * n) * D + 32 * ks);
#pragma unroll
        for (int m = 0; m < 4; ++m) af[m] = *(LAS const bf16x8*)(lds + kc * 1024 + (((16 * m + fr) ^ (kc & 7)) * 16));
#pragma unroll
        for (int m = 0; m < 4; ++m)
#pragma unroll
            for (int n = 0; n < 2; ++n) acc[m][n] = mfma16(af[m], bfr[n], acc[m][n]);
    }
    __syncthreads();
    LAS float* LG = (LAS float*)lds;
#pragma unroll
    for (int m = 0; m < 4; ++m)
#pragma unroll
        for (int n = 0; n < 2; ++n)
#pragma unroll
            for (int reg = 0; reg < 4; ++reg) LG[(32 * wave + 16 * n + fr) * 65 + 16 * m + 4 * fq + reg] = acc[m][n][reg];
    __syncthreads();
    LAS float* CK = (LAS float*)(lds + 69632); LAS int* CI = (LAS int*)(lds + 69632 + 16384);
    const float* rb = a.in[I_RB];
    float bk[8]; int bi[8];
#pragma unroll
    for (int q = 0; q < 4; ++q) {
        float gk[8]; int gi[8];
#pragma unroll
        for (int j = 0; j < 8; ++j) { const int e = 32 * wave + 8 * q + j; gk[j] = sigmoid_f(LG[e * 65 + lane]) + rb[e]; gi[j] = e; }
        KI_SORT8(gk, gi);
        if (q == 0) {
#pragma unroll
            for (int j = 0; j < 8; ++j) { bk[j] = gk[j]; bi[j] = gi[j]; }
        } else KI_MERGE8(bk, bi, gk, gi);
    }
#pragma unroll
    for (int r = 0; r < 8; ++r) { CK[(wave * 8 + r) * 64 + lane] = bk[r]; CI[(wave * 8 + r) * 64 + lane] = bi[r]; }
    __syncthreads();
#define RT_LEVEL(lvl) do { if ((wave & (2 * (lvl) - 1)) == 0) { float ok_[8]; int oi_[8]; \
            _Pragma("unroll") for (int r = 0; r < 8; ++r) { ok_[r] = CK[((wave + (lvl)) * 8 + r) * 64 + lane]; oi_[r] = CI[((wave + (lvl)) * 8 + r) * 64 + lane]; } \
            KI_MERGE8(bk, bi, ok_, oi_); \
            if ((lvl) < 4) { _Pragma("unroll") for (int r = 0; r < 8; ++r) { CK[(wave * 8 + r) * 64 + lane] = bk[r]; CI[(wave * 8 + r) * 64 + lane] = bi[r]; } } } \
        __syncthreads(); } while (0)
    RT_LEVEL(1); RT_LEVEL(2); RT_LEVEL(4);
#undef RT_LEVEL
    LAS unsigned* hist = (LAS unsigned*)(lds + 102400); LAS unsigned* hbase = hist + 256;
    if (tid < 256) hist[tid] = 0u;
    __syncthreads();
    unsigned* cnt = (unsigned*)(ws + WS_CTL) + CW_CNT; int* list = (int*)(ws + WS_LIST); float* gatew = (float*)(ws + WS_GATEW);
    unsigned rank[8];
    if (wave == 0) {
        const int tok = t0 + lane;
        float sel[8], ssum = 0.f;
#pragma unroll
        for (int r = 0; r < 8; ++r) { sel[r] = sigmoid_f(LG[bi[r] * 65 + lane]); ssum += sel[r]; }
#pragma unroll
        for (int r = 0; r < 8; ++r) rank[r] = __hip_atomic_fetch_add(&hist[bi[r]], 1u, __ATOMIC_RELAXED, __HIP_MEMORY_SCOPE_WORKGROUP);
        const float sc = 2.5f / ssum;
        f32x4 g0 = {sel[0] * sc, sel[1] * sc, sel[2] * sc, sel[3] * sc}, g1 = {sel[4] * sc, sel[5] * sc, sel[6] * sc, sel[7] * sc};
        *(f32x4*)(gatew + tok * 8) = g0; *(f32x4*)(gatew + tok * 8 + 4) = g1;
    }
    __syncthreads();
    if (tid < 256) { const unsigned h = hist[tid]; if (h) hbase[tid] = atomicAdd(cnt + 32 * tid, h); }
    __syncthreads();
    if (wave == 0) {
        const int tok = t0 + lane;
#pragma unroll
        for (int r = 0; r < 8; ++r) list[(size_t)bi[r] * LISTCAP + hbase[bi[r]] + rank[r]] = tok * NSLOT + r;
    }
    __syncthreads();
}

__device__ __forceinline__ void moe_tile(const Args& a, ldsp lds, int e, int mt, int nrows, int ntl) {
    const int tid = threadIdx.x, lane = tid & 63, wave = __builtin_amdgcn_readfirstlane(tid >> 6), fr = lane & 15, fq = lane >> 4;
    unsigned char* ws = a.ws;
    constexpr int ASTG = 0, BSTG = 16384, ACT = 49152, SLOTS = 114688, GWO = 115200;
    const bf16* H2 = (const bf16*)(ws + WS_H2);
    const float* Wg = (e < NEXP) ? a.in[I_EG] + (size_t)e * 262144 : a.in[I_SG];
    const float* Wu = (e < NEXP) ? a.in[I_EU] + (size_t)e * 262144 : a.in[I_SU];
    const float* Wd = (e < NEXP) ? a.in[I_ED] + (size_t)e * 262144 : a.in[I_SD];
    if (tid < 128) {
        int slot = -1; float gw = 0.f;
        if (tid < nrows) {
            if (e < NEXP) { slot = ((const int*)(ws + WS_LIST))[(size_t)e * LISTCAP + mt * 128 + tid]; gw = ((const float*)(ws + WS_GATEW))[(slot / NSLOT) * 8 + (slot % NSLOT)]; }
            else { slot = (mt * 128 + tid) * NSLOT + 8; gw = 1.f; }
        }
        ((LAS int*)(lds + SLOTS))[tid] = slot; ((LAS float*)(lds + GWO))[tid] = gw;
    }
    __syncthreads();
    const int wr = wave >> 2, wc = wave & 3;
    const int arow = tid >> 2, akc = tid & 3;
    const int aslot = ((LAS const int*)(lds + SLOTS))[arow];
    const bf16* asrc = H2 + (size_t)((aslot < 0 ? 0 : aslot) / NSLOT) * D + akc * 8;
    const int awr = ASTG + akc * 2048 + ((arow ^ (akc << 1)) * 16);
    const int ng = lane, kq = wave;
    const float* srcg = Wg + (size_t)(4 * kq) * 256 + 4 * ng;
    const float* srcu = Wu + (size_t)(4 * kq) * 256 + 4 * ng;
    const float* src2 = Wd + (size_t)(4 * kq) * 1024 + 4 * ng;
    int bwr2[4];
#pragma unroll
    for (int i = 0; i < 4; ++i) { const int rho2 = 4 * ng + i; bwr2[i] = BSTG + (kq >> 1) * 4096 + ((rho2 ^ ((rho2 >> 3) & 3)) * 16) + (kq & 1) * 8; }
    int ard[4], brd[4], rowm[4];
#pragma unroll
    for (int m = 0; m < 4; ++m) { rowm[m] = 64 * wr + 16 * m + fr; ard[m] = fq * 2048 + ((rowm[m] ^ (fq << 1)) * 16); }
#pragma unroll
    for (int n = 0; n < 4; ++n) { const int rho = 64 * wc + 16 * n + fr; brd[n] = BSTG + fq * 4096 + ((rho ^ ((rho >> 3) & 3)) * 16); }
    bf16* contrib = (bf16*)(ws + WS_CONTRIB);
    f32x4 acc[4][4];
    f32x4 B0[4], B1[4], B2[4], B3[4]; u32x4 A0, A1, A2, A3;
#define G1_LOAD(s_, BR, AR) do { const int s0_ = (s_); const int ss_ = s0_ < 63 ? s0_ : 63; \
        const float* bp_ = ((ss_ < 32) ? srcg : srcu) + (size_t)(32 * (ss_ & 31)) * 256; \
        AR = *(const u32x4*)(asrc + 32 * (ss_ & 31)); \
        _Pragma("unroll") for (int j = 0; j < 4; ++j) BR[j] = *(const f32x4*)(bp_ + j * 256); } while (0)
#define G1_WRITE(BR, AR, buf_) do { \
        *(LAS u32x4*)(lds + (buf_) * 8192 + awr) = AR; \
        _Pragma("unroll") for (int i = 0; i < 4; ++i) { u32x2 w_; w_.x = cvtpk(BR[0][i], BR[1][i]); w_.y = cvtpk(BR[2][i], BR[3][i]); *(LAS u32x2*)(lds + (buf_) * 16384 + bwr2[i]) = w_; } } while (0)
#define MOE_COMPUTE(abase_, buf_) do { \
        bf16x8 af_[4], bf_[4]; \
        _Pragma("unroll") for (int m = 0; m < 4; ++m) af_[m] = *(LAS const bf16x8*)(lds + (abase_) + ard[m]); \
        _Pragma("unroll") for (int n = 0; n < 4; ++n) bf_[n] = *(LAS const bf16x8*)(lds + (buf_) * 16384 + brd[n]); \
        _Pragma("unroll") for (int m = 0; m < 4; ++m) _Pragma("unroll") for (int n = 0; n < 4; ++n) acc[m][n] = mfma16(bf_[n], af_[m], acc[m][n]); } while (0)
#define ACC_ZERO() do { _Pragma("unroll") for (int m = 0; m < 4; ++m) _Pragma("unroll") for (int n = 0; n < 4; ++n) acc[m][n] = (f32x4){0.f, 0.f, 0.f, 0.f}; } while (0)
    G1_LOAD(0, B0, A0); G1_LOAD(1, B1, A1); G1_LOAD(2, B2, A2);
    G1_WRITE(B0, A0, 0);
    __syncthreads();
    for (int s = 0; s < 64; s += 4) {
        if ((s & 31) == 0) ACC_ZERO();
        G1_LOAD(s + 3, B3, A3); MOE_COMPUTE(0, 0); G1_WRITE(B1, A1, 1); __syncthreads();
        G1_LOAD(s + 4, B0, A0); MOE_COMPUTE(8192, 1); G1_WRITE(B2, A2, 0); __syncthreads();
        G1_LOAD(s + 5, B1, A1); MOE_COMPUTE(0, 0); G1_WRITE(B3, A3, 1); __syncthreads();
        G1_LOAD(s + 6, B2, A2); MOE_COMPUTE(8192, 1);
        if (s == 28) {
#pragma unroll
            for (int m = 0; m < 4; ++m)
#pragma unroll
                for (int n = 0; n < 4; ++n) {
                    const f32x4 gv = acc[m][n];
                    u32x2 w; w.x = cvtpk(silu_f(gv[0]), silu_f(gv[1])); w.y = cvtpk(silu_f(gv[2]), silu_f(gv[3]));
                    const int kc = 8 * wc + 2 * n + (fq >> 1);
                    *(LAS u32x2*)(lds + ACT + kc * 2048 + ((rowm[m] ^ ((kc & 3) << 1)) * 16) + (fq & 1) * 8) = w;
                }
        } else if (s == 60) {
#pragma unroll
            for (int m = 0; m < 4; ++m)
#pragma unroll
                for (int n = 0; n < 4; ++n) {
                    const f32x4 uv = acc[m][n];
                    const int kc = 8 * wc + 2 * n + (fq >> 1);
                    LAS u32x2* ap = (LAS u32x2*)(lds + ACT + kc * 2048 + ((rowm[m] ^ ((kc & 3) << 1)) * 16) + (fq & 1) * 8);
                    const u32x2 g = *ap;
                    u32x2 w; w.x = cvtpk(bflo(g.x) * uv[0], bfhi(g.x) * uv[1]); w.y = cvtpk(bflo(g.y) * uv[2], bfhi(g.y) * uv[3]);
                    *ap = w;
                }
        }
        G1_WRITE(B0, A0, 0); __syncthreads();
    }
#define G2_LOAD(s_, BR) do { const int s0_ = (s_); const int t_ = s0_ < 31 ? s0_ : 31; \
        const float* bp_ = src2 + (size_t)(32 * (t_ & 7)) * 1024 + 256 * (t_ >> 3); \
        _Pragma("unroll") for (int j = 0; j < 4; ++j) BR[j] = *(const f32x4*)(bp_ + j * 1024); } while (0)
#define G2_WRITE(BR, buf_) do { \
        _Pragma("unroll") for (int i = 0; i < 4; ++i) { u32x2 w_; w_.x = cvtpk(BR[0][i], BR[1][i]); w_.y = cvtpk(BR[2][i], BR[3][i]); *(LAS u32x2*)(lds + (buf_) * 16384 + bwr2[i]) = w_; } } while (0)
    G2_LOAD(0, B0); G2_LOAD(1, B1); G2_LOAD(2, B2);
    G2_WRITE(B0, 0);
    __syncthreads();
    for (int s = 0; s < 32; s += 4) {
        if ((s & 7) == 0) ACC_ZERO();
        G2_LOAD(s + 3, B3); MOE_COMPUTE(ACT + (s & 7) * 8192, 0); G2_WRITE(B1, 1); __syncthreads();
        G2_LOAD(s + 4, B0); MOE_COMPUTE(ACT + ((s + 1) & 7) * 8192, 1); G2_WRITE(B2, 0); __syncthreads();
        G2_LOAD(s + 5, B1); MOE_COMPUTE(ACT + ((s + 2) & 7) * 8192, 0); G2_WRITE(B3, 1); __syncthreads();
        G2_LOAD(s + 6, B2); MOE_COMPUTE(ACT + ((s + 3) & 7) * 8192, 1);
        if ((s & 7) == 4) {
            const int q = s >> 3;
#pragma unroll
            for (int m = 0; m < 4; ++m) {
                const int slot = ((LAS const int*)(lds + SLOTS))[rowm[m]]; const float gw = ((LAS const float*)(lds + GWO))[rowm[m]];
                if (slot >= 0) {
                    bf16* cp = contrib + (size_t)slot * D + q * 256 + 64 * wc + 4 * fq;
#pragma unroll
                    for (int n = 0; n < 4; ++n) { const f32x4 v = acc[m][n] * gw; u32x2 w; w.x = cvtpk(v[0], v[1]); w.y = cvtpk(v[2], v[3]); *(u32x2*)(cp + 16 * n) = w; }
                }
            }
        }
        G2_WRITE(B0, 0); __syncthreads();
    }
#undef G1_LOAD
#undef G1_WRITE
#undef G2_LOAD
#undef G2_WRITE
#undef ACC_ZERO
#undef MOE_COMPUTE
}

__device__ __forceinline__ const float* uni_ptr(const float* p) {
    const unsigned long long v = (unsigned long long)p;
    const unsigned lo = __builtin_amdgcn_readfirstlane((unsigned)v), hi = __builtin_amdgcn_readfirstlane((unsigned)(v >> 32));
    return (const float*)(((unsigned long long)hi << 32) | lo);
}
__device__ __forceinline__ void moe_decode(int j, int total, LAS const int* pre, LAS const int* cnt, int& e, int& mt, int& nrows) {
    if (j < total) {
        int lo = 0, hi = NEXP;
        while (hi - lo > 1) { const int mid = (lo + hi) >> 1; if (pre[mid] <= j) lo = mid; else hi = mid; }
        e = lo; mt = j - pre[e]; const int c = cnt[e] - mt * 128; nrows = c < 128 ? c : 128;
    } else { e = NEXP; mt = j - total; nrows = 128; }
}
__device__ __forceinline__ void phase_moe(const Args& a, ldsp lds, int G, int vcu) {
    const int tid = threadIdx.x, lane = tid & 63, wave = __builtin_amdgcn_readfirstlane(tid >> 6), fr = lane & 15, fq = lane >> 4;
    unsigned char* ws = a.ws;
    constexpr int ASTG = 0, BSTG = 16384, ACT = 49152, SLOTS = 114688, GWO = SLOTS + MOE_MAXT * 512;
    static_assert(GWO + MOE_MAXT * 512 <= SCR_BYTES, "slot lists overflow the scratch image");
    LAS int* pre = (LAS int*)(lds + MISC_OFF + 512);
    LAS int* cnt = (LAS int*)(lds + MISC_OFF + 2048);
    LAS int* wtot = (LAS int*)(lds + MISC_OFF + 3072);
    int myv = 0, myx = 0;
    if (tid < NEXP) {
        const int c = (int)((const unsigned*)(ws + WS_CTL) + CW_CNT)[32 * tid];
        cnt[tid] = c; myv = (c + 127) >> 7; myx = myv;
#pragma unroll
        for (int o = 1; o < 64; o <<= 1) { const int y = __shfl_up(myx, o); if (lane >= o) myx += y; }
        if (lane == 63) wtot[wave] = myx;
    }
    __syncthreads();
    if (tid < NEXP) { int base = 0; for (int w = 0; w < wave; ++w) base += wtot[w]; pre[tid] = base + myx - myv; if (tid == NEXP - 1) pre[NEXP] = base + myx; }
    __syncthreads();
    const int total = pre[NEXP], ntiles = total + T / 128;
    if (vcu >= ntiles) return;
    for (int tt = tid >> 7; vcu + tt * G < ntiles; tt += 4) {
        const int r = tid & 127; int e_, mt_, nr_; moe_decode(vcu + tt * G, total, pre, cnt, e_, mt_, nr_);
        int slot_ = -1; float gw_ = 0.f;
        if (r < nr_) { if (e_ < NEXP) { slot_ = ((const int*)(ws + WS_LIST))[(size_t)e_ * LISTCAP + mt_ * 128 + r]; gw_ = ((const float*)(ws + WS_GATEW))[(slot_ / NSLOT) * 8 + (slot_ % NSLOT)]; }
                       else { slot_ = (mt_ * 128 + r) * NSLOT + 8; gw_ = 1.f; } }
        ((LAS int*)(lds + SLOTS))[tt * 128 + r] = slot_; ((LAS float*)(lds + GWO))[tt * 128 + r] = gw_;
    }
    __syncthreads();
    if (wave >= 4) {
        const int lt = tid - 256;
        const unsigned char* H2 = ws + WS_H2;
        const int arow = lt >> 1, ahalf = lt & 1;
        const int awr0 = ASTG + (2 * ahalf) * 2048 + ((arow ^ ((2 * ahalf) << 1)) * 16), awr1 = ASTG + (2 * ahalf + 1) * 2048 + ((arow ^ ((2 * ahalf + 1) << 1)) * 16);
        const int ng = lt & 63, kq = lt >> 6;
        const int loff256 = (8 * kq) * 256 + 4 * ng, loff1024 = (8 * kq) * 1024 + 4 * ng;
        const int bw = BSTG + kq * 4096 + (4 * ng) * 16, bx = ((4 * ng) >> 3) & 3;
        f32x4 B0[8], B1[8], B2[8], B3[8]; u32x4 A0, A1, A2, A3, A4, A5, A6, A7;
        int j = vcu, it = 0, e, mt, nrows;
        moe_decode(j, total, pre, cnt, e, mt, nrows);
#ifndef MOE_AUX
#define MOE_AUX 16
#endif
#define W_RSRC(eo_, pe_, ps_) __builtin_amdgcn_make_buffer_rsrc((void*)uni_ptr(((eo_) < NEXP) ? a.in[pe_] + (size_t)(eo_) * 262144 : a.in[ps_]), 0, 1 << 20, 0x00020000)
        const int eu0 = __builtin_amdgcn_readfirstlane(e);
        __amdgpu_buffer_rsrc_t Wg = W_RSRC(eu0, I_EG, I_SG), Wu = W_RSRC(eu0, I_EU, I_SU), Wd = W_RSRC(eu0, I_ED, I_SD);
        int aslot = ((LAS const int*)(lds + SLOTS))[arow];
        const unsigned char* asrc = H2 + (size_t)((aslot < 0 ? 0 : aslot) / NSLOT) * D + 16 * ahalf;
#define L_LOADB1(WG_, WU_, WD_, s_, BR) do { const int ss_ = (s_); const int t_ = ss_ - 64; \
            const __amdgpu_buffer_rsrc_t r_ = (ss_ < 32) ? (WG_) : (ss_ < 64) ? (WU_) : (WD_); \
            const int vo_ = (ss_ < 64) ? 4 * loff256 : 4 * loff1024; \
            const int so_ = (ss_ < 32) ? (32 * ss_) * 1024 : (ss_ < 64) ? (32 * (ss_ - 32)) * 1024 : (32 * (t_ & 7)) * 4096 + 1024 * (t_ >> 3); \
            const int str_ = (ss_ < 64) ? 1024 : 4096;        \
            _Pragma("unroll") for (int jj = 0; jj < 8; ++jj) BR[jj] = __builtin_bit_cast(f32x4, __builtin_amdgcn_raw_buffer_load_b128(r_, vo_, so_ + jj * str_, MOE_AUX)); } while (0)
#define L_LOADA4(AP_, s_, R0, R1, R2, R3) do { const int ss_ = (s_); const int sa_ = ss_ < 60 ? ss_ : 60; const unsigned char* p_ = (AP_) + 32 * (sa_ & 31); \
            R0 = *(const u32x4*)(p_); R1 = *(const u32x4*)(p_ + 32); R2 = *(const u32x4*)(p_ + 64); R3 = *(const u32x4*)(p_ + 96); } while (0)
#define L_LOADB1P(WG_, WU_, WD_, s_, BR, j0_) do { const int ss_ = (s_); const int t_ = ss_ - 64; \
            const __amdgpu_buffer_rsrc_t r_ = (ss_ < 32) ? (WG_) : (ss_ < 64) ? (WU_) : (WD_); \
            const int vo_ = (ss_ < 64) ? 4 * loff256 : 4 * loff1024; \
            const int so_ = (ss_ < 32) ? (32 * ss_) * 1024 : (ss_ < 64) ? (32 * (ss_ - 32)) * 1024 : (32 * (t_ & 7)) * 4096 + 1024 * (t_ >> 3); \
            const int str_ = (ss_ < 64) ? 1024 : 4096; \
            _Pragma("unroll") for (int jj = (j0_); jj < (j0_) + 2; ++jj) BR[jj] = __builtin_bit_cast(f32x4, __builtin_amdgcn_raw_buffer_load_b128(r_, vo_, so_ + jj * str_, MOE_AUX)); } while (0)
#define L_LOAD2P(s_, BR, j0_) do { const int s0_ = (s_); const int t_ = s0_ < 31 ? s0_ : 31; \
            const int so_ = (32 * (t_ & 7)) * 4096 + 1024 * (t_ >> 3); \
            _Pragma("unroll") for (int jj = (j0_); jj < (j0_) + 2; ++jj) BR[jj] = __builtin_bit_cast(f32x4, __builtin_amdgcn_raw_buffer_load_b128(Wd, 4 * loff1024, so_ + jj * 4096, MOE_AUX)); } while (0)
#define L_WRITEB1(BR, buf_, i_) do { const int i = (i_); u32x4 w_; w_.x = cvtpk(BR[0][i], BR[1][i]); w_.y = cvtpk(BR[2][i], BR[3][i]); w_.z = cvtpk(BR[4][i], BR[5][i]); w_.w = cvtpk(BR[6][i], BR[7][i]); \
            *(LAS u32x4*)(lds + (buf_) * 16384 + bw + ((i ^ bx) * 16)) = w_; } while (0)
#define L_SB() __builtin_amdgcn_sched_barrier(0)
#define L_STEP1(WG_, WU_, WD_, ls_, LB, WB, wbuf_) do { _Pragma("unroll") for (int i4 = 0; i4 < 4; ++i4) { L_WRITEB1(WB, wbuf_, i4); L_SB(); L_LOADB1P(WG_, WU_, WD_, ls_, LB, 2 * i4); L_SB(); } } while (0)
#define L_STEP2(ls_, LB, WB, wbuf_) do { _Pragma("unroll") for (int i4 = 0; i4 < 4; ++i4) { L_WRITEB1(WB, wbuf_, i4); L_SB(); L_LOAD2P(ls_, LB, 2 * i4); L_SB(); } } while (0)
#define L_LOAD2(s_, BR) do { const int s0_ = (s_); const int t_ = s0_ < 31 ? s0_ : 31; \
            const int so_ = (32 * (t_ & 7)) * 4096 + 1024 * (t_ >> 3); \
            _Pragma("unroll") for (int jj = 0; jj < 8; ++jj) BR[jj] = __builtin_bit_cast(f32x4, __builtin_amdgcn_raw_buffer_load_b128(Wd, 4 * loff1024, so_ + jj * 4096, MOE_AUX)); } while (0)
#define L_WRITEB(BR, buf_) do { _Pragma("unroll") for (int i = 0; i < 4; ++i) { u32x4 w_; w_.x = cvtpk(BR[0][i], BR[1][i]); w_.y = cvtpk(BR[2][i], BR[3][i]); w_.z = cvtpk(BR[4][i], BR[5][i]); w_.w = cvtpk(BR[6][i], BR[7][i]); \
            *(LAS u32x4*)(lds + (buf_) * 16384 + bw + ((i ^ bx) * 16)) = w_; } } while (0)
#define L_CVT8(w_, o0, o1) do { const f32x2_t l_ = __builtin_amdgcn_cvt_pk_f32_fp8((int)(w_), false), h_ = __builtin_amdgcn_cvt_pk_f32_fp8((int)(w_), true); o0 = cvtpk(l_[0], l_[1]); o1 = cvtpk(h_[0], h_[1]); } while (0)
#define L_WRITEA(AR, buf_) do { u32x4 c0_, c1_; L_CVT8(AR.x, c0_.x, c0_.y); L_CVT8(AR.y, c0_.z, c0_.w); L_CVT8(AR.z, c1_.x, c1_.y); L_CVT8(AR.w, c1_.z, c1_.w); \
            *(LAS u32x4*)(lds + (buf_) * 8192 + awr0) = c0_; *(LAS u32x4*)(lds + (buf_) * 8192 + awr1) = c1_; } while (0)
        L_LOADA4(asrc, 0, A0, A1, A2, A3); L_LOADB1(Wg, Wu, Wd, 0, B0); L_LOADB1(Wg, Wu, Wd, 1, B1); L_LOADB1(Wg, Wu, Wd, 2, B2); L_LOADA4(asrc, 4, A4, A5, A6, A7);
        for (;;) {
            L_WRITEA(A0, 0); L_WRITEB(B0, 0);
            __syncthreads();
            for (int s = 0; s < 64; s += 8) {
                L_WRITEA(A1, 1); L_STEP1(Wg, Wu, Wd, s + 3, B3, B1, 1); __syncthreads();
                L_WRITEA(A2, 0); L_STEP1(Wg, Wu, Wd, s + 4, B0, B2, 0); __syncthreads();
                L_WRITEA(A3, 1); L_STEP1(Wg, Wu, Wd, s + 5, B1, B3, 1); __syncthreads();
                L_WRITEA(A4, 0); L_LOADA4(asrc, s + 8, A0, A1, A2, A3); L_STEP1(Wg, Wu, Wd, s + 6, B2, B0, 0); __syncthreads();
                L_WRITEA(A5, 1); L_STEP1(Wg, Wu, Wd, s + 7, B3, B1, 1); __syncthreads();
                L_WRITEA(A6, 0); L_STEP1(Wg, Wu, Wd, s + 8, B0, B2, 0); __syncthreads();
                L_WRITEA(A7, 1); L_STEP1(Wg, Wu, Wd, s + 9, B1, B3, 1); __syncthreads();
                L_WRITEA(A0, 0); L_LOADA4(asrc, s + 12, A4, A5, A6, A7); L_STEP1(Wg, Wu, Wd, s + 10, B2, B0, 0); __syncthreads();
            }
            for (int s = 0; s < 28; s += 4) {
                L_STEP2(s + 3, B3, B1, 1); __syncthreads();
                L_STEP2(s + 4, B0, B2, 0); __syncthreads();
                L_STEP2(s + 5, B1, B3, 1); __syncthreads();
                L_STEP2(s + 6, B2, B0, 0); __syncthreads();
            }
            const int jn = j + G; const bool more = jn < ntiles;
            int en = e, mtn = mt, nrn = nrows; if (more) moe_decode(jn, total, pre, cnt, en, mtn, nrn);
            const int eun = __builtin_amdgcn_readfirstlane(en);
            const __amdgpu_buffer_rsrc_t Wgn = W_RSRC(eun, I_EG, I_SG), Wun = W_RSRC(eun, I_EU, I_SU), Wdn = W_RSRC(eun, I_ED, I_SD);
            const int aslotn = more ? ((LAS const int*)(lds + SLOTS))[(it + 1) * 128 + arow] : aslot;
            const unsigned char* asrcn = H2 + (size_t)((aslotn < 0 ? 0 : aslotn) / NSLOT) * D + 16 * ahalf;
            L_STEP2(31, B3, B1, 1); __syncthreads();
            L_LOADA4(asrcn, 0, A0, A1, A2, A3); L_STEP1(Wgn, Wun, Wdn, 0, B0, B2, 0); __syncthreads();
            L_STEP1(Wgn, Wun, Wdn, 1, B1, B3, 1); __syncthreads();
            L_LOADB1(Wgn, Wun, Wdn, 2, B2); L_LOADA4(asrcn, 4, A4, A5, A6, A7); __syncthreads();
            if (!more) break;
            j = jn; ++it; e = en; mt = mtn; nrows = nrn; Wg = Wgn; Wu = Wun; Wd = Wdn; aslot = aslotn; asrc = asrcn;
        }
#undef L_LOADB1
#undef L_LOADB1P
#undef L_LOAD2P
#undef L_WRITEB1
#undef L_STEP1
#undef L_STEP2
#undef L_SB
#undef W_RSRC
#undef L_LOADA4
#undef L_CVT8
#undef L_LOAD2
#undef L_WRITEB
#undef L_WRITEA
    } else {
        const int wr = wave >> 1, wc = wave & 1;
        int rowm[4], ard[4], brd[8];
#pragma unroll
        for (int m = 0; m < 4; ++m) { rowm[m] = 64 * wr + 16 * m + fr; ard[m] = fq * 2048 + ((rowm[m] ^ (fq << 1)) * 16); }
#pragma unroll
        for (int n = 0; n < 8; ++n) { const int rho = 128 * wc + 16 * n + fr; brd[n] = BSTG + fq * 4096 + ((rho ^ ((rho >> 3) & 3)) * 16); }
        unsigned char* contrib = ws + WS_CONTRIB;
        f32x4 acc[4][8];
#define M_COMPUTE(abase_, buf_) do { \
            _Pragma("unroll") for (int nh = 0; nh < 2; ++nh) { bf16x8 af_[4], bf_[4]; \
                _Pragma("unroll") for (int m = 0; m < 4; ++m) af_[m] = *(LAS const bf16x8*)(lds + (abase_) + ard[m]); \
                _Pragma("unroll") for (int n = 0; n < 4; ++n) bf_[n] = *(LAS const bf16x8*)(lds + (buf_) * 16384 + brd[4 * nh + n]); \
                _Pragma("unroll") for (int m = 0; m < 4; ++m) _Pragma("unroll") for (int n = 0; n < 4; ++n) acc[m][4 * nh + n] = mfma16(bf_[n], af_[m], acc[m][4 * nh + n]); } } while (0)
#define M_ZERO() do { _Pragma("unroll") for (int m = 0; m < 4; ++m) _Pragma("unroll") for (int n = 0; n < 8; ++n) acc[m][n] = (f32x4){0.f, 0.f, 0.f, 0.f}; } while (0)
        int it = 0;
        for (int j = vcu; j < ntiles; j += G, ++it) {
            __syncthreads();
            for (int s = 0; s < 64; s += 4) {
                if ((s & 31) == 0) M_ZERO();
                M_COMPUTE(0, 0); __syncthreads();
                M_COMPUTE(8192, 1); __syncthreads();
                M_COMPUTE(0, 0); __syncthreads();
                M_COMPUTE(8192, 1);
                if (s == 28) {
#pragma unroll
                    for (int m = 0; m < 4; ++m)
#pragma unroll
                        for (int n = 0; n < 8; ++n) {
                            const f32x4 gv = acc[m][n];
                            u32x2 w; w.x = cvtpk(silu_f(gv[0]), silu_f(gv[1])); w.y = cvtpk(silu_f(gv[2]), silu_f(gv[3]));
                            const int kc = 16 * wc + 2 * n + (fq >> 1);
                            *(LAS u32x2*)(lds + ACT + kc * 2048 + ((rowm[m] ^ ((kc & 3) << 1)) * 16) + (fq & 1) * 8) = w;
                        }
                } else if (s == 60) {
#pragma unroll
                    for (int m = 0; m < 4; ++m)
#pragma unroll
                        for (int n = 0; n < 8; ++n) {
                            const f32x4 uv = acc[m][n];
                            const int kc = 16 * wc + 2 * n + (fq >> 1);
                            LAS u32x2* ap = (LAS u32x2*)(lds + ACT + kc * 2048 + ((rowm[m] ^ ((kc & 3) << 1)) * 16) + (fq & 1) * 8);
                            const u32x2 g = *ap;
                            u32x2 w; w.x = cvtpk(bflo(g.x) * uv[0], bfhi(g.x) * uv[1]); w.y = cvtpk(bflo(g.y) * uv[2], bfhi(g.y) * uv[3]);
                            *ap = w;
                        }
                }
                __syncthreads();
            }
            for (int s = 0; s < 32; s += 4) {
                if ((s & 7) == 0) M_ZERO();
                M_COMPUTE(ACT + (s & 7) * 8192, 0); __syncthreads();
                M_COMPUTE(ACT + ((s + 1) & 7) * 8192, 1); __syncthreads();
                M_COMPUTE(ACT + ((s + 2) & 7) * 8192, 0); __syncthreads();
                M_COMPUTE(ACT + ((s + 3) & 7) * 8192, 1);
                if ((s & 7) == 4) {
                    const int q = s >> 3;
#pragma unroll
                    for (int m = 0; m < 4; ++m) {
                        const int slot = ((LAS const int*)(lds + SLOTS))[it * 128 + rowm[m]]; const float gw = ((LAS const float*)(lds + GWO))[it * 128 + rowm[m]];
                        if (slot >= 0) {
                            unsigned char* cp = contrib + (size_t)slot * D + q * 256 + 128 * wc + 4 * fq;
                            const float gs = gw * CONTRIB_SCALE;
#pragma unroll
                            for (int n = 0; n < 8; ++n) { const f32x4 v = acc[m][n] * gs; int w = 0; w = __builtin_amdgcn_cvt_pk_fp8_f32(v[0], v[1], w, false); w = __builtin_amdgcn_cvt_pk_fp8_f32(v[2], v[3], w, true); *(int*)(cp + 16 * n) = w; }
                        }
                    }
                }
                __syncthreads();
            }
        }
#undef M_COMPUTE
#undef M_ZERO
    }
}

__device__ __forceinline__ void phase_combine(const Args& a, int G) {
    const int tid = threadIdx.x, lane = tid & 63, wave = __builtin_amdgcn_readfirstlane(tid >> 6), blk = blockIdx.x;
    unsigned char* ws = a.ws;
    const bf16* X1 = (const bf16*)(ws + WS_X1); const unsigned char* contrib = ws + WS_CONTRIB; const float* fg = a.in[I_FG];
    for (int t = blk * NWAVES + wave; t < T; t += G * NWAVES) {
        const float* g2 = (const float*)(ws + WS_ADAF) + (t >> 13) * 6144 + 5 * 1024;
        const int c = 16 * lane;
        float sm[16];
#pragma unroll
        for (int i = 0; i < 16; ++i) sm[i] = 0.f;
#pragma unroll
        for (int k = 0; k < NSLOT; ++k) {
            const u32x4 w = *(const u32x4*)(contrib + ((size_t)t * NSLOT + k) * D + c);
#pragma unroll
            for (int q = 0; q < 4; ++q) {
                const f32x2_t lo = __builtin_amdgcn_cvt_pk_f32_fp8((int)w[q], false), hi = __builtin_amdgcn_cvt_pk_f32_fp8((int)w[q], true);
                sm[4 * q] += lo[0]; sm[4 * q + 1] += lo[1]; sm[4 * q + 2] += hi[0]; sm[4 * q + 3] += hi[1];
            }
        }
        const u32x4 xa = *(const u32x4*)(X1 + (size_t)t * D + c), xb = *(const u32x4*)(X1 + (size_t)t * D + c + 8);
        const float x1[16] = {bflo(xa.x), bfhi(xa.x), bflo(xa.y), bfhi(xa.y), bflo(xa.z), bfhi(xa.z), bflo(xa.w), bfhi(xa.w), bflo(xb.x), bfhi(xb.x), bflo(xb.y), bfhi(xb.y), bflo(xb.z), bfhi(xb.z), bflo(xb.w), bfhi(xb.w)};
        f32x4 xv[4]; float ss = 0.f;
#pragma unroll
        for (int h = 0; h < 4; ++h) {
            const f32x4 gg = *(const f32x4*)(g2 + c + 4 * h);
            const f32x4 xx = {x1[4 * h], x1[4 * h + 1], x1[4 * h + 2], x1[4 * h + 3]};
            const f32x4 mv = {sm[4 * h], sm[4 * h + 1], sm[4 * h + 2], sm[4 * h + 3]};
            const f32x4 v = xx + gg * (mv * (1.f / CONTRIB_SCALE)); xv[h] = v; ss += (v[0] * v[0] + v[1] * v[1]) + (v[2] * v[2] + v[3] * v[3]);
        }
        const float r = rsqrtf(wave_sum(ss) * (1.f / D) + 1e-6f);
#pragma unroll
        for (int h = 0; h < 4; ++h) *(f32x4*)(a.out + (size_t)t * D + c + 4 * h) = (xv[h] * r) * *(const f32x4*)(fg + c + 4 * h);
    }
}

constexpr int NPH = 9;
#ifndef N_LAUNCHES
#define N_LAUNCHES 1
#endif
__global__ void __launch_bounds__(NWAVES * 64, 2) mega(Args a) {
    extern __shared__ __attribute__((aligned(16))) unsigned char lds_raw[];
    ldsp lds = (ldsp)lds_raw;
    const int tid = threadIdx.x, G = gridDim.x, bx = blockIdx.x;
    int vcu = (G % 8 == 0) ? (bx % 8) * (G / 8) + bx / 8 : bx;
    unsigned char* ws = a.ws;
    for (int u = tid; u < (LDS_BYTES - MISC_OFF) / 4; u += NWAVES * 64) ((LAS unsigned*)(lds + MISC_OFF))[u] = 0u;
    __syncthreads();
    volatile LAS unsigned* MISC = (volatile LAS unsigned*)(lds + MISC_OFF);
    XcdBarrier bar; bar.bar = (unsigned*)(ws + WS_CTL) + CW_BAR; bar.x = 0; bar.st = nullptr;
    if (N_LAUNCHES == 1) {
        bar = xcd_barrier_post((unsigned*)(ws + WS_CTL) + CW_BAR, MISC + 8);
        if (tid == 0) MISC[16] = atomicAdd((unsigned*)(ws + WS_CTL) + CW_XRANK + 64 * bar.x, 1u);
    }
    const int lo = a.ph_lo, hi = a.ph_hi;
#ifndef PH_MASK
#define PH_MASK 0x1ff
#endif
#define IN(k) (((PH_MASK >> (k)) & 1) && lo <= (k) && (k) < hi)
#define SEAM(k) do { if (IN(k) && IN((k) + 1)) xcd_barrier(bar); } while (0)
#ifndef PH_DUP
#define PH_DUP -1
#endif
#define REP(k) for (int rep_ = 0; rep_ < ((PH_DUP == (k)) ? 2 : 1); ++rep_)
    if (IN(0)) REP(0) { phase_prep(a, lds, G); } SEAM(0);
    if (N_LAUNCHES == 1 && IN(0) && IN(1)) {
        unsigned basex = 0;
        for (unsigned j = 0; j < bar.x; ++j) basex += xb_ld(&bar.bar[XB_XCNT(j)]);
        vcu = (int)(basex + MISC[16]);
    }
    if (IN(1)) REP(1) { phase_hnorm(a, lds, G); } SEAM(1);
    if (IN(2)) REP(2) {
        pg8::Gemm g{(const pg8::bf16_t*)(ws + WS_H), (const pg8::bf16_t*)(ws + WS_WINT), MH, DIN, D};
        WinOrder S; S.init(G, bx);
        EpiWin E{(bf16*)(ws + WS_Z), (bf16*)(ws + WS_KVC), (const float*)(ws + WS_ROPE)};
        pg8::gemm_phase<EpiWin, WinOrder, true, true>(lds, g, S, E);
    } SEAM(2);
    if (IN(3)) REP(3) { phase_mixers(a, lds, G, vcu); } SEAM(3);
    if (IN(4)) REP(4) {
        { pg8::Gemm g{(const pg8::bf16_t*)(ws + WS_A), (const pg8::bf16_t*)(ws + WS_WAT), T, D, 512};
          pg8::StaticOrder S; S.init(T, D, G, bx);
          EpiMergeA E{(const bf16*)(ws + WS_Z), (bf16*)(ws + WS_Y)};
          pg8::gemm_phase<EpiMergeA, pg8::StaticOrder, true, true>(lds, g, S, E); }
        { pg8::Gemm g{(const pg8::bf16_t*)(ws + WS_O), (const pg8::bf16_t*)(ws + WS_WBT), T, D, 512};
          pg8::StaticOrder S; S.init(T, D, G, bx);
          EpiMergeB E{(const bf16*)(ws + WS_Z), (bf16*)(ws + WS_Y)};
          pg8::gemm_phase<EpiMergeB, pg8::StaticOrder, true, true>(lds, g, S, E); }
    } SEAM(4);
    if (IN(5)) REP(5) {
        pg8::Gemm g{(const pg8::bf16_t*)(ws + WS_Y), (const pg8::bf16_t*)(ws + WS_WOT), T, D, D};
        pg8::StaticOrder S; S.init(T, D, G, bx);
        EpiWo E{a.in[I_X], (const float*)(ws + WS_ADAF), (bf16*)(ws + WS_X1)};
        pg8::gemm_phase<EpiWo, pg8::StaticOrder, true, true>(lds, g, S, E);
    } SEAM(5);
    if (IN(6)) { for (int it = vcu; it < T / 64; it += G) router_item(a, lds, it); } SEAM(6);
    if (IN(7)) REP(7) { phase_moe(a, lds, G, vcu); } SEAM(7);
    if (IN(8)) REP(8) { phase_combine(a, G); }
#undef IN
#undef SEAM
}

extern "C" void kernel_launch(void* const* d_in, const int* in_sizes, int n_in, void* d_out, int out_size, void* d_ws, size_t ws_size, hipStream_t stream) {
    static int grid = 0;
    if (grid == 0) {
        if (n_in != 26 || out_size != T * D || ws_size < WS_END) { fprintf(stderr, "kernel_launch: unexpected shapes (n_in %d, out %d, ws %zu)\n", n_in, out_size, ws_size); grid = -1; return; }
        int dev = 0, cus = 0, per_cu = 0;
        (void)hipGetDevice(&dev); (void)hipDeviceGetAttribute(&cus, hipDeviceAttributeMultiprocessorCount, dev);
        (void)hipFuncSetAttribute((const void*)mega, hipFuncAttributeMaxDynamicSharedMemorySize, LDS_BYTES);
        (void)hipOccupancyMaxActiveBlocksPerMultiprocessor(&per_cu, (const void*)mega, NWAVES * 64, LDS_BYTES);
        (void)hipGetLastError();
        if (per_cu < 1) { fprintf(stderr, "kernel_launch: occupancy query says %d blocks per CU\n", per_cu); per_cu = 1; }
        if (cus * MOE_MAXT < T * 8 / 128 + NEXP + T / 128) { fprintf(stderr, "kernel_launch: %d CUs are too few for the expert tile tables\n", cus); grid = -1; return; }
        grid = cus;
    }
    if (grid < 0) return;
    (void)hipMemsetAsync((char*)d_ws + WS_CTL, 0, CTL_ZERO_BYTES, stream);
    Args a{};
    for (int i = 0; i < 26; ++i) a.in[i] = (const float*)d_in[i];
    a.out = (float*)d_out; a.ws = (unsigned char*)d_ws;
    if (N_LAUNCHES == 1) {
        a.ph_lo = 0; a.ph_hi = NPH;
        void* kargs[] = {&a};
        hipError_t e = hipLaunchCooperativeKernel((const void*)mega, dim3(grid), dim3(NWAVES * 64), kargs, LDS_BYTES, stream);
        if (e != hipSuccess) fprintf(stderr, "kernel_launch: cooperative launch failed: %s (grid %d)\n", hipGetErrorString(e), grid);
    } else {
#ifndef HOST_DUP
#define HOST_DUP -1
#endif
        for (int li = 0; li < NPH; ++li) {
            a.ph_lo = li; a.ph_hi = li + 1;
            hipLaunchKernelGGL(mega, dim3(grid), dim3(NWAVES * 64), LDS_BYTES, stream, a);
            if (li == HOST_DUP) {
                if (li == 6) (void)hipMemsetAsync((char*)d_ws + WS_CTL, 0, CTL_ZERO_BYTES, stream);
                hipLaunchKernelGGL(mega, dim3(grid), dim3(NWAVES * 64), LDS_BYTES, stream, a);
            }
        }
    }
}
```

```cpp
#include <hip/hip_runtime.h>
#include <cstdio>
#include <cstdint>
#include <type_traits>
namespace pg8 {
#define PG8_LAS __attribute__((address_space(3)))
typedef unsigned short bf16_t;
typedef short bf16x8 __attribute__((ext_vector_type(8)));
typedef float f32x4 __attribute__((ext_vector_type(4)));
typedef unsigned u32x4 __attribute__((ext_vector_type(4)));
constexpr int BM = 256, BK = 64, HALF = 128, HTB = HALF * BK * 2  , STAGE_BYTES = 8 * HTB, NXCD = 8, WGM = 8;

__host__ __device__ __forceinline__ int lds_byte(int r, int c) { const int st = (r >> 4) * 2 + (c >> 5), rr = r & 15, cc = c & 31, ob = rr * 64 + cc * 2; return st * 1024 + (ob ^ (((ob >> 9) & 1) << 5)); }
__host__ __device__ __forceinline__ void stage_rc(int b, int& R, int& C) { const int st = b / 1024, sb = b % 1024, swz = sb ^ (((sb >> 9) & 1) << 5); R = (st >> 1) * 16 + swz / 64; C = (st & 1) * 32 + (swz % 64) / 2; }
__host__ __device__ __forceinline__ int perm32(int rho) { const int n = rho >> 4, i = rho & 15; return 8 * (i >> 2) + 4 * n + (i & 3); }

struct Unit { int pm, pn; };
struct Gemm { const bf16_t* A; const bf16_t* Bt; int M, N, K; };

struct StaticOrder {
    int nM, nN, nwg, G, c;
    __host__ __device__ void init(int M, int N, int G_, int c_) { nM = M / BM; nN = N / BM; nwg = nM * nN; G = G_; c = c_; }
    __host__ __device__ bool next(int i, Unit& u) const {
        const long L = (long)i * G + c; if (L >= nwg) return false;
        int wgid = (int)L; { const int q = nwg / NXCD, r = nwg % NXCD, xcd = wgid % NXCD, off = wgid / NXCD; wgid = (xcd < r ? xcd * (q + 1) : r * (q + 1) + (xcd - r) * q) + off; }
        const int nig = WGM * nN, gid = wgid / nig, fm = gid * WGM, gsz = (nM - fm) < WGM ? (nM - fm) : WGM;
        u.pm = fm + ((wgid % nig) % gsz); u.pn = (wgid % nig) / gsz; return true;
    }
    __device__ __forceinline__ void a_ready(const Unit&) const {}
    __device__ __forceinline__ void done(const Unit&) const {}
};

__device__ __forceinline__ unsigned cvt_pk_bf16(float lo, float hi) { unsigned r; asm volatile("v_cvt_pk_bf16_f32 %0, %1, %2" : "=v"(r) : "v"(lo), "v"(hi)); return r; }
template <class Epi, class Sched, bool ALIGN_EPI = false, bool SP2 = false>
__device__ __forceinline__ void gemm_phase(PG8_LAS unsigned char* lds, const Gemm g, const Sched& S, const Epi& E) {
    const int tid = threadIdx.x, wid = __builtin_amdgcn_readfirstlane(tid >> 6), lane = tid & 63, wr = wid >> 2, wc = wid & 3, fr = lane & 15, fq = lane >> 4;
    const int K = g.K, nt = K / BK;
    unsigned voffA[2], voffB[2];
#pragma unroll
    for (int i = 0; i < 2; ++i) { int R, C; stage_rc(tid * 16 + i * 8192, R, C); const int Rb = Epi::PERM ? ((R & ~31) + perm32(R & 31)) : R;
        voffA[i] = (unsigned)(R * K + C) * 2u; voffB[i] = (unsigned)(Rb * K + C) * 2u; }
    const size_t kstep = (size_t)(BK * 2);
    const size_t hstep = (size_t)HALF * K * 2;
    const size_t tstep = 2 * hstep;
    const unsigned ldsw = (unsigned)wid * 1024u;
    const int aoff = lds_byte(wr * 64 + fr, fq * 8), boff = lds_byte(wc * 32 + fr, fq * 8);
#define PG8_SA(b, h) (((b) * 2 + (h)) * HTB)
#define PG8_SB(b, h) ((4 + (b) * 2 + (h)) * HTB)
#define PG8_STAGE(bufoff, gbase, voff) do { _Pragma("unroll") for (int _i = 0; _i < 2; ++_i) \
        __builtin_amdgcn_global_load_lds((const unsigned*)((const char*)(gbase) + (voff)[_i]), (PG8_LAS unsigned*)(lds + (bufoff) + ldsw + _i * 8192), 16, 0, 0); } while (0)
#define PG8_LDA(dst, b, h) do { _Pragma("unroll") for (int m = 0; m < 4; ++m) _Pragma("unroll") for (int k = 0; k < 2; ++k) dst[m][k] = *(const PG8_LAS bf16x8*)(lds + PG8_SA(b, h) + aoff + m * 2048 + k * 1024); } while (0)
#define PG8_LDB(dst, b, h) do { _Pragma("unroll") for (int n = 0; n < 2; ++n) _Pragma("unroll") for (int k = 0; k < 2; ++k) dst[n][k] = *(const PG8_LAS bf16x8*)(lds + PG8_SB(b, h) + boff + n * 2048 + k * 1024); } while (0)
#define PG8_MMA(ai, bj, At, Bt) do { __builtin_amdgcn_s_setprio(1); _Pragma("unroll") for (int m = 0; m < 4; ++m) _Pragma("unroll") for (int n = 0; n < 2; ++n) _Pragma("unroll") for (int k = 0; k < 2; ++k) \
        acc[ai][bj][m][n] = __builtin_amdgcn_mfma_f32_16x16x32_bf16(Bt[n][k], At[m][k], acc[ai][bj][m][n], 0, 0, 0); __builtin_amdgcn_s_setprio(0); } while (0)
#define PG8_WAIT_V(n) asm volatile("s_waitcnt vmcnt(" #n ")" ::: "memory")
#define PG8_WAIT_L(n) asm volatile("s_waitcnt lgkmcnt(" #n ")" ::: "memory")
#define PG8_BAR __builtin_amdgcn_s_barrier()
#define PG8_SCHED __builtin_amdgcn_sched_barrier(0)
    Unit cur, nxt; int ui = 0;
    if (!S.next(0, cur)) return;
    f32x4 acc[2][2][4][2];
#pragma unroll
    for (int a = 0; a < 2; ++a)
#pragma unroll
        for (int b = 0; b < 2; ++b)
#pragma unroll
            for (int m = 0; m < 4; ++m)
#pragma unroll
                for (int n = 0; n < 2; ++n) acc[a][b][m][n] = (f32x4){0.f, 0.f, 0.f, 0.f};
    bf16x8 At[4][2], B0[2][2], B1[2][2];
    const char* cA = (const char*)g.A + (size_t)cur.pm * tstep; const char* cB = (const char*)g.Bt + (size_t)cur.pn * tstep;
    S.a_ready(cur);
    if constexpr (SP2) {
        PG8_STAGE(PG8_SB(0, 0), cB, voffB); PG8_STAGE(PG8_SB(0, 1), cB + hstep, voffB); PG8_STAGE(PG8_SA(0, 0), cA, voffA); PG8_STAGE(PG8_SA(0, 1), cA + hstep, voffA);
        if (wr == 1) PG8_BAR;
        PG8_WAIT_V(2); PG8_BAR;
        PG8_STAGE(PG8_SB(1, 0), cB + kstep, voffB); PG8_STAGE(PG8_SA(1, 0), cA + kstep, voffA); PG8_STAGE(PG8_SB(1, 1), cB + hstep + kstep, voffB);
        PG8_WAIT_V(6); PG8_BAR;
    } else {
        PG8_STAGE(PG8_SB(0, 0), cB, voffB); PG8_STAGE(PG8_SA(0, 0), cA, voffA); PG8_STAGE(PG8_SB(0, 1), cB + hstep, voffB); PG8_STAGE(PG8_SA(0, 1), cA + hstep, voffA);
        if (wr == 1) PG8_BAR;
        PG8_WAIT_V(4); PG8_BAR;
        PG8_STAGE(PG8_SB(1, 0), cB + kstep, voffB); PG8_STAGE(PG8_SA(1, 0), cA + kstep, voffA); PG8_STAGE(PG8_SB(1, 1), cB + hstep + kstep, voffB);
        PG8_WAIT_V(6); PG8_BAR;
    }
    for (;;) {
        const bool has_next = S.next(ui + 1, nxt);
        const char* nA = has_next ? (const char*)g.A + (size_t)nxt.pm * tstep : cA; const char* nB = has_next ? (const char*)g.Bt + (size_t)nxt.pn * tstep : cB;
        for (int t = 0; t < nt; t += 2) {
            const bool last = (t == nt - 2);
            const char* a1 = cA + (size_t)(t + 1) * kstep;
            const char* a2 = last ? nA : cA + (size_t)(t + 2) * kstep; const char* b2 = last ? nB : cB + (size_t)(t + 2) * kstep;
            const char* a3 = a2 + kstep; const char* b3 = b2 + kstep;
            if (last && has_next) S.a_ready(nxt);
            if constexpr (SP2) {
            PG8_LDB(B0, 0, 0); PG8_LDB(B1, 0, 1); PG8_SCHED; PG8_LDA(At, 0, 0); PG8_STAGE(PG8_SA(1, 1), a1 + hstep, voffA);
            PG8_WAIT_V(8); PG8_WAIT_L(0); PG8_BAR; PG8_MMA(0, 0, At, B0); PG8_MMA(0, 1, At, B1); PG8_BAR; PG8_SCHED;
            PG8_LDA(At, 0, 1); PG8_STAGE(PG8_SB(0, 0), b2, voffB); PG8_STAGE(PG8_SB(0, 1), b2 + hstep, voffB); PG8_STAGE(PG8_SA(0, 0), a2, voffA);
            PG8_WAIT_V(8); PG8_WAIT_L(0); PG8_BAR; PG8_MMA(1, 0, At, B0); PG8_MMA(1, 1, At, B1); PG8_BAR; PG8_SCHED;
            PG8_LDB(B0, 1, 0); PG8_LDB(B1, 1, 1); PG8_SCHED; PG8_LDA(At, 1, 0); PG8_STAGE(PG8_SA(0, 1), a2 + hstep, voffA);
            PG8_WAIT_V(8); PG8_WAIT_L(0); PG8_BAR; PG8_MMA(0, 0, At, B0); PG8_MMA(0, 1, At, B1); PG8_BAR; PG8_SCHED;
            PG8_LDA(At, 1, 1); PG8_STAGE(PG8_SB(1, 0), b3, voffB); PG8_STAGE(PG8_SB(1, 1), b3 + hstep, voffB); PG8_STAGE(PG8_SA(1, 0), a3, voffA);
            PG8_WAIT_V(8); PG8_WAIT_L(0); PG8_BAR; PG8_MMA(1, 0, At, B0); PG8_MMA(1, 1, At, B1); PG8_BAR; PG8_SCHED;
            } else {
            PG8_LDB(B0, 0, 0); PG8_SCHED; PG8_LDA(At, 0, 0); PG8_STAGE(PG8_SA(1, 1), a1 + hstep, voffA);
            PG8_WAIT_L(8); PG8_BAR; PG8_WAIT_L(0); PG8_MMA(0, 0, At, B0); PG8_BAR; PG8_SCHED;
            PG8_LDB(B1, 0, 1); PG8_STAGE(PG8_SB(0, 0), b2, voffB);
            PG8_BAR; PG8_WAIT_L(0); PG8_MMA(0, 1, At, B1); PG8_BAR;
            PG8_LDA(At, 0, 1); PG8_STAGE(PG8_SA(0, 0), a2, voffA);
            PG8_BAR; PG8_WAIT_L(0); PG8_MMA(1, 0, At, B0); PG8_BAR; PG8_SCHED;
            PG8_STAGE(PG8_SB(0, 1), b2 + hstep, voffB);
            PG8_WAIT_V(6); PG8_BAR; PG8_MMA(1, 1, At, B1); PG8_BAR;
            PG8_LDB(B0, 1, 0); PG8_SCHED; PG8_LDA(At, 1, 0); PG8_STAGE(PG8_SA(0, 1), a2 + hstep, voffA);
            PG8_WAIT_L(8); PG8_BAR; PG8_WAIT_L(0); PG8_MMA(0, 0, At, B0); PG8_BAR; PG8_SCHED;
            PG8_LDB(B1, 1, 1); PG8_STAGE(PG8_SB(1, 0), b3, voffB);
            PG8_BAR; PG8_WAIT_L(0); PG8_MMA(0, 1, At, B1); PG8_BAR;
            PG8_LDA(At, 1, 1); PG8_STAGE(PG8_SA(1, 0), a3, voffA);
            PG8_BAR; PG8_WAIT_L(0); PG8_MMA(1, 0, At, B0); PG8_BAR; PG8_SCHED;
            PG8_STAGE(PG8_SB(1, 1), b3 + hstep, voffB);
            PG8_WAIT_V(6); PG8_BAR; PG8_MMA(1, 1, At, B1); PG8_BAR;
            }
        }
        if constexpr (ALIGN_EPI) { if (wr == 0) PG8_BAR; }
        if constexpr (!Epi::AFTER_DRAIN) { E(acc, cur, wr, wc, fr, fq); S.done(cur); }
        if (!has_next) break;
#pragma unroll
        for (int a = 0; a < 2; ++a)
#pragma unroll
            for (int b = 0; b < 2; ++b)
#pragma unroll
                for (int m = 0; m < 4; ++m)
#pragma unroll
                    for (int n = 0; n < 2; ++n) acc[a][b][m][n] = (f32x4){0.f, 0.f, 0.f, 0.f};
        cur = nxt; cA = nA; cB = nB; ++ui;
        if constexpr (ALIGN_EPI) { if (wr == 1) PG8_BAR; }
    }
    PG8_WAIT_V(0);
    if constexpr (!ALIGN_EPI) { if (wr == 0) PG8_BAR; }
    PG8_BAR;
    if constexpr (Epi::AFTER_DRAIN) { E.fused(acc, cur, wr, wc, fr, fq, lds, wid, lane); S.done(cur); }
#undef PG8_SA
#undef PG8_SB
#undef PG8_STAGE
#undef PG8_LDA
#undef PG8_LDB
#undef PG8_MMA
#undef PG8_WAIT_V
#undef PG8_WAIT_L
#undef PG8_BAR
#undef PG8_SCHED
}
}
#define GAS __attribute__((address_space(1)))
#define LAS __attribute__((address_space(3)))
typedef unsigned short bf16;
typedef unsigned v4u __attribute__((ext_vector_type(4)));
typedef float f32x4 __attribute__((ext_vector_type(4)));
typedef short bf16x8 __attribute__((ext_vector_type(8)));
typedef GAS unsigned gu32;
typedef GAS unsigned long long gu64;
#define RLX_AGENT __ATOMIC_RELAXED, __HIP_MEMORY_SCOPE_AGENT
#define LDS_WAIT() asm volatile("s_waitcnt lgkmcnt(0)" ::: "memory")
#define VM_WAIT() asm volatile("s_waitcnt vmcnt(0)" ::: "memory")
__device__ __forceinline__ unsigned long long rt() { return __builtin_amdgcn_s_memrealtime(); }
__device__ __forceinline__ unsigned f2bf(float f) { unsigned u = __builtin_bit_cast(unsigned, f); return (u + 0x7fffu + ((u >> 16) & 1u)) >> 16; }
__device__ __forceinline__ unsigned pk2(float lo, float hi) { return f2bf(lo) | (f2bf(hi) << 16); }

#define XB_TMO      128
#define XB_XCNT(j)  (256  + 64 * (j))
#define XB_XSUB(j)  (1280 + 64 * (j))
#define XB_XGEN(j)  (2304 + 64 * (j))
#define XB_TOP      3328
#define XB_TOPGEN   3392
#define XCD_BAR_WORDS 3456
#define XB_SPIN_CAP (1u << 18)

__device__ __forceinline__ unsigned xb_ld(unsigned* p)              { return __hip_atomic_load(p, __ATOMIC_RELAXED, __HIP_MEMORY_SCOPE_AGENT); }
__device__ __forceinline__ unsigned xb_add(unsigned* p, unsigned v) { return __hip_atomic_fetch_add(p, v, __ATOMIC_RELAXED, __HIP_MEMORY_SCOPE_AGENT); }
__device__ __forceinline__ unsigned xb_xcc_id() { return (unsigned)__builtin_amdgcn_s_getreg((3 << 11) | 20) & 0xFu; }
#define XB_SPIN(cond, bar) do { unsigned _sp = 0; while (cond) { __builtin_amdgcn_s_sleep(1); \
    if ((++_sp & 255u) == 0u) { if (xb_ld(&(bar)[XB_TMO])) break; if (_sp > XB_SPIN_CAP) { atomicAdd(&(bar)[XB_TMO], 1u); break; } } } } while (0)

struct XcdBarrier {
    unsigned* bar; unsigned x;
    volatile LAS unsigned* st;
};

__device__ __forceinline__ XcdBarrier xcd_barrier_post(unsigned* bar, volatile LAS unsigned* st) {
    XcdBarrier b; b.bar = bar; b.x = xb_xcc_id(); b.st = st;
    if (threadIdx.x == 0) (void)xb_add(&bar[XB_XCNT(b.x)], 1u);
    return b;
}
__device__ __forceinline__ void xcd_barrier_complete(unsigned* bar, unsigned x, unsigned& nloc, unsigned& nx) {
    const unsigned G = gridDim.x * gridDim.y * gridDim.z;
    unsigned sum, cnt, mine, sp = 0u;
    for (;;) {
        sum = 0u; cnt = 0u; mine = 0u;
#pragma unroll
        for (unsigned j = 0; j < 16; ++j) { const unsigned c = xb_ld(&bar[XB_XCNT(j)]); sum += c; cnt += (c > 0u) ? 1u : 0u; mine = (j == x) ? c : mine; }
        if (sum == G) break;
        __builtin_amdgcn_s_sleep(1);
        if ((++sp & 255u) == 0u) { if (xb_ld(&bar[XB_TMO])) break; if (sp > XB_SPIN_CAP) { atomicAdd(&bar[XB_TMO], 1u); break; } }
    }
    nloc = mine > 0u ? mine : 1u; nx = cnt > 0u ? cnt : 1u;
}

__device__ __forceinline__ void xcd_barrier(const XcdBarrier& b) {
    asm volatile("s_waitcnt vmcnt(0)" ::: "memory");
    __syncthreads();
    if (threadIdx.x == 0) {
        unsigned* bar = b.bar;
        __builtin_amdgcn_s_waitcnt(0);
        unsigned nloc = b.st[0], nx = b.st[1];
        if (nloc == 0u) { xcd_barrier_complete(bar, b.x, nloc, nx); b.st[0] = nloc; b.st[1] = nx; }
        const unsigned old = xb_add(&bar[XB_XSUB(b.x)], 1u);
        const unsigned gen = old / nloc;
        if (old + 1u == (gen + 1u) * nloc) {
            __builtin_amdgcn_fence(__ATOMIC_RELEASE, "agent");
            asm volatile("s_waitcnt vmcnt(0)" ::: "memory");
            const unsigned og = xb_add(&bar[XB_TOP], 1u);
            const unsigned tg = og / nx;
            if (og + 1u == (tg + 1u) * nx) xb_add(&bar[XB_TOPGEN], 1u);
            else XB_SPIN(xb_ld(&bar[XB_TOPGEN]) == tg, bar);
            __builtin_amdgcn_fence(__ATOMIC_ACQUIRE, "agent");
            xb_add(&bar[XB_XGEN(b.x)], 1u);
            asm volatile("s_waitcnt vmcnt(0)" ::: "memory");
        } else {
            XB_SPIN(xb_ld(&bar[XB_XGEN(b.x)]) == gen, bar);
            __builtin_amdgcn_fence(__ATOMIC_ACQUIRE, "agent");
            asm volatile("s_waitcnt vmcnt(0)" ::: "memory");
        }
    }
    __syncthreads();
}

constexpr int T = 16384, D = 1024, SEQ = 8192, NCTX = 256, TCX = 512, DIN = 3840, MH = T + TCX;
constexpr int ZU = 0, ZV = 512, ZQ = 1024, ZK = 1536, ZVA = 1664, ZGA = 1792, ZGB = 2816;
constexpr int NEXP = 256, NSLOT = 9, LISTCAP = 16384, MOE_MAXT = 24;
constexpr float LOG2E = 1.4426950408889634f;
constexpr float QSCALE = 0.125f * LOG2E;
constexpr size_t MiB = 1u << 20;
constexpr size_t WS_CTL = 0, CTL_ZERO_BYTES = 1 * MiB;
constexpr size_t WS_ADAP = 1 * MiB;
constexpr size_t WS_ADAF = 2 * MiB;
constexpr size_t WS_ROPE = 2 * MiB + 128 * 1024;
constexpr size_t WS_WST = 2 * MiB + 256 * 1024;
constexpr size_t WS_RWT = 3 * MiB;
constexpr size_t WS_WINT = 4 * MiB;
constexpr size_t WS_WAT = 12 * MiB, WS_WBT = 13 * MiB, WS_WOT = 14 * MiB;
constexpr size_t WS_KVC = 16 * MiB;
constexpr size_t WS_GATEW = 17 * MiB;
constexpr size_t WS_H = 18 * MiB;
constexpr size_t WS_Z = 52 * MiB;
constexpr size_t WS_A = 172 * MiB, WS_O = 188 * MiB;
constexpr size_t WS_TMP = 204 * MiB;
constexpr size_t WS_Y = 268 * MiB;
constexpr size_t WS_X1 = 300 * MiB;
constexpr size_t WS_H2 = 364 * MiB;
constexpr size_t WS_LIST = 396 * MiB;
constexpr size_t WS_CONTRIB = 414 * MiB;
constexpr float CONTRIB_SCALE = 16.f;
constexpr size_t WS_END = 704 * MiB;
constexpr int CW_BAR = 4096;
constexpr int CW_CNT = 16384;
constexpr int CW_XRANK = 32768;
constexpr int SCR_BYTES = 148480;
constexpr int MISC_OFF = SCR_BYTES;
constexpr int LDS_BYTES = 152 * 1024;
constexpr int NWAVES = 8;

typedef float f32x2_t __attribute__((ext_vector_type(2)));
typedef __bf16 bf16x2_t __attribute__((ext_vector_type(2)));
typedef float f32x16 __attribute__((ext_vector_type(16)));
typedef short s16x4 __attribute__((ext_vector_type(4)));
typedef short v4i16_t __attribute__((ext_vector_type(4)));
typedef unsigned u32x2 __attribute__((ext_vector_type(2)));
typedef unsigned u32x4 __attribute__((ext_vector_type(4)));
typedef LAS unsigned char* ldsp;

__device__ __forceinline__ unsigned cvtpk(float lo, float hi) { f32x2_t v = {lo, hi}; bf16x2_t b = __builtin_convertvector(v, bf16x2_t); return __builtin_bit_cast(unsigned, b); }
__device__ __forceinline__ float bf2f(unsigned short u) { return __uint_as_float((unsigned)u << 16); }
__device__ __forceinline__ float bflo(unsigned w) { return __uint_as_float(w << 16); }
__device__ __forceinline__ float bfhi(unsigned w) { return __uint_as_float(w & 0xffff0000u); }
__device__ __forceinline__ float wave_sum(float v) {
#pragma unroll
    for (int o = 1; o < 64; o <<= 1) v += __shfl_xor(v, o);
    return v;
}
__device__ __forceinline__ float sigmoid_f(float x) { return __builtin_amdgcn_rcpf(1.f + __builtin_amdgcn_exp2f(-x * LOG2E)); }
__device__ __forceinline__ float silu_f(float x) { return x * sigmoid_f(x); }
__device__ __forceinline__ float gelu_f(float x) { const float u = 0.7978845608028654f * (x + 0.044715f * x * x * x); return x * sigmoid_f(2.f * u); }
__device__ __forceinline__ f32x16 mfma32(bf16x8 a, bf16x8 b, f32x16 c) { return __builtin_amdgcn_mfma_f32_32x32x16_bf16(a, b, c, 0, 0, 0); }
__device__ __forceinline__ f32x4 mfma16(bf16x8 a, bf16x8 b, f32x4 c) { return __builtin_amdgcn_mfma_f32_16x16x32_bf16(a, b, c, 0, 0, 0); }

struct Args { const float* in[26]; float* out; unsigned char* ws; int ph_lo, ph_hi; };
enum { I_X = 0, I_C, I_CTX, I_CCTX, I_ADAW, I_ADAB, I_N1G, I_N2G, I_WIN, I_LNG, I_LNB, I_GWS, I_GBS, I_SINK, I_WA, I_WB, I_WO, I_RW, I_RB, I_EG, I_EU, I_ED, I_SG, I_SU, I_SD, I_FG };

__device__ __forceinline__ void p0_transpose_item(const float* W, int K, int N, bf16* WT, LAS float* scr, int item, int lane) {
    const int nblk = N / 32, kb = item / nblk, nb = item % nblk, k0 = 64 * kb, n0 = 32 * nb;
#pragma unroll 8
    for (int i = 0; i < 32; ++i) { const int kk = 2 * i + (lane >> 5); scr[kk * 33 + (lane & 31)] = W[(size_t)(k0 + kk) * N + n0 + (lane & 31)]; }
    LDS_WAIT(); asm volatile("" ::: "memory");
    const int c = lane & 7;
#pragma unroll
    for (int j = 0; j < 4; ++j) { const int n = (lane >> 3) + 8 * j; const LAS float* s = scr + (8 * c) * 33 + n;
        v4u o; o.x = pk2(s[0 * 33], s[1 * 33]); o.y = pk2(s[2 * 33], s[3 * 33]); o.z = pk2(s[4 * 33], s[5 * 33]); o.w = pk2(s[6 * 33], s[7 * 33]);
        *(GAS v4u*)(WT + (size_t)(n0 + n) * K + k0 + 8 * c) = o; }
    LDS_WAIT(); asm volatile("" ::: "memory");
}

__device__ __forceinline__ void phase_prep(const Args& a, ldsp lds, int G) {
    const int tid = threadIdx.x, lane = tid & 63, wave = __builtin_amdgcn_readfirstlane(tid >> 6), blk = blockIdx.x;
    unsigned char* ws = a.ws;
    if (blk < 192) {
        const int cb = blk % 24, kc = blk / 24, col = cb * 256 + lane * 4, k0 = kc * 128 + wave * 16;
        const float* c = a.in[I_C]; const float* cc = a.in[I_CCTX]; const float* aw = a.in[I_ADAW];
        f32x4 a0 = {0.f, 0.f, 0.f, 0.f}, a1 = a0, a2 = a0;
#pragma unroll 4
        for (int k = 0; k < 16; ++k) {
            const int kk = k0 + k;
            const float s0 = silu_f(c[kk]), s1 = silu_f(c[1024 + kk]), s2 = silu_f(cc[kk]);
            const f32x4 w = *(const f32x4*)(aw + (size_t)kk * 6144 + col);
            a0 += w * s0; a1 += w * s1; a2 += w * s2;
        }
        LAS float* red = (LAS float*)lds;
        *(LAS f32x4*)(red + (wave * 3 + 0) * 256 + lane * 4) = a0;
        *(LAS f32x4*)(red + (wave * 3 + 1) * 256 + lane * 4) = a1;
        *(LAS f32x4*)(red + (wave * 3 + 2) * 256 + lane * 4) = a2;
        __syncthreads();
        float* adap = (float*)(ws + WS_ADAP);
        for (int idx = tid; idx < 768; idx += 512) {
            const int v = idx >> 8, cl = idx & 255; float s = 0.f;
#pragma unroll
            for (int w = 0; w < 8; ++w) s += red[(w * 3 + v) * 256 + cl];
            adap[(size_t)(kc * 3 + v) * 6144 + cb * 256 + cl] = s;
        }
        __syncthreads();
    }
    {
        LAS float* scr = (LAS float*)(lds + wave * 8704);
        const int gw = blk * NWAVES + wave, NGW = G * NWAVES;
        constexpr int I_1 = 16 * 120, I_2 = 8 * 32, I_3 = 8 * 32, I_4 = 16 * 32, I_5 = 16 * 8;
        for (int it = gw; it < I_1 + I_2 + I_3 + I_4 + I_5; it += NGW) {
            int r = it;
            if (r < I_1) { p0_transpose_item(a.in[I_WIN], 1024, 3840, (bf16*)(ws + WS_WINT), scr, r, lane); continue; } r -= I_1;
            if (r < I_2) { p0_transpose_item(a.in[I_WA], 512, 1024, (bf16*)(ws + WS_WAT), scr, r, lane); continue; } r -= I_2;
            if (r < I_3) { p0_transpose_item(a.in[I_WB], 512, 1024, (bf16*)(ws + WS_WBT), scr, r, lane); continue; } r -= I_3;
            if (r < I_4) { p0_transpose_item(a.in[I_WO], 1024, 1024, (bf16*)(ws + WS_WOT), scr, r, lane); continue; } r -= I_4;
            p0_transpose_item(a.in[I_RW], 1024, 256, (bf16*)(ws + WS_RWT), scr, r, lane);
        }
    }
    {
        const int gt = blk * 512 + tid, NT = G * 512;
        const float* gws = a.in[I_GWS]; bf16* wst = (bf16*)(ws + WS_WST);
        for (int i = gt; i < 8192; i += NT) {
            const f32x4 x0 = *(const f32x4*)(gws + i * 8), x1 = *(const f32x4*)(gws + i * 8 + 4);
            v4u o; o.x = cvtpk(x0[0], x0[1]); o.y = cvtpk(x0[2], x0[3]); o.z = cvtpk(x1[0], x1[1]); o.w = cvtpk(x1[2], x1[3]);
            *(v4u*)(wst + i * 8) = o;
        }
        float* rope = (float*)(ws + WS_ROPE);
        for (int i = gt; i < 2048; i += NT) {
            const int pos = i >> 4, f = i & 15;
            const float inv = __builtin_amdgcn_exp2f(-(float)f * (13.287712379549449f / 16.f));
            const float ang = (float)pos * inv;
            double rev = (double)ang * 0.15915494309189535; rev -= floor(rev);
            rope[pos * 32 + f] = __builtin_amdgcn_cosf((float)rev);
            rope[pos * 32 + 16 + f] = __builtin_amdgcn_sinf((float)rev);
        }
    }
}

__device__ __forceinline__ void phase_hnorm(const Args& a, ldsp lds, int G) {
    const int tid = threadIdx.x, lane = tid & 63, wave = __builtin_amdgcn_readfirstlane(tid >> 6), blk = blockIdx.x;
    unsigned char* ws = a.ws;
    const float* adap = (const float*)(ws + WS_ADAP); const float* adab = a.in[I_ADAB];
    LAS float* modv = (LAS float*)lds;
    for (int idx = tid; idx < 3 * 2048; idx += 512) {
        const int v = idx >> 11, j = idx & 2047; float s = adab[j];
#pragma unroll
        for (int kc = 0; kc < 8; ++kc) s += adap[(size_t)(kc * 3 + v) * 6144 + j];
        modv[idx] = (j >= 1024) ? s + 1.f : s;
    }
    { float* adaf = (float*)(ws + WS_ADAF);
      for (int idx = blk * 512 + tid; idx < 3 * 6144; idx += G * 512) {
          const int v = idx / 6144, j = idx % 6144; float s = adab[j];
#pragma unroll
          for (int kc = 0; kc < 8; ++kc) s += adap[(size_t)(kc * 3 + v) * 6144 + j];
          adaf[idx] = s; } }
    __syncthreads();
    const float* g1 = a.in[I_N1G]; bf16* H = (bf16*)(ws + WS_H);
    for (int t = blk * NWAVES + wave; t < MH; t += G * NWAVES) {
        const float* xr = (t < T) ? a.in[I_X] + (size_t)t * D : a.in[I_CTX] + (size_t)(t - T) * D;
        const int v = (t < T) ? (t >> 13) : 2;
        f32x4 x[4]; float ss = 0.f;
#pragma unroll
        for (int j = 0; j < 4; ++j) { x[j] = *(const f32x4*)(xr + 4 * lane + 256 * j); ss += (x[j][0] * x[j][0] + x[j][1] * x[j][1]) + (x[j][2] * x[j][2] + x[j][3] * x[j][3]); }
        const float r = rsqrtf(wave_sum(ss) * (1.f / D) + 1e-6f);
#pragma unroll
        for (int j = 0; j < 4; ++j) {
            const int col = 4 * lane + 256 * j;
            const f32x4 g = *(const f32x4*)(g1 + col);
            const f32x4 sh = *(LAS f32x4*)(modv + v * 2048 + col), sc = *(LAS f32x4*)(modv + v * 2048 + 1024 + col);
            const f32x4 h = (x[j] * r) * g * sc + sh;
            u32x2 o; o.x = cvtpk(h[0], h[1]); o.y = cvtpk(h[2], h[3]);
            *(u32x2*)(H + (size_t)t * D + col) = o;
        }
    }
}

struct WinOrder {
    pg8::StaticOrder so;
    __device__ void init(int G, int c) { so.init(T, DIN, G, c); }
    __device__ bool next(int i, pg8::Unit& u) const {
        const long L = (long)i * so.G + so.c;
        if (L < 960) return so.next(i, u);
        if (L < 962) { u.pm = 64 + (int)(L - 960); u.pn = 6; return true; }
        return false;
    }
    __device__ __forceinline__ void a_ready(const pg8::Unit&) const {}
    __device__ __forceinline__ void done(const pg8::Unit&) const {}
};
struct EpiWin {
    static constexpr bool PERM = false, AFTER_DRAIN = false;
    bf16* Z; bf16* KVC; const float* rope;
    __device__ __forceinline__ void operator()(const pg8::f32x4 (&acc)[2][2][4][2], const pg8::Unit& u, int wr, int wc, int fr, int fq) const {
        const int row0 = u.pm * 256 + wr * 64 + fr, colb = u.pn * 256 + wc * 32 + 4 * fq, pn = u.pn;
        if (u.pm >= 64) {
#pragma unroll
            for (int ai = 0; ai < 2; ++ai)
#pragma unroll
                for (int m = 0; m < 4; ++m) { bf16* rp = KVC + (size_t)(row0 + ai * 128 + m * 16 - T) * 256 + (colb - ZK);
#pragma unroll
                    for (int bj = 0; bj < 2; ++bj)
#pragma unroll
                        for (int n = 0; n < 2; ++n) { const pg8::f32x4 v = acc[ai][bj][m][n]; u32x2 o; o.x = cvtpk(v[0], v[1]); o.y = cvtpk(v[2], v[3]); *(u32x2*)(rp + bj * 128 + n * 16) = o; } }
            return;
        }
#pragma unroll
        for (int ai = 0; ai < 2; ++ai)
#pragma unroll
            for (int m = 0; m < 4; ++m) {
                const int r = row0 + ai * 128 + m * 16; bf16* rp = Z + (size_t)r * DIN + colb;
                if (pn <= 3) {
#pragma unroll
                    for (int bj = 0; bj < 2; ++bj)
#pragma unroll
                        for (int n = 0; n < 2; ++n) { const pg8::f32x4 v = acc[ai][bj][m][n]; u32x2 o; o.x = cvtpk(gelu_f(v[0]), gelu_f(v[1])); o.y = cvtpk(gelu_f(v[2]), gelu_f(v[3])); *(u32x2*)(rp + bj * 128 + n * 16) = o; }
                } else if (pn <= 6) {
                    const int pos = (wc & 1) ? (r & 63) : ((r & 8191) >> 6);
                    const pg8::f32x4 cs = *(const pg8::f32x4*)(rope + pos * 32 + 4 * fq), sn = *(const pg8::f32x4*)(rope + pos * 32 + 16 + 4 * fq);
                    const float sc = (pn < 6) ? QSCALE : 1.f;
#pragma unroll
                    for (int bj = 0; bj < 2; ++bj) {
                        const pg8::f32x4 x1 = acc[ai][bj][m][0], x2 = acc[ai][bj][m][1];
                        pg8::f32x4 o1, o2;
                        if (pn == 6 && bj == 1) { o1 = x1; o2 = x2; }
                        else { o1 = (x1 * cs - x2 * sn) * sc; o2 = (x2 * cs + x1 * sn) * sc; }
                        u32x2 w1, w2; w1.x = cvtpk(o1[0], o1[1]); w1.y = cvtpk(o1[2], o1[3]); w2.x = cvtpk(o2[0], o2[1]); w2.y = cvtpk(o2[2], o2[3]);
                        *(u32x2*)(rp + bj * 128) = w1; *(u32x2*)(rp + bj * 128 + 16) = w2;
                    }
                } else {
#pragma unroll
                    for (int bj = 0; bj < 2; ++bj)
#pragma unroll
                        for (int n = 0; n < 2; ++n) { const pg8::f32x4 v = acc[ai][bj][m][n]; u32x2 o; o.x = cvtpk(sigmoid_f(v[0]), sigmoid_f(v[1])); o.y = cvtpk(sigmoid_f(v[2]), sigmoid_f(v[3])); *(u32x2*)(rp + bj * 128 + n * 16) = o; }
                }
            }
    }
};
struct EpiMergeA {
    static constexpr bool PERM = true, AFTER_DRAIN = false;
    const bf16* Z; bf16* Y;
    __device__ __forceinline__ void operator()(const pg8::f32x4 (&acc)[2][2][4][2], const pg8::Unit& u, int wr, int wc, int fr, int fq) const {
        const int row0 = u.pm * 256 + wr * 64 + fr, col0 = u.pn * 256 + wc * 32 + 8 * fq;
#pragma unroll
        for (int ai = 0; ai < 2; ++ai)
#pragma unroll
            for (int m = 0; m < 4; ++m) { const int r = row0 + ai * 128 + m * 16;
#pragma unroll
                for (int bj = 0; bj < 2; ++bj) { const int c = col0 + bj * 128;
                    const u32x4 g = *(const u32x4*)(Z + (size_t)r * DIN + ZGA + c);
                    const pg8::f32x4 v0 = acc[ai][bj][m][0], v1 = acc[ai][bj][m][1];
                    u32x4 o;
                    o.x = cvtpk(v0[0] * bflo(g.x), v0[1] * bfhi(g.x)); o.y = cvtpk(v0[2] * bflo(g.y), v0[3] * bfhi(g.y));
                    o.z = cvtpk(v1[0] * bflo(g.z), v1[1] * bfhi(g.z)); o.w = cvtpk(v1[2] * bflo(g.w), v1[3] * bfhi(g.w));
                    *(u32x4*)(Y + (size_t)r * D + c) = o; } }
    }
};
struct EpiMergeB {
    static constexpr bool PERM = true, AFTER_DRAIN = false;
    const bf16* Z; bf16* Y;
    __device__ __forceinline__ void operator()(const pg8::f32x4 (&acc)[2][2][4][2], const pg8::Unit& u, int wr, int wc, int fr, int fq) const {
        const int row0 = u.pm * 256 + wr * 64 + fr, col0 = u.pn * 256 + wc * 32 + 8 * fq;
#pragma unroll
        for (int ai = 0; ai < 2; ++ai)
#pragma unroll
            for (int m = 0; m < 4; ++m) { const int r = row0 + ai * 128 + m * 16;
#pragma unroll
                for (int bj = 0; bj < 2; ++bj) { const int c = col0 + bj * 128;
                    const u32x4 g = *(const u32x4*)(Z + (size_t)r * DIN + ZGB + c);
                    const u32x4 tp = *(const u32x4*)(Y + (size_t)r * D + c);
                    const pg8::f32x4 t0 = {bflo(tp.x), bfhi(tp.x), bflo(tp.y), bfhi(tp.y)}, t1 = {bflo(tp.z), bfhi(tp.z), bflo(tp.w), bfhi(tp.w)};
                    const pg8::f32x4 v0 = acc[ai][bj][m][0], v1 = acc[ai][bj][m][1];
                    u32x4 o;
                    o.x = cvtpk(t0[0] + v0[0] * bflo(g.x), t0[1] + v0[1] * bfhi(g.x)); o.y = cvtpk(t0[2] + v0[2] * bflo(g.y), t0[3] + v0[3] * bfhi(g.y));
                    o.z = cvtpk(t1[0] + v1[0] * bflo(g.z), t1[1] + v1[1] * bfhi(g.z)); o.w = cvtpk(t1[2] + v1[2] * bflo(g.w), t1[3] + v1[3] * bfhi(g.w));
                    *(u32x4*)(Y + (size_t)r * D + c) = o; } }
    }
};
struct EpiWo {
    static constexpr bool PERM = true, AFTER_DRAIN = false;
    const float* x; const float* adaf; bf16* X1;
    __device__ __forceinline__ void operator()(const pg8::f32x4 (&acc)[2][2][4][2], const pg8::Unit& u, int wr, int wc, int fr, int fq) const {
        const int row0 = u.pm * 256 + wr * 64 + fr, col0 = u.pn * 256 + wc * 32 + 8 * fq;
        const float* g1 = adaf + (u.pm >= 32 ? 6144 : 0) + 2048;
#pragma unroll
        for (int bj = 0; bj < 2; ++bj) { const int c = col0 + bj * 128;
            const pg8::f32x4 ga = *(const pg8::f32x4*)(g1 + c), gb = *(const pg8::f32x4*)(g1 + c + 4);
#pragma unroll
            for (int ai = 0; ai < 2; ++ai)
#pragma unroll
                for (int m = 0; m < 4; ++m) { const int r = row0 + ai * 128 + m * 16;
                    const pg8::f32x4 x0 = *(const pg8::f32x4*)(x + (size_t)r * D + c), x1 = *(const pg8::f32x4*)(x + (size_t)r * D + c + 4);
                    const pg8::f32x4 o0 = x0 + ga * acc[ai][bj][m][0], o1 = x1 + gb * acc[ai][bj][m][1];
                    u32x4 w; w.x = cvtpk(o0[0], o0[1]); w.y = cvtpk(o0[2], o0[3]); w.z = cvtpk(o1[0], o1[1]); w.w = cvtpk(o1[2], o1[3]);
                    *(u32x4*)(X1 + (size_t)r * D + c) = w; } }
    }
};


__device__ __forceinline__ s16x4 vtr(LAS const unsigned char* p) { return __builtin_bit_cast(s16x4, __builtin_amdgcn_ds_read_tr16_b64_v4i16((LAS v4i16_t*)p)); }

__device__ __forceinline__ void attn_item(const bf16* Z, const bf16* KVC, const float* sink, bf16* Obuf, ldsp lds, int b, int nb, int hk, int qh) {
    const int tid = threadIdx.x, lane = tid & 63, wave = __builtin_amdgcn_readfirstlane(tid >> 6), r32 = lane & 31, hi = lane >> 5;
    const int rq = wave >> 1, head = hk * 4 + rq;
    const int iq = qh * 64 + (wave & 1) * 32 + r32;
    const int wlo = (nb == 0) ? 2 : qh, whi = (nb == 63) ? 4 : 5 + qh, nwin = whi - wlo, ntile = nwin + 4;
    const int tokq = b * SEQ + nb * 128 + iq;
    bf16x8 qr[4];
#pragma unroll
    for (int d0 = 0; d0 < 4; ++d0) qr[d0] = *(const bf16x8*)(Z + (size_t)tokq * DIN + ZQ + head * 64 + d0 * 16 + hi * 8);
    float mrun = sink[head] * LOG2E, lrun = (hi == 0) ? 1.f : 0.f;
    f32x16 o[2];
#pragma unroll
    for (int j = 0; j < 2; ++j)
#pragma unroll
        for (int r = 0; r < 16; ++r) o[j][r] = 0.f;
    const int kdst = wave * 1024 + lane * 16, vdst = 8192 + (wave >> 2) * 4096 + lane * 64 + (wave & 3) * 16;
#define ATT_SRC(s, kp, vp) do { const int tl_ = (s) < nwin ? wlo + (s) : 6 + (s) - nwin; \
        if (tl_ < 6) { const int tok_ = b * SEQ + (nb - 1 + (tl_ >> 1)) * 128 + (tl_ & 1) * 64 + lane; kp = Z + (size_t)tok_ * DIN + ZK + hk * 64 + wave * 8; vp = Z + (size_t)tok_ * DIN + ZVA + hk * 64 + wave * 8; } \
        else { const int row_ = b * NCTX + (tl_ - 6) * 64 + lane; kp = KVC + (size_t)row_ * 256 + hk * 64 + wave * 8; vp = KVC + (size_t)row_ * 256 + 128 + hk * 64 + wave * 8; } } while (0)
    u32x4 kreg, vreg;
    { const bf16 *kp, *vp; ATT_SRC(0, kp, vp); kreg = *(const u32x4*)kp; vreg = *(const u32x4*)vp; }
    *(LAS u32x4*)(lds + kdst) = kreg; *(LAS u32x4*)(lds + vdst) = vreg;
    __syncthreads();
    const int vrd = ((lane & 15) >> 2) * 64 + ((lane >> 4) & 1) * 32 + (lane & 3) * 8 + hi * 256;
    for (int s = 0; s < ntile; ++s) {
        const int base = (s & 1) * 16384;
        const int tl = s < nwin ? wlo + s : 6 + s - nwin;
        if (s + 1 < ntile) { const bf16 *kp, *vp; ATT_SRC(s + 1, kp, vp); kreg = *(const u32x4*)kp; vreg = *(const u32x4*)vp; }
        {
            f32x16 p0, p1;
#pragma unroll
            for (int r = 0; r < 16; ++r) { p0[r] = 0.f; p1[r] = 0.f; }
#pragma unroll
            for (int d0 = 0; d0 < 4; ++d0) {
                const bf16x8 k0 = *(LAS const bf16x8*)(lds + base + (2 * d0 + hi) * 1024 + r32 * 16);
                const bf16x8 k1 = *(LAS const bf16x8*)(lds + base + (2 * d0 + hi) * 1024 + (r32 + 32) * 16);
                p0 = mfma32(k0, qr[d0], p0); p1 = mfma32(k1, qr[d0], p1);
            }
            if (tl < 2) {
                const int j0 = (tl & 1) * 64 + 4 * hi;
#pragma unroll
                for (int r = 0; r < 16; ++r) { const int j = j0 + (r & 3) + 8 * (r >> 2); if (j < iq) p0[r] = -INFINITY; if (j + 32 < iq) p1[r] = -INFINITY; }
            } else if (tl == 4 || tl == 5) {
                const int j0 = (tl & 1) * 64 + 4 * hi;
#pragma unroll
                for (int r = 0; r < 16; ++r) { const int j = j0 + (r & 3) + 8 * (r >> 2); if (j > iq) p0[r] = -INFINITY; if (j + 32 > iq) p1[r] = -INFINITY; }
            }
            float mx = fmaxf(p0[0], p1[0]);
#pragma unroll
            for (int r = 1; r < 16; ++r) mx = fmaxf(mx, fmaxf(p0[r], p1[r]));
            mx = fmaxf(mx, __shfl_xor(mx, 32));
            const float mn = fmaxf(mrun, mx), alpha = __builtin_amdgcn_exp2f(mrun - mn);
            mrun = mn;
            float rs = 0.f;
#pragma unroll
            for (int r = 0; r < 16; ++r) { p0[r] = __builtin_amdgcn_exp2f(p0[r] - mn); p1[r] = __builtin_amdgcn_exp2f(p1[r] - mn); rs += p0[r] + p1[r]; }
            lrun = lrun * alpha + rs;
#pragma unroll
            for (int r = 0; r < 16; ++r) { o[0][r] *= alpha; o[1][r] *= alpha; }
            bf16x8 pf[4];
#pragma unroll
            for (int s4 = 0; s4 < 4; ++s4) {
                u32x4 w;
                if (s4 < 2) { w.x = cvtpk(p0[8 * s4 + 0], p0[8 * s4 + 1]); w.y = cvtpk(p0[8 * s4 + 2], p0[8 * s4 + 3]); w.z = cvtpk(p0[8 * s4 + 4], p0[8 * s4 + 5]); w.w = cvtpk(p0[8 * s4 + 6], p0[8 * s4 + 7]); }
                else { const int q = s4 - 2; w.x = cvtpk(p1[8 * q + 0], p1[8 * q + 1]); w.y = cvtpk(p1[8 * q + 2], p1[8 * q + 3]); w.z = cvtpk(p1[8 * q + 4], p1[8 * q + 5]); w.w = cvtpk(p1[8 * q + 6], p1[8 * q + 7]); }
                pf[s4] = __builtin_bit_cast(bf16x8, w);
            }
#pragma unroll
            for (int dblk = 0; dblk < 2; ++dblk)
#pragma unroll
                for (int s4 = 0; s4 < 4; ++s4) {
                    const s16x4 lo = vtr(lds + base + 8192 + dblk * 4096 + vrd + (16 * s4) * 64);
                    const s16x4 hh = vtr(lds + base + 8192 + dblk * 4096 + vrd + (16 * s4 + 8) * 64);
                    const bf16x8 vf = {lo[0], lo[1], lo[2], lo[3], hh[0], hh[1], hh[2], hh[3]};
                    o[dblk] = mfma32(vf, pf[s4], o[dblk]);
                }
        }
        if (s + 1 < ntile) { *(LAS u32x4*)(lds + (16384 - base) + kdst) = kreg; *(LAS u32x4*)(lds + (16384 - base) + vdst) = vreg; }
        __syncthreads();
    }
#undef ATT_SRC
    {
        const float lt = lrun + __shfl_xor(lrun, 32), inv = 1.f / lt;
        bf16* op = Obuf + (size_t)tokq * 512 + head * 64;
#pragma unroll
        for (int dblk = 0; dblk < 2; ++dblk)
#pragma unroll
            for (int r4 = 0; r4 < 4; ++r4) {
                u32x2 w; w.x = cvtpk(o[dblk][4 * r4] * inv, o[dblk][4 * r4 + 1] * inv); w.y = cvtpk(o[dblk][4 * r4 + 2] * inv, o[dblk][4 * r4 + 3] * inv);
                *(u32x2*)(op + 32 * dblk + 8 * r4 + 4 * hi) = w;
            }
    }
}

__device__ __forceinline__ void gmlp_item(const bf16* Z, const float* lng, const float* lnb, const bf16* WsT, const float* bs, bf16* Abuf, ldsp lds, int ch, int gp) {
    const int tid = threadIdx.x, lane = tid & 63, wave = __builtin_amdgcn_readfirstlane(tid >> 6), fr = lane & 15, fq = lane >> 4;
    const int tok0 = ch * 128;
    LAS bf16* VT = (LAS bf16*)lds;
    f32x4 gA = *(const f32x4*)(lng + lane * 8), gB = *(const f32x4*)(lng + lane * 8 + 4), bA = *(const f32x4*)(lnb + lane * 8), bB = *(const f32x4*)(lnb + lane * 8 + 4);
#pragma unroll
    for (int rnd = 0; rnd < 2; ++rnd) {
        float y[8][8];
#pragma unroll
        for (int j = 0; j < 8; ++j) {
            const int tok = tok0 + wave * 16 + rnd * 8 + j;
            const u32x4 raw = *(const u32x4*)(Z + (size_t)tok * DIN + ZV + lane * 8);
            float x[8] = {bflo(raw.x), bfhi(raw.x), bflo(raw.y), bfhi(raw.y), bflo(raw.z), bfhi(raw.z), bflo(raw.w), bfhi(raw.w)};
            float s = 0.f;
#pragma unroll
            for (int i = 0; i < 8; ++i) s += x[i];
            const float mu = wave_sum(s) * (1.f / 512.f);
            float q = 0.f;
#pragma unroll
            for (int i = 0; i < 8; ++i) { x[i] -= mu; q += x[i] * x[i]; }
            const float rstd = rsqrtf(wave_sum(q) * (1.f / 512.f) + 1e-6f);
            y[j][0] = x[0] * rstd * gA[0] + bA[0]; y[j][1] = x[1] * rstd * gA[1] + bA[1]; y[j][2] = x[2] * rstd * gA[2] + bA[2]; y[j][3] = x[3] * rstd * gA[3] + bA[3];
            y[j][4] = x[4] * rstd * gB[0] + bB[0]; y[j][5] = x[5] * rstd * gB[1] + bB[1]; y[j][6] = x[6] * rstd * gB[2] + bB[2]; y[j][7] = x[7] * rstd * gB[3] + bB[3];
        }
        if ((lane >> 5) == gp) {
            const int gl = (lane >> 4) & 1;
#pragma unroll
            for (int i = 0; i < 8; ++i) {
                u32x4 w; w.x = cvtpk(y[0][i], y[1][i]); w.y = cvtpk(y[2][i], y[3][i]); w.z = cvtpk(y[4][i], y[5][i]); w.w = cvtpk(y[6][i], y[7][i]);
                *(LAS u32x4*)(VT + gl * (128 * 136) + (8 * (lane & 15) + i) * 136 + wave * 16 + rnd * 8) = w;
            }
        }
    }
    __syncthreads();
    const int wm = wave >> 1, wn = wave & 1;
#pragma unroll
    for (int gl = 0; gl < 2; ++gl) {
        const int g = 2 * gp + gl;
        f32x4 acc[2][4];
#pragma unroll
        for (int m = 0; m < 2; ++m)
#pragma unroll
            for (int n = 0; n < 4; ++n) acc[m][n] = (f32x4){0.f, 0.f, 0.f, 0.f};
#pragma unroll
        for (int ks = 0; ks < 4; ++ks) {
            bf16x8 af[2], bfr[4];
#pragma unroll
            for (int m = 0; m < 2; ++m) af[m] = *(const bf16x8*)(WsT + (size_t)g * 16384 + (32 * wm + 16 * m + fr) * 128 + 32 * ks + 8 * fq);
#pragma unroll
            for (int n = 0; n < 4; ++n) bfr[n] = *(LAS const bf16x8*)(VT + gl * (128 * 136) + (64 * wn + 16 * n + fr) * 136 + 32 * ks + 8 * fq);
#pragma unroll
            for (int m = 0; m < 2; ++m)
#pragma unroll
                for (int n = 0; n < 4; ++n) acc[m][n] = mfma16(bfr[n], af[m], acc[m][n]);
        }
#pragma unroll
        for (int m = 0; m < 2; ++m) {
            const int p = 32 * wm + 16 * m + fr, tok = tok0 + p; const float bias = bs[g * 128 + p];
#pragma unroll
            for (int n = 0; n < 4; ++n) {
                const int c = g * 128 + 64 * wn + 16 * n + 4 * fq;
                const u32x2 uw = *(const u32x2*)(Z + (size_t)tok * DIN + ZU + c);
                u32x2 w; w.x = cvtpk(bflo(uw.x) * (acc[m][n][0] + bias), bfhi(uw.x) * (acc[m][n][1] + bias)); w.y = cvtpk(bflo(uw.y) * (acc[m][n][2] + bias), bfhi(uw.y) * (acc[m][n][3] + bias));
                *(u32x2*)(Abuf + (size_t)tok * 512 + c) = w;
            }
        }
    }
    __syncthreads();
}

__device__ __forceinline__ void phase_mixers(const Args& a, ldsp lds, int G, int vcu) {
    unsigned char* ws = a.ws;
    const bf16* Z = (const bf16*)(ws + WS_Z);
    for (int it = vcu; it < 512; it += G) {
        const int qh = it & 1, hk = (it >> 1) & 1, nb = (it >> 2) & 63, b = it >> 8;
        attn_item(Z, (const bf16*)(ws + WS_KVC), a.in[I_SINK], (bf16*)(ws + WS_O), lds, b, nb, hk, qh);
    }
    for (int it = vcu; it < 256; it += G) {
        gmlp_item(Z, a.in[I_LNG], a.in[I_LNB], (const bf16*)(ws + WS_WST), a.in[I_GBS], (bf16*)(ws + WS_A), lds, it >> 1, it & 1);
    }
}

#define KI_BEFORE(ka, ia, kb, ib) (((ka) > (kb)) || ((ka) == (kb) && (ia) < (ib)))
#define KI_CAS(K, I, p, q) do { const bool sw_ = KI_BEFORE(K[q], I[q], K[p], I[p]); const float kp_ = sw_ ? K[q] : K[p], kq_ = sw_ ? K[p] : K[q]; const int ip_ = sw_ ? I[q] : I[p], iq_ = sw_ ? I[p] : I[q]; \
        K[p] = kp_; I[p] = ip_; K[q] = kq_; I[q] = iq_; } while (0)
#define KI_SORT8(K, I) do { KI_CAS(K, I, 0, 1); KI_CAS(K, I, 2, 3); KI_CAS(K, I, 4, 5); KI_CAS(K, I, 6, 7); \
        KI_CAS(K, I, 0, 2); KI_CAS(K, I, 1, 3); KI_CAS(K, I, 4, 6); KI_CAS(K, I, 5, 7); \
        KI_CAS(K, I, 1, 2); KI_CAS(K, I, 5, 6); KI_CAS(K, I, 0, 4); KI_CAS(K, I, 3, 7); \
        KI_CAS(K, I, 1, 5); KI_CAS(K, I, 2, 6); KI_CAS(K, I, 1, 4); KI_CAS(K, I, 3, 6); \
        KI_CAS(K, I, 2, 4); KI_CAS(K, I, 3, 5); KI_CAS(K, I, 3, 4); } while (0)
#define KI_MERGE8(KA, IA, KB, IB) do { \
        _Pragma("unroll") for (int r_ = 0; r_ < 8; ++r_) { const bool tb_ = KI_BEFORE(KB[7 - r_], IB[7 - r_], KA[r_], IA[r_]); KA[r_] = tb_ ? KB[7 - r_] : KA[r_]; IA[r_] = tb_ ? IB[7 - r_] : IA[r_]; } \
        KI_CAS(KA, IA, 0, 4); KI_CAS(KA, IA, 1, 5); KI_CAS(KA, IA, 2, 6); KI_CAS(KA, IA, 3, 7); \
        KI_CAS(KA, IA, 0, 2); KI_CAS(KA, IA, 1, 3); KI_CAS(KA, IA, 4, 6); KI_CAS(KA, IA, 5, 7); \
        KI_CAS(KA, IA, 0, 1); KI_CAS(KA, IA, 2, 3); KI_CAS(KA, IA, 4, 5); KI_CAS(KA, IA, 6, 7); } while (0)
__device__ __forceinline__ void router_item(const Args& a, ldsp lds, int it) {
    const int tid = threadIdx.x, lane = tid & 63, wave = __builtin_amdgcn_readfirstlane(tid >> 6), fr = lane & 15, fq = lane >> 4;
    unsigned char* ws = a.ws;
    const int t0 = it * 64, b = t0 >> 13;
    const bf16* X1 = (const bf16*)(ws + WS_X1); const float* adaf = (const float*)(ws + WS_ADAF) + b * 6144;
    const float* g2 = a.in[I_N2G]; unsigned char* H2 = ws + WS_H2;
    {
        f32x4 gm[2][2], sh[2][2];
#pragma unroll
        for (int j = 0; j < 2; ++j)
#pragma unroll
            for (int h = 0; h < 2; ++h) {
                const int c = 8 * lane + 512 * j + 4 * h;
                const f32x4 gg = *(const f32x4*)(g2 + c), sc = *(const f32x4*)(adaf + 4 * 1024 + c);
                gm[j][h] = gg * (sc + 1.f); sh[j][h] = *(const f32x4*)(adaf + 3 * 1024 + c);
            }
#pragma unroll
        for (int half = 0; half < 2; ++half) {
            f32x4 x[4][2][2];
#pragma unroll
            for (int tt = 0; tt < 4; ++tt)
#pragma unroll
                for (int j = 0; j < 2; ++j) {
                    const u32x4 w = *(const u32x4*)(X1 + (size_t)(t0 + wave * 8 + half * 4 + tt) * D + 8 * lane + 512 * j);
                    x[tt][j][0] = (f32x4){bflo(w.x), bfhi(w.x), bflo(w.y), bfhi(w.y)}; x[tt][j][1] = (f32x4){bflo(w.z), bfhi(w.z), bflo(w.w), bfhi(w.w)};
                }
#pragma unroll
            for (int tt = 0; tt < 4; ++tt) {
                const int row = wave * 8 + half * 4 + tt, tok = t0 + row;
                float ss = 0.f;
#pragma unroll
                for (int j = 0; j < 2; ++j)
#pragma unroll
                    for (int h = 0; h < 2; ++h) { const f32x4 v = x[tt][j][h]; ss += (v[0] * v[0] + v[1] * v[1]) + (v[2] * v[2] + v[3] * v[3]); }
                const float r = rsqrtf(wave_sum(ss) * (1.f / D) + 1e-6f);
#pragma unroll
                for (int j = 0; j < 2; ++j) {
                    const f32x4 h0 = (x[tt][j][0] * r) * gm[j][0] + sh[j][0], h1 = (x[tt][j][1] * r) * gm[j][1] + sh[j][1];
                    u32x4 w; w.x = cvtpk(h0[0], h0[1]); w.y = cvtpk(h0[2], h0[3]); w.z = cvtpk(h1[0], h1[1]); w.w = cvtpk(h1[2], h1[3]);
                    { int f0 = 0, f1 = 0;
                      f0 = __builtin_amdgcn_cvt_pk_fp8_f32(h0[0], h0[1], f0, false); f0 = __builtin_amdgcn_cvt_pk_fp8_f32(h0[2], h0[3], f0, true);
                      f1 = __builtin_amdgcn_cvt_pk_fp8_f32(h1[0], h1[1], f1, false); f1 = __builtin_amdgcn_cvt_pk_fp8_f32(h1[2], h1[3], f1, true);
                      u32x2 w8; w8.x = (unsigned)f0; w8.y = (unsigned)f1; *(u32x2*)(H2 + (size_t)tok * D + 8 * lane + 512 * j) = w8; }
                    const int kc = lane + 64 * j;
                    *(LAS u32x4*)(lds + kc * 1024 + ((row ^ (kc & 7)) * 16)) = w;
                }
            }
        }
    }
    __syncthreads();
    f32x4 acc[4][2];
#pragma unroll
    for (int m = 0; m < 4; ++m)
#pragma unroll
        for (int n = 0; n < 2; ++n) acc[m][n] = (f32x4){0.f, 0.f, 0.f, 0.f};
    const bf16* RwT = (const bf16*)(ws + WS_RWT) + (size_t)(32 * wave + fr) * D + 8 * fq;
#pragma unroll 8
    for (int ks = 0; ks < 32; ++ks) {
        const int kc = 4 * ks + fq;
        bf16x8 af[4], bfr[2];
#pragma unroll
        for (int n = 0; n < 2; ++n) bfr[n] = *(const bf16x8*)(RwT + (size_t)(16 * n) * D + 32 * ks);
#pragma unroll
        for (int m = 0; m < 4; ++m) af[m] = *(LAS const bf16x8*)(lds + kc * 1024 + (((16 * m + fr) ^ (kc & 7)) * 16));
#pragma unroll
        for (int m = 0; m < 4; ++m)
#pragma unroll
            for (int n = 0; n < 2; ++n) acc[m][n] = mfma16(af[m], bfr[n], acc[m][n]);
    }
    __syncthreads();
    LAS float* LG = (LAS float*)lds;
#pragma unroll
    for (int m = 0; m < 4; ++m)
#pragma unroll
        for (int n = 0; n < 2; ++n)
#pragma unroll
            for (int reg = 0; reg < 4; ++reg) LG[(32 * wave + 16 * n + fr) * 65 + 16 * m + 4 * fq + reg] = acc[m][n][reg];
    __syncthreads();
    LAS float* CK = (LAS float*)(lds + 69632); LAS int* CI = (LAS int*)(lds + 69632 + 16384);
    const float* rb = a.in[I_RB];
    float bk[8]; int bi[8];
#pragma unroll
    for (int q = 0; q < 4; ++q) {
        float gk[8]; int gi[8];
#pragma unroll
        for (int j = 0; j < 8; ++j) { const int e = 32 * wave + 8 * q + j; gk[j] = sigmoid_f(LG[e * 65 + lane]) + rb[e]; gi[j] = e; }
        KI_SORT8(gk, gi);
        if (q == 0) {
#pragma unroll
            for (int j = 0; j < 8; ++j) { bk[j] = gk[j]; bi[j] = gi[j]; }
        } else KI_MERGE8(bk, bi, gk, gi);
    }
#pragma unroll
    for (int r = 0; r < 8; ++r) { CK[(wave * 8 + r) * 64 + lane] = bk[r]; CI[(wave * 8 + r) * 64 + lane] = bi[r]; }
    __syncthreads();
#define RT_LEVEL(lvl) do { if ((wave & (2 * (lvl) - 1)) == 0) { float ok_[8]; int oi_[8]; \
            _Pragma("unroll") for (int r = 0; r < 8; ++r) { ok_[r] = CK[((wave + (lvl)) * 8 + r) * 64 + lane]; oi_[r] = CI[((wave + (lvl)) * 8 + r) * 64 + lane]; } \
            KI_MERGE8(bk, bi, ok_, oi_); \
            if ((lvl) < 4) { _Pragma("unroll") for (int r = 0; r < 8; ++r) { CK[(wave * 8 + r) * 64 + lane] = bk[r]; CI[(wave * 8 + r) * 64 + lane] = bi[r]; } } } \
        __syncthreads(); } while (0)
    RT_LEVEL(1); RT_LEVEL(2); RT_LEVEL(4);
#undef RT_LEVEL
    LAS unsigned* hist = (LAS unsigned*)(lds + 102400); LAS unsigned* hbase = hist + 256;
    if (tid < 256) hist[tid] = 0u;
    __syncthreads();
    unsigned* cnt = (unsigned*)(ws + WS_CTL) + CW_CNT; int* list = (int*)(ws + WS_LIST); float* gatew = (float*)(ws + WS_GATEW);
    unsigned rank[8];
    if (wave == 0) {
        const int tok = t0 + lane;
        float sel[8], ssum = 0.f;
#pragma unroll
        for (int r = 0; r < 8; ++r) { sel[r] = sigmoid_f(LG[bi[r] * 65 + lane]); ssum += sel[r]; }
#pragma unroll
        for (int r = 0; r < 8; ++r) rank[r] = __hip_atomic_fetch_add(&hist[bi[r]], 1u, __ATOMIC_RELAXED, __HIP_MEMORY_SCOPE_WORKGROUP);
        const float sc = 2.5f / ssum;
        f32x4 g0 = {sel[0] * sc, sel[1] * sc, sel[2] * sc, sel[3] * sc}, g1 = {sel[4] * sc, sel[5] * sc, sel[6] * sc, sel[7] * sc};
        *(f32x4*)(gatew + tok * 8) = g0; *(f32x4*)(gatew + tok * 8 + 4) = g1;
    }
    __syncthreads();
    if (tid < 256) { const unsigned h = hist[tid]; if (h) hbase[tid] = atomicAdd(cnt + 32 * tid, h); }
    __syncthreads();
    if (wave == 0) {
        const int tok = t0 + lane;
#pragma unroll
        for (int r = 0; r < 8; ++r) list[(size_t)bi[r] * LISTCAP + hbase[bi[r]] + rank[r]] = tok * NSLOT + r;
    }
    __syncthreads();
}

__device__ __forceinline__ void moe_tile(const Args& a, ldsp lds, int e, int mt, int nrows, int ntl) {
    const int tid = threadIdx.x, lane = tid & 63, wave = __builtin_amdgcn_readfirstlane(tid >> 6), fr = lane & 15, fq = lane >> 4;
    unsigned char* ws = a.ws;
    constexpr int ASTG = 0, BSTG = 16384, ACT = 49152, SLOTS = 114688, GWO = 115200;
    const bf16* H2 = (const bf16*)(ws + WS_H2);
    const float* Wg = (e < NEXP) ? a.in[I_EG] + (size_t)e * 262144 : a.in[I_SG];
    const float* Wu = (e < NEXP) ? a.in[I_EU] + (size_t)e * 262144 : a.in[I_SU];
    const float* Wd = (e < NEXP) ? a.in[I_ED] + (size_t)e * 262144 : a.in[I_SD];
    if (tid < 128) {
        int slot = -1; float gw = 0.f;
        if (tid < nrows) {
            if (e < NEXP) { slot = ((const int*)(ws + WS_LIST))[(size_t)e * LISTCAP + mt * 128 + tid]; gw = ((const float*)(ws + WS_GATEW))[(slot / NSLOT) * 8 + (slot % NSLOT)]; }
            else { slot = (mt * 128 + tid) * NSLOT + 8; gw = 1.f; }
        }
        ((LAS int*)(lds + SLOTS))[tid] = slot; ((LAS float*)(lds + GWO))[tid] = gw;
    }
    __syncthreads();
    const int wr = wave >> 2, wc = wave & 3;
    const int arow = tid >> 2, akc = tid & 3;
    const int aslot = ((LAS const int*)(lds + SLOTS))[arow];
    const bf16* asrc = H2 + (size_t)((aslot < 0 ? 0 : aslot) / NSLOT) * D + akc * 8;
    const int awr = ASTG + akc * 2048 + ((arow ^ (akc << 1)) * 16);
    const int ng = lane, kq = wave;
    const float* srcg = Wg + (size_t)(4 * kq) * 256 + 4 * ng;
    const float* srcu = Wu + (size_t)(4 * kq) * 256 + 4 * ng;
    const float* src2 = Wd + (size_t)(4 * kq) * 1024 + 4 * ng;
    int bwr2[4];
#pragma unroll
    for (int i = 0; i < 4; ++i) { const int rho2 = 4 * ng + i; bwr2[i] = BSTG + (kq >> 1) * 4096 + ((rho2 ^ ((rho2 >> 3) & 3)) * 16) + (kq & 1) * 8; }
    int ard[4], brd[4], rowm[4];
#pragma unroll
    for (int m = 0; m < 4; ++m) { rowm[m] = 64 * wr + 16 * m + fr; ard[m] = fq * 2048 + ((rowm[m] ^ (fq << 1)) * 16); }
#pragma unroll
    for (int n = 0; n < 4; ++n) { const int rho = 64 * wc + 16 * n + fr; brd[n] = BSTG + fq * 4096 + ((rho ^ ((rho >> 3) & 3)) * 16); }
    bf16* contrib = (bf16*)(ws + WS_CONTRIB);
    f32x4 acc[4][4];
    f32x4 B0[4], B1[4], B2[4], B3[4]; u32x4 A0, A1, A2, A3;
#define G1_LOAD(s_, BR, AR) do { const int s0_ = (s_); const int ss_ = s0_ < 63 ? s0_ : 63; \
        const float* bp_ = ((ss_ < 32) ? srcg : srcu) + (size_t)(32 * (ss_ & 31)) * 256; \
        AR = *(const u32x4*)(asrc + 32 * (ss_ & 31)); \
        _Pragma("unroll") for (int j = 0; j < 4; ++j) BR[j] = *(const f32x4*)(bp_ + j * 256); } while (0)
#define G1_WRITE(BR, AR, buf_) do { \
        *(LAS u32x4*)(lds + (buf_) * 8192 + awr) = AR; \
        _Pragma("unroll") for (int i = 0; i < 4; ++i) { u32x2 w_; w_.x = cvtpk(BR[0][i], BR[1][i]); w_.y = cvtpk(BR[2][i], BR[3][i]); *(LAS u32x2*)(lds + (buf_) * 16384 + bwr2[i]) = w_; } } while (0)
#define MOE_COMPUTE(abase_, buf_) do { \
        bf16x8 af_[4], bf_[4]; \
        _Pragma("unroll") for (int m = 0; m < 4; ++m) af_[m] = *(LAS const bf16x8*)(lds + (abase_) + ard[m]); \
        _Pragma("unroll") for (int n = 0; n < 4; ++n) bf_[n] = *(LAS const bf16x8*)(lds + (buf_) * 16384 + brd[n]); \
        _Pragma("unroll") for (int m = 0; m < 4; ++m) _Pragma("unroll") for (int n = 0; n < 4; ++n) acc[m][n] = mfma16(bf_[n], af_[m], acc[m][n]); } while (0)
#define ACC_ZERO() do { _Pragma("unroll") for (int m = 0; m < 4; ++m) _Pragma("unroll") for (int n = 0; n < 4; ++n) acc[m][n] = (f32x4){0.f, 0.f, 0.f, 0.f}; } while (0)
    G1_LOAD(0, B0, A0); G1_LOAD(1, B1, A1); G1_LOAD(2, B2, A2);
    G1_WRITE(B0, A0, 0);
    __syncthreads();
    for (int s = 0; s < 64; s += 4) {
        if ((s & 31) == 0) ACC_ZERO();
        G1_LOAD(s + 3, B3, A3); MOE_COMPUTE(0, 0); G1_WRITE(B1, A1, 1); __syncthreads();
        G1_LOAD(s + 4, B0, A0); MOE_COMPUTE(8192, 1); G1_WRITE(B2, A2, 0); __syncthreads();
        G1_LOAD(s + 5, B1, A1); MOE_COMPUTE(0, 0); G1_WRITE(B3, A3, 1); __syncthreads();
        G1_LOAD(s + 6, B2, A2); MOE_COMPUTE(8192, 1);
        if (s == 28) {
#pragma unroll
            for (int m = 0; m < 4; ++m)
#pragma unroll
                for (int n = 0; n < 4; ++n) {
                    const f32x4 gv = acc[m][n];
                    u32x2 w; w.x = cvtpk(silu_f(gv[0]), silu_f(gv[1])); w.y = cvtpk(silu_f(gv[2]), silu_f(gv[3]));
                    const int kc = 8 * wc + 2 * n + (fq >> 1);
                    *(LAS u32x2*)(lds + ACT + kc * 2048 + ((rowm[m] ^ ((kc & 3) << 1)) * 16) + (fq & 1) * 8) = w;
                }
        } else if (s == 60) {
#pragma unroll
            for (int m = 0; m < 4; ++m)
#pragma unroll
                for (int n = 0; n < 4; ++n) {
                    const f32x4 uv = acc[m][n];
                    const int kc = 8 * wc + 2 * n + (fq >> 1);
                    LAS u32x2* ap = (LAS u32x2*)(lds + ACT + kc * 2048 + ((rowm[m] ^ ((kc & 3) << 1)) * 16) + (fq & 1) * 8);
                    const u32x2 g = *ap;
                    u32x2 w; w.x = cvtpk(bflo(g.x) * uv[0], bfhi(g.x) * uv[1]); w.y = cvtpk(bflo(g.y) * uv[2], bfhi(g.y) * uv[3]);
                    *ap = w;
                }
        }
        G1_WRITE(B0, A0, 0); __syncthreads();
    }
#define G2_LOAD(s_, BR) do { const int s0_ = (s_); const int t_ = s0_ < 31 ? s0_ : 31; \
        const float* bp_ = src2 + (size_t)(32 * (t_ & 7)) * 1024 + 256 * (t_ >> 3); \
        _Pragma("unroll") for (int j = 0; j < 4; ++j) BR[j] = *(const f32x4*)(bp_ + j * 1024); } while (0)
#define G2_WRITE(BR, buf_) do { \
        _Pragma("unroll") for (int i = 0; i < 4; ++i) { u32x2 w_; w_.x = cvtpk(BR[0][i], BR[1][i]); w_.y = cvtpk(BR[2][i], BR[3][i]); *(LAS u32x2*)(lds + (buf_) * 16384 + bwr2[i]) = w_; } } while (0)
    G2_LOAD(0, B0); G2_LOAD(1, B1); G2_LOAD(2, B2);
    G2_WRITE(B0, 0);
    __syncthreads();
    for (int s = 0; s < 32; s += 4) {
        if ((s & 7) == 0) ACC_ZERO();
        G2_LOAD(s + 3, B3); MOE_COMPUTE(ACT + (s & 7) * 8192, 0); G2_WRITE(B1, 1); __syncthreads();
        G2_LOAD(s + 4, B0); MOE_COMPUTE(ACT + ((s + 1) & 7) * 8192, 1); G2_WRITE(B2, 0); __syncthreads();
        G2_LOAD(s + 5, B1); MOE_COMPUTE(ACT + ((s + 2) & 7) * 8192, 0); G2_WRITE(B3, 1); __syncthreads();
        G2_LOAD(s + 6, B2); MOE_COMPUTE(ACT + ((s + 3) & 7) * 8192, 1);
        if ((s & 7) == 4) {
            const int q = s >> 3;
#pragma unroll
            for (int m = 0; m < 4; ++m) {
                const int slot = ((LAS const int*)(lds + SLOTS))[rowm[m]]; const float gw = ((LAS const float*)(lds + GWO))[rowm[m]];
                if (slot >= 0) {
                    bf16* cp = contrib + (size_t)slot * D + q * 256 + 64 * wc + 4 * fq;
#pragma unroll
                    for (int n = 0; n < 4; ++n) { const f32x4 v = acc[m][n] * gw; u32x2 w; w.x = cvtpk(v[0], v[1]); w.y = cvtpk(v[2], v[3]); *(u32x2*)(cp + 16 * n) = w; }
                }
            }
        }
        G2_WRITE(B0, 0); __syncthreads();
    }
#undef G1_LOAD
#undef G1_WRITE
#undef G2_LOAD
#undef G2_WRITE
#undef ACC_ZERO
#undef MOE_COMPUTE
}

__device__ __forceinline__ const float* uni_ptr(const float* p) {
    const unsigned long long v = (unsigned long long)p;
    const unsigned lo = __builtin_amdgcn_readfirstlane((unsigned)v), hi = __builtin_amdgcn_readfirstlane((unsigned)(v >> 32));
    return (const float*)(((unsigned long long)hi << 32) | lo);
}
__device__ __forceinline__ void moe_decode(int j, int total, LAS const int* pre, LAS const int* cnt, int& e, int& mt, int& nrows) {
    if (j < total) {
        int lo = 0, hi = NEXP;
        while (hi - lo > 1) { const int mid = (lo + hi) >> 1; if (pre[mid] <= j) lo = mid; else hi = mid; }
        e = lo; mt = j - pre[e]; const int c = cnt[e] - mt * 128; nrows = c < 128 ? c : 128;
    } else { e = NEXP; mt = j - total; nrows = 128; }
}
__device__ __forceinline__ void phase_moe(const Args& a, ldsp lds, int G, int vcu) {
    const int tid = threadIdx.x, lane = tid & 63, wave = __builtin_amdgcn_readfirstlane(tid >> 6), fr = lane & 15, fq = lane >> 4;
    unsigned char* ws = a.ws;
    constexpr int ASTG = 0, BSTG = 16384, ACT = 49152, SLOTS = 114688, GWO = SLOTS + MOE_MAXT * 512;
    static_assert(GWO + MOE_MAXT * 512 <= SCR_BYTES, "slot lists overflow the scratch image");
    LAS int* pre = (LAS int*)(lds + MISC_OFF + 512);
    LAS int* cnt = (LAS int*)(lds + MISC_OFF + 2048);
    LAS int* wtot = (LAS int*)(lds + MISC_OFF + 3072);
    int myv = 0, myx = 0;
    if (tid < NEXP) {
        const int c = (int)((const unsigned*)(ws + WS_CTL) + CW_CNT)[32 * tid];
        cnt[tid] = c; myv = (c + 127) >> 7; myx = myv;
#pragma unroll
        for (int o = 1; o < 64; o <<= 1) { const int y = __shfl_up(myx, o); if (lane >= o) myx += y; }
        if (lane == 63) wtot[wave] = myx;
    }
    __syncthreads();
    if (tid < NEXP) { int base = 0; for (int w = 0; w < wave; ++w) base += wtot[w]; pre[tid] = base + myx - myv; if (tid == NEXP - 1) pre[NEXP] = base + myx; }
    __syncthreads();
    const int total = pre[NEXP], ntiles = total + T / 128;
    if (vcu >= ntiles) return;
    for (int tt = tid >> 7; vcu + tt * G < ntiles; tt += 4) {
        const int r = tid & 127; int e_, mt_, nr_; moe_decode(vcu + tt * G, total, pre, cnt, e_, mt_, nr_);
        int slot_ = -1; float gw_ = 0.f;
        if (r < nr_) { if (e_ < NEXP) { slot_ = ((const int*)(ws + WS_LIST))[(size_t)e_ * LISTCAP + mt_ * 128 + r]; gw_ = ((const float*)(ws + WS_GATEW))[(slot_ / NSLOT) * 8 + (slot_ % NSLOT)]; }
                       else { slot_ = (mt_ * 128 + r) * NSLOT + 8; gw_ = 1.f; } }
        ((LAS int*)(lds + SLOTS))[tt * 128 + r] = slot_; ((LAS float*)(lds + GWO))[tt * 128 + r] = gw_;
    }
    __syncthreads();
    if (wave >= 4) {
        const int lt = tid - 256;
        const unsigned char* H2 = ws + WS_H2;
        const int arow = lt >> 1, ahalf = lt & 1;
        const int awr0 = ASTG + (2 * ahalf) * 2048 + ((arow ^ ((2 * ahalf) << 1)) * 16), awr1 = ASTG + (2 * ahalf + 1) * 2048 + ((arow ^ ((2 * ahalf + 1) << 1)) * 16);
        const int ng = lt & 63, kq = lt >> 6;
        const int loff256 = (8 * kq) * 256 + 4 * ng, loff1024 = (8 * kq) * 1024 + 4 * ng;
        const int bw = BSTG + kq * 4096 + (4 * ng) * 16, bx = ((4 * ng) >> 3) & 3;
        const int rho_d = 64 * (ng >> 4) + 16 * (ng & 3) + 4 * ((ng >> 2) & 3);
        const int bw_d = BSTG + kq * 4096 + rho_d * 16, bx_d = (rho_d >> 3) & 3;
        f32x4 B0[8], B1[8], B2[8], B3[8]; u32x4 A0, A1, A2, A3, A4, A5, A6, A7;
        int j = vcu, it = 0, e, mt, nrows;
        moe_decode(j, total, pre, cnt, e, mt, nrows);
#ifndef MOE_AUX
#define MOE_AUX 16
#endif
#define W_RSRC(eo_, pe_, ps_) __builtin_amdgcn_make_buffer_rsrc((void*)uni_ptr(((eo_) < NEXP) ? a.in[pe_] + (size_t)(eo_) * 262144 : a.in[ps_]), 0, 1 << 20, 0x00020000)
        const int eu0 = __builtin_amdgcn_readfirstlane(e);
        __amdgpu_buffer_rsrc_t Wg = W_RSRC(eu0, I_EG, I_SG), Wu = W_RSRC(eu0, I_EU, I_SU), Wd = W_RSRC(eu0, I_ED, I_SD);
        int aslot = ((LAS const int*)(lds + SLOTS))[arow];
        const unsigned char* asrc = H2 + (size_t)((aslot < 0 ? 0 : aslot) / NSLOT) * D + 16 * ahalf;
#define L_LOADB1(WG_, WU_, WD_, s_, BR) do { const int ss_ = (s_); const int t_ = ss_ - 64; \
            const __amdgpu_buffer_rsrc_t r_ = (ss_ < 32) ? (WG_) : (ss_ < 64) ? (WU_) : (WD_); \
            const int vo_ = (ss_ < 64) ? 4 * loff256 : 4 * loff1024; \
            const int so_ = (ss_ < 32) ? (32 * ss_) * 1024 : (ss_ < 64) ? (32 * (ss_ - 32)) * 1024 : (32 * (t_ & 7)) * 4096 + 1024 * (t_ >> 3); \
            const int str_ = (ss_ < 64) ? 1024 : 4096;        \
            _Pragma("unroll") for (int jj = 0; jj < 8; ++jj) BR[jj] = __builtin_bit_cast(f32x4, __builtin_amdgcn_raw_buffer_load_b128(r_, vo_, so_ + jj * str_, MOE_AUX)); } while (0)
#define L_LOADA4(AP_, s_, R0, R1, R2, R3) do { const int ss_ = (s_); const int sa_ = ss_ < 60 ? ss_ : 60; const unsigned char* p_ = (AP_) + 32 * (sa_ & 31); \
            R0 = *(const u32x4*)(p_); R1 = *(const u32x4*)(p_ + 32); R2 = *(const u32x4*)(p_ + 64); R3 = *(const u32x4*)(p_ + 96); } while (0)
#define L_LOADB1P(WG_, WU_, WD_, s_, BR, j0_) do { const int ss_ = (s_); const int t_ = ss_ - 64; \
            const __amdgpu_buffer_rsrc_t r_ = (ss_ < 32) ? (WG_) : (ss_ < 64) ? (WU_) : (WD_); \
            const int vo_ = (ss_ < 64) ? 4 * loff256 : 4 * loff1024; \
            const int so_ = (ss_ < 32) ? (32 * ss_) * 1024 : (ss_ < 64) ? (32 * (ss_ - 32)) * 1024 : (32 * (t_ & 7)) * 4096 + 1024 * (t_ >> 3); \
            const int str_ = (ss_ < 64) ? 1024 : 4096; \
            _Pragma("unroll") for (int jj = (j0_); jj < (j0_) + 2; ++jj) BR[jj] = __builtin_bit_cast(f32x4, __builtin_amdgcn_raw_buffer_load_b128(r_, vo_, so_ + jj * str_, MOE_AUX)); } while (0)
#define L_LOAD2P(s_, BR, j0_) do { const int s0_ = (s_); const int t_ = s0_ < 31 ? s0_ : 31; \
            const int so_ = (32 * (t_ & 7)) * 4096 + 1024 * (t_ >> 3); \
            _Pragma("unroll") for (int jj = (j0_); jj < (j0_) + 2; ++jj) BR[jj] = __builtin_bit_cast(f32x4, __builtin_amdgcn_raw_buffer_load_b128(Wd, 4 * loff1024, so_ + jj * 4096, MOE_AUX)); } while (0)
#define L_WRITEB1(BR, buf_, i_, bw_, bx_) do { const int i = (i_); u32x4 w_; w_.x = cvtpk(BR[0][i], BR[1][i]); w_.y = cvtpk(BR[2][i], BR[3][i]); w_.z = cvtpk(BR[4][i], BR[5][i]); w_.w = cvtpk(BR[6][i], BR[7][i]); \
            *(LAS u32x4*)(lds + (buf_) * 16384 + (bw_) + ((i ^ (bx_)) * 16)) = w_; } while (0)
#define L_SB() __builtin_amdgcn_sched_barrier(0)
#define L_STEP1(WG_, WU_, WD_, ls_, LB, WB, wbuf_, ws_) do { const bool dn_ = (ws_) >= 64; const int bwx_ = dn_ ? bw_d : bw, bxx_ = dn_ ? bx_d : bx;        \
            _Pragma("unroll") for (int i4 = 0; i4 < 4; ++i4) { L_WRITEB1(WB, wbuf_, i4, bwx_, bxx_); L_SB(); L_LOADB1P(WG_, WU_, WD_, ls_, LB, 2 * i4); L_SB(); } } while (0)
#define L_STEP2(ls_, LB, WB, wbuf_) do { _Pragma("unroll") for (int i4 = 0; i4 < 4; ++i4) { L_WRITEB1(WB, wbuf_, i4, bw_d, bx_d); L_SB(); L_LOAD2P(ls_, LB, 2 * i4); L_SB(); } } while (0)
#define L_LOAD2(s_, BR) do { const int s0_ = (s_); const int t_ = s0_ < 31 ? s0_ : 31; \
            const int so_ = (32 * (t_ & 7)) * 4096 + 1024 * (t_ >> 3); \
            _Pragma("unroll") for (int jj = 0; jj < 8; ++jj) BR[jj] = __builtin_bit_cast(f32x4, __builtin_amdgcn_raw_buffer_load_b128(Wd, 4 * loff1024, so_ + jj * 4096, MOE_AUX)); } while (0)
#define L_WRITEB(BR, buf_) do { _Pragma("unroll") for (int i = 0; i < 4; ++i) { u32x4 w_; w_.x = cvtpk(BR[0][i], BR[1][i]); w_.y = cvtpk(BR[2][i], BR[3][i]); w_.z = cvtpk(BR[4][i], BR[5][i]); w_.w = cvtpk(BR[6][i], BR[7][i]); \
            *(LAS u32x4*)(lds + (buf_) * 16384 + bw + ((i ^ bx) * 16)) = w_; } } while (0)
#define L_CVT8(w_, o0, o1) do { const f32x2_t l_ = __builtin_amdgcn_cvt_pk_f32_fp8((int)(w_), false), h_ = __builtin_amdgcn_cvt_pk_f32_fp8((int)(w_), true); o0 = cvtpk(l_[0], l_[1]); o1 = cvtpk(h_[0], h_[1]); } while (0)
#define L_WRITEA(AR, buf_) do { u32x4 c0_, c1_; L_CVT8(AR.x, c0_.x, c0_.y); L_CVT8(AR.y, c0_.z, c0_.w); L_CVT8(AR.z, c1_.x, c1_.y); L_CVT8(AR.w, c1_.z, c1_.w); \
            *(LAS u32x4*)(lds + (buf_) * 8192 + awr0) = c0_; *(LAS u32x4*)(lds + (buf_) * 8192 + awr1) = c1_; } while (0)
        L_LOADA4(asrc, 0, A0, A1, A2, A3); L_LOADB1(Wg, Wu, Wd, 0, B0); L_LOADB1(Wg, Wu, Wd, 1, B1); L_LOADB1(Wg, Wu, Wd, 2, B2); L_LOADA4(asrc, 4, A4, A5, A6, A7);
        for (;;) {
            L_WRITEA(A0, 0); L_WRITEB(B0, 0);
            __syncthreads();
            for (int s = 0; s < 64; s += 8) {
                L_WRITEA(A1, 1); L_STEP1(Wg, Wu, Wd, s + 3, B3, B1, 1, s + 1); __syncthreads();
                L_WRITEA(A2, 0); L_STEP1(Wg, Wu, Wd, s + 4, B0, B2, 0, s + 2); __syncthreads();
                L_WRITEA(A3, 1); L_STEP1(Wg, Wu, Wd, s + 5, B1, B3, 1, s + 3); __syncthreads();
                L_WRITEA(A4, 0); L_LOADA4(asrc, s + 8, A0, A1, A2, A3); L_STEP1(Wg, Wu, Wd, s + 6, B2, B0, 0, s + 4); __syncthreads();
                L_WRITEA(A5, 1); L_STEP1(Wg, Wu, Wd, s + 7, B3, B1, 1, s + 5); __syncthreads();
                L_WRITEA(A6, 0); L_STEP1(Wg, Wu, Wd, s + 8, B0, B2, 0, s + 6); __syncthreads();
                L_WRITEA(A7, 1); L_STEP1(Wg, Wu, Wd, s + 9, B1, B3, 1, s + 7); __syncthreads();
                L_WRITEA(A0, 0); L_LOADA4(asrc, s + 12, A4, A5, A6, A7); L_STEP1(Wg, Wu, Wd, s + 10, B2, B0, 0, s + 8); __syncthreads();
            }
            for (int s = 0; s < 28; s += 4) {
                L_STEP2(s + 3, B3, B1, 1); __syncthreads();
                L_STEP2(s + 4, B0, B2, 0); __syncthreads();
                L_STEP2(s + 5, B1, B3, 1); __syncthreads();
                L_STEP2(s + 6, B2, B0, 0); __syncthreads();
            }
            const int jn = j + G; const bool more = jn < ntiles;
            int en = e, mtn = mt, nrn = nrows; if (more) moe_decode(jn, total, pre, cnt, en, mtn, nrn);
            const int eun = __builtin_amdgcn_readfirstlane(en);
            const __amdgpu_buffer_rsrc_t Wgn = W_RSRC(eun, I_EG, I_SG), Wun = W_RSRC(eun, I_EU, I_SU), Wdn = W_RSRC(eun, I_ED, I_SD);
            const int aslotn = more ? ((LAS const int*)(lds + SLOTS))[(it + 1) * 128 + arow] : aslot;
            const unsigned char* asrcn = H2 + (size_t)((aslotn < 0 ? 0 : aslotn) / NSLOT) * D + 16 * ahalf;
            L_STEP2(31, B3, B1, 1); __syncthreads();
            L_LOADA4(asrcn, 0, A0, A1, A2, A3); L_STEP1(Wgn, Wun, Wdn, 0, B0, B2, 0, 94); __syncthreads();
            L_STEP1(Wgn, Wun, Wdn, 1, B1, B3, 1, 95); __syncthreads();
            L_LOADB1(Wgn, Wun, Wdn, 2, B2); L_LOADA4(asrcn, 4, A4, A5, A6, A7); __syncthreads();
            if (!more) break;
            j = jn; ++it; e = en; mt = mtn; nrows = nrn; Wg = Wgn; Wu = Wun; Wd = Wdn; aslot = aslotn; asrc = asrcn;
        }
#undef L_LOADB1
#undef L_LOADB1P
#undef L_LOAD2P
#undef L_WRITEB1
#undef L_STEP1
#undef L_STEP2
#undef L_SB
#undef W_RSRC
#undef L_LOADA4
#undef L_CVT8
#undef L_LOAD2
#undef L_WRITEB
#undef L_WRITEA
    } else {
        const int wr = wave >> 1, wc = wave & 1;
        int rowm[4], ard[4], brd[8];
#pragma unroll
        for (int m = 0; m < 4; ++m) { rowm[m] = 64 * wr + 16 * m + fr; ard[m] = fq * 2048 + ((rowm[m] ^ (fq << 1)) * 16); }
#pragma unroll
        for (int n = 0; n < 8; ++n) { const int rho = 128 * wc + 16 * n + fr; brd[n] = BSTG + fq * 4096 + ((rho ^ ((rho >> 3) & 3)) * 16); }
        unsigned char* contrib = ws + WS_CONTRIB;
        f32x4 acc[4][8];
#define M_COMPUTE(abase_, buf_) do { \
            _Pragma("unroll") for (int nh = 0; nh < 2; ++nh) { bf16x8 af_[4], bf_[4]; \
                _Pragma("unroll") for (int m = 0; m < 4; ++m) af_[m] = *(LAS const bf16x8*)(lds + (abase_) + ard[m]); \
                _Pragma("unroll") for (int n = 0; n < 4; ++n) bf_[n] = *(LAS const bf16x8*)(lds + (buf_) * 16384 + brd[4 * nh + n]); \
                _Pragma("unroll") for (int m = 0; m < 4; ++m) _Pragma("unroll") for (int n = 0; n < 4; ++n) acc[m][4 * nh + n] = mfma16(bf_[n], af_[m], acc[m][4 * nh + n]); } } while (0)
#define M_ZERO() do { _Pragma("unroll") for (int m = 0; m < 4; ++m) _Pragma("unroll") for (int n = 0; n < 8; ++n) acc[m][n] = (f32x4){0.f, 0.f, 0.f, 0.f}; } while (0)
        int it = 0;
        for (int j = vcu; j < ntiles; j += G, ++it) {
            __syncthreads();
            for (int s = 0; s < 64; s += 4) {
                if ((s & 31) == 0) M_ZERO();
                M_COMPUTE(0, 0); __syncthreads();
                M_COMPUTE(8192, 1); __syncthreads();
                M_COMPUTE(0, 0); __syncthreads();
                M_COMPUTE(8192, 1);
                if (s == 28) {
#pragma unroll
                    for (int m = 0; m < 4; ++m)
#pragma unroll
                        for (int n = 0; n < 8; ++n) {
                            const f32x4 gv = acc[m][n];
                            u32x2 w; w.x = cvtpk(silu_f(gv[0]), silu_f(gv[1])); w.y = cvtpk(silu_f(gv[2]), silu_f(gv[3]));
                            const int kc = 16 * wc + 2 * n + (fq >> 1);
                            *(LAS u32x2*)(lds + ACT + kc * 2048 + ((rowm[m] ^ ((kc & 3) << 1)) * 16) + (fq & 1) * 8) = w;
                        }
                } else if (s == 60) {
#pragma unroll
                    for (int m = 0; m < 4; ++m)
#pragma unroll
                        for (int n = 0; n < 8; ++n) {
                            const f32x4 uv = acc[m][n];
                            const int kc = 16 * wc + 2 * n + (fq >> 1);
                            LAS u32x2* ap = (LAS u32x2*)(lds + ACT + kc * 2048 + ((rowm[m] ^ ((kc & 3) << 1)) * 16) + (fq & 1) * 8);
                            const u32x2 g = *ap;
                            u32x2 w; w.x = cvtpk(bflo(g.x) * uv[0], bfhi(g.x) * uv[1]); w.y = cvtpk(bflo(g.y) * uv[2], bfhi(g.y) * uv[3]);
                            *ap = w;
                        }
                }
                __syncthreads();
            }
            for (int s = 0; s < 32; s += 4) {
                if ((s & 7) == 0) M_ZERO();
                M_COMPUTE(ACT + (s & 7) * 8192, 0); __syncthreads();
                M_COMPUTE(ACT + ((s + 1) & 7) * 8192, 1); __syncthreads();
                M_COMPUTE(ACT + ((s + 2) & 7) * 8192, 0); __syncthreads();
                M_COMPUTE(ACT + ((s + 3) & 7) * 8192, 1);
                if ((s & 7) == 4) {
                    const int q = s >> 3;
#pragma unroll
                    for (int m = 0; m < 4; ++m) {
                        const int slot = ((LAS const int*)(lds + SLOTS))[it * 128 + rowm[m]]; const float gw = ((LAS const float*)(lds + GWO))[it * 128 + rowm[m]];
                        if (slot >= 0) {
                            unsigned char* cp = contrib + (size_t)slot * D + q * 256 + 128 * wc + 16 * fq;
                            const float gs = gw * CONTRIB_SCALE;
#pragma unroll
                            for (int k = 0; k < 2; ++k) {
                                u32x4 w4;
#pragma unroll
                                for (int n = 0; n < 4; ++n) { const f32x4 v = acc[m][4 * k + n] * gs; int w = 0; w = __builtin_amdgcn_cvt_pk_fp8_f32(v[0], v[1], w, false); w = __builtin_amdgcn_cvt_pk_fp8_f32(v[2], v[3], w, true); w4[n] = (unsigned)w; }
                                *(u32x4*)(cp + 64 * k) = w4;
                            }
                        }
                    }
                }
                __syncthreads();
            }
        }
#undef M_COMPUTE
#undef M_ZERO
    }
}

__device__ __forceinline__ void phase_combine(const Args& a, int G) {
    const int tid = threadIdx.x, lane = tid & 63, wave = __builtin_amdgcn_readfirstlane(tid >> 6), blk = blockIdx.x;
    unsigned char* ws = a.ws;
    const bf16* X1 = (const bf16*)(ws + WS_X1); const unsigned char* contrib = ws + WS_CONTRIB; const float* fg = a.in[I_FG];
    for (int t = blk * NWAVES + wave; t < T; t += G * NWAVES) {
        const float* g2 = (const float*)(ws + WS_ADAF) + (t >> 13) * 6144 + 5 * 1024;
        const int c = 16 * lane;
        float sm[16];
#pragma unroll
        for (int i = 0; i < 16; ++i) sm[i] = 0.f;
#pragma unroll
        for (int k = 0; k < NSLOT; ++k) {
            const u32x4 w = *(const u32x4*)(contrib + ((size_t)t * NSLOT + k) * D + c);
#pragma unroll
            for (int q = 0; q < 4; ++q) {
                const f32x2_t lo = __builtin_amdgcn_cvt_pk_f32_fp8((int)w[q], false), hi = __builtin_amdgcn_cvt_pk_f32_fp8((int)w[q], true);
                sm[4 * q] += lo[0]; sm[4 * q + 1] += lo[1]; sm[4 * q + 2] += hi[0]; sm[4 * q + 3] += hi[1];
            }
        }
        const u32x4 xa = *(const u32x4*)(X1 + (size_t)t * D + c), xb = *(const u32x4*)(X1 + (size_t)t * D + c + 8);
        const float x1[16] = {bflo(xa.x), bfhi(xa.x), bflo(xa.y), bfhi(xa.y), bflo(xa.z), bfhi(xa.z), bflo(xa.w), bfhi(xa.w), bflo(xb.x), bfhi(xb.x), bflo(xb.y), bfhi(xb.y), bflo(xb.z), bfhi(xb.z), bflo(xb.w), bfhi(xb.w)};
        f32x4 xv[4]; float ss = 0.f;
#pragma unroll
        for (int h = 0; h < 4; ++h) {
            const f32x4 gg = *(const f32x4*)(g2 + c + 4 * h);
            const f32x4 xx = {x1[4 * h], x1[4 * h + 1], x1[4 * h + 2], x1[4 * h + 3]};
            const f32x4 mv = {sm[4 * h], sm[4 * h + 1], sm[4 * h + 2], sm[4 * h + 3]};
            const f32x4 v = xx + gg * (mv * (1.f / CONTRIB_SCALE)); xv[h] = v; ss += (v[0] * v[0] + v[1] * v[1]) + (v[2] * v[2] + v[3] * v[3]);
        }
        const float r = rsqrtf(wave_sum(ss) * (1.f / D) + 1e-6f);
#pragma unroll
        for (int h = 0; h < 4; ++h) *(f32x4*)(a.out + (size_t)t * D + c + 4 * h) = (xv[h] * r) * *(const f32x4*)(fg + c + 4 * h);
    }
}

constexpr int NPH = 9;
#ifndef N_LAUNCHES
#define N_LAUNCHES 1
#endif
__global__ void __launch_bounds__(NWAVES * 64, 2) mega(Args a) {
    extern __shared__ __attribute__((aligned(16))) unsigned char lds_raw[];
    ldsp lds = (ldsp)lds_raw;
    const int tid = threadIdx.x, G = gridDim.x, bx = blockIdx.x;
    int vcu = (G % 8 == 0) ? (bx % 8) * (G / 8) + bx / 8 : bx;
    unsigned char* ws = a.ws;
    for (int u = tid; u < (LDS_BYTES - MISC_OFF) / 4; u += NWAVES * 64) ((LAS unsigned*)(lds + MISC_OFF))[u] = 0u;
    __syncthreads();
    volatile LAS unsigned* MISC = (volatile LAS unsigned*)(lds + MISC_OFF);
    XcdBarrier bar; bar.bar = (unsigned*)(ws + WS_CTL) + CW_BAR; bar.x = 0; bar.st = nullptr;
    if (N_LAUNCHES == 1) {
        bar = xcd_barrier_post((unsigned*)(ws + WS_CTL) + CW_BAR, MISC + 8);
        if (tid == 0) MISC[16] = atomicAdd((unsigned*)(ws + WS_CTL) + CW_XRANK + 64 * bar.x, 1u);
    }
    const int lo = a.ph_lo, hi = a.ph_hi;
#ifndef PH_MASK
#define PH_MASK 0x1ff
#endif
#define IN(k) (((PH_MASK >> (k)) & 1) && lo <= (k) && (k) < hi)
#define SEAM(k) do { if (IN(k) && IN((k) + 1)) xcd_barrier(bar); } while (0)
#ifndef PH_DUP
#define PH_DUP -1
#endif
#define REP(k) for (int rep_ = 0; rep_ < ((PH_DUP == (k)) ? 2 : 1); ++rep_)
    if (IN(0)) REP(0) { phase_prep(a, lds, G); } SEAM(0);
    if (N_LAUNCHES == 1 && IN(0) && IN(1)) {
        unsigned basex = 0;
        for (unsigned j = 0; j < bar.x; ++j) basex += xb_ld(&bar.bar[XB_XCNT(j)]);
        vcu = (int)(basex + MISC[16]);
    }
    if (IN(1)) REP(1) { phase_hnorm(a, lds, G); } SEAM(1);
    if (IN(2)) REP(2) {
        pg8::Gemm g{(const pg8::bf16_t*)(ws + WS_H), (const pg8::bf16_t*)(ws + WS_WINT), MH, DIN, D};
        WinOrder S; S.init(G, bx);
        EpiWin E{(bf16*)(ws + WS_Z), (bf16*)(ws + WS_KVC), (const float*)(ws + WS_ROPE)};
        pg8::gemm_phase<EpiWin, WinOrder, true, true>(lds, g, S, E);
    } SEAM(2);
    if (IN(3)) REP(3) { phase_mixers(a, lds, G, vcu); } SEAM(3);
    if (IN(4)) REP(4) {
        { pg8::Gemm g{(const pg8::bf16_t*)(ws + WS_A), (const pg8::bf16_t*)(ws + WS_WAT), T, D, 512};
          pg8::StaticOrder S; S.init(T, D, G, bx);
          EpiMergeA E{(const bf16*)(ws + WS_Z), (bf16*)(ws + WS_Y)};
          pg8::gemm_phase<EpiMergeA, pg8::StaticOrder, true, true>(lds, g, S, E); }
        { pg8::Gemm g{(const pg8::bf16_t*)(ws + WS_O), (const pg8::bf16_t*)(ws + WS_WBT), T, D, 512};
          pg8::StaticOrder S; S.init(T, D, G, bx);
          EpiMergeB E{(const bf16*)(ws + WS_Z), (bf16*)(ws + WS_Y)};
          pg8::gemm_phase<EpiMergeB, pg8::StaticOrder, true, true>(lds, g, S, E); }
    } SEAM(4);
    if (IN(5)) REP(5) {
        pg8::Gemm g{(const pg8::bf16_t*)(ws + WS_Y), (const pg8::bf16_t*)(ws + WS_WOT), T, D, D};
        pg8::StaticOrder S; S.init(T, D, G, bx);
        EpiWo E{a.in[I_X], (const float*)(ws + WS_ADAF), (bf16*)(ws + WS_X1)};
        pg8::gemm_phase<EpiWo, pg8::StaticOrder, true, true>(lds, g, S, E);
    } SEAM(5);
    if (IN(6)) { for (int it = vcu; it < T / 64; it += G) router_item(a, lds, it); } SEAM(6);
    if (IN(7)) REP(7) { phase_moe(a, lds, G, vcu); } SEAM(7);
    if (IN(8)) REP(8) { phase_combine(a, G); }
#undef IN
#undef SEAM
}

extern "C" void kernel_launch(void* const* d_in, const int* in_sizes, int n_in, void* d_out, int out_size, void* d_ws, size_t ws_size, hipStream_t stream) {
    static int grid = 0;
    if (grid == 0) {
        if (n_in != 26 || out_size != T * D || ws_size < WS_END) { fprintf(stderr, "kernel_launch: unexpected shapes (n_in %d, out %d, ws %zu)\n", n_in, out_size, ws_size); grid = -1; return; }
        int dev = 0, cus = 0, per_cu = 0;
        (void)hipGetDevice(&dev); (void)hipDeviceGetAttribute(&cus, hipDeviceAttributeMultiprocessorCount, dev);
        (void)hipFuncSetAttribute((const void*)mega, hipFuncAttributeMaxDynamicSharedMemorySize, LDS_BYTES);
        (void)hipOccupancyMaxActiveBlocksPerMultiprocessor(&per_cu, (const void*)mega, NWAVES * 64, LDS_BYTES);
        (void)hipGetLastError();
        if (per_cu < 1) { fprintf(stderr, "kernel_launch: occupancy query says %d blocks per CU\n", per_cu); per_cu = 1; }
        if (cus * MOE_MAXT < T * 8 / 128 + NEXP + T / 128) { fprintf(stderr, "kernel_launch: %d CUs are too few for the expert tile tables\n", cus); grid = -1; return; }
        grid = cus;
    }
    if (grid < 0) return;
    (void)hipMemsetAsync((char*)d_ws + WS_CTL, 0, CTL_ZERO_BYTES, stream);
    Args a{};
    for (int i = 0; i < 26; ++i) a.in[i] = (const float*)d_in[i];
    a.out = (float*)d_out; a.ws = (unsigned char*)d_ws;
    if (N_LAUNCHES == 1) {
        a.ph_lo = 0; a.ph_hi = NPH;
        void* kargs[] = {&a};
        hipError_t e = hipLaunchCooperativeKernel((const void*)mega, dim3(grid), dim3(NWAVES * 64), kargs, LDS_BYTES, stream);
        if (e != hipSuccess) fprintf(stderr, "kernel_launch: cooperative launch failed: %s (grid %d)\n", hipGetErrorString(e), grid);
    } else {
#ifndef HOST_DUP
#define HOST_DUP -1
#endif
        for (int li = 0; li < NPH; ++li) {
            a.ph_lo = li; a.ph_hi = li + 1;
            hipLaunchKernelGGL(mega, dim3(grid), dim3(NWAVES * 64), LDS_BYTES, stream, a);
            if (li == HOST_DUP) {
                if (li == 6) (void)hipMemsetAsync((char*)d_ws + WS_CTL, 0, CTL_ZERO_BYTES, stream);
                hipLaunchKernelGGL(mega, dim3(grid), dim3(NWAVES * 64), LDS_BYTES, stream, a);
            }
        }
    }
}
```

```cpp
#include <hip/hip_runtime.h>
#include <cstdio>
#include <cstdint>
#include <type_traits>
namespace pg8 {
#define PG8_LAS __attribute__((address_space(3)))
typedef unsigned short bf16_t;
typedef short bf16x8 __attribute__((ext_vector_type(8)));
typedef float f32x4 __attribute__((ext_vector_type(4)));
typedef unsigned u32x4 __attribute__((ext_vector_type(4)));
constexpr int BM = 256, BK = 64, HALF = 128, HTB = HALF * BK * 2  , STAGE_BYTES = 8 * HTB, NXCD = 8, WGM = 8;

__host__ __device__ __forceinline__ int lds_byte(int r, int c) { const int st = (r >> 4) * 2 + (c >> 5), rr = r & 15, cc = c & 31, ob = rr * 64 + cc * 2; return st * 1024 + (ob ^ (((ob >> 9) & 1) << 5)); }
__host__ __device__ __forceinline__ void stage_rc(int b, int& R, int& C) { const int st = b / 1024, sb = b % 1024, swz = sb ^ (((sb >> 9) & 1) << 5); R = (st >> 1) * 16 + swz / 64; C = (st & 1) * 32 + (swz % 64) / 2; }
__host__ __device__ __forceinline__ int perm32(int rho) { const int n = rho >> 4, i = rho & 15; return 8 * (i >> 2) + 4 * n + (i & 3); }

struct Unit { int pm, pn; };
struct Gemm { const bf16_t* A; const bf16_t* Bt; int M, N, K; };

struct StaticOrder {
    int nM, nN, nwg, G, c;
    __host__ __device__ void init(int M, int N, int G_, int c_) { nM = M / BM; nN = N / BM; nwg = nM * nN; G = G_; c = c_; }
    __host__ __device__ bool next(int i, Unit& u) const {
        const long L = (long)i * G + c; if (L >= nwg) return false;
        int wgid = (int)L; { const int q = nwg / NXCD, r = nwg % NXCD, xcd = wgid % NXCD, off = wgid / NXCD; wgid = (xcd < r ? xcd * (q + 1) : r * (q + 1) + (xcd - r) * q) + off; }
        const int nig = WGM * nN, gid = wgid / nig, fm = gid * WGM, gsz = (nM - fm) < WGM ? (nM - fm) : WGM;
        u.pm = fm + ((wgid % nig) % gsz); u.pn = (wgid % nig) / gsz; return true;
    }
    __device__ __forceinline__ void a_ready(const Unit&) const {}
    __device__ __forceinline__ void done(const Unit&) const {}
};

__device__ __forceinline__ unsigned cvt_pk_bf16(float lo, float hi) { unsigned r; asm volatile("v_cvt_pk_bf16_f32 %0, %1, %2" : "=v"(r) : "v"(lo), "v"(hi)); return r; }
template <class Epi, class Sched, bool ALIGN_EPI = false, bool SP2 = false>
__device__ __forceinline__ void gemm_phase(PG8_LAS unsigned char* lds, const Gemm g, const Sched& S, const Epi& E) {
    const int tid = threadIdx.x, wid = __builtin_amdgcn_readfirstlane(tid >> 6), lane = tid & 63, wr = wid >> 2, wc = wid & 3, fr = lane & 15, fq = lane >> 4;
    const int K = g.K, nt = K / BK;
    unsigned voffA[2], voffB[2];
#pragma unroll
    for (int i = 0; i < 2; ++i) { int R, C; stage_rc(tid * 16 + i * 8192, R, C); const int Rb = Epi::PERM ? ((R & ~31) + perm32(R & 31)) : R;
        voffA[i] = (unsigned)(R * K + C) * 2u; voffB[i] = (unsigned)(Rb * K + C) * 2u; }
    const size_t kstep = (size_t)(BK * 2);
    const size_t hstep = (size_t)HALF * K * 2;
    const size_t tstep = 2 * hstep;
    const unsigned ldsw = (unsigned)wid * 1024u;
    const int aoff = lds_byte(wr * 64 + fr, fq * 8), boff = lds_byte(wc * 32 + fr, fq * 8);
#define PG8_SA(b, h) (((b) * 2 + (h)) * HTB)
#define PG8_SB(b, h) ((4 + (b) * 2 + (h)) * HTB)
#define PG8_STAGE(bufoff, gbase, voff) do { _Pragma("unroll") for (int _i = 0; _i < 2; ++_i) \
        __builtin_amdgcn_global_load_lds((const unsigned*)((const char*)(gbase) + (voff)[_i]), (PG8_LAS unsigned*)(lds + (bufoff) + ldsw + _i * 8192), 16, 0, 0); } while (0)
#define PG8_LDA(dst, b, h) do { _Pragma("unroll") for (int m = 0; m < 4; ++m) _Pragma("unroll") for (int k = 0; k < 2; ++k) dst[m][k] = *(const PG8_LAS bf16x8*)(lds + PG8_SA(b, h) + aoff + m * 2048 + k * 1024); } while (0)
#define PG8_LDB(dst, b, h) do { _Pragma("unroll") for (int n = 0; n < 2; ++n) _Pragma("unroll") for (int k = 0; k < 2; ++k) dst[n][k] = *(const PG8_LAS bf16x8*)(lds + PG8_SB(b, h) + boff + n * 2048 + k * 1024); } while (0)
#define PG8_MMA(ai, bj, At, Bt) do { __builtin_amdgcn_s_setprio(1); _Pragma("unroll") for (int m = 0; m < 4; ++m) _Pragma("unroll") for (int n = 0; n < 2; ++n) _Pragma("unroll") for (int k = 0; k < 2; ++k) \
        acc[ai][bj][m][n] = __builtin_amdgcn_mfma_f32_16x16x32_bf16(Bt[n][k], At[m][k], acc[ai][bj][m][n], 0, 0, 0); __builtin_amdgcn_s_setprio(0); } while (0)
#define PG8_WAIT_V(n) asm volatile("s_waitcnt vmcnt(" #n ")" ::: "memory")
#define PG8_WAIT_L(n) asm volatile("s_waitcnt lgkmcnt(" #n ")" ::: "memory")
#define PG8_BAR __builtin_amdgcn_s_barrier()
#define PG8_SCHED __builtin_amdgcn_sched_barrier(0)
    Unit cur, nxt; int ui = 0;
    if (!S.next(0, cur)) return;
    f32x4 acc[2][2][4][2];
#pragma unroll
    for (int a = 0; a < 2; ++a)
#pragma unroll
        for (int b = 0; b < 2; ++b)
#pragma unroll
            for (int m = 0; m < 4; ++m)
#pragma unroll
                for (int n = 0; n < 2; ++n) acc[a][b][m][n] = (f32x4){0.f, 0.f, 0.f, 0.f};
    bf16x8 At[4][2], B0[2][2], B1[2][2];
    const char* cA = (const char*)g.A + (size_t)cur.pm * tstep; const char* cB = (const char*)g.Bt + (size_t)cur.pn * tstep;
    S.a_ready(cur);
    if constexpr (SP2) {
        PG8_STAGE(PG8_SB(0, 0), cB, voffB); PG8_STAGE(PG8_SB(0, 1), cB + hstep, voffB); PG8_STAGE(PG8_SA(0, 0), cA, voffA); PG8_STAGE(PG8_SA(0, 1), cA + hstep, voffA);
        if (wr == 1) PG8_BAR;
        PG8_WAIT_V(2); PG8_BAR;
        PG8_STAGE(PG8_SB(1, 0), cB + kstep, voffB); PG8_STAGE(PG8_SA(1, 0), cA + kstep, voffA); PG8_STAGE(PG8_SB(1, 1), cB + hstep + kstep, voffB);
        PG8_WAIT_V(6); PG8_BAR;
    } else {
        PG8_STAGE(PG8_SB(0, 0), cB, voffB); PG8_STAGE(PG8_SA(0, 0), cA, voffA); PG8_STAGE(PG8_SB(0, 1), cB + hstep, voffB); PG8_STAGE(PG8_SA(0, 1), cA + hstep, voffA);
        if (wr == 1) PG8_BAR;
        PG8_WAIT_V(4); PG8_BAR;
        PG8_STAGE(PG8_SB(1, 0), cB + kstep, voffB); PG8_STAGE(PG8_SA(1, 0), cA + kstep, voffA); PG8_STAGE(PG8_SB(1, 1), cB + hstep + kstep, voffB);
        PG8_WAIT_V(6); PG8_BAR;
    }
    for (;;) {
        const bool has_next = S.next(ui + 1, nxt);
        const char* nA = has_next ? (const char*)g.A + (size_t)nxt.pm * tstep : cA; const char* nB = has_next ? (const char*)g.Bt + (size_t)nxt.pn * tstep : cB;
        for (int t = 0; t < nt; t += 2) {
            const bool last = (t == nt - 2);
            const char* a1 = cA + (size_t)(t + 1) * kstep;
            const char* a2 = last ? nA : cA + (size_t)(t + 2) * kstep; const char* b2 = last ? nB : cB + (size_t)(t + 2) * kstep;
            const char* a3 = a2 + kstep; const char* b3 = b2 + kstep;
            if (last && has_next) S.a_ready(nxt);
            if constexpr (SP2) {
            PG8_LDB(B0, 0, 0); PG8_LDB(B1, 0, 1); PG8_SCHED; PG8_LDA(At, 0, 0); PG8_STAGE(PG8_SA(1, 1), a1 + hstep, voffA);
            PG8_WAIT_V(8); PG8_WAIT_L(0); PG8_BAR; PG8_MMA(0, 0, At, B0); PG8_MMA(0, 1, At, B1); PG8_BAR; PG8_SCHED;
            PG8_LDA(At, 0, 1); PG8_STAGE(PG8_SB(0, 0), b2, voffB); PG8_STAGE(PG8_SB(0, 1), b2 + hstep, voffB); PG8_STAGE(PG8_SA(0, 0), a2, voffA);
            PG8_WAIT_V(8); PG8_WAIT_L(0); PG8_BAR; PG8_MMA(1, 0, At, B0); PG8_MMA(1, 1, At, B1); PG8_BAR; PG8_SCHED;
            PG8_LDB(B0, 1, 0); PG8_LDB(B1, 1, 1); PG8_SCHED; PG8_LDA(At, 1, 0); PG8_STAGE(PG8_SA(0, 1), a2 + hstep, voffA);
            PG8_WAIT_V(8); PG8_WAIT_L(0); PG8_BAR; PG8_MMA(0, 0, At, B0); PG8_MMA(0, 1, At, B1); PG8_BAR; PG8_SCHED;
            PG8_LDA(At, 1, 1); PG8_STAGE(PG8_SB(1, 0), b3, voffB); PG8_STAGE(PG8_SB(1, 1), b3 + hstep, voffB); PG8_STAGE(PG8_SA(1, 0), a3, voffA);
            PG8_WAIT_V(8); PG8_WAIT_L(0); PG8_BAR; PG8_MMA(1, 0, At, B0); PG8_MMA(1, 1, At, B1); PG8_BAR; PG8_SCHED;
            } else {
            PG8_LDB(B0, 0, 0); PG8_SCHED; PG8_LDA(At, 0, 0); PG8_STAGE(PG8_SA(1, 1), a1 + hstep, voffA);
            PG8_WAIT_L(8); PG8_BAR; PG8_WAIT_L(0); PG8_MMA(0, 0, At, B0); PG8_BAR; PG8_SCHED;
            PG8_LDB(B1, 0, 1); PG8_STAGE(PG8_SB(0, 0), b2, voffB);
            PG8_BAR; PG8_WAIT_L(0); PG8_MMA(0, 1, At, B1); PG8_BAR;
            PG8_LDA(At, 0, 1); PG8_STAGE(PG8_SA(0, 0), a2, voffA);
            PG8_BAR; PG8_WAIT_L(0); PG8_MMA(1, 0, At, B0); PG8_BAR; PG8_SCHED;
            PG8_STAGE(PG8_SB(0, 1), b2 + hstep, voffB);
            PG8_WAIT_V(6); PG8_BAR; PG8_MMA(1, 1, At, B1); PG8_BAR;
            PG8_LDB(B0, 1, 0); PG8_SCHED; PG8_LDA(At, 1, 0); PG8_STAGE(PG8_SA(0, 1), a2 + hstep, voffA);
            PG8_WAIT_L(8); PG8_BAR; PG8_WAIT_L(0); PG8_MMA(0, 0, At, B0); PG8_BAR; PG8_SCHED;
            PG8_LDB(B1, 1, 1); PG8_STAGE(PG8_SB(1, 0), b3, voffB);
            PG8_BAR; PG8_WAIT_L(0); PG8_MMA(0, 1, At, B1); PG8_BAR;
            PG8_LDA(At, 1, 1); PG8_STAGE(PG8_SA(1, 0), a3, voffA);
            PG8_BAR; PG8_WAIT_L(0); PG8_MMA(1, 0, At, B0); PG8_BAR; PG8_SCHED;
            PG8_STAGE(PG8_SB(1, 1), b3 + hstep, voffB);
            PG8_WAIT_V(6); PG8_BAR; PG8_MMA(1, 1, At, B1); PG8_BAR;
            }
        }
        if constexpr (ALIGN_EPI) { if (wr == 0) PG8_BAR; }
        if constexpr (!Epi::AFTER_DRAIN) { E(acc, cur, wr, wc, fr, fq); S.done(cur); }
        if (!has_next) break;
#pragma unroll
        for (int a = 0; a < 2; ++a)
#pragma unroll
            for (int b = 0; b < 2; ++b)
#pragma unroll
                for (int m = 0; m < 4; ++m)
#pragma unroll
                    for (int n = 0; n < 2; ++n) acc[a][b][m][n] = (f32x4){0.f, 0.f, 0.f, 0.f};
        cur = nxt; cA = nA; cB = nB; ++ui;
        if constexpr (ALIGN_EPI) { if (wr == 1) PG8_BAR; }
    }
    PG8_WAIT_V(0);
    if constexpr (!ALIGN_EPI) { if (wr == 0) PG8_BAR; }
    PG8_BAR;
    if constexpr (Epi::AFTER_DRAIN) { E.fused(acc, cur, wr, wc, fr, fq, lds, wid, lane); S.done(cur); }
#undef PG8_SA
#undef PG8_SB
#undef PG8_STAGE
#undef PG8_LDA
#undef PG8_LDB
#undef PG8_MMA
#undef PG8_WAIT_V
#undef PG8_WAIT_L
#undef PG8_BAR
#undef PG8_SCHED
}
}
#define GAS __attribute__((address_space(1)))
#define LAS __attribute__((address_space(3)))
typedef unsigned short bf16;
typedef unsigned v4u __attribute__((ext_vector_type(4)));
typedef float f32x4 __attribute__((ext_vector_type(4)));
typedef short bf16x8 __attribute__((ext_vector_type(8)));
typedef GAS unsigned gu32;
typedef GAS unsigned long long gu64;
#define RLX_AGENT __ATOMIC_RELAXED, __HIP_MEMORY_SCOPE_AGENT
#define LDS_WAIT() asm volatile("s_waitcnt lgkmcnt(0)" ::: "memory")
#define VM_WAIT() asm volatile("s_waitcnt vmcnt(0)" ::: "memory")
__device__ __forceinline__ unsigned long long rt() { return __builtin_amdgcn_s_memrealtime(); }
__device__ __forceinline__ unsigned f2bf(float f) { unsigned u = __builtin_bit_cast(unsigned, f); return (u + 0x7fffu + ((u >> 16) & 1u)) >> 16; }
__device__ __forceinline__ unsigned pk2(float lo, float hi) { return f2bf(lo) | (f2bf(hi) << 16); }

#define XB_TMO      128
#define XB_XCNT(j)  (256  + 64 * (j))
#define XB_XSUB(j)  (1280 + 64 * (j))
#define XB_XGEN(j)  (2304 + 64 * (j))
#define XB_TOP      3328
#define XB_TOPGEN   3392
#define XCD_BAR_WORDS 3456
#define XB_SPIN_CAP (1u << 18)

__device__ __forceinline__ unsigned xb_ld(unsigned* p)              { return __hip_atomic_load(p, __ATOMIC_RELAXED, __HIP_MEMORY_SCOPE_AGENT); }
__device__ __forceinline__ unsigned xb_add(unsigned* p, unsigned v) { return __hip_atomic_fetch_add(p, v, __ATOMIC_RELAXED, __HIP_MEMORY_SCOPE_AGENT); }
__device__ __forceinline__ unsigned xb_xcc_id() { return (unsigned)__builtin_amdgcn_s_getreg((3 << 11) | 20) & 0xFu; }
#define XB_SPIN(cond, bar) do { unsigned _sp = 0; while (cond) { __builtin_amdgcn_s_sleep(1); \
    if ((++_sp & 255u) == 0u) { if (xb_ld(&(bar)[XB_TMO])) break; if (_sp > XB_SPIN_CAP) { atomicAdd(&(bar)[XB_TMO], 1u); break; } } } } while (0)

struct XcdBarrier {
    unsigned* bar; unsigned x;
    volatile LAS unsigned* st;
};

__device__ __forceinline__ XcdBarrier xcd_barrier_post(unsigned* bar, volatile LAS unsigned* st) {
    XcdBarrier b; b.bar = bar; b.x = xb_xcc_id(); b.st = st;
    if (threadIdx.x == 0) (void)xb_add(&bar[XB_XCNT(b.x)], 1u);
    return b;
}
__device__ __forceinline__ void xcd_barrier_complete(unsigned* bar, unsigned x, unsigned& nloc, unsigned& nx) {
    const unsigned G = gridDim.x * gridDim.y * gridDim.z;
    unsigned sum, cnt, mine, sp = 0u;
    for (;;) {
        sum = 0u; cnt = 0u; mine = 0u;
#pragma unroll
        for (unsigned j = 0; j < 16; ++j) { const unsigned c = xb_ld(&bar[XB_XCNT(j)]); sum += c; cnt += (c > 0u) ? 1u : 0u; mine = (j == x) ? c : mine; }
        if (sum == G) break;
        __builtin_amdgcn_s_sleep(1);
        if ((++sp & 255u) == 0u) { if (xb_ld(&bar[XB_TMO])) break; if (sp > XB_SPIN_CAP) { atomicAdd(&bar[XB_TMO], 1u); break; } }
    }
    nloc = mine > 0u ? mine : 1u; nx = cnt > 0u ? cnt : 1u;
}

__device__ __forceinline__ void xcd_barrier(const XcdBarrier& b) {
    asm volatile("s_waitcnt vmcnt(0)" ::: "memory");
    __syncthreads();
    if (threadIdx.x == 0) {
        unsigned* bar = b.bar;
        __builtin_amdgcn_s_waitcnt(0);
        unsigned nloc = b.st[0], nx = b.st[1];
        if (nloc == 0u) { xcd_barrier_complete(bar, b.x, nloc, nx); b.st[0] = nloc; b.st[1] = nx; }
        const unsigned old = xb_add(&bar[XB_XSUB(b.x)], 1u);
        const unsigned gen = old / nloc;
        if (old + 1u == (gen + 1u) * nloc) {
            __builtin_amdgcn_fence(__ATOMIC_RELEASE, "agent");
            asm volatile("s_waitcnt vmcnt(0)" ::: "memory");
            const unsigned og = xb_add(&bar[XB_TOP], 1u);
            const unsigned tg = og / nx;
            if (og + 1u == (tg + 1u) * nx) xb_add(&bar[XB_TOPGEN], 1u);
            else XB_SPIN(xb_ld(&bar[XB_TOPGEN]) == tg, bar);
            __builtin_amdgcn_fence(__ATOMIC_ACQUIRE, "agent");
            xb_add(&bar[XB_XGEN(b.x)], 1u);
            asm volatile("s_waitcnt vmcnt(0)" ::: "memory");
        } else {
            XB_SPIN(xb_ld(&bar[XB_XGEN(b.x)]) == gen, bar);
            __builtin_amdgcn_fence(__ATOMIC_ACQUIRE, "agent");
            asm volatile("s_waitcnt vmcnt(0)" ::: "memory");
        }
    }
    __syncthreads();
}

constexpr int T = 16384, D = 1024, SEQ = 8192, NCTX = 256, TCX = 512, DIN = 3840, MH = T + TCX;
constexpr int ZU = 0, ZV = 512, ZQ = 1024, ZK = 1536, ZVA = 1664, ZGA = 1792, ZGB = 2816;
constexpr int NEXP = 256, NSLOT = 9, LISTCAP = 16384, MOE_MAXT = 24;
constexpr float LOG2E = 1.4426950408889634f;
constexpr float QSCALE = 0.125f * LOG2E;
constexpr size_t MiB = 1u << 20;
constexpr size_t WS_CTL = 0, CTL_ZERO_BYTES = 1 * MiB;
constexpr size_t WS_ADAP = 1 * MiB;
constexpr size_t WS_ADAF = 2 * MiB;
constexpr size_t WS_ROPE = 2 * MiB + 128 * 1024;
constexpr size_t WS_WST = 2 * MiB + 256 * 1024;
constexpr size_t WS_RWT = 3 * MiB;
constexpr size_t WS_WINT = 4 * MiB;
constexpr size_t WS_WAT = 12 * MiB, WS_WBT = 13 * MiB, WS_WOT = 14 * MiB;
constexpr size_t WS_KVC = 16 * MiB;
constexpr size_t WS_GATEW = 17 * MiB;
constexpr size_t WS_H = 18 * MiB;
constexpr size_t WS_Z = 52 * MiB;
constexpr size_t WS_A = 172 * MiB, WS_O = 188 * MiB;
constexpr size_t WS_TMP = 204 * MiB;
constexpr size_t WS_Y = 268 * MiB;
constexpr size_t WS_X1 = 300 * MiB;
constexpr size_t WS_H2 = 364 * MiB;
constexpr size_t WS_LIST = 396 * MiB;
constexpr size_t WS_CONTRIB = 414 * MiB;
constexpr float CONTRIB_SCALE = 16.f;
constexpr size_t WS_END = 704 * MiB;
constexpr int CW_BAR = 4096;
constexpr int CW_CNT = 16384;
constexpr int CW_XRANK = 32768;
constexpr int SCR_BYTES = 148480;
constexpr int MISC_OFF = SCR_BYTES;
constexpr int LDS_BYTES = 152 * 1024;
constexpr int NWAVES = 8;

typedef float f32x2_t __attribute__((ext_vector_type(2)));
typedef __bf16 bf16x2_t __attribute__((ext_vector_type(2)));
typedef float f32x16 __attribute__((ext_vector_type(16)));
typedef short s16x4 __attribute__((ext_vector_type(4)));
typedef short v4i16_t __attribute__((ext_vector_type(4)));
typedef unsigned u32x2 __attribute__((ext_vector_type(2)));
typedef unsigned u32x4 __attribute__((ext_vector_type(4)));
typedef LAS unsigned char* ldsp;

__device__ __forceinline__ unsigned cvtpk(float lo, float hi) { f32x2_t v = {lo, hi}; bf16x2_t b = __builtin_convertvector(v, bf16x2_t); return __builtin_bit_cast(unsigned, b); }
__device__ __forceinline__ float bf2f(unsigned short u) { return __uint_as_float((unsigned)u << 16); }
__device__ __forceinline__ float bflo(unsigned w) { return __uint_as_float(w << 16); }
__device__ __forceinline__ float bfhi(unsigned w) { return __uint_as_float(w & 0xffff0000u); }
__device__ __forceinline__ float wave_sum(float v) {
#pragma unroll
    for (int o = 1; o < 64; o <<= 1) v += __shfl_xor(v, o);
    return v;
}
__device__ __forceinline__ float sigmoid_f(float x) { return __builtin_amdgcn_rcpf(1.f + __builtin_amdgcn_exp2f(-x * LOG2E)); }
__device__ __forceinline__ float silu_f(float x) { return x * sigmoid_f(x); }
__device__ __forceinline__ float gelu_f(float x) { const float u = 0.7978845608028654f * (x + 0.044715f * x * x * x); return x * sigmoid_f(2.f * u); }
__device__ __forceinline__ f32x16 mfma32(bf16x8 a, bf16x8 b, f32x16 c) { return __builtin_amdgcn_mfma_f32_32x32x16_bf16(a, b, c, 0, 0, 0); }
__device__ __forceinline__ f32x4 mfma16(bf16x8 a, bf16x8 b, f32x4 c) { return __builtin_amdgcn_mfma_f32_16x16x32_bf16(a, b, c, 0, 0, 0); }

struct Args { const float* in[26]; float* out; unsigned char* ws; int ph_lo, ph_hi; };
enum { I_X = 0, I_C, I_CTX, I_CCTX, I_ADAW, I_ADAB, I_N1G, I_N2G, I_WIN, I_LNG, I_LNB, I_GWS, I_GBS, I_SINK, I_WA, I_WB, I_WO, I_RW, I_RB, I_EG, I_EU, I_ED, I_SG, I_SU, I_SD, I_FG };

__device__ __forceinline__ void p0_transpose_item(const float* W, int K, int N, bf16* WT, LAS float* scr, int item, int lane) {
    const int nblk = N / 32, kb = item / nblk, nb = item % nblk, k0 = 64 * kb, n0 = 32 * nb;
#pragma unroll 8
    for (int i = 0; i < 32; ++i) { const int kk = 2 * i + (lane >> 5); scr[kk * 33 + (lane & 31)] = W[(size_t)(k0 + kk) * N + n0 + (lane & 31)]; }
    LDS_WAIT(); asm volatile("" ::: "memory");
    const int c = lane & 7;
#pragma unroll
    for (int j = 0; j < 4; ++j) { const int n = (lane >> 3) + 8 * j; const LAS float* s = scr + (8 * c) * 33 + n;
        v4u o; o.x = pk2(s[0 * 33], s[1 * 33]); o.y = pk2(s[2 * 33], s[3 * 33]); o.z = pk2(s[4 * 33], s[5 * 33]); o.w = pk2(s[6 * 33], s[7 * 33]);
        *(GAS v4u*)(WT + (size_t)(n0 + n) * K + k0 + 8 * c) = o; }
    LDS_WAIT(); asm volatile("" ::: "memory");
}

__device__ __forceinline__ void phase_prep(const Args& a, ldsp lds, int G) {
    const int tid = threadIdx.x, lane = tid & 63, wave = __builtin_amdgcn_readfirstlane(tid >> 6), blk = blockIdx.x;
    unsigned char* ws = a.ws;
    if (blk < 192) {
        const int cb = blk % 24, kc = blk / 24, col = cb * 256 + lane * 4, k0 = kc * 128 + wave * 16;
        const float* c = a.in[I_C]; const float* cc = a.in[I_CCTX]; const float* aw = a.in[I_ADAW];
        f32x4 a0 = {0.f, 0.f, 0.f, 0.f}, a1 = a0, a2 = a0;
#pragma unroll 4
        for (int k = 0; k < 16; ++k) {
            const int kk = k0 + k;
            const float s0 = silu_f(c[kk]), s1 = silu_f(c[1024 + kk]), s2 = silu_f(cc[kk]);
            const f32x4 w = *(const f32x4*)(aw + (size_t)kk * 6144 + col);
            a0 += w * s0; a1 += w * s1; a2 += w * s2;
        }
        LAS float* red = (LAS float*)lds;
        *(LAS f32x4*)(red + (wave * 3 + 0) * 256 + lane * 4) = a0;
        *(LAS f32x4*)(red + (wave * 3 + 1) * 256 + lane * 4) = a1;
        *(LAS f32x4*)(red + (wave * 3 + 2) * 256 + lane * 4) = a2;
        __syncthreads();
        float* adap = (float*)(ws + WS_ADAP);
        for (int idx = tid; idx < 768; idx += 512) {
            const int v = idx >> 8, cl = idx & 255; float s = 0.f;
#pragma unroll
            for (int w = 0; w < 8; ++w) s += red[(w * 3 + v) * 256 + cl];
            adap[(size_t)(kc * 3 + v) * 6144 + cb * 256 + cl] = s;
        }
        __syncthreads();
    }
    {
        LAS float* scr = (LAS float*)(lds + wave * 8704);
        const int gw = blk * NWAVES + wave, NGW = G * NWAVES;
        constexpr int I_1 = 16 * 120, I_2 = 8 * 32, I_3 = 8 * 32, I_4 = 16 * 32, I_5 = 16 * 8;
        for (int it = gw; it < I_1 + I_2 + I_3 + I_4 + I_5; it += NGW) {
            int r = it;
            if (r < I_1) { p0_transpose_item(a.in[I_WIN], 1024, 3840, (bf16*)(ws + WS_WINT), scr, r, lane); continue; } r -= I_1;
            if (r < I_2) { p0_transpose_item(a.in[I_WA], 512, 1024, (bf16*)(ws + WS_WAT), scr, r, lane); continue; } r -= I_2;
            if (r < I_3) { p0_transpose_item(a.in[I_WB], 512, 1024, (bf16*)(ws + WS_WBT), scr, r, lane); continue; } r -= I_3;
            if (r < I_4) { p0_transpose_item(a.in[I_WO], 1024, 1024, (bf16*)(ws + WS_WOT), scr, r, lane); continue; } r -= I_4;
            p0_transpose_item(a.in[I_RW], 1024, 256, (bf16*)(ws + WS_RWT), scr, r, lane);
        }
    }
    {
        const int gt = blk * 512 + tid, NT = G * 512;
        const float* gws = a.in[I_GWS]; bf16* wst = (bf16*)(ws + WS_WST);
        for (int i = gt; i < 8192; i += NT) {
            const f32x4 x0 = *(const f32x4*)(gws + i * 8), x1 = *(const f32x4*)(gws + i * 8 + 4);
            v4u o; o.x = cvtpk(x0[0], x0[1]); o.y = cvtpk(x0[2], x0[3]); o.z = cvtpk(x1[0], x1[1]); o.w = cvtpk(x1[2], x1[3]);
            *(v4u*)(wst + i * 8) = o;
        }
        float* rope = (float*)(ws + WS_ROPE);
        for (int i = gt; i < 2048; i += NT) {
            const int pos = i >> 4, f = i & 15;
            const float inv = __builtin_amdgcn_exp2f(-(float)f * (13.287712379549449f / 16.f));
            const float ang = (float)pos * inv;
            double rev = (double)ang * 0.15915494309189535; rev -= floor(rev);
            rope[pos * 32 + f] = __builtin_amdgcn_cosf((float)rev);
            rope[pos * 32 + 16 + f] = __builtin_amdgcn_sinf((float)rev);
        }
    }
}

__device__ __forceinline__ void phase_hnorm(const Args& a, ldsp lds, int G) {
    const int tid = threadIdx.x, lane = tid & 63, wave = __builtin_amdgcn_readfirstlane(tid >> 6), blk = blockIdx.x;
    unsigned char* ws = a.ws;
    const float* adap = (const float*)(ws + WS_ADAP); const float* adab = a.in[I_ADAB];
    LAS float* modv = (LAS float*)lds;
    for (int idx = tid; idx < 3 * 2048; idx += 512) {
        const int v = idx >> 11, j = idx & 2047; float s = adab[j];
#pragma unroll
        for (int kc = 0; kc < 8; ++kc) s += adap[(size_t)(kc * 3 + v) * 6144 + j];
        modv[idx] = (j >= 1024) ? s + 1.f : s;
    }
    { float* adaf = (float*)(ws + WS_ADAF);
      for (int idx = blk * 512 + tid; idx < 3 * 6144; idx += G * 512) {
          const int v = idx / 6144, j = idx % 6144; float s = adab[j];
#pragma unroll
          for (int kc = 0; kc < 8; ++kc) s += adap[(size_t)(kc * 3 + v) * 6144 + j];
          adaf[idx] = s; } }
    __syncthreads();
    const float* g1 = a.in[I_N1G]; bf16* H = (bf16*)(ws + WS_H);
    for (int t = blk * NWAVES + wave; t < MH; t += G * NWAVES) {
        const float* xr = (t < T) ? a.in[I_X] + (size_t)t * D : a.in[I_CTX] + (size_t)(t - T) * D;
        const int v = (t < T) ? (t >> 13) : 2;
        f32x4 x[4]; float ss = 0.f;
#pragma unroll
        for (int j = 0; j < 4; ++j) { x[j] = *(const f32x4*)(xr + 4 * lane + 256 * j); ss += (x[j][0] * x[j][0] + x[j][1] * x[j][1]) + (x[j][2] * x[j][2] + x[j][3] * x[j][3]); }
        const float r = rsqrtf(wave_sum(ss) * (1.f / D) + 1e-6f);
#pragma unroll
        for (int j = 0; j < 4; ++j) {
            const int col = 4 * lane + 256 * j;
            const f32x4 g = *(const f32x4*)(g1 + col);
            const f32x4 sh = *(LAS f32x4*)(modv + v * 2048 + col), sc = *(LAS f32x4*)(modv + v * 2048 + 1024 + col);
            const f32x4 h = (x[j] * r) * g * sc + sh;
            u32x2 o; o.x = cvtpk(h[0], h[1]); o.y = cvtpk(h[2], h[3]);
            *(u32x2*)(H + (size_t)t * D + col) = o;
        }
    }
}

struct WinOrder {
    pg8::StaticOrder so;
    __device__ void init(int G, int c) { so.init(T, DIN, G, c); }
    __device__ bool next(int i, pg8::Unit& u) const {
        const long L = (long)i * so.G + so.c;
        if (L < 960) return so.next(i, u);
        if (L < 962) { u.pm = 64 + (int)(L - 960); u.pn = 6; return true; }
        return false;
    }
    __device__ __forceinline__ void a_ready(const pg8::Unit&) const {}
    __device__ __forceinline__ void done(const pg8::Unit&) const {}
};
struct EpiWin {
    static constexpr bool PERM = false, AFTER_DRAIN = false;
    bf16* Z; bf16* KVC; const float* rope;
    __device__ __forceinline__ void operator()(const pg8::f32x4 (&acc)[2][2][4][2], const pg8::Unit& u, int wr, int wc, int fr, int fq) const {
        const int row0 = u.pm * 256 + wr * 64 + fr, colb = u.pn * 256 + wc * 32 + 4 * fq, pn = u.pn;
        if (u.pm >= 64) {
#pragma unroll
            for (int ai = 0; ai < 2; ++ai)
#pragma unroll
                for (int m = 0; m < 4; ++m) { bf16* rp = KVC + (size_t)(row0 + ai * 128 + m * 16 - T) * 256 + (colb - ZK);
#pragma unroll
                    for (int bj = 0; bj < 2; ++bj)
#pragma unroll
                        for (int n = 0; n < 2; ++n) { const pg8::f32x4 v = acc[ai][bj][m][n]; u32x2 o; o.x = cvtpk(v[0], v[1]); o.y = cvtpk(v[2], v[3]); *(u32x2*)(rp + bj * 128 + n * 16) = o; } }
            return;
        }
#pragma unroll
        for (int ai = 0; ai < 2; ++ai)
#pragma unroll
            for (int m = 0; m < 4; ++m) {
                const int r = row0 + ai * 128 + m * 16; bf16* rp = Z + (size_t)r * DIN + colb;
                if (pn <= 3) {
#pragma unroll
                    for (int bj = 0; bj < 2; ++bj)
#pragma unroll
                        for (int n = 0; n < 2; ++n) { const pg8::f32x4 v = acc[ai][bj][m][n]; u32x2 o; o.x = cvtpk(gelu_f(v[0]), gelu_f(v[1])); o.y = cvtpk(gelu_f(v[2]), gelu_f(v[3])); *(u32x2*)(rp + bj * 128 + n * 16) = o; }
                } else if (pn <= 6) {
                    const int pos = (wc & 1) ? (r & 63) : ((r & 8191) >> 6);
                    const pg8::f32x4 cs = *(const pg8::f32x4*)(rope + pos * 32 + 4 * fq), sn = *(const pg8::f32x4*)(rope + pos * 32 + 16 + 4 * fq);
                    const float sc = (pn < 6) ? QSCALE : 1.f;
#pragma unroll
                    for (int bj = 0; bj < 2; ++bj) {
                        const pg8::f32x4 x1 = acc[ai][bj][m][0], x2 = acc[ai][bj][m][1];
                        pg8::f32x4 o1, o2;
                        if (pn == 6 && bj == 1) { o1 = x1; o2 = x2; }
                        else { o1 = (x1 * cs - x2 * sn) * sc; o2 = (x2 * cs + x1 * sn) * sc; }
                        u32x2 w1, w2; w1.x = cvtpk(o1[0], o1[1]); w1.y = cvtpk(o1[2], o1[3]); w2.x = cvtpk(o2[0], o2[1]); w2.y = cvtpk(o2[2], o2[3]);
                        *(u32x2*)(rp + bj * 128) = w1; *(u32x2*)(rp + bj * 128 + 16) = w2;
                    }
                } else {
#pragma unroll
                    for (int bj = 0; bj < 2; ++bj)
#pragma unroll
                        for (int n = 0; n < 2; ++n) { const pg8::f32x4 v = acc[ai][bj][m][n]; u32x2 o; o.x = cvtpk(sigmoid_f(v[0]), sigmoid_f(v[1])); o.y = cvtpk(sigmoid_f(v[2]), sigmoid_f(v[3])); *(u32x2*)(rp + bj * 128 + n * 16) = o; }
                }
            }
    }
};
struct EpiMergeA {
    static constexpr bool PERM = true, AFTER_DRAIN = false;
    const bf16* Z; bf16* Y;
    __device__ __forceinline__ void operator()(const pg8::f32x4 (&acc)[2][2][4][2], const pg8::Unit& u, int wr, int wc, int fr, int fq) const {
        const int row0 = u.pm * 256 + wr * 64 + fr, col0 = u.pn * 256 + wc * 32 + 8 * fq;
#pragma unroll
        for (int ai = 0; ai < 2; ++ai)
#pragma unroll
            for (int m = 0; m < 4; ++m) { const int r = row0 + ai * 128 + m * 16;
#pragma unroll
                for (int bj = 0; bj < 2; ++bj) { const int c = col0 + bj * 128;
                    const u32x4 g = *(const u32x4*)(Z + (size_t)r * DIN + ZGA + c);
                    const pg8::f32x4 v0 = acc[ai][bj][m][0], v1 = acc[ai][bj][m][1];
                    u32x4 o;
                    o.x = cvtpk(v0[0] * bflo(g.x), v0[1] * bfhi(g.x)); o.y = cvtpk(v0[2] * bflo(g.y), v0[3] * bfhi(g.y));
                    o.z = cvtpk(v1[0] * bflo(g.z), v1[1] * bfhi(g.z)); o.w = cvtpk(v1[2] * bflo(g.w), v1[3] * bfhi(g.w));
                    *(u32x4*)(Y + (size_t)r * D + c) = o; } }
    }
};
struct EpiMergeB {
    static constexpr bool PERM = true, AFTER_DRAIN = false;
    const bf16* Z; bf16* Y;
    __device__ __forceinline__ void operator()(const pg8::f32x4 (&acc)[2][2][4][2], const pg8::Unit& u, int wr, int wc, int fr, int fq) const {
        const int row0 = u.pm * 256 + wr * 64 + fr, col0 = u.pn * 256 + wc * 32 + 8 * fq;
#pragma unroll
        for (int ai = 0; ai < 2; ++ai)
#pragma unroll
            for (int m = 0; m < 4; ++m) { const int r = row0 + ai * 128 + m * 16;
#pragma unroll
                for (int bj = 0; bj < 2; ++bj) { const int c = col0 + bj * 128;
                    const u32x4 g = *(const u32x4*)(Z + (size_t)r * DIN + ZGB + c);
                    const u32x4 tp = *(const u32x4*)(Y + (size_t)r * D + c);
                    const pg8::f32x4 t0 = {bflo(tp.x), bfhi(tp.x), bflo(tp.y), bfhi(tp.y)}, t1 = {bflo(tp.z), bfhi(tp.z), bflo(tp.w), bfhi(tp.w)};
                    const pg8::f32x4 v0 = acc[ai][bj][m][0], v1 = acc[ai][bj][m][1];
                    u32x4 o;
                    o.x = cvtpk(t0[0] + v0[0] * bflo(g.x), t0[1] + v0[1] * bfhi(g.x)); o.y = cvtpk(t0[2] + v0[2] * bflo(g.y), t0[3] + v0[3] * bfhi(g.y));
                    o.z = cvtpk(t1[0] + v1[0] * bflo(g.z), t1[1] + v1[1] * bfhi(g.z)); o.w = cvtpk(t1[2] + v1[2] * bflo(g.w), t1[3] + v1[3] * bfhi(g.w));
                    *(u32x4*)(Y + (size_t)r * D + c) = o; } }
    }
};
struct EpiWo {
    static constexpr bool PERM = true, AFTER_DRAIN = false;
    const float* x; const float* adaf; bf16* X1;
    __device__ __forceinline__ void operator()(const pg8::f32x4 (&acc)[2][2][4][2], const pg8::Unit& u, int wr, int wc, int fr, int fq) const {
        const int row0 = u.pm * 256 + wr * 64 + fr, col0 = u.pn * 256 + wc * 32 + 8 * fq;
        const float* g1 = adaf + (u.pm >= 32 ? 6144 : 0) + 2048;
#pragma unroll
        for (int bj = 0; bj < 2; ++bj) { const int c = col0 + bj * 128;
            const pg8::f32x4 ga = *(const pg8::f32x4*)(g1 + c), gb = *(const pg8::f32x4*)(g1 + c + 4);
#pragma unroll
            for (int ai = 0; ai < 2; ++ai)
#pragma unroll
                for (int m = 0; m < 4; ++m) { const int r = row0 + ai * 128 + m * 16;
                    const pg8::f32x4 x0 = *(const pg8::f32x4*)(x + (size_t)r * D + c), x1 = *(const pg8::f32x4*)(x + (size_t)r * D + c + 4);
                    const pg8::f32x4 o0 = x0 + ga * acc[ai][bj][m][0], o1 = x1 + gb * acc[ai][bj][m][1];
                    u32x4 w; w.x = cvtpk(o0[0], o0[1]); w.y = cvtpk(o0[2], o0[3]); w.z = cvtpk(o1[0], o1[1]); w.w = cvtpk(o1[2], o1[3]);
                    *(u32x4*)(X1 + (size_t)r * D + c) = w; } }
    }
};


__device__ __forceinline__ s16x4 vtr(LAS const unsigned char* p) { return __builtin_bit_cast(s16x4, __builtin_amdgcn_ds_read_tr16_b64_v4i16((LAS v4i16_t*)p)); }

__device__ __forceinline__ void attn_item(const bf16* Z, const bf16* KVC, const float* sink, bf16* Obuf, ldsp lds, int b, int nb, int hk, int qh) {
    const int tid = threadIdx.x, lane = tid & 63, wave = __builtin_amdgcn_readfirstlane(tid >> 6), r32 = lane & 31, hi = lane >> 5;
    const int rq = wave >> 1, head = hk * 4 + rq;
    const int iq = qh * 64 + (wave & 1) * 32 + r32;
    const int wlo = (nb == 0) ? 2 : qh, whi = (nb == 63) ? 4 : 5 + qh, nwin = whi - wlo, ntile = nwin + 4;
    const int tokq = b * SEQ + nb * 128 + iq;
    bf16x8 qr[4];
#pragma unroll
    for (int d0 = 0; d0 < 4; ++d0) qr[d0] = *(const bf16x8*)(Z + (size_t)tokq * DIN + ZQ + head * 64 + d0 * 16 + hi * 8);
    float mrun = sink[head] * LOG2E, lrun = (hi == 0) ? 1.f : 0.f;
    f32x16 o[2];
#pragma unroll
    for (int j = 0; j < 2; ++j)
#pragma unroll
        for (int r = 0; r < 16; ++r) o[j][r] = 0.f;
    const int kdst = wave * 1024 + lane * 16, vdst = 8192 + (wave >> 2) * 4096 + lane * 64 + (wave & 3) * 16;
#define ATT_SRC(s, kp, vp) do { const int tl_ = (s) < nwin ? wlo + (s) : 6 + (s) - nwin; \
        if (tl_ < 6) { const int tok_ = b * SEQ + (nb - 1 + (tl_ >> 1)) * 128 + (tl_ & 1) * 64 + lane; kp = Z + (size_t)tok_ * DIN + ZK + hk * 64 + wave * 8; vp = Z + (size_t)tok_ * DIN + ZVA + hk * 64 + wave * 8; } \
        else { const int row_ = b * NCTX + (tl_ - 6) * 64 + lane; kp = KVC + (size_t)row_ * 256 + hk * 64 + wave * 8; vp = KVC + (size_t)row_ * 256 + 128 + hk * 64 + wave * 8; } } while (0)
    u32x4 kreg, vreg;
    { const bf16 *kp, *vp; ATT_SRC(0, kp, vp); kreg = *(const u32x4*)kp; vreg = *(const u32x4*)vp; }
    *(LAS u32x4*)(lds + kdst) = kreg; *(LAS u32x4*)(lds + vdst) = vreg;
    __syncthreads();
    const int vrd = ((lane & 15) >> 2) * 64 + ((lane >> 4) & 1) * 32 + (lane & 3) * 8 + hi * 256;
    for (int s = 0; s < ntile; ++s) {
        const int base = (s & 1) * 16384;
        const int tl = s < nwin ? wlo + s : 6 + s - nwin;
        if (s + 1 < ntile) { const bf16 *kp, *vp; ATT_SRC(s + 1, kp, vp); kreg = *(const u32x4*)kp; vreg = *(const u32x4*)vp; }
        {
            f32x16 p0, p1;
#pragma unroll
            for (int r = 0; r < 16; ++r) { p0[r] = 0.f; p1[r] = 0.f; }
#pragma unroll
            for (int d0 = 0; d0 < 4; ++d0) {
                const bf16x8 k0 = *(LAS const bf16x8*)(lds + base + (2 * d0 + hi) * 1024 + r32 * 16);
                const bf16x8 k1 = *(LAS const bf16x8*)(lds + base + (2 * d0 + hi) * 1024 + (r32 + 32) * 16);
                p0 = mfma32(k0, qr[d0], p0); p1 = mfma32(k1, qr[d0], p1);
            }
            if (tl < 2) {
                const int j0 = (tl & 1) * 64 + 4 * hi;
#pragma unroll
                for (int r = 0; r < 16; ++r) { const int j = j0 + (r & 3) + 8 * (r >> 2); if (j < iq) p0[r] = -INFINITY; if (j + 32 < iq) p1[r] = -INFINITY; }
            } else if (tl == 4 || tl == 5) {
                const int j0 = (tl & 1) * 64 + 4 * hi;
#pragma unroll
                for (int r = 0; r < 16; ++r) { const int j = j0 + (r & 3) + 8 * (r >> 2); if (j > iq) p0[r] = -INFINITY; if (j + 32 > iq) p1[r] = -INFINITY; }
            }
            float mx = fmaxf(p0[0], p1[0]);
#pragma unroll
            for (int r = 1; r < 16; ++r) mx = fmaxf(mx, fmaxf(p0[r], p1[r]));
            mx = fmaxf(mx, __shfl_xor(mx, 32));
            const float mn = fmaxf(mrun, mx), alpha = __builtin_amdgcn_exp2f(mrun - mn);
            mrun = mn;
            float rs = 0.f;
#pragma unroll
            for (int r = 0; r < 16; ++r) { p0[r] = __builtin_amdgcn_exp2f(p0[r] - mn); p1[r] = __builtin_amdgcn_exp2f(p1[r] - mn); rs += p0[r] + p1[r]; }
            lrun = lrun * alpha + rs;
#pragma unroll
            for (int r = 0; r < 16; ++r) { o[0][r] *= alpha; o[1][r] *= alpha; }
            bf16x8 pf[4];
#pragma unroll
            for (int s4 = 0; s4 < 4; ++s4) {
                u32x4 w;
                if (s4 < 2) { w.x = cvtpk(p0[8 * s4 + 0], p0[8 * s4 + 1]); w.y = cvtpk(p0[8 * s4 + 2], p0[8 * s4 + 3]); w.z = cvtpk(p0[8 * s4 + 4], p0[8 * s4 + 5]); w.w = cvtpk(p0[8 * s4 + 6], p0[8 * s4 + 7]); }
                else { const int q = s4 - 2; w.x = cvtpk(p1[8 * q + 0], p1[8 * q + 1]); w.y = cvtpk(p1[8 * q + 2], p1[8 * q + 3]); w.z = cvtpk(p1[8 * q + 4], p1[8 * q + 5]); w.w = cvtpk(p1[8 * q + 6], p1[8 * q + 7]); }
                pf[s4] = __builtin_bit_cast(bf16x8, w);
            }
#pragma unroll
            for (int dblk = 0; dblk < 2; ++dblk)
#pragma unroll
                for (int s4 = 0; s4 < 4; ++s4) {
                    const s16x4 lo = vtr(lds + base + 8192 + dblk * 4096 + vrd + (16 * s4) * 64);
                    const s16x4 hh = vtr(lds + base + 8192 + dblk * 4096 + vrd + (16 * s4 + 8) * 64);
                    const bf16x8 vf = {lo[0], lo[1], lo[2], lo[3], hh[0], hh[1], hh[2], hh[3]};
                    o[dblk] = mfma32(vf, pf[s4], o[dblk]);
                }
        }
        if (s + 1 < ntile) { *(LAS u32x4*)(lds + (16384 - base) + kdst) = kreg; *(LAS u32x4*)(lds + (16384 - base) + vdst) = vreg; }
        __syncthreads();
    }
#undef ATT_SRC
    {
        const float lt = lrun + __shfl_xor(lrun, 32), inv = 1.f / lt;
        bf16* op = Obuf + (size_t)tokq * 512 + head * 64;
#pragma unroll
        for (int dblk = 0; dblk < 2; ++dblk)
#pragma unroll
            for (int r4 = 0; r4 < 4; ++r4) {
                u32x2 w; w.x = cvtpk(o[dblk][4 * r4] * inv, o[dblk][4 * r4 + 1] * inv); w.y = cvtpk(o[dblk][4 * r4 + 2] * inv, o[dblk][4 * r4 + 3] * inv);
                *(u32x2*)(op + 32 * dblk + 8 * r4 + 4 * hi) = w;
            }
    }
}

__device__ __forceinline__ void gmlp_item(const bf16* Z, const float* lng, const float* lnb, const bf16* WsT, const float* bs, bf16* Abuf, ldsp lds, int ch, int gp) {
    const int tid = threadIdx.x, lane = tid & 63, wave = __builtin_amdgcn_readfirstlane(tid >> 6), fr = lane & 15, fq = lane >> 4;
    const int tok0 = ch * 128;
    LAS bf16* VT = (LAS bf16*)lds;
    f32x4 gA = *(const f32x4*)(lng + lane * 8), gB = *(const f32x4*)(lng + lane * 8 + 4), bA = *(const f32x4*)(lnb + lane * 8), bB = *(const f32x4*)(lnb + lane * 8 + 4);
#pragma unroll
    for (int rnd = 0; rnd < 2; ++rnd) {
        float y[8][8];
#pragma unroll
        for (int j = 0; j < 8; ++j) {
            const int tok = tok0 + wave * 16 + rnd * 8 + j;
            const u32x4 raw = *(const u32x4*)(Z + (size_t)tok * DIN + ZV + lane * 8);
            float x[8] = {bflo(raw.x), bfhi(raw.x), bflo(raw.y), bfhi(raw.y), bflo(raw.z), bfhi(raw.z), bflo(raw.w), bfhi(raw.w)};
            float s = 0.f;
#pragma unroll
            for (int i = 0; i < 8; ++i) s += x[i];
            const float mu = wave_sum(s) * (1.f / 512.f);
            float q = 0.f;
#pragma unroll
            for (int i = 0; i < 8; ++i) { x[i] -= mu; q += x[i] * x[i]; }
            const float rstd = rsqrtf(wave_sum(q) * (1.f / 512.f) + 1e-6f);
            y[j][0] = x[0] * rstd * gA[0] + bA[0]; y[j][1] = x[1] * rstd * gA[1] + bA[1]; y[j][2] = x[2] * rstd * gA[2] + bA[2]; y[j][3] = x[3] * rstd * gA[3] + bA[3];
            y[j][4] = x[4] * rstd * gB[0] + bB[0]; y[j][5] = x[5] * rstd * gB[1] + bB[1]; y[j][6] = x[6] * rstd * gB[2] + bB[2]; y[j][7] = x[7] * rstd * gB[3] + bB[3];
        }
        if ((lane >> 5) == gp) {
            const int gl = (lane >> 4) & 1;
#pragma unroll
            for (int i = 0; i < 8; ++i) {
                u32x4 w; w.x = cvtpk(y[0][i], y[1][i]); w.y = cvtpk(y[2][i], y[3][i]); w.z = cvtpk(y[4][i], y[5][i]); w.w = cvtpk(y[6][i], y[7][i]);
                *(LAS u32x4*)(VT + gl * (128 * 136) + (8 * (lane & 15) + i) * 136 + wave * 16 + rnd * 8) = w;
            }
        }
    }
    __syncthreads();
    const int wm = wave >> 1, wn = wave & 1;
#pragma unroll
    for (int gl = 0; gl < 2; ++gl) {
        const int g = 2 * gp + gl;
        f32x4 acc[2][4];
#pragma unroll
        for (int m = 0; m < 2; ++m)
#pragma unroll
            for (int n = 0; n < 4; ++n) acc[m][n] = (f32x4){0.f, 0.f, 0.f, 0.f};
#pragma unroll
        for (int ks = 0; ks < 4; ++ks) {
            bf16x8 af[2], bfr[4];
#pragma unroll
            for (int m = 0; m < 2; ++m) af[m] = *(const bf16x8*)(WsT + (size_t)g * 16384 + (32 * wm + 16 * m + fr) * 128 + 32 * ks + 8 * fq);
#pragma unroll
            for (int n = 0; n < 4; ++n) bfr[n] = *(LAS const bf16x8*)(VT + gl * (128 * 136) + (64 * wn + 16 * n + fr) * 136 + 32 * ks + 8 * fq);
#pragma unroll
            for (int m = 0; m < 2; ++m)
#pragma unroll
                for (int n = 0; n < 4; ++n) acc[m][n] = mfma16(bfr[n], af[m], acc[m][n]);
        }
#pragma unroll
        for (int m = 0; m < 2; ++m) {
            const int p = 32 * wm + 16 * m + fr, tok = tok0 + p; const float bias = bs[g * 128 + p];
#pragma unroll
            for (int n = 0; n < 4; ++n) {
                const int c = g * 128 + 64 * wn + 16 * n + 4 * fq;
                const u32x2 uw = *(const u32x2*)(Z + (size_t)tok * DIN + ZU + c);
                u32x2 w; w.x = cvtpk(bflo(uw.x) * (acc[m][n][0] + bias), bfhi(uw.x) * (acc[m][n][1] + bias)); w.y = cvtpk(bflo(uw.y) * (acc[m][n][2] + bias), bfhi(uw.y) * (acc[m][n][3] + bias));
                *(u32x2*)(Abuf + (size_t)tok * 512 + c) = w;
            }
        }
    }
    __syncthreads();
}

__device__ __forceinline__ void phase_mixers(const Args& a, ldsp lds, int G, int vcu) {
    unsigned char* ws = a.ws;
    const bf16* Z = (const bf16*)(ws + WS_Z);
    for (int it = vcu; it < 512; it += G) {
        const int qh = it & 1, hk = (it >> 1) & 1, nb = (it >> 2) & 63, b = it >> 8;
        attn_item(Z, (const bf16*)(ws + WS_KVC), a.in[I_SINK], (bf16*)(ws + WS_O), lds, b, nb, hk, qh);
    }
    for (int it = vcu; it < 256; it += G) {
        gmlp_item(Z, a.in[I_LNG], a.in[I_LNB], (const bf16*)(ws + WS_WST), a.in[I_GBS], (bf16*)(ws + WS_A), lds, it >> 1, it & 1);
    }
}

#define KI_BEFORE(ka, ia, kb, ib) (((ka) > (kb)) || ((ka) == (kb) && (ia) < (ib)))
#define KI_CAS(K, I, p, q) do { const bool sw_ = KI_BEFORE(K[q], I[q], K[p], I[p]); const float kp_ = sw_ ? K[q] : K[p], kq_ = sw_ ? K[p] : K[q]; const int ip_ = sw_ ? I[q] : I[p], iq_ = sw_ ? I[p] : I[q]; \
        K[p] = kp_; I[p] = ip_; K[q] = kq_; I[q] = iq_; } while (0)
#define KI_SORT8(K, I) do { KI_CAS(K, I, 0, 1); KI_CAS(K, I, 2, 3); KI_CAS(K, I, 4, 5); KI_CAS(K, I, 6, 7); \
        KI_CAS(K, I, 0, 2); KI_CAS(K, I, 1, 3); KI_CAS(K, I, 4, 6); KI_CAS(K, I, 5, 7); \
        KI_CAS(K, I, 1, 2); KI_CAS(K, I, 5, 6); KI_CAS(K, I, 0, 4); KI_CAS(K, I, 3, 7); \
        KI_CAS(K, I, 1, 5); KI_CAS(K, I, 2, 6); KI_CAS(K, I, 1, 4); KI_CAS(K, I, 3, 6); \
        KI_CAS(K, I, 2, 4); KI_CAS(K, I, 3, 5); KI_CAS(K, I, 3, 4); } while (0)
#define KI_MERGE8(KA, IA, KB, IB) do { \
        _Pragma("unroll") for (int r_ = 0; r_ < 8; ++r_) { const bool tb_ = KI_BEFORE(KB[7 - r_], IB[7 - r_], KA[r_], IA[r_]); KA[r_] = tb_ ? KB[7 - r_] : KA[r_]; IA[r_] = tb_ ? IB[7 - r_] : IA[r_]; } \
        KI_CAS(KA, IA, 0, 4); KI_CAS(KA, IA, 1, 5); KI_CAS(KA, IA, 2, 6); KI_CAS(KA, IA, 3, 7); \
        KI_CAS(KA, IA, 0, 2); KI_CAS(KA, IA, 1, 3); KI_CAS(KA, IA, 4, 6); KI_CAS(KA, IA, 5, 7); \
        KI_CAS(KA, IA, 0, 1); KI_CAS(KA, IA, 2, 3); KI_CAS(KA, IA, 4, 5); KI_CAS(KA, IA, 6, 7); } while (0)
__device__ __forceinline__ void router_item(const Args& a, ldsp lds, int it) {
    const int tid = threadIdx.x, lane = tid & 63, wave = __builtin_amdgcn_readfirstlane(tid >> 6), fr = lane & 15, fq = lane >> 4;
    unsigned char* ws = a.ws;
    const int t0 = it * 64, b = t0 >> 13;
    const bf16* X1 = (const bf16*)(ws + WS_X1); const float* adaf = (const float*)(ws + WS_ADAF) + b * 6144;
    const float* g2 = a.in[I_N2G]; unsigned char* H2 = ws + WS_H2;
    {
        f32x4 gm[2][2], sh[2][2];
#pragma unroll
        for (int j = 0; j < 2; ++j)
#pragma unroll
            for (int h = 0; h < 2; ++h) {
                const int c = 8 * lane + 512 * j + 4 * h;
                const f32x4 gg = *(const f32x4*)(g2 + c), sc = *(const f32x4*)(adaf + 4 * 1024 + c);
                gm[j][h] = gg * (sc + 1.f); sh[j][h] = *(const f32x4*)(adaf + 3 * 1024 + c);
            }
#pragma unroll
        for (int half = 0; half < 2; ++half) {
            f32x4 x[4][2][2];
#pragma unroll
            for (int tt = 0; tt < 4; ++tt)
#pragma unroll
                for (int j = 0; j < 2; ++j) {
                    const u32x4 w = *(const u32x4*)(X1 + (size_t)(t0 + wave * 8 + half * 4 + tt) * D + 8 * lane + 512 * j);
                    x[tt][j][0] = (f32x4){bflo(w.x), bfhi(w.x), bflo(w.y), bfhi(w.y)}; x[tt][j][1] = (f32x4){bflo(w.z), bfhi(w.z), bflo(w.w), bfhi(w.w)};
                }
#pragma unroll
            for (int tt = 0; tt < 4; ++tt) {
                const int row = wave * 8 + half * 4 + tt, tok = t0 + row;
                float ss = 0.f;
#pragma unroll
                for (int j = 0; j < 2; ++j)
#pragma unroll
                    for (int h = 0; h < 2; ++h) { const f32x4 v = x[tt][j][h]; ss += (v[0] * v[0] + v[1] * v[1]) + (v[2] * v[2] + v[3] * v[3]); }
                const float r = rsqrtf(wave_sum(ss) * (1.f / D) + 1e-6f);
#pragma unroll
                for (int j = 0; j < 2; ++j) {
                    const f32x4 h0 = (x[tt][j][0] * r) * gm[j][0] + sh[j][0], h1 = (x[tt][j][1] * r) * gm[j][1] + sh[j][1];
                    u32x4 w; w.x = cvtpk(h0[0], h0[1]); w.y = cvtpk(h0[2], h0[3]); w.z = cvtpk(h1[0], h1[1]); w.w = cvtpk(h1[2], h1[3]);
                    { int f0 = 0, f1 = 0;
                      f0 = __builtin_amdgcn_cvt_pk_fp8_f32(h0[0], h0[1], f0, false); f0 = __builtin_amdgcn_cvt_pk_fp8_f32(h0[2], h0[3], f0, true);
                      f1 = __builtin_amdgcn_cvt_pk_fp8_f32(h1[0], h1[1], f1, false); f1 = __builtin_amdgcn_cvt_pk_fp8_f32(h1[2], h1[3], f1, true);
                      u32x2 w8; w8.x = (unsigned)f0; w8.y = (unsigned)f1; *(u32x2*)(H2 + (size_t)tok * D + 8 * lane + 512 * j) = w8; }
                    const int kc = lane + 64 * j;
                    *(LAS u32x4*)(lds + kc * 1024 + ((row ^ (kc & 7)) * 16)) = w;
                }
            }
        }
    }
    __syncthreads();
    f32x4 acc[4][2];
#pragma unroll
    for (int m = 0; m < 4; ++m)
#pragma unroll
        for (int n = 0; n < 2; ++n) acc[m][n] = (f32x4){0.f, 0.f, 0.f, 0.f};
    const bf16* RwT = (const bf16*)(ws + WS_RWT) + (size_t)(32 * wave + fr) * D + 8 * fq;
#pragma unroll 8
    for (int ks = 0; ks < 32; ++ks) {
        const int kc = 4 * ks + fq;
        bf16x8 af[4], bfr[2];
#pragma unroll
        for (int n = 0; n < 2; ++n) bfr[n] = *(const bf16x8*)(RwT + (size_t)(16 * n) * D + 32 * ks);
#pragma unroll
        for (int m = 0; m < 4; ++m) af[m] = *(LAS const bf16x8*)(lds + kc * 1024 + (((16 * m + fr) ^ (kc & 7)) * 16));
#pragma unroll
        for (int m = 0; m < 4; ++m)
#pragma unroll
            for (int n = 0; n < 2; ++n) acc[m][n] = mfma16(af[m], bfr[n], acc[m][n]);
    }
    __syncthreads();
    LAS float* LG = (LAS float*)lds;
#pragma unroll
    for (int m = 0; m < 4; ++m)
#pragma unroll
        for (int n = 0; n < 2; ++n)
#pragma unroll
            for (int reg = 0; reg < 4; ++reg) LG[(32 * wave + 16 * n + fr) * 65 + 16 * m + 4 * fq + reg] = acc[m][n][reg];
    __syncthreads();
    LAS float* CK = (LAS float*)(lds + 69632); LAS int* CI = (LAS int*)(lds + 69632 + 16384);
    const float* rb = a.in[I_RB];
    float bk[8]; int bi[8];
#pragma unroll
    for (int q = 0; q < 4; ++q) {
        float gk[8]; int gi[8];
#pragma unroll
        for (int j = 0; j < 8; ++j) { const int e = 32 * wave + 8 * q + j; gk[j] = sigmoid_f(LG[e * 65 + lane]) + rb[e]; gi[j] = e; }
        KI_SORT8(gk, gi);
        if (q == 0) {
#pragma unroll
            for (int j = 0; j < 8; ++j) { bk[j] = gk[j]; bi[j] = gi[j]; }
        } else KI_MERGE8(bk, bi, gk, gi);
    }
#pragma unroll
    for (int r = 0; r < 8; ++r) { CK[(wave * 8 + r) * 64 + lane] = bk[r]; CI[(wave * 8 + r) * 64 + lane] = bi[r]; }
    __syncthreads();
#define RT_LEVEL(lvl) do { if ((wave & (2 * (lvl) - 1)) == 0) { float ok_[8]; int oi_[8]; \
            _Pragma("unroll") for (int r = 0; r < 8; ++r) { ok_[r] = CK[((wave + (lvl)) * 8 + r) * 64 + lane]; oi_[r] = CI[((wave + (lvl)) * 8 + r) * 64 + lane]; } \
            KI_MERGE8(bk, bi, ok_, oi_); \
            if ((lvl) < 4) { _Pragma("unroll") for (int r = 0; r < 8; ++r) { CK[(wave * 8 + r) * 64 + lane] = bk[r]; CI[(wave * 8 + r) * 64 + lane] = bi[r]; } } } \
        __syncthreads(); } while (0)
    RT_LEVEL(1); RT_LEVEL(2); RT_LEVEL(4);
#undef RT_LEVEL
    LAS unsigned* hist = (LAS unsigned*)(lds + 102400); LAS unsigned* hbase = hist + 256;
    if (tid < 256) hist[tid] = 0u;
    __syncthreads();
    unsigned* cnt = (unsigned*)(ws + WS_CTL) + CW_CNT; int* list = (int*)(ws + WS_LIST); float* gatew = (float*)(ws + WS_GATEW);
    unsigned rank[8];
    if (wave == 0) {
        const int tok = t0 + lane;
        float sel[8], ssum = 0.f;
#pragma unroll
        for (int r = 0; r < 8; ++r) { sel[r] = sigmoid_f(LG[bi[r] * 65 + lane]); ssum += sel[r]; }
#pragma unroll
        for (int r = 0; r < 8; ++r) rank[r] = __hip_atomic_fetch_add(&hist[bi[r]], 1u, __ATOMIC_RELAXED, __HIP_MEMORY_SCOPE_WORKGROUP);
        const float sc = 2.5f / ssum;
        f32x4 g0 = {sel[0] * sc, sel[1] * sc, sel[2] * sc, sel[3] * sc}, g1 = {sel[4] * sc, sel[5] * sc, sel[6] * sc, sel[7] * sc};
        *(f32x4*)(gatew + tok * 8) = g0; *(f32x4*)(gatew + tok * 8 + 4) = g1;
    }
    __syncthreads();
    if (tid < 256) { const unsigned h = hist[tid]; if (h) hbase[tid] = atomicAdd(cnt + 32 * tid, h); }
    __syncthreads();
    if (wave == 0) {
        const int tok = t0 + lane;
#pragma unroll
        for (int r = 0; r < 8; ++r) list[(size_t)bi[r] * LISTCAP + hbase[bi[r]] + rank[r]] = tok * NSLOT + r;
    }
    __syncthreads();
}

__device__ __forceinline__ void moe_tile(const Args& a, ldsp lds, int e, int mt, int nrows, int ntl) {
    const int tid = threadIdx.x, lane = tid & 63, wave = __builtin_amdgcn_readfirstlane(tid >> 6), fr = lane & 15, fq = lane >> 4;
    unsigned char* ws = a.ws;
    constexpr int ASTG = 0, BSTG = 16384, ACT = 49152, SLOTS = 114688, GWO = 115200;
    const bf16* H2 = (const bf16*)(ws + WS_H2);
    const float* Wg = (e < NEXP) ? a.in[I_EG] + (size_t)e * 262144 : a.in[I_SG];
    const float* Wu = (e < NEXP) ? a.in[I_EU] + (size_t)e * 262144 : a.in[I_SU];
    const float* Wd = (e < NEXP) ? a.in[I_ED] + (size_t)e * 262144 : a.in[I_SD];
    if (tid < 128) {
        int slot = -1; float gw = 0.f;
        if (tid < nrows) {
            if (e < NEXP) { slot = ((const int*)(ws + WS_LIST))[(size_t)e * LISTCAP + mt * 128 + tid]; gw = ((const float*)(ws + WS_GATEW))[(slot / NSLOT) * 8 + (slot % NSLOT)]; }
            else { slot = (mt * 128 + tid) * NSLOT + 8; gw = 1.f; }
        }
        ((LAS int*)(lds + SLOTS))[tid] = slot; ((LAS float*)(lds + GWO))[tid] = gw;
    }
    __syncthreads();
    const int wr = wave >> 2, wc = wave & 3;
    const int arow = tid >> 2, akc = tid & 3;
    const int aslot = ((LAS const int*)(lds + SLOTS))[arow];
    const bf16* asrc = H2 + (size_t)((aslot < 0 ? 0 : aslot) / NSLOT) * D + akc * 8;
    const int awr = ASTG + akc * 2048 + ((arow ^ (akc << 1)) * 16);
    const int ng = lane, kq = wave;
    const float* srcg = Wg + (size_t)(4 * kq) * 256 + 4 * ng;
    const float* srcu = Wu + (size_t)(4 * kq) * 256 + 4 * ng;
    const float* src2 = Wd + (size_t)(4 * kq) * 1024 + 4 * ng;
    int bwr2[4];
#pragma unroll
    for (int i = 0; i < 4; ++i) { const int rho2 = 4 * ng + i; bwr2[i] = BSTG + (kq >> 1) * 4096 + ((rho2 ^ ((rho2 >> 3) & 3)) * 16) + (kq & 1) * 8; }
    int ard[4], brd[4], rowm[4];
#pragma unroll
    for (int m = 0; m < 4; ++m) { rowm[m] = 64 * wr + 16 * m + fr; ard[m] = fq * 2048 + ((rowm[m] ^ (fq << 1)) * 16); }
#pragma unroll
    for (int n = 0; n < 4; ++n) { const int rho = 64 * wc + 16 * n + fr; brd[n] = BSTG + fq * 4096 + ((rho ^ ((rho >> 3) & 3)) * 16); }
    bf16* contrib = (bf16*)(ws + WS_CONTRIB);
    f32x4 acc[4][4];
    f32x4 B0[4], B1[4], B2[4], B3[4]; u32x4 A0, A1, A2, A3;
#define G1_LOAD(s_, BR, AR) do { const int s0_ = (s_); const int ss_ = s0_ < 63 ? s0_ : 63; \
        const float* bp_ = ((ss_ < 32) ? srcg : srcu) + (size_t)(32 * (ss_ & 31)) * 256; \
        AR = *(const u32x4*)(asrc + 32 * (ss_ & 31)); \
        _Pragma("unroll") for (int j = 0; j < 4; ++j) BR[j] = *(const f32x4*)(bp_ + j * 256); } while (0)
#define G1_WRITE(BR, AR, buf_) do { \
        *(LAS u32x4*)(lds + (buf_) * 8192 + awr) = AR; \
        _Pragma("unroll") for (int i = 0; i < 4; ++i) { u32x2 w_; w_.x = cvtpk(BR[0][i], BR[1][i]); w_.y = cvtpk(BR[2][i], BR[3][i]); *(LAS u32x2*)(lds + (buf_) * 16384 + bwr2[i]) = w_; } } while (0)
#define MOE_COMPUTE(abase_, buf_) do { \
        bf16x8 af_[4], bf_[4]; \
        _Pragma("unroll") for (int m = 0; m < 4; ++m) af_[m] = *(LAS const bf16x8*)(lds + (abase_) + ard[m]); \
        _Pragma("unroll") for (int n = 0; n < 4; ++n) bf_[n] = *(LAS const bf16x8*)(lds + (buf_) * 16384 + brd[n]); \
        _Pragma("unroll") for (int m = 0; m < 4; ++m) _Pragma("unroll") for (int n = 0; n < 4; ++n) acc[m][n] = mfma16(bf_[n], af_[m], acc[m][n]); } while (0)
#define ACC_ZERO() do { _Pragma("unroll") for (int m = 0; m < 4; ++m) _Pragma("unroll") for (int n = 0; n < 4; ++n) acc[m][n] = (f32x4){0.f, 0.f, 0.f, 0.f}; } while (0)
    G1_LOAD(0, B0, A0); G1_LOAD(1, B1, A1); G1_LOAD(2, B2, A2);
    G1_WRITE(B0, A0, 0);
    __syncthreads();
    for (int s = 0; s < 64; s += 4) {
        if ((s & 31) == 0) ACC_ZERO();
        G1_LOAD(s + 3, B3, A3); MOE_COMPUTE(0, 0); G1_WRITE(B1, A1, 1); __syncthreads();
        G1_LOAD(s + 4, B0, A0); MOE_COMPUTE(8192, 1); G1_WRITE(B2, A2, 0); __syncthreads();
        G1_LOAD(s + 5, B1, A1); MOE_COMPUTE(0, 0); G1_WRITE(B3, A3, 1); __syncthreads();
        G1_LOAD(s + 6, B2, A2); MOE_COMPUTE(8192, 1);
        if (s == 28) {
#pragma unroll
            for (int m = 0; m < 4; ++m)
#pragma unroll
                for (int n = 0; n < 4; ++n) {
                    const f32x4 gv = acc[m][n];
                    u32x2 w; w.x = cvtpk(silu_f(gv[0]), silu_f(gv[1])); w.y = cvtpk(silu_f(gv[2]), silu_f(gv[3]));
                    const int kc = 8 * wc + 2 * n + (fq >> 1);
                    *(LAS u32x2*)(lds + ACT + kc * 2048 + ((rowm[m] ^ ((kc & 3) << 1)) * 16) + (fq & 1) * 8) = w;
                }
        } else if (s == 60) {
#pragma unroll
            for (int m = 0; m < 4; ++m)
#pragma unroll
                for (int n = 0; n < 4; ++n) {
                    const f32x4 uv = acc[m][n];
                    const int kc = 8 * wc + 2 * n + (fq >> 1);
                    LAS u32x2* ap = (LAS u32x2*)(lds + ACT + kc * 2048 + ((rowm[m] ^ ((kc & 3) << 1)) * 16) + (fq & 1) * 8);
                    const u32x2 g = *ap;
                    u32x2 w; w.x = cvtpk(bflo(g.x) * uv[0], bfhi(g.x) * uv[1]); w.y = cvtpk(bflo(g.y) * uv[2], bfhi(g.y) * uv[3]);
                    *ap = w;
                }
        }
        G1_WRITE(B0, A0, 0); __syncthreads();
    }
#define G2_LOAD(s_, BR) do { const int s0_ = (s_); const int t_ = s0_ < 31 ? s0_ : 31; \
        const float* bp_ = src2 + (size_t)(32 * (t_ & 7)) * 1024 + 256 * (t_ >> 3); \
        _Pragma("unroll") for (int j = 0; j < 4; ++j) BR[j] = *(const f32x4*)(bp_ + j * 1024); } while (0)
#define G2_WRITE(BR, buf_) do { \
        _Pragma("unroll") for (int i = 0; i < 4; ++i) { u32x2 w_; w_.x = cvtpk(BR[0][i], BR[1][i]); w_.y = cvtpk(BR[2][i], BR[3][i]); *(LAS u32x2*)(lds + (buf_) * 16384 + bwr2[i]) = w_; } } while (0)
    G2_LOAD(0, B0); G2_LOAD(1, B1); G2_LOAD(2, B2);
    G2_WRITE(B0, 0);
    __syncthreads();
    for (int s = 0; s < 32; s += 4) {
        if ((s & 7) == 0) ACC_ZERO();
        G2_LOAD(s + 3, B3); MOE_COMPUTE(ACT + (s & 7) * 8192, 0); G2_WRITE(B1, 1); __syncthreads();
        G2_LOAD(s + 4, B0); MOE_COMPUTE(ACT + ((s + 1) & 7) * 8192, 1); G2_WRITE(B2, 0); __syncthreads();
        G2_LOAD(s + 5, B1); MOE_COMPUTE(ACT + ((s + 2) & 7) * 8192, 0); G2_WRITE(B3, 1); __syncthreads();
        G2_LOAD(s + 6, B2); MOE_COMPUTE(ACT + ((s + 3) & 7) * 8192, 1);
        if ((s & 7) == 4) {
            const int q = s >> 3;
#pragma unroll
            for (int m = 0; m < 4; ++m) {
                const int slot = ((LAS const int*)(lds + SLOTS))[rowm[m]]; const float gw = ((LAS const float*)(lds + GWO))[rowm[m]];
                if (slot >= 0) {
                    bf16* cp = contrib + (size_t)slot * D + q * 256 + 64 * wc + 4 * fq;
#pragma unroll
                    for (int n = 0; n < 4; ++n) { const f32x4 v = acc[m][n] * gw; u32x2 w; w.x = cvtpk(v[0], v[1]); w.y = cvtpk(v[2], v[3]); *(u32x2*)(cp + 16 * n) = w; }
                }
            }
        }
        G2_WRITE(B0, 0); __syncthreads();
    }
#undef G1_LOAD
#undef G1_WRITE
#undef G2_LOAD
#undef G2_WRITE
#undef ACC_ZERO
#undef MOE_COMPUTE
}

__device__ __forceinline__ const float* uni_ptr(const float* p) {
    const unsigned long long v = (unsigned long long)p;
    const unsigned lo = __builtin_amdgcn_readfirstlane((unsigned)v), hi = __builtin_amdgcn_readfirstlane((unsigned)(v >> 32));
    return (const float*)(((unsigned long long)hi << 32) | lo);
}
__device__ __forceinline__ void moe_decode(int j, int total, LAS const int* pre, LAS const int* cnt, int& e, int& mt, int& nrows) {
    if (j < total) {
        int lo = 0, hi = NEXP;
        while (hi - lo > 1) { const int mid = (lo + hi) >> 1; if (pre[mid] <= j) lo = mid; else hi = mid; }
        e = lo; mt = j - pre[e]; const int c = cnt[e] - mt * 128; nrows = c < 128 ? c : 128;
    } else { e = NEXP; mt = j - total; nrows = 128; }
}
__device__ __forceinline__ void phase_moe(const Args& a, ldsp lds, int G, int vcu) {
    const int tid = threadIdx.x, lane = tid & 63, wave = __builtin_amdgcn_readfirstlane(tid >> 6), fr = lane & 15, fq = lane >> 4;
    unsigned char* ws = a.ws;
    constexpr int ASTG = 0, BSTG = 16384, ACT = 49152, SLOTS = 114688, GWO = SLOTS + MOE_MAXT * 512;
    static_assert(GWO + MOE_MAXT * 512 <= SCR_BYTES, "slot lists overflow the scratch image");
    LAS int* pre = (LAS int*)(lds + MISC_OFF + 512);
    LAS int* cnt = (LAS int*)(lds + MISC_OFF + 2048);
    LAS int* wtot = (LAS int*)(lds + MISC_OFF + 3072);
    int myv = 0, myx = 0;
    if (tid < NEXP) {
        const int c = (int)((const unsigned*)(ws + WS_CTL) + CW_CNT)[32 * tid];
        cnt[tid] = c; myv = (c + 127) >> 7; myx = myv;
#pragma unroll
        for (int o = 1; o < 64; o <<= 1) { const int y = __shfl_up(myx, o); if (lane >= o) myx += y; }
        if (lane == 63) wtot[wave] = myx;
    }
    __syncthreads();
    if (tid < NEXP) { int base = 0; for (int w = 0; w < wave; ++w) base += wtot[w]; pre[tid] = base + myx - myv; if (tid == NEXP - 1) pre[NEXP] = base + myx; }
    __syncthreads();
    const int total = pre[NEXP], ntiles = total + T / 128;
    if (vcu >= ntiles) return;
    for (int tt = tid >> 7; vcu + tt * G < ntiles; tt += 4) {
        const int r = tid & 127; int e_, mt_, nr_; moe_decode(vcu + tt * G, total, pre, cnt, e_, mt_, nr_);
        int slot_ = -1; float gw_ = 0.f;
        if (r < nr_) { if (e_ < NEXP) { slot_ = ((const int*)(ws + WS_LIST))[(size_t)e_ * LISTCAP + mt_ * 128 + r]; gw_ = ((const float*)(ws + WS_GATEW))[(slot_ / NSLOT) * 8 + (slot_ % NSLOT)]; }
                       else { slot_ = (mt_ * 128 + r) * NSLOT + 8; gw_ = 1.f; } }
        ((LAS int*)(lds + SLOTS))[tt * 128 + r] = slot_; ((LAS float*)(lds + GWO))[tt * 128 + r] = gw_;
    }
    __syncthreads();
    if (wave >= 4) {
        const int lt = tid - 256;
        const unsigned char* H2 = ws + WS_H2;
        const int arow = lt >> 1, ahalf = lt & 1;
        const int awr0 = ASTG + (2 * ahalf) * 2048 + ((arow ^ ((2 * ahalf) << 1)) * 16), awr1 = ASTG + (2 * ahalf + 1) * 2048 + ((arow ^ ((2 * ahalf + 1) << 1)) * 16);
        const int ng = lt & 63, kq = lt >> 6;
        const int loff256 = (8 * kq) * 256 + 4 * ng, loff1024 = (8 * kq) * 1024 + 4 * ng;
        const int bw = BSTG + kq * 4096 + (4 * ng) * 16, bx = ((4 * ng) >> 3) & 3;
        const int rho_d = 64 * (ng >> 4) + 16 * (ng & 3) + 4 * ((ng >> 2) & 3);
        const int bw_d = BSTG + kq * 4096 + rho_d * 16, bx_d = (rho_d >> 4) & 3;
        f32x4 B0[8], B1[8], B2[8], B3[8]; u32x4 A0, A1, A2, A3, A4, A5, A6, A7;
        int j = vcu, it = 0, e, mt, nrows;
        moe_decode(j, total, pre, cnt, e, mt, nrows);
#ifndef MOE_AUX
#define MOE_AUX 16
#endif
#define W_RSRC(eo_, pe_, ps_) __builtin_amdgcn_make_buffer_rsrc((void*)uni_ptr(((eo_) < NEXP) ? a.in[pe_] + (size_t)(eo_) * 262144 : a.in[ps_]), 0, 1 << 20, 0x00020000)
        const int eu0 = __builtin_amdgcn_readfirstlane(e);
        __amdgpu_buffer_rsrc_t Wg = W_RSRC(eu0, I_EG, I_SG), Wu = W_RSRC(eu0, I_EU, I_SU), Wd = W_RSRC(eu0, I_ED, I_SD);
        int aslot = ((LAS const int*)(lds + SLOTS))[arow];
        const unsigned char* asrc = H2 + (size_t)((aslot < 0 ? 0 : aslot) / NSLOT) * D + 16 * ahalf;
#define L_LOADB1(WG_, WU_, WD_, s_, BR) do { const int ss_ = (s_); const int t_ = ss_ - 64; \
            const __amdgpu_buffer_rsrc_t r_ = (ss_ < 32) ? (WG_) : (ss_ < 64) ? (WU_) : (WD_); \
            const int vo_ = (ss_ < 64) ? 4 * loff256 : 4 * loff1024; \
            const int so_ = (ss_ < 32) ? (32 * ss_) * 1024 : (ss_ < 64) ? (32 * (ss_ - 32)) * 1024 : (32 * (t_ & 7)) * 4096 + 1024 * (t_ >> 3); \
            const int str_ = (ss_ < 64) ? 1024 : 4096;        \
            _Pragma("unroll") for (int jj = 0; jj < 8; ++jj) BR[jj] = __builtin_bit_cast(f32x4, __builtin_amdgcn_raw_buffer_load_b128(r_, vo_, so_ + jj * str_, MOE_AUX)); } while (0)
#define L_LOADA4(AP_, s_, R0, R1, R2, R3) do { const int ss_ = (s_); const int sa_ = ss_ < 60 ? ss_ : 60; const unsigned char* p_ = (AP_) + 32 * (sa_ & 31); \
            R0 = *(const u32x4*)(p_); R1 = *(const u32x4*)(p_ + 32); R2 = *(const u32x4*)(p_ + 64); R3 = *(const u32x4*)(p_ + 96); } while (0)
#define L_LOADB1P(WG_, WU_, WD_, s_, BR, j0_) do { const int ss_ = (s_); const int t_ = ss_ - 64; \
            const __amdgpu_buffer_rsrc_t r_ = (ss_ < 32) ? (WG_) : (ss_ < 64) ? (WU_) : (WD_); \
            const int vo_ = (ss_ < 64) ? 4 * loff256 : 4 * loff1024; \
            const int so_ = (ss_ < 32) ? (32 * ss_) * 1024 : (ss_ < 64) ? (32 * (ss_ - 32)) * 1024 : (32 * (t_ & 7)) * 4096 + 1024 * (t_ >> 3); \
            const int str_ = (ss_ < 64) ? 1024 : 4096; \
            _Pragma("unroll") for (int jj = (j0_); jj < (j0_) + 2; ++jj) BR[jj] = __builtin_bit_cast(f32x4, __builtin_amdgcn_raw_buffer_load_b128(r_, vo_, so_ + jj * str_, MOE_AUX)); } while (0)
#define L_LOAD2P(s_, BR, j0_) do { const int s0_ = (s_); const int t_ = s0_ < 31 ? s0_ : 31; \
            const int so_ = (32 * (t_ & 7)) * 4096 + 1024 * (t_ >> 3); \
            _Pragma("unroll") for (int jj = (j0_); jj < (j0_) + 2; ++jj) BR[jj] = __builtin_bit_cast(f32x4, __builtin_amdgcn_raw_buffer_load_b128(Wd, 4 * loff1024, so_ + jj * 4096, MOE_AUX)); } while (0)
#define L_WRITEB1(BR, buf_, i_, bw_, bx_) do { const int i = (i_); u32x4 w_; w_.x = cvtpk(BR[0][i], BR[1][i]); w_.y = cvtpk(BR[2][i], BR[3][i]); w_.z = cvtpk(BR[4][i], BR[5][i]); w_.w = cvtpk(BR[6][i], BR[7][i]); \
            *(LAS u32x4*)(lds + (buf_) * 16384 + (bw_) + ((i ^ (bx_)) * 16)) = w_; } while (0)
#define L_SB() __builtin_amdgcn_sched_barrier(0)
#define L_STEP1(WG_, WU_, WD_, ls_, LB, WB, wbuf_, ws_) do { const bool dn_ = (ws_) >= 64; const int bwx_ = dn_ ? bw_d : bw, bxx_ = dn_ ? bx_d : bx;        \
            _Pragma("unroll") for (int i4 = 0; i4 < 4; ++i4) { L_WRITEB1(WB, wbuf_, i4, bwx_, bxx_); L_SB(); L_LOADB1P(WG_, WU_, WD_, ls_, LB, 2 * i4); L_SB(); } } while (0)
#define L_STEP2(ls_, LB, WB, wbuf_) do { _Pragma("unroll") for (int i4 = 0; i4 < 4; ++i4) { L_WRITEB1(WB, wbuf_, i4, bw_d, bx_d); L_SB(); L_LOAD2P(ls_, LB, 2 * i4); L_SB(); } } while (0)
#define L_LOAD2(s_, BR) do { const int s0_ = (s_); const int t_ = s0_ < 31 ? s0_ : 31; \
            const int so_ = (32 * (t_ & 7)) * 4096 + 1024 * (t_ >> 3); \
            _Pragma("unroll") for (int jj = 0; jj < 8; ++jj) BR[jj] = __builtin_bit_cast(f32x4, __builtin_amdgcn_raw_buffer_load_b128(Wd, 4 * loff1024, so_ + jj * 4096, MOE_AUX)); } while (0)
#define L_WRITEB(BR, buf_) do { _Pragma("unroll") for (int i = 0; i < 4; ++i) { u32x4 w_; w_.x = cvtpk(BR[0][i], BR[1][i]); w_.y = cvtpk(BR[2][i], BR[3][i]); w_.z = cvtpk(BR[4][i], BR[5][i]); w_.w = cvtpk(BR[6][i], BR[7][i]); \
            *(LAS u32x4*)(lds + (buf_) * 16384 + bw + ((i ^ bx) * 16)) = w_; } } while (0)
#define L_CVT8(w_, o0, o1) do { const f32x2_t l_ = __builtin_amdgcn_cvt_pk_f32_fp8((int)(w_), false), h_ = __builtin_amdgcn_cvt_pk_f32_fp8((int)(w_), true); o0 = cvtpk(l_[0], l_[1]); o1 = cvtpk(h_[0], h_[1]); } while (0)
#define L_WRITEA(AR, buf_) do { u32x4 c0_, c1_; L_CVT8(AR.x, c0_.x, c0_.y); L_CVT8(AR.y, c0_.z, c0_.w); L_CVT8(AR.z, c1_.x, c1_.y); L_CVT8(AR.w, c1_.z, c1_.w); \
            *(LAS u32x4*)(lds + (buf_) * 8192 + awr0) = c0_; *(LAS u32x4*)(lds + (buf_) * 8192 + awr1) = c1_; } while (0)
        L_LOADA4(asrc, 0, A0, A1, A2, A3); L_LOADB1(Wg, Wu, Wd, 0, B0); L_LOADB1(Wg, Wu, Wd, 1, B1); L_LOADB1(Wg, Wu, Wd, 2, B2); L_LOADA4(asrc, 4, A4, A5, A6, A7);
        for (;;) {
            L_WRITEA(A0, 0); L_WRITEB(B0, 0);
            __syncthreads();
            for (int s = 0; s < 64; s += 8) {
                L_WRITEA(A1, 1); L_STEP1(Wg, Wu, Wd, s + 3, B3, B1, 1, s + 1); __syncthreads();
                L_WRITEA(A2, 0); L_STEP1(Wg, Wu, Wd, s + 4, B0, B2, 0, s + 2); __syncthreads();
                L_WRITEA(A3, 1); L_STEP1(Wg, Wu, Wd, s + 5, B1, B3, 1, s + 3); __syncthreads();
                L_WRITEA(A4, 0); L_LOADA4(asrc, s + 8, A0, A1, A2, A3); L_STEP1(Wg, Wu, Wd, s + 6, B2, B0, 0, s + 4); __syncthreads();
                L_WRITEA(A5, 1); L_STEP1(Wg, Wu, Wd, s + 7, B3, B1, 1, s + 5); __syncthreads();
                L_WRITEA(A6, 0); L_STEP1(Wg, Wu, Wd, s + 8, B0, B2, 0, s + 6); __syncthreads();
                L_WRITEA(A7, 1); L_STEP1(Wg, Wu, Wd, s + 9, B1, B3, 1, s + 7); __syncthreads();
                L_WRITEA(A0, 0); L_LOADA4(asrc, s + 12, A4, A5, A6, A7); L_STEP1(Wg, Wu, Wd, s + 10, B2, B0, 0, s + 8); __syncthreads();
            }
            for (int s = 0; s < 28; s += 4) {
                L_STEP2(s + 3, B3, B1, 1); __syncthreads();
                L_STEP2(s + 4, B0, B2, 0); __syncthreads();
                L_STEP2(s + 5, B1, B3, 1); __syncthreads();
                L_STEP2(s + 6, B2, B0, 0); __syncthreads();
            }
            const int jn = j + G; const bool more = jn < ntiles;
            int en = e, mtn = mt, nrn = nrows; if (more) moe_decode(jn, total, pre, cnt, en, mtn, nrn);
            const int eun = __builtin_amdgcn_readfirstlane(en);
            const __amdgpu_buffer_rsrc_t Wgn = W_RSRC(eun, I_EG, I_SG), Wun = W_RSRC(eun, I_EU, I_SU), Wdn = W_RSRC(eun, I_ED, I_SD);
            const int aslotn = more ? ((LAS const int*)(lds + SLOTS))[(it + 1) * 128 + arow] : aslot;
            const unsigned char* asrcn = H2 + (size_t)((aslotn < 0 ? 0 : aslotn) / NSLOT) * D + 16 * ahalf;
            L_STEP2(31, B3, B1, 1); __syncthreads();
            L_LOADA4(asrcn, 0, A0, A1, A2, A3); L_STEP1(Wgn, Wun, Wdn, 0, B0, B2, 0, 94); __syncthreads();
            L_STEP1(Wgn, Wun, Wdn, 1, B1, B3, 1, 95); __syncthreads();
            L_LOADB1(Wgn, Wun, Wdn, 2, B2); L_LOADA4(asrcn, 4, A4, A5, A6, A7); __syncthreads();
            if (!more) break;
            j = jn; ++it; e = en; mt = mtn; nrows = nrn; Wg = Wgn; Wu = Wun; Wd = Wdn; aslot = aslotn; asrc = asrcn;
        }
#undef L_LOADB1
#undef L_LOADB1P
#undef L_LOAD2P
#undef L_WRITEB1
#undef L_STEP1
#undef L_STEP2
#undef L_SB
#undef W_RSRC
#undef L_LOADA4
#undef L_CVT8
#undef L_LOAD2
#undef L_WRITEB
#undef L_WRITEA
    } else {
        const int wr = wave >> 1, wc = wave & 1;
        int rowm[4], ard[4], brd[8], brdd[8];
#pragma unroll
        for (int m = 0; m < 4; ++m) { rowm[m] = 64 * wr + 16 * m + fr; ard[m] = fq * 2048 + ((rowm[m] ^ (fq << 1)) * 16); }
#pragma unroll
        for (int n = 0; n < 8; ++n) { const int rho = 128 * wc + 16 * n + fr; brd[n] = BSTG + fq * 4096 + ((rho ^ ((rho >> 3) & 3)) * 16); brdd[n] = BSTG + fq * 4096 + ((rho ^ ((rho >> 4) & 3)) * 16); }
        unsigned char* contrib = ws + WS_CONTRIB;
        f32x4 acc[4][8];
#define M_COMPUTE(abase_, buf_, BRD) do { \
            _Pragma("unroll") for (int nh = 0; nh < 2; ++nh) { bf16x8 af_[4], bf_[4]; \
                _Pragma("unroll") for (int m = 0; m < 4; ++m) af_[m] = *(LAS const bf16x8*)(lds + (abase_) + ard[m]); \
                _Pragma("unroll") for (int n = 0; n < 4; ++n) bf_[n] = *(LAS const bf16x8*)(lds + (buf_) * 16384 + BRD[4 * nh + n]); \
                _Pragma("unroll") for (int m = 0; m < 4; ++m) _Pragma("unroll") for (int n = 0; n < 4; ++n) acc[m][4 * nh + n] = mfma16(bf_[n], af_[m], acc[m][4 * nh + n]); } } while (0)
#define M_ZERO() do { _Pragma("unroll") for (int m = 0; m < 4; ++m) _Pragma("unroll") for (int n = 0; n < 8; ++n) acc[m][n] = (f32x4){0.f, 0.f, 0.f, 0.f}; } while (0)
        int it = 0;
        for (int j = vcu; j < ntiles; j += G, ++it) {
            __syncthreads();
            for (int s = 0; s < 64; s += 4) {
                if ((s & 31) == 0) M_ZERO();
                M_COMPUTE(0, 0, brd); __syncthreads();
                M_COMPUTE(8192, 1, brd); __syncthreads();
                M_COMPUTE(0, 0, brd); __syncthreads();
                M_COMPUTE(8192, 1, brd);
                if (s == 28) {
#pragma unroll
                    for (int m = 0; m < 4; ++m)
#pragma unroll
                        for (int n = 0; n < 8; ++n) {
                            const f32x4 gv = acc[m][n];
                            u32x2 w; w.x = cvtpk(silu_f(gv[0]), silu_f(gv[1])); w.y = cvtpk(silu_f(gv[2]), silu_f(gv[3]));
                            const int kc = 16 * wc + 2 * n + (fq >> 1);
                            *(LAS u32x2*)(lds + ACT + kc * 2048 + ((rowm[m] ^ ((kc & 3) << 1)) * 16) + (fq & 1) * 8) = w;
                        }
                } else if (s == 60) {
#pragma unroll
                    for (int m = 0; m < 4; ++m)
#pragma unroll
                        for (int n = 0; n < 8; ++n) {
                            const f32x4 uv = acc[m][n];
                            const int kc = 16 * wc + 2 * n + (fq >> 1);
                            LAS u32x2* ap = (LAS u32x2*)(lds + ACT + kc * 2048 + ((rowm[m] ^ ((kc & 3) << 1)) * 16) + (fq & 1) * 8);
                            const u32x2 g = *ap;
                            u32x2 w; w.x = cvtpk(bflo(g.x) * uv[0], bfhi(g.x) * uv[1]); w.y = cvtpk(bflo(g.y) * uv[2], bfhi(g.y) * uv[3]);
                            *ap = w;
                        }
                }
                __syncthreads();
            }
            for (int s = 0; s < 32; s += 4) {
                if ((s & 7) == 0) M_ZERO();
                M_COMPUTE(ACT + (s & 7) * 8192, 0, brdd); __syncthreads();
                M_COMPUTE(ACT + ((s + 1) & 7) * 8192, 1, brdd); __syncthreads();
                M_COMPUTE(ACT + ((s + 2) & 7) * 8192, 0, brdd); __syncthreads();
                M_COMPUTE(ACT + ((s + 3) & 7) * 8192, 1, brdd);
                if ((s & 7) == 4) {
                    const int q = s >> 3;
#pragma unroll
                    for (int m = 0; m < 4; ++m) {
                        const int slot = ((LAS const int*)(lds + SLOTS))[it * 128 + rowm[m]]; const float gw = ((LAS const float*)(lds + GWO))[it * 128 + rowm[m]];
                        if (slot >= 0) {
                            unsigned char* cp = contrib + (size_t)slot * D + q * 256 + 128 * wc + 16 * fq;
                            const float gs = gw * CONTRIB_SCALE;
#pragma unroll
                            for (int k = 0; k < 2; ++k) {
                                u32x4 w4;
#pragma unroll
                                for (int n = 0; n < 4; ++n) { const f32x4 v = acc[m][4 * k + n] * gs; int w = 0; w = __builtin_amdgcn_cvt_pk_fp8_f32(v[0], v[1], w, false); w = __builtin_amdgcn_cvt_pk_fp8_f32(v[2], v[3], w, true); w4[n] = (unsigned)w; }
                                *(u32x4*)(cp + 64 * k) = w4;
                            }
                        }
                    }
                }
                __syncthreads();
            }
        }
#undef M_COMPUTE
#undef M_ZERO
    }
}

__device__ __forceinline__ void phase_combine(const Args& a, int G) {
    const int tid = threadIdx.x, lane = tid & 63, wave = __builtin_amdgcn_readfirstlane(tid >> 6), blk = blockIdx.x;
    unsigned char* ws = a.ws;
    const bf16* X1 = (const bf16*)(ws + WS_X1); const unsigned char* contrib = ws + WS_CONTRIB; const float* fg = a.in[I_FG];
    for (int t = blk * NWAVES + wave; t < T; t += G * NWAVES) {
        const float* g2 = (const float*)(ws + WS_ADAF) + (t >> 13) * 6144 + 5 * 1024;
        const int c = 16 * lane;
        float sm[16];
#pragma unroll
        for (int i = 0; i < 16; ++i) sm[i] = 0.f;
#pragma unroll
        for (int k = 0; k < NSLOT; ++k) {
            const u32x4 w = *(const u32x4*)(contrib + ((size_t)t * NSLOT + k) * D + c);
#pragma unroll
            for (int q = 0; q < 4; ++q) {
                const f32x2_t lo = __builtin_amdgcn_cvt_pk_f32_fp8((int)w[q], false), hi = __builtin_amdgcn_cvt_pk_f32_fp8((int)w[q], true);
                sm[4 * q] += lo[0]; sm[4 * q + 1] += lo[1]; sm[4 * q + 2] += hi[0]; sm[4 * q + 3] += hi[1];
            }
        }
        const u32x4 xa = *(const u32x4*)(X1 + (size_t)t * D + c), xb = *(const u32x4*)(X1 + (size_t)t * D + c + 8);
        const float x1[16] = {bflo(xa.x), bfhi(xa.x), bflo(xa.y), bfhi(xa.y), bflo(xa.z), bfhi(xa.z), bflo(xa.w), bfhi(xa.w), bflo(xb.x), bfhi(xb.x), bflo(xb.y), bfhi(xb.y), bflo(xb.z), bfhi(xb.z), bflo(xb.w), bfhi(xb.w)};
        f32x4 xv[4]; float ss = 0.f;
#pragma unroll
        for (int h = 0; h < 4; ++h) {
            const f32x4 gg = *(const f32x4*)(g2 + c + 4 * h);
            const f32x4 xx = {x1[4 * h], x1[4 * h + 1], x1[4 * h + 2], x1[4 * h + 3]};
            const f32x4 mv = {sm[4 * h], sm[4 * h + 1], sm[4 * h + 2], sm[4 * h + 3]};
            const f32x4 v = xx + gg * (mv * (1.f / CONTRIB_SCALE)); xv[h] = v; ss += (v[0] * v[0] + v[1] * v[1]) + (v[2] * v[2] + v[3] * v[3]);
        }
        const float r = rsqrtf(wave_sum(ss) * (1.f / D) + 1e-6f);
#pragma unroll
        for (int h = 0; h < 4; ++h) *(f32x4*)(a.out + (size_t)t * D + c + 4 * h) = (xv[h] * r) * *(const f32x4*)(fg + c + 4 * h);
    }
}

constexpr int NPH = 9;
#ifndef N_LAUNCHES
#define N_LAUNCHES 1
#endif
__global__ void __launch_bounds__(NWAVES * 64, 2) mega(Args a) {
    extern __shared__ __attribute__((aligned(16))) unsigned char lds_raw[];
    ldsp lds = (ldsp)lds_raw;
    const int tid = threadIdx.x, G = gridDim.x, bx = blockIdx.x;
    int vcu = (G % 8 == 0) ? (bx % 8) * (G / 8) + bx / 8 : bx;
    unsigned char* ws = a.ws;
    for (int u = tid; u < (LDS_BYTES - MISC_OFF) / 4; u += NWAVES * 64) ((LAS unsigned*)(lds + MISC_OFF))[u] = 0u;
    __syncthreads();
    volatile LAS unsigned* MISC = (volatile LAS unsigned*)(lds + MISC_OFF);
    XcdBarrier bar; bar.bar = (unsigned*)(ws + WS_CTL) + CW_BAR; bar.x = 0; bar.st = nullptr;
    if (N_LAUNCHES == 1) {
        bar = xcd_barrier_post((unsigned*)(ws + WS_CTL) + CW_BAR, MISC + 8);
        if (tid == 0) MISC[16] = atomicAdd((unsigned*)(ws + WS_CTL) + CW_XRANK + 64 * bar.x, 1u);
    }
    const int lo = a.ph_lo, hi = a.ph_hi;
#ifndef PH_MASK
#define PH_MASK 0x1ff
#endif
#define IN(k) (((PH_MASK >> (k)) & 1) && lo <= (k) && (k) < hi)
#define SEAM(k) do { if (IN(k) && IN((k) + 1)) xcd_barrier(bar); } while (0)
#ifndef PH_DUP
#define PH_DUP -1
#endif
#define REP(k) for (int rep_ = 0; rep_ < ((PH_DUP == (k)) ? 2 : 1); ++rep_)
    if (IN(0)) REP(0) { phase_prep(a, lds, G); } SEAM(0);
    if (N_LAUNCHES == 1 && IN(0) && IN(1)) {
        unsigned basex = 0;
        for (unsigned j = 0; j < bar.x; ++j) basex += xb_ld(&bar.bar[XB_XCNT(j)]);
        vcu = (int)(basex + MISC[16]);
    }
    if (IN(1)) REP(1) { phase_hnorm(a, lds, G); } SEAM(1);
    if (IN(2)) REP(2) {
        pg8::Gemm g{(const pg8::bf16_t*)(ws + WS_H), (const pg8::bf16_t*)(ws + WS_WINT), MH, DIN, D};
        WinOrder S; S.init(G, bx);
        EpiWin E{(bf16*)(ws + WS_Z), (bf16*)(ws + WS_KVC), (const float*)(ws + WS_ROPE)};
        pg8::gemm_phase<EpiWin, WinOrder, true, true>(lds, g, S, E);
    } SEAM(2);
    if (IN(3)) REP(3) { phase_mixers(a, lds, G, vcu); } SEAM(3);
    if (IN(4)) REP(4) {
        { pg8::Gemm g{(const pg8::bf16_t*)(ws + WS_A), (const pg8::bf16_t*)(ws + WS_WAT), T, D, 512};
          pg8::StaticOrder S; S.init(T, D, G, bx);
          EpiMergeA E{(const bf16*)(ws + WS_Z), (bf16*)(ws + WS_Y)};
          pg8::gemm_phase<EpiMergeA, pg8::StaticOrder, true, true>(lds, g, S, E); }
        { pg8::Gemm g{(const pg8::bf16_t*)(ws + WS_O), (const pg8::bf16_t*)(ws + WS_WBT), T, D, 512};
          pg8::StaticOrder S; S.init(T, D, G, bx);
          EpiMergeB E{(const bf16*)(ws + WS_Z), (bf16*)(ws + WS_Y)};
          pg8::gemm_phase<EpiMergeB, pg8::StaticOrder, true, true>(lds, g, S, E); }
    } SEAM(4);
    if (IN(5)) REP(5) {
        pg8::Gemm g{(const pg8::bf16_t*)(ws + WS_Y), (const pg8::bf16_t*)(ws + WS_WOT), T, D, D};
        pg8::StaticOrder S; S.init(T, D, G, bx);
        EpiWo E{a.in[I_X], (const float*)(ws + WS_ADAF), (bf16*)(ws + WS_X1)};
        pg8::gemm_phase<EpiWo, pg8::StaticOrder, true, true>(lds, g, S, E);
    } SEAM(5);
    if (IN(6)) { for (int it = vcu; it < T / 64; it += G) router_item(a, lds, it); } SEAM(6);
    if (IN(7)) REP(7) { phase_moe(a, lds, G, vcu); } SEAM(7);
    if (IN(8)) REP(8) { phase_combine(a, G); }
#undef IN
#undef SEAM
}

extern "C" void kernel_launch(void* const* d_in, const int* in_sizes, int n_in, void* d_out, int out_size, void* d_ws, size_t ws_size, hipStream_t stream) {
    static int grid = 0;
    if (grid == 0) {
        if (n_in != 26 || out_size != T * D || ws_size < WS_END) { fprintf(stderr, "kernel_launch: unexpected shapes (n_in %d, out %d, ws %zu)\n", n_in, out_size, ws_size); grid = -1; return; }
        int dev = 0, cus = 0, per_cu = 0;
        (void)hipGetDevice(&dev); (void)hipDeviceGetAttribute(&cus, hipDeviceAttributeMultiprocessorCount, dev);
        (void)hipFuncSetAttribute((const void*)mega, hipFuncAttributeMaxDynamicSharedMemorySize, LDS_BYTES);
        (void)hipOccupancyMaxActiveBlocksPerMultiprocessor(&per_cu, (const void*)mega, NWAVES * 64, LDS_BYTES);
        (void)hipGetLastError();
        if (per_cu < 1) { fprintf(stderr, "kernel_launch: occupancy query says %d blocks per CU\n", per_cu); per_cu = 1; }
        if (cus * MOE_MAXT < T * 8 / 128 + NEXP + T / 128) { fprintf(stderr, "kernel_launch: %d CUs are too few for the expert tile tables\n", cus); grid = -1; return; }
        grid = cus;
    }
    if (grid < 0) return;
    (void)hipMemsetAsync((char*)d_ws + WS_CTL, 0, CTL_ZERO_BYTES, stream);
    Args a{};
    for (int i = 0; i < 26; ++i) a.in[i] = (const float*)d_in[i];
    a.out = (float*)d_out; a.ws = (unsigned char*)d_ws;
    if (N_LAUNCHES == 1) {
        a.ph_lo = 0; a.ph_hi = NPH;
        void* kargs[] = {&a};
        hipError_t e = hipLaunchCooperativeKernel((const void*)mega, dim3(grid), dim3(NWAVES * 64), kargs, LDS_BYTES, stream);
        if (e != hipSuccess) fprintf(stderr, "kernel_launch: cooperative launch failed: %s (grid %d)\n", hipGetErrorString(e), grid);
    } else {
#ifndef HOST_DUP
#define HOST_DUP -1
#endif
        for (int li = 0; li < NPH; ++li) {
            a.ph_lo = li; a.ph_hi = li + 1;
            hipLaunchKernelGGL(mega, dim3(grid), dim3(NWAVES * 64), LDS_BYTES, stream, a);
            if (li == HOST_DUP) {
                if (li == 6) (void)hipMemsetAsync((char*)d_ws + WS_CTL, 0, CTL_ZERO_BYTES, stream);
                hipLaunchKernelGGL(mega, dim3(grid), dim3(NWAVES * 64), LDS_BYTES, stream, a);
            }
        }
    }
}
```

```cpp
#include <hip/hip_runtime.h>
#include <cstdio>
#include <cstdint>
#include <type_traits>
namespace pg8 {
#define PG8_LAS __attribute__((address_space(3)))
typedef unsigned short bf16_t;
typedef short bf16x8 __attribute__((ext_vector_type(8)));
typedef float f32x4 __attribute__((ext_vector_type(4)));
typedef unsigned u32x4 __attribute__((ext_vector_type(4)));
constexpr int BM = 256, BK = 64, HALF = 128, HTB = HALF * BK * 2  , STAGE_BYTES = 8 * HTB, NXCD = 8, WGM = 8;

__host__ __device__ __forceinline__ int lds_byte(int r, int c) { const int st = (r >> 4) * 2 + (c >> 5), rr = r & 15, cc = c & 31, ob = rr * 64 + cc * 2; return st * 1024 + (ob ^ (((ob >> 9) & 1) << 5)); }
__host__ __device__ __forceinline__ void stage_rc(int b, int& R, int& C) { const int st = b / 1024, sb = b % 1024, swz = sb ^ (((sb >> 9) & 1) << 5); R = (st >> 1) * 16 + swz / 64; C = (st & 1) * 32 + (swz % 64) / 2; }
__host__ __device__ __forceinline__ int perm32(int rho) { const int n = rho >> 4, i = rho & 15; return 8 * (i >> 2) + 4 * n + (i & 3); }

struct Unit { int pm, pn; };
struct Gemm { const bf16_t* A; const bf16_t* Bt; int M, N, K; };

struct StaticOrder {
    int nM, nN, nwg, G, c;
    __host__ __device__ void init(int M, int N, int G_, int c_) { nM = M / BM; nN = N / BM; nwg = nM * nN; G = G_; c = c_; }
    __host__ __device__ bool next(int i, Unit& u) const {
        const long L = (long)i * G + c; if (L >= nwg) return false;
        int wgid = (int)L; { const int q = nwg / NXCD, r = nwg % NXCD, xcd = wgid % NXCD, off = wgid / NXCD; wgid = (xcd < r ? xcd * (q + 1) : r * (q + 1) + (xcd - r) * q) + off; }
        const int nig = WGM * nN, gid = wgid / nig, fm = gid * WGM, gsz = (nM - fm) < WGM ? (nM - fm) : WGM;
        u.pm = fm + ((wgid % nig) % gsz); u.pn = (wgid % nig) / gsz; return true;
    }
    __device__ __forceinline__ void a_ready(const Unit&) const {}
    __device__ __forceinline__ void done(const Unit&) const {}
};

__device__ __forceinline__ unsigned cvt_pk_bf16(float lo, float hi) { unsigned r; asm volatile("v_cvt_pk_bf16_f32 %0, %1, %2" : "=v"(r) : "v"(lo), "v"(hi)); return r; }
template <class Epi, class Sched, bool ALIGN_EPI = false, bool SP2 = false>
__device__ __forceinline__ void gemm_phase(PG8_LAS unsigned char* lds, const Gemm g, const Sched& S, const Epi& E) {
    const int tid = threadIdx.x, wid = __builtin_amdgcn_readfirstlane(tid >> 6), lane = tid & 63, wr = wid >> 2, wc = wid & 3, fr = lane & 15, fq = lane >> 4;
    const int K = g.K, nt = K / BK;
    unsigned voffA[2], voffB[2];
#pragma unroll
    for (int i = 0; i < 2; ++i) { int R, C; stage_rc(tid * 16 + i * 8192, R, C); const int Rb = Epi::PERM ? ((R & ~31) + perm32(R & 31)) : R;
        voffA[i] = (unsigned)(R * K + C) * 2u; voffB[i] = (unsigned)(Rb * K + C) * 2u; }
    const size_t kstep = (size_t)(BK * 2);
    const size_t hstep = (size_t)HALF * K * 2;
    const size_t tstep = 2 * hstep;
    const unsigned ldsw = (unsigned)wid * 1024u;
    const int aoff = lds_byte(wr * 64 + fr, fq * 8), boff = lds_byte(wc * 32 + fr, fq * 8);
#define PG8_SA(b, h) (((b) * 2 + (h)) * HTB)
#define PG8_SB(b, h) ((4 + (b) * 2 + (h)) * HTB)
#define PG8_STAGE(bufoff, gbase, voff) do { _Pragma("unroll") for (int _i = 0; _i < 2; ++_i) \
        __builtin_amdgcn_global_load_lds((const unsigned*)((const char*)(gbase) + (voff)[_i]), (PG8_LAS unsigned*)(lds + (bufoff) + ldsw + _i * 8192), 16, 0, 0); } while (0)
#define PG8_LDA(dst, b, h) do { _Pragma("unroll") for (int m = 0; m < 4; ++m) _Pragma("unroll") for (int k = 0; k < 2; ++k) dst[m][k] = *(const PG8_LAS bf16x8*)(lds + PG8_SA(b, h) + aoff + m * 2048 + k * 1024); } while (0)
#define PG8_LDB(dst, b, h) do { _Pragma("unroll") for (int n = 0; n < 2; ++n) _Pragma("unroll") for (int k = 0; k < 2; ++k) dst[n][k] = *(const PG8_LAS bf16x8*)(lds + PG8_SB(b, h) + boff + n * 2048 + k * 1024); } while (0)
#define PG8_MMA(ai, bj, At, Bt) do { __builtin_amdgcn_s_setprio(1); _Pragma("unroll") for (int m = 0; m < 4; ++m) _Pragma("unroll") for (int n = 0; n < 2; ++n) _Pragma("unroll") for (int k = 0; k < 2; ++k) \
        acc[ai][bj][m][n] = __builtin_amdgcn_mfma_f32_16x16x32_bf16(Bt[n][k], At[m][k], acc[ai][bj][m][n], 0, 0, 0); __builtin_amdgcn_s_setprio(0); } while (0)
#define PG8_WAIT_V(n) asm volatile("s_waitcnt vmcnt(" #n ")" ::: "memory")
#define PG8_WAIT_L(n) asm volatile("s_waitcnt lgkmcnt(" #n ")" ::: "memory")
#define PG8_BAR __builtin_amdgcn_s_barrier()
#define PG8_SCHED __builtin_amdgcn_sched_barrier(0)
    Unit cur, nxt; int ui = 0;
    if (!S.next(0, cur)) return;
    f32x4 acc[2][2][4][2];
#pragma unroll
    for (int a = 0; a < 2; ++a)
#pragma unroll
        for (int b = 0; b < 2; ++b)
#pragma unroll
            for (int m = 0; m < 4; ++m)
#pragma unroll
                for (int n = 0; n < 2; ++n) acc[a][b][m][n] = (f32x4){0.f, 0.f, 0.f, 0.f};
    bf16x8 At[4][2], B0[2][2], B1[2][2];
    const char* cA = (const char*)g.A + (size_t)cur.pm * tstep; const char* cB = (const char*)g.Bt + (size_t)cur.pn * tstep;
    S.a_ready(cur);
    if constexpr (SP2) {
        PG8_STAGE(PG8_SB(0, 0), cB, voffB); PG8_STAGE(PG8_SB(0, 1), cB + hstep, voffB); PG8_STAGE(PG8_SA(0, 0), cA, voffA); PG8_STAGE(PG8_SA(0, 1), cA + hstep, voffA);
        if (wr == 1) PG8_BAR;
        PG8_WAIT_V(2); PG8_BAR;
        PG8_STAGE(PG8_SB(1, 0), cB + kstep, voffB); PG8_STAGE(PG8_SA(1, 0), cA + kstep, voffA); PG8_STAGE(PG8_SB(1, 1), cB + hstep + kstep, voffB);
        PG8_WAIT_V(6); PG8_BAR;
    } else {
        PG8_STAGE(PG8_SB(0, 0), cB, voffB); PG8_STAGE(PG8_SA(0, 0), cA, voffA); PG8_STAGE(PG8_SB(0, 1), cB + hstep, voffB); PG8_STAGE(PG8_SA(0, 1), cA + hstep, voffA);
        if (wr == 1) PG8_BAR;
        PG8_WAIT_V(4); PG8_BAR;
        PG8_STAGE(PG8_SB(1, 0), cB + kstep, voffB); PG8_STAGE(PG8_SA(1, 0), cA + kstep, voffA); PG8_STAGE(PG8_SB(1, 1), cB + hstep + kstep, voffB);
        PG8_WAIT_V(6); PG8_BAR;
    }
    for (;;) {
        const bool has_next = S.next(ui + 1, nxt);
        const char* nA = has_next ? (const char*)g.A + (size_t)nxt.pm * tstep : cA; const char* nB = has_next ? (const char*)g.Bt + (size_t)nxt.pn * tstep : cB;
        for (int t = 0; t < nt; t += 2) {
            const bool last = (t == nt - 2);
            const char* a1 = cA + (size_t)(t + 1) * kstep;
            const char* a2 = last ? nA : cA + (size_t)(t + 2) * kstep; const char* b2 = last ? nB : cB + (size_t)(t + 2) * kstep;
            const char* a3 = a2 + kstep; const char* b3 = b2 + kstep;
            if (last && has_next) S.a_ready(nxt);
            if constexpr (SP2) {
            PG8_LDB(B0, 0, 0); PG8_LDB(B1, 0, 1); PG8_SCHED; PG8_LDA(At, 0, 0); PG8_STAGE(PG8_SA(1, 1), a1 + hstep, voffA);
            PG8_WAIT_V(8); PG8_WAIT_L(0); PG8_BAR; PG8_MMA(0, 0, At, B0); PG8_MMA(0, 1, At, B1); PG8_BAR; PG8_SCHED;
            PG8_LDA(At, 0, 1); PG8_STAGE(PG8_SB(0, 0), b2, voffB); PG8_STAGE(PG8_SB(0, 1), b2 + hstep, voffB); PG8_STAGE(PG8_SA(0, 0), a2, voffA);
            PG8_WAIT_V(8); PG8_WAIT_L(0); PG8_BAR; PG8_MMA(1, 0, At, B0); PG8_MMA(1, 1, At, B1); PG8_BAR; PG8_SCHED;
            PG8_LDB(B0, 1, 0); PG8_LDB(B1, 1, 1); PG8_SCHED; PG8_LDA(At, 1, 0); PG8_STAGE(PG8_SA(0, 1), a2 + hstep, voffA);
            PG8_WAIT_V(8); PG8_WAIT_L(0); PG8_BAR; PG8_MMA(0, 0, At, B0); PG8_MMA(0, 1, At, B1); PG8_BAR; PG8_SCHED;
            PG8_LDA(At, 1, 1); PG8_STAGE(PG8_SB(1, 0), b3, voffB); PG8_STAGE(PG8_SB(1, 1), b3 + hstep, voffB); PG8_STAGE(PG8_SA(1, 0), a3, voffA);
            PG8_WAIT_V(8); PG8_WAIT_L(0); PG8_BAR; PG8_MMA(1, 0, At, B0); PG8_MMA(1, 1, At, B1); PG8_BAR; PG8_SCHED;
            } else {
            PG8_LDB(B0, 0, 0); PG8_SCHED; PG8_LDA(At, 0, 0); PG8_STAGE(PG8_SA(1, 1), a1 + hstep, voffA);
            PG8_WAIT_L(8); PG8_BAR; PG8_WAIT_L(0); PG8_MMA(0, 0, At, B0); PG8_BAR; PG8_SCHED;
            PG8_LDB(B1, 0, 1); PG8_STAGE(PG8_SB(0, 0), b2, voffB);
            PG8_BAR; PG8_WAIT_L(0); PG8_MMA(0, 1, At, B1); PG8_BAR;
            PG8_LDA(At, 0, 1); PG8_STAGE(PG8_SA(0, 0), a2, voffA);
            PG8_BAR; PG8_WAIT_L(0); PG8_MMA(1, 0, At, B0); PG8_BAR; PG8_SCHED;
            PG8_STAGE(PG8_SB(0, 1), b2 + hstep, voffB);
            PG8_WAIT_V(6); PG8_BAR; PG8_MMA(1, 1, At, B1); PG8_BAR;
            PG8_LDB(B0, 1, 0); PG8_SCHED; PG8_LDA(At, 1, 0); PG8_STAGE(PG8_SA(0, 1), a2 + hstep, voffA);
            PG8_WAIT_L(8); PG8_BAR; PG8_WAIT_L(0); PG8_MMA(0, 0, At, B0); PG8_BAR; PG8_SCHED;
            PG8_LDB(B1, 1, 1); PG8_STAGE(PG8_SB(1, 0), b3, voffB);
            PG8_BAR; PG8_WAIT_L(0); PG8_MMA(0, 1, At, B1); PG8_BAR;
            PG8_LDA(At, 1, 1); PG8_STAGE(PG8_SA(1, 0), a3, voffA);
            PG8_BAR; PG8_WAIT_L(0); PG8_MMA(1, 0, At, B0); PG8_BAR; PG8_SCHED;
            PG8_STAGE(PG8_SB(1, 1), b3 + hstep, voffB);
            PG8_WAIT_V(6); PG8_BAR; PG8_MMA(1, 1, At, B1); PG8_BAR;
            }
        }
        if constexpr (ALIGN_EPI) { if (wr == 0) PG8_BAR; }
        if constexpr (!Epi::AFTER_DRAIN) { E(acc, cur, wr, wc, fr, fq); S.done(cur); }
        if (!has_next) break;
#pragma unroll
        for (int a = 0; a < 2; ++a)
#pragma unroll
            for (int b = 0; b < 2; ++b)
#pragma unroll
                for (int m = 0; m < 4; ++m)
#pragma unroll
                    for (int n = 0; n < 2; ++n) acc[a][b][m][n] = (f32x4){0.f, 0.f, 0.f, 0.f};
        cur = nxt; cA = nA; cB = nB; ++ui;
        if constexpr (ALIGN_EPI) { if (wr == 1) PG8_BAR; }
    }
    PG8_WAIT_V(0);
    if constexpr (!ALIGN_EPI) { if (wr == 0) PG8_BAR; }
    PG8_BAR;
    if constexpr (Epi::AFTER_DRAIN) { E.fused(acc, cur, wr, wc, fr, fq, lds, wid, lane); S.done(cur); }
#undef PG8_SA
#undef PG8_SB
#undef PG8_STAGE
#undef PG8_LDA
#undef PG8_LDB
#undef PG8_MMA
#undef PG8_WAIT_V
#undef PG8_WAIT_L
#undef PG8_BAR
#undef PG8_SCHED
}
}
#define GAS __attribute__((address_space(1)))
#define LAS __attribute__((address_space(3)))
typedef unsigned short bf16;
typedef unsigned v4u __attribute__((ext_vector_type(4)));
typedef float f32x4 __attribute__((ext_vector_type(4)));
typedef short bf16x8 __attribute__((ext_vector_type(8)));
typedef GAS unsigned gu32;
typedef GAS unsigned long long gu64;
#define RLX_AGENT __ATOMIC_RELAXED, __HIP_MEMORY_SCOPE_AGENT
#define LDS_WAIT() asm volatile("s_waitcnt lgkmcnt(0)" ::: "memory")
#define VM_WAIT() asm volatile("s_waitcnt vmcnt(0)" ::: "memory")
__device__ __forceinline__ unsigned long long rt() { return __builtin_amdgcn_s_memrealtime(); }
__device__ __forceinline__ unsigned f2bf(float f) { unsigned u = __builtin_bit_cast(unsigned, f); return (u + 0x7fffu + ((u >> 16) & 1u)) >> 16; }
__device__ __forceinline__ unsigned pk2(float lo, float hi) { return f2bf(lo) | (f2bf(hi) << 16); }

#define XB_TMO      128
#define XB_XCNT(j)  (256  + 64 * (j))
#define XB_XSUB(j)  (1280 + 64 * (j))
#define XB_XGEN(j)  (2304 + 64 * (j))
#define XB_TOP      3328
#define XB_TOPGEN   3392
#define XCD_BAR_WORDS 3456
#define XB_SPIN_CAP (1u << 18)

__device__ __forceinline__ unsigned xb_ld(unsigned* p)              { return __hip_atomic_load(p, __ATOMIC_RELAXED, __HIP_MEMORY_SCOPE_AGENT); }
__device__ __forceinline__ unsigned xb_add(unsigned* p, unsigned v) { return __hip_atomic_fetch_add(p, v, __ATOMIC_RELAXED, __HIP_MEMORY_SCOPE_AGENT); }
__device__ __forceinline__ unsigned xb_xcc_id() { return (unsigned)__builtin_amdgcn_s_getreg((3 << 11) | 20) & 0xFu; }
#define XB_SPIN(cond, bar) do { unsigned _sp = 0; while (cond) { __builtin_amdgcn_s_sleep(1); \
    if ((++_sp & 255u) == 0u) { if (xb_ld(&(bar)[XB_TMO])) break; if (_sp > XB_SPIN_CAP) { atomicAdd(&(bar)[XB_TMO], 1u); break; } } } } while (0)

struct XcdBarrier {
    unsigned* bar; unsigned x;
    volatile LAS unsigned* st;
};

__device__ __forceinline__ XcdBarrier xcd_barrier_post(unsigned* bar, volatile LAS unsigned* st) {
    XcdBarrier b; b.bar = bar; b.x = xb_xcc_id(); b.st = st;
    if (threadIdx.x == 0) (void)xb_add(&bar[XB_XCNT(b.x)], 1u);
    return b;
}
__device__ __forceinline__ void xcd_barrier_complete(unsigned* bar, unsigned x, unsigned& nloc, unsigned& nx) {
    const unsigned G = gridDim.x * gridDim.y * gridDim.z;
    unsigned sum, cnt, mine, sp = 0u;
    for (;;) {
        sum = 0u; cnt = 0u; mine = 0u;
#pragma unroll
        for (unsigned j = 0; j < 16; ++j) { const unsigned c = xb_ld(&bar[XB_XCNT(j)]); sum += c; cnt += (c > 0u) ? 1u : 0u; mine = (j == x) ? c : mine; }
        if (sum == G) break;
        __builtin_amdgcn_s_sleep(1);
        if ((++sp & 255u) == 0u) { if (xb_ld(&bar[XB_TMO])) break; if (sp > XB_SPIN_CAP) { atomicAdd(&bar[XB_TMO], 1u); break; } }
    }
    nloc = mine > 0u ? mine : 1u; nx = cnt > 0u ? cnt : 1u;
}

__device__ __forceinline__ void xcd_barrier(const XcdBarrier& b) {
    asm volatile("s_waitcnt vmcnt(0)" ::: "memory");
    __syncthreads();
    if (threadIdx.x == 0) {
        unsigned* bar = b.bar;
        __builtin_amdgcn_s_waitcnt(0);
        unsigned nloc = b.st[0], nx = b.st[1];
        if (nloc == 0u) { xcd_barrier_complete(bar, b.x, nloc, nx); b.st[0] = nloc; b.st[1] = nx; }
        const unsigned old = xb_add(&bar[XB_XSUB(b.x)], 1u);
        const unsigned gen = old / nloc;
        if (old + 1u == (gen + 1u) * nloc) {
            __builtin_amdgcn_fence(__ATOMIC_RELEASE, "agent");
            asm volatile("s_waitcnt vmcnt(0)" ::: "memory");
            const unsigned og = xb_add(&bar[XB_TOP], 1u);
            const unsigned tg = og / nx;
            if (og + 1u == (tg + 1u) * nx) xb_add(&bar[XB_TOPGEN], 1u);
            else XB_SPIN(xb_ld(&bar[XB_TOPGEN]) == tg, bar);
            __builtin_amdgcn_fence(__ATOMIC_ACQUIRE, "agent");
            xb_add(&bar[XB_XGEN(b.x)], 1u);
            asm volatile("s_waitcnt vmcnt(0)" ::: "memory");
        } else {
            XB_SPIN(xb_ld(&bar[XB_XGEN(b.x)]) == gen, bar);
            __builtin_amdgcn_fence(__ATOMIC_ACQUIRE, "agent");
            asm volatile("s_waitcnt vmcnt(0)" ::: "memory");
        }
    }
    __syncthreads();
}

constexpr int T = 16384, D = 1024, SEQ = 8192, NCTX = 256, TCX = 512, DIN = 3840, MH = T + TCX;
constexpr int ZU = 0, ZV = 512, ZQ = 1024, ZK = 1536, ZVA = 1664, ZGA = 1792, ZGB = 2816;
constexpr int NEXP = 256, NSLOT = 9, LISTCAP = 16384, MOE_MAXT = 24;
constexpr float LOG2E = 1.4426950408889634f;
constexpr float QSCALE = 0.125f * LOG2E;
constexpr size_t MiB = 1u << 20;
constexpr size_t WS_CTL = 0, CTL_ZERO_BYTES = 1 * MiB;
constexpr size_t WS_ADAP = 1 * MiB;
constexpr size_t WS_ADAF = 2 * MiB;
constexpr size_t WS_ROPE = 2 * MiB + 128 * 1024;
constexpr size_t WS_WST = 2 * MiB + 256 * 1024;
constexpr size_t WS_RWT = 3 * MiB;
constexpr size_t WS_WINT = 4 * MiB;
constexpr size_t WS_WAT = 12 * MiB, WS_WBT = 13 * MiB, WS_WOT = 14 * MiB;
constexpr size_t WS_KVC = 16 * MiB;
constexpr size_t WS_GATEW = 17 * MiB;
constexpr size_t WS_H = 18 * MiB;
constexpr size_t WS_Z = 52 * MiB;
constexpr size_t WS_A = 172 * MiB, WS_O = 188 * MiB;
constexpr size_t WS_TMP = 204 * MiB;
constexpr size_t WS_Y = 268 * MiB;
constexpr size_t WS_X1 = 300 * MiB;
constexpr size_t WS_H2 = 364 * MiB;
constexpr size_t WS_LIST = 396 * MiB;
constexpr size_t WS_CONTRIB = 414 * MiB;
constexpr float CONTRIB_SCALE = 16.f;
constexpr size_t WS_END = 704 * MiB;
constexpr int CW_BAR = 4096;
constexpr int CW_CNT = 16384;
constexpr int CW_XRANK = 32768;
constexpr int SCR_BYTES = 148480;
constexpr int MISC_OFF = SCR_BYTES;
constexpr int LDS_BYTES = 152 * 1024;
constexpr int NWAVES = 8;

typedef float f32x2_t __attribute__((ext_vector_type(2)));
typedef __bf16 bf16x2_t __attribute__((ext_vector_type(2)));
typedef float f32x16 __attribute__((ext_vector_type(16)));
typedef short s16x4 __attribute__((ext_vector_type(4)));
typedef short v4i16_t __attribute__((ext_vector_type(4)));
typedef unsigned u32x2 __attribute__((ext_vector_type(2)));
typedef unsigned u32x4 __attribute__((ext_vector_type(4)));
typedef LAS unsigned char* ldsp;

__device__ __forceinline__ unsigned cvtpk(float lo, float hi) { f32x2_t v = {lo, hi}; bf16x2_t b = __builtin_convertvector(v, bf16x2_t); return __builtin_bit_cast(unsigned, b); }
__device__ __forceinline__ float bf2f(unsigned short u) { return __uint_as_float((unsigned)u << 16); }
__device__ __forceinline__ float bflo(unsigned w) { return __uint_as_float(w << 16); }
__device__ __forceinline__ float bfhi(unsigned w) { return __uint_as_float(w & 0xffff0000u); }
__device__ __forceinline__ float wave_sum(float v) {
#pragma unroll
    for (int o = 1; o < 64; o <<= 1) v += __shfl_xor(v, o);
    return v;
}
__device__ __forceinline__ float sigmoid_f(float x) { return __builtin_amdgcn_rcpf(1.f + __builtin_amdgcn_exp2f(-x * LOG2E)); }
__device__ __forceinline__ float silu_f(float x) { return x * sigmoid_f(x); }
__device__ __forceinline__ float gelu_f(float x) { const float u = 0.7978845608028654f * (x + 0.044715f * x * x * x); return x * sigmoid_f(2.f * u); }
__device__ __forceinline__ f32x16 mfma32(bf16x8 a, bf16x8 b, f32x16 c) { return __builtin_amdgcn_mfma_f32_32x32x16_bf16(a, b, c, 0, 0, 0); }
__device__ __forceinline__ f32x4 mfma16(bf16x8 a, bf16x8 b, f32x4 c) { return __builtin_amdgcn_mfma_f32_16x16x32_bf16(a, b, c, 0, 0, 0); }

struct Args { const float* in[26]; float* out; unsigned char* ws; int ph_lo, ph_hi; };
enum { I_X = 0, I_C, I_CTX, I_CCTX, I_ADAW, I_ADAB, I_N1G, I_N2G, I_WIN, I_LNG, I_LNB, I_GWS, I_GBS, I_SINK, I_WA, I_WB, I_WO, I_RW, I_RB, I_EG, I_EU, I_ED, I_SG, I_SU, I_SD, I_FG };

__device__ __forceinline__ void p0_transpose_item(const float* W, int K, int N, bf16* WT, LAS float* scr, int item, int lane) {
    const int nblk = N / 32, kb = item / nblk, nb = item % nblk, k0 = 64 * kb, n0 = 32 * nb;
#pragma unroll 8
    for (int i = 0; i < 32; ++i) { const int kk = 2 * i + (lane >> 5); scr[kk * 33 + (lane & 31)] = W[(size_t)(k0 + kk) * N + n0 + (lane & 31)]; }
    LDS_WAIT(); asm volatile("" ::: "memory");
    const int c = lane & 7;
#pragma unroll
    for (int j = 0; j < 4; ++j) { const int n = (lane >> 3) + 8 * j; const LAS float* s = scr + (8 * c) * 33 + n;
        v4u o; o.x = pk2(s[0 * 33], s[1 * 33]); o.y = pk2(s[2 * 33], s[3 * 33]); o.z = pk2(s[4 * 33], s[5 * 33]); o.w = pk2(s[6 * 33], s[7 * 33]);
        *(GAS v4u*)(WT + (size_t)(n0 + n) * K + k0 + 8 * c) = o; }
    LDS_WAIT(); asm volatile("" ::: "memory");
}

__device__ __forceinline__ void phase_prep(const Args& a, ldsp lds, int G) {
    const int tid = threadIdx.x, lane = tid & 63, wave = __builtin_amdgcn_readfirstlane(tid >> 6), blk = blockIdx.x;
    unsigned char* ws = a.ws;
    if (blk < 192) {
        const int cb = blk % 24, kc = blk / 24, col = cb * 256 + lane * 4, k0 = kc * 128 + wave * 16;
        const float* c = a.in[I_C]; const float* cc = a.in[I_CCTX]; const float* aw = a.in[I_ADAW];
        f32x4 a0 = {0.f, 0.f, 0.f, 0.f}, a1 = a0, a2 = a0;
#pragma unroll 4
        for (int k = 0; k < 16; ++k) {
            const int kk = k0 + k;
            const float s0 = silu_f(c[kk]), s1 = silu_f(c[1024 + kk]), s2 = silu_f(cc[kk]);
            const f32x4 w = *(const f32x4*)(aw + (size_t)kk * 6144 + col);
            a0 += w * s0; a1 += w * s1; a2 += w * s2;
        }
        LAS float* red = (LAS float*)lds;
        *(LAS f32x4*)(red + (wave * 3 + 0) * 256 + lane * 4) = a0;
        *(LAS f32x4*)(red + (wave * 3 + 1) * 256 + lane * 4) = a1;
        *(LAS f32x4*)(red + (wave * 3 + 2) * 256 + lane * 4) = a2;
        __syncthreads();
        float* adap = (float*)(ws + WS_ADAP);
        for (int idx = tid; idx < 768; idx += 512) {
            const int v = idx >> 8, cl = idx & 255; float s = 0.f;
#pragma unroll
            for (int w = 0; w < 8; ++w) s += red[(w * 3 + v) * 256 + cl];
            adap[(size_t)(kc * 3 + v) * 6144 + cb * 256 + cl] = s;
        }
        __syncthreads();
    }
    {
        LAS float* scr = (LAS float*)(lds + wave * 8704);
        const int gw = blk * NWAVES + wave, NGW = G * NWAVES;
        constexpr int I_1 = 16 * 120, I_2 = 8 * 32, I_3 = 8 * 32, I_4 = 16 * 32, I_5 = 16 * 8;
        for (int it = gw; it < I_1 + I_2 + I_3 + I_4 + I_5; it += NGW) {
            int r = it;
            if (r < I_1) { p0_transpose_item(a.in[I_WIN], 1024, 3840, (bf16*)(ws + WS_WINT), scr, r, lane); continue; } r -= I_1;
            if (r < I_2) { p0_transpose_item(a.in[I_WA], 512, 1024, (bf16*)(ws + WS_WAT), scr, r, lane); continue; } r -= I_2;
            if (r < I_3) { p0_transpose_item(a.in[I_WB], 512, 1024, (bf16*)(ws + WS_WBT), scr, r, lane); continue; } r -= I_3;
            if (r < I_4) { p0_transpose_item(a.in[I_WO], 1024, 1024, (bf16*)(ws + WS_WOT), scr, r, lane); continue; } r -= I_4;
            p0_transpose_item(a.in[I_RW], 1024, 256, (bf16*)(ws + WS_RWT), scr, r, lane);
        }
    }
    {
        const int gt = blk * 512 + tid, NT = G * 512;
        const float* gws = a.in[I_GWS]; bf16* wst = (bf16*)(ws + WS_WST);
        for (int i = gt; i < 8192; i += NT) {
            const f32x4 x0 = *(const f32x4*)(gws + i * 8), x1 = *(const f32x4*)(gws + i * 8 + 4);
            v4u o; o.x = cvtpk(x0[0], x0[1]); o.y = cvtpk(x0[2], x0[3]); o.z = cvtpk(x1[0], x1[1]); o.w = cvtpk(x1[2], x1[3]);
            *(v4u*)(wst + i * 8) = o;
        }
        float* rope = (float*)(ws + WS_ROPE);
        for (int i = gt; i < 2048; i += NT) {
            const int pos = i >> 4, f = i & 15;
            const float inv = __builtin_amdgcn_exp2f(-(float)f * (13.287712379549449f / 16.f));
            const float ang = (float)pos * inv;
            double rev = (double)ang * 0.15915494309189535; rev -= floor(rev);
            rope[pos * 32 + f] = __builtin_amdgcn_cosf((float)rev);
            rope[pos * 32 + 16 + f] = __builtin_amdgcn_sinf((float)rev);
        }
    }
}

__device__ __forceinline__ void phase_hnorm(const Args& a, ldsp lds, int G) {
    const int tid = threadIdx.x, lane = tid & 63, wave = __builtin_amdgcn_readfirstlane(tid >> 6), blk = blockIdx.x;
    unsigned char* ws = a.ws;
    const float* adap = (const float*)(ws + WS_ADAP); const float* adab = a.in[I_ADAB];
    LAS float* modv = (LAS float*)lds;
    {
        const int j = 4 * tid;
        f32x4 pv[3][9];
#pragma unroll
        for (int v = 0; v < 3; ++v) {
            pv[v][0] = *(const f32x4*)(adab + j);
#pragma unroll
            for (int kc = 0; kc < 8; ++kc) pv[v][kc + 1] = *(const f32x4*)(adap + (size_t)(kc * 3 + v) * 6144 + j);
        }
#pragma unroll
        for (int v = 0; v < 3; ++v) {
            f32x4 s = pv[v][0];
#pragma unroll
            for (int kc = 0; kc < 8; ++kc) s = s + pv[v][kc + 1];
            if (j >= 1024) s = s + (f32x4){1.f, 1.f, 1.f, 1.f};
            *(LAS f32x4*)(modv + v * 2048 + j) = s;
        }
    }
    { float* adaf = (float*)(ws + WS_ADAF);
      for (int idx = blk * 512 + tid; idx < 3 * 6144; idx += G * 512) {
          const int v = idx / 6144, j = idx % 6144; float s = adab[j];
#pragma unroll
          for (int kc = 0; kc < 8; ++kc) s += adap[(size_t)(kc * 3 + v) * 6144 + j];
          adaf[idx] = s; } }
    __syncthreads();
    const float* g1 = a.in[I_N1G]; bf16* H = (bf16*)(ws + WS_H);
    for (int t = blk * NWAVES + wave; t < MH; t += G * NWAVES) {
        const float* xr = (t < T) ? a.in[I_X] + (size_t)t * D : a.in[I_CTX] + (size_t)(t - T) * D;
        const int v = (t < T) ? (t >> 13) : 2;
        f32x4 x[4]; float ss = 0.f;
#pragma unroll
        for (int j = 0; j < 4; ++j) { x[j] = *(const f32x4*)(xr + 4 * lane + 256 * j); ss += (x[j][0] * x[j][0] + x[j][1] * x[j][1]) + (x[j][2] * x[j][2] + x[j][3] * x[j][3]); }
        const float r = rsqrtf(wave_sum(ss) * (1.f / D) + 1e-6f);
#pragma unroll
        for (int j = 0; j < 4; ++j) {
            const int col = 4 * lane + 256 * j;
            const f32x4 g = *(const f32x4*)(g1 + col);
            const f32x4 sh = *(LAS f32x4*)(modv + v * 2048 + col), sc = *(LAS f32x4*)(modv + v * 2048 + 1024 + col);
            const f32x4 h = (x[j] * r) * g * sc + sh;
            u32x2 o; o.x = cvtpk(h[0], h[1]); o.y = cvtpk(h[2], h[3]);
            *(u32x2*)(H + (size_t)t * D + col) = o;
        }
    }
}

struct WinOrder {
    pg8::StaticOrder so;
    __device__ void init(int G, int c) { so.init(T, DIN, G, c); }
    __device__ bool next(int i, pg8::Unit& u) const {
        const long L = (long)i * so.G + so.c;
        if (L < 960) return so.next(i, u);
        if (L < 962) { u.pm = 64 + (int)(L - 960); u.pn = 6; return true; }
        return false;
    }
    __device__ __forceinline__ void a_ready(const pg8::Unit&) const {}
    __device__ __forceinline__ void done(const pg8::Unit&) const {}
};
struct EpiWin {
    static constexpr bool PERM = false, AFTER_DRAIN = false;
    bf16* Z; bf16* KVC; const float* rope;
    __device__ __forceinline__ void operator()(const pg8::f32x4 (&acc)[2][2][4][2], const pg8::Unit& u, int wr, int wc, int fr, int fq) const {
        const int row0 = u.pm * 256 + wr * 64 + fr, colb = u.pn * 256 + wc * 32 + 4 * fq, pn = u.pn;
        if (u.pm >= 64) {
#pragma unroll
            for (int ai = 0; ai < 2; ++ai)
#pragma unroll
                for (int m = 0; m < 4; ++m) { bf16* rp = KVC + (size_t)(row0 + ai * 128 + m * 16 - T) * 256 + (colb - ZK);
#pragma unroll
                    for (int bj = 0; bj < 2; ++bj)
#pragma unroll
                        for (int n = 0; n < 2; ++n) { const pg8::f32x4 v = acc[ai][bj][m][n]; u32x2 o; o.x = cvtpk(v[0], v[1]); o.y = cvtpk(v[2], v[3]); *(u32x2*)(rp + bj * 128 + n * 16) = o; } }
            return;
        }
#pragma unroll
        for (int ai = 0; ai < 2; ++ai)
#pragma unroll
            for (int m = 0; m < 4; ++m) {
                const int r = row0 + ai * 128 + m * 16; bf16* rp = Z + (size_t)r * DIN + colb;
                if (pn <= 3) {
#pragma unroll
                    for (int bj = 0; bj < 2; ++bj)
#pragma unroll
                        for (int n = 0; n < 2; ++n) { const pg8::f32x4 v = acc[ai][bj][m][n]; u32x2 o; o.x = cvtpk(gelu_f(v[0]), gelu_f(v[1])); o.y = cvtpk(gelu_f(v[2]), gelu_f(v[3])); *(u32x2*)(rp + bj * 128 + n * 16) = o; }
                } else if (pn <= 6) {
                    const int pos = (wc & 1) ? (r & 63) : ((r & 8191) >> 6);
                    const pg8::f32x4 cs = *(const pg8::f32x4*)(rope + pos * 32 + 4 * fq), sn = *(const pg8::f32x4*)(rope + pos * 32 + 16 + 4 * fq);
                    const float sc = (pn < 6) ? QSCALE : 1.f;
#pragma unroll
                    for (int bj = 0; bj < 2; ++bj) {
                        const pg8::f32x4 x1 = acc[ai][bj][m][0], x2 = acc[ai][bj][m][1];
                        pg8::f32x4 o1, o2;
                        if (pn == 6 && bj == 1) { o1 = x1; o2 = x2; }
                        else { o1 = (x1 * cs - x2 * sn) * sc; o2 = (x2 * cs + x1 * sn) * sc; }
                        u32x2 w1, w2; w1.x = cvtpk(o1[0], o1[1]); w1.y = cvtpk(o1[2], o1[3]); w2.x = cvtpk(o2[0], o2[1]); w2.y = cvtpk(o2[2], o2[3]);
                        *(u32x2*)(rp + bj * 128) = w1; *(u32x2*)(rp + bj * 128 + 16) = w2;
                    }
                } else {
#pragma unroll
                    for (int bj = 0; bj < 2; ++bj)
#pragma unroll
                        for (int n = 0; n < 2; ++n) { const pg8::f32x4 v = acc[ai][bj][m][n]; u32x2 o; o.x = cvtpk(sigmoid_f(v[0]), sigmoid_f(v[1])); o.y = cvtpk(sigmoid_f(v[2]), sigmoid_f(v[3])); *(u32x2*)(rp + bj * 128 + n * 16) = o; }
                }
            }
    }
};
struct EpiMergeA {
    static constexpr bool PERM = true, AFTER_DRAIN = false;
    const bf16* Z; bf16* Y;
    __device__ __forceinline__ void operator()(const pg8::f32x4 (&acc)[2][2][4][2], const pg8::Unit& u, int wr, int wc, int fr, int fq) const {
        const int row0 = u.pm * 256 + wr * 64 + fr, col0 = u.pn * 256 + wc * 32 + 8 * fq;
#pragma unroll
        for (int ai = 0; ai < 2; ++ai)
#pragma unroll
            for (int m = 0; m < 4; ++m) { const int r = row0 + ai * 128 + m * 16;
#pragma unroll
                for (int bj = 0; bj < 2; ++bj) { const int c = col0 + bj * 128;
                    const u32x4 g = *(const u32x4*)(Z + (size_t)r * DIN + ZGA + c);
                    const pg8::f32x4 v0 = acc[ai][bj][m][0], v1 = acc[ai][bj][m][1];
                    u32x4 o;
                    o.x = cvtpk(v0[0] * bflo(g.x), v0[1] * bfhi(g.x)); o.y = cvtpk(v0[2] * bflo(g.y), v0[3] * bfhi(g.y));
                    o.z = cvtpk(v1[0] * bflo(g.z), v1[1] * bfhi(g.z)); o.w = cvtpk(v1[2] * bflo(g.w), v1[3] * bfhi(g.w));
                    *(u32x4*)(Y + (size_t)r * D + c) = o; } }
    }
};
struct EpiMergeB {
    static constexpr bool PERM = true, AFTER_DRAIN = false;
    const bf16* Z; bf16* Y;
    __device__ __forceinline__ void operator()(const pg8::f32x4 (&acc)[2][2][4][2], const pg8::Unit& u, int wr, int wc, int fr, int fq) const {
        const int row0 = u.pm * 256 + wr * 64 + fr, col0 = u.pn * 256 + wc * 32 + 8 * fq;
#pragma unroll
        for (int ai = 0; ai < 2; ++ai)
#pragma unroll
            for (int m = 0; m < 4; ++m) { const int r = row0 + ai * 128 + m * 16;
#pragma unroll
                for (int bj = 0; bj < 2; ++bj) { const int c = col0 + bj * 128;
                    const u32x4 g = *(const u32x4*)(Z + (size_t)r * DIN + ZGB + c);
                    const u32x4 tp = *(const u32x4*)(Y + (size_t)r * D + c);
                    const pg8::f32x4 t0 = {bflo(tp.x), bfhi(tp.x), bflo(tp.y), bfhi(tp.y)}, t1 = {bflo(tp.z), bfhi(tp.z), bflo(tp.w), bfhi(tp.w)};
                    const pg8::f32x4 v0 = acc[ai][bj][m][0], v1 = acc[ai][bj][m][1];
                    u32x4 o;
                    o.x = cvtpk(t0[0] + v0[0] * bflo(g.x), t0[1] + v0[1] * bfhi(g.x)); o.y = cvtpk(t0[2] + v0[2] * bflo(g.y), t0[3] + v0[3] * bfhi(g.y));
                    o.z = cvtpk(t1[0] + v1[0] * bflo(g.z), t1[1] + v1[1] * bfhi(g.z)); o.w = cvtpk(t1[2] + v1[2] * bflo(g.w), t1[3] + v1[3] * bfhi(g.w));
                    *(u32x4*)(Y + (size_t)r * D + c) = o; } }
    }
};
struct EpiWo {
    static constexpr bool PERM = true, AFTER_DRAIN = false;
    const float* x; const float* adaf; bf16* X1;
    __device__ __forceinline__ void operator()(const pg8::f32x4 (&acc)[2][2][4][2], const pg8::Unit& u, int wr, int wc, int fr, int fq) const {
        const int row0 = u.pm * 256 + wr * 64 + fr, col0 = u.pn * 256 + wc * 32 + 8 * fq;
        const float* g1 = adaf + (u.pm >= 32 ? 6144 : 0) + 2048;
#pragma unroll
        for (int bj = 0; bj < 2; ++bj) { const int c = col0 + bj * 128;
            const pg8::f32x4 ga = *(const pg8::f32x4*)(g1 + c), gb = *(const pg8::f32x4*)(g1 + c + 4);
#pragma unroll
            for (int ai = 0; ai < 2; ++ai)
#pragma unroll
                for (int m = 0; m < 4; ++m) { const int r = row0 + ai * 128 + m * 16;
                    const pg8::f32x4 x0 = *(const pg8::f32x4*)(x + (size_t)r * D + c), x1 = *(const pg8::f32x4*)(x + (size_t)r * D + c + 4);
                    const pg8::f32x4 o0 = x0 + ga * acc[ai][bj][m][0], o1 = x1 + gb * acc[ai][bj][m][1];
                    u32x4 w; w.x = cvtpk(o0[0], o0[1]); w.y = cvtpk(o0[2], o0[3]); w.z = cvtpk(o1[0], o1[1]); w.w = cvtpk(o1[2], o1[3]);
                    *(u32x4*)(X1 + (size_t)r * D + c) = w; } }
    }
};


__device__ __forceinline__ s16x4 vtr(LAS const unsigned char* p) { return __builtin_bit_cast(s16x4, __builtin_amdgcn_ds_read_tr16_b64_v4i16((LAS v4i16_t*)p)); }

__device__ __forceinline__ void attn_item(const bf16* Z, const bf16* KVC, const float* sink, bf16* Obuf, ldsp lds, int b, int nb, int hk, int qh) {
    const int tid = threadIdx.x, lane = tid & 63, wave = __builtin_amdgcn_readfirstlane(tid >> 6), r32 = lane & 31, hi = lane >> 5;
    const int rq = wave >> 1, head = hk * 4 + rq;
    const int iq = qh * 64 + (wave & 1) * 32 + r32;
    const int wlo = (nb == 0) ? 2 : qh, whi = (nb == 63) ? 4 : 5 + qh, nwin = whi - wlo, ntile = nwin + 4;
    const int tokq = b * SEQ + nb * 128 + iq;
    bf16x8 qr[4];
#pragma unroll
    for (int d0 = 0; d0 < 4; ++d0) qr[d0] = *(const bf16x8*)(Z + (size_t)tokq * DIN + ZQ + head * 64 + d0 * 16 + hi * 8);
    float mrun = sink[head] * LOG2E, lrun = (hi == 0) ? 1.f : 0.f;
    f32x16 o[2];
#pragma unroll
    for (int j = 0; j < 2; ++j)
#pragma unroll
        for (int r = 0; r < 16; ++r) o[j][r] = 0.f;
    const int kdst = wave * 1024 + lane * 16, vdst = 8192 + (wave >> 2) * 4096 + lane * 64 + (wave & 3) * 16;
#define ATT_SRC(s, kp, vp) do { const int tl_ = (s) < nwin ? wlo + (s) : 6 + (s) - nwin; \
        if (tl_ < 6) { const int tok_ = b * SEQ + (nb - 1 + (tl_ >> 1)) * 128 + (tl_ & 1) * 64 + lane; kp = Z + (size_t)tok_ * DIN + ZK + hk * 64 + wave * 8; vp = Z + (size_t)tok_ * DIN + ZVA + hk * 64 + wave * 8; } \
        else { const int row_ = b * NCTX + (tl_ - 6) * 64 + lane; kp = KVC + (size_t)row_ * 256 + hk * 64 + wave * 8; vp = KVC + (size_t)row_ * 256 + 128 + hk * 64 + wave * 8; } } while (0)
    u32x4 kreg, vreg;
    { const bf16 *kp, *vp; ATT_SRC(0, kp, vp); kreg = *(const u32x4*)kp; vreg = *(const u32x4*)vp; }
    *(LAS u32x4*)(lds + kdst) = kreg; *(LAS u32x4*)(lds + vdst) = vreg;
    __syncthreads();
    const int vrd = ((lane & 15) >> 2) * 64 + ((lane >> 4) & 1) * 32 + (lane & 3) * 8 + hi * 256;
    for (int s = 0; s < ntile; ++s) {
        const int base = (s & 1) * 16384;
        const int tl = s < nwin ? wlo + s : 6 + s - nwin;
        if (s + 1 < ntile) { const bf16 *kp, *vp; ATT_SRC(s + 1, kp, vp); kreg = *(const u32x4*)kp; vreg = *(const u32x4*)vp; }
        {
            f32x16 p0, p1;
#pragma unroll
            for (int r = 0; r < 16; ++r) { p0[r] = 0.f; p1[r] = 0.f; }
#pragma unroll
            for (int d0 = 0; d0 < 4; ++d0) {
                const bf16x8 k0 = *(LAS const bf16x8*)(lds + base + (2 * d0 + hi) * 1024 + r32 * 16);
                const bf16x8 k1 = *(LAS const bf16x8*)(lds + base + (2 * d0 + hi) * 1024 + (r32 + 32) * 16);
                p0 = mfma32(k0, qr[d0], p0); p1 = mfma32(k1, qr[d0], p1);
            }
            if (tl < 2) {
                const int j0 = (tl & 1) * 64 + 4 * hi;
#pragma unroll
                for (int r = 0; r < 16; ++r) { const int j = j0 + (r & 3) + 8 * (r >> 2); if (j < iq) p0[r] = -INFINITY; if (j + 32 < iq) p1[r] = -INFINITY; }
            } else if (tl == 4 || tl == 5) {
                const int j0 = (tl & 1) * 64 + 4 * hi;
#pragma unroll
                for (int r = 0; r < 16; ++r) { const int j = j0 + (r & 3) + 8 * (r >> 2); if (j > iq) p0[r] = -INFINITY; if (j + 32 > iq) p1[r] = -INFINITY; }
            }
            float mx = fmaxf(p0[0], p1[0]);
#pragma unroll
            for (int r = 1; r < 16; ++r) mx = fmaxf(mx, fmaxf(p0[r], p1[r]));
            mx = fmaxf(mx, __shfl_xor(mx, 32));
            const float mn = fmaxf(mrun, mx), alpha = __builtin_amdgcn_exp2f(mrun - mn);
            mrun = mn;
            float rs = 0.f;
#pragma unroll
            for (int r = 0; r < 16; ++r) { p0[r] = __builtin_amdgcn_exp2f(p0[r] - mn); p1[r] = __builtin_amdgcn_exp2f(p1[r] - mn); rs += p0[r] + p1[r]; }
            lrun = lrun * alpha + rs;
#pragma unroll
            for (int r = 0; r < 16; ++r) { o[0][r] *= alpha; o[1][r] *= alpha; }
            bf16x8 pf[4];
#pragma unroll
            for (int s4 = 0; s4 < 4; ++s4) {
                u32x4 w;
                if (s4 < 2) { w.x = cvtpk(p0[8 * s4 + 0], p0[8 * s4 + 1]); w.y = cvtpk(p0[8 * s4 + 2], p0[8 * s4 + 3]); w.z = cvtpk(p0[8 * s4 + 4], p0[8 * s4 + 5]); w.w = cvtpk(p0[8 * s4 + 6], p0[8 * s4 + 7]); }
                else { const int q = s4 - 2; w.x = cvtpk(p1[8 * q + 0], p1[8 * q + 1]); w.y = cvtpk(p1[8 * q + 2], p1[8 * q + 3]); w.z = cvtpk(p1[8 * q + 4], p1[8 * q + 5]); w.w = cvtpk(p1[8 * q + 6], p1[8 * q + 7]); }
                pf[s4] = __builtin_bit_cast(bf16x8, w);
            }
#pragma unroll
            for (int dblk = 0; dblk < 2; ++dblk)
#pragma unroll
                for (int s4 = 0; s4 < 4; ++s4) {
                    const s16x4 lo = vtr(lds + base + 8192 + dblk * 4096 + vrd + (16 * s4) * 64);
                    const s16x4 hh = vtr(lds + base + 8192 + dblk * 4096 + vrd + (16 * s4 + 8) * 64);
                    const bf16x8 vf = {lo[0], lo[1], lo[2], lo[3], hh[0], hh[1], hh[2], hh[3]};
                    o[dblk] = mfma32(vf, pf[s4], o[dblk]);
                }
        }
        if (s + 1 < ntile) { *(LAS u32x4*)(lds + (16384 - base) + kdst) = kreg; *(LAS u32x4*)(lds + (16384 - base) + vdst) = vreg; }
        __syncthreads();
    }
#undef ATT_SRC
    {
        const float lt = lrun + __shfl_xor(lrun, 32), inv = 1.f / lt;
        bf16* op = Obuf + (size_t)tokq * 512 + head * 64;
#pragma unroll
        for (int dblk = 0; dblk < 2; ++dblk)
#pragma unroll
            for (int r4 = 0; r4 < 4; ++r4) {
                u32x2 w; w.x = cvtpk(o[dblk][4 * r4] * inv, o[dblk][4 * r4 + 1] * inv); w.y = cvtpk(o[dblk][4 * r4 + 2] * inv, o[dblk][4 * r4 + 3] * inv);
                *(u32x2*)(op + 32 * dblk + 8 * r4 + 4 * hi) = w;
            }
    }
}

__device__ __forceinline__ void gmlp_item(const bf16* Z, const float* lng, const float* lnb, const bf16* WsT, const float* bs, bf16* Abuf, ldsp lds, int ch, int gp) {
    const int tid = threadIdx.x, lane = tid & 63, wave = __builtin_amdgcn_readfirstlane(tid >> 6), fr = lane & 15, fq = lane >> 4;
    const int tok0 = ch * 128;
    LAS bf16* VT = (LAS bf16*)lds;
    f32x4 gA = *(const f32x4*)(lng + lane * 8), gB = *(const f32x4*)(lng + lane * 8 + 4), bA = *(const f32x4*)(lnb + lane * 8), bB = *(const f32x4*)(lnb + lane * 8 + 4);
#pragma unroll
    for (int rnd = 0; rnd < 2; ++rnd) {
        float y[8][8];
#pragma unroll
        for (int j = 0; j < 8; ++j) {
            const int tok = tok0 + wave * 16 + rnd * 8 + j;
            const u32x4 raw = *(const u32x4*)(Z + (size_t)tok * DIN + ZV + lane * 8);
            float x[8] = {bflo(raw.x), bfhi(raw.x), bflo(raw.y), bfhi(raw.y), bflo(raw.z), bfhi(raw.z), bflo(raw.w), bfhi(raw.w)};
            float s = 0.f;
#pragma unroll
            for (int i = 0; i < 8; ++i) s += x[i];
            const float mu = wave_sum(s) * (1.f / 512.f);
            float q = 0.f;
#pragma unroll
            for (int i = 0; i < 8; ++i) { x[i] -= mu; q += x[i] * x[i]; }
            const float rstd = rsqrtf(wave_sum(q) * (1.f / 512.f) + 1e-6f);
            y[j][0] = x[0] * rstd * gA[0] + bA[0]; y[j][1] = x[1] * rstd * gA[1] + bA[1]; y[j][2] = x[2] * rstd * gA[2] + bA[2]; y[j][3] = x[3] * rstd * gA[3] + bA[3];
            y[j][4] = x[4] * rstd * gB[0] + bB[0]; y[j][5] = x[5] * rstd * gB[1] + bB[1]; y[j][6] = x[6] * rstd * gB[2] + bB[2]; y[j][7] = x[7] * rstd * gB[3] + bB[3];
        }
        if ((lane >> 5) == gp) {
            const int gl = (lane >> 4) & 1;
#pragma unroll
            for (int i = 0; i < 8; ++i) {
                u32x4 w; w.x = cvtpk(y[0][i], y[1][i]); w.y = cvtpk(y[2][i], y[3][i]); w.z = cvtpk(y[4][i], y[5][i]); w.w = cvtpk(y[6][i], y[7][i]);
                *(LAS u32x4*)(VT + gl * (128 * 136) + (8 * (lane & 15) + i) * 136 + wave * 16 + rnd * 8) = w;
            }
        }
    }
    __syncthreads();
    const int wm = wave >> 1, wn = wave & 1;
#pragma unroll
    for (int gl = 0; gl < 2; ++gl) {
        const int g = 2 * gp + gl;
        f32x4 acc[2][4];
#pragma unroll
        for (int m = 0; m < 2; ++m)
#pragma unroll
            for (int n = 0; n < 4; ++n) acc[m][n] = (f32x4){0.f, 0.f, 0.f, 0.f};
#pragma unroll
        for (int ks = 0; ks < 4; ++ks) {
            bf16x8 af[2], bfr[4];
#pragma unroll
            for (int m = 0; m < 2; ++m) af[m] = *(const bf16x8*)(WsT + (size_t)g * 16384 + (32 * wm + 16 * m + fr) * 128 + 32 * ks + 8 * fq);
#pragma unroll
            for (int n = 0; n < 4; ++n) bfr[n] = *(LAS const bf16x8*)(VT + gl * (128 * 136) + (64 * wn + 16 * n + fr) * 136 + 32 * ks + 8 * fq);
#pragma unroll
            for (int m = 0; m < 2; ++m)
#pragma unroll
                for (int n = 0; n < 4; ++n) acc[m][n] = mfma16(bfr[n], af[m], acc[m][n]);
        }
#pragma unroll
        for (int m = 0; m < 2; ++m) {
            const int p = 32 * wm + 16 * m + fr, tok = tok0 + p; const float bias = bs[g * 128 + p];
#pragma unroll
            for (int n = 0; n < 4; ++n) {
                const int c = g * 128 + 64 * wn + 16 * n + 4 * fq;
                const u32x2 uw = *(const u32x2*)(Z + (size_t)tok * DIN + ZU + c);
                u32x2 w; w.x = cvtpk(bflo(uw.x) * (acc[m][n][0] + bias), bfhi(uw.x) * (acc[m][n][1] + bias)); w.y = cvtpk(bflo(uw.y) * (acc[m][n][2] + bias), bfhi(uw.y) * (acc[m][n][3] + bias));
                *(u32x2*)(Abuf + (size_t)tok * 512 + c) = w;
            }
        }
    }
    __syncthreads();
}

__device__ __forceinline__ void phase_mixers(const Args& a, ldsp lds, int G, int vcu) {
    unsigned char* ws = a.ws;
    const bf16* Z = (const bf16*)(ws + WS_Z);
    for (int it = vcu; it < 512; it += G) {
        const int qh = it & 1, hk = (it >> 1) & 1, nb = (it >> 2) & 63, b = it >> 8;
        attn_item(Z, (const bf16*)(ws + WS_KVC), a.in[I_SINK], (bf16*)(ws + WS_O), lds, b, nb, hk, qh);
    }
    for (int it = vcu; it < 256; it += G) {
        gmlp_item(Z, a.in[I_LNG], a.in[I_LNB], (const bf16*)(ws + WS_WST), a.in[I_GBS], (bf16*)(ws + WS_A), lds, it >> 1, it & 1);
    }
}

#define KI_BEFORE(ka, ia, kb, ib) (((ka) > (kb)) || ((ka) == (kb) && (ia) < (ib)))
#define KI_CAS(K, I, p, q) do { const bool sw_ = KI_BEFORE(K[q], I[q], K[p], I[p]); const float kp_ = sw_ ? K[q] : K[p], kq_ = sw_ ? K[p] : K[q]; const int ip_ = sw_ ? I[q] : I[p], iq_ = sw_ ? I[p] : I[q]; \
        K[p] = kp_; I[p] = ip_; K[q] = kq_; I[q] = iq_; } while (0)
#define KI_SORT8(K, I) do { KI_CAS(K, I, 0, 1); KI_CAS(K, I, 2, 3); KI_CAS(K, I, 4, 5); KI_CAS(K, I, 6, 7); \
        KI_CAS(K, I, 0, 2); KI_CAS(K, I, 1, 3); KI_CAS(K, I, 4, 6); KI_CAS(K, I, 5, 7); \
        KI_CAS(K, I, 1, 2); KI_CAS(K, I, 5, 6); KI_CAS(K, I, 0, 4); KI_CAS(K, I, 3, 7); \
        KI_CAS(K, I, 1, 5); KI_CAS(K, I, 2, 6); KI_CAS(K, I, 1, 4); KI_CAS(K, I, 3, 6); \
        KI_CAS(K, I, 2, 4); KI_CAS(K, I, 3, 5); KI_CAS(K, I, 3, 4); } while (0)
#define KI_MERGE8(KA, IA, KB, IB) do { \
        _Pragma("unroll") for (int r_ = 0; r_ < 8; ++r_) { const bool tb_ = KI_BEFORE(KB[7 - r_], IB[7 - r_], KA[r_], IA[r_]); KA[r_] = tb_ ? KB[7 - r_] : KA[r_]; IA[r_] = tb_ ? IB[7 - r_] : IA[r_]; } \
        KI_CAS(KA, IA, 0, 4); KI_CAS(KA, IA, 1, 5); KI_CAS(KA, IA, 2, 6); KI_CAS(KA, IA, 3, 7); \
        KI_CAS(KA, IA, 0, 2); KI_CAS(KA, IA, 1, 3); KI_CAS(KA, IA, 4, 6); KI_CAS(KA, IA, 5, 7); \
        KI_CAS(KA, IA, 0, 1); KI_CAS(KA, IA, 2, 3); KI_CAS(KA, IA, 4, 5); KI_CAS(KA, IA, 6, 7); } while (0)
__device__ __forceinline__ void router_item(const Args& a, ldsp lds, int it) {
    const int tid = threadIdx.x, lane = tid & 63, wave = __builtin_amdgcn_readfirstlane(tid >> 6), fr = lane & 15, fq = lane >> 4;
    unsigned char* ws = a.ws;
    const int t0 = it * 64, b = t0 >> 13;
    const bf16* X1 = (const bf16*)(ws + WS_X1); const float* adaf = (const float*)(ws + WS_ADAF) + b * 6144;
    const float* g2 = a.in[I_N2G]; unsigned char* H2 = ws + WS_H2;
    {
        f32x4 gm[2][2], sh[2][2];
#pragma unroll
        for (int j = 0; j < 2; ++j)
#pragma unroll
            for (int h = 0; h < 2; ++h) {
                const int c = 8 * lane + 512 * j + 4 * h;
                const f32x4 gg = *(const f32x4*)(g2 + c), sc = *(const f32x4*)(adaf + 4 * 1024 + c);
                gm[j][h] = gg * (sc + 1.f); sh[j][h] = *(const f32x4*)(adaf + 3 * 1024 + c);
            }
#pragma unroll
        for (int half = 0; half < 2; ++half) {
            f32x4 x[4][2][2];
#pragma unroll
            for (int tt = 0; tt < 4; ++tt)
#pragma unroll
                for (int j = 0; j < 2; ++j) {
                    const u32x4 w = *(const u32x4*)(X1 + (size_t)(t0 + wave * 8 + half * 4 + tt) * D + 8 * lane + 512 * j);
                    x[tt][j][0] = (f32x4){bflo(w.x), bfhi(w.x), bflo(w.y), bfhi(w.y)}; x[tt][j][1] = (f32x4){bflo(w.z), bfhi(w.z), bflo(w.w), bfhi(w.w)};
                }
#pragma unroll
            for (int tt = 0; tt < 4; ++tt) {
                const int row = wave * 8 + half * 4 + tt, tok = t0 + row;
                float ss = 0.f;
#pragma unroll
                for (int j = 0; j < 2; ++j)
#pragma unroll
                    for (int h = 0; h < 2; ++h) { const f32x4 v = x[tt][j][h]; ss += (v[0] * v[0] + v[1] * v[1]) + (v[2] * v[2] + v[3] * v[3]); }
                const float r = rsqrtf(wave_sum(ss) * (1.f / D) + 1e-6f);
#pragma unroll
                for (int j = 0; j < 2; ++j) {
                    const f32x4 h0 = (x[tt][j][0] * r) * gm[j][0] + sh[j][0], h1 = (x[tt][j][1] * r) * gm[j][1] + sh[j][1];
                    u32x4 w; w.x = cvtpk(h0[0], h0[1]); w.y = cvtpk(h0[2], h0[3]); w.z = cvtpk(h1[0], h1[1]); w.w = cvtpk(h1[2], h1[3]);
                    { int f0 = 0, f1 = 0;
                      f0 = __builtin_amdgcn_cvt_pk_fp8_f32(h0[0], h0[1], f0, false); f0 = __builtin_amdgcn_cvt_pk_fp8_f32(h0[2], h0[3], f0, true);
                      f1 = __builtin_amdgcn_cvt_pk_fp8_f32(h1[0], h1[1], f1, false); f1 = __builtin_amdgcn_cvt_pk_fp8_f32(h1[2], h1[3], f1, true);
                      u32x2 w8; w8.x = (unsigned)f0; w8.y = (unsigned)f1; *(u32x2*)(H2 + (size_t)tok * D + 8 * lane + 512 * j) = w8; }
                    const int kc = lane + 64 * j;
                    *(LAS u32x4*)(lds + kc * 1024 + ((row ^ (kc & 7)) * 16)) = w;
                }
            }
        }
    }
    __syncthreads();
    f32x4 acc[4][2];
#pragma unroll
    for (int m = 0; m < 4; ++m)
#pragma unroll
        for (int n = 0; n < 2; ++n) acc[m][n] = (f32x4){0.f, 0.f, 0.f, 0.f};
    const bf16* RwT = (const bf16*)(ws + WS_RWT) + (size_t)(32 * wave + fr) * D + 8 * fq;
#pragma unroll 8
    for (int ks = 0; ks < 32; ++ks) {
        const int kc = 4 * ks + fq;
        bf16x8 af[4], bfr[2];
#pragma unroll
        for (int n = 0; n < 2; ++n) bfr[n] = *(const bf16x8*)(RwT + (size_t)(16 * n) * D + 32 * ks);
#pragma unroll
        for (int m = 0; m < 4; ++m) af[m] = *(LAS const bf16x8*)(lds + kc * 1024 + (((16 * m + fr) ^ (kc & 7)) * 16));
#pragma unroll
        for (int m = 0; m < 4; ++m)
#pragma unroll
            for (int n = 0; n < 2; ++n) acc[m][n] = mfma16(af[m], bfr[n], acc[m][n]);
    }
    __syncthreads();
    LAS float* LG = (LAS float*)lds;
#pragma unroll
    for (int m = 0; m < 4; ++m)
#pragma unroll
        for (int n = 0; n < 2; ++n)
#pragma unroll
            for (int reg = 0; reg < 4; ++reg) LG[(32 * wave + 16 * n + fr) * 65 + 16 * m + 4 * fq + reg] = acc[m][n][reg];
    __syncthreads();
    LAS float* CK = (LAS float*)(lds + 69632); LAS int* CI = (LAS int*)(lds + 69632 + 16384);
    const float* rb = a.in[I_RB];
    float bk[8]; int bi[8];
#pragma unroll
    for (int q = 0; q < 4; ++q) {
        float gk[8]; int gi[8];
#pragma unroll
        for (int j = 0; j < 8; ++j) { const int e = 32 * wave + 8 * q + j; gk[j] = sigmoid_f(LG[e * 65 + lane]) + rb[e]; gi[j] = e; }
        KI_SORT8(gk, gi);
        if (q == 0) {
#pragma unroll
            for (int j = 0; j < 8; ++j) { bk[j] = gk[j]; bi[j] = gi[j]; }
        } else KI_MERGE8(bk, bi, gk, gi);
    }
#pragma unroll
    for (int r = 0; r < 8; ++r) { CK[(wave * 8 + r) * 64 + lane] = bk[r]; CI[(wave * 8 + r) * 64 + lane] = bi[r]; }
    __syncthreads();
#define RT_LEVEL(lvl) do { if ((wave & (2 * (lvl) - 1)) == 0) { float ok_[8]; int oi_[8]; \
            _Pragma("unroll") for (int r = 0; r < 8; ++r) { ok_[r] = CK[((wave + (lvl)) * 8 + r) * 64 + lane]; oi_[r] = CI[((wave + (lvl)) * 8 + r) * 64 + lane]; } \
            KI_MERGE8(bk, bi, ok_, oi_); \
            if ((lvl) < 4) { _Pragma("unroll") for (int r = 0; r < 8; ++r) { CK[(wave * 8 + r) * 64 + lane] = bk[r]; CI[(wave * 8 + r) * 64 + lane] = bi[r]; } } } \
        __syncthreads(); } while (0)
    RT_LEVEL(1); RT_LEVEL(2); RT_LEVEL(4);
#undef RT_LEVEL
    LAS unsigned* hist = (LAS unsigned*)(lds + 102400); LAS unsigned* hbase = hist + 256;
    if (tid < 256) hist[tid] = 0u;
    __syncthreads();
    unsigned* cnt = (unsigned*)(ws + WS_CTL) + CW_CNT; int* list = (int*)(ws + WS_LIST); float* gatew = (float*)(ws + WS_GATEW);
    unsigned rank[8];
    if (wave == 0) {
        const int tok = t0 + lane;
        float sel[8], ssum = 0.f;
#pragma unroll
        for (int r = 0; r < 8; ++r) { sel[r] = sigmoid_f(LG[bi[r] * 65 + lane]); ssum += sel[r]; }
#pragma unroll
        for (int r = 0; r < 8; ++r) rank[r] = __hip_atomic_fetch_add(&hist[bi[r]], 1u, __ATOMIC_RELAXED, __HIP_MEMORY_SCOPE_WORKGROUP);
        const float sc = 2.5f / ssum;
        f32x4 g0 = {sel[0] * sc, sel[1] * sc, sel[2] * sc, sel[3] * sc}, g1 = {sel[4] * sc, sel[5] * sc, sel[6] * sc, sel[7] * sc};
        *(f32x4*)(gatew + tok * 8) = g0; *(f32x4*)(gatew + tok * 8 + 4) = g1;
    }
    __syncthreads();
    if (tid < 256) { const unsigned h = hist[tid]; if (h) hbase[tid] = atomicAdd(cnt + 32 * tid, h); }
    __syncthreads();
    if (wave == 0) {
        const int tok = t0 + lane;
#pragma unroll
        for (int r = 0; r < 8; ++r) list[(size_t)bi[r] * LISTCAP + hbase[bi[r]] + rank[r]] = tok * NSLOT + r;
    }
    __syncthreads();
}

__device__ __forceinline__ void moe_tile(const Args& a, ldsp lds, int e, int mt, int nrows, int ntl) {
    const int tid = threadIdx.x, lane = tid & 63, wave = __builtin_amdgcn_readfirstlane(tid >> 6), fr = lane & 15, fq = lane >> 4;
    unsigned char* ws = a.ws;
    constexpr int ASTG = 0, BSTG = 16384, ACT = 49152, SLOTS = 114688, GWO = 115200;
    const bf16* H2 = (const bf16*)(ws + WS_H2);
    const float* Wg = (e < NEXP) ? a.in[I_EG] + (size_t)e * 262144 : a.in[I_SG];
    const float* Wu = (e < NEXP) ? a.in[I_EU] + (size_t)e * 262144 : a.in[I_SU];
    const float* Wd = (e < NEXP) ? a.in[I_ED] + (size_t)e * 262144 : a.in[I_SD];
    if (tid < 128) {
        int slot = -1; float gw = 0.f;
        if (tid < nrows) {
            if (e < NEXP) { slot = ((const int*)(ws + WS_LIST))[(size_t)e * LISTCAP + mt * 128 + tid]; gw = ((const float*)(ws + WS_GATEW))[(slot / NSLOT) * 8 + (slot % NSLOT)]; }
            else { slot = (mt * 128 + tid) * NSLOT + 8; gw = 1.f; }
        }
        ((LAS int*)(lds + SLOTS))[tid] = slot; ((LAS float*)(lds + GWO))[tid] = gw;
    }
    __syncthreads();
    const int wr = wave >> 2, wc = wave & 3;
    const int arow = tid >> 2, akc = tid & 3;
    const int aslot = ((LAS const int*)(lds + SLOTS))[arow];
    const bf16* asrc = H2 + (size_t)((aslot < 0 ? 0 : aslot) / NSLOT) * D + akc * 8;
    const int awr = ASTG + akc * 2048 + ((arow ^ (akc << 1)) * 16);
    const int ng = lane, kq = wave;
    const float* srcg = Wg + (size_t)(4 * kq) * 256 + 4 * ng;
    const float* srcu = Wu + (size_t)(4 * kq) * 256 + 4 * ng;
    const float* src2 = Wd + (size_t)(4 * kq) * 1024 + 4 * ng;
    int bwr2[4];
#pragma unroll
    for (int i = 0; i < 4; ++i) { const int rho2 = 4 * ng + i; bwr2[i] = BSTG + (kq >> 1) * 4096 + ((rho2 ^ ((rho2 >> 3) & 3)) * 16) + (kq & 1) * 8; }
    int ard[4], brd[4], rowm[4];
#pragma unroll
    for (int m = 0; m < 4; ++m) { rowm[m] = 64 * wr + 16 * m + fr; ard[m] = fq * 2048 + ((rowm[m] ^ (fq << 1)) * 16); }
#pragma unroll
    for (int n = 0; n < 4; ++n) { const int rho = 64 * wc + 16 * n + fr; brd[n] = BSTG + fq * 4096 + ((rho ^ ((rho >> 3) & 3)) * 16); }
    bf16* contrib = (bf16*)(ws + WS_CONTRIB);
    f32x4 acc[4][4];
    f32x4 B0[4], B1[4], B2[4], B3[4]; u32x4 A0, A1, A2, A3;
#define G1_LOAD(s_, BR, AR) do { const int s0_ = (s_); const int ss_ = s0_ < 63 ? s0_ : 63; \
        const float* bp_ = ((ss_ < 32) ? srcg : srcu) + (size_t)(32 * (ss_ & 31)) * 256; \
        AR = *(const u32x4*)(asrc + 32 * (ss_ & 31)); \
        _Pragma("unroll") for (int j = 0; j < 4; ++j) BR[j] = *(const f32x4*)(bp_ + j * 256); } while (0)
#define G1_WRITE(BR, AR, buf_) do { \
        *(LAS u32x4*)(lds + (buf_) * 8192 + awr) = AR; \
        _Pragma("unroll") for (int i = 0; i < 4; ++i) { u32x2 w_; w_.x = cvtpk(BR[0][i], BR[1][i]); w_.y = cvtpk(BR[2][i], BR[3][i]); *(LAS u32x2*)(lds + (buf_) * 16384 + bwr2[i]) = w_; } } while (0)
#define MOE_COMPUTE(abase_, buf_) do { \
        bf16x8 af_[4], bf_[4]; \
        _Pragma("unroll") for (int m = 0; m < 4; ++m) af_[m] = *(LAS const bf16x8*)(lds + (abase_) + ard[m]); \
        _Pragma("unroll") for (int n = 0; n < 4; ++n) bf_[n] = *(LAS const bf16x8*)(lds + (buf_) * 16384 + brd[n]); \
        _Pragma("unroll") for (int m = 0; m < 4; ++m) _Pragma("unroll") for (int n = 0; n < 4; ++n) acc[m][n] = mfma16(bf_[n], af_[m], acc[m][n]); } while (0)
#define ACC_ZERO() do { _Pragma("unroll") for (int m = 0; m < 4; ++m) _Pragma("unroll") for (int n = 0; n < 4; ++n) acc[m][n] = (f32x4){0.f, 0.f, 0.f, 0.f}; } while (0)
    G1_LOAD(0, B0, A0); G1_LOAD(1, B1, A1); G1_LOAD(2, B2, A2);
    G1_WRITE(B0, A0, 0);
    __syncthreads();
    for (int s = 0; s < 64; s += 4) {
        if ((s & 31) == 0) ACC_ZERO();
        G1_LOAD(s + 3, B3, A3); MOE_COMPUTE(0, 0); G1_WRITE(B1, A1, 1); __syncthreads();
        G1_LOAD(s + 4, B0, A0); MOE_COMPUTE(8192, 1); G1_WRITE(B2, A2, 0); __syncthreads();
        G1_LOAD(s + 5, B1, A1); MOE_COMPUTE(0, 0); G1_WRITE(B3, A3, 1); __syncthreads();
        G1_LOAD(s + 6, B2, A2); MOE_COMPUTE(8192, 1);
        if (s == 28) {
#pragma unroll
            for (int m = 0; m < 4; ++m)
#pragma unroll
                for (int n = 0; n < 4; ++n) {
                    const f32x4 gv = acc[m][n];
                    u32x2 w; w.x = cvtpk(silu_f(gv[0]), silu_f(gv[1])); w.y = cvtpk(silu_f(gv[2]), silu_f(gv[3]));
                    const int kc = 8 * wc + 2 * n + (fq >> 1);
                    *(LAS u32x2*)(lds + ACT + kc * 2048 + ((rowm[m] ^ ((kc & 3) << 1)) * 16) + (fq & 1) * 8) = w;
                }
        } else if (s == 60) {
#pragma unroll
            for (int m = 0; m < 4; ++m)
#pragma unroll
                for (int n = 0; n < 4; ++n) {
                    const f32x4 uv = acc[m][n];
                    const int kc = 8 * wc + 2 * n + (fq >> 1);
                    LAS u32x2* ap = (LAS u32x2*)(lds + ACT + kc * 2048 + ((rowm[m] ^ ((kc & 3) << 1)) * 16) + (fq & 1) * 8);
                    const u32x2 g = *ap;
                    u32x2 w; w.x = cvtpk(bflo(g.x) * uv[0], bfhi(g.x) * uv[1]); w.y = cvtpk(bflo(g.y) * uv[2], bfhi(g.y) * uv[3]);
                    *ap = w;
                }
        }
        G1_WRITE(B0, A0, 0); __syncthreads();
    }
#define G2_LOAD(s_, BR) do { const int s0_ = (s_); const int t_ = s0_ < 31 ? s0_ : 31; \
        const float* bp_ = src2 + (size_t)(32 * (t_ & 7)) * 1024 + 256 * (t_ >> 3); \
        _Pragma("unroll") for (int j = 0; j < 4; ++j) BR[j] = *(const f32x4*)(bp_ + j * 1024); } while (0)
#define G2_WRITE(BR, buf_) do { \
        _Pragma("unroll") for (int i = 0; i < 4; ++i) { u32x2 w_; w_.x = cvtpk(BR[0][i], BR[1][i]); w_.y = cvtpk(BR[2][i], BR[3][i]); *(LAS u32x2*)(lds + (buf_) * 16384 + bwr2[i]) = w_; } } while (0)
    G2_LOAD(0, B0); G2_LOAD(1, B1); G2_LOAD(2, B2);
    G2_WRITE(B0, 0);
    __syncthreads();
    for (int s = 0; s < 32; s += 4) {
        if ((s & 7) == 0) ACC_ZERO();
        G2_LOAD(s + 3, B3); MOE_COMPUTE(ACT + (s & 7) * 8192, 0); G2_WRITE(B1, 1); __syncthreads();
        G2_LOAD(s + 4, B0); MOE_COMPUTE(ACT + ((s + 1) & 7) * 8192, 1); G2_WRITE(B2, 0); __syncthreads();
        G2_LOAD(s + 5, B1); MOE_COMPUTE(ACT + ((s + 2) & 7) * 8192, 0); G2_WRITE(B3, 1); __syncthreads();
        G2_LOAD(s + 6, B2); MOE_COMPUTE(ACT + ((s + 3) & 7) * 8192, 1);
        if ((s & 7) == 4) {
            const int q = s >> 3;
#pragma unroll
            for (int m = 0; m < 4; ++m) {
                const int slot = ((LAS const int*)(lds + SLOTS))[rowm[m]]; const float gw = ((LAS const float*)(lds + GWO))[rowm[m]];
                if (slot >= 0) {
                    bf16* cp = contrib + (size_t)slot * D + q * 256 + 64 * wc + 4 * fq;
#pragma unroll
                    for (int n = 0; n < 4; ++n) { const f32x4 v = acc[m][n] * gw; u32x2 w; w.x = cvtpk(v[0], v[1]); w.y = cvtpk(v[2], v[3]); *(u32x2*)(cp + 16 * n) = w; }
                }
            }
        }
        G2_WRITE(B0, 0); __syncthreads();
    }
#undef G1_LOAD
#undef G1_WRITE
#undef G2_LOAD
#undef G2_WRITE
#undef ACC_ZERO
#undef MOE_COMPUTE
}

__device__ __forceinline__ const float* uni_ptr(const float* p) {
    const unsigned long long v = (unsigned long long)p;
    const unsigned lo = __builtin_amdgcn_readfirstlane((unsigned)v), hi = __builtin_amdgcn_readfirstlane((unsigned)(v >> 32));
    return (const float*)(((unsigned long long)hi << 32) | lo);
}
__device__ __forceinline__ void moe_decode(int j, int total, LAS const int* pre, LAS const int* cnt, int& e, int& mt, int& nrows) {
    if (j < total) {
        int lo = 0, hi = NEXP;
        while (hi - lo > 1) { const int mid = (lo + hi) >> 1; if (pre[mid] <= j) lo = mid; else hi = mid; }
        e = lo; mt = j - pre[e]; const int c = cnt[e] - mt * 128; nrows = c < 128 ? c : 128;
    } else { e = NEXP; mt = j - total; nrows = 128; }
}
__device__ __forceinline__ void phase_moe(const Args& a, ldsp lds, int G, int vcu) {
    const int tid = threadIdx.x, lane = tid & 63, wave = __builtin_amdgcn_readfirstlane(tid >> 6), fr = lane & 15, fq = lane >> 4;
    unsigned char* ws = a.ws;
    constexpr int ASTG = 0, BSTG = 16384, ACT = 49152, SLOTS = 114688, GWO = SLOTS + MOE_MAXT * 512;
    static_assert(GWO + MOE_MAXT * 512 <= SCR_BYTES, "slot lists overflow the scratch image");
    LAS int* pre = (LAS int*)(lds + MISC_OFF + 512);
    LAS int* cnt = (LAS int*)(lds + MISC_OFF + 2048);
    LAS int* wtot = (LAS int*)(lds + MISC_OFF + 3072);
    int myv = 0, myx = 0;
    if (tid < NEXP) {
        const int c = (int)((const unsigned*)(ws + WS_CTL) + CW_CNT)[32 * tid];
        cnt[tid] = c; myv = (c + 127) >> 7; myx = myv;
#pragma unroll
        for (int o = 1; o < 64; o <<= 1) { const int y = __shfl_up(myx, o); if (lane >= o) myx += y; }
        if (lane == 63) wtot[wave] = myx;
    }
    __syncthreads();
    if (tid < NEXP) { int base = 0; for (int w = 0; w < wave; ++w) base += wtot[w]; pre[tid] = base + myx - myv; if (tid == NEXP - 1) pre[NEXP] = base + myx; }
    __syncthreads();
    const int total = pre[NEXP], ntiles = total + T / 128;
    if (vcu >= ntiles) return;
    for (int tt = tid >> 7; vcu + tt * G < ntiles; tt += 4) {
        const int r = tid & 127; int e_, mt_, nr_; moe_decode(vcu + tt * G, total, pre, cnt, e_, mt_, nr_);
        int slot_ = -1; float gw_ = 0.f;
        if (r < nr_) { if (e_ < NEXP) { slot_ = ((const int*)(ws + WS_LIST))[(size_t)e_ * LISTCAP + mt_ * 128 + r]; gw_ = ((const float*)(ws + WS_GATEW))[(slot_ / NSLOT) * 8 + (slot_ % NSLOT)]; }
                       else { slot_ = (mt_ * 128 + r) * NSLOT + 8; gw_ = 1.f; } }
        ((LAS int*)(lds + SLOTS))[tt * 128 + r] = slot_; ((LAS float*)(lds + GWO))[tt * 128 + r] = gw_;
    }
    __syncthreads();
    if (wave >= 4) {
        const int lt = tid - 256;
        const unsigned char* H2 = ws + WS_H2;
        const int arow = lt >> 1, ahalf = lt & 1;
        const int awr0 = ASTG + (2 * ahalf) * 2048 + ((arow ^ ((2 * ahalf) << 1)) * 16), awr1 = ASTG + (2 * ahalf + 1) * 2048 + ((arow ^ ((2 * ahalf + 1) << 1)) * 16);
        const int ng = lt & 63, kq = lt >> 6;
        const int loff256 = (8 * kq) * 256 + 4 * ng, loff1024 = (8 * kq) * 1024 + 4 * ng;
        const int bw = BSTG + kq * 4096 + (4 * ng) * 16, bx = ((4 * ng) >> 3) & 3;
        const int rho_d = 64 * (ng >> 4) + 16 * (ng & 3) + 4 * ((ng >> 2) & 3);
        const int bw_d = BSTG + kq * 4096 + rho_d * 16, bx_d = (rho_d >> 4) & 3;
        f32x4 B0[8], B1[8], B2[8], B3[8]; u32x4 A0, A1, A2, A3, A4, A5, A6, A7;
        int j = vcu, it = 0, e, mt, nrows;
        moe_decode(j, total, pre, cnt, e, mt, nrows);
#ifndef MOE_AUX
#define MOE_AUX 16
#endif
#define W_RSRC(eo_, pe_, ps_) __builtin_amdgcn_make_buffer_rsrc((void*)uni_ptr(((eo_) < NEXP) ? a.in[pe_] + (size_t)(eo_) * 262144 : a.in[ps_]), 0, 1 << 20, 0x00020000)
        const int eu0 = __builtin_amdgcn_readfirstlane(e);
        __amdgpu_buffer_rsrc_t Wg = W_RSRC(eu0, I_EG, I_SG), Wu = W_RSRC(eu0, I_EU, I_SU), Wd = W_RSRC(eu0, I_ED, I_SD);
        int aslot = ((LAS const int*)(lds + SLOTS))[arow];
        const unsigned char* asrc = H2 + (size_t)((aslot < 0 ? 0 : aslot) / NSLOT) * D + 16 * ahalf;
#define L_LOADB1(WG_, WU_, WD_, s_, BR) do { const int ss_ = (s_); const int t_ = ss_ - 64; \
            const __amdgpu_buffer_rsrc_t r_ = (ss_ < 32) ? (WG_) : (ss_ < 64) ? (WU_) : (WD_); \
            const int vo_ = (ss_ < 64) ? 4 * loff256 : 4 * loff1024; \
            const int so_ = (ss_ < 32) ? (32 * ss_) * 1024 : (ss_ < 64) ? (32 * (ss_ - 32)) * 1024 : (32 * (t_ & 7)) * 4096 + 1024 * (t_ >> 3); \
            const int str_ = (ss_ < 64) ? 1024 : 4096;        \
            _Pragma("unroll") for (int jj = 0; jj < 8; ++jj) BR[jj] = __builtin_bit_cast(f32x4, __builtin_amdgcn_raw_buffer_load_b128(r_, vo_, so_ + jj * str_, MOE_AUX)); } while (0)
#define L_LOADA4(AP_, s_, R0, R1, R2, R3) do { const int ss_ = (s_); const int sa_ = ss_ < 60 ? ss_ : 60; const unsigned char* p_ = (AP_) + 32 * (sa_ & 31); \
            R0 = *(const u32x4*)(p_); R1 = *(const u32x4*)(p_ + 32); R2 = *(const u32x4*)(p_ + 64); R3 = *(const u32x4*)(p_ + 96); } while (0)
#define L_LOADB1P(WG_, WU_, WD_, s_, BR, j0_) do { const int ss_ = (s_); const int t_ = ss_ - 64; \
            const __amdgpu_buffer_rsrc_t r_ = (ss_ < 32) ? (WG_) : (ss_ < 64) ? (WU_) : (WD_); \
            const int vo_ = (ss_ < 64) ? 4 * loff256 : 4 * loff1024; \
            const int so_ = (ss_ < 32) ? (32 * ss_) * 1024 : (ss_ < 64) ? (32 * (ss_ - 32)) * 1024 : (32 * (t_ & 7)) * 4096 + 1024 * (t_ >> 3); \
            const int str_ = (ss_ < 64) ? 1024 : 4096; \
            _Pragma("unroll") for (int jj = (j0_); jj < (j0_) + 2; ++jj) BR[jj] = __builtin_bit_cast(f32x4, __builtin_amdgcn_raw_buffer_load_b128(r_, vo_, so_ + jj * str_, MOE_AUX)); } while (0)
#define L_LOAD2P(s_, BR, j0_) do { const int s0_ = (s_); const int t_ = s0_ < 31 ? s0_ : 31; \
            const int so_ = (32 * (t_ & 7)) * 4096 + 1024 * (t_ >> 3); \
            _Pragma("unroll") for (int jj = (j0_); jj < (j0_) + 2; ++jj) BR[jj] = __builtin_bit_cast(f32x4, __builtin_amdgcn_raw_buffer_load_b128(Wd, 4 * loff1024, so_ + jj * 4096, MOE_AUX)); } while (0)
#define L_WRITEB1(BR, buf_, i_, bw_, bx_) do { const int i = (i_); u32x4 w_; w_.x = cvtpk(BR[0][i], BR[1][i]); w_.y = cvtpk(BR[2][i], BR[3][i]); w_.z = cvtpk(BR[4][i], BR[5][i]); w_.w = cvtpk(BR[6][i], BR[7][i]); \
            *(LAS u32x4*)(lds + (buf_) * 16384 + (bw_) + ((i ^ (bx_)) * 16)) = w_; } while (0)
#define L_SB() __builtin_amdgcn_sched_barrier(0)
#define L_STEP1(WG_, WU_, WD_, ls_, LB, WB, wbuf_, ws_) do { const bool dn_ = (ws_) >= 64; const int bwx_ = dn_ ? bw_d : bw, bxx_ = dn_ ? bx_d : bx;        \
            _Pragma("unroll") for (int i4 = 0; i4 < 4; ++i4) { L_WRITEB1(WB, wbuf_, i4, bwx_, bxx_); L_SB(); L_LOADB1P(WG_, WU_, WD_, ls_, LB, 2 * i4); L_SB(); } } while (0)
#define L_STEP2(ls_, LB, WB, wbuf_) do { _Pragma("unroll") for (int i4 = 0; i4 < 4; ++i4) { L_WRITEB1(WB, wbuf_, i4, bw_d, bx_d); L_SB(); L_LOAD2P(ls_, LB, 2 * i4); L_SB(); } } while (0)
#define L_LOAD2(s_, BR) do { const int s0_ = (s_); const int t_ = s0_ < 31 ? s0_ : 31; \
            const int so_ = (32 * (t_ & 7)) * 4096 + 1024 * (t_ >> 3); \
            _Pragma("unroll") for (int jj = 0; jj < 8; ++jj) BR[jj] = __builtin_bit_cast(f32x4, __builtin_amdgcn_raw_buffer_load_b128(Wd, 4 * loff1024, so_ + jj * 4096, MOE_AUX)); } while (0)
#define L_WRITEB(BR, buf_) do { _Pragma("unroll") for (int i = 0; i < 4; ++i) { u32x4 w_; w_.x = cvtpk(BR[0][i], BR[1][i]); w_.y = cvtpk(BR[2][i], BR[3][i]); w_.z = cvtpk(BR[4][i], BR[5][i]); w_.w = cvtpk(BR[6][i], BR[7][i]); \
            *(LAS u32x4*)(lds + (buf_) * 16384 + bw + ((i ^ bx) * 16)) = w_; } } while (0)
#define L_CVT8(w_, o0, o1) do { const f32x2_t l_ = __builtin_amdgcn_cvt_pk_f32_fp8((int)(w_), false), h_ = __builtin_amdgcn_cvt_pk_f32_fp8((int)(w_), true); o0 = cvtpk(l_[0], l_[1]); o1 = cvtpk(h_[0], h_[1]); } while (0)
#define L_WRITEA(AR, buf_) do { u32x4 c0_, c1_; L_CVT8(AR.x, c0_.x, c0_.y); L_CVT8(AR.y, c0_.z, c0_.w); L_CVT8(AR.z, c1_.x, c1_.y); L_CVT8(AR.w, c1_.z, c1_.w); \
            *(LAS u32x4*)(lds + (buf_) * 8192 + awr0) = c0_; *(LAS u32x4*)(lds + (buf_) * 8192 + awr1) = c1_; } while (0)
        L_LOADA4(asrc, 0, A0, A1, A2, A3); L_LOADB1(Wg, Wu, Wd, 0, B0); L_LOADB1(Wg, Wu, Wd, 1, B1); L_LOADB1(Wg, Wu, Wd, 2, B2); L_LOADA4(asrc, 4, A4, A5, A6, A7);
        for (;;) {
            L_WRITEA(A0, 0); L_WRITEB(B0, 0);
            __syncthreads();
            for (int s = 0; s < 64; s += 8) {
                L_WRITEA(A1, 1); L_STEP1(Wg, Wu, Wd, s + 3, B3, B1, 1, s + 1); __syncthreads();
                L_WRITEA(A2, 0); L_STEP1(Wg, Wu, Wd, s + 4, B0, B2, 0, s + 2); __syncthreads();
                L_WRITEA(A3, 1); L_STEP1(Wg, Wu, Wd, s + 5, B1, B3, 1, s + 3); __syncthreads();
                L_WRITEA(A4, 0); L_LOADA4(asrc, s + 8, A0, A1, A2, A3); L_STEP1(Wg, Wu, Wd, s + 6, B2, B0, 0, s + 4); __syncthreads();
                L_WRITEA(A5, 1); L_STEP1(Wg, Wu, Wd, s + 7, B3, B1, 1, s + 5); __syncthreads();
                L_WRITEA(A6, 0); L_STEP1(Wg, Wu, Wd, s + 8, B0, B2, 0, s + 6); __syncthreads();
                L_WRITEA(A7, 1); L_STEP1(Wg, Wu, Wd, s + 9, B1, B3, 1, s + 7); __syncthreads();
                L_WRITEA(A0, 0); L_LOADA4(asrc, s + 12, A4, A5, A6, A7); L_STEP1(Wg, Wu, Wd, s + 10, B2, B0, 0, s + 8); __syncthreads();
            }
            for (int s = 0; s < 28; s += 4) {
                L_STEP2(s + 3, B3, B1, 1); __syncthreads();
                L_STEP2(s + 4, B0, B2, 0); __syncthreads();
                L_STEP2(s + 5, B1, B3, 1); __syncthreads();
                L_STEP2(s + 6, B2, B0, 0); __syncthreads();
            }
            const int jn = j + G; const bool more = jn < ntiles;
            int en = e, mtn = mt, nrn = nrows; if (more) moe_decode(jn, total, pre, cnt, en, mtn, nrn);
            const int eun = __builtin_amdgcn_readfirstlane(en);
            const __amdgpu_buffer_rsrc_t Wgn = W_RSRC(eun, I_EG, I_SG), Wun = W_RSRC(eun, I_EU, I_SU), Wdn = W_RSRC(eun, I_ED, I_SD);
            const int aslotn = more ? ((LAS const int*)(lds + SLOTS))[(it + 1) * 128 + arow] : aslot;
            const unsigned char* asrcn = H2 + (size_t)((aslotn < 0 ? 0 : aslotn) / NSLOT) * D + 16 * ahalf;
            L_STEP2(31, B3, B1, 1); __syncthreads();
            L_LOADA4(asrcn, 0, A0, A1, A2, A3); L_STEP1(Wgn, Wun, Wdn, 0, B0, B2, 0, 94); __syncthreads();
            L_STEP1(Wgn, Wun, Wdn, 1, B1, B3, 1, 95); __syncthreads();
            L_LOADB1(Wgn, Wun, Wdn, 2, B2); L_LOADA4(asrcn, 4, A4, A5, A6, A7); __syncthreads();
            if (!more) break;
            j = jn; ++it; e = en; mt = mtn; nrows = nrn; Wg = Wgn; Wu = Wun; Wd = Wdn; aslot = aslotn; asrc = asrcn;
        }
#undef L_LOADB1
#undef L_LOADB1P
#undef L_LOAD2P
#undef L_WRITEB1
#undef L_STEP1
#undef L_STEP2
#undef L_SB
#undef W_RSRC
#undef L_LOADA4
#undef L_CVT8
#undef L_LOAD2
#undef L_WRITEB
#undef L_WRITEA
    } else {
        const int wr = wave >> 1, wc = wave & 1;
        int rowm[4], ard[4], brd[8], brdd[8];
#pragma unroll
        for (int m = 0; m < 4; ++m) { rowm[m] = 64 * wr + 16 * m + fr; ard[m] = fq * 2048 + ((rowm[m] ^ (fq << 1)) * 16); }
#pragma unroll
        for (int n = 0; n < 8; ++n) { const int rho = 128 * wc + 16 * n + fr; brd[n] = BSTG + fq * 4096 + ((rho ^ ((rho >> 3) & 3)) * 16); brdd[n] = BSTG + fq * 4096 + ((rho ^ ((rho >> 4) & 3)) * 16); }
        unsigned char* contrib = ws + WS_CONTRIB;
        f32x4 acc[4][8];
#define M_COMPUTE(abase_, buf_, BRD) do { \
            _Pragma("unroll") for (int nh = 0; nh < 2; ++nh) { bf16x8 af_[4], bf_[4]; \
                _Pragma("unroll") for (int m = 0; m < 4; ++m) af_[m] = *(LAS const bf16x8*)(lds + (abase_) + ard[m]); \
                _Pragma("unroll") for (int n = 0; n < 4; ++n) bf_[n] = *(LAS const bf16x8*)(lds + (buf_) * 16384 + BRD[4 * nh + n]); \
                _Pragma("unroll") for (int m = 0; m < 4; ++m) _Pragma("unroll") for (int n = 0; n < 4; ++n) acc[m][4 * nh + n] = mfma16(bf_[n], af_[m], acc[m][4 * nh + n]); } } while (0)
#define M_ZERO() do { _Pragma("unroll") for (int m = 0; m < 4; ++m) _Pragma("unroll") for (int n = 0; n < 8; ++n) acc[m][n] = (f32x4){0.f, 0.f, 0.f, 0.f}; } while (0)
        int it = 0;
        for (int j = vcu; j < ntiles; j += G, ++it) {
            __syncthreads();
            for (int s = 0; s < 64; s += 4) {
                if ((s & 31) == 0) M_ZERO();
                M_COMPUTE(0, 0, brd); __syncthreads();
                M_COMPUTE(8192, 1, brd); __syncthreads();
                M_COMPUTE(0, 0, brd); __syncthreads();
                M_COMPUTE(8192, 1, brd);
                if (s == 28) {
#pragma unroll
                    for (int m = 0; m < 4; ++m)
#pragma unroll
                        for (int n = 0; n < 8; ++n) {
                            const f32x4 gv = acc[m][n];
                            u32x2 w; w.x = cvtpk(silu_f(gv[0]), silu_f(gv[1])); w.y = cvtpk(silu_f(gv[2]), silu_f(gv[3]));
                            const int kc = 16 * wc + 2 * n + (fq >> 1);
                            *(LAS u32x2*)(lds + ACT + kc * 2048 + ((rowm[m] ^ ((kc & 3) << 1)) * 16) + (fq & 1) * 8) = w;
                        }
                } else if (s == 60) {
#pragma unroll
                    for (int m = 0; m < 4; ++m)
#pragma unroll
                        for (int n = 0; n < 8; ++n) {
                            const f32x4 uv = acc[m][n];
                            const int kc = 16 * wc + 2 * n + (fq >> 1);
                            LAS u32x2* ap = (LAS u32x2*)(lds + ACT + kc * 2048 + ((rowm[m] ^ ((kc & 3) << 1)) * 16) + (fq & 1) * 8);
                            const u32x2 g = *ap;
                            u32x2 w; w.x = cvtpk(bflo(g.x) * uv[0], bfhi(g.x) * uv[1]); w.y = cvtpk(bflo(g.y) * uv[2], bfhi(g.y) * uv[3]);
                            *ap = w;
                        }
                }
                __syncthreads();
            }
            for (int s = 0; s < 32; s += 4) {
                if ((s & 7) == 0) M_ZERO();
                M_COMPUTE(ACT + (s & 7) * 8192, 0, brdd); __syncthreads();
                M_COMPUTE(ACT + ((s + 1) & 7) * 8192, 1, brdd); __syncthreads();
                M_COMPUTE(ACT + ((s + 2) & 7) * 8192, 0, brdd); __syncthreads();
                M_COMPUTE(ACT + ((s + 3) & 7) * 8192, 1, brdd);
                if ((s & 7) == 4) {
                    const int q = s >> 3;
#pragma unroll
                    for (int m = 0; m < 4; ++m) {
                        const int slot = ((LAS const int*)(lds + SLOTS))[it * 128 + rowm[m]]; const float gw = ((LAS const float*)(lds + GWO))[it * 128 + rowm[m]];
                        if (slot >= 0) {
                            unsigned char* cp = contrib + (size_t)slot * D + q * 256 + 128 * wc + 16 * fq;
                            const float gs = gw * CONTRIB_SCALE;
#pragma unroll
                            for (int k = 0; k < 2; ++k) {
                                u32x4 w4;
#pragma unroll
                                for (int n = 0; n < 4; ++n) { const f32x4 v = acc[m][4 * k + n] * gs; int w = 0; w = __builtin_amdgcn_cvt_pk_fp8_f32(v[0], v[1], w, false); w = __builtin_amdgcn_cvt_pk_fp8_f32(v[2], v[3], w, true); w4[n] = (unsigned)w; }
                                *(u32x4*)(cp + 64 * k) = w4;
                            }
                        }
                    }
                }
                __syncthreads();
            }
        }
#undef M_COMPUTE
#undef M_ZERO
    }
}

__device__ __forceinline__ void phase_combine(const Args& a, int G) {
    const int tid = threadIdx.x, lane = tid & 63, wave = __builtin_amdgcn_readfirstlane(tid >> 6), blk = blockIdx.x;
    unsigned char* ws = a.ws;
    const bf16* X1 = (const bf16*)(ws + WS_X1); const unsigned char* contrib = ws + WS_CONTRIB; const float* fg = a.in[I_FG];
    for (int t = blk * NWAVES + wave; t < T; t += G * NWAVES) {
        const float* g2 = (const float*)(ws + WS_ADAF) + (t >> 13) * 6144 + 5 * 1024;
        const int c = 16 * lane;
        float sm[16];
#pragma unroll
        for (int i = 0; i < 16; ++i) sm[i] = 0.f;
#pragma unroll
        for (int k = 0; k < NSLOT; ++k) {
            const u32x4 w = *(const u32x4*)(contrib + ((size_t)t * NSLOT + k) * D + c);
#pragma unroll
            for (int q = 0; q < 4; ++q) {
                const f32x2_t lo = __builtin_amdgcn_cvt_pk_f32_fp8((int)w[q], false), hi = __builtin_amdgcn_cvt_pk_f32_fp8((int)w[q], true);
                sm[4 * q] += lo[0]; sm[4 * q + 1] += lo[1]; sm[4 * q + 2] += hi[0]; sm[4 * q + 3] += hi[1];
            }
        }
        const u32x4 xa = *(const u32x4*)(X1 + (size_t)t * D + c), xb = *(const u32x4*)(X1 + (size_t)t * D + c + 8);
        const float x1[16] = {bflo(xa.x), bfhi(xa.x), bflo(xa.y), bfhi(xa.y), bflo(xa.z), bfhi(xa.z), bflo(xa.w), bfhi(xa.w), bflo(xb.x), bfhi(xb.x), bflo(xb.y), bfhi(xb.y), bflo(xb.z), bfhi(xb.z), bflo(xb.w), bfhi(xb.w)};
        f32x4 xv[4]; float ss = 0.f;
#pragma unroll
        for (int h = 0; h < 4; ++h) {
            const f32x4 gg = *(const f32x4*)(g2 + c + 4 * h);
            const f32x4 xx = {x1[4 * h], x1[4 * h + 1], x1[4 * h + 2], x1[4 * h + 3]};
            const f32x4 mv = {sm[4 * h], sm[4 * h + 1], sm[4 * h + 2], sm[4 * h + 3]};
            const f32x4 v = xx + gg * (mv * (1.f / CONTRIB_SCALE)); xv[h] = v; ss += (v[0] * v[0] + v[1] * v[1]) + (v[2] * v[2] + v[3] * v[3]);
        }
        const float r = rsqrtf(wave_sum(ss) * (1.f / D) + 1e-6f);
#pragma unroll
        for (int h = 0; h < 4; ++h) *(f32x4*)(a.out + (size_t)t * D + c + 4 * h) = (xv[h] * r) * *(const f32x4*)(fg + c + 4 * h);
    }
}

constexpr int NPH = 9;
#ifndef N_LAUNCHES
#define N_LAUNCHES 1
#endif
__global__ void __launch_bounds__(NWAVES * 64, 2) mega(Args a) {
    extern __shared__ __attribute__((aligned(16))) unsigned char lds_raw[];
    ldsp lds = (ldsp)lds_raw;
    const int tid = threadIdx.x, G = gridDim.x, bx = blockIdx.x;
    int vcu = (G % 8 == 0) ? (bx % 8) * (G / 8) + bx / 8 : bx;
    unsigned char* ws = a.ws;
    for (int u = tid; u < (LDS_BYTES - MISC_OFF) / 4; u += NWAVES * 64) ((LAS unsigned*)(lds + MISC_OFF))[u] = 0u;
    __syncthreads();
    volatile LAS unsigned* MISC = (volatile LAS unsigned*)(lds + MISC_OFF);
    XcdBarrier bar; bar.bar = (unsigned*)(ws + WS_CTL) + CW_BAR; bar.x = 0; bar.st = nullptr;
    if (N_LAUNCHES == 1) {
        bar = xcd_barrier_post((unsigned*)(ws + WS_CTL) + CW_BAR, MISC + 8);
        if (tid == 0) MISC[16] = atomicAdd((unsigned*)(ws + WS_CTL) + CW_XRANK + 64 * bar.x, 1u);
    }
    const int lo = a.ph_lo, hi = a.ph_hi;
#ifndef PH_MASK
#define PH_MASK 0x1ff
#endif
#define IN(k) (((PH_MASK >> (k)) & 1) && lo <= (k) && (k) < hi)
#define SEAM(k) do { if (IN(k) && IN((k) + 1)) xcd_barrier(bar); } while (0)
#ifndef PH_DUP
#define PH_DUP -1
#endif
#define REP(k) for (int rep_ = 0; rep_ < ((PH_DUP == (k)) ? 2 : 1); ++rep_)
    if (IN(0)) REP(0) { phase_prep(a, lds, G); } SEAM(0);
    if (N_LAUNCHES == 1 && IN(0) && IN(1)) {
        unsigned basex = 0;
        for (unsigned j = 0; j < bar.x; ++j) basex += xb_ld(&bar.bar[XB_XCNT(j)]);
        vcu = (int)(basex + MISC[16]);
    }
    if (IN(1)) REP(1) { phase_hnorm(a, lds, G); } SEAM(1);
    if (IN(2)) REP(2) {
        pg8::Gemm g{(const pg8::bf16_t*)(ws + WS_H), (const pg8::bf16_t*)(ws + WS_WINT), MH, DIN, D};
        WinOrder S; S.init(G, bx);
        EpiWin E{(bf16*)(ws + WS_Z), (bf16*)(ws + WS_KVC), (const float*)(ws + WS_ROPE)};
        pg8::gemm_phase<EpiWin, WinOrder, true, true>(lds, g, S, E);
    } SEAM(2);
    if (IN(3)) REP(3) { phase_mixers(a, lds, G, vcu); } SEAM(3);
    if (IN(4)) REP(4) {
        { pg8::Gemm g{(const pg8::bf16_t*)(ws + WS_A), (const pg8::bf16_t*)(ws + WS_WAT), T, D, 512};
          pg8::StaticOrder S; S.init(T, D, G, bx);
          EpiMergeA E{(const bf16*)(ws + WS_Z), (bf16*)(ws + WS_Y)};
          pg8::gemm_phase<EpiMergeA, pg8::StaticOrder, true, true>(lds, g, S, E); }
        { pg8::Gemm g{(const pg8::bf16_t*)(ws + WS_O), (const pg8::bf16_t*)(ws + WS_WBT), T, D, 512};
          pg8::StaticOrder S; S.init(T, D, G, bx);
          EpiMergeB E{(const bf16*)(ws + WS_Z), (bf16*)(ws + WS_Y)};
          pg8::gemm_phase<EpiMergeB, pg8::StaticOrder, true, true>(lds, g, S, E); }
    } SEAM(4);
    if (IN(5)) REP(5) {
        pg8::Gemm g{(const pg8::bf16_t*)(ws + WS_Y), (const pg8::bf16_t*)(ws + WS_WOT), T, D, D};
        pg8::StaticOrder S; S.init(T, D, G, bx);
        EpiWo E{a.in[I_X], (const float*)(ws + WS_ADAF), (bf16*)(ws + WS_X1)};
        pg8::gemm_phase<EpiWo, pg8::StaticOrder, true, true>(lds, g, S, E);
    } SEAM(5);
    if (IN(6)) { for (int it = vcu; it < T / 64; it += G) router_item(a, lds, it); } SEAM(6);
    if (IN(7)) REP(7) { phase_moe(a, lds, G, vcu); } SEAM(7);
    if (IN(8)) REP(8) { phase_combine(a, G); }
#undef IN
#undef SEAM
}

extern "C" void kernel_launch(void* const* d_in, const int* in_sizes, int n_in, void* d_out, int out_size, void* d_ws, size_t ws_size, hipStream_t stream) {
    static int grid = 0;
    if (grid == 0) {
        if (n_in != 26 || out_size != T * D || ws_size < WS_END) { fprintf(stderr, "kernel_launch: unexpected shapes (n_in %d, out %d, ws %zu)\n", n_in, out_size, ws_size); grid = -1; return; }
        int dev = 0, cus = 0, per_cu = 0;
        (void)hipGetDevice(&dev); (void)hipDeviceGetAttribute(&cus, hipDeviceAttributeMultiprocessorCount, dev);
        (void)hipFuncSetAttribute((const void*)mega, hipFuncAttributeMaxDynamicSharedMemorySize, LDS_BYTES);
        (void)hipOccupancyMaxActiveBlocksPerMultiprocessor(&per_cu, (const void*)mega, NWAVES * 64, LDS_BYTES);
        (void)hipGetLastError();
        if (per_cu < 1) { fprintf(stderr, "kernel_launch: occupancy query says %d blocks per CU\n", per_cu); per_cu = 1; }
        if (cus * MOE_MAXT < T * 8 / 128 + NEXP + T / 128) { fprintf(stderr, "kernel_launch: %d CUs are too few for the expert tile tables\n", cus); grid = -1; return; }
        grid = cus;
    }
    if (grid < 0) return;
    (void)hipMemsetAsync((char*)d_ws + WS_CTL, 0, CTL_ZERO_BYTES, stream);
    Args a{};
    for (int i = 0; i < 26; ++i) a.in[i] = (const float*)d_in[i];
    a.out = (float*)d_out; a.ws = (unsigned char*)d_ws;
    if (N_LAUNCHES == 1) {
        a.ph_lo = 0; a.ph_hi = NPH;
        void* kargs[] = {&a};
        hipError_t e = hipLaunchCooperativeKernel((const void*)mega, dim3(grid), dim3(NWAVES * 64), kargs, LDS_BYTES, stream);
        if (e != hipSuccess) fprintf(stderr, "kernel_launch: cooperative launch failed: %s (grid %d)\n", hipGetErrorString(e), grid);
    } else {
#ifndef HOST_DUP
#define HOST_DUP -1
#endif
        for (int li = 0; li < NPH; ++li) {
            a.ph_lo = li; a.ph_hi = li + 1;
            hipLaunchKernelGGL(mega, dim3(grid), dim3(NWAVES * 64), LDS_BYTES, stream, a);
            if (li == HOST_DUP) {
                if (li == 6) (void)hipMemsetAsync((char*)d_ws + WS_CTL, 0, CTL_ZERO_BYTES, stream);
                hipLaunchKernelGGL(mega, dim3(grid), dim3(NWAVES * 64), LDS_BYTES, stream, a);
            }
        }
    }
}
```

```cpp
#include <hip/hip_runtime.h>
#include <cstdio>
#include <cstdint>
#include <type_traits>
namespace pg8 {
#define PG8_LAS __attribute__((address_space(3)))
typedef unsigned short bf16_t;
typedef short bf16x8 __attribute__((ext_vector_type(8)));
typedef float f32x4 __attribute__((ext_vector_type(4)));
typedef unsigned u32x4 __attribute__((ext_vector_type(4)));
constexpr int BM = 256, BK = 64, HALF = 128, HTB = HALF * BK * 2  , STAGE_BYTES = 8 * HTB, NXCD = 8, WGM = 8;

__host__ __device__ __forceinline__ int lds_byte(int r, int c) { const int st = (r >> 4) * 2 + (c >> 5), rr = r & 15, cc = c & 31, ob = rr * 64 + cc * 2; return st * 1024 + (ob ^ (((ob >> 9) & 1) << 5)); }
__host__ __device__ __forceinline__ void stage_rc(int b, int& R, int& C) { const int st = b / 1024, sb = b % 1024, swz = sb ^ (((sb >> 9) & 1) << 5); R = (st >> 1) * 16 + swz / 64; C = (st & 1) * 32 + (swz % 64) / 2; }
__host__ __device__ __forceinline__ int perm32(int rho) { const int n = rho >> 4, i = rho & 15; return 8 * (i >> 2) + 4 * n + (i & 3); }

struct Unit { int pm, pn; };
struct Gemm { const bf16_t* A; const bf16_t* Bt; int M, N, K; };

struct StaticOrder {
    int nM, nN, nwg, G, c;
    __host__ __device__ void init(int M, int N, int G_, int c_) { nM = M / BM; nN = N / BM; nwg = nM * nN; G = G_; c = c_; }
    __host__ __device__ bool next(int i, Unit& u) const {
        const long L = (long)i * G + c; if (L >= nwg) return false;
        int wgid = (int)L; { const int q = nwg / NXCD, r = nwg % NXCD, xcd = wgid % NXCD, off = wgid / NXCD; wgid = (xcd < r ? xcd * (q + 1) : r * (q + 1) + (xcd - r) * q) + off; }
        const int nig = WGM * nN, gid = wgid / nig, fm = gid * WGM, gsz = (nM - fm) < WGM ? (nM - fm) : WGM;
        u.pm = fm + ((wgid % nig) % gsz); u.pn = (wgid % nig) / gsz; return true;
    }
    __device__ __forceinline__ void a_ready(const Unit&) const {}
    __device__ __forceinline__ void done(const Unit&) const {}
};

__device__ __forceinline__ unsigned cvt_pk_bf16(float lo, float hi) { unsigned r; asm volatile("v_cvt_pk_bf16_f32 %0, %1, %2" : "=v"(r) : "v"(lo), "v"(hi)); return r; }
template <class Epi, class Sched, bool ALIGN_EPI = false, bool SP2 = false>
__device__ __forceinline__ void gemm_phase(PG8_LAS unsigned char* lds, const Gemm g, const Sched& S, const Epi& E) {
    const int tid = threadIdx.x, wid = __builtin_amdgcn_readfirstlane(tid >> 6), lane = tid & 63, wr = wid >> 2, wc = wid & 3, fr = lane & 15, fq = lane >> 4;
    const int K = g.K, nt = K / BK;
    unsigned voffA[2], voffB[2];
#pragma unroll
    for (int i = 0; i < 2; ++i) { int R, C; stage_rc(tid * 16 + i * 8192, R, C); const int Rb = Epi::PERM ? ((R & ~31) + perm32(R & 31)) : R;
        voffA[i] = (unsigned)(R * K + C) * 2u; voffB[i] = (unsigned)(Rb * K + C) * 2u; }
    const size_t kstep = (size_t)(BK * 2);
    const size_t hstep = (size_t)HALF * K * 2;
    const size_t tstep = 2 * hstep;
    const unsigned ldsw = (unsigned)wid * 1024u;
    const int aoff = lds_byte(wr * 64 + fr, fq * 8), boff = lds_byte(wc * 32 + fr, fq * 8);
#define PG8_SA(b, h) (((b) * 2 + (h)) * HTB)
#define PG8_SB(b, h) ((4 + (b) * 2 + (h)) * HTB)
#define PG8_STAGE(bufoff, gbase, voff) do { _Pragma("unroll") for (int _i = 0; _i < 2; ++_i) \
        __builtin_amdgcn_global_load_lds((const unsigned*)((const char*)(gbase) + (voff)[_i]), (PG8_LAS unsigned*)(lds + (bufoff) + ldsw + _i * 8192), 16, 0, 0); } while (0)
#define PG8_LDA(dst, b, h) do { _Pragma("unroll") for (int m = 0; m < 4; ++m) _Pragma("unroll") for (int k = 0; k < 2; ++k) dst[m][k] = *(const PG8_LAS bf16x8*)(lds + PG8_SA(b, h) + aoff + m * 2048 + k * 1024); } while (0)
#define PG8_LDB(dst, b, h) do { _Pragma("unroll") for (int n = 0; n < 2; ++n) _Pragma("unroll") for (int k = 0; k < 2; ++k) dst[n][k] = *(const PG8_LAS bf16x8*)(lds + PG8_SB(b, h) + boff + n * 2048 + k * 1024); } while (0)
#define PG8_MMA(ai, bj, At, Bt) do { __builtin_amdgcn_s_setprio(1); _Pragma("unroll") for (int m = 0; m < 4; ++m) _Pragma("unroll") for (int n = 0; n < 2; ++n) _Pragma("unroll") for (int k = 0; k < 2; ++k) \
        acc[ai][bj][m][n] = __builtin_amdgcn_mfma_f32_16x16x32_bf16(Bt[n][k], At[m][k], acc[ai][bj][m][n], 0, 0, 0); __builtin_amdgcn_s_setprio(0); } while (0)
#define PG8_WAIT_V(n) asm volatile("s_waitcnt vmcnt(" #n ")" ::: "memory")
#define PG8_WAIT_L(n) asm volatile("s_waitcnt lgkmcnt(" #n ")" ::: "memory")
#define PG8_BAR __builtin_amdgcn_s_barrier()
#define PG8_SCHED __builtin_amdgcn_sched_barrier(0)
    Unit cur, nxt; int ui = 0;
    if (!S.next(0, cur)) return;
    f32x4 acc[2][2][4][2];
#pragma unroll
    for (int a = 0; a < 2; ++a)
#pragma unroll
        for (int b = 0; b < 2; ++b)
#pragma unroll
            for (int m = 0; m < 4; ++m)
#pragma unroll
                for (int n = 0; n < 2; ++n) acc[a][b][m][n] = (f32x4){0.f, 0.f, 0.f, 0.f};
    bf16x8 At[4][2], B0[2][2], B1[2][2];
    const char* cA = (const char*)g.A + (size_t)cur.pm * tstep; const char* cB = (const char*)g.Bt + (size_t)cur.pn * tstep;
    S.a_ready(cur);
    if constexpr (SP2) {
        PG8_STAGE(PG8_SB(0, 0), cB, voffB); PG8_STAGE(PG8_SB(0, 1), cB + hstep, voffB); PG8_STAGE(PG8_SA(0, 0), cA, voffA); PG8_STAGE(PG8_SA(0, 1), cA + hstep, voffA);
        if (wr == 1) PG8_BAR;
        PG8_WAIT_V(2); PG8_BAR;
        PG8_STAGE(PG8_SB(1, 0), cB + kstep, voffB); PG8_STAGE(PG8_SA(1, 0), cA + kstep, voffA); PG8_STAGE(PG8_SB(1, 1), cB + hstep + kstep, voffB);
        PG8_WAIT_V(6); PG8_BAR;
    } else {
        PG8_STAGE(PG8_SB(0, 0), cB, voffB); PG8_STAGE(PG8_SA(0, 0), cA, voffA); PG8_STAGE(PG8_SB(0, 1), cB + hstep, voffB); PG8_STAGE(PG8_SA(0, 1), cA + hstep, voffA);
        if (wr == 1) PG8_BAR;
        PG8_WAIT_V(4); PG8_BAR;
        PG8_STAGE(PG8_SB(1, 0), cB + kstep, voffB); PG8_STAGE(PG8_SA(1, 0), cA + kstep, voffA); PG8_STAGE(PG8_SB(1, 1), cB + hstep + kstep, voffB);
        PG8_WAIT_V(6); PG8_BAR;
    }
    for (;;) {
        const bool has_next = S.next(ui + 1, nxt);
        const char* nA = has_next ? (const char*)g.A + (size_t)nxt.pm * tstep : cA; const char* nB = has_next ? (const char*)g.Bt + (size_t)nxt.pn * tstep : cB;
        for (int t = 0; t < nt; t += 2) {
            const bool last = (t == nt - 2);
            const char* a1 = cA + (size_t)(t + 1) * kstep;
            const char* a2 = last ? nA : cA + (size_t)(t + 2) * kstep; const char* b2 = last ? nB : cB + (size_t)(t + 2) * kstep;
            const char* a3 = a2 + kstep; const char* b3 = b2 + kstep;
            if (last && has_next) S.a_ready(nxt);
            if constexpr (SP2) {
            PG8_LDB(B0, 0, 0); PG8_LDB(B1, 0, 1); PG8_SCHED; PG8_LDA(At, 0, 0); PG8_STAGE(PG8_SA(1, 1), a1 + hstep, voffA);
            PG8_WAIT_V(8); PG8_WAIT_L(0); PG8_BAR; PG8_MMA(0, 0, At, B0); PG8_MMA(0, 1, At, B1); PG8_BAR; PG8_SCHED;
            PG8_LDA(At, 0, 1); PG8_STAGE(PG8_SB(0, 0), b2, voffB); PG8_STAGE(PG8_SB(0, 1), b2 + hstep, voffB); PG8_STAGE(PG8_SA(0, 0), a2, voffA);
            PG8_WAIT_V(8); PG8_WAIT_L(0); PG8_BAR; PG8_MMA(1, 0, At, B0); PG8_MMA(1, 1, At, B1); PG8_BAR; PG8_SCHED;
            PG8_LDB(B0, 1, 0); PG8_LDB(B1, 1, 1); PG8_SCHED; PG8_LDA(At, 1, 0); PG8_STAGE(PG8_SA(0, 1), a2 + hstep, voffA);
            PG8_WAIT_V(8); PG8_WAIT_L(0); PG8_BAR; PG8_MMA(0, 0, At, B0); PG8_MMA(0, 1, At, B1); PG8_BAR; PG8_SCHED;
            PG8_LDA(At, 1, 1); PG8_STAGE(PG8_SB(1, 0), b3, voffB); PG8_STAGE(PG8_SB(1, 1), b3 + hstep, voffB); PG8_STAGE(PG8_SA(1, 0), a3, voffA);
            PG8_WAIT_V(8); PG8_WAIT_L(0); PG8_BAR; PG8_MMA(1, 0, At, B0); PG8_MMA(1, 1, At, B1); PG8_BAR; PG8_SCHED;
            } else {
            PG8_LDB(B0, 0, 0); PG8_SCHED; PG8_LDA(At, 0, 0); PG8_STAGE(PG8_SA(1, 1), a1 + hstep, voffA);
            PG8_WAIT_L(8); PG8_BAR; PG8_WAIT_L(0); PG8_MMA(0, 0, At, B0); PG8_BAR; PG8_SCHED;
            PG8_LDB(B1, 0, 1); PG8_STAGE(PG8_SB(0, 0), b2, voffB);
            PG8_BAR; PG8_WAIT_L(0); PG8_MMA(0, 1, At, B1); PG8_BAR;
            PG8_LDA(At, 0, 1); PG8_STAGE(PG8_SA(0, 0), a2, voffA);
            PG8_BAR; PG8_WAIT_L(0); PG8_MMA(1, 0, At, B0); PG8_BAR; PG8_SCHED;
            PG8_STAGE(PG8_SB(0, 1), b2 + hstep, voffB);
            PG8_WAIT_V(6); PG8_BAR; PG8_MMA(1, 1, At, B1); PG8_BAR;
            PG8_LDB(B0, 1, 0); PG8_SCHED; PG8_LDA(At, 1, 0); PG8_STAGE(PG8_SA(0, 1), a2 + hstep, voffA);
            PG8_WAIT_L(8); PG8_BAR; PG8_WAIT_L(0); PG8_MMA(0, 0, At, B0); PG8_BAR; PG8_SCHED;
            PG8_LDB(B1, 1, 1); PG8_STAGE(PG8_SB(1, 0), b3, voffB);
            PG8_BAR; PG8_WAIT_L(0); PG8_MMA(0, 1, At, B1); PG8_BAR;
            PG8_LDA(At, 1, 1); PG8_STAGE(PG8_SA(1, 0), a3, voffA);
            PG8_BAR; PG8_WAIT_L(0); PG8_MMA(1, 0, At, B0); PG8_BAR; PG8_SCHED;
            PG8_STAGE(PG8_SB(1, 1), b3 + hstep, voffB);
            PG8_WAIT_V(6); PG8_BAR; PG8_MMA(1, 1, At, B1); PG8_BAR;
            }
        }
        if constexpr (ALIGN_EPI) { if (wr == 0) PG8_BAR; }
        if constexpr (!Epi::AFTER_DRAIN) { E(acc, cur, wr, wc, fr, fq); S.done(cur); }
        if (!has_next) break;
#pragma unroll
        for (int a = 0; a < 2; ++a)
#pragma unroll
            for (int b = 0; b < 2; ++b)
#pragma unroll
                for (int m = 0; m < 4; ++m)
#pragma unroll
                    for (int n = 0; n < 2; ++n) acc[a][b][m][n] = (f32x4){0.f, 0.f, 0.f, 0.f};
        cur = nxt; cA = nA; cB = nB; ++ui;
        if constexpr (ALIGN_EPI) { if (wr == 1) PG8_BAR; }
    }
    PG8_WAIT_V(0);
    if constexpr (!ALIGN_EPI) { if (wr == 0) PG8_BAR; }
    PG8_BAR;
    if constexpr (Epi::AFTER_DRAIN) { E.fused(acc, cur, wr, wc, fr, fq, lds, wid, lane); S.done(cur); }
#undef PG8_SA
#undef PG8_SB
#undef PG8_STAGE
#undef PG8_LDA
#undef PG8_LDB
#undef PG8_MMA
#undef PG8_WAIT_V
#undef PG8_WAIT_L
#undef PG8_BAR
#undef PG8_SCHED
}
}
#define GAS __attribute__((address_space(1)))
#define LAS __attribute__((address_space(3)))
typedef unsigned short bf16;
typedef unsigned v4u __attribute__((ext_vector_type(4)));
typedef float f32x4 __attribute__((ext_vector_type(4)));
typedef short bf16x8 __attribute__((ext_vector_type(8)));
typedef GAS unsigned gu32;
typedef GAS unsigned long long gu64;
#define RLX_AGENT __ATOMIC_RELAXED, __HIP_MEMORY_SCOPE_AGENT
#define LDS_WAIT() asm volatile("s_waitcnt lgkmcnt(0)" ::: "memory")
#define VM_WAIT() asm volatile("s_waitcnt vmcnt(0)" ::: "memory")
__device__ __forceinline__ unsigned long long rt() { return __builtin_amdgcn_s_memrealtime(); }
__device__ __forceinline__ unsigned f2bf(float f) { unsigned u = __builtin_bit_cast(unsigned, f); return (u + 0x7fffu + ((u >> 16) & 1u)) >> 16; }
__device__ __forceinline__ unsigned pk2(float lo, float hi) { return f2bf(lo) | (f2bf(hi) << 16); }

#define XB_TMO      128
#define XB_XCNT(j)  (256  + 64 * (j))
#define XB_XSUB(j)  (1280 + 64 * (j))
#define XB_XGEN(j)  (2304 + 64 * (j))
#define XB_TOP      3328
#define XB_TOPGEN   3392
#define XCD_BAR_WORDS 3456
#define XB_SPIN_CAP (1u << 18)

__device__ __forceinline__ unsigned xb_ld(unsigned* p)              { return __hip_atomic_load(p, __ATOMIC_RELAXED, __HIP_MEMORY_SCOPE_AGENT); }
__device__ __forceinline__ unsigned xb_add(unsigned* p, unsigned v) { return __hip_atomic_fetch_add(p, v, __ATOMIC_RELAXED, __HIP_MEMORY_SCOPE_AGENT); }
__device__ __forceinline__ unsigned xb_xcc_id() { return (unsigned)__builtin_amdgcn_s_getreg((3 << 11) | 20) & 0xFu; }
#define XB_SPIN(cond, bar) do { unsigned _sp = 0; while (cond) { __builtin_amdgcn_s_sleep(1); \
    if ((++_sp & 255u) == 0u) { if (xb_ld(&(bar)[XB_TMO])) break; if (_sp > XB_SPIN_CAP) { atomicAdd(&(bar)[XB_TMO], 1u); break; } } } } while (0)

struct XcdBarrier {
    unsigned* bar; unsigned x;
    volatile LAS unsigned* st;
};

__device__ __forceinline__ XcdBarrier xcd_barrier_post(unsigned* bar, volatile LAS unsigned* st) {
    XcdBarrier b; b.bar = bar; b.x = xb_xcc_id(); b.st = st;
    if (threadIdx.x == 0) (void)xb_add(&bar[XB_XCNT(b.x)], 1u);
    return b;
}
__device__ __forceinline__ void xcd_barrier_complete(unsigned* bar, unsigned x, unsigned& nloc, unsigned& nx) {
    const unsigned G = gridDim.x * gridDim.y * gridDim.z;
    unsigned sum, cnt, mine, sp = 0u;
    for (;;) {
        sum = 0u; cnt = 0u; mine = 0u;
#pragma unroll
        for (unsigned j = 0; j < 16; ++j) { const unsigned c = xb_ld(&bar[XB_XCNT(j)]); sum += c; cnt += (c > 0u) ? 1u : 0u; mine = (j == x) ? c : mine; }
        if (sum == G) break;
        __builtin_amdgcn_s_sleep(1);
        if ((++sp & 255u) == 0u) { if (xb_ld(&bar[XB_TMO])) break; if (sp > XB_SPIN_CAP) { atomicAdd(&bar[XB_TMO], 1u); break; } }
    }
    nloc = mine > 0u ? mine : 1u; nx = cnt > 0u ? cnt : 1u;
}

__device__ __forceinline__ void xcd_barrier(const XcdBarrier& b) {
    asm volatile("s_waitcnt vmcnt(0)" ::: "memory");
    __syncthreads();
    if (threadIdx.x == 0) {
        unsigned* bar = b.bar;
        __builtin_amdgcn_s_waitcnt(0);
        unsigned nloc = b.st[0], nx = b.st[1];
        if (nloc == 0u) { xcd_barrier_complete(bar, b.x, nloc, nx); b.st[0] = nloc; b.st[1] = nx; }
        const unsigned old = xb_add(&bar[XB_XSUB(b.x)], 1u);
        const unsigned gen = old / nloc;
        if (old + 1u == (gen + 1u) * nloc) {
            __builtin_amdgcn_fence(__ATOMIC_RELEASE, "agent");
            asm volatile("s_waitcnt vmcnt(0)" ::: "memory");
            const unsigned og = xb_add(&bar[XB_TOP], 1u);
            const unsigned tg = og / nx;
            if (og + 1u == (tg + 1u) * nx) xb_add(&bar[XB_TOPGEN], 1u);
            else XB_SPIN(xb_ld(&bar[XB_TOPGEN]) == tg, bar);
            __builtin_amdgcn_fence(__ATOMIC_ACQUIRE, "agent");
            xb_add(&bar[XB_XGEN(b.x)], 1u);
            asm volatile("s_waitcnt vmcnt(0)" ::: "memory");
        } else {
            XB_SPIN(xb_ld(&bar[XB_XGEN(b.x)]) == gen, bar);
            __builtin_amdgcn_fence(__ATOMIC_ACQUIRE, "agent");
            asm volatile("s_waitcnt vmcnt(0)" ::: "memory");
        }
    }
    __syncthreads();
}

constexpr int T = 16384, D = 1024, SEQ = 8192, NCTX = 256, TCX = 512, DIN = 3840, MH = T + TCX;
constexpr int ZU = 0, ZV = 512, ZQ = 1024, ZK = 1536, ZVA = 1664, ZGA = 1792, ZGB = 2816;
constexpr int NEXP = 256, NSLOT = 9, LISTCAP = 16384, MOE_MAXT = 8;
constexpr float LOG2E = 1.4426950408889634f;
constexpr float QSCALE = 0.125f * LOG2E;
constexpr size_t MiB = 1u << 20;
constexpr size_t WS_CTL = 0, CTL_ZERO_BYTES = 1 * MiB;
constexpr size_t WS_ADAP = 1 * MiB;
constexpr size_t WS_ADAF = 2 * MiB;
constexpr size_t WS_ROPE = 2 * MiB + 128 * 1024;
constexpr size_t WS_WST = 2 * MiB + 256 * 1024;
constexpr size_t WS_RWT = 3 * MiB;
constexpr size_t WS_WINT = 4 * MiB;
constexpr size_t WS_WAT = 12 * MiB, WS_WBT = 13 * MiB, WS_WOT = 14 * MiB;
constexpr size_t WS_KVC = 16 * MiB;
constexpr size_t WS_GATEW = 17 * MiB;
constexpr size_t WS_H = 18 * MiB;
constexpr size_t WS_Z = 52 * MiB;
constexpr size_t WS_A = 172 * MiB, WS_O = 188 * MiB;
constexpr size_t WS_TMP = 204 * MiB;
constexpr size_t WS_Y = 268 * MiB;
constexpr size_t WS_X1 = 300 * MiB;
constexpr size_t WS_H2 = 364 * MiB;
constexpr size_t WS_LIST = 396 * MiB;
constexpr size_t WS_CONTRIB = 414 * MiB;
constexpr float CONTRIB_SCALE = 16.f;
constexpr size_t WS_END = 704 * MiB;
constexpr int CW_BAR = 4096;
constexpr int CW_CNT = 16384;
constexpr int CW_XRANK = 32768;
constexpr int SCR_BYTES = 148480;
constexpr int MISC_OFF = SCR_BYTES;
constexpr int LDS_BYTES = 152 * 1024;
constexpr int NWAVES = 8;

typedef float f32x2_t __attribute__((ext_vector_type(2)));
typedef __bf16 bf16x2_t __attribute__((ext_vector_type(2)));
typedef float f32x16 __attribute__((ext_vector_type(16)));
typedef short s16x4 __attribute__((ext_vector_type(4)));
typedef short v4i16_t __attribute__((ext_vector_type(4)));
typedef unsigned u32x2 __attribute__((ext_vector_type(2)));
typedef unsigned u32x4 __attribute__((ext_vector_type(4)));
typedef LAS unsigned char* ldsp;

__device__ __forceinline__ unsigned cvtpk(float lo, float hi) { f32x2_t v = {lo, hi}; bf16x2_t b = __builtin_convertvector(v, bf16x2_t); return __builtin_bit_cast(unsigned, b); }
__device__ __forceinline__ float bf2f(unsigned short u) { return __uint_as_float((unsigned)u << 16); }
__device__ __forceinline__ float bflo(unsigned w) { return __uint_as_float(w << 16); }
__device__ __forceinline__ float bfhi(unsigned w) { return __uint_as_float(w & 0xffff0000u); }
__device__ __forceinline__ float wave_sum(float v) {
#pragma unroll
    for (int o = 1; o < 64; o <<= 1) v += __shfl_xor(v, o);
    return v;
}
__device__ __forceinline__ float sigmoid_f(float x) { return __builtin_amdgcn_rcpf(1.f + __builtin_amdgcn_exp2f(-x * LOG2E)); }
__device__ __forceinline__ float silu_f(float x) { return x * sigmoid_f(x); }
__device__ __forceinline__ float gelu_f(float x) { const float u = 0.7978845608028654f * (x + 0.044715f * x * x * x); return x * sigmoid_f(2.f * u); }
__device__ __forceinline__ f32x16 mfma32(bf16x8 a, bf16x8 b, f32x16 c) { return __builtin_amdgcn_mfma_f32_32x32x16_bf16(a, b, c, 0, 0, 0); }
__device__ __forceinline__ f32x4 mfma16(bf16x8 a, bf16x8 b, f32x4 c) { return __builtin_amdgcn_mfma_f32_16x16x32_bf16(a, b, c, 0, 0, 0); }

struct Args { const float* in[26]; float* out; unsigned char* ws; int ph_lo, ph_hi; };
enum { I_X = 0, I_C, I_CTX, I_CCTX, I_ADAW, I_ADAB, I_N1G, I_N2G, I_WIN, I_LNG, I_LNB, I_GWS, I_GBS, I_SINK, I_WA, I_WB, I_WO, I_RW, I_RB, I_EG, I_EU, I_ED, I_SG, I_SU, I_SD, I_FG };

__device__ __forceinline__ void p0_transpose_item(const float* W, int K, int N, bf16* WT, LAS float* scr, int item, int lane) {
    const int nblk = N / 32, kb = item / nblk, nb = item % nblk, k0 = 64 * kb, n0 = 32 * nb;
#pragma unroll 8
    for (int i = 0; i < 32; ++i) { const int kk = 2 * i + (lane >> 5); scr[kk * 33 + (lane & 31)] = W[(size_t)(k0 + kk) * N + n0 + (lane & 31)]; }
    LDS_WAIT(); asm volatile("" ::: "memory");
    const int c = lane & 7;
#pragma unroll
    for (int j = 0; j < 4; ++j) { const int n = (lane >> 3) + 8 * j; const LAS float* s = scr + (8 * c) * 33 + n;
        v4u o; o.x = pk2(s[0 * 33], s[1 * 33]); o.y = pk2(s[2 * 33], s[3 * 33]); o.z = pk2(s[4 * 33], s[5 * 33]); o.w = pk2(s[6 * 33], s[7 * 33]);
        *(GAS v4u*)(WT + (size_t)(n0 + n) * K + k0 + 8 * c) = o; }
    LDS_WAIT(); asm volatile("" ::: "memory");
}

__device__ __forceinline__ void phase_prep(const Args& a, ldsp lds, int G) {
    const int tid = threadIdx.x, lane = tid & 63, wave = __builtin_amdgcn_readfirstlane(tid >> 6), blk = blockIdx.x;
    unsigned char* ws = a.ws;
    if (blk < 192) {
        const int cb = blk % 24, kc = blk / 24, col = cb * 256 + lane * 4, k0 = kc * 128 + wave * 16;
        const float* c = a.in[I_C]; const float* cc = a.in[I_CCTX]; const float* aw = a.in[I_ADAW];
        f32x4 a0 = {0.f, 0.f, 0.f, 0.f}, a1 = a0, a2 = a0;
#pragma unroll 4
        for (int k = 0; k < 16; ++k) {
            const int kk = k0 + k;
            const float s0 = silu_f(c[kk]), s1 = silu_f(c[1024 + kk]), s2 = silu_f(cc[kk]);
            const f32x4 w = *(const f32x4*)(aw + (size_t)kk * 6144 + col);
            a0 += w * s0; a1 += w * s1; a2 += w * s2;
        }
        LAS float* red = (LAS float*)lds;
        *(LAS f32x4*)(red + (wave * 3 + 0) * 256 + lane * 4) = a0;
        *(LAS f32x4*)(red + (wave * 3 + 1) * 256 + lane * 4) = a1;
        *(LAS f32x4*)(red + (wave * 3 + 2) * 256 + lane * 4) = a2;
        __syncthreads();
        float* adap = (float*)(ws + WS_ADAP);
        for (int idx = tid; idx < 768; idx += 512) {
            const int v = idx >> 8, cl = idx & 255; float s = 0.f;
#pragma unroll
            for (int w = 0; w < 8; ++w) s += red[(w * 3 + v) * 256 + cl];
            adap[(size_t)(kc * 3 + v) * 6144 + cb * 256 + cl] = s;
        }
        __syncthreads();
    }
    {
        LAS float* scr = (LAS float*)(lds + wave * 8704);
        const int gw = blk * NWAVES + wave, NGW = G * NWAVES;
        constexpr int I_1 = 16 * 120, I_2 = 8 * 32, I_3 = 8 * 32, I_4 = 16 * 32, I_5 = 16 * 8;
        for (int it = gw; it < I_1 + I_2 + I_3 + I_4 + I_5; it += NGW) {
            int r = it;
            if (r < I_1) { p0_transpose_item(a.in[I_WIN], 1024, 3840, (bf16*)(ws + WS_WINT), scr, r, lane); continue; } r -= I_1;
            if (r < I_2) { p0_transpose_item(a.in[I_WA], 512, 1024, (bf16*)(ws + WS_WAT), scr, r, lane); continue; } r -= I_2;
            if (r < I_3) { p0_transpose_item(a.in[I_WB], 512, 1024, (bf16*)(ws + WS_WBT), scr, r, lane); continue; } r -= I_3;
            if (r < I_4) { p0_transpose_item(a.in[I_WO], 1024, 1024, (bf16*)(ws + WS_WOT), scr, r, lane); continue; } r -= I_4;
            p0_transpose_item(a.in[I_RW], 1024, 256, (bf16*)(ws + WS_RWT), scr, r, lane);
        }
    }
    {
        const int gt = blk * 512 + tid, NT = G * 512;
        const float* gws = a.in[I_GWS]; bf16* wst = (bf16*)(ws + WS_WST);
        for (int i = gt; i < 8192; i += NT) {
            const f32x4 x0 = *(const f32x4*)(gws + i * 8), x1 = *(const f32x4*)(gws + i * 8 + 4);
            v4u o; o.x = cvtpk(x0[0], x0[1]); o.y = cvtpk(x0[2], x0[3]); o.z = cvtpk(x1[0], x1[1]); o.w = cvtpk(x1[2], x1[3]);
            *(v4u*)(wst + i * 8) = o;
        }
        float* rope = (float*)(ws + WS_ROPE);
        for (int i = gt; i < 2048; i += NT) {
            const int pos = i >> 4, f = i & 15;
            const float inv = __builtin_amdgcn_exp2f(-(float)f * (13.287712379549449f / 16.f));
            const float ang = (float)pos * inv;
            double rev = (double)ang * 0.15915494309189535; rev -= floor(rev);
            rope[pos * 32 + f] = __builtin_amdgcn_cosf((float)rev);
            rope[pos * 32 + 16 + f] = __builtin_amdgcn_sinf((float)rev);
        }
    }
}

__device__ __forceinline__ void phase_hnorm(const Args& a, ldsp lds, int G) {
    const int tid = threadIdx.x, lane = tid & 63, wave = __builtin_amdgcn_readfirstlane(tid >> 6), blk = blockIdx.x;
    unsigned char* ws = a.ws;
    const float* adap = (const float*)(ws + WS_ADAP); const float* adab = a.in[I_ADAB];
    LAS float* modv = (LAS float*)lds;
    {
        const int j = 4 * tid;
        f32x4 pv[3][9];
#pragma unroll
        for (int v = 0; v < 3; ++v) {
            pv[v][0] = *(const f32x4*)(adab + j);
#pragma unroll
            for (int kc = 0; kc < 8; ++kc) pv[v][kc + 1] = *(const f32x4*)(adap + (size_t)(kc * 3 + v) * 6144 + j);
        }
#pragma unroll
        for (int v = 0; v < 3; ++v) {
            f32x4 s = pv[v][0];
#pragma unroll
            for (int kc = 0; kc < 8; ++kc) s = s + pv[v][kc + 1];
            if (j >= 1024) s = s + (f32x4){1.f, 1.f, 1.f, 1.f};
            *(LAS f32x4*)(modv + v * 2048 + j) = s;
        }
    }
    { float* adaf = (float*)(ws + WS_ADAF);
      for (int idx = blk * 512 + tid; idx < 3 * 6144; idx += G * 512) {
          const int v = idx / 6144, j = idx % 6144; float s = adab[j];
#pragma unroll
          for (int kc = 0; kc < 8; ++kc) s += adap[(size_t)(kc * 3 + v) * 6144 + j];
          adaf[idx] = s; } }
    __syncthreads();
    const float* g1 = a.in[I_N1G]; bf16* H = (bf16*)(ws + WS_H);
    for (int t = blk * NWAVES + wave; t < MH; t += G * NWAVES) {
        const float* xr = (t < T) ? a.in[I_X] + (size_t)t * D : a.in[I_CTX] + (size_t)(t - T) * D;
        const int v = (t < T) ? (t >> 13) : 2;
        f32x4 x[4]; float ss = 0.f;
#pragma unroll
        for (int j = 0; j < 4; ++j) { x[j] = *(const f32x4*)(xr + 4 * lane + 256 * j); ss += (x[j][0] * x[j][0] + x[j][1] * x[j][1]) + (x[j][2] * x[j][2] + x[j][3] * x[j][3]); }
        const float r = rsqrtf(wave_sum(ss) * (1.f / D) + 1e-6f);
#pragma unroll
        for (int j = 0; j < 4; ++j) {
            const int col = 4 * lane + 256 * j;
            const f32x4 g = *(const f32x4*)(g1 + col);
            const f32x4 sh = *(LAS f32x4*)(modv + v * 2048 + col), sc = *(LAS f32x4*)(modv + v * 2048 + 1024 + col);
            const f32x4 h = (x[j] * r) * g * sc + sh;
            u32x2 o; o.x = cvtpk(h[0], h[1]); o.y = cvtpk(h[2], h[3]);
            *(u32x2*)(H + (size_t)t * D + col) = o;
        }
    }
}

struct WinOrder {
    pg8::StaticOrder so;
    __device__ void init(int G, int c) { so.init(T, DIN, G, c); }
    __device__ bool next(int i, pg8::Unit& u) const {
        const long L = (long)i * so.G + so.c;
        if (L < 960) return so.next(i, u);
        if (L < 962) { u.pm = 64 + (int)(L - 960); u.pn = 6; return true; }
        return false;
    }
    __device__ __forceinline__ void a_ready(const pg8::Unit&) const {}
    __device__ __forceinline__ void done(const pg8::Unit&) const {}
};
struct EpiWin {
    static constexpr bool PERM = false, AFTER_DRAIN = false;
    bf16* Z; bf16* KVC; const float* rope;
    __device__ __forceinline__ void operator()(const pg8::f32x4 (&acc)[2][2][4][2], const pg8::Unit& u, int wr, int wc, int fr, int fq) const {
        const int row0 = u.pm * 256 + wr * 64 + fr, colb = u.pn * 256 + wc * 32 + 4 * fq, pn = u.pn;
        if (u.pm >= 64) {
#pragma unroll
            for (int ai = 0; ai < 2; ++ai)
#pragma unroll
                for (int m = 0; m < 4; ++m) { bf16* rp = KVC + (size_t)(row0 + ai * 128 + m * 16 - T) * 256 + (colb - ZK);
#pragma unroll
                    for (int bj = 0; bj < 2; ++bj)
#pragma unroll
                        for (int n = 0; n < 2; ++n) { const pg8::f32x4 v = acc[ai][bj][m][n]; u32x2 o; o.x = cvtpk(v[0], v[1]); o.y = cvtpk(v[2], v[3]); *(u32x2*)(rp + bj * 128 + n * 16) = o; } }
            return;
        }
#pragma unroll
        for (int ai = 0; ai < 2; ++ai)
#pragma unroll
            for (int m = 0; m < 4; ++m) {
                const int r = row0 + ai * 128 + m * 16; bf16* rp = Z + (size_t)r * DIN + colb;
                if (pn <= 3) {
#pragma unroll
                    for (int bj = 0; bj < 2; ++bj)
#pragma unroll
                        for (int n = 0; n < 2; ++n) { const pg8::f32x4 v = acc[ai][bj][m][n]; u32x2 o; o.x = cvtpk(gelu_f(v[0]), gelu_f(v[1])); o.y = cvtpk(gelu_f(v[2]), gelu_f(v[3])); *(u32x2*)(rp + bj * 128 + n * 16) = o; }
                } else if (pn <= 6) {
                    const int pos = (wc & 1) ? (r & 63) : ((r & 8191) >> 6);
                    const pg8::f32x4 cs = *(const pg8::f32x4*)(rope + pos * 32 + 4 * fq), sn = *(const pg8::f32x4*)(rope + pos * 32 + 16 + 4 * fq);
                    const float sc = (pn < 6) ? QSCALE : 1.f;
#pragma unroll
                    for (int bj = 0; bj < 2; ++bj) {
                        const pg8::f32x4 x1 = acc[ai][bj][m][0], x2 = acc[ai][bj][m][1];
                        pg8::f32x4 o1, o2;
                        if (pn == 6 && bj == 1) { o1 = x1; o2 = x2; }
                        else { o1 = (x1 * cs - x2 * sn) * sc; o2 = (x2 * cs + x1 * sn) * sc; }
                        u32x2 w1, w2; w1.x = cvtpk(o1[0], o1[1]); w1.y = cvtpk(o1[2], o1[3]); w2.x = cvtpk(o2[0], o2[1]); w2.y = cvtpk(o2[2], o2[3]);
                        *(u32x2*)(rp + bj * 128) = w1; *(u32x2*)(rp + bj * 128 + 16) = w2;
                    }
                } else {
#pragma unroll
                    for (int bj = 0; bj < 2; ++bj)
#pragma unroll
                        for (int n = 0; n < 2; ++n) { const pg8::f32x4 v = acc[ai][bj][m][n]; u32x2 o; o.x = cvtpk(sigmoid_f(v[0]), sigmoid_f(v[1])); o.y = cvtpk(sigmoid_f(v[2]), sigmoid_f(v[3])); *(u32x2*)(rp + bj * 128 + n * 16) = o; }
                }
            }
    }
};
struct EpiMergeA {
    static constexpr bool PERM = true, AFTER_DRAIN = false;
    const bf16* Z; bf16* Y;
    __device__ __forceinline__ void operator()(const pg8::f32x4 (&acc)[2][2][4][2], const pg8::Unit& u, int wr, int wc, int fr, int fq) const {
        const int row0 = u.pm * 256 + wr * 64 + fr, col0 = u.pn * 256 + wc * 32 + 8 * fq;
#pragma unroll
        for (int ai = 0; ai < 2; ++ai)
#pragma unroll
            for (int m = 0; m < 4; ++m) { const int r = row0 + ai * 128 + m * 16;
#pragma unroll
                for (int bj = 0; bj < 2; ++bj) { const int c = col0 + bj * 128;
                    const u32x4 g = *(const u32x4*)(Z + (size_t)r * DIN + ZGA + c);
                    const pg8::f32x4 v0 = acc[ai][bj][m][0], v1 = acc[ai][bj][m][1];
                    u32x4 o;
                    o.x = cvtpk(v0[0] * bflo(g.x), v0[1] * bfhi(g.x)); o.y = cvtpk(v0[2] * bflo(g.y), v0[3] * bfhi(g.y));
                    o.z = cvtpk(v1[0] * bflo(g.z), v1[1] * bfhi(g.z)); o.w = cvtpk(v1[2] * bflo(g.w), v1[3] * bfhi(g.w));
                    *(u32x4*)(Y + (size_t)r * D + c) = o; } }
    }
};
struct EpiMergeB {
    static constexpr bool PERM = true, AFTER_DRAIN = false;
    const bf16* Z; bf16* Y;
    __device__ __forceinline__ void operator()(const pg8::f32x4 (&acc)[2][2][4][2], const pg8::Unit& u, int wr, int wc, int fr, int fq) const {
        const int row0 = u.pm * 256 + wr * 64 + fr, col0 = u.pn * 256 + wc * 32 + 8 * fq;
#pragma unroll
        for (int ai = 0; ai < 2; ++ai)
#pragma unroll
            for (int m = 0; m < 4; ++m) { const int r = row0 + ai * 128 + m * 16;
#pragma unroll
                for (int bj = 0; bj < 2; ++bj) { const int c = col0 + bj * 128;
                    const u32x4 g = *(const u32x4*)(Z + (size_t)r * DIN + ZGB + c);
                    const u32x4 tp = *(const u32x4*)(Y + (size_t)r * D + c);
                    const pg8::f32x4 t0 = {bflo(tp.x), bfhi(tp.x), bflo(tp.y), bfhi(tp.y)}, t1 = {bflo(tp.z), bfhi(tp.z), bflo(tp.w), bfhi(tp.w)};
                    const pg8::f32x4 v0 = acc[ai][bj][m][0], v1 = acc[ai][bj][m][1];
                    u32x4 o;
                    o.x = cvtpk(t0[0] + v0[0] * bflo(g.x), t0[1] + v0[1] * bfhi(g.x)); o.y = cvtpk(t0[2] + v0[2] * bflo(g.y), t0[3] + v0[3] * bfhi(g.y));
                    o.z = cvtpk(t1[0] + v1[0] * bflo(g.z), t1[1] + v1[1] * bfhi(g.z)); o.w = cvtpk(t1[2] + v1[2] * bflo(g.w), t1[3] + v1[3] * bfhi(g.w));
                    *(u32x4*)(Y + (size_t)r * D + c) = o; } }
    }
};
struct EpiWo {
    static constexpr bool PERM = true, AFTER_DRAIN = false;
    const float* x; const float* adaf; bf16* X1;
    __device__ __forceinline__ void operator()(const pg8::f32x4 (&acc)[2][2][4][2], const pg8::Unit& u, int wr, int wc, int fr, int fq) const {
        const int row0 = u.pm * 256 + wr * 64 + fr, col0 = u.pn * 256 + wc * 32 + 8 * fq;
        const float* g1 = adaf + (u.pm >= 32 ? 6144 : 0) + 2048;
#pragma unroll
        for (int bj = 0; bj < 2; ++bj) { const int c = col0 + bj * 128;
            const pg8::f32x4 ga = *(const pg8::f32x4*)(g1 + c), gb = *(const pg8::f32x4*)(g1 + c + 4);
#pragma unroll
            for (int ai = 0; ai < 2; ++ai)
#pragma unroll
                for (int m = 0; m < 4; ++m) { const int r = row0 + ai * 128 + m * 16;
                    const pg8::f32x4 x0 = *(const pg8::f32x4*)(x + (size_t)r * D + c), x1 = *(const pg8::f32x4*)(x + (size_t)r * D + c + 4);
                    const pg8::f32x4 o0 = x0 + ga * acc[ai][bj][m][0], o1 = x1 + gb * acc[ai][bj][m][1];
                    u32x4 w; w.x = cvtpk(o0[0], o0[1]); w.y = cvtpk(o0[2], o0[3]); w.z = cvtpk(o1[0], o1[1]); w.w = cvtpk(o1[2], o1[3]);
                    *(u32x4*)(X1 + (size_t)r * D + c) = w; } }
    }
};


__device__ __forceinline__ s16x4 vtr(LAS const unsigned char* p) { return __builtin_bit_cast(s16x4, __builtin_amdgcn_ds_read_tr16_b64_v4i16((LAS v4i16_t*)p)); }

__device__ __forceinline__ void attn_item(const bf16* Z, const bf16* KVC, const float* sink, bf16* Obuf, ldsp lds, int b, int nb, int hk, int qh) {
    const int tid = threadIdx.x, lane = tid & 63, wave = __builtin_amdgcn_readfirstlane(tid >> 6), r32 = lane & 31, hi = lane >> 5;
    const int rq = wave >> 1, head = hk * 4 + rq;
    const int iq = qh * 64 + (wave & 1) * 32 + r32;
    const int wlo = (nb == 0) ? 2 : qh, whi = (nb == 63) ? 4 : 5 + qh, nwin = whi - wlo, ntile = nwin + 4;
    const int tokq = b * SEQ + nb * 128 + iq;
    bf16x8 qr[4];
#pragma unroll
    for (int d0 = 0; d0 < 4; ++d0) qr[d0] = *(const bf16x8*)(Z + (size_t)tokq * DIN + ZQ + head * 64 + d0 * 16 + hi * 8);
    float mrun = sink[head] * LOG2E, lrun = (hi == 0) ? 1.f : 0.f;
    f32x16 o[2];
#pragma unroll
    for (int j = 0; j < 2; ++j)
#pragma unroll
        for (int r = 0; r < 16; ++r) o[j][r] = 0.f;
    const int kdst = wave * 1024 + lane * 16, vdst = 8192 + (wave >> 2) * 4096 + lane * 64 + (wave & 3) * 16;
#define ATT_SRC(s, kp, vp) do { const int tl_ = (s) < nwin ? wlo + (s) : 6 + (s) - nwin; \
        if (tl_ < 6) { const int tok_ = b * SEQ + (nb - 1 + (tl_ >> 1)) * 128 + (tl_ & 1) * 64 + lane; kp = Z + (size_t)tok_ * DIN + ZK + hk * 64 + wave * 8; vp = Z + (size_t)tok_ * DIN + ZVA + hk * 64 + wave * 8; } \
        else { const int row_ = b * NCTX + (tl_ - 6) * 64 + lane; kp = KVC + (size_t)row_ * 256 + hk * 64 + wave * 8; vp = KVC + (size_t)row_ * 256 + 128 + hk * 64 + wave * 8; } } while (0)
    u32x4 kreg, vreg;
    { const bf16 *kp, *vp; ATT_SRC(0, kp, vp); kreg = *(const u32x4*)kp; vreg = *(const u32x4*)vp; }
    *(LAS u32x4*)(lds + kdst) = kreg; *(LAS u32x4*)(lds + vdst) = vreg;
    __syncthreads();
    const int vrd = ((lane & 15) >> 2) * 64 + ((lane >> 4) & 1) * 32 + (lane & 3) * 8 + hi * 256;
    for (int s = 0; s < ntile; ++s) {
        const int base = (s & 1) * 16384;
        const int tl = s < nwin ? wlo + s : 6 + s - nwin;
        if (s + 1 < ntile) { const bf16 *kp, *vp; ATT_SRC(s + 1, kp, vp); kreg = *(const u32x4*)kp; vreg = *(const u32x4*)vp; }
        {
            f32x16 p0, p1;
#pragma unroll
            for (int r = 0; r < 16; ++r) { p0[r] = 0.f; p1[r] = 0.f; }
#pragma unroll
            for (int d0 = 0; d0 < 4; ++d0) {
                const bf16x8 k0 = *(LAS const bf16x8*)(lds + base + (2 * d0 + hi) * 1024 + r32 * 16);
                const bf16x8 k1 = *(LAS const bf16x8*)(lds + base + (2 * d0 + hi) * 1024 + (r32 + 32) * 16);
                p0 = mfma32(k0, qr[d0], p0); p1 = mfma32(k1, qr[d0], p1);
            }
            if (tl < 2) {
                const int j0 = (tl & 1) * 64 + 4 * hi;
#pragma unroll
                for (int r = 0; r < 16; ++r) { const int j = j0 + (r & 3) + 8 * (r >> 2); if (j < iq) p0[r] = -INFINITY; if (j + 32 < iq) p1[r] = -INFINITY; }
            } else if (tl == 4 || tl == 5) {
                const int j0 = (tl & 1) * 64 + 4 * hi;
#pragma unroll
                for (int r = 0; r < 16; ++r) { const int j = j0 + (r & 3) + 8 * (r >> 2); if (j > iq) p0[r] = -INFINITY; if (j + 32 > iq) p1[r] = -INFINITY; }
            }
            float mx = fmaxf(p0[0], p1[0]);
#pragma unroll
            for (int r = 1; r < 16; ++r) mx = fmaxf(mx, fmaxf(p0[r], p1[r]));
            mx = fmaxf(mx, __shfl_xor(mx, 32));
            const float mn = fmaxf(mrun, mx), alpha = __builtin_amdgcn_exp2f(mrun - mn);
            mrun = mn;
            float rs = 0.f;
#pragma unroll
            for (int r = 0; r < 16; ++r) { p0[r] = __builtin_amdgcn_exp2f(p0[r] - mn); p1[r] = __builtin_amdgcn_exp2f(p1[r] - mn); rs += p0[r] + p1[r]; }
            lrun = lrun * alpha + rs;
#pragma unroll
            for (int r = 0; r < 16; ++r) { o[0][r] *= alpha; o[1][r] *= alpha; }
            bf16x8 pf[4];
#pragma unroll
            for (int s4 = 0; s4 < 4; ++s4) {
                u32x4 w;
                if (s4 < 2) { w.x = cvtpk(p0[8 * s4 + 0], p0[8 * s4 + 1]); w.y = cvtpk(p0[8 * s4 + 2], p0[8 * s4 + 3]); w.z = cvtpk(p0[8 * s4 + 4], p0[8 * s4 + 5]); w.w = cvtpk(p0[8 * s4 + 6], p0[8 * s4 + 7]); }
                else { const int q = s4 - 2; w.x = cvtpk(p1[8 * q + 0], p1[8 * q + 1]); w.y = cvtpk(p1[8 * q + 2], p1[8 * q + 3]); w.z = cvtpk(p1[8 * q + 4], p1[8 * q + 5]); w.w = cvtpk(p1[8 * q + 6], p1[8 * q + 7]); }
                pf[s4] = __builtin_bit_cast(bf16x8, w);
            }
#pragma unroll
            for (int dblk = 0; dblk < 2; ++dblk)
#pragma unroll
                for (int s4 = 0; s4 < 4; ++s4) {
                    const s16x4 lo = vtr(lds + base + 8192 + dblk * 4096 + vrd + (16 * s4) * 64);
                    const s16x4 hh = vtr(lds + base + 8192 + dblk * 4096 + vrd + (16 * s4 + 8) * 64);
                    const bf16x8 vf = {lo[0], lo[1], lo[2], lo[3], hh[0], hh[1], hh[2], hh[3]};
                    o[dblk] = mfma32(vf, pf[s4], o[dblk]);
                }
        }
        if (s + 1 < ntile) { *(LAS u32x4*)(lds + (16384 - base) + kdst) = kreg; *(LAS u32x4*)(lds + (16384 - base) + vdst) = vreg; }
        __syncthreads();
    }
#undef ATT_SRC
    {
        const float lt = lrun + __shfl_xor(lrun, 32), inv = 1.f / lt;
        bf16* op = Obuf + (size_t)tokq * 512 + head * 64;
#pragma unroll
        for (int dblk = 0; dblk < 2; ++dblk)
#pragma unroll
            for (int r4 = 0; r4 < 4; ++r4) {
                u32x2 w; w.x = cvtpk(o[dblk][4 * r4] * inv, o[dblk][4 * r4 + 1] * inv); w.y = cvtpk(o[dblk][4 * r4 + 2] * inv, o[dblk][4 * r4 + 3] * inv);
                *(u32x2*)(op + 32 * dblk + 8 * r4 + 4 * hi) = w;
            }
    }
}

__device__ __forceinline__ void gmlp_item(const bf16* Z, const float* lng, const float* lnb, const bf16* WsT, const float* bs, bf16* Abuf, ldsp lds, int ch, int gp) {
    const int tid = threadIdx.x, lane = tid & 63, wave = __builtin_amdgcn_readfirstlane(tid >> 6), fr = lane & 15, fq = lane >> 4;
    const int tok0 = ch * 128;
    LAS bf16* VT = (LAS bf16*)lds;
    f32x4 gA = *(const f32x4*)(lng + lane * 8), gB = *(const f32x4*)(lng + lane * 8 + 4), bA = *(const f32x4*)(lnb + lane * 8), bB = *(const f32x4*)(lnb + lane * 8 + 4);
#pragma unroll
    for (int rnd = 0; rnd < 2; ++rnd) {
        float y[8][8];
#pragma unroll
        for (int j = 0; j < 8; ++j) {
            const int tok = tok0 + wave * 16 + rnd * 8 + j;
            const u32x4 raw = *(const u32x4*)(Z + (size_t)tok * DIN + ZV + lane * 8);
            float x[8] = {bflo(raw.x), bfhi(raw.x), bflo(raw.y), bfhi(raw.y), bflo(raw.z), bfhi(raw.z), bflo(raw.w), bfhi(raw.w)};
            float s = 0.f;
#pragma unroll
            for (int i = 0; i < 8; ++i) s += x[i];
            const float mu = wave_sum(s) * (1.f / 512.f);
            float q = 0.f;
#pragma unroll
            for (int i = 0; i < 8; ++i) { x[i] -= mu; q += x[i] * x[i]; }
            const float rstd = rsqrtf(wave_sum(q) * (1.f / 512.f) + 1e-6f);
            y[j][0] = x[0] * rstd * gA[0] + bA[0]; y[j][1] = x[1] * rstd * gA[1] + bA[1]; y[j][2] = x[2] * rstd * gA[2] + bA[2]; y[j][3] = x[3] * rstd * gA[3] + bA[3];
            y[j][4] = x[4] * rstd * gB[0] + bB[0]; y[j][5] = x[5] * rstd * gB[1] + bB[1]; y[j][6] = x[6] * rstd * gB[2] + bB[2]; y[j][7] = x[7] * rstd * gB[3] + bB[3];
        }
        if ((lane >> 5) == gp) {
            const int gl = (lane >> 4) & 1;
#pragma unroll
            for (int i = 0; i < 8; ++i) {
                u32x4 w; w.x = cvtpk(y[0][i], y[1][i]); w.y = cvtpk(y[2][i], y[3][i]); w.z = cvtpk(y[4][i], y[5][i]); w.w = cvtpk(y[6][i], y[7][i]);
                *(LAS u32x4*)(VT + gl * (128 * 136) + (8 * (lane & 15) + i) * 136 + wave * 16 + rnd * 8) = w;
            }
        }
    }
    __syncthreads();
    const int wm = wave >> 1, wn = wave & 1;
#pragma unroll
    for (int gl = 0; gl < 2; ++gl) {
        const int g = 2 * gp + gl;
        f32x4 acc[2][4];
#pragma unroll
        for (int m = 0; m < 2; ++m)
#pragma unroll
            for (int n = 0; n < 4; ++n) acc[m][n] = (f32x4){0.f, 0.f, 0.f, 0.f};
#pragma unroll
        for (int ks = 0; ks < 4; ++ks) {
            bf16x8 af[2], bfr[4];
#pragma unroll
            for (int m = 0; m < 2; ++m) af[m] = *(const bf16x8*)(WsT + (size_t)g * 16384 + (32 * wm + 16 * m + fr) * 128 + 32 * ks + 8 * fq);
#pragma unroll
            for (int n = 0; n < 4; ++n) bfr[n] = *(LAS const bf16x8*)(VT + gl * (128 * 136) + (64 * wn + 16 * n + fr) * 136 + 32 * ks + 8 * fq);
#pragma unroll
            for (int m = 0; m < 2; ++m)
#pragma unroll
                for (int n = 0; n < 4; ++n) acc[m][n] = mfma16(bfr[n], af[m], acc[m][n]);
        }
#pragma unroll
        for (int m = 0; m < 2; ++m) {
            const int p = 32 * wm + 16 * m + fr, tok = tok0 + p; const float bias = bs[g * 128 + p];
#pragma unroll
            for (int n = 0; n < 4; ++n) {
                const int c = g * 128 + 64 * wn + 16 * n + 4 * fq;
                const u32x2 uw = *(const u32x2*)(Z + (size_t)tok * DIN + ZU + c);
                u32x2 w; w.x = cvtpk(bflo(uw.x) * (acc[m][n][0] + bias), bfhi(uw.x) * (acc[m][n][1] + bias)); w.y = cvtpk(bflo(uw.y) * (acc[m][n][2] + bias), bfhi(uw.y) * (acc[m][n][3] + bias));
                *(u32x2*)(Abuf + (size_t)tok * 512 + c) = w;
            }
        }
    }
    __syncthreads();
}

__device__ __forceinline__ void phase_mixers(const Args& a, ldsp lds, int G, int vcu) {
    unsigned char* ws = a.ws;
    const bf16* Z = (const bf16*)(ws + WS_Z);
    for (int it = vcu; it < 512; it += G) {
        const int qh = it & 1, hk = (it >> 1) & 1, nb = (it >> 2) & 63, b = it >> 8;
        attn_item(Z, (const bf16*)(ws + WS_KVC), a.in[I_SINK], (bf16*)(ws + WS_O), lds, b, nb, hk, qh);
    }
    for (int it = vcu; it < 256; it += G) {
        gmlp_item(Z, a.in[I_LNG], a.in[I_LNB], (const bf16*)(ws + WS_WST), a.in[I_GBS], (bf16*)(ws + WS_A), lds, it >> 1, it & 1);
    }
}

#define KI_BEFORE(ka, ia, kb, ib) (((ka) > (kb)) || ((ka) == (kb) && (ia) < (ib)))
#define KI_CAS(K, I, p, q) do { const bool sw_ = KI_BEFORE(K[q], I[q], K[p], I[p]); const float kp_ = sw_ ? K[q] : K[p], kq_ = sw_ ? K[p] : K[q]; const int ip_ = sw_ ? I[q] : I[p], iq_ = sw_ ? I[p] : I[q]; \
        K[p] = kp_; I[p] = ip_; K[q] = kq_; I[q] = iq_; } while (0)
#define KI_SORT8(K, I) do { KI_CAS(K, I, 0, 1); KI_CAS(K, I, 2, 3); KI_CAS(K, I, 4, 5); KI_CAS(K, I, 6, 7); \
        KI_CAS(K, I, 0, 2); KI_CAS(K, I, 1, 3); KI_CAS(K, I, 4, 6); KI_CAS(K, I, 5, 7); \
        KI_CAS(K, I, 1, 2); KI_CAS(K, I, 5, 6); KI_CAS(K, I, 0, 4); KI_CAS(K, I, 3, 7); \
        KI_CAS(K, I, 1, 5); KI_CAS(K, I, 2, 6); KI_CAS(K, I, 1, 4); KI_CAS(K, I, 3, 6); \
        KI_CAS(K, I, 2, 4); KI_CAS(K, I, 3, 5); KI_CAS(K, I, 3, 4); } while (0)
#define KI_MERGE8(KA, IA, KB, IB) do { \
        _Pragma("unroll") for (int r_ = 0; r_ < 8; ++r_) { const bool tb_ = KI_BEFORE(KB[7 - r_], IB[7 - r_], KA[r_], IA[r_]); KA[r_] = tb_ ? KB[7 - r_] : KA[r_]; IA[r_] = tb_ ? IB[7 - r_] : IA[r_]; } \
        KI_CAS(KA, IA, 0, 4); KI_CAS(KA, IA, 1, 5); KI_CAS(KA, IA, 2, 6); KI_CAS(KA, IA, 3, 7); \
        KI_CAS(KA, IA, 0, 2); KI_CAS(KA, IA, 1, 3); KI_CAS(KA, IA, 4, 6); KI_CAS(KA, IA, 5, 7); \
        KI_CAS(KA, IA, 0, 1); KI_CAS(KA, IA, 2, 3); KI_CAS(KA, IA, 4, 5); KI_CAS(KA, IA, 6, 7); } while (0)
__device__ __forceinline__ void router_item(const Args& a, ldsp lds, int it) {
    const int tid = threadIdx.x, lane = tid & 63, wave = __builtin_amdgcn_readfirstlane(tid >> 6), fr = lane & 15, fq = lane >> 4;
    unsigned char* ws = a.ws;
    const int t0 = it * 64, b = t0 >> 13;
    const bf16* X1 = (const bf16*)(ws + WS_X1); const float* adaf = (const float*)(ws + WS_ADAF) + b * 6144;
    const float* g2 = a.in[I_N2G]; unsigned char* H2 = ws + WS_H2;
    {
        f32x4 gm[2][2], sh[2][2];
#pragma unroll
        for (int j = 0; j < 2; ++j)
#pragma unroll
            for (int h = 0; h < 2; ++h) {
                const int c = 8 * lane + 512 * j + 4 * h;
                const f32x4 gg = *(const f32x4*)(g2 + c), sc = *(const f32x4*)(adaf + 4 * 1024 + c);
                gm[j][h] = gg * (sc + 1.f); sh[j][h] = *(const f32x4*)(adaf + 3 * 1024 + c);
            }
#pragma unroll
        for (int half = 0; half < 2; ++half) {
            f32x4 x[4][2][2];
#pragma unroll
            for (int tt = 0; tt < 4; ++tt)
#pragma unroll
                for (int j = 0; j < 2; ++j) {
                    const u32x4 w = *(const u32x4*)(X1 + (size_t)(t0 + wave * 8 + half * 4 + tt) * D + 8 * lane + 512 * j);
                    x[tt][j][0] = (f32x4){bflo(w.x), bfhi(w.x), bflo(w.y), bfhi(w.y)}; x[tt][j][1] = (f32x4){bflo(w.z), bfhi(w.z), bflo(w.w), bfhi(w.w)};
                }
#pragma unroll
            for (int tt = 0; tt < 4; ++tt) {
                const int row = wave * 8 + half * 4 + tt, tok = t0 + row;
                float ss = 0.f;
#pragma unroll
                for (int j = 0; j < 2; ++j)
#pragma unroll
                    for (int h = 0; h < 2; ++h) { const f32x4 v = x[tt][j][h]; ss += (v[0] * v[0] + v[1] * v[1]) + (v[2] * v[2] + v[3] * v[3]); }
                const float r = rsqrtf(wave_sum(ss) * (1.f / D) + 1e-6f);
#pragma unroll
                for (int j = 0; j < 2; ++j) {
                    const f32x4 h0 = (x[tt][j][0] * r) * gm[j][0] + sh[j][0], h1 = (x[tt][j][1] * r) * gm[j][1] + sh[j][1];
                    u32x4 w; w.x = cvtpk(h0[0], h0[1]); w.y = cvtpk(h0[2], h0[3]); w.z = cvtpk(h1[0], h1[1]); w.w = cvtpk(h1[2], h1[3]);
                    { int f0 = 0, f1 = 0;
                      f0 = __builtin_amdgcn_cvt_pk_fp8_f32(h0[0], h0[1], f0, false); f0 = __builtin_amdgcn_cvt_pk_fp8_f32(h0[2], h0[3], f0, true);
                      f1 = __builtin_amdgcn_cvt_pk_fp8_f32(h1[0], h1[1], f1, false); f1 = __builtin_amdgcn_cvt_pk_fp8_f32(h1[2], h1[3], f1, true);
                      u32x2 w8; w8.x = (unsigned)f0; w8.y = (unsigned)f1; *(u32x2*)(H2 + (size_t)tok * D + 8 * lane + 512 * j) = w8; }
                    const int kc = lane + 64 * j;
                    *(LAS u32x4*)(lds + kc * 1024 + ((row ^ (kc & 7)) * 16)) = w;
                }
            }
        }
    }
    __syncthreads();
    f32x4 acc[4][2];
#pragma unroll
    for (int m = 0; m < 4; ++m)
#pragma unroll
        for (int n = 0; n < 2; ++n) acc[m][n] = (f32x4){0.f, 0.f, 0.f, 0.f};
    const bf16* RwT = (const bf16*)(ws + WS_RWT) + (size_t)(32 * wave + fr) * D + 8 * fq;
#pragma unroll 8
    for (int ks = 0; ks < 32; ++ks) {
        const int kc = 4 * ks + fq;
        bf16x8 af[4], bfr[2];
#pragma unroll
        for (int n = 0; n < 2; ++n) bfr[n] = *(const bf16x8*)(RwT + (size_t)(16 * n) * D + 32 * ks);
#pragma unroll
        for (int m = 0; m < 4; ++m) af[m] = *(LAS const bf16x8*)(lds + kc * 1024 + (((16 * m + fr) ^ (kc & 7)) * 16));
#pragma unroll
        for (int m = 0; m < 4; ++m)
#pragma unroll
            for (int n = 0; n < 2; ++n) acc[m][n] = mfma16(af[m], bfr[n], acc[m][n]);
    }
    __syncthreads();
    LAS float* LG = (LAS float*)lds;
#pragma unroll
    for (int m = 0; m < 4; ++m)
#pragma unroll
        for (int n = 0; n < 2; ++n)
#pragma unroll
            for (int reg = 0; reg < 4; ++reg) LG[(32 * wave + 16 * n + fr) * 65 + 16 * m + 4 * fq + reg] = acc[m][n][reg];
    __syncthreads();
    LAS float* CK = (LAS float*)(lds + 69632); LAS int* CI = (LAS int*)(lds + 69632 + 16384);
    const float* rb = a.in[I_RB];
    float bk[8]; int bi[8];
#pragma unroll
    for (int q = 0; q < 4; ++q) {
        float gk[8]; int gi[8];
#pragma unroll
        for (int j = 0; j < 8; ++j) { const int e = 32 * wave + 8 * q + j; gk[j] = sigmoid_f(LG[e * 65 + lane]) + rb[e]; gi[j] = e; }
        KI_SORT8(gk, gi);
        if (q == 0) {
#pragma unroll
            for (int j = 0; j < 8; ++j) { bk[j] = gk[j]; bi[j] = gi[j]; }
        } else KI_MERGE8(bk, bi, gk, gi);
    }
#pragma unroll
    for (int r = 0; r < 8; ++r) { CK[(wave * 8 + r) * 64 + lane] = bk[r]; CI[(wave * 8 + r) * 64 + lane] = bi[r]; }
    __syncthreads();
#define RT_LEVEL(lvl) do { if ((wave & (2 * (lvl) - 1)) == 0) { float ok_[8]; int oi_[8]; \
            _Pragma("unroll") for (int r = 0; r < 8; ++r) { ok_[r] = CK[((wave + (lvl)) * 8 + r) * 64 + lane]; oi_[r] = CI[((wave + (lvl)) * 8 + r) * 64 + lane]; } \
            KI_MERGE8(bk, bi, ok_, oi_); \
            if ((lvl) < 4) { _Pragma("unroll") for (int r = 0; r < 8; ++r) { CK[(wave * 8 + r) * 64 + lane] = bk[r]; CI[(wave * 8 + r) * 64 + lane] = bi[r]; } } } \
        __syncthreads(); } while (0)
    RT_LEVEL(1); RT_LEVEL(2); RT_LEVEL(4);
#undef RT_LEVEL
    LAS unsigned* hist = (LAS unsigned*)(lds + 102400); LAS unsigned* hbase = hist + 256;
    if (tid < 256) hist[tid] = 0u;
    __syncthreads();
    unsigned* cnt = (unsigned*)(ws + WS_CTL) + CW_CNT; int* list = (int*)(ws + WS_LIST); float* gatew = (float*)(ws + WS_GATEW);
    unsigned rank[8];
    if (wave == 0) {
        const int tok = t0 + lane;
        float sel[8], ssum = 0.f;
#pragma unroll
        for (int r = 0; r < 8; ++r) { sel[r] = sigmoid_f(LG[bi[r] * 65 + lane]); ssum += sel[r]; }
#pragma unroll
        for (int r = 0; r < 8; ++r) rank[r] = __hip_atomic_fetch_add(&hist[bi[r]], 1u, __ATOMIC_RELAXED, __HIP_MEMORY_SCOPE_WORKGROUP);
        const float sc = 2.5f / ssum;
        f32x4 g0 = {sel[0] * sc, sel[1] * sc, sel[2] * sc, sel[3] * sc}, g1 = {sel[4] * sc, sel[5] * sc, sel[6] * sc, sel[7] * sc};
        *(f32x4*)(gatew + tok * 8) = g0; *(f32x4*)(gatew + tok * 8 + 4) = g1;
    }
    __syncthreads();
    if (tid < 256) { const unsigned h = hist[tid]; if (h) hbase[tid] = atomicAdd(cnt + 32 * tid, h); }
    __syncthreads();
    if (wave == 0) {
        const int tok = t0 + lane;
#pragma unroll
        for (int r = 0; r < 8; ++r) list[(size_t)bi[r] * LISTCAP + hbase[bi[r]] + rank[r]] = tok * NSLOT + r;
    }
    __syncthreads();
}

__device__ __forceinline__ const float* uni_ptr(const float* p) {
    const unsigned long long v = (unsigned long long)p;
    const unsigned lo = __builtin_amdgcn_readfirstlane((unsigned)v), hi = __builtin_amdgcn_readfirstlane((unsigned)(v >> 32));
    return (const float*)(((unsigned long long)hi << 32) | lo);
}
__device__ __forceinline__ void moe_decode(int j, int total, LAS const int* pre, LAS const int* cnt, int& e, int& mt, int& nrows) {
    if (j < total) {
        int lo = 0, hi = NEXP;
        while (hi - lo > 1) { const int mid = (lo + hi) >> 1; if (pre[mid] <= j) lo = mid; else hi = mid; }
        e = lo; mt = j - pre[e]; const int c = cnt[e] - mt * 128; nrows = c < 128 ? c : 128;
    } else { e = NEXP; mt = j - total; nrows = 128; }
}
__device__ __forceinline__ void phase_moe(const Args& a, ldsp lds, int G, int vcu) {
    const int tid = threadIdx.x, lane = tid & 63, wave = __builtin_amdgcn_readfirstlane(tid >> 6), fr = lane & 15, fq = lane >> 4;
    unsigned char* ws = a.ws;
    constexpr int AF8 = 0, BSTG = 32768, ACT = 65536, SLOTS = 131072, GWO = SLOTS + MOE_MAXT * 512;
    static_assert(GWO + MOE_MAXT * 512 <= SCR_BYTES, "slot lists overflow the scratch image");
    LAS int* pre = (LAS int*)(lds + MISC_OFF + 512);
    LAS int* cnt = (LAS int*)(lds + MISC_OFF + 2048);
    LAS int* wtot = (LAS int*)(lds + MISC_OFF + 3072);
    int myv = 0, myx = 0;
    if (tid < NEXP) {
        const int c = (int)((const unsigned*)(ws + WS_CTL) + CW_CNT)[32 * tid];
        cnt[tid] = c; myv = (c + 127) >> 7; myx = myv;
#pragma unroll
        for (int o = 1; o < 64; o <<= 1) { const int y = __shfl_up(myx, o); if (lane >= o) myx += y; }
        if (lane == 63) wtot[wave] = myx;
    }
    __syncthreads();
    if (tid < NEXP) { int base = 0; for (int w = 0; w < wave; ++w) base += wtot[w]; pre[tid] = base + myx - myv; if (tid == NEXP - 1) pre[NEXP] = base + myx; }
    __syncthreads();
    const int total = pre[NEXP], ntiles = total + T / 128;
    if (vcu >= ntiles) return;
    for (int tt = tid >> 7; vcu + tt * G < ntiles; tt += 4) {
        const int r = tid & 127; int e_, mt_, nr_; moe_decode(vcu + tt * G, total, pre, cnt, e_, mt_, nr_);
        int slot_ = -1; float gw_ = 0.f;
        if (r < nr_) { if (e_ < NEXP) { slot_ = ((const int*)(ws + WS_LIST))[(size_t)e_ * LISTCAP + mt_ * 128 + r]; gw_ = ((const float*)(ws + WS_GATEW))[(slot_ / NSLOT) * 8 + (slot_ % NSLOT)]; }
                       else { slot_ = (mt_ * 128 + r) * NSLOT + 8; gw_ = 1.f; } }
        ((LAS int*)(lds + SLOTS))[tt * 128 + r] = slot_; ((LAS float*)(lds + GWO))[tt * 128 + r] = gw_;
    }
    __syncthreads();
    if (wave >= 4) {
        const int lt = tid - 256;
        const unsigned char* H2 = ws + WS_H2;
        const int ln = lt & 63, kqu = wave - 4;
        const unsigned ldsb = (unsigned)(size_t)lds;
        const unsigned char *ap0, *ap1, *ap2, *ap3;
        int sn0, sn1, sn2, sn3;
#define L_SLOTS(it_) do { LAS const int* sl_ = (LAS const int*)(lds + SLOTS) + (it_) * 128 + 32 * kqu + (ln >> 3); sn0 = sl_[0]; sn1 = sl_[8]; sn2 = sl_[16]; sn3 = sl_[24]; } while (0)
#define L_APTR() do { const int s0_ = sn0, s1_ = sn1, s2_ = sn2, s3_ = sn3; const int px0_ = ((ln & 7) ^ (ln >> 4)) * 16, px1_ = ((ln & 7) ^ (4 + (ln >> 4))) * 16; \
            ap0 = H2 + (size_t)((s0_ < 0 ? 0 : s0_) / NSLOT) * D + px0_; ap1 = H2 + (size_t)((s1_ < 0 ? 0 : s1_) / NSLOT) * D + px1_; \
            ap2 = H2 + (size_t)((s2_ < 0 ? 0 : s2_) / NSLOT) * D + px0_; ap3 = H2 + (size_t)((s3_ < 0 ? 0 : s3_) / NSLOT) * D + px1_; } while (0)
#define L_DMA1(g_, m_) do { unsigned keep_; asm volatile("s_mov_b32 %0, m0\n\ts_mov_b32 m0, %2\n\ts_nop 0\n\tglobal_load_lds_dwordx4 %1, off\n\ts_mov_b32 m0, %0" : "=&s"(keep_) : "v"(g_), "s"(m_) : "memory"); } while (0)
#define L_DMA(grp_, buf_) do { const int ko_ = 128 * ((grp_) & 7); const unsigned d_ = __builtin_amdgcn_readfirstlane(ldsb + AF8 + (buf_) * 16384 + kqu * 4096); \
            L_DMA1(ap0 + ko_, d_); L_DMA1(ap1 + ko_, d_ + 1024u); L_DMA1(ap2 + ko_, d_ + 2048u); L_DMA1(ap3 + ko_, d_ + 3072u); } while (0)
#define L_DSW(p_, v_) asm volatile("ds_write_b128 %0, %1" :: "v"((unsigned)(size_t)(p_)), "v"(v_) : "memory")
#define L_BAR() do { asm volatile("s_waitcnt lgkmcnt(0)" ::: "memory"); __builtin_amdgcn_s_barrier(); } while (0)
        const int ng = lt & 63, kq = lt >> 6;
        const int loff256 = (8 * kq) * 256 + 4 * ng, loff1024 = (8 * kq) * 1024 + 4 * ng;
        const int bw = BSTG + kq * 4096 + (4 * ng) * 16, bx = ((4 * ng) >> 3) & 3;
        const int rho_d = 64 * (ng >> 4) + 16 * (ng & 3) + 4 * ((ng >> 2) & 3);
        const int bw_d = BSTG + kq * 4096 + rho_d * 16, bx_d = (rho_d >> 4) & 3;
        f32x4 B0[8], B1[8], B2[8], B3[8];
        int j = vcu, it = 0, e, mt, nrows;
        moe_decode(j, total, pre, cnt, e, mt, nrows);
#ifndef MOE_AUX
#define MOE_AUX 16
#endif
#define W_RSRC(eo_, pe_, ps_) __builtin_amdgcn_make_buffer_rsrc((void*)uni_ptr(((eo_) < NEXP) ? a.in[pe_] + (size_t)(eo_) * 262144 : a.in[ps_]), 0, 1 << 20, 0x00020000)
        const int eu0 = __builtin_amdgcn_readfirstlane(e);
        __amdgpu_buffer_rsrc_t Wg = W_RSRC(eu0, I_EG, I_SG), Wu = W_RSRC(eu0, I_EU, I_SU), Wd = W_RSRC(eu0, I_ED, I_SD);
        L_SLOTS(0); L_APTR();
#define L_LOADB1(WG_, WU_, WD_, s_, BR) do { const int ss_ = (s_); const int t_ = ss_ - 64; \
            const __amdgpu_buffer_rsrc_t r_ = (ss_ < 32) ? (WG_) : (ss_ < 64) ? (WU_) : (WD_); \
            const int vo_ = (ss_ < 64) ? 4 * loff256 : 4 * loff1024; \
            const int so_ = (ss_ < 32) ? (32 * ss_) * 1024 : (ss_ < 64) ? (32 * (ss_ - 32)) * 1024 : (32 * (t_ & 7)) * 4096 + 1024 * (t_ >> 3); \
            const int str_ = (ss_ < 64) ? 1024 : 4096;        \
            _Pragma("unroll") for (int jj = 0; jj < 8; ++jj) BR[jj] = __builtin_bit_cast(f32x4, __builtin_amdgcn_raw_buffer_load_b128(r_, vo_, so_ + jj * str_, MOE_AUX)); } while (0)
#define L_LOADB1P(WG_, WU_, WD_, s_, BR, j0_) do { const int ss_ = (s_); const int t_ = ss_ - 64; \
            const __amdgpu_buffer_rsrc_t r_ = (ss_ < 32) ? (WG_) : (ss_ < 64) ? (WU_) : (WD_); \
            const int vo_ = (ss_ < 64) ? 4 * loff256 : 4 * loff1024; \
            const int so_ = (ss_ < 32) ? (32 * ss_) * 1024 : (ss_ < 64) ? (32 * (ss_ - 32)) * 1024 : (32 * (t_ & 7)) * 4096 + 1024 * (t_ >> 3); \
            const int str_ = (ss_ < 64) ? 1024 : 4096; \
            _Pragma("unroll") for (int jj = (j0_); jj < (j0_) + 2; ++jj) BR[jj] = __builtin_bit_cast(f32x4, __builtin_amdgcn_raw_buffer_load_b128(r_, vo_, so_ + jj * str_, MOE_AUX)); } while (0)
#define L_LOAD2P(s_, BR, j0_) do { const int s0_ = (s_); const int t_ = s0_ < 31 ? s0_ : 31; \
            const int so_ = (32 * (t_ & 7)) * 4096 + 1024 * (t_ >> 3); \
            _Pragma("unroll") for (int jj = (j0_); jj < (j0_) + 2; ++jj) BR[jj] = __builtin_bit_cast(f32x4, __builtin_amdgcn_raw_buffer_load_b128(Wd, 4 * loff1024, so_ + jj * 4096, MOE_AUX)); } while (0)
#define L_WRITEB1(BR, buf_, i_, bw_, bx_) do { const int i = (i_); u32x4 w_; w_.x = cvtpk(BR[0][i], BR[1][i]); w_.y = cvtpk(BR[2][i], BR[3][i]); w_.z = cvtpk(BR[4][i], BR[5][i]); w_.w = cvtpk(BR[6][i], BR[7][i]); \
            L_DSW(lds + (buf_) * 16384 + (bw_) + ((i ^ (bx_)) * 16), w_); } while (0)
#define L_SB() __builtin_amdgcn_sched_barrier(0)
#define L_STEP1(WG_, WU_, WD_, ls_, LB, WB, wbuf_, ws_) do { const bool dn_ = (ws_) >= 64; const int bwx_ = dn_ ? bw_d : bw, bxx_ = dn_ ? bx_d : bx;        \
            _Pragma("unroll") for (int i4 = 0; i4 < 4; ++i4) { L_WRITEB1(WB, wbuf_, i4, bwx_, bxx_); L_SB(); L_LOADB1P(WG_, WU_, WD_, ls_, LB, 2 * i4); L_SB(); } } while (0)
#define L_STEP2(ls_, LB, WB, wbuf_) do { _Pragma("unroll") for (int i4 = 0; i4 < 4; ++i4) { L_WRITEB1(WB, wbuf_, i4, bw_d, bx_d); L_SB(); L_LOAD2P(ls_, LB, 2 * i4); L_SB(); } } while (0)
#define L_LOAD2(s_, BR) do { const int s0_ = (s_); const int t_ = s0_ < 31 ? s0_ : 31; \
            const int so_ = (32 * (t_ & 7)) * 4096 + 1024 * (t_ >> 3); \
            _Pragma("unroll") for (int jj = 0; jj < 8; ++jj) BR[jj] = __builtin_bit_cast(f32x4, __builtin_amdgcn_raw_buffer_load_b128(Wd, 4 * loff1024, so_ + jj * 4096, MOE_AUX)); } while (0)
#define L_WRITEB(BR, buf_) do { _Pragma("unroll") for (int i = 0; i < 4; ++i) { u32x4 w_; w_.x = cvtpk(BR[0][i], BR[1][i]); w_.y = cvtpk(BR[2][i], BR[3][i]); w_.z = cvtpk(BR[4][i], BR[5][i]); w_.w = cvtpk(BR[6][i], BR[7][i]); \
            L_DSW(lds + (buf_) * 16384 + bw + ((i ^ bx) * 16), w_); } } while (0)
        L_DMA(0, 0); L_LOADB1(Wg, Wu, Wd, 0, B0); L_LOADB1(Wg, Wu, Wd, 1, B1); L_LOADB1(Wg, Wu, Wd, 2, B2);
        for (;;) {
            const int jn = j + G; const bool more = jn < ntiles;
            int en = e, mtn = mt, nrn = nrows; if (more) { moe_decode(jn, total, pre, cnt, en, mtn, nrn); L_SLOTS(it + 1); }
            L_WRITEB(B0, 0);
            L_BAR();
            for (int s = 0; s < 64; s += 8) {
                L_DMA((s >> 2) + 1, 1); L_STEP1(Wg, Wu, Wd, s + 3, B3, B1, 1, s + 1); L_BAR();
                L_STEP1(Wg, Wu, Wd, s + 4, B0, B2, 0, s + 2); L_BAR();
                L_STEP1(Wg, Wu, Wd, s + 5, B1, B3, 1, s + 3); L_BAR();
                L_STEP1(Wg, Wu, Wd, s + 6, B2, B0, 0, s + 4); L_BAR();
                L_DMA((s >> 2) + 2, 0); L_STEP1(Wg, Wu, Wd, s + 7, B3, B1, 1, s + 5); L_BAR();
                L_STEP1(Wg, Wu, Wd, s + 8, B0, B2, 0, s + 6); L_BAR();
                L_STEP1(Wg, Wu, Wd, s + 9, B1, B3, 1, s + 7); L_BAR();
                L_STEP1(Wg, Wu, Wd, s + 10, B2, B0, 0, s + 8); L_BAR();
            }
            for (int s = 0; s < 28; s += 4) {
                L_STEP2(s + 3, B3, B1, 1); L_BAR();
                L_STEP2(s + 4, B0, B2, 0); L_BAR();
                L_STEP2(s + 5, B1, B3, 1); L_BAR();
                L_STEP2(s + 6, B2, B0, 0); L_BAR();
            }
            const int eun = __builtin_amdgcn_readfirstlane(en);
            const __amdgpu_buffer_rsrc_t Wgn = W_RSRC(eun, I_EG, I_SG), Wun = W_RSRC(eun, I_EU, I_SU), Wdn = W_RSRC(eun, I_ED, I_SD);
            L_STEP2(31, B3, B1, 1); L_BAR();
            L_APTR();
            L_DMA(0, 0); L_STEP1(Wgn, Wun, Wdn, 0, B0, B2, 0, 94); L_BAR();
            L_STEP1(Wgn, Wun, Wdn, 1, B1, B3, 1, 95); L_BAR();
            L_LOADB1(Wgn, Wun, Wdn, 2, B2); L_BAR();
            if (!more) break;
            j = jn; ++it; e = en; mt = mtn; nrows = nrn; Wg = Wgn; Wu = Wun; Wd = Wdn;
        }
#undef L_LOADB1
#undef L_LOADB1P
#undef L_LOAD2P
#undef L_WRITEB1
#undef L_STEP1
#undef L_STEP2
#undef L_SB
#undef W_RSRC
#undef L_APTR
#undef L_SLOTS
#undef L_DSW
#undef L_DMA
#undef L_DMA1
#undef L_BAR
#undef L_LOAD2
#undef L_WRITEB
    } else {
        const int wr = wave >> 1, wc = wave & 1;
        int rowm[4], ard[4], a8[4], brd[8], brdd[8];
        const int ax8 = (fr >> 1) & 7;
#pragma unroll
        for (int m = 0; m < 4; ++m) { rowm[m] = 64 * wr + 16 * m + fr; ard[m] = fq * 2048 + ((rowm[m] ^ (fq << 1)) * 16); a8[m] = AF8 + rowm[m] * 128 + (fq & 1) * 8; }
#pragma unroll
        for (int n = 0; n < 8; ++n) { const int rho = 128 * wc + 16 * n + fr; brd[n] = BSTG + fq * 4096 + ((rho ^ ((rho >> 3) & 3)) * 16); brdd[n] = BSTG + fq * 4096 + ((rho ^ ((rho >> 4) & 3)) * 16); }
        unsigned char* contrib = ws + WS_CONTRIB;
        f32x4 acc[4][8];
#define M_COMPUTE(abase_, buf_, BRD) do { \
            _Pragma("unroll") for (int nh = 0; nh < 2; ++nh) { bf16x8 af_[4], bf_[4]; \
                _Pragma("unroll") for (int m = 0; m < 4; ++m) af_[m] = *(LAS const bf16x8*)(lds + (abase_) + ard[m]); \
                _Pragma("unroll") for (int n = 0; n < 4; ++n) bf_[n] = *(LAS const bf16x8*)(lds + (buf_) * 16384 + BRD[4 * nh + n]); \
                _Pragma("unroll") for (int m = 0; m < 4; ++m) _Pragma("unroll") for (int n = 0; n < 4; ++n) acc[m][4 * nh + n] = mfma16(bf_[n], af_[m], acc[m][4 * nh + n]); } } while (0)
#define M_COMPUTE8(q_, abuf_, bbuf_) do { bf16x8 af_[4]; const int pz_ = (abuf_) * 16384 + (((2 * (q_) + (fq >> 1)) ^ ax8) << 4); \
            _Pragma("unroll") for (int m = 0; m < 4; ++m) { const u32x2 w_ = *(LAS const u32x2*)(lds + a8[m] + pz_); \
                const f32x2_t c0_ = __builtin_amdgcn_cvt_pk_f32_fp8((int)w_.x, false), c1_ = __builtin_amdgcn_cvt_pk_f32_fp8((int)w_.x, true), c2_ = __builtin_amdgcn_cvt_pk_f32_fp8((int)w_.y, false), c3_ = __builtin_amdgcn_cvt_pk_f32_fp8((int)w_.y, true); \
                u32x4 p_; p_.x = cvtpk(c0_[0], c0_[1]); p_.y = cvtpk(c1_[0], c1_[1]); p_.z = cvtpk(c2_[0], c2_[1]); p_.w = cvtpk(c3_[0], c3_[1]); af_[m] = __builtin_bit_cast(bf16x8, p_); } \
            _Pragma("unroll") for (int nh = 0; nh < 2; ++nh) { bf16x8 bf_[4]; \
                _Pragma("unroll") for (int n = 0; n < 4; ++n) bf_[n] = *(LAS const bf16x8*)(lds + (bbuf_) * 16384 + brd[4 * nh + n]); \
                _Pragma("unroll") for (int m = 0; m < 4; ++m) _Pragma("unroll") for (int n = 0; n < 4; ++n) acc[m][4 * nh + n] = mfma16(bf_[n], af_[m], acc[m][4 * nh + n]); } } while (0)
#define M_ZERO() do { _Pragma("unroll") for (int m = 0; m < 4; ++m) _Pragma("unroll") for (int n = 0; n < 8; ++n) acc[m][n] = (f32x4){0.f, 0.f, 0.f, 0.f}; } while (0)
        int it = 0;
        for (int j = vcu; j < ntiles; j += G, ++it) {
            __syncthreads();
            for (int s = 0; s < 64; s += 4) {
                if ((s & 31) == 0) M_ZERO();
                const int ab = (s >> 2) & 1;
                M_COMPUTE8(0, ab, 0); __syncthreads();
                M_COMPUTE8(1, ab, 1); __syncthreads();
                M_COMPUTE8(2, ab, 0); __syncthreads();
                M_COMPUTE8(3, ab, 1);
                if (s == 28) {
#pragma unroll
                    for (int m = 0; m < 4; ++m)
#pragma unroll
                        for (int n = 0; n < 8; ++n) {
                            const f32x4 gv = acc[m][n];
                            u32x2 w; w.x = cvtpk(silu_f(gv[0]), silu_f(gv[1])); w.y = cvtpk(silu_f(gv[2]), silu_f(gv[3]));
                            const int kc = 16 * wc + 2 * n + (fq >> 1);
                            *(LAS u32x2*)(lds + ACT + kc * 2048 + ((rowm[m] ^ ((kc & 3) << 1)) * 16) + (fq & 1) * 8) = w;
                        }
                } else if (s == 60) {
#pragma unroll
                    for (int m = 0; m < 4; ++m)
#pragma unroll
                        for (int n = 0; n < 8; ++n) {
                            const f32x4 uv = acc[m][n];
                            const int kc = 16 * wc + 2 * n + (fq >> 1);
                            LAS u32x2* ap = (LAS u32x2*)(lds + ACT + kc * 2048 + ((rowm[m] ^ ((kc & 3) << 1)) * 16) + (fq & 1) * 8);
                            const u32x2 g = *ap;
                            u32x2 w; w.x = cvtpk(bflo(g.x) * uv[0], bfhi(g.x) * uv[1]); w.y = cvtpk(bflo(g.y) * uv[2], bfhi(g.y) * uv[3]);
                            *ap = w;
                        }
                }
                __syncthreads();
            }
            for (int s = 0; s < 32; s += 4) {
                if ((s & 7) == 0) M_ZERO();
                M_COMPUTE(ACT + (s & 7) * 8192, 0, brdd); __syncthreads();
                M_COMPUTE(ACT + ((s + 1) & 7) * 8192, 1, brdd); __syncthreads();
                M_COMPUTE(ACT + ((s + 2) & 7) * 8192, 0, brdd); __syncthreads();
                M_COMPUTE(ACT + ((s + 3) & 7) * 8192, 1, brdd);
                if ((s & 7) == 4) {
                    const int q = s >> 3;
#pragma unroll
                    for (int m = 0; m < 4; ++m) {
                        const int slot = ((LAS const int*)(lds + SLOTS))[it * 128 + rowm[m]]; const float gw = ((LAS const float*)(lds + GWO))[it * 128 + rowm[m]];
                        if (slot >= 0) {
                            unsigned char* cp = contrib + (size_t)slot * D + q * 256 + 128 * wc + 16 * fq;
                            const float gs = gw * CONTRIB_SCALE;
#pragma unroll
                            for (int k = 0; k < 2; ++k) {
                                u32x4 w4;
#pragma unroll
                                for (int n = 0; n < 4; ++n) { const f32x4 v = acc[m][4 * k + n] * gs; int w = 0; w = __builtin_amdgcn_cvt_pk_fp8_f32(v[0], v[1], w, false); w = __builtin_amdgcn_cvt_pk_fp8_f32(v[2], v[3], w, true); w4[n] = (unsigned)w; }
                                *(u32x4*)(cp + 64 * k) = w4;
                            }
                        }
                    }
                }
                __syncthreads();
            }
        }
#undef M_COMPUTE
#undef M_COMPUTE8
#undef M_ZERO
    }
}

__device__ __forceinline__ void phase_combine(const Args& a, int G) {
    const int tid = threadIdx.x, lane = tid & 63, wave = __builtin_amdgcn_readfirstlane(tid >> 6), blk = blockIdx.x;
    unsigned char* ws = a.ws;
    const bf16* X1 = (const bf16*)(ws + WS_X1); const unsigned char* contrib = ws + WS_CONTRIB; const float* fg = a.in[I_FG];
    for (int t = blk * NWAVES + wave; t < T; t += G * NWAVES) {
        const float* g2 = (const float*)(ws + WS_ADAF) + (t >> 13) * 6144 + 5 * 1024;
        const int c = 16 * lane;
        float sm[16];
#pragma unroll
        for (int i = 0; i < 16; ++i) sm[i] = 0.f;
#pragma unroll
        for (int k = 0; k < NSLOT; ++k) {
            const u32x4 w = *(const u32x4*)(contrib + ((size_t)t * NSLOT + k) * D + c);
#pragma unroll
            for (int q = 0; q < 4; ++q) {
                const f32x2_t lo = __builtin_amdgcn_cvt_pk_f32_fp8((int)w[q], false), hi = __builtin_amdgcn_cvt_pk_f32_fp8((int)w[q], true);
                sm[4 * q] += lo[0]; sm[4 * q + 1] += lo[1]; sm[4 * q + 2] += hi[0]; sm[4 * q + 3] += hi[1];
            }
        }
        const u32x4 xa = *(const u32x4*)(X1 + (size_t)t * D + c), xb = *(const u32x4*)(X1 + (size_t)t * D + c + 8);
        const float x1[16] = {bflo(xa.x), bfhi(xa.x), bflo(xa.y), bfhi(xa.y), bflo(xa.z), bfhi(xa.z), bflo(xa.w), bfhi(xa.w), bflo(xb.x), bfhi(xb.x), bflo(xb.y), bfhi(xb.y), bflo(xb.z), bfhi(xb.z), bflo(xb.w), bfhi(xb.w)};
        f32x4 xv[4]; float ss = 0.f;
#pragma unroll
        for (int h = 0; h < 4; ++h) {
            const f32x4 gg = *(const f32x4*)(g2 + c + 4 * h);
            const f32x4 xx = {x1[4 * h], x1[4 * h + 1], x1[4 * h + 2], x1[4 * h + 3]};
            const f32x4 mv = {sm[4 * h], sm[4 * h + 1], sm[4 * h + 2], sm[4 * h + 3]};
            const f32x4 v = xx + gg * (mv * (1.f / CONTRIB_SCALE)); xv[h] = v; ss += (v[0] * v[0] + v[1] * v[1]) + (v[2] * v[2] + v[3] * v[3]);
        }
        const float r = rsqrtf(wave_sum(ss) * (1.f / D) + 1e-6f);
#pragma unroll
        for (int h = 0; h < 4; ++h) *(f32x4*)(a.out + (size_t)t * D + c + 4 * h) = (xv[h] * r) * *(const f32x4*)(fg + c + 4 * h);
    }
}

constexpr int NPH = 9;
#ifndef N_LAUNCHES
#define N_LAUNCHES 1
#endif
__global__ void __launch_bounds__(NWAVES * 64, 2) mega(Args a) {
    extern __shared__ __attribute__((aligned(16))) unsigned char lds_raw[];
    ldsp lds = (ldsp)lds_raw;
    const int tid = threadIdx.x, G = gridDim.x, bx = blockIdx.x;
    int vcu = (G % 8 == 0) ? (bx % 8) * (G / 8) + bx / 8 : bx;
    unsigned char* ws = a.ws;
    for (int u = tid; u < (LDS_BYTES - MISC_OFF) / 4; u += NWAVES * 64) ((LAS unsigned*)(lds + MISC_OFF))[u] = 0u;
    __syncthreads();
    volatile LAS unsigned* MISC = (volatile LAS unsigned*)(lds + MISC_OFF);
    XcdBarrier bar; bar.bar = (unsigned*)(ws + WS_CTL) + CW_BAR; bar.x = 0; bar.st = nullptr;
    if (N_LAUNCHES == 1) {
        bar = xcd_barrier_post((unsigned*)(ws + WS_CTL) + CW_BAR, MISC + 8);
        if (tid == 0) MISC[16] = atomicAdd((unsigned*)(ws + WS_CTL) + CW_XRANK + 64 * bar.x, 1u);
    }
    const int lo = a.ph_lo, hi = a.ph_hi;
#ifndef PH_MASK
#define PH_MASK 0x1ff
#endif
#define IN(k) (((PH_MASK >> (k)) & 1) && lo <= (k) && (k) < hi)
#define SEAM(k) do { if (IN(k) && IN((k) + 1)) xcd_barrier(bar); } while (0)
#ifndef PH_DUP
#define PH_DUP -1
#endif
#define REP(k) for (int rep_ = 0; rep_ < ((PH_DUP == (k)) ? 2 : 1); ++rep_)
    if (IN(0)) REP(0) { phase_prep(a, lds, G); } SEAM(0);
    if (N_LAUNCHES == 1 && IN(0) && IN(1)) {
        unsigned basex = 0;
        for (unsigned j = 0; j < bar.x; ++j) basex += xb_ld(&bar.bar[XB_XCNT(j)]);
        vcu = (int)(basex + MISC[16]);
    }
    if (IN(1)) REP(1) { phase_hnorm(a, lds, G); } SEAM(1);
    if (IN(2)) REP(2) {
        pg8::Gemm g{(const pg8::bf16_t*)(ws + WS_H), (const pg8::bf16_t*)(ws + WS_WINT), MH, DIN, D};
        WinOrder S; S.init(G, bx);
        EpiWin E{(bf16*)(ws + WS_Z), (bf16*)(ws + WS_KVC), (const float*)(ws + WS_ROPE)};
        pg8::gemm_phase<EpiWin, WinOrder, true, true>(lds, g, S, E);
    } SEAM(2);
    if (IN(3)) REP(3) { phase_mixers(a, lds, G, vcu); } SEAM(3);
    if (IN(4)) REP(4) {
        { pg8::Gemm g{(const pg8::bf16_t*)(ws + WS_A), (const pg8::bf16_t*)(ws + WS_WAT), T, D, 512};
          pg8::StaticOrder S; S.init(T, D, G, bx);
          EpiMergeA E{(const bf16*)(ws + WS_Z), (bf16*)(ws + WS_Y)};
          pg8::gemm_phase<EpiMergeA, pg8::StaticOrder, true, true>(lds, g, S, E); }
        { pg8::Gemm g{(const pg8::bf16_t*)(ws + WS_O), (const pg8::bf16_t*)(ws + WS_WBT), T, D, 512};
          pg8::StaticOrder S; S.init(T, D, G, bx);
          EpiMergeB E{(const bf16*)(ws + WS_Z), (bf16*)(ws + WS_Y)};
          pg8::gemm_phase<EpiMergeB, pg8::StaticOrder, true, true>(lds, g, S, E); }
    } SEAM(4);
    if (IN(5)) REP(5) {
        pg8::Gemm g{(const pg8::bf16_t*)(ws + WS_Y), (const pg8::bf16_t*)(ws + WS_WOT), T, D, D};
        pg8::StaticOrder S; S.init(T, D, G, bx);
        EpiWo E{a.in[I_X], (const float*)(ws + WS_ADAF), (bf16*)(ws + WS_X1)};
        pg8::gemm_phase<EpiWo, pg8::StaticOrder, true, true>(lds, g, S, E);
    } SEAM(5);
    if (IN(6)) { for (int it = vcu; it < T / 64; it += G) router_item(a, lds, it); } SEAM(6);
    if (IN(7)) REP(7) { phase_moe(a, lds, G, vcu); } SEAM(7);
    if (IN(8)) REP(8) { phase_combine(a, G); }
#undef IN
#undef SEAM
}

extern "C" void kernel_launch(void* const* d_in, const int* in_sizes, int n_in, void* d_out, int out_size, void* d_ws, size_t ws_size, hipStream_t stream) {
    static int grid = 0;
    if (grid == 0) {
        if (n_in != 26 || out_size != T * D || ws_size < WS_END) { fprintf(stderr, "kernel_launch: unexpected shapes (n_in %d, out %d, ws %zu)\n", n_in, out_size, ws_size); grid = -1; return; }
        int dev = 0, cus = 0, per_cu = 0;
        (void)hipGetDevice(&dev); (void)hipDeviceGetAttribute(&cus, hipDeviceAttributeMultiprocessorCount, dev);
        (void)hipFuncSetAttribute((const void*)mega, hipFuncAttributeMaxDynamicSharedMemorySize, LDS_BYTES);
        (void)hipOccupancyMaxActiveBlocksPerMultiprocessor(&per_cu, (const void*)mega, NWAVES * 64, LDS_BYTES);
        (void)hipGetLastError();
        if (per_cu < 1) { fprintf(stderr, "kernel_launch: occupancy query says %d blocks per CU\n", per_cu); per_cu = 1; }
        if (cus * MOE_MAXT < T * 8 / 128 + NEXP + T / 128) { fprintf(stderr, "kernel_launch: %d CUs are too few for the expert tile tables\n", cus); grid = -1; return; }
        grid = cus;
    }
    if (grid < 0) return;
    (void)hipMemsetAsync((char*)d_ws + WS_CTL, 0, CTL_ZERO_BYTES, stream);
    Args a{};
    for (int i = 0; i < 26; ++i) a.in[i] = (const float*)d_in[i];
    a.out = (float*)d_out; a.ws = (unsigned char*)d_ws;
    if (N_LAUNCHES == 1) {
        a.ph_lo = 0; a.ph_hi = NPH;
        void* kargs[] = {&a};
        hipError_t e = hipLaunchCooperativeKernel((const void*)mega, dim3(grid), dim3(NWAVES * 64), kargs, LDS_BYTES, stream);
        if (e != hipSuccess) fprintf(stderr, "kernel_launch: cooperative launch failed: %s (grid %d)\n", hipGetErrorString(e), grid);
    } else {
#ifndef HOST_DUP
#define HOST_DUP -1
#endif
        for (int li = 0; li < NPH; ++li) {
            a.ph_lo = li; a.ph_hi = li + 1;
            hipLaunchKernelGGL(mega, dim3(grid), dim3(NWAVES * 64), LDS_BYTES, stream, a);
            if (li == HOST_DUP) {
                if (li == 6) (void)hipMemsetAsync((char*)d_ws + WS_CTL, 0, CTL_ZERO_BYTES, stream);
                hipLaunchKernelGGL(mega, dim3(grid), dim3(NWAVES * 64), LDS_BYTES, stream, a);
            }
        }
    }
}
```

```cpp
#include <hip/hip_runtime.h>
#include <cstdio>
#include <cstdint>
#include <type_traits>
namespace pg8 {
#define PG8_LAS __attribute__((address_space(3)))
typedef unsigned short bf16_t;
typedef short bf16x8 __attribute__((ext_vector_type(8)));
typedef float f32x4 __attribute__((ext_vector_type(4)));
typedef unsigned u32x4 __attribute__((ext_vector_type(4)));
constexpr int BM = 256, BK = 64, HALF = 128, HTB = HALF * BK * 2  , STAGE_BYTES = 8 * HTB, NXCD = 8, WGM = 8;

__host__ __device__ __forceinline__ int lds_byte(int r, int c) { const int st = (r >> 4) * 2 + (c >> 5), rr = r & 15, cc = c & 31, ob = rr * 64 + cc * 2; return st * 1024 + (ob ^ (((ob >> 9) & 1) << 5)); }
__host__ __device__ __forceinline__ void stage_rc(int b, int& R, int& C) { const int st = b / 1024, sb = b % 1024, swz = sb ^ (((sb >> 9) & 1) << 5); R = (st >> 1) * 16 + swz / 64; C = (st & 1) * 32 + (swz % 64) / 2; }
__host__ __device__ __forceinline__ int perm32(int rho) { const int n = rho >> 4, i = rho & 15; return 8 * (i >> 2) + 4 * n + (i & 3); }

struct Unit { int pm, pn; };
struct Gemm { const bf16_t* A; const bf16_t* Bt; int M, N, K; };

struct StaticOrder {
    int nM, nN, nwg, G, c;
    __host__ __device__ void init(int M, int N, int G_, int c_) { nM = M / BM; nN = N / BM; nwg = nM * nN; G = G_; c = c_; }
    __host__ __device__ bool next(int i, Unit& u) const {
        const long L = (long)i * G + c; if (L >= nwg) return false;
        int wgid = (int)L; { const int q = nwg / NXCD, r = nwg % NXCD, xcd = wgid % NXCD, off = wgid / NXCD; wgid = (xcd < r ? xcd * (q + 1) : r * (q + 1) + (xcd - r) * q) + off; }
        const int nig = WGM * nN, gid = wgid / nig, fm = gid * WGM, gsz = (nM - fm) < WGM ? (nM - fm) : WGM;
        u.pm = fm + ((wgid % nig) % gsz); u.pn = (wgid % nig) / gsz; return true;
    }
    __device__ __forceinline__ void a_ready(const Unit&) const {}
    __device__ __forceinline__ void done(const Unit&) const {}
};

__device__ __forceinline__ unsigned cvt_pk_bf16(float lo, float hi) { unsigned r; asm volatile("v_cvt_pk_bf16_f32 %0, %1, %2" : "=v"(r) : "v"(lo), "v"(hi)); return r; }
template <class Epi, class Sched, bool ALIGN_EPI = false, bool SP2 = false>
__device__ __forceinline__ void gemm_phase(PG8_LAS unsigned char* lds, const Gemm g, const Sched& S, const Epi& E) {
    const int tid = threadIdx.x, wid = __builtin_amdgcn_readfirstlane(tid >> 6), lane = tid & 63, wr = wid >> 2, wc = wid & 3, fr = lane & 15, fq = lane >> 4;
    const int K = g.K, nt = K / BK;
    unsigned voffA[2], voffB[2];
#pragma unroll
    for (int i = 0; i < 2; ++i) { int R, C; stage_rc(tid * 16 + i * 8192, R, C); const int Rb = Epi::PERM ? ((R & ~31) + perm32(R & 31)) : R;
        voffA[i] = (unsigned)(R * K + C) * 2u; voffB[i] = (unsigned)(Rb * K + C) * 2u; }
    const size_t kstep = (size_t)(BK * 2);
    const size_t hstep = (size_t)HALF * K * 2;
    const size_t tstep = 2 * hstep;
    const unsigned ldsw = (unsigned)wid * 1024u;
    const int aoff = lds_byte(wr * 64 + fr, fq * 8), boff = lds_byte(wc * 32 + fr, fq * 8);
#define PG8_SA(b, h) (((b) * 2 + (h)) * HTB)
#define PG8_SB(b, h) ((4 + (b) * 2 + (h)) * HTB)
#define PG8_STAGE(bufoff, gbase, voff) do { _Pragma("unroll") for (int _i = 0; _i < 2; ++_i) \
        __builtin_amdgcn_global_load_lds((const unsigned*)((const char*)(gbase) + (voff)[_i]), (PG8_LAS unsigned*)(lds + (bufoff) + ldsw + _i * 8192), 16, 0, 0); } while (0)
#define PG8_LDA(dst, b, h) do { _Pragma("unroll") for (int m = 0; m < 4; ++m) _Pragma("unroll") for (int k = 0; k < 2; ++k) dst[m][k] = *(const PG8_LAS bf16x8*)(lds + PG8_SA(b, h) + aoff + m * 2048 + k * 1024); } while (0)
#define PG8_LDB(dst, b, h) do { _Pragma("unroll") for (int n = 0; n < 2; ++n) _Pragma("unroll") for (int k = 0; k < 2; ++k) dst[n][k] = *(const PG8_LAS bf16x8*)(lds + PG8_SB(b, h) + boff + n * 2048 + k * 1024); } while (0)
#define PG8_MMA(ai, bj, At, Bt) do { __builtin_amdgcn_s_setprio(1); _Pragma("unroll") for (int m = 0; m < 4; ++m) _Pragma("unroll") for (int n = 0; n < 2; ++n) _Pragma("unroll") for (int k = 0; k < 2; ++k) \
        acc[ai][bj][m][n] = __builtin_amdgcn_mfma_f32_16x16x32_bf16(Bt[n][k], At[m][k], acc[ai][bj][m][n], 0, 0, 0); __builtin_amdgcn_s_setprio(0); } while (0)
#define PG8_WAIT_V(n) asm volatile("s_waitcnt vmcnt(" #n ")" ::: "memory")
#define PG8_WAIT_L(n) asm volatile("s_waitcnt lgkmcnt(" #n ")" ::: "memory")
#define PG8_BAR __builtin_amdgcn_s_barrier()
#define PG8_SCHED __builtin_amdgcn_sched_barrier(0)
    Unit cur, nxt; int ui = 0;
    if (!S.next(0, cur)) return;
    f32x4 acc[2][2][4][2];
#pragma unroll
    for (int a = 0; a < 2; ++a)
#pragma unroll
        for (int b = 0; b < 2; ++b)
#pragma unroll
            for (int m = 0; m < 4; ++m)
#pragma unroll
                for (int n = 0; n < 2; ++n) acc[a][b][m][n] = (f32x4){0.f, 0.f, 0.f, 0.f};
    bf16x8 At[4][2], B0[2][2], B1[2][2];
    const char* cA = (const char*)g.A + (size_t)cur.pm * tstep; const char* cB = (const char*)g.Bt + (size_t)cur.pn * tstep;
    S.a_ready(cur);
    if constexpr (SP2) {
        PG8_STAGE(PG8_SB(0, 0), cB, voffB); PG8_STAGE(PG8_SB(0, 1), cB + hstep, voffB); PG8_STAGE(PG8_SA(0, 0), cA, voffA); PG8_STAGE(PG8_SA(0, 1), cA + hstep, voffA);
        if (wr == 1) PG8_BAR;
        PG8_WAIT_V(2); PG8_BAR;
        PG8_STAGE(PG8_SB(1, 0), cB + kstep, voffB); PG8_STAGE(PG8_SA(1, 0), cA + kstep, voffA); PG8_STAGE(PG8_SB(1, 1), cB + hstep + kstep, voffB);
        PG8_WAIT_V(6); PG8_BAR;
    } else {
        PG8_STAGE(PG8_SB(0, 0), cB, voffB); PG8_STAGE(PG8_SA(0, 0), cA, voffA); PG8_STAGE(PG8_SB(0, 1), cB + hstep, voffB); PG8_STAGE(PG8_SA(0, 1), cA + hstep, voffA);
        if (wr == 1) PG8_BAR;
        PG8_WAIT_V(4); PG8_BAR;
        PG8_STAGE(PG8_SB(1, 0), cB + kstep, voffB); PG8_STAGE(PG8_SA(1, 0), cA + kstep, voffA); PG8_STAGE(PG8_SB(1, 1), cB + hstep + kstep, voffB);
        PG8_WAIT_V(6); PG8_BAR;
    }
    for (;;) {
        const bool has_next = S.next(ui + 1, nxt);
        const char* nA = has_next ? (const char*)g.A + (size_t)nxt.pm * tstep : cA; const char* nB = has_next ? (const char*)g.Bt + (size_t)nxt.pn * tstep : cB;
        for (int t = 0; t < nt; t += 2) {
            const bool last = (t == nt - 2);
            const char* a1 = cA + (size_t)(t + 1) * kstep;
            const char* a2 = last ? nA : cA + (size_t)(t + 2) * kstep; const char* b2 = last ? nB : cB + (size_t)(t + 2) * kstep;
            const char* a3 = a2 + kstep; const char* b3 = b2 + kstep;
            if (last && has_next) S.a_ready(nxt);
            if constexpr (SP2) {
            PG8_LDB(B0, 0, 0); PG8_LDB(B1, 0, 1); PG8_SCHED; PG8_LDA(At, 0, 0); PG8_STAGE(PG8_SA(1, 1), a1 + hstep, voffA);
            PG8_WAIT_V(8); PG8_WAIT_L(0); PG8_BAR; PG8_MMA(0, 0, At, B0); PG8_MMA(0, 1, At, B1); PG8_BAR; PG8_SCHED;
            PG8_LDA(At, 0, 1); PG8_STAGE(PG8_SB(0, 0), b2, voffB); PG8_STAGE(PG8_SB(0, 1), b2 + hstep, voffB); PG8_STAGE(PG8_SA(0, 0), a2, voffA);
            PG8_WAIT_V(8); PG8_WAIT_L(0); PG8_BAR; PG8_MMA(1, 0, At, B0); PG8_MMA(1, 1, At, B1); PG8_BAR; PG8_SCHED;
            PG8_LDB(B0, 1, 0); PG8_LDB(B1, 1, 1); PG8_SCHED; PG8_LDA(At, 1, 0); PG8_STAGE(PG8_SA(0, 1), a2 + hstep, voffA);
            PG8_WAIT_V(8); PG8_WAIT_L(0); PG8_BAR; PG8_MMA(0, 0, At, B0); PG8_MMA(0, 1, At, B1); PG8_BAR; PG8_SCHED;
            PG8_LDA(At, 1, 1); PG8_STAGE(PG8_SB(1, 0), b3, voffB); PG8_STAGE(PG8_SB(1, 1), b3 + hstep, voffB); PG8_STAGE(PG8_SA(1, 0), a3, voffA);
            PG8_WAIT_V(8); PG8_WAIT_L(0); PG8_BAR; PG8_MMA(1, 0, At, B0); PG8_MMA(1, 1, At, B1); PG8_BAR; PG8_SCHED;
            } else {
            PG8_LDB(B0, 0, 0); PG8_SCHED; PG8_LDA(At, 0, 0); PG8_STAGE(PG8_SA(1, 1), a1 + hstep, voffA);
            PG8_WAIT_L(8); PG8_BAR; PG8_WAIT_L(0); PG8_MMA(0, 0, At, B0); PG8_BAR; PG8_SCHED;
            PG8_LDB(B1, 0, 1); PG8_STAGE(PG8_SB(0, 0), b2, voffB);
            PG8_BAR; PG8_WAIT_L(0); PG8_MMA(0, 1, At, B1); PG8_BAR;
            PG8_LDA(At, 0, 1); PG8_STAGE(PG8_SA(0, 0), a2, voffA);
            PG8_BAR; PG8_WAIT_L(0); PG8_MMA(1, 0, At, B0); PG8_BAR; PG8_SCHED;
            PG8_STAGE(PG8_SB(0, 1), b2 + hstep, voffB);
            PG8_WAIT_V(6); PG8_BAR; PG8_MMA(1, 1, At, B1); PG8_BAR;
            PG8_LDB(B0, 1, 0); PG8_SCHED; PG8_LDA(At, 1, 0); PG8_STAGE(PG8_SA(0, 1), a2 + hstep, voffA);
            PG8_WAIT_L(8); PG8_BAR; PG8_WAIT_L(0); PG8_MMA(0, 0, At, B0); PG8_BAR; PG8_SCHED;
            PG8_LDB(B1, 1, 1); PG8_STAGE(PG8_SB(1, 0), b3, voffB);
            PG8_BAR; PG8_WAIT_L(0); PG8_MMA(0, 1, At, B1); PG8_BAR;
            PG8_LDA(At, 1, 1); PG8_STAGE(PG8_SA(1, 0), a3, voffA);
            PG8_BAR; PG8_WAIT_L(0); PG8_MMA(1, 0, At, B0); PG8_BAR; PG8_SCHED;
            PG8_STAGE(PG8_SB(1, 1), b3 + hstep, voffB);
            PG8_WAIT_V(6); PG8_BAR; PG8_MMA(1, 1, At, B1); PG8_BAR;
            }
        }
        if constexpr (ALIGN_EPI) { if (wr == 0) PG8_BAR; }
        if constexpr (!Epi::AFTER_DRAIN) { E(acc, cur, wr, wc, fr, fq); S.done(cur); }
        if (!has_next) break;
#pragma unroll
        for (int a = 0; a < 2; ++a)
#pragma unroll
            for (int b = 0; b < 2; ++b)
#pragma unroll
                for (int m = 0; m < 4; ++m)
#pragma unroll
                    for (int n = 0; n < 2; ++n) acc[a][b][m][n] = (f32x4){0.f, 0.f, 0.f, 0.f};
        cur = nxt; cA = nA; cB = nB; ++ui;
        if constexpr (ALIGN_EPI) { if (wr == 1) PG8_BAR; }
    }
    PG8_WAIT_V(0);
    if constexpr (!ALIGN_EPI) { if (wr == 0) PG8_BAR; }
    PG8_BAR;
    if constexpr (Epi::AFTER_DRAIN) { E.fused(acc, cur, wr, wc, fr, fq, lds, wid, lane); S.done(cur); }
#undef PG8_SA
#undef PG8_SB
#undef PG8_STAGE
#undef PG8_LDA
#undef PG8_LDB
#undef PG8_MMA
#undef PG8_WAIT_V
#undef PG8_WAIT_L
#undef PG8_BAR
#undef PG8_SCHED
}
}
#define GAS __attribute__((address_space(1)))
#define LAS __attribute__((address_space(3)))
typedef unsigned short bf16;
typedef unsigned v4u __attribute__((ext_vector_type(4)));
typedef float f32x4 __attribute__((ext_vector_type(4)));
typedef short bf16x8 __attribute__((ext_vector_type(8)));
typedef GAS unsigned gu32;
typedef GAS unsigned long long gu64;
#define RLX_AGENT __ATOMIC_RELAXED, __HIP_MEMORY_SCOPE_AGENT
#define LDS_WAIT() asm volatile("s_waitcnt lgkmcnt(0)" ::: "memory")
#define VM_WAIT() asm volatile("s_waitcnt vmcnt(0)" ::: "memory")
__device__ __forceinline__ unsigned long long rt() { return __builtin_amdgcn_s_memrealtime(); }
__device__ __forceinline__ unsigned f2bf(float f) { unsigned u = __builtin_bit_cast(unsigned, f); return (u + 0x7fffu + ((u >> 16) & 1u)) >> 16; }
__device__ __forceinline__ unsigned pk2(float lo, float hi) { return f2bf(lo) | (f2bf(hi) << 16); }

#define XB_TMO      128
#define XB_XCNT(j)  (256  + 64 * (j))
#define XB_XSUB(j)  (1280 + 64 * (j))
#define XB_XGEN(j)  (2304 + 64 * (j))
#define XB_TOP      3328
#define XB_TOPGEN   3392
#define XCD_BAR_WORDS 3456
#define XB_SPIN_CAP (1u << 18)

__device__ __forceinline__ unsigned xb_ld(unsigned* p)              { return __hip_atomic_load(p, __ATOMIC_RELAXED, __HIP_MEMORY_SCOPE_AGENT); }
__device__ __forceinline__ unsigned xb_add(unsigned* p, unsigned v) { return __hip_atomic_fetch_add(p, v, __ATOMIC_RELAXED, __HIP_MEMORY_SCOPE_AGENT); }
__device__ __forceinline__ unsigned xb_xcc_id() { return (unsigned)__builtin_amdgcn_s_getreg((3 << 11) | 20) & 0xFu; }
#define XB_SPIN(cond, bar) do { unsigned _sp = 0; while (cond) { __builtin_amdgcn_s_sleep(1); \
    if ((++_sp & 255u) == 0u) { if (xb_ld(&(bar)[XB_TMO])) break; if (_sp > XB_SPIN_CAP) { atomicAdd(&(bar)[XB_TMO], 1u); break; } } } } while (0)

struct XcdBarrier {
    unsigned* bar; unsigned x;
    volatile LAS unsigned* st;
};

__device__ __forceinline__ XcdBarrier xcd_barrier_post(unsigned* bar, volatile LAS unsigned* st) {
    XcdBarrier b; b.bar = bar; b.x = xb_xcc_id(); b.st = st;
    if (threadIdx.x == 0) (void)xb_add(&bar[XB_XCNT(b.x)], 1u);
    return b;
}
__device__ __forceinline__ void xcd_barrier_complete(unsigned* bar, unsigned x, unsigned& nloc, unsigned& nx) {
    const unsigned G = gridDim.x * gridDim.y * gridDim.z;
    unsigned sum, cnt, mine, sp = 0u;
    for (;;) {
        sum = 0u; cnt = 0u; mine = 0u;
#pragma unroll
        for (unsigned j = 0; j < 16; ++j) { const unsigned c = xb_ld(&bar[XB_XCNT(j)]); sum += c; cnt += (c > 0u) ? 1u : 0u; mine = (j == x) ? c : mine; }
        if (sum == G) break;
        __builtin_amdgcn_s_sleep(1);
        if ((++sp & 255u) == 0u) { if (xb_ld(&bar[XB_TMO])) break; if (sp > XB_SPIN_CAP) { atomicAdd(&bar[XB_TMO], 1u); break; } }
    }
    nloc = mine > 0u ? mine : 1u; nx = cnt > 0u ? cnt : 1u;
}

__device__ __forceinline__ void xcd_barrier(const XcdBarrier& b) {
    asm volatile("s_waitcnt vmcnt(0)" ::: "memory");
    __syncthreads();
    if (threadIdx.x == 0) {
        unsigned* bar = b.bar;
        __builtin_amdgcn_s_waitcnt(0);
        unsigned nloc = b.st[0], nx = b.st[1];
        if (nloc == 0u) { xcd_barrier_complete(bar, b.x, nloc, nx); b.st[0] = nloc; b.st[1] = nx; }
        const unsigned old = xb_add(&bar[XB_XSUB(b.x)], 1u);
        const unsigned gen = old / nloc;
        if (old + 1u == (gen + 1u) * nloc) {
            __builtin_amdgcn_fence(__ATOMIC_RELEASE, "agent");
            asm volatile("s_waitcnt vmcnt(0)" ::: "memory");
            const unsigned og = xb_add(&bar[XB_TOP], 1u);
            const unsigned tg = og / nx;
            if (og + 1u == (tg + 1u) * nx) xb_add(&bar[XB_TOPGEN], 1u);
            else XB_SPIN(xb_ld(&bar[XB_TOPGEN]) == tg, bar);
            __builtin_amdgcn_fence(__ATOMIC_ACQUIRE, "agent");
            xb_add(&bar[XB_XGEN(b.x)], 1u);
            asm volatile("s_waitcnt vmcnt(0)" ::: "memory");
        } else {
            XB_SPIN(xb_ld(&bar[XB_XGEN(b.x)]) == gen, bar);
            __builtin_amdgcn_fence(__ATOMIC_ACQUIRE, "agent");
            asm volatile("s_waitcnt vmcnt(0)" ::: "memory");
        }
    }
    __syncthreads();
}

constexpr int T = 16384, D = 1024, SEQ = 8192, NCTX = 256, TCX = 512, DIN = 3840, MH = T + TCX;
constexpr int ZU = 0, ZV = 512, ZQ = 1024, ZK = 1536, ZVA = 1664, ZGA = 1792, ZGB = 2816;
constexpr int NEXP = 256, NSLOT = 9, LISTCAP = 16384, MOE_MAXT = 8;
constexpr float LOG2E = 1.4426950408889634f;
constexpr float QSCALE = 0.125f * LOG2E;
constexpr size_t MiB = 1u << 20;
constexpr size_t WS_CTL = 0, CTL_ZERO_BYTES = 1 * MiB;
constexpr size_t WS_ADAP = 1 * MiB;
constexpr size_t WS_ADAF = 2 * MiB;
constexpr size_t WS_ROPE = 2 * MiB + 128 * 1024;
constexpr size_t WS_WST = 2 * MiB + 256 * 1024;
constexpr size_t WS_RWT = 3 * MiB;
constexpr size_t WS_WINT = 4 * MiB;
constexpr size_t WS_WAT = 12 * MiB, WS_WBT = 13 * MiB, WS_WOT = 14 * MiB;
constexpr size_t WS_KVC = 16 * MiB;
constexpr size_t WS_GATEW = 17 * MiB;
constexpr size_t WS_H = 18 * MiB;
constexpr size_t WS_Z = 52 * MiB;
constexpr size_t WS_A = 172 * MiB, WS_O = 188 * MiB;
constexpr size_t WS_TMP = 204 * MiB;
constexpr size_t WS_Y = 268 * MiB;
constexpr size_t WS_X1 = 300 * MiB;
constexpr size_t WS_H2 = 364 * MiB;
constexpr size_t WS_LIST = 396 * MiB;
constexpr size_t WS_CONTRIB = 414 * MiB;
constexpr float CONTRIB_SCALE = 16.f;
constexpr size_t WS_END = 704 * MiB;
constexpr int CW_BAR = 4096;
constexpr int CW_CNT = 16384;
constexpr int CW_XRANK = 32768;
constexpr int SCR_BYTES = 148480;
constexpr int MISC_OFF = SCR_BYTES;
constexpr int LDS_BYTES = 152 * 1024;
constexpr int NWAVES = 8;

typedef float f32x2_t __attribute__((ext_vector_type(2)));
typedef __bf16 bf16x2_t __attribute__((ext_vector_type(2)));
typedef float f32x16 __attribute__((ext_vector_type(16)));
typedef short s16x4 __attribute__((ext_vector_type(4)));
typedef short v4i16_t __attribute__((ext_vector_type(4)));
typedef unsigned u32x2 __attribute__((ext_vector_type(2)));
typedef unsigned u32x4 __attribute__((ext_vector_type(4)));
typedef LAS unsigned char* ldsp;

__device__ __forceinline__ unsigned cvtpk(float lo, float hi) { f32x2_t v = {lo, hi}; bf16x2_t b = __builtin_convertvector(v, bf16x2_t); return __builtin_bit_cast(unsigned, b); }
__device__ __forceinline__ float bf2f(unsigned short u) { return __uint_as_float((unsigned)u << 16); }
__device__ __forceinline__ float bflo(unsigned w) { return __uint_as_float(w << 16); }
__device__ __forceinline__ float bfhi(unsigned w) { return __uint_as_float(w & 0xffff0000u); }
__device__ __forceinline__ float wave_sum(float v) {
#pragma unroll
    for (int o = 1; o < 64; o <<= 1) v += __shfl_xor(v, o);
    return v;
}
__device__ __forceinline__ float sigmoid_f(float x) { return __builtin_amdgcn_rcpf(1.f + __builtin_amdgcn_exp2f(-x * LOG2E)); }
__device__ __forceinline__ float silu_f(float x) { return x * sigmoid_f(x); }
__device__ __forceinline__ float gelu_f(float x) { const float u = 0.7978845608028654f * (x + 0.044715f * x * x * x); return x * sigmoid_f(2.f * u); }
__device__ __forceinline__ f32x16 mfma32(bf16x8 a, bf16x8 b, f32x16 c) { return __builtin_amdgcn_mfma_f32_32x32x16_bf16(a, b, c, 0, 0, 0); }
__device__ __forceinline__ f32x4 mfma16(bf16x8 a, bf16x8 b, f32x4 c) { return __builtin_amdgcn_mfma_f32_16x16x32_bf16(a, b, c, 0, 0, 0); }

struct Args { const float* in[26]; float* out; unsigned char* ws; int ph_lo, ph_hi; };
enum { I_X = 0, I_C, I_CTX, I_CCTX, I_ADAW, I_ADAB, I_N1G, I_N2G, I_WIN, I_LNG, I_LNB, I_GWS, I_GBS, I_SINK, I_WA, I_WB, I_WO, I_RW, I_RB, I_EG, I_EU, I_ED, I_SG, I_SU, I_SD, I_FG };

__device__ __forceinline__ void p0_transpose_item(const float* W, int K, int N, bf16* WT, LAS float* scr, int item, int lane) {
    const int nblk = N / 32, kb = item / nblk, nb = item % nblk, k0 = 64 * kb, n0 = 32 * nb;
#pragma unroll 8
    for (int i = 0; i < 32; ++i) { const int kk = 2 * i + (lane >> 5); scr[kk * 33 + (lane & 31)] = W[(size_t)(k0 + kk) * N + n0 + (lane & 31)]; }
    LDS_WAIT(); asm volatile("" ::: "memory");
    const int c = lane & 7;
#pragma unroll
    for (int j = 0; j < 4; ++j) { const int n = (lane >> 3) + 8 * j; const LAS float* s = scr + (8 * c) * 33 + n;
        v4u o; o.x = pk2(s[0 * 33], s[1 * 33]); o.y = pk2(s[2 * 33], s[3 * 33]); o.z = pk2(s[4 * 33], s[5 * 33]); o.w = pk2(s[6 * 33], s[7 * 33]);
        *(GAS v4u*)(WT + (size_t)(n0 + n) * K + k0 + 8 * c) = o; }
    LDS_WAIT(); asm volatile("" ::: "memory");
}

__device__ __forceinline__ void phase_prep(const Args& a, ldsp lds, int G) {
    const int tid = threadIdx.x, lane = tid & 63, wave = __builtin_amdgcn_readfirstlane(tid >> 6), blk = blockIdx.x;
    unsigned char* ws = a.ws;
    if (blk < 192) {
        const int cb = blk % 24, kc = blk / 24, col = cb * 256 + lane * 4, k0 = kc * 128 + wave * 16;
        const float* c = a.in[I_C]; const float* cc = a.in[I_CCTX]; const float* aw = a.in[I_ADAW];
        f32x4 a0 = {0.f, 0.f, 0.f, 0.f}, a1 = a0, a2 = a0;
#pragma unroll 4
        for (int k = 0; k < 16; ++k) {
            const int kk = k0 + k;
            const float s0 = silu_f(c[kk]), s1 = silu_f(c[1024 + kk]), s2 = silu_f(cc[kk]);
            const f32x4 w = *(const f32x4*)(aw + (size_t)kk * 6144 + col);
            a0 += w * s0; a1 += w * s1; a2 += w * s2;
        }
        LAS float* red = (LAS float*)lds;
        *(LAS f32x4*)(red + (wave * 3 + 0) * 256 + lane * 4) = a0;
        *(LAS f32x4*)(red + (wave * 3 + 1) * 256 + lane * 4) = a1;
        *(LAS f32x4*)(red + (wave * 3 + 2) * 256 + lane * 4) = a2;
        __syncthreads();
        float* adap = (float*)(ws + WS_ADAP);
        for (int idx = tid; idx < 768; idx += 512) {
            const int v = idx >> 8, cl = idx & 255; float s = 0.f;
#pragma unroll
            for (int w = 0; w < 8; ++w) s += red[(w * 3 + v) * 256 + cl];
            adap[(size_t)(kc * 3 + v) * 6144 + cb * 256 + cl] = s;
        }
        __syncthreads();
    }
    {
        LAS float* scr = (LAS float*)(lds + wave * 8704);
        const int gw = blk * NWAVES + wave, NGW = G * NWAVES;
        constexpr int I_1 = 16 * 120, I_2 = 8 * 32, I_3 = 8 * 32, I_4 = 16 * 32, I_5 = 16 * 8;
        for (int it = gw; it < I_1 + I_2 + I_3 + I_4 + I_5; it += NGW) {
            int r = it;
            if (r < I_1) { p0_transpose_item(a.in[I_WIN], 1024, 3840, (bf16*)(ws + WS_WINT), scr, r, lane); continue; } r -= I_1;
            if (r < I_2) { p0_transpose_item(a.in[I_WA], 512, 1024, (bf16*)(ws + WS_WAT), scr, r, lane); continue; } r -= I_2;
            if (r < I_3) { p0_transpose_item(a.in[I_WB], 512, 1024, (bf16*)(ws + WS_WBT), scr, r, lane); continue; } r -= I_3;
            if (r < I_4) { p0_transpose_item(a.in[I_WO], 1024, 1024, (bf16*)(ws + WS_WOT), scr, r, lane); continue; } r -= I_4;
            p0_transpose_item(a.in[I_RW], 1024, 256, (bf16*)(ws + WS_RWT), scr, r, lane);
        }
    }
    {
        const int gt = blk * 512 + tid, NT = G * 512;
        const float* gws = a.in[I_GWS]; bf16* wst = (bf16*)(ws + WS_WST);
        for (int i = gt; i < 8192; i += NT) {
            const f32x4 x0 = *(const f32x4*)(gws + i * 8), x1 = *(const f32x4*)(gws + i * 8 + 4);
            v4u o; o.x = cvtpk(x0[0], x0[1]); o.y = cvtpk(x0[2], x0[3]); o.z = cvtpk(x1[0], x1[1]); o.w = cvtpk(x1[2], x1[3]);
            *(v4u*)(wst + i * 8) = o;
        }
        float* rope = (float*)(ws + WS_ROPE);
        for (int i = gt; i < 2048; i += NT) {
            const int pos = i >> 4, f = i & 15;
            const float inv = __builtin_amdgcn_exp2f(-(float)f * (13.287712379549449f / 16.f));
            const float ang = (float)pos * inv;
            double rev = (double)ang * 0.15915494309189535; rev -= floor(rev);
            rope[pos * 32 + f] = __builtin_amdgcn_cosf((float)rev);
            rope[pos * 32 + 16 + f] = __builtin_amdgcn_sinf((float)rev);
        }
    }
}

__device__ __forceinline__ void phase_hnorm(const Args& a, ldsp lds, int G) {
    const int tid = threadIdx.x, lane = tid & 63, wave = __builtin_amdgcn_readfirstlane(tid >> 6), blk = blockIdx.x;
    unsigned char* ws = a.ws;
    const float* adap = (const float*)(ws + WS_ADAP); const float* adab = a.in[I_ADAB];
    LAS float* modv = (LAS float*)lds;
    {
        const int j = 4 * tid;
        f32x4 pv[3][9];
#pragma unroll
        for (int v = 0; v < 3; ++v) {
            pv[v][0] = *(const f32x4*)(adab + j);
#pragma unroll
            for (int kc = 0; kc < 8; ++kc) pv[v][kc + 1] = *(const f32x4*)(adap + (size_t)(kc * 3 + v) * 6144 + j);
        }
#pragma unroll
        for (int v = 0; v < 3; ++v) {
            f32x4 s = pv[v][0];
#pragma unroll
            for (int kc = 0; kc < 8; ++kc) s = s + pv[v][kc + 1];
            if (j >= 1024) s = s + (f32x4){1.f, 1.f, 1.f, 1.f};
            *(LAS f32x4*)(modv + v * 2048 + j) = s;
        }
    }
    { float* adaf = (float*)(ws + WS_ADAF);
      for (int idx = blk * 512 + tid; idx < 3 * 6144; idx += G * 512) {
          const int v = idx / 6144, j = idx % 6144; float s = adab[j];
#pragma unroll
          for (int kc = 0; kc < 8; ++kc) s += adap[(size_t)(kc * 3 + v) * 6144 + j];
          adaf[idx] = s; } }
    __syncthreads();
    const float* g1 = a.in[I_N1G]; bf16* H = (bf16*)(ws + WS_H);
    for (int t = blk * NWAVES + wave; t < MH; t += G * NWAVES) {
        const float* xr = (t < T) ? a.in[I_X] + (size_t)t * D : a.in[I_CTX] + (size_t)(t - T) * D;
        const int v = (t < T) ? (t >> 13) : 2;
        f32x4 x[4]; float ss = 0.f;
#pragma unroll
        for (int j = 0; j < 4; ++j) { x[j] = *(const f32x4*)(xr + 4 * lane + 256 * j); ss += (x[j][0] * x[j][0] + x[j][1] * x[j][1]) + (x[j][2] * x[j][2] + x[j][3] * x[j][3]); }
        const float r = rsqrtf(wave_sum(ss) * (1.f / D) + 1e-6f);
#pragma unroll
        for (int j = 0; j < 4; ++j) {
            const int col = 4 * lane + 256 * j;
            const f32x4 g = *(const f32x4*)(g1 + col);
            const f32x4 sh = *(LAS f32x4*)(modv + v * 2048 + col), sc = *(LAS f32x4*)(modv + v * 2048 + 1024 + col);
            const f32x4 h = (x[j] * r) * g * sc + sh;
            u32x2 o; o.x = cvtpk(h[0], h[1]); o.y = cvtpk(h[2], h[3]);
            *(u32x2*)(H + (size_t)t * D + col) = o;
        }
    }
}

struct WinOrder {
    pg8::StaticOrder so;
    __device__ void init(int G, int c) { so.init(T, DIN, G, c); }
    __device__ bool next(int i, pg8::Unit& u) const {
        const long L = (long)i * so.G + so.c;
        if (L < 960) return so.next(i, u);
        if (L < 962) { u.pm = 64 + (int)(L - 960); u.pn = 6; return true; }
        return false;
    }
    __device__ __forceinline__ void a_ready(const pg8::Unit&) const {}
    __device__ __forceinline__ void done(const pg8::Unit&) const {}
};
struct EpiWin {
    static constexpr bool PERM = false, AFTER_DRAIN = false;
    bf16* Z; bf16* KVC; const float* rope;
    __device__ __forceinline__ void operator()(const pg8::f32x4 (&acc)[2][2][4][2], const pg8::Unit& u, int wr, int wc, int fr, int fq) const {
        const int row0 = u.pm * 256 + wr * 64 + fr, colb = u.pn * 256 + wc * 32 + 4 * fq, pn = u.pn;
        if (u.pm >= 64) {
#pragma unroll
            for (int ai = 0; ai < 2; ++ai)
#pragma unroll
                for (int m = 0; m < 4; ++m) { bf16* rp = KVC + (size_t)(row0 + ai * 128 + m * 16 - T) * 256 + (colb - ZK);
#pragma unroll
                    for (int bj = 0; bj < 2; ++bj)
#pragma unroll
                        for (int n = 0; n < 2; ++n) { const pg8::f32x4 v = acc[ai][bj][m][n]; u32x2 o; o.x = cvtpk(v[0], v[1]); o.y = cvtpk(v[2], v[3]); *(u32x2*)(rp + bj * 128 + n * 16) = o; } }
            return;
        }
#pragma unroll
        for (int ai = 0; ai < 2; ++ai)
#pragma unroll
            for (int m = 0; m < 4; ++m) {
                const int r = row0 + ai * 128 + m * 16; bf16* rp = Z + (size_t)r * DIN + colb;
                if (pn <= 3) {
#pragma unroll
                    for (int bj = 0; bj < 2; ++bj)
#pragma unroll
                        for (int n = 0; n < 2; ++n) { const pg8::f32x4 v = acc[ai][bj][m][n]; u32x2 o; o.x = cvtpk(gelu_f(v[0]), gelu_f(v[1])); o.y = cvtpk(gelu_f(v[2]), gelu_f(v[3])); *(u32x2*)(rp + bj * 128 + n * 16) = o; }
                } else if (pn <= 6) {
                    const int pos = (wc & 1) ? (r & 63) : ((r & 8191) >> 6);
                    const pg8::f32x4 cs = *(const pg8::f32x4*)(rope + pos * 32 + 4 * fq), sn = *(const pg8::f32x4*)(rope + pos * 32 + 16 + 4 * fq);
                    const float sc = (pn < 6) ? QSCALE : 1.f;
#pragma unroll
                    for (int bj = 0; bj < 2; ++bj) {
                        const pg8::f32x4 x1 = acc[ai][bj][m][0], x2 = acc[ai][bj][m][1];
                        pg8::f32x4 o1, o2;
                        if (pn == 6 && bj == 1) { o1 = x1; o2 = x2; }
                        else { o1 = (x1 * cs - x2 * sn) * sc; o2 = (x2 * cs + x1 * sn) * sc; }
                        u32x2 w1, w2; w1.x = cvtpk(o1[0], o1[1]); w1.y = cvtpk(o1[2], o1[3]); w2.x = cvtpk(o2[0], o2[1]); w2.y = cvtpk(o2[2], o2[3]);
                        *(u32x2*)(rp + bj * 128) = w1; *(u32x2*)(rp + bj * 128 + 16) = w2;
                    }
                } else {
#pragma unroll
                    for (int bj = 0; bj < 2; ++bj)
#pragma unroll
                        for (int n = 0; n < 2; ++n) { const pg8::f32x4 v = acc[ai][bj][m][n]; u32x2 o; o.x = cvtpk(sigmoid_f(v[0]), sigmoid_f(v[1])); o.y = cvtpk(sigmoid_f(v[2]), sigmoid_f(v[3])); *(u32x2*)(rp + bj * 128 + n * 16) = o; }
                }
            }
    }
};
struct EpiMergeA {
    static constexpr bool PERM = true, AFTER_DRAIN = false;
    const bf16* Z; bf16* Y;
    __device__ __forceinline__ void operator()(const pg8::f32x4 (&acc)[2][2][4][2], const pg8::Unit& u, int wr, int wc, int fr, int fq) const {
        const int row0 = u.pm * 256 + wr * 64 + fr, col0 = u.pn * 256 + wc * 32 + 8 * fq;
#pragma unroll
        for (int ai = 0; ai < 2; ++ai)
#pragma unroll
            for (int m = 0; m < 4; ++m) { const int r = row0 + ai * 128 + m * 16;
#pragma unroll
                for (int bj = 0; bj < 2; ++bj) { const int c = col0 + bj * 128;
                    const u32x4 g = *(const u32x4*)(Z + (size_t)r * DIN + ZGA + c);
                    const pg8::f32x4 v0 = acc[ai][bj][m][0], v1 = acc[ai][bj][m][1];
                    u32x4 o;
                    o.x = cvtpk(v0[0] * bflo(g.x), v0[1] * bfhi(g.x)); o.y = cvtpk(v0[2] * bflo(g.y), v0[3] * bfhi(g.y));
                    o.z = cvtpk(v1[0] * bflo(g.z), v1[1] * bfhi(g.z)); o.w = cvtpk(v1[2] * bflo(g.w), v1[3] * bfhi(g.w));
                    *(u32x4*)(Y + (size_t)r * D + c) = o; } }
    }
};
struct EpiMergeB {
    static constexpr bool PERM = true, AFTER_DRAIN = false;
    const bf16* Z; bf16* Y;
    __device__ __forceinline__ void operator()(const pg8::f32x4 (&acc)[2][2][4][2], const pg8::Unit& u, int wr, int wc, int fr, int fq) const {
        const int row0 = u.pm * 256 + wr * 64 + fr, col0 = u.pn * 256 + wc * 32 + 8 * fq;
#pragma unroll
        for (int ai = 0; ai < 2; ++ai)
#pragma unroll
            for (int m = 0; m < 4; ++m) { const int r = row0 + ai * 128 + m * 16;
#pragma unroll
                for (int bj = 0; bj < 2; ++bj) { const int c = col0 + bj * 128;
                    const u32x4 g = *(const u32x4*)(Z + (size_t)r * DIN + ZGB + c);
                    const u32x4 tp = *(const u32x4*)(Y + (size_t)r * D + c);
                    const pg8::f32x4 t0 = {bflo(tp.x), bfhi(tp.x), bflo(tp.y), bfhi(tp.y)}, t1 = {bflo(tp.z), bfhi(tp.z), bflo(tp.w), bfhi(tp.w)};
                    const pg8::f32x4 v0 = acc[ai][bj][m][0], v1 = acc[ai][bj][m][1];
                    u32x4 o;
                    o.x = cvtpk(t0[0] + v0[0] * bflo(g.x), t0[1] + v0[1] * bfhi(g.x)); o.y = cvtpk(t0[2] + v0[2] * bflo(g.y), t0[3] + v0[3] * bfhi(g.y));
                    o.z = cvtpk(t1[0] + v1[0] * bflo(g.z), t1[1] + v1[1] * bfhi(g.z)); o.w = cvtpk(t1[2] + v1[2] * bflo(g.w), t1[3] + v1[3] * bfhi(g.w));
                    *(u32x4*)(Y + (size_t)r * D + c) = o; } }
    }
};
struct EpiWo {
    static constexpr bool PERM = true, AFTER_DRAIN = false;
    const float* x; const float* adaf; bf16* X1;
    __device__ __forceinline__ void operator()(const pg8::f32x4 (&acc)[2][2][4][2], const pg8::Unit& u, int wr, int wc, int fr, int fq) const {
        const int row0 = u.pm * 256 + wr * 64 + fr, col0 = u.pn * 256 + wc * 32 + 8 * fq;
        const float* g1 = adaf + (u.pm >= 32 ? 6144 : 0) + 2048;
#pragma unroll
        for (int bj = 0; bj < 2; ++bj) { const int c = col0 + bj * 128;
            const pg8::f32x4 ga = *(const pg8::f32x4*)(g1 + c), gb = *(const pg8::f32x4*)(g1 + c + 4);
#pragma unroll
            for (int ai = 0; ai < 2; ++ai)
#pragma unroll
                for (int m = 0; m < 4; ++m) { const int r = row0 + ai * 128 + m * 16;
                    const pg8::f32x4 x0 = *(const pg8::f32x4*)(x + (size_t)r * D + c), x1 = *(const pg8::f32x4*)(x + (size_t)r * D + c + 4);
                    const pg8::f32x4 o0 = x0 + ga * acc[ai][bj][m][0], o1 = x1 + gb * acc[ai][bj][m][1];
                    u32x4 w; w.x = cvtpk(o0[0], o0[1]); w.y = cvtpk(o0[2], o0[3]); w.z = cvtpk(o1[0], o1[1]); w.w = cvtpk(o1[2], o1[3]);
                    *(u32x4*)(X1 + (size_t)r * D + c) = w; } }
    }
};


__device__ __forceinline__ s16x4 vtr(LAS const unsigned char* p) { return __builtin_bit_cast(s16x4, __builtin_amdgcn_ds_read_tr16_b64_v4i16((LAS v4i16_t*)p)); }

typedef float f32x8v __attribute__((ext_vector_type(8)));
__device__ __forceinline__ void attn_item(const bf16* Z, const bf16* KVC, const float* sink, bf16* Obuf, ldsp lds, int b, int nb, int hk, int qh) {
    const int tid = threadIdx.x, lane = tid & 63, wave = __builtin_amdgcn_readfirstlane(tid >> 6), r32 = lane & 31, hi = lane >> 5;
    const int rq = wave >> 1, head = hk * 4 + rq;
    const int iq = qh * 64 + (wave & 1) * 32 + r32;
    const int wlo = (nb == 0) ? 2 : qh, whi = (nb == 63) ? 4 : 5 + qh, nwin = whi - wlo, ntile = nwin + 4;
    const int tokq = b * SEQ + nb * 128 + iq;
    bf16x8 qr[4];
#pragma unroll
    for (int d0 = 0; d0 < 4; ++d0) qr[d0] = *(const bf16x8*)(Z + (size_t)tokq * DIN + ZQ + head * 64 + d0 * 16 + hi * 8);
    float mrun = sink[head] * LOG2E, lrun = (hi == 0) ? 1.f : 0.f;
    f32x16 o[2];
#pragma unroll
    for (int j = 0; j < 2; ++j)
#pragma unroll
        for (int r = 0; r < 16; ++r) o[j][r] = 0.f;
    const int kdst = wave * 1024 + lane * 16, vdst = 8192 + (wave >> 2) * 4096 + lane * 64 + (wave & 3) * 16;
#define ATT_SRC(s, kp, vp) do { const int tl_ = (s) < nwin ? wlo + (s) : 6 + (s) - nwin; \
        if (tl_ < 6) { const int tok_ = b * SEQ + (nb - 1 + (tl_ >> 1)) * 128 + (tl_ & 1) * 64 + lane; kp = Z + (size_t)tok_ * DIN + ZK + hk * 64 + wave * 8; vp = Z + (size_t)tok_ * DIN + ZVA + hk * 64 + wave * 8; } \
        else { const int row_ = b * NCTX + (tl_ - 6) * 64 + lane; kp = KVC + (size_t)row_ * 256 + hk * 64 + wave * 8; vp = KVC + (size_t)row_ * 256 + 128 + hk * 64 + wave * 8; } } while (0)
    u32x4 kreg, vreg;
    { const bf16 *kp, *vp; ATT_SRC(0, kp, vp); kreg = *(const u32x4*)kp; vreg = *(const u32x4*)vp; }
    *(LAS u32x4*)(lds + kdst) = kreg; *(LAS u32x4*)(lds + vdst) = vreg;
    __syncthreads();
    const int vrd = ((lane & 15) >> 2) * 64 + ((lane >> 4) & 1) * 32 + (lane & 3) * 8 + hi * 256;
    for (int s = 0; s < ntile; ++s) {
        const int base = (s & 1) * 16384;
        const int tl = s < nwin ? wlo + s : 6 + s - nwin;
        if (s + 1 < ntile) { const bf16 *kp, *vp; ATT_SRC(s + 1, kp, vp); kreg = *(const u32x4*)kp; vreg = *(const u32x4*)vp; }
        {
            f32x16 p0, p1;
#pragma unroll
            for (int r = 0; r < 16; ++r) { p0[r] = 0.f; p1[r] = 0.f; }
#pragma unroll
            for (int d0 = 0; d0 < 4; ++d0) {
                const bf16x8 k0 = *(LAS const bf16x8*)(lds + base + (2 * d0 + hi) * 1024 + r32 * 16);
                const bf16x8 k1 = *(LAS const bf16x8*)(lds + base + (2 * d0 + hi) * 1024 + (r32 + 32) * 16);
                p0 = mfma32(k0, qr[d0], p0); p1 = mfma32(k1, qr[d0], p1);
            }
            if (tl < 2) {
                const int j0 = (tl & 1) * 64 + 4 * hi;
#pragma unroll
                for (int r = 0; r < 16; ++r) { const int j = j0 + (r & 3) + 8 * (r >> 2); if (j < iq) p0[r] = -INFINITY; if (j + 32 < iq) p1[r] = -INFINITY; }
            } else if (tl == 4 || tl == 5) {
                const int j0 = (tl & 1) * 64 + 4 * hi;
#pragma unroll
                for (int r = 0; r < 16; ++r) { const int j = j0 + (r & 3) + 8 * (r >> 2); if (j > iq) p0[r] = -INFINITY; if (j + 32 > iq) p1[r] = -INFINITY; }
            }
            float mx = fmaxf(p0[0], p1[0]);
#pragma unroll
            for (int r = 1; r < 16; ++r) mx = fmaxf(mx, fmaxf(p0[r], p1[r]));
            mx = fmaxf(mx, __shfl_xor(mx, 32));
            const float mn = fmaxf(mrun, mx), alpha = __builtin_amdgcn_exp2f(mrun - mn);
            mrun = mn;
            p0 = p0 - mn; p1 = p1 - mn;
#pragma unroll
            for (int r = 0; r < 16; ++r) { p0[r] = __builtin_amdgcn_exp2f(p0[r]); p1[r] = __builtin_amdgcn_exp2f(p1[r]); }
            const f32x16 t16 = p0 + p1;
            const f32x8v t8 = __builtin_shufflevector(t16, t16, 0, 1, 2, 3, 4, 5, 6, 7) + __builtin_shufflevector(t16, t16, 8, 9, 10, 11, 12, 13, 14, 15);
            const f32x4 t4 = __builtin_shufflevector(t8, t8, 0, 1, 2, 3) + __builtin_shufflevector(t8, t8, 4, 5, 6, 7);
            const float rs = (t4[0] + t4[1]) + (t4[2] + t4[3]);
            lrun = lrun * alpha + rs;
#pragma unroll
            for (int r = 0; r < 16; ++r) { o[0][r] *= alpha; o[1][r] *= alpha; }
            bf16x8 pf[4];
#pragma unroll
            for (int s4 = 0; s4 < 4; ++s4) {
                u32x4 w;
                if (s4 < 2) { w.x = cvtpk(p0[8 * s4 + 0], p0[8 * s4 + 1]); w.y = cvtpk(p0[8 * s4 + 2], p0[8 * s4 + 3]); w.z = cvtpk(p0[8 * s4 + 4], p0[8 * s4 + 5]); w.w = cvtpk(p0[8 * s4 + 6], p0[8 * s4 + 7]); }
                else { const int q = s4 - 2; w.x = cvtpk(p1[8 * q + 0], p1[8 * q + 1]); w.y = cvtpk(p1[8 * q + 2], p1[8 * q + 3]); w.z = cvtpk(p1[8 * q + 4], p1[8 * q + 5]); w.w = cvtpk(p1[8 * q + 6], p1[8 * q + 7]); }
                pf[s4] = __builtin_bit_cast(bf16x8, w);
            }
#pragma unroll
            for (int dblk = 0; dblk < 2; ++dblk)
#pragma unroll
                for (int s4 = 0; s4 < 4; ++s4) {
                    const s16x4 lo = vtr(lds + base + 8192 + dblk * 4096 + vrd + (16 * s4) * 64);
                    const s16x4 hh = vtr(lds + base + 8192 + dblk * 4096 + vrd + (16 * s4 + 8) * 64);
                    const bf16x8 vf = {lo[0], lo[1], lo[2], lo[3], hh[0], hh[1], hh[2], hh[3]};
                    o[dblk] = mfma32(vf, pf[s4], o[dblk]);
                }
        }
        if (s + 1 < ntile) { *(LAS u32x4*)(lds + (16384 - base) + kdst) = kreg; *(LAS u32x4*)(lds + (16384 - base) + vdst) = vreg; }
        __syncthreads();
    }
#undef ATT_SRC
    {
        const float lt = lrun + __shfl_xor(lrun, 32), inv = 1.f / lt;
        bf16* op = Obuf + (size_t)tokq * 512 + head * 64;
#pragma unroll
        for (int dblk = 0; dblk < 2; ++dblk)
#pragma unroll
            for (int r4 = 0; r4 < 4; ++r4) {
                u32x2 w; w.x = cvtpk(o[dblk][4 * r4] * inv, o[dblk][4 * r4 + 1] * inv); w.y = cvtpk(o[dblk][4 * r4 + 2] * inv, o[dblk][4 * r4 + 3] * inv);
                *(u32x2*)(op + 32 * dblk + 8 * r4 + 4 * hi) = w;
            }
    }
}

__device__ __forceinline__ void gmlp_item(const bf16* Z, const float* lng, const float* lnb, const bf16* WsT, const float* bs, bf16* Abuf, ldsp lds, int ch, int gp) {
    const int tid = threadIdx.x, lane = tid & 63, wave = __builtin_amdgcn_readfirstlane(tid >> 6), fr = lane & 15, fq = lane >> 4;
    const int tok0 = ch * 128;
    LAS bf16* VT = (LAS bf16*)lds;
    f32x4 gA = *(const f32x4*)(lng + lane * 8), gB = *(const f32x4*)(lng + lane * 8 + 4), bA = *(const f32x4*)(lnb + lane * 8), bB = *(const f32x4*)(lnb + lane * 8 + 4);
#pragma unroll
    for (int rnd = 0; rnd < 2; ++rnd) {
        float y[8][8];
#pragma unroll
        for (int j = 0; j < 8; ++j) {
            const int tok = tok0 + wave * 16 + rnd * 8 + j;
            const u32x4 raw = *(const u32x4*)(Z + (size_t)tok * DIN + ZV + lane * 8);
            float x[8] = {bflo(raw.x), bfhi(raw.x), bflo(raw.y), bfhi(raw.y), bflo(raw.z), bfhi(raw.z), bflo(raw.w), bfhi(raw.w)};
            float s = 0.f;
#pragma unroll
            for (int i = 0; i < 8; ++i) s += x[i];
            const float mu = wave_sum(s) * (1.f / 512.f);
            float q = 0.f;
#pragma unroll
            for (int i = 0; i < 8; ++i) { x[i] -= mu; q += x[i] * x[i]; }
            const float rstd = rsqrtf(wave_sum(q) * (1.f / 512.f) + 1e-6f);
            y[j][0] = x[0] * rstd * gA[0] + bA[0]; y[j][1] = x[1] * rstd * gA[1] + bA[1]; y[j][2] = x[2] * rstd * gA[2] + bA[2]; y[j][3] = x[3] * rstd * gA[3] + bA[3];
            y[j][4] = x[4] * rstd * gB[0] + bB[0]; y[j][5] = x[5] * rstd * gB[1] + bB[1]; y[j][6] = x[6] * rstd * gB[2] + bB[2]; y[j][7] = x[7] * rstd * gB[3] + bB[3];
        }
        if ((lane >> 5) == gp) {
            const int gl = (lane >> 4) & 1;
#pragma unroll
            for (int i = 0; i < 8; ++i) {
                u32x4 w; w.x = cvtpk(y[0][i], y[1][i]); w.y = cvtpk(y[2][i], y[3][i]); w.z = cvtpk(y[4][i], y[5][i]); w.w = cvtpk(y[6][i], y[7][i]);
                *(LAS u32x4*)(VT + gl * (128 * 136) + (8 * (lane & 15) + i) * 136 + wave * 16 + rnd * 8) = w;
            }
        }
    }
    __syncthreads();
    const int wm = wave >> 1, wn = wave & 1;
    u32x2 uwv[2][2][4];
#pragma unroll
    for (int gl = 0; gl < 2; ++gl)
#pragma unroll
        for (int m = 0; m < 2; ++m)
#pragma unroll
            for (int n = 0; n < 4; ++n) uwv[gl][m][n] = *(const u32x2*)(Z + (size_t)(tok0 + 32 * wm + 16 * m + fr) * DIN + ZU + (2 * gp + gl) * 128 + 64 * wn + 16 * n + 4 * fq);
#pragma unroll
    for (int gl = 0; gl < 2; ++gl) {
        const int g = 2 * gp + gl;
        f32x4 acc[2][4];
#pragma unroll
        for (int m = 0; m < 2; ++m)
#pragma unroll
            for (int n = 0; n < 4; ++n) acc[m][n] = (f32x4){0.f, 0.f, 0.f, 0.f};
#pragma unroll
        for (int ks = 0; ks < 4; ++ks) {
            bf16x8 af[2], bfr[4];
#pragma unroll
            for (int m = 0; m < 2; ++m) af[m] = *(const bf16x8*)(WsT + (size_t)g * 16384 + (32 * wm + 16 * m + fr) * 128 + 32 * ks + 8 * fq);
#pragma unroll
            for (int n = 0; n < 4; ++n) bfr[n] = *(LAS const bf16x8*)(VT + gl * (128 * 136) + (64 * wn + 16 * n + fr) * 136 + 32 * ks + 8 * fq);
#pragma unroll
            for (int m = 0; m < 2; ++m)
#pragma unroll
                for (int n = 0; n < 4; ++n) acc[m][n] = mfma16(bfr[n], af[m], acc[m][n]);
        }
#pragma unroll
        for (int m = 0; m < 2; ++m) {
            const int p = 32 * wm + 16 * m + fr, tok = tok0 + p; const float bias = bs[g * 128 + p];
#pragma unroll
            for (int n = 0; n < 4; ++n) {
                const int c = g * 128 + 64 * wn + 16 * n + 4 * fq;
                const u32x2 uw = uwv[gl][m][n];
                u32x2 w; w.x = cvtpk(bflo(uw.x) * (acc[m][n][0] + bias), bfhi(uw.x) * (acc[m][n][1] + bias)); w.y = cvtpk(bflo(uw.y) * (acc[m][n][2] + bias), bfhi(uw.y) * (acc[m][n][3] + bias));
                *(u32x2*)(Abuf + (size_t)tok * 512 + c) = w;
            }
        }
    }
    __syncthreads();
}

__device__ __forceinline__ void phase_mixers(const Args& a, ldsp lds, int G, int vcu) {
    unsigned char* ws = a.ws;
    const bf16* Z = (const bf16*)(ws + WS_Z);
    for (int it = vcu; it < 512; it += G) {
        const int qh = it & 1, hk = (it >> 1) & 1, nb = (it >> 2) & 63, b = it >> 8;
        attn_item(Z, (const bf16*)(ws + WS_KVC), a.in[I_SINK], (bf16*)(ws + WS_O), lds, b, nb, hk, qh);
    }
    for (int it = vcu; it < 256; it += G) {
        gmlp_item(Z, a.in[I_LNG], a.in[I_LNB], (const bf16*)(ws + WS_WST), a.in[I_GBS], (bf16*)(ws + WS_A), lds, it >> 1, it & 1);
    }
}

#define KI_BEFORE(ka, ia, kb, ib) (((ka) > (kb)) || ((ka) == (kb) && (ia) < (ib)))
#define KI_CAS(K, I, p, q) do { const bool sw_ = KI_BEFORE(K[q], I[q], K[p], I[p]); const float kp_ = sw_ ? K[q] : K[p], kq_ = sw_ ? K[p] : K[q]; const int ip_ = sw_ ? I[q] : I[p], iq_ = sw_ ? I[p] : I[q]; \
        K[p] = kp_; I[p] = ip_; K[q] = kq_; I[q] = iq_; } while (0)
#define KI_SORT8(K, I) do { KI_CAS(K, I, 0, 1); KI_CAS(K, I, 2, 3); KI_CAS(K, I, 4, 5); KI_CAS(K, I, 6, 7); \
        KI_CAS(K, I, 0, 2); KI_CAS(K, I, 1, 3); KI_CAS(K, I, 4, 6); KI_CAS(K, I, 5, 7); \
        KI_CAS(K, I, 1, 2); KI_CAS(K, I, 5, 6); KI_CAS(K, I, 0, 4); KI_CAS(K, I, 3, 7); \
        KI_CAS(K, I, 1, 5); KI_CAS(K, I, 2, 6); KI_CAS(K, I, 1, 4); KI_CAS(K, I, 3, 6); \
        KI_CAS(K, I, 2, 4); KI_CAS(K, I, 3, 5); KI_CAS(K, I, 3, 4); } while (0)
#define KI_MERGE8(KA, IA, KB, IB) do { \
        _Pragma("unroll") for (int r_ = 0; r_ < 8; ++r_) { const bool tb_ = KI_BEFORE(KB[7 - r_], IB[7 - r_], KA[r_], IA[r_]); KA[r_] = tb_ ? KB[7 - r_] : KA[r_]; IA[r_] = tb_ ? IB[7 - r_] : IA[r_]; } \
        KI_CAS(KA, IA, 0, 4); KI_CAS(KA, IA, 1, 5); KI_CAS(KA, IA, 2, 6); KI_CAS(KA, IA, 3, 7); \
        KI_CAS(KA, IA, 0, 2); KI_CAS(KA, IA, 1, 3); KI_CAS(KA, IA, 4, 6); KI_CAS(KA, IA, 5, 7); \
        KI_CAS(KA, IA, 0, 1); KI_CAS(KA, IA, 2, 3); KI_CAS(KA, IA, 4, 5); KI_CAS(KA, IA, 6, 7); } while (0)
__device__ __forceinline__ void router_item(const Args& a, ldsp lds, int it) {
    const int tid = threadIdx.x, lane = tid & 63, wave = __builtin_amdgcn_readfirstlane(tid >> 6), fr = lane & 15, fq = lane >> 4;
    unsigned char* ws = a.ws;
    const int t0 = it * 64, b = t0 >> 13;
    const bf16* X1 = (const bf16*)(ws + WS_X1); const float* adaf = (const float*)(ws + WS_ADAF) + b * 6144;
    const float* g2 = a.in[I_N2G]; unsigned char* H2 = ws + WS_H2;
    {
        f32x4 gm[2][2], sh[2][2];
#pragma unroll
        for (int j = 0; j < 2; ++j)
#pragma unroll
            for (int h = 0; h < 2; ++h) {
                const int c = 8 * lane + 512 * j + 4 * h;
                const f32x4 gg = *(const f32x4*)(g2 + c), sc = *(const f32x4*)(adaf + 4 * 1024 + c);
                gm[j][h] = gg * (sc + 1.f); sh[j][h] = *(const f32x4*)(adaf + 3 * 1024 + c);
            }
#pragma unroll
        for (int half = 0; half < 2; ++half) {
            f32x4 x[4][2][2];
#pragma unroll
            for (int tt = 0; tt < 4; ++tt)
#pragma unroll
                for (int j = 0; j < 2; ++j) {
                    const u32x4 w = *(const u32x4*)(X1 + (size_t)(t0 + wave * 8 + half * 4 + tt) * D + 8 * lane + 512 * j);
                    x[tt][j][0] = (f32x4){bflo(w.x), bfhi(w.x), bflo(w.y), bfhi(w.y)}; x[tt][j][1] = (f32x4){bflo(w.z), bfhi(w.z), bflo(w.w), bfhi(w.w)};
                }
#pragma unroll
            for (int tt = 0; tt < 4; ++tt) {
                const int row = wave * 8 + half * 4 + tt, tok = t0 + row;
                float ss = 0.f;
#pragma unroll
                for (int j = 0; j < 2; ++j)
#pragma unroll
                    for (int h = 0; h < 2; ++h) { const f32x4 v = x[tt][j][h]; ss += (v[0] * v[0] + v[1] * v[1]) + (v[2] * v[2] + v[3] * v[3]); }
                const float r = rsqrtf(wave_sum(ss) * (1.f / D) + 1e-6f);
#pragma unroll
                for (int j = 0; j < 2; ++j) {
                    const f32x4 h0 = (x[tt][j][0] * r) * gm[j][0] + sh[j][0], h1 = (x[tt][j][1] * r) * gm[j][1] + sh[j][1];
                    u32x4 w; w.x = cvtpk(h0[0], h0[1]); w.y = cvtpk(h0[2], h0[3]); w.z = cvtpk(h1[0], h1[1]); w.w = cvtpk(h1[2], h1[3]);
                    { int f0 = 0, f1 = 0;
                      f0 = __builtin_amdgcn_cvt_pk_fp8_f32(h0[0], h0[1], f0, false); f0 = __builtin_amdgcn_cvt_pk_fp8_f32(h0[2], h0[3], f0, true);
                      f1 = __builtin_amdgcn_cvt_pk_fp8_f32(h1[0], h1[1], f1, false); f1 = __builtin_amdgcn_cvt_pk_fp8_f32(h1[2], h1[3], f1, true);
                      u32x2 w8; w8.x = (unsigned)f0; w8.y = (unsigned)f1; *(u32x2*)(H2 + (size_t)tok * D + 8 * lane + 512 * j) = w8; }
                    const int kc = lane + 64 * j;
                    *(LAS u32x4*)(lds + kc * 1024 + ((row ^ (kc & 7)) * 16)) = w;
                }
            }
        }
    }
    __syncthreads();
    f32x4 acc[4][2];
#pragma unroll
    for (int m = 0; m < 4; ++m)
#pragma unroll
        for (int n = 0; n < 2; ++n) acc[m][n] = (f32x4){0.f, 0.f, 0.f, 0.f};
    const bf16* RwT = (const bf16*)(ws + WS_RWT) + (size_t)(32 * wave + fr) * D + 8 * fq;
#pragma unroll 8
    for (int ks = 0; ks < 32; ++ks) {
        const int kc = 4 * ks + fq;
        bf16x8 af[4], bfr[2];
#pragma unroll
        for (int n = 0; n < 2; ++n) bfr[n] = *(const bf16x8*)(RwT + (size_t)(16 * n) * D + 32 * ks);
#pragma unroll
        for (int m = 0; m < 4; ++m) af[m] = *(LAS const bf16x8*)(lds + kc * 1024 + (((16 * m + fr) ^ (kc & 7)) * 16));
#pragma unroll
        for (int m = 0; m < 4; ++m)
#pragma unroll
            for (int n = 0; n < 2; ++n) acc[m][n] = mfma16(af[m], bfr[n], acc[m][n]);
    }
    __syncthreads();
    LAS float* LG = (LAS float*)lds;
#pragma unroll
    for (int m = 0; m < 4; ++m)
#pragma unroll
        for (int n = 0; n < 2; ++n)
#pragma unroll
            for (int reg = 0; reg < 4; ++reg) LG[(32 * wave + 16 * n + fr) * 65 + 16 * m + 4 * fq + reg] = acc[m][n][reg];
    __syncthreads();
    LAS float* CK = (LAS float*)(lds + 69632); LAS int* CI = (LAS int*)(lds + 69632 + 16384);
    const float* rb = a.in[I_RB];
    float bk[8]; int bi[8];
#pragma unroll
    for (int q = 0; q < 4; ++q) {
        float gk[8]; int gi[8];
#pragma unroll
        for (int j = 0; j < 8; ++j) { const int e = 32 * wave + 8 * q + j; gk[j] = sigmoid_f(LG[e * 65 + lane]) + rb[e]; gi[j] = e; }
        KI_SORT8(gk, gi);
        if (q == 0) {
#pragma unroll
            for (int j = 0; j < 8; ++j) { bk[j] = gk[j]; bi[j] = gi[j]; }
        } else KI_MERGE8(bk, bi, gk, gi);
    }
#pragma unroll
    for (int r = 0; r < 8; ++r) { CK[(wave * 8 + r) * 64 + lane] = bk[r]; CI[(wave * 8 + r) * 64 + lane] = bi[r]; }
    __syncthreads();
#define RT_LEVEL(lvl) do { if ((wave & (2 * (lvl) - 1)) == 0) { float ok_[8]; int oi_[8]; \
            _Pragma("unroll") for (int r = 0; r < 8; ++r) { ok_[r] = CK[((wave + (lvl)) * 8 + r) * 64 + lane]; oi_[r] = CI[((wave + (lvl)) * 8 + r) * 64 + lane]; } \
            KI_MERGE8(bk, bi, ok_, oi_); \
            if ((lvl) < 4) { _Pragma("unroll") for (int r = 0; r < 8; ++r) { CK[(wave * 8 + r) * 64 + lane] = bk[r]; CI[(wave * 8 + r) * 64 + lane] = bi[r]; } } } \
        __syncthreads(); } while (0)
    RT_LEVEL(1); RT_LEVEL(2); RT_LEVEL(4);
#undef RT_LEVEL
    LAS unsigned* hist = (LAS unsigned*)(lds + 102400); LAS unsigned* hbase = hist + 256;
    if (tid < 256) hist[tid] = 0u;
    __syncthreads();
    unsigned* cnt = (unsigned*)(ws + WS_CTL) + CW_CNT; int* list = (int*)(ws + WS_LIST); float* gatew = (float*)(ws + WS_GATEW);
    unsigned rank[8];
    if (wave == 0) {
        const int tok = t0 + lane;
        float sel[8], ssum = 0.f;
#pragma unroll
        for (int r = 0; r < 8; ++r) { sel[r] = sigmoid_f(LG[bi[r] * 65 + lane]); ssum += sel[r]; }
#pragma unroll
        for (int r = 0; r < 8; ++r) rank[r] = __hip_atomic_fetch_add(&hist[bi[r]], 1u, __ATOMIC_RELAXED, __HIP_MEMORY_SCOPE_WORKGROUP);
        const float sc = 2.5f / ssum;
        f32x4 g0 = {sel[0] * sc, sel[1] * sc, sel[2] * sc, sel[3] * sc}, g1 = {sel[4] * sc, sel[5] * sc, sel[6] * sc, sel[7] * sc};
        *(f32x4*)(gatew + tok * 8) = g0; *(f32x4*)(gatew + tok * 8 + 4) = g1;
    }
    __syncthreads();
    if (tid < 256) { const unsigned h = hist[tid]; if (h) hbase[tid] = atomicAdd(cnt + 32 * tid, h); }
    __syncthreads();
    if (wave == 0) {
        const int tok = t0 + lane;
#pragma unroll
        for (int r = 0; r < 8; ++r) list[(size_t)bi[r] * LISTCAP + hbase[bi[r]] + rank[r]] = tok * NSLOT + r;
    }
    __syncthreads();
}

__device__ __forceinline__ const float* uni_ptr(const float* p) {
    const unsigned long long v = (unsigned long long)p;
    const unsigned lo = __builtin_amdgcn_readfirstlane((unsigned)v), hi = __builtin_amdgcn_readfirstlane((unsigned)(v >> 32));
    return (const float*)(((unsigned long long)hi << 32) | lo);
}
__device__ __forceinline__ void moe_decode(int j, int total, LAS const int* pre, LAS const int* cnt, int& e, int& mt, int& nrows) {
    if (j < total) {
        int lo = 0, hi = NEXP;
        while (hi - lo > 1) { const int mid = (lo + hi) >> 1; if (pre[mid] <= j) lo = mid; else hi = mid; }
        e = lo; mt = j - pre[e]; const int c = cnt[e] - mt * 128; nrows = c < 128 ? c : 128;
    } else { e = NEXP; mt = j - total; nrows = 128; }
}
__device__ __forceinline__ void phase_moe(const Args& a, ldsp lds, int G, int vcu) {
    const int tid = threadIdx.x, lane = tid & 63, wave = __builtin_amdgcn_readfirstlane(tid >> 6), fr = lane & 15, fq = lane >> 4;
    unsigned char* ws = a.ws;
    constexpr int AF8 = 0, BSTG = 32768, ACT = 65536, SLOTS = 131072, GWO = SLOTS + MOE_MAXT * 512;
    static_assert(GWO + MOE_MAXT * 512 <= SCR_BYTES, "slot lists overflow the scratch image");
    LAS int* pre = (LAS int*)(lds + MISC_OFF + 512);
    LAS int* cnt = (LAS int*)(lds + MISC_OFF + 2048);
    LAS int* wtot = (LAS int*)(lds + MISC_OFF + 3072);
    int myv = 0, myx = 0;
    if (tid < NEXP) {
        const int c = (int)((const unsigned*)(ws + WS_CTL) + CW_CNT)[32 * tid];
        cnt[tid] = c; myv = (c + 127) >> 7; myx = myv;
#pragma unroll
        for (int o = 1; o < 64; o <<= 1) { const int y = __shfl_up(myx, o); if (lane >= o) myx += y; }
        if (lane == 63) wtot[wave] = myx;
    }
    __syncthreads();
    if (tid < NEXP) { int base = 0; for (int w = 0; w < wave; ++w) base += wtot[w]; pre[tid] = base + myx - myv; if (tid == NEXP - 1) pre[NEXP] = base + myx; }
    __syncthreads();
    const int total = pre[NEXP], ntiles = total + T / 128;
    if (vcu >= ntiles) return;
    for (int tt = tid >> 7; vcu + tt * G < ntiles; tt += 4) {
        const int r = tid & 127; int e_, mt_, nr_; moe_decode(vcu + tt * G, total, pre, cnt, e_, mt_, nr_);
        int slot_ = -1; float gw_ = 0.f;
        if (r < nr_) { if (e_ < NEXP) { slot_ = ((const int*)(ws + WS_LIST))[(size_t)e_ * LISTCAP + mt_ * 128 + r]; gw_ = ((const float*)(ws + WS_GATEW))[(slot_ / NSLOT) * 8 + (slot_ % NSLOT)]; }
                       else { slot_ = (mt_ * 128 + r) * NSLOT + 8; gw_ = 1.f; } }
        ((LAS int*)(lds + SLOTS))[tt * 128 + r] = slot_; ((LAS float*)(lds + GWO))[tt * 128 + r] = gw_;
    }
    __syncthreads();
    if (wave >= 4) {
        const int lt = tid - 256;
        const unsigned char* H2 = ws + WS_H2;
        const int ln = lt & 63, kqu = wave - 4;
        const unsigned ldsb = (unsigned)(size_t)lds;
        const unsigned char *ap0, *ap1, *ap2, *ap3;
        int sn0, sn1, sn2, sn3;
#define L_SLOTS(it_) do { LAS const int* sl_ = (LAS const int*)(lds + SLOTS) + (it_) * 128 + 32 * kqu + (ln >> 3); sn0 = sl_[0]; sn1 = sl_[8]; sn2 = sl_[16]; sn3 = sl_[24]; } while (0)
#define L_APTR() do { const int s0_ = sn0, s1_ = sn1, s2_ = sn2, s3_ = sn3; const int px0_ = ((ln & 7) ^ (ln >> 4)) * 16, px1_ = ((ln & 7) ^ (4 + (ln >> 4))) * 16; \
            ap0 = H2 + (size_t)((s0_ < 0 ? 0 : s0_) / NSLOT) * D + px0_; ap1 = H2 + (size_t)((s1_ < 0 ? 0 : s1_) / NSLOT) * D + px1_; \
            ap2 = H2 + (size_t)((s2_ < 0 ? 0 : s2_) / NSLOT) * D + px0_; ap3 = H2 + (size_t)((s3_ < 0 ? 0 : s3_) / NSLOT) * D + px1_; } while (0)
#define L_DMA1(g_, m_) do { unsigned keep_; asm volatile("s_mov_b32 %0, m0\n\ts_mov_b32 m0, %2\n\ts_nop 0\n\tglobal_load_lds_dwordx4 %1, off\n\ts_mov_b32 m0, %0" : "=&s"(keep_) : "v"(g_), "s"(m_) : "memory"); } while (0)
#define L_DMA(grp_, buf_) do { const int ko_ = 128 * ((grp_) & 7); const unsigned d_ = __builtin_amdgcn_readfirstlane(ldsb + AF8 + (buf_) * 16384 + kqu * 4096); \
            L_DMA1(ap0 + ko_, d_); L_DMA1(ap1 + ko_, d_ + 1024u); L_DMA1(ap2 + ko_, d_ + 2048u); L_DMA1(ap3 + ko_, d_ + 3072u); } while (0)
#define L_DSW(p_, v_) asm volatile("ds_write_b128 %0, %1" :: "v"((unsigned)(size_t)(p_)), "v"(v_) : "memory")
#define L_BAR() do { asm volatile("s_waitcnt lgkmcnt(0)" ::: "memory"); __builtin_amdgcn_s_barrier(); } while (0)
        const int ng = lt & 63, kq = lt >> 6;
        const int loff256 = (8 * kq) * 256 + 4 * ng, loff1024 = (8 * kq) * 1024 + 4 * ng;
        const int bw = BSTG + kq * 4096 + (4 * ng) * 16, bx = ((4 * ng) >> 3) & 3;
        const int rho_d = 64 * (ng >> 4) + 16 * (ng & 3) + 4 * ((ng >> 2) & 3);
        const int bw_d = BSTG + kq * 4096 + rho_d * 16, bx_d = (rho_d >> 4) & 3;
        f32x4 B0[8], B1[8], B2[8], B3[8];
        int j = vcu, it = 0, e, mt, nrows;
        moe_decode(j, total, pre, cnt, e, mt, nrows);
#ifndef MOE_AUX
#define MOE_AUX 16
#endif
#define W_RSRC(eo_, pe_, ps_) __builtin_amdgcn_make_buffer_rsrc((void*)uni_ptr(((eo_) < NEXP) ? a.in[pe_] + (size_t)(eo_) * 262144 : a.in[ps_]), 0, 1 << 20, 0x00020000)
        const int eu0 = __builtin_amdgcn_readfirstlane(e);
        __amdgpu_buffer_rsrc_t Wg = W_RSRC(eu0, I_EG, I_SG), Wu = W_RSRC(eu0, I_EU, I_SU), Wd = W_RSRC(eu0, I_ED, I_SD);
        L_SLOTS(0); L_APTR();
#define L_LOADB1(WG_, WU_, WD_, s_, BR) do { const int ss_ = (s_); const int t_ = ss_ - 64; \
            const __amdgpu_buffer_rsrc_t r_ = (ss_ < 32) ? (WG_) : (ss_ < 64) ? (WU_) : (WD_); \
            const int vo_ = (ss_ < 64) ? 4 * loff256 : 4 * loff1024; \
            const int so_ = (ss_ < 32) ? (32 * ss_) * 1024 : (ss_ < 64) ? (32 * (ss_ - 32)) * 1024 : (32 * (t_ & 7)) * 4096 + 1024 * (t_ >> 3); \
            const int str_ = (ss_ < 64) ? 1024 : 4096;        \
            _Pragma("unroll") for (int jj = 0; jj < 8; ++jj) BR[jj] = __builtin_bit_cast(f32x4, __builtin_amdgcn_raw_buffer_load_b128(r_, vo_, so_ + jj * str_, MOE_AUX)); } while (0)
#define L_LOADB1P(WG_, WU_, WD_, s_, BR, j0_) do { const int ss_ = (s_); const int t_ = ss_ - 64; \
            const __amdgpu_buffer_rsrc_t r_ = (ss_ < 32) ? (WG_) : (ss_ < 64) ? (WU_) : (WD_); \
            const int vo_ = (ss_ < 64) ? 4 * loff256 : 4 * loff1024; \
            const int so_ = (ss_ < 32) ? (32 * ss_) * 1024 : (ss_ < 64) ? (32 * (ss_ - 32)) * 1024 : (32 * (t_ & 7)) * 4096 + 1024 * (t_ >> 3); \
            const int str_ = (ss_ < 64) ? 1024 : 4096; \
            _Pragma("unroll") for (int jj = (j0_); jj < (j0_) + 2; ++jj) BR[jj] = __builtin_bit_cast(f32x4, __builtin_amdgcn_raw_buffer_load_b128(r_, vo_, so_ + jj * str_, MOE_AUX)); } while (0)
#define L_LOAD2P(s_, BR, j0_) do { const int s0_ = (s_); const int t_ = s0_ < 31 ? s0_ : 31; \
            const int so_ = (32 * (t_ & 7)) * 4096 + 1024 * (t_ >> 3); \
            _Pragma("unroll") for (int jj = (j0_); jj < (j0_) + 2; ++jj) BR[jj] = __builtin_bit_cast(f32x4, __builtin_amdgcn_raw_buffer_load_b128(Wd, 4 * loff1024, so_ + jj * 4096, MOE_AUX)); } while (0)
#define L_WRITEB1(BR, buf_, i_, bw_, bx_) do { const int i = (i_); u32x4 w_; w_.x = cvtpk(BR[0][i], BR[1][i]); w_.y = cvtpk(BR[2][i], BR[3][i]); w_.z = cvtpk(BR[4][i], BR[5][i]); w_.w = cvtpk(BR[6][i], BR[7][i]); \
            L_DSW(lds + (buf_) * 16384 + (bw_) + ((i ^ (bx_)) * 16), w_); } while (0)
#define L_SB() __builtin_amdgcn_sched_barrier(0)
#define L_STEP1(WG_, WU_, WD_, ls_, LB, WB, wbuf_, ws_) do { const bool dn_ = (ws_) >= 64; const int bwx_ = dn_ ? bw_d : bw, bxx_ = dn_ ? bx_d : bx;        \
            _Pragma("unroll") for (int i4 = 0; i4 < 4; ++i4) { L_WRITEB1(WB, wbuf_, i4, bwx_, bxx_); L_SB(); L_LOADB1P(WG_, WU_, WD_, ls_, LB, 2 * i4); L_SB(); } } while (0)
#define L_STEP2(ls_, LB, WB, wbuf_) do { _Pragma("unroll") for (int i4 = 0; i4 < 4; ++i4) { L_WRITEB1(WB, wbuf_, i4, bw_d, bx_d); L_SB(); L_LOAD2P(ls_, LB, 2 * i4); L_SB(); } } while (0)
#define L_LOAD2(s_, BR) do { const int s0_ = (s_); const int t_ = s0_ < 31 ? s0_ : 31; \
            const int so_ = (32 * (t_ & 7)) * 4096 + 1024 * (t_ >> 3); \
            _Pragma("unroll") for (int jj = 0; jj < 8; ++jj) BR[jj] = __builtin_bit_cast(f32x4, __builtin_amdgcn_raw_buffer_load_b128(Wd, 4 * loff1024, so_ + jj * 4096, MOE_AUX)); } while (0)
#define L_WRITEB(BR, buf_) do { _Pragma("unroll") for (int i = 0; i < 4; ++i) { u32x4 w_; w_.x = cvtpk(BR[0][i], BR[1][i]); w_.y = cvtpk(BR[2][i], BR[3][i]); w_.z = cvtpk(BR[4][i], BR[5][i]); w_.w = cvtpk(BR[6][i], BR[7][i]); \
            L_DSW(lds + (buf_) * 16384 + bw + ((i ^ bx) * 16), w_); } } while (0)
        L_DMA(0, 0); L_LOADB1(Wg, Wu, Wd, 0, B0); L_LOADB1(Wg, Wu, Wd, 1, B1); L_LOADB1(Wg, Wu, Wd, 2, B2);
        for (;;) {
            const int jn = j + G; const bool more = jn < ntiles;
            int en = e, mtn = mt, nrn = nrows; if (more) { moe_decode(jn, total, pre, cnt, en, mtn, nrn); L_SLOTS(it + 1); }
            L_WRITEB(B0, 0);
            L_BAR();
            for (int s = 0; s < 64; s += 8) {
                L_DMA((s >> 2) + 1, 1); L_STEP1(Wg, Wu, Wd, s + 3, B3, B1, 1, s + 1); L_BAR();
                L_STEP1(Wg, Wu, Wd, s + 4, B0, B2, 0, s + 2); L_BAR();
                L_STEP1(Wg, Wu, Wd, s + 5, B1, B3, 1, s + 3); L_BAR();
                L_STEP1(Wg, Wu, Wd, s + 6, B2, B0, 0, s + 4); L_BAR();
                L_DMA((s >> 2) + 2, 0); L_STEP1(Wg, Wu, Wd, s + 7, B3, B1, 1, s + 5); L_BAR();
                L_STEP1(Wg, Wu, Wd, s + 8, B0, B2, 0, s + 6); L_BAR();
                L_STEP1(Wg, Wu, Wd, s + 9, B1, B3, 1, s + 7); L_BAR();
                L_STEP1(Wg, Wu, Wd, s + 10, B2, B0, 0, s + 8); L_BAR();
            }
            for (int s = 0; s < 28; s += 4) {
                L_STEP2(s + 3, B3, B1, 1); L_BAR();
                L_STEP2(s + 4, B0, B2, 0); L_BAR();
                L_STEP2(s + 5, B1, B3, 1); L_BAR();
                L_STEP2(s + 6, B2, B0, 0); L_BAR();
            }
            const int eun = __builtin_amdgcn_readfirstlane(en);
            const __amdgpu_buffer_rsrc_t Wgn = W_RSRC(eun, I_EG, I_SG), Wun = W_RSRC(eun, I_EU, I_SU), Wdn = W_RSRC(eun, I_ED, I_SD);
            L_STEP2(31, B3, B1, 1); L_BAR();
            L_APTR();
            L_DMA(0, 0); L_STEP1(Wgn, Wun, Wdn, 0, B0, B2, 0, 94); L_BAR();
            L_STEP1(Wgn, Wun, Wdn, 1, B1, B3, 1, 95); L_BAR();
            L_LOADB1(Wgn, Wun, Wdn, 2, B2); L_BAR();
            if (!more) break;
            j = jn; ++it; e = en; mt = mtn; nrows = nrn; Wg = Wgn; Wu = Wun; Wd = Wdn;
        }
#undef L_LOADB1
#undef L_LOADB1P
#undef L_LOAD2P
#undef L_WRITEB1
#undef L_STEP1
#undef L_STEP2
#undef L_SB
#undef W_RSRC
#undef L_APTR
#undef L_SLOTS
#undef L_DSW
#undef L_DMA
#undef L_DMA1
#undef L_BAR
#undef L_LOAD2
#undef L_WRITEB
    } else {
        const int wr = wave >> 1, wc = wave & 1;
        int rowm[4], ard[4], a8[4], brd[8], brdd[8];
        const int ax8 = (fr >> 1) & 7;
#pragma unroll
        for (int m = 0; m < 4; ++m) { rowm[m] = 64 * wr + 16 * m + fr; ard[m] = fq * 2048 + ((rowm[m] ^ (fq << 1)) * 16); a8[m] = AF8 + rowm[m] * 128 + (fq & 1) * 8; }
#pragma unroll
        for (int n = 0; n < 8; ++n) { const int rho = 128 * wc + 16 * n + fr; brd[n] = BSTG + fq * 4096 + ((rho ^ ((rho >> 3) & 3)) * 16); brdd[n] = BSTG + fq * 4096 + ((rho ^ ((rho >> 4) & 3)) * 16); }
        unsigned char* contrib = ws + WS_CONTRIB;
        f32x4 acc[4][8];
#define M_COMPUTE(abase_, buf_, BRD) do { \
            _Pragma("unroll") for (int nh = 0; nh < 2; ++nh) { bf16x8 af_[4], bf_[4]; \
                _Pragma("unroll") for (int m = 0; m < 4; ++m) af_[m] = *(LAS const bf16x8*)(lds + (abase_) + ard[m]); \
                _Pragma("unroll") for (int n = 0; n < 4; ++n) bf_[n] = *(LAS const bf16x8*)(lds + (buf_) * 16384 + BRD[4 * nh + n]); \
                _Pragma("unroll") for (int m = 0; m < 4; ++m) _Pragma("unroll") for (int n = 0; n < 4; ++n) acc[m][4 * nh + n] = mfma16(bf_[n], af_[m], acc[m][4 * nh + n]); } } while (0)
#define M_COMPUTE8(q_, abuf_, bbuf_) do { bf16x8 af_[4]; const int pz_ = (abuf_) * 16384 + (((2 * (q_) + (fq >> 1)) ^ ax8) << 4); \
            _Pragma("unroll") for (int m = 0; m < 4; ++m) { const u32x2 w_ = *(LAS const u32x2*)(lds + a8[m] + pz_); \
                const f32x2_t c0_ = __builtin_amdgcn_cvt_pk_f32_fp8((int)w_.x, false), c1_ = __builtin_amdgcn_cvt_pk_f32_fp8((int)w_.x, true), c2_ = __builtin_amdgcn_cvt_pk_f32_fp8((int)w_.y, false), c3_ = __builtin_amdgcn_cvt_pk_f32_fp8((int)w_.y, true); \
                u32x4 p_; p_.x = cvtpk(c0_[0], c0_[1]); p_.y = cvtpk(c1_[0], c1_[1]); p_.z = cvtpk(c2_[0], c2_[1]); p_.w = cvtpk(c3_[0], c3_[1]); af_[m] = __builtin_bit_cast(bf16x8, p_); } \
            _Pragma("unroll") for (int nh = 0; nh < 2; ++nh) { bf16x8 bf_[4]; \
                _Pragma("unroll") for (int n = 0; n < 4; ++n) bf_[n] = *(LAS const bf16x8*)(lds + (bbuf_) * 16384 + brd[4 * nh + n]); \
                _Pragma("unroll") for (int m = 0; m < 4; ++m) _Pragma("unroll") for (int n = 0; n < 4; ++n) acc[m][4 * nh + n] = mfma16(bf_[n], af_[m], acc[m][4 * nh + n]); } } while (0)
#define M_ZERO() do { _Pragma("unroll") for (int m = 0; m < 4; ++m) _Pragma("unroll") for (int n = 0; n < 8; ++n) acc[m][n] = (f32x4){0.f, 0.f, 0.f, 0.f}; } while (0)
        int it = 0;
        for (int j = vcu; j < ntiles; j += G, ++it) {
            __syncthreads();
            for (int s = 0; s < 64; s += 4) {
                if ((s & 31) == 0) M_ZERO();
                const int ab = (s >> 2) & 1;
                M_COMPUTE8(0, ab, 0); __syncthreads();
                M_COMPUTE8(1, ab, 1); __syncthreads();
                M_COMPUTE8(2, ab, 0); __syncthreads();
                M_COMPUTE8(3, ab, 1);
                if (s == 28) {
#pragma unroll
                    for (int m = 0; m < 4; ++m)
#pragma unroll
                        for (int n = 0; n < 8; ++n) {
                            const f32x4 gv = acc[m][n];
                            u32x2 w; w.x = cvtpk(silu_f(gv[0]), silu_f(gv[1])); w.y = cvtpk(silu_f(gv[2]), silu_f(gv[3]));
                            const int kc = 16 * wc + 2 * n + (fq >> 1);
                            *(LAS u32x2*)(lds + ACT + kc * 2048 + ((rowm[m] ^ ((kc & 3) << 1)) * 16) + (fq & 1) * 8) = w;
                        }
                } else if (s == 60) {
#pragma unroll
                    for (int m = 0; m < 4; ++m)
#pragma unroll
                        for (int n = 0; n < 8; ++n) {
                            const f32x4 uv = acc[m][n];
                            const int kc = 16 * wc + 2 * n + (fq >> 1);
                            LAS u32x2* ap = (LAS u32x2*)(lds + ACT + kc * 2048 + ((rowm[m] ^ ((kc & 3) << 1)) * 16) + (fq & 1) * 8);
                            const u32x2 g = *ap;
                            u32x2 w; w.x = cvtpk(bflo(g.x) * uv[0], bfhi(g.x) * uv[1]); w.y = cvtpk(bflo(g.y) * uv[2], bfhi(g.y) * uv[3]);
                            *ap = w;
                        }
                }
                __syncthreads();
            }
            for (int s = 0; s < 32; s += 4) {
                if ((s & 7) == 0) M_ZERO();
                M_COMPUTE(ACT + (s & 7) * 8192, 0, brdd); __syncthreads();
                M_COMPUTE(ACT + ((s + 1) & 7) * 8192, 1, brdd); __syncthreads();
                M_COMPUTE(ACT + ((s + 2) & 7) * 8192, 0, brdd); __syncthreads();
                M_COMPUTE(ACT + ((s + 3) & 7) * 8192, 1, brdd);
                if ((s & 7) == 4) {
                    const int q = s >> 3;
#pragma unroll
                    for (int m = 0; m < 4; ++m) {
                        const int slot = ((LAS const int*)(lds + SLOTS))[it * 128 + rowm[m]]; const float gw = ((LAS const float*)(lds + GWO))[it * 128 + rowm[m]];
                        if (slot >= 0) {
                            unsigned char* cp = contrib + (size_t)slot * D + q * 256 + 128 * wc + 16 * fq;
                            const float gs = gw * CONTRIB_SCALE;
#pragma unroll
                            for (int k = 0; k < 2; ++k) {
                                u32x4 w4;
#pragma unroll
                                for (int n = 0; n < 4; ++n) { const f32x4 v = acc[m][4 * k + n] * gs; int w = 0; w = __builtin_amdgcn_cvt_pk_fp8_f32(v[0], v[1], w, false); w = __builtin_amdgcn_cvt_pk_fp8_f32(v[2], v[3], w, true); w4[n] = (unsigned)w; }
                                *(u32x4*)(cp + 64 * k) = w4;
                            }
                        }
                    }
                }
                __syncthreads();
            }
        }
#undef M_COMPUTE
#undef M_COMPUTE8
#undef M_ZERO
    }
}

__device__ __forceinline__ void phase_combine(const Args& a, int G) {
    const int tid = threadIdx.x, lane = tid & 63, wave = __builtin_amdgcn_readfirstlane(tid >> 6), blk = blockIdx.x;
    unsigned char* ws = a.ws;
    const bf16* X1 = (const bf16*)(ws + WS_X1); const unsigned char* contrib = ws + WS_CONTRIB; const float* fg = a.in[I_FG];
    for (int t = blk * NWAVES + wave; t < T; t += G * NWAVES) {
        const float* g2 = (const float*)(ws + WS_ADAF) + (t >> 13) * 6144 + 5 * 1024;
        const int c = 16 * lane;
        float sm[16];
#pragma unroll
        for (int i = 0; i < 16; ++i) sm[i] = 0.f;
#pragma unroll
        for (int k = 0; k < NSLOT; ++k) {
            const u32x4 w = *(const u32x4*)(contrib + ((size_t)t * NSLOT + k) * D + c);
#pragma unroll
            for (int q = 0; q < 4; ++q) {
                const f32x2_t lo = __builtin_amdgcn_cvt_pk_f32_fp8((int)w[q], false), hi = __builtin_amdgcn_cvt_pk_f32_fp8((int)w[q], true);
                sm[4 * q] += lo[0]; sm[4 * q + 1] += lo[1]; sm[4 * q + 2] += hi[0]; sm[4 * q + 3] += hi[1];
            }
        }
        const u32x4 xa = *(const u32x4*)(X1 + (size_t)t * D + c), xb = *(const u32x4*)(X1 + (size_t)t * D + c + 8);
        const float x1[16] = {bflo(xa.x), bfhi(xa.x), bflo(xa.y), bfhi(xa.y), bflo(xa.z), bfhi(xa.z), bflo(xa.w), bfhi(xa.w), bflo(xb.x), bfhi(xb.x), bflo(xb.y), bfhi(xb.y), bflo(xb.z), bfhi(xb.z), bflo(xb.w), bfhi(xb.w)};
        f32x4 xv[4]; float ss = 0.f;
#pragma unroll
        for (int h = 0; h < 4; ++h) {
            const f32x4 gg = *(const f32x4*)(g2 + c + 4 * h);
            const f32x4 xx = {x1[4 * h], x1[4 * h + 1], x1[4 * h + 2], x1[4 * h + 3]};
            const f32x4 mv = {sm[4 * h], sm[4 * h + 1], sm[4 * h + 2], sm[4 * h + 3]};
            const f32x4 v = xx + gg * (mv * (1.f / CONTRIB_SCALE)); xv[h] = v; ss += (v[0] * v[0] + v[1] * v[1]) + (v[2] * v[2] + v[3] * v[3]);
        }
        const float r = rsqrtf(wave_sum(ss) * (1.f / D) + 1e-6f);
#pragma unroll
        for (int h = 0; h < 4; ++h) *(f32x4*)(a.out + (size_t)t * D + c + 4 * h) = (xv[h] * r) * *(const f32x4*)(fg + c + 4 * h);
    }
}

constexpr int NPH = 9;
#ifndef N_LAUNCHES
#define N_LAUNCHES 1
#endif
__global__ void __launch_bounds__(NWAVES * 64, 2) mega(Args a) {
    extern __shared__ __attribute__((aligned(16))) unsigned char lds_raw[];
    ldsp lds = (ldsp)lds_raw;
    const int tid = threadIdx.x, G = gridDim.x, bx = blockIdx.x;
    int vcu = (G % 8 == 0) ? (bx % 8) * (G / 8) + bx / 8 : bx;
    unsigned char* ws = a.ws;
    for (int u = tid; u < (LDS_BYTES - MISC_OFF) / 4; u += NWAVES * 64) ((LAS unsigned*)(lds + MISC_OFF))[u] = 0u;
    __syncthreads();
    volatile LAS unsigned* MISC = (volatile LAS unsigned*)(lds + MISC_OFF);
    XcdBarrier bar; bar.bar = (unsigned*)(ws + WS_CTL) + CW_BAR; bar.x = 0; bar.st = nullptr;
    if (N_LAUNCHES == 1) {
        bar = xcd_barrier_post((unsigned*)(ws + WS_CTL) + CW_BAR, MISC + 8);
        if (tid == 0) MISC[16] = atomicAdd((unsigned*)(ws + WS_CTL) + CW_XRANK + 64 * bar.x, 1u);
    }
    const int lo = a.ph_lo, hi = a.ph_hi;
#ifndef PH_MASK
#define PH_MASK 0x1ff
#endif
#define IN(k) (((PH_MASK >> (k)) & 1) && lo <= (k) && (k) < hi)
#define SEAM(k) do { if (IN(k) && IN((k) + 1)) xcd_barrier(bar); } while (0)
#ifndef PH_DUP
#define PH_DUP -1
#endif
#define REP(k) for (int rep_ = 0; rep_ < ((PH_DUP == (k)) ? 2 : 1); ++rep_)
    if (IN(0)) REP(0) { phase_prep(a, lds, G); } SEAM(0);
    if (N_LAUNCHES == 1 && IN(0) && IN(1)) {
        unsigned basex = 0;
        for (unsigned j = 0; j < bar.x; ++j) basex += xb_ld(&bar.bar[XB_XCNT(j)]);
        vcu = (int)(basex + MISC[16]);
    }
    if (IN(1)) REP(1) { phase_hnorm(a, lds, G); } SEAM(1);
    if (IN(2)) REP(2) {
        pg8::Gemm g{(const pg8::bf16_t*)(ws + WS_H), (const pg8::bf16_t*)(ws + WS_WINT), MH, DIN, D};
        WinOrder S; S.init(G, bx);
        EpiWin E{(bf16*)(ws + WS_Z), (bf16*)(ws + WS_KVC), (const float*)(ws + WS_ROPE)};
        pg8::gemm_phase<EpiWin, WinOrder, true, true>(lds, g, S, E);
    } SEAM(2);
    if (IN(3)) REP(3) { phase_mixers(a, lds, G, vcu); } SEAM(3);
    if (IN(4)) REP(4) {
        { pg8::Gemm g{(const pg8::bf16_t*)(ws + WS_A), (const pg8::bf16_t*)(ws + WS_WAT), T, D, 512};
          pg8::StaticOrder S; S.init(T, D, G, bx);
          EpiMergeA E{(const bf16*)(ws + WS_Z), (bf16*)(ws + WS_Y)};
          pg8::gemm_phase<EpiMergeA, pg8::StaticOrder, true, true>(lds, g, S, E); }
        { pg8::Gemm g{(const pg8::bf16_t*)(ws + WS_O), (const pg8::bf16_t*)(ws + WS_WBT), T, D, 512};
          pg8::StaticOrder S; S.init(T, D, G, bx);
          EpiMergeB E{(const bf16*)(ws + WS_Z), (bf16*)(ws + WS_Y)};
          pg8::gemm_phase<EpiMergeB, pg8::StaticOrder, true, true>(lds, g, S, E); }
    } SEAM(4);
    if (IN(5)) REP(5) {
        pg8::Gemm g{(const pg8::bf16_t*)(ws + WS_Y), (const pg8::bf16_t*)(ws + WS_WOT), T, D, D};
        pg8::StaticOrder S; S.init(T, D, G, bx);
        EpiWo E{a.in[I_X], (const float*)(ws + WS_ADAF), (bf16*)(ws + WS_X1)};
        pg8::gemm_phase<EpiWo, pg8::StaticOrder, true, true>(lds, g, S, E);
    } SEAM(5);
    if (IN(6)) { for (int it = vcu; it < T / 64; it += G) router_item(a, lds, it); } SEAM(6);
    if (IN(7)) REP(7) { phase_moe(a, lds, G, vcu); } SEAM(7);
    if (IN(8)) REP(8) { phase_combine(a, G); }
#undef IN
#undef SEAM
}

extern "C" void kernel_launch(void* const* d_in, const int* in_sizes, int n_in, void* d_out, int out_size, void* d_ws, size_t ws_size, hipStream_t stream) {
    static int grid = 0;
    if (grid == 0) {
        if (n_in != 26 || out_size != T * D || ws_size < WS_END) { fprintf(stderr, "kernel_launch: unexpected shapes (n_in %d, out %d, ws %zu)\n", n_in, out_size, ws_size); grid = -1; return; }
        int dev = 0, cus = 0, per_cu = 0;
        (void)hipGetDevice(&dev); (void)hipDeviceGetAttribute(&cus, hipDeviceAttributeMultiprocessorCount, dev);
        (void)hipFuncSetAttribute((const void*)mega, hipFuncAttributeMaxDynamicSharedMemorySize, LDS_BYTES);
        (void)hipOccupancyMaxActiveBlocksPerMultiprocessor(&per_cu, (const void*)mega, NWAVES * 64, LDS_BYTES);
        (void)hipGetLastError();
        if (per_cu < 1) { fprintf(stderr, "kernel_launch: occupancy query says %d blocks per CU\n", per_cu); per_cu = 1; }
        if (cus * MOE_MAXT < T * 8 / 128 + NEXP + T / 128) { fprintf(stderr, "kernel_launch: %d CUs are too few for the expert tile tables\n", cus); grid = -1; return; }
        grid = cus;
    }
    if (grid < 0) return;
    (void)hipMemsetAsync((char*)d_ws + WS_CTL, 0, CTL_ZERO_BYTES, stream);
    Args a{};
    for (int i = 0; i < 26; ++i) a.in[i] = (const float*)d_in[i];
    a.out = (float*)d_out; a.ws = (unsigned char*)d_ws;
    if (N_LAUNCHES == 1) {
        a.ph_lo = 0; a.ph_hi = NPH;
        void* kargs[] = {&a};
        hipError_t e = hipLaunchCooperativeKernel((const void*)mega, dim3(grid), dim3(NWAVES * 64), kargs, LDS_BYTES, stream);
        if (e != hipSuccess) fprintf(stderr, "kernel_launch: cooperative launch failed: %s (grid %d)\n", hipGetErrorString(e), grid);
    } else {
#ifndef HOST_DUP
#define HOST_DUP -1
#endif
        for (int li = 0; li < NPH; ++li) {
            a.ph_lo = li; a.ph_hi = li + 1;
            hipLaunchKernelGGL(mega, dim3(grid), dim3(NWAVES * 64), LDS_BYTES, stream, a);
            if (li == HOST_DUP) {
                if (li == 6) (void)hipMemsetAsync((char*)d_ws + WS_CTL, 0, CTL_ZERO_BYTES, stream);
                hipLaunchKernelGGL(mega, dim3(grid), dim3(NWAVES * 64), LDS_BYTES, stream, a);
            }
        }
    }
}
```
